# Optimizing an MI355X kernel written in HIP

```python
import jax, jax.numpy as jnp
from jax import lax
import numpy as np

D_MODEL = 1024
BATCH = 4
SEQ = 8192
DEPTH = 1

D_MIX = D_MODEL
HEAD_DIM = 64
GDN_HEADS = (D_MIX // 2) // HEAD_DIM
GDN_WIDTH = GDN_HEADS * HEAD_DIM
CONV_K = 4
CHUNK = 64
SWA_Q_HEADS = (D_MIX // 2) // HEAD_DIM
SWA_KV_HEADS = 2
SWA_GROUP = SWA_Q_HEADS // SWA_KV_HEADS
SWA_Q_WIDTH = SWA_Q_HEADS * HEAD_DIM
SWA_KV_WIDTH = SWA_KV_HEADS * HEAD_DIM
WINDOW = 128
BLOCK = 128
ROPE_THETA = 10000.0
N_GROUPS = 4
EXPERTS_PER_GROUP = 8
N_EXPERTS = N_GROUPS * EXPERTS_PER_GROUP
TOP_K = 2
D_EXPERT = D_MODEL // 4
EPS = 1e-6
IN_WIDTHS = (GDN_WIDTH, GDN_WIDTH, GDN_WIDTH, GDN_WIDTH, GDN_HEADS, GDN_HEADS,
             SWA_Q_WIDTH, SWA_KV_WIDTH, SWA_KV_WIDTH)
IN_WIDTH = sum(IN_WIDTHS)
MIX_OUT_WIDTH = GDN_WIDTH + SWA_Q_WIDTH

kernel_name = "hybrid_gdn_swa_sink_hmoe_adaln"


def rms_norm(x, gain):
    xf = x.astype(jnp.float32)
    y = xf * lax.rsqrt(jnp.mean(xf * xf, axis=-1, keepdims=True) + EPS)
    return (y * gain.astype(jnp.float32)).astype(x.dtype)


def l2_norm(x):
    return x * lax.rsqrt(jnp.sum(x * x, axis=-1, keepdims=True) + EPS)


def modulate(x, shift, scale):
    return x * (1 + scale[:, None, :]) + shift[:, None, :]


def causal_conv_silu(x, w):
    seq = x.shape[1]
    xp = jnp.pad(x, ((0, 0), (CONV_K - 1, 0), (0, 0)))
    y = xp[:, 0:seq] * w[0]
    for j in range(1, CONV_K):
        y = y + xp[:, j:j + seq] * w[j]
    return jax.nn.silu(y)


def rope(x, positions):
    half = x.shape[-1] // 2
    inv_freq = jnp.power(jnp.float32(ROPE_THETA), -jnp.arange(half, dtype=jnp.float32) / half)
    ang = positions.astype(jnp.float32)[..., None] * inv_freq
    cos = jnp.cos(ang)[:, :, None, :]
    sin = jnp.sin(ang)[:, :, None, :]
    xf = x.astype(jnp.float32)
    x1, x2 = xf[..., :half], xf[..., half:]
    out = jnp.concatenate([x1 * cos - x2 * sin, x1 * sin + x2 * cos], axis=-1)
    return out.astype(x.dtype)


def chunked_gated_delta_rule(q, k, v, g, beta):
    bsz, seq, heads, dh = q.shape
    n_chunks = seq // CHUNK

    def to_chunks(t):
        return t.reshape(bsz, n_chunks, CHUNK, heads, -1).transpose(0, 3, 1, 2, 4)

    q, k, v = to_chunks(q), to_chunks(k), to_chunks(v)
    g = g.reshape(bsz, n_chunks, CHUNK, heads).transpose(0, 3, 1, 2)
    beta = beta.reshape(bsz, n_chunks, CHUNK, heads).transpose(0, 3, 1, 2)
    G = jnp.cumsum(g, axis=-1)

    idx = jnp.arange(CHUNK)
    lower_incl = idx[:, None] >= idx[None, :]
    strict = idx[:, None] > idx[None, :]
    diff = G[..., :, None] - G[..., None, :]
    decay = jnp.where(lower_incl, jnp.exp(jnp.where(lower_incl, diff, 0.0)), 0.0)

    kb = k * beta[..., None]
    vb = v * beta[..., None]
    m = jnp.where(strict, jnp.einsum('bhncd,bhnsd->bhncs', kb, k) * decay, 0.0)
    eye = jnp.eye(CHUNK, dtype=jnp.float32)
    a_mat = eye + m
    t_mat = lax.linalg.triangular_solve(a_mat, jnp.broadcast_to(eye, a_mat.shape),
                                        left_side=True, lower=True)
    u = jnp.einsum('bhncs,bhnse->bhnce', t_mat, vb)
    w = jnp.einsum('bhncs,bhnsd->bhncd', t_mat, kb * jnp.exp(G)[..., None])
    qg = q * jnp.exp(G)[..., None]
    attn = jnp.einsum('bhncd,bhnsd->bhncs', q, k) * decay
    g_last = G[..., -1]
    k_dec = k * jnp.exp(g_last[..., None] - G)[..., None]

    xs = tuple(jnp.moveaxis(t, 2, 0) for t in (u, w, qg, attn, k_dec, g_last))

    def step(state, inp):
        u_n, w_n, qg_n, attn_n, kdec_n, gl_n = inp
        v_new = u_n - jnp.einsum('bhcd,bhde->bhce', w_n, state)
        o_n = (jnp.einsum('bhcd,bhde->bhce', qg_n, state)
               + jnp.einsum('bhcs,bhse->bhce', attn_n, v_new))
        state = (state * jnp.exp(gl_n)[..., None, None]
                 + jnp.einsum('bhcd,bhce->bhde', kdec_n, v_new))
        return state, o_n

    s0 = jnp.zeros((bsz, heads, dh, v.shape[-1]), jnp.float32)
    _, o = lax.scan(step, s0, xs)
    return o.transpose(1, 0, 3, 2, 4).reshape(bsz, seq, heads, -1)


def gated_deltanet(q_in, k_in, v_in, z, a, b, conv_w, a_log, dt_bias, out_norm):
    bsz, seq, _ = q_in.shape
    qkv = causal_conv_silu(jnp.concatenate([q_in, k_in, v_in], axis=-1), conv_w)
    q, k, v = jnp.split(qkv.astype(jnp.float32), 3, axis=-1)
    q = l2_norm(q.reshape(bsz, seq, GDN_HEADS, HEAD_DIM)) * (HEAD_DIM ** -0.5)
    k = l2_norm(k.reshape(bsz, seq, GDN_HEADS, HEAD_DIM))
    v = v.reshape(bsz, seq, GDN_HEADS, HEAD_DIM)
    g = -jnp.exp(a_log.astype(jnp.float32)) * jax.nn.softplus(
        a.astype(jnp.float32) + dt_bias.astype(jnp.float32))
    beta = jax.nn.sigmoid(b.astype(jnp.float32))
    o = chunked_gated_delta_rule(q, k, v, g, beta)
    zf = z.astype(jnp.float32).reshape(bsz, seq, GDN_HEADS, HEAD_DIM)
    o = rms_norm(o, out_norm) * jax.nn.silu(zf)
    return o.reshape(bsz, seq, GDN_WIDTH).astype(q_in.dtype)


def sliding_window_attention(q, k, v, q_norm, k_norm, sinks, positions):
    bsz, seq, _ = q.shape
    n_blk = seq // BLOCK
    q = rope(rms_norm(q.reshape(bsz, seq, SWA_Q_HEADS, HEAD_DIM), q_norm), positions)
    k = rope(rms_norm(k.reshape(bsz, seq, SWA_KV_HEADS, HEAD_DIM), k_norm), positions)
    v = v.reshape(bsz, seq, SWA_KV_HEADS, HEAD_DIM)

    qb = q.reshape(bsz, n_blk, BLOCK, SWA_KV_HEADS, SWA_GROUP, HEAD_DIM)

    def band(t):
        tb = t.reshape(bsz, n_blk, BLOCK, SWA_KV_HEADS, HEAD_DIM)
        prev = jnp.pad(tb[:, :-1], ((0, 0), (1, 0), (0, 0), (0, 0), (0, 0)))
        return jnp.concatenate([prev, tb], axis=2)

    k_band, v_band = band(k), band(v)
    scores = jnp.einsum('bnqhgd,bnkhd->bnhgqk', qb, k_band).astype(jnp.float32) * (HEAD_DIM ** -0.5)

    qi = jnp.arange(BLOCK)[:, None]
    kj = jnp.arange(2 * BLOCK)[None, :]
    rel = qi + BLOCK - kj
    in_window = (rel >= 0) & (rel < WINDOW)
    has_prev = jnp.arange(n_blk)[:, None, None] > 0
    valid = in_window[None] & (has_prev | (kj >= BLOCK)[None])
    scores = jnp.where(valid[None, :, None, None], scores, -jnp.inf)

    sink = sinks.astype(jnp.float32).reshape(SWA_KV_HEADS, SWA_GROUP)[None, None, :, :, None]
    mx = jnp.maximum(scores.max(axis=-1), sink)
    p = jnp.exp(scores - mx[..., None])
    denom = p.sum(axis=-1) + jnp.exp(sink - mx)
    p = p / denom[..., None]
    out = jnp.einsum('bnhgqk,bnkhd->bnqhgd', p, v_band.astype(jnp.float32))
    return out.reshape(bsz, seq, SWA_Q_WIDTH).astype(q.dtype)


def hierarchical_moe(h, w_group, b_group, w_router, b_router, w_gate, w_up, w_down):
    bsz, seq, d = h.shape
    t = h.reshape(-1, d)
    group_prob = jax.nn.softmax((t @ w_group + b_group).astype(jnp.float32), axis=-1)
    p_group, g_idx = lax.top_k(group_prob, 1)
    expert_logits = (t @ w_router + b_router).astype(jnp.float32).reshape(
        -1, N_GROUPS, EXPERTS_PER_GROUP)
    g_onehot = jax.nn.one_hot(g_idx[:, 0], N_GROUPS, dtype=jnp.float32)
    in_group = jnp.einsum('tg,tge->te', g_onehot, expert_logits)
    p_exp = jax.nn.softmax(in_group, axis=-1)
    w_top, e_idx = lax.top_k(p_exp, TOP_K)
    w_top = w_top / jnp.sum(w_top, axis=-1, keepdims=True) * p_group
    expert_ids = g_idx * EXPERTS_PER_GROUP + e_idx
    combine = jnp.sum(jax.nn.one_hot(expert_ids, N_EXPERTS, dtype=jnp.float32)
                      * w_top[..., None], axis=1)
    out = jnp.zeros(t.shape, jnp.float32)
    for e in range(N_EXPERTS):
        hid = jax.nn.silu(t @ w_gate[e]) * (t @ w_up[e])
        out = out + combine[:, e:e + 1] * (hid @ w_down[e]).astype(jnp.float32)
    return out.astype(h.dtype).reshape(bsz, seq, d)


def setup_inputs(seed: int = 0) -> dict:
    key = jax.random.key(seed)
    ks = jax.random.split(key, 24)
    f32 = jnp.float32
    nrm = lambda k, shape: jax.random.normal(k, shape, f32)
    dt = jnp.exp(jax.random.uniform(ks[6], (DEPTH, GDN_HEADS), f32,
                                    jnp.log(jnp.float32(1e-3)), jnp.log(jnp.float32(1e-1))))
    return {
        "x": nrm(ks[0], (BATCH, SEQ, D_MODEL)),
        "c": nrm(ks[1], (BATCH, D_MODEL)),
        "positions": jnp.broadcast_to(jnp.arange(SEQ, dtype=jnp.int32), (BATCH, SEQ)),
        "w_ada": nrm(ks[2], (DEPTH, D_MODEL, 6 * D_MODEL)) * (0.5 * D_MODEL ** -0.5),
        "b_ada": 0.01 * nrm(ks[3], (DEPTH, 6 * D_MODEL)),
        "norm_mix": 1.0 + 0.1 * nrm(ks[4], (DEPTH, D_MODEL)),
        "w_in": nrm(ks[5], (DEPTH, D_MODEL, IN_WIDTH)) * D_MODEL ** -0.5,
        "conv_w": nrm(ks[7], (DEPTH, CONV_K, 3 * GDN_WIDTH)) * CONV_K ** -0.5,
        "a_log": jnp.log(jax.random.uniform(ks[8], (DEPTH, GDN_HEADS), f32, 1.0, 16.0)),
        "dt_bias": jnp.log(jnp.expm1(dt)),
        "gdn_out_norm": 1.0 + 0.1 * nrm(ks[9], (DEPTH, HEAD_DIM)),
        "q_norm": 1.0 + 0.1 * nrm(ks[10], (DEPTH, HEAD_DIM)),
        "k_norm": 1.0 + 0.1 * nrm(ks[11], (DEPTH, HEAD_DIM)),
        "sinks": nrm(ks[12], (DEPTH, SWA_Q_HEADS)),
        "w_out": nrm(ks[13], (DEPTH, MIX_OUT_WIDTH, D_MODEL)) * MIX_OUT_WIDTH ** -0.5,
        "norm_ffn": 1.0 + 0.1 * nrm(ks[14], (DEPTH, D_MODEL)),
        "w_group": nrm(ks[15], (DEPTH, D_MODEL, N_GROUPS)) * D_MODEL ** -0.5,
        "b_group": 0.01 * nrm(ks[16], (DEPTH, N_GROUPS)),
        "w_router": nrm(ks[17], (DEPTH, D_MODEL, N_EXPERTS)) * D_MODEL ** -0.5,
        "b_router": 0.01 * nrm(ks[18], (DEPTH, N_EXPERTS)),
        "w_gate": nrm(ks[19], (DEPTH, N_EXPERTS, D_MODEL, D_EXPERT)) * D_MODEL ** -0.5,
        "w_up": nrm(ks[20], (DEPTH, N_EXPERTS, D_MODEL, D_EXPERT)) * D_MODEL ** -0.5,
        "w_down": nrm(ks[21], (DEPTH, N_EXPERTS, D_EXPERT, D_MODEL)) * D_EXPERT ** -0.5,
    }


def reference(x, c, positions, w_ada, b_ada, norm_mix, w_in, conv_w, a_log, dt_bias,
              gdn_out_norm, q_norm, k_norm, sinks, w_out, norm_ffn, w_group, b_group,
              w_router, b_router, w_gate, w_up, w_down):
    split_points = tuple(int(s) for s in np.cumsum(IN_WIDTHS)[:-1])
    c_act = jax.nn.silu(c)
    for l in range(DEPTH):
        mod = c_act @ w_ada[l] + b_ada[l]
        shift1, scale1, gate1, shift2, scale2, gate2 = jnp.split(mod, 6, axis=-1)

        h = modulate(rms_norm(x, norm_mix[l]), shift1, scale1)
        proj = h @ w_in[l]
        (g_q, g_k, g_v, g_z, g_a, g_b, s_q, s_k, s_v) = jnp.split(proj, split_points, axis=-1)
        gdn_out = gated_deltanet(g_q, g_k, g_v, g_z, g_a, g_b, conv_w[l], a_log[l],
                                 dt_bias[l], gdn_out_norm[l])
        swa_out = sliding_window_attention(s_q, s_k, s_v, q_norm[l], k_norm[l],
                                           sinks[l], positions)
        mixed = jnp.concatenate([gdn_out, swa_out], axis=-1) @ w_out[l]
        x = x + gate1[:, None, :] * mixed

        h2 = modulate(rms_norm(x, norm_ffn[l]), shift2, scale2)
        ffn = hierarchical_moe(h2, w_group[l], b_group[l], w_router[l], b_router[l],
                               w_gate[l], w_up[l], w_down[l])
        x = x + gate2[:, None, :] * ffn
    return x
```

```cpp
#include <hip/hip_runtime.h>
#include <cstdio>
#include <cstdint>
namespace pg8 {
#define PG8_LAS __attribute__((address_space(3)))
typedef unsigned short bf16_t;
typedef short bf16x8 __attribute__((ext_vector_type(8)));
typedef float f32x4 __attribute__((ext_vector_type(4)));
typedef unsigned u32x4 __attribute__((ext_vector_type(4)));
constexpr int BM = 256, BK = 64, HALF = 128, HTB = HALF * BK * 2  , STAGE_BYTES = 8 * HTB, NXCD = 8, WGM = 8;

__host__ __device__ __forceinline__ int lds_byte(int r, int c) { const int st = (r >> 4) * 2 + (c >> 5), rr = r & 15, cc = c & 31, ob = rr * 64 + cc * 2; return st * 1024 + (ob ^ (((ob >> 9) & 1) << 5)); }
__host__ __device__ __forceinline__ void stage_rc(int b, int& R, int& C) { const int st = b / 1024, sb = b % 1024, swz = sb ^ (((sb >> 9) & 1) << 5); R = (st >> 1) * 16 + swz / 64; C = (st & 1) * 32 + (swz % 64) / 2; }
__host__ __device__ __forceinline__ int perm32(int rho) { const int n = rho >> 4, i = rho & 15; return 8 * (i >> 2) + 4 * n + (i & 3); }

struct Unit { int pm, pn; };
struct Gemm { const bf16_t* A; const bf16_t* Bt; int M, N, K; };

struct StaticOrder {
    int nM, nN, nwg, G, c;
    __host__ __device__ void init(int M, int N, int G_, int c_) { nM = M / BM; nN = N / BM; nwg = nM * nN; G = G_; c = c_; }
    __host__ __device__ bool next(int i, Unit& u) const {
        const long L = (long)i * G + c; if (L >= nwg) return false;
        int wgid = (int)L; { const int q = nwg / NXCD, r = nwg % NXCD, xcd = wgid % NXCD, off = wgid / NXCD; wgid = (xcd < r ? xcd * (q + 1) : r * (q + 1) + (xcd - r) * q) + off; }
        const int nig = WGM * nN, gid = wgid / nig, fm = gid * WGM, gsz = (nM - fm) < WGM ? (nM - fm) : WGM;
        u.pm = fm + ((wgid % nig) % gsz); u.pn = (wgid % nig) / gsz; return true;
    }
    __device__ __forceinline__ void a_ready(const Unit&) const {}
    __device__ __forceinline__ void done(const Unit&) const {}
};

__device__ __forceinline__ unsigned cvt_pk_bf16(float lo, float hi) { unsigned r; asm volatile("v_cvt_pk_bf16_f32 %0, %1, %2" : "=v"(r) : "v"(lo), "v"(hi)); return r; }

struct EpiProj {
    static constexpr bool PERM = true, AFTER_DRAIN = false;
    bf16_t* P; float* AB; int ldp;
    __device__ __forceinline__ void operator()(const f32x4 (&acc)[2][2][4][2], const Unit& u, int wr, int wc, int fr, int fq) const {
        const int row0 = u.pm * BM + wr * 64 + fr;
        if (u.pn < 11) {
            const int col0 = u.pn * BM + wc * 32 + 8 * fq;
#pragma unroll
            for (int ai = 0; ai < 2; ++ai)
#pragma unroll
                for (int m = 0; m < 4; ++m) { bf16_t* rowp = P + (size_t)(row0 + ai * HALF + m * 16) * ldp + col0;
#pragma unroll
                    for (int bj = 0; bj < 2; ++bj) { const f32x4 v0 = acc[ai][bj][m][0], v1 = acc[ai][bj][m][1];
                        u32x4 w; w.x = cvt_pk_bf16(v0[0], v0[1]); w.y = cvt_pk_bf16(v0[2], v0[3]); w.z = cvt_pk_bf16(v1[0], v1[1]); w.w = cvt_pk_bf16(v1[2], v1[3]);
                        *(u32x4*)(rowp + bj * HALF) = w; } }
        } else if (wc == 0 && fq < 2) {
#pragma unroll
            for (int ai = 0; ai < 2; ++ai)
#pragma unroll
                for (int m = 0; m < 4; ++m) { float* rowp = AB + (size_t)(row0 + ai * HALF + m * 16) * 16 + 8 * fq;
                    *(f32x4*)(rowp) = acc[ai][0][m][0]; *(f32x4*)(rowp + 4) = acc[ai][0][m][1]; }
        }
    }
};
struct EpiOut {
    static constexpr bool PERM = false, AFTER_DRAIN = false;
    const float* X; float* O; const float* gate; int rows_per_batch, ldg;
    __device__ __forceinline__ void operator()(const f32x4 (&acc)[2][2][4][2], const Unit& u, int wr, int wc, int fr, int fq) const {
        const int row0 = u.pm * BM + wr * 64 + fr, col0 = u.pn * BM + wc * 32 + 4 * fq;
        const float* gb = gate + (size_t)((u.pm * BM) / rows_per_batch) * ldg + col0;
        f32x4 gv[2][2];
#pragma unroll
        for (int bj = 0; bj < 2; ++bj)
#pragma unroll
            for (int n = 0; n < 2; ++n) gv[bj][n] = *(const f32x4*)(gb + bj * HALF + n * 16);
#pragma unroll
        for (int ai = 0; ai < 2; ++ai)
#pragma unroll
            for (int m = 0; m < 4; ++m) { const size_t ro = (size_t)(row0 + ai * HALF + m * 16) * 1024 + col0;
#pragma unroll
                for (int bj = 0; bj < 2; ++bj)
#pragma unroll
                    for (int n = 0; n < 2; ++n) { const f32x4 xv = *(const f32x4*)(X + ro + bj * HALF + n * 16);
                        *(f32x4*)(O + ro + bj * HALF + n * 16) = xv + gv[bj][n] * acc[ai][bj][m][n]; } }
    }
};
template <class Epi, class Sched, bool ALIGN_EPI = false, bool SP2 = false>
__device__ __forceinline__ void gemm_phase(PG8_LAS unsigned char* lds, const Gemm g, const Sched& S, const Epi& E) {
    const int tid = threadIdx.x, wid = __builtin_amdgcn_readfirstlane(tid >> 6), lane = tid & 63, wr = wid >> 2, wc = wid & 3, fr = lane & 15, fq = lane >> 4;
    const int K = g.K, nt = K / BK;
    unsigned voffA[2], voffB[2];
#pragma unroll
    for (int i = 0; i < 2; ++i) { int R, C; stage_rc(tid * 16 + i * 8192, R, C); const int Rb = Epi::PERM ? ((R & ~31) + perm32(R & 31)) : R;
        voffA[i] = (unsigned)(R * K + C) * 2u; voffB[i] = (unsigned)(Rb * K + C) * 2u; }
    const size_t kstep = (size_t)(BK * 2);
    const size_t hstep = (size_t)HALF * K * 2;
    const size_t tstep = 2 * hstep;
    const unsigned ldsw = (unsigned)wid * 1024u;
    const int aoff = lds_byte(wr * 64 + fr, fq * 8), boff = lds_byte(wc * 32 + fr, fq * 8);
#define PG8_SA(b, h) (((b) * 2 + (h)) * HTB)
#define PG8_SB(b, h) ((4 + (b) * 2 + (h)) * HTB)
#define PG8_STAGE(bufoff, gbase, voff) do { _Pragma("unroll") for (int _i = 0; _i < 2; ++_i) \
        __builtin_amdgcn_global_load_lds((const unsigned*)((const char*)(gbase) + (voff)[_i]), (PG8_LAS unsigned*)(lds + (bufoff) + ldsw + _i * 8192), 16, 0, 0); } while (0)
#define PG8_LDA(dst, b, h) do { _Pragma("unroll") for (int m = 0; m < 4; ++m) _Pragma("unroll") for (int k = 0; k < 2; ++k) dst[m][k] = *(const PG8_LAS bf16x8*)(lds + PG8_SA(b, h) + aoff + m * 2048 + k * 1024); } while (0)
#define PG8_LDB(dst, b, h) do { _Pragma("unroll") for (int n = 0; n < 2; ++n) _Pragma("unroll") for (int k = 0; k < 2; ++k) dst[n][k] = *(const PG8_LAS bf16x8*)(lds + PG8_SB(b, h) + boff + n * 2048 + k * 1024); } while (0)
#define PG8_MMA(ai, bj, At, Bt) do { __builtin_amdgcn_s_setprio(1); _Pragma("unroll") for (int m = 0; m < 4; ++m) _Pragma("unroll") for (int n = 0; n < 2; ++n) _Pragma("unroll") for (int k = 0; k < 2; ++k) \
        acc[ai][bj][m][n] = __builtin_amdgcn_mfma_f32_16x16x32_bf16(Bt[n][k], At[m][k], acc[ai][bj][m][n], 0, 0, 0); __builtin_amdgcn_s_setprio(0); } while (0)
#define PG8_WAIT_V(n) asm volatile("s_waitcnt vmcnt(" #n ")" ::: "memory")
#define PG8_WAIT_L(n) asm volatile("s_waitcnt lgkmcnt(" #n ")" ::: "memory")
#define PG8_BAR __builtin_amdgcn_s_barrier()
#define PG8_SCHED __builtin_amdgcn_sched_barrier(0)
    Unit cur, nxt; int ui = 0;
    if (!S.next(0, cur)) return;
    f32x4 acc[2][2][4][2];
#pragma unroll
    for (int a = 0; a < 2; ++a)
#pragma unroll
        for (int b = 0; b < 2; ++b)
#pragma unroll
            for (int m = 0; m < 4; ++m)
#pragma unroll
                for (int n = 0; n < 2; ++n) acc[a][b][m][n] = (f32x4){0.f, 0.f, 0.f, 0.f};
    bf16x8 At[4][2], B0[2][2], B1[2][2];
    const char* cA = (const char*)g.A + (size_t)cur.pm * tstep; const char* cB = (const char*)g.Bt + (size_t)cur.pn * tstep;
    S.a_ready(cur);
    if constexpr (SP2) {
        PG8_STAGE(PG8_SB(0, 0), cB, voffB); PG8_STAGE(PG8_SB(0, 1), cB + hstep, voffB); PG8_STAGE(PG8_SA(0, 0), cA, voffA); PG8_STAGE(PG8_SA(0, 1), cA + hstep, voffA);
        if (wr == 1) PG8_BAR;
        PG8_WAIT_V(2); PG8_BAR;
        PG8_STAGE(PG8_SB(1, 0), cB + kstep, voffB); PG8_STAGE(PG8_SA(1, 0), cA + kstep, voffA); PG8_STAGE(PG8_SB(1, 1), cB + hstep + kstep, voffB);
        PG8_WAIT_V(6); PG8_BAR;
    } else {
        PG8_STAGE(PG8_SB(0, 0), cB, voffB); PG8_STAGE(PG8_SA(0, 0), cA, voffA); PG8_STAGE(PG8_SB(0, 1), cB + hstep, voffB); PG8_STAGE(PG8_SA(0, 1), cA + hstep, voffA);
        if (wr == 1) PG8_BAR;
        PG8_WAIT_V(4); PG8_BAR;
        PG8_STAGE(PG8_SB(1, 0), cB + kstep, voffB); PG8_STAGE(PG8_SA(1, 0), cA + kstep, voffA); PG8_STAGE(PG8_SB(1, 1), cB + hstep + kstep, voffB);
        PG8_WAIT_V(6); PG8_BAR;
    }
    for (;;) {
        const bool has_next = S.next(ui + 1, nxt);
        const char* nA = has_next ? (const char*)g.A + (size_t)nxt.pm * tstep : cA; const char* nB = has_next ? (const char*)g.Bt + (size_t)nxt.pn * tstep : cB;
        for (int t = 0; t < nt; t += 2) {
            const bool last = (t == nt - 2);
            const char* a1 = cA + (size_t)(t + 1) * kstep;
            const char* a2 = last ? nA : cA + (size_t)(t + 2) * kstep; const char* b2 = last ? nB : cB + (size_t)(t + 2) * kstep;
            const char* a3 = a2 + kstep; const char* b3 = b2 + kstep;
            if (last && has_next) S.a_ready(nxt);
            if constexpr (SP2) {
            PG8_LDB(B0, 0, 0); PG8_LDB(B1, 0, 1); PG8_SCHED; PG8_LDA(At, 0, 0); PG8_STAGE(PG8_SA(1, 1), a1 + hstep, voffA);
            PG8_WAIT_V(8); PG8_WAIT_L(0); PG8_BAR; PG8_MMA(0, 0, At, B0); PG8_MMA(0, 1, At, B1); PG8_BAR; PG8_SCHED;
            PG8_LDA(At, 0, 1); PG8_STAGE(PG8_SB(0, 0), b2, voffB); PG8_STAGE(PG8_SB(0, 1), b2 + hstep, voffB); PG8_STAGE(PG8_SA(0, 0), a2, voffA);
            PG8_WAIT_V(8); PG8_WAIT_L(0); PG8_BAR; PG8_MMA(1, 0, At, B0); PG8_MMA(1, 1, At, B1); PG8_BAR; PG8_SCHED;
            PG8_LDB(B0, 1, 0); PG8_LDB(B1, 1, 1); PG8_SCHED; PG8_LDA(At, 1, 0); PG8_STAGE(PG8_SA(0, 1), a2 + hstep, voffA);
            PG8_WAIT_V(8); PG8_WAIT_L(0); PG8_BAR; PG8_MMA(0, 0, At, B0); PG8_MMA(0, 1, At, B1); PG8_BAR; PG8_SCHED;
            PG8_LDA(At, 1, 1); PG8_STAGE(PG8_SB(1, 0), b3, voffB); PG8_STAGE(PG8_SB(1, 1), b3 + hstep, voffB); PG8_STAGE(PG8_SA(1, 0), a3, voffA);
            PG8_WAIT_V(8); PG8_WAIT_L(0); PG8_BAR; PG8_MMA(1, 0, At, B0); PG8_MMA(1, 1, At, B1); PG8_BAR; PG8_SCHED;
            } else {
            PG8_LDB(B0, 0, 0); PG8_SCHED; PG8_LDA(At, 0, 0); PG8_STAGE(PG8_SA(1, 1), a1 + hstep, voffA);
            PG8_WAIT_L(8); PG8_BAR; PG8_WAIT_L(0); PG8_MMA(0, 0, At, B0); PG8_BAR; PG8_SCHED;
            PG8_LDB(B1, 0, 1); PG8_STAGE(PG8_SB(0, 0), b2, voffB);
            PG8_BAR; PG8_WAIT_L(0); PG8_MMA(0, 1, At, B1); PG8_BAR;
            PG8_LDA(At, 0, 1); PG8_STAGE(PG8_SA(0, 0), a2, voffA);
            PG8_BAR; PG8_WAIT_L(0); PG8_MMA(1, 0, At, B0); PG8_BAR; PG8_SCHED;
            PG8_STAGE(PG8_SB(0, 1), b2 + hstep, voffB);
            PG8_WAIT_V(6); PG8_BAR; PG8_MMA(1, 1, At, B1); PG8_BAR;
            PG8_LDB(B0, 1, 0); PG8_SCHED; PG8_LDA(At, 1, 0); PG8_STAGE(PG8_SA(0, 1), a2 + hstep, voffA);
            PG8_WAIT_L(8); PG8_BAR; PG8_WAIT_L(0); PG8_MMA(0, 0, At, B0); PG8_BAR; PG8_SCHED;
            PG8_LDB(B1, 1, 1); PG8_STAGE(PG8_SB(1, 0), b3, voffB);
            PG8_BAR; PG8_WAIT_L(0); PG8_MMA(0, 1, At, B1); PG8_BAR;
            PG8_LDA(At, 1, 1); PG8_STAGE(PG8_SA(1, 0), a3, voffA);
            PG8_BAR; PG8_WAIT_L(0); PG8_MMA(1, 0, At, B0); PG8_BAR; PG8_SCHED;
            PG8_STAGE(PG8_SB(1, 1), b3 + hstep, voffB);
            PG8_WAIT_V(6); PG8_BAR; PG8_MMA(1, 1, At, B1); PG8_BAR;
            }
        }
        if constexpr (ALIGN_EPI) { if (wr == 0) PG8_BAR; }
        if constexpr (!Epi::AFTER_DRAIN) { E(acc, cur, wr, wc, fr, fq); S.done(cur); }
        if (!has_next) break;
#pragma unroll
        for (int a = 0; a < 2; ++a)
#pragma unroll
            for (int b = 0; b < 2; ++b)
#pragma unroll
                for (int m = 0; m < 4; ++m)
#pragma unroll
                    for (int n = 0; n < 2; ++n) acc[a][b][m][n] = (f32x4){0.f, 0.f, 0.f, 0.f};
        cur = nxt; cA = nA; cB = nB; ++ui;
        if constexpr (ALIGN_EPI) { if (wr == 1) PG8_BAR; }
    }
    PG8_WAIT_V(0);
    if constexpr (!ALIGN_EPI) { if (wr == 0) PG8_BAR; }
    PG8_BAR;
    if constexpr (Epi::AFTER_DRAIN) { E.fused(acc, cur, wr, wc, fr, fq, lds, wid, lane); S.done(cur); }
#undef PG8_SA
#undef PG8_SB
#undef PG8_STAGE
#undef PG8_LDA
#undef PG8_LDB
#undef PG8_MMA
#undef PG8_WAIT_V
#undef PG8_WAIT_L
#undef PG8_BAR
#undef PG8_SCHED
}
}

constexpr int NB = 4, SEQ = 8192, DM = 1024, TT = NB * SEQ;
constexpr int NPROJ = 2816, NPAD = 3072;
constexpr int PC_Q = 0, PC_K = 512, PC_V = 1024, PC_Z = 1536, PC_SQ = 2048, PC_SK = 2560, PC_SV = 2688;
constexpr int NE = 32, NCLS = 112, DE = 256;
constexpr float EPS = 1e-6f;
constexpr int NWAVES = 8, NTHR = 512;
constexpr int N_PHASES = 9;
#ifndef MK_ONE_LAUNCH
#define MK_ONE_LAUNCH 0
#endif

constexpr size_t MiB = 1u << 20;
constexpr size_t WS_CTL = 0, CTL_ZERO_BYTES = 1 * MiB;
constexpr size_t WS_MOD = 1 * MiB;
constexpr size_t WS_WINT = 2 * MiB, WS_WOUTT = 8 * MiB, WS_WGUT = 10 * MiB, WS_WDT = 42 * MiB;
constexpr size_t WS_H = 58 * MiB;
constexpr size_t WS_PROJ = 122 * MiB;
constexpr size_t WS_AB = 298 * MiB;
constexpr size_t WS_MIX = 300 * MiB;
constexpr size_t WS_QR = 364 * MiB, WS_KR = 428 * MiB;
constexpr size_t WS_META = 444 * MiB;
constexpr size_t WS_ELIST = 446 * MiB, WS_CLIST = 450 * MiB;
constexpr size_t WS_HID = WS_PROJ;
constexpr size_t WS_END = 464 * MiB;
constexpr int CW_BAR = 4096, CW_ECNT = 8192, CW_CCNT = 8256;

constexpr int RING_BYTES = 131072, LDSCTL_OFF = RING_BYTES, MISC_OFF = LDSCTL_OFF + 320, LDS_BYTES = 147456;

#define GAS __attribute__((address_space(1)))
#define LAS __attribute__((address_space(3)))
typedef unsigned short bf16;
typedef unsigned v4u __attribute__((ext_vector_type(4)));
typedef float f32x4 __attribute__((ext_vector_type(4)));
typedef GAS unsigned gu32;
#define RLX_AGENT __ATOMIC_RELAXED, __HIP_MEMORY_SCOPE_AGENT
#define LDS_WAIT() asm volatile("s_waitcnt lgkmcnt(0)" ::: "memory")
__device__ __forceinline__ unsigned f2bf(float f) { unsigned u = __builtin_bit_cast(unsigned, f); return (u + 0x7fffu + ((u >> 16) & 1u)) >> 16; }
__device__ __forceinline__ unsigned pk2(float lo, float hi) { return f2bf(lo) | (f2bf(hi) << 16); }
__device__ __forceinline__ float bf2f(bf16 v) { return __builtin_bit_cast(float, (unsigned)v << 16); }
__device__ __forceinline__ float wave_sum(float v) {
#pragma unroll
    for (int o = 1; o < 64; o <<= 1) v += __shfl_xor(v, o);
    return v;
}
__device__ __forceinline__ float siluf(float y) { return y / (1.f + __expf(-y)); }
#define XB_TMO      128
#define XB_XCNT(j)  (256  + 64 * (j))
#define XB_XSUB(j)  (1280 + 64 * (j))
#define XB_XGEN(j)  (2304 + 64 * (j))
#define XB_TOP      3328
#define XB_TOPGEN   3392
#define XCD_BAR_WORDS 3456
#define XB_SPIN_CAP (1u << 18)
__device__ __forceinline__ unsigned xb_ld(unsigned* p)              { return __hip_atomic_load(p, __ATOMIC_RELAXED, __HIP_MEMORY_SCOPE_AGENT); }
__device__ __forceinline__ unsigned xb_add(unsigned* p, unsigned v) { return __hip_atomic_fetch_add(p, v, __ATOMIC_RELAXED, __HIP_MEMORY_SCOPE_AGENT); }
__device__ __forceinline__ unsigned xb_xcc_id() { return (unsigned)__builtin_amdgcn_s_getreg((3 << 11) | 20) & 0xFu; }
#define XB_SPIN(cond, bar) do { unsigned _sp = 0; while (cond) { __builtin_amdgcn_s_sleep(1); \
    if ((++_sp & 255u) == 0u) { if (xb_ld(&(bar)[XB_TMO])) break; if (_sp > XB_SPIN_CAP) { atomicAdd(&(bar)[XB_TMO], 1u); break; } } } } while (0)

struct XcdBarrier {
    unsigned* bar; unsigned x;
    volatile LAS unsigned* st;
};

__device__ __forceinline__ XcdBarrier xcd_barrier_post(unsigned* bar, volatile LAS unsigned* st) {
    XcdBarrier b; b.bar = bar; b.x = xb_xcc_id(); b.st = st;
    if (threadIdx.x == 0) (void)xb_add(&bar[XB_XCNT(b.x)], 1u);
    return b;
}
__device__ __forceinline__ void xcd_barrier_complete(unsigned* bar, unsigned x, unsigned& nloc, unsigned& nx) {
    const unsigned G = gridDim.x * gridDim.y * gridDim.z;
    unsigned sum, cnt, mine, sp = 0u;
    for (;;) {
        sum = 0u; cnt = 0u; mine = 0u;
#pragma unroll
        for (unsigned j = 0; j < 16; ++j) { const unsigned c = xb_ld(&bar[XB_XCNT(j)]); sum += c; cnt += (c > 0u) ? 1u : 0u; mine = (j == x) ? c : mine; }
        if (sum == G) break;
        __builtin_amdgcn_s_sleep(1);
        if ((++sp & 255u) == 0u) { if (xb_ld(&bar[XB_TMO])) break; if (sp > XB_SPIN_CAP) { atomicAdd(&bar[XB_TMO], 1u); break; } }
    }
    nloc = mine > 0u ? mine : 1u; nx = cnt > 0u ? cnt : 1u;
}

__device__ __forceinline__ void xcd_barrier(const XcdBarrier& b) {
    asm volatile("s_waitcnt vmcnt(0)" ::: "memory");
    __syncthreads();
    if (threadIdx.x == 0) {
        unsigned* bar = b.bar;
        __builtin_amdgcn_s_waitcnt(0);
        unsigned nloc = b.st[0], nx = b.st[1];
        if (nloc == 0u) { xcd_barrier_complete(bar, b.x, nloc, nx); b.st[0] = nloc; b.st[1] = nx; }
        const unsigned old = xb_add(&bar[XB_XSUB(b.x)], 1u);
        const unsigned gen = old / nloc;
        if (old + 1u == (gen + 1u) * nloc) {
            __builtin_amdgcn_fence(__ATOMIC_RELEASE, "agent");
            asm volatile("s_waitcnt vmcnt(0)" ::: "memory");
            const unsigned og = xb_add(&bar[XB_TOP], 1u);
            const unsigned tg = og / nx;
            if (og + 1u == (tg + 1u) * nx) xb_add(&bar[XB_TOPGEN], 1u);
            else XB_SPIN(xb_ld(&bar[XB_TOPGEN]) == tg, bar);
            __builtin_amdgcn_fence(__ATOMIC_ACQUIRE, "agent");
            xb_add(&bar[XB_XGEN(b.x)], 1u);
            asm volatile("s_waitcnt vmcnt(0)" ::: "memory");
        } else {
            XB_SPIN(xb_ld(&bar[XB_XGEN(b.x)]) == gen, bar);
            __builtin_amdgcn_fence(__ATOMIC_ACQUIRE, "agent");
            asm volatile("s_waitcnt vmcnt(0)" ::: "memory");
        }
    }
    __syncthreads();
}

struct Args { const void* in[23]; float* out; unsigned char* ws; int ph_lo, ph_hi; };
enum { I_X = 0, I_C, I_POS, I_WADA, I_BADA, I_NORM_MIX, I_WIN, I_CONVW, I_ALOG, I_DTB, I_GNORM, I_QNORM, I_KNORM, I_SINKS, I_WOUT, I_NORM_FFN, I_WGRP, I_BGRP, I_WRT, I_BRT, I_WGATE, I_WUP, I_WDOWN };

template <class CM>
__device__ __forceinline__ void transpose_item(const float* W, int ldw, int k0, bf16* WT, int ldt, int n0, CM cm, LAS float* scr, int lane) {
    const int sc = cm(n0 + (lane & 31));
#pragma unroll 8
    for (int i = 0; i < 32; ++i) { const int kk = 2 * i + (lane >> 5); scr[kk * 33 + (lane & 31)] = sc >= 0 ? W[(size_t)(k0 + kk) * ldw + sc] : 0.f; }
    LDS_WAIT(); asm volatile("" ::: "memory");
    const int c = lane & 7;
#pragma unroll
    for (int j = 0; j < 4; ++j) { const int n = (lane >> 3) + 8 * j; const LAS float* s = scr + (8 * c) * 33 + n;
        v4u o; o.x = pk2(s[0 * 33], s[1 * 33]); o.y = pk2(s[2 * 33], s[3 * 33]); o.z = pk2(s[4 * 33], s[5 * 33]); o.w = pk2(s[6 * 33], s[7 * 33]);
        *(v4u*)(WT + (size_t)(n0 + n) * ldt + k0 + 8 * c) = o; }
    LDS_WAIT(); asm volatile("" ::: "memory");
}
struct CmIn { __device__ __forceinline__ int operator()(int n) const { return n < 2048 ? n : (n < 2816 ? n + 16 : (n < 2832 ? 2048 + (n - 2816) : -1)); } };
struct CmId { __device__ __forceinline__ int operator()(int n) const { return n; } };

__device__ __forceinline__ void p0_prologue(const Args& A, LAS unsigned char* lds, int tid, int lane, int wave) {
    unsigned char* ws = A.ws;
    LAS float* scr = (LAS float*)(lds + wave * 8448);
    const int G = gridDim.x, gw = blockIdx.x * NWAVES + wave, NGW = G * NWAVES;
    constexpr int IT_IN = (NPAD / 32) * (DM / 64), IT_OUT = (DM / 32) * (DM / 64);
    for (int it = gw; it < IT_IN + IT_OUT; it += NGW) {
        if (it < IT_IN) { const int nb = it % (NPAD / 32), kb = it / (NPAD / 32); transpose_item((const float*)A.in[I_WIN], 2832, kb * 64, (bf16*)(ws + WS_WINT), DM, nb * 32, CmIn(), scr, lane); }
        else { const int r = it - IT_IN, nb = r % (DM / 32), kb = r / (DM / 32); transpose_item((const float*)A.in[I_WOUT], DM, kb * 64, (bf16*)(ws + WS_WOUTT), DM, nb * 32, CmId(), scr, lane); }
    }
    LAS float* cact = (LAS float*)(lds + 69632);
    LAS float* red = (LAS float*)(lds + 69632 + 16384);
    const float* c = (const float*)A.in[I_C]; const float* wada = (const float*)A.in[I_WADA]; const float* bada = (const float*)A.in[I_BADA];
    float* mod = (float*)(ws + WS_MOD);
    if ((int)blockIdx.x < 96) {
        __syncthreads();
        for (int i = tid; i < 4096; i += NTHR) cact[i] = siluf(c[i]);
        __syncthreads();
        for (int u = blockIdx.x; u < 96; u += G) {
            const int n = u * 64 + lane; float a0 = 0.f, a1 = 0.f, a2 = 0.f, a3 = 0.f;
            for (int k = wave * 128; k < wave * 128 + 128; ++k) { const float w = wada[(size_t)k * 6144 + n]; a0 += cact[k] * w; a1 += cact[1024 + k] * w; a2 += cact[2048 + k] * w; a3 += cact[3072 + k] * w; }
            red[(wave * 4 + 0) * 64 + lane] = a0; red[(wave * 4 + 1) * 64 + lane] = a1; red[(wave * 4 + 2) * 64 + lane] = a2; red[(wave * 4 + 3) * 64 + lane] = a3;
            __syncthreads();
            if (tid < 256) { const int b = tid >> 6, l = tid & 63; float s = bada[u * 64 + l];
#pragma unroll
                for (int w = 0; w < 8; ++w) s += red[(w * 4 + b) * 64 + l];
                mod[b * 6144 + u * 64 + l] = s; }
            __syncthreads();
        }
    }
}

template <bool ROUTE>
__device__ __forceinline__ void norm_rows(const Args& A, const float* X, const float* gain, const float* shift, const float* scale, bf16* H, LAS unsigned char* lds, int lane, int wave) {
    LAS float* hl = (LAS float*)(lds + wave * 4096);
    const int G = gridDim.x, gw = blockIdx.x * NWAVES + wave, NGW = G * NWAVES;
    unsigned char* ws = A.ws;
    for (int r0 = gw * 16; r0 < TT; r0 += NGW * 16) {
        const int b = r0 / SEQ;
        f32x4 mf[4], af[4];
#pragma unroll
        for (int j = 0; j < 4; ++j) { const int col = 4 * lane + 256 * j; const f32x4 g = *(const f32x4*)(gain + col), sc = *(const f32x4*)(scale + b * 6144 + col);
            mf[j] = g * (sc + 1.0f); af[j] = *(const f32x4*)(shift + b * 6144 + col); }
        for (int i = 0; i < 16; ++i) {
            const int row = r0 + i;
            const f32x4* xr = (const f32x4*)(X + (size_t)row * DM) + lane;
            f32x4 v[4]; float s = 0.f;
#pragma unroll
            for (int j = 0; j < 4; ++j) { v[j] = xr[64 * j]; s += (v[j].x * v[j].x + v[j].y * v[j].y) + (v[j].z * v[j].z + v[j].w * v[j].w); }
            const float rstd = 1.f / sqrtf(wave_sum(s) * (1.f / DM) + EPS);
            unsigned long long* o8 = (unsigned long long*)(H + (size_t)row * DM) + lane;
#pragma unroll
            for (int j = 0; j < 4; ++j) { v[j] = v[j] * rstd * mf[j] + af[j];
                o8[64 * j] = (unsigned long long)pk2(v[j].x, v[j].y) | ((unsigned long long)pk2(v[j].z, v[j].w) << 32); }
            if constexpr (ROUTE) {
                const float* wg = (const float*)A.in[I_WGRP]; const float* wr = (const float*)A.in[I_WRT];
                float lg[36];
#pragma unroll
                for (int o = 0; o < 36; ++o) lg[o] = 0.f;
#pragma unroll
                for (int j = 0; j < 4; ++j) *(LAS f32x4*)(hl + 4 * lane + 256 * j) = v[j];
                LDS_WAIT(); asm volatile("" ::: "memory");
#pragma unroll 1
                for (int ii = 0; ii < 16; ++ii) { const int k = lane + 64 * ii; const float hv = hl[k];
                    const f32x4 g4 = *(const f32x4*)(wg + k * 4);
                    lg[0] += hv * g4.x; lg[1] += hv * g4.y; lg[2] += hv * g4.z; lg[3] += hv * g4.w;
#pragma unroll
                    for (int q = 0; q < 8; ++q) { const f32x4 r4 = *(const f32x4*)(wr + k * 32 + q * 4);
                        lg[4 + q * 4 + 0] += hv * r4.x; lg[4 + q * 4 + 1] += hv * r4.y; lg[4 + q * 4 + 2] += hv * r4.z; lg[4 + q * 4 + 3] += hv * r4.w; } }
                LDS_WAIT(); asm volatile("" ::: "memory");
#pragma unroll
                for (int o = 0; o < 36; ++o) lg[o] = wave_sum(lg[o]);
                const float* bg = (const float*)A.in[I_BGRP]; const float* br = (const float*)A.in[I_BRT];
#pragma unroll
                for (int o = 0; o < 4; ++o) lg[o] += bg[o];
#pragma unroll
                for (int o = 0; o < 32; ++o) lg[4 + o] += br[o];
                int gi = 0; float gm = lg[0];
#pragma unroll
                for (int o = 1; o < 4; ++o) if (lg[o] > gm) { gm = lg[o]; gi = o; }
                float gs = 0.f;
#pragma unroll
                for (int o = 0; o < 4; ++o) gs += __expf(lg[o] - gm);
                const float pg = 1.f / gs;
                float le[8];
#pragma unroll
                for (int j = 0; j < 8; ++j) { le[j] = lg[4 + j];
#pragma unroll
                    for (int g = 1; g < 4; ++g) le[j] = (gi == g) ? lg[4 + g * 8 + j] : le[j]; }
                int j1 = 0; float m1 = le[0];
#pragma unroll
                for (int j = 1; j < 8; ++j) if (le[j] > m1) { m1 = le[j]; j1 = j; }
                int j2 = -1; float m2 = -3.0e38f;
#pragma unroll
                for (int j = 0; j < 8; ++j) if (j != j1 && le[j] > m2) { m2 = le[j]; j2 = j; }
                const float ex = __expf(m2 - m1), w1 = pg / (1.f + ex), w2 = pg * ex / (1.f + ex);
                if (lane == 0) {
                    const int e1 = gi * 8 + j1, e2 = gi * 8 + j2;
                    int* meta = (int*)(ws + WS_META) + (size_t)row * 4;
                    meta[0] = e1; meta[1] = e2; meta[2] = __builtin_bit_cast(int, w1); meta[3] = __builtin_bit_cast(int, w2);
                    unsigned* ctl = (unsigned*)(ws + WS_CTL);
                    int* elist = (int*)(ws + WS_ELIST); int* clist = (int*)(ws + WS_CLIST);
                    const unsigned p1 = atomicAdd(ctl + CW_ECNT + e1, 1u); elist[(size_t)e1 * TT + p1] = row * 2;
                    const unsigned p2 = atomicAdd(ctl + CW_ECNT + e2, 1u); elist[(size_t)e2 * TT + p2] = row * 2 + 1;
                    const int a = j1 < j2 ? j1 : j2, bb = j1 < j2 ? j2 : j1;
                    const int cls = gi * 28 + (a * 7 - (a * (a - 1)) / 2 + (bb - a - 1));
                    const unsigned pc = atomicAdd(ctl + CW_CCNT + cls, 1u); clist[(size_t)cls * TT + pc] = row;
                }
            }
        }
    }
}

__device__ __forceinline__ void swa_prep(const Args& A, int lane, int wave) {
    unsigned char* ws = A.ws;
    const int G = gridDim.x, gw = blockIdx.x * NWAVES + wave, NGW = G * NWAVES;
    const bf16* proj = (const bf16*)(ws + WS_PROJ); float* qr = (float*)(ws + WS_QR); float* kr = (float*)(ws + WS_KR);
    const int* pos = (const int*)A.in[I_POS];
    const float qg = ((const float*)A.in[I_QNORM])[lane], kg = ((const float*)A.in[I_KNORM])[lane];
    const float inv = powf(10000.f, -(float)(lane & 31) / 32.f);
    for (int t = gw; t < TT; t += NGW) {
        const float ang = (float)pos[t] * inv; float sn, cs; sincosf(ang, &sn, &cs);
        for (int hd = 0; hd < 10; ++hd) {
            const int col = hd < 8 ? PC_SQ + hd * 64 : PC_SK + (hd - 8) * 64;
            const float x = bf2f(proj[(size_t)t * NPROJ + col + lane]);
            const float ss = wave_sum(x * x);
            const float xn = x * (1.f / sqrtf(ss * (1.f / 64.f) + EPS)) * (hd < 8 ? qg : kg);
            const float pr = __shfl_xor(xn, 32);
            const float o = lane < 32 ? xn * cs - pr * sn : pr * sn + xn * cs;
            if (hd < 8) qr[(size_t)t * 512 + hd * 64 + lane] = o; else kr[(size_t)t * 128 + (hd - 8) * 64 + lane] = o;
        }
    }
}
__device__ __forceinline__ void swa_naive(const Args& A, int tid, int blk, int nblk) {
    unsigned char* ws = A.ws;
    const bf16* proj = (const bf16*)(ws + WS_PROJ); const float* qr = (const float*)(ws + WS_QR); const float* kr = (const float*)(ws + WS_KR);
    bf16* mix = (bf16*)(ws + WS_MIX); const float* sinks = (const float*)A.in[I_SINKS];
    for (int item = blk * NTHR + tid; item < TT * 8; item += nblk * NTHR) {
        const int t = item >> 3, hq = item & 7, kvh = hq >> 2, b = t / SEQ, p = t % SEQ;
        float q[64], acc[64];
#pragma unroll
        for (int d = 0; d < 64; d += 4) { const f32x4 v = *(const f32x4*)(qr + (size_t)t * 512 + hq * 64 + d); q[d] = v.x * 0.125f; q[d + 1] = v.y * 0.125f; q[d + 2] = v.z * 0.125f; q[d + 3] = v.w * 0.125f; }
#pragma unroll
        for (int d = 0; d < 64; ++d) acc[d] = 0.f;
        float m = sinks[hq], l = 1.f;
        const int k0 = p - 127 > 0 ? p - 127 : 0;
        for (int kp = k0; kp <= p; ++kp) {
            const size_t tk = (size_t)b * SEQ + kp;
            float s = 0.f;
#pragma unroll
            for (int d = 0; d < 64; d += 4) { const f32x4 v = *(const f32x4*)(kr + tk * 128 + kvh * 64 + d); s += q[d] * v.x + q[d + 1] * v.y + q[d + 2] * v.z + q[d + 3] * v.w; }
            if (s > m) { const float sc = __expf(m - s); l *= sc;
#pragma unroll
                for (int d = 0; d < 64; ++d) acc[d] *= sc;
                m = s; }
            const float pe = __expf(s - m); l += pe;
#pragma unroll
            for (int d = 0; d < 64; d += 8) { const v4u raw = *(const v4u*)(proj + tk * NPROJ + PC_SV + kvh * 64 + d);
                acc[d + 0] += pe * __builtin_bit_cast(float, raw.x << 16); acc[d + 1] += pe * __builtin_bit_cast(float, raw.x & 0xffff0000u);
                acc[d + 2] += pe * __builtin_bit_cast(float, raw.y << 16); acc[d + 3] += pe * __builtin_bit_cast(float, raw.y & 0xffff0000u);
                acc[d + 4] += pe * __builtin_bit_cast(float, raw.z << 16); acc[d + 5] += pe * __builtin_bit_cast(float, raw.z & 0xffff0000u);
                acc[d + 6] += pe * __builtin_bit_cast(float, raw.w << 16); acc[d + 7] += pe * __builtin_bit_cast(float, raw.w & 0xffff0000u); }
        }
        const float il = 1.f / l;
#pragma unroll
        for (int d = 0; d < 64; d += 8) { v4u o; o.x = pk2(acc[d] * il, acc[d + 1] * il); o.y = pk2(acc[d + 2] * il, acc[d + 3] * il); o.z = pk2(acc[d + 4] * il, acc[d + 5] * il); o.w = pk2(acc[d + 6] * il, acc[d + 7] * il);
            *(v4u*)(mix + (size_t)t * DM + 512 + hq * 64 + d) = o; }
    }
}

__device__ __forceinline__ void gdn_naive(const Args& A, int bh, LAS float* L, int tid) {
    unsigned char* ws = A.ws;
    const bf16* proj = (const bf16*)(ws + WS_PROJ); const float* ab = (const float*)(ws + WS_AB); bf16* mix = (bf16*)(ws + WS_MIX);
    const float* convw = (const float*)A.in[I_CONVW]; const float* onorm = (const float*)A.in[I_GNORM];
    const int b = bh >> 3, h = bh & 7;
    constexpr int LD = 65, AR = 64 * LD;
    LAS float* S = L; LAS float* q = S + AR; LAS float* k = q + AR; LAS float* v = k + AR; LAS float* Mm = v + AR; LAS float* At = Mm + AR; LAS float* w = At + AR;
    LAS float* Gc = w + AR; LAS float* beta = Gc + 64;
    for (int i = tid; i < AR; i += NTHR) S[i] = 0.f;
    const float Ah = expf(((const float*)A.in[I_ALOG])[h]), dtb = ((const float*)A.in[I_DTB])[h];
    const int i8 = tid >> 3, e0 = (tid & 7) * 8;
    for (int n = 0; n < SEQ / 64; ++n) {
        const int t0 = b * SEQ + n * 64;
        __syncthreads();
        for (int idx = tid; idx < 3 * 4096; idx += NTHR) {
            const int part = idx >> 12, rem = idx & 4095, i = rem >> 6, d = rem & 63, c = part * 512 + h * 64 + d;
            float y = 0.f;
#pragma unroll
            for (int j = 0; j < 4; ++j) { const int s = n * 64 + i - 3 + j; if (s >= 0) y += convw[j * 1536 + c] * bf2f(proj[(size_t)(b * SEQ + s) * NPROJ + c]); }
            y = y / (1.f + expf(-y));
            (part == 0 ? q : (part == 1 ? k : v))[i * LD + d] = y;
        }
        if (tid < 64) { const float a = ab[(size_t)(t0 + tid) * 16 + h], bb = ab[(size_t)(t0 + tid) * 16 + 8 + h]; const float xx = a + dtb;
            const float sp = xx > 20.f ? xx : log1pf(expf(xx)); Gc[tid] = -Ah * sp; beta[tid] = 1.f / (1.f + expf(-bb)); }
        __syncthreads();
        if (tid < 128) { LAS float* arr = tid < 64 ? q : k; const int i = tid & 63; float ss = 0.f;
            for (int d = 0; d < 64; ++d) ss += arr[i * LD + d] * arr[i * LD + d];
            const float r = (1.f / sqrtf(ss + EPS)) * (tid < 64 ? 0.125f : 1.f);
            for (int d = 0; d < 64; ++d) arr[i * LD + d] *= r; }
        if (tid == 128) { float run = 0.f; for (int i = 0; i < 64; ++i) { run += Gc[i]; Gc[i] = run; } }
        __syncthreads();
        {
            const int i = i8;
            for (int jj = 0; jj < 8; ++jj) { const int j = e0 + jj; float dq = 0.f, dk = 0.f;
                _Pragma("unroll 2") for (int d = 0; d < 64; ++d) { const float kj = k[j * LD + d]; dq += q[i * LD + d] * kj; dk += k[i * LD + d] * kj; }
                const float dec = (i >= j) ? expf(Gc[i] - Gc[j]) : 0.f;
                At[i * LD + j] = dq * dec; Mm[i * LD + j] = (i > j) ? dk * beta[i] * dec : 0.f; }
        }
        __syncthreads();
        for (int idx = tid; idx < 4096; idx += NTHR) { const int i = idx >> 6, d = idx & 63; v[i * LD + d] *= beta[i]; w[i * LD + d] = k[i * LD + d] * beta[i] * expf(Gc[i]); }
        __syncthreads();
        if (tid < 128) { LAS float* arr = tid < 64 ? v : w; const int c = tid & 63;
            _Pragma("unroll 1") for (int i = 1; i < 64; ++i) { float a = arr[i * LD + c]; _Pragma("unroll 4") for (int j = 0; j < i; ++j) a -= Mm[i * LD + j] * arr[j * LD + c]; arr[i * LD + c] = a; } }
        __syncthreads();
        {
            const int i = i8; float a[8];
#pragma unroll
            for (int ee = 0; ee < 8; ++ee) a[ee] = v[i * LD + e0 + ee];
_Pragma("unroll 2")
            for (int d = 0; d < 64; ++d) { const float wv = w[i * LD + d];
#pragma unroll
                for (int ee = 0; ee < 8; ++ee) a[ee] -= wv * S[d * LD + e0 + ee]; }
#pragma unroll
            for (int ee = 0; ee < 8; ++ee) v[i * LD + e0 + ee] = a[ee];
        }
        __syncthreads();
        float o[8];
        {
            const int i = i8;
#pragma unroll
            for (int ee = 0; ee < 8; ++ee) o[ee] = 0.f;
_Pragma("unroll 2")
            for (int d = 0; d < 64; ++d) { const float qv = q[i * LD + d];
#pragma unroll
                for (int ee = 0; ee < 8; ++ee) o[ee] += qv * S[d * LD + e0 + ee]; }
            const float eg = expf(Gc[i]);
#pragma unroll
            for (int ee = 0; ee < 8; ++ee) o[ee] *= eg;
_Pragma("unroll 2")
            for (int j = 0; j <= i; ++j) { const float av = At[i * LD + j];
#pragma unroll
                for (int ee = 0; ee < 8; ++ee) o[ee] += av * v[j * LD + e0 + ee]; }
        }
        __syncthreads();
        {
            const int d = i8; const float gl = Gc[63]; float a[8]; const float egl = expf(gl);
#pragma unroll
            for (int ee = 0; ee < 8; ++ee) a[ee] = S[d * LD + e0 + ee] * egl;
_Pragma("unroll 2")
            for (int i = 0; i < 64; ++i) { const float kv = k[i * LD + d] * expf(gl - Gc[i]);
#pragma unroll
                for (int ee = 0; ee < 8; ++ee) a[ee] += kv * v[i * LD + e0 + ee]; }
#pragma unroll
            for (int ee = 0; ee < 8; ++ee) S[d * LD + e0 + ee] = a[ee];
        }
        {
            const int i = i8; float ss = 0.f;
#pragma unroll
            for (int ee = 0; ee < 8; ++ee) ss += o[ee] * o[ee];
            ss += __shfl_xor(ss, 1); ss += __shfl_xor(ss, 2); ss += __shfl_xor(ss, 4);
            const float r = 1.f / sqrtf(ss * (1.f / 64.f) + EPS);
            const v4u zr = *(const v4u*)(proj + (size_t)(t0 + i) * NPROJ + PC_Z + h * 64 + e0);
            float z[8] = { __builtin_bit_cast(float, zr.x << 16), __builtin_bit_cast(float, zr.x & 0xffff0000u), __builtin_bit_cast(float, zr.y << 16), __builtin_bit_cast(float, zr.y & 0xffff0000u),
                           __builtin_bit_cast(float, zr.z << 16), __builtin_bit_cast(float, zr.z & 0xffff0000u), __builtin_bit_cast(float, zr.w << 16), __builtin_bit_cast(float, zr.w & 0xffff0000u) };
            float y[8];
#pragma unroll
            for (int ee = 0; ee < 8; ++ee) y[ee] = o[ee] * r * onorm[e0 + ee] * siluf(z[ee]);
            v4u ov; ov.x = pk2(y[0], y[1]); ov.y = pk2(y[2], y[3]); ov.z = pk2(y[4], y[5]); ov.w = pk2(y[6], y[7]);
            *(v4u*)(mix + (size_t)(t0 + i) * DM + h * 64 + e0) = ov;
        }
    }
}

__device__ __forceinline__ void moe1_naive(const Args& A, LAS unsigned char* lds, int tid) {
    unsigned char* ws = A.ws;
    const unsigned* ctl = (const unsigned*)(ws + WS_CTL); const int* elist = (const int*)(ws + WS_ELIST); const int* meta = (const int*)(ws + WS_META);
    const bf16* h2 = (const bf16*)(ws + WS_H); float* hid = (float*)(ws + WS_HID);
    const float* wgate = (const float*)A.in[I_WGATE]; const float* wup = (const float*)A.in[I_WUP];
    LAS float* xs = (LAS float*)lds;
    LAS int* pre = (LAS int*)(lds + 65536);
    LAS int* ent = (LAS int*)(lds + 65536 + 256);
    __syncthreads();
    if (tid == 0) { int s = 0; for (int e = 0; e < NE; ++e) { pre[e] = s; s += ((int)ctl[CW_ECNT + e] + 15) / 16; } pre[NE] = s; }
    __syncthreads();
    const int nun = pre[NE];
    for (int u = blockIdx.x; u < nun; u += gridDim.x) {
        int e = 0; while (u >= pre[e + 1]) ++e;
        const int tile = u - pre[e], cnt = (int)ctl[CW_ECNT + e], nin = (cnt - tile * 16) < 16 ? (cnt - tile * 16) : 16;
        if (tid < 16) ent[tid] = tid < nin ? elist[(size_t)e * TT + tile * 16 + tid] : -1;
        __syncthreads();
        for (int idx = tid; idx < 16 * 1024; idx += NTHR) { const int r = idx >> 10, k = idx & 1023, en = ent[r]; xs[idx] = en >= 0 ? bf2f(h2[(size_t)(en >> 1) * DM + k]) : 0.f; }
        __syncthreads();
        const int j = tid & 255, hf = tid >> 8;
        float ag[8], au[8];
#pragma unroll
        for (int r = 0; r < 8; ++r) { ag[r] = 0.f; au[r] = 0.f; }
        for (int k = 0; k < 1024; ++k) { const float g = wgate[((size_t)e * 1024 + k) * 256 + j], uu = wup[((size_t)e * 1024 + k) * 256 + j];
#pragma unroll
            for (int r = 0; r < 8; ++r) { const float x = xs[(hf * 8 + r) * 1024 + k]; ag[r] += x * g; au[r] += x * uu; } }
#pragma unroll
        for (int r = 0; r < 8; ++r) { const int en = ent[hf * 8 + r];
            if (en >= 0) { const int t = en >> 1, slot = en & 1; const int eo = meta[(size_t)t * 4 + (slot ? 0 : 1)]; const float wt = __builtin_bit_cast(float, meta[(size_t)t * 4 + 2 + slot]);
                hid[(size_t)t * 512 + (e > eo ? 256 : 0) + j] = wt * siluf(ag[r]) * au[r]; } }
        __syncthreads();
    }
}
__device__ __forceinline__ void moe2_naive(const Args& A, LAS unsigned char* lds, int tid) {
    unsigned char* ws = A.ws;
    const unsigned* ctl = (const unsigned*)(ws + WS_CTL); const int* clist = (const int*)(ws + WS_CLIST);
    const float* hid = (const float*)(ws + WS_HID); const float* wdown = (const float*)A.in[I_WDOWN]; const float* mod = (const float*)(ws + WS_MOD);
    float* out = A.out;
    LAS float* hs = (LAS float*)lds;
    LAS int* pre = (LAS int*)(lds + 32768);
    LAS int* tk = (LAS int*)(lds + 32768 + 512);
    __syncthreads();
    if (tid == 0) { int s = 0; for (int c = 0; c < NCLS; ++c) { pre[c] = s; s += ((int)ctl[CW_CCNT + c] + 15) / 16; } pre[NCLS] = s; }
    __syncthreads();
    const int nun = pre[NCLS];
    for (int u = blockIdx.x; u < nun; u += gridDim.x) {
        int c = 0; while (u >= pre[c + 1]) ++c;
        const int tile = u - pre[c], cnt = (int)ctl[CW_CCNT + c], nin = (cnt - tile * 16) < 16 ? (cnt - tile * 16) : 16;
        const int g = c / 28; int a = 0, rem = c % 28; while (rem >= 7 - a) { rem -= 7 - a; ++a; } const int bb = a + 1 + rem;
        const int ea = g * 8 + a, eb = g * 8 + bb;
        if (tid < 16) tk[tid] = tid < nin ? clist[(size_t)c * TT + tile * 16 + tid] : -1;
        __syncthreads();
        for (int idx = tid; idx < 16 * 512; idx += NTHR) { const int r = idx >> 9, k = idx & 511, t = tk[r]; hs[idx] = t >= 0 ? hid[(size_t)t * 512 + k] : 0.f; }
        __syncthreads();
        const int n = tid & 255, hf = tid >> 8;
        float acc[8][4];
#pragma unroll
        for (int r = 0; r < 8; ++r)
#pragma unroll
            for (int cc = 0; cc < 4; ++cc) acc[r][cc] = 0.f;
        for (int k = 0; k < 512; ++k) { const int e = k < 256 ? ea : eb, kk = k & 255; float wv[4];
#pragma unroll
            for (int cc = 0; cc < 4; ++cc) wv[cc] = wdown[((size_t)e * 256 + kk) * 1024 + n + 256 * cc];
#pragma unroll
            for (int r = 0; r < 8; ++r) { const float hv = hs[(hf * 8 + r) * 512 + k];
#pragma unroll
                for (int cc = 0; cc < 4; ++cc) acc[r][cc] += hv * wv[cc]; } }
#pragma unroll
        for (int r = 0; r < 8; ++r) { const int t = tk[hf * 8 + r];
            if (t >= 0) { const int b = t / SEQ;
#pragma unroll
                for (int cc = 0; cc < 4; ++cc) { const int col = n + 256 * cc; out[(size_t)t * DM + col] += mod[b * 6144 + 5120 + col] * acc[r][cc]; } } }
        __syncthreads();
    }
}

__global__ void __launch_bounds__(NTHR, 2) fwd_kernel(Args args) {
    extern __shared__ __attribute__((aligned(16))) unsigned char lds_raw[];
    LAS unsigned char* lds = (LAS unsigned char*)lds_raw;
    volatile LAS unsigned* MISC = (volatile LAS unsigned*)(lds + MISC_OFF);
    const int tid = threadIdx.x, lane = tid & 63, wave = __builtin_amdgcn_readfirstlane(tid >> 6);
    const int G = gridDim.x;
    unsigned char* ws = args.ws;
    for (int u = tid; u < (LDS_BYTES - LDSCTL_OFF) / 4; u += NTHR) ((LAS unsigned*)(lds + LDSCTL_OFF))[u] = 0u;
    __syncthreads();
    const int lo = args.ph_lo, hi = args.ph_hi;
    const bool use_bar = (hi - lo) > 1;
    XcdBarrier bar; bar.bar = (unsigned*)(ws + WS_CTL) + CW_BAR; bar.x = 0; bar.st = nullptr;
    if (use_bar) bar = xcd_barrier_post((unsigned*)(ws + WS_CTL) + CW_BAR, MISC + 8);
#define IN(k) (lo <= (k) && (k) < hi)
#define BOTH(k) (IN(k) && IN((k) + 1))
#define GRID_BAR(k) do { if (BOTH(k)) xcd_barrier(bar); } while (0)
    const float* mod = (const float*)(ws + WS_MOD);

    if (IN(0)) { p0_prologue(args, lds, tid, lane, wave); GRID_BAR(0); }
    if (IN(1)) { norm_rows<false>(args, (const float*)args.in[I_X], (const float*)args.in[I_NORM_MIX], mod + 0, mod + 1024, (bf16*)(ws + WS_H), lds, lane, wave); GRID_BAR(1); }
    if (IN(2)) {
        pg8::Gemm g{(const pg8::bf16_t*)(ws + WS_H), (const pg8::bf16_t*)(ws + WS_WINT), TT, NPAD, DM}; pg8::StaticOrder S; S.init(TT, NPAD, G, (int)blockIdx.x);
        pg8::EpiProj E{(pg8::bf16_t*)(ws + WS_PROJ), (float*)(ws + WS_AB), NPROJ};
        pg8::gemm_phase<pg8::EpiProj, pg8::StaticOrder, true, true>(lds, g, S, E);
        GRID_BAR(2);
    }
    if (IN(3)) { swa_prep(args, lane, wave); GRID_BAR(3); }
    if (IN(4)) {
        if ((int)blockIdx.x < 32) gdn_naive(args, (int)blockIdx.x, (LAS float*)lds, tid);
        else swa_naive(args, tid, (int)blockIdx.x - 32, G - 32);
        GRID_BAR(4);
    }
    if (IN(5)) {
        pg8::Gemm g{(const pg8::bf16_t*)(ws + WS_MIX), (const pg8::bf16_t*)(ws + WS_WOUTT), TT, DM, DM}; pg8::StaticOrder S; S.init(TT, DM, G, (int)blockIdx.x);
        pg8::EpiOut E{(const float*)args.in[I_X], args.out, mod + 2048, SEQ, 6144};
        pg8::gemm_phase<pg8::EpiOut, pg8::StaticOrder, true, true>(lds, g, S, E);
        GRID_BAR(5);
    }
    if (IN(6)) { norm_rows<true>(args, args.out, (const float*)args.in[I_NORM_FFN], mod + 3072, mod + 4096, (bf16*)(ws + WS_H), lds, lane, wave); GRID_BAR(6); }
    if (IN(7)) { moe1_naive(args, lds, tid); GRID_BAR(7); }
    if (IN(8)) { moe2_naive(args, lds, tid); }
#undef IN
#undef BOTH
#undef GRID_BAR
}

extern "C" void kernel_launch(void* const* d_in, const int* in_sizes, int n_in, void* d_out, int out_size, void* d_ws, size_t ws_size, hipStream_t stream) {
    static int grid = 0;
    if (grid == 0) {
        if (n_in != 23 || in_sizes[0] != TT * DM || out_size != TT * DM || ws_size < WS_END) { fprintf(stderr, "kernel_launch: unexpected shapes: n_in %d in0 %d out %d ws %zu (need %zu)\n", n_in, n_in > 0 ? in_sizes[0] : -1, out_size, ws_size, (size_t)WS_END); grid = -1; return; }
        int dev = 0, cus = 0, per_cu = 0;
        if (hipGetDevice(&dev) != hipSuccess || hipDeviceGetAttribute(&cus, hipDeviceAttributeMultiprocessorCount, dev) != hipSuccess) { grid = -1; return; }
        if (hipFuncSetAttribute((const void*)fwd_kernel, hipFuncAttributeMaxDynamicSharedMemorySize, LDS_BYTES) != hipSuccess) { fprintf(stderr, "kernel_launch: hipFuncSetAttribute failed\n"); grid = -1; return; }
        if (hipOccupancyMaxActiveBlocksPerMultiprocessor(&per_cu, (const void*)fwd_kernel, NTHR, LDS_BYTES) != hipSuccess || per_cu < 1) fprintf(stderr, "kernel_launch: occupancy query reports %d\n", per_cu);
        (void)hipGetLastError();
        grid = cus;
    }
    if (grid < 0) return;
    if (hipMemsetAsync((char*)d_ws + WS_CTL, 0, CTL_ZERO_BYTES, stream) != hipSuccess) { fprintf(stderr, "kernel_launch: memset failed\n"); return; }
    Args a{};
    for (int i = 0; i < 23; ++i) a.in[i] = d_in[i];
    a.out = (float*)d_out; a.ws = (unsigned char*)d_ws;
#if MK_ONE_LAUNCH
    a.ph_lo = 0; a.ph_hi = N_PHASES;
    hipLaunchKernelGGL(fwd_kernel, dim3(grid), dim3(NTHR), LDS_BYTES, stream, a);
#else
    for (int p = 0; p < N_PHASES; ++p) { a.ph_lo = p; a.ph_hi = p + 1; hipLaunchKernelGGL(fwd_kernel, dim3(grid), dim3(NTHR), LDS_BYTES, stream, a); }
#endif
}
```

```cpp
#include <hip/hip_runtime.h>
#include <cstdio>
#include <cstdint>
namespace pg8 {
#define PG8_LAS __attribute__((address_space(3)))
typedef unsigned short bf16_t;
typedef short bf16x8 __attribute__((ext_vector_type(8)));
typedef float f32x4 __attribute__((ext_vector_type(4)));
typedef unsigned u32x4 __attribute__((ext_vector_type(4)));
constexpr int BM = 256, BK = 64, HALF = 128, HTB = HALF * BK * 2  , STAGE_BYTES = 8 * HTB, NXCD = 8, WGM = 8;

__host__ __device__ __forceinline__ int lds_byte(int r, int c) { const int st = (r >> 4) * 2 + (c >> 5), rr = r & 15, cc = c & 31, ob = rr * 64 + cc * 2; return st * 1024 + (ob ^ (((ob >> 9) & 1) << 5)); }
__host__ __device__ __forceinline__ void stage_rc(int b, int& R, int& C) { const int st = b / 1024, sb = b % 1024, swz = sb ^ (((sb >> 9) & 1) << 5); R = (st >> 1) * 16 + swz / 64; C = (st & 1) * 32 + (swz % 64) / 2; }
__host__ __device__ __forceinline__ int perm32(int rho) { const int n = rho >> 4, i = rho & 15; return 8 * (i >> 2) + 4 * n + (i & 3); }

struct Unit { int pm, pn; };
struct Gemm { const bf16_t* A; const bf16_t* Bt; int M, N, K; };

struct StaticOrder {
    int nM, nN, nwg, G, c;
    __host__ __device__ void init(int M, int N, int G_, int c_) { nM = M / BM; nN = N / BM; nwg = nM * nN; G = G_; c = c_; }
    __host__ __device__ bool next(int i, Unit& u) const {
        const long L = (long)i * G + c; if (L >= nwg) return false;
        int wgid = (int)L; { const int q = nwg / NXCD, r = nwg % NXCD, xcd = wgid % NXCD, off = wgid / NXCD; wgid = (xcd < r ? xcd * (q + 1) : r * (q + 1) + (xcd - r) * q) + off; }
        const int nig = WGM * nN, gid = wgid / nig, fm = gid * WGM, gsz = (nM - fm) < WGM ? (nM - fm) : WGM;
        u.pm = fm + ((wgid % nig) % gsz); u.pn = (wgid % nig) / gsz; return true;
    }
    __device__ __forceinline__ void a_ready(const Unit&) const {}
    __device__ __forceinline__ void done(const Unit&) const {}
};

__device__ __forceinline__ unsigned cvt_pk_bf16(float lo, float hi) { unsigned r; asm volatile("v_cvt_pk_bf16_f32 %0, %1, %2" : "=v"(r) : "v"(lo), "v"(hi)); return r; }

struct EpiProj {
    static constexpr bool PERM = true, AFTER_DRAIN = false;
    bf16_t* P; float* AB; int ldp;
    __device__ __forceinline__ void operator()(const f32x4 (&acc)[2][2][4][2], const Unit& u, int wr, int wc, int fr, int fq) const {
        const int row0 = u.pm * BM + wr * 64 + fr;
        if (u.pn < 11) {
            const int col0 = u.pn * BM + wc * 32 + 8 * fq;
#pragma unroll
            for (int ai = 0; ai < 2; ++ai)
#pragma unroll
                for (int m = 0; m < 4; ++m) { bf16_t* rowp = P + (size_t)(row0 + ai * HALF + m * 16) * ldp + col0;
#pragma unroll
                    for (int bj = 0; bj < 2; ++bj) { const f32x4 v0 = acc[ai][bj][m][0], v1 = acc[ai][bj][m][1];
                        u32x4 w; w.x = cvt_pk_bf16(v0[0], v0[1]); w.y = cvt_pk_bf16(v0[2], v0[3]); w.z = cvt_pk_bf16(v1[0], v1[1]); w.w = cvt_pk_bf16(v1[2], v1[3]);
                        *(u32x4*)(rowp + bj * HALF) = w; } }
        } else if (wc == 0 && fq < 2) {
#pragma unroll
            for (int ai = 0; ai < 2; ++ai)
#pragma unroll
                for (int m = 0; m < 4; ++m) { float* rowp = AB + (size_t)(row0 + ai * HALF + m * 16) * 16 + 8 * fq;
                    *(f32x4*)(rowp) = acc[ai][0][m][0]; *(f32x4*)(rowp + 4) = acc[ai][0][m][1]; }
        }
    }
};
struct EpiOut {
    static constexpr bool PERM = false, AFTER_DRAIN = false;
    const float* X; float* O; const float* gate; int rows_per_batch, ldg;
    __device__ __forceinline__ void operator()(const f32x4 (&acc)[2][2][4][2], const Unit& u, int wr, int wc, int fr, int fq) const {
        const int row0 = u.pm * BM + wr * 64 + fr, col0 = u.pn * BM + wc * 32 + 4 * fq;
        const float* gb = gate + (size_t)((u.pm * BM) / rows_per_batch) * ldg + col0;
        f32x4 gv[2][2];
#pragma unroll
        for (int bj = 0; bj < 2; ++bj)
#pragma unroll
            for (int n = 0; n < 2; ++n) gv[bj][n] = *(const f32x4*)(gb + bj * HALF + n * 16);
#pragma unroll
        for (int ai = 0; ai < 2; ++ai)
#pragma unroll
            for (int m = 0; m < 4; ++m) { const size_t ro = (size_t)(row0 + ai * HALF + m * 16) * 1024 + col0;
#pragma unroll
                for (int bj = 0; bj < 2; ++bj)
#pragma unroll
                    for (int n = 0; n < 2; ++n) { const f32x4 xv = *(const f32x4*)(X + ro + bj * HALF + n * 16);
                        *(f32x4*)(O + ro + bj * HALF + n * 16) = xv + gv[bj][n] * acc[ai][bj][m][n]; } }
    }
};
template <class Epi, class Sched, bool ALIGN_EPI = false, bool SP2 = false>
__device__ __forceinline__ void gemm_phase(PG8_LAS unsigned char* lds, const Gemm g, const Sched& S, const Epi& E) {
    const int tid = threadIdx.x, wid = __builtin_amdgcn_readfirstlane(tid >> 6), lane = tid & 63, wr = wid >> 2, wc = wid & 3, fr = lane & 15, fq = lane >> 4;
    const int K = g.K, nt = K / BK;
    unsigned voffA[2], voffB[2];
#pragma unroll
    for (int i = 0; i < 2; ++i) { int R, C; stage_rc(tid * 16 + i * 8192, R, C); const int Rb = Epi::PERM ? ((R & ~31) + perm32(R & 31)) : R;
        voffA[i] = (unsigned)(R * K + C) * 2u; voffB[i] = (unsigned)(Rb * K + C) * 2u; }
    const size_t kstep = (size_t)(BK * 2);
    const size_t hstep = (size_t)HALF * K * 2;
    const size_t tstep = 2 * hstep;
    const unsigned ldsw = (unsigned)wid * 1024u;
    const int aoff = lds_byte(wr * 64 + fr, fq * 8), boff = lds_byte(wc * 32 + fr, fq * 8);
#define PG8_SA(b, h) (((b) * 2 + (h)) * HTB)
#define PG8_SB(b, h) ((4 + (b) * 2 + (h)) * HTB)
#define PG8_STAGE(bufoff, gbase, voff) do { _Pragma("unroll") for (int _i = 0; _i < 2; ++_i) \
        __builtin_amdgcn_global_load_lds((const unsigned*)((const char*)(gbase) + (voff)[_i]), (PG8_LAS unsigned*)(lds + (bufoff) + ldsw + _i * 8192), 16, 0, 0); } while (0)
#define PG8_LDA(dst, b, h) do { _Pragma("unroll") for (int m = 0; m < 4; ++m) _Pragma("unroll") for (int k = 0; k < 2; ++k) dst[m][k] = *(const PG8_LAS bf16x8*)(lds + PG8_SA(b, h) + aoff + m * 2048 + k * 1024); } while (0)
#define PG8_LDB(dst, b, h) do { _Pragma("unroll") for (int n = 0; n < 2; ++n) _Pragma("unroll") for (int k = 0; k < 2; ++k) dst[n][k] = *(const PG8_LAS bf16x8*)(lds + PG8_SB(b, h) + boff + n * 2048 + k * 1024); } while (0)
#define PG8_MMA(ai, bj, At, Bt) do { __builtin_amdgcn_s_setprio(1); _Pragma("unroll") for (int m = 0; m < 4; ++m) _Pragma("unroll") for (int n = 0; n < 2; ++n) _Pragma("unroll") for (int k = 0; k < 2; ++k) \
        acc[ai][bj][m][n] = __builtin_amdgcn_mfma_f32_16x16x32_bf16(Bt[n][k], At[m][k], acc[ai][bj][m][n], 0, 0, 0); __builtin_amdgcn_s_setprio(0); } while (0)
#define PG8_WAIT_V(n) asm volatile("s_waitcnt vmcnt(" #n ")" ::: "memory")
#define PG8_WAIT_L(n) asm volatile("s_waitcnt lgkmcnt(" #n ")" ::: "memory")
#define PG8_BAR __builtin_amdgcn_s_barrier()
#define PG8_SCHED __builtin_amdgcn_sched_barrier(0)
    Unit cur, nxt; int ui = 0;
    if (!S.next(0, cur)) return;
    f32x4 acc[2][2][4][2];
#pragma unroll
    for (int a = 0; a < 2; ++a)
#pragma unroll
        for (int b = 0; b < 2; ++b)
#pragma unroll
            for (int m = 0; m < 4; ++m)
#pragma unroll
                for (int n = 0; n < 2; ++n) acc[a][b][m][n] = (f32x4){0.f, 0.f, 0.f, 0.f};
    bf16x8 At[4][2], B0[2][2], B1[2][2];
    const char* cA = (const char*)g.A + (size_t)cur.pm * tstep; const char* cB = (const char*)g.Bt + (size_t)cur.pn * tstep;
    S.a_ready(cur);
    if constexpr (SP2) {
        PG8_STAGE(PG8_SB(0, 0), cB, voffB); PG8_STAGE(PG8_SB(0, 1), cB + hstep, voffB); PG8_STAGE(PG8_SA(0, 0), cA, voffA); PG8_STAGE(PG8_SA(0, 1), cA + hstep, voffA);
        if (wr == 1) PG8_BAR;
        PG8_WAIT_V(2); PG8_BAR;
        PG8_STAGE(PG8_SB(1, 0), cB + kstep, voffB); PG8_STAGE(PG8_SA(1, 0), cA + kstep, voffA); PG8_STAGE(PG8_SB(1, 1), cB + hstep + kstep, voffB);
        PG8_WAIT_V(6); PG8_BAR;
    } else {
        PG8_STAGE(PG8_SB(0, 0), cB, voffB); PG8_STAGE(PG8_SA(0, 0), cA, voffA); PG8_STAGE(PG8_SB(0, 1), cB + hstep, voffB); PG8_STAGE(PG8_SA(0, 1), cA + hstep, voffA);
        if (wr == 1) PG8_BAR;
        PG8_WAIT_V(4); PG8_BAR;
        PG8_STAGE(PG8_SB(1, 0), cB + kstep, voffB); PG8_STAGE(PG8_SA(1, 0), cA + kstep, voffA); PG8_STAGE(PG8_SB(1, 1), cB + hstep + kstep, voffB);
        PG8_WAIT_V(6); PG8_BAR;
    }
    for (;;) {
        const bool has_next = S.next(ui + 1, nxt);
        const char* nA = has_next ? (const char*)g.A + (size_t)nxt.pm * tstep : cA; const char* nB = has_next ? (const char*)g.Bt + (size_t)nxt.pn * tstep : cB;
        for (int t = 0; t < nt; t += 2) {
            const bool last = (t == nt - 2);
            const char* a1 = cA + (size_t)(t + 1) * kstep;
            const char* a2 = last ? nA : cA + (size_t)(t + 2) * kstep; const char* b2 = last ? nB : cB + (size_t)(t + 2) * kstep;
            const char* a3 = a2 + kstep; const char* b3 = b2 + kstep;
            if (last && has_next) S.a_ready(nxt);
            if constexpr (SP2) {
            PG8_LDB(B0, 0, 0); PG8_LDB(B1, 0, 1); PG8_SCHED; PG8_LDA(At, 0, 0); PG8_STAGE(PG8_SA(1, 1), a1 + hstep, voffA);
            PG8_WAIT_V(8); PG8_WAIT_L(0); PG8_BAR; PG8_MMA(0, 0, At, B0); PG8_MMA(0, 1, At, B1); PG8_BAR; PG8_SCHED;
            PG8_LDA(At, 0, 1); PG8_STAGE(PG8_SB(0, 0), b2, voffB); PG8_STAGE(PG8_SB(0, 1), b2 + hstep, voffB); PG8_STAGE(PG8_SA(0, 0), a2, voffA);
            PG8_WAIT_V(8); PG8_WAIT_L(0); PG8_BAR; PG8_MMA(1, 0, At, B0); PG8_MMA(1, 1, At, B1); PG8_BAR; PG8_SCHED;
            PG8_LDB(B0, 1, 0); PG8_LDB(B1, 1, 1); PG8_SCHED; PG8_LDA(At, 1, 0); PG8_STAGE(PG8_SA(0, 1), a2 + hstep, voffA);
            PG8_WAIT_V(8); PG8_WAIT_L(0); PG8_BAR; PG8_MMA(0, 0, At, B0); PG8_MMA(0, 1, At, B1); PG8_BAR; PG8_SCHED;
            PG8_LDA(At, 1, 1); PG8_STAGE(PG8_SB(1, 0), b3, voffB); PG8_STAGE(PG8_SB(1, 1), b3 + hstep, voffB); PG8_STAGE(PG8_SA(1, 0), a3, voffA);
            PG8_WAIT_V(8); PG8_WAIT_L(0); PG8_BAR; PG8_MMA(1, 0, At, B0); PG8_MMA(1, 1, At, B1); PG8_BAR; PG8_SCHED;
            } else {
            PG8_LDB(B0, 0, 0); PG8_SCHED; PG8_LDA(At, 0, 0); PG8_STAGE(PG8_SA(1, 1), a1 + hstep, voffA);
            PG8_WAIT_L(8); PG8_BAR; PG8_WAIT_L(0); PG8_MMA(0, 0, At, B0); PG8_BAR; PG8_SCHED;
            PG8_LDB(B1, 0, 1); PG8_STAGE(PG8_SB(0, 0), b2, voffB);
            PG8_BAR; PG8_WAIT_L(0); PG8_MMA(0, 1, At, B1); PG8_BAR;
            PG8_LDA(At, 0, 1); PG8_STAGE(PG8_SA(0, 0), a2, voffA);
            PG8_BAR; PG8_WAIT_L(0); PG8_MMA(1, 0, At, B0); PG8_BAR; PG8_SCHED;
            PG8_STAGE(PG8_SB(0, 1), b2 + hstep, voffB);
            PG8_WAIT_V(6); PG8_BAR; PG8_MMA(1, 1, At, B1); PG8_BAR;
            PG8_LDB(B0, 1, 0); PG8_SCHED; PG8_LDA(At, 1, 0); PG8_STAGE(PG8_SA(0, 1), a2 + hstep, voffA);
            PG8_WAIT_L(8); PG8_BAR; PG8_WAIT_L(0); PG8_MMA(0, 0, At, B0); PG8_BAR; PG8_SCHED;
            PG8_LDB(B1, 1, 1); PG8_STAGE(PG8_SB(1, 0), b3, voffB);
            PG8_BAR; PG8_WAIT_L(0); PG8_MMA(0, 1, At, B1); PG8_BAR;
            PG8_LDA(At, 1, 1); PG8_STAGE(PG8_SA(1, 0), a3, voffA);
            PG8_BAR; PG8_WAIT_L(0); PG8_MMA(1, 0, At, B0); PG8_BAR; PG8_SCHED;
            PG8_STAGE(PG8_SB(1, 1), b3 + hstep, voffB);
            PG8_WAIT_V(6); PG8_BAR; PG8_MMA(1, 1, At, B1); PG8_BAR;
            }
        }
        if constexpr (ALIGN_EPI) { if (wr == 0) PG8_BAR; }
        if constexpr (!Epi::AFTER_DRAIN) { E(acc, cur, wr, wc, fr, fq); S.done(cur); }
        if (!has_next) break;
#pragma unroll
        for (int a = 0; a < 2; ++a)
#pragma unroll
            for (int b = 0; b < 2; ++b)
#pragma unroll
                for (int m = 0; m < 4; ++m)
#pragma unroll
                    for (int n = 0; n < 2; ++n) acc[a][b][m][n] = (f32x4){0.f, 0.f, 0.f, 0.f};
        cur = nxt; cA = nA; cB = nB; ++ui;
        if constexpr (ALIGN_EPI) { if (wr == 1) PG8_BAR; }
    }
    PG8_WAIT_V(0);
    if constexpr (!ALIGN_EPI) { if (wr == 0) PG8_BAR; }
    PG8_BAR;
    if constexpr (Epi::AFTER_DRAIN) { E.fused(acc, cur, wr, wc, fr, fq, lds, wid, lane); S.done(cur); }
#undef PG8_SA
#undef PG8_SB
#undef PG8_STAGE
#undef PG8_LDA
#undef PG8_LDB
#undef PG8_MMA
#undef PG8_WAIT_V
#undef PG8_WAIT_L
#undef PG8_BAR
#undef PG8_SCHED
}
}

constexpr int NB = 4, SEQ = 8192, DM = 1024, TT = NB * SEQ;
constexpr int NPROJ = 2816, NPAD = 3072;
constexpr int PC_Q = 0, PC_K = 512, PC_V = 1024, PC_Z = 1536, PC_SQ = 2048, PC_SK = 2560, PC_SV = 2688;
constexpr int NE = 32, NCLS = 112, DE = 256;
constexpr float EPS = 1e-6f;
constexpr int NWAVES = 8, NTHR = 512;
constexpr int N_PHASES = 10;
#ifndef MK_ONE_LAUNCH
#define MK_ONE_LAUNCH 1
#endif

constexpr size_t MiB = 1u << 20;
constexpr size_t WS_CTL = 0, CTL_ZERO_BYTES = 1 * MiB;
constexpr size_t WS_MOD = 1 * MiB;
constexpr size_t WS_WINT = 2 * MiB, WS_WOUTT = 8 * MiB, WS_WGUT = 10 * MiB, WS_WDT = 42 * MiB;
constexpr size_t WS_H = 58 * MiB;
constexpr size_t WS_PROJ = 122 * MiB;
constexpr size_t WS_AB = 298 * MiB;
constexpr size_t WS_MIX = 300 * MiB;
constexpr size_t WS_QR = 364 * MiB, WS_KR = 428 * MiB;
constexpr size_t WS_META = 444 * MiB;
constexpr size_t WS_ELIST = 446 * MiB, WS_CLIST = 450 * MiB;
constexpr size_t WS_HID = WS_PROJ;
constexpr size_t WS_GAP = WS_H, WS_GQP = WS_H + 32 * MiB;
constexpr size_t WS_GBP = WS_WGUT, WS_GOP = 464 * MiB, WS_GGL = 496 * MiB;
constexpr size_t WS_END = 497 * MiB;
constexpr int CW_BAR = 4096, CW_ECNT = 8192, CW_CCNT = 8256;

constexpr int RING_BYTES = 131072, LDSCTL_OFF = RING_BYTES, MISC_OFF = LDSCTL_OFF + 320, LDS_BYTES = 147456;

#define GAS __attribute__((address_space(1)))
#define LAS __attribute__((address_space(3)))
typedef unsigned short bf16;
typedef unsigned v4u __attribute__((ext_vector_type(4)));
typedef float f32x4 __attribute__((ext_vector_type(4)));
typedef GAS unsigned gu32;
#define RLX_AGENT __ATOMIC_RELAXED, __HIP_MEMORY_SCOPE_AGENT
#define LDS_WAIT() asm volatile("s_waitcnt lgkmcnt(0)" ::: "memory")
__device__ __forceinline__ unsigned f2bf(float f) { unsigned u = __builtin_bit_cast(unsigned, f); return (u + 0x7fffu + ((u >> 16) & 1u)) >> 16; }
__device__ __forceinline__ unsigned pk2(float lo, float hi) { return f2bf(lo) | (f2bf(hi) << 16); }
__device__ __forceinline__ float bf2f(bf16 v) { return __builtin_bit_cast(float, (unsigned)v << 16); }
__device__ __forceinline__ float wave_sum(float v) {
#pragma unroll
    for (int o = 1; o < 64; o <<= 1) v += __shfl_xor(v, o);
    return v;
}
__device__ __forceinline__ float siluf(float y) { return y / (1.f + __expf(-y)); }
#define XB_TMO      128
#define XB_XCNT(j)  (256  + 64 * (j))
#define XB_XSUB(j)  (1280 + 64 * (j))
#define XB_XGEN(j)  (2304 + 64 * (j))
#define XB_TOP      3328
#define XB_TOPGEN   3392
#define XCD_BAR_WORDS 3456
#define XB_SPIN_CAP (1u << 18)
__device__ __forceinline__ unsigned xb_ld(unsigned* p)              { return __hip_atomic_load(p, __ATOMIC_RELAXED, __HIP_MEMORY_SCOPE_AGENT); }
__device__ __forceinline__ unsigned xb_add(unsigned* p, unsigned v) { return __hip_atomic_fetch_add(p, v, __ATOMIC_RELAXED, __HIP_MEMORY_SCOPE_AGENT); }
__device__ __forceinline__ unsigned xb_xcc_id() { return (unsigned)__builtin_amdgcn_s_getreg((3 << 11) | 20) & 0xFu; }
#define XB_SPIN(cond, bar) do { unsigned _sp = 0; while (cond) { __builtin_amdgcn_s_sleep(1); \
    if ((++_sp & 255u) == 0u) { if (xb_ld(&(bar)[XB_TMO])) break; if (_sp > XB_SPIN_CAP) { atomicAdd(&(bar)[XB_TMO], 1u); break; } } } } while (0)

struct XcdBarrier {
    unsigned* bar; unsigned x;
    volatile LAS unsigned* st;
};

__device__ __forceinline__ XcdBarrier xcd_barrier_post(unsigned* bar, volatile LAS unsigned* st) {
    XcdBarrier b; b.bar = bar; b.x = xb_xcc_id(); b.st = st;
    if (threadIdx.x == 0) (void)xb_add(&bar[XB_XCNT(b.x)], 1u);
    return b;
}
__device__ __forceinline__ void xcd_barrier_complete(unsigned* bar, unsigned x, unsigned& nloc, unsigned& nx) {
    const unsigned G = gridDim.x * gridDim.y * gridDim.z;
    unsigned sum, cnt, mine, sp = 0u;
    for (;;) {
        sum = 0u; cnt = 0u; mine = 0u;
#pragma unroll
        for (unsigned j = 0; j < 16; ++j) { const unsigned c = xb_ld(&bar[XB_XCNT(j)]); sum += c; cnt += (c > 0u) ? 1u : 0u; mine = (j == x) ? c : mine; }
        if (sum == G) break;
        __builtin_amdgcn_s_sleep(1);
        if ((++sp & 255u) == 0u) { if (xb_ld(&bar[XB_TMO])) break; if (sp > XB_SPIN_CAP) { atomicAdd(&bar[XB_TMO], 1u); break; } }
    }
    nloc = mine > 0u ? mine : 1u; nx = cnt > 0u ? cnt : 1u;
}

__device__ __forceinline__ void xcd_barrier(const XcdBarrier& b) {
    asm volatile("s_waitcnt vmcnt(0)" ::: "memory");
    __syncthreads();
    if (threadIdx.x == 0) {
        unsigned* bar = b.bar;
        __builtin_amdgcn_s_waitcnt(0);
        unsigned nloc = b.st[0], nx = b.st[1];
        if (nloc == 0u) { xcd_barrier_complete(bar, b.x, nloc, nx); b.st[0] = nloc; b.st[1] = nx; }
        const unsigned old = xb_add(&bar[XB_XSUB(b.x)], 1u);
        const unsigned gen = old / nloc;
        if (old + 1u == (gen + 1u) * nloc) {
            __builtin_amdgcn_fence(__ATOMIC_RELEASE, "agent");
            asm volatile("s_waitcnt vmcnt(0)" ::: "memory");
            const unsigned og = xb_add(&bar[XB_TOP], 1u);
            const unsigned tg = og / nx;
            if (og + 1u == (tg + 1u) * nx) xb_add(&bar[XB_TOPGEN], 1u);
            else XB_SPIN(xb_ld(&bar[XB_TOPGEN]) == tg, bar);
            __builtin_amdgcn_fence(__ATOMIC_ACQUIRE, "agent");
            xb_add(&bar[XB_XGEN(b.x)], 1u);
            asm volatile("s_waitcnt vmcnt(0)" ::: "memory");
        } else {
            XB_SPIN(xb_ld(&bar[XB_XGEN(b.x)]) == gen, bar);
            __builtin_amdgcn_fence(__ATOMIC_ACQUIRE, "agent");
            asm volatile("s_waitcnt vmcnt(0)" ::: "memory");
        }
    }
    __syncthreads();
}

struct Args { const void* in[23]; float* out; unsigned char* ws; int ph_lo, ph_hi; };
enum { I_X = 0, I_C, I_POS, I_WADA, I_BADA, I_NORM_MIX, I_WIN, I_CONVW, I_ALOG, I_DTB, I_GNORM, I_QNORM, I_KNORM, I_SINKS, I_WOUT, I_NORM_FFN, I_WGRP, I_BGRP, I_WRT, I_BRT, I_WGATE, I_WUP, I_WDOWN };

template <class CM>
__device__ __forceinline__ void transpose_item(const float* W, int ldw, int k0, bf16* WT, int ldt, int n0, CM cm, LAS float* scr, int lane) {
    const int sc = cm(n0 + (lane & 31));
#pragma unroll 8
    for (int i = 0; i < 32; ++i) { const int kk = 2 * i + (lane >> 5); scr[kk * 33 + (lane & 31)] = sc >= 0 ? W[(size_t)(k0 + kk) * ldw + sc] : 0.f; }
    LDS_WAIT(); asm volatile("" ::: "memory");
    const int c = lane & 7;
#pragma unroll
    for (int j = 0; j < 4; ++j) { const int n = (lane >> 3) + 8 * j; const LAS float* s = scr + (8 * c) * 33 + n;
        v4u o; o.x = pk2(s[0 * 33], s[1 * 33]); o.y = pk2(s[2 * 33], s[3 * 33]); o.z = pk2(s[4 * 33], s[5 * 33]); o.w = pk2(s[6 * 33], s[7 * 33]);
        *(v4u*)(WT + (size_t)(n0 + n) * ldt + k0 + 8 * c) = o; }
    LDS_WAIT(); asm volatile("" ::: "memory");
}
struct CmIn { __device__ __forceinline__ int operator()(int n) const { return n < 2048 ? n : (n < 2816 ? n + 16 : (n < 2832 ? 2048 + (n - 2816) : -1)); } };
struct CmId { __device__ __forceinline__ int operator()(int n) const { return n; } };

__device__ __forceinline__ void p0_prologue(const Args& A, LAS unsigned char* lds, int tid, int lane, int wave) {
    unsigned char* ws = A.ws;
    LAS float* scr = (LAS float*)(lds + wave * 8448);
    const int G = gridDim.x, gw = blockIdx.x * NWAVES + wave, NGW = G * NWAVES;
    constexpr int IT_IN = (NPAD / 32) * (DM / 64), IT_OUT = (DM / 32) * (DM / 64);
    for (int it = gw; it < IT_IN + IT_OUT; it += NGW) {
        if (it < IT_IN) { const int nb = it % (NPAD / 32), kb = it / (NPAD / 32); transpose_item((const float*)A.in[I_WIN], 2832, kb * 64, (bf16*)(ws + WS_WINT), DM, nb * 32, CmIn(), scr, lane); }
        else { const int r = it - IT_IN, nb = r % (DM / 32), kb = r / (DM / 32); transpose_item((const float*)A.in[I_WOUT], DM, kb * 64, (bf16*)(ws + WS_WOUTT), DM, nb * 32, CmId(), scr, lane); }
    }
    LAS float* cact = (LAS float*)(lds + 69632);
    LAS float* red = (LAS float*)(lds + 69632 + 16384);
    const float* c = (const float*)A.in[I_C]; const float* wada = (const float*)A.in[I_WADA]; const float* bada = (const float*)A.in[I_BADA];
    float* mod = (float*)(ws + WS_MOD);
    if ((int)blockIdx.x < 96) {
        __syncthreads();
        for (int i = tid; i < 4096; i += NTHR) cact[i] = siluf(c[i]);
        __syncthreads();
        for (int u = blockIdx.x; u < 96; u += G) {
            const int n = u * 64 + lane; float a0 = 0.f, a1 = 0.f, a2 = 0.f, a3 = 0.f;
            for (int k = wave * 128; k < wave * 128 + 128; ++k) { const float w = wada[(size_t)k * 6144 + n]; a0 += cact[k] * w; a1 += cact[1024 + k] * w; a2 += cact[2048 + k] * w; a3 += cact[3072 + k] * w; }
            red[(wave * 4 + 0) * 64 + lane] = a0; red[(wave * 4 + 1) * 64 + lane] = a1; red[(wave * 4 + 2) * 64 + lane] = a2; red[(wave * 4 + 3) * 64 + lane] = a3;
            __syncthreads();
            if (tid < 256) { const int b = tid >> 6, l = tid & 63; float s = bada[u * 64 + l];
#pragma unroll
                for (int w = 0; w < 8; ++w) s += red[(w * 4 + b) * 64 + l];
                mod[b * 6144 + u * 64 + l] = s; }
            __syncthreads();
        }
    }
}

template <bool ROUTE>
__device__ __forceinline__ void norm_rows(const Args& A, const float* X, const float* gain, const float* shift, const float* scale, bf16* H, LAS unsigned char* lds, int lane, int wave) {
    LAS float* hl = (LAS float*)(lds + wave * 4096);
    const int G = gridDim.x, gw = blockIdx.x * NWAVES + wave, NGW = G * NWAVES;
    unsigned char* ws = A.ws;
    for (int r0 = gw * 16; r0 < TT; r0 += NGW * 16) {
        const int b = r0 / SEQ;
        f32x4 mf[4], af[4];
#pragma unroll
        for (int j = 0; j < 4; ++j) { const int col = 4 * lane + 256 * j; const f32x4 g = *(const f32x4*)(gain + col), sc = *(const f32x4*)(scale + b * 6144 + col);
            mf[j] = g * (sc + 1.0f); af[j] = *(const f32x4*)(shift + b * 6144 + col); }
        for (int i = 0; i < 16; ++i) {
            const int row = r0 + i;
            const f32x4* xr = (const f32x4*)(X + (size_t)row * DM) + lane;
            f32x4 v[4]; float s = 0.f;
#pragma unroll
            for (int j = 0; j < 4; ++j) { v[j] = xr[64 * j]; s += (v[j].x * v[j].x + v[j].y * v[j].y) + (v[j].z * v[j].z + v[j].w * v[j].w); }
            const float rstd = 1.f / sqrtf(wave_sum(s) * (1.f / DM) + EPS);
            unsigned long long* o8 = (unsigned long long*)(H + (size_t)row * DM) + lane;
#pragma unroll
            for (int j = 0; j < 4; ++j) { v[j] = v[j] * rstd * mf[j] + af[j];
                o8[64 * j] = (unsigned long long)pk2(v[j].x, v[j].y) | ((unsigned long long)pk2(v[j].z, v[j].w) << 32); }
            if constexpr (ROUTE) {
                const float* wg = (const float*)A.in[I_WGRP]; const float* wr = (const float*)A.in[I_WRT];
                float lg[36];
#pragma unroll
                for (int o = 0; o < 36; ++o) lg[o] = 0.f;
#pragma unroll
                for (int j = 0; j < 4; ++j) *(LAS f32x4*)(hl + 4 * lane + 256 * j) = v[j];
                LDS_WAIT(); asm volatile("" ::: "memory");
#pragma unroll 1
                for (int ii = 0; ii < 16; ++ii) { const int k = lane + 64 * ii; const float hv = hl[k];
                    const f32x4 g4 = *(const f32x4*)(wg + k * 4);
                    lg[0] += hv * g4.x; lg[1] += hv * g4.y; lg[2] += hv * g4.z; lg[3] += hv * g4.w;
#pragma unroll
                    for (int q = 0; q < 8; ++q) { const f32x4 r4 = *(const f32x4*)(wr + k * 32 + q * 4);
                        lg[4 + q * 4 + 0] += hv * r4.x; lg[4 + q * 4 + 1] += hv * r4.y; lg[4 + q * 4 + 2] += hv * r4.z; lg[4 + q * 4 + 3] += hv * r4.w; } }
                LDS_WAIT(); asm volatile("" ::: "memory");
#pragma unroll
                for (int o = 0; o < 36; ++o) lg[o] = wave_sum(lg[o]);
                const float* bg = (const float*)A.in[I_BGRP]; const float* br = (const float*)A.in[I_BRT];
#pragma unroll
                for (int o = 0; o < 4; ++o) lg[o] += bg[o];
#pragma unroll
                for (int o = 0; o < 32; ++o) lg[4 + o] += br[o];
                int gi = 0; float gm = lg[0];
#pragma unroll
                for (int o = 1; o < 4; ++o) if (lg[o] > gm) { gm = lg[o]; gi = o; }
                float gs = 0.f;
#pragma unroll
                for (int o = 0; o < 4; ++o) gs += __expf(lg[o] - gm);
                const float pg = 1.f / gs;
                float le[8];
#pragma unroll
                for (int j = 0; j < 8; ++j) { le[j] = lg[4 + j];
#pragma unroll
                    for (int g = 1; g < 4; ++g) le[j] = (gi == g) ? lg[4 + g * 8 + j] : le[j]; }
                int j1 = 0; float m1 = le[0];
#pragma unroll
                for (int j = 1; j < 8; ++j) if (le[j] > m1) { m1 = le[j]; j1 = j; }
                int j2 = -1; float m2 = -3.0e38f;
#pragma unroll
                for (int j = 0; j < 8; ++j) if (j != j1 && le[j] > m2) { m2 = le[j]; j2 = j; }
                const float ex = __expf(m2 - m1), w1 = pg / (1.f + ex), w2 = pg * ex / (1.f + ex);
                if (lane == 0) {
                    const int e1 = gi * 8 + j1, e2 = gi * 8 + j2;
                    int* meta = (int*)(ws + WS_META) + (size_t)row * 4;
                    meta[0] = e1; meta[1] = e2; meta[2] = __builtin_bit_cast(int, w1); meta[3] = __builtin_bit_cast(int, w2);
                    unsigned* ctl = (unsigned*)(ws + WS_CTL);
                    int* elist = (int*)(ws + WS_ELIST); int* clist = (int*)(ws + WS_CLIST);
                    const unsigned p1 = atomicAdd(ctl + CW_ECNT + e1, 1u); elist[(size_t)e1 * TT + p1] = row * 2;
                    const unsigned p2 = atomicAdd(ctl + CW_ECNT + e2, 1u); elist[(size_t)e2 * TT + p2] = row * 2 + 1;
                    const int a = j1 < j2 ? j1 : j2, bb = j1 < j2 ? j2 : j1;
                    const int cls = gi * 28 + (a * 7 - (a * (a - 1)) / 2 + (bb - a - 1));
                    const unsigned pc = atomicAdd(ctl + CW_CCNT + cls, 1u); clist[(size_t)cls * TT + pc] = row;
                }
            }
        }
    }
}

__device__ __forceinline__ void swa_prep(const Args& A, int lane, int wave) {
    unsigned char* ws = A.ws;
    const int G = gridDim.x, gw = blockIdx.x * NWAVES + wave, NGW = G * NWAVES;
    const bf16* proj = (const bf16*)(ws + WS_PROJ); float* qr = (float*)(ws + WS_QR); float* kr = (float*)(ws + WS_KR);
    const int* pos = (const int*)A.in[I_POS];
    const float qg = ((const float*)A.in[I_QNORM])[lane], kg = ((const float*)A.in[I_KNORM])[lane];
    const float inv = powf(10000.f, -(float)(lane & 31) / 32.f);
    for (int t = gw; t < TT; t += NGW) {
        const float ang = (float)pos[t] * inv; float sn, cs; sincosf(ang, &sn, &cs);
        for (int hd = 0; hd < 10; ++hd) {
            const int col = hd < 8 ? PC_SQ + hd * 64 : PC_SK + (hd - 8) * 64;
            const float x = bf2f(proj[(size_t)t * NPROJ + col + lane]);
            const float ss = wave_sum(x * x);
            const float xn = x * (1.f / sqrtf(ss * (1.f / 64.f) + EPS)) * (hd < 8 ? qg : kg);
            const float pr = __shfl_xor(xn, 32);
            const float o = lane < 32 ? xn * cs - pr * sn : pr * sn + xn * cs;
            if (hd < 8) qr[(size_t)t * 512 + hd * 64 + lane] = o; else kr[(size_t)t * 128 + (hd - 8) * 64 + lane] = o;
        }
    }
}
__device__ __forceinline__ void swa_naive(const Args& A, int tid, int blk, int nblk) {
    unsigned char* ws = A.ws;
    const bf16* proj = (const bf16*)(ws + WS_PROJ); const float* qr = (const float*)(ws + WS_QR); const float* kr = (const float*)(ws + WS_KR);
    bf16* mix = (bf16*)(ws + WS_MIX); const float* sinks = (const float*)A.in[I_SINKS];
    for (int item = blk * NTHR + tid; item < TT * 8; item += nblk * NTHR) {
        const int t = item >> 3, hq = item & 7, kvh = hq >> 2, b = t / SEQ, p = t % SEQ;
        float q[64], acc[64];
#pragma unroll
        for (int d = 0; d < 64; d += 4) { const f32x4 v = *(const f32x4*)(qr + (size_t)t * 512 + hq * 64 + d); q[d] = v.x * 0.125f; q[d + 1] = v.y * 0.125f; q[d + 2] = v.z * 0.125f; q[d + 3] = v.w * 0.125f; }
#pragma unroll
        for (int d = 0; d < 64; ++d) acc[d] = 0.f;
        float m = sinks[hq], l = 1.f;
        const int k0 = p - 127 > 0 ? p - 127 : 0;
        for (int kp = k0; kp <= p; ++kp) {
            const size_t tk = (size_t)b * SEQ + kp;
            float s = 0.f;
#pragma unroll
            for (int d = 0; d < 64; d += 4) { const f32x4 v = *(const f32x4*)(kr + tk * 128 + kvh * 64 + d); s += q[d] * v.x + q[d + 1] * v.y + q[d + 2] * v.z + q[d + 3] * v.w; }
            if (s > m) { const float sc = __expf(m - s); l *= sc;
#pragma unroll
                for (int d = 0; d < 64; ++d) acc[d] *= sc;
                m = s; }
            const float pe = __expf(s - m); l += pe;
#pragma unroll
            for (int d = 0; d < 64; d += 8) { const v4u raw = *(const v4u*)(proj + tk * NPROJ + PC_SV + kvh * 64 + d);
                acc[d + 0] += pe * __builtin_bit_cast(float, raw.x << 16); acc[d + 1] += pe * __builtin_bit_cast(float, raw.x & 0xffff0000u);
                acc[d + 2] += pe * __builtin_bit_cast(float, raw.y << 16); acc[d + 3] += pe * __builtin_bit_cast(float, raw.y & 0xffff0000u);
                acc[d + 4] += pe * __builtin_bit_cast(float, raw.z << 16); acc[d + 5] += pe * __builtin_bit_cast(float, raw.z & 0xffff0000u);
                acc[d + 6] += pe * __builtin_bit_cast(float, raw.w << 16); acc[d + 7] += pe * __builtin_bit_cast(float, raw.w & 0xffff0000u); }
        }
        const float il = 1.f / l;
#pragma unroll
        for (int d = 0; d < 64; d += 8) { v4u o; o.x = pk2(acc[d] * il, acc[d + 1] * il); o.y = pk2(acc[d + 2] * il, acc[d + 3] * il); o.z = pk2(acc[d + 4] * il, acc[d + 5] * il); o.w = pk2(acc[d + 6] * il, acc[d + 7] * il);
            *(v4u*)(mix + (size_t)t * DM + 512 + hq * 64 + d) = o; }
    }
}

__device__ __forceinline__ void gdn_g1_naive(const Args& A, LAS float* L, int tid) {
    unsigned char* ws = A.ws;
    const bf16* proj = (const bf16*)(ws + WS_PROJ); const float* ab = (const float*)(ws + WS_AB);
    bf16* AP = (bf16*)(ws + WS_GAP); bf16* BP = (bf16*)(ws + WS_GBP); bf16* QP = (bf16*)(ws + WS_GQP); bf16* OP = (bf16*)(ws + WS_GOP); float* GL = (float*)(ws + WS_GGL);
    const float* convw = (const float*)A.in[I_CONVW];
    constexpr int LD = 65, AR = 64 * LD;
    LAS float* q = L; LAS float* k = q + AR; LAS float* v = k + AR; LAS float* Mm = v + AR; LAS float* At = Mm + AR; LAS float* w = At + AR;
    LAS float* Gc = w + AR; LAS float* beta = Gc + 64;
    const int i8 = tid >> 3, e0 = (tid & 7) * 8;
    for (int cid = blockIdx.x; cid < NB * 8 * 128; cid += gridDim.x) {
        const int n = cid & 127, bh = cid >> 7, b = bh >> 3, h = bh & 7;
        const float Ah = expf(((const float*)A.in[I_ALOG])[h]), dtb = ((const float*)A.in[I_DTB])[h];
        const int t0 = b * SEQ + n * 64;
        __syncthreads();
        for (int idx = tid; idx < 3 * 4096; idx += NTHR) {
            const int part = idx >> 12, rem = idx & 4095, i = rem >> 6, d = rem & 63, c = part * 512 + h * 64 + d;
            float y = 0.f;
#pragma unroll
            for (int j = 0; j < 4; ++j) { const int s = n * 64 + i - 3 + j; if (s >= 0) y += convw[j * 1536 + c] * bf2f(proj[(size_t)(b * SEQ + s) * NPROJ + c]); }
            y = y / (1.f + __expf(-y));
            (part == 0 ? q : (part == 1 ? k : v))[i * LD + d] = y;
        }
        if (tid < 64) { const float a = ab[(size_t)(t0 + tid) * 16 + h], bb = ab[(size_t)(t0 + tid) * 16 + 8 + h]; const float xx = a + dtb;
            const float sp = xx > 20.f ? xx : log1pf(expf(xx)); Gc[tid] = -Ah * sp; beta[tid] = 1.f / (1.f + __expf(-bb)); }
        __syncthreads();
        if (tid < 128) { LAS float* arr = tid < 64 ? q : k; const int i = tid & 63; float ss = 0.f;
            for (int d = 0; d < 64; ++d) ss += arr[i * LD + d] * arr[i * LD + d];
            const float r = (1.f / sqrtf(ss + EPS)) * (tid < 64 ? 0.125f : 1.f);
            for (int d = 0; d < 64; ++d) arr[i * LD + d] *= r; }
        if (tid == 128) { float run = 0.f; for (int i = 0; i < 64; ++i) { run += Gc[i]; Gc[i] = run; } }
        __syncthreads();
        {   const int i = i8;
            for (int jj = 0; jj < 8; ++jj) { const int j = e0 + jj; float dq = 0.f, dk = 0.f;
_Pragma("unroll 2") for (int d = 0; d < 64; ++d) { const float kj = k[j * LD + d]; dq += q[i * LD + d] * kj; dk += k[i * LD + d] * kj; }
                const float dec = (i >= j) ? __expf(Gc[i] - Gc[j]) : 0.f;
                At[i * LD + j] = dq * dec; Mm[i * LD + j] = (i > j) ? dk * beta[i] * dec : 0.f; }
        }
        __syncthreads();
        for (int idx = tid; idx < 4096; idx += NTHR) { const int i = idx >> 6, d = idx & 63; v[i * LD + d] *= beta[i]; w[i * LD + d] = k[i * LD + d] * beta[i] * __expf(Gc[i]); }
        __syncthreads();
        if (tid < 128) { LAS float* arr = tid < 64 ? v : w; const int c = tid & 63;
            _Pragma("unroll 1") for (int i = 1; i < 64; ++i) { float a = arr[i * LD + c]; _Pragma("unroll 4") for (int j = 0; j < i; ++j) a -= Mm[i * LD + j] * arr[j * LD + c]; arr[i * LD + c] = a; } }
        __syncthreads();
        const float gl = Gc[63];
        const size_t cb = (size_t)cid * 4096;
        {
            const int d = i8; float a[8], bq[8];
#pragma unroll
            for (int ee = 0; ee < 8; ++ee) { a[ee] = 0.f; bq[ee] = 0.f; }
_Pragma("unroll 2")
            for (int c = 0; c < 64; ++c) { const float kd = k[c * LD + d] * __expf(gl - Gc[c]);
#pragma unroll
                for (int ee = 0; ee < 8; ++ee) { a[ee] -= kd * w[c * LD + e0 + ee]; bq[ee] += kd * v[c * LD + e0 + ee]; } }
            v4u o; o.x = pk2(a[0], a[1]); o.y = pk2(a[2], a[3]); o.z = pk2(a[4], a[5]); o.w = pk2(a[6], a[7]);
            *(v4u*)(AP + cb + d * 64 + e0) = o;
            o.x = pk2(bq[0], bq[1]); o.y = pk2(bq[2], bq[3]); o.z = pk2(bq[4], bq[5]); o.w = pk2(bq[6], bq[7]);
            *(v4u*)(BP + cb + d * 64 + e0) = o;
        }
        {
            const int c = i8; float a[8], bq[8]; const float eg = __expf(Gc[c]);
#pragma unroll
            for (int ee = 0; ee < 8; ++ee) { a[ee] = eg * q[c * LD + e0 + ee]; bq[ee] = 0.f; }
_Pragma("unroll 2")
            for (int s2 = 0; s2 <= c; ++s2) { const float av = At[c * LD + s2];
#pragma unroll
                for (int ee = 0; ee < 8; ++ee) { a[ee] -= av * w[s2 * LD + e0 + ee]; bq[ee] += av * v[s2 * LD + e0 + ee]; } }
            v4u o; o.x = pk2(a[0], a[1]); o.y = pk2(a[2], a[3]); o.z = pk2(a[4], a[5]); o.w = pk2(a[6], a[7]);
            *(v4u*)(QP + cb + c * 64 + e0) = o;
            o.x = pk2(bq[0], bq[1]); o.y = pk2(bq[2], bq[3]); o.z = pk2(bq[4], bq[5]); o.w = pk2(bq[6], bq[7]);
            *(v4u*)(OP + cb + c * 64 + e0) = o;
        }
        if (tid == 0) GL[cid] = __expf(gl);
    }
}
__device__ __forceinline__ void gdn_g2_naive(const Args& A, int bh, LAS float* L, int tid) {
    unsigned char* ws = A.ws;
    const bf16* proj = (const bf16*)(ws + WS_PROJ); bf16* mix = (bf16*)(ws + WS_MIX);
    const bf16* AP = (const bf16*)(ws + WS_GAP); const bf16* BP = (const bf16*)(ws + WS_GBP); const bf16* QP = (const bf16*)(ws + WS_GQP); const bf16* OP = (const bf16*)(ws + WS_GOP); const float* GL = (const float*)(ws + WS_GGL);
    const float* onorm = (const float*)A.in[I_GNORM];
    const int b = bh >> 3, h = bh & 7;
    constexpr int LD = 65, AR = 64 * LD;
    LAS float* S = L; LAS float* a = S + AR; LAS float* qp = a + AR;
    for (int i = tid; i < AR; i += NTHR) S[i] = 0.f;
    const int i8 = tid >> 3, e0 = (tid & 7) * 8;
    for (int n = 0; n < SEQ / 64; ++n) {
        const int cid = bh * 128 + n, t0 = b * SEQ + n * 64; const size_t cb = (size_t)cid * 4096;
        __syncthreads();
        {   const v4u ra = *(const v4u*)(AP + cb + i8 * 64 + e0), rq = *(const v4u*)(QP + cb + i8 * 64 + e0);
            const unsigned au[4] = {ra.x, ra.y, ra.z, ra.w}, qu[4] = {rq.x, rq.y, rq.z, rq.w};
#pragma unroll
            for (int p = 0; p < 4; ++p) { a[i8 * LD + e0 + 2 * p] = __builtin_bit_cast(float, au[p] << 16); a[i8 * LD + e0 + 2 * p + 1] = __builtin_bit_cast(float, au[p] & 0xffff0000u);
                qp[i8 * LD + e0 + 2 * p] = __builtin_bit_cast(float, qu[p] << 16); qp[i8 * LD + e0 + 2 * p + 1] = __builtin_bit_cast(float, qu[p] & 0xffff0000u); } }
        __syncthreads();
        const float egl = GL[cid];
        float o[8], sn[8];
        {   const v4u rb = *(const v4u*)(BP + cb + i8 * 64 + e0), ro = *(const v4u*)(OP + cb + i8 * 64 + e0);
            const unsigned bu[4] = {rb.x, rb.y, rb.z, rb.w}, ou[4] = {ro.x, ro.y, ro.z, ro.w};
#pragma unroll
            for (int p = 0; p < 4; ++p) { sn[2 * p] = __builtin_bit_cast(float, bu[p] << 16); sn[2 * p + 1] = __builtin_bit_cast(float, bu[p] & 0xffff0000u);
                o[2 * p] = __builtin_bit_cast(float, ou[p] << 16); o[2 * p + 1] = __builtin_bit_cast(float, ou[p] & 0xffff0000u); }
#pragma unroll
            for (int ee = 0; ee < 8; ++ee) sn[ee] += egl * S[i8 * LD + e0 + ee];
_Pragma("unroll 2")
            for (int d = 0; d < 64; ++d) { const float av = a[i8 * LD + d], qv = qp[i8 * LD + d];
#pragma unroll
                for (int ee = 0; ee < 8; ++ee) { const float sv = S[d * LD + e0 + ee]; sn[ee] += av * sv; o[ee] += qv * sv; } }
        }
        __syncthreads();
#pragma unroll
        for (int ee = 0; ee < 8; ++ee) S[i8 * LD + e0 + ee] = sn[ee];
        {   const int i = i8; float ss = 0.f;
#pragma unroll
            for (int ee = 0; ee < 8; ++ee) ss += o[ee] * o[ee];
            ss += __shfl_xor(ss, 1); ss += __shfl_xor(ss, 2); ss += __shfl_xor(ss, 4);
            const float r = 1.f / sqrtf(ss * (1.f / 64.f) + EPS);
            const v4u zr = *(const v4u*)(proj + (size_t)(t0 + i) * NPROJ + PC_Z + h * 64 + e0);
            float z[8] = { __builtin_bit_cast(float, zr.x << 16), __builtin_bit_cast(float, zr.x & 0xffff0000u), __builtin_bit_cast(float, zr.y << 16), __builtin_bit_cast(float, zr.y & 0xffff0000u),
                           __builtin_bit_cast(float, zr.z << 16), __builtin_bit_cast(float, zr.z & 0xffff0000u), __builtin_bit_cast(float, zr.w << 16), __builtin_bit_cast(float, zr.w & 0xffff0000u) };
            float y[8];
#pragma unroll
            for (int ee = 0; ee < 8; ++ee) y[ee] = o[ee] * r * onorm[e0 + ee] * siluf(z[ee]);
            v4u ov; ov.x = pk2(y[0], y[1]); ov.y = pk2(y[2], y[3]); ov.z = pk2(y[4], y[5]); ov.w = pk2(y[6], y[7]);
            *(v4u*)(mix + (size_t)(t0 + i) * DM + h * 64 + e0) = ov;
        }
    }
}

__device__ __forceinline__ void moe1_naive(const Args& A, LAS unsigned char* lds, int tid) {
    unsigned char* ws = A.ws;
    const unsigned* ctl = (const unsigned*)(ws + WS_CTL); const int* elist = (const int*)(ws + WS_ELIST); const int* meta = (const int*)(ws + WS_META);
    const bf16* h2 = (const bf16*)(ws + WS_H); float* hid = (float*)(ws + WS_HID);
    const float* wgate = (const float*)A.in[I_WGATE]; const float* wup = (const float*)A.in[I_WUP];
    LAS float* xs = (LAS float*)lds;
    LAS int* pre = (LAS int*)(lds + 65536);
    LAS int* ent = (LAS int*)(lds + 65536 + 256);
    __syncthreads();
    if (tid == 0) { int s = 0; for (int e = 0; e < NE; ++e) { pre[e] = s; s += ((int)ctl[CW_ECNT + e] + 15) / 16; } pre[NE] = s; }
    __syncthreads();
    const int nun = pre[NE];
    for (int u = blockIdx.x; u < nun; u += gridDim.x) {
        int e = 0; while (u >= pre[e + 1]) ++e;
        const int tile = u - pre[e], cnt = (int)ctl[CW_ECNT + e], nin = (cnt - tile * 16) < 16 ? (cnt - tile * 16) : 16;
        if (tid < 16) ent[tid] = tid < nin ? elist[(size_t)e * TT + tile * 16 + tid] : -1;
        __syncthreads();
        for (int idx = tid; idx < 16 * 1024; idx += NTHR) { const int r = idx >> 10, k = idx & 1023, en = ent[r]; xs[idx] = en >= 0 ? bf2f(h2[(size_t)(en >> 1) * DM + k]) : 0.f; }
        __syncthreads();
        const int j = tid & 255, hf = tid >> 8;
        float ag[8], au[8];
#pragma unroll
        for (int r = 0; r < 8; ++r) { ag[r] = 0.f; au[r] = 0.f; }
        for (int k = 0; k < 1024; ++k) { const float g = wgate[((size_t)e * 1024 + k) * 256 + j], uu = wup[((size_t)e * 1024 + k) * 256 + j];
#pragma unroll
            for (int r = 0; r < 8; ++r) { const float x = xs[(hf * 8 + r) * 1024 + k]; ag[r] += x * g; au[r] += x * uu; } }
#pragma unroll
        for (int r = 0; r < 8; ++r) { const int en = ent[hf * 8 + r];
            if (en >= 0) { const int t = en >> 1, slot = en & 1; const int eo = meta[(size_t)t * 4 + (slot ? 0 : 1)]; const float wt = __builtin_bit_cast(float, meta[(size_t)t * 4 + 2 + slot]);
                hid[(size_t)t * 512 + (e > eo ? 256 : 0) + j] = wt * siluf(ag[r]) * au[r]; } }
        __syncthreads();
    }
}
__device__ __forceinline__ void moe2_naive(const Args& A, LAS unsigned char* lds, int tid) {
    unsigned char* ws = A.ws;
    const unsigned* ctl = (const unsigned*)(ws + WS_CTL); const int* clist = (const int*)(ws + WS_CLIST);
    const float* hid = (const float*)(ws + WS_HID); const float* wdown = (const float*)A.in[I_WDOWN]; const float* mod = (const float*)(ws + WS_MOD);
    float* out = A.out;
    LAS float* hs = (LAS float*)lds;
    LAS int* pre = (LAS int*)(lds + 32768);
    LAS int* tk = (LAS int*)(lds + 32768 + 512);
    __syncthreads();
    if (tid == 0) { int s = 0; for (int c = 0; c < NCLS; ++c) { pre[c] = s; s += ((int)ctl[CW_CCNT + c] + 15) / 16; } pre[NCLS] = s; }
    __syncthreads();
    const int nun = pre[NCLS];
    for (int u = blockIdx.x; u < nun; u += gridDim.x) {
        int c = 0; while (u >= pre[c + 1]) ++c;
        const int tile = u - pre[c], cnt = (int)ctl[CW_CCNT + c], nin = (cnt - tile * 16) < 16 ? (cnt - tile * 16) : 16;
        const int g = c / 28; int a = 0, rem = c % 28; while (rem >= 7 - a) { rem -= 7 - a; ++a; } const int bb = a + 1 + rem;
        const int ea = g * 8 + a, eb = g * 8 + bb;
        if (tid < 16) tk[tid] = tid < nin ? clist[(size_t)c * TT + tile * 16 + tid] : -1;
        __syncthreads();
        for (int idx = tid; idx < 16 * 512; idx += NTHR) { const int r = idx >> 9, k = idx & 511, t = tk[r]; hs[idx] = t >= 0 ? hid[(size_t)t * 512 + k] : 0.f; }
        __syncthreads();
        const int n = tid & 255, hf = tid >> 8;
        float acc[8][4];
#pragma unroll
        for (int r = 0; r < 8; ++r)
#pragma unroll
            for (int cc = 0; cc < 4; ++cc) acc[r][cc] = 0.f;
        for (int k = 0; k < 512; ++k) { const int e = k < 256 ? ea : eb, kk = k & 255; float wv[4];
#pragma unroll
            for (int cc = 0; cc < 4; ++cc) wv[cc] = wdown[((size_t)e * 256 + kk) * 1024 + n + 256 * cc];
#pragma unroll
            for (int r = 0; r < 8; ++r) { const float hv = hs[(hf * 8 + r) * 512 + k];
#pragma unroll
                for (int cc = 0; cc < 4; ++cc) acc[r][cc] += hv * wv[cc]; } }
#pragma unroll
        for (int r = 0; r < 8; ++r) { const int t = tk[hf * 8 + r];
            if (t >= 0) { const int b = t / SEQ;
#pragma unroll
                for (int cc = 0; cc < 4; ++cc) { const int col = n + 256 * cc; out[(size_t)t * DM + col] += mod[b * 6144 + 5120 + col] * acc[r][cc]; } } }
        __syncthreads();
    }
}

__global__ void __launch_bounds__(NTHR, 2) fwd_kernel(Args args) {
    extern __shared__ __attribute__((aligned(16))) unsigned char lds_raw[];
    LAS unsigned char* lds = (LAS unsigned char*)lds_raw;
    volatile LAS unsigned* MISC = (volatile LAS unsigned*)(lds + MISC_OFF);
    const int tid = threadIdx.x, lane = tid & 63, wave = __builtin_amdgcn_readfirstlane(tid >> 6);
    const int G = gridDim.x;
    unsigned char* ws = args.ws;
    for (int u = tid; u < (LDS_BYTES - LDSCTL_OFF) / 4; u += NTHR) ((LAS unsigned*)(lds + LDSCTL_OFF))[u] = 0u;
    __syncthreads();
    const int lo = args.ph_lo, hi = args.ph_hi;
    const bool use_bar = (hi - lo) > 1;
    XcdBarrier bar; bar.bar = (unsigned*)(ws + WS_CTL) + CW_BAR; bar.x = 0; bar.st = nullptr;
    if (use_bar) bar = xcd_barrier_post((unsigned*)(ws + WS_CTL) + CW_BAR, MISC + 8);
#define IN(k) (lo <= (k) && (k) < hi)
#define BOTH(k) (IN(k) && IN((k) + 1))
#define GRID_BAR(k) do { if (BOTH(k)) xcd_barrier(bar); } while (0)
    const float* mod = (const float*)(ws + WS_MOD);

    if (IN(0)) { p0_prologue(args, lds, tid, lane, wave); GRID_BAR(0); }
    if (IN(1)) { norm_rows<false>(args, (const float*)args.in[I_X], (const float*)args.in[I_NORM_MIX], mod + 0, mod + 1024, (bf16*)(ws + WS_H), lds, lane, wave); GRID_BAR(1); }
    if (IN(2)) {
        pg8::Gemm g{(const pg8::bf16_t*)(ws + WS_H), (const pg8::bf16_t*)(ws + WS_WINT), TT, NPAD, DM}; pg8::StaticOrder S; S.init(TT, NPAD, G, (int)blockIdx.x);
        pg8::EpiProj E{(pg8::bf16_t*)(ws + WS_PROJ), (float*)(ws + WS_AB), NPROJ};
        pg8::gemm_phase<pg8::EpiProj, pg8::StaticOrder, true, true>(lds, g, S, E);
        GRID_BAR(2);
    }
    if (IN(3)) { swa_prep(args, lane, wave); GRID_BAR(3); }
    if (IN(4)) { gdn_g1_naive(args, (LAS float*)lds, tid); GRID_BAR(4); }
    if (IN(5)) {
        if ((int)blockIdx.x < 32) gdn_g2_naive(args, (int)blockIdx.x, (LAS float*)lds, tid);
        else swa_naive(args, tid, (int)blockIdx.x - 32, G - 32);
        GRID_BAR(5);
    }
    if (IN(6)) {
        pg8::Gemm g{(const pg8::bf16_t*)(ws + WS_MIX), (const pg8::bf16_t*)(ws + WS_WOUTT), TT, DM, DM}; pg8::StaticOrder S; S.init(TT, DM, G, (int)blockIdx.x);
        pg8::EpiOut E{(const float*)args.in[I_X], args.out, mod + 2048, SEQ, 6144};
        pg8::gemm_phase<pg8::EpiOut, pg8::StaticOrder, true, true>(lds, g, S, E);
        GRID_BAR(6);
    }
    if (IN(7)) { norm_rows<true>(args, args.out, (const float*)args.in[I_NORM_FFN], mod + 3072, mod + 4096, (bf16*)(ws + WS_H), lds, lane, wave); GRID_BAR(7); }
    if (IN(8)) { moe1_naive(args, lds, tid); GRID_BAR(8); }
    if (IN(9)) { moe2_naive(args, lds, tid); }
#undef IN
#undef BOTH
#undef GRID_BAR
}

extern "C" void kernel_launch(void* const* d_in, const int* in_sizes, int n_in, void* d_out, int out_size, void* d_ws, size_t ws_size, hipStream_t stream) {
    static int grid = 0;
    if (grid == 0) {
        if (n_in != 23 || in_sizes[0] != TT * DM || out_size != TT * DM || ws_size < WS_END) { fprintf(stderr, "kernel_launch: unexpected shapes: n_in %d in0 %d out %d ws %zu (need %zu)\n", n_in, n_in > 0 ? in_sizes[0] : -1, out_size, ws_size, (size_t)WS_END); grid = -1; return; }
        int dev = 0, cus = 0, per_cu = 0;
        if (hipGetDevice(&dev) != hipSuccess || hipDeviceGetAttribute(&cus, hipDeviceAttributeMultiprocessorCount, dev) != hipSuccess) { grid = -1; return; }
        if (hipFuncSetAttribute((const void*)fwd_kernel, hipFuncAttributeMaxDynamicSharedMemorySize, LDS_BYTES) != hipSuccess) { fprintf(stderr, "kernel_launch: hipFuncSetAttribute failed\n"); grid = -1; return; }
        if (hipOccupancyMaxActiveBlocksPerMultiprocessor(&per_cu, (const void*)fwd_kernel, NTHR, LDS_BYTES) != hipSuccess || per_cu < 1) fprintf(stderr, "kernel_launch: occupancy query reports %d\n", per_cu);
        (void)hipGetLastError();
        grid = cus;
    }
    if (grid < 0) return;
    if (hipMemsetAsync((char*)d_ws + WS_CTL, 0, CTL_ZERO_BYTES, stream) != hipSuccess) { fprintf(stderr, "kernel_launch: memset failed\n"); return; }
    Args a{};
    for (int i = 0; i < 23; ++i) a.in[i] = d_in[i];
    a.out = (float*)d_out; a.ws = (unsigned char*)d_ws;
#if MK_ONE_LAUNCH
    a.ph_lo = 0; a.ph_hi = N_PHASES;
    hipLaunchKernelGGL(fwd_kernel, dim3(grid), dim3(NTHR), LDS_BYTES, stream, a);
#else
    for (int p = 0; p < N_PHASES; ++p) { a.ph_lo = p; a.ph_hi = p + 1; hipLaunchKernelGGL(fwd_kernel, dim3(grid), dim3(NTHR), LDS_BYTES, stream, a); }
#endif
}
```

```cpp
#include <hip/hip_runtime.h>
#include <cstdio>
#include <cstdint>
namespace pg8 {
#define PG8_LAS __attribute__((address_space(3)))
typedef unsigned short bf16_t;
typedef short bf16x8 __attribute__((ext_vector_type(8)));
typedef float f32x4 __attribute__((ext_vector_type(4)));
typedef unsigned u32x4 __attribute__((ext_vector_type(4)));
constexpr int BM = 256, BK = 64, HALF = 128, HTB = HALF * BK * 2  , STAGE_BYTES = 8 * HTB, NXCD = 8, WGM = 8;

__host__ __device__ __forceinline__ int lds_byte(int r, int c) { const int st = (r >> 4) * 2 + (c >> 5), rr = r & 15, cc = c & 31, ob = rr * 64 + cc * 2; return st * 1024 + (ob ^ (((ob >> 9) & 1) << 5)); }
__host__ __device__ __forceinline__ void stage_rc(int b, int& R, int& C) { const int st = b / 1024, sb = b % 1024, swz = sb ^ (((sb >> 9) & 1) << 5); R = (st >> 1) * 16 + swz / 64; C = (st & 1) * 32 + (swz % 64) / 2; }
__host__ __device__ __forceinline__ int perm32(int rho) { const int n = rho >> 4, i = rho & 15; return 8 * (i >> 2) + 4 * n + (i & 3); }

struct Unit { int pm, pn; };
struct Gemm { const bf16_t* A; const bf16_t* Bt; int M, N, K; };

struct StaticOrder {
    int nM, nN, nwg, G, c;
    __host__ __device__ void init(int M, int N, int G_, int c_) { nM = M / BM; nN = N / BM; nwg = nM * nN; G = G_; c = c_; }
    __host__ __device__ bool next(int i, Unit& u) const {
        const long L = (long)i * G + c; if (L >= nwg) return false;
        int wgid = (int)L; { const int q = nwg / NXCD, r = nwg % NXCD, xcd = wgid % NXCD, off = wgid / NXCD; wgid = (xcd < r ? xcd * (q + 1) : r * (q + 1) + (xcd - r) * q) + off; }
        const int nig = WGM * nN, gid = wgid / nig, fm = gid * WGM, gsz = (nM - fm) < WGM ? (nM - fm) : WGM;
        u.pm = fm + ((wgid % nig) % gsz); u.pn = (wgid % nig) / gsz; return true;
    }
    __device__ __forceinline__ void a_ready(const Unit&) const {}
    __device__ __forceinline__ void done(const Unit&) const {}
};

__device__ __forceinline__ unsigned cvt_pk_bf16(float lo, float hi) { unsigned r; asm volatile("v_cvt_pk_bf16_f32 %0, %1, %2" : "=v"(r) : "v"(lo), "v"(hi)); return r; }

struct EpiProj {
    static constexpr bool PERM = true, AFTER_DRAIN = false;
    bf16_t* P; float* AB; int ldp;
    __device__ __forceinline__ void operator()(const f32x4 (&acc)[2][2][4][2], const Unit& u, int wr, int wc, int fr, int fq) const {
        const int row0 = u.pm * BM + wr * 64 + fr;
        if (u.pn < 11) {
            const int col0 = u.pn * BM + wc * 32 + 8 * fq;
#pragma unroll
            for (int ai = 0; ai < 2; ++ai)
#pragma unroll
                for (int m = 0; m < 4; ++m) { bf16_t* rowp = P + (size_t)(row0 + ai * HALF + m * 16) * ldp + col0;
#pragma unroll
                    for (int bj = 0; bj < 2; ++bj) { const f32x4 v0 = acc[ai][bj][m][0], v1 = acc[ai][bj][m][1];
                        u32x4 w; w.x = cvt_pk_bf16(v0[0], v0[1]); w.y = cvt_pk_bf16(v0[2], v0[3]); w.z = cvt_pk_bf16(v1[0], v1[1]); w.w = cvt_pk_bf16(v1[2], v1[3]);
                        *(u32x4*)(rowp + bj * HALF) = w; } }
        } else if (wc == 0 && fq < 2) {
#pragma unroll
            for (int ai = 0; ai < 2; ++ai)
#pragma unroll
                for (int m = 0; m < 4; ++m) { float* rowp = AB + (size_t)(row0 + ai * HALF + m * 16) * 16 + 8 * fq;
                    *(f32x4*)(rowp) = acc[ai][0][m][0]; *(f32x4*)(rowp + 4) = acc[ai][0][m][1]; }
        }
    }
};
struct EpiOut {
    static constexpr bool PERM = false, AFTER_DRAIN = false;
    const float* X; float* O; const float* gate; int rows_per_batch, ldg;
    __device__ __forceinline__ void operator()(const f32x4 (&acc)[2][2][4][2], const Unit& u, int wr, int wc, int fr, int fq) const {
        const int row0 = u.pm * BM + wr * 64 + fr, col0 = u.pn * BM + wc * 32 + 4 * fq;
        const float* gb = gate + (size_t)((u.pm * BM) / rows_per_batch) * ldg + col0;
        f32x4 gv[2][2];
#pragma unroll
        for (int bj = 0; bj < 2; ++bj)
#pragma unroll
            for (int n = 0; n < 2; ++n) gv[bj][n] = *(const f32x4*)(gb + bj * HALF + n * 16);
#pragma unroll
        for (int ai = 0; ai < 2; ++ai)
#pragma unroll
            for (int m = 0; m < 4; ++m) { const size_t ro = (size_t)(row0 + ai * HALF + m * 16) * 1024 + col0;
#pragma unroll
                for (int bj = 0; bj < 2; ++bj)
#pragma unroll
                    for (int n = 0; n < 2; ++n) { const f32x4 xv = *(const f32x4*)(X + ro + bj * HALF + n * 16);
                        *(f32x4*)(O + ro + bj * HALF + n * 16) = xv + gv[bj][n] * acc[ai][bj][m][n]; } }
    }
};

struct UnitG { int id, tile, pn, nrows; };
template <class Epi, class Sched>
__device__ __forceinline__ void gemm_phase_g(PG8_LAS unsigned char* lds, const bf16_t* Abase, const int KA, const int KB, const int nt, const int ksplit, const Sched& S, const Epi& E) {
    const int tid = threadIdx.x, wid = __builtin_amdgcn_readfirstlane(tid >> 6), lane = tid & 63, wr = wid >> 2, wc = wid & 3, fr = lane & 15, fq = lane >> 4;
    int Rr[2]; unsigned cB2[2], voffB[2];
#pragma unroll
    for (int i = 0; i < 2; ++i) { int R, C; stage_rc(tid * 16 + i * 8192, R, C); const int Rb = Epi::PERM ? ((R & ~31) + perm32(R & 31)) : R;
        Rr[i] = R; cB2[i] = (unsigned)C * 2u; voffB[i] = (unsigned)(Rb * KB + C) * 2u; }
    const size_t kstep = (size_t)(BK * 2);
    const size_t hstepB = (size_t)HALF * KB * 2;
    const unsigned ldsw = (unsigned)wid * 1024u;
    const int aoff = lds_byte(wr * 64 + fr, fq * 8), boff = lds_byte(wc * 32 + fr, fq * 8);
#define PG8_SA(b, h) (((b) * 2 + (h)) * HTB)
#define PG8_SB(b, h) ((4 + (b) * 2 + (h)) * HTB)
#define PG8_STAGE2(bufoff, gbase, v0, v1) do { \
        __builtin_amdgcn_global_load_lds((const unsigned*)((const char*)(gbase) + (v0)), (PG8_LAS unsigned*)(lds + (bufoff) + ldsw), 16, 0, 0); \
        __builtin_amdgcn_global_load_lds((const unsigned*)((const char*)(gbase) + (v1)), (PG8_LAS unsigned*)(lds + (bufoff) + ldsw + 8192), 16, 0, 0); } while (0)
#define PG8_LDA(dst, b, h) do { _Pragma("unroll") for (int m = 0; m < 4; ++m) _Pragma("unroll") for (int k = 0; k < 2; ++k) dst[m][k] = *(const PG8_LAS bf16x8*)(lds + PG8_SA(b, h) + aoff + m * 2048 + k * 1024); } while (0)
#define PG8_LDB(dst, b, h) do { _Pragma("unroll") for (int n = 0; n < 2; ++n) _Pragma("unroll") for (int k = 0; k < 2; ++k) dst[n][k] = *(const PG8_LAS bf16x8*)(lds + PG8_SB(b, h) + boff + n * 2048 + k * 1024); } while (0)
#define PG8_MMA(ai, bj, At, Bt) do { __builtin_amdgcn_s_setprio(1); _Pragma("unroll") for (int m = 0; m < 4; ++m) _Pragma("unroll") for (int n = 0; n < 2; ++n) _Pragma("unroll") for (int k = 0; k < 2; ++k) \
        acc[ai][bj][m][n] = __builtin_amdgcn_mfma_f32_16x16x32_bf16(Bt[n][k], At[m][k], acc[ai][bj][m][n], 0, 0, 0); __builtin_amdgcn_s_setprio(0); } while (0)
#define PG8_WAIT_V(n) asm volatile("s_waitcnt vmcnt(" #n ")" ::: "memory")
#define PG8_WAIT_L(n) asm volatile("s_waitcnt lgkmcnt(" #n ")" ::: "memory")
#define PG8_BAR __builtin_amdgcn_s_barrier()
#define PG8_SCHED __builtin_amdgcn_sched_barrier(0)
#define PG8_AOFFS(u, o00, o01, o10, o11) do { const unsigned _ks = (unsigned)KA * 2u; \
        o00 = (unsigned)S.tok(u, Rr[0]) * _ks + cB2[0]; o01 = (unsigned)S.tok(u, Rr[1]) * _ks + cB2[1]; \
        o10 = (unsigned)S.tok(u, HALF + Rr[0]) * _ks + cB2[0]; o11 = (unsigned)S.tok(u, HALF + Rr[1]) * _ks + cB2[1]; } while (0)
#define PG8_BT(u, t) (((t) < ksplit) ? S.bseg(u, 0) + (size_t)(t) * kstep : S.bseg(u, 1) + (size_t)((t) - ksplit) * kstep)
    UnitG cur, nxt; int ui = 0;
    if (!S.next(0, cur)) return;
    f32x4 acc[2][2][4][2];
#pragma unroll
    for (int a = 0; a < 2; ++a)
#pragma unroll
        for (int b = 0; b < 2; ++b)
#pragma unroll
            for (int m = 0; m < 4; ++m)
#pragma unroll
                for (int n = 0; n < 2; ++n) acc[a][b][m][n] = (f32x4){0.f, 0.f, 0.f, 0.f};
    bf16x8 At[4][2], B0[2][2], B1[2][2];
    unsigned c00, c01, c10, c11, n00 = 0, n01 = 0, n10 = 0, n11 = 0;
    PG8_AOFFS(cur, c00, c01, c10, c11);
    const char* const Ab = (const char*)Abase;
    {   const char* b0p = PG8_BT(cur, 0); const char* b1p = PG8_BT(cur, 1);
        PG8_STAGE2(PG8_SB(0, 0), b0p, voffB[0], voffB[1]); PG8_STAGE2(PG8_SB(0, 1), b0p + hstepB, voffB[0], voffB[1]); PG8_STAGE2(PG8_SA(0, 0), Ab, c00, c01); PG8_STAGE2(PG8_SA(0, 1), Ab, c10, c11);
        if (wr == 1) PG8_BAR;
        PG8_WAIT_V(2); PG8_BAR;
        PG8_STAGE2(PG8_SB(1, 0), b1p, voffB[0], voffB[1]); PG8_STAGE2(PG8_SA(1, 0), Ab + kstep, c00, c01); PG8_STAGE2(PG8_SB(1, 1), b1p + hstepB, voffB[0], voffB[1]);
        PG8_WAIT_V(6); PG8_BAR;
    }
    for (;;) {
        const bool has_next = S.next(ui + 1, nxt);
        for (int t = 0; t < nt; t += 2) {
            const bool last = (t == nt - 2);
            if (last && has_next) PG8_AOFFS(nxt, n00, n01, n10, n11);
            const bool usen = last && has_next;
            const int t2 = last ? 0 : t + 2, t3 = t2 + 1;
            const char* a1 = Ab + (size_t)(t + 1) * kstep;
            const char* a2 = Ab + (size_t)t2 * kstep; const char* a3 = Ab + (size_t)t3 * kstep;
            const char* b2 = usen ? PG8_BT(nxt, t2) : PG8_BT(cur, t2); const char* b3 = usen ? PG8_BT(nxt, t3) : PG8_BT(cur, t3);
            const unsigned o00 = usen ? n00 : c00, o01 = usen ? n01 : c01, o10 = usen ? n10 : c10, o11 = usen ? n11 : c11;
            PG8_LDB(B0, 0, 0); PG8_LDB(B1, 0, 1); PG8_SCHED; PG8_LDA(At, 0, 0); PG8_STAGE2(PG8_SA(1, 1), a1, c10, c11);
            PG8_WAIT_V(8); PG8_WAIT_L(0); PG8_BAR; PG8_MMA(0, 0, At, B0); PG8_MMA(0, 1, At, B1); PG8_BAR; PG8_SCHED;
            PG8_LDA(At, 0, 1); PG8_STAGE2(PG8_SB(0, 0), b2, voffB[0], voffB[1]); PG8_STAGE2(PG8_SB(0, 1), b2 + hstepB, voffB[0], voffB[1]); PG8_STAGE2(PG8_SA(0, 0), a2, o00, o01);
            PG8_WAIT_V(8); PG8_WAIT_L(0); PG8_BAR; PG8_MMA(1, 0, At, B0); PG8_MMA(1, 1, At, B1); PG8_BAR; PG8_SCHED;
            PG8_LDB(B0, 1, 0); PG8_LDB(B1, 1, 1); PG8_SCHED; PG8_LDA(At, 1, 0); PG8_STAGE2(PG8_SA(0, 1), a2, o10, o11);
            PG8_WAIT_V(8); PG8_WAIT_L(0); PG8_BAR; PG8_MMA(0, 0, At, B0); PG8_MMA(0, 1, At, B1); PG8_BAR; PG8_SCHED;
            PG8_LDA(At, 1, 1); PG8_STAGE2(PG8_SB(1, 0), b3, voffB[0], voffB[1]); PG8_STAGE2(PG8_SB(1, 1), b3 + hstepB, voffB[0], voffB[1]); PG8_STAGE2(PG8_SA(1, 0), a3, o00, o01);
            PG8_WAIT_V(8); PG8_WAIT_L(0); PG8_BAR; PG8_MMA(1, 0, At, B0); PG8_MMA(1, 1, At, B1); PG8_BAR; PG8_SCHED;
        }
        if (wr == 0) PG8_BAR;
        E(acc, cur, S, wr, wc, fr, fq);
        if (!has_next) break;
#pragma unroll
        for (int a = 0; a < 2; ++a)
#pragma unroll
            for (int b = 0; b < 2; ++b)
#pragma unroll
                for (int m = 0; m < 4; ++m)
#pragma unroll
                    for (int n = 0; n < 2; ++n) acc[a][b][m][n] = (f32x4){0.f, 0.f, 0.f, 0.f};
        cur = nxt; c00 = n00; c01 = n01; c10 = n10; c11 = n11; ++ui;
        if (wr == 1) PG8_BAR;
    }
    PG8_WAIT_V(0);
    PG8_BAR;
#undef PG8_SA
#undef PG8_SB
#undef PG8_STAGE2
#undef PG8_LDA
#undef PG8_LDB
#undef PG8_MMA
#undef PG8_WAIT_V
#undef PG8_WAIT_L
#undef PG8_BAR
#undef PG8_SCHED
#undef PG8_AOFFS
#undef PG8_BT
}
template <class Epi, class Sched, bool ALIGN_EPI = false, bool SP2 = false>
__device__ __forceinline__ void gemm_phase(PG8_LAS unsigned char* lds, const Gemm g, const Sched& S, const Epi& E) {
    const int tid = threadIdx.x, wid = __builtin_amdgcn_readfirstlane(tid >> 6), lane = tid & 63, wr = wid >> 2, wc = wid & 3, fr = lane & 15, fq = lane >> 4;
    const int K = g.K, nt = K / BK;
    unsigned voffA[2], voffB[2];
#pragma unroll
    for (int i = 0; i < 2; ++i) { int R, C; stage_rc(tid * 16 + i * 8192, R, C); const int Rb = Epi::PERM ? ((R & ~31) + perm32(R & 31)) : R;
        voffA[i] = (unsigned)(R * K + C) * 2u; voffB[i] = (unsigned)(Rb * K + C) * 2u; }
    const size_t kstep = (size_t)(BK * 2);
    const size_t hstep = (size_t)HALF * K * 2;
    const size_t tstep = 2 * hstep;
    const unsigned ldsw = (unsigned)wid * 1024u;
    const int aoff = lds_byte(wr * 64 + fr, fq * 8), boff = lds_byte(wc * 32 + fr, fq * 8);
#define PG8_SA(b, h) (((b) * 2 + (h)) * HTB)
#define PG8_SB(b, h) ((4 + (b) * 2 + (h)) * HTB)
#define PG8_STAGE(bufoff, gbase, voff) do { _Pragma("unroll") for (int _i = 0; _i < 2; ++_i) \
        __builtin_amdgcn_global_load_lds((const unsigned*)((const char*)(gbase) + (voff)[_i]), (PG8_LAS unsigned*)(lds + (bufoff) + ldsw + _i * 8192), 16, 0, 0); } while (0)
#define PG8_LDA(dst, b, h) do { _Pragma("unroll") for (int m = 0; m < 4; ++m) _Pragma("unroll") for (int k = 0; k < 2; ++k) dst[m][k] = *(const PG8_LAS bf16x8*)(lds + PG8_SA(b, h) + aoff + m * 2048 + k * 1024); } while (0)
#define PG8_LDB(dst, b, h) do { _Pragma("unroll") for (int n = 0; n < 2; ++n) _Pragma("unroll") for (int k = 0; k < 2; ++k) dst[n][k] = *(const PG8_LAS bf16x8*)(lds + PG8_SB(b, h) + boff + n * 2048 + k * 1024); } while (0)
#define PG8_MMA(ai, bj, At, Bt) do { __builtin_amdgcn_s_setprio(1); _Pragma("unroll") for (int m = 0; m < 4; ++m) _Pragma("unroll") for (int n = 0; n < 2; ++n) _Pragma("unroll") for (int k = 0; k < 2; ++k) \
        acc[ai][bj][m][n] = __builtin_amdgcn_mfma_f32_16x16x32_bf16(Bt[n][k], At[m][k], acc[ai][bj][m][n], 0, 0, 0); __builtin_amdgcn_s_setprio(0); } while (0)
#define PG8_WAIT_V(n) asm volatile("s_waitcnt vmcnt(" #n ")" ::: "memory")
#define PG8_WAIT_L(n) asm volatile("s_waitcnt lgkmcnt(" #n ")" ::: "memory")
#define PG8_BAR __builtin_amdgcn_s_barrier()
#define PG8_SCHED __builtin_amdgcn_sched_barrier(0)
    Unit cur, nxt; int ui = 0;
    if (!S.next(0, cur)) return;
    f32x4 acc[2][2][4][2];
#pragma unroll
    for (int a = 0; a < 2; ++a)
#pragma unroll
        for (int b = 0; b < 2; ++b)
#pragma unroll
            for (int m = 0; m < 4; ++m)
#pragma unroll
                for (int n = 0; n < 2; ++n) acc[a][b][m][n] = (f32x4){0.f, 0.f, 0.f, 0.f};
    bf16x8 At[4][2], B0[2][2], B1[2][2];
    const char* cA = (const char*)g.A + (size_t)cur.pm * tstep; const char* cB = (const char*)g.Bt + (size_t)cur.pn * tstep;
    S.a_ready(cur);
    if constexpr (SP2) {
        PG8_STAGE(PG8_SB(0, 0), cB, voffB); PG8_STAGE(PG8_SB(0, 1), cB + hstep, voffB); PG8_STAGE(PG8_SA(0, 0), cA, voffA); PG8_STAGE(PG8_SA(0, 1), cA + hstep, voffA);
        if (wr == 1) PG8_BAR;
        PG8_WAIT_V(2); PG8_BAR;
        PG8_STAGE(PG8_SB(1, 0), cB + kstep, voffB); PG8_STAGE(PG8_SA(1, 0), cA + kstep, voffA); PG8_STAGE(PG8_SB(1, 1), cB + hstep + kstep, voffB);
        PG8_WAIT_V(6); PG8_BAR;
    } else {
        PG8_STAGE(PG8_SB(0, 0), cB, voffB); PG8_STAGE(PG8_SA(0, 0), cA, voffA); PG8_STAGE(PG8_SB(0, 1), cB + hstep, voffB); PG8_STAGE(PG8_SA(0, 1), cA + hstep, voffA);
        if (wr == 1) PG8_BAR;
        PG8_WAIT_V(4); PG8_BAR;
        PG8_STAGE(PG8_SB(1, 0), cB + kstep, voffB); PG8_STAGE(PG8_SA(1, 0), cA + kstep, voffA); PG8_STAGE(PG8_SB(1, 1), cB + hstep + kstep, voffB);
        PG8_WAIT_V(6); PG8_BAR;
    }
    for (;;) {
        const bool has_next = S.next(ui + 1, nxt);
        const char* nA = has_next ? (const char*)g.A + (size_t)nxt.pm * tstep : cA; const char* nB = has_next ? (const char*)g.Bt + (size_t)nxt.pn * tstep : cB;
        for (int t = 0; t < nt; t += 2) {
            const bool last = (t == nt - 2);
            const char* a1 = cA + (size_t)(t + 1) * kstep;
            const char* a2 = last ? nA : cA + (size_t)(t + 2) * kstep; const char* b2 = last ? nB : cB + (size_t)(t + 2) * kstep;
            const char* a3 = a2 + kstep; const char* b3 = b2 + kstep;
            if (last && has_next) S.a_ready(nxt);
            if constexpr (SP2) {
            PG8_LDB(B0, 0, 0); PG8_LDB(B1, 0, 1); PG8_SCHED; PG8_LDA(At, 0, 0); PG8_STAGE(PG8_SA(1, 1), a1 + hstep, voffA);
            PG8_WAIT_V(8); PG8_WAIT_L(0); PG8_BAR; PG8_MMA(0, 0, At, B0); PG8_MMA(0, 1, At, B1); PG8_BAR; PG8_SCHED;
            PG8_LDA(At, 0, 1); PG8_STAGE(PG8_SB(0, 0), b2, voffB); PG8_STAGE(PG8_SB(0, 1), b2 + hstep, voffB); PG8_STAGE(PG8_SA(0, 0), a2, voffA);
            PG8_WAIT_V(8); PG8_WAIT_L(0); PG8_BAR; PG8_MMA(1, 0, At, B0); PG8_MMA(1, 1, At, B1); PG8_BAR; PG8_SCHED;
            PG8_LDB(B0, 1, 0); PG8_LDB(B1, 1, 1); PG8_SCHED; PG8_LDA(At, 1, 0); PG8_STAGE(PG8_SA(0, 1), a2 + hstep, voffA);
            PG8_WAIT_V(8); PG8_WAIT_L(0); PG8_BAR; PG8_MMA(0, 0, At, B0); PG8_MMA(0, 1, At, B1); PG8_BAR; PG8_SCHED;
            PG8_LDA(At, 1, 1); PG8_STAGE(PG8_SB(1, 0), b3, voffB); PG8_STAGE(PG8_SB(1, 1), b3 + hstep, voffB); PG8_STAGE(PG8_SA(1, 0), a3, voffA);
            PG8_WAIT_V(8); PG8_WAIT_L(0); PG8_BAR; PG8_MMA(1, 0, At, B0); PG8_MMA(1, 1, At, B1); PG8_BAR; PG8_SCHED;
            } else {
            PG8_LDB(B0, 0, 0); PG8_SCHED; PG8_LDA(At, 0, 0); PG8_STAGE(PG8_SA(1, 1), a1 + hstep, voffA);
            PG8_WAIT_L(8); PG8_BAR; PG8_WAIT_L(0); PG8_MMA(0, 0, At, B0); PG8_BAR; PG8_SCHED;
            PG8_LDB(B1, 0, 1); PG8_STAGE(PG8_SB(0, 0), b2, voffB);
            PG8_BAR; PG8_WAIT_L(0); PG8_MMA(0, 1, At, B1); PG8_BAR;
            PG8_LDA(At, 0, 1); PG8_STAGE(PG8_SA(0, 0), a2, voffA);
            PG8_BAR; PG8_WAIT_L(0); PG8_MMA(1, 0, At, B0); PG8_BAR; PG8_SCHED;
            PG8_STAGE(PG8_SB(0, 1), b2 + hstep, voffB);
            PG8_WAIT_V(6); PG8_BAR; PG8_MMA(1, 1, At, B1); PG8_BAR;
            PG8_LDB(B0, 1, 0); PG8_SCHED; PG8_LDA(At, 1, 0); PG8_STAGE(PG8_SA(0, 1), a2 + hstep, voffA);
            PG8_WAIT_L(8); PG8_BAR; PG8_WAIT_L(0); PG8_MMA(0, 0, At, B0); PG8_BAR; PG8_SCHED;
            PG8_LDB(B1, 1, 1); PG8_STAGE(PG8_SB(1, 0), b3, voffB);
            PG8_BAR; PG8_WAIT_L(0); PG8_MMA(0, 1, At, B1); PG8_BAR;
            PG8_LDA(At, 1, 1); PG8_STAGE(PG8_SA(1, 0), a3, voffA);
            PG8_BAR; PG8_WAIT_L(0); PG8_MMA(1, 0, At, B0); PG8_BAR; PG8_SCHED;
            PG8_STAGE(PG8_SB(1, 1), b3 + hstep, voffB);
            PG8_WAIT_V(6); PG8_BAR; PG8_MMA(1, 1, At, B1); PG8_BAR;
            }
        }
        if constexpr (ALIGN_EPI) { if (wr == 0) PG8_BAR; }
        if constexpr (!Epi::AFTER_DRAIN) { E(acc, cur, wr, wc, fr, fq); S.done(cur); }
        if (!has_next) break;
#pragma unroll
        for (int a = 0; a < 2; ++a)
#pragma unroll
            for (int b = 0; b < 2; ++b)
#pragma unroll
                for (int m = 0; m < 4; ++m)
#pragma unroll
                    for (int n = 0; n < 2; ++n) acc[a][b][m][n] = (f32x4){0.f, 0.f, 0.f, 0.f};
        cur = nxt; cA = nA; cB = nB; ++ui;
        if constexpr (ALIGN_EPI) { if (wr == 1) PG8_BAR; }
    }
    PG8_WAIT_V(0);
    if constexpr (!ALIGN_EPI) { if (wr == 0) PG8_BAR; }
    PG8_BAR;
    if constexpr (Epi::AFTER_DRAIN) { E.fused(acc, cur, wr, wc, fr, fq, lds, wid, lane); S.done(cur); }
#undef PG8_SA
#undef PG8_SB
#undef PG8_STAGE
#undef PG8_LDA
#undef PG8_LDB
#undef PG8_MMA
#undef PG8_WAIT_V
#undef PG8_WAIT_L
#undef PG8_BAR
#undef PG8_SCHED
}
}

constexpr int NB = 4, SEQ = 8192, DM = 1024, TT = NB * SEQ;
constexpr int NPROJ = 2816, NPAD = 3072;
constexpr int PC_Q = 0, PC_K = 512, PC_V = 1024, PC_Z = 1536, PC_SQ = 2048, PC_SK = 2560, PC_SV = 2688;
constexpr int NE = 32, NCLS = 112, DE = 256;
constexpr float EPS = 1e-6f;
constexpr int NWAVES = 8, NTHR = 512;
constexpr int N_PHASES = 10;
#ifndef MK_ONE_LAUNCH
#define MK_ONE_LAUNCH 1
#endif

constexpr size_t MiB = 1u << 20;
constexpr size_t WS_CTL = 0, CTL_ZERO_BYTES = 1 * MiB;
constexpr size_t WS_MOD = 1 * MiB;
constexpr size_t WS_WINT = 2 * MiB, WS_WOUTT = 8 * MiB, WS_WGUT = 10 * MiB, WS_WDT = 42 * MiB;
constexpr size_t WS_H = 58 * MiB;
constexpr size_t WS_PROJ = 122 * MiB;
constexpr size_t WS_AB = 298 * MiB;
constexpr size_t WS_MIX = 300 * MiB;
constexpr size_t WS_QR = 364 * MiB, WS_KR = 396 * MiB;
constexpr size_t WS_EREC = 404 * MiB, WS_CLIST = 412 * MiB;
constexpr size_t WS_HID = WS_PROJ;
constexpr size_t WS_GAP = WS_H, WS_GQP = WS_H + 32 * MiB;
constexpr size_t WS_GOP = 426 * MiB, WS_GBP = 458 * MiB, WS_GGL = 490 * MiB;
constexpr size_t WS_END = 491 * MiB;
constexpr int CW_BAR = 4096, CW_ECNT = 8192, CW_CCNT = 8256;

constexpr int RING_BYTES = 131072, LDSCTL_OFF = RING_BYTES, MISC_OFF = LDSCTL_OFF + 320, LDS_BYTES = 147456;

#define GAS __attribute__((address_space(1)))
#define LAS __attribute__((address_space(3)))
typedef unsigned short bf16;
typedef unsigned v4u __attribute__((ext_vector_type(4)));
typedef float f32x4 __attribute__((ext_vector_type(4)));
typedef GAS unsigned gu32;
#define RLX_AGENT __ATOMIC_RELAXED, __HIP_MEMORY_SCOPE_AGENT
#define LDS_WAIT() asm volatile("s_waitcnt lgkmcnt(0)" ::: "memory")
__device__ __forceinline__ unsigned f2bf(float f) { unsigned u = __builtin_bit_cast(unsigned, f); return (u + 0x7fffu + ((u >> 16) & 1u)) >> 16; }
__device__ __forceinline__ unsigned pk2(float lo, float hi) { return f2bf(lo) | (f2bf(hi) << 16); }
__device__ __forceinline__ float bf2f(bf16 v) { return __builtin_bit_cast(float, (unsigned)v << 16); }
__device__ __forceinline__ float wave_sum(float v) {
#pragma unroll
    for (int o = 1; o < 64; o <<= 1) v += __shfl_xor(v, o);
    return v;
}
__device__ __forceinline__ float siluf(float y) { return y / (1.f + __expf(-y)); }
#define XB_TMO      128
#define XB_XCNT(j)  (256  + 64 * (j))
#define XB_XSUB(j)  (1280 + 64 * (j))
#define XB_XGEN(j)  (2304 + 64 * (j))
#define XB_TOP      3328
#define XB_TOPGEN   3392
#define XCD_BAR_WORDS 3456
#define XB_SPIN_CAP (1u << 18)
__device__ __forceinline__ unsigned xb_ld(unsigned* p)              { return __hip_atomic_load(p, __ATOMIC_RELAXED, __HIP_MEMORY_SCOPE_AGENT); }
__device__ __forceinline__ unsigned xb_add(unsigned* p, unsigned v) { return __hip_atomic_fetch_add(p, v, __ATOMIC_RELAXED, __HIP_MEMORY_SCOPE_AGENT); }
__device__ __forceinline__ unsigned xb_xcc_id() { return (unsigned)__builtin_amdgcn_s_getreg((3 << 11) | 20) & 0xFu; }
#define XB_SPIN(cond, bar) do { unsigned _sp = 0; while (cond) { __builtin_amdgcn_s_sleep(1); \
    if ((++_sp & 255u) == 0u) { if (xb_ld(&(bar)[XB_TMO])) break; if (_sp > XB_SPIN_CAP) { atomicAdd(&(bar)[XB_TMO], 1u); break; } } } } while (0)

struct XcdBarrier {
    unsigned* bar; unsigned x;
    volatile LAS unsigned* st;
};

__device__ __forceinline__ XcdBarrier xcd_barrier_post(unsigned* bar, volatile LAS unsigned* st) {
    XcdBarrier b; b.bar = bar; b.x = xb_xcc_id(); b.st = st;
    if (threadIdx.x == 0) (void)xb_add(&bar[XB_XCNT(b.x)], 1u);
    return b;
}
__device__ __forceinline__ void xcd_barrier_complete(unsigned* bar, unsigned x, unsigned& nloc, unsigned& nx) {
    const unsigned G = gridDim.x * gridDim.y * gridDim.z;
    unsigned sum, cnt, mine, sp = 0u;
    for (;;) {
        sum = 0u; cnt = 0u; mine = 0u;
#pragma unroll
        for (unsigned j = 0; j < 16; ++j) { const unsigned c = xb_ld(&bar[XB_XCNT(j)]); sum += c; cnt += (c > 0u) ? 1u : 0u; mine = (j == x) ? c : mine; }
        if (sum == G) break;
        __builtin_amdgcn_s_sleep(1);
        if ((++sp & 255u) == 0u) { if (xb_ld(&bar[XB_TMO])) break; if (sp > XB_SPIN_CAP) { atomicAdd(&bar[XB_TMO], 1u); break; } }
    }
    nloc = mine > 0u ? mine : 1u; nx = cnt > 0u ? cnt : 1u;
}

__device__ __forceinline__ void xcd_barrier(const XcdBarrier& b) {
    asm volatile("s_waitcnt vmcnt(0)" ::: "memory");
    __syncthreads();
    if (threadIdx.x == 0) {
        unsigned* bar = b.bar;
        __builtin_amdgcn_s_waitcnt(0);
        unsigned nloc = b.st[0], nx = b.st[1];
        if (nloc == 0u) { xcd_barrier_complete(bar, b.x, nloc, nx); b.st[0] = nloc; b.st[1] = nx; }
        const unsigned old = xb_add(&bar[XB_XSUB(b.x)], 1u);
        const unsigned gen = old / nloc;
        if (old + 1u == (gen + 1u) * nloc) {
            __builtin_amdgcn_fence(__ATOMIC_RELEASE, "agent");
            asm volatile("s_waitcnt vmcnt(0)" ::: "memory");
            const unsigned og = xb_add(&bar[XB_TOP], 1u);
            const unsigned tg = og / nx;
            if (og + 1u == (tg + 1u) * nx) xb_add(&bar[XB_TOPGEN], 1u);
            else XB_SPIN(xb_ld(&bar[XB_TOPGEN]) == tg, bar);
            __builtin_amdgcn_fence(__ATOMIC_ACQUIRE, "agent");
            xb_add(&bar[XB_XGEN(b.x)], 1u);
            asm volatile("s_waitcnt vmcnt(0)" ::: "memory");
        } else {
            XB_SPIN(xb_ld(&bar[XB_XGEN(b.x)]) == gen, bar);
            __builtin_amdgcn_fence(__ATOMIC_ACQUIRE, "agent");
            asm volatile("s_waitcnt vmcnt(0)" ::: "memory");
        }
    }
    __syncthreads();
}

struct Args { const void* in[23]; float* out; unsigned char* ws; int ph_lo, ph_hi; };
enum { I_X = 0, I_C, I_POS, I_WADA, I_BADA, I_NORM_MIX, I_WIN, I_CONVW, I_ALOG, I_DTB, I_GNORM, I_QNORM, I_KNORM, I_SINKS, I_WOUT, I_NORM_FFN, I_WGRP, I_BGRP, I_WRT, I_BRT, I_WGATE, I_WUP, I_WDOWN };

template <class CM>
__device__ __forceinline__ void transpose_item(const float* W, int ldw, int k0, bf16* WT, int ldt, int n0, CM cm, LAS float* scr, int lane) {
    const int sc = cm(n0 + (lane & 31));
#pragma unroll 8
    for (int i = 0; i < 32; ++i) { const int kk = 2 * i + (lane >> 5); scr[kk * 33 + (lane & 31)] = sc >= 0 ? W[(size_t)(k0 + kk) * ldw + sc] : 0.f; }
    LDS_WAIT(); asm volatile("" ::: "memory");
    const int c = lane & 7;
#pragma unroll
    for (int j = 0; j < 4; ++j) { const int n = (lane >> 3) + 8 * j; const LAS float* s = scr + (8 * c) * 33 + n;
        v4u o; o.x = pk2(s[0 * 33], s[1 * 33]); o.y = pk2(s[2 * 33], s[3 * 33]); o.z = pk2(s[4 * 33], s[5 * 33]); o.w = pk2(s[6 * 33], s[7 * 33]);
        *(v4u*)(WT + (size_t)(n0 + n) * ldt + k0 + 8 * c) = o; }
    LDS_WAIT(); asm volatile("" ::: "memory");
}
struct CmIn { __device__ __forceinline__ int operator()(int n) const { return n < 2048 ? n : (n < 2816 ? n + 16 : (n < 2832 ? 2048 + (n - 2816) : -1)); } };
struct CmOff { int off; __device__ __forceinline__ int operator()(int n) const { return n + off; } };
struct CmId { __device__ __forceinline__ int operator()(int n) const { return n; } };

__device__ __forceinline__ void p0_prologue(const Args& A, LAS unsigned char* lds, int tid, int lane, int wave) {
    unsigned char* ws = A.ws;
    LAS float* scr = (LAS float*)(lds + wave * 8448);
    const int G = gridDim.x, gw = blockIdx.x * NWAVES + wave, NGW = G * NWAVES;
    constexpr int IT_IN = (NPAD / 32) * (DM / 64), IT_OUT = (DM / 32) * (DM / 64);
    for (int it = gw; it < IT_IN + IT_OUT; it += NGW) {
        if (it < IT_IN) { const int nb = it % (NPAD / 32), kb = it / (NPAD / 32); transpose_item((const float*)A.in[I_WIN], 2832, kb * 64, (bf16*)(ws + WS_WINT), DM, nb * 32, CmIn(), scr, lane); }
        else { const int r = it - IT_IN, nb = r % (DM / 32), kb = r / (DM / 32); transpose_item((const float*)A.in[I_WOUT], DM, kb * 64, (bf16*)(ws + WS_WOUTT), DM, nb * 32, CmId(), scr, lane); }
    }
    {   constexpr int IT_GU = NE * 16 * 16, IT_D = NE * 32 * 4;
        const float* wgate = (const float*)A.in[I_WGATE]; const float* wup = (const float*)A.in[I_WUP]; const float* wdown = (const float*)A.in[I_WDOWN];
        for (int it = gw; it < IT_GU + IT_D; it += NGW) {
            if (it < IT_GU) { const int e = it >> 8, r = it & 255, nb = r & 15, kb = r >> 4, j = nb >> 3, q = nb & 7;
                const float* W = (q < 4 ? wgate : wup) + (size_t)e * 1024 * 256; const int col0 = j * 128 + (q & 3) * 32;
                transpose_item(W, 256, kb * 64, (bf16*)(ws + WS_WGUT) + (size_t)e * 512 * 1024, 1024, nb * 32, CmOff{col0 - nb * 32}, scr, lane); }
            else { const int r2 = it - IT_GU, e = r2 >> 7, r = r2 & 127, nb = r & 31, kb = r >> 5;
                transpose_item(wdown + (size_t)e * 256 * 1024, 1024, kb * 64, (bf16*)(ws + WS_WDT) + (size_t)e * 1024 * 256, 256, nb * 32, CmId(), scr, lane); }
        }
    }
    LAS float* cact = (LAS float*)(lds + 69632);
    LAS float* red = (LAS float*)(lds + 69632 + 16384);
    const float* c = (const float*)A.in[I_C]; const float* wada = (const float*)A.in[I_WADA]; const float* bada = (const float*)A.in[I_BADA];
    float* mod = (float*)(ws + WS_MOD);
    if ((int)blockIdx.x < 96) {
        __syncthreads();
        for (int i = tid; i < 4096; i += NTHR) cact[i] = siluf(c[i]);
        __syncthreads();
        for (int u = blockIdx.x; u < 96; u += G) {
            const int n = u * 64 + lane; float a0 = 0.f, a1 = 0.f, a2 = 0.f, a3 = 0.f;
            for (int k = wave * 128; k < wave * 128 + 128; ++k) { const float w = wada[(size_t)k * 6144 + n]; a0 += cact[k] * w; a1 += cact[1024 + k] * w; a2 += cact[2048 + k] * w; a3 += cact[3072 + k] * w; }
            red[(wave * 4 + 0) * 64 + lane] = a0; red[(wave * 4 + 1) * 64 + lane] = a1; red[(wave * 4 + 2) * 64 + lane] = a2; red[(wave * 4 + 3) * 64 + lane] = a3;
            __syncthreads();
            if (tid < 256) { const int b = tid >> 6, l = tid & 63; float s = bada[u * 64 + l];
#pragma unroll
                for (int w = 0; w < 8; ++w) s += red[(w * 4 + b) * 64 + l];
                mod[b * 6144 + u * 64 + l] = s; }
            __syncthreads();
        }
    }
}

template <bool ROUTE>
__device__ __forceinline__ void norm_rows(const Args& A, const float* X, const float* gain, const float* shift, const float* scale, bf16* H, LAS unsigned char* lds, int lane, int wave) {
    LAS float* hl = (LAS float*)(lds + wave * 4096);
    const int G = gridDim.x, gw = blockIdx.x * NWAVES + wave, NGW = G * NWAVES;
    unsigned char* ws = A.ws;
    for (int r0 = gw * 16; r0 < TT; r0 += NGW * 16) {
        const int b = r0 / SEQ;
        f32x4 mf[4], af[4];
#pragma unroll
        for (int j = 0; j < 4; ++j) { const int col = 4 * lane + 256 * j; const f32x4 g = *(const f32x4*)(gain + col), sc = *(const f32x4*)(scale + b * 6144 + col);
            mf[j] = g * (sc + 1.0f); af[j] = *(const f32x4*)(shift + b * 6144 + col); }
        for (int i = 0; i < 16; ++i) {
            const int row = r0 + i;
            const f32x4* xr = (const f32x4*)(X + (size_t)row * DM) + lane;
            f32x4 v[4]; float s = 0.f;
#pragma unroll
            for (int j = 0; j < 4; ++j) { v[j] = xr[64 * j]; s += (v[j].x * v[j].x + v[j].y * v[j].y) + (v[j].z * v[j].z + v[j].w * v[j].w); }
            const float rstd = 1.f / sqrtf(wave_sum(s) * (1.f / DM) + EPS);
            unsigned long long* o8 = (unsigned long long*)(H + (size_t)row * DM) + lane;
#pragma unroll
            for (int j = 0; j < 4; ++j) { v[j] = v[j] * rstd * mf[j] + af[j];
                o8[64 * j] = (unsigned long long)pk2(v[j].x, v[j].y) | ((unsigned long long)pk2(v[j].z, v[j].w) << 32); }
            if constexpr (ROUTE) {
                const float* wg = (const float*)A.in[I_WGRP]; const float* wr = (const float*)A.in[I_WRT];
                float lg[36];
#pragma unroll
                for (int o = 0; o < 36; ++o) lg[o] = 0.f;
#pragma unroll
                for (int j = 0; j < 4; ++j) *(LAS f32x4*)(hl + 4 * lane + 256 * j) = v[j];
                LDS_WAIT(); asm volatile("" ::: "memory");
#pragma unroll 1
                for (int ii = 0; ii < 16; ++ii) { const int k = lane + 64 * ii; const float hv = hl[k];
                    const f32x4 g4 = *(const f32x4*)(wg + k * 4);
                    lg[0] += hv * g4.x; lg[1] += hv * g4.y; lg[2] += hv * g4.z; lg[3] += hv * g4.w;
#pragma unroll
                    for (int q = 0; q < 8; ++q) { const f32x4 r4 = *(const f32x4*)(wr + k * 32 + q * 4);
                        lg[4 + q * 4 + 0] += hv * r4.x; lg[4 + q * 4 + 1] += hv * r4.y; lg[4 + q * 4 + 2] += hv * r4.z; lg[4 + q * 4 + 3] += hv * r4.w; } }
                LDS_WAIT(); asm volatile("" ::: "memory");
#pragma unroll
                for (int o = 0; o < 36; ++o) lg[o] = wave_sum(lg[o]);
                const float* bg = (const float*)A.in[I_BGRP]; const float* br = (const float*)A.in[I_BRT];
#pragma unroll
                for (int o = 0; o < 4; ++o) lg[o] += bg[o];
#pragma unroll
                for (int o = 0; o < 32; ++o) lg[4 + o] += br[o];
                int gi = 0; float gm = lg[0];
#pragma unroll
                for (int o = 1; o < 4; ++o) if (lg[o] > gm) { gm = lg[o]; gi = o; }
                float gs = 0.f;
#pragma unroll
                for (int o = 0; o < 4; ++o) gs += __expf(lg[o] - gm);
                const float pg = 1.f / gs;
                float le[8];
#pragma unroll
                for (int j = 0; j < 8; ++j) { le[j] = lg[4 + j];
#pragma unroll
                    for (int g = 1; g < 4; ++g) le[j] = (gi == g) ? lg[4 + g * 8 + j] : le[j]; }
                int j1 = 0; float m1 = le[0];
#pragma unroll
                for (int j = 1; j < 8; ++j) if (le[j] > m1) { m1 = le[j]; j1 = j; }
                int j2 = -1; float m2 = -3.0e38f;
#pragma unroll
                for (int j = 0; j < 8; ++j) if (j != j1 && le[j] > m2) { m2 = le[j]; j2 = j; }
                const float ex = __expf(m2 - m1), w1 = pg / (1.f + ex), w2 = pg * ex / (1.f + ex);
                if (lane == 0) {
                    const int e1 = gi * 8 + j1, e2 = gi * 8 + j2;
                    unsigned* ctl = (unsigned*)(ws + WS_CTL);
                    int2* erec = (int2*)(ws + WS_EREC); int* clist = (int*)(ws + WS_CLIST);
                    const unsigned p1 = atomicAdd(ctl + CW_ECNT + e1, 1u); erec[(size_t)e1 * TT + p1] = make_int2(row * 2 + (e1 > e2 ? 1 : 0), __builtin_bit_cast(int, w1));
                    const unsigned p2 = atomicAdd(ctl + CW_ECNT + e2, 1u); erec[(size_t)e2 * TT + p2] = make_int2(row * 2 + (e2 > e1 ? 1 : 0), __builtin_bit_cast(int, w2));
                    const int a = j1 < j2 ? j1 : j2, bb = j1 < j2 ? j2 : j1;
                    const int cls = gi * 28 + (a * 7 - (a * (a - 1)) / 2 + (bb - a - 1));
                    const unsigned pc = atomicAdd(ctl + CW_CCNT + cls, 1u); clist[(size_t)cls * TT + pc] = row;
                }
            }
        }
    }
}

__device__ __forceinline__ void swa_prep(const Args& A, int lane, int wave) {
    unsigned char* ws = A.ws;
    const int G = gridDim.x, gw = blockIdx.x * NWAVES + wave, NGW = G * NWAVES;
    const bf16* proj = (const bf16*)(ws + WS_PROJ); bf16* qr = (bf16*)(ws + WS_QR); bf16* kr = (bf16*)(ws + WS_KR);
    const int* pos = (const int*)A.in[I_POS];
    const float qg = ((const float*)A.in[I_QNORM])[lane], kg = ((const float*)A.in[I_KNORM])[lane];
    const float inv = powf(10000.f, -(float)(lane & 31) / 32.f);
    for (int t = gw; t < TT; t += NGW) {
        const float ang = (float)pos[t] * inv; float sn, cs; sincosf(ang, &sn, &cs);
        for (int hd = 0; hd < 10; ++hd) {
            const int col = hd < 8 ? PC_SQ + hd * 64 : PC_SK + (hd - 8) * 64;
            const float x = bf2f(proj[(size_t)t * NPROJ + col + lane]);
            const float ss = wave_sum(x * x);
            const float xn = x * (1.f / sqrtf(ss * (1.f / 64.f) + EPS)) * (hd < 8 ? qg : kg);
            const float pr = __shfl_xor(xn, 32);
            const float o = lane < 32 ? xn * cs - pr * sn : pr * sn + xn * cs;
            if (hd < 8) qr[(size_t)t * 512 + hd * 64 + lane] = (bf16)f2bf(o); else kr[(size_t)t * 128 + (hd - 8) * 64 + lane] = (bf16)f2bf(o);
        }
    }
}
__device__ __forceinline__ void swa_naive(const Args& A, int tid, int blk, int nblk) {
    unsigned char* ws = A.ws;
    const bf16* proj = (const bf16*)(ws + WS_PROJ); const bf16* qr = (const bf16*)(ws + WS_QR); const bf16* kr = (const bf16*)(ws + WS_KR);
    bf16* mix = (bf16*)(ws + WS_MIX); const float* sinks = (const float*)A.in[I_SINKS];
    for (int item = blk * NTHR + tid; item < TT * 8; item += nblk * NTHR) {
        const int t = item >> 3, hq = item & 7, kvh = hq >> 2, b = t / SEQ, p = t % SEQ;
        float q[64], acc[64];
#pragma unroll
        for (int d = 0; d < 64; d += 8) { const v4u v = *(const v4u*)(qr + (size_t)t * 512 + hq * 64 + d);
            q[d] = 0.125f * __builtin_bit_cast(float, v.x << 16); q[d + 1] = 0.125f * __builtin_bit_cast(float, v.x & 0xffff0000u); q[d + 2] = 0.125f * __builtin_bit_cast(float, v.y << 16); q[d + 3] = 0.125f * __builtin_bit_cast(float, v.y & 0xffff0000u);
            q[d + 4] = 0.125f * __builtin_bit_cast(float, v.z << 16); q[d + 5] = 0.125f * __builtin_bit_cast(float, v.z & 0xffff0000u); q[d + 6] = 0.125f * __builtin_bit_cast(float, v.w << 16); q[d + 7] = 0.125f * __builtin_bit_cast(float, v.w & 0xffff0000u); }
#pragma unroll
        for (int d = 0; d < 64; ++d) acc[d] = 0.f;
        float m = sinks[hq], l = 1.f;
        const int k0 = p - 127 > 0 ? p - 127 : 0;
        for (int kp = k0; kp <= p; ++kp) {
            const size_t tk = (size_t)b * SEQ + kp;
            float s = 0.f;
#pragma unroll
            for (int d = 0; d < 64; d += 8) { const v4u v = *(const v4u*)(kr + tk * 128 + kvh * 64 + d);
                s += q[d] * __builtin_bit_cast(float, v.x << 16) + q[d + 1] * __builtin_bit_cast(float, v.x & 0xffff0000u) + q[d + 2] * __builtin_bit_cast(float, v.y << 16) + q[d + 3] * __builtin_bit_cast(float, v.y & 0xffff0000u)
                   + q[d + 4] * __builtin_bit_cast(float, v.z << 16) + q[d + 5] * __builtin_bit_cast(float, v.z & 0xffff0000u) + q[d + 6] * __builtin_bit_cast(float, v.w << 16) + q[d + 7] * __builtin_bit_cast(float, v.w & 0xffff0000u); }
            if (s > m) { const float sc = __expf(m - s); l *= sc;
#pragma unroll
                for (int d = 0; d < 64; ++d) acc[d] *= sc;
                m = s; }
            const float pe = __expf(s - m); l += pe;
#pragma unroll
            for (int d = 0; d < 64; d += 8) { const v4u raw = *(const v4u*)(proj + tk * NPROJ + PC_SV + kvh * 64 + d);
                acc[d + 0] += pe * __builtin_bit_cast(float, raw.x << 16); acc[d + 1] += pe * __builtin_bit_cast(float, raw.x & 0xffff0000u);
                acc[d + 2] += pe * __builtin_bit_cast(float, raw.y << 16); acc[d + 3] += pe * __builtin_bit_cast(float, raw.y & 0xffff0000u);
                acc[d + 4] += pe * __builtin_bit_cast(float, raw.z << 16); acc[d + 5] += pe * __builtin_bit_cast(float, raw.z & 0xffff0000u);
                acc[d + 6] += pe * __builtin_bit_cast(float, raw.w << 16); acc[d + 7] += pe * __builtin_bit_cast(float, raw.w & 0xffff0000u); }
        }
        const float il = 1.f / l;
#pragma unroll
        for (int d = 0; d < 64; d += 8) { v4u o; o.x = pk2(acc[d] * il, acc[d + 1] * il); o.y = pk2(acc[d + 2] * il, acc[d + 3] * il); o.z = pk2(acc[d + 4] * il, acc[d + 5] * il); o.w = pk2(acc[d + 6] * il, acc[d + 7] * il);
            *(v4u*)(mix + (size_t)t * DM + 512 + hq * 64 + d) = o; }
    }
}

typedef short bf16x8_t __attribute__((ext_vector_type(8)));
typedef float f32x16 __attribute__((ext_vector_type(16)));
typedef unsigned v2u __attribute__((ext_vector_type(2)));
__device__ __forceinline__ unsigned cvtpk(float lo, float hi) { unsigned r; asm volatile("v_cvt_pk_bf16_f32 %0, %1, %2" : "=v"(r) : "v"(lo), "v"(hi)); return r; }
__device__ __forceinline__ void swa_mfma(const Args& A, LAS unsigned char* lds, int tid, int lane, int wave, int blk, int nblk) {
    unsigned char* ws = A.ws;
    const bf16* proj = (const bf16*)(ws + WS_PROJ); const bf16* qr = (const bf16*)(ws + WS_QR); const bf16* kr = (const bf16*)(ws + WS_KR);
    bf16* mix = (bf16*)(ws + WS_MIX); const float* sinks = (const float*)A.in[I_SINKS];
    constexpr int KST = 144, VST = 520;
    LAS unsigned char* Kl = lds; LAS unsigned char* Vt = lds + 256 * KST;
    const int g = wave >> 1, qh = wave & 1, ql = lane & 31, hh = lane >> 5;
    constexpr float LOG2E = 1.4426950408889634f, CS = 0.125f * LOG2E;
    for (int u = blk; u < NB * 2 * (SEQ / 128); u += nblk) {
        const int n = u & 63, kvh = (u >> 6) & 1, b = u >> 7;
        const int tb = b * SEQ + n * 128;
        __syncthreads();
#pragma unroll
        for (int it = 0; it < 4; ++it) { const int idx = tid + it * NTHR, key = idx >> 3, ch = idx & 7; int tk = tb - 128 + key; if (tk < b * SEQ) tk = b * SEQ;
            const v4u kv = *(const v4u*)(kr + (size_t)tk * 128 + kvh * 64 + ch * 8);
            *(LAS v4u*)(Kl + key * KST + ch * 16) = kv;
            const v4u vv = *(const v4u*)(proj + (size_t)tk * NPROJ + PC_SV + kvh * 64 + ch * 8);
            LAS unsigned short* vp = (LAS unsigned short*)(Vt + (ch * 8) * VST + key * 2);
            vp[0 * (VST / 2)] = (unsigned short)(vv.x & 0xffffu); vp[1 * (VST / 2)] = (unsigned short)(vv.x >> 16);
            vp[2 * (VST / 2)] = (unsigned short)(vv.y & 0xffffu); vp[3 * (VST / 2)] = (unsigned short)(vv.y >> 16);
            vp[4 * (VST / 2)] = (unsigned short)(vv.z & 0xffffu); vp[5 * (VST / 2)] = (unsigned short)(vv.z >> 16);
            vp[6 * (VST / 2)] = (unsigned short)(vv.w & 0xffffu); vp[7 * (VST / 2)] = (unsigned short)(vv.w >> 16); }
        __syncthreads();
        const int hq = kvh * 4 + g; const float sinkl = sinks[hq] * LOG2E;
#pragma unroll 1
        for (int qt = 0; qt < 2; ++qt) {
            const int i0 = qh * 64 + qt * 32, iq = i0 + ql;
            const size_t tq = (size_t)(tb + iq);
            bf16x8_t qf[4];
#pragma unroll
            for (int ks = 0; ks < 4; ++ks) qf[ks] = *(const bf16x8_t*)(qr + tq * 512 + hq * 64 + ks * 16 + hh * 8);
            f32x16 sc[5];
#pragma unroll
            for (int kt = 0; kt < 5; ++kt) { f32x16 acc;
#pragma unroll
                for (int r = 0; r < 16; ++r) acc[r] = 0.f;
#pragma unroll
                for (int ks = 0; ks < 4; ++ks) { const bf16x8_t kf = *(const LAS bf16x8_t*)(Kl + (i0 + 32 * kt + ql) * KST + (ks * 16 + hh * 8) * 2);
                    acc = __builtin_amdgcn_mfma_f32_32x32x16_bf16(kf, qf[ks], acc, 0, 0, 0); }
                sc[kt] = acc; }
            float mloc = -3.0e38f;
#pragma unroll
            for (int kt = 0; kt < 5; ++kt)
#pragma unroll
                for (int r = 0; r < 16; ++r) { const int j = i0 + 32 * kt + (r & 3) + 8 * (r >> 2) + 4 * hh;
                    const bool valid = (j > iq) && (j <= iq + 128) && (n > 0 || j >= 128);
                    const float sv = valid ? sc[kt][r] * CS : -1.0e30f; sc[kt][r] = sv; mloc = fmaxf(mloc, sv); }
            float mx = fmaxf(mloc, __shfl_xor(mloc, 32)); mx = fmaxf(mx, sinkl);
            float lsum = 0.f;
#pragma unroll
            for (int kt = 0; kt < 5; ++kt)
#pragma unroll
                for (int r = 0; r < 16; ++r) { const float p = __builtin_amdgcn_exp2f(sc[kt][r] - mx); sc[kt][r] = p; lsum += p; }
            lsum += __shfl_xor(lsum, 32); lsum += __builtin_amdgcn_exp2f(sinkl - mx);
            f32x16 o0, o1;
#pragma unroll
            for (int r = 0; r < 16; ++r) { o0[r] = 0.f; o1[r] = 0.f; }
#pragma unroll
            for (int kt = 0; kt < 5; ++kt)
#pragma unroll
                for (int s2 = 0; s2 < 2; ++s2) {
                    union { bf16x8_t v; unsigned u[4]; } pf;
#pragma unroll
                    for (int p = 0; p < 4; ++p) pf.u[p] = cvtpk(sc[kt][8 * s2 + 2 * p], sc[kt][8 * s2 + 2 * p + 1]);
                    const int jb = i0 + 32 * kt + 16 * s2 + 4 * hh;
                    union { bf16x8_t v; v2u u[2]; } v0, v1;
                    const LAS unsigned char* r0 = Vt + ql * VST + jb * 2; const LAS unsigned char* r1 = Vt + (32 + ql) * VST + jb * 2;
                    v0.u[0] = *(const LAS v2u*)(r0); v0.u[1] = *(const LAS v2u*)(r0 + 16);
                    v1.u[0] = *(const LAS v2u*)(r1); v1.u[1] = *(const LAS v2u*)(r1 + 16);
                    o0 = __builtin_amdgcn_mfma_f32_32x32x16_bf16(v0.v, pf.v, o0, 0, 0, 0);
                    o1 = __builtin_amdgcn_mfma_f32_32x32x16_bf16(v1.v, pf.v, o1, 0, 0, 0);
                }
            const float il = 1.f / lsum;
            bf16* op = mix + tq * DM + 512 + hq * 64 + 4 * hh;
#pragma unroll
            for (int rq = 0; rq < 4; ++rq) {
                v2u w0; w0.x = cvtpk(o0[4 * rq] * il, o0[4 * rq + 1] * il); w0.y = cvtpk(o0[4 * rq + 2] * il, o0[4 * rq + 3] * il);
                *(v2u*)(op + 8 * rq) = w0;
                v2u w1; w1.x = cvtpk(o1[4 * rq] * il, o1[4 * rq + 1] * il); w1.y = cvtpk(o1[4 * rq + 2] * il, o1[4 * rq + 3] * il);
                *(v2u*)(op + 32 + 8 * rq) = w1; }
        }
    }
}

__device__ __forceinline__ int frag_a_idx(int row, int col) { const int mt = row >> 4, l15 = row & 15, ks = col >> 5, x = col & 31, jh = x >> 4, g4 = (x >> 2) & 3, jl = x & 3; return ((mt * 2 + ks) * 64 + g4 * 16 + l15) * 8 + 4 * jh + jl; }
__device__ __forceinline__ int frag_c_idx(int row, int col) { const int w = col >> 4, l15 = col & 15, mt = row >> 4, y = row & 15, g4 = y >> 2, i = y & 3; return ((w * 64 + g4 * 16 + l15) * 4 + mt) * 4 + i; }
__device__ __forceinline__ void gdn_g1_naive(const Args& A, LAS float* L, int tid) {
    unsigned char* ws = A.ws;
    const bf16* proj = (const bf16*)(ws + WS_PROJ); const float* ab = (const float*)(ws + WS_AB);
    bf16* AP = (bf16*)(ws + WS_GAP); bf16* BP = (bf16*)(ws + WS_GBP); bf16* QP = (bf16*)(ws + WS_GQP); bf16* OP = (bf16*)(ws + WS_GOP); float* GL = (float*)(ws + WS_GGL);
    const float* convw = (const float*)A.in[I_CONVW];
    constexpr int LD = 65, AR = 64 * LD;
    LAS float* q = L; LAS float* k = q + AR; LAS float* v = k + AR; LAS float* Mm = v + AR; LAS float* At = Mm + AR; LAS float* w = At + AR;
    LAS float* Gc = w + AR; LAS float* beta = Gc + 64;
    const int i8 = tid >> 3, e0 = (tid & 7) * 8;
    for (int cid = blockIdx.x; cid < NB * 8 * 128; cid += gridDim.x) {
        const int n = cid & 127, bh = cid >> 7, b = bh >> 3, h = bh & 7;
        const float Ah = expf(((const float*)A.in[I_ALOG])[h]), dtb = ((const float*)A.in[I_DTB])[h];
        const int t0 = b * SEQ + n * 64;
        __syncthreads();
        for (int idx = tid; idx < 3 * 4096; idx += NTHR) {
            const int part = idx >> 12, rem = idx & 4095, i = rem >> 6, d = rem & 63, c = part * 512 + h * 64 + d;
            float y = 0.f;
#pragma unroll
            for (int j = 0; j < 4; ++j) { const int s = n * 64 + i - 3 + j; if (s >= 0) y += convw[j * 1536 + c] * bf2f(proj[(size_t)(b * SEQ + s) * NPROJ + c]); }
            y = y / (1.f + __expf(-y));
            (part == 0 ? q : (part == 1 ? k : v))[i * LD + d] = y;
        }
        if (tid < 64) { const float a = ab[(size_t)(t0 + tid) * 16 + h], bb = ab[(size_t)(t0 + tid) * 16 + 8 + h]; const float xx = a + dtb;
            const float sp = xx > 20.f ? xx : log1pf(expf(xx)); Gc[tid] = -Ah * sp; beta[tid] = 1.f / (1.f + __expf(-bb)); }
        __syncthreads();
        if (tid < 128) { LAS float* arr = tid < 64 ? q : k; const int i = tid & 63; float ss = 0.f;
            for (int d = 0; d < 64; ++d) ss += arr[i * LD + d] * arr[i * LD + d];
            const float r = (1.f / sqrtf(ss + EPS)) * (tid < 64 ? 0.125f : 1.f);
            for (int d = 0; d < 64; ++d) arr[i * LD + d] *= r; }
        if (tid == 128) { float run = 0.f; for (int i = 0; i < 64; ++i) { run += Gc[i]; Gc[i] = run; } }
        __syncthreads();
        {   const int i = i8;
            for (int jj = 0; jj < 8; ++jj) { const int j = e0 + jj; float dq = 0.f, dk = 0.f;
_Pragma("unroll 2") for (int d = 0; d < 64; ++d) { const float kj = k[j * LD + d]; dq += q[i * LD + d] * kj; dk += k[i * LD + d] * kj; }
                const float dec = (i >= j) ? __expf(Gc[i] - Gc[j]) : 0.f;
                At[i * LD + j] = dq * dec; Mm[i * LD + j] = (i > j) ? dk * beta[i] * dec : 0.f; }
        }
        __syncthreads();
        for (int idx = tid; idx < 4096; idx += NTHR) { const int i = idx >> 6, d = idx & 63; v[i * LD + d] *= beta[i]; w[i * LD + d] = k[i * LD + d] * beta[i] * __expf(Gc[i]); }
        __syncthreads();
        if (tid < 128) { LAS float* arr = tid < 64 ? v : w; const int c = tid & 63;
            _Pragma("unroll 1") for (int i = 1; i < 64; ++i) { float a = arr[i * LD + c]; _Pragma("unroll 4") for (int j = 0; j < i; ++j) a -= Mm[i * LD + j] * arr[j * LD + c]; arr[i * LD + c] = a; } }
        __syncthreads();
        const float gl = Gc[63];
        const size_t cb = (size_t)cid * 4096;
        {
            const int d = i8; float a[8], bq[8];
#pragma unroll
            for (int ee = 0; ee < 8; ++ee) { a[ee] = 0.f; bq[ee] = 0.f; }
_Pragma("unroll 2")
            for (int c = 0; c < 64; ++c) { const float kd = k[c * LD + d] * __expf(gl - Gc[c]);
#pragma unroll
                for (int ee = 0; ee < 8; ++ee) { a[ee] -= kd * w[c * LD + e0 + ee]; bq[ee] += kd * v[c * LD + e0 + ee]; } }
#pragma unroll
            for (int ee = 0; ee < 8; ++ee) { const int dp = e0 + ee; AP[cb + frag_a_idx(d, dp)] = (bf16)f2bf(a[ee]); BP[cb + frag_c_idx(d, dp)] = (bf16)f2bf(bq[ee]); }
        }
        {
            const int c = i8; float a[8], bq[8]; const float eg = __expf(Gc[c]);
#pragma unroll
            for (int ee = 0; ee < 8; ++ee) { a[ee] = eg * q[c * LD + e0 + ee]; bq[ee] = 0.f; }
_Pragma("unroll 2")
            for (int s2 = 0; s2 <= c; ++s2) { const float av = At[c * LD + s2];
#pragma unroll
                for (int ee = 0; ee < 8; ++ee) { a[ee] -= av * w[s2 * LD + e0 + ee]; bq[ee] += av * v[s2 * LD + e0 + ee]; } }
#pragma unroll
            for (int ee = 0; ee < 8; ++ee) { const int dp = e0 + ee; QP[cb + frag_a_idx(c, dp)] = (bf16)f2bf(a[ee]); OP[cb + frag_c_idx(c, dp)] = (bf16)f2bf(bq[ee]); }
        }
        if (tid == 0) GL[cid] = __expf(gl);
    }
}
struct G2Set { bf16x8_t a[4][2], q[4][2]; v4u b[2], o[2]; float egl; };
__device__ __forceinline__ f32x4 g2_unpack(const v4u (&p)[2], int mt) {
    const unsigned d0 = mt == 0 ? p[0].x : mt == 1 ? p[0].z : mt == 2 ? p[1].x : p[1].z, d1 = mt == 0 ? p[0].y : mt == 1 ? p[0].w : mt == 2 ? p[1].y : p[1].w;
    f32x4 r; r.x = __builtin_bit_cast(float, d0 << 16); r.y = __builtin_bit_cast(float, d0 & 0xffff0000u); r.z = __builtin_bit_cast(float, d1 << 16); r.w = __builtin_bit_cast(float, d1 & 0xffff0000u); return r;
}
__device__ __forceinline__ void gdn_g2_mfma(const Args& A, int bh, LAS unsigned char* lds, int tid, int lane, int wave) {
    unsigned char* ws = A.ws;
    const bf16* proj = (const bf16*)(ws + WS_PROJ); bf16* mix = (bf16*)(ws + WS_MIX);
    const bf16* AP = (const bf16*)(ws + WS_GAP); const bf16* BP = (const bf16*)(ws + WS_GBP); const bf16* QP = (const bf16*)(ws + WS_GQP); const bf16* OP = (const bf16*)(ws + WS_GOP); const float* GL = (const float*)(ws + WS_GGL);
    const int b = bh >> 3, h = bh & 7;
    constexpr int OST = 68;
    LAS float* obuf = (LAS float*)lds;
    __syncthreads();
    if (wave < 4) {
        const int l15 = lane & 15, g4 = lane >> 4;
        f32x4 sC[4]; bf16x8_t sB[2];
#pragma unroll
        for (int mt = 0; mt < 4; ++mt) sC[mt] = (f32x4){0.f, 0.f, 0.f, 0.f};
#pragma unroll
        for (int ks = 0; ks < 2; ++ks)
#pragma unroll
            for (int j = 0; j < 8; ++j) sB[ks][j] = 0;
#define G2_LOAD(S, n) do { const size_t cb_ = (size_t)(bh * 128 + (n)) * 4096; \
        _Pragma("unroll") for (int mt = 0; mt < 4; ++mt) _Pragma("unroll") for (int ks = 0; ks < 2; ++ks) { \
            S.a[mt][ks] = *(const bf16x8_t*)(AP + cb_ + ((mt * 2 + ks) * 64 + lane) * 8); S.q[mt][ks] = *(const bf16x8_t*)(QP + cb_ + ((mt * 2 + ks) * 64 + lane) * 8); } \
        S.b[0] = *(const v4u*)(BP + cb_ + (wave * 64 + lane) * 16); S.b[1] = *(const v4u*)(BP + cb_ + (wave * 64 + lane) * 16 + 8); \
        S.o[0] = *(const v4u*)(OP + cb_ + (wave * 64 + lane) * 16); S.o[1] = *(const v4u*)(OP + cb_ + (wave * 64 + lane) * 16 + 8); \
        S.egl = GL[bh * 128 + (n)]; } while (0)
#define G2_STEP(S, n) do { f32x4 oacc[4], sacc[4]; \
        _Pragma("unroll") for (int mt = 0; mt < 4; ++mt) { oacc[mt] = g2_unpack(S.o, mt); sacc[mt] = sC[mt] * S.egl + g2_unpack(S.b, mt); } \
        _Pragma("unroll") for (int mt = 0; mt < 4; ++mt) _Pragma("unroll") for (int ks = 0; ks < 2; ++ks) sacc[mt] = __builtin_amdgcn_mfma_f32_16x16x32_bf16(S.a[mt][ks], sB[ks], sacc[mt], 0, 0, 0); \
        _Pragma("unroll") for (int mt = 0; mt < 4; ++mt) _Pragma("unroll") for (int ks = 0; ks < 2; ++ks) oacc[mt] = __builtin_amdgcn_mfma_f32_16x16x32_bf16(S.q[mt][ks], sB[ks], oacc[mt], 0, 0, 0); \
        LAS float* ob_ = obuf + ((n) & 1) * 64 * OST + wave * 16 + l15; \
        _Pragma("unroll") for (int mt = 0; mt < 4; ++mt) _Pragma("unroll") for (int i = 0; i < 4; ++i) ob_[(16 * mt + 4 * g4 + i) * OST] = oacc[mt][i]; \
        _Pragma("unroll") for (int mt = 0; mt < 4; ++mt) sC[mt] = sacc[mt]; \
        _Pragma("unroll") for (int ks = 0; ks < 2; ++ks) { union { bf16x8_t v; unsigned u[4]; } pk_; \
            pk_.u[0] = cvtpk(sC[2 * ks].x, sC[2 * ks].y); pk_.u[1] = cvtpk(sC[2 * ks].z, sC[2 * ks].w); pk_.u[2] = cvtpk(sC[2 * ks + 1].x, sC[2 * ks + 1].y); pk_.u[3] = cvtpk(sC[2 * ks + 1].z, sC[2 * ks + 1].w); sB[ks] = pk_.v; } \
        __syncthreads(); } while (0)
        G2Set s0, s1;
        G2_LOAD(s0, 0);
#pragma unroll 1
        for (int n = 0; n < SEQ / 64; n += 2) {
            G2_LOAD(s1, n + 1);
            G2_STEP(s0, n);
            if (n + 2 < SEQ / 64) G2_LOAD(s0, n + 2);
            G2_STEP(s1, n + 1);
        }
#undef G2_LOAD
#undef G2_STEP
    } else {
        const int f = wave - 4, c = 16 * f + (lane >> 2), q4 = lane & 3;
        const float* onorm = (const float*)A.in[I_GNORM];
        float gain[16];
#pragma unroll
        for (int k = 0; k < 16; ++k) gain[k] = onorm[16 * q4 + k];
#pragma unroll 1
        for (int n = 0; n < SEQ / 64; ++n) {
            const size_t t = (size_t)b * SEQ + n * 64 + c;
            const v4u z0 = *(const v4u*)(proj + t * NPROJ + PC_Z + h * 64 + 16 * q4), z1 = *(const v4u*)(proj + t * NPROJ + PC_Z + h * 64 + 16 * q4 + 8);
            __syncthreads();
            const LAS float* ob = obuf + (n & 1) * 64 * OST + c * OST + 16 * q4;
            float o[16];
#pragma unroll
            for (int k = 0; k < 4; ++k) { const f32x4 v = *(const LAS f32x4*)(ob + 4 * k); o[4 * k] = v.x; o[4 * k + 1] = v.y; o[4 * k + 2] = v.z; o[4 * k + 3] = v.w; }
            float ss = 0.f;
#pragma unroll
            for (int k = 0; k < 16; ++k) ss += o[k] * o[k];
            ss += __shfl_xor(ss, 1); ss += __shfl_xor(ss, 2);
            const float r = 1.f / sqrtf(ss * (1.f / 64.f) + EPS);
            const unsigned zu[8] = {z0.x, z0.y, z0.z, z0.w, z1.x, z1.y, z1.z, z1.w};
            unsigned ou[8];
#pragma unroll
            for (int k = 0; k < 8; ++k) { const float za = __builtin_bit_cast(float, zu[k] << 16), zb = __builtin_bit_cast(float, zu[k] & 0xffff0000u);
                ou[k] = pk2(o[2 * k] * r * gain[2 * k] * siluf(za), o[2 * k + 1] * r * gain[2 * k + 1] * siluf(zb)); }
            bf16* op = mix + t * DM + h * 64 + 16 * q4;
            *(v4u*)(op) = (v4u){ou[0], ou[1], ou[2], ou[3]}; *(v4u*)(op + 8) = (v4u){ou[4], ou[5], ou[6], ou[7]};
        }
    }
}

__device__ __forceinline__ int wave_incl_scan(int v, int lane) {
#pragma unroll
    for (int o = 1; o < 64; o <<= 1) { const int t = __shfl_up(v, o); if (lane >= o) v += t; }
    return v;
}
struct SchedE {
    int G, c, cntv, prev, total_rt; const int2* rec; const char* W;
    __device__ __forceinline__ void init(const unsigned* cnt, const int2* rec_, const char* W_, int G_, int c_, int lane) {
        G = G_; c = c_; rec = rec_; W = W_;
        cntv = lane < NE ? (int)cnt[lane] : 0;
        const int inc = wave_incl_scan((cntv + 255) >> 8, lane);
        total_rt = __builtin_amdgcn_readlane(inc, 63);
        prev = lane < NE ? inc : 0x7fffffff;
    }
    __device__ __forceinline__ bool next(int i, pg8::UnitG& u) const {
        const int L = i * G + c; if (L >= 2 * total_rt) return false;
        const int rt = L >> 1;
        const int e = __builtin_amdgcn_readfirstlane(__popcll(__ballot(prev <= rt)));
        const int base = e ? __builtin_amdgcn_readlane(prev, e - 1) : 0;
        const int cnt = __builtin_amdgcn_readlane(cntv, e);
        u.id = e; u.tile = rt - base; u.pn = L & 1; const int rem = cnt - u.tile * 256; u.nrows = rem < 256 ? rem : 256;
        return true;
    }
    __device__ __forceinline__ int tok(const pg8::UnitG& u, int r) const { return r < u.nrows ? (rec[(size_t)u.id * TT + u.tile * 256 + r].x >> 1) : 0; }
    __device__ __forceinline__ const char* bseg(const pg8::UnitG& u, int) const { return W + ((size_t)u.id * 512 + u.pn * 256) * 2048; }
};
struct EpiGU {
    static constexpr bool PERM = true;
    bf16* HID;
    __device__ __forceinline__ void operator()(const pg8::f32x4 (&acc)[2][2][4][2], const pg8::UnitG& u, const SchedE& S, int wr, int wc, int fr, int fq) const {
#pragma unroll
        for (int ai = 0; ai < 2; ++ai)
#pragma unroll
            for (int m = 0; m < 4; ++m) { const int r = ai * 128 + wr * 64 + m * 16 + fr;
                if (r < u.nrows) { const int2 rc = S.rec[(size_t)u.id * TT + u.tile * 256 + r]; const int t = rc.x >> 1, half = rc.x & 1; const float w = __builtin_bit_cast(float, rc.y);
                    float hv[8];
#pragma unroll
                    for (int n = 0; n < 2; ++n)
#pragma unroll
                        for (int j = 0; j < 4; ++j) { const float g = acc[ai][0][m][n][j], up = acc[ai][1][m][n][j]; hv[n * 4 + j] = w * siluf(g) * up; }
                    v4u o; o.x = pk2(hv[0], hv[1]); o.y = pk2(hv[2], hv[3]); o.z = pk2(hv[4], hv[5]); o.w = pk2(hv[6], hv[7]);
                    *(v4u*)(HID + (size_t)t * 512 + half * 256 + u.pn * 128 + wc * 32 + 8 * fq) = o; } }
    }
};
struct SchedC {
    int G, c, cntA, cntB, preA, preB, total_rt; const int* clist; const char* W;
    __device__ __forceinline__ void init(const unsigned* cnt, const int* clist_, const char* W_, int G_, int c_, int lane) {
        G = G_; c = c_; clist = clist_; W = W_;
        cntA = (int)cnt[lane]; cntB = lane < NCLS - 64 ? (int)cnt[64 + lane] : 0;
        const int ia = wave_incl_scan((cntA + 255) >> 8, lane); const int ta = __builtin_amdgcn_readlane(ia, 63);
        const int ib = wave_incl_scan((cntB + 255) >> 8, lane) + ta;
        total_rt = __builtin_amdgcn_readlane(ib, 63);
        preA = ia; preB = lane < NCLS - 64 ? ib : 0x7fffffff;
    }
    __device__ __forceinline__ bool next(int i, pg8::UnitG& u) const {
        const int L = i * G + c; if (L >= 4 * total_rt) return false;
        const int rt = L >> 2;
        const int cls = __builtin_amdgcn_readfirstlane(__popcll(__ballot(preA <= rt)) + __popcll(__ballot(preB <= rt)));
        int base = 0; if (cls > 0) base = (cls - 1 < 64) ? __builtin_amdgcn_readlane(preA, cls - 1) : __builtin_amdgcn_readlane(preB, cls - 65);
        const int cnt = cls < 64 ? __builtin_amdgcn_readlane(cntA, cls) : __builtin_amdgcn_readlane(cntB, cls - 64);
        u.id = cls; u.tile = rt - base; u.pn = L & 3; const int rem = cnt - u.tile * 256; u.nrows = rem < 256 ? rem : 256;
        return true;
    }
    __device__ __forceinline__ int tok(const pg8::UnitG& u, int r) const { return r < u.nrows ? clist[(size_t)u.id * TT + u.tile * 256 + r] : 0; }
    __device__ __forceinline__ const char* bseg(const pg8::UnitG& u, int seg) const {
        const int g = u.id / 28; int a = 0, rem = u.id % 28; while (rem >= 7 - a) { rem -= 7 - a; ++a; } const int b = a + 1 + rem;
        const int e = g * 8 + (seg ? b : a);
        return W + ((size_t)e * 1024 + u.pn * 256) * 512;
    }
};
struct EpiDown {
    static constexpr bool PERM = false;
    float* OUT; const float* gate2;
    __device__ __forceinline__ void operator()(const pg8::f32x4 (&acc)[2][2][4][2], const pg8::UnitG& u, const SchedC& S, int wr, int wc, int fr, int fq) const {
#pragma unroll
        for (int ai = 0; ai < 2; ++ai)
#pragma unroll
            for (int m = 0; m < 4; ++m) { const int r = ai * 128 + wr * 64 + m * 16 + fr;
                if (r < u.nrows) { const int t = S.clist[(size_t)u.id * TT + u.tile * 256 + r]; const int b = t / SEQ; const int col0 = u.pn * 256 + wc * 32 + 4 * fq;
                    float* op = OUT + (size_t)t * DM + col0; const float* gp = gate2 + b * 6144 + col0;
#pragma unroll
                    for (int bj = 0; bj < 2; ++bj)
#pragma unroll
                        for (int n = 0; n < 2; ++n) { const int off = bj * 128 + n * 16; const f32x4 xv = *(const f32x4*)(op + off), gv = *(const f32x4*)(gp + off);
                            *(f32x4*)(op + off) = xv + gv * acc[ai][bj][m][n]; } } }
    }
};

__global__ void __launch_bounds__(NTHR, 2) fwd_kernel(Args args) {
    extern __shared__ __attribute__((aligned(16))) unsigned char lds_raw[];
    LAS unsigned char* lds = (LAS unsigned char*)lds_raw;
    volatile LAS unsigned* MISC = (volatile LAS unsigned*)(lds + MISC_OFF);
    const int tid = threadIdx.x, lane = tid & 63, wave = __builtin_amdgcn_readfirstlane(tid >> 6);
    const int G = gridDim.x;
    unsigned char* ws = args.ws;
    for (int u = tid; u < (LDS_BYTES - LDSCTL_OFF) / 4; u += NTHR) ((LAS unsigned*)(lds + LDSCTL_OFF))[u] = 0u;
    __syncthreads();
    const int lo = args.ph_lo, hi = args.ph_hi;
    const bool use_bar = (hi - lo) > 1;
    XcdBarrier bar; bar.bar = (unsigned*)(ws + WS_CTL) + CW_BAR; bar.x = 0; bar.st = nullptr;
    if (use_bar) bar = xcd_barrier_post((unsigned*)(ws + WS_CTL) + CW_BAR, MISC + 8);
#define IN(k) (lo <= (k) && (k) < hi)
#define BOTH(k) (IN(k) && IN((k) + 1))
#define GRID_BAR(k) do { if (BOTH(k)) xcd_barrier(bar); } while (0)
    const float* mod = (const float*)(ws + WS_MOD);

    if (IN(0)) { p0_prologue(args, lds, tid, lane, wave); GRID_BAR(0); }
    if (IN(1)) { norm_rows<false>(args, (const float*)args.in[I_X], (const float*)args.in[I_NORM_MIX], mod + 0, mod + 1024, (bf16*)(ws + WS_H), lds, lane, wave); GRID_BAR(1); }
    if (IN(2)) {
        pg8::Gemm g{(const pg8::bf16_t*)(ws + WS_H), (const pg8::bf16_t*)(ws + WS_WINT), TT, NPAD, DM}; pg8::StaticOrder S; S.init(TT, NPAD, G, (int)blockIdx.x);
        pg8::EpiProj E{(pg8::bf16_t*)(ws + WS_PROJ), (float*)(ws + WS_AB), NPROJ};
        pg8::gemm_phase<pg8::EpiProj, pg8::StaticOrder, true, true>(lds, g, S, E);
        GRID_BAR(2);
    }
    if (IN(3)) { swa_prep(args, lane, wave); GRID_BAR(3); }
    if (IN(4)) { gdn_g1_naive(args, (LAS float*)lds, tid); GRID_BAR(4); }
    if (IN(5)) {
        if ((int)blockIdx.x < 32) gdn_g2_mfma(args, (int)blockIdx.x, lds, tid, lane, wave);
        else swa_mfma(args, lds, tid, lane, wave, (int)blockIdx.x - 32, G - 32);
        GRID_BAR(5);
    }
    if (IN(6)) {
        pg8::Gemm g{(const pg8::bf16_t*)(ws + WS_MIX), (const pg8::bf16_t*)(ws + WS_WOUTT), TT, DM, DM}; pg8::StaticOrder S; S.init(TT, DM, G, (int)blockIdx.x);
        pg8::EpiOut E{(const float*)args.in[I_X], args.out, mod + 2048, SEQ, 6144};
        pg8::gemm_phase<pg8::EpiOut, pg8::StaticOrder, true, true>(lds, g, S, E);
        GRID_BAR(6);
    }
    if (IN(7)) { norm_rows<true>(args, args.out, (const float*)args.in[I_NORM_FFN], mod + 3072, mod + 4096, (bf16*)(ws + WS_H), lds, lane, wave); GRID_BAR(7); }
    if (IN(8)) {
        SchedE S; S.init((const unsigned*)(ws + WS_CTL) + CW_ECNT, (const int2*)(ws + WS_EREC), (const char*)(ws + WS_WGUT), G, (int)blockIdx.x, lane);
        EpiGU E{(bf16*)(ws + WS_HID)};
        pg8::gemm_phase_g<EpiGU, SchedE>(lds, (const pg8::bf16_t*)(ws + WS_H), 1024, 1024, 16, 16, S, E);
        GRID_BAR(8);
    }
    if (IN(9)) {
        SchedC S; S.init((const unsigned*)(ws + WS_CTL) + CW_CCNT, (const int*)(ws + WS_CLIST), (const char*)(ws + WS_WDT), G, (int)blockIdx.x, lane);
        EpiDown E{args.out, mod + 5120};
        pg8::gemm_phase_g<EpiDown, SchedC>(lds, (const pg8::bf16_t*)(ws + WS_HID), 512, 256, 8, 4, S, E);
    }
#undef IN
#undef BOTH
#undef GRID_BAR
}

extern "C" void kernel_launch(void* const* d_in, const int* in_sizes, int n_in, void* d_out, int out_size, void* d_ws, size_t ws_size, hipStream_t stream) {
    static int grid = 0;
    if (grid == 0) {
        if (n_in != 23 || in_sizes[0] != TT * DM || out_size != TT * DM || ws_size < WS_END) { fprintf(stderr, "kernel_launch: unexpected shapes: n_in %d in0 %d out %d ws %zu (need %zu)\n", n_in, n_in > 0 ? in_sizes[0] : -1, out_size, ws_size, (size_t)WS_END); grid = -1; return; }
        int dev = 0, cus = 0, per_cu = 0;
        if (hipGetDevice(&dev) != hipSuccess || hipDeviceGetAttribute(&cus, hipDeviceAttributeMultiprocessorCount, dev) != hipSuccess) { grid = -1; return; }
        if (hipFuncSetAttribute((const void*)fwd_kernel, hipFuncAttributeMaxDynamicSharedMemorySize, LDS_BYTES) != hipSuccess) { fprintf(stderr, "kernel_launch: hipFuncSetAttribute failed\n"); grid = -1; return; }
        if (hipOccupancyMaxActiveBlocksPerMultiprocessor(&per_cu, (const void*)fwd_kernel, NTHR, LDS_BYTES) != hipSuccess || per_cu < 1) fprintf(stderr, "kernel_launch: occupancy query reports %d\n", per_cu);
        (void)hipGetLastError();
        grid = cus;
    }
    if (grid < 0) return;
    if (hipMemsetAsync((char*)d_ws + WS_CTL, 0, CTL_ZERO_BYTES, stream) != hipSuccess) { fprintf(stderr, "kernel_launch: memset failed\n"); return; }
    Args a{};
    for (int i = 0; i < 23; ++i) a.in[i] = d_in[i];
    a.out = (float*)d_out; a.ws = (unsigned char*)d_ws;
#if MK_ONE_LAUNCH
    a.ph_lo = 0; a.ph_hi = N_PHASES;
    hipLaunchKernelGGL(fwd_kernel, dim3(grid), dim3(NTHR), LDS_BYTES, stream, a);
#else
    for (int p = 0; p < N_PHASES; ++p) { a.ph_lo = p; a.ph_hi = p + 1; hipLaunchKernelGGL(fwd_kernel, dim3(grid), dim3(NTHR), LDS_BYTES, stream, a); }
#endif
}
```

```cpp
#include <hip/hip_runtime.h>
#include <cstdio>
#include <cstdint>
namespace pg8 {
#define PG8_LAS __attribute__((address_space(3)))
typedef unsigned short bf16_t;
typedef short bf16x8 __attribute__((ext_vector_type(8)));
typedef float f32x4 __attribute__((ext_vector_type(4)));
typedef unsigned u32x4 __attribute__((ext_vector_type(4)));
constexpr int BM = 256, BK = 64, HALF = 128, HTB = HALF * BK * 2  , STAGE_BYTES = 8 * HTB, NXCD = 8, WGM = 8;

__host__ __device__ __forceinline__ int lds_byte(int r, int c) { const int st = (r >> 4) * 2 + (c >> 5), rr = r & 15, cc = c & 31, ob = rr * 64 + cc * 2; return st * 1024 + (ob ^ (((ob >> 9) & 1) << 5)); }
__host__ __device__ __forceinline__ void stage_rc(int b, int& R, int& C) { const int st = b / 1024, sb = b % 1024, swz = sb ^ (((sb >> 9) & 1) << 5); R = (st >> 1) * 16 + swz / 64; C = (st & 1) * 32 + (swz % 64) / 2; }
__host__ __device__ __forceinline__ int perm32(int rho) { const int n = rho >> 4, i = rho & 15; return 8 * (i >> 2) + 4 * n + (i & 3); }

struct Unit { int pm, pn; };
struct Gemm { const bf16_t* A; const bf16_t* Bt; int M, N, K; };

struct StaticOrder {
    int nM, nN, nwg, G, c;
    __host__ __device__ void init(int M, int N, int G_, int c_) { nM = M / BM; nN = N / BM; nwg = nM * nN; G = G_; c = c_; }
    __host__ __device__ bool next(int i, Unit& u) const {
        const long L = (long)i * G + c; if (L >= nwg) return false;
        int wgid = (int)L; { const int q = nwg / NXCD, r = nwg % NXCD, xcd = wgid % NXCD, off = wgid / NXCD; wgid = (xcd < r ? xcd * (q + 1) : r * (q + 1) + (xcd - r) * q) + off; }
        const int nig = WGM * nN, gid = wgid / nig, fm = gid * WGM, gsz = (nM - fm) < WGM ? (nM - fm) : WGM;
        u.pm = fm + ((wgid % nig) % gsz); u.pn = (wgid % nig) / gsz; return true;
    }
    __device__ __forceinline__ void a_ready(const Unit&) const {}
    __device__ __forceinline__ void done(const Unit&) const {}
};

__device__ __forceinline__ unsigned cvt_pk_bf16(float lo, float hi) { unsigned r; asm volatile("v_cvt_pk_bf16_f32 %0, %1, %2" : "=v"(r) : "v"(lo), "v"(hi)); return r; }

struct EpiProj {
    static constexpr bool PERM = true, AFTER_DRAIN = false;
    bf16_t* P; float* AB; int ldp;
    __device__ __forceinline__ void operator()(const f32x4 (&acc)[2][2][4][2], const Unit& u, int wr, int wc, int fr, int fq) const {
        const int row0 = u.pm * BM + wr * 64 + fr;
        if (u.pn < 11) {
            const int col0 = u.pn * BM + wc * 32 + 8 * fq;
#pragma unroll
            for (int ai = 0; ai < 2; ++ai)
#pragma unroll
                for (int m = 0; m < 4; ++m) { bf16_t* rowp = P + (size_t)(row0 + ai * HALF + m * 16) * ldp + col0;
#pragma unroll
                    for (int bj = 0; bj < 2; ++bj) { const f32x4 v0 = acc[ai][bj][m][0], v1 = acc[ai][bj][m][1];
                        u32x4 w; w.x = cvt_pk_bf16(v0[0], v0[1]); w.y = cvt_pk_bf16(v0[2], v0[3]); w.z = cvt_pk_bf16(v1[0], v1[1]); w.w = cvt_pk_bf16(v1[2], v1[3]);
                        *(u32x4*)(rowp + bj * HALF) = w; } }
        } else if (wc == 0 && fq < 2) {
#pragma unroll
            for (int ai = 0; ai < 2; ++ai)
#pragma unroll
                for (int m = 0; m < 4; ++m) { float* rowp = AB + (size_t)(row0 + ai * HALF + m * 16) * 16 + 8 * fq;
                    *(f32x4*)(rowp) = acc[ai][0][m][0]; *(f32x4*)(rowp + 4) = acc[ai][0][m][1]; }
        }
    }
};
struct EpiOut {
    static constexpr bool PERM = false, AFTER_DRAIN = false;
    const float* X; float* O; const float* gate; int rows_per_batch, ldg;
    __device__ __forceinline__ void operator()(const f32x4 (&acc)[2][2][4][2], const Unit& u, int wr, int wc, int fr, int fq) const {
        const int row0 = u.pm * BM + wr * 64 + fr, col0 = u.pn * BM + wc * 32 + 4 * fq;
        const float* gb = gate + (size_t)((u.pm * BM) / rows_per_batch) * ldg + col0;
        f32x4 gv[2][2];
#pragma unroll
        for (int bj = 0; bj < 2; ++bj)
#pragma unroll
            for (int n = 0; n < 2; ++n) gv[bj][n] = *(const f32x4*)(gb + bj * HALF + n * 16);
#pragma unroll
        for (int ai = 0; ai < 2; ++ai)
#pragma unroll
            for (int m = 0; m < 4; ++m) { const size_t ro = (size_t)(row0 + ai * HALF + m * 16) * 1024 + col0;
#pragma unroll
                for (int bj = 0; bj < 2; ++bj)
#pragma unroll
                    for (int n = 0; n < 2; ++n) { const f32x4 xv = *(const f32x4*)(X + ro + bj * HALF + n * 16);
                        *(f32x4*)(O + ro + bj * HALF + n * 16) = xv + gv[bj][n] * acc[ai][bj][m][n]; } }
    }
};

struct UnitG { int id, tile, pn, nrows; };
template <class Epi, class Sched>
__device__ __forceinline__ void gemm_phase_g(PG8_LAS unsigned char* lds, const bf16_t* Abase, const int KA, const int KB, const int nt, const int ksplit, const Sched& S, const Epi& E) {
    const int tid = threadIdx.x, wid = __builtin_amdgcn_readfirstlane(tid >> 6), lane = tid & 63, wr = wid >> 2, wc = wid & 3, fr = lane & 15, fq = lane >> 4;
    int Rr[2]; unsigned cB2[2], voffB[2];
#pragma unroll
    for (int i = 0; i < 2; ++i) { int R, C; stage_rc(tid * 16 + i * 8192, R, C); const int Rb = Epi::PERM ? ((R & ~31) + perm32(R & 31)) : R;
        Rr[i] = R; cB2[i] = (unsigned)C * 2u; voffB[i] = (unsigned)(Rb * KB + C) * 2u; }
    const size_t kstep = (size_t)(BK * 2);
    const size_t hstepB = (size_t)HALF * KB * 2;
    const unsigned ldsw = (unsigned)wid * 1024u;
    const int aoff = lds_byte(wr * 64 + fr, fq * 8), boff = lds_byte(wc * 32 + fr, fq * 8);
#define PG8_SA(b, h) (((b) * 2 + (h)) * HTB)
#define PG8_SB(b, h) ((4 + (b) * 2 + (h)) * HTB)
#define PG8_STAGE2(bufoff, gbase, v0, v1) do { \
        __builtin_amdgcn_global_load_lds((const unsigned*)((const char*)(gbase) + (v0)), (PG8_LAS unsigned*)(lds + (bufoff) + ldsw), 16, 0, 0); \
        __builtin_amdgcn_global_load_lds((const unsigned*)((const char*)(gbase) + (v1)), (PG8_LAS unsigned*)(lds + (bufoff) + ldsw + 8192), 16, 0, 0); } while (0)
#define PG8_LDA(dst, b, h) do { _Pragma("unroll") for (int m = 0; m < 4; ++m) _Pragma("unroll") for (int k = 0; k < 2; ++k) dst[m][k] = *(const PG8_LAS bf16x8*)(lds + PG8_SA(b, h) + aoff + m * 2048 + k * 1024); } while (0)
#define PG8_LDB(dst, b, h) do { _Pragma("unroll") for (int n = 0; n < 2; ++n) _Pragma("unroll") for (int k = 0; k < 2; ++k) dst[n][k] = *(const PG8_LAS bf16x8*)(lds + PG8_SB(b, h) + boff + n * 2048 + k * 1024); } while (0)
#define PG8_MMA(ai, bj, At, Bt) do { __builtin_amdgcn_s_setprio(1); _Pragma("unroll") for (int m = 0; m < 4; ++m) _Pragma("unroll") for (int n = 0; n < 2; ++n) _Pragma("unroll") for (int k = 0; k < 2; ++k) \
        acc[ai][bj][m][n] = __builtin_amdgcn_mfma_f32_16x16x32_bf16(Bt[n][k], At[m][k], acc[ai][bj][m][n], 0, 0, 0); __builtin_amdgcn_s_setprio(0); } while (0)
#define PG8_WAIT_V(n) asm volatile("s_waitcnt vmcnt(" #n ")" ::: "memory")
#define PG8_WAIT_L(n) asm volatile("s_waitcnt lgkmcnt(" #n ")" ::: "memory")
#define PG8_BAR __builtin_amdgcn_s_barrier()
#define PG8_SCHED __builtin_amdgcn_sched_barrier(0)
#define PG8_AOFFS(u, o00, o01, o10, o11) do { const unsigned _ks = (unsigned)KA * 2u; \
        o00 = (unsigned)S.tok(u, Rr[0]) * _ks + cB2[0]; o01 = (unsigned)S.tok(u, Rr[1]) * _ks + cB2[1]; \
        o10 = (unsigned)S.tok(u, HALF + Rr[0]) * _ks + cB2[0]; o11 = (unsigned)S.tok(u, HALF + Rr[1]) * _ks + cB2[1]; } while (0)
#define PG8_BT(u, t) (((t) < ksplit) ? S.bseg(u, 0) + (size_t)(t) * kstep : S.bseg(u, 1) + (size_t)((t) - ksplit) * kstep)
    UnitG cur, nxt; int ui = 0;
    if (!S.next(0, cur)) return;
    f32x4 acc[2][2][4][2];
#pragma unroll
    for (int a = 0; a < 2; ++a)
#pragma unroll
        for (int b = 0; b < 2; ++b)
#pragma unroll
            for (int m = 0; m < 4; ++m)
#pragma unroll
                for (int n = 0; n < 2; ++n) acc[a][b][m][n] = (f32x4){0.f, 0.f, 0.f, 0.f};
    bf16x8 At[4][2], B0[2][2], B1[2][2];
    unsigned c00, c01, c10, c11, n00 = 0, n01 = 0, n10 = 0, n11 = 0;
    PG8_AOFFS(cur, c00, c01, c10, c11);
    const char* const Ab = (const char*)Abase;
    {   const char* b0p = PG8_BT(cur, 0); const char* b1p = PG8_BT(cur, 1);
        PG8_STAGE2(PG8_SB(0, 0), b0p, voffB[0], voffB[1]); PG8_STAGE2(PG8_SB(0, 1), b0p + hstepB, voffB[0], voffB[1]); PG8_STAGE2(PG8_SA(0, 0), Ab, c00, c01); PG8_STAGE2(PG8_SA(0, 1), Ab, c10, c11);
        if (wr == 1) PG8_BAR;
        PG8_WAIT_V(2); PG8_BAR;
        PG8_STAGE2(PG8_SB(1, 0), b1p, voffB[0], voffB[1]); PG8_STAGE2(PG8_SA(1, 0), Ab + kstep, c00, c01); PG8_STAGE2(PG8_SB(1, 1), b1p + hstepB, voffB[0], voffB[1]);
        PG8_WAIT_V(6); PG8_BAR;
    }
    for (;;) {
        const bool has_next = S.next(ui + 1, nxt);
        for (int t = 0; t < nt; t += 2) {
            const bool last = (t == nt - 2);
            if (last && has_next) PG8_AOFFS(nxt, n00, n01, n10, n11);
            const bool usen = last && has_next;
            const int t2 = last ? 0 : t + 2, t3 = t2 + 1;
            const char* a1 = Ab + (size_t)(t + 1) * kstep;
            const char* a2 = Ab + (size_t)t2 * kstep; const char* a3 = Ab + (size_t)t3 * kstep;
            const char* b2 = usen ? PG8_BT(nxt, t2) : PG8_BT(cur, t2); const char* b3 = usen ? PG8_BT(nxt, t3) : PG8_BT(cur, t3);
            const unsigned o00 = usen ? n00 : c00, o01 = usen ? n01 : c01, o10 = usen ? n10 : c10, o11 = usen ? n11 : c11;
            PG8_LDB(B0, 0, 0); PG8_LDB(B1, 0, 1); PG8_SCHED; PG8_LDA(At, 0, 0); PG8_STAGE2(PG8_SA(1, 1), a1, c10, c11);
            PG8_WAIT_V(8); PG8_WAIT_L(0); PG8_BAR; PG8_MMA(0, 0, At, B0); PG8_MMA(0, 1, At, B1); PG8_BAR; PG8_SCHED;
            PG8_LDA(At, 0, 1); PG8_STAGE2(PG8_SB(0, 0), b2, voffB[0], voffB[1]); PG8_STAGE2(PG8_SB(0, 1), b2 + hstepB, voffB[0], voffB[1]); PG8_STAGE2(PG8_SA(0, 0), a2, o00, o01);
            PG8_WAIT_V(8); PG8_WAIT_L(0); PG8_BAR; PG8_MMA(1, 0, At, B0); PG8_MMA(1, 1, At, B1); PG8_BAR; PG8_SCHED;
            PG8_LDB(B0, 1, 0); PG8_LDB(B1, 1, 1); PG8_SCHED; PG8_LDA(At, 1, 0); PG8_STAGE2(PG8_SA(0, 1), a2, o10, o11);
            PG8_WAIT_V(8); PG8_WAIT_L(0); PG8_BAR; PG8_MMA(0, 0, At, B0); PG8_MMA(0, 1, At, B1); PG8_BAR; PG8_SCHED;
            PG8_LDA(At, 1, 1); PG8_STAGE2(PG8_SB(1, 0), b3, voffB[0], voffB[1]); PG8_STAGE2(PG8_SB(1, 1), b3 + hstepB, voffB[0], voffB[1]); PG8_STAGE2(PG8_SA(1, 0), a3, o00, o01);
            PG8_WAIT_V(8); PG8_WAIT_L(0); PG8_BAR; PG8_MMA(1, 0, At, B0); PG8_MMA(1, 1, At, B1); PG8_BAR; PG8_SCHED;
        }
        if (wr == 0) PG8_BAR;
        E(acc, cur, S, wr, wc, fr, fq);
        if (!has_next) break;
#pragma unroll
        for (int a = 0; a < 2; ++a)
#pragma unroll
            for (int b = 0; b < 2; ++b)
#pragma unroll
                for (int m = 0; m < 4; ++m)
#pragma unroll
                    for (int n = 0; n < 2; ++n) acc[a][b][m][n] = (f32x4){0.f, 0.f, 0.f, 0.f};
        cur = nxt; c00 = n00; c01 = n01; c10 = n10; c11 = n11; ++ui;
        if (wr == 1) PG8_BAR;
    }
    PG8_WAIT_V(0);
    PG8_BAR;
#undef PG8_SA
#undef PG8_SB
#undef PG8_STAGE2
#undef PG8_LDA
#undef PG8_LDB
#undef PG8_MMA
#undef PG8_WAIT_V
#undef PG8_WAIT_L
#undef PG8_BAR
#undef PG8_SCHED
#undef PG8_AOFFS
#undef PG8_BT
}
template <class Epi, class Sched, bool ALIGN_EPI = false, bool SP2 = false>
__device__ __forceinline__ void gemm_phase(PG8_LAS unsigned char* lds, const Gemm g, const Sched& S, const Epi& E) {
    const int tid = threadIdx.x, wid = __builtin_amdgcn_readfirstlane(tid >> 6), lane = tid & 63, wr = wid >> 2, wc = wid & 3, fr = lane & 15, fq = lane >> 4;
    const int K = g.K, nt = K / BK;
    unsigned voffA[2], voffB[2];
#pragma unroll
    for (int i = 0; i < 2; ++i) { int R, C; stage_rc(tid * 16 + i * 8192, R, C); const int Rb = Epi::PERM ? ((R & ~31) + perm32(R & 31)) : R;
        voffA[i] = (unsigned)(R * K + C) * 2u; voffB[i] = (unsigned)(Rb * K + C) * 2u; }
    const size_t kstep = (size_t)(BK * 2);
    const size_t hstep = (size_t)HALF * K * 2;
    const size_t tstep = 2 * hstep;
    const unsigned ldsw = (unsigned)wid * 1024u;
    const int aoff = lds_byte(wr * 64 + fr, fq * 8), boff = lds_byte(wc * 32 + fr, fq * 8);
#define PG8_SA(b, h) (((b) * 2 + (h)) * HTB)
#define PG8_SB(b, h) ((4 + (b) * 2 + (h)) * HTB)
#define PG8_STAGE(bufoff, gbase, voff) do { _Pragma("unroll") for (int _i = 0; _i < 2; ++_i) \
        __builtin_amdgcn_global_load_lds((const unsigned*)((const char*)(gbase) + (voff)[_i]), (PG8_LAS unsigned*)(lds + (bufoff) + ldsw + _i * 8192), 16, 0, 0); } while (0)
#define PG8_LDA(dst, b, h) do { _Pragma("unroll") for (int m = 0; m < 4; ++m) _Pragma("unroll") for (int k = 0; k < 2; ++k) dst[m][k] = *(const PG8_LAS bf16x8*)(lds + PG8_SA(b, h) + aoff + m * 2048 + k * 1024); } while (0)
#define PG8_LDB(dst, b, h) do { _Pragma("unroll") for (int n = 0; n < 2; ++n) _Pragma("unroll") for (int k = 0; k < 2; ++k) dst[n][k] = *(const PG8_LAS bf16x8*)(lds + PG8_SB(b, h) + boff + n * 2048 + k * 1024); } while (0)
#define PG8_MMA(ai, bj, At, Bt) do { __builtin_amdgcn_s_setprio(1); _Pragma("unroll") for (int m = 0; m < 4; ++m) _Pragma("unroll") for (int n = 0; n < 2; ++n) _Pragma("unroll") for (int k = 0; k < 2; ++k) \
        acc[ai][bj][m][n] = __builtin_amdgcn_mfma_f32_16x16x32_bf16(Bt[n][k], At[m][k], acc[ai][bj][m][n], 0, 0, 0); __builtin_amdgcn_s_setprio(0); } while (0)
#define PG8_WAIT_V(n) asm volatile("s_waitcnt vmcnt(" #n ")" ::: "memory")
#define PG8_WAIT_L(n) asm volatile("s_waitcnt lgkmcnt(" #n ")" ::: "memory")
#define PG8_BAR __builtin_amdgcn_s_barrier()
#define PG8_SCHED __builtin_amdgcn_sched_barrier(0)
    Unit cur, nxt; int ui = 0;
    if (!S.next(0, cur)) return;
    f32x4 acc[2][2][4][2];
#pragma unroll
    for (int a = 0; a < 2; ++a)
#pragma unroll
        for (int b = 0; b < 2; ++b)
#pragma unroll
            for (int m = 0; m < 4; ++m)
#pragma unroll
                for (int n = 0; n < 2; ++n) acc[a][b][m][n] = (f32x4){0.f, 0.f, 0.f, 0.f};
    bf16x8 At[4][2], B0[2][2], B1[2][2];
    const char* cA = (const char*)g.A + (size_t)cur.pm * tstep; const char* cB = (const char*)g.Bt + (size_t)cur.pn * tstep;
    S.a_ready(cur);
    if constexpr (SP2) {
        PG8_STAGE(PG8_SB(0, 0), cB, voffB); PG8_STAGE(PG8_SB(0, 1), cB + hstep, voffB); PG8_STAGE(PG8_SA(0, 0), cA, voffA); PG8_STAGE(PG8_SA(0, 1), cA + hstep, voffA);
        if (wr == 1) PG8_BAR;
        PG8_WAIT_V(2); PG8_BAR;
        PG8_STAGE(PG8_SB(1, 0), cB + kstep, voffB); PG8_STAGE(PG8_SA(1, 0), cA + kstep, voffA); PG8_STAGE(PG8_SB(1, 1), cB + hstep + kstep, voffB);
        PG8_WAIT_V(6); PG8_BAR;
    } else {
        PG8_STAGE(PG8_SB(0, 0), cB, voffB); PG8_STAGE(PG8_SA(0, 0), cA, voffA); PG8_STAGE(PG8_SB(0, 1), cB + hstep, voffB); PG8_STAGE(PG8_SA(0, 1), cA + hstep, voffA);
        if (wr == 1) PG8_BAR;
        PG8_WAIT_V(4); PG8_BAR;
        PG8_STAGE(PG8_SB(1, 0), cB + kstep, voffB); PG8_STAGE(PG8_SA(1, 0), cA + kstep, voffA); PG8_STAGE(PG8_SB(1, 1), cB + hstep + kstep, voffB);
        PG8_WAIT_V(6); PG8_BAR;
    }
    for (;;) {
        const bool has_next = S.next(ui + 1, nxt);
        const char* nA = has_next ? (const char*)g.A + (size_t)nxt.pm * tstep : cA; const char* nB = has_next ? (const char*)g.Bt + (size_t)nxt.pn * tstep : cB;
        for (int t = 0; t < nt; t += 2) {
            const bool last = (t == nt - 2);
            const char* a1 = cA + (size_t)(t + 1) * kstep;
            const char* a2 = last ? nA : cA + (size_t)(t + 2) * kstep; const char* b2 = last ? nB : cB + (size_t)(t + 2) * kstep;
            const char* a3 = a2 + kstep; const char* b3 = b2 + kstep;
            if (last && has_next) S.a_ready(nxt);
            if constexpr (SP2) {
            PG8_LDB(B0, 0, 0); PG8_LDB(B1, 0, 1); PG8_SCHED; PG8_LDA(At, 0, 0); PG8_STAGE(PG8_SA(1, 1), a1 + hstep, voffA);
            PG8_WAIT_V(8); PG8_WAIT_L(0); PG8_BAR; PG8_MMA(0, 0, At, B0); PG8_MMA(0, 1, At, B1); PG8_BAR; PG8_SCHED;
            PG8_LDA(At, 0, 1); PG8_STAGE(PG8_SB(0, 0), b2, voffB); PG8_STAGE(PG8_SB(0, 1), b2 + hstep, voffB); PG8_STAGE(PG8_SA(0, 0), a2, voffA);
            PG8_WAIT_V(8); PG8_WAIT_L(0); PG8_BAR; PG8_MMA(1, 0, At, B0); PG8_MMA(1, 1, At, B1); PG8_BAR; PG8_SCHED;
            PG8_LDB(B0, 1, 0); PG8_LDB(B1, 1, 1); PG8_SCHED; PG8_LDA(At, 1, 0); PG8_STAGE(PG8_SA(0, 1), a2 + hstep, voffA);
            PG8_WAIT_V(8); PG8_WAIT_L(0); PG8_BAR; PG8_MMA(0, 0, At, B0); PG8_MMA(0, 1, At, B1); PG8_BAR; PG8_SCHED;
            PG8_LDA(At, 1, 1); PG8_STAGE(PG8_SB(1, 0), b3, voffB); PG8_STAGE(PG8_SB(1, 1), b3 + hstep, voffB); PG8_STAGE(PG8_SA(1, 0), a3, voffA);
            PG8_WAIT_V(8); PG8_WAIT_L(0); PG8_BAR; PG8_MMA(1, 0, At, B0); PG8_MMA(1, 1, At, B1); PG8_BAR; PG8_SCHED;
            } else {
            PG8_LDB(B0, 0, 0); PG8_SCHED; PG8_LDA(At, 0, 0); PG8_STAGE(PG8_SA(1, 1), a1 + hstep, voffA);
            PG8_WAIT_L(8); PG8_BAR; PG8_WAIT_L(0); PG8_MMA(0, 0, At, B0); PG8_BAR; PG8_SCHED;
            PG8_LDB(B1, 0, 1); PG8_STAGE(PG8_SB(0, 0), b2, voffB);
            PG8_BAR; PG8_WAIT_L(0); PG8_MMA(0, 1, At, B1); PG8_BAR;
            PG8_LDA(At, 0, 1); PG8_STAGE(PG8_SA(0, 0), a2, voffA);
            PG8_BAR; PG8_WAIT_L(0); PG8_MMA(1, 0, At, B0); PG8_BAR; PG8_SCHED;
            PG8_STAGE(PG8_SB(0, 1), b2 + hstep, voffB);
            PG8_WAIT_V(6); PG8_BAR; PG8_MMA(1, 1, At, B1); PG8_BAR;
            PG8_LDB(B0, 1, 0); PG8_SCHED; PG8_LDA(At, 1, 0); PG8_STAGE(PG8_SA(0, 1), a2 + hstep, voffA);
            PG8_WAIT_L(8); PG8_BAR; PG8_WAIT_L(0); PG8_MMA(0, 0, At, B0); PG8_BAR; PG8_SCHED;
            PG8_LDB(B1, 1, 1); PG8_STAGE(PG8_SB(1, 0), b3, voffB);
            PG8_BAR; PG8_WAIT_L(0); PG8_MMA(0, 1, At, B1); PG8_BAR;
            PG8_LDA(At, 1, 1); PG8_STAGE(PG8_SA(1, 0), a3, voffA);
            PG8_BAR; PG8_WAIT_L(0); PG8_MMA(1, 0, At, B0); PG8_BAR; PG8_SCHED;
            PG8_STAGE(PG8_SB(1, 1), b3 + hstep, voffB);
            PG8_WAIT_V(6); PG8_BAR; PG8_MMA(1, 1, At, B1); PG8_BAR;
            }
        }
        if constexpr (ALIGN_EPI) { if (wr == 0) PG8_BAR; }
        if constexpr (!Epi::AFTER_DRAIN) { E(acc, cur, wr, wc, fr, fq); S.done(cur); }
        if (!has_next) break;
#pragma unroll
        for (int a = 0; a < 2; ++a)
#pragma unroll
            for (int b = 0; b < 2; ++b)
#pragma unroll
                for (int m = 0; m < 4; ++m)
#pragma unroll
                    for (int n = 0; n < 2; ++n) acc[a][b][m][n] = (f32x4){0.f, 0.f, 0.f, 0.f};
        cur = nxt; cA = nA; cB = nB; ++ui;
        if constexpr (ALIGN_EPI) { if (wr == 1) PG8_BAR; }
    }
    PG8_WAIT_V(0);
    if constexpr (!ALIGN_EPI) { if (wr == 0) PG8_BAR; }
    PG8_BAR;
    if constexpr (Epi::AFTER_DRAIN) { E.fused(acc, cur, wr, wc, fr, fq, lds, wid, lane); S.done(cur); }
#undef PG8_SA
#undef PG8_SB
#undef PG8_STAGE
#undef PG8_LDA
#undef PG8_LDB
#undef PG8_MMA
#undef PG8_WAIT_V
#undef PG8_WAIT_L
#undef PG8_BAR
#undef PG8_SCHED
}
}

constexpr int NB = 4, SEQ = 8192, DM = 1024, TT = NB * SEQ;
constexpr int NPROJ = 2816, NPAD = 3072;
constexpr int PC_Q = 0, PC_K = 512, PC_V = 1024, PC_Z = 1536, PC_SQ = 2048, PC_SK = 2560, PC_SV = 2688;
constexpr int NE = 32, NCLS = 112, DE = 256;
constexpr float EPS = 1e-6f;
constexpr int NWAVES = 8, NTHR = 512;
constexpr int N_PHASES = 10;
#ifndef G1_SM
#define G1_SM 31
#endif
#ifndef MK_ONE_LAUNCH
#define MK_ONE_LAUNCH 1
#endif

constexpr size_t MiB = 1u << 20;
constexpr size_t WS_CTL = 0, CTL_ZERO_BYTES = 1 * MiB;
constexpr size_t WS_MOD = 1 * MiB;
constexpr size_t WS_WINT = 2 * MiB, WS_WOUTT = 8 * MiB, WS_WGUT = 10 * MiB, WS_WDT = 42 * MiB;
constexpr size_t WS_H = 58 * MiB;
constexpr size_t WS_PROJ = 122 * MiB;
constexpr size_t WS_AB = 298 * MiB;
constexpr size_t WS_MIX = 300 * MiB;
constexpr size_t WS_QR = 364 * MiB, WS_KR = 396 * MiB;
constexpr size_t WS_EREC = 404 * MiB, WS_CLIST = 412 * MiB;
constexpr size_t WS_HID = WS_PROJ;
constexpr size_t WS_GAP = WS_H, WS_GQP = WS_H + 32 * MiB;
constexpr size_t WS_GOP = 426 * MiB, WS_GBP = 458 * MiB, WS_GGL = 490 * MiB;
constexpr size_t WS_END = 491 * MiB;
constexpr int CW_BAR = 4096, CW_ECNT = 8192, CW_CCNT = 8256;

constexpr int RING_BYTES = 131072, LDSCTL_OFF = RING_BYTES, MISC_OFF = LDSCTL_OFF + 320, LDS_BYTES = 147456;

#define GAS __attribute__((address_space(1)))
#define LAS __attribute__((address_space(3)))
typedef unsigned short bf16;
typedef unsigned v4u __attribute__((ext_vector_type(4)));
typedef float f32x4 __attribute__((ext_vector_type(4)));
typedef GAS unsigned gu32;
#define RLX_AGENT __ATOMIC_RELAXED, __HIP_MEMORY_SCOPE_AGENT
#define LDS_WAIT() asm volatile("s_waitcnt lgkmcnt(0)" ::: "memory")
__device__ __forceinline__ unsigned f2bf(float f) { unsigned u = __builtin_bit_cast(unsigned, f); return (u + 0x7fffu + ((u >> 16) & 1u)) >> 16; }
__device__ __forceinline__ unsigned pk2(float lo, float hi) { return f2bf(lo) | (f2bf(hi) << 16); }
__device__ __forceinline__ float bf2f(bf16 v) { return __builtin_bit_cast(float, (unsigned)v << 16); }
__device__ __forceinline__ float wave_sum(float v) {
#pragma unroll
    for (int o = 1; o < 64; o <<= 1) v += __shfl_xor(v, o);
    return v;
}
__device__ __forceinline__ float siluf(float y) { return y / (1.f + __expf(-y)); }
#define XB_TMO      128
#define XB_XCNT(j)  (256  + 64 * (j))
#define XB_XSUB(j)  (1280 + 64 * (j))
#define XB_XGEN(j)  (2304 + 64 * (j))
#define XB_TOP      3328
#define XB_TOPGEN   3392
#define XCD_BAR_WORDS 3456
#define XB_SPIN_CAP (1u << 18)
__device__ __forceinline__ unsigned xb_ld(unsigned* p)              { return __hip_atomic_load(p, __ATOMIC_RELAXED, __HIP_MEMORY_SCOPE_AGENT); }
__device__ __forceinline__ unsigned xb_add(unsigned* p, unsigned v) { return __hip_atomic_fetch_add(p, v, __ATOMIC_RELAXED, __HIP_MEMORY_SCOPE_AGENT); }
__device__ __forceinline__ unsigned xb_xcc_id() { return (unsigned)__builtin_amdgcn_s_getreg((3 << 11) | 20) & 0xFu; }
#define XB_SPIN(cond, bar) do { unsigned _sp = 0; while (cond) { __builtin_amdgcn_s_sleep(1); \
    if ((++_sp & 255u) == 0u) { if (xb_ld(&(bar)[XB_TMO])) break; if (_sp > XB_SPIN_CAP) { atomicAdd(&(bar)[XB_TMO], 1u); break; } } } } while (0)

struct XcdBarrier {
    unsigned* bar; unsigned x;
    volatile LAS unsigned* st;
};

__device__ __forceinline__ XcdBarrier xcd_barrier_post(unsigned* bar, volatile LAS unsigned* st) {
    XcdBarrier b; b.bar = bar; b.x = xb_xcc_id(); b.st = st;
    if (threadIdx.x == 0) (void)xb_add(&bar[XB_XCNT(b.x)], 1u);
    return b;
}
__device__ __forceinline__ void xcd_barrier_complete(unsigned* bar, unsigned x, unsigned& nloc, unsigned& nx) {
    const unsigned G = gridDim.x * gridDim.y * gridDim.z;
    unsigned sum, cnt, mine, sp = 0u;
    for (;;) {
        sum = 0u; cnt = 0u; mine = 0u;
#pragma unroll
        for (unsigned j = 0; j < 16; ++j) { const unsigned c = xb_ld(&bar[XB_XCNT(j)]); sum += c; cnt += (c > 0u) ? 1u : 0u; mine = (j == x) ? c : mine; }
        if (sum == G) break;
        __builtin_amdgcn_s_sleep(1);
        if ((++sp & 255u) == 0u) { if (xb_ld(&bar[XB_TMO])) break; if (sp > XB_SPIN_CAP) { atomicAdd(&bar[XB_TMO], 1u); break; } }
    }
    nloc = mine > 0u ? mine : 1u; nx = cnt > 0u ? cnt : 1u;
}

__device__ __forceinline__ void xcd_barrier(const XcdBarrier& b) {
    asm volatile("s_waitcnt vmcnt(0)" ::: "memory");
    __syncthreads();
    if (threadIdx.x == 0) {
        unsigned* bar = b.bar;
        __builtin_amdgcn_s_waitcnt(0);
        unsigned nloc = b.st[0], nx = b.st[1];
        if (nloc == 0u) { xcd_barrier_complete(bar, b.x, nloc, nx); b.st[0] = nloc; b.st[1] = nx; }
        const unsigned old = xb_add(&bar[XB_XSUB(b.x)], 1u);
        const unsigned gen = old / nloc;
        if (old + 1u == (gen + 1u) * nloc) {
            __builtin_amdgcn_fence(__ATOMIC_RELEASE, "agent");
            asm volatile("s_waitcnt vmcnt(0)" ::: "memory");
            const unsigned og = xb_add(&bar[XB_TOP], 1u);
            const unsigned tg = og / nx;
            if (og + 1u == (tg + 1u) * nx) xb_add(&bar[XB_TOPGEN], 1u);
            else XB_SPIN(xb_ld(&bar[XB_TOPGEN]) == tg, bar);
            __builtin_amdgcn_fence(__ATOMIC_ACQUIRE, "agent");
            xb_add(&bar[XB_XGEN(b.x)], 1u);
            asm volatile("s_waitcnt vmcnt(0)" ::: "memory");
        } else {
            XB_SPIN(xb_ld(&bar[XB_XGEN(b.x)]) == gen, bar);
            __builtin_amdgcn_fence(__ATOMIC_ACQUIRE, "agent");
            asm volatile("s_waitcnt vmcnt(0)" ::: "memory");
        }
    }
    __syncthreads();
}

struct Args { const void* in[23]; float* out; unsigned char* ws; int ph_lo, ph_hi; };
enum { I_X = 0, I_C, I_POS, I_WADA, I_BADA, I_NORM_MIX, I_WIN, I_CONVW, I_ALOG, I_DTB, I_GNORM, I_QNORM, I_KNORM, I_SINKS, I_WOUT, I_NORM_FFN, I_WGRP, I_BGRP, I_WRT, I_BRT, I_WGATE, I_WUP, I_WDOWN };

template <class CM>
__device__ __forceinline__ void transpose_item(const float* W, int ldw, int k0, bf16* WT, int ldt, int n0, CM cm, LAS float* scr, int lane) {
    const int sc = cm(n0 + (lane & 31));
#pragma unroll 8
    for (int i = 0; i < 32; ++i) { const int kk = 2 * i + (lane >> 5); scr[kk * 33 + (lane & 31)] = sc >= 0 ? W[(size_t)(k0 + kk) * ldw + sc] : 0.f; }
    LDS_WAIT(); asm volatile("" ::: "memory");
    const int c = lane & 7;
#pragma unroll
    for (int j = 0; j < 4; ++j) { const int n = (lane >> 3) + 8 * j; const LAS float* s = scr + (8 * c) * 33 + n;
        v4u o; o.x = pk2(s[0 * 33], s[1 * 33]); o.y = pk2(s[2 * 33], s[3 * 33]); o.z = pk2(s[4 * 33], s[5 * 33]); o.w = pk2(s[6 * 33], s[7 * 33]);
        *(v4u*)(WT + (size_t)(n0 + n) * ldt + k0 + 8 * c) = o; }
    LDS_WAIT(); asm volatile("" ::: "memory");
}
struct CmIn { __device__ __forceinline__ int operator()(int n) const { return n < 2048 ? n : (n < 2816 ? n + 16 : (n < 2832 ? 2048 + (n - 2816) : -1)); } };
struct CmOff { int off; __device__ __forceinline__ int operator()(int n) const { return n + off; } };
struct CmId { __device__ __forceinline__ int operator()(int n) const { return n; } };

__device__ __forceinline__ void p0_prologue(const Args& A, LAS unsigned char* lds, int tid, int lane, int wave) {
    unsigned char* ws = A.ws;
    LAS float* scr = (LAS float*)(lds + wave * 8448);
    const int G = gridDim.x, gw = blockIdx.x * NWAVES + wave, NGW = G * NWAVES;
    constexpr int IT_IN = (NPAD / 32) * (DM / 64), IT_OUT = (DM / 32) * (DM / 64);
    for (int it = gw; it < IT_IN + IT_OUT; it += NGW) {
        if (it < IT_IN) { const int nb = it % (NPAD / 32), kb = it / (NPAD / 32); transpose_item((const float*)A.in[I_WIN], 2832, kb * 64, (bf16*)(ws + WS_WINT), DM, nb * 32, CmIn(), scr, lane); }
        else { const int r = it - IT_IN, nb = r % (DM / 32), kb = r / (DM / 32); transpose_item((const float*)A.in[I_WOUT], DM, kb * 64, (bf16*)(ws + WS_WOUTT), DM, nb * 32, CmId(), scr, lane); }
    }
    {   constexpr int IT_GU = NE * 16 * 16, IT_D = NE * 32 * 4;
        const float* wgate = (const float*)A.in[I_WGATE]; const float* wup = (const float*)A.in[I_WUP]; const float* wdown = (const float*)A.in[I_WDOWN];
        for (int it = gw; it < IT_GU + IT_D; it += NGW) {
            if (it < IT_GU) { const int e = it >> 8, r = it & 255, nb = r & 15, kb = r >> 4, j = nb >> 3, q = nb & 7;
                const float* W = (q < 4 ? wgate : wup) + (size_t)e * 1024 * 256; const int col0 = j * 128 + (q & 3) * 32;
                transpose_item(W, 256, kb * 64, (bf16*)(ws + WS_WGUT) + (size_t)e * 512 * 1024, 1024, nb * 32, CmOff{col0 - nb * 32}, scr, lane); }
            else { const int r2 = it - IT_GU, e = r2 >> 7, r = r2 & 127, nb = r & 31, kb = r >> 5;
                transpose_item(wdown + (size_t)e * 256 * 1024, 1024, kb * 64, (bf16*)(ws + WS_WDT) + (size_t)e * 1024 * 256, 256, nb * 32, CmId(), scr, lane); }
        }
    }
    LAS float* cact = (LAS float*)(lds + 69632);
    LAS float* red = (LAS float*)(lds + 69632 + 16384);
    const float* c = (const float*)A.in[I_C]; const float* wada = (const float*)A.in[I_WADA]; const float* bada = (const float*)A.in[I_BADA];
    float* mod = (float*)(ws + WS_MOD);
    if ((int)blockIdx.x < 96) {
        __syncthreads();
        for (int i = tid; i < 4096; i += NTHR) cact[i] = siluf(c[i]);
        __syncthreads();
        for (int u = blockIdx.x; u < 96; u += G) {
            const int n = u * 64 + lane; float a0 = 0.f, a1 = 0.f, a2 = 0.f, a3 = 0.f;
            for (int k = wave * 128; k < wave * 128 + 128; ++k) { const float w = wada[(size_t)k * 6144 + n]; a0 += cact[k] * w; a1 += cact[1024 + k] * w; a2 += cact[2048 + k] * w; a3 += cact[3072 + k] * w; }
            red[(wave * 4 + 0) * 64 + lane] = a0; red[(wave * 4 + 1) * 64 + lane] = a1; red[(wave * 4 + 2) * 64 + lane] = a2; red[(wave * 4 + 3) * 64 + lane] = a3;
            __syncthreads();
            if (tid < 256) { const int b = tid >> 6, l = tid & 63; float s = bada[u * 64 + l];
#pragma unroll
                for (int w = 0; w < 8; ++w) s += red[(w * 4 + b) * 64 + l];
                mod[b * 6144 + u * 64 + l] = s; }
            __syncthreads();
        }
    }
}

template <bool ROUTE>
__device__ __forceinline__ void norm_rows(const Args& A, const float* X, const float* gain, const float* shift, const float* scale, bf16* H, LAS unsigned char* lds, int lane, int wave) {
    LAS float* hl = (LAS float*)(lds + wave * 4096);
    const int G = gridDim.x, gw = blockIdx.x * NWAVES + wave, NGW = G * NWAVES;
    unsigned char* ws = A.ws;
    for (int r0 = gw * 16; r0 < TT; r0 += NGW * 16) {
        const int b = r0 / SEQ;
        f32x4 mf[4], af[4];
#pragma unroll
        for (int j = 0; j < 4; ++j) { const int col = 4 * lane + 256 * j; const f32x4 g = *(const f32x4*)(gain + col), sc = *(const f32x4*)(scale + b * 6144 + col);
            mf[j] = g * (sc + 1.0f); af[j] = *(const f32x4*)(shift + b * 6144 + col); }
        for (int i = 0; i < 16; ++i) {
            const int row = r0 + i;
            const f32x4* xr = (const f32x4*)(X + (size_t)row * DM) + lane;
            f32x4 v[4]; float s = 0.f;
#pragma unroll
            for (int j = 0; j < 4; ++j) { v[j] = xr[64 * j]; s += (v[j].x * v[j].x + v[j].y * v[j].y) + (v[j].z * v[j].z + v[j].w * v[j].w); }
            const float rstd = 1.f / sqrtf(wave_sum(s) * (1.f / DM) + EPS);
            unsigned long long* o8 = (unsigned long long*)(H + (size_t)row * DM) + lane;
#pragma unroll
            for (int j = 0; j < 4; ++j) { v[j] = v[j] * rstd * mf[j] + af[j];
                o8[64 * j] = (unsigned long long)pk2(v[j].x, v[j].y) | ((unsigned long long)pk2(v[j].z, v[j].w) << 32); }
            if constexpr (ROUTE) {
                const float* wg = (const float*)A.in[I_WGRP]; const float* wr = (const float*)A.in[I_WRT];
                float lg[36];
#pragma unroll
                for (int o = 0; o < 36; ++o) lg[o] = 0.f;
#pragma unroll
                for (int j = 0; j < 4; ++j) *(LAS f32x4*)(hl + 4 * lane + 256 * j) = v[j];
                LDS_WAIT(); asm volatile("" ::: "memory");
#pragma unroll 1
                for (int ii = 0; ii < 16; ++ii) { const int k = lane + 64 * ii; const float hv = hl[k];
                    const f32x4 g4 = *(const f32x4*)(wg + k * 4);
                    lg[0] += hv * g4.x; lg[1] += hv * g4.y; lg[2] += hv * g4.z; lg[3] += hv * g4.w;
#pragma unroll
                    for (int q = 0; q < 8; ++q) { const f32x4 r4 = *(const f32x4*)(wr + k * 32 + q * 4);
                        lg[4 + q * 4 + 0] += hv * r4.x; lg[4 + q * 4 + 1] += hv * r4.y; lg[4 + q * 4 + 2] += hv * r4.z; lg[4 + q * 4 + 3] += hv * r4.w; } }
                LDS_WAIT(); asm volatile("" ::: "memory");
#pragma unroll
                for (int o = 0; o < 36; ++o) lg[o] = wave_sum(lg[o]);
                const float* bg = (const float*)A.in[I_BGRP]; const float* br = (const float*)A.in[I_BRT];
#pragma unroll
                for (int o = 0; o < 4; ++o) lg[o] += bg[o];
#pragma unroll
                for (int o = 0; o < 32; ++o) lg[4 + o] += br[o];
                int gi = 0; float gm = lg[0];
#pragma unroll
                for (int o = 1; o < 4; ++o) if (lg[o] > gm) { gm = lg[o]; gi = o; }
                float gs = 0.f;
#pragma unroll
                for (int o = 0; o < 4; ++o) gs += __expf(lg[o] - gm);
                const float pg = 1.f / gs;
                float le[8];
#pragma unroll
                for (int j = 0; j < 8; ++j) { le[j] = lg[4 + j];
#pragma unroll
                    for (int g = 1; g < 4; ++g) le[j] = (gi == g) ? lg[4 + g * 8 + j] : le[j]; }
                int j1 = 0; float m1 = le[0];
#pragma unroll
                for (int j = 1; j < 8; ++j) if (le[j] > m1) { m1 = le[j]; j1 = j; }
                int j2 = -1; float m2 = -3.0e38f;
#pragma unroll
                for (int j = 0; j < 8; ++j) if (j != j1 && le[j] > m2) { m2 = le[j]; j2 = j; }
                const float ex = __expf(m2 - m1), w1 = pg / (1.f + ex), w2 = pg * ex / (1.f + ex);
                if (lane == 0) {
                    const int e1 = gi * 8 + j1, e2 = gi * 8 + j2;
                    unsigned* ctl = (unsigned*)(ws + WS_CTL);
                    int2* erec = (int2*)(ws + WS_EREC); int* clist = (int*)(ws + WS_CLIST);
                    const unsigned p1 = atomicAdd(ctl + CW_ECNT + e1, 1u); erec[(size_t)e1 * TT + p1] = make_int2(row * 2 + (e1 > e2 ? 1 : 0), __builtin_bit_cast(int, w1));
                    const unsigned p2 = atomicAdd(ctl + CW_ECNT + e2, 1u); erec[(size_t)e2 * TT + p2] = make_int2(row * 2 + (e2 > e1 ? 1 : 0), __builtin_bit_cast(int, w2));
                    const int a = j1 < j2 ? j1 : j2, bb = j1 < j2 ? j2 : j1;
                    const int cls = gi * 28 + (a * 7 - (a * (a - 1)) / 2 + (bb - a - 1));
                    const unsigned pc = atomicAdd(ctl + CW_CCNT + cls, 1u); clist[(size_t)cls * TT + pc] = row;
                }
            }
        }
    }
}

__device__ __forceinline__ void swa_prep(const Args& A, int lane, int wave) {
    unsigned char* ws = A.ws;
    const int G = gridDim.x, gw = blockIdx.x * NWAVES + wave, NGW = G * NWAVES;
    const bf16* proj = (const bf16*)(ws + WS_PROJ); bf16* qr = (bf16*)(ws + WS_QR); bf16* kr = (bf16*)(ws + WS_KR);
    const int* pos = (const int*)A.in[I_POS];
    const float qg = ((const float*)A.in[I_QNORM])[lane], kg = ((const float*)A.in[I_KNORM])[lane];
    const float inv = powf(10000.f, -(float)(lane & 31) / 32.f);
    for (int t = gw; t < TT; t += NGW) {
        const float ang = (float)pos[t] * inv; float sn, cs; sincosf(ang, &sn, &cs);
        for (int hd = 0; hd < 10; ++hd) {
            const int col = hd < 8 ? PC_SQ + hd * 64 : PC_SK + (hd - 8) * 64;
            const float x = bf2f(proj[(size_t)t * NPROJ + col + lane]);
            const float ss = wave_sum(x * x);
            const float xn = x * (1.f / sqrtf(ss * (1.f / 64.f) + EPS)) * (hd < 8 ? qg : kg);
            const float pr = __shfl_xor(xn, 32);
            const float o = lane < 32 ? xn * cs - pr * sn : pr * sn + xn * cs;
            if (hd < 8) qr[(size_t)t * 512 + hd * 64 + lane] = (bf16)f2bf(o); else kr[(size_t)t * 128 + (hd - 8) * 64 + lane] = (bf16)f2bf(o);
        }
    }
}
__device__ __forceinline__ void swa_naive(const Args& A, int tid, int blk, int nblk) {
    unsigned char* ws = A.ws;
    const bf16* proj = (const bf16*)(ws + WS_PROJ); const bf16* qr = (const bf16*)(ws + WS_QR); const bf16* kr = (const bf16*)(ws + WS_KR);
    bf16* mix = (bf16*)(ws + WS_MIX); const float* sinks = (const float*)A.in[I_SINKS];
    for (int item = blk * NTHR + tid; item < TT * 8; item += nblk * NTHR) {
        const int t = item >> 3, hq = item & 7, kvh = hq >> 2, b = t / SEQ, p = t % SEQ;
        float q[64], acc[64];
#pragma unroll
        for (int d = 0; d < 64; d += 8) { const v4u v = *(const v4u*)(qr + (size_t)t * 512 + hq * 64 + d);
            q[d] = 0.125f * __builtin_bit_cast(float, v.x << 16); q[d + 1] = 0.125f * __builtin_bit_cast(float, v.x & 0xffff0000u); q[d + 2] = 0.125f * __builtin_bit_cast(float, v.y << 16); q[d + 3] = 0.125f * __builtin_bit_cast(float, v.y & 0xffff0000u);
            q[d + 4] = 0.125f * __builtin_bit_cast(float, v.z << 16); q[d + 5] = 0.125f * __builtin_bit_cast(float, v.z & 0xffff0000u); q[d + 6] = 0.125f * __builtin_bit_cast(float, v.w << 16); q[d + 7] = 0.125f * __builtin_bit_cast(float, v.w & 0xffff0000u); }
#pragma unroll
        for (int d = 0; d < 64; ++d) acc[d] = 0.f;
        float m = sinks[hq], l = 1.f;
        const int k0 = p - 127 > 0 ? p - 127 : 0;
        for (int kp = k0; kp <= p; ++kp) {
            const size_t tk = (size_t)b * SEQ + kp;
            float s = 0.f;
#pragma unroll
            for (int d = 0; d < 64; d += 8) { const v4u v = *(const v4u*)(kr + tk * 128 + kvh * 64 + d);
                s += q[d] * __builtin_bit_cast(float, v.x << 16) + q[d + 1] * __builtin_bit_cast(float, v.x & 0xffff0000u) + q[d + 2] * __builtin_bit_cast(float, v.y << 16) + q[d + 3] * __builtin_bit_cast(float, v.y & 0xffff0000u)
                   + q[d + 4] * __builtin_bit_cast(float, v.z << 16) + q[d + 5] * __builtin_bit_cast(float, v.z & 0xffff0000u) + q[d + 6] * __builtin_bit_cast(float, v.w << 16) + q[d + 7] * __builtin_bit_cast(float, v.w & 0xffff0000u); }
            if (s > m) { const float sc = __expf(m - s); l *= sc;
#pragma unroll
                for (int d = 0; d < 64; ++d) acc[d] *= sc;
                m = s; }
            const float pe = __expf(s - m); l += pe;
#pragma unroll
            for (int d = 0; d < 64; d += 8) { const v4u raw = *(const v4u*)(proj + tk * NPROJ + PC_SV + kvh * 64 + d);
                acc[d + 0] += pe * __builtin_bit_cast(float, raw.x << 16); acc[d + 1] += pe * __builtin_bit_cast(float, raw.x & 0xffff0000u);
                acc[d + 2] += pe * __builtin_bit_cast(float, raw.y << 16); acc[d + 3] += pe * __builtin_bit_cast(float, raw.y & 0xffff0000u);
                acc[d + 4] += pe * __builtin_bit_cast(float, raw.z << 16); acc[d + 5] += pe * __builtin_bit_cast(float, raw.z & 0xffff0000u);
                acc[d + 6] += pe * __builtin_bit_cast(float, raw.w << 16); acc[d + 7] += pe * __builtin_bit_cast(float, raw.w & 0xffff0000u); }
        }
        const float il = 1.f / l;
#pragma unroll
        for (int d = 0; d < 64; d += 8) { v4u o; o.x = pk2(acc[d] * il, acc[d + 1] * il); o.y = pk2(acc[d + 2] * il, acc[d + 3] * il); o.z = pk2(acc[d + 4] * il, acc[d + 5] * il); o.w = pk2(acc[d + 6] * il, acc[d + 7] * il);
            *(v4u*)(mix + (size_t)t * DM + 512 + hq * 64 + d) = o; }
    }
}

typedef short bf16x8_t __attribute__((ext_vector_type(8)));
typedef float f32x16 __attribute__((ext_vector_type(16)));
typedef unsigned v2u __attribute__((ext_vector_type(2)));
typedef float f32x2_t __attribute__((ext_vector_type(2)));
typedef __bf16 bf16x2_t __attribute__((ext_vector_type(2)));
__device__ __forceinline__ unsigned cvtpk(float lo, float hi) { const f32x2_t f = {lo, hi}; return __builtin_bit_cast(unsigned, __builtin_convertvector(f, bf16x2_t)); }
__device__ __forceinline__ void swa_mfma(const Args& A, LAS unsigned char* lds, int tid, int lane, int wave, int blk, int nblk) {
    unsigned char* ws = A.ws;
    const bf16* proj = (const bf16*)(ws + WS_PROJ); const bf16* qr = (const bf16*)(ws + WS_QR); const bf16* kr = (const bf16*)(ws + WS_KR);
    bf16* mix = (bf16*)(ws + WS_MIX); const float* sinks = (const float*)A.in[I_SINKS];
    constexpr int KST = 144, VST = 520;
    LAS unsigned char* Kl = lds; LAS unsigned char* Vt = lds + 256 * KST;
    const int g = wave >> 1, qh = wave & 1, ql = lane & 31, hh = lane >> 5;
    constexpr float LOG2E = 1.4426950408889634f, CS = 0.125f * LOG2E;
    for (int u = blk; u < NB * 2 * (SEQ / 128); u += nblk) {
        const int n = u & 63, kvh = (u >> 6) & 1, b = u >> 7;
        const int tb = b * SEQ + n * 128;
        __syncthreads();
#pragma unroll
        for (int it = 0; it < 4; ++it) { const int idx = tid + it * NTHR, key = idx >> 3, ch = idx & 7; int tk = tb - 128 + key; if (tk < b * SEQ) tk = b * SEQ;
            const v4u kv = *(const v4u*)(kr + (size_t)tk * 128 + kvh * 64 + ch * 8);
            *(LAS v4u*)(Kl + key * KST + ch * 16) = kv;
            const v4u vv = *(const v4u*)(proj + (size_t)tk * NPROJ + PC_SV + kvh * 64 + ch * 8);
            LAS unsigned short* vp = (LAS unsigned short*)(Vt + (ch * 8) * VST + key * 2);
            vp[0 * (VST / 2)] = (unsigned short)(vv.x & 0xffffu); vp[1 * (VST / 2)] = (unsigned short)(vv.x >> 16);
            vp[2 * (VST / 2)] = (unsigned short)(vv.y & 0xffffu); vp[3 * (VST / 2)] = (unsigned short)(vv.y >> 16);
            vp[4 * (VST / 2)] = (unsigned short)(vv.z & 0xffffu); vp[5 * (VST / 2)] = (unsigned short)(vv.z >> 16);
            vp[6 * (VST / 2)] = (unsigned short)(vv.w & 0xffffu); vp[7 * (VST / 2)] = (unsigned short)(vv.w >> 16); }
        __syncthreads();
        const int hq = kvh * 4 + g; const float sinkl = sinks[hq] * LOG2E;
#pragma unroll 1
        for (int qt = 0; qt < 2; ++qt) {
            const int i0 = qh * 64 + qt * 32, iq = i0 + ql;
            const size_t tq = (size_t)(tb + iq);
            bf16x8_t qf[4];
#pragma unroll
            for (int ks = 0; ks < 4; ++ks) qf[ks] = *(const bf16x8_t*)(qr + tq * 512 + hq * 64 + ks * 16 + hh * 8);
            f32x16 sc[5];
#pragma unroll
            for (int kt = 0; kt < 5; ++kt) { f32x16 acc;
#pragma unroll
                for (int r = 0; r < 16; ++r) acc[r] = 0.f;
#pragma unroll
                for (int ks = 0; ks < 4; ++ks) { const bf16x8_t kf = *(const LAS bf16x8_t*)(Kl + (i0 + 32 * kt + ql) * KST + (ks * 16 + hh * 8) * 2);
                    acc = __builtin_amdgcn_mfma_f32_32x32x16_bf16(kf, qf[ks], acc, 0, 0, 0); }
                sc[kt] = acc; }
            float mloc = -3.0e38f;
#pragma unroll
            for (int kt = 0; kt < 5; ++kt)
#pragma unroll
                for (int r = 0; r < 16; ++r) { const int j = i0 + 32 * kt + (r & 3) + 8 * (r >> 2) + 4 * hh;
                    const bool valid = (j > iq) && (j <= iq + 128) && (n > 0 || j >= 128);
                    const float sv = valid ? sc[kt][r] * CS : -1.0e30f; sc[kt][r] = sv; mloc = fmaxf(mloc, sv); }
            float mx = fmaxf(mloc, __shfl_xor(mloc, 32)); mx = fmaxf(mx, sinkl);
            float lsum = 0.f;
#pragma unroll
            for (int kt = 0; kt < 5; ++kt)
#pragma unroll
                for (int r = 0; r < 16; ++r) { const float p = __builtin_amdgcn_exp2f(sc[kt][r] - mx); sc[kt][r] = p; lsum += p; }
            lsum += __shfl_xor(lsum, 32); lsum += __builtin_amdgcn_exp2f(sinkl - mx);
            f32x16 o0, o1;
#pragma unroll
            for (int r = 0; r < 16; ++r) { o0[r] = 0.f; o1[r] = 0.f; }
#pragma unroll
            for (int kt = 0; kt < 5; ++kt)
#pragma unroll
                for (int s2 = 0; s2 < 2; ++s2) {
                    union { bf16x8_t v; unsigned u[4]; } pf;
#pragma unroll
                    for (int p = 0; p < 4; ++p) pf.u[p] = cvtpk(sc[kt][8 * s2 + 2 * p], sc[kt][8 * s2 + 2 * p + 1]);
                    const int jb = i0 + 32 * kt + 16 * s2 + 4 * hh;
                    union { bf16x8_t v; v2u u[2]; } v0, v1;
                    const LAS unsigned char* r0 = Vt + ql * VST + jb * 2; const LAS unsigned char* r1 = Vt + (32 + ql) * VST + jb * 2;
                    v0.u[0] = *(const LAS v2u*)(r0); v0.u[1] = *(const LAS v2u*)(r0 + 16);
                    v1.u[0] = *(const LAS v2u*)(r1); v1.u[1] = *(const LAS v2u*)(r1 + 16);
                    o0 = __builtin_amdgcn_mfma_f32_32x32x16_bf16(v0.v, pf.v, o0, 0, 0, 0);
                    o1 = __builtin_amdgcn_mfma_f32_32x32x16_bf16(v1.v, pf.v, o1, 0, 0, 0);
                }
            const float il = 1.f / lsum;
            bf16* op = mix + tq * DM + 512 + hq * 64 + 4 * hh;
#pragma unroll
            for (int rq = 0; rq < 4; ++rq) {
                v2u w0; w0.x = cvtpk(o0[4 * rq] * il, o0[4 * rq + 1] * il); w0.y = cvtpk(o0[4 * rq + 2] * il, o0[4 * rq + 3] * il);
                *(v2u*)(op + 8 * rq) = w0;
                v2u w1; w1.x = cvtpk(o1[4 * rq] * il, o1[4 * rq + 1] * il); w1.y = cvtpk(o1[4 * rq + 2] * il, o1[4 * rq + 3] * il);
                *(v2u*)(op + 32 + 8 * rq) = w1; }
        }
    }
}

__device__ __forceinline__ int frag_a_idx(int row, int col) { const int mt = row >> 4, l15 = row & 15, ks = col >> 5, x = col & 31, jh = x >> 4, g4 = (x >> 2) & 3, jl = x & 3; return ((mt * 2 + ks) * 64 + g4 * 16 + l15) * 8 + 4 * jh + jl; }
__device__ __forceinline__ int frag_c_idx(int row, int col) { const int w = col >> 4, l15 = col & 15, mt = row >> 4, y = row & 15, g4 = y >> 2, i = y & 3; return ((w * 64 + g4 * 16 + l15) * 4 + mt) * 4 + i; }
__device__ __forceinline__ void gdn_g1_naive(const Args& A, LAS float* L, int tid) {
    unsigned char* ws = A.ws;
    const bf16* proj = (const bf16*)(ws + WS_PROJ); const float* ab = (const float*)(ws + WS_AB);
    bf16* AP = (bf16*)(ws + WS_GAP); bf16* BP = (bf16*)(ws + WS_GBP); bf16* QP = (bf16*)(ws + WS_GQP); bf16* OP = (bf16*)(ws + WS_GOP); float* GL = (float*)(ws + WS_GGL);
    const float* convw = (const float*)A.in[I_CONVW];
    constexpr int LD = 65, AR = 64 * LD;
    LAS float* q = L; LAS float* k = q + AR; LAS float* v = k + AR; LAS float* Mm = v + AR; LAS float* At = Mm + AR; LAS float* w = At + AR;
    LAS float* Gc = w + AR; LAS float* beta = Gc + 64;
    const int i8 = tid >> 3, e0 = (tid & 7) * 8;
    for (int cid = blockIdx.x; cid < NB * 8 * 128; cid += gridDim.x) {
        const int n = cid & 127, bh = cid >> 7, b = bh >> 3, h = bh & 7;
        const float Ah = expf(((const float*)A.in[I_ALOG])[h]), dtb = ((const float*)A.in[I_DTB])[h];
        const int t0 = b * SEQ + n * 64;
        __syncthreads();
        for (int idx = tid; idx < 3 * 4096; idx += NTHR) {
            const int part = idx >> 12, rem = idx & 4095, i = rem >> 6, d = rem & 63, c = part * 512 + h * 64 + d;
            float y = 0.f;
#pragma unroll
            for (int j = 0; j < 4; ++j) { const int s = n * 64 + i - 3 + j; if (s >= 0) y += convw[j * 1536 + c] * bf2f(proj[(size_t)(b * SEQ + s) * NPROJ + c]); }
            y = y / (1.f + __expf(-y));
            (part == 0 ? q : (part == 1 ? k : v))[i * LD + d] = y;
        }
        if (tid < 64) { const float a = ab[(size_t)(t0 + tid) * 16 + h], bb = ab[(size_t)(t0 + tid) * 16 + 8 + h]; const float xx = a + dtb;
            const float sp = xx > 20.f ? xx : log1pf(expf(xx)); Gc[tid] = -Ah * sp; beta[tid] = 1.f / (1.f + __expf(-bb)); }
        __syncthreads();
        if (tid < 128) { LAS float* arr = tid < 64 ? q : k; const int i = tid & 63; float ss = 0.f;
            for (int d = 0; d < 64; ++d) ss += arr[i * LD + d] * arr[i * LD + d];
            const float r = (1.f / sqrtf(ss + EPS)) * (tid < 64 ? 0.125f : 1.f);
            for (int d = 0; d < 64; ++d) arr[i * LD + d] *= r; }
        if (tid == 128) { float run = 0.f; for (int i = 0; i < 64; ++i) { run += Gc[i]; Gc[i] = run; } }
        __syncthreads();
        {   const int i = i8;
            for (int jj = 0; jj < 8; ++jj) { const int j = e0 + jj; float dq = 0.f, dk = 0.f;
_Pragma("unroll 2") for (int d = 0; d < 64; ++d) { const float kj = k[j * LD + d]; dq += q[i * LD + d] * kj; dk += k[i * LD + d] * kj; }
                const float dec = (i >= j) ? __expf(Gc[i] - Gc[j]) : 0.f;
                At[i * LD + j] = dq * dec; Mm[i * LD + j] = (i > j) ? dk * beta[i] * dec : 0.f; }
        }
        __syncthreads();
        for (int idx = tid; idx < 4096; idx += NTHR) { const int i = idx >> 6, d = idx & 63; v[i * LD + d] *= beta[i]; w[i * LD + d] = k[i * LD + d] * beta[i] * __expf(Gc[i]); }
        __syncthreads();
        if (tid < 128) { LAS float* arr = tid < 64 ? v : w; const int c = tid & 63;
            _Pragma("unroll 1") for (int i = 1; i < 64; ++i) { float a = arr[i * LD + c]; _Pragma("unroll 4") for (int j = 0; j < i; ++j) a -= Mm[i * LD + j] * arr[j * LD + c]; arr[i * LD + c] = a; } }
        __syncthreads();
        const float gl = Gc[63];
        const size_t cb = (size_t)cid * 4096;
        {
            const int d = i8; float a[8], bq[8];
#pragma unroll
            for (int ee = 0; ee < 8; ++ee) { a[ee] = 0.f; bq[ee] = 0.f; }
_Pragma("unroll 2")
            for (int c = 0; c < 64; ++c) { const float kd = k[c * LD + d] * __expf(gl - Gc[c]);
#pragma unroll
                for (int ee = 0; ee < 8; ++ee) { a[ee] -= kd * w[c * LD + e0 + ee]; bq[ee] += kd * v[c * LD + e0 + ee]; } }
#pragma unroll
            for (int ee = 0; ee < 8; ++ee) { const int dp = e0 + ee; AP[cb + frag_a_idx(d, dp)] = (bf16)f2bf(a[ee]); BP[cb + frag_c_idx(d, dp)] = (bf16)f2bf(bq[ee]); }
        }
        {
            const int c = i8; float a[8], bq[8]; const float eg = __expf(Gc[c]);
#pragma unroll
            for (int ee = 0; ee < 8; ++ee) { a[ee] = eg * q[c * LD + e0 + ee]; bq[ee] = 0.f; }
_Pragma("unroll 2")
            for (int s2 = 0; s2 <= c; ++s2) { const float av = At[c * LD + s2];
#pragma unroll
                for (int ee = 0; ee < 8; ++ee) { a[ee] -= av * w[s2 * LD + e0 + ee]; bq[ee] += av * v[s2 * LD + e0 + ee]; } }
#pragma unroll
            for (int ee = 0; ee < 8; ++ee) { const int dp = e0 + ee; QP[cb + frag_a_idx(c, dp)] = (bf16)f2bf(a[ee]); OP[cb + frag_c_idx(c, dp)] = (bf16)f2bf(bq[ee]); }
        }
        if (tid == 0) GL[cid] = __expf(gl);
    }
}
__device__ __forceinline__ float wave_incl_scan_f(float v, int lane) {
#pragma unroll
    for (int o = 1; o < 64; o <<= 1) { const float t = __shfl_up(v, o); if (lane >= o) v += t; }
    return v;
}
__device__ __forceinline__ v2u pack4(f32x4 v) { v2u r; r.x = cvtpk(v.x, v.y); r.y = cvtpk(v.z, v.w); return r; }
__device__ __forceinline__ bf16x8_t mk8(v2u lo, v2u hi) { union { bf16x8_t v; unsigned u[4]; } x; x.u[0] = lo.x; x.u[1] = lo.y; x.u[2] = hi.x; x.u[3] = hi.y; return x.v; }
template <int SM>
__device__ __forceinline__ void gdn_g1_mfma(const Args& A, LAS unsigned char* lds, int tid, int lane, int wave) {
    unsigned char* ws = A.ws;
    const bf16* proj = (const bf16*)(ws + WS_PROJ); const float* ab = (const float*)(ws + WS_AB);
    bf16* AP = (bf16*)(ws + WS_GAP); bf16* BP = (bf16*)(ws + WS_GBP); bf16* QP = (bf16*)(ws + WS_GQP); bf16* OP = (bf16*)(ws + WS_GOP); float* GL = (float*)(ws + WS_GGL);
    const float* convw = (const float*)A.in[I_CONVW];
    constexpr int KST = 144, RST = 68;
    LAS unsigned char* Kr = lds; LAS unsigned char* Qr = lds + 9216; LAS unsigned char* kdT = lds + 18432; LAS unsigned char* Mm = lds + 27648; LAS unsigned char* At = lds + 36864;
    LAS float* Rt = (LAS float*)(lds + 46080);
    LAS float* Md = (LAS float*)(lds + 80896);
    LAS unsigned char* Tl = lds + 86016;
    LAS float* Gs = (LAS float*)(lds + 88064); LAS float* Bs = Gs + 64;
    const int l15 = lane & 15, g4 = lane >> 4;
    const v2u zero2 = {0u, 0u};
    for (int cid = blockIdx.x; cid < NB * 8 * 128; cid += gridDim.x) {
        const int n = cid & 127, bh = cid >> 7, b = bh >> 3, h = bh & 7;
        const int t0 = b * SEQ + n * 64;
        const size_t cb = (size_t)cid * 4096;
        __syncthreads();
        if (wave == 0) {
            const float Ah = __expf(((const float*)A.in[I_ALOG])[h]), dtb = ((const float*)A.in[I_DTB])[h];
            const float a = ab[(size_t)(t0 + lane) * 16 + h], bb = ab[(size_t)(t0 + lane) * 16 + 8 + h]; const float xx = a + dtb;
            const float sp = xx > 20.f ? xx : log1pf(__expf(xx));
            const float G = wave_incl_scan_f(-Ah * sp, lane);
            Gs[lane] = G; Bs[lane] = 1.f / (1.f + __expf(-bb));
            if ((SM & 16) && lane == 63) GL[cid] = __expf(G);
        }
        __syncthreads();
        {
            const int i = tid >> 3, dg = tid & 7, d0 = dg * 8;
            const float Gi = Gs[i], bi = Bs[i], gl = Gs[63];
            const float eG = __expf(Gi), ekd = __expf(gl - Gi);
            float y[3][8];
#pragma unroll
            for (int part = 0; part < 3; ++part) {
                const int ch = part * 512 + h * 64 + d0;
                float acc[8];
#pragma unroll
                for (int e = 0; e < 8; ++e) acc[e] = 0.f;
#pragma unroll
                for (int j = 0; j < 4; ++j) { const int s = n * 64 + i - 3 + j;
                    const f32x4 w0 = *(const f32x4*)(convw + j * 1536 + ch), w1 = *(const f32x4*)(convw + j * 1536 + ch + 4);
                    v4u x = {0u, 0u, 0u, 0u}; if (s >= 0) x = *(const v4u*)(proj + (size_t)(b * SEQ + s) * NPROJ + ch);
                    acc[0] += w0.x * __builtin_bit_cast(float, x.x << 16); acc[1] += w0.y * __builtin_bit_cast(float, x.x & 0xffff0000u);
                    acc[2] += w0.z * __builtin_bit_cast(float, x.y << 16); acc[3] += w0.w * __builtin_bit_cast(float, x.y & 0xffff0000u);
                    acc[4] += w1.x * __builtin_bit_cast(float, x.z << 16); acc[5] += w1.y * __builtin_bit_cast(float, x.z & 0xffff0000u);
                    acc[6] += w1.z * __builtin_bit_cast(float, x.w << 16); acc[7] += w1.w * __builtin_bit_cast(float, x.w & 0xffff0000u); }
#pragma unroll
                for (int e = 0; e < 8; ++e) y[part][e] = siluf(acc[e]);
            }
            float sq = 0.f, sk = 0.f;
#pragma unroll
            for (int e = 0; e < 8; ++e) { sq += y[0][e] * y[0][e]; sk += y[1][e] * y[1][e]; }
            sq += __shfl_xor(sq, 1); sq += __shfl_xor(sq, 2); sq += __shfl_xor(sq, 4);
            sk += __shfl_xor(sk, 1); sk += __shfl_xor(sk, 2); sk += __shfl_xor(sk, 4);
            const float rq = (1.f / sqrtf(sq + EPS)) * 0.125f, rk = 1.f / sqrtf(sk + EPS);
#pragma unroll
            for (int e = 0; e < 8; ++e) { y[0][e] *= rq; y[1][e] *= rk; }
            v4u pq, pk;
            pq.x = cvtpk(y[0][0], y[0][1]); pq.y = cvtpk(y[0][2], y[0][3]); pq.z = cvtpk(y[0][4], y[0][5]); pq.w = cvtpk(y[0][6], y[0][7]);
            pk.x = cvtpk(y[1][0], y[1][1]); pk.y = cvtpk(y[1][2], y[1][3]); pk.z = cvtpk(y[1][4], y[1][5]); pk.w = cvtpk(y[1][6], y[1][7]);
            *(LAS v4u*)(Qr + i * KST + d0 * 2) = pq; *(LAS v4u*)(Kr + i * KST + d0 * 2) = pk;
#pragma unroll
            for (int e = 0; e < 8; ++e) { *(LAS unsigned short*)(kdT + (d0 + e) * KST + i * 2) = (unsigned short)f2bf(y[1][e] * ekd);
                Rt[(d0 + e) * RST + i] = y[1][e] * bi * eG; Rt[(64 + d0 + e) * RST + i] = y[2][e] * bi; }
        }
        __syncthreads();
        {
            const int ct = wave & 3, which = wave >> 2;
            const LAS unsigned char* Xb = which ? Kr : Qr;
            const int c = 16 * ct + l15; const float Gc = Gs[c], bc = Bs[c];
            bf16x8_t bfr[2];
#pragma unroll
            for (int ks = 0; ks < 2; ++ks) bfr[ks] = *(const LAS bf16x8_t*)(Xb + c * KST + (32 * ks + 8 * g4) * 2);
#pragma unroll
            for (int st = 0; st < 4; ++st) {
                f32x4 acc = {0.f, 0.f, 0.f, 0.f};
#pragma unroll
                for (int ks = 0; ks < 2; ++ks) { const bf16x8_t af = *(const LAS bf16x8_t*)(Kr + (16 * st + l15) * KST + (32 * ks + 8 * g4) * 2);
                    acc = __builtin_amdgcn_mfma_f32_16x16x32_bf16(af, bfr[ks], acc, 0, 0, 0); }
                f32x4 vals;
#pragma unroll
                for (int r = 0; r < 4; ++r) { const int s2 = 16 * st + 4 * g4 + r; const float dec = __expf(fminf(Gc - Gs[s2], 0.f));
                    vals[r] = which ? ((s2 < c) ? -acc[r] * bc * dec : 0.f) : ((s2 <= c) ? acc[r] * dec : 0.f); }
                *(LAS v2u*)((which ? Mm : At) + c * KST + (16 * st + 4 * g4) * 2) = pack4(vals);
                if (which && st == ct) *(LAS f32x4*)(Md + (ct * 16 + l15) * 20 + 4 * g4) = -vals;
            }
        }
        __syncthreads();
        if (wave == 0) {
            float t[16];
#pragma unroll
            for (int r = 0; r < 16; ++r) { float acc = (r == l15) ? 1.f : 0.f;
#pragma unroll
                for (int s4 = 0; s4 < r; s4 += 4) { const f32x4 m = *(const LAS f32x4*)(Md + (g4 * 16 + r) * 20 + s4);
                    acc -= m.x * t[s4]; if (s4 + 1 < r) acc -= m.y * t[s4 + 1]; if (s4 + 2 < r) acc -= m.z * t[s4 + 2]; if (s4 + 3 < r) acc -= m.w * t[s4 + 3]; }
                t[r] = acc; }
#pragma unroll
            for (int r = 0; r < 16; ++r) *(LAS unsigned short*)(Tl + ((g4 * 16 + r) * 16 + l15) * 2) = (unsigned short)f2bf(t[r]);
        }
        __syncthreads();
        f32x4 wt[4];
        {   const int colw = 16 * wave + l15;
#pragma unroll
            for (int i = 0; i < 4; ++i) {
                f32x4 acc = *(const LAS f32x4*)(Rt + colw * RST + 16 * i + 4 * g4);
                const LAS unsigned char* mrow = Mm + (16 * i + l15) * KST + (4 * g4) * 2;
                if (i >= 1) { const v2u alo = *(const LAS v2u*)(mrow), ahi = (i >= 2) ? *(const LAS v2u*)(mrow + 32) : zero2;
                    acc = __builtin_amdgcn_mfma_f32_16x16x32_bf16(mk8(alo, ahi), mk8(pack4(wt[0]), (i >= 2) ? pack4(wt[1]) : zero2), acc, 0, 0, 0); }
                if (i == 3) { const v2u alo = *(const LAS v2u*)(mrow + 64);
                    acc = __builtin_amdgcn_mfma_f32_16x16x32_bf16(mk8(alo, zero2), mk8(pack4(wt[2]), zero2), acc, 0, 0, 0); }
                const v2u tlo = *(const LAS v2u*)(Tl + ((i * 16 + l15) * 16 + 4 * g4) * 2);
                wt[i] = __builtin_amdgcn_mfma_f32_16x16x32_bf16(mk8(tlo, zero2), mk8(pack4(acc), zero2), (f32x4){0.f, 0.f, 0.f, 0.f}, 0, 0, 0);
            }
        }
        if (wave < 4) {
            bf16x8_t wn[2];
#pragma unroll
            for (int ks = 0; ks < 2; ++ks) { v2u lo = pack4(wt[2 * ks]), hi = pack4(wt[2 * ks + 1]); lo.x ^= 0x80008000u; lo.y ^= 0x80008000u; hi.x ^= 0x80008000u; hi.y ^= 0x80008000u; wn[ks] = mk8(lo, hi); }
#pragma unroll
            for (int nt = 0; nt < 4; ++nt) { const int x = 16 * nt + l15;
                f32x4 ca = {0.f, 0.f, 0.f, 0.f};
                const v2u qraw = *(const LAS v2u*)(Qr + x * KST + (16 * wave + 4 * g4) * 2); const float eg = __expf(Gs[x]);
                f32x4 cq; cq.x = eg * __builtin_bit_cast(float, qraw.x << 16); cq.y = eg * __builtin_bit_cast(float, qraw.x & 0xffff0000u); cq.z = eg * __builtin_bit_cast(float, qraw.y << 16); cq.w = eg * __builtin_bit_cast(float, qraw.y & 0xffff0000u);
#pragma unroll
                for (int ks = 0; ks < 2; ++ks) { const LAS unsigned char* kp = kdT + x * KST + (32 * ks + 4 * g4) * 2; const LAS unsigned char* ap = At + x * KST + (32 * ks + 4 * g4) * 2;
                    ca = __builtin_amdgcn_mfma_f32_16x16x32_bf16(wn[ks], mk8(*(const LAS v2u*)(kp), *(const LAS v2u*)(kp + 32)), ca, 0, 0, 0);
                    cq = __builtin_amdgcn_mfma_f32_16x16x32_bf16(wn[ks], mk8(*(const LAS v2u*)(ap), *(const LAS v2u*)(ap + 32)), cq, 0, 0, 0); }
                const size_t off = cb + (size_t)((nt * 2 + (wave >> 1)) * 64 + lane) * 8 + 4 * (wave & 1);
                if (SM & 1) *(v2u*)(AP + off) = pack4(ca); if (SM & 2) *(v2u*)(QP + off) = pack4(cq);
            }
        } else {
            bf16x8_t ub[2];
#pragma unroll
            for (int ks = 0; ks < 2; ++ks) ub[ks] = mk8(pack4(wt[2 * ks]), pack4(wt[2 * ks + 1]));
            unsigned bo[8], oo[8];
#pragma unroll
            for (int mt = 0; mt < 4; ++mt) { const int x = 16 * mt + l15;
                f32x4 cbv = {0.f, 0.f, 0.f, 0.f}, co = {0.f, 0.f, 0.f, 0.f};
#pragma unroll
                for (int ks = 0; ks < 2; ++ks) { const LAS unsigned char* kp = kdT + x * KST + (32 * ks + 4 * g4) * 2; const LAS unsigned char* ap = At + x * KST + (32 * ks + 4 * g4) * 2;
                    cbv = __builtin_amdgcn_mfma_f32_16x16x32_bf16(mk8(*(const LAS v2u*)(kp), *(const LAS v2u*)(kp + 32)), ub[ks], cbv, 0, 0, 0);
                    co = __builtin_amdgcn_mfma_f32_16x16x32_bf16(mk8(*(const LAS v2u*)(ap), *(const LAS v2u*)(ap + 32)), ub[ks], co, 0, 0, 0); }
                const v2u pb = pack4(cbv), po = pack4(co); bo[2 * mt] = pb.x; bo[2 * mt + 1] = pb.y; oo[2 * mt] = po.x; oo[2 * mt + 1] = po.y; }
            const size_t off = cb + (size_t)((wave - 4) * 64 + lane) * 16;
            if (SM & 4) { *(v4u*)(BP + off) = (v4u){bo[0], bo[1], bo[2], bo[3]}; *(v4u*)(BP + off + 8) = (v4u){bo[4], bo[5], bo[6], bo[7]}; }
            if (SM & 8) { *(v4u*)(OP + off) = (v4u){oo[0], oo[1], oo[2], oo[3]}; *(v4u*)(OP + off + 8) = (v4u){oo[4], oo[5], oo[6], oo[7]}; }
        }
    }
}

struct G2Set { bf16x8_t a[4][2], q[4][2]; v4u b[2], o[2]; float egl; };
__device__ __forceinline__ f32x4 g2_unpack(const v4u (&p)[2], int mt) {
    const unsigned d0 = mt == 0 ? p[0].x : mt == 1 ? p[0].z : mt == 2 ? p[1].x : p[1].z, d1 = mt == 0 ? p[0].y : mt == 1 ? p[0].w : mt == 2 ? p[1].y : p[1].w;
    f32x4 r; r.x = __builtin_bit_cast(float, d0 << 16); r.y = __builtin_bit_cast(float, d0 & 0xffff0000u); r.z = __builtin_bit_cast(float, d1 << 16); r.w = __builtin_bit_cast(float, d1 & 0xffff0000u); return r;
}
__device__ __forceinline__ void gdn_g2_mfma(const Args& A, int bh, LAS unsigned char* lds, int tid, int lane, int wave) {
    unsigned char* ws = A.ws;
    const bf16* proj = (const bf16*)(ws + WS_PROJ); bf16* mix = (bf16*)(ws + WS_MIX);
    const bf16* AP = (const bf16*)(ws + WS_GAP); const bf16* BP = (const bf16*)(ws + WS_GBP); const bf16* QP = (const bf16*)(ws + WS_GQP); const bf16* OP = (const bf16*)(ws + WS_GOP); const float* GL = (const float*)(ws + WS_GGL);
    const int b = bh >> 3, h = bh & 7;
    constexpr int OST = 68;
    LAS float* obuf = (LAS float*)lds;
    __syncthreads();
    if (wave < 4) {
        const int l15 = lane & 15, g4 = lane >> 4;
        f32x4 sC[4]; bf16x8_t sB[2];
#pragma unroll
        for (int mt = 0; mt < 4; ++mt) sC[mt] = (f32x4){0.f, 0.f, 0.f, 0.f};
#pragma unroll
        for (int ks = 0; ks < 2; ++ks)
#pragma unroll
            for (int j = 0; j < 8; ++j) sB[ks][j] = 0;
#define G2_LOAD(S, n) do { const size_t cb_ = (size_t)(bh * 128 + (n)) * 4096; \
        _Pragma("unroll") for (int mt = 0; mt < 4; ++mt) _Pragma("unroll") for (int ks = 0; ks < 2; ++ks) { \
            S.a[mt][ks] = *(const bf16x8_t*)(AP + cb_ + ((mt * 2 + ks) * 64 + lane) * 8); S.q[mt][ks] = *(const bf16x8_t*)(QP + cb_ + ((mt * 2 + ks) * 64 + lane) * 8); } \
        S.b[0] = *(const v4u*)(BP + cb_ + (wave * 64 + lane) * 16); S.b[1] = *(const v4u*)(BP + cb_ + (wave * 64 + lane) * 16 + 8); \
        S.o[0] = *(const v4u*)(OP + cb_ + (wave * 64 + lane) * 16); S.o[1] = *(const v4u*)(OP + cb_ + (wave * 64 + lane) * 16 + 8); \
        S.egl = GL[bh * 128 + (n)]; } while (0)
#define G2_STEP(S, n) do { f32x4 oacc[4], sacc[4]; \
        _Pragma("unroll") for (int mt = 0; mt < 4; ++mt) { oacc[mt] = g2_unpack(S.o, mt); sacc[mt] = sC[mt] * S.egl + g2_unpack(S.b, mt); } \
        _Pragma("unroll") for (int mt = 0; mt < 4; ++mt) _Pragma("unroll") for (int ks = 0; ks < 2; ++ks) sacc[mt] = __builtin_amdgcn_mfma_f32_16x16x32_bf16(S.a[mt][ks], sB[ks], sacc[mt], 0, 0, 0); \
        _Pragma("unroll") for (int mt = 0; mt < 4; ++mt) _Pragma("unroll") for (int ks = 0; ks < 2; ++ks) oacc[mt] = __builtin_amdgcn_mfma_f32_16x16x32_bf16(S.q[mt][ks], sB[ks], oacc[mt], 0, 0, 0); \
        LAS float* ob_ = obuf + ((n) & 1) * 64 * OST + wave * 16 + l15; \
        _Pragma("unroll") for (int mt = 0; mt < 4; ++mt) _Pragma("unroll") for (int i = 0; i < 4; ++i) ob_[(16 * mt + 4 * g4 + i) * OST] = oacc[mt][i]; \
        _Pragma("unroll") for (int mt = 0; mt < 4; ++mt) sC[mt] = sacc[mt]; \
        _Pragma("unroll") for (int ks = 0; ks < 2; ++ks) { union { bf16x8_t v; unsigned u[4]; } pk_; \
            pk_.u[0] = cvtpk(sC[2 * ks].x, sC[2 * ks].y); pk_.u[1] = cvtpk(sC[2 * ks].z, sC[2 * ks].w); pk_.u[2] = cvtpk(sC[2 * ks + 1].x, sC[2 * ks + 1].y); pk_.u[3] = cvtpk(sC[2 * ks + 1].z, sC[2 * ks + 1].w); sB[ks] = pk_.v; } \
        __syncthreads(); } while (0)
        G2Set s0, s1;
        G2_LOAD(s0, 0);
#pragma unroll 1
        for (int n = 0; n < SEQ / 64; n += 2) {
            G2_LOAD(s1, n + 1);
            G2_STEP(s0, n);
            if (n + 2 < SEQ / 64) G2_LOAD(s0, n + 2);
            G2_STEP(s1, n + 1);
        }
#undef G2_LOAD
#undef G2_STEP
    } else {
        const int f = wave - 4, c = 16 * f + (lane >> 2), q4 = lane & 3;
        const float* onorm = (const float*)A.in[I_GNORM];
        float gain[16];
#pragma unroll
        for (int k = 0; k < 16; ++k) gain[k] = onorm[16 * q4 + k];
#pragma unroll 1
        for (int n = 0; n < SEQ / 64; ++n) {
            const size_t t = (size_t)b * SEQ + n * 64 + c;
            const v4u z0 = *(const v4u*)(proj + t * NPROJ + PC_Z + h * 64 + 16 * q4), z1 = *(const v4u*)(proj + t * NPROJ + PC_Z + h * 64 + 16 * q4 + 8);
            __syncthreads();
            const LAS float* ob = obuf + (n & 1) * 64 * OST + c * OST + 16 * q4;
            float o[16];
#pragma unroll
            for (int k = 0; k < 4; ++k) { const f32x4 v = *(const LAS f32x4*)(ob + 4 * k); o[4 * k] = v.x; o[4 * k + 1] = v.y; o[4 * k + 2] = v.z; o[4 * k + 3] = v.w; }
            float ss = 0.f;
#pragma unroll
            for (int k = 0; k < 16; ++k) ss += o[k] * o[k];
            ss += __shfl_xor(ss, 1); ss += __shfl_xor(ss, 2);
            const float r = 1.f / sqrtf(ss * (1.f / 64.f) + EPS);
            const unsigned zu[8] = {z0.x, z0.y, z0.z, z0.w, z1.x, z1.y, z1.z, z1.w};
            unsigned ou[8];
#pragma unroll
            for (int k = 0; k < 8; ++k) { const float za = __builtin_bit_cast(float, zu[k] << 16), zb = __builtin_bit_cast(float, zu[k] & 0xffff0000u);
                ou[k] = pk2(o[2 * k] * r * gain[2 * k] * siluf(za), o[2 * k + 1] * r * gain[2 * k + 1] * siluf(zb)); }
            bf16* op = mix + t * DM + h * 64 + 16 * q4;
            *(v4u*)(op) = (v4u){ou[0], ou[1], ou[2], ou[3]}; *(v4u*)(op + 8) = (v4u){ou[4], ou[5], ou[6], ou[7]};
        }
    }
}

__device__ __forceinline__ int wave_incl_scan(int v, int lane) {
#pragma unroll
    for (int o = 1; o < 64; o <<= 1) { const int t = __shfl_up(v, o); if (lane >= o) v += t; }
    return v;
}
struct SchedE {
    int G, c, cntv, prev, total_rt; const int2* rec; const char* W;
    __device__ __forceinline__ void init(const unsigned* cnt, const int2* rec_, const char* W_, int G_, int c_, int lane) {
        G = G_; c = c_; rec = rec_; W = W_;
        cntv = lane < NE ? (int)cnt[lane] : 0;
        const int inc = wave_incl_scan((cntv + 255) >> 8, lane);
        total_rt = __builtin_amdgcn_readlane(inc, 63);
        prev = lane < NE ? inc : 0x7fffffff;
    }
    __device__ __forceinline__ bool next(int i, pg8::UnitG& u) const {
        const int L = i * G + c; if (L >= 2 * total_rt) return false;
        const int rt = L >> 1;
        const int e = __builtin_amdgcn_readfirstlane(__popcll(__ballot(prev <= rt)));
        const int base = e ? __builtin_amdgcn_readlane(prev, e - 1) : 0;
        const int cnt = __builtin_amdgcn_readlane(cntv, e);
        u.id = e; u.tile = rt - base; u.pn = L & 1; const int rem = cnt - u.tile * 256; u.nrows = rem < 256 ? rem : 256;
        return true;
    }
    __device__ __forceinline__ int tok(const pg8::UnitG& u, int r) const { return r < u.nrows ? (rec[(size_t)u.id * TT + u.tile * 256 + r].x >> 1) : 0; }
    __device__ __forceinline__ const char* bseg(const pg8::UnitG& u, int) const { return W + ((size_t)u.id * 512 + u.pn * 256) * 2048; }
};
struct EpiGU {
    static constexpr bool PERM = true;
    bf16* HID;
    __device__ __forceinline__ void operator()(const pg8::f32x4 (&acc)[2][2][4][2], const pg8::UnitG& u, const SchedE& S, int wr, int wc, int fr, int fq) const {
#pragma unroll
        for (int ai = 0; ai < 2; ++ai)
#pragma unroll
            for (int m = 0; m < 4; ++m) { const int r = ai * 128 + wr * 64 + m * 16 + fr;
                if (r < u.nrows) { const int2 rc = S.rec[(size_t)u.id * TT + u.tile * 256 + r]; const int t = rc.x >> 1, half = rc.x & 1; const float w = __builtin_bit_cast(float, rc.y);
                    float hv[8];
#pragma unroll
                    for (int n = 0; n < 2; ++n)
#pragma unroll
                        for (int j = 0; j < 4; ++j) { const float g = acc[ai][0][m][n][j], up = acc[ai][1][m][n][j]; hv[n * 4 + j] = w * siluf(g) * up; }
                    v4u o; o.x = pk2(hv[0], hv[1]); o.y = pk2(hv[2], hv[3]); o.z = pk2(hv[4], hv[5]); o.w = pk2(hv[6], hv[7]);
                    *(v4u*)(HID + (size_t)t * 512 + half * 256 + u.pn * 128 + wc * 32 + 8 * fq) = o; } }
    }
};
struct SchedC {
    int G, c, cntA, cntB, preA, preB, total_rt; const int* clist; const char* W;
    __device__ __forceinline__ void init(const unsigned* cnt, const int* clist_, const char* W_, int G_, int c_, int lane) {
        G = G_; c = c_; clist = clist_; W = W_;
        cntA = (int)cnt[lane]; cntB = lane < NCLS - 64 ? (int)cnt[64 + lane] : 0;
        const int ia = wave_incl_scan((cntA + 255) >> 8, lane); const int ta = __builtin_amdgcn_readlane(ia, 63);
        const int ib = wave_incl_scan((cntB + 255) >> 8, lane) + ta;
        total_rt = __builtin_amdgcn_readlane(ib, 63);
        preA = ia; preB = lane < NCLS - 64 ? ib : 0x7fffffff;
    }
    __device__ __forceinline__ bool next(int i, pg8::UnitG& u) const {
        const int L = i * G + c; if (L >= 4 * total_rt) return false;
        const int rt = L >> 2;
        const int cls = __builtin_amdgcn_readfirstlane(__popcll(__ballot(preA <= rt)) + __popcll(__ballot(preB <= rt)));
        int base = 0; if (cls > 0) base = (cls - 1 < 64) ? __builtin_amdgcn_readlane(preA, cls - 1) : __builtin_amdgcn_readlane(preB, cls - 65);
        const int cnt = cls < 64 ? __builtin_amdgcn_readlane(cntA, cls) : __builtin_amdgcn_readlane(cntB, cls - 64);
        u.id = cls; u.tile = rt - base; u.pn = L & 3; const int rem = cnt - u.tile * 256; u.nrows = rem < 256 ? rem : 256;
        return true;
    }
    __device__ __forceinline__ int tok(const pg8::UnitG& u, int r) const { return r < u.nrows ? clist[(size_t)u.id * TT + u.tile * 256 + r] : 0; }
    __device__ __forceinline__ const char* bseg(const pg8::UnitG& u, int seg) const {
        const int g = u.id / 28; int a = 0, rem = u.id % 28; while (rem >= 7 - a) { rem -= 7 - a; ++a; } const int b = a + 1 + rem;
        const int e = g * 8 + (seg ? b : a);
        return W + ((size_t)e * 1024 + u.pn * 256) * 512;
    }
};
struct EpiDown {
    static constexpr bool PERM = false;
    float* OUT; const float* gate2;
    __device__ __forceinline__ void operator()(const pg8::f32x4 (&acc)[2][2][4][2], const pg8::UnitG& u, const SchedC& S, int wr, int wc, int fr, int fq) const {
#pragma unroll
        for (int ai = 0; ai < 2; ++ai)
#pragma unroll
            for (int m = 0; m < 4; ++m) { const int r = ai * 128 + wr * 64 + m * 16 + fr;
                if (r < u.nrows) { const int t = S.clist[(size_t)u.id * TT + u.tile * 256 + r]; const int b = t / SEQ; const int col0 = u.pn * 256 + wc * 32 + 4 * fq;
                    float* op = OUT + (size_t)t * DM + col0; const float* gp = gate2 + b * 6144 + col0;
#pragma unroll
                    for (int bj = 0; bj < 2; ++bj)
#pragma unroll
                        for (int n = 0; n < 2; ++n) { const int off = bj * 128 + n * 16; const f32x4 xv = *(const f32x4*)(op + off), gv = *(const f32x4*)(gp + off);
                            *(f32x4*)(op + off) = xv + gv * acc[ai][bj][m][n]; } } }
    }
};

__global__ void __launch_bounds__(NTHR, 2) fwd_kernel(Args args) {
    extern __shared__ __attribute__((aligned(16))) unsigned char lds_raw[];
    LAS unsigned char* lds = (LAS unsigned char*)lds_raw;
    volatile LAS unsigned* MISC = (volatile LAS unsigned*)(lds + MISC_OFF);
    const int tid = threadIdx.x, lane = tid & 63, wave = __builtin_amdgcn_readfirstlane(tid >> 6);
    const int G = gridDim.x;
    unsigned char* ws = args.ws;
    for (int u = tid; u < (LDS_BYTES - LDSCTL_OFF) / 4; u += NTHR) ((LAS unsigned*)(lds + LDSCTL_OFF))[u] = 0u;
    __syncthreads();
    const int lo = args.ph_lo, hi = args.ph_hi;
    const bool use_bar = (hi - lo) > 1;
    XcdBarrier bar; bar.bar = (unsigned*)(ws + WS_CTL) + CW_BAR; bar.x = 0; bar.st = nullptr;
    if (use_bar) bar = xcd_barrier_post((unsigned*)(ws + WS_CTL) + CW_BAR, MISC + 8);
#define IN(k) (lo <= (k) && (k) < hi)
#define BOTH(k) (IN(k) && IN((k) + 1))
#define GRID_BAR(k) do { if (BOTH(k)) xcd_barrier(bar); } while (0)
    const float* mod = (const float*)(ws + WS_MOD);

    if (IN(0)) { p0_prologue(args, lds, tid, lane, wave); GRID_BAR(0); }
    if (IN(1)) { norm_rows<false>(args, (const float*)args.in[I_X], (const float*)args.in[I_NORM_MIX], mod + 0, mod + 1024, (bf16*)(ws + WS_H), lds, lane, wave); GRID_BAR(1); }
    if (IN(2)) {
        pg8::Gemm g{(const pg8::bf16_t*)(ws + WS_H), (const pg8::bf16_t*)(ws + WS_WINT), TT, NPAD, DM}; pg8::StaticOrder S; S.init(TT, NPAD, G, (int)blockIdx.x);
        pg8::EpiProj E{(pg8::bf16_t*)(ws + WS_PROJ), (float*)(ws + WS_AB), NPROJ};
        pg8::gemm_phase<pg8::EpiProj, pg8::StaticOrder, true, true>(lds, g, S, E);
        GRID_BAR(2);
    }
    if (IN(3)) { swa_prep(args, lane, wave); GRID_BAR(3); }
    if (IN(4)) { gdn_g1_mfma<31>(args, lds, tid, lane, wave); GRID_BAR(4); }
    if (IN(5)) {
        if ((int)blockIdx.x < 32) gdn_g2_mfma(args, (int)blockIdx.x, lds, tid, lane, wave);
        else swa_mfma(args, lds, tid, lane, wave, (int)blockIdx.x - 32, G - 32);
        GRID_BAR(5);
    }
    if (IN(6)) {
        pg8::Gemm g{(const pg8::bf16_t*)(ws + WS_MIX), (const pg8::bf16_t*)(ws + WS_WOUTT), TT, DM, DM}; pg8::StaticOrder S; S.init(TT, DM, G, (int)blockIdx.x);
        pg8::EpiOut E{(const float*)args.in[I_X], args.out, mod + 2048, SEQ, 6144};
        pg8::gemm_phase<pg8::EpiOut, pg8::StaticOrder, true, true>(lds, g, S, E);
        GRID_BAR(6);
    }
    if (IN(7)) { norm_rows<true>(args, args.out, (const float*)args.in[I_NORM_FFN], mod + 3072, mod + 4096, (bf16*)(ws + WS_H), lds, lane, wave); GRID_BAR(7); }
    if (IN(8)) {
        SchedE S; S.init((const unsigned*)(ws + WS_CTL) + CW_ECNT, (const int2*)(ws + WS_EREC), (const char*)(ws + WS_WGUT), G, (int)blockIdx.x, lane);
        EpiGU E{(bf16*)(ws + WS_HID)};
        pg8::gemm_phase_g<EpiGU, SchedE>(lds, (const pg8::bf16_t*)(ws + WS_H), 1024, 1024, 16, 16, S, E);
        GRID_BAR(8);
    }
    if (IN(9)) {
        SchedC S; S.init((const unsigned*)(ws + WS_CTL) + CW_CCNT, (const int*)(ws + WS_CLIST), (const char*)(ws + WS_WDT), G, (int)blockIdx.x, lane);
        EpiDown E{args.out, mod + 5120};
        pg8::gemm_phase_g<EpiDown, SchedC>(lds, (const pg8::bf16_t*)(ws + WS_HID), 512, 256, 8, 4, S, E);
    }
#undef IN
#undef BOTH
#undef GRID_BAR
}

extern "C" void kernel_launch(void* const* d_in, const int* in_sizes, int n_in, void* d_out, int out_size, void* d_ws, size_t ws_size, hipStream_t stream) {
    static int grid = 0;
    if (grid == 0) {
        if (n_in != 23 || in_sizes[0] != TT * DM || out_size != TT * DM || ws_size < WS_END) { fprintf(stderr, "kernel_launch: unexpected shapes: n_in %d in0 %d out %d ws %zu (need %zu)\n", n_in, n_in > 0 ? in_sizes[0] : -1, out_size, ws_size, (size_t)WS_END); grid = -1; return; }
        int dev = 0, cus = 0, per_cu = 0;
        if (hipGetDevice(&dev) != hipSuccess || hipDeviceGetAttribute(&cus, hipDeviceAttributeMultiprocessorCount, dev) != hipSuccess) { grid = -1; return; }
        if (hipFuncSetAttribute((const void*)fwd_kernel, hipFuncAttributeMaxDynamicSharedMemorySize, LDS_BYTES) != hipSuccess) { fprintf(stderr, "kernel_launch: hipFuncSetAttribute failed\n"); grid = -1; return; }
        if (hipOccupancyMaxActiveBlocksPerMultiprocessor(&per_cu, (const void*)fwd_kernel, NTHR, LDS_BYTES) != hipSuccess || per_cu < 1) fprintf(stderr, "kernel_launch: occupancy query reports %d\n", per_cu);
        (void)hipGetLastError();
        grid = cus;
    }
    if (grid < 0) return;
    if (hipMemsetAsync((char*)d_ws + WS_CTL, 0, CTL_ZERO_BYTES, stream) != hipSuccess) { fprintf(stderr, "kernel_launch: memset failed\n"); return; }
    Args a{};
    for (int i = 0; i < 23; ++i) a.in[i] = d_in[i];
    a.out = (float*)d_out; a.ws = (unsigned char*)d_ws;
#if MK_ONE_LAUNCH
    a.ph_lo = 0; a.ph_hi = N_PHASES;
    hipLaunchKernelGGL(fwd_kernel, dim3(grid), dim3(NTHR), LDS_BYTES, stream, a);
#else
    for (int p = 0; p < N_PHASES; ++p) { a.ph_lo = p; a.ph_hi = p + 1; hipLaunchKernelGGL(fwd_kernel, dim3(grid), dim3(NTHR), LDS_BYTES, stream, a); }
#endif
}
```

```cpp
#include <hip/hip_runtime.h>
#include <cstdio>
#include <cstdint>
namespace pg8 {
#define PG8_LAS __attribute__((address_space(3)))
typedef unsigned short bf16_t;
typedef short bf16x8 __attribute__((ext_vector_type(8)));
typedef float f32x4 __attribute__((ext_vector_type(4)));
typedef unsigned u32x4 __attribute__((ext_vector_type(4)));
constexpr int BM = 256, BK = 64, HALF = 128, HTB = HALF * BK * 2  , STAGE_BYTES = 8 * HTB, NXCD = 8, WGM = 8;

__host__ __device__ __forceinline__ int lds_byte(int r, int c) { const int st = (r >> 4) * 2 + (c >> 5), rr = r & 15, cc = c & 31, ob = rr * 64 + cc * 2; return st * 1024 + (ob ^ (((ob >> 9) & 1) << 5)); }
__host__ __device__ __forceinline__ void stage_rc(int b, int& R, int& C) { const int st = b / 1024, sb = b % 1024, swz = sb ^ (((sb >> 9) & 1) << 5); R = (st >> 1) * 16 + swz / 64; C = (st & 1) * 32 + (swz % 64) / 2; }
__host__ __device__ __forceinline__ int perm32(int rho) { const int n = rho >> 4, i = rho & 15; return 8 * (i >> 2) + 4 * n + (i & 3); }

struct Unit { int pm, pn; };
struct Gemm { const bf16_t* A; const bf16_t* Bt; int M, N, K; };

struct StaticOrder {
    int nM, nN, nwg, G, c;
    __host__ __device__ void init(int M, int N, int G_, int c_) { nM = M / BM; nN = N / BM; nwg = nM * nN; G = G_; c = c_; }
    __host__ __device__ bool next(int i, Unit& u) const {
        const long L = (long)i * G + c; if (L >= nwg) return false;
        int wgid = (int)L; { const int q = nwg / NXCD, r = nwg % NXCD, xcd = wgid % NXCD, off = wgid / NXCD; wgid = (xcd < r ? xcd * (q + 1) : r * (q + 1) + (xcd - r) * q) + off; }
        const int nig = WGM * nN, gid = wgid / nig, fm = gid * WGM, gsz = (nM - fm) < WGM ? (nM - fm) : WGM;
        u.pm = fm + ((wgid % nig) % gsz); u.pn = (wgid % nig) / gsz; return true;
    }
    __device__ __forceinline__ void a_ready(const Unit&) const {}
    __device__ __forceinline__ void done(const Unit&) const {}
};

__device__ __forceinline__ unsigned cvt_pk_bf16(float lo, float hi) { unsigned r; asm volatile("v_cvt_pk_bf16_f32 %0, %1, %2" : "=v"(r) : "v"(lo), "v"(hi)); return r; }

struct EpiProj {
    static constexpr bool PERM = true, AFTER_DRAIN = false;
    bf16_t* P; float* AB; int ldp;
    __device__ __forceinline__ void operator()(const f32x4 (&acc)[2][2][4][2], const Unit& u, int wr, int wc, int fr, int fq) const {
        const int row0 = u.pm * BM + wr * 64 + fr;
        if (u.pn < 11) {
            const int col0 = u.pn * BM + wc * 32 + 8 * fq;
#pragma unroll
            for (int ai = 0; ai < 2; ++ai)
#pragma unroll
                for (int m = 0; m < 4; ++m) { bf16_t* rowp = P + (size_t)(row0 + ai * HALF + m * 16) * ldp + col0;
#pragma unroll
                    for (int bj = 0; bj < 2; ++bj) { const f32x4 v0 = acc[ai][bj][m][0], v1 = acc[ai][bj][m][1];
                        u32x4 w; w.x = cvt_pk_bf16(v0[0], v0[1]); w.y = cvt_pk_bf16(v0[2], v0[3]); w.z = cvt_pk_bf16(v1[0], v1[1]); w.w = cvt_pk_bf16(v1[2], v1[3]);
                        *(u32x4*)(rowp + bj * HALF) = w; } }
        } else if (wc == 0 && fq < 2) {
#pragma unroll
            for (int ai = 0; ai < 2; ++ai)
#pragma unroll
                for (int m = 0; m < 4; ++m) { float* rowp = AB + (size_t)(row0 + ai * HALF + m * 16) * 16 + 8 * fq;
                    *(f32x4*)(rowp) = acc[ai][0][m][0]; *(f32x4*)(rowp + 4) = acc[ai][0][m][1]; }
        }
    }
};
struct EpiOut {
    static constexpr bool PERM = false, AFTER_DRAIN = false;
    const float* X; float* O; const float* gate; int rows_per_batch, ldg;
    __device__ __forceinline__ void operator()(const f32x4 (&acc)[2][2][4][2], const Unit& u, int wr, int wc, int fr, int fq) const {
        const int row0 = u.pm * BM + wr * 64 + fr, col0 = u.pn * BM + wc * 32 + 4 * fq;
        const float* gb = gate + (size_t)((u.pm * BM) / rows_per_batch) * ldg + col0;
        f32x4 gv[2][2];
#pragma unroll
        for (int bj = 0; bj < 2; ++bj)
#pragma unroll
            for (int n = 0; n < 2; ++n) gv[bj][n] = *(const f32x4*)(gb + bj * HALF + n * 16);
#pragma unroll
        for (int ai = 0; ai < 2; ++ai)
#pragma unroll
            for (int m = 0; m < 4; ++m) { const size_t ro = (size_t)(row0 + ai * HALF + m * 16) * 1024 + col0;
#pragma unroll
                for (int bj = 0; bj < 2; ++bj)
#pragma unroll
                    for (int n = 0; n < 2; ++n) { const f32x4 xv = *(const f32x4*)(X + ro + bj * HALF + n * 16);
                        *(f32x4*)(O + ro + bj * HALF + n * 16) = xv + gv[bj][n] * acc[ai][bj][m][n]; } }
    }
};

struct UnitG { int id, tile, pn, nrows; };
template <class Epi, class Sched>
__device__ __forceinline__ void gemm_phase_g(PG8_LAS unsigned char* lds, const bf16_t* Abase, const int KA, const int KB, const int nt, const int ksplit, const Sched& S, const Epi& E) {
    const int tid = threadIdx.x, wid = __builtin_amdgcn_readfirstlane(tid >> 6), lane = tid & 63, wr = wid >> 2, wc = wid & 3, fr = lane & 15, fq = lane >> 4;
    int Rr[2]; unsigned cB2[2], voffB[2];
#pragma unroll
    for (int i = 0; i < 2; ++i) { int R, C; stage_rc(tid * 16 + i * 8192, R, C); const int Rb = Epi::PERM ? ((R & ~31) + perm32(R & 31)) : R;
        Rr[i] = R; cB2[i] = (unsigned)C * 2u; voffB[i] = (unsigned)(Rb * KB + C) * 2u; }
    const size_t kstep = (size_t)(BK * 2);
    const size_t hstepB = (size_t)HALF * KB * 2;
    const unsigned ldsw = (unsigned)wid * 1024u;
    const int aoff = lds_byte(wr * 64 + fr, fq * 8), boff = lds_byte(wc * 32 + fr, fq * 8);
#define PG8_SA(b, h) (((b) * 2 + (h)) * HTB)
#define PG8_SB(b, h) ((4 + (b) * 2 + (h)) * HTB)
#define PG8_STAGE2(bufoff, gbase, v0, v1) do { \
        __builtin_amdgcn_global_load_lds((const unsigned*)((const char*)(gbase) + (v0)), (PG8_LAS unsigned*)(lds + (bufoff) + ldsw), 16, 0, 0); \
        __builtin_amdgcn_global_load_lds((const unsigned*)((const char*)(gbase) + (v1)), (PG8_LAS unsigned*)(lds + (bufoff) + ldsw + 8192), 16, 0, 0); } while (0)
#define PG8_LDA(dst, b, h) do { _Pragma("unroll") for (int m = 0; m < 4; ++m) _Pragma("unroll") for (int k = 0; k < 2; ++k) dst[m][k] = *(const PG8_LAS bf16x8*)(lds + PG8_SA(b, h) + aoff + m * 2048 + k * 1024); } while (0)
#define PG8_LDB(dst, b, h) do { _Pragma("unroll") for (int n = 0; n < 2; ++n) _Pragma("unroll") for (int k = 0; k < 2; ++k) dst[n][k] = *(const PG8_LAS bf16x8*)(lds + PG8_SB(b, h) + boff + n * 2048 + k * 1024); } while (0)
#define PG8_MMA(ai, bj, At, Bt) do { __builtin_amdgcn_s_setprio(1); _Pragma("unroll") for (int m = 0; m < 4; ++m) _Pragma("unroll") for (int n = 0; n < 2; ++n) _Pragma("unroll") for (int k = 0; k < 2; ++k) \
        acc[ai][bj][m][n] = __builtin_amdgcn_mfma_f32_16x16x32_bf16(Bt[n][k], At[m][k], acc[ai][bj][m][n], 0, 0, 0); __builtin_amdgcn_s_setprio(0); } while (0)
#define PG8_WAIT_V(n) asm volatile("s_waitcnt vmcnt(" #n ")" ::: "memory")
#define PG8_WAIT_L(n) asm volatile("s_waitcnt lgkmcnt(" #n ")" ::: "memory")
#define PG8_BAR __builtin_amdgcn_s_barrier()
#define PG8_SCHED __builtin_amdgcn_sched_barrier(0)
#define PG8_AOFFS(u, o00, o01, o10, o11) do { const unsigned _ks = (unsigned)KA * 2u; \
        o00 = (unsigned)S.tok(u, Rr[0]) * _ks + cB2[0]; o01 = (unsigned)S.tok(u, Rr[1]) * _ks + cB2[1]; \
        o10 = (unsigned)S.tok(u, HALF + Rr[0]) * _ks + cB2[0]; o11 = (unsigned)S.tok(u, HALF + Rr[1]) * _ks + cB2[1]; } while (0)
#define PG8_BT(u, t) (((t) < ksplit) ? S.bseg(u, 0) + (size_t)(t) * kstep : S.bseg(u, 1) + (size_t)((t) - ksplit) * kstep)
    UnitG cur, nxt; int ui = 0;
    if (!S.next(0, cur)) return;
    f32x4 acc[2][2][4][2];
#pragma unroll
    for (int a = 0; a < 2; ++a)
#pragma unroll
        for (int b = 0; b < 2; ++b)
#pragma unroll
            for (int m = 0; m < 4; ++m)
#pragma unroll
                for (int n = 0; n < 2; ++n) acc[a][b][m][n] = (f32x4){0.f, 0.f, 0.f, 0.f};
    bf16x8 At[4][2], B0[2][2], B1[2][2];
    unsigned c00, c01, c10, c11, n00 = 0, n01 = 0, n10 = 0, n11 = 0;
    PG8_AOFFS(cur, c00, c01, c10, c11);
    const char* const Ab = (const char*)Abase;
    {   const char* b0p = PG8_BT(cur, 0); const char* b1p = PG8_BT(cur, 1);
        PG8_STAGE2(PG8_SB(0, 0), b0p, voffB[0], voffB[1]); PG8_STAGE2(PG8_SB(0, 1), b0p + hstepB, voffB[0], voffB[1]); PG8_STAGE2(PG8_SA(0, 0), Ab, c00, c01); PG8_STAGE2(PG8_SA(0, 1), Ab, c10, c11);
        if (wr == 1) PG8_BAR;
        PG8_WAIT_V(2); PG8_BAR;
        PG8_STAGE2(PG8_SB(1, 0), b1p, voffB[0], voffB[1]); PG8_STAGE2(PG8_SA(1, 0), Ab + kstep, c00, c01); PG8_STAGE2(PG8_SB(1, 1), b1p + hstepB, voffB[0], voffB[1]);
        PG8_WAIT_V(6); PG8_BAR;
    }
    for (;;) {
        const bool has_next = S.next(ui + 1, nxt);
        for (int t = 0; t < nt; t += 2) {
            const bool last = (t == nt - 2);
            if (last && has_next) PG8_AOFFS(nxt, n00, n01, n10, n11);
            const bool usen = last && has_next;
            const int t2 = last ? 0 : t + 2, t3 = t2 + 1;
            const char* a1 = Ab + (size_t)(t + 1) * kstep;
            const char* a2 = Ab + (size_t)t2 * kstep; const char* a3 = Ab + (size_t)t3 * kstep;
            const char* b2 = usen ? PG8_BT(nxt, t2) : PG8_BT(cur, t2); const char* b3 = usen ? PG8_BT(nxt, t3) : PG8_BT(cur, t3);
            const unsigned o00 = usen ? n00 : c00, o01 = usen ? n01 : c01, o10 = usen ? n10 : c10, o11 = usen ? n11 : c11;
            PG8_LDB(B0, 0, 0); PG8_LDB(B1, 0, 1); PG8_SCHED; PG8_LDA(At, 0, 0); PG8_STAGE2(PG8_SA(1, 1), a1, c10, c11);
            PG8_WAIT_V(8); PG8_WAIT_L(0); PG8_BAR; PG8_MMA(0, 0, At, B0); PG8_MMA(0, 1, At, B1); PG8_BAR; PG8_SCHED;
            PG8_LDA(At, 0, 1); PG8_STAGE2(PG8_SB(0, 0), b2, voffB[0], voffB[1]); PG8_STAGE2(PG8_SB(0, 1), b2 + hstepB, voffB[0], voffB[1]); PG8_STAGE2(PG8_SA(0, 0), a2, o00, o01);
            PG8_WAIT_V(8); PG8_WAIT_L(0); PG8_BAR; PG8_MMA(1, 0, At, B0); PG8_MMA(1, 1, At, B1); PG8_BAR; PG8_SCHED;
            PG8_LDB(B0, 1, 0); PG8_LDB(B1, 1, 1); PG8_SCHED; PG8_LDA(At, 1, 0); PG8_STAGE2(PG8_SA(0, 1), a2, o10, o11);
            PG8_WAIT_V(8); PG8_WAIT_L(0); PG8_BAR; PG8_MMA(0, 0, At, B0); PG8_MMA(0, 1, At, B1); PG8_BAR; PG8_SCHED;
            PG8_LDA(At, 1, 1); PG8_STAGE2(PG8_SB(1, 0), b3, voffB[0], voffB[1]); PG8_STAGE2(PG8_SB(1, 1), b3 + hstepB, voffB[0], voffB[1]); PG8_STAGE2(PG8_SA(1, 0), a3, o00, o01);
            PG8_WAIT_V(8); PG8_WAIT_L(0); PG8_BAR; PG8_MMA(1, 0, At, B0); PG8_MMA(1, 1, At, B1); PG8_BAR; PG8_SCHED;
        }
        if (wr == 0) PG8_BAR;
        E(acc, cur, S, wr, wc, fr, fq);
        if (!has_next) break;
#pragma unroll
        for (int a = 0; a < 2; ++a)
#pragma unroll
            for (int b = 0; b < 2; ++b)
#pragma unroll
                for (int m = 0; m < 4; ++m)
#pragma unroll
                    for (int n = 0; n < 2; ++n) acc[a][b][m][n] = (f32x4){0.f, 0.f, 0.f, 0.f};
        cur = nxt; c00 = n00; c01 = n01; c10 = n10; c11 = n11; ++ui;
        if (wr == 1) PG8_BAR;
    }
    PG8_WAIT_V(0);
    PG8_BAR;
#undef PG8_SA
#undef PG8_SB
#undef PG8_STAGE2
#undef PG8_LDA
#undef PG8_LDB
#undef PG8_MMA
#undef PG8_WAIT_V
#undef PG8_WAIT_L
#undef PG8_BAR
#undef PG8_SCHED
#undef PG8_AOFFS
#undef PG8_BT
}
template <class Epi, class Sched, bool ALIGN_EPI = false, bool SP2 = false>
__device__ __forceinline__ void gemm_phase(PG8_LAS unsigned char* lds, const Gemm g, const Sched& S, const Epi& E) {
    const int tid = threadIdx.x, wid = __builtin_amdgcn_readfirstlane(tid >> 6), lane = tid & 63, wr = wid >> 2, wc = wid & 3, fr = lane & 15, fq = lane >> 4;
    const int K = g.K, nt = K / BK;
    unsigned voffA[2], voffB[2];
#pragma unroll
    for (int i = 0; i < 2; ++i) { int R, C; stage_rc(tid * 16 + i * 8192, R, C); const int Rb = Epi::PERM ? ((R & ~31) + perm32(R & 31)) : R;
        voffA[i] = (unsigned)(R * K + C) * 2u; voffB[i] = (unsigned)(Rb * K + C) * 2u; }
    const size_t kstep = (size_t)(BK * 2);
    const size_t hstep = (size_t)HALF * K * 2;
    const size_t tstep = 2 * hstep;
    const unsigned ldsw = (unsigned)wid * 1024u;
    const int aoff = lds_byte(wr * 64 + fr, fq * 8), boff = lds_byte(wc * 32 + fr, fq * 8);
#define PG8_SA(b, h) (((b) * 2 + (h)) * HTB)
#define PG8_SB(b, h) ((4 + (b) * 2 + (h)) * HTB)
#define PG8_STAGE(bufoff, gbase, voff) do { _Pragma("unroll") for (int _i = 0; _i < 2; ++_i) \
        __builtin_amdgcn_global_load_lds((const unsigned*)((const char*)(gbase) + (voff)[_i]), (PG8_LAS unsigned*)(lds + (bufoff) + ldsw + _i * 8192), 16, 0, 0); } while (0)
#define PG8_LDA(dst, b, h) do { _Pragma("unroll") for (int m = 0; m < 4; ++m) _Pragma("unroll") for (int k = 0; k < 2; ++k) dst[m][k] = *(const PG8_LAS bf16x8*)(lds + PG8_SA(b, h) + aoff + m * 2048 + k * 1024); } while (0)
#define PG8_LDB(dst, b, h) do { _Pragma("unroll") for (int n = 0; n < 2; ++n) _Pragma("unroll") for (int k = 0; k < 2; ++k) dst[n][k] = *(const PG8_LAS bf16x8*)(lds + PG8_SB(b, h) + boff + n * 2048 + k * 1024); } while (0)
#define PG8_MMA(ai, bj, At, Bt) do { __builtin_amdgcn_s_setprio(1); _Pragma("unroll") for (int m = 0; m < 4; ++m) _Pragma("unroll") for (int n = 0; n < 2; ++n) _Pragma("unroll") for (int k = 0; k < 2; ++k) \
        acc[ai][bj][m][n] = __builtin_amdgcn_mfma_f32_16x16x32_bf16(Bt[n][k], At[m][k], acc[ai][bj][m][n], 0, 0, 0); __builtin_amdgcn_s_setprio(0); } while (0)
#define PG8_WAIT_V(n) asm volatile("s_waitcnt vmcnt(" #n ")" ::: "memory")
#define PG8_WAIT_L(n) asm volatile("s_waitcnt lgkmcnt(" #n ")" ::: "memory")
#define PG8_BAR __builtin_amdgcn_s_barrier()
#define PG8_SCHED __builtin_amdgcn_sched_barrier(0)
    Unit cur, nxt; int ui = 0;
    if (!S.next(0, cur)) return;
    f32x4 acc[2][2][4][2];
#pragma unroll
    for (int a = 0; a < 2; ++a)
#pragma unroll
        for (int b = 0; b < 2; ++b)
#pragma unroll
            for (int m = 0; m < 4; ++m)
#pragma unroll
                for (int n = 0; n < 2; ++n) acc[a][b][m][n] = (f32x4){0.f, 0.f, 0.f, 0.f};
    bf16x8 At[4][2], B0[2][2], B1[2][2];
    const char* cA = (const char*)g.A + (size_t)cur.pm * tstep; const char* cB = (const char*)g.Bt + (size_t)cur.pn * tstep;
    S.a_ready(cur);
    if constexpr (SP2) {
        PG8_STAGE(PG8_SB(0, 0), cB, voffB); PG8_STAGE(PG8_SB(0, 1), cB + hstep, voffB); PG8_STAGE(PG8_SA(0, 0), cA, voffA); PG8_STAGE(PG8_SA(0, 1), cA + hstep, voffA);
        if (wr == 1) PG8_BAR;
        PG8_WAIT_V(2); PG8_BAR;
        PG8_STAGE(PG8_SB(1, 0), cB + kstep, voffB); PG8_STAGE(PG8_SA(1, 0), cA + kstep, voffA); PG8_STAGE(PG8_SB(1, 1), cB + hstep + kstep, voffB);
        PG8_WAIT_V(6); PG8_BAR;
    } else {
        PG8_STAGE(PG8_SB(0, 0), cB, voffB); PG8_STAGE(PG8_SA(0, 0), cA, voffA); PG8_STAGE(PG8_SB(0, 1), cB + hstep, voffB); PG8_STAGE(PG8_SA(0, 1), cA + hstep, voffA);
        if (wr == 1) PG8_BAR;
        PG8_WAIT_V(4); PG8_BAR;
        PG8_STAGE(PG8_SB(1, 0), cB + kstep, voffB); PG8_STAGE(PG8_SA(1, 0), cA + kstep, voffA); PG8_STAGE(PG8_SB(1, 1), cB + hstep + kstep, voffB);
        PG8_WAIT_V(6); PG8_BAR;
    }
    for (;;) {
        const bool has_next = S.next(ui + 1, nxt);
        const char* nA = has_next ? (const char*)g.A + (size_t)nxt.pm * tstep : cA; const char* nB = has_next ? (const char*)g.Bt + (size_t)nxt.pn * tstep : cB;
        for (int t = 0; t < nt; t += 2) {
            const bool last = (t == nt - 2);
            const char* a1 = cA + (size_t)(t + 1) * kstep;
            const char* a2 = last ? nA : cA + (size_t)(t + 2) * kstep; const char* b2 = last ? nB : cB + (size_t)(t + 2) * kstep;
            const char* a3 = a2 + kstep; const char* b3 = b2 + kstep;
            if (last && has_next) S.a_ready(nxt);
            if constexpr (SP2) {
            PG8_LDB(B0, 0, 0); PG8_LDB(B1, 0, 1); PG8_SCHED; PG8_LDA(At, 0, 0); PG8_STAGE(PG8_SA(1, 1), a1 + hstep, voffA);
            PG8_WAIT_V(8); PG8_WAIT_L(0); PG8_BAR; PG8_MMA(0, 0, At, B0); PG8_MMA(0, 1, At, B1); PG8_BAR; PG8_SCHED;
            PG8_LDA(At, 0, 1); PG8_STAGE(PG8_SB(0, 0), b2, voffB); PG8_STAGE(PG8_SB(0, 1), b2 + hstep, voffB); PG8_STAGE(PG8_SA(0, 0), a2, voffA);
            PG8_WAIT_V(8); PG8_WAIT_L(0); PG8_BAR; PG8_MMA(1, 0, At, B0); PG8_MMA(1, 1, At, B1); PG8_BAR; PG8_SCHED;
            PG8_LDB(B0, 1, 0); PG8_LDB(B1, 1, 1); PG8_SCHED; PG8_LDA(At, 1, 0); PG8_STAGE(PG8_SA(0, 1), a2 + hstep, voffA);
            PG8_WAIT_V(8); PG8_WAIT_L(0); PG8_BAR; PG8_MMA(0, 0, At, B0); PG8_MMA(0, 1, At, B1); PG8_BAR; PG8_SCHED;
            PG8_LDA(At, 1, 1); PG8_STAGE(PG8_SB(1, 0), b3, voffB); PG8_STAGE(PG8_SB(1, 1), b3 + hstep, voffB); PG8_STAGE(PG8_SA(1, 0), a3, voffA);
            PG8_WAIT_V(8); PG8_WAIT_L(0); PG8_BAR; PG8_MMA(1, 0, At, B0); PG8_MMA(1, 1, At, B1); PG8_BAR; PG8_SCHED;
            } else {
            PG8_LDB(B0, 0, 0); PG8_SCHED; PG8_LDA(At, 0, 0); PG8_STAGE(PG8_SA(1, 1), a1 + hstep, voffA);
            PG8_WAIT_L(8); PG8_BAR; PG8_WAIT_L(0); PG8_MMA(0, 0, At, B0); PG8_BAR; PG8_SCHED;
            PG8_LDB(B1, 0, 1); PG8_STAGE(PG8_SB(0, 0), b2, voffB);
            PG8_BAR; PG8_WAIT_L(0); PG8_MMA(0, 1, At, B1); PG8_BAR;
            PG8_LDA(At, 0, 1); PG8_STAGE(PG8_SA(0, 0), a2, voffA);
            PG8_BAR; PG8_WAIT_L(0); PG8_MMA(1, 0, At, B0); PG8_BAR; PG8_SCHED;
            PG8_STAGE(PG8_SB(0, 1), b2 + hstep, voffB);
            PG8_WAIT_V(6); PG8_BAR; PG8_MMA(1, 1, At, B1); PG8_BAR;
            PG8_LDB(B0, 1, 0); PG8_SCHED; PG8_LDA(At, 1, 0); PG8_STAGE(PG8_SA(0, 1), a2 + hstep, voffA);
            PG8_WAIT_L(8); PG8_BAR; PG8_WAIT_L(0); PG8_MMA(0, 0, At, B0); PG8_BAR; PG8_SCHED;
            PG8_LDB(B1, 1, 1); PG8_STAGE(PG8_SB(1, 0), b3, voffB);
            PG8_BAR; PG8_WAIT_L(0); PG8_MMA(0, 1, At, B1); PG8_BAR;
            PG8_LDA(At, 1, 1); PG8_STAGE(PG8_SA(1, 0), a3, voffA);
            PG8_BAR; PG8_WAIT_L(0); PG8_MMA(1, 0, At, B0); PG8_BAR; PG8_SCHED;
            PG8_STAGE(PG8_SB(1, 1), b3 + hstep, voffB);
            PG8_WAIT_V(6); PG8_BAR; PG8_MMA(1, 1, At, B1); PG8_BAR;
            }
        }
        if constexpr (ALIGN_EPI) { if (wr == 0) PG8_BAR; }
        if constexpr (!Epi::AFTER_DRAIN) { E(acc, cur, wr, wc, fr, fq); S.done(cur); }
        if (!has_next) break;
#pragma unroll
        for (int a = 0; a < 2; ++a)
#pragma unroll
            for (int b = 0; b < 2; ++b)
#pragma unroll
                for (int m = 0; m < 4; ++m)
#pragma unroll
                    for (int n = 0; n < 2; ++n) acc[a][b][m][n] = (f32x4){0.f, 0.f, 0.f, 0.f};
        cur = nxt; cA = nA; cB = nB; ++ui;
        if constexpr (ALIGN_EPI) { if (wr == 1) PG8_BAR; }
    }
    PG8_WAIT_V(0);
    if constexpr (!ALIGN_EPI) { if (wr == 0) PG8_BAR; }
    PG8_BAR;
    if constexpr (Epi::AFTER_DRAIN) { E.fused(acc, cur, wr, wc, fr, fq, lds, wid, lane); S.done(cur); }
#undef PG8_SA
#undef PG8_SB
#undef PG8_STAGE
#undef PG8_LDA
#undef PG8_LDB
#undef PG8_MMA
#undef PG8_WAIT_V
#undef PG8_WAIT_L
#undef PG8_BAR
#undef PG8_SCHED
}
}

constexpr int NB = 4, SEQ = 8192, DM = 1024, TT = NB * SEQ;
constexpr int NPROJ = 2816, NPAD = 3072;
constexpr int PC_Q = 0, PC_K = 512, PC_V = 1024, PC_Z = 1536, PC_SQ = 2048, PC_SK = 2560, PC_SV = 2688;
constexpr int NE = 32, NCLS = 112, DE = 256;
constexpr float EPS = 1e-6f;
constexpr int NWAVES = 8, NTHR = 512;
constexpr int N_PHASES = 10;
#ifndef G1_SM
#define G1_SM 31
#endif
#ifndef PROBE_REP
#define PROBE_REP -1
#endif
#ifndef MK_ONE_LAUNCH
#define MK_ONE_LAUNCH 1
#endif

constexpr size_t MiB = 1u << 20;
constexpr size_t WS_CTL = 0, CTL_ZERO_BYTES = 1 * MiB;
constexpr size_t WS_MOD = 1 * MiB;
constexpr size_t WS_WINT = 2 * MiB, WS_WOUTT = 8 * MiB, WS_WGUT = 10 * MiB, WS_WDT = 42 * MiB;
constexpr size_t WS_H = 58 * MiB;
constexpr size_t WS_PROJ = 122 * MiB;
constexpr size_t WS_AB = 298 * MiB;
constexpr size_t WS_MIX = 300 * MiB;
constexpr size_t WS_GSF = 364 * MiB;
constexpr size_t WS_EREC = 404 * MiB, WS_CLIST = 412 * MiB;
constexpr size_t WS_HID = WS_PROJ;
constexpr size_t WS_GAP = WS_H, WS_GQP = WS_H + 32 * MiB;
constexpr size_t WS_GOP = 426 * MiB, WS_GBP = 458 * MiB, WS_GGL = 490 * MiB;
constexpr size_t WS_WRT = 491 * MiB;
constexpr size_t WS_END = 492 * MiB;
constexpr int CW_BAR = 4096, CW_ECNT = 8192, CW_CCNT = 8256;

constexpr int RING_BYTES = 131072, LDSCTL_OFF = RING_BYTES, LDS_BYTES = 147456, MISC_OFF = LDS_BYTES - 128;

#define GAS __attribute__((address_space(1)))
#define LAS __attribute__((address_space(3)))
typedef unsigned short bf16;
typedef unsigned v4u __attribute__((ext_vector_type(4)));
typedef float f32x4 __attribute__((ext_vector_type(4)));
typedef GAS unsigned gu32;
#define RLX_AGENT __ATOMIC_RELAXED, __HIP_MEMORY_SCOPE_AGENT
#define LDS_WAIT() asm volatile("s_waitcnt lgkmcnt(0)" ::: "memory")
__device__ __forceinline__ unsigned f2bf(float f) { unsigned u = __builtin_bit_cast(unsigned, f); return (u + 0x7fffu + ((u >> 16) & 1u)) >> 16; }
__device__ __forceinline__ unsigned pk2(float lo, float hi) { return f2bf(lo) | (f2bf(hi) << 16); }
__device__ __forceinline__ float bf2f(bf16 v) { return __builtin_bit_cast(float, (unsigned)v << 16); }
__device__ __forceinline__ float wave_sum(float v) {
#pragma unroll
    for (int o = 1; o < 64; o <<= 1) v += __shfl_xor(v, o);
    return v;
}
__device__ __forceinline__ float siluf(float y) { return y / (1.f + __expf(-y)); }
#define XB_TMO      128
#define XB_XCNT(j)  (256  + 64 * (j))
#define XB_XSUB(j)  (1280 + 64 * (j))
#define XB_XGEN(j)  (2304 + 64 * (j))
#define XB_TOP      3328
#define XB_TOPGEN   3392
#define XCD_BAR_WORDS 3456
#define XB_SPIN_CAP (1u << 18)
__device__ __forceinline__ unsigned xb_ld(unsigned* p)              { return __hip_atomic_load(p, __ATOMIC_RELAXED, __HIP_MEMORY_SCOPE_AGENT); }
__device__ __forceinline__ unsigned xb_add(unsigned* p, unsigned v) { return __hip_atomic_fetch_add(p, v, __ATOMIC_RELAXED, __HIP_MEMORY_SCOPE_AGENT); }
__device__ __forceinline__ unsigned xb_xcc_id() { return (unsigned)__builtin_amdgcn_s_getreg((3 << 11) | 20) & 0xFu; }
#define XB_SPIN(cond, bar) do { unsigned _sp = 0; while (cond) { __builtin_amdgcn_s_sleep(1); \
    if ((++_sp & 255u) == 0u) { if (xb_ld(&(bar)[XB_TMO])) break; if (_sp > XB_SPIN_CAP) { atomicAdd(&(bar)[XB_TMO], 1u); break; } } } } while (0)

struct XcdBarrier {
    unsigned* bar; unsigned x;
    volatile LAS unsigned* st;
};

__device__ __forceinline__ XcdBarrier xcd_barrier_post(unsigned* bar, volatile LAS unsigned* st) {
    XcdBarrier b; b.bar = bar; b.x = xb_xcc_id(); b.st = st;
    if (threadIdx.x == 0) (void)xb_add(&bar[XB_XCNT(b.x)], 1u);
    return b;
}
__device__ __forceinline__ void xcd_barrier_complete(unsigned* bar, unsigned x, unsigned& nloc, unsigned& nx) {
    const unsigned G = gridDim.x * gridDim.y * gridDim.z;
    unsigned sum, cnt, mine, sp = 0u;
    for (;;) {
        sum = 0u; cnt = 0u; mine = 0u;
#pragma unroll
        for (unsigned j = 0; j < 16; ++j) { const unsigned c = xb_ld(&bar[XB_XCNT(j)]); sum += c; cnt += (c > 0u) ? 1u : 0u; mine = (j == x) ? c : mine; }
        if (sum == G) break;
        __builtin_amdgcn_s_sleep(1);
        if ((++sp & 255u) == 0u) { if (xb_ld(&bar[XB_TMO])) break; if (sp > XB_SPIN_CAP) { atomicAdd(&bar[XB_TMO], 1u); break; } }
    }
    nloc = mine > 0u ? mine : 1u; nx = cnt > 0u ? cnt : 1u;
}

__device__ __forceinline__ void xcd_barrier(const XcdBarrier& b) {
    asm volatile("s_waitcnt vmcnt(0)" ::: "memory");
    __syncthreads();
    if (threadIdx.x == 0) {
        unsigned* bar = b.bar;
        __builtin_amdgcn_s_waitcnt(0);
        unsigned nloc = b.st[0], nx = b.st[1];
        if (nloc == 0u) { xcd_barrier_complete(bar, b.x, nloc, nx); b.st[0] = nloc; b.st[1] = nx; }
        const unsigned old = xb_add(&bar[XB_XSUB(b.x)], 1u);
        const unsigned gen = old / nloc;
        if (old + 1u == (gen + 1u) * nloc) {
            __builtin_amdgcn_fence(__ATOMIC_RELEASE, "agent");
            asm volatile("s_waitcnt vmcnt(0)" ::: "memory");
            const unsigned og = xb_add(&bar[XB_TOP], 1u);
            const unsigned tg = og / nx;
            if (og + 1u == (tg + 1u) * nx) xb_add(&bar[XB_TOPGEN], 1u);
            else XB_SPIN(xb_ld(&bar[XB_TOPGEN]) == tg, bar);
            __builtin_amdgcn_fence(__ATOMIC_ACQUIRE, "agent");
            xb_add(&bar[XB_XGEN(b.x)], 1u);
            asm volatile("s_waitcnt vmcnt(0)" ::: "memory");
        } else {
            XB_SPIN(xb_ld(&bar[XB_XGEN(b.x)]) == gen, bar);
            __builtin_amdgcn_fence(__ATOMIC_ACQUIRE, "agent");
            asm volatile("s_waitcnt vmcnt(0)" ::: "memory");
        }
    }
    __syncthreads();
}

struct Args { const void* in[23]; float* out; unsigned char* ws; int ph_lo, ph_hi; };
enum { I_X = 0, I_C, I_POS, I_WADA, I_BADA, I_NORM_MIX, I_WIN, I_CONVW, I_ALOG, I_DTB, I_GNORM, I_QNORM, I_KNORM, I_SINKS, I_WOUT, I_NORM_FFN, I_WGRP, I_BGRP, I_WRT, I_BRT, I_WGATE, I_WUP, I_WDOWN };

template <class CM>
__device__ __forceinline__ void transpose_item(const float* W, int ldw, int k0, bf16* WT, int ldt, int n0, CM cm, LAS float* scr, int lane) {
    const int sc = cm(n0 + (lane & 31));
#pragma unroll 8
    for (int i = 0; i < 32; ++i) { const int kk = 2 * i + (lane >> 5); scr[kk * 33 + (lane & 31)] = sc >= 0 ? W[(size_t)(k0 + kk) * ldw + sc] : 0.f; }
    LDS_WAIT(); asm volatile("" ::: "memory");
    const int c = lane & 7;
#pragma unroll
    for (int j = 0; j < 4; ++j) { const int n = (lane >> 3) + 8 * j; const LAS float* s = scr + (8 * c) * 33 + n;
        v4u o; o.x = pk2(s[0 * 33], s[1 * 33]); o.y = pk2(s[2 * 33], s[3 * 33]); o.z = pk2(s[4 * 33], s[5 * 33]); o.w = pk2(s[6 * 33], s[7 * 33]);
        *(v4u*)(WT + (size_t)(n0 + n) * ldt + k0 + 8 * c) = o; }
    LDS_WAIT(); asm volatile("" ::: "memory");
}
struct CmIn { __device__ __forceinline__ int operator()(int n) const { return n < 2048 ? n : (n < 2816 ? n + 16 : (n < 2832 ? 2048 + (n - 2816) : -1)); } };
struct CmOff { int off; __device__ __forceinline__ int operator()(int n) const { return n + off; } };
struct CmId { __device__ __forceinline__ int operator()(int n) const { return n; } };

__device__ __forceinline__ void p0_prologue(const Args& A, LAS unsigned char* lds, int tid, int lane, int wave) {
    unsigned char* ws = A.ws;
    LAS float* scr = (LAS float*)(lds + wave * 8448);
    const int G = gridDim.x, gw = blockIdx.x * NWAVES + wave, NGW = G * NWAVES;
    constexpr int IT_IN = (NPAD / 32) * (DM / 64), IT_OUT = (DM / 32) * (DM / 64);
    for (int it = gw; it < IT_IN + IT_OUT; it += NGW) {
        if (it < IT_IN) { const int nb = it % (NPAD / 32), kb = it / (NPAD / 32); transpose_item((const float*)A.in[I_WIN], 2832, kb * 64, (bf16*)(ws + WS_WINT), DM, nb * 32, CmIn(), scr, lane); }
        else { const int r = it - IT_IN, nb = r % (DM / 32), kb = r / (DM / 32); transpose_item((const float*)A.in[I_WOUT], DM, kb * 64, (bf16*)(ws + WS_WOUTT), DM, nb * 32, CmId(), scr, lane); }
    }
    {   constexpr int IT_GU = NE * 16 * 16, IT_D = NE * 32 * 4;
        const float* wgate = (const float*)A.in[I_WGATE]; const float* wup = (const float*)A.in[I_WUP]; const float* wdown = (const float*)A.in[I_WDOWN];
        for (int it = gw; it < IT_GU + IT_D; it += NGW) {
            if (it < IT_GU) { const int e = it >> 8, r = it & 255, nb = r & 15, kb = r >> 4, j = nb >> 3, q = nb & 7;
                const float* W = (q < 4 ? wgate : wup) + (size_t)e * 1024 * 256; const int col0 = j * 128 + (q & 3) * 32;
                transpose_item(W, 256, kb * 64, (bf16*)(ws + WS_WGUT) + (size_t)e * 512 * 1024, 1024, nb * 32, CmOff{col0 - nb * 32}, scr, lane); }
            else { const int r2 = it - IT_GU, e = r2 >> 7, r = r2 & 127, nb = r & 31, kb = r >> 5;
                transpose_item(wdown + (size_t)e * 256 * 1024, 1024, kb * 64, (bf16*)(ws + WS_WDT) + (size_t)e * 1024 * 256, 256, nb * 32, CmId(), scr, lane); }
        }
    }
    {   const float* wgp = (const float*)A.in[I_WGRP]; const float* wrt = (const float*)A.in[I_WRT];
        bf16* wh = (bf16*)(ws + WS_WRT); bf16* wl = wh + 48 * 1024;
        for (int idx = blockIdx.x * NTHR + tid; idx < 48 * 1024; idx += G * NTHR) { const int o = idx >> 10, k = idx & 1023;
            const float w = o < 4 ? wgp[k * 4 + o] : (o < 36 ? wrt[k * 32 + o - 4] : 0.f);
            const unsigned hb = f2bf(w); const float hf = __builtin_bit_cast(float, hb << 16);
            wh[idx] = (bf16)hb; wl[idx] = (bf16)f2bf(w - hf); }
    }
    LAS float* cact = (LAS float*)(lds + 69632);
    LAS float* red = (LAS float*)(lds + 69632 + 16384);
    const float* c = (const float*)A.in[I_C]; const float* wada = (const float*)A.in[I_WADA]; const float* bada = (const float*)A.in[I_BADA];
    float* mod = (float*)(ws + WS_MOD);
    if ((int)blockIdx.x < 96) {
        __syncthreads();
        for (int i = tid; i < 4096; i += NTHR) cact[i] = siluf(c[i]);
        __syncthreads();
        for (int u = blockIdx.x; u < 96; u += G) {
            const int n = u * 64 + lane; float a0 = 0.f, a1 = 0.f, a2 = 0.f, a3 = 0.f;
            for (int k = wave * 128; k < wave * 128 + 128; ++k) { const float w = wada[(size_t)k * 6144 + n]; a0 += cact[k] * w; a1 += cact[1024 + k] * w; a2 += cact[2048 + k] * w; a3 += cact[3072 + k] * w; }
            red[(wave * 4 + 0) * 64 + lane] = a0; red[(wave * 4 + 1) * 64 + lane] = a1; red[(wave * 4 + 2) * 64 + lane] = a2; red[(wave * 4 + 3) * 64 + lane] = a3;
            __syncthreads();
            if (tid < 256) { const int b = tid >> 6, l = tid & 63; float s = bada[u * 64 + l];
#pragma unroll
                for (int w = 0; w < 8; ++w) s += red[(w * 4 + b) * 64 + l];
                mod[b * 6144 + u * 64 + l] = s; }
            __syncthreads();
        }
    }
}

template <bool ROUTE>
__device__ __forceinline__ void norm_rows(const Args& A, const float* X, const float* gain, const float* shift, const float* scale, bf16* H, LAS unsigned char* lds, int lane, int wave) {
    LAS float* hl = (LAS float*)(lds + wave * 4096);
    const int G = gridDim.x, gw = blockIdx.x * NWAVES + wave, NGW = G * NWAVES;
    unsigned char* ws = A.ws;
    for (int r0 = gw * 16; r0 < TT; r0 += NGW * 16) {
        const int b = r0 / SEQ;
        f32x4 mf[4], af[4];
#pragma unroll
        for (int j = 0; j < 4; ++j) { const int col = 4 * lane + 256 * j; const f32x4 g = *(const f32x4*)(gain + col), sc = *(const f32x4*)(scale + b * 6144 + col);
            mf[j] = g * (sc + 1.0f); af[j] = *(const f32x4*)(shift + b * 6144 + col); }
        for (int i = 0; i < 16; ++i) {
            const int row = r0 + i;
            const f32x4* xr = (const f32x4*)(X + (size_t)row * DM) + lane;
            f32x4 v[4]; float s = 0.f;
#pragma unroll
            for (int j = 0; j < 4; ++j) { v[j] = xr[64 * j]; s += (v[j].x * v[j].x + v[j].y * v[j].y) + (v[j].z * v[j].z + v[j].w * v[j].w); }
            const float rstd = 1.f / sqrtf(wave_sum(s) * (1.f / DM) + EPS);
            unsigned long long* o8 = (unsigned long long*)(H + (size_t)row * DM) + lane;
#pragma unroll
            for (int j = 0; j < 4; ++j) { v[j] = v[j] * rstd * mf[j] + af[j];
                o8[64 * j] = (unsigned long long)pk2(v[j].x, v[j].y) | ((unsigned long long)pk2(v[j].z, v[j].w) << 32); }
            if constexpr (ROUTE) {
                const float* wg = (const float*)A.in[I_WGRP]; const float* wr = (const float*)A.in[I_WRT];
                float lg[36];
#pragma unroll
                for (int o = 0; o < 36; ++o) lg[o] = 0.f;
#pragma unroll
                for (int j = 0; j < 4; ++j) *(LAS f32x4*)(hl + 4 * lane + 256 * j) = v[j];
                LDS_WAIT(); asm volatile("" ::: "memory");
#pragma unroll 1
                for (int ii = 0; ii < 16; ++ii) { const int k = lane + 64 * ii; const float hv = hl[k];
                    const f32x4 g4 = *(const f32x4*)(wg + k * 4);
                    lg[0] += hv * g4.x; lg[1] += hv * g4.y; lg[2] += hv * g4.z; lg[3] += hv * g4.w;
#pragma unroll
                    for (int q = 0; q < 8; ++q) { const f32x4 r4 = *(const f32x4*)(wr + k * 32 + q * 4);
                        lg[4 + q * 4 + 0] += hv * r4.x; lg[4 + q * 4 + 1] += hv * r4.y; lg[4 + q * 4 + 2] += hv * r4.z; lg[4 + q * 4 + 3] += hv * r4.w; } }
                LDS_WAIT(); asm volatile("" ::: "memory");
#pragma unroll
                for (int o = 0; o < 36; ++o) lg[o] = wave_sum(lg[o]);
                const float* bg = (const float*)A.in[I_BGRP]; const float* br = (const float*)A.in[I_BRT];
#pragma unroll
                for (int o = 0; o < 4; ++o) lg[o] += bg[o];
#pragma unroll
                for (int o = 0; o < 32; ++o) lg[4 + o] += br[o];
                int gi = 0; float gm = lg[0];
#pragma unroll
                for (int o = 1; o < 4; ++o) if (lg[o] > gm) { gm = lg[o]; gi = o; }
                float gs = 0.f;
#pragma unroll
                for (int o = 0; o < 4; ++o) gs += __expf(lg[o] - gm);
                const float pg = 1.f / gs;
                float le[8];
#pragma unroll
                for (int j = 0; j < 8; ++j) { le[j] = lg[4 + j];
#pragma unroll
                    for (int g = 1; g < 4; ++g) le[j] = (gi == g) ? lg[4 + g * 8 + j] : le[j]; }
                int j1 = 0; float m1 = le[0];
#pragma unroll
                for (int j = 1; j < 8; ++j) if (le[j] > m1) { m1 = le[j]; j1 = j; }
                int j2 = -1; float m2 = -3.0e38f;
#pragma unroll
                for (int j = 0; j < 8; ++j) if (j != j1 && le[j] > m2) { m2 = le[j]; j2 = j; }
                const float ex = __expf(m2 - m1), w1 = pg / (1.f + ex), w2 = pg * ex / (1.f + ex);
                if (lane == 0) {
                    const int e1 = gi * 8 + j1, e2 = gi * 8 + j2;
                    unsigned* ctl = (unsigned*)(ws + WS_CTL);
                    int2* erec = (int2*)(ws + WS_EREC); int* clist = (int*)(ws + WS_CLIST);
                    const unsigned p1 = atomicAdd(ctl + CW_ECNT + e1, 1u); erec[(size_t)e1 * TT + p1] = make_int2(row * 2 + (e1 > e2 ? 1 : 0), __builtin_bit_cast(int, w1));
                    const unsigned p2 = atomicAdd(ctl + CW_ECNT + e2, 1u); erec[(size_t)e2 * TT + p2] = make_int2(row * 2 + (e2 > e1 ? 1 : 0), __builtin_bit_cast(int, w2));
                    const int a = j1 < j2 ? j1 : j2, bb = j1 < j2 ? j2 : j1;
                    const int cls = gi * 28 + (a * 7 - (a * (a - 1)) / 2 + (bb - a - 1));
                    const unsigned pc = atomicAdd(ctl + CW_CCNT + cls, 1u); clist[(size_t)cls * TT + pc] = row;
                }
            }
        }
    }
}

typedef short bf16x8_t __attribute__((ext_vector_type(8)));
typedef float f32x16 __attribute__((ext_vector_type(16)));
typedef unsigned v2u __attribute__((ext_vector_type(2)));
typedef float f32x2_t __attribute__((ext_vector_type(2)));
typedef __bf16 bf16x2_t __attribute__((ext_vector_type(2)));
__device__ __forceinline__ unsigned cvtpk(float lo, float hi) { const f32x2_t f = {lo, hi}; return __builtin_bit_cast(unsigned, __builtin_convertvector(f, bf16x2_t)); }
__device__ __forceinline__ void fast_sincos(float ang, float& sn, float& cs) {
    float rev = ang * 0.15915494309189535f; rev -= floorf(rev);
    sn = __builtin_amdgcn_sinf(rev); cs = __builtin_amdgcn_cosf(rev);
}
__device__ __forceinline__ void swa_mfma(const Args& A, LAS unsigned char* lds, int tid, int lane, int wave, int blk, int nblk) {
    unsigned char* ws = A.ws;
    const bf16* proj = (const bf16*)(ws + WS_PROJ);
    bf16* mix = (bf16*)(ws + WS_MIX); const float* sinks = (const float*)A.in[I_SINKS];
    const int* pos = (const int*)A.in[I_POS]; const float* qn = (const float*)A.in[I_QNORM]; const float* kn = (const float*)A.in[I_KNORM];
    constexpr int KST = 144, VST = 520;
    LAS unsigned char* Kl = lds; LAS unsigned char* Vt = lds + 256 * KST;
    const int g = wave >> 1, qh = wave & 1, ql = lane & 31, hh = lane >> 5;
    constexpr float LOG2E = 1.4426950408889634f, CS = 0.125f * LOG2E, L2T = 13.287712379549449f / 32.f;
    const int sch = tid & 7;
    float kinv[8], kgn[8];
#pragma unroll
    for (int j = 0; j < 8; ++j) { kinv[j] = __builtin_amdgcn_exp2f(-(float)((sch & 3) * 8 + j) * L2T); kgn[j] = kn[sch * 8 + j]; }
    float qinv[2][8];
#pragma unroll
    for (int ks = 0; ks < 2; ++ks)
#pragma unroll
        for (int j = 0; j < 8; ++j) qinv[ks][j] = __builtin_amdgcn_exp2f(-(float)(ks * 16 + hh * 8 + j) * L2T);
    for (int u = blk; u < NB * 2 * (SEQ / 128); u += nblk) {
        const int n = u & 63, kvh = (u >> 6) & 1, b = u >> 7;
        const int tb = b * SEQ + n * 128;
        __syncthreads();
#pragma unroll
        for (int it = 0; it < 4; ++it) { const int idx = tid + it * NTHR, key = idx >> 3, ch = idx & 7; int tk = tb - 128 + key; if (tk < b * SEQ) tk = b * SEQ;
            const v4u kv = *(const v4u*)(proj + (size_t)tk * NPROJ + PC_SK + kvh * 64 + ch * 8);
            const v4u vv = *(const v4u*)(proj + (size_t)tk * NPROJ + PC_SV + kvh * 64 + ch * 8);
            const float pf = (float)pos[tk];
            float x[8] = { __builtin_bit_cast(float, kv.x << 16), __builtin_bit_cast(float, kv.x & 0xffff0000u), __builtin_bit_cast(float, kv.y << 16), __builtin_bit_cast(float, kv.y & 0xffff0000u),
                           __builtin_bit_cast(float, kv.z << 16), __builtin_bit_cast(float, kv.z & 0xffff0000u), __builtin_bit_cast(float, kv.w << 16), __builtin_bit_cast(float, kv.w & 0xffff0000u) };
            float ss = 0.f;
#pragma unroll
            for (int j = 0; j < 8; ++j) ss += x[j] * x[j];
            ss += __shfl_xor(ss, 1); ss += __shfl_xor(ss, 2); ss += __shfl_xor(ss, 4);
            const float rn = 1.f / sqrtf(ss * (1.f / 64.f) + EPS);
            float o[8];
#pragma unroll
            for (int j = 0; j < 8; ++j) { const float xn = x[j] * rn * kgn[j]; const float pr = __shfl_xor(xn, 4); float sn, cs; fast_sincos(pf * kinv[j], sn, cs);
                o[j] = (ch < 4) ? xn * cs - pr * sn : pr * sn + xn * cs; }
            v4u ko; ko.x = cvtpk(o[0], o[1]); ko.y = cvtpk(o[2], o[3]); ko.z = cvtpk(o[4], o[5]); ko.w = cvtpk(o[6], o[7]);
            *(LAS v4u*)(Kl + key * KST + ch * 16) = ko;
            LAS unsigned short* vp = (LAS unsigned short*)(Vt + (ch * 8) * VST + key * 2);
            vp[0 * (VST / 2)] = (unsigned short)(vv.x & 0xffffu); vp[1 * (VST / 2)] = (unsigned short)(vv.x >> 16);
            vp[2 * (VST / 2)] = (unsigned short)(vv.y & 0xffffu); vp[3 * (VST / 2)] = (unsigned short)(vv.y >> 16);
            vp[4 * (VST / 2)] = (unsigned short)(vv.z & 0xffffu); vp[5 * (VST / 2)] = (unsigned short)(vv.z >> 16);
            vp[6 * (VST / 2)] = (unsigned short)(vv.w & 0xffffu); vp[7 * (VST / 2)] = (unsigned short)(vv.w >> 16); }
        __syncthreads();
        const int hq = kvh * 4 + g; const float sinkl = sinks[hq] * LOG2E;
#pragma unroll 1
        for (int qt = 0; qt < 2; ++qt) {
            const int i0 = qh * 64 + qt * 32, iq = i0 + ql;
            const size_t tq = (size_t)(tb + iq);
            bf16x8_t qf[4];
            {   float xq[4][8]; float ss = 0.f;
#pragma unroll
                for (int ks = 0; ks < 4; ++ks) { const v4u r = *(const v4u*)(proj + tq * NPROJ + PC_SQ + hq * 64 + ks * 16 + hh * 8);
                    xq[ks][0] = __builtin_bit_cast(float, r.x << 16); xq[ks][1] = __builtin_bit_cast(float, r.x & 0xffff0000u); xq[ks][2] = __builtin_bit_cast(float, r.y << 16); xq[ks][3] = __builtin_bit_cast(float, r.y & 0xffff0000u);
                    xq[ks][4] = __builtin_bit_cast(float, r.z << 16); xq[ks][5] = __builtin_bit_cast(float, r.z & 0xffff0000u); xq[ks][6] = __builtin_bit_cast(float, r.w << 16); xq[ks][7] = __builtin_bit_cast(float, r.w & 0xffff0000u);
#pragma unroll
                    for (int j = 0; j < 8; ++j) ss += xq[ks][j] * xq[ks][j]; }
                ss += __shfl_xor(ss, 32);
                const float rn = 1.f / sqrtf(ss * (1.f / 64.f) + EPS); const float pf = (float)pos[tq];
#pragma unroll
                for (int ks = 0; ks < 4; ++ks)
#pragma unroll
                    for (int j = 0; j < 8; ++j) xq[ks][j] *= rn * qn[ks * 16 + hh * 8 + j];
#pragma unroll
                for (int ks = 0; ks < 2; ++ks)
#pragma unroll
                    for (int j = 0; j < 8; ++j) { float sn, cs; fast_sincos(pf * qinv[ks][j], sn, cs); const float x1 = xq[ks][j], x2 = xq[ks + 2][j];
                        xq[ks][j] = x1 * cs - x2 * sn; xq[ks + 2][j] = x1 * sn + x2 * cs; }
#pragma unroll
                for (int ks = 0; ks < 4; ++ks) { union { bf16x8_t v; unsigned u[4]; } p; p.u[0] = cvtpk(xq[ks][0], xq[ks][1]); p.u[1] = cvtpk(xq[ks][2], xq[ks][3]); p.u[2] = cvtpk(xq[ks][4], xq[ks][5]); p.u[3] = cvtpk(xq[ks][6], xq[ks][7]); qf[ks] = p.v; }
            }
            f32x16 sc[5];
#pragma unroll
            for (int kt = 0; kt < 5; ++kt) { f32x16 acc;
#pragma unroll
                for (int r = 0; r < 16; ++r) acc[r] = 0.f;
#pragma unroll
                for (int ks = 0; ks < 4; ++ks) { const bf16x8_t kf = *(const LAS bf16x8_t*)(Kl + (i0 + 32 * kt + ql) * KST + (ks * 16 + hh * 8) * 2);
                    acc = __builtin_amdgcn_mfma_f32_32x32x16_bf16(kf, qf[ks], acc, 0, 0, 0); }
                sc[kt] = acc; }
            float mloc = -3.0e38f;
#pragma unroll
            for (int kt = 0; kt < 5; ++kt)
#pragma unroll
                for (int r = 0; r < 16; ++r) { const int j = i0 + 32 * kt + (r & 3) + 8 * (r >> 2) + 4 * hh;
                    const bool valid = (j > iq) && (j <= iq + 128) && (n > 0 || j >= 128);
                    const float sv = valid ? sc[kt][r] * CS : -1.0e30f; sc[kt][r] = sv; mloc = fmaxf(mloc, sv); }
            float mx = fmaxf(mloc, __shfl_xor(mloc, 32)); mx = fmaxf(mx, sinkl);
            float lsum = 0.f;
#pragma unroll
            for (int kt = 0; kt < 5; ++kt)
#pragma unroll
                for (int r = 0; r < 16; ++r) { const float p = __builtin_amdgcn_exp2f(sc[kt][r] - mx); sc[kt][r] = p; lsum += p; }
            lsum += __shfl_xor(lsum, 32); lsum += __builtin_amdgcn_exp2f(sinkl - mx);
            f32x16 o0, o1;
#pragma unroll
            for (int r = 0; r < 16; ++r) { o0[r] = 0.f; o1[r] = 0.f; }
#pragma unroll
            for (int kt = 0; kt < 5; ++kt)
#pragma unroll
                for (int s2 = 0; s2 < 2; ++s2) {
                    union { bf16x8_t v; unsigned u[4]; } pf;
#pragma unroll
                    for (int p = 0; p < 4; ++p) pf.u[p] = cvtpk(sc[kt][8 * s2 + 2 * p], sc[kt][8 * s2 + 2 * p + 1]);
                    const int jb = i0 + 32 * kt + 16 * s2 + 4 * hh;
                    union { bf16x8_t v; v2u u[2]; } v0, v1;
                    const LAS unsigned char* r0 = Vt + ql * VST + jb * 2; const LAS unsigned char* r1 = Vt + (32 + ql) * VST + jb * 2;
                    v0.u[0] = *(const LAS v2u*)(r0); v0.u[1] = *(const LAS v2u*)(r0 + 16);
                    v1.u[0] = *(const LAS v2u*)(r1); v1.u[1] = *(const LAS v2u*)(r1 + 16);
                    o0 = __builtin_amdgcn_mfma_f32_32x32x16_bf16(v0.v, pf.v, o0, 0, 0, 0);
                    o1 = __builtin_amdgcn_mfma_f32_32x32x16_bf16(v1.v, pf.v, o1, 0, 0, 0);
                }
            const float il = 1.f / lsum;
            bf16* op = mix + tq * DM + 512 + hq * 64 + 4 * hh;
#pragma unroll
            for (int rq = 0; rq < 4; ++rq) {
                v2u w0; w0.x = cvtpk(o0[4 * rq] * il, o0[4 * rq + 1] * il); w0.y = cvtpk(o0[4 * rq + 2] * il, o0[4 * rq + 3] * il);
                *(v2u*)(op + 8 * rq) = w0;
                v2u w1; w1.x = cvtpk(o1[4 * rq] * il, o1[4 * rq + 1] * il); w1.y = cvtpk(o1[4 * rq + 2] * il, o1[4 * rq + 3] * il);
                *(v2u*)(op + 32 + 8 * rq) = w1; }
        }
    }
}

__device__ __forceinline__ int frag_a_idx(int row, int col) { const int mt = row >> 4, l15 = row & 15, ks = col >> 5, x = col & 31, jh = x >> 4, g4 = (x >> 2) & 3, jl = x & 3; return ((mt * 2 + ks) * 64 + g4 * 16 + l15) * 8 + 4 * jh + jl; }
__device__ __forceinline__ int frag_c_idx(int row, int col) { const int w = col >> 4, l15 = col & 15, mt = row >> 4, y = row & 15, g4 = y >> 2, i = y & 3; return ((w * 64 + g4 * 16 + l15) * 4 + mt) * 4 + i; }
__device__ __forceinline__ void gdn_g1_naive(const Args& A, LAS float* L, int tid) {
    unsigned char* ws = A.ws;
    const bf16* proj = (const bf16*)(ws + WS_PROJ); const float* ab = (const float*)(ws + WS_AB);
    bf16* AP = (bf16*)(ws + WS_GAP); bf16* BP = (bf16*)(ws + WS_GBP); bf16* QP = (bf16*)(ws + WS_GQP); bf16* OP = (bf16*)(ws + WS_GOP); float* GL = (float*)(ws + WS_GGL);
    const float* convw = (const float*)A.in[I_CONVW];
    constexpr int LD = 65, AR = 64 * LD;
    LAS float* q = L; LAS float* k = q + AR; LAS float* v = k + AR; LAS float* Mm = v + AR; LAS float* At = Mm + AR; LAS float* w = At + AR;
    LAS float* Gc = w + AR; LAS float* beta = Gc + 64;
    const int i8 = tid >> 3, e0 = (tid & 7) * 8;
    for (int cid = blockIdx.x; cid < NB * 8 * 128; cid += gridDim.x) {
        const int n = cid & 127, bh = cid >> 7, b = bh >> 3, h = bh & 7;
        const float Ah = expf(((const float*)A.in[I_ALOG])[h]), dtb = ((const float*)A.in[I_DTB])[h];
        const int t0 = b * SEQ + n * 64;
        __syncthreads();
        for (int idx = tid; idx < 3 * 4096; idx += NTHR) {
            const int part = idx >> 12, rem = idx & 4095, i = rem >> 6, d = rem & 63, c = part * 512 + h * 64 + d;
            float y = 0.f;
#pragma unroll
            for (int j = 0; j < 4; ++j) { const int s = n * 64 + i - 3 + j; if (s >= 0) y += convw[j * 1536 + c] * bf2f(proj[(size_t)(b * SEQ + s) * NPROJ + c]); }
            y = y / (1.f + __expf(-y));
            (part == 0 ? q : (part == 1 ? k : v))[i * LD + d] = y;
        }
        if (tid < 64) { const float a = ab[(size_t)(t0 + tid) * 16 + h], bb = ab[(size_t)(t0 + tid) * 16 + 8 + h]; const float xx = a + dtb;
            const float sp = xx > 20.f ? xx : log1pf(expf(xx)); Gc[tid] = -Ah * sp; beta[tid] = 1.f / (1.f + __expf(-bb)); }
        __syncthreads();
        if (tid < 128) { LAS float* arr = tid < 64 ? q : k; const int i = tid & 63; float ss = 0.f;
            for (int d = 0; d < 64; ++d) ss += arr[i * LD + d] * arr[i * LD + d];
            const float r = (1.f / sqrtf(ss + EPS)) * (tid < 64 ? 0.125f : 1.f);
            for (int d = 0; d < 64; ++d) arr[i * LD + d] *= r; }
        if (tid == 128) { float run = 0.f; for (int i = 0; i < 64; ++i) { run += Gc[i]; Gc[i] = run; } }
        __syncthreads();
        {   const int i = i8;
            for (int jj = 0; jj < 8; ++jj) { const int j = e0 + jj; float dq = 0.f, dk = 0.f;
_Pragma("unroll 2") for (int d = 0; d < 64; ++d) { const float kj = k[j * LD + d]; dq += q[i * LD + d] * kj; dk += k[i * LD + d] * kj; }
                const float dec = (i >= j) ? __expf(Gc[i] - Gc[j]) : 0.f;
                At[i * LD + j] = dq * dec; Mm[i * LD + j] = (i > j) ? dk * beta[i] * dec : 0.f; }
        }
        __syncthreads();
        for (int idx = tid; idx < 4096; idx += NTHR) { const int i = idx >> 6, d = idx & 63; v[i * LD + d] *= beta[i]; w[i * LD + d] = k[i * LD + d] * beta[i] * __expf(Gc[i]); }
        __syncthreads();
        if (tid < 128) { LAS float* arr = tid < 64 ? v : w; const int c = tid & 63;
            _Pragma("unroll 1") for (int i = 1; i < 64; ++i) { float a = arr[i * LD + c]; _Pragma("unroll 4") for (int j = 0; j < i; ++j) a -= Mm[i * LD + j] * arr[j * LD + c]; arr[i * LD + c] = a; } }
        __syncthreads();
        const float gl = Gc[63];
        const size_t cb = (size_t)cid * 4096;
        {
            const int d = i8; float a[8], bq[8];
#pragma unroll
            for (int ee = 0; ee < 8; ++ee) { a[ee] = 0.f; bq[ee] = 0.f; }
_Pragma("unroll 2")
            for (int c = 0; c < 64; ++c) { const float kd = k[c * LD + d] * __expf(gl - Gc[c]);
#pragma unroll
                for (int ee = 0; ee < 8; ++ee) { a[ee] -= kd * w[c * LD + e0 + ee]; bq[ee] += kd * v[c * LD + e0 + ee]; } }
#pragma unroll
            for (int ee = 0; ee < 8; ++ee) { const int dp = e0 + ee; AP[cb + frag_a_idx(d, dp)] = (bf16)f2bf(a[ee]); BP[cb + frag_c_idx(d, dp)] = (bf16)f2bf(bq[ee]); }
        }
        {
            const int c = i8; float a[8], bq[8]; const float eg = __expf(Gc[c]);
#pragma unroll
            for (int ee = 0; ee < 8; ++ee) { a[ee] = eg * q[c * LD + e0 + ee]; bq[ee] = 0.f; }
_Pragma("unroll 2")
            for (int s2 = 0; s2 <= c; ++s2) { const float av = At[c * LD + s2];
#pragma unroll
                for (int ee = 0; ee < 8; ++ee) { a[ee] -= av * w[s2 * LD + e0 + ee]; bq[ee] += av * v[s2 * LD + e0 + ee]; } }
#pragma unroll
            for (int ee = 0; ee < 8; ++ee) { const int dp = e0 + ee; QP[cb + frag_a_idx(c, dp)] = (bf16)f2bf(a[ee]); OP[cb + frag_c_idx(c, dp)] = (bf16)f2bf(bq[ee]); }
        }
        if (tid == 0) GL[cid] = __expf(gl);
    }
}
__device__ __forceinline__ float wave_incl_scan_f(float v, int lane) {
#pragma unroll
    for (int o = 1; o < 64; o <<= 1) { const float t = __shfl_up(v, o); if (lane >= o) v += t; }
    return v;
}
__device__ __forceinline__ v2u pack4(f32x4 v) { v2u r; r.x = cvtpk(v.x, v.y); r.y = cvtpk(v.z, v.w); return r; }
__device__ __forceinline__ bf16x8_t mk8(v2u lo, v2u hi) { union { bf16x8_t v; unsigned u[4]; } x; x.u[0] = lo.x; x.u[1] = lo.y; x.u[2] = hi.x; x.u[3] = hi.y; return x.v; }
template <int SM>
__device__ __forceinline__ void gdn_g1_mfma(const Args& A, LAS unsigned char* lds, int tid, int lane, int wave) {
    unsigned char* ws = A.ws;
    const bf16* proj = (const bf16*)(ws + WS_PROJ); const float* ab = (const float*)(ws + WS_AB);
    bf16* AP = (bf16*)(ws + WS_GAP); bf16* BP = (bf16*)(ws + WS_GBP); bf16* QP = (bf16*)(ws + WS_GQP); bf16* OP = (bf16*)(ws + WS_GOP); float* GL = (float*)(ws + WS_GGL);
    const float* convw = (const float*)A.in[I_CONVW];
    constexpr int KST = 144, RST = 68;
    LAS unsigned char* Kr = lds; LAS unsigned char* Qr = lds + 9216; LAS unsigned char* kdT = lds + 18432; LAS unsigned char* Mm = lds + 27648; LAS unsigned char* At = lds + 36864;
    LAS float* Rt = (LAS float*)(lds + 46080);
    LAS float* Md = (LAS float*)(lds + 80896);
    LAS unsigned char* Tl = lds + 86016;
    LAS float* Gs = (LAS float*)(lds + 88064); LAS float* Bs = Gs + 64;
    const int l15 = lane & 15, g4 = lane >> 4;
    const v2u zero2 = {0u, 0u};
    for (int cid = blockIdx.x; cid < NB * 8 * 128; cid += gridDim.x) {
        const int n = cid & 127, bh = cid >> 7, b = bh >> 3, h = bh & 7;
        const int t0 = b * SEQ + n * 64;
        const size_t cb = (size_t)cid * 4096;
        __syncthreads();
        if (wave == 0) {
            const float Ah = __expf(((const float*)A.in[I_ALOG])[h]), dtb = ((const float*)A.in[I_DTB])[h];
            const float a = ab[(size_t)(t0 + lane) * 16 + h], bb = ab[(size_t)(t0 + lane) * 16 + 8 + h]; const float xx = a + dtb;
            const float sp = xx > 20.f ? xx : log1pf(__expf(xx));
            const float G = wave_incl_scan_f(-Ah * sp, lane);
            Gs[lane] = G; Bs[lane] = 1.f / (1.f + __expf(-bb));
            if ((SM & 16) && lane == 63) GL[cid] = __expf(G);
        }
        __syncthreads();
        {
            const int i = tid >> 3, dg = tid & 7, d0 = dg * 8;
            const float Gi = Gs[i], bi = Bs[i], gl = Gs[63];
            const float eG = __expf(Gi), ekd = __expf(gl - Gi);
            float y[3][8];
#pragma unroll
            for (int part = 0; part < 3; ++part) {
                const int ch = part * 512 + h * 64 + d0;
                float acc[8];
#pragma unroll
                for (int e = 0; e < 8; ++e) acc[e] = 0.f;
#pragma unroll
                for (int j = 0; j < 4; ++j) { const int s = n * 64 + i - 3 + j;
                    const f32x4 w0 = *(const f32x4*)(convw + j * 1536 + ch), w1 = *(const f32x4*)(convw + j * 1536 + ch + 4);
                    v4u x = {0u, 0u, 0u, 0u}; if (s >= 0) x = *(const v4u*)(proj + (size_t)(b * SEQ + s) * NPROJ + ch);
                    acc[0] += w0.x * __builtin_bit_cast(float, x.x << 16); acc[1] += w0.y * __builtin_bit_cast(float, x.x & 0xffff0000u);
                    acc[2] += w0.z * __builtin_bit_cast(float, x.y << 16); acc[3] += w0.w * __builtin_bit_cast(float, x.y & 0xffff0000u);
                    acc[4] += w1.x * __builtin_bit_cast(float, x.z << 16); acc[5] += w1.y * __builtin_bit_cast(float, x.z & 0xffff0000u);
                    acc[6] += w1.z * __builtin_bit_cast(float, x.w << 16); acc[7] += w1.w * __builtin_bit_cast(float, x.w & 0xffff0000u); }
#pragma unroll
                for (int e = 0; e < 8; ++e) y[part][e] = siluf(acc[e]);
            }
            float sq = 0.f, sk = 0.f;
#pragma unroll
            for (int e = 0; e < 8; ++e) { sq += y[0][e] * y[0][e]; sk += y[1][e] * y[1][e]; }
            sq += __shfl_xor(sq, 1); sq += __shfl_xor(sq, 2); sq += __shfl_xor(sq, 4);
            sk += __shfl_xor(sk, 1); sk += __shfl_xor(sk, 2); sk += __shfl_xor(sk, 4);
            const float rq = (1.f / sqrtf(sq + EPS)) * 0.125f, rk = 1.f / sqrtf(sk + EPS);
#pragma unroll
            for (int e = 0; e < 8; ++e) { y[0][e] *= rq; y[1][e] *= rk; }
            v4u pq, pk;
            pq.x = cvtpk(y[0][0], y[0][1]); pq.y = cvtpk(y[0][2], y[0][3]); pq.z = cvtpk(y[0][4], y[0][5]); pq.w = cvtpk(y[0][6], y[0][7]);
            pk.x = cvtpk(y[1][0], y[1][1]); pk.y = cvtpk(y[1][2], y[1][3]); pk.z = cvtpk(y[1][4], y[1][5]); pk.w = cvtpk(y[1][6], y[1][7]);
            *(LAS v4u*)(Qr + i * KST + d0 * 2) = pq; *(LAS v4u*)(Kr + i * KST + d0 * 2) = pk;
#pragma unroll
            for (int e = 0; e < 8; ++e) { *(LAS unsigned short*)(kdT + (d0 + e) * KST + i * 2) = (unsigned short)f2bf(y[1][e] * ekd);
                Rt[(d0 + e) * RST + i] = y[1][e] * bi * eG; Rt[(64 + d0 + e) * RST + i] = y[2][e] * bi; }
        }
        __syncthreads();
        {
            const int ct = wave & 3, which = wave >> 2;
            const LAS unsigned char* Xb = which ? Kr : Qr;
            const int c = 16 * ct + l15; const float Gc = Gs[c], bc = Bs[c];
            bf16x8_t bfr[2];
#pragma unroll
            for (int ks = 0; ks < 2; ++ks) bfr[ks] = *(const LAS bf16x8_t*)(Xb + c * KST + (32 * ks + 8 * g4) * 2);
#pragma unroll
            for (int st = 0; st < 4; ++st) {
                f32x4 acc = {0.f, 0.f, 0.f, 0.f};
#pragma unroll
                for (int ks = 0; ks < 2; ++ks) { const bf16x8_t af = *(const LAS bf16x8_t*)(Kr + (16 * st + l15) * KST + (32 * ks + 8 * g4) * 2);
                    acc = __builtin_amdgcn_mfma_f32_16x16x32_bf16(af, bfr[ks], acc, 0, 0, 0); }
                f32x4 vals;
#pragma unroll
                for (int r = 0; r < 4; ++r) { const int s2 = 16 * st + 4 * g4 + r; const float dec = __expf(fminf(Gc - Gs[s2], 0.f));
                    vals[r] = which ? ((s2 < c) ? -acc[r] * bc * dec : 0.f) : ((s2 <= c) ? acc[r] * dec : 0.f); }
                *(LAS v2u*)((which ? Mm : At) + c * KST + (16 * st + 4 * g4) * 2) = pack4(vals);
                if (which && st == ct) *(LAS f32x4*)(Md + (ct * 16 + l15) * 20 + 4 * g4) = -vals;
            }
        }
        __syncthreads();
        if (wave == 0) {
            float t[16];
#pragma unroll
            for (int r = 0; r < 16; ++r) { float acc = (r == l15) ? 1.f : 0.f;
#pragma unroll
                for (int s4 = 0; s4 < r; s4 += 4) { const f32x4 m = *(const LAS f32x4*)(Md + (g4 * 16 + r) * 20 + s4);
                    acc -= m.x * t[s4]; if (s4 + 1 < r) acc -= m.y * t[s4 + 1]; if (s4 + 2 < r) acc -= m.z * t[s4 + 2]; if (s4 + 3 < r) acc -= m.w * t[s4 + 3]; }
                t[r] = acc; }
#pragma unroll
            for (int r = 0; r < 16; ++r) *(LAS unsigned short*)(Tl + ((g4 * 16 + r) * 16 + l15) * 2) = (unsigned short)f2bf(t[r]);
        }
        __syncthreads();
        f32x4 wt[4];
        {   const int colw = 16 * wave + l15;
#pragma unroll
            for (int i = 0; i < 4; ++i) {
                f32x4 acc = *(const LAS f32x4*)(Rt + colw * RST + 16 * i + 4 * g4);
                const LAS unsigned char* mrow = Mm + (16 * i + l15) * KST + (4 * g4) * 2;
                if (i >= 1) { const v2u alo = *(const LAS v2u*)(mrow), ahi = (i >= 2) ? *(const LAS v2u*)(mrow + 32) : zero2;
                    acc = __builtin_amdgcn_mfma_f32_16x16x32_bf16(mk8(alo, ahi), mk8(pack4(wt[0]), (i >= 2) ? pack4(wt[1]) : zero2), acc, 0, 0, 0); }
                if (i == 3) { const v2u alo = *(const LAS v2u*)(mrow + 64);
                    acc = __builtin_amdgcn_mfma_f32_16x16x32_bf16(mk8(alo, zero2), mk8(pack4(wt[2]), zero2), acc, 0, 0, 0); }
                const v2u tlo = *(const LAS v2u*)(Tl + ((i * 16 + l15) * 16 + 4 * g4) * 2);
                wt[i] = __builtin_amdgcn_mfma_f32_16x16x32_bf16(mk8(tlo, zero2), mk8(pack4(acc), zero2), (f32x4){0.f, 0.f, 0.f, 0.f}, 0, 0, 0);
            }
        }
        if (wave < 4) {
            bf16x8_t wn[2];
#pragma unroll
            for (int ks = 0; ks < 2; ++ks) { v2u lo = pack4(wt[2 * ks]), hi = pack4(wt[2 * ks + 1]); lo.x ^= 0x80008000u; lo.y ^= 0x80008000u; hi.x ^= 0x80008000u; hi.y ^= 0x80008000u; wn[ks] = mk8(lo, hi); }
#pragma unroll
            for (int nt = 0; nt < 4; ++nt) { const int x = 16 * nt + l15;
                f32x4 ca = {0.f, 0.f, 0.f, 0.f};
                const v2u qraw = *(const LAS v2u*)(Qr + x * KST + (16 * wave + 4 * g4) * 2); const float eg = __expf(Gs[x]);
                f32x4 cq; cq.x = eg * __builtin_bit_cast(float, qraw.x << 16); cq.y = eg * __builtin_bit_cast(float, qraw.x & 0xffff0000u); cq.z = eg * __builtin_bit_cast(float, qraw.y << 16); cq.w = eg * __builtin_bit_cast(float, qraw.y & 0xffff0000u);
#pragma unroll
                for (int ks = 0; ks < 2; ++ks) { const LAS unsigned char* kp = kdT + x * KST + (32 * ks + 4 * g4) * 2; const LAS unsigned char* ap = At + x * KST + (32 * ks + 4 * g4) * 2;
                    ca = __builtin_amdgcn_mfma_f32_16x16x32_bf16(wn[ks], mk8(*(const LAS v2u*)(kp), *(const LAS v2u*)(kp + 32)), ca, 0, 0, 0);
                    cq = __builtin_amdgcn_mfma_f32_16x16x32_bf16(wn[ks], mk8(*(const LAS v2u*)(ap), *(const LAS v2u*)(ap + 32)), cq, 0, 0, 0); }
                const size_t off = cb + (size_t)((nt * 2 + (wave >> 1)) * 64 + lane) * 8 + 4 * (wave & 1);
                if (SM & 1) *(v2u*)(AP + off) = pack4(ca); if (SM & 2) *(v2u*)(QP + off) = pack4(cq);
            }
        } else {
            bf16x8_t ub[2];
#pragma unroll
            for (int ks = 0; ks < 2; ++ks) ub[ks] = mk8(pack4(wt[2 * ks]), pack4(wt[2 * ks + 1]));
            unsigned bo[8], oo[8];
#pragma unroll
            for (int mt = 0; mt < 4; ++mt) { const int x = 16 * mt + l15;
                f32x4 cbv = {0.f, 0.f, 0.f, 0.f}, co = {0.f, 0.f, 0.f, 0.f};
#pragma unroll
                for (int ks = 0; ks < 2; ++ks) { const LAS unsigned char* kp = kdT + x * KST + (32 * ks + 4 * g4) * 2; const LAS unsigned char* ap = At + x * KST + (32 * ks + 4 * g4) * 2;
                    cbv = __builtin_amdgcn_mfma_f32_16x16x32_bf16(mk8(*(const LAS v2u*)(kp), *(const LAS v2u*)(kp + 32)), ub[ks], cbv, 0, 0, 0);
                    co = __builtin_amdgcn_mfma_f32_16x16x32_bf16(mk8(*(const LAS v2u*)(ap), *(const LAS v2u*)(ap + 32)), ub[ks], co, 0, 0, 0); }
                const v2u pb = pack4(cbv), po = pack4(co); bo[2 * mt] = pb.x; bo[2 * mt + 1] = pb.y; oo[2 * mt] = po.x; oo[2 * mt + 1] = po.y; }
            const size_t off = cb + (size_t)((wave - 4) * 64 + lane) * 16;
            if (SM & 4) { *(v4u*)(BP + off) = (v4u){bo[0], bo[1], bo[2], bo[3]}; *(v4u*)(BP + off + 8) = (v4u){bo[4], bo[5], bo[6], bo[7]}; }
            if (SM & 8) { *(v4u*)(OP + off) = (v4u){oo[0], oo[1], oo[2], oo[3]}; *(v4u*)(OP + off + 8) = (v4u){oo[4], oo[5], oo[6], oo[7]}; }
        }
    }
}

__device__ __forceinline__ f32x4 g2_unpack(const v4u (&p)[2], int mt) {
    const unsigned d0 = mt == 0 ? p[0].x : mt == 1 ? p[0].z : mt == 2 ? p[1].x : p[1].z, d1 = mt == 0 ? p[0].y : mt == 1 ? p[0].w : mt == 2 ? p[1].y : p[1].w;
    f32x4 r; r.x = __builtin_bit_cast(float, d0 << 16); r.y = __builtin_bit_cast(float, d0 & 0xffff0000u); r.z = __builtin_bit_cast(float, d1 << 16); r.w = __builtin_bit_cast(float, d1 & 0xffff0000u); return r;
}
__device__ __forceinline__ void gdn_scan(const Args& A, int bh, LAS unsigned char* lds, int tid, int lane, int wave) {
    unsigned char* ws = A.ws;
    const char* AP = (const char*)(ws + WS_GAP); const char* BP = (const char*)(ws + WS_GBP); const float* GL = (const float*)(ws + WS_GGL); bf16* SF = (bf16*)(ws + WS_GSF);
    constexpr int SLOT = 16384, NSL = 8, EGL_OFF = NSL * SLOT;
    LAS float* eglt = (LAS float*)(lds + EGL_OFF);
    __syncthreads();
    { int tl = tid; asm volatile("" : "+v"(tl));
      if (tl < 128) eglt[tl] = GL[bh * 128 + tl]; }
    if (wave < 4) {
        f32x4 sC[4]; bf16x8_t sB[2];
#pragma unroll
        for (int mt = 0; mt < 4; ++mt) sC[mt] = (f32x4){0.f, 0.f, 0.f, 0.f};
#pragma unroll
        for (int ks = 0; ks < 2; ++ks)
#pragma unroll
            for (int j = 0; j < 8; ++j) sB[ks][j] = 0;
        asm volatile("s_waitcnt vmcnt(0) lgkmcnt(0)" ::: "memory");
        __builtin_amdgcn_s_barrier();
#pragma unroll 1
        for (int n = 0; n < SEQ / 64; ++n) {
            const LAS unsigned char* slot = lds + (n & (NSL - 1)) * SLOT;
            bf16x8_t fa[4][2]; v4u fb[2];
#pragma unroll
            for (int mt = 0; mt < 4; ++mt)
#pragma unroll
                for (int ks = 0; ks < 2; ++ks) fa[mt][ks] = *(const LAS bf16x8_t*)(slot + ((mt * 2 + ks) * 64 + lane) * 16);
            fb[0] = *(const LAS v4u*)(slot + 8192 + (wave * 64 + lane) * 32); fb[1] = *(const LAS v4u*)(slot + 8192 + (wave * 64 + lane) * 32 + 16);
            const float egl = eglt[n];
            bf16* sf = SF + (size_t)(bh * 128 + n) * 4096 + (size_t)((wave * 2) * 64 + lane) * 8;
            *(bf16x8_t*)(sf) = sB[0]; *(bf16x8_t*)(sf + 512) = sB[1];
            f32x4 sacc[4];
#pragma unroll
            for (int mt = 0; mt < 4; ++mt) sacc[mt] = sC[mt] * egl + g2_unpack(fb, mt);
#pragma unroll
            for (int mt = 0; mt < 4; ++mt)
#pragma unroll
                for (int ks = 0; ks < 2; ++ks) sacc[mt] = __builtin_amdgcn_mfma_f32_16x16x32_bf16(fa[mt][ks], sB[ks], sacc[mt], 0, 0, 0);
#pragma unroll
            for (int mt = 0; mt < 4; ++mt) sC[mt] = sacc[mt];
#pragma unroll
            for (int ks = 0; ks < 2; ++ks) { union { bf16x8_t v; unsigned u[4]; } pk_;
                pk_.u[0] = cvtpk(sC[2 * ks].x, sC[2 * ks].y); pk_.u[1] = cvtpk(sC[2 * ks].z, sC[2 * ks].w); pk_.u[2] = cvtpk(sC[2 * ks + 1].x, sC[2 * ks + 1].y); pk_.u[3] = cvtpk(sC[2 * ks + 1].z, sC[2 * ks + 1].w); sB[ks] = pk_.v; }
            asm volatile("s_waitcnt lgkmcnt(0)" ::: "memory");
            __builtin_amdgcn_s_barrier();
        }
    } else {
        const int f = wave - 4;
        const unsigned lin = (unsigned)(2 * f) * 1024u + (unsigned)lane * 16u;
#define G2_DMA(nn) do { const int n_ = (nn) < SEQ / 64 ? (nn) : SEQ / 64 - 1; const size_t cb_ = (size_t)(bh * 128 + n_) * 8192; LAS unsigned char* d_ = lds + ((nn) & (NSL - 1)) * SLOT + (2 * f) * 1024; \
        __builtin_amdgcn_global_load_lds((const unsigned*)(AP + cb_ + lin), (LAS unsigned*)(d_), 16, 0, 0); __builtin_amdgcn_global_load_lds((const unsigned*)(AP + cb_ + lin + 1024), (LAS unsigned*)(d_ + 1024), 16, 0, 0); \
        __builtin_amdgcn_global_load_lds((const unsigned*)(BP + cb_ + lin), (LAS unsigned*)(d_ + 8192), 16, 0, 0); __builtin_amdgcn_global_load_lds((const unsigned*)(BP + cb_ + lin + 1024), (LAS unsigned*)(d_ + 8192 + 1024), 16, 0, 0); } while (0)
        asm volatile("s_waitcnt vmcnt(0) lgkmcnt(0)" ::: "memory");
        G2_DMA(0); G2_DMA(1); G2_DMA(2); G2_DMA(3); G2_DMA(4); G2_DMA(5); G2_DMA(6);
        asm volatile("s_waitcnt vmcnt(24)" ::: "memory");
        __builtin_amdgcn_s_barrier();
#pragma unroll 1
        for (int n = 0; n < SEQ / 64; ++n) {
            G2_DMA(n + 7);
            asm volatile("s_waitcnt vmcnt(24)" ::: "memory");
            __builtin_amdgcn_s_barrier();
        }
#undef G2_DMA
        asm volatile("s_waitcnt vmcnt(0)" ::: "memory");
    }
    __syncthreads();
}
__device__ __forceinline__ void gdn_out(const Args& A, LAS unsigned char* lds, int lane, int wave) {
    unsigned char* ws = A.ws;
    const bf16* proj = (const bf16*)(ws + WS_PROJ); bf16* mix = (bf16*)(ws + WS_MIX);
    const bf16* QP = (const bf16*)(ws + WS_GQP); const bf16* OP = (const bf16*)(ws + WS_GOP); const bf16* SF = (const bf16*)(ws + WS_GSF);
    const float* onorm = (const float*)A.in[I_GNORM];
    const int mt = wave & 3, l15 = lane & 15, g4 = lane >> 4, rr = lane >> 2, q4 = lane & 3;
    constexpr int OST = 68;
    LAS float* ot = (LAS float*)(lds + wave * 4608);
    float gain[16];
#pragma unroll
    for (int k = 0; k < 16; ++k) gain[k] = onorm[16 * q4 + k];
    for (int cid = blockIdx.x * 2 + (wave >> 2); cid < NB * 8 * 128; cid += gridDim.x * 2) {
        const int n = cid & 127, bh = cid >> 7, b = bh >> 3, h = bh & 7;
        const size_t cb = (size_t)cid * 4096;
        const size_t t = (size_t)b * SEQ + n * 64 + 16 * mt + rr;
        const v4u z0 = *(const v4u*)(proj + t * NPROJ + PC_Z + h * 64 + 16 * q4), z1 = *(const v4u*)(proj + t * NPROJ + PC_Z + h * 64 + 16 * q4 + 8);
        bf16x8_t qa[2], sb[4][2]; v2u oi[4];
#pragma unroll
        for (int ks = 0; ks < 2; ++ks) qa[ks] = *(const bf16x8_t*)(QP + cb + ((mt * 2 + ks) * 64 + lane) * 8);
#pragma unroll
        for (int nt = 0; nt < 4; ++nt) {
#pragma unroll
            for (int ks = 0; ks < 2; ++ks) sb[nt][ks] = *(const bf16x8_t*)(SF + cb + ((nt * 2 + ks) * 64 + lane) * 8);
            oi[nt] = *(const v2u*)(OP + cb + ((nt * 64 + lane) * 4 + mt) * 4); }
#pragma unroll
        for (int nt = 0; nt < 4; ++nt) {
            f32x4 acc; acc.x = __builtin_bit_cast(float, oi[nt].x << 16); acc.y = __builtin_bit_cast(float, oi[nt].x & 0xffff0000u); acc.z = __builtin_bit_cast(float, oi[nt].y << 16); acc.w = __builtin_bit_cast(float, oi[nt].y & 0xffff0000u);
#pragma unroll
            for (int ks = 0; ks < 2; ++ks) acc = __builtin_amdgcn_mfma_f32_16x16x32_bf16(qa[ks], sb[nt][ks], acc, 0, 0, 0);
#pragma unroll
            for (int i = 0; i < 4; ++i) ot[(4 * g4 + i) * OST + 16 * nt + l15] = acc[i];
        }
        LDS_WAIT(); asm volatile("" ::: "memory");
        float o[16]; float ss = 0.f;
#pragma unroll
        for (int k = 0; k < 4; ++k) { const f32x4 v = *(const LAS f32x4*)(ot + rr * OST + 16 * q4 + 4 * k); o[4 * k] = v.x; o[4 * k + 1] = v.y; o[4 * k + 2] = v.z; o[4 * k + 3] = v.w; }
#pragma unroll
        for (int k = 0; k < 16; ++k) ss += o[k] * o[k];
        ss += __shfl_xor(ss, 1); ss += __shfl_xor(ss, 2);
        const float r = 1.f / sqrtf(ss * (1.f / 64.f) + EPS);
        const unsigned zu[8] = {z0.x, z0.y, z0.z, z0.w, z1.x, z1.y, z1.z, z1.w};
        unsigned ou[8];
#pragma unroll
        for (int k = 0; k < 8; ++k) { const float za = __builtin_bit_cast(float, zu[k] << 16), zb = __builtin_bit_cast(float, zu[k] & 0xffff0000u);
            ou[k] = cvtpk(o[2 * k] * r * gain[2 * k] * siluf(za), o[2 * k + 1] * r * gain[2 * k + 1] * siluf(zb)); }
        bf16* op = mix + t * DM + h * 64 + 16 * q4;
        *(v4u*)(op) = (v4u){ou[0], ou[1], ou[2], ou[3]}; *(v4u*)(op + 8) = (v4u){ou[4], ou[5], ou[6], ou[7]};
        LDS_WAIT(); asm volatile("" ::: "memory");
    }
}

template <bool DRY>
__device__ __forceinline__ void norm_route_mfma(const Args& A, const float* X, const float* gain, const float* shift, const float* scale, bf16* H, LAS unsigned char* lds, int lane, int wave) {
    unsigned char* ws = A.ws;
    const int G = gridDim.x, gw = blockIdx.x * NWAVES + wave, NGW = G * NWAVES;
    const int l15 = lane & 15, g4 = lane >> 4;
    LAS float* lgs = (LAS float*)(lds + wave * 4096);
    const bf16* wh = (const bf16*)(ws + WS_WRT); const bf16* wl = wh + 48 * 1024;
    const float* bg = (const float*)A.in[I_BGRP]; const float* br = (const float*)A.in[I_BRT];
    for (int r0 = gw * 16; r0 < TT; r0 += NGW * 16) {
        const int b = r0 / SEQ, row = r0 + l15;
        const float* xr = X + (size_t)row * DM + 8 * g4;
        float ss = 0.f;
#pragma unroll 8
        for (int ks = 0; ks < 32; ++ks) { const f32x4 a = *(const f32x4*)(xr + 32 * ks), c = *(const f32x4*)(xr + 32 * ks + 4);
            ss += (a.x * a.x + a.y * a.y) + (a.z * a.z + a.w * a.w) + (c.x * c.x + c.y * c.y) + (c.z * c.z + c.w * c.w); }
        ss += __shfl_xor(ss, 16); ss += __shfl_xor(ss, 32);
        const float rstd = 1.f / sqrtf(ss * (1.f / DM) + EPS);
        f32x4 acc[3];
#pragma unroll
        for (int nt = 0; nt < 3; ++nt) acc[nt] = (f32x4){0.f, 0.f, 0.f, 0.f};
        const float* gp = gain + 8 * g4; const float* sp = scale + b * 6144 + 8 * g4; const float* hp = shift + b * 6144 + 8 * g4;
        bf16* hrow = H + (size_t)row * DM + 8 * g4;
#pragma unroll 2
        for (int ks = 0; ks < 32; ++ks) {
            float hv[8];
            {   const f32x4 a = *(const f32x4*)(xr + 32 * ks), c = *(const f32x4*)(xr + 32 * ks + 4);
                const f32x4 g0 = *(const f32x4*)(gp + 32 * ks), g1 = *(const f32x4*)(gp + 32 * ks + 4), s0 = *(const f32x4*)(sp + 32 * ks), s1 = *(const f32x4*)(sp + 32 * ks + 4), h0 = *(const f32x4*)(hp + 32 * ks), h1 = *(const f32x4*)(hp + 32 * ks + 4);
                const f32x4 v0 = a * rstd * (g0 * (s0 + 1.0f)) + h0, v1 = c * rstd * (g1 * (s1 + 1.0f)) + h1;
                hv[0] = v0.x; hv[1] = v0.y; hv[2] = v0.z; hv[3] = v0.w; hv[4] = v1.x; hv[5] = v1.y; hv[6] = v1.z; hv[7] = v1.w; }
            unsigned hu[4], lu[4];
#pragma unroll
            for (int p = 0; p < 4; ++p) { hu[p] = cvtpk(hv[2 * p], hv[2 * p + 1]);
                const float ra = hv[2 * p] - __builtin_bit_cast(float, hu[p] << 16), rb = hv[2 * p + 1] - __builtin_bit_cast(float, hu[p] & 0xffff0000u); lu[p] = cvtpk(ra, rb); }
            *(v4u*)(hrow + 32 * ks) = (v4u){hu[0], hu[1], hu[2], hu[3]};
            union { bf16x8_t v; unsigned u[4]; } ah, al; ah.u[0] = hu[0]; ah.u[1] = hu[1]; ah.u[2] = hu[2]; ah.u[3] = hu[3]; al.u[0] = lu[0]; al.u[1] = lu[1]; al.u[2] = lu[2]; al.u[3] = lu[3];
#pragma unroll
            for (int nt = 0; nt < 3; ++nt) { const size_t wo = (size_t)(16 * nt + l15) * 1024 + 32 * ks + 8 * g4;
                const bf16x8_t bh = *(const bf16x8_t*)(wh + wo), bl = *(const bf16x8_t*)(wl + wo);
                acc[nt] = __builtin_amdgcn_mfma_f32_16x16x32_bf16(ah.v, bh, acc[nt], 0, 0, 0);
                acc[nt] = __builtin_amdgcn_mfma_f32_16x16x32_bf16(ah.v, bl, acc[nt], 0, 0, 0);
                acc[nt] = __builtin_amdgcn_mfma_f32_16x16x32_bf16(al.v, bh, acc[nt], 0, 0, 0); }
        }
#pragma unroll
        for (int nt = 0; nt < 3; ++nt)
#pragma unroll
            for (int r = 0; r < 4; ++r) lgs[(4 * g4 + r) * 52 + 16 * nt + l15] = acc[nt][r];
        LDS_WAIT(); asm volatile("" ::: "memory");
        if (lane < 16) {
            float lg[36];
#pragma unroll
            for (int q = 0; q < 9; ++q) { const f32x4 v = *(const LAS f32x4*)(lgs + lane * 52 + 4 * q); lg[4 * q] = v.x; lg[4 * q + 1] = v.y; lg[4 * q + 2] = v.z; lg[4 * q + 3] = v.w; }
#pragma unroll
            for (int o = 0; o < 4; ++o) lg[o] += bg[o];
#pragma unroll
            for (int o = 0; o < 32; ++o) lg[4 + o] += br[o];
            int gi = 0; float gm = lg[0];
#pragma unroll
            for (int o = 1; o < 4; ++o) if (lg[o] > gm) { gm = lg[o]; gi = o; }
            float gs = 0.f;
#pragma unroll
            for (int o = 0; o < 4; ++o) gs += __expf(lg[o] - gm);
            const float pg = 1.f / gs;
            float le[8];
#pragma unroll
            for (int j = 0; j < 8; ++j) { le[j] = lg[4 + j];
#pragma unroll
                for (int g = 1; g < 4; ++g) le[j] = (gi == g) ? lg[4 + g * 8 + j] : le[j]; }
            int j1 = 0; float m1 = le[0];
#pragma unroll
            for (int j = 1; j < 8; ++j) if (le[j] > m1) { m1 = le[j]; j1 = j; }
            int j2 = -1; float m2 = -3.0e38f;
#pragma unroll
            for (int j = 0; j < 8; ++j) if (j != j1 && le[j] > m2) { m2 = le[j]; j2 = j; }
            const float ex = __expf(m2 - m1), w1 = pg / (1.f + ex), w2 = pg * ex / (1.f + ex);
            const int e1 = gi * 8 + j1, e2 = gi * 8 + j2, rw = r0 + lane;
            unsigned* ctl = (unsigned*)(ws + WS_CTL);
            int2* erec = (int2*)(ws + WS_EREC); int* clist = (int*)(ws + WS_CLIST);
            if constexpr (DRY) { ((int2*)(ws + WS_PROJ + 168 * MiB))[rw] = make_int2(e1 * 64 + e2, __builtin_bit_cast(int, w1 + w2)); } else {
            const unsigned p1 = atomicAdd(ctl + CW_ECNT + e1, 1u); erec[(size_t)e1 * TT + p1] = make_int2(rw * 2 + (e1 > e2 ? 1 : 0), __builtin_bit_cast(int, w1));
            const unsigned p2 = atomicAdd(ctl + CW_ECNT + e2, 1u); erec[(size_t)e2 * TT + p2] = make_int2(rw * 2 + (e2 > e1 ? 1 : 0), __builtin_bit_cast(int, w2));
            const int a = j1 < j2 ? j1 : j2, bb = j1 < j2 ? j2 : j1;
            const int cls = gi * 28 + (a * 7 - (a * (a - 1)) / 2 + (bb - a - 1));
            const unsigned pc = atomicAdd(ctl + CW_CCNT + cls, 1u); clist[(size_t)cls * TT + pc] = rw; }
        }
        LDS_WAIT(); asm volatile("" ::: "memory");
    }
}

__device__ __forceinline__ int wave_incl_scan(int v, int lane) {
#pragma unroll
    for (int o = 1; o < 64; o <<= 1) { const int t = __shfl_up(v, o); if (lane >= o) v += t; }
    return v;
}
struct SchedE {
    int G, c, cntv, prev, total_rt; const int2* rec; const char* W;
    __device__ __forceinline__ void init(const unsigned* cnt, const int2* rec_, const char* W_, int G_, int c_, int lane) {
        G = G_; c = c_; rec = rec_; W = W_;
        cntv = lane < NE ? (int)cnt[lane] : 0;
        const int inc = wave_incl_scan((cntv + 255) >> 8, lane);
        total_rt = __builtin_amdgcn_readlane(inc, 63);
        prev = lane < NE ? inc : 0x7fffffff;
    }
    __device__ __forceinline__ bool next(int i, pg8::UnitG& u) const {
        const int L = i * G + c; if (L >= 2 * total_rt) return false;
        const int rt = L >> 1;
        const int e = __builtin_amdgcn_readfirstlane(__popcll(__ballot(prev <= rt)));
        const int base = e ? __builtin_amdgcn_readlane(prev, e - 1) : 0;
        const int cnt = __builtin_amdgcn_readlane(cntv, e);
        u.id = e; u.tile = rt - base; u.pn = L & 1; const int rem = cnt - u.tile * 256; u.nrows = rem < 256 ? rem : 256;
        return true;
    }
    __device__ __forceinline__ int tok(const pg8::UnitG& u, int r) const { return r < u.nrows ? (rec[(size_t)u.id * TT + u.tile * 256 + r].x >> 1) : 0; }
    __device__ __forceinline__ const char* bseg(const pg8::UnitG& u, int) const { return W + ((size_t)u.id * 512 + u.pn * 256) * 2048; }
};
struct EpiGU {
    static constexpr bool PERM = true;
    bf16* HID;
    __device__ __forceinline__ void operator()(const pg8::f32x4 (&acc)[2][2][4][2], const pg8::UnitG& u, const SchedE& S, int wr, int wc, int fr, int fq) const {
#pragma unroll
        for (int ai = 0; ai < 2; ++ai)
#pragma unroll
            for (int m = 0; m < 4; ++m) { const int r = ai * 128 + wr * 64 + m * 16 + fr;
                if (r < u.nrows) { const int2 rc = S.rec[(size_t)u.id * TT + u.tile * 256 + r]; const int t = rc.x >> 1, half = rc.x & 1; const float w = __builtin_bit_cast(float, rc.y);
                    float hv[8];
#pragma unroll
                    for (int n = 0; n < 2; ++n)
#pragma unroll
                        for (int j = 0; j < 4; ++j) { const float g = acc[ai][0][m][n][j], up = acc[ai][1][m][n][j]; hv[n * 4 + j] = w * siluf(g) * up; }
                    v4u o; o.x = pk2(hv[0], hv[1]); o.y = pk2(hv[2], hv[3]); o.z = pk2(hv[4], hv[5]); o.w = pk2(hv[6], hv[7]);
                    *(v4u*)(HID + (size_t)t * 512 + half * 256 + u.pn * 128 + wc * 32 + 8 * fq) = o; } }
    }
};
struct SchedC {
    int G, c, cntA, cntB, preA, preB, total_rt; const int* clist; const char* W;
    __device__ __forceinline__ void init(const unsigned* cnt, const int* clist_, const char* W_, int G_, int c_, int lane) {
        G = G_; c = c_; clist = clist_; W = W_;
        cntA = (int)cnt[lane]; cntB = lane < NCLS - 64 ? (int)cnt[64 + lane] : 0;
        const int ia = wave_incl_scan((cntA + 255) >> 8, lane); const int ta = __builtin_amdgcn_readlane(ia, 63);
        const int ib = wave_incl_scan((cntB + 255) >> 8, lane) + ta;
        total_rt = __builtin_amdgcn_readlane(ib, 63);
        preA = ia; preB = lane < NCLS - 64 ? ib : 0x7fffffff;
    }
    __device__ __forceinline__ bool next(int i, pg8::UnitG& u) const {
        const int L = i * G + c; if (L >= 4 * total_rt) return false;
        const int rt = L >> 2;
        const int cls = __builtin_amdgcn_readfirstlane(__popcll(__ballot(preA <= rt)) + __popcll(__ballot(preB <= rt)));
        int base = 0; if (cls > 0) base = (cls - 1 < 64) ? __builtin_amdgcn_readlane(preA, cls - 1) : __builtin_amdgcn_readlane(preB, cls - 65);
        const int cnt = cls < 64 ? __builtin_amdgcn_readlane(cntA, cls) : __builtin_amdgcn_readlane(cntB, cls - 64);
        u.id = cls; u.tile = rt - base; u.pn = L & 3; const int rem = cnt - u.tile * 256; u.nrows = rem < 256 ? rem : 256;
        return true;
    }
    __device__ __forceinline__ int tok(const pg8::UnitG& u, int r) const { return r < u.nrows ? clist[(size_t)u.id * TT + u.tile * 256 + r] : 0; }
    __device__ __forceinline__ const char* bseg(const pg8::UnitG& u, int seg) const {
        const int g = u.id / 28; int a = 0, rem = u.id % 28; while (rem >= 7 - a) { rem -= 7 - a; ++a; } const int b = a + 1 + rem;
        const int e = g * 8 + (seg ? b : a);
        return W + ((size_t)e * 1024 + u.pn * 256) * 512;
    }
};
struct EpiDown {
    static constexpr bool PERM = false;
    float* OUT; const float* gate2;
    __device__ __forceinline__ void operator()(const pg8::f32x4 (&acc)[2][2][4][2], const pg8::UnitG& u, const SchedC& S, int wr, int wc, int fr, int fq) const {
#pragma unroll
        for (int ai = 0; ai < 2; ++ai)
#pragma unroll
            for (int m = 0; m < 4; ++m) { const int r = ai * 128 + wr * 64 + m * 16 + fr;
                if (r < u.nrows) { const int t = S.clist[(size_t)u.id * TT + u.tile * 256 + r]; const int b = t / SEQ; const int col0 = u.pn * 256 + wc * 32 + 4 * fq;
                    float* op = OUT + (size_t)t * DM + col0; const float* gp = gate2 + b * 6144 + col0;
#pragma unroll
                    for (int bj = 0; bj < 2; ++bj)
#pragma unroll
                        for (int n = 0; n < 2; ++n) { const int off = bj * 128 + n * 16; const f32x4 xv = *(const f32x4*)(op + off), gv = *(const f32x4*)(gp + off);
                            *(f32x4*)(op + off) = xv + gv * acc[ai][bj][m][n]; } } }
    }
};

__global__ void __launch_bounds__(NTHR, 2) fwd_kernel(Args args) {
    extern __shared__ __attribute__((aligned(16))) unsigned char lds_raw[];
    LAS unsigned char* lds = (LAS unsigned char*)lds_raw;
    volatile LAS unsigned* MISC = (volatile LAS unsigned*)(lds + MISC_OFF);
    const int tid = threadIdx.x, lane = tid & 63, wave = __builtin_amdgcn_readfirstlane(tid >> 6);
    const int G = gridDim.x;
    unsigned char* ws = args.ws;
    for (int u = tid; u < (LDS_BYTES - LDSCTL_OFF) / 4; u += NTHR) ((LAS unsigned*)(lds + LDSCTL_OFF))[u] = 0u;
    __syncthreads();
    const int lo = args.ph_lo, hi = args.ph_hi;
    const bool use_bar = (hi - lo) > 1;
    XcdBarrier bar; bar.bar = (unsigned*)(ws + WS_CTL) + CW_BAR; bar.x = 0; bar.st = nullptr;
    if (use_bar) bar = xcd_barrier_post((unsigned*)(ws + WS_CTL) + CW_BAR, MISC + 8);
#define IN(k) (lo <= (k) && (k) < hi)
#define BOTH(k) (IN(k) && IN((k) + 1))
#define GRID_BAR(k) do { if (BOTH(k)) xcd_barrier(bar); } while (0)
    const float* mod = (const float*)(ws + WS_MOD);

    if (IN(0)) { p0_prologue(args, lds, tid, lane, wave); GRID_BAR(0); }
    if (IN(1)) { norm_rows<false>(args, (const float*)args.in[I_X], (const float*)args.in[I_NORM_MIX], mod + 0, mod + 1024, (bf16*)(ws + WS_H), lds, lane, wave); GRID_BAR(1); }
    if (IN(2)) {
        pg8::Gemm g{(const pg8::bf16_t*)(ws + WS_H), (const pg8::bf16_t*)(ws + WS_WINT), TT, NPAD, DM}; pg8::StaticOrder S; S.init(TT, NPAD, G, (int)blockIdx.x);
        pg8::EpiProj E{(pg8::bf16_t*)(ws + WS_PROJ), (float*)(ws + WS_AB), NPROJ};
        pg8::gemm_phase<pg8::EpiProj, pg8::StaticOrder, true, true>(lds, g, S, E);
        GRID_BAR(2);
    }
    if (IN(3)) { gdn_g1_mfma<31>(args, lds, tid, lane, wave); GRID_BAR(3); }
    if (IN(4)) {
        if ((int)blockIdx.x < 32) gdn_scan(args, (int)blockIdx.x, lds, tid, lane, wave);
        else swa_mfma(args, lds, tid, lane, wave, (int)blockIdx.x - 32, G - 32);
        GRID_BAR(4);
    }
    if (IN(5)) { gdn_out(args, lds, lane, wave); GRID_BAR(5); }
    if (IN(6)) {
        pg8::Gemm g{(const pg8::bf16_t*)(ws + WS_MIX), (const pg8::bf16_t*)(ws + WS_WOUTT), TT, DM, DM}; pg8::StaticOrder S; S.init(TT, DM, G, (int)blockIdx.x);
        pg8::EpiOut E{(const float*)args.in[I_X], args.out, mod + 2048, SEQ, 6144};
        pg8::gemm_phase<pg8::EpiOut, pg8::StaticOrder, true, true>(lds, g, S, E);
        GRID_BAR(6);
    }
    if (IN(7)) { norm_route_mfma<false>(args, args.out, (const float*)args.in[I_NORM_FFN], mod + 3072, mod + 4096, (bf16*)(ws + WS_H), lds, lane, wave); GRID_BAR(7); }
    if (IN(8)) {
        SchedE S; S.init((const unsigned*)(ws + WS_CTL) + CW_ECNT, (const int2*)(ws + WS_EREC), (const char*)(ws + WS_WGUT), G, (int)blockIdx.x, lane);
        EpiGU E{(bf16*)(ws + WS_HID)};
        pg8::gemm_phase_g<EpiGU, SchedE>(lds, (const pg8::bf16_t*)(ws + WS_H), 1024, 1024, 16, 16, S, E);
        GRID_BAR(8);
    }
    if (IN(9)) {
        SchedC S; S.init((const unsigned*)(ws + WS_CTL) + CW_CCNT, (const int*)(ws + WS_CLIST), (const char*)(ws + WS_WDT), G, (int)blockIdx.x, lane);
        EpiDown E{args.out, mod + 5120};
        pg8::gemm_phase_g<EpiDown, SchedC>(lds, (const pg8::bf16_t*)(ws + WS_HID), 512, 256, 8, 4, S, E);
    }
#undef IN
#undef BOTH
#undef GRID_BAR
}

#if PROBE_REP >= 0
template <int P>
__global__ void __launch_bounds__(NTHR, 2) probe_kernel(Args args) {
    extern __shared__ __attribute__((aligned(16))) unsigned char lds_raw[];
    LAS unsigned char* lds = (LAS unsigned char*)lds_raw;
    const int tid = threadIdx.x, lane = tid & 63, wave = __builtin_amdgcn_readfirstlane(tid >> 6);
    const int G = gridDim.x; unsigned char* ws = args.ws; const float* mod = (const float*)(ws + WS_MOD);
    if constexpr (P == 1) norm_rows<false>(args, (const float*)args.in[I_X], (const float*)args.in[I_NORM_MIX], mod + 0, mod + 1024, (bf16*)(ws + WS_GAP + 0)  , lds, lane, wave);
    if constexpr (P == 4) gdn_g1_mfma<31>(args, lds, tid, lane, wave);
    if constexpr (P == 50) { if ((int)blockIdx.x < 32) gdn_scan(args, (int)blockIdx.x, lds, tid, lane, wave); }
    if constexpr (P == 52) gdn_out(args, lds, lane, wave);
    if constexpr (P == 51) { if ((int)blockIdx.x >= 32) swa_mfma(args, lds, tid, lane, wave, (int)blockIdx.x - 32, G - 32); }
    if constexpr (P == 6) { pg8::Gemm g{(const pg8::bf16_t*)(ws + WS_MIX), (const pg8::bf16_t*)(ws + WS_WOUTT), TT, DM, DM}; pg8::StaticOrder S; S.init(TT, DM, G, (int)blockIdx.x);
        pg8::EpiOut E{(const float*)args.in[I_X], (float*)(ws + WS_GSF)  , mod + 2048, SEQ, 6144}; pg8::gemm_phase<pg8::EpiOut, pg8::StaticOrder, true, true>(lds, g, S, E); }
    if constexpr (P == 8) { SchedE S; S.init((const unsigned*)(ws + WS_CTL) + CW_ECNT, (const int2*)(ws + WS_EREC), (const char*)(ws + WS_WGUT), G, (int)blockIdx.x, lane);
        EpiGU E{(bf16*)(ws + WS_HID)}; pg8::gemm_phase_g<EpiGU, SchedE>(lds, (const pg8::bf16_t*)(ws + WS_H), 1024, 1024, 16, 16, S, E); }
    if constexpr (P == 7) norm_route_mfma<true>(args, args.out, (const float*)args.in[I_NORM_FFN], mod + 3072, mod + 4096, (bf16*)(ws + WS_PROJ + 32 * MiB), lds, lane, wave);
    if constexpr (P == 9) { SchedC S; S.init((const unsigned*)(ws + WS_CTL) + CW_CCNT, (const int*)(ws + WS_CLIST), (const char*)(ws + WS_WDT), G, (int)blockIdx.x, lane);
        EpiDown E{(float*)(ws + WS_PROJ + 32 * MiB), mod + 5120}; pg8::gemm_phase_g<EpiDown, SchedC>(lds, (const pg8::bf16_t*)(ws + WS_HID), 512, 256, 8, 4, S, E); }
}
#endif
extern "C" void kernel_launch(void* const* d_in, const int* in_sizes, int n_in, void* d_out, int out_size, void* d_ws, size_t ws_size, hipStream_t stream) {
    static int grid = 0;
    if (grid == 0) {
        if (n_in != 23 || in_sizes[0] != TT * DM || out_size != TT * DM || ws_size < WS_END) { fprintf(stderr, "kernel_launch: unexpected shapes: n_in %d in0 %d out %d ws %zu (need %zu)\n", n_in, n_in > 0 ? in_sizes[0] : -1, out_size, ws_size, (size_t)WS_END); grid = -1; return; }
        int dev = 0, cus = 0, per_cu = 0;
        if (hipGetDevice(&dev) != hipSuccess || hipDeviceGetAttribute(&cus, hipDeviceAttributeMultiprocessorCount, dev) != hipSuccess) { grid = -1; return; }
        if (hipFuncSetAttribute((const void*)fwd_kernel, hipFuncAttributeMaxDynamicSharedMemorySize, LDS_BYTES) != hipSuccess) { fprintf(stderr, "kernel_launch: hipFuncSetAttribute failed\n"); grid = -1; return; }
        if (hipOccupancyMaxActiveBlocksPerMultiprocessor(&per_cu, (const void*)fwd_kernel, NTHR, LDS_BYTES) != hipSuccess || per_cu < 1) fprintf(stderr, "kernel_launch: occupancy query reports %d\n", per_cu);
        (void)hipGetLastError();
        grid = cus;
    }
    if (grid < 0) return;
    if (hipMemsetAsync((char*)d_ws + WS_CTL, 0, CTL_ZERO_BYTES, stream) != hipSuccess) { fprintf(stderr, "kernel_launch: memset failed\n"); return; }
    Args a{};
    for (int i = 0; i < 23; ++i) a.in[i] = d_in[i];
    a.out = (float*)d_out; a.ws = (unsigned char*)d_ws;
#if MK_ONE_LAUNCH
    a.ph_lo = 0; a.ph_hi = N_PHASES;
    hipLaunchKernelGGL(fwd_kernel, dim3(grid), dim3(NTHR), LDS_BYTES, stream, a);
#if PROBE_REP >= 0
    hipFuncSetAttribute((const void*)probe_kernel<PROBE_REP>, hipFuncAttributeMaxDynamicSharedMemorySize, LDS_BYTES);
    hipLaunchKernelGGL(probe_kernel<PROBE_REP>, dim3(grid), dim3(NTHR), LDS_BYTES, stream, a);
#endif
#else
    for (int p = 0; p < N_PHASES; ++p) { a.ph_lo = p; a.ph_hi = p + 1; hipLaunchKernelGGL(fwd_kernel, dim3(grid), dim3(NTHR), LDS_BYTES, stream, a); }
#endif
}
```

```cpp
#include <hip/hip_runtime.h>
#include <cstdio>
#include <cstdint>
namespace pg8 {
#define PG8_LAS __attribute__((address_space(3)))
typedef unsigned short bf16_t;
typedef short bf16x8 __attribute__((ext_vector_type(8)));
typedef float f32x4 __attribute__((ext_vector_type(4)));
typedef unsigned u32x4 __attribute__((ext_vector_type(4)));
constexpr int BM = 256, BK = 64, HALF = 128, HTB = HALF * BK * 2  , STAGE_BYTES = 8 * HTB, NXCD = 8, WGM = 8;

__host__ __device__ __forceinline__ int lds_byte(int r, int c) { const int st = (r >> 4) * 2 + (c >> 5), rr = r & 15, cc = c & 31, ob = rr * 64 + cc * 2; return st * 1024 + (ob ^ (((ob >> 9) & 1) << 5)); }
__host__ __device__ __forceinline__ void stage_rc(int b, int& R, int& C) { const int st = b / 1024, sb = b % 1024, swz = sb ^ (((sb >> 9) & 1) << 5); R = (st >> 1) * 16 + swz / 64; C = (st & 1) * 32 + (swz % 64) / 2; }
__host__ __device__ __forceinline__ int perm32(int rho) { const int n = rho >> 4, i = rho & 15; return 8 * (i >> 2) + 4 * n + (i & 3); }

struct Unit { int pm, pn; };
struct Gemm { const bf16_t* A; const bf16_t* Bt; int M, N, K; };

struct StaticOrder {
    int nM, nN, nwg, G, c;
    __host__ __device__ void init(int M, int N, int G_, int c_) { nM = M / BM; nN = N / BM; nwg = nM * nN; G = G_; c = c_; }
    __host__ __device__ bool next(int i, Unit& u) const {
        const long L = (long)i * G + c; if (L >= nwg) return false;
        int wgid = (int)L; { const int q = nwg / NXCD, r = nwg % NXCD, xcd = wgid % NXCD, off = wgid / NXCD; wgid = (xcd < r ? xcd * (q + 1) : r * (q + 1) + (xcd - r) * q) + off; }
        const int nig = WGM * nN, gid = wgid / nig, fm = gid * WGM, gsz = (nM - fm) < WGM ? (nM - fm) : WGM;
        u.pm = fm + ((wgid % nig) % gsz); u.pn = (wgid % nig) / gsz; return true;
    }
    __device__ __forceinline__ void a_ready(const Unit&) const {}
    __device__ __forceinline__ void done(const Unit&) const {}
};

__device__ __forceinline__ unsigned cvt_pk_bf16(float lo, float hi) { unsigned r; asm volatile("v_cvt_pk_bf16_f32 %0, %1, %2" : "=v"(r) : "v"(lo), "v"(hi)); return r; }

struct EpiProj {
    static constexpr bool PERM = true, AFTER_DRAIN = false;
    bf16_t* P; float* AB; int ldp;
    __device__ __forceinline__ void operator()(const f32x4 (&acc)[2][2][4][2], const Unit& u, int wr, int wc, int fr, int fq) const {
        const int row0 = u.pm * BM + wr * 64 + fr;
        if (u.pn < 11) {
            const int col0 = u.pn * BM + wc * 32 + 8 * fq;
#pragma unroll
            for (int ai = 0; ai < 2; ++ai)
#pragma unroll
                for (int m = 0; m < 4; ++m) { bf16_t* rowp = P + (size_t)(row0 + ai * HALF + m * 16) * ldp + col0;
#pragma unroll
                    for (int bj = 0; bj < 2; ++bj) { const f32x4 v0 = acc[ai][bj][m][0], v1 = acc[ai][bj][m][1];
                        u32x4 w; w.x = cvt_pk_bf16(v0[0], v0[1]); w.y = cvt_pk_bf16(v0[2], v0[3]); w.z = cvt_pk_bf16(v1[0], v1[1]); w.w = cvt_pk_bf16(v1[2], v1[3]);
                        *(u32x4*)(rowp + bj * HALF) = w; } }
        } else if (wc == 0 && fq < 2) {
#pragma unroll
            for (int ai = 0; ai < 2; ++ai)
#pragma unroll
                for (int m = 0; m < 4; ++m) { float* rowp = AB + (size_t)(row0 + ai * HALF + m * 16) * 16 + 8 * fq;
                    *(f32x4*)(rowp) = acc[ai][0][m][0]; *(f32x4*)(rowp + 4) = acc[ai][0][m][1]; }
        }
    }
};
struct EpiOut {
    static constexpr bool PERM = false, AFTER_DRAIN = false;
    const float* X; float* O; const float* gate; int rows_per_batch, ldg;
    float* SSQ;
    __device__ __forceinline__ void operator()(const f32x4 (&acc)[2][2][4][2], const Unit& u, int wr, int wc, int fr, int fq) const {
        const int row0 = u.pm * BM + wr * 64 + fr, col0 = u.pn * BM + wc * 32 + 4 * fq;
        const float* gb = gate + (size_t)((u.pm * BM) / rows_per_batch) * ldg + col0;
        f32x4 gv[2][2];
#pragma unroll
        for (int bj = 0; bj < 2; ++bj)
#pragma unroll
            for (int n = 0; n < 2; ++n) gv[bj][n] = *(const f32x4*)(gb + bj * HALF + n * 16);
#pragma unroll
        for (int ai = 0; ai < 2; ++ai)
#pragma unroll
            for (int m = 0; m < 4; ++m) { const size_t ro = (size_t)(row0 + ai * HALF + m * 16) * 1024 + col0; float ss = 0.f;
#pragma unroll
                for (int bj = 0; bj < 2; ++bj)
#pragma unroll
                    for (int n = 0; n < 2; ++n) { const f32x4 xv = *(const f32x4*)(X + ro + bj * HALF + n * 16); const f32x4 v = xv + gv[bj][n] * acc[ai][bj][m][n];
                        *(f32x4*)(O + ro + bj * HALF + n * 16) = v; ss += (v.x * v.x + v.y * v.y) + (v.z * v.z + v.w * v.w); }
                if (SSQ) { ss += __shfl_xor(ss, 16); ss += __shfl_xor(ss, 32); if (fq == 0) SSQ[(size_t)(row0 + ai * HALF + m * 16) * 16 + u.pn * 4 + wc] = ss; } }
    }
};

struct UnitG { int id, tile, pn, nrows; };
template <class Epi, class Sched>
__device__ __forceinline__ void gemm_phase_g(PG8_LAS unsigned char* lds, const bf16_t* Abase, const int KA, const int KB, const int nt, const int ksplit, const Sched& S, const Epi& E) {
    const int tid = threadIdx.x, wid = __builtin_amdgcn_readfirstlane(tid >> 6), lane = tid & 63, wr = wid >> 2, wc = wid & 3, fr = lane & 15, fq = lane >> 4;
    int Rr[2]; unsigned cB2[2], voffB[2];
#pragma unroll
    for (int i = 0; i < 2; ++i) { int R, C; stage_rc(tid * 16 + i * 8192, R, C); const int Rb = Epi::PERM ? ((R & ~31) + perm32(R & 31)) : R;
        Rr[i] = R; cB2[i] = (unsigned)C * 2u; voffB[i] = (unsigned)(Rb * KB + C) * 2u; }
    const size_t kstep = (size_t)(BK * 2);
    const size_t hstepB = (size_t)HALF * KB * 2;
    const unsigned ldsw = (unsigned)wid * 1024u;
    const int aoff = lds_byte(wr * 64 + fr, fq * 8), boff = lds_byte(wc * 32 + fr, fq * 8);
#define PG8_SA(b, h) (((b) * 2 + (h)) * HTB)
#define PG8_SB(b, h) ((4 + (b) * 2 + (h)) * HTB)
#define PG8_STAGE2(bufoff, gbase, v0, v1) do { \
        __builtin_amdgcn_global_load_lds((const unsigned*)((const char*)(gbase) + (v0)), (PG8_LAS unsigned*)(lds + (bufoff) + ldsw), 16, 0, 0); \
        __builtin_amdgcn_global_load_lds((const unsigned*)((const char*)(gbase) + (v1)), (PG8_LAS unsigned*)(lds + (bufoff) + ldsw + 8192), 16, 0, 0); } while (0)
#define PG8_LDA(dst, b, h) do { _Pragma("unroll") for (int m = 0; m < 4; ++m) _Pragma("unroll") for (int k = 0; k < 2; ++k) dst[m][k] = *(const PG8_LAS bf16x8*)(lds + PG8_SA(b, h) + aoff + m * 2048 + k * 1024); } while (0)
#define PG8_LDB(dst, b, h) do { _Pragma("unroll") for (int n = 0; n < 2; ++n) _Pragma("unroll") for (int k = 0; k < 2; ++k) dst[n][k] = *(const PG8_LAS bf16x8*)(lds + PG8_SB(b, h) + boff + n * 2048 + k * 1024); } while (0)
#define PG8_MMA(ai, bj, At, Bt) do { __builtin_amdgcn_s_setprio(1); _Pragma("unroll") for (int m = 0; m < 4; ++m) _Pragma("unroll") for (int n = 0; n < 2; ++n) _Pragma("unroll") for (int k = 0; k < 2; ++k) \
        acc[ai][bj][m][n] = __builtin_amdgcn_mfma_f32_16x16x32_bf16(Bt[n][k], At[m][k], acc[ai][bj][m][n], 0, 0, 0); __builtin_amdgcn_s_setprio(0); } while (0)
#define PG8_WAIT_V(n) asm volatile("s_waitcnt vmcnt(" #n ")" ::: "memory")
#define PG8_WAIT_L(n) asm volatile("s_waitcnt lgkmcnt(" #n ")" ::: "memory")
#define PG8_BAR __builtin_amdgcn_s_barrier()
#define PG8_SCHED __builtin_amdgcn_sched_barrier(0)
#define PG8_AOFFS(u, o00, o01, o10, o11) do { const unsigned _ks = (unsigned)KA * 2u; \
        o00 = (unsigned)S.tok(u, Rr[0]) * _ks + cB2[0]; o01 = (unsigned)S.tok(u, Rr[1]) * _ks + cB2[1]; \
        o10 = (unsigned)S.tok(u, HALF + Rr[0]) * _ks + cB2[0]; o11 = (unsigned)S.tok(u, HALF + Rr[1]) * _ks + cB2[1]; } while (0)
#define PG8_BT(u, t) (((t) < ksplit) ? S.bseg(u, 0) + (size_t)(t) * kstep : S.bseg(u, 1) + (size_t)((t) - ksplit) * kstep)
    UnitG cur, nxt; int ui = 0;
    if (!S.next(0, cur)) return;
    f32x4 acc[2][2][4][2];
#pragma unroll
    for (int a = 0; a < 2; ++a)
#pragma unroll
        for (int b = 0; b < 2; ++b)
#pragma unroll
            for (int m = 0; m < 4; ++m)
#pragma unroll
                for (int n = 0; n < 2; ++n) acc[a][b][m][n] = (f32x4){0.f, 0.f, 0.f, 0.f};
    bf16x8 At[4][2], B0[2][2], B1[2][2];
    unsigned c00, c01, c10, c11, n00 = 0, n01 = 0, n10 = 0, n11 = 0;
    PG8_AOFFS(cur, c00, c01, c10, c11);
    const char* const Ab = (const char*)Abase;
    {   const char* b0p = PG8_BT(cur, 0); const char* b1p = PG8_BT(cur, 1);
        PG8_STAGE2(PG8_SB(0, 0), b0p, voffB[0], voffB[1]); PG8_STAGE2(PG8_SB(0, 1), b0p + hstepB, voffB[0], voffB[1]); PG8_STAGE2(PG8_SA(0, 0), Ab, c00, c01); PG8_STAGE2(PG8_SA(0, 1), Ab, c10, c11);
        if (wr == 1) PG8_BAR;
        PG8_WAIT_V(2); PG8_BAR;
        PG8_STAGE2(PG8_SB(1, 0), b1p, voffB[0], voffB[1]); PG8_STAGE2(PG8_SA(1, 0), Ab + kstep, c00, c01); PG8_STAGE2(PG8_SB(1, 1), b1p + hstepB, voffB[0], voffB[1]);
        PG8_WAIT_V(6); PG8_BAR;
    }
    for (;;) {
        const bool has_next = S.next(ui + 1, nxt);
        for (int t = 0; t < nt; t += 2) {
            const bool last = (t == nt - 2);
            if (last && has_next) PG8_AOFFS(nxt, n00, n01, n10, n11);
            const bool usen = last && has_next;
            const int t2 = last ? 0 : t + 2, t3 = t2 + 1;
            const char* a1 = Ab + (size_t)(t + 1) * kstep;
            const char* a2 = Ab + (size_t)t2 * kstep; const char* a3 = Ab + (size_t)t3 * kstep;
            const char* b2 = usen ? PG8_BT(nxt, t2) : PG8_BT(cur, t2); const char* b3 = usen ? PG8_BT(nxt, t3) : PG8_BT(cur, t3);
            const unsigned o00 = usen ? n00 : c00, o01 = usen ? n01 : c01, o10 = usen ? n10 : c10, o11 = usen ? n11 : c11;
            PG8_LDB(B0, 0, 0); PG8_LDB(B1, 0, 1); PG8_SCHED; PG8_LDA(At, 0, 0); PG8_STAGE2(PG8_SA(1, 1), a1, c10, c11);
            PG8_WAIT_V(8); PG8_WAIT_L(0); PG8_BAR; PG8_MMA(0, 0, At, B0); PG8_MMA(0, 1, At, B1); PG8_BAR; PG8_SCHED;
            PG8_LDA(At, 0, 1); PG8_STAGE2(PG8_SB(0, 0), b2, voffB[0], voffB[1]); PG8_STAGE2(PG8_SB(0, 1), b2 + hstepB, voffB[0], voffB[1]); PG8_STAGE2(PG8_SA(0, 0), a2, o00, o01);
            PG8_WAIT_V(8); PG8_WAIT_L(0); PG8_BAR; PG8_MMA(1, 0, At, B0); PG8_MMA(1, 1, At, B1); PG8_BAR; PG8_SCHED;
            PG8_LDB(B0, 1, 0); PG8_LDB(B1, 1, 1); PG8_SCHED; PG8_LDA(At, 1, 0); PG8_STAGE2(PG8_SA(0, 1), a2, o10, o11);
            PG8_WAIT_V(8); PG8_WAIT_L(0); PG8_BAR; PG8_MMA(0, 0, At, B0); PG8_MMA(0, 1, At, B1); PG8_BAR; PG8_SCHED;
            PG8_LDA(At, 1, 1); PG8_STAGE2(PG8_SB(1, 0), b3, voffB[0], voffB[1]); PG8_STAGE2(PG8_SB(1, 1), b3 + hstepB, voffB[0], voffB[1]); PG8_STAGE2(PG8_SA(1, 0), a3, o00, o01);
            PG8_WAIT_V(8); PG8_WAIT_L(0); PG8_BAR; PG8_MMA(1, 0, At, B0); PG8_MMA(1, 1, At, B1); PG8_BAR; PG8_SCHED;
        }
        if (wr == 0) PG8_BAR;
        E(acc, cur, S, wr, wc, fr, fq);
        if (!has_next) break;
#pragma unroll
        for (int a = 0; a < 2; ++a)
#pragma unroll
            for (int b = 0; b < 2; ++b)
#pragma unroll
                for (int m = 0; m < 4; ++m)
#pragma unroll
                    for (int n = 0; n < 2; ++n) acc[a][b][m][n] = (f32x4){0.f, 0.f, 0.f, 0.f};
        cur = nxt; c00 = n00; c01 = n01; c10 = n10; c11 = n11; ++ui;
        if (wr == 1) PG8_BAR;
    }
    PG8_WAIT_V(0);
    PG8_BAR;
#undef PG8_SA
#undef PG8_SB
#undef PG8_STAGE2
#undef PG8_LDA
#undef PG8_LDB
#undef PG8_MMA
#undef PG8_WAIT_V
#undef PG8_WAIT_L
#undef PG8_BAR
#undef PG8_SCHED
#undef PG8_AOFFS
#undef PG8_BT
}
template <class Epi, class Sched, bool ALIGN_EPI = false, bool SP2 = false>
__device__ __forceinline__ void gemm_phase(PG8_LAS unsigned char* lds, const Gemm g, const Sched& S, const Epi& E) {
    const int tid = threadIdx.x, wid = __builtin_amdgcn_readfirstlane(tid >> 6), lane = tid & 63, wr = wid >> 2, wc = wid & 3, fr = lane & 15, fq = lane >> 4;
    const int K = g.K, nt = K / BK;
    unsigned voffA[2], voffB[2];
#pragma unroll
    for (int i = 0; i < 2; ++i) { int R, C; stage_rc(tid * 16 + i * 8192, R, C); const int Rb = Epi::PERM ? ((R & ~31) + perm32(R & 31)) : R;
        voffA[i] = (unsigned)(R * K + C) * 2u; voffB[i] = (unsigned)(Rb * K + C) * 2u; }
    const size_t kstep = (size_t)(BK * 2);
    const size_t hstep = (size_t)HALF * K * 2;
    const size_t tstep = 2 * hstep;
    const unsigned ldsw = (unsigned)wid * 1024u;
    const int aoff = lds_byte(wr * 64 + fr, fq * 8), boff = lds_byte(wc * 32 + fr, fq * 8);
#define PG8_SA(b, h) (((b) * 2 + (h)) * HTB)
#define PG8_SB(b, h) ((4 + (b) * 2 + (h)) * HTB)
#define PG8_STAGE(bufoff, gbase, voff) do { _Pragma("unroll") for (int _i = 0; _i < 2; ++_i) \
        __builtin_amdgcn_global_load_lds((const unsigned*)((const char*)(gbase) + (voff)[_i]), (PG8_LAS unsigned*)(lds + (bufoff) + ldsw + _i * 8192), 16, 0, 0); } while (0)
#define PG8_LDA(dst, b, h) do { _Pragma("unroll") for (int m = 0; m < 4; ++m) _Pragma("unroll") for (int k = 0; k < 2; ++k) dst[m][k] = *(const PG8_LAS bf16x8*)(lds + PG8_SA(b, h) + aoff + m * 2048 + k * 1024); } while (0)
#define PG8_LDB(dst, b, h) do { _Pragma("unroll") for (int n = 0; n < 2; ++n) _Pragma("unroll") for (int k = 0; k < 2; ++k) dst[n][k] = *(const PG8_LAS bf16x8*)(lds + PG8_SB(b, h) + boff + n * 2048 + k * 1024); } while (0)
#define PG8_MMA(ai, bj, At, Bt) do { __builtin_amdgcn_s_setprio(1); _Pragma("unroll") for (int m = 0; m < 4; ++m) _Pragma("unroll") for (int n = 0; n < 2; ++n) _Pragma("unroll") for (int k = 0; k < 2; ++k) \
        acc[ai][bj][m][n] = __builtin_amdgcn_mfma_f32_16x16x32_bf16(Bt[n][k], At[m][k], acc[ai][bj][m][n], 0, 0, 0); __builtin_amdgcn_s_setprio(0); } while (0)
#define PG8_WAIT_V(n) asm volatile("s_waitcnt vmcnt(" #n ")" ::: "memory")
#define PG8_WAIT_L(n) asm volatile("s_waitcnt lgkmcnt(" #n ")" ::: "memory")
#define PG8_BAR __builtin_amdgcn_s_barrier()
#define PG8_SCHED __builtin_amdgcn_sched_barrier(0)
    Unit cur, nxt; int ui = 0;
    if (!S.next(0, cur)) return;
    f32x4 acc[2][2][4][2];
#pragma unroll
    for (int a = 0; a < 2; ++a)
#pragma unroll
        for (int b = 0; b < 2; ++b)
#pragma unroll
            for (int m = 0; m < 4; ++m)
#pragma unroll
                for (int n = 0; n < 2; ++n) acc[a][b][m][n] = (f32x4){0.f, 0.f, 0.f, 0.f};
    bf16x8 At[4][2], B0[2][2], B1[2][2];
    const char* cA = (const char*)g.A + (size_t)cur.pm * tstep; const char* cB = (const char*)g.Bt + (size_t)cur.pn * tstep;
    S.a_ready(cur);
    if constexpr (SP2) {
        PG8_STAGE(PG8_SB(0, 0), cB, voffB); PG8_STAGE(PG8_SB(0, 1), cB + hstep, voffB); PG8_STAGE(PG8_SA(0, 0), cA, voffA); PG8_STAGE(PG8_SA(0, 1), cA + hstep, voffA);
        if (wr == 1) PG8_BAR;
        PG8_WAIT_V(2); PG8_BAR;
        PG8_STAGE(PG8_SB(1, 0), cB + kstep, voffB); PG8_STAGE(PG8_SA(1, 0), cA + kstep, voffA); PG8_STAGE(PG8_SB(1, 1), cB + hstep + kstep, voffB);
        PG8_WAIT_V(6); PG8_BAR;
    } else {
        PG8_STAGE(PG8_SB(0, 0), cB, voffB); PG8_STAGE(PG8_SA(0, 0), cA, voffA); PG8_STAGE(PG8_SB(0, 1), cB + hstep, voffB); PG8_STAGE(PG8_SA(0, 1), cA + hstep, voffA);
        if (wr == 1) PG8_BAR;
        PG8_WAIT_V(4); PG8_BAR;
        PG8_STAGE(PG8_SB(1, 0), cB + kstep, voffB); PG8_STAGE(PG8_SA(1, 0), cA + kstep, voffA); PG8_STAGE(PG8_SB(1, 1), cB + hstep + kstep, voffB);
        PG8_WAIT_V(6); PG8_BAR;
    }
    for (;;) {
        const bool has_next = S.next(ui + 1, nxt);
        const char* nA = has_next ? (const char*)g.A + (size_t)nxt.pm * tstep : cA; const char* nB = has_next ? (const char*)g.Bt + (size_t)nxt.pn * tstep : cB;
        for (int t = 0; t < nt; t += 2) {
            const bool last = (t == nt - 2);
            const char* a1 = cA + (size_t)(t + 1) * kstep;
            const char* a2 = last ? nA : cA + (size_t)(t + 2) * kstep; const char* b2 = last ? nB : cB + (size_t)(t + 2) * kstep;
            const char* a3 = a2 + kstep; const char* b3 = b2 + kstep;
            if (last && has_next) S.a_ready(nxt);
            if constexpr (SP2) {
            PG8_LDB(B0, 0, 0); PG8_LDB(B1, 0, 1); PG8_SCHED; PG8_LDA(At, 0, 0); PG8_STAGE(PG8_SA(1, 1), a1 + hstep, voffA);
            PG8_WAIT_V(8); PG8_WAIT_L(0); PG8_BAR; PG8_MMA(0, 0, At, B0); PG8_MMA(0, 1, At, B1); PG8_BAR; PG8_SCHED;
            PG8_LDA(At, 0, 1); PG8_STAGE(PG8_SB(0, 0), b2, voffB); PG8_STAGE(PG8_SB(0, 1), b2 + hstep, voffB); PG8_STAGE(PG8_SA(0, 0), a2, voffA);
            PG8_WAIT_V(8); PG8_WAIT_L(0); PG8_BAR; PG8_MMA(1, 0, At, B0); PG8_MMA(1, 1, At, B1); PG8_BAR; PG8_SCHED;
            PG8_LDB(B0, 1, 0); PG8_LDB(B1, 1, 1); PG8_SCHED; PG8_LDA(At, 1, 0); PG8_STAGE(PG8_SA(0, 1), a2 + hstep, voffA);
            PG8_WAIT_V(8); PG8_WAIT_L(0); PG8_BAR; PG8_MMA(0, 0, At, B0); PG8_MMA(0, 1, At, B1); PG8_BAR; PG8_SCHED;
            PG8_LDA(At, 1, 1); PG8_STAGE(PG8_SB(1, 0), b3, voffB); PG8_STAGE(PG8_SB(1, 1), b3 + hstep, voffB); PG8_STAGE(PG8_SA(1, 0), a3, voffA);
            PG8_WAIT_V(8); PG8_WAIT_L(0); PG8_BAR; PG8_MMA(1, 0, At, B0); PG8_MMA(1, 1, At, B1); PG8_BAR; PG8_SCHED;
            } else {
            PG8_LDB(B0, 0, 0); PG8_SCHED; PG8_LDA(At, 0, 0); PG8_STAGE(PG8_SA(1, 1), a1 + hstep, voffA);
            PG8_WAIT_L(8); PG8_BAR; PG8_WAIT_L(0); PG8_MMA(0, 0, At, B0); PG8_BAR; PG8_SCHED;
            PG8_LDB(B1, 0, 1); PG8_STAGE(PG8_SB(0, 0), b2, voffB);
            PG8_BAR; PG8_WAIT_L(0); PG8_MMA(0, 1, At, B1); PG8_BAR;
            PG8_LDA(At, 0, 1); PG8_STAGE(PG8_SA(0, 0), a2, voffA);
            PG8_BAR; PG8_WAIT_L(0); PG8_MMA(1, 0, At, B0); PG8_BAR; PG8_SCHED;
            PG8_STAGE(PG8_SB(0, 1), b2 + hstep, voffB);
            PG8_WAIT_V(6); PG8_BAR; PG8_MMA(1, 1, At, B1); PG8_BAR;
            PG8_LDB(B0, 1, 0); PG8_SCHED; PG8_LDA(At, 1, 0); PG8_STAGE(PG8_SA(0, 1), a2 + hstep, voffA);
            PG8_WAIT_L(8); PG8_BAR; PG8_WAIT_L(0); PG8_MMA(0, 0, At, B0); PG8_BAR; PG8_SCHED;
            PG8_LDB(B1, 1, 1); PG8_STAGE(PG8_SB(1, 0), b3, voffB);
            PG8_BAR; PG8_WAIT_L(0); PG8_MMA(0, 1, At, B1); PG8_BAR;
            PG8_LDA(At, 1, 1); PG8_STAGE(PG8_SA(1, 0), a3, voffA);
            PG8_BAR; PG8_WAIT_L(0); PG8_MMA(1, 0, At, B0); PG8_BAR; PG8_SCHED;
            PG8_STAGE(PG8_SB(1, 1), b3 + hstep, voffB);
            PG8_WAIT_V(6); PG8_BAR; PG8_MMA(1, 1, At, B1); PG8_BAR;
            }
        }
        if constexpr (ALIGN_EPI) { if (wr == 0) PG8_BAR; }
        if constexpr (!Epi::AFTER_DRAIN) { E(acc, cur, wr, wc, fr, fq); S.done(cur); }
        if (!has_next) break;
#pragma unroll
        for (int a = 0; a < 2; ++a)
#pragma unroll
            for (int b = 0; b < 2; ++b)
#pragma unroll
                for (int m = 0; m < 4; ++m)
#pragma unroll
                    for (int n = 0; n < 2; ++n) acc[a][b][m][n] = (f32x4){0.f, 0.f, 0.f, 0.f};
        cur = nxt; cA = nA; cB = nB; ++ui;
        if constexpr (ALIGN_EPI) { if (wr == 1) PG8_BAR; }
    }
    PG8_WAIT_V(0);
    if constexpr (!ALIGN_EPI) { if (wr == 0) PG8_BAR; }
    PG8_BAR;
    if constexpr (Epi::AFTER_DRAIN) { E.fused(acc, cur, wr, wc, fr, fq, lds, wid, lane); S.done(cur); }
#undef PG8_SA
#undef PG8_SB
#undef PG8_STAGE
#undef PG8_LDA
#undef PG8_LDB
#undef PG8_MMA
#undef PG8_WAIT_V
#undef PG8_WAIT_L
#undef PG8_BAR
#undef PG8_SCHED
}
}

constexpr int NB = 4, SEQ = 8192, DM = 1024, TT = NB * SEQ;
constexpr int NPROJ = 2816, NPAD = 3072;
constexpr int PC_Q = 0, PC_K = 512, PC_V = 1024, PC_Z = 1536, PC_SQ = 2048, PC_SK = 2560, PC_SV = 2688;
constexpr int NE = 32, NCLS = 112, DE = 256;
constexpr float EPS = 1e-6f;
constexpr int NWAVES = 8, NTHR = 512;
constexpr int N_PHASES = 10;
#ifndef G1_SM
#define G1_SM 31
#endif
#ifndef PROBE_REP
#define PROBE_REP -1
#endif
#ifndef MK_ONE_LAUNCH
#define MK_ONE_LAUNCH 1
#endif

constexpr size_t MiB = 1u << 20;
constexpr size_t WS_CTL = 0, CTL_ZERO_BYTES = 1 * MiB;
constexpr size_t WS_MOD = 1 * MiB;
constexpr size_t WS_WINT = 2 * MiB, WS_WOUTT = 8 * MiB, WS_WGUT = 10 * MiB, WS_WDT = 42 * MiB;
constexpr size_t WS_H = 58 * MiB;
constexpr size_t WS_PROJ = 122 * MiB;
constexpr size_t WS_AB = 298 * MiB;
constexpr size_t WS_SSQ = WS_AB;
constexpr size_t WS_MIX = 300 * MiB;
constexpr size_t WS_GSF = 364 * MiB;
constexpr size_t WS_EREC = 404 * MiB, WS_CLIST = 412 * MiB;
constexpr size_t WS_HID = WS_PROJ;
constexpr size_t WS_GAP = WS_H, WS_GQP = WS_H + 32 * MiB;
constexpr size_t WS_GOP = 426 * MiB, WS_GBP = 458 * MiB, WS_GGL = 490 * MiB;
constexpr size_t WS_WRT = 491 * MiB;
constexpr size_t WS_END = 492 * MiB;
constexpr int CW_BAR = 4096, CW_ECNT = 8192, CW_CCNT = 8256;

constexpr int RING_BYTES = 131072, LDSCTL_OFF = RING_BYTES, LDS_BYTES = 147456, MISC_OFF = LDS_BYTES - 128;

#define GAS __attribute__((address_space(1)))
#define LAS __attribute__((address_space(3)))
typedef unsigned short bf16;
typedef unsigned v4u __attribute__((ext_vector_type(4)));
typedef float f32x4 __attribute__((ext_vector_type(4)));
typedef GAS unsigned gu32;
#define RLX_AGENT __ATOMIC_RELAXED, __HIP_MEMORY_SCOPE_AGENT
#define LDS_WAIT() asm volatile("s_waitcnt lgkmcnt(0)" ::: "memory")
__device__ __forceinline__ unsigned f2bf(float f) { unsigned u = __builtin_bit_cast(unsigned, f); return (u + 0x7fffu + ((u >> 16) & 1u)) >> 16; }
__device__ __forceinline__ unsigned pk2(float lo, float hi) { return f2bf(lo) | (f2bf(hi) << 16); }
__device__ __forceinline__ float bf2f(bf16 v) { return __builtin_bit_cast(float, (unsigned)v << 16); }
__device__ __forceinline__ float wave_sum(float v) {
#pragma unroll
    for (int o = 1; o < 64; o <<= 1) v += __shfl_xor(v, o);
    return v;
}
__device__ __forceinline__ float siluf(float y) { return y / (1.f + __expf(-y)); }
#define XB_TMO      128
#define XB_XCNT(j)  (256  + 64 * (j))
#define XB_XSUB(j)  (1280 + 64 * (j))
#define XB_XGEN(j)  (2304 + 64 * (j))
#define XB_TOP      3328
#define XB_TOPGEN   3392
#define XCD_BAR_WORDS 3456
#define XB_SPIN_CAP (1u << 18)
__device__ __forceinline__ unsigned xb_ld(unsigned* p)              { return __hip_atomic_load(p, __ATOMIC_RELAXED, __HIP_MEMORY_SCOPE_AGENT); }
__device__ __forceinline__ unsigned xb_add(unsigned* p, unsigned v) { return __hip_atomic_fetch_add(p, v, __ATOMIC_RELAXED, __HIP_MEMORY_SCOPE_AGENT); }
__device__ __forceinline__ unsigned xb_xcc_id() { return (unsigned)__builtin_amdgcn_s_getreg((3 << 11) | 20) & 0xFu; }
#define XB_SPIN(cond, bar) do { unsigned _sp = 0; while (cond) { __builtin_amdgcn_s_sleep(1); \
    if ((++_sp & 255u) == 0u) { if (xb_ld(&(bar)[XB_TMO])) break; if (_sp > XB_SPIN_CAP) { atomicAdd(&(bar)[XB_TMO], 1u); break; } } } } while (0)

struct XcdBarrier {
    unsigned* bar; unsigned x;
    volatile LAS unsigned* st;
};

__device__ __forceinline__ XcdBarrier xcd_barrier_post(unsigned* bar, volatile LAS unsigned* st, bool leader  ) {
    XcdBarrier b; b.bar = bar; b.x = xb_xcc_id(); b.st = st;
    if (leader) (void)xb_add(&bar[XB_XCNT(b.x)], 1u);
    return b;
}
__device__ __forceinline__ void xcd_barrier_complete(unsigned* bar, unsigned x, unsigned& nloc, unsigned& nx) {
    const unsigned G = gridDim.x * gridDim.y * gridDim.z;
    unsigned sum, cnt, mine, sp = 0u;
    for (;;) {
        sum = 0u; cnt = 0u; mine = 0u;
#pragma unroll
        for (unsigned j = 0; j < 16; ++j) { const unsigned c = xb_ld(&bar[XB_XCNT(j)]); sum += c; cnt += (c > 0u) ? 1u : 0u; mine = (j == x) ? c : mine; }
        if (sum == G) break;
        __builtin_amdgcn_s_sleep(1);
        if ((++sp & 255u) == 0u) { if (xb_ld(&bar[XB_TMO])) break; if (sp > XB_SPIN_CAP) { atomicAdd(&bar[XB_TMO], 1u); break; } }
    }
    nloc = mine > 0u ? mine : 1u; nx = cnt > 0u ? cnt : 1u;
}

__device__ __forceinline__ void xcd_barrier(const XcdBarrier& b, bool leader  ) {
    asm volatile("s_waitcnt vmcnt(0)" ::: "memory");
    __syncthreads();
    if (leader) {
        unsigned* bar = b.bar;
        __builtin_amdgcn_s_waitcnt(0);
        unsigned nloc = b.st[0], nx = b.st[1];
        if (nloc == 0u) { xcd_barrier_complete(bar, b.x, nloc, nx); b.st[0] = nloc; b.st[1] = nx; }
        const unsigned old = xb_add(&bar[XB_XSUB(b.x)], 1u);
        const unsigned gen = old / nloc;
        if (old + 1u == (gen + 1u) * nloc) {
            __builtin_amdgcn_fence(__ATOMIC_RELEASE, "agent");
            asm volatile("s_waitcnt vmcnt(0)" ::: "memory");
            const unsigned og = xb_add(&bar[XB_TOP], 1u);
            const unsigned tg = og / nx;
            if (og + 1u == (tg + 1u) * nx) xb_add(&bar[XB_TOPGEN], 1u);
            else XB_SPIN(xb_ld(&bar[XB_TOPGEN]) == tg, bar);
            __builtin_amdgcn_fence(__ATOMIC_ACQUIRE, "agent");
            xb_add(&bar[XB_XGEN(b.x)], 1u);
            asm volatile("s_waitcnt vmcnt(0)" ::: "memory");
        } else {
            XB_SPIN(xb_ld(&bar[XB_XGEN(b.x)]) == gen, bar);
            __builtin_amdgcn_fence(__ATOMIC_ACQUIRE, "agent");
            asm volatile("s_waitcnt vmcnt(0)" ::: "memory");
        }
    }
    __syncthreads();
}

struct Args { const void* in[23]; float* out; unsigned char* ws; int ph_lo, ph_hi; };
enum { I_X = 0, I_C, I_POS, I_WADA, I_BADA, I_NORM_MIX, I_WIN, I_CONVW, I_ALOG, I_DTB, I_GNORM, I_QNORM, I_KNORM, I_SINKS, I_WOUT, I_NORM_FFN, I_WGRP, I_BGRP, I_WRT, I_BRT, I_WGATE, I_WUP, I_WDOWN };

template <class CM>
__device__ __forceinline__ void transpose_item(const float* W, int ldw, int k0, bf16* WT, int ldt, int n0, CM cm, LAS float* scr, int lane) {
    const int sc = cm(n0 + (lane & 31));
#pragma unroll 8
    for (int i = 0; i < 32; ++i) { const int kk = 2 * i + (lane >> 5); scr[kk * 33 + (lane & 31)] = sc >= 0 ? W[(size_t)(k0 + kk) * ldw + sc] : 0.f; }
    LDS_WAIT(); asm volatile("" ::: "memory");
    const int c = lane & 7;
#pragma unroll
    for (int j = 0; j < 4; ++j) { const int n = (lane >> 3) + 8 * j; const LAS float* s = scr + (8 * c) * 33 + n;
        v4u o; o.x = pk2(s[0 * 33], s[1 * 33]); o.y = pk2(s[2 * 33], s[3 * 33]); o.z = pk2(s[4 * 33], s[5 * 33]); o.w = pk2(s[6 * 33], s[7 * 33]);
        *(v4u*)(WT + (size_t)(n0 + n) * ldt + k0 + 8 * c) = o; }
    LDS_WAIT(); asm volatile("" ::: "memory");
}
struct CmIn { __device__ __forceinline__ int operator()(int n) const { return n < 2048 ? n : (n < 2816 ? n + 16 : (n < 2832 ? 2048 + (n - 2816) : -1)); } };
struct CmOff { int off; __device__ __forceinline__ int operator()(int n) const { return n + off; } };
struct CmId { __device__ __forceinline__ int operator()(int n) const { return n; } };

__device__ __forceinline__ void p0_prologue(const Args& A, LAS unsigned char* lds, int tid, int lane, int wave) {
    unsigned char* ws = A.ws;
    LAS float* scr = (LAS float*)(lds + wave * 8448);
    const int G = gridDim.x, gw = blockIdx.x * NWAVES + wave, NGW = G * NWAVES;
    constexpr int IT_IN = (NPAD / 32) * (DM / 64), IT_OUT = (DM / 32) * (DM / 64);
    for (int it = gw; it < IT_IN + IT_OUT; it += NGW) {
        if (it < IT_IN) { const int nb = it % (NPAD / 32), kb = it / (NPAD / 32); transpose_item((const float*)A.in[I_WIN], 2832, kb * 64, (bf16*)(ws + WS_WINT), DM, nb * 32, CmIn(), scr, lane); }
        else { const int r = it - IT_IN, nb = r % (DM / 32), kb = r / (DM / 32); transpose_item((const float*)A.in[I_WOUT], DM, kb * 64, (bf16*)(ws + WS_WOUTT), DM, nb * 32, CmId(), scr, lane); }
    }
    {   constexpr int IT_GU = NE * 16 * 16, IT_D = NE * 32 * 4;
        const float* wgate = (const float*)A.in[I_WGATE]; const float* wup = (const float*)A.in[I_WUP]; const float* wdown = (const float*)A.in[I_WDOWN];
        for (int it = gw; it < IT_GU + IT_D; it += NGW) {
            if (it < IT_GU) { const int e = it >> 8, r = it & 255, nb = r & 15, kb = r >> 4, j = nb >> 3, q = nb & 7;
                const float* W = (q < 4 ? wgate : wup) + (size_t)e * 1024 * 256; const int col0 = j * 128 + (q & 3) * 32;
                transpose_item(W, 256, kb * 64, (bf16*)(ws + WS_WGUT) + (size_t)e * 512 * 1024, 1024, nb * 32, CmOff{col0 - nb * 32}, scr, lane); }
            else { const int r2 = it - IT_GU, e = r2 >> 7, r = r2 & 127, nb = r & 31, kb = r >> 5;
                transpose_item(wdown + (size_t)e * 256 * 1024, 1024, kb * 64, (bf16*)(ws + WS_WDT) + (size_t)e * 1024 * 256, 256, nb * 32, CmId(), scr, lane); }
        }
    }
    {   const float* wgp = (const float*)A.in[I_WGRP]; const float* wrt = (const float*)A.in[I_WRT];
        bf16* wf = (bf16*)(ws + WS_WRT);
        for (int idx = blockIdx.x * NTHR + tid; idx < 48 * 1024; idx += G * NTHR) { const int j = idx & 7, ln = (idx >> 3) & 63, ks = (idx >> 9) & 31, nt = idx >> 14;
            const int o = 16 * nt + (ln & 15), k = 32 * ks + 8 * (ln >> 4) + j;
            const float w = o < 4 ? wgp[k * 4 + o] : (o < 36 ? wrt[k * 32 + o - 4] : 0.f);
            const unsigned hb = f2bf(w); wf[idx] = (bf16)hb; wf[48 * 1024 + idx] = (bf16)f2bf(w - __builtin_bit_cast(float, hb << 16)); }
    }
    LAS float* cact = (LAS float*)(lds + 69632);
    LAS float* red = (LAS float*)(lds + 69632 + 16384);
    const float* c = (const float*)A.in[I_C]; const float* wada = (const float*)A.in[I_WADA]; const float* bada = (const float*)A.in[I_BADA];
    float* mod = (float*)(ws + WS_MOD);
    if ((int)blockIdx.x < 96) {
        __syncthreads();
        for (int i = tid; i < 4096; i += NTHR) cact[i] = siluf(c[i]);
        __syncthreads();
        for (int u = blockIdx.x; u < 96; u += G) {
            const int n = u * 64 + lane; float a0 = 0.f, a1 = 0.f, a2 = 0.f, a3 = 0.f;
            for (int k = wave * 128; k < wave * 128 + 128; ++k) { const float w = wada[(size_t)k * 6144 + n]; a0 += cact[k] * w; a1 += cact[1024 + k] * w; a2 += cact[2048 + k] * w; a3 += cact[3072 + k] * w; }
            red[(wave * 4 + 0) * 64 + lane] = a0; red[(wave * 4 + 1) * 64 + lane] = a1; red[(wave * 4 + 2) * 64 + lane] = a2; red[(wave * 4 + 3) * 64 + lane] = a3;
            __syncthreads();
            if (tid < 256) { const int b = tid >> 6, l = tid & 63; float s = bada[u * 64 + l];
#pragma unroll
                for (int w = 0; w < 8; ++w) s += red[(w * 4 + b) * 64 + l];
                mod[b * 6144 + u * 64 + l] = s; }
            __syncthreads();
        }
    }
}

template <bool ROUTE>
__device__ __forceinline__ void norm_rows(const Args& A, const float* X, const float* gain, const float* shift, const float* scale, bf16* H, LAS unsigned char* lds, int lane, int wave) {
    LAS float* hl = (LAS float*)(lds + wave * 4096);
    const int G = gridDim.x, gw = blockIdx.x * NWAVES + wave, NGW = G * NWAVES;
    unsigned char* ws = A.ws;
    for (int r0 = gw * 16; r0 < TT; r0 += NGW * 16) {
        const int b = r0 / SEQ;
        f32x4 mf[4], af[4];
#pragma unroll
        for (int j = 0; j < 4; ++j) { const int col = 4 * lane + 256 * j; const f32x4 g = *(const f32x4*)(gain + col), sc = *(const f32x4*)(scale + b * 6144 + col);
            mf[j] = g * (sc + 1.0f); af[j] = *(const f32x4*)(shift + b * 6144 + col); }
#pragma unroll 4
        for (int i = 0; i < 16; ++i) {
            const int row = r0 + i;
            const f32x4* xr = (const f32x4*)(X + (size_t)row * DM) + lane;
            f32x4 v[4]; float s = 0.f;
#pragma unroll
            for (int j = 0; j < 4; ++j) { v[j] = xr[64 * j]; s += (v[j].x * v[j].x + v[j].y * v[j].y) + (v[j].z * v[j].z + v[j].w * v[j].w); }
            const float rstd = 1.f / sqrtf(wave_sum(s) * (1.f / DM) + EPS);
            unsigned long long* o8 = (unsigned long long*)(H + (size_t)row * DM) + lane;
#pragma unroll
            for (int j = 0; j < 4; ++j) { v[j] = v[j] * rstd * mf[j] + af[j];
                o8[64 * j] = (unsigned long long)pk2(v[j].x, v[j].y) | ((unsigned long long)pk2(v[j].z, v[j].w) << 32); }
            if constexpr (ROUTE) {
                const float* wg = (const float*)A.in[I_WGRP]; const float* wr = (const float*)A.in[I_WRT];
                float lg[36];
#pragma unroll
                for (int o = 0; o < 36; ++o) lg[o] = 0.f;
#pragma unroll
                for (int j = 0; j < 4; ++j) *(LAS f32x4*)(hl + 4 * lane + 256 * j) = v[j];
                LDS_WAIT(); asm volatile("" ::: "memory");
#pragma unroll 1
                for (int ii = 0; ii < 16; ++ii) { const int k = lane + 64 * ii; const float hv = hl[k];
                    const f32x4 g4 = *(const f32x4*)(wg + k * 4);
                    lg[0] += hv * g4.x; lg[1] += hv * g4.y; lg[2] += hv * g4.z; lg[3] += hv * g4.w;
#pragma unroll
                    for (int q = 0; q < 8; ++q) { const f32x4 r4 = *(const f32x4*)(wr + k * 32 + q * 4);
                        lg[4 + q * 4 + 0] += hv * r4.x; lg[4 + q * 4 + 1] += hv * r4.y; lg[4 + q * 4 + 2] += hv * r4.z; lg[4 + q * 4 + 3] += hv * r4.w; } }
                LDS_WAIT(); asm volatile("" ::: "memory");
#pragma unroll
                for (int o = 0; o < 36; ++o) lg[o] = wave_sum(lg[o]);
                const float* bg = (const float*)A.in[I_BGRP]; const float* br = (const float*)A.in[I_BRT];
#pragma unroll
                for (int o = 0; o < 4; ++o) lg[o] += bg[o];
#pragma unroll
                for (int o = 0; o < 32; ++o) lg[4 + o] += br[o];
                int gi = 0; float gm = lg[0];
#pragma unroll
                for (int o = 1; o < 4; ++o) if (lg[o] > gm) { gm = lg[o]; gi = o; }
                float gs = 0.f;
#pragma unroll
                for (int o = 0; o < 4; ++o) gs += __expf(lg[o] - gm);
                const float pg = 1.f / gs;
                float le[8];
#pragma unroll
                for (int j = 0; j < 8; ++j) { le[j] = lg[4 + j];
#pragma unroll
                    for (int g = 1; g < 4; ++g) le[j] = (gi == g) ? lg[4 + g * 8 + j] : le[j]; }
                int j1 = 0; float m1 = le[0];
#pragma unroll
                for (int j = 1; j < 8; ++j) if (le[j] > m1) { m1 = le[j]; j1 = j; }
                int j2 = -1; float m2 = -3.0e38f;
#pragma unroll
                for (int j = 0; j < 8; ++j) if (j != j1 && le[j] > m2) { m2 = le[j]; j2 = j; }
                const float ex = __expf(m2 - m1), w1 = pg / (1.f + ex), w2 = pg * ex / (1.f + ex);
                if (lane == 0) {
                    const int e1 = gi * 8 + j1, e2 = gi * 8 + j2;
                    unsigned* ctl = (unsigned*)(ws + WS_CTL);
                    int2* erec = (int2*)(ws + WS_EREC); int* clist = (int*)(ws + WS_CLIST);
                    const unsigned p1 = atomicAdd(ctl + CW_ECNT + e1, 1u); erec[(size_t)e1 * TT + p1] = make_int2(row * 2 + (e1 > e2 ? 1 : 0), __builtin_bit_cast(int, w1));
                    const unsigned p2 = atomicAdd(ctl + CW_ECNT + e2, 1u); erec[(size_t)e2 * TT + p2] = make_int2(row * 2 + (e2 > e1 ? 1 : 0), __builtin_bit_cast(int, w2));
                    const int a = j1 < j2 ? j1 : j2, bb = j1 < j2 ? j2 : j1;
                    const int cls = gi * 28 + (a * 7 - (a * (a - 1)) / 2 + (bb - a - 1));
                    const unsigned pc = atomicAdd(ctl + CW_CCNT + cls, 1u); clist[(size_t)cls * TT + pc] = row;
                }
            }
        }
    }
}

typedef short bf16x8_t __attribute__((ext_vector_type(8)));
typedef float f32x16 __attribute__((ext_vector_type(16)));
typedef unsigned v2u __attribute__((ext_vector_type(2)));
typedef float f32x2_t __attribute__((ext_vector_type(2)));
typedef __bf16 bf16x2_t __attribute__((ext_vector_type(2)));
__device__ __forceinline__ unsigned cvtpk(float lo, float hi) { const f32x2_t f = {lo, hi}; return __builtin_bit_cast(unsigned, __builtin_convertvector(f, bf16x2_t)); }
__device__ __forceinline__ void fast_sincos(float ang, float& sn, float& cs) {
    float rev = ang * 0.15915494309189535f; rev -= floorf(rev);
    sn = __builtin_amdgcn_sinf(rev); cs = __builtin_amdgcn_cosf(rev);
}
__device__ __forceinline__ void swa_mfma(const Args& A, LAS unsigned char* lds, int tid, int lane, int wave, int blk, int nblk) {
    unsigned char* ws = A.ws;
    const bf16* proj = (const bf16*)(ws + WS_PROJ);
    bf16* mix = (bf16*)(ws + WS_MIX); const float* sinks = (const float*)A.in[I_SINKS];
    const int* pos = (const int*)A.in[I_POS]; const float* qn = (const float*)A.in[I_QNORM]; const float* kn = (const float*)A.in[I_KNORM];
    constexpr int KST = 144, VST = 520;
    LAS unsigned char* Kl = lds; LAS unsigned char* Vt = lds + 256 * KST;
    const int g = wave >> 1, qh = wave & 1, ql = lane & 31, hh = lane >> 5;
    constexpr float LOG2E = 1.4426950408889634f, CS = 0.125f * LOG2E, L2T = 13.287712379549449f / 32.f;
    const int sch = tid & 7;
    float kinv[8], kgn[8];
#pragma unroll
    for (int j = 0; j < 8; ++j) { kinv[j] = __builtin_amdgcn_exp2f(-(float)((sch & 3) * 8 + j) * L2T); kgn[j] = kn[sch * 8 + j]; }
    float qinv[2][8];
#pragma unroll
    for (int ks = 0; ks < 2; ++ks)
#pragma unroll
        for (int j = 0; j < 8; ++j) qinv[ks][j] = __builtin_amdgcn_exp2f(-(float)(ks * 16 + hh * 8 + j) * L2T);
    for (int u = blk; u < NB * 2 * (SEQ / 128); u += nblk) {
        const int n = u & 63, kvh = (u >> 6) & 1, b = u >> 7;
        const int tb = b * SEQ + n * 128;
        __syncthreads();
#pragma unroll
        for (int it = 0; it < 4; ++it) { const int idx = tid + it * NTHR, key = idx >> 3, ch = idx & 7; int tk = tb - 128 + key; if (tk < b * SEQ) tk = b * SEQ;
            const v4u kv = *(const v4u*)(proj + (size_t)tk * NPROJ + PC_SK + kvh * 64 + ch * 8);
            const v4u vv = *(const v4u*)(proj + (size_t)tk * NPROJ + PC_SV + kvh * 64 + ch * 8);
            const float pf = (float)pos[tk];
            float x[8] = { __builtin_bit_cast(float, kv.x << 16), __builtin_bit_cast(float, kv.x & 0xffff0000u), __builtin_bit_cast(float, kv.y << 16), __builtin_bit_cast(float, kv.y & 0xffff0000u),
                           __builtin_bit_cast(float, kv.z << 16), __builtin_bit_cast(float, kv.z & 0xffff0000u), __builtin_bit_cast(float, kv.w << 16), __builtin_bit_cast(float, kv.w & 0xffff0000u) };
            float ss = 0.f;
#pragma unroll
            for (int j = 0; j < 8; ++j) ss += x[j] * x[j];
            ss += __shfl_xor(ss, 1); ss += __shfl_xor(ss, 2); ss += __shfl_xor(ss, 4);
            const float rn = 1.f / sqrtf(ss * (1.f / 64.f) + EPS);
            float o[8];
#pragma unroll
            for (int j = 0; j < 8; ++j) { const float xn = x[j] * rn * kgn[j]; const float pr = __shfl_xor(xn, 4); float sn, cs; fast_sincos(pf * kinv[j], sn, cs);
                o[j] = (ch < 4) ? xn * cs - pr * sn : pr * sn + xn * cs; }
            v4u ko; ko.x = cvtpk(o[0], o[1]); ko.y = cvtpk(o[2], o[3]); ko.z = cvtpk(o[4], o[5]); ko.w = cvtpk(o[6], o[7]);
            *(LAS v4u*)(Kl + key * KST + ch * 16) = ko;
            LAS unsigned short* vp = (LAS unsigned short*)(Vt + (ch * 8) * VST + key * 2);
            vp[0 * (VST / 2)] = (unsigned short)(vv.x & 0xffffu); vp[1 * (VST / 2)] = (unsigned short)(vv.x >> 16);
            vp[2 * (VST / 2)] = (unsigned short)(vv.y & 0xffffu); vp[3 * (VST / 2)] = (unsigned short)(vv.y >> 16);
            vp[4 * (VST / 2)] = (unsigned short)(vv.z & 0xffffu); vp[5 * (VST / 2)] = (unsigned short)(vv.z >> 16);
            vp[6 * (VST / 2)] = (unsigned short)(vv.w & 0xffffu); vp[7 * (VST / 2)] = (unsigned short)(vv.w >> 16); }
        __syncthreads();
        const int hq = kvh * 4 + g; const float sinkl = sinks[hq] * LOG2E;
#pragma unroll 1
        for (int qt = 0; qt < 2; ++qt) {
            const int i0 = qh * 64 + qt * 32, iq = i0 + ql;
            const size_t tq = (size_t)(tb + iq);
            bf16x8_t qf[4];
            {   float xq[4][8]; float ss = 0.f;
#pragma unroll
                for (int ks = 0; ks < 4; ++ks) { const v4u r = *(const v4u*)(proj + tq * NPROJ + PC_SQ + hq * 64 + ks * 16 + hh * 8);
                    xq[ks][0] = __builtin_bit_cast(float, r.x << 16); xq[ks][1] = __builtin_bit_cast(float, r.x & 0xffff0000u); xq[ks][2] = __builtin_bit_cast(float, r.y << 16); xq[ks][3] = __builtin_bit_cast(float, r.y & 0xffff0000u);
                    xq[ks][4] = __builtin_bit_cast(float, r.z << 16); xq[ks][5] = __builtin_bit_cast(float, r.z & 0xffff0000u); xq[ks][6] = __builtin_bit_cast(float, r.w << 16); xq[ks][7] = __builtin_bit_cast(float, r.w & 0xffff0000u);
#pragma unroll
                    for (int j = 0; j < 8; ++j) ss += xq[ks][j] * xq[ks][j]; }
                ss += __shfl_xor(ss, 32);
                const float rn = 1.f / sqrtf(ss * (1.f / 64.f) + EPS); const float pf = (float)pos[tq];
#pragma unroll
                for (int ks = 0; ks < 4; ++ks)
#pragma unroll
                    for (int j = 0; j < 8; ++j) xq[ks][j] *= rn * qn[ks * 16 + hh * 8 + j];
#pragma unroll
                for (int ks = 0; ks < 2; ++ks)
#pragma unroll
                    for (int j = 0; j < 8; ++j) { float sn, cs; fast_sincos(pf * qinv[ks][j], sn, cs); const float x1 = xq[ks][j], x2 = xq[ks + 2][j];
                        xq[ks][j] = x1 * cs - x2 * sn; xq[ks + 2][j] = x1 * sn + x2 * cs; }
#pragma unroll
                for (int ks = 0; ks < 4; ++ks) { union { bf16x8_t v; unsigned u[4]; } p; p.u[0] = cvtpk(xq[ks][0], xq[ks][1]); p.u[1] = cvtpk(xq[ks][2], xq[ks][3]); p.u[2] = cvtpk(xq[ks][4], xq[ks][5]); p.u[3] = cvtpk(xq[ks][6], xq[ks][7]); qf[ks] = p.v; }
            }
            f32x16 sc[5];
#pragma unroll
            for (int kt = 0; kt < 5; ++kt) { f32x16 acc;
#pragma unroll
                for (int r = 0; r < 16; ++r) acc[r] = 0.f;
#pragma unroll
                for (int ks = 0; ks < 4; ++ks) { const bf16x8_t kf = *(const LAS bf16x8_t*)(Kl + (i0 + 32 * kt + ql) * KST + (ks * 16 + hh * 8) * 2);
                    acc = __builtin_amdgcn_mfma_f32_32x32x16_bf16(kf, qf[ks], acc, 0, 0, 0); }
                sc[kt] = acc; }
            float mloc = -3.0e38f;
#pragma unroll
            for (int kt = 0; kt < 5; ++kt)
#pragma unroll
                for (int r = 0; r < 16; ++r) { const int j = i0 + 32 * kt + (r & 3) + 8 * (r >> 2) + 4 * hh;
                    const bool valid = (j > iq) && (j <= iq + 128) && (n > 0 || j >= 128);
                    const float sv = valid ? sc[kt][r] * CS : -1.0e30f; sc[kt][r] = sv; mloc = fmaxf(mloc, sv); }
            float mx = fmaxf(mloc, __shfl_xor(mloc, 32)); mx = fmaxf(mx, sinkl);
            float lsum = 0.f;
#pragma unroll
            for (int kt = 0; kt < 5; ++kt)
#pragma unroll
                for (int r = 0; r < 16; ++r) { const float p = __builtin_amdgcn_exp2f(sc[kt][r] - mx); sc[kt][r] = p; lsum += p; }
            lsum += __shfl_xor(lsum, 32); lsum += __builtin_amdgcn_exp2f(sinkl - mx);
            f32x16 o0, o1;
#pragma unroll
            for (int r = 0; r < 16; ++r) { o0[r] = 0.f; o1[r] = 0.f; }
#pragma unroll
            for (int kt = 0; kt < 5; ++kt)
#pragma unroll
                for (int s2 = 0; s2 < 2; ++s2) {
                    union { bf16x8_t v; unsigned u[4]; } pf;
#pragma unroll
                    for (int p = 0; p < 4; ++p) pf.u[p] = cvtpk(sc[kt][8 * s2 + 2 * p], sc[kt][8 * s2 + 2 * p + 1]);
                    const int jb = i0 + 32 * kt + 16 * s2 + 4 * hh;
                    union { bf16x8_t v; v2u u[2]; } v0, v1;
                    const LAS unsigned char* r0 = Vt + ql * VST + jb * 2; const LAS unsigned char* r1 = Vt + (32 + ql) * VST + jb * 2;
                    v0.u[0] = *(const LAS v2u*)(r0); v0.u[1] = *(const LAS v2u*)(r0 + 16);
                    v1.u[0] = *(const LAS v2u*)(r1); v1.u[1] = *(const LAS v2u*)(r1 + 16);
                    o0 = __builtin_amdgcn_mfma_f32_32x32x16_bf16(v0.v, pf.v, o0, 0, 0, 0);
                    o1 = __builtin_amdgcn_mfma_f32_32x32x16_bf16(v1.v, pf.v, o1, 0, 0, 0);
                }
            const float il = 1.f / lsum;
            bf16* op = mix + tq * DM + 512 + hq * 64 + 4 * hh;
#pragma unroll
            for (int rq = 0; rq < 4; ++rq) {
                v2u w0; w0.x = cvtpk(o0[4 * rq] * il, o0[4 * rq + 1] * il); w0.y = cvtpk(o0[4 * rq + 2] * il, o0[4 * rq + 3] * il);
                *(v2u*)(op + 8 * rq) = w0;
                v2u w1; w1.x = cvtpk(o1[4 * rq] * il, o1[4 * rq + 1] * il); w1.y = cvtpk(o1[4 * rq + 2] * il, o1[4 * rq + 3] * il);
                *(v2u*)(op + 32 + 8 * rq) = w1; }
        }
    }
}

__device__ __forceinline__ int frag_a_idx(int row, int col) { const int mt = row >> 4, l15 = row & 15, ks = col >> 5, x = col & 31, jh = x >> 4, g4 = (x >> 2) & 3, jl = x & 3; return ((mt * 2 + ks) * 64 + g4 * 16 + l15) * 8 + 4 * jh + jl; }
__device__ __forceinline__ int frag_c_idx(int row, int col) { const int w = col >> 4, l15 = col & 15, mt = row >> 4, y = row & 15, g4 = y >> 2, i = y & 3; return ((w * 64 + g4 * 16 + l15) * 4 + mt) * 4 + i; }
__device__ __forceinline__ void gdn_g1_naive(const Args& A, LAS float* L, int tid) {
    unsigned char* ws = A.ws;
    const bf16* proj = (const bf16*)(ws + WS_PROJ); const float* ab = (const float*)(ws + WS_AB);
    bf16* AP = (bf16*)(ws + WS_GAP); bf16* BP = (bf16*)(ws + WS_GBP); bf16* QP = (bf16*)(ws + WS_GQP); bf16* OP = (bf16*)(ws + WS_GOP); float* GL = (float*)(ws + WS_GGL);
    const float* convw = (const float*)A.in[I_CONVW];
    constexpr int LD = 65, AR = 64 * LD;
    LAS float* q = L; LAS float* k = q + AR; LAS float* v = k + AR; LAS float* Mm = v + AR; LAS float* At = Mm + AR; LAS float* w = At + AR;
    LAS float* Gc = w + AR; LAS float* beta = Gc + 64;
    const int i8 = tid >> 3, e0 = (tid & 7) * 8;
    for (int cid = blockIdx.x; cid < NB * 8 * 128; cid += gridDim.x) {
        const int n = cid & 127, bh = cid >> 7, b = bh >> 3, h = bh & 7;
        const float Ah = expf(((const float*)A.in[I_ALOG])[h]), dtb = ((const float*)A.in[I_DTB])[h];
        const int t0 = b * SEQ + n * 64;
        __syncthreads();
        for (int idx = tid; idx < 3 * 4096; idx += NTHR) {
            const int part = idx >> 12, rem = idx & 4095, i = rem >> 6, d = rem & 63, c = part * 512 + h * 64 + d;
            float y = 0.f;
#pragma unroll
            for (int j = 0; j < 4; ++j) { const int s = n * 64 + i - 3 + j; if (s >= 0) y += convw[j * 1536 + c] * bf2f(proj[(size_t)(b * SEQ + s) * NPROJ + c]); }
            y = y / (1.f + __expf(-y));
            (part == 0 ? q : (part == 1 ? k : v))[i * LD + d] = y;
        }
        if (tid < 64) { const float a = ab[(size_t)(t0 + tid) * 16 + h], bb = ab[(size_t)(t0 + tid) * 16 + 8 + h]; const float xx = a + dtb;
            const float sp = xx > 20.f ? xx : log1pf(expf(xx)); Gc[tid] = -Ah * sp; beta[tid] = 1.f / (1.f + __expf(-bb)); }
        __syncthreads();
        if (tid < 128) { LAS float* arr = tid < 64 ? q : k; const int i = tid & 63; float ss = 0.f;
            for (int d = 0; d < 64; ++d) ss += arr[i * LD + d] * arr[i * LD + d];
            const float r = (1.f / sqrtf(ss + EPS)) * (tid < 64 ? 0.125f : 1.f);
            for (int d = 0; d < 64; ++d) arr[i * LD + d] *= r; }
        if (tid == 128) { float run = 0.f; for (int i = 0; i < 64; ++i) { run += Gc[i]; Gc[i] = run; } }
        __syncthreads();
        {   const int i = i8;
            for (int jj = 0; jj < 8; ++jj) { const int j = e0 + jj; float dq = 0.f, dk = 0.f;
_Pragma("unroll 2") for (int d = 0; d < 64; ++d) { const float kj = k[j * LD + d]; dq += q[i * LD + d] * kj; dk += k[i * LD + d] * kj; }
                const float dec = (i >= j) ? __expf(Gc[i] - Gc[j]) : 0.f;
                At[i * LD + j] = dq * dec; Mm[i * LD + j] = (i > j) ? dk * beta[i] * dec : 0.f; }
        }
        __syncthreads();
        for (int idx = tid; idx < 4096; idx += NTHR) { const int i = idx >> 6, d = idx & 63; v[i * LD + d] *= beta[i]; w[i * LD + d] = k[i * LD + d] * beta[i] * __expf(Gc[i]); }
        __syncthreads();
        if (tid < 128) { LAS float* arr = tid < 64 ? v : w; const int c = tid & 63;
            _Pragma("unroll 1") for (int i = 1; i < 64; ++i) { float a = arr[i * LD + c]; _Pragma("unroll 4") for (int j = 0; j < i; ++j) a -= Mm[i * LD + j] * arr[j * LD + c]; arr[i * LD + c] = a; } }
        __syncthreads();
        const float gl = Gc[63];
        const size_t cb = (size_t)cid * 4096;
        {
            const int d = i8; float a[8], bq[8];
#pragma unroll
            for (int ee = 0; ee < 8; ++ee) { a[ee] = 0.f; bq[ee] = 0.f; }
_Pragma("unroll 2")
            for (int c = 0; c < 64; ++c) { const float kd = k[c * LD + d] * __expf(gl - Gc[c]);
#pragma unroll
                for (int ee = 0; ee < 8; ++ee) { a[ee] -= kd * w[c * LD + e0 + ee]; bq[ee] += kd * v[c * LD + e0 + ee]; } }
#pragma unroll
            for (int ee = 0; ee < 8; ++ee) { const int dp = e0 + ee; AP[cb + frag_a_idx(d, dp)] = (bf16)f2bf(a[ee]); BP[cb + frag_c_idx(d, dp)] = (bf16)f2bf(bq[ee]); }
        }
        {
            const int c = i8; float a[8], bq[8]; const float eg = __expf(Gc[c]);
#pragma unroll
            for (int ee = 0; ee < 8; ++ee) { a[ee] = eg * q[c * LD + e0 + ee]; bq[ee] = 0.f; }
_Pragma("unroll 2")
            for (int s2 = 0; s2 <= c; ++s2) { const float av = At[c * LD + s2];
#pragma unroll
                for (int ee = 0; ee < 8; ++ee) { a[ee] -= av * w[s2 * LD + e0 + ee]; bq[ee] += av * v[s2 * LD + e0 + ee]; } }
#pragma unroll
            for (int ee = 0; ee < 8; ++ee) { const int dp = e0 + ee; QP[cb + frag_a_idx(c, dp)] = (bf16)f2bf(a[ee]); OP[cb + frag_c_idx(c, dp)] = (bf16)f2bf(bq[ee]); }
        }
        if (tid == 0) GL[cid] = __expf(gl);
    }
}
__device__ __forceinline__ float wave_incl_scan_f(float v, int lane) {
#pragma unroll
    for (int o = 1; o < 64; o <<= 1) { const float t = __shfl_up(v, o); if (lane >= o) v += t; }
    return v;
}
__device__ __forceinline__ v2u pack4(f32x4 v) { v2u r; r.x = cvtpk(v.x, v.y); r.y = cvtpk(v.z, v.w); return r; }
__device__ __forceinline__ bf16x8_t mk8(v2u lo, v2u hi) { union { bf16x8_t v; unsigned u[4]; } x; x.u[0] = lo.x; x.u[1] = lo.y; x.u[2] = hi.x; x.u[3] = hi.y; return x.v; }
template <int SM, int STG = 7>
__device__ __forceinline__ void gdn_g1_mfma(const Args& A, LAS unsigned char* lds, int tid, int lane, int wave) {
    unsigned char* ws = A.ws;
    const bf16* proj = (const bf16*)(ws + WS_PROJ); const float* ab = (const float*)(ws + WS_AB);
    bf16* AP = (bf16*)(ws + WS_GAP); bf16* BP = (bf16*)(ws + WS_GBP); bf16* QP = (bf16*)(ws + WS_GQP); bf16* OP = (bf16*)(ws + WS_GOP); float* GL = (float*)(ws + WS_GGL);
    const float* convw = (const float*)A.in[I_CONVW];
    constexpr int KST = 144, RST = 68;
    LAS unsigned char* const Kr0 = lds;
    const int l15 = lane & 15, g4 = lane >> 4;
    const v2u zero2 = {0u, 0u};
    const int G = gridDim.x;
    const int pi = tid >> 3, pd0 = (tid & 7) * 8;
    v4u xr[3][4]; float pa = 0.f, pb = 0.f;
#define G1_PREFETCH_PART(IDX, part) do { const int h_ = (IDX) & 7, bn_ = (IDX) >> 3, b_ = bn_ >> 7, n_ = bn_ & 127; \
        _Pragma("unroll") for (int j = 0; j < 4; ++j) { const int s_ = n_ * 64 + pi - 3 + j, sc_ = s_ < 0 ? 0 : s_; \
            const v4u r_ = *(const v4u*)(proj + (size_t)(b_ * SEQ + sc_) * NPROJ + (part) * 512 + h_ * 64 + pd0); const unsigned m_ = s_ < 0 ? 0u : 0xffffffffu; \
            xr[part][j] = (v4u){r_.x & m_, r_.y & m_, r_.z & m_, r_.w & m_}; } } while (0)
#define G1_PREFETCH_AB(IDX) do { const int h_ = (IDX) & 7, bn_ = (IDX) >> 3, b_ = bn_ >> 7, n_ = bn_ & 127; const size_t t_ = (size_t)(b_ * SEQ + n_ * 64 + lane) * 16; pa = ab[t_ + h_]; pb = ab[t_ + 8 + h_]; } while (0)
#define G1_PREFETCH(IDX) do { G1_PREFETCH_PART(IDX, 0); G1_PREFETCH_PART(IDX, 1); G1_PREFETCH_PART(IDX, 2); G1_PREFETCH_AB(IDX); } while (0)
    int hcur = -1;
    if ((int)blockIdx.x < NB * 8 * 128) G1_PREFETCH((int)blockIdx.x);
    for (int idx = blockIdx.x; idx < NB * 8 * 128; idx += G) {
        const int h = idx & 7, bn = idx >> 3, b = bn >> 7, n = bn & 127, bh = b * 8 + h, cid = bh * 128 + n;
        const size_t cb = (size_t)cid * 4096;
        int oz = 0; asm volatile("" : "+v"(oz));
        LAS unsigned char* const Kr = Kr0 + oz; LAS unsigned char* const Qr = Kr + 9216; LAS unsigned char* const kdT = Kr + 18432; LAS unsigned char* const Mm = Kr + 27648; LAS unsigned char* const At = Kr + 36864;
        LAS float* const Rt = (LAS float*)(Kr + 46080);
        LAS float* const Md = (LAS float*)(Kr + 80896);
        LAS unsigned char* const Tl = Kr + 86016;
        LAS float* const Gs = (LAS float*)(Kr + 88064); LAS float* const Bs = Gs + 64;
        LAS float* const cwl = (LAS float*)(Kr + 88576);
        __syncthreads();
        if (h != hcur) { hcur = h; for (int q = tid; q < 768; q += NTHR) { const int part = q >> 8, j = (q >> 6) & 3, d = q & 63; cwl[q] = convw[j * 1536 + part * 512 + h * 64 + d]; } }
        if (wave == 0) {
            const float Ah = __expf(((const float*)A.in[I_ALOG])[h]), dtb = ((const float*)A.in[I_DTB])[h];
            const float xx = pa + dtb;
            const float sp = xx > 20.f ? xx : log1pf(__expf(xx));
            const float Gv = wave_incl_scan_f(-Ah * sp, lane);
            Gs[lane] = Gv; Bs[lane] = 1.f / (1.f + __expf(-pb));
            if ((SM & 16) && lane == 63) GL[cid] = __expf(Gv);
        }
        const bool more = (idx + G < NB * 8 * 128);
        if (more) G1_PREFETCH_AB(idx + G);
        __syncthreads();
        {
            const int i = pi, d0 = pd0, swk = (d0 >> 3) << 3, swr = ((d0 >> 3) & 3) << 3;
            const float Gi = Gs[i], bi = Bs[i], gl = Gs[63];
            const float eG = __expf(Gi), ekd = __expf(gl - Gi);
#define G1_CONV(part, y) do { float acc_[8]; \
                _Pragma("unroll") for (int e = 0; e < 8; ++e) acc_[e] = 0.f; \
                _Pragma("unroll") for (int j = 0; j < 4; ++j) { \
                    const f32x4 w0 = *(const LAS f32x4*)(cwl + ((part) * 4 + j) * 64 + d0), w1 = *(const LAS f32x4*)(cwl + ((part) * 4 + j) * 64 + d0 + 4); \
                    const v4u x = xr[part][j]; \
                    acc_[0] += w0.x * __builtin_bit_cast(float, x.x << 16); acc_[1] += w0.y * __builtin_bit_cast(float, x.x & 0xffff0000u); \
                    acc_[2] += w0.z * __builtin_bit_cast(float, x.y << 16); acc_[3] += w0.w * __builtin_bit_cast(float, x.y & 0xffff0000u); \
                    acc_[4] += w1.x * __builtin_bit_cast(float, x.z << 16); acc_[5] += w1.y * __builtin_bit_cast(float, x.z & 0xffff0000u); \
                    acc_[6] += w1.z * __builtin_bit_cast(float, x.w << 16); acc_[7] += w1.w * __builtin_bit_cast(float, x.w & 0xffff0000u); } \
                _Pragma("unroll") for (int e = 0; e < 8; ++e) y[e] = acc_[e] * __builtin_amdgcn_rcpf(1.f + __expf(-acc_[e])); } while (0)
            {   float y[8]; G1_CONV(0, y); if (more) G1_PREFETCH_PART(idx + G, 0);
                float sq = 0.f;
#pragma unroll
                for (int e = 0; e < 8; ++e) sq += y[e] * y[e];
                sq += __shfl_xor(sq, 1); sq += __shfl_xor(sq, 2); sq += __shfl_xor(sq, 4);
                const float rq = (1.f / sqrtf(sq + EPS)) * 0.125f;
                v4u pq; pq.x = cvtpk(y[0] * rq, y[1] * rq); pq.y = cvtpk(y[2] * rq, y[3] * rq); pq.z = cvtpk(y[4] * rq, y[5] * rq); pq.w = cvtpk(y[6] * rq, y[7] * rq);
                *(LAS v4u*)(Qr + i * KST + d0 * 2) = pq; }
            asm volatile("" ::: "memory");
            {   float y[8]; G1_CONV(1, y); if (more) G1_PREFETCH_PART(idx + G, 1);
                float sk = 0.f;
#pragma unroll
                for (int e = 0; e < 8; ++e) sk += y[e] * y[e];
                sk += __shfl_xor(sk, 1); sk += __shfl_xor(sk, 2); sk += __shfl_xor(sk, 4);
                const float rk = 1.f / sqrtf(sk + EPS);
#pragma unroll
                for (int e = 0; e < 8; ++e) y[e] *= rk;
                v4u pk; pk.x = cvtpk(y[0], y[1]); pk.y = cvtpk(y[2], y[3]); pk.z = cvtpk(y[4], y[5]); pk.w = cvtpk(y[6], y[7]);
                *(LAS v4u*)(Kr + i * KST + d0 * 2) = pk;
#pragma unroll
                for (int e = 0; e < 8; ++e) { *(LAS unsigned short*)(kdT + (d0 + e) * KST + (i ^ swk) * 2) = (unsigned short)f2bf(y[e] * ekd); Rt[(d0 + e) * RST + (i ^ swr)] = y[e] * bi * eG; } }
            asm volatile("" ::: "memory");
            {   float y[8]; G1_CONV(2, y); if (more) G1_PREFETCH_PART(idx + G, 2);
#pragma unroll
                for (int e = 0; e < 8; ++e) Rt[(64 + d0 + e) * RST + (i ^ swr)] = y[e] * bi; }
#undef G1_CONV
        }
        __syncthreads();
        if constexpr (STG & 1) {
            const int ct = wave & 3, which = wave >> 2;
            const LAS unsigned char* Xb = which ? Kr : Qr;
            const int c = 16 * ct + l15; const float Gc = Gs[c], bc = Bs[c];
            bf16x8_t bfr[2];
#pragma unroll
            for (int ks = 0; ks < 2; ++ks) bfr[ks] = *(const LAS bf16x8_t*)(Xb + c * KST + (32 * ks + 8 * g4) * 2);
#pragma unroll
            for (int st = 0; st < 4; ++st) {
                f32x4 acc = {0.f, 0.f, 0.f, 0.f};
#pragma unroll
                for (int ks = 0; ks < 2; ++ks) { const bf16x8_t af = *(const LAS bf16x8_t*)(Kr + (16 * st + l15) * KST + (32 * ks + 8 * g4) * 2);
                    acc = __builtin_amdgcn_mfma_f32_16x16x32_bf16(af, bfr[ks], acc, 0, 0, 0); }
                f32x4 vals;
#pragma unroll
                for (int r = 0; r < 4; ++r) { const int s2 = 16 * st + 4 * g4 + r; const float dec = __expf(fminf(Gc - Gs[s2], 0.f));
                    vals[r] = which ? ((s2 < c) ? -acc[r] * bc * dec : 0.f) : ((s2 <= c) ? acc[r] * dec : 0.f); }
                *(LAS v2u*)((which ? Mm : At) + c * KST + (16 * st + 4 * g4) * 2) = pack4(vals);
                if (which && st == ct) *(LAS f32x4*)(Md + (ct * 16 + l15) * 20 + 4 * g4) = -vals;
            }
        }
        __syncthreads();
        if ((STG & 2) && wave == 0) {
            float t[16];
#pragma unroll
            for (int r = 0; r < 16; ++r) { float acc = (r == l15) ? 1.f : 0.f;
#pragma unroll
                for (int s4 = 0; s4 < r; s4 += 4) { const f32x4 m = *(const LAS f32x4*)(Md + (g4 * 16 + r) * 20 + s4);
                    acc -= m.x * t[s4]; if (s4 + 1 < r) acc -= m.y * t[s4 + 1]; if (s4 + 2 < r) acc -= m.z * t[s4 + 2]; if (s4 + 3 < r) acc -= m.w * t[s4 + 3]; }
                t[r] = acc; }
#pragma unroll
            for (int r = 0; r < 16; ++r) *(LAS unsigned short*)(Tl + ((g4 * 16 + r) * 16 + l15) * 2) = (unsigned short)f2bf(t[r]);
        }
        __syncthreads();
        if constexpr (STG & 4) {
        f32x4 wt[4];
        {   const int colw = 16 * wave + l15;
#pragma unroll
            for (int i = 0; i < 4; ++i) {
                f32x4 acc = *(const LAS f32x4*)(Rt + colw * RST + ((16 * i + 4 * g4) ^ (((colw >> 3) & 3) << 3)));
                const LAS unsigned char* mrow = Mm + (16 * i + l15) * KST + (4 * g4) * 2;
                if (i >= 1) { const v2u alo = *(const LAS v2u*)(mrow), ahi = (i >= 2) ? *(const LAS v2u*)(mrow + 32) : zero2;
                    acc = __builtin_amdgcn_mfma_f32_16x16x32_bf16(mk8(alo, ahi), mk8(pack4(wt[0]), (i >= 2) ? pack4(wt[1]) : zero2), acc, 0, 0, 0); }
                if (i == 3) { const v2u alo = *(const LAS v2u*)(mrow + 64);
                    acc = __builtin_amdgcn_mfma_f32_16x16x32_bf16(mk8(alo, zero2), mk8(pack4(wt[2]), zero2), acc, 0, 0, 0); }
                const v2u tlo = *(const LAS v2u*)(Tl + ((i * 16 + l15) * 16 + 4 * g4) * 2);
                wt[i] = __builtin_amdgcn_mfma_f32_16x16x32_bf16(mk8(tlo, zero2), mk8(pack4(acc), zero2), (f32x4){0.f, 0.f, 0.f, 0.f}, 0, 0, 0);
            }
        }
        if (wave < 4) {
            bf16x8_t wn[2];
#pragma unroll
            for (int ks = 0; ks < 2; ++ks) { v2u lo = pack4(wt[2 * ks]), hi = pack4(wt[2 * ks + 1]); lo.x ^= 0x80008000u; lo.y ^= 0x80008000u; hi.x ^= 0x80008000u; hi.y ^= 0x80008000u; wn[ks] = mk8(lo, hi); }
#pragma unroll
            for (int nt = 0; nt < 4; ++nt) { const int x = 16 * nt + l15;
                f32x4 ca = {0.f, 0.f, 0.f, 0.f};
                const v2u qraw = *(const LAS v2u*)(Qr + x * KST + (16 * wave + 4 * g4) * 2); const float eg = __expf(Gs[x]);
                f32x4 cq; cq.x = eg * __builtin_bit_cast(float, qraw.x << 16); cq.y = eg * __builtin_bit_cast(float, qraw.x & 0xffff0000u); cq.z = eg * __builtin_bit_cast(float, qraw.y << 16); cq.w = eg * __builtin_bit_cast(float, qraw.y & 0xffff0000u);
#pragma unroll
                for (int ks = 0; ks < 2; ++ks) { const int xs = (x >> 3) << 3; const LAS unsigned char* kp0 = kdT + x * KST + ((32 * ks + 4 * g4) ^ xs) * 2; const LAS unsigned char* kp1 = kdT + x * KST + ((32 * ks + 16 + 4 * g4) ^ xs) * 2; const LAS unsigned char* ap = At + x * KST + (32 * ks + 4 * g4) * 2;
                    ca = __builtin_amdgcn_mfma_f32_16x16x32_bf16(wn[ks], mk8(*(const LAS v2u*)(kp0), *(const LAS v2u*)(kp1)), ca, 0, 0, 0);
                    cq = __builtin_amdgcn_mfma_f32_16x16x32_bf16(wn[ks], mk8(*(const LAS v2u*)(ap), *(const LAS v2u*)(ap + 32)), cq, 0, 0, 0); }
                const size_t off = cb + (size_t)((nt * 2 + (wave >> 1)) * 64 + lane) * 8 + 4 * (wave & 1);
                if (SM & 1) *(v2u*)(AP + off) = pack4(ca); if (SM & 2) *(v2u*)(QP + off) = pack4(cq);
            }
        } else {
            bf16x8_t ub[2];
#pragma unroll
            for (int ks = 0; ks < 2; ++ks) ub[ks] = mk8(pack4(wt[2 * ks]), pack4(wt[2 * ks + 1]));
            unsigned bo[8], oo[8];
#pragma unroll
            for (int mt = 0; mt < 4; ++mt) { const int x = 16 * mt + l15;
                f32x4 cbv = {0.f, 0.f, 0.f, 0.f}, co = {0.f, 0.f, 0.f, 0.f};
#pragma unroll
                for (int ks = 0; ks < 2; ++ks) { const int xs = (x >> 3) << 3; const LAS unsigned char* kp0 = kdT + x * KST + ((32 * ks + 4 * g4) ^ xs) * 2; const LAS unsigned char* kp1 = kdT + x * KST + ((32 * ks + 16 + 4 * g4) ^ xs) * 2; const LAS unsigned char* ap = At + x * KST + (32 * ks + 4 * g4) * 2;
                    cbv = __builtin_amdgcn_mfma_f32_16x16x32_bf16(mk8(*(const LAS v2u*)(kp0), *(const LAS v2u*)(kp1)), ub[ks], cbv, 0, 0, 0);
                    co = __builtin_amdgcn_mfma_f32_16x16x32_bf16(mk8(*(const LAS v2u*)(ap), *(const LAS v2u*)(ap + 32)), ub[ks], co, 0, 0, 0); }
                const v2u pb = pack4(cbv), po = pack4(co); bo[2 * mt] = pb.x; bo[2 * mt + 1] = pb.y; oo[2 * mt] = po.x; oo[2 * mt + 1] = po.y; }
            const size_t off = cb + (size_t)((wave - 4) * 64 + lane) * 16;
            if (SM & 4) { *(v4u*)(BP + off) = (v4u){bo[0], bo[1], bo[2], bo[3]}; *(v4u*)(BP + off + 8) = (v4u){bo[4], bo[5], bo[6], bo[7]}; }
            if (SM & 8) { *(v4u*)(OP + off) = (v4u){oo[0], oo[1], oo[2], oo[3]}; *(v4u*)(OP + off + 8) = (v4u){oo[4], oo[5], oo[6], oo[7]}; }
        }
        }
    }
#undef G1_PREFETCH
#undef G1_PREFETCH_PART
#undef G1_PREFETCH_AB
}

__device__ __forceinline__ f32x4 g2_unpack(const v4u (&p)[2], int mt) {
    const unsigned d0 = mt == 0 ? p[0].x : mt == 1 ? p[0].z : mt == 2 ? p[1].x : p[1].z, d1 = mt == 0 ? p[0].y : mt == 1 ? p[0].w : mt == 2 ? p[1].y : p[1].w;
    f32x4 r; r.x = __builtin_bit_cast(float, d0 << 16); r.y = __builtin_bit_cast(float, d0 & 0xffff0000u); r.z = __builtin_bit_cast(float, d1 << 16); r.w = __builtin_bit_cast(float, d1 & 0xffff0000u); return r;
}
__device__ __forceinline__ void gdn_scan(const Args& A, int bh, LAS unsigned char* lds, int tid, int lane, int wave) {
    unsigned char* ws = A.ws;
    const char* AP = (const char*)(ws + WS_GAP); const char* BP = (const char*)(ws + WS_GBP); const float* GL = (const float*)(ws + WS_GGL); bf16* SF = (bf16*)(ws + WS_GSF);
    constexpr int SLOT = 16384, NSL = 8, EGL_OFF = NSL * SLOT;
    LAS float* eglt = (LAS float*)(lds + EGL_OFF);
    __syncthreads();
    { int tl = tid; asm volatile("" : "+v"(tl));
      if (tl < 128) eglt[tl] = GL[bh * 128 + tl]; }
    if (wave < 4) {
        f32x4 sC[4]; bf16x8_t sB[2];
#pragma unroll
        for (int mt = 0; mt < 4; ++mt) sC[mt] = (f32x4){0.f, 0.f, 0.f, 0.f};
#pragma unroll
        for (int ks = 0; ks < 2; ++ks)
#pragma unroll
            for (int j = 0; j < 8; ++j) sB[ks][j] = 0;
        asm volatile("s_waitcnt vmcnt(0) lgkmcnt(0)" ::: "memory");
        __builtin_amdgcn_s_barrier();
#pragma unroll 1
        for (int n = 0; n < SEQ / 64; ++n) {
            const LAS unsigned char* slot = lds + (n & (NSL - 1)) * SLOT;
            bf16x8_t fa[4][2]; v4u fb[2];
#pragma unroll
            for (int mt = 0; mt < 4; ++mt)
#pragma unroll
                for (int ks = 0; ks < 2; ++ks) fa[mt][ks] = *(const LAS bf16x8_t*)(slot + ((mt * 2 + ks) * 64 + lane) * 16);
            fb[0] = *(const LAS v4u*)(slot + 8192 + (wave * 64 + lane) * 32); fb[1] = *(const LAS v4u*)(slot + 8192 + (wave * 64 + lane) * 32 + 16);
            const float egl = eglt[n];
            bf16* sf = SF + (size_t)(bh * 128 + n) * 4096 + (size_t)((wave * 2) * 64 + lane) * 8;
            *(bf16x8_t*)(sf) = sB[0]; *(bf16x8_t*)(sf + 512) = sB[1];
            f32x4 sacc[4];
#pragma unroll
            for (int mt = 0; mt < 4; ++mt) sacc[mt] = sC[mt] * egl + g2_unpack(fb, mt);
#pragma unroll
            for (int mt = 0; mt < 4; ++mt)
#pragma unroll
                for (int ks = 0; ks < 2; ++ks) sacc[mt] = __builtin_amdgcn_mfma_f32_16x16x32_bf16(fa[mt][ks], sB[ks], sacc[mt], 0, 0, 0);
#pragma unroll
            for (int mt = 0; mt < 4; ++mt) sC[mt] = sacc[mt];
#pragma unroll
            for (int ks = 0; ks < 2; ++ks) { union { bf16x8_t v; unsigned u[4]; } pk_;
                pk_.u[0] = cvtpk(sC[2 * ks].x, sC[2 * ks].y); pk_.u[1] = cvtpk(sC[2 * ks].z, sC[2 * ks].w); pk_.u[2] = cvtpk(sC[2 * ks + 1].x, sC[2 * ks + 1].y); pk_.u[3] = cvtpk(sC[2 * ks + 1].z, sC[2 * ks + 1].w); sB[ks] = pk_.v; }
            asm volatile("s_waitcnt lgkmcnt(0)" ::: "memory");
            __builtin_amdgcn_s_barrier();
        }
    } else {
        const int f = wave - 4;
        const unsigned lin = (unsigned)(2 * f) * 1024u + (unsigned)lane * 16u;
#define G2_DMA(nn) do { const int n_ = (nn) < SEQ / 64 ? (nn) : SEQ / 64 - 1; const size_t cb_ = (size_t)(bh * 128 + n_) * 8192; LAS unsigned char* d_ = lds + ((nn) & (NSL - 1)) * SLOT + (2 * f) * 1024; \
        __builtin_amdgcn_global_load_lds((const unsigned*)(AP + cb_ + lin), (LAS unsigned*)(d_), 16, 0, 0); __builtin_amdgcn_global_load_lds((const unsigned*)(AP + cb_ + lin + 1024), (LAS unsigned*)(d_ + 1024), 16, 0, 0); \
        __builtin_amdgcn_global_load_lds((const unsigned*)(BP + cb_ + lin), (LAS unsigned*)(d_ + 8192), 16, 0, 0); __builtin_amdgcn_global_load_lds((const unsigned*)(BP + cb_ + lin + 1024), (LAS unsigned*)(d_ + 8192 + 1024), 16, 0, 0); } while (0)
        asm volatile("s_waitcnt vmcnt(0) lgkmcnt(0)" ::: "memory");
        G2_DMA(0); G2_DMA(1); G2_DMA(2); G2_DMA(3); G2_DMA(4); G2_DMA(5); G2_DMA(6);
        asm volatile("s_waitcnt vmcnt(24)" ::: "memory");
        __builtin_amdgcn_s_barrier();
#pragma unroll 1
        for (int n = 0; n < SEQ / 64; ++n) {
            G2_DMA(n + 7);
            asm volatile("s_waitcnt vmcnt(24)" ::: "memory");
            __builtin_amdgcn_s_barrier();
        }
#undef G2_DMA
        asm volatile("s_waitcnt vmcnt(0)" ::: "memory");
    }
    __syncthreads();
}
__device__ __forceinline__ void gdn_out(const Args& A, LAS unsigned char* lds, int lane, int wave) {
    unsigned char* ws = A.ws;
    const bf16* proj = (const bf16*)(ws + WS_PROJ); bf16* mix = (bf16*)(ws + WS_MIX);
    const bf16* QP = (const bf16*)(ws + WS_GQP); const bf16* OP = (const bf16*)(ws + WS_GOP); const bf16* SF = (const bf16*)(ws + WS_GSF);
    const float* onorm = (const float*)A.in[I_GNORM];
    const int mt = wave & 3, l15 = lane & 15, g4 = lane >> 4, rr = lane >> 2, q4 = lane & 3;
    constexpr int OST = 68;
    LAS float* ot = (LAS float*)(lds + wave * 4608);
    float gain[16];
#pragma unroll
    for (int k = 0; k < 16; ++k) gain[k] = onorm[16 * q4 + k];
    struct OSet { bf16x8_t qa[2], sb[4][2]; v2u oi[4]; v4u z0, z1; };
#define GO_LOAD(S, CID) do { const int n_ = (CID) & 127, bh_ = (CID) >> 7, b_ = bh_ >> 3, h_ = bh_ & 7; const size_t cb_ = (size_t)(CID) * 4096; \
        const size_t t_ = (size_t)b_ * SEQ + n_ * 64 + 16 * mt + rr; \
        S.z0 = *(const v4u*)(proj + t_ * NPROJ + PC_Z + h_ * 64 + 16 * q4); S.z1 = *(const v4u*)(proj + t_ * NPROJ + PC_Z + h_ * 64 + 16 * q4 + 8); \
        _Pragma("unroll") for (int ks = 0; ks < 2; ++ks) S.qa[ks] = *(const bf16x8_t*)(QP + cb_ + ((mt * 2 + ks) * 64 + lane) * 8); \
        _Pragma("unroll") for (int nt = 0; nt < 4; ++nt) { _Pragma("unroll") for (int ks = 0; ks < 2; ++ks) S.sb[nt][ks] = *(const bf16x8_t*)(SF + cb_ + ((nt * 2 + ks) * 64 + lane) * 8); \
            S.oi[nt] = *(const v2u*)(OP + cb_ + ((nt * 64 + lane) * 4 + mt) * 4); } } while (0)
#define GO_STEP(S, CID) do { const int n_ = (CID) & 127, bh_ = (CID) >> 7, b_ = bh_ >> 3, h_ = bh_ & 7; const size_t t_ = (size_t)b_ * SEQ + n_ * 64 + 16 * mt + rr; \
        _Pragma("unroll") for (int nt = 0; nt < 4; ++nt) { \
            f32x4 acc; acc.x = __builtin_bit_cast(float, S.oi[nt].x << 16); acc.y = __builtin_bit_cast(float, S.oi[nt].x & 0xffff0000u); acc.z = __builtin_bit_cast(float, S.oi[nt].y << 16); acc.w = __builtin_bit_cast(float, S.oi[nt].y & 0xffff0000u); \
            _Pragma("unroll") for (int ks = 0; ks < 2; ++ks) acc = __builtin_amdgcn_mfma_f32_16x16x32_bf16(S.qa[ks], S.sb[nt][ks], acc, 0, 0, 0); \
            _Pragma("unroll") for (int i = 0; i < 4; ++i) ot[(4 * g4 + i) * OST + 16 * nt + l15] = acc[i]; } \
        LDS_WAIT(); asm volatile("" ::: "memory"); \
        float o[16]; float ss = 0.f; \
        _Pragma("unroll") for (int k = 0; k < 4; ++k) { const f32x4 v = *(const LAS f32x4*)(ot + rr * OST + 16 * q4 + 4 * k); o[4 * k] = v.x; o[4 * k + 1] = v.y; o[4 * k + 2] = v.z; o[4 * k + 3] = v.w; } \
        _Pragma("unroll") for (int k = 0; k < 16; ++k) ss += o[k] * o[k]; \
        ss += __shfl_xor(ss, 1); ss += __shfl_xor(ss, 2); \
        const float r = 1.f / sqrtf(ss * (1.f / 64.f) + EPS); \
        const unsigned zu[8] = {S.z0.x, S.z0.y, S.z0.z, S.z0.w, S.z1.x, S.z1.y, S.z1.z, S.z1.w}; \
        unsigned ou[8]; \
        _Pragma("unroll") for (int k = 0; k < 8; ++k) { const float za = __builtin_bit_cast(float, zu[k] << 16), zb = __builtin_bit_cast(float, zu[k] & 0xffff0000u); \
            ou[k] = cvtpk(o[2 * k] * r * gain[2 * k] * siluf(za), o[2 * k + 1] * r * gain[2 * k + 1] * siluf(zb)); } \
        bf16* op = mix + t_ * DM + h_ * 64 + 16 * q4; \
        *(v4u*)(op) = (v4u){ou[0], ou[1], ou[2], ou[3]}; *(v4u*)(op + 8) = (v4u){ou[4], ou[5], ou[6], ou[7]}; \
        LDS_WAIT(); asm volatile("" ::: "memory"); } while (0)
    const int NC = NB * 8 * 128, st = gridDim.x * 2;
    int cid = blockIdx.x * 2 + (wave >> 2);
    OSet s0, s1;
    if (cid < NC) GO_LOAD(s0, cid);
#pragma unroll 1
    for (; cid < NC; cid += 2 * st) {
        if (cid + st < NC) GO_LOAD(s1, cid + st);
        GO_STEP(s0, cid);
        if (cid + st < NC) { if (cid + 2 * st < NC) GO_LOAD(s0, cid + 2 * st); GO_STEP(s1, cid + st); }
    }
#undef GO_LOAD
#undef GO_STEP
}

template <bool DRY, int VAR = 0>
__device__ __forceinline__ void norm_route_mfma(const Args& A, const float* X, const float* ssqp, const float* gain, const float* shift, const float* scale, bf16* H, LAS unsigned char* lds, int tid, int lane, int wave) {
    unsigned char* ws = A.ws;
    const int G = gridDim.x;
    const int l15 = lane & 15, g4 = lane >> 4;
    LAS unsigned char* wfl = lds;
    LAS float* mfl = (LAS float*)(lds + 98304); LAS float* afl = mfl + 1024;
    LAS float* lgs = (LAS float*)(lds + 98304 + 8192 + wave * 3328);
    const float* bg = (const float*)A.in[I_BGRP]; const float* br = (const float*)A.in[I_BRT];
#define P7_LOADW(half) do { const v4u* src_ = (const v4u*)(ws + WS_WRT); \
        for (int q = tid; q < 3072; q += NTHR) { const int nt_ = q >> 10, r_ = q & 1023; const int g_ = (nt_ * 32 + 16 * (half)) * 64 + r_; \
            *(LAS v4u*)(wfl + q * 16) = src_[g_]; *(LAS v4u*)(wfl + 49152 + q * 16) = src_[6144 + g_]; } } while (0)
    int bcur = -1;
    for (int rb = blockIdx.x * 128; rb < TT; rb += G * 128) {
        const int b = rb / SEQ, r0 = rb + wave * 16, row = r0 + l15;
        if (b != bcur) { bcur = b; __syncthreads();
            for (int q = tid; q < 1024; q += NTHR) { mfl[q] = gain[q] * (scale[b * 6144 + q] + 1.0f); afl[q] = shift[b * 6144 + q]; }
            __syncthreads(); }
        const float* xr = X + (size_t)row * DM + 8 * g4;
        float ss;
        {   const f32x4 p4 = *(const f32x4*)(ssqp + (size_t)row * 16 + 4 * g4); ss = (p4.x + p4.y) + (p4.z + p4.w); }
        ss += __shfl_xor(ss, 16); ss += __shfl_xor(ss, 32);
        const float rstd = 1.f / sqrtf(ss * (1.f / DM) + EPS);
        f32x4 acc[3];
#pragma unroll
        for (int nt = 0; nt < 3; ++nt) acc[nt] = (f32x4){0.f, 0.f, 0.f, 0.f};
        bf16* hrow = H + (size_t)row * DM + 8 * g4;
#pragma unroll 1
        for (int half = 0; half < 2; ++half) {
        __syncthreads(); P7_LOADW(half); __syncthreads();
#pragma unroll 4
        for (int ks = 16 * half; ks < 16 * half + 16; ++ks) {
            float hv[8];
            {   const f32x4 a = *(const f32x4*)(xr + 32 * ks), c = *(const f32x4*)(xr + 32 * ks + 4);
                const f32x4 m0 = *(const LAS f32x4*)(mfl + 32 * ks + 8 * g4), m1 = *(const LAS f32x4*)(mfl + 32 * ks + 8 * g4 + 4), h0 = *(const LAS f32x4*)(afl + 32 * ks + 8 * g4), h1 = *(const LAS f32x4*)(afl + 32 * ks + 8 * g4 + 4);
                const f32x4 v0 = a * rstd * m0 + h0, v1 = c * rstd * m1 + h1;
                hv[0] = v0.x; hv[1] = v0.y; hv[2] = v0.z; hv[3] = v0.w; hv[4] = v1.x; hv[5] = v1.y; hv[6] = v1.z; hv[7] = v1.w; }
            unsigned hu[4], lu[4];
#pragma unroll
            for (int p = 0; p < 4; ++p) { hu[p] = cvtpk(hv[2 * p], hv[2 * p + 1]);
                const float ra = hv[2 * p] - __builtin_bit_cast(float, hu[p] << 16), rb2 = hv[2 * p + 1] - __builtin_bit_cast(float, hu[p] & 0xffff0000u); lu[p] = cvtpk(ra, rb2); }
            *(v4u*)(hrow + 32 * ks) = (v4u){hu[0], hu[1], hu[2], hu[3]};
            union { bf16x8_t v; unsigned u[4]; } ah, al; ah.u[0] = hu[0]; ah.u[1] = hu[1]; ah.u[2] = hu[2]; ah.u[3] = hu[3]; al.u[0] = lu[0]; al.u[1] = lu[1]; al.u[2] = lu[2]; al.u[3] = lu[3];
#pragma unroll
            for (int nt = 0; nt < 3; ++nt) { const int fo = ((nt * 16 + (ks & 15)) * 64 + lane) * 16;
                const bf16x8_t bh = *(const LAS bf16x8_t*)(wfl + fo), bl = *(const LAS bf16x8_t*)(wfl + 49152 + fo);
                acc[nt] = __builtin_amdgcn_mfma_f32_16x16x32_bf16(ah.v, bh, acc[nt], 0, 0, 0);
                acc[nt] = __builtin_amdgcn_mfma_f32_16x16x32_bf16(ah.v, bl, acc[nt], 0, 0, 0);
                acc[nt] = __builtin_amdgcn_mfma_f32_16x16x32_bf16(al.v, bh, acc[nt], 0, 0, 0); }
        }
        }
#pragma unroll
        for (int nt = 0; nt < 3; ++nt)
#pragma unroll
            for (int r = 0; r < 4; ++r) lgs[(4 * g4 + r) * 52 + 16 * nt + l15] = acc[nt][r];
        LDS_WAIT(); asm volatile("" ::: "memory");
        if (lane < 16) {
            float lg[36];
#pragma unroll
            for (int q = 0; q < 9; ++q) { const f32x4 v = *(const LAS f32x4*)(lgs + lane * 52 + 4 * q); lg[4 * q] = v.x; lg[4 * q + 1] = v.y; lg[4 * q + 2] = v.z; lg[4 * q + 3] = v.w; }
#pragma unroll
            for (int o = 0; o < 4; ++o) lg[o] += bg[o];
#pragma unroll
            for (int o = 0; o < 32; ++o) lg[4 + o] += br[o];
            int gi = 0; float gm = lg[0];
#pragma unroll
            for (int o = 1; o < 4; ++o) if (lg[o] > gm) { gm = lg[o]; gi = o; }
            float gs = 0.f;
#pragma unroll
            for (int o = 0; o < 4; ++o) gs += __expf(lg[o] - gm);
            const float pg = 1.f / gs;
            float le[8];
#pragma unroll
            for (int j = 0; j < 8; ++j) { le[j] = lg[4 + j];
#pragma unroll
                for (int g = 1; g < 4; ++g) le[j] = (gi == g) ? lg[4 + g * 8 + j] : le[j]; }
            int j1 = 0; float m1 = le[0];
#pragma unroll
            for (int j = 1; j < 8; ++j) if (le[j] > m1) { m1 = le[j]; j1 = j; }
            int j2 = -1; float m2 = -3.0e38f;
#pragma unroll
            for (int j = 0; j < 8; ++j) if (j != j1 && le[j] > m2) { m2 = le[j]; j2 = j; }
            const float ex = __expf(m2 - m1), w1 = pg / (1.f + ex), w2 = pg * ex / (1.f + ex);
            const int e1 = gi * 8 + j1, e2 = gi * 8 + j2, rw = r0 + lane;
            unsigned* ctl = (unsigned*)(ws + WS_CTL);
            int2* erec = (int2*)(ws + WS_EREC); int* clist = (int*)(ws + WS_CLIST);
            if constexpr (DRY) { ((int2*)(ws + WS_PROJ + 168 * MiB))[rw] = make_int2(e1 * 64 + e2, __builtin_bit_cast(int, w1 + w2)); } else {
            const unsigned p1 = atomicAdd(ctl + CW_ECNT + e1, 1u); erec[(size_t)e1 * TT + p1] = make_int2(rw * 2 + (e1 > e2 ? 1 : 0), __builtin_bit_cast(int, w1));
            const unsigned p2 = atomicAdd(ctl + CW_ECNT + e2, 1u); erec[(size_t)e2 * TT + p2] = make_int2(rw * 2 + (e2 > e1 ? 1 : 0), __builtin_bit_cast(int, w2));
            const int a = j1 < j2 ? j1 : j2, bb = j1 < j2 ? j2 : j1;
            const int cls = gi * 28 + (a * 7 - (a * (a - 1)) / 2 + (bb - a - 1));
            const unsigned pc = atomicAdd(ctl + CW_CCNT + cls, 1u); clist[(size_t)cls * TT + pc] = rw; }
        }
        LDS_WAIT(); asm volatile("" ::: "memory");
    }
#undef P7_LOADW
}

__device__ __forceinline__ int wave_incl_scan(int v, int lane) {
#pragma unroll
    for (int o = 1; o < 64; o <<= 1) { const int t = __shfl_up(v, o); if (lane >= o) v += t; }
    return v;
}
struct SchedE {
    int G, c, cntv, prev, total_rt; const int2* rec; const char* W;
    __device__ __forceinline__ void init(const unsigned* cnt, const int2* rec_, const char* W_, int G_, int c_, int lane) {
        G = G_; c = c_; rec = rec_; W = W_;
        cntv = lane < NE ? (int)cnt[lane] : 0;
        const int inc = wave_incl_scan((cntv + 255) >> 8, lane);
        total_rt = __builtin_amdgcn_readlane(inc, 63);
        prev = lane < NE ? inc : 0x7fffffff;
    }
    __device__ __forceinline__ bool next(int i, pg8::UnitG& u) const {
        const int L = i * G + c; if (L >= 2 * total_rt) return false;
        const int rt = L >> 1;
        const int e = __builtin_amdgcn_readfirstlane(__popcll(__ballot(prev <= rt)));
        const int base = e ? __builtin_amdgcn_readlane(prev, e - 1) : 0;
        const int cnt = __builtin_amdgcn_readlane(cntv, e);
        u.id = e; u.tile = rt - base; u.pn = L & 1; const int rem = cnt - u.tile * 256; u.nrows = rem < 256 ? rem : 256;
        return true;
    }
    __device__ __forceinline__ int tok(const pg8::UnitG& u, int r) const { return r < u.nrows ? (rec[(size_t)u.id * TT + u.tile * 256 + r].x >> 1) : 0; }
    __device__ __forceinline__ const char* bseg(const pg8::UnitG& u, int) const { return W + ((size_t)u.id * 512 + u.pn * 256) * 2048; }
};
struct EpiGU {
    static constexpr bool PERM = true;
    bf16* HID;
    __device__ __forceinline__ void operator()(const pg8::f32x4 (&acc)[2][2][4][2], const pg8::UnitG& u, const SchedE& S, int wr, int wc, int fr, int fq) const {
#pragma unroll
        for (int ai = 0; ai < 2; ++ai)
#pragma unroll
            for (int m = 0; m < 4; ++m) { const int r = ai * 128 + wr * 64 + m * 16 + fr;
                if (r < u.nrows) { const int2 rc = S.rec[(size_t)u.id * TT + u.tile * 256 + r]; const int t = rc.x >> 1, half = rc.x & 1; const float w = __builtin_bit_cast(float, rc.y);
                    float hv[8];
#pragma unroll
                    for (int n = 0; n < 2; ++n)
#pragma unroll
                        for (int j = 0; j < 4; ++j) { const float g = acc[ai][0][m][n][j], up = acc[ai][1][m][n][j]; hv[n * 4 + j] = w * siluf(g) * up; }
                    v4u o; o.x = pk2(hv[0], hv[1]); o.y = pk2(hv[2], hv[3]); o.z = pk2(hv[4], hv[5]); o.w = pk2(hv[6], hv[7]);
                    *(v4u*)(HID + (size_t)t * 512 + half * 256 + u.pn * 128 + wc * 32 + 8 * fq) = o; } }
    }
};
struct SchedC {
    int G, c, cntA, cntB, preA, preB, total_rt; const int* clist; const char* W;
    __device__ __forceinline__ void init(const unsigned* cnt, const int* clist_, const char* W_, int G_, int c_, int lane) {
        G = G_; c = c_; clist = clist_; W = W_;
        cntA = (int)cnt[lane]; cntB = lane < NCLS - 64 ? (int)cnt[64 + lane] : 0;
        const int ia = wave_incl_scan((cntA + 255) >> 8, lane); const int ta = __builtin_amdgcn_readlane(ia, 63);
        const int ib = wave_incl_scan((cntB + 255) >> 8, lane) + ta;
        total_rt = __builtin_amdgcn_readlane(ib, 63);
        preA = ia; preB = lane < NCLS - 64 ? ib : 0x7fffffff;
    }
    __device__ __forceinline__ bool next(int i, pg8::UnitG& u) const {
        const int L = i * G + c; if (L >= 4 * total_rt) return false;
        const int rt = L >> 2;
        const int cls = __builtin_amdgcn_readfirstlane(__popcll(__ballot(preA <= rt)) + __popcll(__ballot(preB <= rt)));
        int base = 0; if (cls > 0) base = (cls - 1 < 64) ? __builtin_amdgcn_readlane(preA, cls - 1) : __builtin_amdgcn_readlane(preB, cls - 65);
        const int cnt = cls < 64 ? __builtin_amdgcn_readlane(cntA, cls) : __builtin_amdgcn_readlane(cntB, cls - 64);
        u.id = cls; u.tile = rt - base; u.pn = L & 3; const int rem = cnt - u.tile * 256; u.nrows = rem < 256 ? rem : 256;
        return true;
    }
    __device__ __forceinline__ int tok(const pg8::UnitG& u, int r) const { return r < u.nrows ? clist[(size_t)u.id * TT + u.tile * 256 + r] : 0; }
    __device__ __forceinline__ const char* bseg(const pg8::UnitG& u, int seg) const {
        const int g = u.id / 28; int a = 0, rem = u.id % 28; while (rem >= 7 - a) { rem -= 7 - a; ++a; } const int b = a + 1 + rem;
        const int e = g * 8 + (seg ? b : a);
        return W + ((size_t)e * 1024 + u.pn * 256) * 512;
    }
};
struct EpiDown {
    static constexpr bool PERM = false;
    float* OUT; const float* gate2;
    __device__ __forceinline__ void operator()(const pg8::f32x4 (&acc)[2][2][4][2], const pg8::UnitG& u, const SchedC& S, int wr, int wc, int fr, int fq) const {
#pragma unroll
        for (int ai = 0; ai < 2; ++ai)
#pragma unroll
            for (int m = 0; m < 4; ++m) { const int r = ai * 128 + wr * 64 + m * 16 + fr;
                if (r < u.nrows) { const int t = S.clist[(size_t)u.id * TT + u.tile * 256 + r]; const int b = t / SEQ; const int col0 = u.pn * 256 + wc * 32 + 4 * fq;
                    float* op = OUT + (size_t)t * DM + col0; const float* gp = gate2 + b * 6144 + col0;
#pragma unroll
                    for (int bj = 0; bj < 2; ++bj)
#pragma unroll
                        for (int n = 0; n < 2; ++n) { const int off = bj * 128 + n * 16; const f32x4 xv = *(const f32x4*)(op + off), gv = *(const f32x4*)(gp + off);
                            *(f32x4*)(op + off) = xv + gv * acc[ai][bj][m][n]; } } }
    }
};

__global__ void __launch_bounds__(NTHR, 2) fwd_kernel(Args args) {
    extern __shared__ __attribute__((aligned(16))) unsigned char lds_raw[];
    LAS unsigned char* lds = (LAS unsigned char*)lds_raw;
    volatile LAS unsigned* MISC = (volatile LAS unsigned*)(lds + MISC_OFF);
    const int G = gridDim.x;
    unsigned char* ws = args.ws;
    const int wave_s = __builtin_amdgcn_readfirstlane(threadIdx.x >> 6);
    for (int u = threadIdx.x; u < (LDS_BYTES - LDSCTL_OFF) / 4; u += NTHR) ((LAS unsigned*)(lds + LDSCTL_OFF))[u] = 0u;
    __syncthreads();
    const int lo = args.ph_lo, hi = args.ph_hi;
    const bool use_bar = (hi - lo) > 1;
    XcdBarrier bar; bar.bar = (unsigned*)(ws + WS_CTL) + CW_BAR; bar.x = 0; bar.st = nullptr;
    if (use_bar) bar = xcd_barrier_post((unsigned*)(ws + WS_CTL) + CW_BAR, MISC + 8, threadIdx.x == 0);
#define IN(k) (lo <= (k) && (k) < hi)
#define BOTH(k) (IN(k) && IN((k) + 1))
#define GRID_BAR(k) do { if (BOTH(k)) xcd_barrier(bar, wave_s == 0 && __builtin_amdgcn_mbcnt_hi(~0u, __builtin_amdgcn_mbcnt_lo(~0u, 0u)) == 0u); } while (0)
#define FRESH_IDS() const int wave = wave_s; int lane = (int)__builtin_amdgcn_mbcnt_hi(~0u, __builtin_amdgcn_mbcnt_lo(~0u, 0u)); asm volatile("" : "+v"(lane)); const int tid = wave * 64 + lane; (void)tid
    const float* mod = (const float*)(ws + WS_MOD);

    if (IN(0)) { FRESH_IDS(); p0_prologue(args, lds, tid, lane, wave); GRID_BAR(0); }
    if (IN(1)) { FRESH_IDS(); norm_rows<false>(args, (const float*)args.in[I_X], (const float*)args.in[I_NORM_MIX], mod + 0, mod + 1024, (bf16*)(ws + WS_H), lds, lane, wave); GRID_BAR(1); }
    if (IN(2)) { FRESH_IDS();
        pg8::Gemm g{(const pg8::bf16_t*)(ws + WS_H), (const pg8::bf16_t*)(ws + WS_WINT), TT, NPAD, DM}; pg8::StaticOrder S; S.init(TT, NPAD, G, (int)blockIdx.x);
        pg8::EpiProj E{(pg8::bf16_t*)(ws + WS_PROJ), (float*)(ws + WS_AB), NPROJ};
        pg8::gemm_phase<pg8::EpiProj, pg8::StaticOrder, true, true>(lds, g, S, E);
        GRID_BAR(2);
    }
    if (IN(3)) { FRESH_IDS(); gdn_g1_mfma<31>(args, lds, tid, lane, wave); GRID_BAR(3); }
    if (IN(4)) { FRESH_IDS();
        if ((int)blockIdx.x < 32) gdn_scan(args, (int)blockIdx.x, lds, tid, lane, wave);
        else swa_mfma(args, lds, tid, lane, wave, (int)blockIdx.x - 32, G - 32);
        GRID_BAR(4);
    }
    if (IN(5)) { FRESH_IDS(); gdn_out(args, lds, lane, wave); GRID_BAR(5); }
    if (IN(6)) { FRESH_IDS();
        pg8::Gemm g{(const pg8::bf16_t*)(ws + WS_MIX), (const pg8::bf16_t*)(ws + WS_WOUTT), TT, DM, DM}; pg8::StaticOrder S; S.init(TT, DM, G, (int)blockIdx.x);
        pg8::EpiOut E{(const float*)args.in[I_X], args.out, mod + 2048, SEQ, 6144, (float*)(ws + WS_SSQ)};
        pg8::gemm_phase<pg8::EpiOut, pg8::StaticOrder, true, true>(lds, g, S, E);
        GRID_BAR(6);
    }
    if (IN(7)) { FRESH_IDS(); norm_route_mfma<false>(args, args.out, (const float*)(ws + WS_SSQ), (const float*)args.in[I_NORM_FFN], mod + 3072, mod + 4096, (bf16*)(ws + WS_H), lds, tid, lane, wave); GRID_BAR(7); }
    if (IN(8)) { FRESH_IDS();
        SchedE S; S.init((const unsigned*)(ws + WS_CTL) + CW_ECNT, (const int2*)(ws + WS_EREC), (const char*)(ws + WS_WGUT), G, (int)blockIdx.x, lane);
        EpiGU E{(bf16*)(ws + WS_HID)};
        pg8::gemm_phase_g<EpiGU, SchedE>(lds, (const pg8::bf16_t*)(ws + WS_H), 1024, 1024, 16, 16, S, E);
        GRID_BAR(8);
    }
    if (IN(9)) { FRESH_IDS();
        SchedC S; S.init((const unsigned*)(ws + WS_CTL) + CW_CCNT, (const int*)(ws + WS_CLIST), (const char*)(ws + WS_WDT), G, (int)blockIdx.x, lane);
        EpiDown E{args.out, mod + 5120};
        pg8::gemm_phase_g<EpiDown, SchedC>(lds, (const pg8::bf16_t*)(ws + WS_HID), 512, 256, 8, 4, S, E);
    }
#undef IN
#undef BOTH
#undef GRID_BAR
}

#if PROBE_REP >= 0
template <int P>
__global__ void __launch_bounds__(NTHR, 2) probe_kernel(Args args) {
    extern __shared__ __attribute__((aligned(16))) unsigned char lds_raw[];
    LAS unsigned char* lds = (LAS unsigned char*)lds_raw;
    const int tid = threadIdx.x, lane = tid & 63, wave = __builtin_amdgcn_readfirstlane(tid >> 6);
    const int G = gridDim.x; unsigned char* ws = args.ws; const float* mod = (const float*)(ws + WS_MOD);
    if constexpr (P == 1) norm_rows<false>(args, (const float*)args.in[I_X], (const float*)args.in[I_NORM_MIX], mod + 0, mod + 1024, (bf16*)(ws + WS_GAP + 0)  , lds, lane, wave);
    if constexpr (P == 4) gdn_g1_mfma<31>(args, lds, tid, lane, wave);
    if constexpr (P == 40) gdn_g1_mfma<31, 0>(args, lds, tid, lane, wave);
    if constexpr (P == 41) gdn_g1_mfma<31, 1>(args, lds, tid, lane, wave);
    if constexpr (P == 42) gdn_g1_mfma<31, 3>(args, lds, tid, lane, wave);
    if constexpr (P == 43) gdn_g1_mfma<0, 7>(args, lds, tid, lane, wave);
    if constexpr (P == 50) { if ((int)blockIdx.x < 32) gdn_scan(args, (int)blockIdx.x, lds, tid, lane, wave); }
    if constexpr (P == 52) gdn_out(args, lds, lane, wave);
    if constexpr (P == 51) { if ((int)blockIdx.x >= 32) swa_mfma(args, lds, tid, lane, wave, (int)blockIdx.x - 32, G - 32); }
    if constexpr (P == 6) { pg8::Gemm g{(const pg8::bf16_t*)(ws + WS_MIX), (const pg8::bf16_t*)(ws + WS_WOUTT), TT, DM, DM}; pg8::StaticOrder S; S.init(TT, DM, G, (int)blockIdx.x);
        pg8::EpiOut E{(const float*)args.in[I_X], (float*)(ws + WS_GSF)  , mod + 2048, SEQ, 6144, nullptr}; pg8::gemm_phase<pg8::EpiOut, pg8::StaticOrder, true, true>(lds, g, S, E); }
    if constexpr (P == 8) { SchedE S; S.init((const unsigned*)(ws + WS_CTL) + CW_ECNT, (const int2*)(ws + WS_EREC), (const char*)(ws + WS_WGUT), G, (int)blockIdx.x, lane);
        EpiGU E{(bf16*)(ws + WS_HID)}; pg8::gemm_phase_g<EpiGU, SchedE>(lds, (const pg8::bf16_t*)(ws + WS_H), 1024, 1024, 16, 16, S, E); }
    if constexpr (P == 71) norm_route_mfma<true, 1>(args, args.out, (const float*)(ws + WS_SSQ), (const float*)args.in[I_NORM_FFN], mod + 3072, mod + 4096, (bf16*)(ws + WS_PROJ + 32 * MiB), lds, tid, lane, wave);
    if constexpr (P == 7) norm_route_mfma<true>(args, args.out, (const float*)(ws + WS_SSQ), (const float*)args.in[I_NORM_FFN], mod + 3072, mod + 4096, (bf16*)(ws + WS_PROJ + 32 * MiB), lds, tid, lane, wave);
    if constexpr (P == 9) { SchedC S; S.init((const unsigned*)(ws + WS_CTL) + CW_CCNT, (const int*)(ws + WS_CLIST), (const char*)(ws + WS_WDT), G, (int)blockIdx.x, lane);
        EpiDown E{(float*)(ws + WS_PROJ + 32 * MiB), mod + 5120}; pg8::gemm_phase_g<EpiDown, SchedC>(lds, (const pg8::bf16_t*)(ws + WS_HID), 512, 256, 8, 4, S, E); }
}
#endif
extern "C" void kernel_launch(void* const* d_in, const int* in_sizes, int n_in, void* d_out, int out_size, void* d_ws, size_t ws_size, hipStream_t stream) {
    static int grid = 0;
    if (grid == 0) {
        if (n_in != 23 || in_sizes[0] != TT * DM || out_size != TT * DM || ws_size < WS_END) { fprintf(stderr, "kernel_launch: unexpected shapes: n_in %d in0 %d out %d ws %zu (need %zu)\n", n_in, n_in > 0 ? in_sizes[0] : -1, out_size, ws_size, (size_t)WS_END); grid = -1; return; }
        int dev = 0, cus = 0, per_cu = 0;
        if (hipGetDevice(&dev) != hipSuccess || hipDeviceGetAttribute(&cus, hipDeviceAttributeMultiprocessorCount, dev) != hipSuccess) { grid = -1; return; }
        if (hipFuncSetAttribute((const void*)fwd_kernel, hipFuncAttributeMaxDynamicSharedMemorySize, LDS_BYTES) != hipSuccess) { fprintf(stderr, "kernel_launch: hipFuncSetAttribute failed\n"); grid = -1; return; }
        if (hipOccupancyMaxActiveBlocksPerMultiprocessor(&per_cu, (const void*)fwd_kernel, NTHR, LDS_BYTES) != hipSuccess || per_cu < 1) fprintf(stderr, "kernel_launch: occupancy query reports %d\n", per_cu);
        (void)hipGetLastError();
        grid = cus;
    }
    if (grid < 0) return;
    if (hipMemsetAsync((char*)d_ws + WS_CTL, 0, CTL_ZERO_BYTES, stream) != hipSuccess) { fprintf(stderr, "kernel_launch: memset failed\n"); return; }
    Args a{};
    for (int i = 0; i < 23; ++i) a.in[i] = d_in[i];
    a.out = (float*)d_out; a.ws = (unsigned char*)d_ws;
#if MK_ONE_LAUNCH
    a.ph_lo = 0; a.ph_hi = N_PHASES;
    hipLaunchKernelGGL(fwd_kernel, dim3(grid), dim3(NTHR), LDS_BYTES, stream, a);
#if PROBE_REP >= 0
    hipFuncSetAttribute((const void*)probe_kernel<PROBE_REP>, hipFuncAttributeMaxDynamicSharedMemorySize, LDS_BYTES);
    hipLaunchKernelGGL(probe_kernel<PROBE_REP>, dim3(grid), dim3(NTHR), LDS_BYTES, stream, a);
#endif
#else
    for (int p = 0; p < N_PHASES; ++p) { a.ph_lo = p; a.ph_hi = p + 1; hipLaunchKernelGGL(fwd_kernel, dim3(grid), dim3(NTHR), LDS_BYTES, stream, a); }
#endif
}
```

```cpp
#include <hip/hip_runtime.h>
#include <cstdio>
#include <cstdint>
namespace pg8 {
#define PG8_LAS __attribute__((address_space(3)))
typedef unsigned short bf16_t;
typedef short bf16x8 __attribute__((ext_vector_type(8)));
typedef float f32x4 __attribute__((ext_vector_type(4)));
typedef unsigned u32x4 __attribute__((ext_vector_type(4)));
constexpr int BM = 256, BK = 64, HALF = 128, HTB = HALF * BK * 2  , STAGE_BYTES = 8 * HTB, NXCD = 8, WGM = 8;

__host__ __device__ __forceinline__ int lds_byte(int r, int c) { const int st = (r >> 4) * 2 + (c >> 5), rr = r & 15, cc = c & 31, ob = rr * 64 + cc * 2; return st * 1024 + (ob ^ (((ob >> 9) & 1) << 5)); }
__host__ __device__ __forceinline__ void stage_rc(int b, int& R, int& C) { const int st = b / 1024, sb = b % 1024, swz = sb ^ (((sb >> 9) & 1) << 5); R = (st >> 1) * 16 + swz / 64; C = (st & 1) * 32 + (swz % 64) / 2; }
__host__ __device__ __forceinline__ int perm32(int rho) { const int n = rho >> 4, i = rho & 15; return 8 * (i >> 2) + 4 * n + (i & 3); }

struct Unit { int pm, pn; };
struct Gemm { const bf16_t* A; const bf16_t* Bt; int M, N, K; };

struct StaticOrder {
    int nM, nN, nwg, G, c;
    __host__ __device__ void init(int M, int N, int G_, int c_) { nM = M / BM; nN = N / BM; nwg = nM * nN; G = G_; c = c_; }
    __host__ __device__ bool next(int i, Unit& u) const {
        const long L = (long)i * G + c; if (L >= nwg) return false;
        int wgid = (int)L; { const int q = nwg / NXCD, r = nwg % NXCD, xcd = wgid % NXCD, off = wgid / NXCD; wgid = (xcd < r ? xcd * (q + 1) : r * (q + 1) + (xcd - r) * q) + off; }
        const int nig = WGM * nN, gid = wgid / nig, fm = gid * WGM, gsz = (nM - fm) < WGM ? (nM - fm) : WGM;
        u.pm = fm + ((wgid % nig) % gsz); u.pn = (wgid % nig) / gsz; return true;
    }
    __device__ __forceinline__ void a_ready(const Unit&) const {}
    __device__ __forceinline__ void done(const Unit&) const {}
};

__device__ __forceinline__ unsigned cvt_pk_bf16(float lo, float hi) { unsigned r; asm volatile("v_cvt_pk_bf16_f32 %0, %1, %2" : "=v"(r) : "v"(lo), "v"(hi)); return r; }

struct EpiProj {
    static constexpr bool PERM = true, AFTER_DRAIN = false;
    bf16_t* P; float* AB; int ldp;
    __device__ __forceinline__ void operator()(const f32x4 (&acc)[2][2][4][2], const Unit& u, int wr, int wc, int fr, int fq) const {
        const int row0 = u.pm * BM + wr * 64 + fr;
        if (u.pn < 11) {
            const int col0 = u.pn * BM + wc * 32 + 8 * fq;
#pragma unroll
            for (int ai = 0; ai < 2; ++ai)
#pragma unroll
                for (int m = 0; m < 4; ++m) { bf16_t* rowp = P + (size_t)(row0 + ai * HALF + m * 16) * ldp + col0;
#pragma unroll
                    for (int bj = 0; bj < 2; ++bj) { const f32x4 v0 = acc[ai][bj][m][0], v1 = acc[ai][bj][m][1];
                        u32x4 w; w.x = cvt_pk_bf16(v0[0], v0[1]); w.y = cvt_pk_bf16(v0[2], v0[3]); w.z = cvt_pk_bf16(v1[0], v1[1]); w.w = cvt_pk_bf16(v1[2], v1[3]);
                        *(u32x4*)(rowp + bj * HALF) = w; } }
        } else if (wc == 0 && fq < 2) {
#pragma unroll
            for (int ai = 0; ai < 2; ++ai)
#pragma unroll
                for (int m = 0; m < 4; ++m) { float* rowp = AB + (size_t)(row0 + ai * HALF + m * 16) * 16 + 8 * fq;
                    *(f32x4*)(rowp) = acc[ai][0][m][0]; *(f32x4*)(rowp + 4) = acc[ai][0][m][1]; }
        }
    }
};
struct EpiOut {
    static constexpr bool PERM = false, AFTER_DRAIN = false;
    const float* X; float* O; const float* gate; int rows_per_batch, ldg;
    float* SSQ;
    __device__ __forceinline__ void operator()(const f32x4 (&acc)[2][2][4][2], const Unit& u, int wr, int wc, int fr, int fq) const {
        const int row0 = u.pm * BM + wr * 64 + fr, col0 = u.pn * BM + wc * 32 + 4 * fq;
        const float* gb = gate + (size_t)((u.pm * BM) / rows_per_batch) * ldg + col0;
        f32x4 gv[2][2];
#pragma unroll
        for (int bj = 0; bj < 2; ++bj)
#pragma unroll
            for (int n = 0; n < 2; ++n) gv[bj][n] = *(const f32x4*)(gb + bj * HALF + n * 16);
#pragma unroll
        for (int ai = 0; ai < 2; ++ai)
#pragma unroll
            for (int m = 0; m < 4; ++m) { const size_t ro = (size_t)(row0 + ai * HALF + m * 16) * 1024 + col0; float ss = 0.f;
#pragma unroll
                for (int bj = 0; bj < 2; ++bj)
#pragma unroll
                    for (int n = 0; n < 2; ++n) { const f32x4 xv = *(const f32x4*)(X + ro + bj * HALF + n * 16); const f32x4 v = xv + gv[bj][n] * acc[ai][bj][m][n];
                        *(f32x4*)(O + ro + bj * HALF + n * 16) = v; ss += (v.x * v.x + v.y * v.y) + (v.z * v.z + v.w * v.w); }
                if (SSQ) { ss += __shfl_xor(ss, 16); ss += __shfl_xor(ss, 32); if (fq == 0) SSQ[(size_t)(row0 + ai * HALF + m * 16) * 16 + u.pn * 4 + wc] = ss; } }
    }
};

struct UnitG { int id, tile, pn, nrows; };
template <class Epi, class Sched>
__device__ __forceinline__ void gemm_phase_g(PG8_LAS unsigned char* lds, const bf16_t* Abase, const int KA, const int KB, const int nt, const int ksplit, const Sched& S, const Epi& E) {
    const int tid = threadIdx.x, wid = __builtin_amdgcn_readfirstlane(tid >> 6), lane = tid & 63, wr = wid >> 2, wc = wid & 3, fr = lane & 15, fq = lane >> 4;
    int Rr[2]; unsigned cB2[2], voffB[2];
#pragma unroll
    for (int i = 0; i < 2; ++i) { int R, C; stage_rc(tid * 16 + i * 8192, R, C); const int Rb = Epi::PERM ? ((R & ~31) + perm32(R & 31)) : R;
        Rr[i] = R; cB2[i] = (unsigned)C * 2u; voffB[i] = (unsigned)(Rb * KB + C) * 2u; }
    const size_t kstep = (size_t)(BK * 2);
    const size_t hstepB = (size_t)HALF * KB * 2;
    const unsigned ldsw = (unsigned)wid * 1024u;
    const int aoff = lds_byte(wr * 64 + fr, fq * 8), boff = lds_byte(wc * 32 + fr, fq * 8);
#define PG8_SA(b, h) (((b) * 2 + (h)) * HTB)
#define PG8_SB(b, h) ((4 + (b) * 2 + (h)) * HTB)
#define PG8_STAGE2(bufoff, gbase, v0, v1) do { \
        __builtin_amdgcn_global_load_lds((const unsigned*)((const char*)(gbase) + (v0)), (PG8_LAS unsigned*)(lds + (bufoff) + ldsw), 16, 0, 0); \
        __builtin_amdgcn_global_load_lds((const unsigned*)((const char*)(gbase) + (v1)), (PG8_LAS unsigned*)(lds + (bufoff) + ldsw + 8192), 16, 0, 0); } while (0)
#define PG8_LDA(dst, b, h) do { _Pragma("unroll") for (int m = 0; m < 4; ++m) _Pragma("unroll") for (int k = 0; k < 2; ++k) dst[m][k] = *(const PG8_LAS bf16x8*)(lds + PG8_SA(b, h) + aoff + m * 2048 + k * 1024); } while (0)
#define PG8_LDB(dst, b, h) do { _Pragma("unroll") for (int n = 0; n < 2; ++n) _Pragma("unroll") for (int k = 0; k < 2; ++k) dst[n][k] = *(const PG8_LAS bf16x8*)(lds + PG8_SB(b, h) + boff + n * 2048 + k * 1024); } while (0)
#define PG8_MMA(ai, bj, At, Bt) do { __builtin_amdgcn_s_setprio(1); _Pragma("unroll") for (int m = 0; m < 4; ++m) _Pragma("unroll") for (int n = 0; n < 2; ++n) _Pragma("unroll") for (int k = 0; k < 2; ++k) \
        acc[ai][bj][m][n] = __builtin_amdgcn_mfma_f32_16x16x32_bf16(Bt[n][k], At[m][k], acc[ai][bj][m][n], 0, 0, 0); __builtin_amdgcn_s_setprio(0); } while (0)
#define PG8_WAIT_V(n) asm volatile("s_waitcnt vmcnt(" #n ")" ::: "memory")
#define PG8_WAIT_L(n) asm volatile("s_waitcnt lgkmcnt(" #n ")" ::: "memory")
#define PG8_BAR __builtin_amdgcn_s_barrier()
#define PG8_SCHED __builtin_amdgcn_sched_barrier(0)
#define PG8_AOFFS(u, o00, o01, o10, o11) do { const unsigned _ks = (unsigned)KA * 2u; \
        o00 = (unsigned)S.tok(u, Rr[0]) * _ks + cB2[0]; o01 = (unsigned)S.tok(u, Rr[1]) * _ks + cB2[1]; \
        o10 = (unsigned)S.tok(u, HALF + Rr[0]) * _ks + cB2[0]; o11 = (unsigned)S.tok(u, HALF + Rr[1]) * _ks + cB2[1]; } while (0)
#define PG8_BT(u, t) (((t) < ksplit) ? S.bseg(u, 0) + (size_t)(t) * kstep : S.bseg(u, 1) + (size_t)((t) - ksplit) * kstep)
    UnitG cur, nxt; int ui = 0;
    if (!S.next(0, cur)) return;
    f32x4 acc[2][2][4][2];
#pragma unroll
    for (int a = 0; a < 2; ++a)
#pragma unroll
        for (int b = 0; b < 2; ++b)
#pragma unroll
            for (int m = 0; m < 4; ++m)
#pragma unroll
                for (int n = 0; n < 2; ++n) acc[a][b][m][n] = (f32x4){0.f, 0.f, 0.f, 0.f};
    bf16x8 At[4][2], B0[2][2], B1[2][2];
    unsigned c00, c01, c10, c11, n00 = 0, n01 = 0, n10 = 0, n11 = 0;
    PG8_AOFFS(cur, c00, c01, c10, c11);
    const char* const Ab = (const char*)Abase;
    {   const char* b0p = PG8_BT(cur, 0); const char* b1p = PG8_BT(cur, 1);
        PG8_STAGE2(PG8_SB(0, 0), b0p, voffB[0], voffB[1]); PG8_STAGE2(PG8_SB(0, 1), b0p + hstepB, voffB[0], voffB[1]); PG8_STAGE2(PG8_SA(0, 0), Ab, c00, c01); PG8_STAGE2(PG8_SA(0, 1), Ab, c10, c11);
        if (wr == 1) PG8_BAR;
        PG8_WAIT_V(2); PG8_BAR;
        PG8_STAGE2(PG8_SB(1, 0), b1p, voffB[0], voffB[1]); PG8_STAGE2(PG8_SA(1, 0), Ab + kstep, c00, c01); PG8_STAGE2(PG8_SB(1, 1), b1p + hstepB, voffB[0], voffB[1]);
        PG8_WAIT_V(6); PG8_BAR;
    }
    for (;;) {
        const bool has_next = S.next(ui + 1, nxt);
        const bool h1 = cur.nrows > HALF;
        for (int t = 0; t < nt; t += 2) {
            const bool last = (t == nt - 2);
            if (last && has_next) PG8_AOFFS(nxt, n00, n01, n10, n11);
            const bool usen = last && has_next;
            const int t2 = last ? 0 : t + 2, t3 = t2 + 1;
            const char* a1 = Ab + (size_t)(t + 1) * kstep;
            const char* a2 = Ab + (size_t)t2 * kstep; const char* a3 = Ab + (size_t)t3 * kstep;
            const char* b2 = usen ? PG8_BT(nxt, t2) : PG8_BT(cur, t2); const char* b3 = usen ? PG8_BT(nxt, t3) : PG8_BT(cur, t3);
            const unsigned o00 = usen ? n00 : c00, o01 = usen ? n01 : c01, o10 = usen ? n10 : c10, o11 = usen ? n11 : c11;
            PG8_LDB(B0, 0, 0); PG8_LDB(B1, 0, 1); PG8_SCHED; PG8_LDA(At, 0, 0); PG8_STAGE2(PG8_SA(1, 1), a1, c10, c11);
            PG8_WAIT_V(8); PG8_WAIT_L(0); PG8_BAR; PG8_MMA(0, 0, At, B0); PG8_MMA(0, 1, At, B1); PG8_BAR; PG8_SCHED;
            PG8_LDA(At, 0, 1); PG8_STAGE2(PG8_SB(0, 0), b2, voffB[0], voffB[1]); PG8_STAGE2(PG8_SB(0, 1), b2 + hstepB, voffB[0], voffB[1]); PG8_STAGE2(PG8_SA(0, 0), a2, o00, o01);
            PG8_WAIT_V(8); PG8_WAIT_L(0); PG8_BAR; if (h1) { PG8_MMA(1, 0, At, B0); PG8_MMA(1, 1, At, B1); } PG8_BAR; PG8_SCHED;
            PG8_LDB(B0, 1, 0); PG8_LDB(B1, 1, 1); PG8_SCHED; PG8_LDA(At, 1, 0); PG8_STAGE2(PG8_SA(0, 1), a2, o10, o11);
            PG8_WAIT_V(8); PG8_WAIT_L(0); PG8_BAR; PG8_MMA(0, 0, At, B0); PG8_MMA(0, 1, At, B1); PG8_BAR; PG8_SCHED;
            PG8_LDA(At, 1, 1); PG8_STAGE2(PG8_SB(1, 0), b3, voffB[0], voffB[1]); PG8_STAGE2(PG8_SB(1, 1), b3 + hstepB, voffB[0], voffB[1]); PG8_STAGE2(PG8_SA(1, 0), a3, o00, o01);
            PG8_WAIT_V(8); PG8_WAIT_L(0); PG8_BAR; if (h1) { PG8_MMA(1, 0, At, B0); PG8_MMA(1, 1, At, B1); } PG8_BAR; PG8_SCHED;
        }
        if (wr == 0) PG8_BAR;
        E(acc, cur, S, wr, wc, fr, fq);
        if (!has_next) break;
#pragma unroll
        for (int a = 0; a < 2; ++a)
#pragma unroll
            for (int b = 0; b < 2; ++b)
#pragma unroll
                for (int m = 0; m < 4; ++m)
#pragma unroll
                    for (int n = 0; n < 2; ++n) acc[a][b][m][n] = (f32x4){0.f, 0.f, 0.f, 0.f};
        cur = nxt; c00 = n00; c01 = n01; c10 = n10; c11 = n11; ++ui;
        if (wr == 1) PG8_BAR;
    }
    PG8_WAIT_V(0);
    PG8_BAR;
#undef PG8_SA
#undef PG8_SB
#undef PG8_STAGE2
#undef PG8_LDA
#undef PG8_LDB
#undef PG8_MMA
#undef PG8_WAIT_V
#undef PG8_WAIT_L
#undef PG8_BAR
#undef PG8_SCHED
#undef PG8_AOFFS
#undef PG8_BT
}
template <class Epi, class Sched, bool ALIGN_EPI = false, bool SP2 = false>
__device__ __forceinline__ void gemm_phase(PG8_LAS unsigned char* lds, const Gemm g, const Sched& S, const Epi& E) {
    const int tid = threadIdx.x, wid = __builtin_amdgcn_readfirstlane(tid >> 6), lane = tid & 63, wr = wid >> 2, wc = wid & 3, fr = lane & 15, fq = lane >> 4;
    const int K = g.K, nt = K / BK;
    unsigned voffA[2], voffB[2];
#pragma unroll
    for (int i = 0; i < 2; ++i) { int R, C; stage_rc(tid * 16 + i * 8192, R, C); const int Rb = Epi::PERM ? ((R & ~31) + perm32(R & 31)) : R;
        voffA[i] = (unsigned)(R * K + C) * 2u; voffB[i] = (unsigned)(Rb * K + C) * 2u; }
    const size_t kstep = (size_t)(BK * 2);
    const size_t hstep = (size_t)HALF * K * 2;
    const size_t tstep = 2 * hstep;
    const unsigned ldsw = (unsigned)wid * 1024u;
    const int aoff = lds_byte(wr * 64 + fr, fq * 8), boff = lds_byte(wc * 32 + fr, fq * 8);
#define PG8_SA(b, h) (((b) * 2 + (h)) * HTB)
#define PG8_SB(b, h) ((4 + (b) * 2 + (h)) * HTB)
#define PG8_STAGE(bufoff, gbase, voff) do { _Pragma("unroll") for (int _i = 0; _i < 2; ++_i) \
        __builtin_amdgcn_global_load_lds((const unsigned*)((const char*)(gbase) + (voff)[_i]), (PG8_LAS unsigned*)(lds + (bufoff) + ldsw + _i * 8192), 16, 0, 0); } while (0)
#define PG8_LDA(dst, b, h) do { _Pragma("unroll") for (int m = 0; m < 4; ++m) _Pragma("unroll") for (int k = 0; k < 2; ++k) dst[m][k] = *(const PG8_LAS bf16x8*)(lds + PG8_SA(b, h) + aoff + m * 2048 + k * 1024); } while (0)
#define PG8_LDB(dst, b, h) do { _Pragma("unroll") for (int n = 0; n < 2; ++n) _Pragma("unroll") for (int k = 0; k < 2; ++k) dst[n][k] = *(const PG8_LAS bf16x8*)(lds + PG8_SB(b, h) + boff + n * 2048 + k * 1024); } while (0)
#define PG8_MMA(ai, bj, At, Bt) do { __builtin_amdgcn_s_setprio(1); _Pragma("unroll") for (int m = 0; m < 4; ++m) _Pragma("unroll") for (int n = 0; n < 2; ++n) _Pragma("unroll") for (int k = 0; k < 2; ++k) \
        acc[ai][bj][m][n] = __builtin_amdgcn_mfma_f32_16x16x32_bf16(Bt[n][k], At[m][k], acc[ai][bj][m][n], 0, 0, 0); __builtin_amdgcn_s_setprio(0); } while (0)
#define PG8_WAIT_V(n) asm volatile("s_waitcnt vmcnt(" #n ")" ::: "memory")
#define PG8_WAIT_L(n) asm volatile("s_waitcnt lgkmcnt(" #n ")" ::: "memory")
#define PG8_BAR __builtin_amdgcn_s_barrier()
#define PG8_SCHED __builtin_amdgcn_sched_barrier(0)
    Unit cur, nxt; int ui = 0;
    if (!S.next(0, cur)) return;
    f32x4 acc[2][2][4][2];
#pragma unroll
    for (int a = 0; a < 2; ++a)
#pragma unroll
        for (int b = 0; b < 2; ++b)
#pragma unroll
            for (int m = 0; m < 4; ++m)
#pragma unroll
                for (int n = 0; n < 2; ++n) acc[a][b][m][n] = (f32x4){0.f, 0.f, 0.f, 0.f};
    bf16x8 At[4][2], B0[2][2], B1[2][2];
    const char* cA = (const char*)g.A + (size_t)cur.pm * tstep; const char* cB = (const char*)g.Bt + (size_t)cur.pn * tstep;
    S.a_ready(cur);
    if constexpr (SP2) {
        PG8_STAGE(PG8_SB(0, 0), cB, voffB); PG8_STAGE(PG8_SB(0, 1), cB + hstep, voffB); PG8_STAGE(PG8_SA(0, 0), cA, voffA); PG8_STAGE(PG8_SA(0, 1), cA + hstep, voffA);
        if (wr == 1) PG8_BAR;
        PG8_WAIT_V(2); PG8_BAR;
        PG8_STAGE(PG8_SB(1, 0), cB + kstep, voffB); PG8_STAGE(PG8_SA(1, 0), cA + kstep, voffA); PG8_STAGE(PG8_SB(1, 1), cB + hstep + kstep, voffB);
        PG8_WAIT_V(6); PG8_BAR;
    } else {
        PG8_STAGE(PG8_SB(0, 0), cB, voffB); PG8_STAGE(PG8_SA(0, 0), cA, voffA); PG8_STAGE(PG8_SB(0, 1), cB + hstep, voffB); PG8_STAGE(PG8_SA(0, 1), cA + hstep, voffA);
        if (wr == 1) PG8_BAR;
        PG8_WAIT_V(4); PG8_BAR;
        PG8_STAGE(PG8_SB(1, 0), cB + kstep, voffB); PG8_STAGE(PG8_SA(1, 0), cA + kstep, voffA); PG8_STAGE(PG8_SB(1, 1), cB + hstep + kstep, voffB);
        PG8_WAIT_V(6); PG8_BAR;
    }
    for (;;) {
        const bool has_next = S.next(ui + 1, nxt);
        const char* nA = has_next ? (const char*)g.A + (size_t)nxt.pm * tstep : cA; const char* nB = has_next ? (const char*)g.Bt + (size_t)nxt.pn * tstep : cB;
        for (int t = 0; t < nt; t += 2) {
            const bool last = (t == nt - 2);
            const char* a1 = cA + (size_t)(t + 1) * kstep;
            const char* a2 = last ? nA : cA + (size_t)(t + 2) * kstep; const char* b2 = last ? nB : cB + (size_t)(t + 2) * kstep;
            const char* a3 = a2 + kstep; const char* b3 = b2 + kstep;
            if (last && has_next) S.a_ready(nxt);
            if constexpr (SP2) {
            PG8_LDB(B0, 0, 0); PG8_LDB(B1, 0, 1); PG8_SCHED; PG8_LDA(At, 0, 0); PG8_STAGE(PG8_SA(1, 1), a1 + hstep, voffA);
            PG8_WAIT_V(8); PG8_WAIT_L(0); PG8_BAR; PG8_MMA(0, 0, At, B0); PG8_MMA(0, 1, At, B1); PG8_BAR; PG8_SCHED;
            PG8_LDA(At, 0, 1); PG8_STAGE(PG8_SB(0, 0), b2, voffB); PG8_STAGE(PG8_SB(0, 1), b2 + hstep, voffB); PG8_STAGE(PG8_SA(0, 0), a2, voffA);
            PG8_WAIT_V(8); PG8_WAIT_L(0); PG8_BAR; PG8_MMA(1, 0, At, B0); PG8_MMA(1, 1, At, B1); PG8_BAR; PG8_SCHED;
            PG8_LDB(B0, 1, 0); PG8_LDB(B1, 1, 1); PG8_SCHED; PG8_LDA(At, 1, 0); PG8_STAGE(PG8_SA(0, 1), a2 + hstep, voffA);
            PG8_WAIT_V(8); PG8_WAIT_L(0); PG8_BAR; PG8_MMA(0, 0, At, B0); PG8_MMA(0, 1, At, B1); PG8_BAR; PG8_SCHED;
            PG8_LDA(At, 1, 1); PG8_STAGE(PG8_SB(1, 0), b3, voffB); PG8_STAGE(PG8_SB(1, 1), b3 + hstep, voffB); PG8_STAGE(PG8_SA(1, 0), a3, voffA);
            PG8_WAIT_V(8); PG8_WAIT_L(0); PG8_BAR; PG8_MMA(1, 0, At, B0); PG8_MMA(1, 1, At, B1); PG8_BAR; PG8_SCHED;
            } else {
            PG8_LDB(B0, 0, 0); PG8_SCHED; PG8_LDA(At, 0, 0); PG8_STAGE(PG8_SA(1, 1), a1 + hstep, voffA);
            PG8_WAIT_L(8); PG8_BAR; PG8_WAIT_L(0); PG8_MMA(0, 0, At, B0); PG8_BAR; PG8_SCHED;
            PG8_LDB(B1, 0, 1); PG8_STAGE(PG8_SB(0, 0), b2, voffB);
            PG8_BAR; PG8_WAIT_L(0); PG8_MMA(0, 1, At, B1); PG8_BAR;
            PG8_LDA(At, 0, 1); PG8_STAGE(PG8_SA(0, 0), a2, voffA);
            PG8_BAR; PG8_WAIT_L(0); PG8_MMA(1, 0, At, B0); PG8_BAR; PG8_SCHED;
            PG8_STAGE(PG8_SB(0, 1), b2 + hstep, voffB);
            PG8_WAIT_V(6); PG8_BAR; PG8_MMA(1, 1, At, B1); PG8_BAR;
            PG8_LDB(B0, 1, 0); PG8_SCHED; PG8_LDA(At, 1, 0); PG8_STAGE(PG8_SA(0, 1), a2 + hstep, voffA);
            PG8_WAIT_L(8); PG8_BAR; PG8_WAIT_L(0); PG8_MMA(0, 0, At, B0); PG8_BAR; PG8_SCHED;
            PG8_LDB(B1, 1, 1); PG8_STAGE(PG8_SB(1, 0), b3, voffB);
            PG8_BAR; PG8_WAIT_L(0); PG8_MMA(0, 1, At, B1); PG8_BAR;
            PG8_LDA(At, 1, 1); PG8_STAGE(PG8_SA(1, 0), a3, voffA);
            PG8_BAR; PG8_WAIT_L(0); PG8_MMA(1, 0, At, B0); PG8_BAR; PG8_SCHED;
            PG8_STAGE(PG8_SB(1, 1), b3 + hstep, voffB);
            PG8_WAIT_V(6); PG8_BAR; PG8_MMA(1, 1, At, B1); PG8_BAR;
            }
        }
        if constexpr (ALIGN_EPI) { if (wr == 0) PG8_BAR; }
        if constexpr (!Epi::AFTER_DRAIN) { E(acc, cur, wr, wc, fr, fq); S.done(cur); }
        if (!has_next) break;
#pragma unroll
        for (int a = 0; a < 2; ++a)
#pragma unroll
            for (int b = 0; b < 2; ++b)
#pragma unroll
                for (int m = 0; m < 4; ++m)
#pragma unroll
                    for (int n = 0; n < 2; ++n) acc[a][b][m][n] = (f32x4){0.f, 0.f, 0.f, 0.f};
        cur = nxt; cA = nA; cB = nB; ++ui;
        if constexpr (ALIGN_EPI) { if (wr == 1) PG8_BAR; }
    }
    PG8_WAIT_V(0);
    if constexpr (!ALIGN_EPI) { if (wr == 0) PG8_BAR; }
    PG8_BAR;
    if constexpr (Epi::AFTER_DRAIN) { E.fused(acc, cur, wr, wc, fr, fq, lds, wid, lane); S.done(cur); }
#undef PG8_SA
#undef PG8_SB
#undef PG8_STAGE
#undef PG8_LDA
#undef PG8_LDB
#undef PG8_MMA
#undef PG8_WAIT_V
#undef PG8_WAIT_L
#undef PG8_BAR
#undef PG8_SCHED
}
}

constexpr int NB = 4, SEQ = 8192, DM = 1024, TT = NB * SEQ;
constexpr int NPROJ = 2816, NPAD = 3072;
constexpr int PC_Q = 0, PC_K = 512, PC_V = 1024, PC_Z = 1536, PC_SQ = 2048, PC_SK = 2560, PC_SV = 2688;
constexpr int NE = 32, NCLS = 112, DE = 256;
constexpr float EPS = 1e-6f;
constexpr int NWAVES = 8, NTHR = 512;
constexpr int N_PHASES = 10;
#ifndef G1_SM
#define G1_SM 31
#endif
#ifndef PROBE_REP
#define PROBE_REP -1
#endif
#ifndef MK_ONE_LAUNCH
#define MK_ONE_LAUNCH 1
#endif

constexpr size_t MiB = 1u << 20;
constexpr size_t WS_CTL = 0, CTL_ZERO_BYTES = 1 * MiB;
constexpr size_t WS_MOD = 1 * MiB;
constexpr size_t WS_WINT = 2 * MiB, WS_WOUTT = 8 * MiB, WS_WGUT = 10 * MiB, WS_WDT = 42 * MiB;
constexpr size_t WS_H = 58 * MiB;
constexpr size_t WS_PROJ = 122 * MiB;
constexpr size_t WS_AB = 298 * MiB;
constexpr size_t WS_SSQ = WS_AB;
constexpr size_t WS_MIX = 300 * MiB;
constexpr size_t WS_GSF = 364 * MiB;
constexpr size_t WS_EREC = 404 * MiB, WS_CLIST = 412 * MiB;
constexpr size_t WS_HID = WS_PROJ;
constexpr size_t WS_GAP = WS_H, WS_GQP = WS_H + 32 * MiB;
constexpr size_t WS_GOP = 426 * MiB, WS_GBP = 458 * MiB, WS_GGL = 490 * MiB;
constexpr size_t WS_WRT = 491 * MiB;
constexpr size_t WS_END = 492 * MiB;
constexpr int CW_BAR = 4096, CW_ECNT = 8192, CW_CCNT = 8256;

constexpr int RING_BYTES = 131072, LDSCTL_OFF = RING_BYTES, LDS_BYTES = 147456, MISC_OFF = LDS_BYTES - 128;

#define GAS __attribute__((address_space(1)))
#define LAS __attribute__((address_space(3)))
typedef unsigned short bf16;
typedef unsigned v4u __attribute__((ext_vector_type(4)));
typedef float f32x4 __attribute__((ext_vector_type(4)));
typedef GAS unsigned gu32;
#define RLX_AGENT __ATOMIC_RELAXED, __HIP_MEMORY_SCOPE_AGENT
#define LDS_WAIT() asm volatile("s_waitcnt lgkmcnt(0)" ::: "memory")
__device__ __forceinline__ unsigned f2bf(float f) { unsigned u = __builtin_bit_cast(unsigned, f); return (u + 0x7fffu + ((u >> 16) & 1u)) >> 16; }
__device__ __forceinline__ unsigned pk2(float lo, float hi) { return f2bf(lo) | (f2bf(hi) << 16); }
__device__ __forceinline__ float bf2f(bf16 v) { return __builtin_bit_cast(float, (unsigned)v << 16); }
__device__ __forceinline__ float wave_sum(float v) {
#pragma unroll
    for (int o = 1; o < 64; o <<= 1) v += __shfl_xor(v, o);
    return v;
}
__device__ __forceinline__ float siluf(float y) { return y / (1.f + __expf(-y)); }
#define XB_TMO      128
#define XB_XCNT(j)  (256  + 64 * (j))
#define XB_XSUB(j)  (1280 + 64 * (j))
#define XB_XGEN(j)  (2304 + 64 * (j))
#define XB_TOP      3328
#define XB_TOPGEN   3392
#define XCD_BAR_WORDS 3456
#define XB_SPIN_CAP (1u << 18)
__device__ __forceinline__ unsigned xb_ld(unsigned* p)              { return __hip_atomic_load(p, __ATOMIC_RELAXED, __HIP_MEMORY_SCOPE_AGENT); }
__device__ __forceinline__ unsigned xb_add(unsigned* p, unsigned v) { return __hip_atomic_fetch_add(p, v, __ATOMIC_RELAXED, __HIP_MEMORY_SCOPE_AGENT); }
__device__ __forceinline__ unsigned xb_xcc_id() { return (unsigned)__builtin_amdgcn_s_getreg((3 << 11) | 20) & 0xFu; }
#define XB_SPIN(cond, bar) do { unsigned _sp = 0; while (cond) { __builtin_amdgcn_s_sleep(1); \
    if ((++_sp & 255u) == 0u) { if (xb_ld(&(bar)[XB_TMO])) break; if (_sp > XB_SPIN_CAP) { atomicAdd(&(bar)[XB_TMO], 1u); break; } } } } while (0)

struct XcdBarrier {
    unsigned* bar; unsigned x;
    volatile LAS unsigned* st;
};

__device__ __forceinline__ XcdBarrier xcd_barrier_post(unsigned* bar, volatile LAS unsigned* st, bool leader  ) {
    XcdBarrier b; b.bar = bar; b.x = xb_xcc_id(); b.st = st;
    if (leader) (void)xb_add(&bar[XB_XCNT(b.x)], 1u);
    return b;
}
__device__ __forceinline__ void xcd_barrier_complete(unsigned* bar, unsigned x, unsigned& nloc, unsigned& nx) {
    const unsigned G = gridDim.x * gridDim.y * gridDim.z;
    unsigned sum, cnt, mine, sp = 0u;
    for (;;) {
        sum = 0u; cnt = 0u; mine = 0u;
#pragma unroll
        for (unsigned j = 0; j < 16; ++j) { const unsigned c = xb_ld(&bar[XB_XCNT(j)]); sum += c; cnt += (c > 0u) ? 1u : 0u; mine = (j == x) ? c : mine; }
        if (sum == G) break;
        __builtin_amdgcn_s_sleep(1);
        if ((++sp & 255u) == 0u) { if (xb_ld(&bar[XB_TMO])) break; if (sp > XB_SPIN_CAP) { atomicAdd(&bar[XB_TMO], 1u); break; } }
    }
    nloc = mine > 0u ? mine : 1u; nx = cnt > 0u ? cnt : 1u;
}

__device__ __forceinline__ void xcd_barrier(const XcdBarrier& b, bool leader  ) {
    asm volatile("s_waitcnt vmcnt(0)" ::: "memory");
    __syncthreads();
    if (leader) {
        unsigned* bar = b.bar;
        __builtin_amdgcn_s_waitcnt(0);
        unsigned nloc = b.st[0], nx = b.st[1];
        if (nloc == 0u) { xcd_barrier_complete(bar, b.x, nloc, nx); b.st[0] = nloc; b.st[1] = nx; }
        const unsigned old = xb_add(&bar[XB_XSUB(b.x)], 1u);
        const unsigned gen = old / nloc;
        if (old + 1u == (gen + 1u) * nloc) {
            __builtin_amdgcn_fence(__ATOMIC_RELEASE, "agent");
            asm volatile("s_waitcnt vmcnt(0)" ::: "memory");
            const unsigned og = xb_add(&bar[XB_TOP], 1u);
            const unsigned tg = og / nx;
            if (og + 1u == (tg + 1u) * nx) xb_add(&bar[XB_TOPGEN], 1u);
            else XB_SPIN(xb_ld(&bar[XB_TOPGEN]) == tg, bar);
            __builtin_amdgcn_fence(__ATOMIC_ACQUIRE, "agent");
            xb_add(&bar[XB_XGEN(b.x)], 1u);
            asm volatile("s_waitcnt vmcnt(0)" ::: "memory");
        } else {
            XB_SPIN(xb_ld(&bar[XB_XGEN(b.x)]) == gen, bar);
            __builtin_amdgcn_fence(__ATOMIC_ACQUIRE, "agent");
            asm volatile("s_waitcnt vmcnt(0)" ::: "memory");
        }
    }
    __syncthreads();
}

struct Args { const void* in[23]; float* out; unsigned char* ws; int ph_lo, ph_hi; };
enum { I_X = 0, I_C, I_POS, I_WADA, I_BADA, I_NORM_MIX, I_WIN, I_CONVW, I_ALOG, I_DTB, I_GNORM, I_QNORM, I_KNORM, I_SINKS, I_WOUT, I_NORM_FFN, I_WGRP, I_BGRP, I_WRT, I_BRT, I_WGATE, I_WUP, I_WDOWN };

template <class CM>
__device__ __forceinline__ void transpose_item(const float* W, int ldw, int k0, bf16* WT, int ldt, int n0, CM cm, LAS float* scr, int lane) {
    const int sc = cm(n0 + (lane & 31));
    float tv[32];
#pragma unroll
    for (int i = 0; i < 32; ++i) { const int kk = 2 * i + (lane >> 5); tv[i] = W[(size_t)(k0 + kk) * ldw + (sc >= 0 ? sc : 0)]; }
#pragma unroll
    for (int i = 0; i < 32; ++i) { const int kk = 2 * i + (lane >> 5); scr[kk * 33 + (lane & 31)] = sc >= 0 ? tv[i] : 0.f; }
    LDS_WAIT(); asm volatile("" ::: "memory");
    const int c = lane & 7;
#pragma unroll
    for (int j = 0; j < 4; ++j) { const int n = (lane >> 3) + 8 * j; const LAS float* s = scr + (8 * c) * 33 + n;
        v4u o; o.x = pk2(s[0 * 33], s[1 * 33]); o.y = pk2(s[2 * 33], s[3 * 33]); o.z = pk2(s[4 * 33], s[5 * 33]); o.w = pk2(s[6 * 33], s[7 * 33]);
        *(v4u*)(WT + (size_t)(n0 + n) * ldt + k0 + 8 * c) = o; }
    LDS_WAIT(); asm volatile("" ::: "memory");
}
struct CmIn { __device__ __forceinline__ int operator()(int n) const { return n < 2048 ? n : (n < 2816 ? n + 16 : (n < 2832 ? 2048 + (n - 2816) : -1)); } };
struct CmOff { int off; __device__ __forceinline__ int operator()(int n) const { return n + off; } };
struct CmId { __device__ __forceinline__ int operator()(int n) const { return n; } };

__device__ __forceinline__ void p0_prologue(const Args& A, LAS unsigned char* lds, int tid, int lane, int wave) {
    unsigned char* ws = A.ws;
    LAS float* scr = (LAS float*)(lds + wave * 8448);
    const int G = gridDim.x, gw = blockIdx.x * NWAVES + wave, NGW = G * NWAVES;
    constexpr int IT_IN = (NPAD / 32) * (DM / 64), IT_OUT = (DM / 32) * (DM / 64);
    for (int it = gw; it < IT_IN + IT_OUT; it += NGW) {
        if (it < IT_IN) { const int nb = it % (NPAD / 32), kb = it / (NPAD / 32); transpose_item((const float*)A.in[I_WIN], 2832, kb * 64, (bf16*)(ws + WS_WINT), DM, nb * 32, CmIn(), scr, lane); }
        else { const int r = it - IT_IN, nb = r % (DM / 32), kb = r / (DM / 32); transpose_item((const float*)A.in[I_WOUT], DM, kb * 64, (bf16*)(ws + WS_WOUTT), DM, nb * 32, CmId(), scr, lane); }
    }
    {   constexpr int IT_GU = NE * 16 * 16, IT_D = NE * 32 * 4;
        const float* wgate = (const float*)A.in[I_WGATE]; const float* wup = (const float*)A.in[I_WUP]; const float* wdown = (const float*)A.in[I_WDOWN];
        for (int it = gw; it < IT_GU + IT_D; it += NGW) {
            if (it < IT_GU) { const int e = it >> 8, r = it & 255, nb = r & 15, kb = r >> 4, j = nb >> 3, q = nb & 7;
                const float* W = (q < 4 ? wgate : wup) + (size_t)e * 1024 * 256; const int col0 = j * 128 + (q & 3) * 32;
                transpose_item(W, 256, kb * 64, (bf16*)(ws + WS_WGUT) + (size_t)e * 512 * 1024, 1024, nb * 32, CmOff{col0 - nb * 32}, scr, lane); }
            else { const int r2 = it - IT_GU, e = r2 >> 7, r = r2 & 127, nb = r & 31, kb = r >> 5;
                transpose_item(wdown + (size_t)e * 256 * 1024, 1024, kb * 64, (bf16*)(ws + WS_WDT) + (size_t)e * 1024 * 256, 256, nb * 32, CmId(), scr, lane); }
        }
    }
    {   const float* wgp = (const float*)A.in[I_WGRP]; const float* wrt = (const float*)A.in[I_WRT];
        bf16* wf = (bf16*)(ws + WS_WRT);
        for (int idx = blockIdx.x * NTHR + tid; idx < 48 * 1024; idx += G * NTHR) { const int j = idx & 7, ln = (idx >> 3) & 63, ks = (idx >> 9) & 31, nt = idx >> 14;
            const int o = 16 * nt + (ln & 15), k = 32 * ks + 8 * (ln >> 4) + j;
            const float w = o < 4 ? wgp[k * 4 + o] : (o < 36 ? wrt[k * 32 + o - 4] : 0.f);
            const unsigned hb = f2bf(w); wf[idx] = (bf16)hb; wf[48 * 1024 + idx] = (bf16)f2bf(w - __builtin_bit_cast(float, hb << 16)); }
    }
    LAS float* cact = (LAS float*)(lds + 69632);
    LAS float* red = (LAS float*)(lds + 69632 + 16384);
    const float* c = (const float*)A.in[I_C]; const float* wada = (const float*)A.in[I_WADA]; const float* bada = (const float*)A.in[I_BADA];
    float* mod = (float*)(ws + WS_MOD);
    if ((int)blockIdx.x < 96) {
        __syncthreads();
        for (int i = tid; i < 4096; i += NTHR) cact[i] = siluf(c[i]);
        __syncthreads();
        for (int u = blockIdx.x; u < 96; u += G) {
            const int n = u * 64 + lane; float a0 = 0.f, a1 = 0.f, a2 = 0.f, a3 = 0.f;
#pragma unroll 16
            for (int k = wave * 128; k < wave * 128 + 128; ++k) { const float w = wada[(size_t)k * 6144 + n]; a0 += cact[k] * w; a1 += cact[1024 + k] * w; a2 += cact[2048 + k] * w; a3 += cact[3072 + k] * w; }
            red[(wave * 4 + 0) * 64 + lane] = a0; red[(wave * 4 + 1) * 64 + lane] = a1; red[(wave * 4 + 2) * 64 + lane] = a2; red[(wave * 4 + 3) * 64 + lane] = a3;
            __syncthreads();
            if (tid < 256) { const int b = tid >> 6, l = tid & 63; float s = bada[u * 64 + l];
#pragma unroll
                for (int w = 0; w < 8; ++w) s += red[(w * 4 + b) * 64 + l];
                mod[b * 6144 + u * 64 + l] = s; }
            __syncthreads();
        }
    }
}

template <bool ROUTE>
__device__ __forceinline__ void norm_rows(const Args& A, const float* X, const float* gain, const float* shift, const float* scale, bf16* H, LAS unsigned char* lds, int lane, int wave) {
    LAS float* hl = (LAS float*)(lds + wave * 4096);
    const int G = gridDim.x, gw = blockIdx.x * NWAVES + wave, NGW = G * NWAVES;
    unsigned char* ws = A.ws;
    for (int r0 = gw * 16; r0 < TT; r0 += NGW * 16) {
        const int b = r0 / SEQ;
        f32x4 mf[4], af[4];
#pragma unroll
        for (int j = 0; j < 4; ++j) { const int col = 4 * lane + 256 * j; const f32x4 g = *(const f32x4*)(gain + col), sc = *(const f32x4*)(scale + b * 6144 + col);
            mf[j] = g * (sc + 1.0f); af[j] = *(const f32x4*)(shift + b * 6144 + col); }
#pragma unroll 4
        for (int i = 0; i < 16; ++i) {
            const int row = r0 + i;
            const f32x4* xr = (const f32x4*)(X + (size_t)row * DM) + lane;
            f32x4 v[4]; float s = 0.f;
#pragma unroll
            for (int j = 0; j < 4; ++j) { v[j] = xr[64 * j]; s += (v[j].x * v[j].x + v[j].y * v[j].y) + (v[j].z * v[j].z + v[j].w * v[j].w); }
            const float rstd = 1.f / sqrtf(wave_sum(s) * (1.f / DM) + EPS);
            unsigned long long* o8 = (unsigned long long*)(H + (size_t)row * DM) + lane;
#pragma unroll
            for (int j = 0; j < 4; ++j) { v[j] = v[j] * rstd * mf[j] + af[j];
                o8[64 * j] = (unsigned long long)pk2(v[j].x, v[j].y) | ((unsigned long long)pk2(v[j].z, v[j].w) << 32); }
            if constexpr (ROUTE) {
                const float* wg = (const float*)A.in[I_WGRP]; const float* wr = (const float*)A.in[I_WRT];
                float lg[36];
#pragma unroll
                for (int o = 0; o < 36; ++o) lg[o] = 0.f;
#pragma unroll
                for (int j = 0; j < 4; ++j) *(LAS f32x4*)(hl + 4 * lane + 256 * j) = v[j];
                LDS_WAIT(); asm volatile("" ::: "memory");
#pragma unroll 1
                for (int ii = 0; ii < 16; ++ii) { const int k = lane + 64 * ii; const float hv = hl[k];
                    const f32x4 g4 = *(const f32x4*)(wg + k * 4);
                    lg[0] += hv * g4.x; lg[1] += hv * g4.y; lg[2] += hv * g4.z; lg[3] += hv * g4.w;
#pragma unroll
                    for (int q = 0; q < 8; ++q) { const f32x4 r4 = *(const f32x4*)(wr + k * 32 + q * 4);
                        lg[4 + q * 4 + 0] += hv * r4.x; lg[4 + q * 4 + 1] += hv * r4.y; lg[4 + q * 4 + 2] += hv * r4.z; lg[4 + q * 4 + 3] += hv * r4.w; } }
                LDS_WAIT(); asm volatile("" ::: "memory");
#pragma unroll
                for (int o = 0; o < 36; ++o) lg[o] = wave_sum(lg[o]);
                const float* bg = (const float*)A.in[I_BGRP]; const float* br = (const float*)A.in[I_BRT];
#pragma unroll
                for (int o = 0; o < 4; ++o) lg[o] += bg[o];
#pragma unroll
                for (int o = 0; o < 32; ++o) lg[4 + o] += br[o];
                int gi = 0; float gm = lg[0];
#pragma unroll
                for (int o = 1; o < 4; ++o) if (lg[o] > gm) { gm = lg[o]; gi = o; }
                float gs = 0.f;
#pragma unroll
                for (int o = 0; o < 4; ++o) gs += __expf(lg[o] - gm);
                const float pg = 1.f / gs;
                float le[8];
#pragma unroll
                for (int j = 0; j < 8; ++j) { le[j] = lg[4 + j];
#pragma unroll
                    for (int g = 1; g < 4; ++g) le[j] = (gi == g) ? lg[4 + g * 8 + j] : le[j]; }
                int j1 = 0; float m1 = le[0];
#pragma unroll
                for (int j = 1; j < 8; ++j) if (le[j] > m1) { m1 = le[j]; j1 = j; }
                int j2 = -1; float m2 = -3.0e38f;
#pragma unroll
                for (int j = 0; j < 8; ++j) if (j != j1 && le[j] > m2) { m2 = le[j]; j2 = j; }
                const float ex = __expf(m2 - m1), w1 = pg / (1.f + ex), w2 = pg * ex / (1.f + ex);
                if (lane == 0) {
                    const int e1 = gi * 8 + j1, e2 = gi * 8 + j2;
                    unsigned* ctl = (unsigned*)(ws + WS_CTL);
                    int2* erec = (int2*)(ws + WS_EREC); int* clist = (int*)(ws + WS_CLIST);
                    const unsigned p1 = atomicAdd(ctl + CW_ECNT + e1, 1u); erec[(size_t)e1 * TT + p1] = make_int2(row * 2 + (e1 > e2 ? 1 : 0), __builtin_bit_cast(int, w1));
                    const unsigned p2 = atomicAdd(ctl + CW_ECNT + e2, 1u); erec[(size_t)e2 * TT + p2] = make_int2(row * 2 + (e2 > e1 ? 1 : 0), __builtin_bit_cast(int, w2));
                    const int a = j1 < j2 ? j1 : j2, bb = j1 < j2 ? j2 : j1;
                    const int cls = gi * 28 + (a * 7 - (a * (a - 1)) / 2 + (bb - a - 1));
                    const unsigned pc = atomicAdd(ctl + CW_CCNT + cls, 1u); clist[(size_t)cls * TT + pc] = row;
                }
            }
        }
    }
}

typedef short bf16x8_t __attribute__((ext_vector_type(8)));
typedef float f32x16 __attribute__((ext_vector_type(16)));
typedef unsigned v2u __attribute__((ext_vector_type(2)));
typedef float f32x2_t __attribute__((ext_vector_type(2)));
typedef __bf16 bf16x2_t __attribute__((ext_vector_type(2)));
__device__ __forceinline__ unsigned cvtpk(float lo, float hi) { const f32x2_t f = {lo, hi}; return __builtin_bit_cast(unsigned, __builtin_convertvector(f, bf16x2_t)); }
__device__ __forceinline__ void fast_sincos(float ang, float& sn, float& cs) {
    float rev = ang * 0.15915494309189535f; rev -= floorf(rev);
    sn = __builtin_amdgcn_sinf(rev); cs = __builtin_amdgcn_cosf(rev);
}
__device__ __forceinline__ void swa_mfma(const Args& A, LAS unsigned char* lds, int tid, int lane, int wave, int blk, int nblk) {
    unsigned char* ws = A.ws;
    const bf16* proj = (const bf16*)(ws + WS_PROJ);
    bf16* mix = (bf16*)(ws + WS_MIX); const float* sinks = (const float*)A.in[I_SINKS];
    const int* pos = (const int*)A.in[I_POS]; const float* qn = (const float*)A.in[I_QNORM]; const float* kn = (const float*)A.in[I_KNORM];
    constexpr int KST = 144, VST = 520;
    LAS unsigned char* Kl = lds; LAS unsigned char* Vt = lds + 256 * KST;
    const int g = wave >> 1, qh = wave & 1, ql = lane & 31, hh = lane >> 5;
    constexpr float LOG2E = 1.4426950408889634f, CS = 0.125f * LOG2E, L2T = 13.287712379549449f / 32.f;
    const int sch = tid & 7;
    float kinv[8], kgn[8];
#pragma unroll
    for (int j = 0; j < 8; ++j) { kinv[j] = __builtin_amdgcn_exp2f(-(float)((sch & 3) * 8 + j) * L2T); kgn[j] = kn[sch * 8 + j]; }
    float qinv[2][8];
#pragma unroll
    for (int ks = 0; ks < 2; ++ks)
#pragma unroll
        for (int j = 0; j < 8; ++j) qinv[ks][j] = __builtin_amdgcn_exp2f(-(float)(ks * 16 + hh * 8 + j) * L2T);
    for (int u = blk; u < NB * 2 * (SEQ / 128); u += nblk) {
        const int n = u & 63, kvh = (u >> 6) & 1, b = u >> 7;
        const int tb = b * SEQ + n * 128;
        __syncthreads();
#pragma unroll
        for (int it = 0; it < 4; ++it) { const int idx = tid + it * NTHR, key = idx >> 3, ch = idx & 7; int tk = tb - 128 + key; if (tk < b * SEQ) tk = b * SEQ;
            const v4u kv = *(const v4u*)(proj + (size_t)tk * NPROJ + PC_SK + kvh * 64 + ch * 8);
            const v4u vv = *(const v4u*)(proj + (size_t)tk * NPROJ + PC_SV + kvh * 64 + ch * 8);
            const float pf = (float)pos[tk];
            float x[8] = { __builtin_bit_cast(float, kv.x << 16), __builtin_bit_cast(float, kv.x & 0xffff0000u), __builtin_bit_cast(float, kv.y << 16), __builtin_bit_cast(float, kv.y & 0xffff0000u),
                           __builtin_bit_cast(float, kv.z << 16), __builtin_bit_cast(float, kv.z & 0xffff0000u), __builtin_bit_cast(float, kv.w << 16), __builtin_bit_cast(float, kv.w & 0xffff0000u) };
            float ss = 0.f;
#pragma unroll
            for (int j = 0; j < 8; ++j) ss += x[j] * x[j];
            ss += __shfl_xor(ss, 1); ss += __shfl_xor(ss, 2); ss += __shfl_xor(ss, 4);
            const float rn = 1.f / sqrtf(ss * (1.f / 64.f) + EPS);
            float o[8];
#pragma unroll
            for (int j = 0; j < 8; ++j) { const float xn = x[j] * rn * kgn[j]; const float pr = __shfl_xor(xn, 4); float sn, cs; fast_sincos(pf * kinv[j], sn, cs);
                o[j] = (ch < 4) ? xn * cs - pr * sn : pr * sn + xn * cs; }
            v4u ko; ko.x = cvtpk(o[0], o[1]); ko.y = cvtpk(o[2], o[3]); ko.z = cvtpk(o[4], o[5]); ko.w = cvtpk(o[6], o[7]);
            *(LAS v4u*)(Kl + key * KST + ch * 16) = ko;
            LAS unsigned short* vp = (LAS unsigned short*)(Vt + (ch * 8) * VST + key * 2);
            vp[0 * (VST / 2)] = (unsigned short)(vv.x & 0xffffu); vp[1 * (VST / 2)] = (unsigned short)(vv.x >> 16);
            vp[2 * (VST / 2)] = (unsigned short)(vv.y & 0xffffu); vp[3 * (VST / 2)] = (unsigned short)(vv.y >> 16);
            vp[4 * (VST / 2)] = (unsigned short)(vv.z & 0xffffu); vp[5 * (VST / 2)] = (unsigned short)(vv.z >> 16);
            vp[6 * (VST / 2)] = (unsigned short)(vv.w & 0xffffu); vp[7 * (VST / 2)] = (unsigned short)(vv.w >> 16); }
        __syncthreads();
        const int hq = kvh * 4 + g; const float sinkl = sinks[hq] * LOG2E;
#pragma unroll 1
        for (int qt = 0; qt < 2; ++qt) {
            const int i0 = qh * 64 + qt * 32, iq = i0 + ql;
            const size_t tq = (size_t)(tb + iq);
            bf16x8_t qf[4];
            {   float xq[4][8]; float ss = 0.f;
#pragma unroll
                for (int ks = 0; ks < 4; ++ks) { const v4u r = *(const v4u*)(proj + tq * NPROJ + PC_SQ + hq * 64 + ks * 16 + hh * 8);
                    xq[ks][0] = __builtin_bit_cast(float, r.x << 16); xq[ks][1] = __builtin_bit_cast(float, r.x & 0xffff0000u); xq[ks][2] = __builtin_bit_cast(float, r.y << 16); xq[ks][3] = __builtin_bit_cast(float, r.y & 0xffff0000u);
                    xq[ks][4] = __builtin_bit_cast(float, r.z << 16); xq[ks][5] = __builtin_bit_cast(float, r.z & 0xffff0000u); xq[ks][6] = __builtin_bit_cast(float, r.w << 16); xq[ks][7] = __builtin_bit_cast(float, r.w & 0xffff0000u);
#pragma unroll
                    for (int j = 0; j < 8; ++j) ss += xq[ks][j] * xq[ks][j]; }
                ss += __shfl_xor(ss, 32);
                const float rn = 1.f / sqrtf(ss * (1.f / 64.f) + EPS); const float pf = (float)pos[tq];
#pragma unroll
                for (int ks = 0; ks < 4; ++ks)
#pragma unroll
                    for (int j = 0; j < 8; ++j) xq[ks][j] *= rn * qn[ks * 16 + hh * 8 + j];
#pragma unroll
                for (int ks = 0; ks < 2; ++ks)
#pragma unroll
                    for (int j = 0; j < 8; ++j) { float sn, cs; fast_sincos(pf * qinv[ks][j], sn, cs); const float x1 = xq[ks][j], x2 = xq[ks + 2][j];
                        xq[ks][j] = x1 * cs - x2 * sn; xq[ks + 2][j] = x1 * sn + x2 * cs; }
#pragma unroll
                for (int ks = 0; ks < 4; ++ks) { union { bf16x8_t v; unsigned u[4]; } p; p.u[0] = cvtpk(xq[ks][0], xq[ks][1]); p.u[1] = cvtpk(xq[ks][2], xq[ks][3]); p.u[2] = cvtpk(xq[ks][4], xq[ks][5]); p.u[3] = cvtpk(xq[ks][6], xq[ks][7]); qf[ks] = p.v; }
            }
            f32x16 sc[5];
#pragma unroll
            for (int kt = 0; kt < 5; ++kt) { f32x16 acc;
#pragma unroll
                for (int r = 0; r < 16; ++r) acc[r] = 0.f;
#pragma unroll
                for (int ks = 0; ks < 4; ++ks) { const bf16x8_t kf = *(const LAS bf16x8_t*)(Kl + (i0 + 32 * kt + ql) * KST + (ks * 16 + hh * 8) * 2);
                    acc = __builtin_amdgcn_mfma_f32_32x32x16_bf16(kf, qf[ks], acc, 0, 0, 0); }
                sc[kt] = acc; }
            float mloc = -3.0e38f;
#pragma unroll
            for (int kt = 0; kt < 5; ++kt)
#pragma unroll
                for (int r = 0; r < 16; ++r) { const int j = i0 + 32 * kt + (r & 3) + 8 * (r >> 2) + 4 * hh;
                    const bool valid = (j > iq) && (j <= iq + 128) && (n > 0 || j >= 128);
                    const float sv = valid ? sc[kt][r] * CS : -1.0e30f; sc[kt][r] = sv; mloc = fmaxf(mloc, sv); }
            float mx = fmaxf(mloc, __shfl_xor(mloc, 32)); mx = fmaxf(mx, sinkl);
            float lsum = 0.f;
#pragma unroll
            for (int kt = 0; kt < 5; ++kt)
#pragma unroll
                for (int r = 0; r < 16; ++r) { const float p = __builtin_amdgcn_exp2f(sc[kt][r] - mx); sc[kt][r] = p; lsum += p; }
            lsum += __shfl_xor(lsum, 32); lsum += __builtin_amdgcn_exp2f(sinkl - mx);
            f32x16 o0, o1;
#pragma unroll
            for (int r = 0; r < 16; ++r) { o0[r] = 0.f; o1[r] = 0.f; }
#pragma unroll
            for (int kt = 0; kt < 5; ++kt)
#pragma unroll
                for (int s2 = 0; s2 < 2; ++s2) {
                    union { bf16x8_t v; unsigned u[4]; } pf;
#pragma unroll
                    for (int p = 0; p < 4; ++p) pf.u[p] = cvtpk(sc[kt][8 * s2 + 2 * p], sc[kt][8 * s2 + 2 * p + 1]);
                    const int jb = i0 + 32 * kt + 16 * s2 + 4 * hh;
                    union { bf16x8_t v; v2u u[2]; } v0, v1;
                    const LAS unsigned char* r0 = Vt + ql * VST + jb * 2; const LAS unsigned char* r1 = Vt + (32 + ql) * VST + jb * 2;
                    v0.u[0] = *(const LAS v2u*)(r0); v0.u[1] = *(const LAS v2u*)(r0 + 16);
                    v1.u[0] = *(const LAS v2u*)(r1); v1.u[1] = *(const LAS v2u*)(r1 + 16);
                    o0 = __builtin_amdgcn_mfma_f32_32x32x16_bf16(v0.v, pf.v, o0, 0, 0, 0);
                    o1 = __builtin_amdgcn_mfma_f32_32x32x16_bf16(v1.v, pf.v, o1, 0, 0, 0);
                }
            const float il = 1.f / lsum;
            bf16* op = mix + tq * DM + 512 + hq * 64 + 4 * hh;
#pragma unroll
            for (int rq = 0; rq < 4; ++rq) {
                v2u w0; w0.x = cvtpk(o0[4 * rq] * il, o0[4 * rq + 1] * il); w0.y = cvtpk(o0[4 * rq + 2] * il, o0[4 * rq + 3] * il);
                *(v2u*)(op + 8 * rq) = w0;
                v2u w1; w1.x = cvtpk(o1[4 * rq] * il, o1[4 * rq + 1] * il); w1.y = cvtpk(o1[4 * rq + 2] * il, o1[4 * rq + 3] * il);
                *(v2u*)(op + 32 + 8 * rq) = w1; }
        }
    }
}

__device__ __forceinline__ int frag_a_idx(int row, int col) { const int mt = row >> 4, l15 = row & 15, ks = col >> 5, x = col & 31, jh = x >> 4, g4 = (x >> 2) & 3, jl = x & 3; return ((mt * 2 + ks) * 64 + g4 * 16 + l15) * 8 + 4 * jh + jl; }
__device__ __forceinline__ int frag_c_idx(int row, int col) { const int w = col >> 4, l15 = col & 15, mt = row >> 4, y = row & 15, g4 = y >> 2, i = y & 3; return ((w * 64 + g4 * 16 + l15) * 4 + mt) * 4 + i; }
__device__ __forceinline__ void gdn_g1_naive(const Args& A, LAS float* L, int tid) {
    unsigned char* ws = A.ws;
    const bf16* proj = (const bf16*)(ws + WS_PROJ); const float* ab = (const float*)(ws + WS_AB);
    bf16* AP = (bf16*)(ws + WS_GAP); bf16* BP = (bf16*)(ws + WS_GBP); bf16* QP = (bf16*)(ws + WS_GQP); bf16* OP = (bf16*)(ws + WS_GOP); float* GL = (float*)(ws + WS_GGL);
    const float* convw = (const float*)A.in[I_CONVW];
    constexpr int LD = 65, AR = 64 * LD;
    LAS float* q = L; LAS float* k = q + AR; LAS float* v = k + AR; LAS float* Mm = v + AR; LAS float* At = Mm + AR; LAS float* w = At + AR;
    LAS float* Gc = w + AR; LAS float* beta = Gc + 64;
    const int i8 = tid >> 3, e0 = (tid & 7) * 8;
    for (int cid = blockIdx.x; cid < NB * 8 * 128; cid += gridDim.x) {
        const int n = cid & 127, bh = cid >> 7, b = bh >> 3, h = bh & 7;
        const float Ah = expf(((const float*)A.in[I_ALOG])[h]), dtb = ((const float*)A.in[I_DTB])[h];
        const int t0 = b * SEQ + n * 64;
        __syncthreads();
        for (int idx = tid; idx < 3 * 4096; idx += NTHR) {
            const int part = idx >> 12, rem = idx & 4095, i = rem >> 6, d = rem & 63, c = part * 512 + h * 64 + d;
            float y = 0.f;
#pragma unroll
            for (int j = 0; j < 4; ++j) { const int s = n * 64 + i - 3 + j; if (s >= 0) y += convw[j * 1536 + c] * bf2f(proj[(size_t)(b * SEQ + s) * NPROJ + c]); }
            y = y / (1.f + __expf(-y));
            (part == 0 ? q : (part == 1 ? k : v))[i * LD + d] = y;
        }
        if (tid < 64) { const float a = ab[(size_t)(t0 + tid) * 16 + h], bb = ab[(size_t)(t0 + tid) * 16 + 8 + h]; const float xx = a + dtb;
            const float sp = xx > 20.f ? xx : log1pf(expf(xx)); Gc[tid] = -Ah * sp; beta[tid] = 1.f / (1.f + __expf(-bb)); }
        __syncthreads();
        if (tid < 128) { LAS float* arr = tid < 64 ? q : k; const int i = tid & 63; float ss = 0.f;
            for (int d = 0; d < 64; ++d) ss += arr[i * LD + d] * arr[i * LD + d];
            const float r = (1.f / sqrtf(ss + EPS)) * (tid < 64 ? 0.125f : 1.f);
            for (int d = 0; d < 64; ++d) arr[i * LD + d] *= r; }
        if (tid == 128) { float run = 0.f; for (int i = 0; i < 64; ++i) { run += Gc[i]; Gc[i] = run; } }
        __syncthreads();
        {   const int i = i8;
            for (int jj = 0; jj < 8; ++jj) { const int j = e0 + jj; float dq = 0.f, dk = 0.f;
_Pragma("unroll 2") for (int d = 0; d < 64; ++d) { const float kj = k[j * LD + d]; dq += q[i * LD + d] * kj; dk += k[i * LD + d] * kj; }
                const float dec = (i >= j) ? __expf(Gc[i] - Gc[j]) : 0.f;
                At[i * LD + j] = dq * dec; Mm[i * LD + j] = (i > j) ? dk * beta[i] * dec : 0.f; }
        }
        __syncthreads();
        for (int idx = tid; idx < 4096; idx += NTHR) { const int i = idx >> 6, d = idx & 63; v[i * LD + d] *= beta[i]; w[i * LD + d] = k[i * LD + d] * beta[i] * __expf(Gc[i]); }
        __syncthreads();
        if (tid < 128) { LAS float* arr = tid < 64 ? v : w; const int c = tid & 63;
            _Pragma("unroll 1") for (int i = 1; i < 64; ++i) { float a = arr[i * LD + c]; _Pragma("unroll 4") for (int j = 0; j < i; ++j) a -= Mm[i * LD + j] * arr[j * LD + c]; arr[i * LD + c] = a; } }
        __syncthreads();
        const float gl = Gc[63];
        const size_t cb = (size_t)cid * 4096;
        {
            const int d = i8; float a[8], bq[8];
#pragma unroll
            for (int ee = 0; ee < 8; ++ee) { a[ee] = 0.f; bq[ee] = 0.f; }
_Pragma("unroll 2")
            for (int c = 0; c < 64; ++c) { const float kd = k[c * LD + d] * __expf(gl - Gc[c]);
#pragma unroll
                for (int ee = 0; ee < 8; ++ee) { a[ee] -= kd * w[c * LD + e0 + ee]; bq[ee] += kd * v[c * LD + e0 + ee]; } }
#pragma unroll
            for (int ee = 0; ee < 8; ++ee) { const int dp = e0 + ee; AP[cb + frag_a_idx(d, dp)] = (bf16)f2bf(a[ee]); BP[cb + frag_c_idx(d, dp)] = (bf16)f2bf(bq[ee]); }
        }
        {
            const int c = i8; float a[8], bq[8]; const float eg = __expf(Gc[c]);
#pragma unroll
            for (int ee = 0; ee < 8; ++ee) { a[ee] = eg * q[c * LD + e0 + ee]; bq[ee] = 0.f; }
_Pragma("unroll 2")
            for (int s2 = 0; s2 <= c; ++s2) { const float av = At[c * LD + s2];
#pragma unroll
                for (int ee = 0; ee < 8; ++ee) { a[ee] -= av * w[s2 * LD + e0 + ee]; bq[ee] += av * v[s2 * LD + e0 + ee]; } }
#pragma unroll
            for (int ee = 0; ee < 8; ++ee) { const int dp = e0 + ee; QP[cb + frag_a_idx(c, dp)] = (bf16)f2bf(a[ee]); OP[cb + frag_c_idx(c, dp)] = (bf16)f2bf(bq[ee]); }
        }
        if (tid == 0) GL[cid] = __expf(gl);
    }
}
__device__ __forceinline__ float wave_incl_scan_f(float v, int lane) {
#pragma unroll
    for (int o = 1; o < 64; o <<= 1) { const float t = __shfl_up(v, o); if (lane >= o) v += t; }
    return v;
}
__device__ __forceinline__ v2u pack4(f32x4 v) { v2u r; r.x = cvtpk(v.x, v.y); r.y = cvtpk(v.z, v.w); return r; }
__device__ __forceinline__ bf16x8_t mk8(v2u lo, v2u hi) { union { bf16x8_t v; unsigned u[4]; } x; x.u[0] = lo.x; x.u[1] = lo.y; x.u[2] = hi.x; x.u[3] = hi.y; return x.v; }
template <int SM, int STG = 7>
__device__ __forceinline__ void gdn_g1_mfma(const Args& A, LAS unsigned char* lds, int tid, int lane, int wave) {
    unsigned char* ws = A.ws;
    const bf16* proj = (const bf16*)(ws + WS_PROJ); const float* ab = (const float*)(ws + WS_AB);
    bf16* AP = (bf16*)(ws + WS_GAP); bf16* BP = (bf16*)(ws + WS_GBP); bf16* QP = (bf16*)(ws + WS_GQP); bf16* OP = (bf16*)(ws + WS_GOP); float* GL = (float*)(ws + WS_GGL);
    const float* convw = (const float*)A.in[I_CONVW];
    constexpr int KST = 144, RST = 68;
    LAS unsigned char* const Kr0 = lds;
    const int l15 = lane & 15, g4 = lane >> 4;
    const v2u zero2 = {0u, 0u};
    const int G = gridDim.x;
    const int ppart = wave >> 1, pt4 = 4 * ((wave & 1) * 8 + (lane >> 3)), pd0 = (lane & 7) * 8;
    v4u xr7[7];
#define G1_PREFETCH(IDX) do { if (wave < 6) { const int h_ = (IDX) & 7, bn_ = (IDX) >> 3, b_ = bn_ >> 7, n_ = bn_ & 127; \
        _Pragma("unroll") for (int r = 0; r < 7; ++r) { const int s_ = n_ * 64 + pt4 - 3 + r, sc_ = s_ < 0 ? 0 : s_; \
            const v4u r_ = *(const v4u*)(proj + (size_t)(b_ * SEQ + sc_) * NPROJ + ppart * 512 + h_ * 64 + pd0); const unsigned m_ = s_ < 0 ? 0u : 0xffffffffu; \
            xr7[r] = (v4u){r_.x & m_, r_.y & m_, r_.z & m_, r_.w & m_}; } } } while (0)
    int hcur = -1;
    constexpr int NC = NB * 8 * 128;
    if ((int)blockIdx.x < NC) G1_PREFETCH((int)blockIdx.x);
    for (int base = blockIdx.x; base < NC; base += 16 * G) {
    {
        LAS float* const GsT0 = (LAS float*)(Kr0 + 91648);
        __syncthreads();
        for (int q = wave; q < 16; q += 8) { const int idx2 = base + q * G;
            if (idx2 < NC) { const int h2 = idx2 & 7, bn2 = idx2 >> 3, b2 = bn2 >> 7, n2 = bn2 & 127;
                const size_t t2 = (size_t)(b2 * SEQ + n2 * 64 + lane) * 16;
                const float Ah = __expf(((const float*)A.in[I_ALOG])[h2]), dtb = ((const float*)A.in[I_DTB])[h2];
                const float xx = ab[t2 + h2] + dtb, bb2 = ab[t2 + 8 + h2];
                const float sp = xx > 20.f ? xx : log1pf(__expf(xx));
                const float Gv = wave_incl_scan_f(-Ah * sp, lane);
                GsT0[q * 64 + lane] = Gv; GsT0[1024 + q * 64 + lane] = 1.f / (1.f + __expf(-bb2));
                if ((SM & 16) && lane == 63) GL[(b2 * 8 + h2) * 128 + n2] = __expf(Gv); } }
    }
#pragma unroll 1
    for (int it = 0; it < 16; ++it) {
        const int idx = base + it * G; if (idx >= NC) break;
        const int h = idx & 7, bn = idx >> 3, b = bn >> 7, n = bn & 127, bh = b * 8 + h, cid = bh * 128 + n;
        const size_t cb = (size_t)cid * 4096;
        int oz = 0; asm volatile("" : "+v"(oz));
        LAS unsigned char* const Kr = Kr0 + oz; LAS unsigned char* const Qr = Kr + 9216; LAS unsigned char* const kdT = Kr + 18432; LAS unsigned char* const Mm = Kr + 27648; LAS unsigned char* const At = Kr + 36864;
        LAS float* const Rt = (LAS float*)(Kr + 46080);
        LAS float* const Md = (LAS float*)(Kr + 80896);
        LAS unsigned char* const Tl = Kr + 86016;
        LAS float* const Gs = (LAS float*)(Kr + 91648) + 64 * it; LAS float* const Bs = Gs + 1024;
        LAS float* const cwl = (LAS float*)(Kr + 88576);
        __syncthreads();
        if (h != hcur) { hcur = h; for (int q = tid; q < 768; q += NTHR) { const int part = q >> 8, j = (q >> 6) & 3, d = q & 63; cwl[q] = convw[j * 1536 + part * 512 + h * 64 + d]; } __syncthreads(); }
        const bool more = (idx + G < NC);
        if (wave < 6) {
            const int d0 = pd0, t4 = pt4, dg = d0 >> 3, swk = dg << 3, swr = (dg & 3) << 3;
            float y[4][8];
            {   float wv[4][8];
#pragma unroll
                for (int j = 0; j < 4; ++j) { const f32x4 w0 = *(const LAS f32x4*)(cwl + (ppart * 4 + j) * 64 + d0), w1 = *(const LAS f32x4*)(cwl + (ppart * 4 + j) * 64 + d0 + 4);
                    wv[j][0] = w0.x; wv[j][1] = w0.y; wv[j][2] = w0.z; wv[j][3] = w0.w; wv[j][4] = w1.x; wv[j][5] = w1.y; wv[j][6] = w1.z; wv[j][7] = w1.w; }
#define G1_XE(r, e) __builtin_bit_cast(float, ((e) & 1) ? (((e) >> 1) == 0 ? xr7[r].x : ((e) >> 1) == 1 ? xr7[r].y : ((e) >> 1) == 2 ? xr7[r].z : xr7[r].w) & 0xffff0000u \
                                                        : (((e) >> 1) == 0 ? xr7[r].x : ((e) >> 1) == 1 ? xr7[r].y : ((e) >> 1) == 2 ? xr7[r].z : xr7[r].w) << 16)
#pragma unroll
                for (int tk = 0; tk < 4; ++tk)
#pragma unroll
                    for (int e = 0; e < 8; ++e) { const float a_ = wv[0][e] * G1_XE(tk, e) + wv[1][e] * G1_XE(tk + 1, e) + wv[2][e] * G1_XE(tk + 2, e) + wv[3][e] * G1_XE(tk + 3, e);
                        y[tk][e] = a_ * __builtin_amdgcn_rcpf(1.f + __expf(-a_)); }
#undef G1_XE
            }
            if (more) G1_PREFETCH(idx + G);
            const f32x4 G4 = *(const LAS f32x4*)(Gs + t4), B4 = *(const LAS f32x4*)(Bs + t4); const float gl = Gs[63];
            if (ppart < 2) {
                float rn[4];
#pragma unroll
                for (int tk = 0; tk < 4; ++tk) { float ss = 0.f;
#pragma unroll
                    for (int e = 0; e < 8; ++e) ss += y[tk][e] * y[tk][e];
                    ss += __shfl_xor(ss, 1); ss += __shfl_xor(ss, 2); ss += __shfl_xor(ss, 4);
                    rn[tk] = (1.f / sqrtf(ss + EPS)) * (ppart == 0 ? 0.125f : 1.f); }
#pragma unroll
                for (int tk = 0; tk < 4; ++tk) {
#pragma unroll
                    for (int e = 0; e < 8; ++e) y[tk][e] *= rn[tk];
                    v4u pk; pk.x = cvtpk(y[tk][0], y[tk][1]); pk.y = cvtpk(y[tk][2], y[tk][3]); pk.z = cvtpk(y[tk][4], y[tk][5]); pk.w = cvtpk(y[tk][6], y[tk][7]);
                    *(LAS v4u*)((ppart == 0 ? Qr : Kr) + (t4 + tk) * KST + d0 * 2) = pk; }
                if (ppart == 1) {
                    const float ek0 = __expf(gl - G4.x), ek1 = __expf(gl - G4.y), ek2 = __expf(gl - G4.z), ek3 = __expf(gl - G4.w);
                    const float bg0 = B4.x * __expf(G4.x), bg1 = B4.y * __expf(G4.y), bg2 = B4.z * __expf(G4.z), bg3 = B4.w * __expf(G4.w);
#pragma unroll
                    for (int e = 0; e < 8; ++e) {
                        v2u kd; kd.x = cvtpk(y[0][e] * ek0, y[1][e] * ek1); kd.y = cvtpk(y[2][e] * ek2, y[3][e] * ek3);
                        *(LAS v2u*)(kdT + (d0 + e) * KST + (t4 ^ swk) * 2) = kd;
                        *(LAS f32x4*)(Rt + (d0 + e) * RST + (t4 ^ swr)) = (f32x4){y[0][e] * bg0, y[1][e] * bg1, y[2][e] * bg2, y[3][e] * bg3}; }
                }
            } else {
#pragma unroll
                for (int e = 0; e < 8; ++e) *(LAS f32x4*)(Rt + (64 + d0 + e) * RST + (t4 ^ swr)) = (f32x4){y[0][e] * B4.x, y[1][e] * B4.y, y[2][e] * B4.z, y[3][e] * B4.w};
            }
        }
        __syncthreads();
#define G1_TILE(which, ct, st) do { const LAS unsigned char* Xb_ = (which) ? Kr : Qr; const int c_ = 16 * (ct) + l15; const float Gc_ = Gs[c_], bc_ = Bs[c_]; \
            f32x4 acc_ = {0.f, 0.f, 0.f, 0.f}; \
            _Pragma("unroll") for (int ks = 0; ks < 2; ++ks) { const bf16x8_t bf_ = *(const LAS bf16x8_t*)(Xb_ + c_ * KST + (32 * ks + 8 * g4) * 2); \
                const bf16x8_t af_ = *(const LAS bf16x8_t*)(Kr + (16 * (st) + l15) * KST + (32 * ks + 8 * g4) * 2); acc_ = __builtin_amdgcn_mfma_f32_16x16x32_bf16(af_, bf_, acc_, 0, 0, 0); } \
            f32x4 vals_; \
            _Pragma("unroll") for (int r = 0; r < 4; ++r) { const int s2_ = 16 * (st) + 4 * g4 + r; const float dec_ = __expf(fminf(Gc_ - Gs[s2_], 0.f)); \
                vals_[r] = (which) ? ((s2_ < c_) ? -acc_[r] * bc_ * dec_ : 0.f) : ((s2_ <= c_) ? acc_[r] * dec_ : 0.f); } \
            *(LAS v2u*)(((which) ? Mm : At) + c_ * KST + (16 * (st) + 4 * g4) * 2) = pack4(vals_); \
            if ((which) && (st) == (ct)) *(LAS f32x4*)(Md + ((ct) * 16 + l15) * 20 + 4 * g4) = -vals_; } while (0)
        if constexpr (STG & 1) {
            const int ct = wave & 3, st0 = 2 * (wave >> 2);
            G1_TILE(1, ct, st0); G1_TILE(1, ct, st0 + 1);
        }
        __syncthreads();
        if constexpr (STG & 1) {
            if (wave != 0) { for (int tix = wave - 1; tix < 16; tix += 7) { const int ct = tix & 3, st = tix >> 2; G1_TILE(0, ct, st); } }
        }
        if ((STG & 2) && wave == 0) {
            float t[16];
#pragma unroll
            for (int r = 0; r < 16; ++r) { float acc = (r == l15) ? 1.f : 0.f;
#pragma unroll
                for (int s4 = 0; s4 < r; s4 += 4) { const f32x4 m = *(const LAS f32x4*)(Md + (g4 * 16 + r) * 20 + s4);
                    acc -= m.x * t[s4]; if (s4 + 1 < r) acc -= m.y * t[s4 + 1]; if (s4 + 2 < r) acc -= m.z * t[s4 + 2]; if (s4 + 3 < r) acc -= m.w * t[s4 + 3]; }
                t[r] = acc; }
#pragma unroll
            for (int r = 0; r < 16; ++r) *(LAS unsigned short*)(Tl + ((g4 * 16 + r) * 16 + l15) * 2) = (unsigned short)f2bf(t[r]);
        }
        __syncthreads();
        if constexpr (STG & 4) {
        f32x4 wt[4];
        {   const int colw = 16 * wave + l15;
#pragma unroll
            for (int i = 0; i < 4; ++i) {
                f32x4 acc = *(const LAS f32x4*)(Rt + colw * RST + ((16 * i + 4 * g4) ^ (((colw >> 3) & 3) << 3)));
                const LAS unsigned char* mrow = Mm + (16 * i + l15) * KST + (4 * g4) * 2;
                if (i >= 1) { const v2u alo = *(const LAS v2u*)(mrow), ahi = (i >= 2) ? *(const LAS v2u*)(mrow + 32) : zero2;
                    acc = __builtin_amdgcn_mfma_f32_16x16x32_bf16(mk8(alo, ahi), mk8(pack4(wt[0]), (i >= 2) ? pack4(wt[1]) : zero2), acc, 0, 0, 0); }
                if (i == 3) { const v2u alo = *(const LAS v2u*)(mrow + 64);
                    acc = __builtin_amdgcn_mfma_f32_16x16x32_bf16(mk8(alo, zero2), mk8(pack4(wt[2]), zero2), acc, 0, 0, 0); }
                const v2u tlo = *(const LAS v2u*)(Tl + ((i * 16 + l15) * 16 + 4 * g4) * 2);
                wt[i] = __builtin_amdgcn_mfma_f32_16x16x32_bf16(mk8(tlo, zero2), mk8(pack4(acc), zero2), (f32x4){0.f, 0.f, 0.f, 0.f}, 0, 0, 0);
            }
        }
        if (wave < 4) {
            bf16x8_t wn[2];
#pragma unroll
            for (int ks = 0; ks < 2; ++ks) { v2u lo = pack4(wt[2 * ks]), hi = pack4(wt[2 * ks + 1]); lo.x ^= 0x80008000u; lo.y ^= 0x80008000u; hi.x ^= 0x80008000u; hi.y ^= 0x80008000u; wn[ks] = mk8(lo, hi); }
#pragma unroll
            for (int nt = 0; nt < 4; ++nt) { const int x = 16 * nt + l15;
                f32x4 ca = {0.f, 0.f, 0.f, 0.f};
                const v2u qraw = *(const LAS v2u*)(Qr + x * KST + (16 * wave + 4 * g4) * 2); const float eg = __expf(Gs[x]);
                f32x4 cq; cq.x = eg * __builtin_bit_cast(float, qraw.x << 16); cq.y = eg * __builtin_bit_cast(float, qraw.x & 0xffff0000u); cq.z = eg * __builtin_bit_cast(float, qraw.y << 16); cq.w = eg * __builtin_bit_cast(float, qraw.y & 0xffff0000u);
#pragma unroll
                for (int ks = 0; ks < 2; ++ks) { const int xs = (x >> 3) << 3; const LAS unsigned char* kp0 = kdT + x * KST + ((32 * ks + 4 * g4) ^ xs) * 2; const LAS unsigned char* kp1 = kdT + x * KST + ((32 * ks + 16 + 4 * g4) ^ xs) * 2; const LAS unsigned char* ap = At + x * KST + (32 * ks + 4 * g4) * 2;
                    ca = __builtin_amdgcn_mfma_f32_16x16x32_bf16(wn[ks], mk8(*(const LAS v2u*)(kp0), *(const LAS v2u*)(kp1)), ca, 0, 0, 0);
                    cq = __builtin_amdgcn_mfma_f32_16x16x32_bf16(wn[ks], mk8(*(const LAS v2u*)(ap), *(const LAS v2u*)(ap + 32)), cq, 0, 0, 0); }
                const size_t off = cb + (size_t)((nt * 2 + (wave >> 1)) * 64 + lane) * 8 + 4 * (wave & 1);
                if (SM & 1) *(v2u*)(AP + off) = pack4(ca); if (SM & 2) *(v2u*)(QP + off) = pack4(cq);
            }
        } else {
            bf16x8_t ub[2];
#pragma unroll
            for (int ks = 0; ks < 2; ++ks) ub[ks] = mk8(pack4(wt[2 * ks]), pack4(wt[2 * ks + 1]));
            unsigned bo[8], oo[8];
#pragma unroll
            for (int mt = 0; mt < 4; ++mt) { const int x = 16 * mt + l15;
                f32x4 cbv = {0.f, 0.f, 0.f, 0.f}, co = {0.f, 0.f, 0.f, 0.f};
#pragma unroll
                for (int ks = 0; ks < 2; ++ks) { const int xs = (x >> 3) << 3; const LAS unsigned char* kp0 = kdT + x * KST + ((32 * ks + 4 * g4) ^ xs) * 2; const LAS unsigned char* kp1 = kdT + x * KST + ((32 * ks + 16 + 4 * g4) ^ xs) * 2; const LAS unsigned char* ap = At + x * KST + (32 * ks + 4 * g4) * 2;
                    cbv = __builtin_amdgcn_mfma_f32_16x16x32_bf16(mk8(*(const LAS v2u*)(kp0), *(const LAS v2u*)(kp1)), ub[ks], cbv, 0, 0, 0);
                    co = __builtin_amdgcn_mfma_f32_16x16x32_bf16(mk8(*(const LAS v2u*)(ap), *(const LAS v2u*)(ap + 32)), ub[ks], co, 0, 0, 0); }
                const v2u pb = pack4(cbv), po = pack4(co); bo[2 * mt] = pb.x; bo[2 * mt + 1] = pb.y; oo[2 * mt] = po.x; oo[2 * mt + 1] = po.y; }
            const size_t off = cb + (size_t)((wave - 4) * 64 + lane) * 16;
            if (SM & 4) { *(v4u*)(BP + off) = (v4u){bo[0], bo[1], bo[2], bo[3]}; *(v4u*)(BP + off + 8) = (v4u){bo[4], bo[5], bo[6], bo[7]}; }
            if (SM & 8) { *(v4u*)(OP + off) = (v4u){oo[0], oo[1], oo[2], oo[3]}; *(v4u*)(OP + off + 8) = (v4u){oo[4], oo[5], oo[6], oo[7]}; }
        }
        }
    }
    }
#undef G1_TILE
#undef G1_PREFETCH
}

__device__ __forceinline__ f32x4 g2_unpack(const v4u (&p)[2], int mt) {
    const unsigned d0 = mt == 0 ? p[0].x : mt == 1 ? p[0].z : mt == 2 ? p[1].x : p[1].z, d1 = mt == 0 ? p[0].y : mt == 1 ? p[0].w : mt == 2 ? p[1].y : p[1].w;
    f32x4 r; r.x = __builtin_bit_cast(float, d0 << 16); r.y = __builtin_bit_cast(float, d0 & 0xffff0000u); r.z = __builtin_bit_cast(float, d1 << 16); r.w = __builtin_bit_cast(float, d1 & 0xffff0000u); return r;
}
__device__ __forceinline__ void gdn_scan(const Args& A, int bh, LAS unsigned char* lds, int tid, int lane, int wave) {
    unsigned char* ws = A.ws;
    const char* AP = (const char*)(ws + WS_GAP); const char* BP = (const char*)(ws + WS_GBP); const float* GL = (const float*)(ws + WS_GGL); bf16* SF = (bf16*)(ws + WS_GSF);
    constexpr int SLOT = 16384, NSL = 8, EGL_OFF = NSL * SLOT;
    LAS float* eglt = (LAS float*)(lds + EGL_OFF);
    __syncthreads();
    { int tl = tid; asm volatile("" : "+v"(tl));
      if (tl < 128) eglt[tl] = GL[bh * 128 + tl]; }
    if (wave < 4) {
        f32x4 sC[4]; bf16x8_t sB[2];
#pragma unroll
        for (int mt = 0; mt < 4; ++mt) sC[mt] = (f32x4){0.f, 0.f, 0.f, 0.f};
#pragma unroll
        for (int ks = 0; ks < 2; ++ks)
#pragma unroll
            for (int j = 0; j < 8; ++j) sB[ks][j] = 0;
        asm volatile("s_waitcnt vmcnt(0) lgkmcnt(0)" ::: "memory");
        __builtin_amdgcn_s_barrier();
#pragma unroll 1
        for (int n = 0; n < SEQ / 64; ++n) {
            const LAS unsigned char* slot = lds + (n & (NSL - 1)) * SLOT;
            bf16x8_t fa[4][2]; v4u fb[2];
#pragma unroll
            for (int mt = 0; mt < 4; ++mt)
#pragma unroll
                for (int ks = 0; ks < 2; ++ks) fa[mt][ks] = *(const LAS bf16x8_t*)(slot + ((mt * 2 + ks) * 64 + lane) * 16);
            fb[0] = *(const LAS v4u*)(slot + 8192 + (wave * 64 + lane) * 32); fb[1] = *(const LAS v4u*)(slot + 8192 + (wave * 64 + lane) * 32 + 16);
            const float egl = eglt[n];
            bf16* sf = SF + (size_t)(bh * 128 + n) * 4096 + (size_t)((wave * 2) * 64 + lane) * 8;
            *(bf16x8_t*)(sf) = sB[0]; *(bf16x8_t*)(sf + 512) = sB[1];
            f32x4 sacc[4];
#pragma unroll
            for (int mt = 0; mt < 4; ++mt) sacc[mt] = sC[mt] * egl + g2_unpack(fb, mt);
#pragma unroll
            for (int mt = 0; mt < 4; ++mt)
#pragma unroll
                for (int ks = 0; ks < 2; ++ks) sacc[mt] = __builtin_amdgcn_mfma_f32_16x16x32_bf16(fa[mt][ks], sB[ks], sacc[mt], 0, 0, 0);
#pragma unroll
            for (int mt = 0; mt < 4; ++mt) sC[mt] = sacc[mt];
#pragma unroll
            for (int ks = 0; ks < 2; ++ks) { union { bf16x8_t v; unsigned u[4]; } pk_;
                pk_.u[0] = cvtpk(sC[2 * ks].x, sC[2 * ks].y); pk_.u[1] = cvtpk(sC[2 * ks].z, sC[2 * ks].w); pk_.u[2] = cvtpk(sC[2 * ks + 1].x, sC[2 * ks + 1].y); pk_.u[3] = cvtpk(sC[2 * ks + 1].z, sC[2 * ks + 1].w); sB[ks] = pk_.v; }
            asm volatile("s_waitcnt lgkmcnt(0)" ::: "memory");
            __builtin_amdgcn_s_barrier();
        }
    } else {
        const int f = wave - 4;
        const unsigned lin = (unsigned)(2 * f) * 1024u + (unsigned)lane * 16u;
#define G2_DMA(nn) do { const int n_ = (nn) < SEQ / 64 ? (nn) : SEQ / 64 - 1; const size_t cb_ = (size_t)(bh * 128 + n_) * 8192; LAS unsigned char* d_ = lds + ((nn) & (NSL - 1)) * SLOT + (2 * f) * 1024; \
        __builtin_amdgcn_global_load_lds((const unsigned*)(AP + cb_ + lin), (LAS unsigned*)(d_), 16, 0, 0); __builtin_amdgcn_global_load_lds((const unsigned*)(AP + cb_ + lin + 1024), (LAS unsigned*)(d_ + 1024), 16, 0, 0); \
        __builtin_amdgcn_global_load_lds((const unsigned*)(BP + cb_ + lin), (LAS unsigned*)(d_ + 8192), 16, 0, 0); __builtin_amdgcn_global_load_lds((const unsigned*)(BP + cb_ + lin + 1024), (LAS unsigned*)(d_ + 8192 + 1024), 16, 0, 0); } while (0)
        asm volatile("s_waitcnt vmcnt(0) lgkmcnt(0)" ::: "memory");
        G2_DMA(0); G2_DMA(1); G2_DMA(2); G2_DMA(3); G2_DMA(4); G2_DMA(5); G2_DMA(6);
        asm volatile("s_waitcnt vmcnt(24)" ::: "memory");
        __builtin_amdgcn_s_barrier();
#pragma unroll 1
        for (int n = 0; n < SEQ / 64; ++n) {
            G2_DMA(n + 7);
            asm volatile("s_waitcnt vmcnt(24)" ::: "memory");
            __builtin_amdgcn_s_barrier();
        }
#undef G2_DMA
        asm volatile("s_waitcnt vmcnt(0)" ::: "memory");
    }
    __syncthreads();
}
__device__ __forceinline__ void gdn_out(const Args& A, LAS unsigned char* lds, int lane, int wave) {
    unsigned char* ws = A.ws;
    const bf16* proj = (const bf16*)(ws + WS_PROJ); bf16* mix = (bf16*)(ws + WS_MIX);
    const bf16* QP = (const bf16*)(ws + WS_GQP); const bf16* OP = (const bf16*)(ws + WS_GOP); const bf16* SF = (const bf16*)(ws + WS_GSF);
    const float* onorm = (const float*)A.in[I_GNORM];
    const int mt = wave & 3, l15 = lane & 15, g4 = lane >> 4, rr = lane >> 2, q4 = lane & 3;
    constexpr int OST = 68;
    LAS float* ot = (LAS float*)(lds + wave * 4608);
    float gain[16];
#pragma unroll
    for (int k = 0; k < 16; ++k) gain[k] = onorm[16 * q4 + k];
    struct OSet { bf16x8_t qa[2], sb[4][2]; v2u oi[4]; v4u z0, z1; };
#define GO_LOAD(S, CID) do { const int n_ = (CID) & 127, bh_ = (CID) >> 7, b_ = bh_ >> 3, h_ = bh_ & 7; const size_t cb_ = (size_t)(CID) * 4096; \
        const size_t t_ = (size_t)b_ * SEQ + n_ * 64 + 16 * mt + rr; \
        S.z0 = *(const v4u*)(proj + t_ * NPROJ + PC_Z + h_ * 64 + 16 * q4); S.z1 = *(const v4u*)(proj + t_ * NPROJ + PC_Z + h_ * 64 + 16 * q4 + 8); \
        _Pragma("unroll") for (int ks = 0; ks < 2; ++ks) S.qa[ks] = *(const bf16x8_t*)(QP + cb_ + ((mt * 2 + ks) * 64 + lane) * 8); \
        _Pragma("unroll") for (int nt = 0; nt < 4; ++nt) { _Pragma("unroll") for (int ks = 0; ks < 2; ++ks) S.sb[nt][ks] = *(const bf16x8_t*)(SF + cb_ + ((nt * 2 + ks) * 64 + lane) * 8); \
            S.oi[nt] = *(const v2u*)(OP + cb_ + ((nt * 64 + lane) * 4 + mt) * 4); } } while (0)
#define GO_STEP(S, CID) do { const int n_ = (CID) & 127, bh_ = (CID) >> 7, b_ = bh_ >> 3, h_ = bh_ & 7; const size_t t_ = (size_t)b_ * SEQ + n_ * 64 + 16 * mt + rr; \
        _Pragma("unroll") for (int nt = 0; nt < 4; ++nt) { \
            f32x4 acc; acc.x = __builtin_bit_cast(float, S.oi[nt].x << 16); acc.y = __builtin_bit_cast(float, S.oi[nt].x & 0xffff0000u); acc.z = __builtin_bit_cast(float, S.oi[nt].y << 16); acc.w = __builtin_bit_cast(float, S.oi[nt].y & 0xffff0000u); \
            _Pragma("unroll") for (int ks = 0; ks < 2; ++ks) acc = __builtin_amdgcn_mfma_f32_16x16x32_bf16(S.qa[ks], S.sb[nt][ks], acc, 0, 0, 0); \
            _Pragma("unroll") for (int i = 0; i < 4; ++i) ot[(4 * g4 + i) * OST + 16 * nt + l15] = acc[i]; } \
        LDS_WAIT(); asm volatile("" ::: "memory"); \
        float o[16]; float ss = 0.f; \
        _Pragma("unroll") for (int k = 0; k < 4; ++k) { const f32x4 v = *(const LAS f32x4*)(ot + rr * OST + 16 * q4 + 4 * k); o[4 * k] = v.x; o[4 * k + 1] = v.y; o[4 * k + 2] = v.z; o[4 * k + 3] = v.w; } \
        _Pragma("unroll") for (int k = 0; k < 16; ++k) ss += o[k] * o[k]; \
        ss += __shfl_xor(ss, 1); ss += __shfl_xor(ss, 2); \
        const float r = 1.f / sqrtf(ss * (1.f / 64.f) + EPS); \
        const unsigned zu[8] = {S.z0.x, S.z0.y, S.z0.z, S.z0.w, S.z1.x, S.z1.y, S.z1.z, S.z1.w}; \
        unsigned ou[8]; \
        _Pragma("unroll") for (int k = 0; k < 8; ++k) { const float za = __builtin_bit_cast(float, zu[k] << 16), zb = __builtin_bit_cast(float, zu[k] & 0xffff0000u); \
            ou[k] = cvtpk(o[2 * k] * r * gain[2 * k] * siluf(za), o[2 * k + 1] * r * gain[2 * k + 1] * siluf(zb)); } \
        bf16* op = mix + t_ * DM + h_ * 64 + 16 * q4; \
        *(v4u*)(op) = (v4u){ou[0], ou[1], ou[2], ou[3]}; *(v4u*)(op + 8) = (v4u){ou[4], ou[5], ou[6], ou[7]}; \
        LDS_WAIT(); asm volatile("" ::: "memory"); } while (0)
    const int NC = NB * 8 * 128, st = gridDim.x * 2;
    int cid = blockIdx.x * 2 + (wave >> 2);
    OSet s0, s1;
    if (cid < NC) GO_LOAD(s0, cid);
#pragma unroll 1
    for (; cid < NC; cid += 2 * st) {
        if (cid + st < NC) GO_LOAD(s1, cid + st);
        GO_STEP(s0, cid);
        if (cid + st < NC) { if (cid + 2 * st < NC) GO_LOAD(s0, cid + 2 * st); GO_STEP(s1, cid + st); }
    }
#undef GO_LOAD
#undef GO_STEP
}

template <bool DRY, int VAR = 0>
__device__ __forceinline__ void norm_route_mfma(const Args& A, const float* X, const float* ssqp, const float* gain, const float* shift, const float* scale, bf16* H, LAS unsigned char* lds, int tid, int lane, int wave) {
    unsigned char* ws = A.ws;
    const int G = gridDim.x;
    const int l15 = lane & 15, g4 = lane >> 4;
    LAS unsigned char* wfl = lds;
    LAS float* mfl = (LAS float*)(lds + 98304); LAS float* afl = mfl + 1024;
    LAS float* lgs = (LAS float*)(lds + 98304 + 8192 + wave * 3328);
    const float* bg = (const float*)A.in[I_BGRP]; const float* br = (const float*)A.in[I_BRT];
#define P7_LOADW(half) do { const v4u* src_ = (const v4u*)(ws + WS_WRT); \
        for (int q = tid; q < 3072; q += NTHR) { const int nt_ = q >> 10, r_ = q & 1023; const int g_ = (nt_ * 32 + 16 * (half)) * 64 + r_; \
            *(LAS v4u*)(wfl + q * 16) = src_[g_]; *(LAS v4u*)(wfl + 49152 + q * 16) = src_[6144 + g_]; } } while (0)
    int bcur = -1;
    for (int rb = blockIdx.x * 128; rb < TT; rb += G * 128) {
        const int b = rb / SEQ, r0 = rb + wave * 16, row = r0 + l15;
        if (b != bcur) { bcur = b; __syncthreads();
            for (int q = tid; q < 1024; q += NTHR) { mfl[q] = gain[q] * (scale[b * 6144 + q] + 1.0f); afl[q] = shift[b * 6144 + q]; }
            __syncthreads(); }
        const float* xr = X + (size_t)row * DM + 8 * g4;
        float ss;
        {   const f32x4 p4 = *(const f32x4*)(ssqp + (size_t)row * 16 + 4 * g4); ss = (p4.x + p4.y) + (p4.z + p4.w); }
        ss += __shfl_xor(ss, 16); ss += __shfl_xor(ss, 32);
        const float rstd = 1.f / sqrtf(ss * (1.f / DM) + EPS);
        f32x4 acc[3];
#pragma unroll
        for (int nt = 0; nt < 3; ++nt) acc[nt] = (f32x4){0.f, 0.f, 0.f, 0.f};
        bf16* hrow = H + (size_t)row * DM + 8 * g4;
#pragma unroll 1
        for (int half = 0; half < 2; ++half) {
        __syncthreads(); P7_LOADW(half); __syncthreads();
#pragma unroll 4
        for (int ks = 16 * half; ks < 16 * half + 16; ++ks) {
            float hv[8];
            {   const f32x4 a = *(const f32x4*)(xr + 32 * ks), c = *(const f32x4*)(xr + 32 * ks + 4);
                const f32x4 m0 = *(const LAS f32x4*)(mfl + 32 * ks + 8 * g4), m1 = *(const LAS f32x4*)(mfl + 32 * ks + 8 * g4 + 4), h0 = *(const LAS f32x4*)(afl + 32 * ks + 8 * g4), h1 = *(const LAS f32x4*)(afl + 32 * ks + 8 * g4 + 4);
                const f32x4 v0 = a * rstd * m0 + h0, v1 = c * rstd * m1 + h1;
                hv[0] = v0.x; hv[1] = v0.y; hv[2] = v0.z; hv[3] = v0.w; hv[4] = v1.x; hv[5] = v1.y; hv[6] = v1.z; hv[7] = v1.w; }
            unsigned hu[4], lu[4];
#pragma unroll
            for (int p = 0; p < 4; ++p) { hu[p] = cvtpk(hv[2 * p], hv[2 * p + 1]);
                const float ra = hv[2 * p] - __builtin_bit_cast(float, hu[p] << 16), rb2 = hv[2 * p + 1] - __builtin_bit_cast(float, hu[p] & 0xffff0000u); lu[p] = cvtpk(ra, rb2); }
            *(v4u*)(hrow + 32 * ks) = (v4u){hu[0], hu[1], hu[2], hu[3]};
            union { bf16x8_t v; unsigned u[4]; } ah, al; ah.u[0] = hu[0]; ah.u[1] = hu[1]; ah.u[2] = hu[2]; ah.u[3] = hu[3]; al.u[0] = lu[0]; al.u[1] = lu[1]; al.u[2] = lu[2]; al.u[3] = lu[3];
#pragma unroll
            for (int nt = 0; nt < 3; ++nt) { const int fo = ((nt * 16 + (ks & 15)) * 64 + lane) * 16;
                const bf16x8_t bh = *(const LAS bf16x8_t*)(wfl + fo), bl = *(const LAS bf16x8_t*)(wfl + 49152 + fo);
                acc[nt] = __builtin_amdgcn_mfma_f32_16x16x32_bf16(ah.v, bh, acc[nt], 0, 0, 0);
                acc[nt] = __builtin_amdgcn_mfma_f32_16x16x32_bf16(ah.v, bl, acc[nt], 0, 0, 0);
                acc[nt] = __builtin_amdgcn_mfma_f32_16x16x32_bf16(al.v, bh, acc[nt], 0, 0, 0); }
        }
        }
#pragma unroll
        for (int nt = 0; nt < 3; ++nt)
#pragma unroll
            for (int r = 0; r < 4; ++r) lgs[(4 * g4 + r) * 52 + 16 * nt + l15] = acc[nt][r];
        LDS_WAIT(); asm volatile("" ::: "memory");
        if (lane < 16) {
            float lg[36];
#pragma unroll
            for (int q = 0; q < 9; ++q) { const f32x4 v = *(const LAS f32x4*)(lgs + lane * 52 + 4 * q); lg[4 * q] = v.x; lg[4 * q + 1] = v.y; lg[4 * q + 2] = v.z; lg[4 * q + 3] = v.w; }
#pragma unroll
            for (int o = 0; o < 4; ++o) lg[o] += bg[o];
#pragma unroll
            for (int o = 0; o < 32; ++o) lg[4 + o] += br[o];
            int gi = 0; float gm = lg[0];
#pragma unroll
            for (int o = 1; o < 4; ++o) if (lg[o] > gm) { gm = lg[o]; gi = o; }
            float gs = 0.f;
#pragma unroll
            for (int o = 0; o < 4; ++o) gs += __expf(lg[o] - gm);
            const float pg = 1.f / gs;
            float le[8];
#pragma unroll
            for (int j = 0; j < 8; ++j) { le[j] = lg[4 + j];
#pragma unroll
                for (int g = 1; g < 4; ++g) le[j] = (gi == g) ? lg[4 + g * 8 + j] : le[j]; }
            int j1 = 0; float m1 = le[0];
#pragma unroll
            for (int j = 1; j < 8; ++j) if (le[j] > m1) { m1 = le[j]; j1 = j; }
            int j2 = -1; float m2 = -3.0e38f;
#pragma unroll
            for (int j = 0; j < 8; ++j) if (j != j1 && le[j] > m2) { m2 = le[j]; j2 = j; }
            const float ex = __expf(m2 - m1), w1 = pg / (1.f + ex), w2 = pg * ex / (1.f + ex);
            const int e1 = gi * 8 + j1, e2 = gi * 8 + j2, rw = r0 + lane;
            unsigned* ctl = (unsigned*)(ws + WS_CTL);
            int2* erec = (int2*)(ws + WS_EREC); int* clist = (int*)(ws + WS_CLIST);
            if constexpr (DRY) { ((int2*)(ws + WS_PROJ + 168 * MiB))[rw] = make_int2(e1 * 64 + e2, __builtin_bit_cast(int, w1 + w2)); } else {
            const unsigned p1 = atomicAdd(ctl + CW_ECNT + e1, 1u); erec[(size_t)e1 * TT + p1] = make_int2(rw * 2 + (e1 > e2 ? 1 : 0), __builtin_bit_cast(int, w1));
            const unsigned p2 = atomicAdd(ctl + CW_ECNT + e2, 1u); erec[(size_t)e2 * TT + p2] = make_int2(rw * 2 + (e2 > e1 ? 1 : 0), __builtin_bit_cast(int, w2));
            const int a = j1 < j2 ? j1 : j2, bb = j1 < j2 ? j2 : j1;
            const int cls = gi * 28 + (a * 7 - (a * (a - 1)) / 2 + (bb - a - 1));
            const unsigned pc = atomicAdd(ctl + CW_CCNT + cls, 1u); clist[(size_t)cls * TT + pc] = rw; }
        }
        LDS_WAIT(); asm volatile("" ::: "memory");
    }
#undef P7_LOADW
}

__device__ __forceinline__ int wave_incl_scan(int v, int lane) {
#pragma unroll
    for (int o = 1; o < 64; o <<= 1) { const int t = __shfl_up(v, o); if (lane >= o) v += t; }
    return v;
}
struct SchedE {
    int G, c, cntv, preF, preP, totF, totP; const int2* rec; const char* W;
    __device__ __forceinline__ void init(const unsigned* cnt, const int2* rec_, const char* W_, int G_, int c_, int lane) {
        G = G_; c = c_; rec = rec_; W = W_;
        cntv = lane < NE ? (int)cnt[lane] : 0;
        const int incF = wave_incl_scan(cntv >> 8, lane), incP = wave_incl_scan((cntv & 255) ? 1 : 0, lane);
        totF = __builtin_amdgcn_readlane(incF, 63); totP = __builtin_amdgcn_readlane(incP, 63);
        preF = lane < NE ? incF : 0x7fffffff; preP = lane < NE ? incP : 0x7fffffff;
    }
    __device__ __forceinline__ bool next(int i, pg8::UnitG& u) const {
        const int L = i * G + c; if (L >= 2 * (totF + totP)) return false;
        if (L < 2 * totF) { const int ft = L >> 1;
            const int e = __builtin_amdgcn_readfirstlane(__popcll(__ballot(preF <= ft)));
            const int base = e ? __builtin_amdgcn_readlane(preF, e - 1) : 0;
            u.id = e; u.tile = ft - base; u.pn = L & 1; u.nrows = 256;
        } else { const int p = (L - 2 * totF) >> 1;
            const int e = __builtin_amdgcn_readfirstlane(__popcll(__ballot(preP <= p)));
            const int cnt = __builtin_amdgcn_readlane(cntv, e);
            u.id = e; u.tile = cnt >> 8; u.pn = L & 1; u.nrows = cnt & 255; }
        return true;
    }
    __device__ __forceinline__ int tok(const pg8::UnitG& u, int r) const { return r < u.nrows ? (rec[(size_t)u.id * TT + u.tile * 256 + r].x >> 1) : 0; }
    __device__ __forceinline__ const char* bseg(const pg8::UnitG& u, int) const { return W + ((size_t)u.id * 512 + u.pn * 256) * 2048; }
};
struct EpiGU {
    static constexpr bool PERM = true;
    bf16* HID;
    __device__ __forceinline__ void operator()(const pg8::f32x4 (&acc)[2][2][4][2], const pg8::UnitG& u, const SchedE& S, int wr, int wc, int fr, int fq) const {
#pragma unroll
        for (int ai = 0; ai < 2; ++ai)
#pragma unroll
            for (int m = 0; m < 4; ++m) { const int r = ai * 128 + wr * 64 + m * 16 + fr;
                if (r < u.nrows) { const int2 rc = S.rec[(size_t)u.id * TT + u.tile * 256 + r]; const int t = rc.x >> 1, half = rc.x & 1; const float w = __builtin_bit_cast(float, rc.y);
                    float hv[8];
#pragma unroll
                    for (int n = 0; n < 2; ++n)
#pragma unroll
                        for (int j = 0; j < 4; ++j) { const float g = acc[ai][0][m][n][j], up = acc[ai][1][m][n][j]; hv[n * 4 + j] = w * siluf(g) * up; }
                    v4u o; o.x = pk2(hv[0], hv[1]); o.y = pk2(hv[2], hv[3]); o.z = pk2(hv[4], hv[5]); o.w = pk2(hv[6], hv[7]);
                    *(v4u*)(HID + (size_t)t * 512 + half * 256 + u.pn * 128 + wc * 32 + 8 * fq) = o; } }
    }
};
struct SchedC {
    int G, c, cntA, cntB, preA, preB, total_rt; const int* clist; const char* W;
    __device__ __forceinline__ void init(const unsigned* cnt, const int* clist_, const char* W_, int G_, int c_, int lane) {
        G = G_; c = c_; clist = clist_; W = W_;
        cntA = (int)cnt[lane]; cntB = lane < NCLS - 64 ? (int)cnt[64 + lane] : 0;
        const int ia = wave_incl_scan((cntA + 255) >> 8, lane); const int ta = __builtin_amdgcn_readlane(ia, 63);
        const int ib = wave_incl_scan((cntB + 255) >> 8, lane) + ta;
        total_rt = __builtin_amdgcn_readlane(ib, 63);
        preA = ia; preB = lane < NCLS - 64 ? ib : 0x7fffffff;
    }
    __device__ __forceinline__ bool next(int i, pg8::UnitG& u) const {
        const int L = i * G + c; if (L >= 4 * total_rt) return false;
        const int rt = L >> 2;
        const int cls = __builtin_amdgcn_readfirstlane(__popcll(__ballot(preA <= rt)) + __popcll(__ballot(preB <= rt)));
        int base = 0; if (cls > 0) base = (cls - 1 < 64) ? __builtin_amdgcn_readlane(preA, cls - 1) : __builtin_amdgcn_readlane(preB, cls - 65);
        const int cnt = cls < 64 ? __builtin_amdgcn_readlane(cntA, cls) : __builtin_amdgcn_readlane(cntB, cls - 64);
        u.id = cls; u.tile = rt - base; u.pn = L & 3; const int rem = cnt - u.tile * 256; u.nrows = rem < 256 ? rem : 256;
        return true;
    }
    __device__ __forceinline__ int tok(const pg8::UnitG& u, int r) const { return r < u.nrows ? clist[(size_t)u.id * TT + u.tile * 256 + r] : 0; }
    __device__ __forceinline__ const char* bseg(const pg8::UnitG& u, int seg) const {
        const int g = u.id / 28; int a = 0, rem = u.id % 28; while (rem >= 7 - a) { rem -= 7 - a; ++a; } const int b = a + 1 + rem;
        const int e = g * 8 + (seg ? b : a);
        return W + ((size_t)e * 1024 + u.pn * 256) * 512;
    }
};
template <int VAR = 0>
struct EpiDownT {
    static constexpr bool PERM = false;
    float* OUT; const float* gate2;
    __device__ __forceinline__ void operator()(const pg8::f32x4 (&acc)[2][2][4][2], const pg8::UnitG& u, const SchedC& S, int wr, int wc, int fr, int fq) const {
#pragma unroll
        for (int ai = 0; ai < 2; ++ai)
#pragma unroll
            for (int m = 0; m < 4; ++m) { const int r = ai * 128 + wr * 64 + m * 16 + fr;
                if (r < u.nrows) { const int t = S.clist[(size_t)u.id * TT + u.tile * 256 + r]; const int b = t / SEQ; const int col0 = u.pn * 256 + wc * 32 + 4 * fq;
                    float* op = OUT + (size_t)t * DM + col0; const float* gp = gate2 + b * 6144 + col0;
#pragma unroll
                    for (int bj = 0; bj < 2; ++bj)
#pragma unroll
                        for (int n = 0; n < 2; ++n) { const int off = bj * 128 + n * 16; const f32x4 xv = (VAR == 1) ? (f32x4){1.f, 1.f, 1.f, 1.f} : *(const f32x4*)(op + off), gv = (VAR == 2) ? (f32x4){1.f, 1.f, 1.f, 1.f} : *(const f32x4*)(gp + off);
                            *(f32x4*)(op + off) = xv + gv * acc[ai][bj][m][n]; } } }
    }
};
typedef EpiDownT<0> EpiDown;

__global__ void __launch_bounds__(NTHR, 2) fwd_kernel(Args args) {
    extern __shared__ __attribute__((aligned(16))) unsigned char lds_raw[];
    LAS unsigned char* lds = (LAS unsigned char*)lds_raw;
    volatile LAS unsigned* MISC = (volatile LAS unsigned*)(lds + MISC_OFF);
    const int G = gridDim.x;
    unsigned char* ws = args.ws;
    const int wave_s = __builtin_amdgcn_readfirstlane(threadIdx.x >> 6);
    for (int u = threadIdx.x; u < (LDS_BYTES - LDSCTL_OFF) / 4; u += NTHR) ((LAS unsigned*)(lds + LDSCTL_OFF))[u] = 0u;
    __syncthreads();
    const int lo = args.ph_lo, hi = args.ph_hi;
    const bool use_bar = (hi - lo) > 1;
    XcdBarrier bar; bar.bar = (unsigned*)(ws + WS_CTL) + CW_BAR; bar.x = 0; bar.st = nullptr;
    if (use_bar) bar = xcd_barrier_post((unsigned*)(ws + WS_CTL) + CW_BAR, MISC + 8, threadIdx.x == 0);
#define IN(k) (lo <= (k) && (k) < hi)
#define BOTH(k) (IN(k) && IN((k) + 1))
#define GRID_BAR(k) do { if (BOTH(k)) xcd_barrier(bar, wave_s == 0 && __builtin_amdgcn_mbcnt_hi(~0u, __builtin_amdgcn_mbcnt_lo(~0u, 0u)) == 0u); } while (0)
#define FRESH_IDS() const int wave = wave_s; int lane = (int)__builtin_amdgcn_mbcnt_hi(~0u, __builtin_amdgcn_mbcnt_lo(~0u, 0u)); asm volatile("" : "+v"(lane)); const int tid = wave * 64 + lane; (void)tid
    const float* mod = (const float*)(ws + WS_MOD);

    if (IN(0)) { FRESH_IDS(); p0_prologue(args, lds, tid, lane, wave); GRID_BAR(0); }
    if (IN(1)) { FRESH_IDS(); norm_rows<false>(args, (const float*)args.in[I_X], (const float*)args.in[I_NORM_MIX], mod + 0, mod + 1024, (bf16*)(ws + WS_H), lds, lane, wave); GRID_BAR(1); }
    if (IN(2)) { FRESH_IDS();
        pg8::Gemm g{(const pg8::bf16_t*)(ws + WS_H), (const pg8::bf16_t*)(ws + WS_WINT), TT, NPAD, DM}; pg8::StaticOrder S; S.init(TT, NPAD, G, (int)blockIdx.x);
        pg8::EpiProj E{(pg8::bf16_t*)(ws + WS_PROJ), (float*)(ws + WS_AB), NPROJ};
        pg8::gemm_phase<pg8::EpiProj, pg8::StaticOrder, true, true>(lds, g, S, E);
        GRID_BAR(2);
    }
    if (IN(3)) { FRESH_IDS(); gdn_g1_mfma<31>(args, lds, tid, lane, wave); GRID_BAR(3); }
    if (IN(4)) { FRESH_IDS();
        if ((int)blockIdx.x < 32) gdn_scan(args, (int)blockIdx.x, lds, tid, lane, wave);
        else swa_mfma(args, lds, tid, lane, wave, (int)blockIdx.x - 32, G - 32);
        GRID_BAR(4);
    }
    if (IN(5)) { FRESH_IDS(); gdn_out(args, lds, lane, wave); GRID_BAR(5); }
    if (IN(6)) { FRESH_IDS();
        pg8::Gemm g{(const pg8::bf16_t*)(ws + WS_MIX), (const pg8::bf16_t*)(ws + WS_WOUTT), TT, DM, DM}; pg8::StaticOrder S; S.init(TT, DM, G, (int)blockIdx.x);
        pg8::EpiOut E{(const float*)args.in[I_X], args.out, mod + 2048, SEQ, 6144, (float*)(ws + WS_SSQ)};
        pg8::gemm_phase<pg8::EpiOut, pg8::StaticOrder, true, true>(lds, g, S, E);
        GRID_BAR(6);
    }
    if (IN(7)) { FRESH_IDS(); norm_route_mfma<false>(args, args.out, (const float*)(ws + WS_SSQ), (const float*)args.in[I_NORM_FFN], mod + 3072, mod + 4096, (bf16*)(ws + WS_H), lds, tid, lane, wave); GRID_BAR(7); }
    if (IN(8)) { FRESH_IDS();
        SchedE S; S.init((const unsigned*)(ws + WS_CTL) + CW_ECNT, (const int2*)(ws + WS_EREC), (const char*)(ws + WS_WGUT), G, (int)blockIdx.x, lane);
        EpiGU E{(bf16*)(ws + WS_HID)};
        pg8::gemm_phase_g<EpiGU, SchedE>(lds, (const pg8::bf16_t*)(ws + WS_H), 1024, 1024, 16, 16, S, E);
        GRID_BAR(8);
    }
    if (IN(9)) { FRESH_IDS();
        SchedC S; S.init((const unsigned*)(ws + WS_CTL) + CW_CCNT, (const int*)(ws + WS_CLIST), (const char*)(ws + WS_WDT), G, (int)blockIdx.x, lane);
        EpiDown E{args.out, mod + 5120};
        pg8::gemm_phase_g<EpiDown, SchedC>(lds, (const pg8::bf16_t*)(ws + WS_HID), 512, 256, 8, 4, S, E);
    }
#if PROBE_REP == 1000
    if (use_bar) { for (int q = 0; q < 8; ++q) xcd_barrier(bar, wave_s == 0 && __builtin_amdgcn_mbcnt_hi(~0u, __builtin_amdgcn_mbcnt_lo(~0u, 0u)) == 0u); }
#endif
#undef IN
#undef BOTH
#undef GRID_BAR
}

#if PROBE_REP >= 0 && PROBE_REP < 1000
template <int P>
__global__ void __launch_bounds__(NTHR, 2) probe_kernel(Args args) {
    extern __shared__ __attribute__((aligned(16))) unsigned char lds_raw[];
    LAS unsigned char* lds = (LAS unsigned char*)lds_raw;
    const int tid = threadIdx.x, lane = tid & 63, wave = __builtin_amdgcn_readfirstlane(tid >> 6);
    const int G = gridDim.x; unsigned char* ws = args.ws; const float* mod = (const float*)(ws + WS_MOD);
    if constexpr (P == 1) norm_rows<false>(args, (const float*)args.in[I_X], (const float*)args.in[I_NORM_MIX], mod + 0, mod + 1024, (bf16*)(ws + WS_GAP + 0)  , lds, lane, wave);
    if constexpr (P == 2) { pg8::Gemm g{(const pg8::bf16_t*)(ws + WS_H), (const pg8::bf16_t*)(ws + WS_WINT), TT, NPAD, DM}; pg8::StaticOrder S; S.init(TT, NPAD, G, (int)blockIdx.x);
        pg8::EpiProj E{(pg8::bf16_t*)(ws + WS_PROJ), (float*)(ws + WS_AB), NPROJ}; pg8::gemm_phase<pg8::EpiProj, pg8::StaticOrder, true, true>(lds, g, S, E); }
    if constexpr (P == 0) p0_prologue(args, lds, tid, lane, wave);
    if constexpr (P == 4) gdn_g1_mfma<31>(args, lds, tid, lane, wave);
    if constexpr (P == 40) gdn_g1_mfma<31, 0>(args, lds, tid, lane, wave);
    if constexpr (P == 41) gdn_g1_mfma<31, 1>(args, lds, tid, lane, wave);
    if constexpr (P == 42) gdn_g1_mfma<31, 3>(args, lds, tid, lane, wave);
    if constexpr (P == 43) gdn_g1_mfma<0, 7>(args, lds, tid, lane, wave);
    if constexpr (P == 50) { if ((int)blockIdx.x < 32) gdn_scan(args, (int)blockIdx.x, lds, tid, lane, wave); }
    if constexpr (P == 52) gdn_out(args, lds, lane, wave);
    if constexpr (P == 51) { if ((int)blockIdx.x >= 32) swa_mfma(args, lds, tid, lane, wave, (int)blockIdx.x - 32, G - 32); }
    if constexpr (P == 6) { pg8::Gemm g{(const pg8::bf16_t*)(ws + WS_MIX), (const pg8::bf16_t*)(ws + WS_WOUTT), TT, DM, DM}; pg8::StaticOrder S; S.init(TT, DM, G, (int)blockIdx.x);
        pg8::EpiOut E{(const float*)args.in[I_X], (float*)(ws + WS_GSF)  , mod + 2048, SEQ, 6144, nullptr}; pg8::gemm_phase<pg8::EpiOut, pg8::StaticOrder, true, true>(lds, g, S, E); }
    if constexpr (P == 8) { SchedE S; S.init((const unsigned*)(ws + WS_CTL) + CW_ECNT, (const int2*)(ws + WS_EREC), (const char*)(ws + WS_WGUT), G, (int)blockIdx.x, lane);
        EpiGU E{(bf16*)(ws + WS_HID)}; pg8::gemm_phase_g<EpiGU, SchedE>(lds, (const pg8::bf16_t*)(ws + WS_H), 1024, 1024, 16, 16, S, E); }
    if constexpr (P == 71) norm_route_mfma<true, 1>(args, args.out, (const float*)(ws + WS_SSQ), (const float*)args.in[I_NORM_FFN], mod + 3072, mod + 4096, (bf16*)(ws + WS_PROJ + 32 * MiB), lds, tid, lane, wave);
    if constexpr (P == 7) norm_route_mfma<true>(args, args.out, (const float*)(ws + WS_SSQ), (const float*)args.in[I_NORM_FFN], mod + 3072, mod + 4096, (bf16*)(ws + WS_PROJ + 32 * MiB), lds, tid, lane, wave);
    if constexpr (P == 91 || P == 92) { SchedC S; S.init((const unsigned*)(ws + WS_CTL) + CW_CCNT, (const int*)(ws + WS_CLIST), (const char*)(ws + WS_WDT), G, (int)blockIdx.x, lane);
        EpiDownT<P - 90> E{(float*)(ws + WS_PROJ + 32 * MiB), mod + 5120}; pg8::gemm_phase_g<EpiDownT<P - 90>, SchedC>(lds, (const pg8::bf16_t*)(ws + WS_HID), 512, 256, 8, 4, S, E); }
    if constexpr (P == 9) { SchedC S; S.init((const unsigned*)(ws + WS_CTL) + CW_CCNT, (const int*)(ws + WS_CLIST), (const char*)(ws + WS_WDT), G, (int)blockIdx.x, lane);
        EpiDown E{(float*)(ws + WS_PROJ + 32 * MiB), mod + 5120}; pg8::gemm_phase_g<EpiDown, SchedC>(lds, (const pg8::bf16_t*)(ws + WS_HID), 512, 256, 8, 4, S, E); }
}
#endif
extern "C" void kernel_launch(void* const* d_in, const int* in_sizes, int n_in, void* d_out, int out_size, void* d_ws, size_t ws_size, hipStream_t stream) {
    static int grid = 0;
    if (grid == 0) {
        if (n_in != 23 || in_sizes[0] != TT * DM || out_size != TT * DM || ws_size < WS_END) { fprintf(stderr, "kernel_launch: unexpected shapes: n_in %d in0 %d out %d ws %zu (need %zu)\n", n_in, n_in > 0 ? in_sizes[0] : -1, out_size, ws_size, (size_t)WS_END); grid = -1; return; }
        int dev = 0, cus = 0, per_cu = 0;
        if (hipGetDevice(&dev) != hipSuccess || hipDeviceGetAttribute(&cus, hipDeviceAttributeMultiprocessorCount, dev) != hipSuccess) { grid = -1; return; }
        if (hipFuncSetAttribute((const void*)fwd_kernel, hipFuncAttributeMaxDynamicSharedMemorySize, LDS_BYTES) != hipSuccess) { fprintf(stderr, "kernel_launch: hipFuncSetAttribute failed\n"); grid = -1; return; }
        if (hipOccupancyMaxActiveBlocksPerMultiprocessor(&per_cu, (const void*)fwd_kernel, NTHR, LDS_BYTES) != hipSuccess || per_cu < 1) fprintf(stderr, "kernel_launch: occupancy query reports %d\n", per_cu);
        (void)hipGetLastError();
        grid = cus;
    }
    if (grid < 0) return;
    if (hipMemsetAsync((char*)d_ws + WS_CTL, 0, CTL_ZERO_BYTES, stream) != hipSuccess) { fprintf(stderr, "kernel_launch: memset failed\n"); return; }
    Args a{};
    for (int i = 0; i < 23; ++i) a.in[i] = d_in[i];
    a.out = (float*)d_out; a.ws = (unsigned char*)d_ws;
#if MK_ONE_LAUNCH
    a.ph_lo = 0; a.ph_hi = N_PHASES;
    hipLaunchKernelGGL(fwd_kernel, dim3(grid), dim3(NTHR), LDS_BYTES, stream, a);
#if PROBE_REP >= 0 && PROBE_REP < 1000
    hipFuncSetAttribute((const void*)probe_kernel<PROBE_REP>, hipFuncAttributeMaxDynamicSharedMemorySize, LDS_BYTES);
    hipLaunchKernelGGL(probe_kernel<PROBE_REP>, dim3(grid), dim3(NTHR), LDS_BYTES, stream, a);
#endif
#else
    for (int p = 0; p < N_PHASES; ++p) { a.ph_lo = p; a.ph_hi = p + 1; hipLaunchKernelGGL(fwd_kernel, dim3(grid), dim3(NTHR), LDS_BYTES, stream, a); }
#endif
}
```

```cpp
#include <hip/hip_runtime.h>
#include <cstdio>
#include <cstdint>
namespace pg8 {
#define PG8_LAS __attribute__((address_space(3)))
typedef unsigned short bf16_t;
typedef short bf16x8 __attribute__((ext_vector_type(8)));
typedef float f32x4 __attribute__((ext_vector_type(4)));
typedef unsigned u32x4 __attribute__((ext_vector_type(4)));
constexpr int BM = 256, BK = 64, HALF = 128, HTB = HALF * BK * 2  , STAGE_BYTES = 8 * HTB, NXCD = 8, WGM = 8;

__host__ __device__ __forceinline__ int lds_byte(int r, int c) { const int st = (r >> 4) * 2 + (c >> 5), rr = r & 15, cc = c & 31, ob = rr * 64 + cc * 2; return st * 1024 + (ob ^ (((ob >> 9) & 1) << 5)); }
__host__ __device__ __forceinline__ void stage_rc(int b, int& R, int& C) { const int st = b / 1024, sb = b % 1024, swz = sb ^ (((sb >> 9) & 1) << 5); R = (st >> 1) * 16 + swz / 64; C = (st & 1) * 32 + (swz % 64) / 2; }
__host__ __device__ __forceinline__ int perm32(int rho) { const int n = rho >> 4, i = rho & 15; return 8 * (i >> 2) + 4 * n + (i & 3); }

struct Unit { int pm, pn; };
struct Gemm { const bf16_t* A; const bf16_t* Bt; int M, N, K; };

struct StaticOrder {
    int nM, nN, nwg, G, c;
    __host__ __device__ void init(int M, int N, int G_, int c_) { nM = M / BM; nN = N / BM; nwg = nM * nN; G = G_; c = c_; }
    __host__ __device__ bool next(int i, Unit& u) const {
        const long L = (long)i * G + c; if (L >= nwg) return false;
        int wgid = (int)L; { const int q = nwg / NXCD, r = nwg % NXCD, xcd = wgid % NXCD, off = wgid / NXCD; wgid = (xcd < r ? xcd * (q + 1) : r * (q + 1) + (xcd - r) * q) + off; }
        const int nig = WGM * nN, gid = wgid / nig, fm = gid * WGM, gsz = (nM - fm) < WGM ? (nM - fm) : WGM;
        u.pm = fm + ((wgid % nig) % gsz); u.pn = (wgid % nig) / gsz; return true;
    }
    __device__ __forceinline__ void a_ready(const Unit&) const {}
    __device__ __forceinline__ void done(const Unit&) const {}
};

__device__ __forceinline__ unsigned cvt_pk_bf16(float lo, float hi) { unsigned r; asm volatile("v_cvt_pk_bf16_f32 %0, %1, %2" : "=v"(r) : "v"(lo), "v"(hi)); return r; }

struct EpiProj {
    static constexpr bool PERM = true, AFTER_DRAIN = false, PREFETCH = false;
    bf16_t* P; float* AB; int ldp;
    __device__ __forceinline__ void operator()(const f32x4 (&acc)[2][2][4][2], const Unit& u, int wr, int wc, int fr, int fq) const {
        const int row0 = u.pm * BM + wr * 64 + fr;
        if (u.pn < 11) {
            const int col0 = u.pn * BM + wc * 32 + 8 * fq;
#pragma unroll
            for (int ai = 0; ai < 2; ++ai)
#pragma unroll
                for (int m = 0; m < 4; ++m) { bf16_t* rowp = P + (size_t)(row0 + ai * HALF + m * 16) * ldp + col0;
#pragma unroll
                    for (int bj = 0; bj < 2; ++bj) { const f32x4 v0 = acc[ai][bj][m][0], v1 = acc[ai][bj][m][1];
                        u32x4 w; w.x = cvt_pk_bf16(v0[0], v0[1]); w.y = cvt_pk_bf16(v0[2], v0[3]); w.z = cvt_pk_bf16(v1[0], v1[1]); w.w = cvt_pk_bf16(v1[2], v1[3]);
                        *(u32x4*)(rowp + bj * HALF) = w; } }
        } else if (wc == 0 && fq < 2) {
#pragma unroll
            for (int ai = 0; ai < 2; ++ai)
#pragma unroll
                for (int m = 0; m < 4; ++m) { float* rowp = AB + (size_t)(row0 + ai * HALF + m * 16) * 16 + 8 * fq;
                    *(f32x4*)(rowp) = acc[ai][0][m][0]; *(f32x4*)(rowp + 4) = acc[ai][0][m][1]; }
        }
    }
};
struct EpiOut {
    static constexpr bool PERM = false, AFTER_DRAIN = false, PREFETCH = false;
    const float* X; float* O; const float* gate; int rows_per_batch, ldg;
    float* SSQ;
    __device__ __forceinline__ void prefetch(PG8_LAS unsigned char* lds, const Unit& u, int tid) const {
        const char* base = (const char*)X + ((size_t)(u.pm * BM) * 1024 + (size_t)u.pn * BM) * 4 + (size_t)(tid >> 3) * 4096 + (size_t)(tid & 7) * 128;
#pragma unroll
        for (int i = 0; i < 4; ++i) __builtin_amdgcn_global_load_lds((const unsigned*)(base + (size_t)i * 64 * 4096), (PG8_LAS unsigned*)(lds + STAGE_BYTES + 256), 4, 0, 0);
    }
    __device__ __forceinline__ void operator()(const f32x4 (&acc)[2][2][4][2], const Unit& u, int wr, int wc, int fr, int fq) const {
        const int row0 = u.pm * BM + wr * 64 + fr, col0 = u.pn * BM + wc * 32 + 4 * fq;
        const float* gb = gate + (size_t)((u.pm * BM) / rows_per_batch) * ldg + col0;
        f32x4 gv[2][2];
#pragma unroll
        for (int bj = 0; bj < 2; ++bj)
#pragma unroll
            for (int n = 0; n < 2; ++n) gv[bj][n] = *(const f32x4*)(gb + bj * HALF + n * 16);
#pragma unroll
        for (int ai = 0; ai < 2; ++ai)
#pragma unroll
            for (int m = 0; m < 4; ++m) { const size_t ro = (size_t)(row0 + ai * HALF + m * 16) * 1024 + col0; float ss = 0.f;
#pragma unroll
                for (int bj = 0; bj < 2; ++bj)
#pragma unroll
                    for (int n = 0; n < 2; ++n) { const f32x4 xv = *(const f32x4*)(X + ro + bj * HALF + n * 16); const f32x4 v = xv + gv[bj][n] * acc[ai][bj][m][n];
                        *(f32x4*)(O + ro + bj * HALF + n * 16) = v; ss += (v.x * v.x + v.y * v.y) + (v.z * v.z + v.w * v.w); }
                if (SSQ) { ss += __shfl_xor(ss, 16); ss += __shfl_xor(ss, 32); if (fq == 0) SSQ[(size_t)(row0 + ai * HALF + m * 16) * 16 + u.pn * 4 + wc] = ss; } }
    }
};

struct UnitG { int id, tile, pn, nrows; };
template <class Epi, class Sched>
__device__ __forceinline__ void gemm_phase_g(PG8_LAS unsigned char* lds, const bf16_t* Abase, const int KA, const int KB, const int nt, const int ksplit, const Sched& S, const Epi& E) {
    const int tid = threadIdx.x, wid = __builtin_amdgcn_readfirstlane(tid >> 6), lane = tid & 63, wr = wid >> 2, wc = wid & 3, fr = lane & 15, fq = lane >> 4;
    int Rr[2]; unsigned cB2[2], voffB[2];
#pragma unroll
    for (int i = 0; i < 2; ++i) { int R, C; stage_rc(tid * 16 + i * 8192, R, C); const int Rb = Epi::PERM ? ((R & ~31) + perm32(R & 31)) : R;
        Rr[i] = R; cB2[i] = (unsigned)C * 2u; voffB[i] = (unsigned)(Rb * KB + C) * 2u; }
    const size_t kstep = (size_t)(BK * 2);
    const size_t hstepB = (size_t)HALF * KB * 2;
    const unsigned ldsw = (unsigned)wid * 1024u;
    const int aoff = lds_byte(wr * 64 + fr, fq * 8), boff = lds_byte(wc * 32 + fr, fq * 8);
#define PG8_SA(b, h) (((b) * 2 + (h)) * HTB)
#define PG8_SB(b, h) ((4 + (b) * 2 + (h)) * HTB)
#define PG8_STAGE2(bufoff, gbase, v0, v1) do { \
        __builtin_amdgcn_global_load_lds((const unsigned*)((const char*)(gbase) + (v0)), (PG8_LAS unsigned*)(lds + (bufoff) + ldsw), 16, 0, 0); \
        __builtin_amdgcn_global_load_lds((const unsigned*)((const char*)(gbase) + (v1)), (PG8_LAS unsigned*)(lds + (bufoff) + ldsw + 8192), 16, 0, 0); } while (0)
#define PG8_LDA(dst, b, h) do { _Pragma("unroll") for (int m = 0; m < 4; ++m) _Pragma("unroll") for (int k = 0; k < 2; ++k) dst[m][k] = *(const PG8_LAS bf16x8*)(lds + PG8_SA(b, h) + aoff + m * 2048 + k * 1024); } while (0)
#define PG8_LDB(dst, b, h) do { _Pragma("unroll") for (int n = 0; n < 2; ++n) _Pragma("unroll") for (int k = 0; k < 2; ++k) dst[n][k] = *(const PG8_LAS bf16x8*)(lds + PG8_SB(b, h) + boff + n * 2048 + k * 1024); } while (0)
#define PG8_MMA(ai, bj, At, Bt) do { __builtin_amdgcn_s_setprio(1); _Pragma("unroll") for (int m = 0; m < 4; ++m) _Pragma("unroll") for (int n = 0; n < 2; ++n) _Pragma("unroll") for (int k = 0; k < 2; ++k) \
        acc[ai][bj][m][n] = __builtin_amdgcn_mfma_f32_16x16x32_bf16(Bt[n][k], At[m][k], acc[ai][bj][m][n], 0, 0, 0); __builtin_amdgcn_s_setprio(0); } while (0)
#define PG8_WAIT_V(n) asm volatile("s_waitcnt vmcnt(" #n ")" ::: "memory")
#define PG8_WAIT_L(n) asm volatile("s_waitcnt lgkmcnt(" #n ")" ::: "memory")
#define PG8_BAR __builtin_amdgcn_s_barrier()
#define PG8_SCHED __builtin_amdgcn_sched_barrier(0)
#define PG8_AOFFS(u, o00, o01, o10, o11) do { const unsigned _ks = (unsigned)KA * 2u; \
        o00 = (unsigned)S.tok(u, Rr[0]) * _ks + cB2[0]; o01 = (unsigned)S.tok(u, Rr[1]) * _ks + cB2[1]; \
        o10 = (unsigned)S.tok(u, HALF + Rr[0]) * _ks + cB2[0]; o11 = (unsigned)S.tok(u, HALF + Rr[1]) * _ks + cB2[1]; } while (0)
#define PG8_BT(u, t) (((t) < ksplit) ? S.bseg(u, 0) + (size_t)(t) * kstep : S.bseg(u, 1) + (size_t)((t) - ksplit) * kstep)
    UnitG cur, nxt; int ui = 0;
    if (!S.next(0, cur)) return;
    f32x4 acc[2][2][4][2];
#pragma unroll
    for (int a = 0; a < 2; ++a)
#pragma unroll
        for (int b = 0; b < 2; ++b)
#pragma unroll
            for (int m = 0; m < 4; ++m)
#pragma unroll
                for (int n = 0; n < 2; ++n) acc[a][b][m][n] = (f32x4){0.f, 0.f, 0.f, 0.f};
    bf16x8 At[4][2], B0[2][2], B1[2][2];
    unsigned c00, c01, c10, c11, n00 = 0, n01 = 0, n10 = 0, n11 = 0;
    PG8_AOFFS(cur, c00, c01, c10, c11);
    if constexpr (Epi::PREFETCH) E.prefetch(lds, cur, S, tid);
    const char* const Ab = (const char*)Abase;
    {   const char* b0p = PG8_BT(cur, 0); const char* b1p = PG8_BT(cur, 1);
        PG8_STAGE2(PG8_SB(0, 0), b0p, voffB[0], voffB[1]); PG8_STAGE2(PG8_SB(0, 1), b0p + hstepB, voffB[0], voffB[1]); PG8_STAGE2(PG8_SA(0, 0), Ab, c00, c01); PG8_STAGE2(PG8_SA(0, 1), Ab, c10, c11);
        if (wr == 1) PG8_BAR;
        PG8_WAIT_V(2); PG8_BAR;
        PG8_STAGE2(PG8_SB(1, 0), b1p, voffB[0], voffB[1]); PG8_STAGE2(PG8_SA(1, 0), Ab + kstep, c00, c01); PG8_STAGE2(PG8_SB(1, 1), b1p + hstepB, voffB[0], voffB[1]);
        PG8_WAIT_V(6); PG8_BAR;
    }
    for (;;) {
        const bool has_next = S.next(ui + 1, nxt);
        const bool h1 = cur.nrows > HALF;
        for (int t = 0; t < nt; t += 2) {
            const bool last = (t == nt - 2);
            if (last && has_next) { PG8_AOFFS(nxt, n00, n01, n10, n11); if constexpr (Epi::PREFETCH) E.prefetch(lds, nxt, S, tid); }
            const bool usen = last && has_next;
            const int t2 = last ? 0 : t + 2, t3 = t2 + 1;
            const char* a1 = Ab + (size_t)(t + 1) * kstep;
            const char* a2 = Ab + (size_t)t2 * kstep; const char* a3 = Ab + (size_t)t3 * kstep;
            const char* b2 = usen ? PG8_BT(nxt, t2) : PG8_BT(cur, t2); const char* b3 = usen ? PG8_BT(nxt, t3) : PG8_BT(cur, t3);
            const unsigned o00 = usen ? n00 : c00, o01 = usen ? n01 : c01, o10 = usen ? n10 : c10, o11 = usen ? n11 : c11;
            PG8_LDB(B0, 0, 0); PG8_LDB(B1, 0, 1); PG8_SCHED; PG8_LDA(At, 0, 0); PG8_STAGE2(PG8_SA(1, 1), a1, c10, c11);
            PG8_WAIT_V(8); PG8_WAIT_L(0); PG8_BAR; PG8_MMA(0, 0, At, B0); PG8_MMA(0, 1, At, B1); PG8_BAR; PG8_SCHED;
            PG8_LDA(At, 0, 1); PG8_STAGE2(PG8_SB(0, 0), b2, voffB[0], voffB[1]); PG8_STAGE2(PG8_SB(0, 1), b2 + hstepB, voffB[0], voffB[1]); PG8_STAGE2(PG8_SA(0, 0), a2, o00, o01);
            PG8_WAIT_V(8); PG8_WAIT_L(0); PG8_BAR; if (h1) { PG8_MMA(1, 0, At, B0); PG8_MMA(1, 1, At, B1); } PG8_BAR; PG8_SCHED;
            PG8_LDB(B0, 1, 0); PG8_LDB(B1, 1, 1); PG8_SCHED; PG8_LDA(At, 1, 0); PG8_STAGE2(PG8_SA(0, 1), a2, o10, o11);
            PG8_WAIT_V(8); PG8_WAIT_L(0); PG8_BAR; PG8_MMA(0, 0, At, B0); PG8_MMA(0, 1, At, B1); PG8_BAR; PG8_SCHED;
            PG8_LDA(At, 1, 1); PG8_STAGE2(PG8_SB(1, 0), b3, voffB[0], voffB[1]); PG8_STAGE2(PG8_SB(1, 1), b3 + hstepB, voffB[0], voffB[1]); PG8_STAGE2(PG8_SA(1, 0), a3, o00, o01);
            PG8_WAIT_V(8); PG8_WAIT_L(0); PG8_BAR; if (h1) { PG8_MMA(1, 0, At, B0); PG8_MMA(1, 1, At, B1); } PG8_BAR; PG8_SCHED;
        }
        if (wr == 0) PG8_BAR;
        E(acc, cur, S, wr, wc, fr, fq);
        if (!has_next) break;
#pragma unroll
        for (int a = 0; a < 2; ++a)
#pragma unroll
            for (int b = 0; b < 2; ++b)
#pragma unroll
                for (int m = 0; m < 4; ++m)
#pragma unroll
                    for (int n = 0; n < 2; ++n) acc[a][b][m][n] = (f32x4){0.f, 0.f, 0.f, 0.f};
        cur = nxt; c00 = n00; c01 = n01; c10 = n10; c11 = n11; ++ui;
        if (wr == 1) PG8_BAR;
    }
    PG8_WAIT_V(0);
    PG8_BAR;
#undef PG8_SA
#undef PG8_SB
#undef PG8_STAGE2
#undef PG8_LDA
#undef PG8_LDB
#undef PG8_MMA
#undef PG8_WAIT_V
#undef PG8_WAIT_L
#undef PG8_BAR
#undef PG8_SCHED
#undef PG8_AOFFS
#undef PG8_BT
}
template <class Epi, class Sched, bool ALIGN_EPI = false, bool SP2 = false>
__device__ __forceinline__ void gemm_phase(PG8_LAS unsigned char* lds, const Gemm g, const Sched& S, const Epi& E) {
    const int tid = threadIdx.x, wid = __builtin_amdgcn_readfirstlane(tid >> 6), lane = tid & 63, wr = wid >> 2, wc = wid & 3, fr = lane & 15, fq = lane >> 4;
    const int K = g.K, nt = K / BK;
    unsigned voffA[2], voffB[2];
#pragma unroll
    for (int i = 0; i < 2; ++i) { int R, C; stage_rc(tid * 16 + i * 8192, R, C); const int Rb = Epi::PERM ? ((R & ~31) + perm32(R & 31)) : R;
        voffA[i] = (unsigned)(R * K + C) * 2u; voffB[i] = (unsigned)(Rb * K + C) * 2u; }
    const size_t kstep = (size_t)(BK * 2);
    const size_t hstep = (size_t)HALF * K * 2;
    const size_t tstep = 2 * hstep;
    const unsigned ldsw = (unsigned)wid * 1024u;
    const int aoff = lds_byte(wr * 64 + fr, fq * 8), boff = lds_byte(wc * 32 + fr, fq * 8);
#define PG8_SA(b, h) (((b) * 2 + (h)) * HTB)
#define PG8_SB(b, h) ((4 + (b) * 2 + (h)) * HTB)
#define PG8_STAGE(bufoff, gbase, voff) do { _Pragma("unroll") for (int _i = 0; _i < 2; ++_i) \
        __builtin_amdgcn_global_load_lds((const unsigned*)((const char*)(gbase) + (voff)[_i]), (PG8_LAS unsigned*)(lds + (bufoff) + ldsw + _i * 8192), 16, 0, 0); } while (0)
#define PG8_LDA(dst, b, h) do { _Pragma("unroll") for (int m = 0; m < 4; ++m) _Pragma("unroll") for (int k = 0; k < 2; ++k) dst[m][k] = *(const PG8_LAS bf16x8*)(lds + PG8_SA(b, h) + aoff + m * 2048 + k * 1024); } while (0)
#define PG8_LDB(dst, b, h) do { _Pragma("unroll") for (int n = 0; n < 2; ++n) _Pragma("unroll") for (int k = 0; k < 2; ++k) dst[n][k] = *(const PG8_LAS bf16x8*)(lds + PG8_SB(b, h) + boff + n * 2048 + k * 1024); } while (0)
#define PG8_MMA(ai, bj, At, Bt) do { __builtin_amdgcn_s_setprio(1); _Pragma("unroll") for (int m = 0; m < 4; ++m) _Pragma("unroll") for (int n = 0; n < 2; ++n) _Pragma("unroll") for (int k = 0; k < 2; ++k) \
        acc[ai][bj][m][n] = __builtin_amdgcn_mfma_f32_16x16x32_bf16(Bt[n][k], At[m][k], acc[ai][bj][m][n], 0, 0, 0); __builtin_amdgcn_s_setprio(0); } while (0)
#define PG8_WAIT_V(n) asm volatile("s_waitcnt vmcnt(" #n ")" ::: "memory")
#define PG8_WAIT_L(n) asm volatile("s_waitcnt lgkmcnt(" #n ")" ::: "memory")
#define PG8_BAR __builtin_amdgcn_s_barrier()
#define PG8_SCHED __builtin_amdgcn_sched_barrier(0)
    Unit cur, nxt; int ui = 0;
    if (!S.next(0, cur)) return;
    f32x4 acc[2][2][4][2];
#pragma unroll
    for (int a = 0; a < 2; ++a)
#pragma unroll
        for (int b = 0; b < 2; ++b)
#pragma unroll
            for (int m = 0; m < 4; ++m)
#pragma unroll
                for (int n = 0; n < 2; ++n) acc[a][b][m][n] = (f32x4){0.f, 0.f, 0.f, 0.f};
    bf16x8 At[4][2], B0[2][2], B1[2][2];
    const char* cA = (const char*)g.A + (size_t)cur.pm * tstep; const char* cB = (const char*)g.Bt + (size_t)cur.pn * tstep;
    S.a_ready(cur);
    if constexpr (SP2) {
        PG8_STAGE(PG8_SB(0, 0), cB, voffB); PG8_STAGE(PG8_SB(0, 1), cB + hstep, voffB); PG8_STAGE(PG8_SA(0, 0), cA, voffA); PG8_STAGE(PG8_SA(0, 1), cA + hstep, voffA);
        if (wr == 1) PG8_BAR;
        PG8_WAIT_V(2); PG8_BAR;
        PG8_STAGE(PG8_SB(1, 0), cB + kstep, voffB); PG8_STAGE(PG8_SA(1, 0), cA + kstep, voffA); PG8_STAGE(PG8_SB(1, 1), cB + hstep + kstep, voffB);
        PG8_WAIT_V(6); PG8_BAR;
    } else {
        PG8_STAGE(PG8_SB(0, 0), cB, voffB); PG8_STAGE(PG8_SA(0, 0), cA, voffA); PG8_STAGE(PG8_SB(0, 1), cB + hstep, voffB); PG8_STAGE(PG8_SA(0, 1), cA + hstep, voffA);
        if (wr == 1) PG8_BAR;
        PG8_WAIT_V(4); PG8_BAR;
        PG8_STAGE(PG8_SB(1, 0), cB + kstep, voffB); PG8_STAGE(PG8_SA(1, 0), cA + kstep, voffA); PG8_STAGE(PG8_SB(1, 1), cB + hstep + kstep, voffB);
        PG8_WAIT_V(6); PG8_BAR;
    }
    if constexpr (Epi::PREFETCH) E.prefetch(lds, cur, tid);
    for (;;) {
        const bool has_next = S.next(ui + 1, nxt);
        const char* nA = has_next ? (const char*)g.A + (size_t)nxt.pm * tstep : cA; const char* nB = has_next ? (const char*)g.Bt + (size_t)nxt.pn * tstep : cB;
        for (int t = 0; t < nt; t += 2) {
            const bool last = (t == nt - 2);
            const char* a1 = cA + (size_t)(t + 1) * kstep;
            const char* a2 = last ? nA : cA + (size_t)(t + 2) * kstep; const char* b2 = last ? nB : cB + (size_t)(t + 2) * kstep;
            const char* a3 = a2 + kstep; const char* b3 = b2 + kstep;
            if (last && has_next) S.a_ready(nxt);
            if constexpr (SP2) {
            PG8_LDB(B0, 0, 0); PG8_LDB(B1, 0, 1); PG8_SCHED; PG8_LDA(At, 0, 0); PG8_STAGE(PG8_SA(1, 1), a1 + hstep, voffA);
            PG8_WAIT_V(8); PG8_WAIT_L(0); PG8_BAR; PG8_MMA(0, 0, At, B0); PG8_MMA(0, 1, At, B1); PG8_BAR; PG8_SCHED;
            PG8_LDA(At, 0, 1); PG8_STAGE(PG8_SB(0, 0), b2, voffB); PG8_STAGE(PG8_SB(0, 1), b2 + hstep, voffB); PG8_STAGE(PG8_SA(0, 0), a2, voffA);
            PG8_WAIT_V(8); PG8_WAIT_L(0); PG8_BAR; PG8_MMA(1, 0, At, B0); PG8_MMA(1, 1, At, B1); PG8_BAR; PG8_SCHED;
            PG8_LDB(B0, 1, 0); PG8_LDB(B1, 1, 1); PG8_SCHED; PG8_LDA(At, 1, 0); PG8_STAGE(PG8_SA(0, 1), a2 + hstep, voffA);
            PG8_WAIT_V(8); PG8_WAIT_L(0); PG8_BAR; PG8_MMA(0, 0, At, B0); PG8_MMA(0, 1, At, B1); PG8_BAR; PG8_SCHED;
            PG8_LDA(At, 1, 1); PG8_STAGE(PG8_SB(1, 0), b3, voffB); PG8_STAGE(PG8_SB(1, 1), b3 + hstep, voffB); PG8_STAGE(PG8_SA(1, 0), a3, voffA);
            PG8_WAIT_V(8); PG8_WAIT_L(0); PG8_BAR; PG8_MMA(1, 0, At, B0); PG8_MMA(1, 1, At, B1); PG8_BAR; PG8_SCHED;
            } else {
            PG8_LDB(B0, 0, 0); PG8_SCHED; PG8_LDA(At, 0, 0); PG8_STAGE(PG8_SA(1, 1), a1 + hstep, voffA);
            PG8_WAIT_L(8); PG8_BAR; PG8_WAIT_L(0); PG8_MMA(0, 0, At, B0); PG8_BAR; PG8_SCHED;
            PG8_LDB(B1, 0, 1); PG8_STAGE(PG8_SB(0, 0), b2, voffB);
            PG8_BAR; PG8_WAIT_L(0); PG8_MMA(0, 1, At, B1); PG8_BAR;
            PG8_LDA(At, 0, 1); PG8_STAGE(PG8_SA(0, 0), a2, voffA);
            PG8_BAR; PG8_WAIT_L(0); PG8_MMA(1, 0, At, B0); PG8_BAR; PG8_SCHED;
            PG8_STAGE(PG8_SB(0, 1), b2 + hstep, voffB);
            PG8_WAIT_V(6); PG8_BAR; PG8_MMA(1, 1, At, B1); PG8_BAR;
            PG8_LDB(B0, 1, 0); PG8_SCHED; PG8_LDA(At, 1, 0); PG8_STAGE(PG8_SA(0, 1), a2 + hstep, voffA);
            PG8_WAIT_L(8); PG8_BAR; PG8_WAIT_L(0); PG8_MMA(0, 0, At, B0); PG8_BAR; PG8_SCHED;
            PG8_LDB(B1, 1, 1); PG8_STAGE(PG8_SB(1, 0), b3, voffB);
            PG8_BAR; PG8_WAIT_L(0); PG8_MMA(0, 1, At, B1); PG8_BAR;
            PG8_LDA(At, 1, 1); PG8_STAGE(PG8_SA(1, 0), a3, voffA);
            PG8_BAR; PG8_WAIT_L(0); PG8_MMA(1, 0, At, B0); PG8_BAR; PG8_SCHED;
            PG8_STAGE(PG8_SB(1, 1), b3 + hstep, voffB);
            PG8_WAIT_V(6); PG8_BAR; PG8_MMA(1, 1, At, B1); PG8_BAR;
            }
        }
        if constexpr (ALIGN_EPI) { if (wr == 0) PG8_BAR; }
        if constexpr (!Epi::AFTER_DRAIN) { E(acc, cur, wr, wc, fr, fq); S.done(cur); }
        if (!has_next) break;
#pragma unroll
        for (int a = 0; a < 2; ++a)
#pragma unroll
            for (int b = 0; b < 2; ++b)
#pragma unroll
                for (int m = 0; m < 4; ++m)
#pragma unroll
                    for (int n = 0; n < 2; ++n) acc[a][b][m][n] = (f32x4){0.f, 0.f, 0.f, 0.f};
        cur = nxt; cA = nA; cB = nB; ++ui;
        if constexpr (Epi::PREFETCH) { int l_ = fr + 16 * fq; asm volatile("" : "+v"(l_)); E.prefetch(lds, cur, wid * 64 + l_); }
        if constexpr (ALIGN_EPI) { if (wr == 1) PG8_BAR; }
    }
    PG8_WAIT_V(0);
    if constexpr (!ALIGN_EPI) { if (wr == 0) PG8_BAR; }
    PG8_BAR;
    if constexpr (Epi::AFTER_DRAIN) { E.fused(acc, cur, wr, wc, fr, fq, lds, wid, lane); S.done(cur); }
#undef PG8_SA
#undef PG8_SB
#undef PG8_STAGE
#undef PG8_LDA
#undef PG8_LDB
#undef PG8_MMA
#undef PG8_WAIT_V
#undef PG8_WAIT_L
#undef PG8_BAR
#undef PG8_SCHED
}
}

constexpr int NB = 4, SEQ = 8192, DM = 1024, TT = NB * SEQ;
constexpr int NPROJ = 2816, NPAD = 3072;
constexpr int PC_Q = 0, PC_K = 512, PC_V = 1024, PC_Z = 1536, PC_SQ = 2048, PC_SK = 2560, PC_SV = 2688;
constexpr int NE = 32, NCLS = 112, DE = 256;
constexpr float EPS = 1e-6f;
constexpr int NWAVES = 8, NTHR = 512;
constexpr int N_PHASES = 10;
#ifndef G1_SM
#define G1_SM 31
#endif
#ifndef PROBE_REP
#define PROBE_REP -1
#endif
#ifndef MK_ONE_LAUNCH
#define MK_ONE_LAUNCH 1
#endif

constexpr size_t MiB = 1u << 20;
constexpr size_t WS_CTL = 0, CTL_ZERO_BYTES = 1 * MiB;
constexpr size_t WS_MOD = 1 * MiB;
constexpr size_t WS_WINT = 2 * MiB, WS_WOUTT = 8 * MiB, WS_WGUT = 10 * MiB, WS_WDT = 42 * MiB;
constexpr size_t WS_H = 58 * MiB;
constexpr size_t WS_PROJ = 122 * MiB;
constexpr size_t WS_AB = 298 * MiB;
constexpr size_t WS_SSQ = WS_AB;
constexpr size_t WS_MIX = 300 * MiB;
constexpr size_t WS_GSF = 364 * MiB;
constexpr size_t WS_EREC = 404 * MiB, WS_CLIST = 412 * MiB;
constexpr size_t WS_HID = WS_PROJ;
constexpr size_t WS_GAP = WS_H, WS_GQP = WS_H + 32 * MiB;
constexpr size_t WS_GOP = 426 * MiB, WS_GBP = 458 * MiB, WS_GGL = 490 * MiB;
constexpr size_t WS_WRT = 491 * MiB;
constexpr size_t WS_END = 492 * MiB;
constexpr int CW_BAR = 4096, CW_ECNT = 8192, CW_CCNT = 8256;

constexpr int RING_BYTES = 131072, LDSCTL_OFF = RING_BYTES, LDS_BYTES = 147456, MISC_OFF = LDS_BYTES - 128;

#define GAS __attribute__((address_space(1)))
#define LAS __attribute__((address_space(3)))
typedef unsigned short bf16;
typedef unsigned v4u __attribute__((ext_vector_type(4)));
typedef float f32x4 __attribute__((ext_vector_type(4)));
typedef GAS unsigned gu32;
#define RLX_AGENT __ATOMIC_RELAXED, __HIP_MEMORY_SCOPE_AGENT
#define LDS_WAIT() asm volatile("s_waitcnt lgkmcnt(0)" ::: "memory")
__device__ __forceinline__ unsigned f2bf(float f) { unsigned u = __builtin_bit_cast(unsigned, f); return (u + 0x7fffu + ((u >> 16) & 1u)) >> 16; }
__device__ __forceinline__ unsigned pk2(float lo, float hi) { return f2bf(lo) | (f2bf(hi) << 16); }
__device__ __forceinline__ float bf2f(bf16 v) { return __builtin_bit_cast(float, (unsigned)v << 16); }
__device__ __forceinline__ float wave_sum(float v) {
#pragma unroll
    for (int o = 1; o < 64; o <<= 1) v += __shfl_xor(v, o);
    return v;
}
__device__ __forceinline__ float siluf(float y) { return y / (1.f + __expf(-y)); }
#define XB_TMO      128
#define XB_XCNT(j)  (256  + 64 * (j))
#define XB_XSUB(j)  (1280 + 64 * (j))
#define XB_XGEN(j)  (2304 + 64 * (j))
#define XB_TOP      3328
#define XB_TOPGEN   3392
#define XCD_BAR_WORDS 3456
#define XB_SPIN_CAP (1u << 18)
__device__ __forceinline__ unsigned xb_ld(unsigned* p)              { return __hip_atomic_load(p, __ATOMIC_RELAXED, __HIP_MEMORY_SCOPE_AGENT); }
__device__ __forceinline__ unsigned xb_add(unsigned* p, unsigned v) { return __hip_atomic_fetch_add(p, v, __ATOMIC_RELAXED, __HIP_MEMORY_SCOPE_AGENT); }
__device__ __forceinline__ unsigned xb_xcc_id() { return (unsigned)__builtin_amdgcn_s_getreg((3 << 11) | 20) & 0xFu; }
#define XB_SPIN(cond, bar) do { unsigned _sp = 0; while (cond) { __builtin_amdgcn_s_sleep(1); \
    if ((++_sp & 255u) == 0u) { if (xb_ld(&(bar)[XB_TMO])) break; if (_sp > XB_SPIN_CAP) { atomicAdd(&(bar)[XB_TMO], 1u); break; } } } } while (0)

struct XcdBarrier {
    unsigned* bar; unsigned x;
    volatile LAS unsigned* st;
};

__device__ __forceinline__ XcdBarrier xcd_barrier_post(unsigned* bar, volatile LAS unsigned* st, bool leader  ) {
    XcdBarrier b; b.bar = bar; b.x = xb_xcc_id(); b.st = st;
    if (leader) (void)xb_add(&bar[XB_XCNT(b.x)], 1u);
    return b;
}
__device__ __forceinline__ void xcd_barrier_complete(unsigned* bar, unsigned x, unsigned& nloc, unsigned& nx) {
    const unsigned G = gridDim.x * gridDim.y * gridDim.z;
    unsigned sum, cnt, mine, sp = 0u;
    for (;;) {
        sum = 0u; cnt = 0u; mine = 0u;
#pragma unroll
        for (unsigned j = 0; j < 16; ++j) { const unsigned c = xb_ld(&bar[XB_XCNT(j)]); sum += c; cnt += (c > 0u) ? 1u : 0u; mine = (j == x) ? c : mine; }
        if (sum == G) break;
        __builtin_amdgcn_s_sleep(1);
        if ((++sp & 255u) == 0u) { if (xb_ld(&bar[XB_TMO])) break; if (sp > XB_SPIN_CAP) { atomicAdd(&bar[XB_TMO], 1u); break; } }
    }
    nloc = mine > 0u ? mine : 1u; nx = cnt > 0u ? cnt : 1u;
}

__device__ __forceinline__ void xcd_barrier(const XcdBarrier& b, bool leader  ) {
    asm volatile("s_waitcnt vmcnt(0)" ::: "memory");
    __syncthreads();
    if (leader) {
        unsigned* bar = b.bar;
        __builtin_amdgcn_s_waitcnt(0);
        unsigned nloc = b.st[0], nx = b.st[1];
        if (nloc == 0u) { xcd_barrier_complete(bar, b.x, nloc, nx); b.st[0] = nloc; b.st[1] = nx; }
        const unsigned old = xb_add(&bar[XB_XSUB(b.x)], 1u);
        const unsigned gen = old / nloc;
        if (old + 1u == (gen + 1u) * nloc) {
            __builtin_amdgcn_fence(__ATOMIC_RELEASE, "agent");
            asm volatile("s_waitcnt vmcnt(0)" ::: "memory");
            const unsigned og = xb_add(&bar[XB_TOP], 1u);
            const unsigned tg = og / nx;
            if (og + 1u == (tg + 1u) * nx) xb_add(&bar[XB_TOPGEN], 1u);
            else XB_SPIN(xb_ld(&bar[XB_TOPGEN]) == tg, bar);
            __builtin_amdgcn_fence(__ATOMIC_ACQUIRE, "agent");
            xb_add(&bar[XB_XGEN(b.x)], 1u);
            asm volatile("s_waitcnt vmcnt(0)" ::: "memory");
        } else {
            XB_SPIN(xb_ld(&bar[XB_XGEN(b.x)]) == gen, bar);
            __builtin_amdgcn_fence(__ATOMIC_ACQUIRE, "agent");
            asm volatile("s_waitcnt vmcnt(0)" ::: "memory");
        }
    }
    __syncthreads();
}

struct Args { const void* in[23]; float* out; unsigned char* ws; int ph_lo, ph_hi; };
enum { I_X = 0, I_C, I_POS, I_WADA, I_BADA, I_NORM_MIX, I_WIN, I_CONVW, I_ALOG, I_DTB, I_GNORM, I_QNORM, I_KNORM, I_SINKS, I_WOUT, I_NORM_FFN, I_WGRP, I_BGRP, I_WRT, I_BRT, I_WGATE, I_WUP, I_WDOWN };

template <class CM>
__device__ __forceinline__ void transpose_item(const float* W, int ldw, int k0, bf16* WT, int ldt, int n0, CM cm, LAS float* scr, int lane) {
    const int sc = cm(n0 + (lane & 31));
    float tv[32];
#pragma unroll
    for (int i = 0; i < 32; ++i) { const int kk = 2 * i + (lane >> 5); tv[i] = W[(size_t)(k0 + kk) * ldw + (sc >= 0 ? sc : 0)]; }
#pragma unroll
    for (int i = 0; i < 32; ++i) { const int kk = 2 * i + (lane >> 5); scr[kk * 33 + (lane & 31)] = sc >= 0 ? tv[i] : 0.f; }
    LDS_WAIT(); asm volatile("" ::: "memory");
    const int c = lane & 7;
#pragma unroll
    for (int j = 0; j < 4; ++j) { const int n = (lane >> 3) + 8 * j; const LAS float* s = scr + (8 * c) * 33 + n;
        v4u o; o.x = pk2(s[0 * 33], s[1 * 33]); o.y = pk2(s[2 * 33], s[3 * 33]); o.z = pk2(s[4 * 33], s[5 * 33]); o.w = pk2(s[6 * 33], s[7 * 33]);
        *(v4u*)(WT + (size_t)(n0 + n) * ldt + k0 + 8 * c) = o; }
    LDS_WAIT(); asm volatile("" ::: "memory");
}
struct CmIn { __device__ __forceinline__ int operator()(int n) const { return n < 2048 ? n : (n < 2816 ? n + 16 : (n < 2832 ? 2048 + (n - 2816) : -1)); } };
struct CmOff { int off; __device__ __forceinline__ int operator()(int n) const { return n + off; } };
struct CmId { __device__ __forceinline__ int operator()(int n) const { return n; } };

__device__ __forceinline__ void p0_prologue(const Args& A, LAS unsigned char* lds, int tid, int lane, int wave) {
    unsigned char* ws = A.ws;
    LAS float* scr = (LAS float*)(lds + wave * 8448);
    const int G = gridDim.x, gw = blockIdx.x * NWAVES + wave, NGW = G * NWAVES;
    constexpr int IT_IN = (NPAD / 32) * (DM / 64), IT_OUT = (DM / 32) * (DM / 64);
    for (int it = gw; it < IT_IN + IT_OUT; it += NGW) {
        if (it < IT_IN) { const int nb = it % (NPAD / 32), kb = it / (NPAD / 32); transpose_item((const float*)A.in[I_WIN], 2832, kb * 64, (bf16*)(ws + WS_WINT), DM, nb * 32, CmIn(), scr, lane); }
        else { const int r = it - IT_IN, nb = r % (DM / 32), kb = r / (DM / 32); transpose_item((const float*)A.in[I_WOUT], DM, kb * 64, (bf16*)(ws + WS_WOUTT), DM, nb * 32, CmId(), scr, lane); }
    }
    {   constexpr int IT_GU = NE * 16 * 16, IT_D = NE * 32 * 4;
        const float* wgate = (const float*)A.in[I_WGATE]; const float* wup = (const float*)A.in[I_WUP]; const float* wdown = (const float*)A.in[I_WDOWN];
        for (int it = gw; it < IT_GU + IT_D; it += NGW) {
            if (it < IT_GU) { const int e = it >> 8, r = it & 255, nb = r & 15, kb = r >> 4, j = nb >> 3, q = nb & 7;
                const float* W = (q < 4 ? wgate : wup) + (size_t)e * 1024 * 256; const int col0 = j * 128 + (q & 3) * 32;
                transpose_item(W, 256, kb * 64, (bf16*)(ws + WS_WGUT) + (size_t)e * 512 * 1024, 1024, nb * 32, CmOff{col0 - nb * 32}, scr, lane); }
            else { const int r2 = it - IT_GU, e = r2 >> 7, r = r2 & 127, nb = r & 31, kb = r >> 5;
                transpose_item(wdown + (size_t)e * 256 * 1024, 1024, kb * 64, (bf16*)(ws + WS_WDT) + (size_t)e * 1024 * 256, 256, nb * 32, CmId(), scr, lane); }
        }
    }
    {   const float* wgp = (const float*)A.in[I_WGRP]; const float* wrt = (const float*)A.in[I_WRT];
        bf16* wf = (bf16*)(ws + WS_WRT);
        for (int idx = blockIdx.x * NTHR + tid; idx < 48 * 1024; idx += G * NTHR) { const int j = idx & 7, ln = (idx >> 3) & 63, ks = (idx >> 9) & 31, nt = idx >> 14;
            const int o = 16 * nt + (ln & 15), k = 32 * ks + 8 * (ln >> 4) + j;
            const float w = o < 4 ? wgp[k * 4 + o] : (o < 36 ? wrt[k * 32 + o - 4] : 0.f);
            const unsigned hb = f2bf(w); wf[idx] = (bf16)hb; wf[48 * 1024 + idx] = (bf16)f2bf(w - __builtin_bit_cast(float, hb << 16)); }
    }
    LAS float* cact = (LAS float*)(lds + 69632);
    LAS float* red = (LAS float*)(lds + 69632 + 16384);
    const float* c = (const float*)A.in[I_C]; const float* wada = (const float*)A.in[I_WADA]; const float* bada = (const float*)A.in[I_BADA];
    float* mod = (float*)(ws + WS_MOD);
    if ((int)blockIdx.x < 96) {
        __syncthreads();
        for (int i = tid; i < 4096; i += NTHR) cact[i] = siluf(c[i]);
        __syncthreads();
        for (int u = blockIdx.x; u < 96; u += G) {
            const int n = u * 64 + lane; float a0 = 0.f, a1 = 0.f, a2 = 0.f, a3 = 0.f;
#pragma unroll 16
            for (int k = wave * 128; k < wave * 128 + 128; ++k) { const float w = wada[(size_t)k * 6144 + n]; a0 += cact[k] * w; a1 += cact[1024 + k] * w; a2 += cact[2048 + k] * w; a3 += cact[3072 + k] * w; }
            red[(wave * 4 + 0) * 64 + lane] = a0; red[(wave * 4 + 1) * 64 + lane] = a1; red[(wave * 4 + 2) * 64 + lane] = a2; red[(wave * 4 + 3) * 64 + lane] = a3;
            __syncthreads();
            if (tid < 256) { const int b = tid >> 6, l = tid & 63; float s = bada[u * 64 + l];
#pragma unroll
                for (int w = 0; w < 8; ++w) s += red[(w * 4 + b) * 64 + l];
                mod[b * 6144 + u * 64 + l] = s; }
            __syncthreads();
        }
    }
}

template <bool ROUTE>
__device__ __forceinline__ void norm_rows(const Args& A, const float* X, const float* gain, const float* shift, const float* scale, bf16* H, LAS unsigned char* lds, int lane, int wave) {
    LAS float* hl = (LAS float*)(lds + wave * 4096);
    const int G = gridDim.x, gw = blockIdx.x * NWAVES + wave, NGW = G * NWAVES;
    unsigned char* ws = A.ws;
    for (int r0 = gw * 16; r0 < TT; r0 += NGW * 16) {
        const int b = r0 / SEQ;
        f32x4 mf[4], af[4];
#pragma unroll
        for (int j = 0; j < 4; ++j) { const int col = 4 * lane + 256 * j; const f32x4 g = *(const f32x4*)(gain + col), sc = *(const f32x4*)(scale + b * 6144 + col);
            mf[j] = g * (sc + 1.0f); af[j] = *(const f32x4*)(shift + b * 6144 + col); }
#pragma unroll 4
        for (int i = 0; i < 16; ++i) {
            const int row = r0 + i;
            const f32x4* xr = (const f32x4*)(X + (size_t)row * DM) + lane;
            f32x4 v[4]; float s = 0.f;
#pragma unroll
            for (int j = 0; j < 4; ++j) { v[j] = xr[64 * j]; s += (v[j].x * v[j].x + v[j].y * v[j].y) + (v[j].z * v[j].z + v[j].w * v[j].w); }
            const float rstd = 1.f / sqrtf(wave_sum(s) * (1.f / DM) + EPS);
            unsigned long long* o8 = (unsigned long long*)(H + (size_t)row * DM) + lane;
#pragma unroll
            for (int j = 0; j < 4; ++j) { v[j] = v[j] * rstd * mf[j] + af[j];
                o8[64 * j] = (unsigned long long)pk2(v[j].x, v[j].y) | ((unsigned long long)pk2(v[j].z, v[j].w) << 32); }
            if constexpr (ROUTE) {
                const float* wg = (const float*)A.in[I_WGRP]; const float* wr = (const float*)A.in[I_WRT];
                float lg[36];
#pragma unroll
                for (int o = 0; o < 36; ++o) lg[o] = 0.f;
#pragma unroll
                for (int j = 0; j < 4; ++j) *(LAS f32x4*)(hl + 4 * lane + 256 * j) = v[j];
                LDS_WAIT(); asm volatile("" ::: "memory");
#pragma unroll 1
                for (int ii = 0; ii < 16; ++ii) { const int k = lane + 64 * ii; const float hv = hl[k];
                    const f32x4 g4 = *(const f32x4*)(wg + k * 4);
                    lg[0] += hv * g4.x; lg[1] += hv * g4.y; lg[2] += hv * g4.z; lg[3] += hv * g4.w;
#pragma unroll
                    for (int q = 0; q < 8; ++q) { const f32x4 r4 = *(const f32x4*)(wr + k * 32 + q * 4);
                        lg[4 + q * 4 + 0] += hv * r4.x; lg[4 + q * 4 + 1] += hv * r4.y; lg[4 + q * 4 + 2] += hv * r4.z; lg[4 + q * 4 + 3] += hv * r4.w; } }
                LDS_WAIT(); asm volatile("" ::: "memory");
#pragma unroll
                for (int o = 0; o < 36; ++o) lg[o] = wave_sum(lg[o]);
                const float* bg = (const float*)A.in[I_BGRP]; const float* br = (const float*)A.in[I_BRT];
#pragma unroll
                for (int o = 0; o < 4; ++o) lg[o] += bg[o];
#pragma unroll
                for (int o = 0; o < 32; ++o) lg[4 + o] += br[o];
                int gi = 0; float gm = lg[0];
#pragma unroll
                for (int o = 1; o < 4; ++o) if (lg[o] > gm) { gm = lg[o]; gi = o; }
                float gs = 0.f;
#pragma unroll
                for (int o = 0; o < 4; ++o) gs += __expf(lg[o] - gm);
                const float pg = 1.f / gs;
                float le[8];
#pragma unroll
                for (int j = 0; j < 8; ++j) { le[j] = lg[4 + j];
#pragma unroll
                    for (int g = 1; g < 4; ++g) le[j] = (gi == g) ? lg[4 + g * 8 + j] : le[j]; }
                int j1 = 0; float m1 = le[0];
#pragma unroll
                for (int j = 1; j < 8; ++j) if (le[j] > m1) { m1 = le[j]; j1 = j; }
                int j2 = -1; float m2 = -3.0e38f;
#pragma unroll
                for (int j = 0; j < 8; ++j) if (j != j1 && le[j] > m2) { m2 = le[j]; j2 = j; }
                const float ex = __expf(m2 - m1), w1 = pg / (1.f + ex), w2 = pg * ex / (1.f + ex);
                if (lane == 0) {
                    const int e1 = gi * 8 + j1, e2 = gi * 8 + j2;
                    unsigned* ctl = (unsigned*)(ws + WS_CTL);
                    int2* erec = (int2*)(ws + WS_EREC); int* clist = (int*)(ws + WS_CLIST);
                    const unsigned p1 = atomicAdd(ctl + CW_ECNT + e1, 1u); erec[(size_t)e1 * TT + p1] = make_int2(row * 2 + (e1 > e2 ? 1 : 0), __builtin_bit_cast(int, w1));
                    const unsigned p2 = atomicAdd(ctl + CW_ECNT + e2, 1u); erec[(size_t)e2 * TT + p2] = make_int2(row * 2 + (e2 > e1 ? 1 : 0), __builtin_bit_cast(int, w2));
                    const int a = j1 < j2 ? j1 : j2, bb = j1 < j2 ? j2 : j1;
                    const int cls = gi * 28 + (a * 7 - (a * (a - 1)) / 2 + (bb - a - 1));
                    const unsigned pc = atomicAdd(ctl + CW_CCNT + cls, 1u); clist[(size_t)cls * TT + pc] = row;
                }
            }
        }
    }
}

typedef short bf16x8_t __attribute__((ext_vector_type(8)));
typedef float f32x16 __attribute__((ext_vector_type(16)));
typedef unsigned v2u __attribute__((ext_vector_type(2)));
typedef float f32x2_t __attribute__((ext_vector_type(2)));
typedef __bf16 bf16x2_t __attribute__((ext_vector_type(2)));
__device__ __forceinline__ unsigned cvtpk(float lo, float hi) { const f32x2_t f = {lo, hi}; return __builtin_bit_cast(unsigned, __builtin_convertvector(f, bf16x2_t)); }
__device__ __forceinline__ void fast_sincos(float ang, float& sn, float& cs) {
    float rev = ang * 0.15915494309189535f; rev -= floorf(rev);
    sn = __builtin_amdgcn_sinf(rev); cs = __builtin_amdgcn_cosf(rev);
}
__device__ __forceinline__ void swa_mfma(const Args& A, LAS unsigned char* lds, int tid, int lane, int wave, int blk, int nblk) {
    unsigned char* ws = A.ws;
    const bf16* proj = (const bf16*)(ws + WS_PROJ);
    bf16* mix = (bf16*)(ws + WS_MIX); const float* sinks = (const float*)A.in[I_SINKS];
    const int* pos = (const int*)A.in[I_POS]; const float* qn = (const float*)A.in[I_QNORM]; const float* kn = (const float*)A.in[I_KNORM];
    constexpr int KST = 144, VST = 520;
    LAS unsigned char* Kl = lds; LAS unsigned char* Vt = lds + 256 * KST;
    const int g = wave >> 1, qh = wave & 1, ql = lane & 31, hh = lane >> 5;
    constexpr float LOG2E = 1.4426950408889634f, CS = 0.125f * LOG2E, L2T = 13.287712379549449f / 32.f;
    const int sch = tid & 7;
    float kinv[8], kgn[8];
#pragma unroll
    for (int j = 0; j < 8; ++j) { kinv[j] = __builtin_amdgcn_exp2f(-(float)((sch & 3) * 8 + j) * L2T); kgn[j] = kn[sch * 8 + j]; }
    float qinv[2][8];
#pragma unroll
    for (int ks = 0; ks < 2; ++ks)
#pragma unroll
        for (int j = 0; j < 8; ++j) qinv[ks][j] = __builtin_amdgcn_exp2f(-(float)(ks * 16 + hh * 8 + j) * L2T);
    for (int u = blk; u < NB * 2 * (SEQ / 128); u += nblk) {
        const int n = u & 63, kvh = (u >> 6) & 1, b = u >> 7;
        const int tb = b * SEQ + n * 128;
        __syncthreads();
#pragma unroll
        for (int it = 0; it < 4; ++it) { const int idx = tid + it * NTHR, key = idx >> 3, ch = idx & 7; int tk = tb - 128 + key; if (tk < b * SEQ) tk = b * SEQ;
            const v4u kv = *(const v4u*)(proj + (size_t)tk * NPROJ + PC_SK + kvh * 64 + ch * 8);
            const v4u vv = *(const v4u*)(proj + (size_t)tk * NPROJ + PC_SV + kvh * 64 + ch * 8);
            const float pf = (float)pos[tk];
            float x[8] = { __builtin_bit_cast(float, kv.x << 16), __builtin_bit_cast(float, kv.x & 0xffff0000u), __builtin_bit_cast(float, kv.y << 16), __builtin_bit_cast(float, kv.y & 0xffff0000u),
                           __builtin_bit_cast(float, kv.z << 16), __builtin_bit_cast(float, kv.z & 0xffff0000u), __builtin_bit_cast(float, kv.w << 16), __builtin_bit_cast(float, kv.w & 0xffff0000u) };
            float ss = 0.f;
#pragma unroll
            for (int j = 0; j < 8; ++j) ss += x[j] * x[j];
            ss += __shfl_xor(ss, 1); ss += __shfl_xor(ss, 2); ss += __shfl_xor(ss, 4);
            const float rn = 1.f / sqrtf(ss * (1.f / 64.f) + EPS);
            float o[8];
#pragma unroll
            for (int j = 0; j < 8; ++j) { const float xn = x[j] * rn * kgn[j]; const float pr = __shfl_xor(xn, 4); float sn, cs; fast_sincos(pf * kinv[j], sn, cs);
                o[j] = (ch < 4) ? xn * cs - pr * sn : pr * sn + xn * cs; }
            v4u ko; ko.x = cvtpk(o[0], o[1]); ko.y = cvtpk(o[2], o[3]); ko.z = cvtpk(o[4], o[5]); ko.w = cvtpk(o[6], o[7]);
            *(LAS v4u*)(Kl + key * KST + ch * 16) = ko;
            LAS unsigned short* vp = (LAS unsigned short*)(Vt + (ch * 8) * VST + key * 2);
            vp[0 * (VST / 2)] = (unsigned short)(vv.x & 0xffffu); vp[1 * (VST / 2)] = (unsigned short)(vv.x >> 16);
            vp[2 * (VST / 2)] = (unsigned short)(vv.y & 0xffffu); vp[3 * (VST / 2)] = (unsigned short)(vv.y >> 16);
            vp[4 * (VST / 2)] = (unsigned short)(vv.z & 0xffffu); vp[5 * (VST / 2)] = (unsigned short)(vv.z >> 16);
            vp[6 * (VST / 2)] = (unsigned short)(vv.w & 0xffffu); vp[7 * (VST / 2)] = (unsigned short)(vv.w >> 16); }
        __syncthreads();
        const int hq = kvh * 4 + g; const float sinkl = sinks[hq] * LOG2E;
#pragma unroll 1
        for (int qt = 0; qt < 2; ++qt) {
            const int i0 = qh * 64 + qt * 32, iq = i0 + ql;
            const size_t tq = (size_t)(tb + iq);
            bf16x8_t qf[4];
            {   float xq[4][8]; float ss = 0.f;
#pragma unroll
                for (int ks = 0; ks < 4; ++ks) { const v4u r = *(const v4u*)(proj + tq * NPROJ + PC_SQ + hq * 64 + ks * 16 + hh * 8);
                    xq[ks][0] = __builtin_bit_cast(float, r.x << 16); xq[ks][1] = __builtin_bit_cast(float, r.x & 0xffff0000u); xq[ks][2] = __builtin_bit_cast(float, r.y << 16); xq[ks][3] = __builtin_bit_cast(float, r.y & 0xffff0000u);
                    xq[ks][4] = __builtin_bit_cast(float, r.z << 16); xq[ks][5] = __builtin_bit_cast(float, r.z & 0xffff0000u); xq[ks][6] = __builtin_bit_cast(float, r.w << 16); xq[ks][7] = __builtin_bit_cast(float, r.w & 0xffff0000u);
#pragma unroll
                    for (int j = 0; j < 8; ++j) ss += xq[ks][j] * xq[ks][j]; }
                ss += __shfl_xor(ss, 32);
                const float rn = 1.f / sqrtf(ss * (1.f / 64.f) + EPS); const float pf = (float)pos[tq];
#pragma unroll
                for (int ks = 0; ks < 4; ++ks)
#pragma unroll
                    for (int j = 0; j < 8; ++j) xq[ks][j] *= rn * qn[ks * 16 + hh * 8 + j];
#pragma unroll
                for (int ks = 0; ks < 2; ++ks)
#pragma unroll
                    for (int j = 0; j < 8; ++j) { float sn, cs; fast_sincos(pf * qinv[ks][j], sn, cs); const float x1 = xq[ks][j], x2 = xq[ks + 2][j];
                        xq[ks][j] = x1 * cs - x2 * sn; xq[ks + 2][j] = x1 * sn + x2 * cs; }
#pragma unroll
                for (int ks = 0; ks < 4; ++ks) { union { bf16x8_t v; unsigned u[4]; } p; p.u[0] = cvtpk(xq[ks][0], xq[ks][1]); p.u[1] = cvtpk(xq[ks][2], xq[ks][3]); p.u[2] = cvtpk(xq[ks][4], xq[ks][5]); p.u[3] = cvtpk(xq[ks][6], xq[ks][7]); qf[ks] = p.v; }
            }
            f32x16 sc[5];
#pragma unroll
            for (int kt = 0; kt < 5; ++kt) { f32x16 acc;
#pragma unroll
                for (int r = 0; r < 16; ++r) acc[r] = 0.f;
#pragma unroll
                for (int ks = 0; ks < 4; ++ks) { const bf16x8_t kf = *(const LAS bf16x8_t*)(Kl + (i0 + 32 * kt + ql) * KST + (ks * 16 + hh * 8) * 2);
                    acc = __builtin_amdgcn_mfma_f32_32x32x16_bf16(kf, qf[ks], acc, 0, 0, 0); }
                sc[kt] = acc; }
            float mloc = -3.0e38f;
#pragma unroll
            for (int kt = 0; kt < 5; ++kt) {
                if (kt == 0 || kt == 4 || n == 0) {
#pragma unroll
                    for (int r = 0; r < 16; ++r) { const int j = i0 + 32 * kt + (r & 3) + 8 * (r >> 2) + 4 * hh;
                        const bool valid = (j > iq) && (j <= iq + 128) && (n > 0 || j >= 128);
                        const float sv = valid ? sc[kt][r] * CS : -1.0e30f; sc[kt][r] = sv; mloc = fmaxf(mloc, sv); }
                } else {
#pragma unroll
                    for (int r = 0; r < 16; ++r) { const float sv = sc[kt][r] * CS; sc[kt][r] = sv; mloc = fmaxf(mloc, sv); }
                } }
            float mx = fmaxf(mloc, __shfl_xor(mloc, 32)); mx = fmaxf(mx, sinkl);
            float lsum = 0.f;
#pragma unroll
            for (int kt = 0; kt < 5; ++kt)
#pragma unroll
                for (int r = 0; r < 16; ++r) { const float p = __builtin_amdgcn_exp2f(sc[kt][r] - mx); sc[kt][r] = p; lsum += p; }
            lsum += __shfl_xor(lsum, 32); lsum += __builtin_amdgcn_exp2f(sinkl - mx);
            f32x16 o0, o1;
#pragma unroll
            for (int r = 0; r < 16; ++r) { o0[r] = 0.f; o1[r] = 0.f; }
#pragma unroll
            for (int kt = 0; kt < 5; ++kt)
#pragma unroll
                for (int s2 = 0; s2 < 2; ++s2) {
                    union { bf16x8_t v; unsigned u[4]; } pf;
#pragma unroll
                    for (int p = 0; p < 4; ++p) pf.u[p] = cvtpk(sc[kt][8 * s2 + 2 * p], sc[kt][8 * s2 + 2 * p + 1]);
                    const int jb = i0 + 32 * kt + 16 * s2 + 4 * hh;
                    union { bf16x8_t v; v2u u[2]; } v0, v1;
                    const LAS unsigned char* r0 = Vt + ql * VST + jb * 2; const LAS unsigned char* r1 = Vt + (32 + ql) * VST + jb * 2;
                    v0.u[0] = *(const LAS v2u*)(r0); v0.u[1] = *(const LAS v2u*)(r0 + 16);
                    v1.u[0] = *(const LAS v2u*)(r1); v1.u[1] = *(const LAS v2u*)(r1 + 16);
                    o0 = __builtin_amdgcn_mfma_f32_32x32x16_bf16(v0.v, pf.v, o0, 0, 0, 0);
                    o1 = __builtin_amdgcn_mfma_f32_32x32x16_bf16(v1.v, pf.v, o1, 0, 0, 0);
                }
            const float il = 1.f / lsum;
            bf16* op = mix + tq * DM + 512 + hq * 64 + 4 * hh;
#pragma unroll
            for (int rq = 0; rq < 4; ++rq) {
                v2u w0; w0.x = cvtpk(o0[4 * rq] * il, o0[4 * rq + 1] * il); w0.y = cvtpk(o0[4 * rq + 2] * il, o0[4 * rq + 3] * il);
                *(v2u*)(op + 8 * rq) = w0;
                v2u w1; w1.x = cvtpk(o1[4 * rq] * il, o1[4 * rq + 1] * il); w1.y = cvtpk(o1[4 * rq + 2] * il, o1[4 * rq + 3] * il);
                *(v2u*)(op + 32 + 8 * rq) = w1; }
        }
    }
}

__device__ __forceinline__ int frag_a_idx(int row, int col) { const int mt = row >> 4, l15 = row & 15, ks = col >> 5, x = col & 31, jh = x >> 4, g4 = (x >> 2) & 3, jl = x & 3; return ((mt * 2 + ks) * 64 + g4 * 16 + l15) * 8 + 4 * jh + jl; }
__device__ __forceinline__ int frag_c_idx(int row, int col) { const int w = col >> 4, l15 = col & 15, mt = row >> 4, y = row & 15, g4 = y >> 2, i = y & 3; return ((w * 64 + g4 * 16 + l15) * 4 + mt) * 4 + i; }
__device__ __forceinline__ void gdn_g1_naive(const Args& A, LAS float* L, int tid) {
    unsigned char* ws = A.ws;
    const bf16* proj = (const bf16*)(ws + WS_PROJ); const float* ab = (const float*)(ws + WS_AB);
    bf16* AP = (bf16*)(ws + WS_GAP); bf16* BP = (bf16*)(ws + WS_GBP); bf16* QP = (bf16*)(ws + WS_GQP); bf16* OP = (bf16*)(ws + WS_GOP); float* GL = (float*)(ws + WS_GGL);
    const float* convw = (const float*)A.in[I_CONVW];
    constexpr int LD = 65, AR = 64 * LD;
    LAS float* q = L; LAS float* k = q + AR; LAS float* v = k + AR; LAS float* Mm = v + AR; LAS float* At = Mm + AR; LAS float* w = At + AR;
    LAS float* Gc = w + AR; LAS float* beta = Gc + 64;
    const int i8 = tid >> 3, e0 = (tid & 7) * 8;
    for (int cid = blockIdx.x; cid < NB * 8 * 128; cid += gridDim.x) {
        const int n = cid & 127, bh = cid >> 7, b = bh >> 3, h = bh & 7;
        const float Ah = expf(((const float*)A.in[I_ALOG])[h]), dtb = ((const float*)A.in[I_DTB])[h];
        const int t0 = b * SEQ + n * 64;
        __syncthreads();
        for (int idx = tid; idx < 3 * 4096; idx += NTHR) {
            const int part = idx >> 12, rem = idx & 4095, i = rem >> 6, d = rem & 63, c = part * 512 + h * 64 + d;
            float y = 0.f;
#pragma unroll
            for (int j = 0; j < 4; ++j) { const int s = n * 64 + i - 3 + j; if (s >= 0) y += convw[j * 1536 + c] * bf2f(proj[(size_t)(b * SEQ + s) * NPROJ + c]); }
            y = y / (1.f + __expf(-y));
            (part == 0 ? q : (part == 1 ? k : v))[i * LD + d] = y;
        }
        if (tid < 64) { const float a = ab[(size_t)(t0 + tid) * 16 + h], bb = ab[(size_t)(t0 + tid) * 16 + 8 + h]; const float xx = a + dtb;
            const float sp = xx > 20.f ? xx : log1pf(expf(xx)); Gc[tid] = -Ah * sp; beta[tid] = 1.f / (1.f + __expf(-bb)); }
        __syncthreads();
        if (tid < 128) { LAS float* arr = tid < 64 ? q : k; const int i = tid & 63; float ss = 0.f;
            for (int d = 0; d < 64; ++d) ss += arr[i * LD + d] * arr[i * LD + d];
            const float r = (1.f / sqrtf(ss + EPS)) * (tid < 64 ? 0.125f : 1.f);
            for (int d = 0; d < 64; ++d) arr[i * LD + d] *= r; }
        if (tid == 128) { float run = 0.f; for (int i = 0; i < 64; ++i) { run += Gc[i]; Gc[i] = run; } }
        __syncthreads();
        {   const int i = i8;
            for (int jj = 0; jj < 8; ++jj) { const int j = e0 + jj; float dq = 0.f, dk = 0.f;
_Pragma("unroll 2") for (int d = 0; d < 64; ++d) { const float kj = k[j * LD + d]; dq += q[i * LD + d] * kj; dk += k[i * LD + d] * kj; }
                const float dec = (i >= j) ? __expf(Gc[i] - Gc[j]) : 0.f;
                At[i * LD + j] = dq * dec; Mm[i * LD + j] = (i > j) ? dk * beta[i] * dec : 0.f; }
        }
        __syncthreads();
        for (int idx = tid; idx < 4096; idx += NTHR) { const int i = idx >> 6, d = idx & 63; v[i * LD + d] *= beta[i]; w[i * LD + d] = k[i * LD + d] * beta[i] * __expf(Gc[i]); }
        __syncthreads();
        if (tid < 128) { LAS float* arr = tid < 64 ? v : w; const int c = tid & 63;
            _Pragma("unroll 1") for (int i = 1; i < 64; ++i) { float a = arr[i * LD + c]; _Pragma("unroll 4") for (int j = 0; j < i; ++j) a -= Mm[i * LD + j] * arr[j * LD + c]; arr[i * LD + c] = a; } }
        __syncthreads();
        const float gl = Gc[63];
        const size_t cb = (size_t)cid * 4096;
        {
            const int d = i8; float a[8], bq[8];
#pragma unroll
            for (int ee = 0; ee < 8; ++ee) { a[ee] = 0.f; bq[ee] = 0.f; }
_Pragma("unroll 2")
            for (int c = 0; c < 64; ++c) { const float kd = k[c * LD + d] * __expf(gl - Gc[c]);
#pragma unroll
                for (int ee = 0; ee < 8; ++ee) { a[ee] -= kd * w[c * LD + e0 + ee]; bq[ee] += kd * v[c * LD + e0 + ee]; } }
#pragma unroll
            for (int ee = 0; ee < 8; ++ee) { const int dp = e0 + ee; AP[cb + frag_a_idx(d, dp)] = (bf16)f2bf(a[ee]); BP[cb + frag_c_idx(d, dp)] = (bf16)f2bf(bq[ee]); }
        }
        {
            const int c = i8; float a[8], bq[8]; const float eg = __expf(Gc[c]);
#pragma unroll
            for (int ee = 0; ee < 8; ++ee) { a[ee] = eg * q[c * LD + e0 + ee]; bq[ee] = 0.f; }
_Pragma("unroll 2")
            for (int s2 = 0; s2 <= c; ++s2) { const float av = At[c * LD + s2];
#pragma unroll
                for (int ee = 0; ee < 8; ++ee) { a[ee] -= av * w[s2 * LD + e0 + ee]; bq[ee] += av * v[s2 * LD + e0 + ee]; } }
#pragma unroll
            for (int ee = 0; ee < 8; ++ee) { const int dp = e0 + ee; QP[cb + frag_a_idx(c, dp)] = (bf16)f2bf(a[ee]); OP[cb + frag_c_idx(c, dp)] = (bf16)f2bf(bq[ee]); }
        }
        if (tid == 0) GL[cid] = __expf(gl);
    }
}
__device__ __forceinline__ float wave_incl_scan_f(float v, int lane) {
#pragma unroll
    for (int o = 1; o < 64; o <<= 1) { const float t = __shfl_up(v, o); if (lane >= o) v += t; }
    return v;
}
__device__ __forceinline__ v2u pack4(f32x4 v) { v2u r; r.x = cvtpk(v.x, v.y); r.y = cvtpk(v.z, v.w); return r; }
__device__ __forceinline__ bf16x8_t mk8(v2u lo, v2u hi) { union { bf16x8_t v; unsigned u[4]; } x; x.u[0] = lo.x; x.u[1] = lo.y; x.u[2] = hi.x; x.u[3] = hi.y; return x.v; }
template <int SM, int STG = 7>
__device__ __forceinline__ void gdn_g1_mfma(const Args& A, LAS unsigned char* lds, int tid, int lane, int wave) {
    unsigned char* ws = A.ws;
    const bf16* proj = (const bf16*)(ws + WS_PROJ); const float* ab = (const float*)(ws + WS_AB);
    bf16* AP = (bf16*)(ws + WS_GAP); bf16* BP = (bf16*)(ws + WS_GBP); bf16* QP = (bf16*)(ws + WS_GQP); bf16* OP = (bf16*)(ws + WS_GOP); float* GL = (float*)(ws + WS_GGL);
    const float* convw = (const float*)A.in[I_CONVW];
    constexpr int KST = 144, RST = 68;
    LAS unsigned char* const Kr0 = lds;
    const int l15 = lane & 15, g4 = lane >> 4;
    const v2u zero2 = {0u, 0u};
    const int G = gridDim.x;
    const int ppart = wave >> 1, pt4 = 4 * ((wave & 1) * 8 + (lane >> 3)), pd0 = (lane & 7) * 8;
    v4u xr7[7];
#define G1_PREFETCH(IDX) do { if (wave < 6) { const int h_ = (IDX) & 7, bn_ = (IDX) >> 3, b_ = bn_ >> 7, n_ = bn_ & 127; \
        _Pragma("unroll") for (int r = 0; r < 7; ++r) { const int s_ = n_ * 64 + pt4 - 3 + r, sc_ = s_ < 0 ? 0 : s_; \
            const v4u r_ = *(const v4u*)(proj + (size_t)(b_ * SEQ + sc_) * NPROJ + ppart * 512 + h_ * 64 + pd0); const unsigned m_ = s_ < 0 ? 0u : 0xffffffffu; \
            xr7[r] = (v4u){r_.x & m_, r_.y & m_, r_.z & m_, r_.w & m_}; } } } while (0)
    int hcur = -1;
    constexpr int NC = NB * 8 * 128;
    if ((int)blockIdx.x < NC) G1_PREFETCH((int)blockIdx.x);
    for (int base = blockIdx.x; base < NC; base += 16 * G) {
    {
        LAS float* const GsT0 = (LAS float*)(Kr0 + 91648);
        __syncthreads();
        for (int q = wave; q < 16; q += 8) { const int idx2 = base + q * G;
            if (idx2 < NC) { const int h2 = idx2 & 7, bn2 = idx2 >> 3, b2 = bn2 >> 7, n2 = bn2 & 127;
                const size_t t2 = (size_t)(b2 * SEQ + n2 * 64 + lane) * 16;
                const float Ah = __expf(((const float*)A.in[I_ALOG])[h2]), dtb = ((const float*)A.in[I_DTB])[h2];
                const float xx = ab[t2 + h2] + dtb, bb2 = ab[t2 + 8 + h2];
                const float sp = xx > 20.f ? xx : log1pf(__expf(xx));
                const float Gv = wave_incl_scan_f(-Ah * sp, lane);
                GsT0[q * 64 + lane] = Gv; GsT0[1024 + q * 64 + lane] = 1.f / (1.f + __expf(-bb2));
                if ((SM & 16) && lane == 63) GL[(b2 * 8 + h2) * 128 + n2] = __expf(Gv); } }
    }
#pragma unroll 1
    for (int it = 0; it < 16; ++it) {
        const int idx = base + it * G; if (idx >= NC) break;
        const int h = idx & 7, bn = idx >> 3, b = bn >> 7, n = bn & 127, bh = b * 8 + h, cid = bh * 128 + n;
        const size_t cb = (size_t)cid * 4096;
        int oz = 0; asm volatile("" : "+v"(oz));
        LAS unsigned char* const Kr = Kr0 + oz; LAS unsigned char* const Qr = Kr + 9216; LAS unsigned char* const kdT = Kr + 18432; LAS unsigned char* const Mm = Kr + 27648; LAS unsigned char* const At = Kr + 36864;
        LAS float* const Rt = (LAS float*)(Kr + 46080);
        LAS float* const Md = (LAS float*)(Kr + 80896);
        LAS unsigned char* const Tl = Kr + 86016;
        LAS float* const Gs = (LAS float*)(Kr + 91648) + 64 * it; LAS float* const Bs = Gs + 1024;
        LAS float* const cwl = (LAS float*)(Kr + 88576);
        __syncthreads();
        if (h != hcur) { hcur = h; for (int q = tid; q < 768; q += NTHR) { const int part = q >> 8, j = (q >> 6) & 3, d = q & 63; cwl[q] = convw[j * 1536 + part * 512 + h * 64 + d]; } __syncthreads(); }
        const bool more = (idx + G < NC);
        if (wave < 6) {
            const int d0 = pd0, t4 = pt4, dg = d0 >> 3, swk = dg << 3, swr = (dg & 3) << 3;
            float y[4][8];
            {   float wv[4][8];
#pragma unroll
                for (int j = 0; j < 4; ++j) { const f32x4 w0 = *(const LAS f32x4*)(cwl + (ppart * 4 + j) * 64 + d0), w1 = *(const LAS f32x4*)(cwl + (ppart * 4 + j) * 64 + d0 + 4);
                    wv[j][0] = w0.x; wv[j][1] = w0.y; wv[j][2] = w0.z; wv[j][3] = w0.w; wv[j][4] = w1.x; wv[j][5] = w1.y; wv[j][6] = w1.z; wv[j][7] = w1.w; }
#define G1_XE(r, e) __builtin_bit_cast(float, ((e) & 1) ? (((e) >> 1) == 0 ? xr7[r].x : ((e) >> 1) == 1 ? xr7[r].y : ((e) >> 1) == 2 ? xr7[r].z : xr7[r].w) & 0xffff0000u \
                                                        : (((e) >> 1) == 0 ? xr7[r].x : ((e) >> 1) == 1 ? xr7[r].y : ((e) >> 1) == 2 ? xr7[r].z : xr7[r].w) << 16)
#pragma unroll
                for (int tk = 0; tk < 4; ++tk)
#pragma unroll
                    for (int e = 0; e < 8; ++e) { const float a_ = wv[0][e] * G1_XE(tk, e) + wv[1][e] * G1_XE(tk + 1, e) + wv[2][e] * G1_XE(tk + 2, e) + wv[3][e] * G1_XE(tk + 3, e);
                        y[tk][e] = a_ * __builtin_amdgcn_rcpf(1.f + __expf(-a_)); }
#undef G1_XE
            }
            if (more) G1_PREFETCH(idx + G);
            const f32x4 G4 = *(const LAS f32x4*)(Gs + t4), B4 = *(const LAS f32x4*)(Bs + t4); const float gl = Gs[63];
            if (ppart < 2) {
                float rn[4];
#pragma unroll
                for (int tk = 0; tk < 4; ++tk) { float ss = 0.f;
#pragma unroll
                    for (int e = 0; e < 8; ++e) ss += y[tk][e] * y[tk][e];
                    ss += __shfl_xor(ss, 1); ss += __shfl_xor(ss, 2); ss += __shfl_xor(ss, 4);
                    rn[tk] = (1.f / sqrtf(ss + EPS)) * (ppart == 0 ? 0.125f : 1.f); }
#pragma unroll
                for (int tk = 0; tk < 4; ++tk) {
#pragma unroll
                    for (int e = 0; e < 8; ++e) y[tk][e] *= rn[tk];
                    v4u pk; pk.x = cvtpk(y[tk][0], y[tk][1]); pk.y = cvtpk(y[tk][2], y[tk][3]); pk.z = cvtpk(y[tk][4], y[tk][5]); pk.w = cvtpk(y[tk][6], y[tk][7]);
                    *(LAS v4u*)((ppart == 0 ? Qr : Kr) + (t4 + tk) * KST + d0 * 2) = pk; }
                if (ppart == 1) {
                    const float ek0 = __expf(gl - G4.x), ek1 = __expf(gl - G4.y), ek2 = __expf(gl - G4.z), ek3 = __expf(gl - G4.w);
                    const float bg0 = B4.x * __expf(G4.x), bg1 = B4.y * __expf(G4.y), bg2 = B4.z * __expf(G4.z), bg3 = B4.w * __expf(G4.w);
#pragma unroll
                    for (int e = 0; e < 8; ++e) {
                        v2u kd; kd.x = cvtpk(y[0][e] * ek0, y[1][e] * ek1); kd.y = cvtpk(y[2][e] * ek2, y[3][e] * ek3);
                        *(LAS v2u*)(kdT + (d0 + e) * KST + (t4 ^ swk) * 2) = kd;
                        *(LAS f32x4*)(Rt + (d0 + e) * RST + (t4 ^ swr)) = (f32x4){y[0][e] * bg0, y[1][e] * bg1, y[2][e] * bg2, y[3][e] * bg3}; }
                }
            } else {
#pragma unroll
                for (int e = 0; e < 8; ++e) *(LAS f32x4*)(Rt + (64 + d0 + e) * RST + (t4 ^ swr)) = (f32x4){y[0][e] * B4.x, y[1][e] * B4.y, y[2][e] * B4.z, y[3][e] * B4.w};
            }
        }
        __syncthreads();
#define G1_TILE(which, ct, st) do { const LAS unsigned char* Xb_ = (which) ? Kr : Qr; const int c_ = 16 * (ct) + l15; const float Gc_ = Gs[c_], bc_ = Bs[c_]; \
            f32x4 acc_ = {0.f, 0.f, 0.f, 0.f}; \
            _Pragma("unroll") for (int ks = 0; ks < 2; ++ks) { const bf16x8_t bf_ = *(const LAS bf16x8_t*)(Xb_ + c_ * KST + (32 * ks + 8 * g4) * 2); \
                const bf16x8_t af_ = *(const LAS bf16x8_t*)(Kr + (16 * (st) + l15) * KST + (32 * ks + 8 * g4) * 2); acc_ = __builtin_amdgcn_mfma_f32_16x16x32_bf16(af_, bf_, acc_, 0, 0, 0); } \
            f32x4 vals_; \
            _Pragma("unroll") for (int r = 0; r < 4; ++r) { const int s2_ = 16 * (st) + 4 * g4 + r; const float dec_ = __expf(fminf(Gc_ - Gs[s2_], 0.f)); \
                vals_[r] = (which) ? ((s2_ < c_) ? -acc_[r] * bc_ * dec_ : 0.f) : ((s2_ <= c_) ? acc_[r] * dec_ : 0.f); } \
            *(LAS v2u*)(((which) ? Mm : At) + c_ * KST + (16 * (st) + 4 * g4) * 2) = pack4(vals_); \
            if ((which) && (st) == (ct)) *(LAS f32x4*)(Md + ((ct) * 16 + l15) * 20 + 4 * g4) = -vals_; } while (0)
        if constexpr (STG & 1) {
            const int ct = wave & 3, st0 = 2 * (wave >> 2);
            G1_TILE(1, ct, st0); G1_TILE(1, ct, st0 + 1);
        }
        __syncthreads();
        if constexpr (STG & 1) {
            if (wave != 0) { for (int tix = wave - 1; tix < 16; tix += 7) { const int ct = tix & 3, st = tix >> 2; G1_TILE(0, ct, st); } }
        }
        if ((STG & 2) && wave == 0) {
            float t[16];
#pragma unroll
            for (int r = 0; r < 16; ++r) { float acc = (r == l15) ? 1.f : 0.f;
#pragma unroll
                for (int s4 = 0; s4 < r; s4 += 4) { const f32x4 m = *(const LAS f32x4*)(Md + (g4 * 16 + r) * 20 + s4);
                    acc -= m.x * t[s4]; if (s4 + 1 < r) acc -= m.y * t[s4 + 1]; if (s4 + 2 < r) acc -= m.z * t[s4 + 2]; if (s4 + 3 < r) acc -= m.w * t[s4 + 3]; }
                t[r] = acc; }
#pragma unroll
            for (int r = 0; r < 16; ++r) *(LAS unsigned short*)(Tl + ((g4 * 16 + r) * 16 + l15) * 2) = (unsigned short)f2bf(t[r]);
        }
        __syncthreads();
        if constexpr (STG & 4) {
        f32x4 wt[4];
        {   const int colw = 16 * wave + l15;
#pragma unroll
            for (int i = 0; i < 4; ++i) {
                f32x4 acc = *(const LAS f32x4*)(Rt + colw * RST + ((16 * i + 4 * g4) ^ (((colw >> 3) & 3) << 3)));
                const LAS unsigned char* mrow = Mm + (16 * i + l15) * KST + (4 * g4) * 2;
                if (i >= 1) { const v2u alo = *(const LAS v2u*)(mrow), ahi = (i >= 2) ? *(const LAS v2u*)(mrow + 32) : zero2;
                    acc = __builtin_amdgcn_mfma_f32_16x16x32_bf16(mk8(alo, ahi), mk8(pack4(wt[0]), (i >= 2) ? pack4(wt[1]) : zero2), acc, 0, 0, 0); }
                if (i == 3) { const v2u alo = *(const LAS v2u*)(mrow + 64);
                    acc = __builtin_amdgcn_mfma_f32_16x16x32_bf16(mk8(alo, zero2), mk8(pack4(wt[2]), zero2), acc, 0, 0, 0); }
                const v2u tlo = *(const LAS v2u*)(Tl + ((i * 16 + l15) * 16 + 4 * g4) * 2);
                wt[i] = __builtin_amdgcn_mfma_f32_16x16x32_bf16(mk8(tlo, zero2), mk8(pack4(acc), zero2), (f32x4){0.f, 0.f, 0.f, 0.f}, 0, 0, 0);
            }
        }
        if (wave < 4) {
            bf16x8_t wn[2];
#pragma unroll
            for (int ks = 0; ks < 2; ++ks) { v2u lo = pack4(wt[2 * ks]), hi = pack4(wt[2 * ks + 1]); lo.x ^= 0x80008000u; lo.y ^= 0x80008000u; hi.x ^= 0x80008000u; hi.y ^= 0x80008000u; wn[ks] = mk8(lo, hi); }
#pragma unroll
            for (int nt = 0; nt < 4; ++nt) { const int x = 16 * nt + l15;
                f32x4 ca = {0.f, 0.f, 0.f, 0.f};
                const v2u qraw = *(const LAS v2u*)(Qr + x * KST + (16 * wave + 4 * g4) * 2); const float eg = __expf(Gs[x]);
                f32x4 cq; cq.x = eg * __builtin_bit_cast(float, qraw.x << 16); cq.y = eg * __builtin_bit_cast(float, qraw.x & 0xffff0000u); cq.z = eg * __builtin_bit_cast(float, qraw.y << 16); cq.w = eg * __builtin_bit_cast(float, qraw.y & 0xffff0000u);
#pragma unroll
                for (int ks = 0; ks < 2; ++ks) { const int xs = (x >> 3) << 3; const LAS unsigned char* kp0 = kdT + x * KST + ((32 * ks + 4 * g4) ^ xs) * 2; const LAS unsigned char* kp1 = kdT + x * KST + ((32 * ks + 16 + 4 * g4) ^ xs) * 2; const LAS unsigned char* ap = At + x * KST + (32 * ks + 4 * g4) * 2;
                    ca = __builtin_amdgcn_mfma_f32_16x16x32_bf16(wn[ks], mk8(*(const LAS v2u*)(kp0), *(const LAS v2u*)(kp1)), ca, 0, 0, 0);
                    cq = __builtin_amdgcn_mfma_f32_16x16x32_bf16(wn[ks], mk8(*(const LAS v2u*)(ap), *(const LAS v2u*)(ap + 32)), cq, 0, 0, 0); }
                const size_t off = cb + (size_t)((nt * 2 + (wave >> 1)) * 64 + lane) * 8 + 4 * (wave & 1);
                if (SM & 1) *(v2u*)(AP + off) = pack4(ca); if (SM & 2) *(v2u*)(QP + off) = pack4(cq);
            }
        } else {
            bf16x8_t ub[2];
#pragma unroll
            for (int ks = 0; ks < 2; ++ks) ub[ks] = mk8(pack4(wt[2 * ks]), pack4(wt[2 * ks + 1]));
            unsigned bo[8], oo[8];
#pragma unroll
            for (int mt = 0; mt < 4; ++mt) { const int x = 16 * mt + l15;
                f32x4 cbv = {0.f, 0.f, 0.f, 0.f}, co = {0.f, 0.f, 0.f, 0.f};
#pragma unroll
                for (int ks = 0; ks < 2; ++ks) { const int xs = (x >> 3) << 3; const LAS unsigned char* kp0 = kdT + x * KST + ((32 * ks + 4 * g4) ^ xs) * 2; const LAS unsigned char* kp1 = kdT + x * KST + ((32 * ks + 16 + 4 * g4) ^ xs) * 2; const LAS unsigned char* ap = At + x * KST + (32 * ks + 4 * g4) * 2;
                    cbv = __builtin_amdgcn_mfma_f32_16x16x32_bf16(mk8(*(const LAS v2u*)(kp0), *(const LAS v2u*)(kp1)), ub[ks], cbv, 0, 0, 0);
                    co = __builtin_amdgcn_mfma_f32_16x16x32_bf16(mk8(*(const LAS v2u*)(ap), *(const LAS v2u*)(ap + 32)), ub[ks], co, 0, 0, 0); }
                const v2u pb = pack4(cbv), po = pack4(co); bo[2 * mt] = pb.x; bo[2 * mt + 1] = pb.y; oo[2 * mt] = po.x; oo[2 * mt + 1] = po.y; }
            const size_t off = cb + (size_t)((wave - 4) * 64 + lane) * 16;
            if (SM & 4) { *(v4u*)(BP + off) = (v4u){bo[0], bo[1], bo[2], bo[3]}; *(v4u*)(BP + off + 8) = (v4u){bo[4], bo[5], bo[6], bo[7]}; }
            if (SM & 8) { *(v4u*)(OP + off) = (v4u){oo[0], oo[1], oo[2], oo[3]}; *(v4u*)(OP + off + 8) = (v4u){oo[4], oo[5], oo[6], oo[7]}; }
        }
        }
    }
    }
#undef G1_TILE
#undef G1_PREFETCH
}

__device__ __forceinline__ f32x4 g2_unpack(const v4u (&p)[2], int mt) {
    const unsigned d0 = mt == 0 ? p[0].x : mt == 1 ? p[0].z : mt == 2 ? p[1].x : p[1].z, d1 = mt == 0 ? p[0].y : mt == 1 ? p[0].w : mt == 2 ? p[1].y : p[1].w;
    f32x4 r; r.x = __builtin_bit_cast(float, d0 << 16); r.y = __builtin_bit_cast(float, d0 & 0xffff0000u); r.z = __builtin_bit_cast(float, d1 << 16); r.w = __builtin_bit_cast(float, d1 & 0xffff0000u); return r;
}
__device__ __forceinline__ void gdn_scan(const Args& A, int bh, LAS unsigned char* lds, int tid, int lane, int wave) {
    unsigned char* ws = A.ws;
    const char* AP = (const char*)(ws + WS_GAP); const char* BP = (const char*)(ws + WS_GBP); const float* GL = (const float*)(ws + WS_GGL); bf16* SF = (bf16*)(ws + WS_GSF);
    constexpr int SLOT = 16384, NSL = 8, EGL_OFF = NSL * SLOT;
    LAS float* eglt = (LAS float*)(lds + EGL_OFF);
    __syncthreads();
    { int tl = tid; asm volatile("" : "+v"(tl));
      if (tl < 128) eglt[tl] = GL[bh * 128 + tl]; }
    if (wave < 4) {
        f32x4 sC[4]; bf16x8_t sB[2];
#pragma unroll
        for (int mt = 0; mt < 4; ++mt) sC[mt] = (f32x4){0.f, 0.f, 0.f, 0.f};
#pragma unroll
        for (int ks = 0; ks < 2; ++ks)
#pragma unroll
            for (int j = 0; j < 8; ++j) sB[ks][j] = 0;
        asm volatile("s_waitcnt vmcnt(0) lgkmcnt(0)" ::: "memory");
        __builtin_amdgcn_s_barrier();
        struct SSet { bf16x8_t fa[4][2]; v4u fb[2]; float egl; };
#define SC_LOAD(S, n) do { const int n_ = (n) < SEQ / 64 ? (n) : SEQ / 64 - 1; const LAS unsigned char* slot_ = lds + (n_ & (NSL - 1)) * SLOT; \
            _Pragma("unroll") for (int mt = 0; mt < 4; ++mt) _Pragma("unroll") for (int ks = 0; ks < 2; ++ks) S.fa[mt][ks] = *(const LAS bf16x8_t*)(slot_ + ((mt * 2 + ks) * 64 + lane) * 16); \
            S.fb[0] = *(const LAS v4u*)(slot_ + 8192 + (wave * 64 + lane) * 32); S.fb[1] = *(const LAS v4u*)(slot_ + 8192 + (wave * 64 + lane) * 32 + 16); S.egl = eglt[n_]; } while (0)
#define SC_STEP(S, n) do { bf16* sf = SF + (size_t)(bh * 128 + (n)) * 4096 + (size_t)((wave * 2) * 64 + lane) * 8; \
            *(bf16x8_t*)(sf) = sB[0]; *(bf16x8_t*)(sf + 512) = sB[1]; \
            f32x4 sacc[4]; \
            _Pragma("unroll") for (int mt = 0; mt < 4; ++mt) sacc[mt] = sC[mt] * S.egl + g2_unpack(S.fb, mt); \
            _Pragma("unroll") for (int mt = 0; mt < 4; ++mt) _Pragma("unroll") for (int ks = 0; ks < 2; ++ks) sacc[mt] = __builtin_amdgcn_mfma_f32_16x16x32_bf16(S.fa[mt][ks], sB[ks], sacc[mt], 0, 0, 0); \
            _Pragma("unroll") for (int mt = 0; mt < 4; ++mt) sC[mt] = sacc[mt]; \
            _Pragma("unroll") for (int ks = 0; ks < 2; ++ks) { union { bf16x8_t v; unsigned u[4]; } pk_; \
                pk_.u[0] = cvtpk(sC[2 * ks].x, sC[2 * ks].y); pk_.u[1] = cvtpk(sC[2 * ks].z, sC[2 * ks].w); pk_.u[2] = cvtpk(sC[2 * ks + 1].x, sC[2 * ks + 1].y); pk_.u[3] = cvtpk(sC[2 * ks + 1].z, sC[2 * ks + 1].w); sB[ks] = pk_.v; } \
            asm volatile("s_waitcnt lgkmcnt(0)" ::: "memory"); \
            __builtin_amdgcn_s_barrier(); } while (0)
        SSet s0, s1;
        SC_LOAD(s0, 0);
#pragma unroll 1
        for (int n = 0; n < SEQ / 64; n += 2) {
            SC_LOAD(s1, n + 1);
            SC_STEP(s0, n);
            SC_LOAD(s0, n + 2);
            SC_STEP(s1, n + 1);
        }
#undef SC_LOAD
#undef SC_STEP
    } else {
        const int f = wave - 4;
        const unsigned lin = (unsigned)(2 * f) * 1024u + (unsigned)lane * 16u;
#define G2_DMA(nn) do { const int n_ = (nn) < SEQ / 64 ? (nn) : SEQ / 64 - 1; const size_t cb_ = (size_t)(bh * 128 + n_) * 8192; LAS unsigned char* d_ = lds + ((nn) & (NSL - 1)) * SLOT + (2 * f) * 1024; \
        __builtin_amdgcn_global_load_lds((const unsigned*)(AP + cb_ + lin), (LAS unsigned*)(d_), 16, 0, 0); __builtin_amdgcn_global_load_lds((const unsigned*)(AP + cb_ + lin + 1024), (LAS unsigned*)(d_ + 1024), 16, 0, 0); \
        __builtin_amdgcn_global_load_lds((const unsigned*)(BP + cb_ + lin), (LAS unsigned*)(d_ + 8192), 16, 0, 0); __builtin_amdgcn_global_load_lds((const unsigned*)(BP + cb_ + lin + 1024), (LAS unsigned*)(d_ + 8192 + 1024), 16, 0, 0); } while (0)
        asm volatile("s_waitcnt vmcnt(0) lgkmcnt(0)" ::: "memory");
        G2_DMA(0); G2_DMA(1); G2_DMA(2); G2_DMA(3); G2_DMA(4); G2_DMA(5); G2_DMA(6);
        asm volatile("s_waitcnt vmcnt(20)" ::: "memory");
        __builtin_amdgcn_s_barrier();
#pragma unroll 1
        for (int n = 0; n < SEQ / 64; ++n) {
            G2_DMA(n + 7);
            asm volatile("s_waitcnt vmcnt(20)" ::: "memory");
            __builtin_amdgcn_s_barrier();
        }
#undef G2_DMA
        asm volatile("s_waitcnt vmcnt(0)" ::: "memory");
    }
    __syncthreads();
}
__device__ __forceinline__ void gdn_out(const Args& A, LAS unsigned char* lds, int lane, int wave) {
    unsigned char* ws = A.ws;
    const bf16* proj = (const bf16*)(ws + WS_PROJ); bf16* mix = (bf16*)(ws + WS_MIX);
    const bf16* QP = (const bf16*)(ws + WS_GQP); const bf16* OP = (const bf16*)(ws + WS_GOP); const bf16* SF = (const bf16*)(ws + WS_GSF);
    const float* onorm = (const float*)A.in[I_GNORM];
    const int mt = wave & 3, l15 = lane & 15, g4 = lane >> 4, rr = lane >> 2, q4 = lane & 3;
    constexpr int OST = 68;
    LAS float* ot = (LAS float*)(lds + wave * 4608);
    float gain[16];
#pragma unroll
    for (int k = 0; k < 16; ++k) gain[k] = onorm[16 * q4 + k];
    struct OSet { bf16x8_t qa[2], sb[4][2]; v2u oi[4]; v4u z0, z1; };
#define GO_LOAD(S, CID) do { const int n_ = (CID) & 127, bh_ = (CID) >> 7, b_ = bh_ >> 3, h_ = bh_ & 7; const size_t cb_ = (size_t)(CID) * 4096; \
        const size_t t_ = (size_t)b_ * SEQ + n_ * 64 + 16 * mt + rr; \
        S.z0 = *(const v4u*)(proj + t_ * NPROJ + PC_Z + h_ * 64 + 16 * q4); S.z1 = *(const v4u*)(proj + t_ * NPROJ + PC_Z + h_ * 64 + 16 * q4 + 8); \
        _Pragma("unroll") for (int ks = 0; ks < 2; ++ks) S.qa[ks] = *(const bf16x8_t*)(QP + cb_ + ((mt * 2 + ks) * 64 + lane) * 8); \
        _Pragma("unroll") for (int nt = 0; nt < 4; ++nt) { _Pragma("unroll") for (int ks = 0; ks < 2; ++ks) S.sb[nt][ks] = *(const bf16x8_t*)(SF + cb_ + ((nt * 2 + ks) * 64 + lane) * 8); \
            S.oi[nt] = *(const v2u*)(OP + cb_ + ((nt * 64 + lane) * 4 + mt) * 4); } } while (0)
#define GO_STEP(S, CID) do { const int n_ = (CID) & 127, bh_ = (CID) >> 7, b_ = bh_ >> 3, h_ = bh_ & 7; const size_t t_ = (size_t)b_ * SEQ + n_ * 64 + 16 * mt + rr; \
        _Pragma("unroll") for (int nt = 0; nt < 4; ++nt) { \
            f32x4 acc; acc.x = __builtin_bit_cast(float, S.oi[nt].x << 16); acc.y = __builtin_bit_cast(float, S.oi[nt].x & 0xffff0000u); acc.z = __builtin_bit_cast(float, S.oi[nt].y << 16); acc.w = __builtin_bit_cast(float, S.oi[nt].y & 0xffff0000u); \
            _Pragma("unroll") for (int ks = 0; ks < 2; ++ks) acc = __builtin_amdgcn_mfma_f32_16x16x32_bf16(S.qa[ks], S.sb[nt][ks], acc, 0, 0, 0); \
            _Pragma("unroll") for (int i = 0; i < 4; ++i) ot[(4 * g4 + i) * OST + 16 * nt + l15] = acc[i]; } \
        LDS_WAIT(); asm volatile("" ::: "memory"); \
        float o[16]; float ss = 0.f; \
        _Pragma("unroll") for (int k = 0; k < 4; ++k) { const f32x4 v = *(const LAS f32x4*)(ot + rr * OST + 16 * q4 + 4 * k); o[4 * k] = v.x; o[4 * k + 1] = v.y; o[4 * k + 2] = v.z; o[4 * k + 3] = v.w; } \
        _Pragma("unroll") for (int k = 0; k < 16; ++k) ss += o[k] * o[k]; \
        ss += __shfl_xor(ss, 1); ss += __shfl_xor(ss, 2); \
        const float r = 1.f / sqrtf(ss * (1.f / 64.f) + EPS); \
        const unsigned zu[8] = {S.z0.x, S.z0.y, S.z0.z, S.z0.w, S.z1.x, S.z1.y, S.z1.z, S.z1.w}; \
        unsigned ou[8]; \
        _Pragma("unroll") for (int k = 0; k < 8; ++k) { const float za = __builtin_bit_cast(float, zu[k] << 16), zb = __builtin_bit_cast(float, zu[k] & 0xffff0000u); \
            ou[k] = cvtpk(o[2 * k] * r * gain[2 * k] * siluf(za), o[2 * k + 1] * r * gain[2 * k + 1] * siluf(zb)); } \
        bf16* op = mix + t_ * DM + h_ * 64 + 16 * q4; \
        *(v4u*)(op) = (v4u){ou[0], ou[1], ou[2], ou[3]}; *(v4u*)(op + 8) = (v4u){ou[4], ou[5], ou[6], ou[7]}; \
        LDS_WAIT(); asm volatile("" ::: "memory"); } while (0)
    const int NC = NB * 8 * 128, st = gridDim.x * 2;
    int cid = blockIdx.x * 2 + (wave >> 2);
    OSet s0, s1;
    if (cid < NC) GO_LOAD(s0, cid);
#pragma unroll 1
    for (; cid < NC; cid += 2 * st) {
        if (cid + st < NC) GO_LOAD(s1, cid + st);
        GO_STEP(s0, cid);
        if (cid + st < NC) { if (cid + 2 * st < NC) GO_LOAD(s0, cid + 2 * st); GO_STEP(s1, cid + st); }
    }
#undef GO_LOAD
#undef GO_STEP
}

template <bool DRY, int VAR = 0>
__device__ __forceinline__ void norm_route_mfma(const Args& A, const float* X, const float* ssqp, const float* gain, const float* shift, const float* scale, bf16* H, LAS unsigned char* lds, int tid, int lane, int wave) {
    unsigned char* ws = A.ws;
    const int G = gridDim.x;
    const int l15 = lane & 15, g4 = lane >> 4;
    LAS unsigned char* wfl = lds;
    LAS float* mfl = (LAS float*)(lds + 98304); LAS float* afl = mfl + 1024;
    LAS float* lgs = (LAS float*)(lds + 98304 + 8192 + wave * 3328);
    const float* bg = (const float*)A.in[I_BGRP]; const float* br = (const float*)A.in[I_BRT];
#define P7_LOADW(half) do { const v4u* src_ = (const v4u*)(ws + WS_WRT); \
        for (int q = tid; q < 3072; q += NTHR) { const int nt_ = q >> 10, r_ = q & 1023; const int g_ = (nt_ * 32 + 16 * (half)) * 64 + r_; \
            *(LAS v4u*)(wfl + q * 16) = src_[g_]; *(LAS v4u*)(wfl + 49152 + q * 16) = src_[6144 + g_]; } } while (0)
    int bcur = -1;
    for (int rb = blockIdx.x * 128; rb < TT; rb += G * 128) {
        const int b = rb / SEQ, r0 = rb + wave * 16, row = r0 + l15;
        if (b != bcur) { bcur = b; __syncthreads();
            for (int q = tid; q < 1024; q += NTHR) { mfl[q] = gain[q] * (scale[b * 6144 + q] + 1.0f); afl[q] = shift[b * 6144 + q]; }
            __syncthreads(); }
        const float* xr = X + (size_t)row * DM + 8 * g4;
        float ss;
        {   const f32x4 p4 = *(const f32x4*)(ssqp + (size_t)row * 16 + 4 * g4); ss = (p4.x + p4.y) + (p4.z + p4.w); }
        ss += __shfl_xor(ss, 16); ss += __shfl_xor(ss, 32);
        const float rstd = 1.f / sqrtf(ss * (1.f / DM) + EPS);
        f32x4 acc[3];
#pragma unroll
        for (int nt = 0; nt < 3; ++nt) acc[nt] = (f32x4){0.f, 0.f, 0.f, 0.f};
        bf16* hrow = H + (size_t)row * DM + 8 * g4;
#pragma unroll 1
        for (int half = 0; half < 2; ++half) {
        __syncthreads(); P7_LOADW(half); __syncthreads();
#pragma unroll 4
        for (int ks = 16 * half; ks < 16 * half + 16; ++ks) {
            float hv[8];
            {   const f32x4 a = *(const f32x4*)(xr + 32 * ks), c = *(const f32x4*)(xr + 32 * ks + 4);
                const f32x4 m0 = *(const LAS f32x4*)(mfl + 32 * ks + 8 * g4), m1 = *(const LAS f32x4*)(mfl + 32 * ks + 8 * g4 + 4), h0 = *(const LAS f32x4*)(afl + 32 * ks + 8 * g4), h1 = *(const LAS f32x4*)(afl + 32 * ks + 8 * g4 + 4);
                const f32x4 v0 = a * rstd * m0 + h0, v1 = c * rstd * m1 + h1;
                hv[0] = v0.x; hv[1] = v0.y; hv[2] = v0.z; hv[3] = v0.w; hv[4] = v1.x; hv[5] = v1.y; hv[6] = v1.z; hv[7] = v1.w; }
            unsigned hu[4], lu[4];
#pragma unroll
            for (int p = 0; p < 4; ++p) { hu[p] = cvtpk(hv[2 * p], hv[2 * p + 1]);
                const float ra = hv[2 * p] - __builtin_bit_cast(float, hu[p] << 16), rb2 = hv[2 * p + 1] - __builtin_bit_cast(float, hu[p] & 0xffff0000u); lu[p] = cvtpk(ra, rb2); }
            *(v4u*)(hrow + 32 * ks) = (v4u){hu[0], hu[1], hu[2], hu[3]};
            union { bf16x8_t v; unsigned u[4]; } ah, al; ah.u[0] = hu[0]; ah.u[1] = hu[1]; ah.u[2] = hu[2]; ah.u[3] = hu[3]; al.u[0] = lu[0]; al.u[1] = lu[1]; al.u[2] = lu[2]; al.u[3] = lu[3];
#pragma unroll
            for (int nt = 0; nt < 3; ++nt) { const int fo = ((nt * 16 + (ks & 15)) * 64 + lane) * 16;
                const bf16x8_t bh = *(const LAS bf16x8_t*)(wfl + fo), bl = *(const LAS bf16x8_t*)(wfl + 49152 + fo);
                acc[nt] = __builtin_amdgcn_mfma_f32_16x16x32_bf16(ah.v, bh, acc[nt], 0, 0, 0);
                acc[nt] = __builtin_amdgcn_mfma_f32_16x16x32_bf16(ah.v, bl, acc[nt], 0, 0, 0);
                acc[nt] = __builtin_amdgcn_mfma_f32_16x16x32_bf16(al.v, bh, acc[nt], 0, 0, 0); }
        }
        }
#pragma unroll
        for (int nt = 0; nt < 3; ++nt)
#pragma unroll
            for (int r = 0; r < 4; ++r) lgs[(4 * g4 + r) * 52 + 16 * nt + l15] = acc[nt][r];
        LDS_WAIT(); asm volatile("" ::: "memory");
        if (lane < 16) {
            float lg[36];
#pragma unroll
            for (int q = 0; q < 9; ++q) { const f32x4 v = *(const LAS f32x4*)(lgs + lane * 52 + 4 * q); lg[4 * q] = v.x; lg[4 * q + 1] = v.y; lg[4 * q + 2] = v.z; lg[4 * q + 3] = v.w; }
#pragma unroll
            for (int o = 0; o < 4; ++o) lg[o] += bg[o];
#pragma unroll
            for (int o = 0; o < 32; ++o) lg[4 + o] += br[o];
            int gi = 0; float gm = lg[0];
#pragma unroll
            for (int o = 1; o < 4; ++o) if (lg[o] > gm) { gm = lg[o]; gi = o; }
            float gs = 0.f;
#pragma unroll
            for (int o = 0; o < 4; ++o) gs += __expf(lg[o] - gm);
            const float pg = 1.f / gs;
            float le[8];
#pragma unroll
            for (int j = 0; j < 8; ++j) { le[j] = lg[4 + j];
#pragma unroll
                for (int g = 1; g < 4; ++g) le[j] = (gi == g) ? lg[4 + g * 8 + j] : le[j]; }
            int j1 = 0; float m1 = le[0];
#pragma unroll
            for (int j = 1; j < 8; ++j) if (le[j] > m1) { m1 = le[j]; j1 = j; }
            int j2 = -1; float m2 = -3.0e38f;
#pragma unroll
            for (int j = 0; j < 8; ++j) if (j != j1 && le[j] > m2) { m2 = le[j]; j2 = j; }
            const float ex = __expf(m2 - m1), w1 = pg / (1.f + ex), w2 = pg * ex / (1.f + ex);
            const int e1 = gi * 8 + j1, e2 = gi * 8 + j2, rw = r0 + lane;
            unsigned* ctl = (unsigned*)(ws + WS_CTL);
            int2* erec = (int2*)(ws + WS_EREC); int* clist = (int*)(ws + WS_CLIST);
            if constexpr (DRY) { ((int2*)(ws + WS_PROJ + 168 * MiB))[rw] = make_int2(e1 * 64 + e2, __builtin_bit_cast(int, w1 + w2)); } else {
            const unsigned p1 = atomicAdd(ctl + CW_ECNT + e1, 1u); erec[(size_t)e1 * TT + p1] = make_int2(rw * 2 + (e1 > e2 ? 1 : 0), __builtin_bit_cast(int, w1));
            const unsigned p2 = atomicAdd(ctl + CW_ECNT + e2, 1u); erec[(size_t)e2 * TT + p2] = make_int2(rw * 2 + (e2 > e1 ? 1 : 0), __builtin_bit_cast(int, w2));
            const int a = j1 < j2 ? j1 : j2, bb = j1 < j2 ? j2 : j1;
            const int cls = gi * 28 + (a * 7 - (a * (a - 1)) / 2 + (bb - a - 1));
            const unsigned pc = atomicAdd(ctl + CW_CCNT + cls, 1u); clist[(size_t)cls * TT + pc] = rw; }
        }
        LDS_WAIT(); asm volatile("" ::: "memory");
    }
#undef P7_LOADW
}

__device__ __forceinline__ int wave_incl_scan(int v, int lane) {
#pragma unroll
    for (int o = 1; o < 64; o <<= 1) { const int t = __shfl_up(v, o); if (lane >= o) v += t; }
    return v;
}
template <int NOPART = 0>
struct SchedET {
    int G, c, cntv, preF, preP, totF, totP; const int2* rec; const char* W;
    __device__ __forceinline__ void init(const unsigned* cnt, const int2* rec_, const char* W_, int G_, int c_, int lane) {
        G = G_; c = c_; rec = rec_; W = W_;
        cntv = lane < NE ? (int)cnt[lane] : 0;
        const int incF = wave_incl_scan(cntv >> 8, lane), incP = wave_incl_scan((cntv & 255) ? 1 : 0, lane);
        totF = __builtin_amdgcn_readlane(incF, 63); totP = NOPART ? 0 : __builtin_amdgcn_readlane(incP, 63);
        preF = lane < NE ? incF : 0x7fffffff; preP = lane < NE ? incP : 0x7fffffff;
    }
    __device__ __forceinline__ bool next(int i, pg8::UnitG& u) const {
        const int L = i * G + c; if (L >= 2 * (totF + totP)) return false;
        if (L < 2 * totF) { const int ft = L >> 1;
            const int e = __builtin_amdgcn_readfirstlane(__popcll(__ballot(preF <= ft)));
            const int base = e ? __builtin_amdgcn_readlane(preF, e - 1) : 0;
            u.id = e; u.tile = ft - base; u.pn = L & 1; u.nrows = 256;
        } else { const int p = (L - 2 * totF) >> 1;
            const int e = __builtin_amdgcn_readfirstlane(__popcll(__ballot(preP <= p)));
            const int cnt = __builtin_amdgcn_readlane(cntv, e);
            u.id = e; u.tile = cnt >> 8; u.pn = L & 1; u.nrows = cnt & 255; }
        return true;
    }
    __device__ __forceinline__ int tok(const pg8::UnitG& u, int r) const { return r < u.nrows ? (rec[(size_t)u.id * TT + u.tile * 256 + r].x >> 1) : 0; }
    __device__ __forceinline__ const char* bseg(const pg8::UnitG& u, int) const { return W + ((size_t)u.id * 512 + u.pn * 256) * 2048; }
};
typedef SchedET<0> SchedE;
struct EpiGU {
    static constexpr bool PERM = true, PREFETCH = false;
    bf16* HID;
    template <class SC> __device__ __forceinline__ void operator()(const pg8::f32x4 (&acc)[2][2][4][2], const pg8::UnitG& u, const SC& S, int wr, int wc, int fr, int fq) const {
#pragma unroll
        for (int ai = 0; ai < 2; ++ai)
#pragma unroll
            for (int m = 0; m < 4; ++m) { const int r = ai * 128 + wr * 64 + m * 16 + fr;
                if (r < u.nrows) { const int2 rc = S.rec[(size_t)u.id * TT + u.tile * 256 + r]; const int t = rc.x >> 1, half = rc.x & 1; const float w = __builtin_bit_cast(float, rc.y);
                    float hv[8];
#pragma unroll
                    for (int n = 0; n < 2; ++n)
#pragma unroll
                        for (int j = 0; j < 4; ++j) { const float g = acc[ai][0][m][n][j], up = acc[ai][1][m][n][j]; hv[n * 4 + j] = w * siluf(g) * up; }
                    v4u o; o.x = pk2(hv[0], hv[1]); o.y = pk2(hv[2], hv[3]); o.z = pk2(hv[4], hv[5]); o.w = pk2(hv[6], hv[7]);
                    *(v4u*)(HID + (size_t)t * 512 + half * 256 + u.pn * 128 + wc * 32 + 8 * fq) = o; } }
    }
};
struct SchedC {
    int G, c, cntA, cntB, preA, preB, total_rt; const int* clist; const char* W;
    __device__ __forceinline__ void init(const unsigned* cnt, const int* clist_, const char* W_, int G_, int c_, int lane) {
        G = G_; c = c_; clist = clist_; W = W_;
        cntA = (int)cnt[lane]; cntB = lane < NCLS - 64 ? (int)cnt[64 + lane] : 0;
        const int ia = wave_incl_scan((cntA + 255) >> 8, lane); const int ta = __builtin_amdgcn_readlane(ia, 63);
        const int ib = wave_incl_scan((cntB + 255) >> 8, lane) + ta;
        total_rt = __builtin_amdgcn_readlane(ib, 63);
        preA = ia; preB = lane < NCLS - 64 ? ib : 0x7fffffff;
    }
    __device__ __forceinline__ bool next(int i, pg8::UnitG& u) const {
        const int L = i * G + c; if (L >= 4 * total_rt) return false;
        const int rt = L >> 2;
        const int cls = __builtin_amdgcn_readfirstlane(__popcll(__ballot(preA <= rt)) + __popcll(__ballot(preB <= rt)));
        int base = 0; if (cls > 0) base = (cls - 1 < 64) ? __builtin_amdgcn_readlane(preA, cls - 1) : __builtin_amdgcn_readlane(preB, cls - 65);
        const int cnt = cls < 64 ? __builtin_amdgcn_readlane(cntA, cls) : __builtin_amdgcn_readlane(cntB, cls - 64);
        u.id = cls; u.tile = rt - base; u.pn = L & 3; const int rem = cnt - u.tile * 256; u.nrows = rem < 256 ? rem : 256;
        return true;
    }
    __device__ __forceinline__ int tok(const pg8::UnitG& u, int r) const { return r < u.nrows ? clist[(size_t)u.id * TT + u.tile * 256 + r] : 0; }
    __device__ __forceinline__ const char* bseg(const pg8::UnitG& u, int seg) const {
        const int g = u.id / 28; int a = 0, rem = u.id % 28; while (rem >= 7 - a) { rem -= 7 - a; ++a; } const int b = a + 1 + rem;
        const int e = g * 8 + (seg ? b : a);
        return W + ((size_t)e * 1024 + u.pn * 256) * 512;
    }
};
template <int VAR = 0>
struct EpiDownT {
    static constexpr bool PERM = false, PREFETCH = false;
    float* OUT; const float* gate2;
    template <class SC> __device__ __forceinline__ void prefetch(LAS unsigned char* lds, const pg8::UnitG& u, const SC& S, int tid) const {
#pragma unroll
        for (int i = 0; i < 4; ++i) { const int r = (tid >> 3) + 64 * i; const int t = S.tok(u, r);
            __builtin_amdgcn_global_load_lds((const unsigned*)((const char*)OUT + (size_t)t * 4096 + (size_t)u.pn * 1024 + (size_t)(tid & 7) * 128), (LAS unsigned*)(lds + pg8::STAGE_BYTES + 256), 4, 0, 0); }
    }
    template <class SC> __device__ __forceinline__ void operator()(const pg8::f32x4 (&acc)[2][2][4][2], const pg8::UnitG& u, const SC& S, int wr, int wc, int fr, int fq) const {
#pragma unroll
        for (int ai = 0; ai < 2; ++ai)
#pragma unroll
            for (int m = 0; m < 4; ++m) { const int r = ai * 128 + wr * 64 + m * 16 + fr;
                if (r < u.nrows) { const int t = S.clist[(size_t)u.id * TT + u.tile * 256 + r]; const int b = t / SEQ; const int col0 = u.pn * 256 + wc * 32 + 4 * fq;
                    float* op = OUT + (size_t)t * DM + col0; const float* gp = gate2 + b * 6144 + col0;
#pragma unroll
                    for (int bj = 0; bj < 2; ++bj)
#pragma unroll
                        for (int n = 0; n < 2; ++n) { const int off = bj * 128 + n * 16; const f32x4 xv = (VAR == 1) ? (f32x4){1.f, 1.f, 1.f, 1.f} : *(const f32x4*)(op + off), gv = (VAR == 2) ? (f32x4){1.f, 1.f, 1.f, 1.f} : *(const f32x4*)(gp + off);
                            *(f32x4*)(op + off) = xv + gv * acc[ai][bj][m][n]; } } }
    }
};
typedef EpiDownT<0> EpiDown;

__global__ void __launch_bounds__(NTHR, 2) fwd_kernel(Args args) {
    extern __shared__ __attribute__((aligned(16))) unsigned char lds_raw[];
    LAS unsigned char* lds = (LAS unsigned char*)lds_raw;
    volatile LAS unsigned* MISC = (volatile LAS unsigned*)(lds + MISC_OFF);
    const int G = gridDim.x;
    unsigned char* ws = args.ws;
    const int wave_s = __builtin_amdgcn_readfirstlane(threadIdx.x >> 6);
    for (int u = threadIdx.x; u < (LDS_BYTES - LDSCTL_OFF) / 4; u += NTHR) ((LAS unsigned*)(lds + LDSCTL_OFF))[u] = 0u;
    __syncthreads();
    const int lo = args.ph_lo, hi = args.ph_hi;
    const bool use_bar = (hi - lo) > 1;
    XcdBarrier bar; bar.bar = (unsigned*)(ws + WS_CTL) + CW_BAR; bar.x = 0; bar.st = nullptr;
    if (use_bar) bar = xcd_barrier_post((unsigned*)(ws + WS_CTL) + CW_BAR, MISC + 8, threadIdx.x == 0);
#define IN(k) (lo <= (k) && (k) < hi)
#define BOTH(k) (IN(k) && IN((k) + 1))
#define GRID_BAR(k) do { if (BOTH(k)) xcd_barrier(bar, wave_s == 0 && __builtin_amdgcn_mbcnt_hi(~0u, __builtin_amdgcn_mbcnt_lo(~0u, 0u)) == 0u); } while (0)
#define FRESH_IDS() const int wave = wave_s; int lane = (int)__builtin_amdgcn_mbcnt_hi(~0u, __builtin_amdgcn_mbcnt_lo(~0u, 0u)); asm volatile("" : "+v"(lane)); const int tid = wave * 64 + lane; (void)tid
    const float* mod = (const float*)(ws + WS_MOD);

    if (IN(0)) { FRESH_IDS(); p0_prologue(args, lds, tid, lane, wave); GRID_BAR(0); }
    if (IN(1)) { FRESH_IDS(); norm_rows<false>(args, (const float*)args.in[I_X], (const float*)args.in[I_NORM_MIX], mod + 0, mod + 1024, (bf16*)(ws + WS_H), lds, lane, wave); GRID_BAR(1); }
    if (IN(2)) { FRESH_IDS();
        pg8::Gemm g{(const pg8::bf16_t*)(ws + WS_H), (const pg8::bf16_t*)(ws + WS_WINT), TT, NPAD, DM}; pg8::StaticOrder S; S.init(TT, NPAD, G, (int)blockIdx.x);
        pg8::EpiProj E{(pg8::bf16_t*)(ws + WS_PROJ), (float*)(ws + WS_AB), NPROJ};
        pg8::gemm_phase<pg8::EpiProj, pg8::StaticOrder, true, true>(lds, g, S, E);
        GRID_BAR(2);
    }
    if (IN(3)) { FRESH_IDS(); gdn_g1_mfma<31>(args, lds, tid, lane, wave); GRID_BAR(3); }
    if (IN(4)) { FRESH_IDS();
        if ((int)blockIdx.x < 32) gdn_scan(args, (int)blockIdx.x, lds, tid, lane, wave);
        else swa_mfma(args, lds, tid, lane, wave, (int)blockIdx.x - 32, G - 32);
        GRID_BAR(4);
    }
    if (IN(5)) { FRESH_IDS(); gdn_out(args, lds, lane, wave); GRID_BAR(5); }
    if (IN(6)) { FRESH_IDS();
        pg8::Gemm g{(const pg8::bf16_t*)(ws + WS_MIX), (const pg8::bf16_t*)(ws + WS_WOUTT), TT, DM, DM}; pg8::StaticOrder S; S.init(TT, DM, G, (int)blockIdx.x);
        pg8::EpiOut E{(const float*)args.in[I_X], args.out, mod + 2048, SEQ, 6144, (float*)(ws + WS_SSQ)};
        pg8::gemm_phase<pg8::EpiOut, pg8::StaticOrder, true, true>(lds, g, S, E);
        GRID_BAR(6);
    }
    if (IN(7)) { FRESH_IDS(); norm_route_mfma<false>(args, args.out, (const float*)(ws + WS_SSQ), (const float*)args.in[I_NORM_FFN], mod + 3072, mod + 4096, (bf16*)(ws + WS_H), lds, tid, lane, wave); GRID_BAR(7); }
    if (IN(8)) { FRESH_IDS();
        SchedE S; S.init((const unsigned*)(ws + WS_CTL) + CW_ECNT, (const int2*)(ws + WS_EREC), (const char*)(ws + WS_WGUT), G, (int)blockIdx.x, lane);
        EpiGU E{(bf16*)(ws + WS_HID)};
        pg8::gemm_phase_g<EpiGU, SchedE>(lds, (const pg8::bf16_t*)(ws + WS_H), 1024, 1024, 16, 16, S, E);
        GRID_BAR(8);
    }
    if (IN(9)) { FRESH_IDS();
        SchedC S; S.init((const unsigned*)(ws + WS_CTL) + CW_CCNT, (const int*)(ws + WS_CLIST), (const char*)(ws + WS_WDT), G, (int)blockIdx.x, lane);
        EpiDown E{args.out, mod + 5120};
        pg8::gemm_phase_g<EpiDown, SchedC>(lds, (const pg8::bf16_t*)(ws + WS_HID), 512, 256, 8, 4, S, E);
    }
#if PROBE_REP == 1000
    if (use_bar) { for (int q = 0; q < 8; ++q) xcd_barrier(bar, wave_s == 0 && __builtin_amdgcn_mbcnt_hi(~0u, __builtin_amdgcn_mbcnt_lo(~0u, 0u)) == 0u); }
#endif
#undef IN
#undef BOTH
#undef GRID_BAR
}

#if PROBE_REP >= 0 && PROBE_REP < 1000
template <int P>
__global__ void __launch_bounds__(NTHR, 2) probe_kernel(Args args) {
    extern __shared__ __attribute__((aligned(16))) unsigned char lds_raw[];
    LAS unsigned char* lds = (LAS unsigned char*)lds_raw;
    const int tid = threadIdx.x, lane = tid & 63, wave = __builtin_amdgcn_readfirstlane(tid >> 6);
    const int G = gridDim.x; unsigned char* ws = args.ws; const float* mod = (const float*)(ws + WS_MOD);
    if constexpr (P == 1) norm_rows<false>(args, (const float*)args.in[I_X], (const float*)args.in[I_NORM_MIX], mod + 0, mod + 1024, (bf16*)(ws + WS_GAP + 0)  , lds, lane, wave);
    if constexpr (P == 2) { pg8::Gemm g{(const pg8::bf16_t*)(ws + WS_H), (const pg8::bf16_t*)(ws + WS_WINT), TT, NPAD, DM}; pg8::StaticOrder S; S.init(TT, NPAD, G, (int)blockIdx.x);
        pg8::EpiProj E{(pg8::bf16_t*)(ws + WS_PROJ), (float*)(ws + WS_AB), NPROJ}; pg8::gemm_phase<pg8::EpiProj, pg8::StaticOrder, true, true>(lds, g, S, E); }
    if constexpr (P == 0) p0_prologue(args, lds, tid, lane, wave);
    if constexpr (P == 4) gdn_g1_mfma<31>(args, lds, tid, lane, wave);
    if constexpr (P == 40) gdn_g1_mfma<31, 0>(args, lds, tid, lane, wave);
    if constexpr (P == 41) gdn_g1_mfma<31, 1>(args, lds, tid, lane, wave);
    if constexpr (P == 42) gdn_g1_mfma<31, 3>(args, lds, tid, lane, wave);
    if constexpr (P == 43) gdn_g1_mfma<0, 7>(args, lds, tid, lane, wave);
    if constexpr (P == 50) { if ((int)blockIdx.x < 32) gdn_scan(args, (int)blockIdx.x, lds, tid, lane, wave); }
    if constexpr (P == 52) gdn_out(args, lds, lane, wave);
    if constexpr (P == 51) { if ((int)blockIdx.x >= 32) swa_mfma(args, lds, tid, lane, wave, (int)blockIdx.x - 32, G - 32); }
    if constexpr (P == 6) { pg8::Gemm g{(const pg8::bf16_t*)(ws + WS_MIX), (const pg8::bf16_t*)(ws + WS_WOUTT), TT, DM, DM}; pg8::StaticOrder S; S.init(TT, DM, G, (int)blockIdx.x);
        pg8::EpiOut E{(const float*)args.in[I_X], (float*)(ws + WS_GSF)  , mod + 2048, SEQ, 6144, nullptr}; pg8::gemm_phase<pg8::EpiOut, pg8::StaticOrder, true, true>(lds, g, S, E); }
    if constexpr (P == 81) { SchedET<1> S; S.init((const unsigned*)(ws + WS_CTL) + CW_ECNT, (const int2*)(ws + WS_EREC), (const char*)(ws + WS_WGUT), G, (int)blockIdx.x, lane);
        EpiGU E{(bf16*)(ws + WS_HID)}; pg8::gemm_phase_g<EpiGU, SchedET<1>>(lds, (const pg8::bf16_t*)(ws + WS_H), 1024, 1024, 16, 16, S, E); }
    if constexpr (P == 8) { SchedE S; S.init((const unsigned*)(ws + WS_CTL) + CW_ECNT, (const int2*)(ws + WS_EREC), (const char*)(ws + WS_WGUT), G, (int)blockIdx.x, lane);
        EpiGU E{(bf16*)(ws + WS_HID)}; pg8::gemm_phase_g<EpiGU, SchedE>(lds, (const pg8::bf16_t*)(ws + WS_H), 1024, 1024, 16, 16, S, E); }
    if constexpr (P == 71) norm_route_mfma<true, 1>(args, args.out, (const float*)(ws + WS_SSQ), (const float*)args.in[I_NORM_FFN], mod + 3072, mod + 4096, (bf16*)(ws + WS_PROJ + 32 * MiB), lds, tid, lane, wave);
    if constexpr (P == 7) norm_route_mfma<true>(args, args.out, (const float*)(ws + WS_SSQ), (const float*)args.in[I_NORM_FFN], mod + 3072, mod + 4096, (bf16*)(ws + WS_PROJ + 32 * MiB), lds, tid, lane, wave);
    if constexpr (P == 91 || P == 92) { SchedC S; S.init((const unsigned*)(ws + WS_CTL) + CW_CCNT, (const int*)(ws + WS_CLIST), (const char*)(ws + WS_WDT), G, (int)blockIdx.x, lane);
        EpiDownT<P - 90> E{(float*)(ws + WS_PROJ + 32 * MiB), mod + 5120}; pg8::gemm_phase_g<EpiDownT<P - 90>, SchedC>(lds, (const pg8::bf16_t*)(ws + WS_HID), 512, 256, 8, 4, S, E); }
    if constexpr (P == 9) { SchedC S; S.init((const unsigned*)(ws + WS_CTL) + CW_CCNT, (const int*)(ws + WS_CLIST), (const char*)(ws + WS_WDT), G, (int)blockIdx.x, lane);
        EpiDown E{(float*)(ws + WS_PROJ + 32 * MiB), mod + 5120}; pg8::gemm_phase_g<EpiDown, SchedC>(lds, (const pg8::bf16_t*)(ws + WS_HID), 512, 256, 8, 4, S, E); }
}
#endif
extern "C" void kernel_launch(void* const* d_in, const int* in_sizes, int n_in, void* d_out, int out_size, void* d_ws, size_t ws_size, hipStream_t stream) {
    static int grid = 0;
    if (grid == 0) {
        if (n_in != 23 || in_sizes[0] != TT * DM || out_size != TT * DM || ws_size < WS_END) { fprintf(stderr, "kernel_launch: unexpected shapes: n_in %d in0 %d out %d ws %zu (need %zu)\n", n_in, n_in > 0 ? in_sizes[0] : -1, out_size, ws_size, (size_t)WS_END); grid = -1; return; }
        int dev = 0, cus = 0, per_cu = 0;
        if (hipGetDevice(&dev) != hipSuccess || hipDeviceGetAttribute(&cus, hipDeviceAttributeMultiprocessorCount, dev) != hipSuccess) { grid = -1; return; }
        if (hipFuncSetAttribute((const void*)fwd_kernel, hipFuncAttributeMaxDynamicSharedMemorySize, LDS_BYTES) != hipSuccess) { fprintf(stderr, "kernel_launch: hipFuncSetAttribute failed\n"); grid = -1; return; }
        if (hipOccupancyMaxActiveBlocksPerMultiprocessor(&per_cu, (const void*)fwd_kernel, NTHR, LDS_BYTES) != hipSuccess || per_cu < 1) fprintf(stderr, "kernel_launch: occupancy query reports %d\n", per_cu);
        (void)hipGetLastError();
        grid = cus;
    }
    if (grid < 0) return;
    if (hipMemsetAsync((char*)d_ws + WS_CTL, 0, CTL_ZERO_BYTES, stream) != hipSuccess) { fprintf(stderr, "kernel_launch: memset failed\n"); return; }
    Args a{};
    for (int i = 0; i < 23; ++i) a.in[i] = d_in[i];
    a.out = (float*)d_out; a.ws = (unsigned char*)d_ws;
#if MK_ONE_LAUNCH
    a.ph_lo = 0; a.ph_hi = N_PHASES;
    hipLaunchKernelGGL(fwd_kernel, dim3(grid), dim3(NTHR), LDS_BYTES, stream, a);
#if PROBE_REP >= 0 && PROBE_REP < 1000
    hipFuncSetAttribute((const void*)probe_kernel<PROBE_REP>, hipFuncAttributeMaxDynamicSharedMemorySize, LDS_BYTES);
    hipLaunchKernelGGL(probe_kernel<PROBE_REP>, dim3(grid), dim3(NTHR), LDS_BYTES, stream, a);
#endif
#else
    for (int p = 0; p < N_PHASES; ++p) { a.ph_lo = p; a.ph_hi = p + 1; hipLaunchKernelGGL(fwd_kernel, dim3(grid), dim3(NTHR), LDS_BYTES, stream, a); }
#endif
}
```

```cpp
#include <hip/hip_runtime.h>
#include <cstdio>
#include <cstdint>
namespace pg8 {
#define PG8_LAS __attribute__((address_space(3)))
typedef unsigned short bf16_t;
typedef short bf16x8 __attribute__((ext_vector_type(8)));
typedef float f32x4 __attribute__((ext_vector_type(4)));
typedef unsigned u32x4 __attribute__((ext_vector_type(4)));
constexpr int BM = 256, BK = 64, HALF = 128, HTB = HALF * BK * 2  , STAGE_BYTES = 8 * HTB, NXCD = 8, WGM = 8;

__host__ __device__ __forceinline__ int lds_byte(int r, int c) { const int st = (r >> 4) * 2 + (c >> 5), rr = r & 15, cc = c & 31, ob = rr * 64 + cc * 2; return st * 1024 + (ob ^ (((ob >> 9) & 1) << 5)); }
__host__ __device__ __forceinline__ void stage_rc(int b, int& R, int& C) { const int st = b / 1024, sb = b % 1024, swz = sb ^ (((sb >> 9) & 1) << 5); R = (st >> 1) * 16 + swz / 64; C = (st & 1) * 32 + (swz % 64) / 2; }
__host__ __device__ __forceinline__ int perm32(int rho) { const int n = rho >> 4, i = rho & 15; return 8 * (i >> 2) + 4 * n + (i & 3); }

struct Unit { int pm, pn; };
struct Gemm { const bf16_t* A; const bf16_t* Bt; int M, N, K; };

struct StaticOrder {
    int nM, nN, nwg, G, c;
    __host__ __device__ void init(int M, int N, int G_, int c_) { nM = M / BM; nN = N / BM; nwg = nM * nN; G = G_; c = c_; }
    __host__ __device__ bool next(int i, Unit& u) const {
        const long L = (long)i * G + c; if (L >= nwg) return false;
        int wgid = (int)L; { const int q = nwg / NXCD, r = nwg % NXCD, xcd = wgid % NXCD, off = wgid / NXCD; wgid = (xcd < r ? xcd * (q + 1) : r * (q + 1) + (xcd - r) * q) + off; }
        const int nig = WGM * nN, gid = wgid / nig, fm = gid * WGM, gsz = (nM - fm) < WGM ? (nM - fm) : WGM;
        u.pm = fm + ((wgid % nig) % gsz); u.pn = (wgid % nig) / gsz; return true;
    }
    __device__ __forceinline__ void a_ready(const Unit&) const {}
    __device__ __forceinline__ void done(const Unit&) const {}
};

__device__ __forceinline__ unsigned cvt_pk_bf16(float lo, float hi) { unsigned r; asm volatile("v_cvt_pk_bf16_f32 %0, %1, %2" : "=v"(r) : "v"(lo), "v"(hi)); return r; }

__device__ __forceinline__ void store16_wt(void* base, unsigned byte_off, u32x4 v) {
    __amdgpu_buffer_rsrc_t r = __builtin_amdgcn_make_buffer_rsrc(base, 0, 0x7fffffff, 0x00020000);
    __builtin_amdgcn_raw_buffer_store_b128(v, r, (int)byte_off, 0, 16);
}
struct EpiProj {
    static constexpr bool PERM = true, AFTER_DRAIN = false, PREFETCH = false;
    bf16_t* P; float* AB; int ldp;
    __device__ __forceinline__ void operator()(const f32x4 (&acc)[2][2][4][2], const Unit& u, int wr, int wc, int fr, int fq) const {
        const int row0 = u.pm * BM + wr * 64 + fr;
        if (u.pn < 11) {
            const int col0 = u.pn * BM + wc * 32 + 8 * fq;
#pragma unroll
            for (int ai = 0; ai < 2; ++ai)
#pragma unroll
                for (int m = 0; m < 4; ++m) { const unsigned ro = ((unsigned)(row0 + ai * HALF + m * 16) * (unsigned)ldp + (unsigned)col0) * 2u;
#pragma unroll
                    for (int bj = 0; bj < 2; ++bj) { const f32x4 v0 = acc[ai][bj][m][0], v1 = acc[ai][bj][m][1];
                        u32x4 w; w.x = cvt_pk_bf16(v0[0], v0[1]); w.y = cvt_pk_bf16(v0[2], v0[3]); w.z = cvt_pk_bf16(v1[0], v1[1]); w.w = cvt_pk_bf16(v1[2], v1[3]);
                        *(u32x4*)((char*)P + ro + (unsigned)(bj * HALF) * 2u) = w; } }
        } else if (wc == 0 && fq < 2) {
#pragma unroll
            for (int ai = 0; ai < 2; ++ai)
#pragma unroll
                for (int m = 0; m < 4; ++m) { float* rowp = AB + (size_t)(row0 + ai * HALF + m * 16) * 16 + 8 * fq;
                    *(f32x4*)(rowp) = acc[ai][0][m][0]; *(f32x4*)(rowp + 4) = acc[ai][0][m][1]; }
        }
    }
};
struct EpiOut {
    static constexpr bool PERM = false, AFTER_DRAIN = false, PREFETCH = false;
    const float* X; float* O; const float* gate; int rows_per_batch, ldg;
    float* SSQ;
    __device__ __forceinline__ void prefetch(PG8_LAS unsigned char* lds, const Unit& u, int tid) const {
        const char* base = (const char*)X + ((size_t)(u.pm * BM) * 1024 + (size_t)u.pn * BM) * 4 + (size_t)(tid >> 3) * 4096 + (size_t)(tid & 7) * 128;
#pragma unroll
        for (int i = 0; i < 4; ++i) __builtin_amdgcn_global_load_lds((const unsigned*)(base + (size_t)i * 64 * 4096), (PG8_LAS unsigned*)(lds + STAGE_BYTES + 256), 4, 0, 0);
    }
    __device__ __forceinline__ void operator()(const f32x4 (&acc)[2][2][4][2], const Unit& u, int wr, int wc, int fr, int fq) const {
        const int row0 = u.pm * BM + wr * 64 + fr, col0 = u.pn * BM + wc * 32 + 4 * fq;
        const float* gb = gate + (size_t)((u.pm * BM) / rows_per_batch) * ldg + col0;
        f32x4 gv[2][2];
#pragma unroll
        for (int bj = 0; bj < 2; ++bj)
#pragma unroll
            for (int n = 0; n < 2; ++n) gv[bj][n] = *(const f32x4*)(gb + bj * HALF + n * 16);
#pragma unroll
        for (int ai = 0; ai < 2; ++ai)
#pragma unroll
            for (int m = 0; m < 4; ++m) { const size_t ro = (size_t)(row0 + ai * HALF + m * 16) * 1024 + col0; float ss = 0.f;
#pragma unroll
                for (int bj = 0; bj < 2; ++bj)
#pragma unroll
                    for (int n = 0; n < 2; ++n) { const f32x4 xv = *(const f32x4*)(X + ro + bj * HALF + n * 16); const f32x4 v = xv + gv[bj][n] * acc[ai][bj][m][n];
                        *(f32x4*)(O + ro + bj * HALF + n * 16) = v; ss += (v.x * v.x + v.y * v.y) + (v.z * v.z + v.w * v.w); }
                if (SSQ) { ss += __shfl_xor(ss, 16); ss += __shfl_xor(ss, 32); if (fq == 0) SSQ[(size_t)(row0 + ai * HALF + m * 16) * 16 + u.pn * 4 + wc] = ss; } }
    }
};

struct UnitG { int id, tile, pn, nrows; };
template <class Epi, class Sched>
__device__ __forceinline__ void gemm_phase_g(PG8_LAS unsigned char* lds, const bf16_t* Abase, const int KA, const int KB, const int nt, const int ksplit, const Sched& S, const Epi& E) {
    const int tid = threadIdx.x, wid = __builtin_amdgcn_readfirstlane(tid >> 6), lane = tid & 63, wr = wid >> 2, wc = wid & 3, fr = lane & 15, fq = lane >> 4;
    int Rr[2]; unsigned cB2[2], voffB[2];
#pragma unroll
    for (int i = 0; i < 2; ++i) { int R, C; stage_rc(tid * 16 + i * 8192, R, C); const int Rb = Epi::PERM ? ((R & ~31) + perm32(R & 31)) : R;
        Rr[i] = R; cB2[i] = (unsigned)C * 2u; voffB[i] = (unsigned)(Rb * KB + C) * 2u; }
    const size_t kstep = (size_t)(BK * 2);
    const size_t hstepB = (size_t)HALF * KB * 2;
    const unsigned ldsw = (unsigned)wid * 1024u;
    const int aoff = lds_byte(wr * 64 + fr, fq * 8), boff = lds_byte(wc * 32 + fr, fq * 8);
#define PG8_SA(b, h) (((b) * 2 + (h)) * HTB)
#define PG8_SB(b, h) ((4 + (b) * 2 + (h)) * HTB)
#define PG8_STAGE2(bufoff, gbase, v0, v1) do { \
        __builtin_amdgcn_global_load_lds((const unsigned*)((const char*)(gbase) + (v0)), (PG8_LAS unsigned*)(lds + (bufoff) + ldsw), 16, 0, 0); \
        __builtin_amdgcn_global_load_lds((const unsigned*)((const char*)(gbase) + (v1)), (PG8_LAS unsigned*)(lds + (bufoff) + ldsw + 8192), 16, 0, 0); } while (0)
#define PG8_LDA(dst, b, h) do { _Pragma("unroll") for (int m = 0; m < 4; ++m) _Pragma("unroll") for (int k = 0; k < 2; ++k) dst[m][k] = *(const PG8_LAS bf16x8*)(lds + PG8_SA(b, h) + aoff + m * 2048 + k * 1024); } while (0)
#define PG8_LDB(dst, b, h) do { _Pragma("unroll") for (int n = 0; n < 2; ++n) _Pragma("unroll") for (int k = 0; k < 2; ++k) dst[n][k] = *(const PG8_LAS bf16x8*)(lds + PG8_SB(b, h) + boff + n * 2048 + k * 1024); } while (0)
#define PG8_MMA(ai, bj, At, Bt) do { __builtin_amdgcn_s_setprio(1); _Pragma("unroll") for (int m = 0; m < 4; ++m) _Pragma("unroll") for (int n = 0; n < 2; ++n) _Pragma("unroll") for (int k = 0; k < 2; ++k) \
        acc[ai][bj][m][n] = __builtin_amdgcn_mfma_f32_16x16x32_bf16(Bt[n][k], At[m][k], acc[ai][bj][m][n], 0, 0, 0); __builtin_amdgcn_s_setprio(0); } while (0)
#define PG8_WAIT_V(n) asm volatile("s_waitcnt vmcnt(" #n ")" ::: "memory")
#define PG8_WAIT_L(n) asm volatile("s_waitcnt lgkmcnt(" #n ")" ::: "memory")
#define PG8_BAR __builtin_amdgcn_s_barrier()
#define PG8_SCHED __builtin_amdgcn_sched_barrier(0)
#define PG8_AOFFS(u, o00, o01, o10, o11) do { const unsigned _ks = (unsigned)KA * 2u; \
        o00 = (unsigned)S.tok(u, Rr[0]) * _ks + cB2[0]; o01 = (unsigned)S.tok(u, Rr[1]) * _ks + cB2[1]; \
        o10 = (unsigned)S.tok(u, HALF + Rr[0]) * _ks + cB2[0]; o11 = (unsigned)S.tok(u, HALF + Rr[1]) * _ks + cB2[1]; } while (0)
#define PG8_BT(u, t) (((t) < ksplit) ? S.bseg(u, 0) + (size_t)(t) * kstep : S.bseg(u, 1) + (size_t)((t) - ksplit) * kstep)
    UnitG cur, nxt; int ui = 0;
    if (!S.next(0, cur)) return;
    f32x4 acc[2][2][4][2];
#pragma unroll
    for (int a = 0; a < 2; ++a)
#pragma unroll
        for (int b = 0; b < 2; ++b)
#pragma unroll
            for (int m = 0; m < 4; ++m)
#pragma unroll
                for (int n = 0; n < 2; ++n) acc[a][b][m][n] = (f32x4){0.f, 0.f, 0.f, 0.f};
    bf16x8 At[4][2], B0[2][2], B1[2][2];
    unsigned c00, c01, c10, c11, n00 = 0, n01 = 0, n10 = 0, n11 = 0;
    PG8_AOFFS(cur, c00, c01, c10, c11);
    if constexpr (Epi::PREFETCH) E.prefetch(lds, cur, S, tid);
    const char* const Ab = (const char*)Abase;
    {   const char* b0p = PG8_BT(cur, 0); const char* b1p = PG8_BT(cur, 1);
        PG8_STAGE2(PG8_SB(0, 0), b0p, voffB[0], voffB[1]); PG8_STAGE2(PG8_SB(0, 1), b0p + hstepB, voffB[0], voffB[1]); PG8_STAGE2(PG8_SA(0, 0), Ab, c00, c01); PG8_STAGE2(PG8_SA(0, 1), Ab, c10, c11);
        if (wr == 1) PG8_BAR;
        PG8_WAIT_V(2); PG8_BAR;
        PG8_STAGE2(PG8_SB(1, 0), b1p, voffB[0], voffB[1]); PG8_STAGE2(PG8_SA(1, 0), Ab + kstep, c00, c01); PG8_STAGE2(PG8_SB(1, 1), b1p + hstepB, voffB[0], voffB[1]);
        PG8_WAIT_V(6); PG8_BAR;
    }
    for (;;) {
        const bool has_next = S.next(ui + 1, nxt);
        const bool h1 = cur.nrows > HALF;
        for (int t = 0; t < nt; t += 2) {
            const bool last = (t == nt - 2);
            if (last && has_next) { PG8_AOFFS(nxt, n00, n01, n10, n11); if constexpr (Epi::PREFETCH) E.prefetch(lds, nxt, S, tid); }
            const bool usen = last && has_next;
            const int t2 = last ? 0 : t + 2, t3 = t2 + 1;
            const char* a1 = Ab + (size_t)(t + 1) * kstep;
            const char* a2 = Ab + (size_t)t2 * kstep; const char* a3 = Ab + (size_t)t3 * kstep;
            const char* b2 = usen ? PG8_BT(nxt, t2) : PG8_BT(cur, t2); const char* b3 = usen ? PG8_BT(nxt, t3) : PG8_BT(cur, t3);
            const unsigned o00 = usen ? n00 : c00, o01 = usen ? n01 : c01, o10 = usen ? n10 : c10, o11 = usen ? n11 : c11;
            PG8_LDB(B0, 0, 0); PG8_LDB(B1, 0, 1); PG8_SCHED; PG8_LDA(At, 0, 0); PG8_STAGE2(PG8_SA(1, 1), a1, c10, c11);
            PG8_WAIT_V(8); PG8_WAIT_L(0); PG8_BAR; PG8_MMA(0, 0, At, B0); PG8_MMA(0, 1, At, B1); PG8_BAR; PG8_SCHED;
            PG8_LDA(At, 0, 1); PG8_STAGE2(PG8_SB(0, 0), b2, voffB[0], voffB[1]); PG8_STAGE2(PG8_SB(0, 1), b2 + hstepB, voffB[0], voffB[1]); PG8_STAGE2(PG8_SA(0, 0), a2, o00, o01);
            PG8_WAIT_V(8); PG8_WAIT_L(0); PG8_BAR; if (h1) { PG8_MMA(1, 0, At, B0); PG8_MMA(1, 1, At, B1); } PG8_BAR; PG8_SCHED;
            PG8_LDB(B0, 1, 0); PG8_LDB(B1, 1, 1); PG8_SCHED; PG8_LDA(At, 1, 0); PG8_STAGE2(PG8_SA(0, 1), a2, o10, o11);
            PG8_WAIT_V(8); PG8_WAIT_L(0); PG8_BAR; PG8_MMA(0, 0, At, B0); PG8_MMA(0, 1, At, B1); PG8_BAR; PG8_SCHED;
            PG8_LDA(At, 1, 1); PG8_STAGE2(PG8_SB(1, 0), b3, voffB[0], voffB[1]); PG8_STAGE2(PG8_SB(1, 1), b3 + hstepB, voffB[0], voffB[1]); PG8_STAGE2(PG8_SA(1, 0), a3, o00, o01);
            PG8_WAIT_V(8); PG8_WAIT_L(0); PG8_BAR; if (h1) { PG8_MMA(1, 0, At, B0); PG8_MMA(1, 1, At, B1); } PG8_BAR; PG8_SCHED;
        }
        if (wr == 0) PG8_BAR;
        E(acc, cur, S, wr, wc, fr, fq);
        if (!has_next) break;
#pragma unroll
        for (int a = 0; a < 2; ++a)
#pragma unroll
            for (int b = 0; b < 2; ++b)
#pragma unroll
                for (int m = 0; m < 4; ++m)
#pragma unroll
                    for (int n = 0; n < 2; ++n) acc[a][b][m][n] = (f32x4){0.f, 0.f, 0.f, 0.f};
        cur = nxt; c00 = n00; c01 = n01; c10 = n10; c11 = n11; ++ui;
        if (wr == 1) PG8_BAR;
    }
    PG8_WAIT_V(0);
    PG8_BAR;
#undef PG8_SA
#undef PG8_SB
#undef PG8_STAGE2
#undef PG8_LDA
#undef PG8_LDB
#undef PG8_MMA
#undef PG8_WAIT_V
#undef PG8_WAIT_L
#undef PG8_BAR
#undef PG8_SCHED
#undef PG8_AOFFS
#undef PG8_BT
}
template <class Epi, class Sched, bool ALIGN_EPI = false, bool SP2 = false>
__device__ __forceinline__ void gemm_phase(PG8_LAS unsigned char* lds, const Gemm g, const Sched& S, const Epi& E) {
    const int tid = threadIdx.x, wid = __builtin_amdgcn_readfirstlane(tid >> 6), lane = tid & 63, wr = wid >> 2, wc = wid & 3, fr = lane & 15, fq = lane >> 4;
    const int K = g.K, nt = K / BK;
    unsigned voffA[2], voffB[2];
#pragma unroll
    for (int i = 0; i < 2; ++i) { int R, C; stage_rc(tid * 16 + i * 8192, R, C); const int Rb = Epi::PERM ? ((R & ~31) + perm32(R & 31)) : R;
        voffA[i] = (unsigned)(R * K + C) * 2u; voffB[i] = (unsigned)(Rb * K + C) * 2u; }
    const size_t kstep = (size_t)(BK * 2);
    const size_t hstep = (size_t)HALF * K * 2;
    const size_t tstep = 2 * hstep;
    const unsigned ldsw = (unsigned)wid * 1024u;
    const int aoff = lds_byte(wr * 64 + fr, fq * 8), boff = lds_byte(wc * 32 + fr, fq * 8);
#define PG8_SA(b, h) (((b) * 2 + (h)) * HTB)
#define PG8_SB(b, h) ((4 + (b) * 2 + (h)) * HTB)
#define PG8_STAGE(bufoff, gbase, voff) do { _Pragma("unroll") for (int _i = 0; _i < 2; ++_i) \
        __builtin_amdgcn_global_load_lds((const unsigned*)((const char*)(gbase) + (voff)[_i]), (PG8_LAS unsigned*)(lds + (bufoff) + ldsw + _i * 8192), 16, 0, 0); } while (0)
#define PG8_LDA(dst, b, h) do { _Pragma("unroll") for (int m = 0; m < 4; ++m) _Pragma("unroll") for (int k = 0; k < 2; ++k) dst[m][k] = *(const PG8_LAS bf16x8*)(lds + PG8_SA(b, h) + aoff + m * 2048 + k * 1024); } while (0)
#define PG8_LDB(dst, b, h) do { _Pragma("unroll") for (int n = 0; n < 2; ++n) _Pragma("unroll") for (int k = 0; k < 2; ++k) dst[n][k] = *(const PG8_LAS bf16x8*)(lds + PG8_SB(b, h) + boff + n * 2048 + k * 1024); } while (0)
#define PG8_MMA(ai, bj, At, Bt) do { __builtin_amdgcn_s_setprio(1); _Pragma("unroll") for (int m = 0; m < 4; ++m) _Pragma("unroll") for (int n = 0; n < 2; ++n) _Pragma("unroll") for (int k = 0; k < 2; ++k) \
        acc[ai][bj][m][n] = __builtin_amdgcn_mfma_f32_16x16x32_bf16(Bt[n][k], At[m][k], acc[ai][bj][m][n], 0, 0, 0); __builtin_amdgcn_s_setprio(0); } while (0)
#define PG8_WAIT_V(n) asm volatile("s_waitcnt vmcnt(" #n ")" ::: "memory")
#define PG8_WAIT_L(n) asm volatile("s_waitcnt lgkmcnt(" #n ")" ::: "memory")
#define PG8_BAR __builtin_amdgcn_s_barrier()
#define PG8_SCHED __builtin_amdgcn_sched_barrier(0)
    Unit cur, nxt; int ui = 0;
    if (!S.next(0, cur)) return;
    f32x4 acc[2][2][4][2];
#pragma unroll
    for (int a = 0; a < 2; ++a)
#pragma unroll
        for (int b = 0; b < 2; ++b)
#pragma unroll
            for (int m = 0; m < 4; ++m)
#pragma unroll
                for (int n = 0; n < 2; ++n) acc[a][b][m][n] = (f32x4){0.f, 0.f, 0.f, 0.f};
    bf16x8 At[4][2], B0[2][2], B1[2][2];
    const char* cA = (const char*)g.A + (size_t)cur.pm * tstep; const char* cB = (const char*)g.Bt + (size_t)cur.pn * tstep;
    S.a_ready(cur);
    if constexpr (SP2) {
        PG8_STAGE(PG8_SB(0, 0), cB, voffB); PG8_STAGE(PG8_SB(0, 1), cB + hstep, voffB); PG8_STAGE(PG8_SA(0, 0), cA, voffA); PG8_STAGE(PG8_SA(0, 1), cA + hstep, voffA);
        if (wr == 1) PG8_BAR;
        PG8_WAIT_V(2); PG8_BAR;
        PG8_STAGE(PG8_SB(1, 0), cB + kstep, voffB); PG8_STAGE(PG8_SA(1, 0), cA + kstep, voffA); PG8_STAGE(PG8_SB(1, 1), cB + hstep + kstep, voffB);
        PG8_WAIT_V(6); PG8_BAR;
    } else {
        PG8_STAGE(PG8_SB(0, 0), cB, voffB); PG8_STAGE(PG8_SA(0, 0), cA, voffA); PG8_STAGE(PG8_SB(0, 1), cB + hstep, voffB); PG8_STAGE(PG8_SA(0, 1), cA + hstep, voffA);
        if (wr == 1) PG8_BAR;
        PG8_WAIT_V(4); PG8_BAR;
        PG8_STAGE(PG8_SB(1, 0), cB + kstep, voffB); PG8_STAGE(PG8_SA(1, 0), cA + kstep, voffA); PG8_STAGE(PG8_SB(1, 1), cB + hstep + kstep, voffB);
        PG8_WAIT_V(6); PG8_BAR;
    }
    if constexpr (Epi::PREFETCH) E.prefetch(lds, cur, tid);
    for (;;) {
        const bool has_next = S.next(ui + 1, nxt);
        const char* nA = has_next ? (const char*)g.A + (size_t)nxt.pm * tstep : cA; const char* nB = has_next ? (const char*)g.Bt + (size_t)nxt.pn * tstep : cB;
        for (int t = 0; t < nt; t += 2) {
            const bool last = (t == nt - 2);
            const char* a1 = cA + (size_t)(t + 1) * kstep;
            const char* a2 = last ? nA : cA + (size_t)(t + 2) * kstep; const char* b2 = last ? nB : cB + (size_t)(t + 2) * kstep;
            const char* a3 = a2 + kstep; const char* b3 = b2 + kstep;
            if (last && has_next) S.a_ready(nxt);
            if constexpr (SP2) {
            PG8_LDB(B0, 0, 0); PG8_LDB(B1, 0, 1); PG8_SCHED; PG8_LDA(At, 0, 0); PG8_STAGE(PG8_SA(1, 1), a1 + hstep, voffA);
            PG8_WAIT_V(8); PG8_WAIT_L(0); PG8_BAR; PG8_MMA(0, 0, At, B0); PG8_MMA(0, 1, At, B1); PG8_BAR; PG8_SCHED;
            PG8_LDA(At, 0, 1); PG8_STAGE(PG8_SB(0, 0), b2, voffB); PG8_STAGE(PG8_SB(0, 1), b2 + hstep, voffB); PG8_STAGE(PG8_SA(0, 0), a2, voffA);
            PG8_WAIT_V(8); PG8_WAIT_L(0); PG8_BAR; PG8_MMA(1, 0, At, B0); PG8_MMA(1, 1, At, B1); PG8_BAR; PG8_SCHED;
            PG8_LDB(B0, 1, 0); PG8_LDB(B1, 1, 1); PG8_SCHED; PG8_LDA(At, 1, 0); PG8_STAGE(PG8_SA(0, 1), a2 + hstep, voffA);
            PG8_WAIT_V(8); PG8_WAIT_L(0); PG8_BAR; PG8_MMA(0, 0, At, B0); PG8_MMA(0, 1, At, B1); PG8_BAR; PG8_SCHED;
            PG8_LDA(At, 1, 1); PG8_STAGE(PG8_SB(1, 0), b3, voffB); PG8_STAGE(PG8_SB(1, 1), b3 + hstep, voffB); PG8_STAGE(PG8_SA(1, 0), a3, voffA);
            PG8_WAIT_V(8); PG8_WAIT_L(0); PG8_BAR; PG8_MMA(1, 0, At, B0); PG8_MMA(1, 1, At, B1); PG8_BAR; PG8_SCHED;
            } else {
            PG8_LDB(B0, 0, 0); PG8_SCHED; PG8_LDA(At, 0, 0); PG8_STAGE(PG8_SA(1, 1), a1 + hstep, voffA);
            PG8_WAIT_L(8); PG8_BAR; PG8_WAIT_L(0); PG8_MMA(0, 0, At, B0); PG8_BAR; PG8_SCHED;
            PG8_LDB(B1, 0, 1); PG8_STAGE(PG8_SB(0, 0), b2, voffB);
            PG8_BAR; PG8_WAIT_L(0); PG8_MMA(0, 1, At, B1); PG8_BAR;
            PG8_LDA(At, 0, 1); PG8_STAGE(PG8_SA(0, 0), a2, voffA);
            PG8_BAR; PG8_WAIT_L(0); PG8_MMA(1, 0, At, B0); PG8_BAR; PG8_SCHED;
            PG8_STAGE(PG8_SB(0, 1), b2 + hstep, voffB);
            PG8_WAIT_V(6); PG8_BAR; PG8_MMA(1, 1, At, B1); PG8_BAR;
            PG8_LDB(B0, 1, 0); PG8_SCHED; PG8_LDA(At, 1, 0); PG8_STAGE(PG8_SA(0, 1), a2 + hstep, voffA);
            PG8_WAIT_L(8); PG8_BAR; PG8_WAIT_L(0); PG8_MMA(0, 0, At, B0); PG8_BAR; PG8_SCHED;
            PG8_LDB(B1, 1, 1); PG8_STAGE(PG8_SB(1, 0), b3, voffB);
            PG8_BAR; PG8_WAIT_L(0); PG8_MMA(0, 1, At, B1); PG8_BAR;
            PG8_LDA(At, 1, 1); PG8_STAGE(PG8_SA(1, 0), a3, voffA);
            PG8_BAR; PG8_WAIT_L(0); PG8_MMA(1, 0, At, B0); PG8_BAR; PG8_SCHED;
            PG8_STAGE(PG8_SB(1, 1), b3 + hstep, voffB);
            PG8_WAIT_V(6); PG8_BAR; PG8_MMA(1, 1, At, B1); PG8_BAR;
            }
        }
        if constexpr (ALIGN_EPI) { if (wr == 0) PG8_BAR; }
        if constexpr (!Epi::AFTER_DRAIN) { E(acc, cur, wr, wc, fr, fq); S.done(cur); }
        if (!has_next) break;
#pragma unroll
        for (int a = 0; a < 2; ++a)
#pragma unroll
            for (int b = 0; b < 2; ++b)
#pragma unroll
                for (int m = 0; m < 4; ++m)
#pragma unroll
                    for (int n = 0; n < 2; ++n) acc[a][b][m][n] = (f32x4){0.f, 0.f, 0.f, 0.f};
        cur = nxt; cA = nA; cB = nB; ++ui;
        if constexpr (Epi::PREFETCH) { int l_ = fr + 16 * fq; asm volatile("" : "+v"(l_)); E.prefetch(lds, cur, wid * 64 + l_); }
        if constexpr (ALIGN_EPI) { if (wr == 1) PG8_BAR; }
    }
    PG8_WAIT_V(0);
    if constexpr (!ALIGN_EPI) { if (wr == 0) PG8_BAR; }
    PG8_BAR;
    if constexpr (Epi::AFTER_DRAIN) { E.fused(acc, cur, wr, wc, fr, fq, lds, wid, lane); S.done(cur); }
#undef PG8_SA
#undef PG8_SB
#undef PG8_STAGE
#undef PG8_LDA
#undef PG8_LDB
#undef PG8_MMA
#undef PG8_WAIT_V
#undef PG8_WAIT_L
#undef PG8_BAR
#undef PG8_SCHED
}
}

constexpr int NB = 4, SEQ = 8192, DM = 1024, TT = NB * SEQ;
constexpr int NPROJ = 2816, NPAD = 3072;
constexpr int PC_Q = 0, PC_K = 512, PC_V = 1024, PC_Z = 1536, PC_SQ = 2048, PC_SK = 2560, PC_SV = 2688;
constexpr int NE = 32, NCLS = 112, DE = 256;
constexpr float EPS = 1e-6f;
constexpr int NWAVES = 8, NTHR = 512;
constexpr int N_PHASES = 10;
#ifndef G1_SM
#define G1_SM 31
#endif
#ifndef PROBE_REP
#define PROBE_REP -1
#endif
#ifndef MK_ONE_LAUNCH
#define MK_ONE_LAUNCH 1
#endif

constexpr size_t MiB = 1u << 20;
constexpr size_t WS_CTL = 0, CTL_ZERO_BYTES = 65536;
constexpr size_t WS_MOD = 1 * MiB;
constexpr size_t WS_WINT = 2 * MiB, WS_WOUTT = 8 * MiB, WS_WGUT = 10 * MiB, WS_WDT = 42 * MiB;
constexpr size_t WS_H = 58 * MiB;
constexpr size_t WS_PROJ = 122 * MiB;
constexpr size_t WS_AB = 298 * MiB;
constexpr size_t WS_SSQ = WS_AB;
constexpr size_t WS_MIX = 300 * MiB;
constexpr size_t WS_GSF = 364 * MiB;
constexpr size_t WS_EREC = 404 * MiB, WS_CLIST = 412 * MiB;
constexpr size_t WS_HID = WS_PROJ;
constexpr size_t WS_GAP = WS_H, WS_GQP = WS_H + 32 * MiB;
constexpr size_t WS_GOP = 426 * MiB, WS_GBP = 458 * MiB, WS_GGL = 490 * MiB;
constexpr size_t WS_WRT = 491 * MiB;
constexpr size_t WS_END = 492 * MiB;
constexpr int CW_BAR = 4096, CW_ECNT = 8192, CW_CCNT = 8256;

constexpr int RING_BYTES = 131072, LDSCTL_OFF = RING_BYTES, LDS_BYTES = 147456, MISC_OFF = LDS_BYTES - 128;

#define GAS __attribute__((address_space(1)))
#define LAS __attribute__((address_space(3)))
typedef unsigned short bf16;
typedef unsigned v4u __attribute__((ext_vector_type(4)));
typedef float f32x4 __attribute__((ext_vector_type(4)));
typedef GAS unsigned gu32;
#define RLX_AGENT __ATOMIC_RELAXED, __HIP_MEMORY_SCOPE_AGENT
#define LDS_WAIT() asm volatile("s_waitcnt lgkmcnt(0)" ::: "memory")
__device__ __forceinline__ unsigned f2bf(float f) { unsigned u = __builtin_bit_cast(unsigned, f); return (u + 0x7fffu + ((u >> 16) & 1u)) >> 16; }
__device__ __forceinline__ unsigned pk2(float lo, float hi) { return f2bf(lo) | (f2bf(hi) << 16); }
__device__ __forceinline__ float bf2f(bf16 v) { return __builtin_bit_cast(float, (unsigned)v << 16); }
__device__ __forceinline__ float wave_sum(float v) {
#pragma unroll
    for (int o = 1; o < 64; o <<= 1) v += __shfl_xor(v, o);
    return v;
}
__device__ __forceinline__ float siluf(float y) { return y / (1.f + __expf(-y)); }
#define XB_TMO      128
#define XB_XCNT(j)  (256  + 64 * (j))
#define XB_XSUB(j)  (1280 + 64 * (j))
#define XB_XGEN(j)  (2304 + 64 * (j))
#define XB_TOP      3328
#define XB_TOPGEN   3392
#define XCD_BAR_WORDS 3456
#define XB_SPIN_CAP (1u << 18)
__device__ __forceinline__ unsigned xb_ld(unsigned* p)              { return __hip_atomic_load(p, __ATOMIC_RELAXED, __HIP_MEMORY_SCOPE_AGENT); }
__device__ __forceinline__ unsigned xb_add(unsigned* p, unsigned v) { return __hip_atomic_fetch_add(p, v, __ATOMIC_RELAXED, __HIP_MEMORY_SCOPE_AGENT); }
__device__ __forceinline__ unsigned xb_xcc_id() { return (unsigned)__builtin_amdgcn_s_getreg((3 << 11) | 20) & 0xFu; }
#define XB_SPIN(cond, bar) do { unsigned _sp = 0; while (cond) { __builtin_amdgcn_s_sleep(1); \
    if ((++_sp & 255u) == 0u) { if (xb_ld(&(bar)[XB_TMO])) break; if (_sp > XB_SPIN_CAP) { atomicAdd(&(bar)[XB_TMO], 1u); break; } } } } while (0)

struct XcdBarrier {
    unsigned* bar; unsigned x;
    volatile LAS unsigned* st;
};

__device__ __forceinline__ XcdBarrier xcd_barrier_post(unsigned* bar, volatile LAS unsigned* st, bool leader  ) {
    XcdBarrier b; b.bar = bar; b.x = xb_xcc_id(); b.st = st;
    if (leader) (void)xb_add(&bar[XB_XCNT(b.x)], 1u);
    return b;
}
__device__ __forceinline__ void xcd_barrier_complete(unsigned* bar, unsigned x, unsigned& nloc, unsigned& nx) {
    const unsigned G = gridDim.x * gridDim.y * gridDim.z;
    unsigned sum, cnt, mine, sp = 0u;
    for (;;) {
        sum = 0u; cnt = 0u; mine = 0u;
#pragma unroll
        for (unsigned j = 0; j < 16; ++j) { const unsigned c = xb_ld(&bar[XB_XCNT(j)]); sum += c; cnt += (c > 0u) ? 1u : 0u; mine = (j == x) ? c : mine; }
        if (sum == G) break;
        __builtin_amdgcn_s_sleep(1);
        if ((++sp & 255u) == 0u) { if (xb_ld(&bar[XB_TMO])) break; if (sp > XB_SPIN_CAP) { atomicAdd(&bar[XB_TMO], 1u); break; } }
    }
    nloc = mine > 0u ? mine : 1u; nx = cnt > 0u ? cnt : 1u;
}

__device__ __forceinline__ void xcd_barrier(const XcdBarrier& b, bool leader  ) {
    asm volatile("s_waitcnt vmcnt(0)" ::: "memory");
    __syncthreads();
    if (leader) {
        unsigned* bar = b.bar;
        __builtin_amdgcn_s_waitcnt(0);
        unsigned nloc = b.st[0], nx = b.st[1];
        if (nloc == 0u) { xcd_barrier_complete(bar, b.x, nloc, nx); b.st[0] = nloc; b.st[1] = nx; }
        const unsigned old = xb_add(&bar[XB_XSUB(b.x)], 1u);
        const unsigned gen = old / nloc;
        if (old + 1u == (gen + 1u) * nloc) {
            __builtin_amdgcn_fence(__ATOMIC_RELEASE, "agent");
            asm volatile("s_waitcnt vmcnt(0)" ::: "memory");
            const unsigned og = xb_add(&bar[XB_TOP], 1u);
            const unsigned tg = og / nx;
            if (og + 1u == (tg + 1u) * nx) xb_add(&bar[XB_TOPGEN], 1u);
            else XB_SPIN(xb_ld(&bar[XB_TOPGEN]) == tg, bar);
            __builtin_amdgcn_fence(__ATOMIC_ACQUIRE, "agent");
            xb_add(&bar[XB_XGEN(b.x)], 1u);
            asm volatile("s_waitcnt vmcnt(0)" ::: "memory");
        } else {
            XB_SPIN(xb_ld(&bar[XB_XGEN(b.x)]) == gen, bar);
            __builtin_amdgcn_fence(__ATOMIC_ACQUIRE, "agent");
            asm volatile("s_waitcnt vmcnt(0)" ::: "memory");
        }
    }
    __syncthreads();
}

struct Args { const void* in[23]; float* out; unsigned char* ws; int ph_lo, ph_hi; };
enum { I_X = 0, I_C, I_POS, I_WADA, I_BADA, I_NORM_MIX, I_WIN, I_CONVW, I_ALOG, I_DTB, I_GNORM, I_QNORM, I_KNORM, I_SINKS, I_WOUT, I_NORM_FFN, I_WGRP, I_BGRP, I_WRT, I_BRT, I_WGATE, I_WUP, I_WDOWN };

template <class CM>
__device__ __forceinline__ void transpose_item(const float* W, int ldw, int k0, bf16* WT, int ldt, int n0, CM cm, LAS float* scr, int lane) {
    const int sc = cm(n0 + (lane & 31));
    float tv[32];
#pragma unroll
    for (int i = 0; i < 32; ++i) { const int kk = 2 * i + (lane >> 5); tv[i] = W[(size_t)(k0 + kk) * ldw + (sc >= 0 ? sc : 0)]; }
#pragma unroll
    for (int i = 0; i < 32; ++i) { const int kk = 2 * i + (lane >> 5); scr[kk * 33 + (lane & 31)] = sc >= 0 ? tv[i] : 0.f; }
    LDS_WAIT(); asm volatile("" ::: "memory");
    const int c = lane & 7;
#pragma unroll
    for (int j = 0; j < 4; ++j) { const int n = (lane >> 3) + 8 * j; const LAS float* s = scr + (8 * c) * 33 + n;
        v4u o; o.x = pk2(s[0 * 33], s[1 * 33]); o.y = pk2(s[2 * 33], s[3 * 33]); o.z = pk2(s[4 * 33], s[5 * 33]); o.w = pk2(s[6 * 33], s[7 * 33]);
        *(v4u*)(WT + (size_t)(n0 + n) * ldt + k0 + 8 * c) = o; }
    LDS_WAIT(); asm volatile("" ::: "memory");
}
struct CmIn { __device__ __forceinline__ int operator()(int n) const { return n < 2048 ? n : (n < 2816 ? n + 16 : (n < 2832 ? 2048 + (n - 2816) : -1)); } };
struct CmOff { int off; __device__ __forceinline__ int operator()(int n) const { return n + off; } };
struct CmId { __device__ __forceinline__ int operator()(int n) const { return n; } };

__device__ __forceinline__ void p0_prologue(const Args& A, LAS unsigned char* lds, int tid, int lane, int wave) {
    unsigned char* ws = A.ws;
    LAS float* scr = (LAS float*)(lds + wave * 8448);
    const int G = gridDim.x, gw = blockIdx.x * NWAVES + wave, NGW = G * NWAVES;
    constexpr int IT_IN = (NPAD / 32) * (DM / 64), IT_OUT = (DM / 32) * (DM / 64);
    for (int it = gw; it < IT_IN + IT_OUT; it += NGW) {
        if (it < IT_IN) { const int nb = it % (NPAD / 32), kb = it / (NPAD / 32); transpose_item((const float*)A.in[I_WIN], 2832, kb * 64, (bf16*)(ws + WS_WINT), DM, nb * 32, CmIn(), scr, lane); }
        else { const int r = it - IT_IN, nb = r % (DM / 32), kb = r / (DM / 32); transpose_item((const float*)A.in[I_WOUT], DM, kb * 64, (bf16*)(ws + WS_WOUTT), DM, nb * 32, CmId(), scr, lane); }
    }
    {   constexpr int IT_GU = NE * 16 * 16, IT_D = NE * 32 * 4;
        const float* wgate = (const float*)A.in[I_WGATE]; const float* wup = (const float*)A.in[I_WUP]; const float* wdown = (const float*)A.in[I_WDOWN];
        for (int it = gw; it < IT_GU + IT_D; it += NGW) {
            if (it < IT_GU) { const int e = it >> 8, r = it & 255, nb = r & 15, kb = r >> 4, j = nb >> 3, q = nb & 7;
                const float* W = (q < 4 ? wgate : wup) + (size_t)e * 1024 * 256; const int col0 = j * 128 + (q & 3) * 32;
                transpose_item(W, 256, kb * 64, (bf16*)(ws + WS_WGUT) + (size_t)e * 512 * 1024, 1024, nb * 32, CmOff{col0 - nb * 32}, scr, lane); }
            else { const int r2 = it - IT_GU, e = r2 >> 7, r = r2 & 127, nb = r & 31, kb = r >> 5;
                transpose_item(wdown + (size_t)e * 256 * 1024, 1024, kb * 64, (bf16*)(ws + WS_WDT) + (size_t)e * 1024 * 256, 256, nb * 32, CmId(), scr, lane); }
        }
    }
    {   const float* wgp = (const float*)A.in[I_WGRP]; const float* wrt = (const float*)A.in[I_WRT];
        bf16* wf = (bf16*)(ws + WS_WRT);
        for (int idx = blockIdx.x * NTHR + tid; idx < 48 * 1024; idx += G * NTHR) { const int j = idx & 7, ln = (idx >> 3) & 63, ks = (idx >> 9) & 31, nt = idx >> 14;
            const int o = 16 * nt + (ln & 15), k = 32 * ks + 8 * (ln >> 4) + j;
            const float w = o < 4 ? wgp[k * 4 + o] : (o < 36 ? wrt[k * 32 + o - 4] : 0.f);
            const unsigned hb = f2bf(w); wf[idx] = (bf16)hb; wf[48 * 1024 + idx] = (bf16)f2bf(w - __builtin_bit_cast(float, hb << 16)); }
    }
    LAS float* cact = (LAS float*)(lds + 69632);
    LAS float* red = (LAS float*)(lds + 69632 + 16384);
    const float* c = (const float*)A.in[I_C]; const float* wada = (const float*)A.in[I_WADA]; const float* bada = (const float*)A.in[I_BADA];
    float* mod = (float*)(ws + WS_MOD);
    if ((int)blockIdx.x < 96) {
        __syncthreads();
        for (int i = tid; i < 4096; i += NTHR) cact[i] = siluf(c[i]);
        __syncthreads();
        for (int u = blockIdx.x; u < 96; u += G) {
            const int n = u * 64 + lane; float a0 = 0.f, a1 = 0.f, a2 = 0.f, a3 = 0.f;
#pragma unroll 16
            for (int k = wave * 128; k < wave * 128 + 128; ++k) { const float w = wada[(size_t)k * 6144 + n]; a0 += cact[k] * w; a1 += cact[1024 + k] * w; a2 += cact[2048 + k] * w; a3 += cact[3072 + k] * w; }
            red[(wave * 4 + 0) * 64 + lane] = a0; red[(wave * 4 + 1) * 64 + lane] = a1; red[(wave * 4 + 2) * 64 + lane] = a2; red[(wave * 4 + 3) * 64 + lane] = a3;
            __syncthreads();
            if (tid < 256) { const int b = tid >> 6, l = tid & 63; float s = bada[u * 64 + l];
#pragma unroll
                for (int w = 0; w < 8; ++w) s += red[(w * 4 + b) * 64 + l];
                mod[b * 6144 + u * 64 + l] = s; }
            __syncthreads();
        }
    }
}

template <bool ROUTE>
__device__ __forceinline__ void norm_rows(const Args& A, const float* X, const float* gain, const float* shift, const float* scale, bf16* H, LAS unsigned char* lds, int lane, int wave) {
    LAS float* hl = (LAS float*)(lds + wave * 4096);
    const int G = gridDim.x, gw = blockIdx.x * NWAVES + wave, NGW = G * NWAVES;
    unsigned char* ws = A.ws;
    for (int r0 = gw * 16; r0 < TT; r0 += NGW * 16) {
        const int b = r0 / SEQ;
        f32x4 mf[4], af[4];
#pragma unroll
        for (int j = 0; j < 4; ++j) { const int col = 4 * lane + 256 * j; const f32x4 g = *(const f32x4*)(gain + col), sc = *(const f32x4*)(scale + b * 6144 + col);
            mf[j] = g * (sc + 1.0f); af[j] = *(const f32x4*)(shift + b * 6144 + col); }
#pragma unroll 4
        for (int i = 0; i < 16; ++i) {
            const int row = r0 + i;
            const f32x4* xr = (const f32x4*)(X + (size_t)row * DM) + lane;
            f32x4 v[4]; float s = 0.f;
#pragma unroll
            for (int j = 0; j < 4; ++j) { v[j] = xr[64 * j]; s += (v[j].x * v[j].x + v[j].y * v[j].y) + (v[j].z * v[j].z + v[j].w * v[j].w); }
            const float rstd = 1.f / sqrtf(wave_sum(s) * (1.f / DM) + EPS);
            unsigned long long* o8 = (unsigned long long*)(H + (size_t)row * DM) + lane;
#pragma unroll
            for (int j = 0; j < 4; ++j) { v[j] = v[j] * rstd * mf[j] + af[j];
                o8[64 * j] = (unsigned long long)pk2(v[j].x, v[j].y) | ((unsigned long long)pk2(v[j].z, v[j].w) << 32); }
            if constexpr (ROUTE) {
                const float* wg = (const float*)A.in[I_WGRP]; const float* wr = (const float*)A.in[I_WRT];
                float lg[36];
#pragma unroll
                for (int o = 0; o < 36; ++o) lg[o] = 0.f;
#pragma unroll
                for (int j = 0; j < 4; ++j) *(LAS f32x4*)(hl + 4 * lane + 256 * j) = v[j];
                LDS_WAIT(); asm volatile("" ::: "memory");
#pragma unroll 1
                for (int ii = 0; ii < 16; ++ii) { const int k = lane + 64 * ii; const float hv = hl[k];
                    const f32x4 g4 = *(const f32x4*)(wg + k * 4);
                    lg[0] += hv * g4.x; lg[1] += hv * g4.y; lg[2] += hv * g4.z; lg[3] += hv * g4.w;
#pragma unroll
                    for (int q = 0; q < 8; ++q) { const f32x4 r4 = *(const f32x4*)(wr + k * 32 + q * 4);
                        lg[4 + q * 4 + 0] += hv * r4.x; lg[4 + q * 4 + 1] += hv * r4.y; lg[4 + q * 4 + 2] += hv * r4.z; lg[4 + q * 4 + 3] += hv * r4.w; } }
                LDS_WAIT(); asm volatile("" ::: "memory");
#pragma unroll
                for (int o = 0; o < 36; ++o) lg[o] = wave_sum(lg[o]);
                const float* bg = (const float*)A.in[I_BGRP]; const float* br = (const float*)A.in[I_BRT];
#pragma unroll
                for (int o = 0; o < 4; ++o) lg[o] += bg[o];
#pragma unroll
                for (int o = 0; o < 32; ++o) lg[4 + o] += br[o];
                int gi = 0; float gm = lg[0];
#pragma unroll
                for (int o = 1; o < 4; ++o) if (lg[o] > gm) { gm = lg[o]; gi = o; }
                float gs = 0.f;
#pragma unroll
                for (int o = 0; o < 4; ++o) gs += __expf(lg[o] - gm);
                const float pg = 1.f / gs;
                float le[8];
#pragma unroll
                for (int j = 0; j < 8; ++j) { le[j] = lg[4 + j];
#pragma unroll
                    for (int g = 1; g < 4; ++g) le[j] = (gi == g) ? lg[4 + g * 8 + j] : le[j]; }
                int j1 = 0; float m1 = le[0];
#pragma unroll
                for (int j = 1; j < 8; ++j) if (le[j] > m1) { m1 = le[j]; j1 = j; }
                int j2 = -1; float m2 = -3.0e38f;
#pragma unroll
                for (int j = 0; j < 8; ++j) if (j != j1 && le[j] > m2) { m2 = le[j]; j2 = j; }
                const float ex = __expf(m2 - m1), w1 = pg / (1.f + ex), w2 = pg * ex / (1.f + ex);
                if (lane == 0) {
                    const int e1 = gi * 8 + j1, e2 = gi * 8 + j2;
                    unsigned* ctl = (unsigned*)(ws + WS_CTL);
                    int2* erec = (int2*)(ws + WS_EREC); int* clist = (int*)(ws + WS_CLIST);
                    const unsigned p1 = atomicAdd(ctl + CW_ECNT + e1, 1u); erec[(size_t)e1 * TT + p1] = make_int2(row * 2 + (e1 > e2 ? 1 : 0), __builtin_bit_cast(int, w1));
                    const unsigned p2 = atomicAdd(ctl + CW_ECNT + e2, 1u); erec[(size_t)e2 * TT + p2] = make_int2(row * 2 + (e2 > e1 ? 1 : 0), __builtin_bit_cast(int, w2));
                    const int a = j1 < j2 ? j1 : j2, bb = j1 < j2 ? j2 : j1;
                    const int cls = gi * 28 + (a * 7 - (a * (a - 1)) / 2 + (bb - a - 1));
                    const unsigned pc = atomicAdd(ctl + CW_CCNT + cls, 1u); clist[(size_t)cls * TT + pc] = row;
                }
            }
        }
    }
}

typedef short bf16x8_t __attribute__((ext_vector_type(8)));
typedef float f32x16 __attribute__((ext_vector_type(16)));
typedef unsigned v2u __attribute__((ext_vector_type(2)));
typedef float f32x2_t __attribute__((ext_vector_type(2)));
typedef __bf16 bf16x2_t __attribute__((ext_vector_type(2)));
__device__ __forceinline__ unsigned cvtpk(float lo, float hi) { const f32x2_t f = {lo, hi}; return __builtin_bit_cast(unsigned, __builtin_convertvector(f, bf16x2_t)); }
__device__ __forceinline__ void fast_sincos(float ang, float& sn, float& cs) {
    float rev = ang * 0.15915494309189535f; rev -= floorf(rev);
    sn = __builtin_amdgcn_sinf(rev); cs = __builtin_amdgcn_cosf(rev);
}
__device__ __forceinline__ void swa_mfma(const Args& A, LAS unsigned char* lds, int tid, int lane, int wave, int blk, int nblk) {
    unsigned char* ws = A.ws;
    const bf16* proj = (const bf16*)(ws + WS_PROJ);
    bf16* mix = (bf16*)(ws + WS_MIX); const float* sinks = (const float*)A.in[I_SINKS];
    const int* pos = (const int*)A.in[I_POS]; const float* qn = (const float*)A.in[I_QNORM]; const float* kn = (const float*)A.in[I_KNORM];
    constexpr int KST = 144, VST = 520;
    LAS unsigned char* Kl = lds; LAS unsigned char* Vt = lds + 256 * KST;
    const int g = wave >> 1, qh = wave & 1, ql = lane & 31, hh = lane >> 5;
    constexpr float LOG2E = 1.4426950408889634f, CS = 0.125f * LOG2E, L2T = 13.287712379549449f / 32.f;
    const int sch = tid & 7;
    float kinv[8], kgn[8];
#pragma unroll
    for (int j = 0; j < 8; ++j) { kinv[j] = __builtin_amdgcn_exp2f(-(float)((sch & 3) * 8 + j) * L2T); kgn[j] = kn[sch * 8 + j]; }
    float qinv[2][8];
#pragma unroll
    for (int ks = 0; ks < 2; ++ks)
#pragma unroll
        for (int j = 0; j < 8; ++j) qinv[ks][j] = __builtin_amdgcn_exp2f(-(float)(ks * 16 + hh * 8 + j) * L2T);
    for (int u = blk; u < NB * 2 * (SEQ / 128); u += nblk) {
        const int n = u & 63, kvh = (u >> 6) & 1, b = u >> 7;
        const int tb = b * SEQ + n * 128;
        __syncthreads();
#pragma unroll
        for (int it = 0; it < 4; ++it) { const int idx = tid + it * NTHR, key = idx >> 3, ch = idx & 7; int tk = tb - 128 + key; if (tk < b * SEQ) tk = b * SEQ;
            const v4u kv = *(const v4u*)(proj + (size_t)tk * NPROJ + PC_SK + kvh * 64 + ch * 8);
            const v4u vv = *(const v4u*)(proj + (size_t)tk * NPROJ + PC_SV + kvh * 64 + ch * 8);
            const float pf = (float)pos[tk];
            float x[8] = { __builtin_bit_cast(float, kv.x << 16), __builtin_bit_cast(float, kv.x & 0xffff0000u), __builtin_bit_cast(float, kv.y << 16), __builtin_bit_cast(float, kv.y & 0xffff0000u),
                           __builtin_bit_cast(float, kv.z << 16), __builtin_bit_cast(float, kv.z & 0xffff0000u), __builtin_bit_cast(float, kv.w << 16), __builtin_bit_cast(float, kv.w & 0xffff0000u) };
            float ss = 0.f;
#pragma unroll
            for (int j = 0; j < 8; ++j) ss += x[j] * x[j];
            ss += __shfl_xor(ss, 1); ss += __shfl_xor(ss, 2); ss += __shfl_xor(ss, 4);
            const float rn = 1.f / sqrtf(ss * (1.f / 64.f) + EPS);
            float o[8];
#pragma unroll
            for (int j = 0; j < 8; ++j) { const float xn = x[j] * rn * kgn[j]; const float pr = __shfl_xor(xn, 4); float sn, cs; fast_sincos(pf * kinv[j], sn, cs);
                o[j] = (ch < 4) ? xn * cs - pr * sn : pr * sn + xn * cs; }
            v4u ko; ko.x = cvtpk(o[0], o[1]); ko.y = cvtpk(o[2], o[3]); ko.z = cvtpk(o[4], o[5]); ko.w = cvtpk(o[6], o[7]);
            *(LAS v4u*)(Kl + key * KST + ch * 16) = ko;
            LAS unsigned short* vp = (LAS unsigned short*)(Vt + (ch * 8) * VST + key * 2);
            vp[0 * (VST / 2)] = (unsigned short)(vv.x & 0xffffu); vp[1 * (VST / 2)] = (unsigned short)(vv.x >> 16);
            vp[2 * (VST / 2)] = (unsigned short)(vv.y & 0xffffu); vp[3 * (VST / 2)] = (unsigned short)(vv.y >> 16);
            vp[4 * (VST / 2)] = (unsigned short)(vv.z & 0xffffu); vp[5 * (VST / 2)] = (unsigned short)(vv.z >> 16);
            vp[6 * (VST / 2)] = (unsigned short)(vv.w & 0xffffu); vp[7 * (VST / 2)] = (unsigned short)(vv.w >> 16); }
        __syncthreads();
        const int hq = kvh * 4 + g; const float sinkl = sinks[hq] * LOG2E;
#pragma unroll 1
        for (int qt = 0; qt < 2; ++qt) {
            const int i0 = qh * 64 + qt * 32, iq = i0 + ql;
            const size_t tq = (size_t)(tb + iq);
            bf16x8_t qf[4];
            {   float xq[4][8]; float ss = 0.f;
#pragma unroll
                for (int ks = 0; ks < 4; ++ks) { const v4u r = *(const v4u*)(proj + tq * NPROJ + PC_SQ + hq * 64 + ks * 16 + hh * 8);
                    xq[ks][0] = __builtin_bit_cast(float, r.x << 16); xq[ks][1] = __builtin_bit_cast(float, r.x & 0xffff0000u); xq[ks][2] = __builtin_bit_cast(float, r.y << 16); xq[ks][3] = __builtin_bit_cast(float, r.y & 0xffff0000u);
                    xq[ks][4] = __builtin_bit_cast(float, r.z << 16); xq[ks][5] = __builtin_bit_cast(float, r.z & 0xffff0000u); xq[ks][6] = __builtin_bit_cast(float, r.w << 16); xq[ks][7] = __builtin_bit_cast(float, r.w & 0xffff0000u);
#pragma unroll
                    for (int j = 0; j < 8; ++j) ss += xq[ks][j] * xq[ks][j]; }
                ss += __shfl_xor(ss, 32);
                const float rn = 1.f / sqrtf(ss * (1.f / 64.f) + EPS); const float pf = (float)pos[tq];
#pragma unroll
                for (int ks = 0; ks < 4; ++ks)
#pragma unroll
                    for (int j = 0; j < 8; ++j) xq[ks][j] *= rn * qn[ks * 16 + hh * 8 + j];
#pragma unroll
                for (int ks = 0; ks < 2; ++ks)
#pragma unroll
                    for (int j = 0; j < 8; ++j) { float sn, cs; fast_sincos(pf * qinv[ks][j], sn, cs); const float x1 = xq[ks][j], x2 = xq[ks + 2][j];
                        xq[ks][j] = x1 * cs - x2 * sn; xq[ks + 2][j] = x1 * sn + x2 * cs; }
#pragma unroll
                for (int ks = 0; ks < 4; ++ks) { union { bf16x8_t v; unsigned u[4]; } p; p.u[0] = cvtpk(xq[ks][0], xq[ks][1]); p.u[1] = cvtpk(xq[ks][2], xq[ks][3]); p.u[2] = cvtpk(xq[ks][4], xq[ks][5]); p.u[3] = cvtpk(xq[ks][6], xq[ks][7]); qf[ks] = p.v; }
            }
            f32x16 sc[5];
#pragma unroll
            for (int kt = 0; kt < 5; ++kt) { f32x16 acc;
#pragma unroll
                for (int r = 0; r < 16; ++r) acc[r] = 0.f;
#pragma unroll
                for (int ks = 0; ks < 4; ++ks) { const bf16x8_t kf = *(const LAS bf16x8_t*)(Kl + (i0 + 32 * kt + ql) * KST + (ks * 16 + hh * 8) * 2);
                    acc = __builtin_amdgcn_mfma_f32_32x32x16_bf16(kf, qf[ks], acc, 0, 0, 0); }
                sc[kt] = acc; }
            float mloc = -3.0e38f;
#pragma unroll
            for (int kt = 0; kt < 5; ++kt) {
                if (kt == 0 || kt == 4 || n == 0) {
#pragma unroll
                    for (int r = 0; r < 16; ++r) { const int j = i0 + 32 * kt + (r & 3) + 8 * (r >> 2) + 4 * hh;
                        const bool valid = (j > iq) && (j <= iq + 128) && (n > 0 || j >= 128);
                        const float sv = valid ? sc[kt][r] * CS : -1.0e30f; sc[kt][r] = sv; mloc = fmaxf(mloc, sv); }
                } else {
#pragma unroll
                    for (int r = 0; r < 16; ++r) { const float sv = sc[kt][r] * CS; sc[kt][r] = sv; mloc = fmaxf(mloc, sv); }
                } }
            float mx = fmaxf(mloc, __shfl_xor(mloc, 32)); mx = fmaxf(mx, sinkl);
            float lsum = 0.f;
#pragma unroll
            for (int kt = 0; kt < 5; ++kt)
#pragma unroll
                for (int r = 0; r < 16; ++r) { const float p = __builtin_amdgcn_exp2f(sc[kt][r] - mx); sc[kt][r] = p; lsum += p; }
            lsum += __shfl_xor(lsum, 32); lsum += __builtin_amdgcn_exp2f(sinkl - mx);
            f32x16 o0, o1;
#pragma unroll
            for (int r = 0; r < 16; ++r) { o0[r] = 0.f; o1[r] = 0.f; }
#pragma unroll
            for (int kt = 0; kt < 5; ++kt)
#pragma unroll
                for (int s2 = 0; s2 < 2; ++s2) {
                    union { bf16x8_t v; unsigned u[4]; } pf;
#pragma unroll
                    for (int p = 0; p < 4; ++p) pf.u[p] = cvtpk(sc[kt][8 * s2 + 2 * p], sc[kt][8 * s2 + 2 * p + 1]);
                    const int jb = i0 + 32 * kt + 16 * s2 + 4 * hh;
                    union { bf16x8_t v; v2u u[2]; } v0, v1;
                    const LAS unsigned char* r0 = Vt + ql * VST + jb * 2; const LAS unsigned char* r1 = Vt + (32 + ql) * VST + jb * 2;
                    v0.u[0] = *(const LAS v2u*)(r0); v0.u[1] = *(const LAS v2u*)(r0 + 16);
                    v1.u[0] = *(const LAS v2u*)(r1); v1.u[1] = *(const LAS v2u*)(r1 + 16);
                    o0 = __builtin_amdgcn_mfma_f32_32x32x16_bf16(v0.v, pf.v, o0, 0, 0, 0);
                    o1 = __builtin_amdgcn_mfma_f32_32x32x16_bf16(v1.v, pf.v, o1, 0, 0, 0);
                }
            const float il = 1.f / lsum;
            bf16* op = mix + tq * DM + 512 + hq * 64 + 4 * hh;
#pragma unroll
            for (int rq = 0; rq < 4; ++rq) {
                v2u w0; w0.x = cvtpk(o0[4 * rq] * il, o0[4 * rq + 1] * il); w0.y = cvtpk(o0[4 * rq + 2] * il, o0[4 * rq + 3] * il);
                *(v2u*)(op + 8 * rq) = w0;
                v2u w1; w1.x = cvtpk(o1[4 * rq] * il, o1[4 * rq + 1] * il); w1.y = cvtpk(o1[4 * rq + 2] * il, o1[4 * rq + 3] * il);
                *(v2u*)(op + 32 + 8 * rq) = w1; }
        }
    }
}

__device__ __forceinline__ int frag_a_idx(int row, int col) { const int mt = row >> 4, l15 = row & 15, ks = col >> 5, x = col & 31, jh = x >> 4, g4 = (x >> 2) & 3, jl = x & 3; return ((mt * 2 + ks) * 64 + g4 * 16 + l15) * 8 + 4 * jh + jl; }
__device__ __forceinline__ int frag_c_idx(int row, int col) { const int w = col >> 4, l15 = col & 15, mt = row >> 4, y = row & 15, g4 = y >> 2, i = y & 3; return ((w * 64 + g4 * 16 + l15) * 4 + mt) * 4 + i; }
__device__ __forceinline__ void gdn_g1_naive(const Args& A, LAS float* L, int tid) {
    unsigned char* ws = A.ws;
    const bf16* proj = (const bf16*)(ws + WS_PROJ); const float* ab = (const float*)(ws + WS_AB);
    bf16* AP = (bf16*)(ws + WS_GAP); bf16* BP = (bf16*)(ws + WS_GBP); bf16* QP = (bf16*)(ws + WS_GQP); bf16* OP = (bf16*)(ws + WS_GOP); float* GL = (float*)(ws + WS_GGL);
    const float* convw = (const float*)A.in[I_CONVW];
    constexpr int LD = 65, AR = 64 * LD;
    LAS float* q = L; LAS float* k = q + AR; LAS float* v = k + AR; LAS float* Mm = v + AR; LAS float* At = Mm + AR; LAS float* w = At + AR;
    LAS float* Gc = w + AR; LAS float* beta = Gc + 64;
    const int i8 = tid >> 3, e0 = (tid & 7) * 8;
    for (int cid = blockIdx.x; cid < NB * 8 * 128; cid += gridDim.x) {
        const int n = cid & 127, bh = cid >> 7, b = bh >> 3, h = bh & 7;
        const float Ah = expf(((const float*)A.in[I_ALOG])[h]), dtb = ((const float*)A.in[I_DTB])[h];
        const int t0 = b * SEQ + n * 64;
        __syncthreads();
        for (int idx = tid; idx < 3 * 4096; idx += NTHR) {
            const int part = idx >> 12, rem = idx & 4095, i = rem >> 6, d = rem & 63, c = part * 512 + h * 64 + d;
            float y = 0.f;
#pragma unroll
            for (int j = 0; j < 4; ++j) { const int s = n * 64 + i - 3 + j; if (s >= 0) y += convw[j * 1536 + c] * bf2f(proj[(size_t)(b * SEQ + s) * NPROJ + c]); }
            y = y / (1.f + __expf(-y));
            (part == 0 ? q : (part == 1 ? k : v))[i * LD + d] = y;
        }
        if (tid < 64) { const float a = ab[(size_t)(t0 + tid) * 16 + h], bb = ab[(size_t)(t0 + tid) * 16 + 8 + h]; const float xx = a + dtb;
            const float sp = xx > 20.f ? xx : log1pf(expf(xx)); Gc[tid] = -Ah * sp; beta[tid] = 1.f / (1.f + __expf(-bb)); }
        __syncthreads();
        if (tid < 128) { LAS float* arr = tid < 64 ? q : k; const int i = tid & 63; float ss = 0.f;
            for (int d = 0; d < 64; ++d) ss += arr[i * LD + d] * arr[i * LD + d];
            const float r = (1.f / sqrtf(ss + EPS)) * (tid < 64 ? 0.125f : 1.f);
            for (int d = 0; d < 64; ++d) arr[i * LD + d] *= r; }
        if (tid == 128) { float run = 0.f; for (int i = 0; i < 64; ++i) { run += Gc[i]; Gc[i] = run; } }
        __syncthreads();
        {   const int i = i8;
            for (int jj = 0; jj < 8; ++jj) { const int j = e0 + jj; float dq = 0.f, dk = 0.f;
_Pragma("unroll 2") for (int d = 0; d < 64; ++d) { const float kj = k[j * LD + d]; dq += q[i * LD + d] * kj; dk += k[i * LD + d] * kj; }
                const float dec = (i >= j) ? __expf(Gc[i] - Gc[j]) : 0.f;
                At[i * LD + j] = dq * dec; Mm[i * LD + j] = (i > j) ? dk * beta[i] * dec : 0.f; }
        }
        __syncthreads();
        for (int idx = tid; idx < 4096; idx += NTHR) { const int i = idx >> 6, d = idx & 63; v[i * LD + d] *= beta[i]; w[i * LD + d] = k[i * LD + d] * beta[i] * __expf(Gc[i]); }
        __syncthreads();
        if (tid < 128) { LAS float* arr = tid < 64 ? v : w; const int c = tid & 63;
            _Pragma("unroll 1") for (int i = 1; i < 64; ++i) { float a = arr[i * LD + c]; _Pragma("unroll 4") for (int j = 0; j < i; ++j) a -= Mm[i * LD + j] * arr[j * LD + c]; arr[i * LD + c] = a; } }
        __syncthreads();
        const float gl = Gc[63];
        const size_t cb = (size_t)cid * 4096;
        {
            const int d = i8; float a[8], bq[8];
#pragma unroll
            for (int ee = 0; ee < 8; ++ee) { a[ee] = 0.f; bq[ee] = 0.f; }
_Pragma("unroll 2")
            for (int c = 0; c < 64; ++c) { const float kd = k[c * LD + d] * __expf(gl - Gc[c]);
#pragma unroll
                for (int ee = 0; ee < 8; ++ee) { a[ee] -= kd * w[c * LD + e0 + ee]; bq[ee] += kd * v[c * LD + e0 + ee]; } }
#pragma unroll
            for (int ee = 0; ee < 8; ++ee) { const int dp = e0 + ee; AP[cb + frag_a_idx(d, dp)] = (bf16)f2bf(a[ee]); BP[cb + frag_c_idx(d, dp)] = (bf16)f2bf(bq[ee]); }
        }
        {
            const int c = i8; float a[8], bq[8]; const float eg = __expf(Gc[c]);
#pragma unroll
            for (int ee = 0; ee < 8; ++ee) { a[ee] = eg * q[c * LD + e0 + ee]; bq[ee] = 0.f; }
_Pragma("unroll 2")
            for (int s2 = 0; s2 <= c; ++s2) { const float av = At[c * LD + s2];
#pragma unroll
                for (int ee = 0; ee < 8; ++ee) { a[ee] -= av * w[s2 * LD + e0 + ee]; bq[ee] += av * v[s2 * LD + e0 + ee]; } }
#pragma unroll
            for (int ee = 0; ee < 8; ++ee) { const int dp = e0 + ee; QP[cb + frag_a_idx(c, dp)] = (bf16)f2bf(a[ee]); OP[cb + frag_c_idx(c, dp)] = (bf16)f2bf(bq[ee]); }
        }
        if (tid == 0) GL[cid] = __expf(gl);
    }
}
__device__ __forceinline__ float wave_incl_scan_f(float v, int lane) {
#pragma unroll
    for (int o = 1; o < 64; o <<= 1) { const float t = __shfl_up(v, o); if (lane >= o) v += t; }
    return v;
}
__device__ __forceinline__ v2u pack4(f32x4 v) { v2u r; r.x = cvtpk(v.x, v.y); r.y = cvtpk(v.z, v.w); return r; }
__device__ __forceinline__ bf16x8_t mk8(v2u lo, v2u hi) { union { bf16x8_t v; unsigned u[4]; } x; x.u[0] = lo.x; x.u[1] = lo.y; x.u[2] = hi.x; x.u[3] = hi.y; return x.v; }
template <int SM, int STG = 7>
__device__ __forceinline__ void gdn_g1_mfma(const Args& A, LAS unsigned char* lds, int tid, int lane, int wave) {
    unsigned char* ws = A.ws;
    const bf16* proj = (const bf16*)(ws + WS_PROJ); const float* ab = (const float*)(ws + WS_AB);
    bf16* AP = (bf16*)(ws + WS_GAP); bf16* BP = (bf16*)(ws + WS_GBP); bf16* QP = (bf16*)(ws + WS_GQP); bf16* OP = (bf16*)(ws + WS_GOP); float* GL = (float*)(ws + WS_GGL);
    const float* convw = (const float*)A.in[I_CONVW];
    constexpr int KST = 144, RST = 68;
    LAS unsigned char* const Kr0 = lds;
    const int l15 = lane & 15, g4 = lane >> 4;
    const v2u zero2 = {0u, 0u};
    const int G = gridDim.x;
    const int ppart = wave >> 1, pt4 = 4 * ((wave & 1) * 8 + (lane >> 3)), pd0 = (lane & 7) * 8;
    v4u xr7[7];
#define G1_PREFETCH(IDX) do { if (wave < 6) { const int h_ = (IDX) & 7, bn_ = (IDX) >> 3, b_ = bn_ >> 7, n_ = bn_ & 127; \
        _Pragma("unroll") for (int r = 0; r < 7; ++r) { const int s_ = n_ * 64 + pt4 - 3 + r, sc_ = s_ < 0 ? 0 : s_; \
            const v4u r_ = *(const v4u*)(proj + (size_t)(b_ * SEQ + sc_) * NPROJ + ppart * 512 + h_ * 64 + pd0); const unsigned m_ = s_ < 0 ? 0u : 0xffffffffu; \
            xr7[r] = (v4u){r_.x & m_, r_.y & m_, r_.z & m_, r_.w & m_}; } } } while (0)
    int hcur = -1;
    constexpr int NC = NB * 8 * 128;
    if ((int)blockIdx.x < NC) G1_PREFETCH((int)blockIdx.x);
    for (int base = blockIdx.x; base < NC; base += 16 * G) {
    {
        LAS float* const GsT0 = (LAS float*)(Kr0 + 91648);
        __syncthreads();
        for (int q = wave; q < 16; q += 8) { const int idx2 = base + q * G;
            if (idx2 < NC) { const int h2 = idx2 & 7, bn2 = idx2 >> 3, b2 = bn2 >> 7, n2 = bn2 & 127;
                const size_t t2 = (size_t)(b2 * SEQ + n2 * 64 + lane) * 16;
                const float Ah = __expf(((const float*)A.in[I_ALOG])[h2]), dtb = ((const float*)A.in[I_DTB])[h2];
                const float xx = ab[t2 + h2] + dtb, bb2 = ab[t2 + 8 + h2];
                const float sp = xx > 20.f ? xx : log1pf(__expf(xx));
                const float Gv = wave_incl_scan_f(-Ah * sp, lane);
                GsT0[q * 64 + lane] = Gv; GsT0[1024 + q * 64 + lane] = 1.f / (1.f + __expf(-bb2));
                if ((SM & 16) && lane == 63) GL[(b2 * 8 + h2) * 128 + n2] = __expf(Gv); } }
    }
#pragma unroll 1
    for (int it = 0; it < 16; ++it) {
        const int idx = base + it * G; if (idx >= NC) break;
        const int h = idx & 7, bn = idx >> 3, b = bn >> 7, n = bn & 127, bh = b * 8 + h, cid = bh * 128 + n;
        const size_t cb = (size_t)cid * 4096;
        int oz = 0; asm volatile("" : "+v"(oz));
        LAS unsigned char* const Kr = Kr0 + oz; LAS unsigned char* const Qr = Kr + 9216; LAS unsigned char* const kdT = Kr + 18432; LAS unsigned char* const Mm = Kr + 27648; LAS unsigned char* const At = Kr + 36864;
        LAS float* const Rt = (LAS float*)(Kr + 46080);
        LAS float* const Md = (LAS float*)(Kr + 80896);
        LAS unsigned char* const Tl = Kr + 86016;
        LAS float* const Gs = (LAS float*)(Kr + 91648) + 64 * it; LAS float* const Bs = Gs + 1024;
        LAS float* const cwl = (LAS float*)(Kr + 88576);
        __syncthreads();
        if (h != hcur) { hcur = h; for (int q = tid; q < 768; q += NTHR) { const int part = q >> 8, j = (q >> 6) & 3, d = q & 63; cwl[q] = convw[j * 1536 + part * 512 + h * 64 + d]; } __syncthreads(); }
        const bool more = (idx + G < NC);
        if (wave < 6) {
            const int d0 = pd0, t4 = pt4, dg = d0 >> 3, swk = dg << 3, swr = (dg & 3) << 3;
            float y[4][8];
            {   float wv[4][8];
#pragma unroll
                for (int j = 0; j < 4; ++j) { const f32x4 w0 = *(const LAS f32x4*)(cwl + (ppart * 4 + j) * 64 + d0), w1 = *(const LAS f32x4*)(cwl + (ppart * 4 + j) * 64 + d0 + 4);
                    wv[j][0] = w0.x; wv[j][1] = w0.y; wv[j][2] = w0.z; wv[j][3] = w0.w; wv[j][4] = w1.x; wv[j][5] = w1.y; wv[j][6] = w1.z; wv[j][7] = w1.w; }
#define G1_XE(r, e) __builtin_bit_cast(float, ((e) & 1) ? (((e) >> 1) == 0 ? xr7[r].x : ((e) >> 1) == 1 ? xr7[r].y : ((e) >> 1) == 2 ? xr7[r].z : xr7[r].w) & 0xffff0000u \
                                                        : (((e) >> 1) == 0 ? xr7[r].x : ((e) >> 1) == 1 ? xr7[r].y : ((e) >> 1) == 2 ? xr7[r].z : xr7[r].w) << 16)
#pragma unroll
                for (int tk = 0; tk < 4; ++tk)
#pragma unroll
                    for (int e = 0; e < 8; ++e) { const float a_ = wv[0][e] * G1_XE(tk, e) + wv[1][e] * G1_XE(tk + 1, e) + wv[2][e] * G1_XE(tk + 2, e) + wv[3][e] * G1_XE(tk + 3, e);
                        y[tk][e] = a_ * __builtin_amdgcn_rcpf(1.f + __expf(-a_)); }
#undef G1_XE
            }
            if (more) G1_PREFETCH(idx + G);
            const f32x4 G4 = *(const LAS f32x4*)(Gs + t4), B4 = *(const LAS f32x4*)(Bs + t4); const float gl = Gs[63];
            if (ppart < 2) {
                float rn[4];
#pragma unroll
                for (int tk = 0; tk < 4; ++tk) { float ss = 0.f;
#pragma unroll
                    for (int e = 0; e < 8; ++e) ss += y[tk][e] * y[tk][e];
                    ss += __shfl_xor(ss, 1); ss += __shfl_xor(ss, 2); ss += __shfl_xor(ss, 4);
                    rn[tk] = (1.f / sqrtf(ss + EPS)) * (ppart == 0 ? 0.125f : 1.f); }
#pragma unroll
                for (int tk = 0; tk < 4; ++tk) {
#pragma unroll
                    for (int e = 0; e < 8; ++e) y[tk][e] *= rn[tk];
                    v4u pk; pk.x = cvtpk(y[tk][0], y[tk][1]); pk.y = cvtpk(y[tk][2], y[tk][3]); pk.z = cvtpk(y[tk][4], y[tk][5]); pk.w = cvtpk(y[tk][6], y[tk][7]);
                    *(LAS v4u*)((ppart == 0 ? Qr : Kr) + (t4 + tk) * KST + d0 * 2) = pk; }
                if (ppart == 1) {
                    const float ek0 = __expf(gl - G4.x), ek1 = __expf(gl - G4.y), ek2 = __expf(gl - G4.z), ek3 = __expf(gl - G4.w);
                    const float bg0 = B4.x * __expf(G4.x), bg1 = B4.y * __expf(G4.y), bg2 = B4.z * __expf(G4.z), bg3 = B4.w * __expf(G4.w);
#pragma unroll
                    for (int e = 0; e < 8; ++e) {
                        v2u kd; kd.x = cvtpk(y[0][e] * ek0, y[1][e] * ek1); kd.y = cvtpk(y[2][e] * ek2, y[3][e] * ek3);
                        *(LAS v2u*)(kdT + (d0 + e) * KST + (t4 ^ swk) * 2) = kd;
                        *(LAS f32x4*)(Rt + (d0 + e) * RST + (t4 ^ swr)) = (f32x4){y[0][e] * bg0, y[1][e] * bg1, y[2][e] * bg2, y[3][e] * bg3}; }
                }
            } else {
#pragma unroll
                for (int e = 0; e < 8; ++e) *(LAS f32x4*)(Rt + (64 + d0 + e) * RST + (t4 ^ swr)) = (f32x4){y[0][e] * B4.x, y[1][e] * B4.y, y[2][e] * B4.z, y[3][e] * B4.w};
            }
        }
        __syncthreads();
#define G1_TILE(which, ct, st) do { const LAS unsigned char* Xb_ = (which) ? Kr : Qr; const int c_ = 16 * (ct) + l15; const float Gc_ = Gs[c_], bc_ = Bs[c_]; \
            f32x4 acc_ = {0.f, 0.f, 0.f, 0.f}; \
            _Pragma("unroll") for (int ks = 0; ks < 2; ++ks) { const bf16x8_t bf_ = *(const LAS bf16x8_t*)(Xb_ + c_ * KST + (32 * ks + 8 * g4) * 2); \
                const bf16x8_t af_ = *(const LAS bf16x8_t*)(Kr + (16 * (st) + l15) * KST + (32 * ks + 8 * g4) * 2); acc_ = __builtin_amdgcn_mfma_f32_16x16x32_bf16(af_, bf_, acc_, 0, 0, 0); } \
            f32x4 vals_; \
            _Pragma("unroll") for (int r = 0; r < 4; ++r) { const int s2_ = 16 * (st) + 4 * g4 + r; const float dec_ = __expf(fminf(Gc_ - Gs[s2_], 0.f)); \
                vals_[r] = (which) ? ((s2_ < c_) ? -acc_[r] * bc_ * dec_ : 0.f) : ((s2_ <= c_) ? acc_[r] * dec_ : 0.f); } \
            *(LAS v2u*)(((which) ? Mm : At) + c_ * KST + (16 * (st) + 4 * g4) * 2) = pack4(vals_); \
            if ((which) && (st) == (ct)) *(LAS f32x4*)(Md + ((ct) * 16 + l15) * 20 + 4 * g4) = -vals_; } while (0)
        if constexpr (STG & 1) {
            const int ct = wave & 3, st0 = 2 * (wave >> 2);
            G1_TILE(1, ct, st0); G1_TILE(1, ct, st0 + 1);
        }
        __syncthreads();
        if constexpr (STG & 1) {
            if (wave != 0) { for (int tix = wave - 1; tix < 16; tix += 7) { const int ct = tix & 3, st = tix >> 2; G1_TILE(0, ct, st); } }
        }
        if ((STG & 2) && wave == 0) {
            float t[16];
#pragma unroll
            for (int r = 0; r < 16; ++r) { float acc = (r == l15) ? 1.f : 0.f;
#pragma unroll
                for (int s4 = 0; s4 < r; s4 += 4) { const f32x4 m = *(const LAS f32x4*)(Md + (g4 * 16 + r) * 20 + s4);
                    acc -= m.x * t[s4]; if (s4 + 1 < r) acc -= m.y * t[s4 + 1]; if (s4 + 2 < r) acc -= m.z * t[s4 + 2]; if (s4 + 3 < r) acc -= m.w * t[s4 + 3]; }
                t[r] = acc; }
#pragma unroll
            for (int r = 0; r < 16; ++r) *(LAS unsigned short*)(Tl + ((g4 * 16 + r) * 16 + l15) * 2) = (unsigned short)f2bf(t[r]);
        }
        __syncthreads();
        if constexpr (STG & 4) {
        f32x4 wt[4];
        {   const int colw = 16 * wave + l15;
#pragma unroll
            for (int i = 0; i < 4; ++i) {
                f32x4 acc = *(const LAS f32x4*)(Rt + colw * RST + ((16 * i + 4 * g4) ^ (((colw >> 3) & 3) << 3)));
                const LAS unsigned char* mrow = Mm + (16 * i + l15) * KST + (4 * g4) * 2;
                if (i >= 1) { const v2u alo = *(const LAS v2u*)(mrow), ahi = (i >= 2) ? *(const LAS v2u*)(mrow + 32) : zero2;
                    acc = __builtin_amdgcn_mfma_f32_16x16x32_bf16(mk8(alo, ahi), mk8(pack4(wt[0]), (i >= 2) ? pack4(wt[1]) : zero2), acc, 0, 0, 0); }
                if (i == 3) { const v2u alo = *(const LAS v2u*)(mrow + 64);
                    acc = __builtin_amdgcn_mfma_f32_16x16x32_bf16(mk8(alo, zero2), mk8(pack4(wt[2]), zero2), acc, 0, 0, 0); }
                const v2u tlo = *(const LAS v2u*)(Tl + ((i * 16 + l15) * 16 + 4 * g4) * 2);
                wt[i] = __builtin_amdgcn_mfma_f32_16x16x32_bf16(mk8(tlo, zero2), mk8(pack4(acc), zero2), (f32x4){0.f, 0.f, 0.f, 0.f}, 0, 0, 0);
            }
        }
        if (wave < 4) {
            bf16x8_t wn[2];
#pragma unroll
            for (int ks = 0; ks < 2; ++ks) { v2u lo = pack4(wt[2 * ks]), hi = pack4(wt[2 * ks + 1]); lo.x ^= 0x80008000u; lo.y ^= 0x80008000u; hi.x ^= 0x80008000u; hi.y ^= 0x80008000u; wn[ks] = mk8(lo, hi); }
#pragma unroll
            for (int nt = 0; nt < 4; ++nt) { const int x = 16 * nt + l15;
                f32x4 ca = {0.f, 0.f, 0.f, 0.f};
                const v2u qraw = *(const LAS v2u*)(Qr + x * KST + (16 * wave + 4 * g4) * 2); const float eg = __expf(Gs[x]);
                f32x4 cq; cq.x = eg * __builtin_bit_cast(float, qraw.x << 16); cq.y = eg * __builtin_bit_cast(float, qraw.x & 0xffff0000u); cq.z = eg * __builtin_bit_cast(float, qraw.y << 16); cq.w = eg * __builtin_bit_cast(float, qraw.y & 0xffff0000u);
#pragma unroll
                for (int ks = 0; ks < 2; ++ks) { const int xs = (x >> 3) << 3; const LAS unsigned char* kp0 = kdT + x * KST + ((32 * ks + 4 * g4) ^ xs) * 2; const LAS unsigned char* kp1 = kdT + x * KST + ((32 * ks + 16 + 4 * g4) ^ xs) * 2; const LAS unsigned char* ap = At + x * KST + (32 * ks + 4 * g4) * 2;
                    ca = __builtin_amdgcn_mfma_f32_16x16x32_bf16(wn[ks], mk8(*(const LAS v2u*)(kp0), *(const LAS v2u*)(kp1)), ca, 0, 0, 0);
                    cq = __builtin_amdgcn_mfma_f32_16x16x32_bf16(wn[ks], mk8(*(const LAS v2u*)(ap), *(const LAS v2u*)(ap + 32)), cq, 0, 0, 0); }
                const size_t off = cb + (size_t)((nt * 2 + (wave >> 1)) * 64 + lane) * 8 + 4 * (wave & 1);
                if (SM & 1) *(v2u*)(AP + off) = pack4(ca); if (SM & 2) *(v2u*)(QP + off) = pack4(cq);
            }
        } else {
            bf16x8_t ub[2];
#pragma unroll
            for (int ks = 0; ks < 2; ++ks) ub[ks] = mk8(pack4(wt[2 * ks]), pack4(wt[2 * ks + 1]));
            unsigned bo[8], oo[8];
#pragma unroll
            for (int mt = 0; mt < 4; ++mt) { const int x = 16 * mt + l15;
                f32x4 cbv = {0.f, 0.f, 0.f, 0.f}, co = {0.f, 0.f, 0.f, 0.f};
#pragma unroll
                for (int ks = 0; ks < 2; ++ks) { const int xs = (x >> 3) << 3; const LAS unsigned char* kp0 = kdT + x * KST + ((32 * ks + 4 * g4) ^ xs) * 2; const LAS unsigned char* kp1 = kdT + x * KST + ((32 * ks + 16 + 4 * g4) ^ xs) * 2; const LAS unsigned char* ap = At + x * KST + (32 * ks + 4 * g4) * 2;
                    cbv = __builtin_amdgcn_mfma_f32_16x16x32_bf16(mk8(*(const LAS v2u*)(kp0), *(const LAS v2u*)(kp1)), ub[ks], cbv, 0, 0, 0);
                    co = __builtin_amdgcn_mfma_f32_16x16x32_bf16(mk8(*(const LAS v2u*)(ap), *(const LAS v2u*)(ap + 32)), ub[ks], co, 0, 0, 0); }
                const v2u pb = pack4(cbv), po = pack4(co); bo[2 * mt] = pb.x; bo[2 * mt + 1] = pb.y; oo[2 * mt] = po.x; oo[2 * mt + 1] = po.y; }
            const size_t off = cb + (size_t)((wave - 4) * 64 + lane) * 16;
            if (SM & 4) { *(v4u*)(BP + off) = (v4u){bo[0], bo[1], bo[2], bo[3]}; *(v4u*)(BP + off + 8) = (v4u){bo[4], bo[5], bo[6], bo[7]}; }
            if (SM & 8) { *(v4u*)(OP + off) = (v4u){oo[0], oo[1], oo[2], oo[3]}; *(v4u*)(OP + off + 8) = (v4u){oo[4], oo[5], oo[6], oo[7]}; }
        }
        }
    }
    }
#undef G1_TILE
#undef G1_PREFETCH
}

__device__ __forceinline__ f32x4 g2_unpack(const v4u (&p)[2], int mt) {
    const unsigned d0 = mt == 0 ? p[0].x : mt == 1 ? p[0].z : mt == 2 ? p[1].x : p[1].z, d1 = mt == 0 ? p[0].y : mt == 1 ? p[0].w : mt == 2 ? p[1].y : p[1].w;
    f32x4 r; r.x = __builtin_bit_cast(float, d0 << 16); r.y = __builtin_bit_cast(float, d0 & 0xffff0000u); r.z = __builtin_bit_cast(float, d1 << 16); r.w = __builtin_bit_cast(float, d1 & 0xffff0000u); return r;
}
template <int VAR = 0>
__device__ __forceinline__ void gdn_scan(const Args& A, int bh, LAS unsigned char* lds, int tid, int lane, int wave) {
    unsigned char* ws = A.ws;
    const char* AP = (const char*)(ws + WS_GAP); const char* BP = (const char*)(ws + WS_GBP); const float* GL = (const float*)(ws + WS_GGL); bf16* SF = (bf16*)(ws + WS_GSF);
    constexpr int SLOT = 16384, NSL = 8, EGL_OFF = NSL * SLOT;
    LAS float* eglt = (LAS float*)(lds + EGL_OFF);
    __syncthreads();
    { int tl = tid; asm volatile("" : "+v"(tl));
      if (tl < 128) eglt[tl] = GL[bh * 128 + tl]; }
    if (wave < 4) {
        f32x4 sC[4]; bf16x8_t sB[2];
#pragma unroll
        for (int mt = 0; mt < 4; ++mt) sC[mt] = (f32x4){0.f, 0.f, 0.f, 0.f};
#pragma unroll
        for (int ks = 0; ks < 2; ++ks)
#pragma unroll
            for (int j = 0; j < 8; ++j) sB[ks][j] = 0;
        asm volatile("s_waitcnt vmcnt(0) lgkmcnt(0)" ::: "memory");
        __builtin_amdgcn_s_barrier();
        struct SSet { bf16x8_t fa[4][2]; v4u fb[2]; float egl; };
#define SC_LOAD(S, n) do { const int n_ = (n) < SEQ / 64 ? (n) : SEQ / 64 - 1; const LAS unsigned char* slot_ = lds + (n_ & (NSL - 1)) * SLOT; \
            _Pragma("unroll") for (int mt = 0; mt < 4; ++mt) _Pragma("unroll") for (int ks = 0; ks < 2; ++ks) S.fa[mt][ks] = *(const LAS bf16x8_t*)(slot_ + ((mt * 2 + ks) * 64 + lane) * 16); \
            S.fb[0] = *(const LAS v4u*)(slot_ + 8192 + (wave * 64 + lane) * 32); S.fb[1] = *(const LAS v4u*)(slot_ + 8192 + (wave * 64 + lane) * 32 + 16); S.egl = eglt[n_]; } while (0)
#define SC_STEP(S, n) do { bf16* sf = SF + (size_t)(bh * 128 + (n)) * 4096 + (size_t)((wave * 2) * 64 + lane) * 8; \
            *(bf16x8_t*)(sf) = sB[0]; *(bf16x8_t*)(sf + 512) = sB[1]; \
            f32x4 sacc[4]; \
            _Pragma("unroll") for (int mt = 0; mt < 4; ++mt) sacc[mt] = sC[mt] * S.egl + g2_unpack(S.fb, mt); \
            _Pragma("unroll") for (int mt = 0; mt < 4; ++mt) _Pragma("unroll") for (int ks = 0; ks < 2; ++ks) sacc[mt] = __builtin_amdgcn_mfma_f32_16x16x32_bf16(S.fa[mt][ks], sB[ks], sacc[mt], 0, 0, 0); \
            _Pragma("unroll") for (int mt = 0; mt < 4; ++mt) sC[mt] = sacc[mt]; \
            _Pragma("unroll") for (int ks = 0; ks < 2; ++ks) { union { bf16x8_t v; unsigned u[4]; } pk_; \
                pk_.u[0] = cvtpk(sC[2 * ks].x, sC[2 * ks].y); pk_.u[1] = cvtpk(sC[2 * ks].z, sC[2 * ks].w); pk_.u[2] = cvtpk(sC[2 * ks + 1].x, sC[2 * ks + 1].y); pk_.u[3] = cvtpk(sC[2 * ks + 1].z, sC[2 * ks + 1].w); sB[ks] = pk_.v; } \
            asm volatile("s_waitcnt lgkmcnt(0)" ::: "memory"); \
            __builtin_amdgcn_s_barrier(); } while (0)
        SSet s0;
#pragma unroll 1
        for (int n = 0; n < SEQ / 64; ++n) {
            if (VAR == 2) { asm volatile("s_waitcnt lgkmcnt(0)" ::: "memory"); __builtin_amdgcn_s_barrier(); continue; }
            SC_LOAD(s0, n);
            SC_STEP(s0, n);
        }
#undef SC_LOAD
#undef SC_STEP
    } else {
        const int f = wave - 4;
        const unsigned lin = (unsigned)(2 * f) * 1024u + (unsigned)lane * 16u;
#define G2_DMA(nn) do { const int n_ = (nn) < SEQ / 64 ? (nn) : SEQ / 64 - 1; const size_t cb_ = (size_t)(bh * 128 + n_) * 8192; LAS unsigned char* d_ = lds + ((nn) & (NSL - 1)) * SLOT + (2 * f) * 1024; \
        __builtin_amdgcn_global_load_lds((const unsigned*)(AP + cb_ + lin), (LAS unsigned*)(d_), 16, 0, 0); __builtin_amdgcn_global_load_lds((const unsigned*)(AP + cb_ + lin + 1024), (LAS unsigned*)(d_ + 1024), 16, 0, 0); \
        __builtin_amdgcn_global_load_lds((const unsigned*)(BP + cb_ + lin), (LAS unsigned*)(d_ + 8192), 16, 0, 0); __builtin_amdgcn_global_load_lds((const unsigned*)(BP + cb_ + lin + 1024), (LAS unsigned*)(d_ + 8192 + 1024), 16, 0, 0); } while (0)
        asm volatile("s_waitcnt vmcnt(0) lgkmcnt(0)" ::: "memory");
        G2_DMA(0); G2_DMA(1); G2_DMA(2); G2_DMA(3); G2_DMA(4); G2_DMA(5); G2_DMA(6);
        asm volatile("s_waitcnt vmcnt(24)" ::: "memory");
        __builtin_amdgcn_s_barrier();
#pragma unroll 1
        for (int n = 0; n < SEQ / 64; ++n) {
            if (VAR != 1) G2_DMA(n + 7);
            asm volatile("s_waitcnt vmcnt(24)" ::: "memory");
            __builtin_amdgcn_s_barrier();
        }
#undef G2_DMA
        asm volatile("s_waitcnt vmcnt(0)" ::: "memory");
    }
    __syncthreads();
}
__device__ __forceinline__ void gdn_out(const Args& A, LAS unsigned char* lds, int lane, int wave) {
    unsigned char* ws = A.ws;
    const bf16* proj = (const bf16*)(ws + WS_PROJ); bf16* mix = (bf16*)(ws + WS_MIX);
    const bf16* QP = (const bf16*)(ws + WS_GQP); const bf16* OP = (const bf16*)(ws + WS_GOP); const bf16* SF = (const bf16*)(ws + WS_GSF);
    const float* onorm = (const float*)A.in[I_GNORM];
    const int mt = wave & 3, l15 = lane & 15, g4 = lane >> 4, rr = lane >> 2, q4 = lane & 3;
    constexpr int OST = 68;
    LAS float* ot = (LAS float*)(lds + wave * 4608);
    float gain[16];
#pragma unroll
    for (int k = 0; k < 16; ++k) gain[k] = onorm[16 * q4 + k];
    struct OSet { bf16x8_t qa[2], sb[4][2]; v2u oi[4]; v4u z0, z1; };
#define GO_LOAD(S, CID) do { const int n_ = (CID) & 127, bh_ = (CID) >> 7, b_ = bh_ >> 3, h_ = bh_ & 7; const size_t cb_ = (size_t)(CID) * 4096; \
        const size_t t_ = (size_t)b_ * SEQ + n_ * 64 + 16 * mt + rr; \
        S.z0 = *(const v4u*)(proj + t_ * NPROJ + PC_Z + h_ * 64 + 16 * q4); S.z1 = *(const v4u*)(proj + t_ * NPROJ + PC_Z + h_ * 64 + 16 * q4 + 8); \
        _Pragma("unroll") for (int ks = 0; ks < 2; ++ks) S.qa[ks] = *(const bf16x8_t*)(QP + cb_ + ((mt * 2 + ks) * 64 + lane) * 8); \
        _Pragma("unroll") for (int nt = 0; nt < 4; ++nt) { _Pragma("unroll") for (int ks = 0; ks < 2; ++ks) S.sb[nt][ks] = *(const bf16x8_t*)(SF + cb_ + ((nt * 2 + ks) * 64 + lane) * 8); \
            S.oi[nt] = *(const v2u*)(OP + cb_ + ((nt * 64 + lane) * 4 + mt) * 4); } } while (0)
#define GO_STEP(S, CID) do { const int n_ = (CID) & 127, bh_ = (CID) >> 7, b_ = bh_ >> 3, h_ = bh_ & 7; const size_t t_ = (size_t)b_ * SEQ + n_ * 64 + 16 * mt + rr; \
        _Pragma("unroll") for (int nt = 0; nt < 4; ++nt) { \
            f32x4 acc; acc.x = __builtin_bit_cast(float, S.oi[nt].x << 16); acc.y = __builtin_bit_cast(float, S.oi[nt].x & 0xffff0000u); acc.z = __builtin_bit_cast(float, S.oi[nt].y << 16); acc.w = __builtin_bit_cast(float, S.oi[nt].y & 0xffff0000u); \
            _Pragma("unroll") for (int ks = 0; ks < 2; ++ks) acc = __builtin_amdgcn_mfma_f32_16x16x32_bf16(S.qa[ks], S.sb[nt][ks], acc, 0, 0, 0); \
            _Pragma("unroll") for (int i = 0; i < 4; ++i) ot[(4 * g4 + i) * OST + 16 * nt + l15] = acc[i]; } \
        LDS_WAIT(); asm volatile("" ::: "memory"); \
        float o[16]; float ss = 0.f; \
        _Pragma("unroll") for (int k = 0; k < 4; ++k) { const f32x4 v = *(const LAS f32x4*)(ot + rr * OST + 16 * q4 + 4 * k); o[4 * k] = v.x; o[4 * k + 1] = v.y; o[4 * k + 2] = v.z; o[4 * k + 3] = v.w; } \
        _Pragma("unroll") for (int k = 0; k < 16; ++k) ss += o[k] * o[k]; \
        ss += __shfl_xor(ss, 1); ss += __shfl_xor(ss, 2); \
        const float r = 1.f / sqrtf(ss * (1.f / 64.f) + EPS); \
        const unsigned zu[8] = {S.z0.x, S.z0.y, S.z0.z, S.z0.w, S.z1.x, S.z1.y, S.z1.z, S.z1.w}; \
        unsigned ou[8]; \
        _Pragma("unroll") for (int k = 0; k < 8; ++k) { const float za = __builtin_bit_cast(float, zu[k] << 16), zb = __builtin_bit_cast(float, zu[k] & 0xffff0000u); \
            ou[k] = cvtpk(o[2 * k] * r * gain[2 * k] * siluf(za), o[2 * k + 1] * r * gain[2 * k + 1] * siluf(zb)); } \
        bf16* op = mix + t_ * DM + h_ * 64 + 16 * q4; \
        *(v4u*)(op) = (v4u){ou[0], ou[1], ou[2], ou[3]}; *(v4u*)(op + 8) = (v4u){ou[4], ou[5], ou[6], ou[7]}; \
        LDS_WAIT(); asm volatile("" ::: "memory"); } while (0)
    const int NC = NB * 8 * 128, st = gridDim.x * 2;
    int cid = blockIdx.x * 2 + (wave >> 2);
    OSet s0, s1, s2;
    if (cid < NC) GO_LOAD(s0, cid);
    if (cid + st < NC) GO_LOAD(s1, cid + st);
#pragma unroll 1
    for (; cid < NC; cid += 3 * st) {
        if (cid + 2 * st < NC) GO_LOAD(s2, cid + 2 * st);
        GO_STEP(s0, cid);
        if (cid + st < NC) { if (cid + 3 * st < NC) GO_LOAD(s0, cid + 3 * st); GO_STEP(s1, cid + st); }
        if (cid + 2 * st < NC) { if (cid + 4 * st < NC) GO_LOAD(s1, cid + 4 * st); GO_STEP(s2, cid + 2 * st); }
    }
#undef GO_LOAD
#undef GO_STEP
}

template <bool DRY, int VAR = 0>
__device__ __forceinline__ void norm_route_mfma(const Args& A, const float* X, const float* ssqp, const float* gain, const float* shift, const float* scale, bf16* H, LAS unsigned char* lds, int tid, int lane, int wave) {
    unsigned char* ws = A.ws;
    const int G = gridDim.x;
    const int l15 = lane & 15, g4 = lane >> 4;
    LAS unsigned char* wfl = lds;
    LAS float* mfl = (LAS float*)(lds + 98304); LAS float* afl = mfl + 1024;
    LAS float* lgs = (LAS float*)(lds + 98304 + 8192 + wave * 3328);
    const float* bg = (const float*)A.in[I_BGRP]; const float* br = (const float*)A.in[I_BRT];
#define P7_LOADW(half) do { const v4u* src_ = (const v4u*)(ws + WS_WRT); \
        for (int q = tid; q < 3072; q += NTHR) { const int nt_ = q >> 10, r_ = q & 1023; const int g_ = (nt_ * 32 + 16 * (half)) * 64 + r_; \
            *(LAS v4u*)(wfl + q * 16) = src_[g_]; *(LAS v4u*)(wfl + 49152 + q * 16) = src_[6144 + g_]; } } while (0)
    int bcur = -1;
    for (int rb = blockIdx.x * 128; rb < TT; rb += G * 128) {
        const int b = rb / SEQ, r0 = rb + wave * 16, row = r0 + l15;
        if (b != bcur) { bcur = b; __syncthreads();
            for (int q = tid; q < 1024; q += NTHR) { mfl[q] = gain[q] * (scale[b * 6144 + q] + 1.0f); afl[q] = shift[b * 6144 + q]; }
            __syncthreads(); }
        const float* xr = X + (size_t)row * DM + 8 * g4;
        float ss;
        {   const f32x4 p4 = *(const f32x4*)(ssqp + (size_t)row * 16 + 4 * g4); ss = (p4.x + p4.y) + (p4.z + p4.w); }
        ss += __shfl_xor(ss, 16); ss += __shfl_xor(ss, 32);
        const float rstd = 1.f / sqrtf(ss * (1.f / DM) + EPS);
        f32x4 acc[3];
#pragma unroll
        for (int nt = 0; nt < 3; ++nt) acc[nt] = (f32x4){0.f, 0.f, 0.f, 0.f};
        bf16* hrow = H + (size_t)row * DM + 8 * g4;
#pragma unroll 1
        for (int half = 0; half < 2; ++half) {
        __syncthreads(); P7_LOADW(half); __syncthreads();
#pragma unroll 8
        for (int ks = 16 * half; ks < 16 * half + 16; ++ks) {
            float hv[8];
            {   const f32x4 a = *(const f32x4*)(xr + 32 * ks), c = *(const f32x4*)(xr + 32 * ks + 4);
                const f32x4 m0 = *(const LAS f32x4*)(mfl + 32 * ks + 8 * g4), m1 = *(const LAS f32x4*)(mfl + 32 * ks + 8 * g4 + 4), h0 = *(const LAS f32x4*)(afl + 32 * ks + 8 * g4), h1 = *(const LAS f32x4*)(afl + 32 * ks + 8 * g4 + 4);
                const f32x4 v0 = a * rstd * m0 + h0, v1 = c * rstd * m1 + h1;
                hv[0] = v0.x; hv[1] = v0.y; hv[2] = v0.z; hv[3] = v0.w; hv[4] = v1.x; hv[5] = v1.y; hv[6] = v1.z; hv[7] = v1.w; }
            unsigned hu[4], lu[4];
#pragma unroll
            for (int p = 0; p < 4; ++p) { hu[p] = cvtpk(hv[2 * p], hv[2 * p + 1]);
                const float ra = hv[2 * p] - __builtin_bit_cast(float, hu[p] << 16), rb2 = hv[2 * p + 1] - __builtin_bit_cast(float, hu[p] & 0xffff0000u); lu[p] = cvtpk(ra, rb2); }
            *(v4u*)(hrow + 32 * ks) = (v4u){hu[0], hu[1], hu[2], hu[3]};
            union { bf16x8_t v; unsigned u[4]; } ah, al; ah.u[0] = hu[0]; ah.u[1] = hu[1]; ah.u[2] = hu[2]; ah.u[3] = hu[3]; al.u[0] = lu[0]; al.u[1] = lu[1]; al.u[2] = lu[2]; al.u[3] = lu[3];
#pragma unroll
            for (int nt = 0; nt < 3; ++nt) { const int fo = ((nt * 16 + (ks & 15)) * 64 + lane) * 16;
                const bf16x8_t bh = *(const LAS bf16x8_t*)(wfl + fo), bl = *(const LAS bf16x8_t*)(wfl + 49152 + fo);
                acc[nt] = __builtin_amdgcn_mfma_f32_16x16x32_bf16(ah.v, bh, acc[nt], 0, 0, 0);
                acc[nt] = __builtin_amdgcn_mfma_f32_16x16x32_bf16(ah.v, bl, acc[nt], 0, 0, 0);
                acc[nt] = __builtin_amdgcn_mfma_f32_16x16x32_bf16(al.v, bh, acc[nt], 0, 0, 0); }
        }
        }
#pragma unroll
        for (int nt = 0; nt < 3; ++nt)
#pragma unroll
            for (int r = 0; r < 4; ++r) lgs[(4 * g4 + r) * 52 + 16 * nt + l15] = acc[nt][r];
        LDS_WAIT(); asm volatile("" ::: "memory");
        if (lane < 16) {
            float lg[36];
#pragma unroll
            for (int q = 0; q < 9; ++q) { const f32x4 v = *(const LAS f32x4*)(lgs + lane * 52 + 4 * q); lg[4 * q] = v.x; lg[4 * q + 1] = v.y; lg[4 * q + 2] = v.z; lg[4 * q + 3] = v.w; }
#pragma unroll
            for (int o = 0; o < 4; ++o) lg[o] += bg[o];
#pragma unroll
            for (int o = 0; o < 32; ++o) lg[4 + o] += br[o];
            int gi = 0; float gm = lg[0];
#pragma unroll
            for (int o = 1; o < 4; ++o) if (lg[o] > gm) { gm = lg[o]; gi = o; }
            float gs = 0.f;
#pragma unroll
            for (int o = 0; o < 4; ++o) gs += __expf(lg[o] - gm);
            const float pg = 1.f / gs;
            float le[8];
#pragma unroll
            for (int j = 0; j < 8; ++j) { le[j] = lg[4 + j];
#pragma unroll
                for (int g = 1; g < 4; ++g) le[j] = (gi == g) ? lg[4 + g * 8 + j] : le[j]; }
            int j1 = 0; float m1 = le[0];
#pragma unroll
            for (int j = 1; j < 8; ++j) if (le[j] > m1) { m1 = le[j]; j1 = j; }
            int j2 = -1; float m2 = -3.0e38f;
#pragma unroll
            for (int j = 0; j < 8; ++j) if (j != j1 && le[j] > m2) { m2 = le[j]; j2 = j; }
            const float ex = __expf(m2 - m1), w1 = pg / (1.f + ex), w2 = pg * ex / (1.f + ex);
            const int e1 = gi * 8 + j1, e2 = gi * 8 + j2, rw = r0 + lane;
            unsigned* ctl = (unsigned*)(ws + WS_CTL);
            int2* erec = (int2*)(ws + WS_EREC); int* clist = (int*)(ws + WS_CLIST);
            if constexpr (DRY) { ((int2*)(ws + WS_PROJ + 168 * MiB))[rw] = make_int2(e1 * 64 + e2, __builtin_bit_cast(int, w1 + w2)); } else {
            const unsigned p1 = atomicAdd(ctl + CW_ECNT + e1, 1u); erec[(size_t)e1 * TT + p1] = make_int2(rw * 2 + (e1 > e2 ? 1 : 0), __builtin_bit_cast(int, w1));
            const unsigned p2 = atomicAdd(ctl + CW_ECNT + e2, 1u); erec[(size_t)e2 * TT + p2] = make_int2(rw * 2 + (e2 > e1 ? 1 : 0), __builtin_bit_cast(int, w2));
            const int a = j1 < j2 ? j1 : j2, bb = j1 < j2 ? j2 : j1;
            const int cls = gi * 28 + (a * 7 - (a * (a - 1)) / 2 + (bb - a - 1));
            const unsigned pc = atomicAdd(ctl + CW_CCNT + cls, 1u); clist[(size_t)cls * TT + pc] = rw; }
        }
        LDS_WAIT(); asm volatile("" ::: "memory");
    }
#undef P7_LOADW
}

__device__ __forceinline__ int wave_incl_scan(int v, int lane) {
#pragma unroll
    for (int o = 1; o < 64; o <<= 1) { const int t = __shfl_up(v, o); if (lane >= o) v += t; }
    return v;
}
template <int NOPART = 0>
struct SchedET {
    int G, c, cntv, preF, preP, totF, totP; const int2* rec; const char* W;
    __device__ __forceinline__ void init(const unsigned* cnt, const int2* rec_, const char* W_, int G_, int c_, int lane) {
        G = G_; c = c_; rec = rec_; W = W_;
        cntv = lane < NE ? (int)cnt[lane] : 0;
        const int incF = wave_incl_scan(cntv >> 8, lane), incP = wave_incl_scan((cntv & 255) ? 1 : 0, lane);
        totF = __builtin_amdgcn_readlane(incF, 63); totP = NOPART ? 0 : __builtin_amdgcn_readlane(incP, 63);
        preF = lane < NE ? incF : 0x7fffffff; preP = lane < NE ? incP : 0x7fffffff;
    }
    __device__ __forceinline__ bool next(int i, pg8::UnitG& u) const {
        const int L = i * G + c; if (L >= 2 * (totF + totP)) return false;
        if (L < 2 * totF) { const int ft = L >> 1;
            const int e = __builtin_amdgcn_readfirstlane(__popcll(__ballot(preF <= ft)));
            const int base = e ? __builtin_amdgcn_readlane(preF, e - 1) : 0;
            u.id = e; u.tile = ft - base; u.pn = L & 1; u.nrows = 256;
        } else { const int p = (L - 2 * totF) >> 1;
            const int e = __builtin_amdgcn_readfirstlane(__popcll(__ballot(preP <= p)));
            const int cnt = __builtin_amdgcn_readlane(cntv, e);
            u.id = e; u.tile = cnt >> 8; u.pn = L & 1; u.nrows = cnt & 255; }
        return true;
    }
    __device__ __forceinline__ int tok(const pg8::UnitG& u, int r) const { return r < u.nrows ? (rec[(size_t)u.id * TT + u.tile * 256 + r].x >> 1) : 0; }
    __device__ __forceinline__ const char* bseg(const pg8::UnitG& u, int) const { return W + ((size_t)u.id * 512 + u.pn * 256) * 2048; }
};
typedef SchedET<0> SchedE;
struct EpiGU {
    static constexpr bool PERM = true, PREFETCH = false;
    bf16* HID;
    template <class SC> __device__ __forceinline__ void operator()(const pg8::f32x4 (&acc)[2][2][4][2], const pg8::UnitG& u, const SC& S, int wr, int wc, int fr, int fq) const {
#pragma unroll
        for (int ai = 0; ai < 2; ++ai)
#pragma unroll
            for (int m = 0; m < 4; ++m) { const int r = ai * 128 + wr * 64 + m * 16 + fr;
                if (r < u.nrows) { const int2 rc = S.rec[(size_t)u.id * TT + u.tile * 256 + r]; const int t = rc.x >> 1, half = rc.x & 1; const float w = __builtin_bit_cast(float, rc.y);
                    float hv[8];
#pragma unroll
                    for (int n = 0; n < 2; ++n)
#pragma unroll
                        for (int j = 0; j < 4; ++j) { const float g = acc[ai][0][m][n][j], up = acc[ai][1][m][n][j]; hv[n * 4 + j] = w * siluf(g) * up; }
                    v4u o; o.x = pk2(hv[0], hv[1]); o.y = pk2(hv[2], hv[3]); o.z = pk2(hv[4], hv[5]); o.w = pk2(hv[6], hv[7]);
                    *(v4u*)(HID + (size_t)t * 512 + half * 256 + u.pn * 128 + wc * 32 + 8 * fq) = o; } }
    }
};
struct SchedC {
    int G, c, cntA, cntB, preA, preB, total_rt; const int* clist; const char* W;
    __device__ __forceinline__ void init(const unsigned* cnt, const int* clist_, const char* W_, int G_, int c_, int lane) {
        G = G_; c = c_; clist = clist_; W = W_;
        cntA = (int)cnt[lane]; cntB = lane < NCLS - 64 ? (int)cnt[64 + lane] : 0;
        const int ia = wave_incl_scan((cntA + 255) >> 8, lane); const int ta = __builtin_amdgcn_readlane(ia, 63);
        const int ib = wave_incl_scan((cntB + 255) >> 8, lane) + ta;
        total_rt = __builtin_amdgcn_readlane(ib, 63);
        preA = ia; preB = lane < NCLS - 64 ? ib : 0x7fffffff;
    }
    __device__ __forceinline__ bool next(int i, pg8::UnitG& u) const {
        const int L = i * G + c; if (L >= 4 * total_rt) return false;
        const int rt = L >> 2;
        const int cls = __builtin_amdgcn_readfirstlane(__popcll(__ballot(preA <= rt)) + __popcll(__ballot(preB <= rt)));
        int base = 0; if (cls > 0) base = (cls - 1 < 64) ? __builtin_amdgcn_readlane(preA, cls - 1) : __builtin_amdgcn_readlane(preB, cls - 65);
        const int cnt = cls < 64 ? __builtin_amdgcn_readlane(cntA, cls) : __builtin_amdgcn_readlane(cntB, cls - 64);
        u.id = cls; u.tile = rt - base; u.pn = L & 3; const int rem = cnt - u.tile * 256; u.nrows = rem < 256 ? rem : 256;
        return true;
    }
    __device__ __forceinline__ int tok(const pg8::UnitG& u, int r) const { return r < u.nrows ? clist[(size_t)u.id * TT + u.tile * 256 + r] : 0; }
    __device__ __forceinline__ const char* bseg(const pg8::UnitG& u, int seg) const {
        const int g = u.id / 28; int a = 0, rem = u.id % 28; while (rem >= 7 - a) { rem -= 7 - a; ++a; } const int b = a + 1 + rem;
        const int e = g * 8 + (seg ? b : a);
        return W + ((size_t)e * 1024 + u.pn * 256) * 512;
    }
};
template <int VAR = 0>
struct EpiDownT {
    static constexpr bool PERM = false, PREFETCH = false;
    float* OUT; const float* gate2;
    const LAS unsigned char* gt;
    template <class SC> __device__ __forceinline__ void prefetch(LAS unsigned char* lds, const pg8::UnitG& u, const SC& S, int tid) const {
#pragma unroll
        for (int i = 0; i < 4; ++i) { const int r = (tid >> 3) + 64 * i; const int t = S.tok(u, r);
            __builtin_amdgcn_global_load_lds((const unsigned*)((const char*)OUT + (size_t)t * 4096 + (size_t)u.pn * 1024 + (size_t)(tid & 7) * 128), (LAS unsigned*)(lds + pg8::STAGE_BYTES + 256), 4, 0, 0); }
    }
    template <class SC> __device__ __forceinline__ void operator()(const pg8::f32x4 (&acc)[2][2][4][2], const pg8::UnitG& u, const SC& S, int wr, int wc, int fr, int fq) const {
#pragma unroll
        for (int ai = 0; ai < 2; ++ai)
#pragma unroll
            for (int m = 0; m < 4; ++m) { const int r = ai * 128 + wr * 64 + m * 16 + fr;
                if (r < u.nrows) { const int t = S.clist[(size_t)u.id * TT + u.tile * 256 + r]; const int b = t / SEQ; const int col0 = u.pn * 256 + wc * 32 + 4 * fq;
                    float* op = OUT + (size_t)t * DM + col0; const float* gp = gate2 + b * 6144 + col0;
#pragma unroll
                    for (int bj = 0; bj < 2; ++bj)
#pragma unroll
                        for (int n = 0; n < 2; ++n) { const int off = bj * 128 + n * 16; const f32x4 xv = (VAR == 1) ? (f32x4){1.f, 1.f, 1.f, 1.f} : *(const f32x4*)(op + off);
                            f32x4 gv;
                            if (VAR == 2) gv = (f32x4){1.f, 1.f, 1.f, 1.f};
                            else if (gt) { const v2u g2 = *(const LAS v2u*)(gt + (b * 1024 + col0 + off) * 2);
                                gv.x = __builtin_bit_cast(float, g2.x << 16); gv.y = __builtin_bit_cast(float, g2.x & 0xffff0000u); gv.z = __builtin_bit_cast(float, g2.y << 16); gv.w = __builtin_bit_cast(float, g2.y & 0xffff0000u); }
                            else gv = *(const f32x4*)(gp + off);
                            *(f32x4*)(op + off) = xv + gv * acc[ai][bj][m][n]; } } }
    }
};
typedef EpiDownT<0> EpiDown;

__global__ void __launch_bounds__(NTHR, 2) fwd_kernel(Args args) {
    extern __shared__ __attribute__((aligned(16))) unsigned char lds_raw[];
    LAS unsigned char* lds = (LAS unsigned char*)lds_raw;
    volatile LAS unsigned* MISC = (volatile LAS unsigned*)(lds + MISC_OFF);
    const int G = gridDim.x;
    unsigned char* ws = args.ws;
    const int wave_s = __builtin_amdgcn_readfirstlane(threadIdx.x >> 6);
    for (int u = threadIdx.x; u < (LDS_BYTES - LDSCTL_OFF) / 4; u += NTHR) ((LAS unsigned*)(lds + LDSCTL_OFF))[u] = 0u;
    __syncthreads();
    const int lo = args.ph_lo, hi = args.ph_hi;
    const bool use_bar = (hi - lo) > 1;
    XcdBarrier bar; bar.bar = (unsigned*)(ws + WS_CTL) + CW_BAR; bar.x = 0; bar.st = nullptr;
    if (use_bar) bar = xcd_barrier_post((unsigned*)(ws + WS_CTL) + CW_BAR, MISC + 8, threadIdx.x == 0);
#define IN(k) (lo <= (k) && (k) < hi)
#define BOTH(k) (IN(k) && IN((k) + 1))
#if PROBE_REP == 1000
#define GRID_BAR(k) do { if (BOTH(k)) { xcd_barrier(bar, wave_s == 0 && __builtin_amdgcn_mbcnt_hi(~0u, __builtin_amdgcn_mbcnt_lo(~0u, 0u)) == 0u); xcd_barrier(bar, wave_s == 0 && __builtin_amdgcn_mbcnt_hi(~0u, __builtin_amdgcn_mbcnt_lo(~0u, 0u)) == 0u); } } while (0)
#else
#define GRID_BAR(k) do { if (BOTH(k)) xcd_barrier(bar, wave_s == 0 && __builtin_amdgcn_mbcnt_hi(~0u, __builtin_amdgcn_mbcnt_lo(~0u, 0u)) == 0u); } while (0)
#endif
#define FRESH_IDS() const int wave = wave_s; int lane = (int)__builtin_amdgcn_mbcnt_hi(~0u, __builtin_amdgcn_mbcnt_lo(~0u, 0u)); asm volatile("" : "+v"(lane)); const int tid = wave * 64 + lane; (void)tid
    const float* mod = (const float*)(ws + WS_MOD);

    if (IN(0)) { FRESH_IDS(); p0_prologue(args, lds, tid, lane, wave); GRID_BAR(0); }
    if (IN(1)) { FRESH_IDS(); norm_rows<false>(args, (const float*)args.in[I_X], (const float*)args.in[I_NORM_MIX], mod + 0, mod + 1024, (bf16*)(ws + WS_H), lds, lane, wave); GRID_BAR(1); }
    if (IN(2)) { FRESH_IDS();
        pg8::Gemm g{(const pg8::bf16_t*)(ws + WS_H), (const pg8::bf16_t*)(ws + WS_WINT), TT, NPAD, DM}; pg8::StaticOrder S; S.init(TT, NPAD, G, (int)blockIdx.x);
        pg8::EpiProj E{(pg8::bf16_t*)(ws + WS_PROJ), (float*)(ws + WS_AB), NPROJ};
        pg8::gemm_phase<pg8::EpiProj, pg8::StaticOrder, true, true>(lds, g, S, E);
        GRID_BAR(2);
    }
    if (IN(3)) { FRESH_IDS(); gdn_g1_mfma<31>(args, lds, tid, lane, wave); GRID_BAR(3); }
    if (IN(4)) { FRESH_IDS();
        if ((int)blockIdx.x < 32) gdn_scan(args, (int)blockIdx.x, lds, tid, lane, wave);
        else swa_mfma(args, lds, tid, lane, wave, (int)blockIdx.x - 32, G - 32);
        GRID_BAR(4);
    }
    if (IN(5)) { FRESH_IDS(); gdn_out(args, lds, lane, wave); GRID_BAR(5); }
    if (IN(6)) { FRESH_IDS();
        pg8::Gemm g{(const pg8::bf16_t*)(ws + WS_MIX), (const pg8::bf16_t*)(ws + WS_WOUTT), TT, DM, DM}; pg8::StaticOrder S; S.init(TT, DM, G, (int)blockIdx.x);
        pg8::EpiOut E{(const float*)args.in[I_X], args.out, mod + 2048, SEQ, 6144, (float*)(ws + WS_SSQ)};
        pg8::gemm_phase<pg8::EpiOut, pg8::StaticOrder, true, true>(lds, g, S, E);
        GRID_BAR(6);
    }
    if (IN(7)) { FRESH_IDS(); norm_route_mfma<false>(args, args.out, (const float*)(ws + WS_SSQ), (const float*)args.in[I_NORM_FFN], mod + 3072, mod + 4096, (bf16*)(ws + WS_H), lds, tid, lane, wave); GRID_BAR(7); }
    if (IN(8)) { FRESH_IDS();
        SchedE S; S.init((const unsigned*)(ws + WS_CTL) + CW_ECNT, (const int2*)(ws + WS_EREC), (const char*)(ws + WS_WGUT), G, (int)blockIdx.x, lane);
        EpiGU E{(bf16*)(ws + WS_HID)};
        pg8::gemm_phase_g<EpiGU, SchedE>(lds, (const pg8::bf16_t*)(ws + WS_H), 1024, 1024, 16, 16, S, E);
        GRID_BAR(8);
    }
    if (IN(9)) { FRESH_IDS();
        SchedC S; S.init((const unsigned*)(ws + WS_CTL) + CW_CCNT, (const int*)(ws + WS_CLIST), (const char*)(ws + WS_WDT), G, (int)blockIdx.x, lane);
        LAS unsigned char* gtl = lds + RING_BYTES + 512;
        for (int q = tid; q < 4096; q += NTHR) *(LAS unsigned short*)(gtl + q * 2) = (unsigned short)f2bf(mod[(q >> 10) * 6144 + 5120 + (q & 1023)]);
        __syncthreads();
        EpiDown E{args.out, mod + 5120, gtl};
        pg8::gemm_phase_g<EpiDown, SchedC>(lds, (const pg8::bf16_t*)(ws + WS_HID), 512, 256, 8, 4, S, E);
    }
#undef IN
#undef BOTH
#undef GRID_BAR
}

#if PROBE_REP >= 0 && PROBE_REP < 1000
template <int P>
__global__ void __launch_bounds__(NTHR, 2) probe_kernel(Args args) {
    extern __shared__ __attribute__((aligned(16))) unsigned char lds_raw[];
    LAS unsigned char* lds = (LAS unsigned char*)lds_raw;
    const int tid = threadIdx.x, lane = tid & 63, wave = __builtin_amdgcn_readfirstlane(tid >> 6);
    const int G = gridDim.x; unsigned char* ws = args.ws; const float* mod = (const float*)(ws + WS_MOD);
    if constexpr (P == 1) norm_rows<false>(args, (const float*)args.in[I_X], (const float*)args.in[I_NORM_MIX], mod + 0, mod + 1024, (bf16*)(ws + WS_GAP + 0)  , lds, lane, wave);
    if constexpr (P == 2) { pg8::Gemm g{(const pg8::bf16_t*)(ws + WS_H), (const pg8::bf16_t*)(ws + WS_WINT), TT, NPAD, DM}; pg8::StaticOrder S; S.init(TT, NPAD, G, (int)blockIdx.x);
        pg8::EpiProj E{(pg8::bf16_t*)(ws + WS_PROJ), (float*)(ws + WS_AB), NPROJ}; pg8::gemm_phase<pg8::EpiProj, pg8::StaticOrder, true, true>(lds, g, S, E); }
    if constexpr (P == 0) p0_prologue(args, lds, tid, lane, wave);
    if constexpr (P == 4) gdn_g1_mfma<31>(args, lds, tid, lane, wave);
    if constexpr (P == 40) gdn_g1_mfma<31, 0>(args, lds, tid, lane, wave);
    if constexpr (P == 41) gdn_g1_mfma<31, 1>(args, lds, tid, lane, wave);
    if constexpr (P == 42) gdn_g1_mfma<31, 3>(args, lds, tid, lane, wave);
    if constexpr (P == 43) gdn_g1_mfma<0, 7>(args, lds, tid, lane, wave);
    if constexpr (P == 50) { if ((int)blockIdx.x < 32) gdn_scan(args, (int)blockIdx.x, lds, tid, lane, wave); }
    if constexpr (P == 501) { if ((int)blockIdx.x < 32) gdn_scan<1>(args, (int)blockIdx.x, lds, tid, lane, wave); }
    if constexpr (P == 502) { if ((int)blockIdx.x < 32) gdn_scan<2>(args, (int)blockIdx.x, lds, tid, lane, wave); }
    if constexpr (P == 52) gdn_out(args, lds, lane, wave);
    if constexpr (P == 51) { if ((int)blockIdx.x >= 32) swa_mfma(args, lds, tid, lane, wave, (int)blockIdx.x - 32, G - 32); }
    if constexpr (P == 6) { pg8::Gemm g{(const pg8::bf16_t*)(ws + WS_MIX), (const pg8::bf16_t*)(ws + WS_WOUTT), TT, DM, DM}; pg8::StaticOrder S; S.init(TT, DM, G, (int)blockIdx.x);
        pg8::EpiOut E{(const float*)args.in[I_X], (float*)(ws + WS_GSF)  , mod + 2048, SEQ, 6144, nullptr}; pg8::gemm_phase<pg8::EpiOut, pg8::StaticOrder, true, true>(lds, g, S, E); }
    if constexpr (P == 81) { SchedET<1> S; S.init((const unsigned*)(ws + WS_CTL) + CW_ECNT, (const int2*)(ws + WS_EREC), (const char*)(ws + WS_WGUT), G, (int)blockIdx.x, lane);
        EpiGU E{(bf16*)(ws + WS_HID)}; pg8::gemm_phase_g<EpiGU, SchedET<1>>(lds, (const pg8::bf16_t*)(ws + WS_H), 1024, 1024, 16, 16, S, E); }
    if constexpr (P == 8) { SchedE S; S.init((const unsigned*)(ws + WS_CTL) + CW_ECNT, (const int2*)(ws + WS_EREC), (const char*)(ws + WS_WGUT), G, (int)blockIdx.x, lane);
        EpiGU E{(bf16*)(ws + WS_HID)}; pg8::gemm_phase_g<EpiGU, SchedE>(lds, (const pg8::bf16_t*)(ws + WS_H), 1024, 1024, 16, 16, S, E); }
    if constexpr (P == 71) norm_route_mfma<true, 1>(args, args.out, (const float*)(ws + WS_SSQ), (const float*)args.in[I_NORM_FFN], mod + 3072, mod + 4096, (bf16*)(ws + WS_PROJ + 32 * MiB), lds, tid, lane, wave);
    if constexpr (P == 7) norm_route_mfma<true>(args, args.out, (const float*)(ws + WS_SSQ), (const float*)args.in[I_NORM_FFN], mod + 3072, mod + 4096, (bf16*)(ws + WS_PROJ + 32 * MiB), lds, tid, lane, wave);
    if constexpr (P == 91 || P == 92) { SchedC S; S.init((const unsigned*)(ws + WS_CTL) + CW_CCNT, (const int*)(ws + WS_CLIST), (const char*)(ws + WS_WDT), G, (int)blockIdx.x, lane);
        EpiDownT<P - 90> E{(float*)(ws + WS_PROJ + 32 * MiB), mod + 5120, nullptr}; pg8::gemm_phase_g<EpiDownT<P - 90>, SchedC>(lds, (const pg8::bf16_t*)(ws + WS_HID), 512, 256, 8, 4, S, E); }
    if constexpr (P == 9) { SchedC S; S.init((const unsigned*)(ws + WS_CTL) + CW_CCNT, (const int*)(ws + WS_CLIST), (const char*)(ws + WS_WDT), G, (int)blockIdx.x, lane);
        EpiDown E{(float*)(ws + WS_PROJ + 32 * MiB), mod + 5120, nullptr}; pg8::gemm_phase_g<EpiDown, SchedC>(lds, (const pg8::bf16_t*)(ws + WS_HID), 512, 256, 8, 4, S, E); }
}
#endif
extern "C" void kernel_launch(void* const* d_in, const int* in_sizes, int n_in, void* d_out, int out_size, void* d_ws, size_t ws_size, hipStream_t stream) {
    static int grid = 0;
    if (grid == 0) {
        if (n_in != 23 || in_sizes[0] != TT * DM || out_size != TT * DM || ws_size < WS_END) { fprintf(stderr, "kernel_launch: unexpected shapes: n_in %d in0 %d out %d ws %zu (need %zu)\n", n_in, n_in > 0 ? in_sizes[0] : -1, out_size, ws_size, (size_t)WS_END); grid = -1; return; }
        int dev = 0, cus = 0, per_cu = 0;
        if (hipGetDevice(&dev) != hipSuccess || hipDeviceGetAttribute(&cus, hipDeviceAttributeMultiprocessorCount, dev) != hipSuccess) { grid = -1; return; }
        if (hipFuncSetAttribute((const void*)fwd_kernel, hipFuncAttributeMaxDynamicSharedMemorySize, LDS_BYTES) != hipSuccess) { fprintf(stderr, "kernel_launch: hipFuncSetAttribute failed\n"); grid = -1; return; }
        if (hipOccupancyMaxActiveBlocksPerMultiprocessor(&per_cu, (const void*)fwd_kernel, NTHR, LDS_BYTES) != hipSuccess || per_cu < 1) fprintf(stderr, "kernel_launch: occupancy query reports %d\n", per_cu);
        (void)hipGetLastError();
        grid = cus;
    }
    if (grid < 0) return;
    if (hipMemsetAsync((char*)d_ws + WS_CTL, 0, CTL_ZERO_BYTES, stream) != hipSuccess) { fprintf(stderr, "kernel_launch: memset failed\n"); return; }
    Args a{};
    for (int i = 0; i < 23; ++i) a.in[i] = d_in[i];
    a.out = (float*)d_out; a.ws = (unsigned char*)d_ws;
#if MK_ONE_LAUNCH
    a.ph_lo = 0; a.ph_hi = N_PHASES;
    hipLaunchKernelGGL(fwd_kernel, dim3(grid), dim3(NTHR), LDS_BYTES, stream, a);
#if PROBE_REP >= 0 && PROBE_REP < 1000
    hipFuncSetAttribute((const void*)probe_kernel<PROBE_REP>, hipFuncAttributeMaxDynamicSharedMemorySize, LDS_BYTES);
    hipLaunchKernelGGL(probe_kernel<PROBE_REP>, dim3(grid), dim3(NTHR), LDS_BYTES, stream, a);
#endif
#else
    for (int p = 0; p < N_PHASES; ++p) { a.ph_lo = p; a.ph_hi = p + 1; hipLaunchKernelGGL(fwd_kernel, dim3(grid), dim3(NTHR), LDS_BYTES, stream, a); }
#endif
}
```

```cpp
#include <hip/hip_runtime.h>
#include <cstdio>
#include <cstdint>
namespace pg8 {
#define PG8_LAS __attribute__((address_space(3)))
typedef unsigned short bf16_t;
typedef short bf16x8 __attribute__((ext_vector_type(8)));
typedef float f32x4 __attribute__((ext_vector_type(4)));
typedef unsigned u32x4 __attribute__((ext_vector_type(4)));
constexpr int BM = 256, BK = 64, HALF = 128, HTB = HALF * BK * 2  , STAGE_BYTES = 8 * HTB, NXCD = 8, WGM = 8;

__host__ __device__ __forceinline__ int lds_byte(int r, int c) { const int st = (r >> 4) * 2 + (c >> 5), rr = r & 15, cc = c & 31, ob = rr * 64 + cc * 2; return st * 1024 + (ob ^ (((ob >> 9) & 1) << 5)); }
__host__ __device__ __forceinline__ void stage_rc(int b, int& R, int& C) { const int st = b / 1024, sb = b % 1024, swz = sb ^ (((sb >> 9) & 1) << 5); R = (st >> 1) * 16 + swz / 64; C = (st & 1) * 32 + (swz % 64) / 2; }
__host__ __device__ __forceinline__ int perm32(int rho) { const int n = rho >> 4, i = rho & 15; return 8 * (i >> 2) + 4 * n + (i & 3); }

struct Unit { int pm, pn; };
struct Gemm { const bf16_t* A; const bf16_t* Bt; int M, N, K; };

struct StaticOrder {
    int nM, nN, nwg, G, c;
    __host__ __device__ void init(int M, int N, int G_, int c_) { nM = M / BM; nN = N / BM; nwg = nM * nN; G = G_; c = c_; }
    __host__ __device__ bool next(int i, Unit& u) const {
        const long L = (long)i * G + c; if (L >= nwg) return false;
        int wgid = (int)L; { const int q = nwg / NXCD, r = nwg % NXCD, xcd = wgid % NXCD, off = wgid / NXCD; wgid = (xcd < r ? xcd * (q + 1) : r * (q + 1) + (xcd - r) * q) + off; }
        const int nig = WGM * nN, gid = wgid / nig, fm = gid * WGM, gsz = (nM - fm) < WGM ? (nM - fm) : WGM;
        u.pm = fm + ((wgid % nig) % gsz); u.pn = (wgid % nig) / gsz; return true;
    }
    __device__ __forceinline__ void a_ready(const Unit&) const {}
    __device__ __forceinline__ void done(const Unit&) const {}
};

__device__ __forceinline__ unsigned cvt_pk_bf16(float lo, float hi) { unsigned r; asm volatile("v_cvt_pk_bf16_f32 %0, %1, %2" : "=v"(r) : "v"(lo), "v"(hi)); return r; }

__device__ __forceinline__ void store16_wt(void* base, unsigned byte_off, u32x4 v) {
    __amdgpu_buffer_rsrc_t r = __builtin_amdgcn_make_buffer_rsrc(base, 0, 0x7fffffff, 0x00020000);
    __builtin_amdgcn_raw_buffer_store_b128(v, r, (int)byte_off, 0, 16);
}
struct EpiProj {
    static constexpr bool PERM = true, AFTER_DRAIN = false, PREFETCH = false;
    bf16_t* P; float* AB; int ldp;
    __device__ __forceinline__ void operator()(const f32x4 (&acc)[2][2][4][2], const Unit& u, int wr, int wc, int fr, int fq) const {
        const int row0 = u.pm * BM + wr * 64 + fr;
        if (u.pn < 11) {
            const int col0 = u.pn * BM + wc * 32 + 8 * fq;
#pragma unroll
            for (int ai = 0; ai < 2; ++ai)
#pragma unroll
                for (int m = 0; m < 4; ++m) { const unsigned ro = ((unsigned)(row0 + ai * HALF + m * 16) * (unsigned)ldp + (unsigned)col0) * 2u;
#pragma unroll
                    for (int bj = 0; bj < 2; ++bj) { const f32x4 v0 = acc[ai][bj][m][0], v1 = acc[ai][bj][m][1];
                        u32x4 w; w.x = cvt_pk_bf16(v0[0], v0[1]); w.y = cvt_pk_bf16(v0[2], v0[3]); w.z = cvt_pk_bf16(v1[0], v1[1]); w.w = cvt_pk_bf16(v1[2], v1[3]);
                        *(u32x4*)((char*)P + ro + (unsigned)(bj * HALF) * 2u) = w; } }
        } else if (wc == 0 && fq < 2) {
#pragma unroll
            for (int ai = 0; ai < 2; ++ai)
#pragma unroll
                for (int m = 0; m < 4; ++m) { float* rowp = AB + (size_t)(row0 + ai * HALF + m * 16) * 16 + 8 * fq;
                    *(f32x4*)(rowp) = acc[ai][0][m][0]; *(f32x4*)(rowp + 4) = acc[ai][0][m][1]; }
        }
    }
};
struct EpiOut {
    static constexpr bool PERM = false, AFTER_DRAIN = false, PREFETCH = false;
    const float* X; float* O; const float* gate; int rows_per_batch, ldg;
    float* SSQ;
    __device__ __forceinline__ void prefetch(PG8_LAS unsigned char* lds, const Unit& u, int tid) const {
        const char* base = (const char*)X + ((size_t)(u.pm * BM) * 1024 + (size_t)u.pn * BM) * 4 + (size_t)(tid >> 3) * 4096 + (size_t)(tid & 7) * 128;
#pragma unroll
        for (int i = 0; i < 4; ++i) __builtin_amdgcn_global_load_lds((const unsigned*)(base + (size_t)i * 64 * 4096), (PG8_LAS unsigned*)(lds + STAGE_BYTES + 256), 4, 0, 0);
    }
    __device__ __forceinline__ void operator()(const f32x4 (&acc)[2][2][4][2], const Unit& u, int wr, int wc, int fr, int fq) const {
        const int row0 = u.pm * BM + wr * 64 + fr, col0 = u.pn * BM + wc * 32 + 4 * fq;
        const float* gb = gate + (size_t)((u.pm * BM) / rows_per_batch) * ldg + col0;
        f32x4 gv[2][2];
#pragma unroll
        for (int bj = 0; bj < 2; ++bj)
#pragma unroll
            for (int n = 0; n < 2; ++n) gv[bj][n] = *(const f32x4*)(gb + bj * HALF + n * 16);
#pragma unroll
        for (int ai = 0; ai < 2; ++ai)
#pragma unroll
            for (int m = 0; m < 4; ++m) { const size_t ro = (size_t)(row0 + ai * HALF + m * 16) * 1024 + col0; float ss = 0.f;
#pragma unroll
                for (int bj = 0; bj < 2; ++bj)
#pragma unroll
                    for (int n = 0; n < 2; ++n) { const f32x4 xv = *(const f32x4*)(X + ro + bj * HALF + n * 16); const f32x4 v = xv + gv[bj][n] * acc[ai][bj][m][n];
                        *(f32x4*)(O + ro + bj * HALF + n * 16) = v; ss += (v.x * v.x + v.y * v.y) + (v.z * v.z + v.w * v.w); }
                if (SSQ) { ss += __shfl_xor(ss, 16); ss += __shfl_xor(ss, 32); if (fq == 0) SSQ[(size_t)(row0 + ai * HALF + m * 16) * 16 + u.pn * 4 + wc] = ss; } }
    }
};

struct UnitG { int id, tile, pn, nrows; };
template <class Epi, class Sched>
__device__ __forceinline__ void gemm_phase_g(PG8_LAS unsigned char* lds, const bf16_t* Abase, const int KA, const int KB, const int nt, const int ksplit, const Sched& S, const Epi& E) {
    const int tid = threadIdx.x, wid = __builtin_amdgcn_readfirstlane(tid >> 6), lane = tid & 63, wr = wid >> 2, wc = wid & 3, fr = lane & 15, fq = lane >> 4;
    int Rr[2]; unsigned cB2[2], voffB[2];
#pragma unroll
    for (int i = 0; i < 2; ++i) { int R, C; stage_rc(tid * 16 + i * 8192, R, C); const int Rb = Epi::PERM ? ((R & ~31) + perm32(R & 31)) : R;
        Rr[i] = R; cB2[i] = (unsigned)C * 2u; voffB[i] = (unsigned)(Rb * KB + C) * 2u; }
    const size_t kstep = (size_t)(BK * 2);
    const size_t hstepB = (size_t)HALF * KB * 2;
    const unsigned ldsw = (unsigned)wid * 1024u;
    const int aoff = lds_byte(wr * 64 + fr, fq * 8), boff = lds_byte(wc * 32 + fr, fq * 8);
#define PG8_SA(b, h) (((b) * 2 + (h)) * HTB)
#define PG8_SB(b, h) ((4 + (b) * 2 + (h)) * HTB)
#define PG8_STAGE2(bufoff, gbase, v0, v1) do { \
        __builtin_amdgcn_global_load_lds((const unsigned*)((const char*)(gbase) + (v0)), (PG8_LAS unsigned*)(lds + (bufoff) + ldsw), 16, 0, 0); \
        __builtin_amdgcn_global_load_lds((const unsigned*)((const char*)(gbase) + (v1)), (PG8_LAS unsigned*)(lds + (bufoff) + ldsw + 8192), 16, 0, 0); } while (0)
#define PG8_LDA(dst, b, h) do { _Pragma("unroll") for (int m = 0; m < 4; ++m) _Pragma("unroll") for (int k = 0; k < 2; ++k) dst[m][k] = *(const PG8_LAS bf16x8*)(lds + PG8_SA(b, h) + aoff + m * 2048 + k * 1024); } while (0)
#define PG8_LDB(dst, b, h) do { _Pragma("unroll") for (int n = 0; n < 2; ++n) _Pragma("unroll") for (int k = 0; k < 2; ++k) dst[n][k] = *(const PG8_LAS bf16x8*)(lds + PG8_SB(b, h) + boff + n * 2048 + k * 1024); } while (0)
#define PG8_MMA(ai, bj, At, Bt) do { __builtin_amdgcn_s_setprio(1); _Pragma("unroll") for (int m = 0; m < 4; ++m) _Pragma("unroll") for (int n = 0; n < 2; ++n) _Pragma("unroll") for (int k = 0; k < 2; ++k) \
        acc[ai][bj][m][n] = __builtin_amdgcn_mfma_f32_16x16x32_bf16(Bt[n][k], At[m][k], acc[ai][bj][m][n], 0, 0, 0); __builtin_amdgcn_s_setprio(0); } while (0)
#define PG8_WAIT_V(n) asm volatile("s_waitcnt vmcnt(" #n ")" ::: "memory")
#define PG8_WAIT_L(n) asm volatile("s_waitcnt lgkmcnt(" #n ")" ::: "memory")
#define PG8_BAR __builtin_amdgcn_s_barrier()
#define PG8_SCHED __builtin_amdgcn_sched_barrier(0)
#define PG8_AOFFS(u, o00, o01, o10, o11) do { const unsigned _ks = (unsigned)KA * 2u; \
        o00 = (unsigned)S.tok(u, Rr[0]) * _ks + cB2[0]; o01 = (unsigned)S.tok(u, Rr[1]) * _ks + cB2[1]; \
        o10 = (unsigned)S.tok(u, HALF + Rr[0]) * _ks + cB2[0]; o11 = (unsigned)S.tok(u, HALF + Rr[1]) * _ks + cB2[1]; } while (0)
#define PG8_BT(u, t) (((t) < ksplit) ? S.bseg(u, 0) + (size_t)(t) * kstep : S.bseg(u, 1) + (size_t)((t) - ksplit) * kstep)
    UnitG cur, nxt; int ui = 0;
    if (!S.next(0, cur)) return;
    f32x4 acc[2][2][4][2];
#pragma unroll
    for (int a = 0; a < 2; ++a)
#pragma unroll
        for (int b = 0; b < 2; ++b)
#pragma unroll
            for (int m = 0; m < 4; ++m)
#pragma unroll
                for (int n = 0; n < 2; ++n) acc[a][b][m][n] = (f32x4){0.f, 0.f, 0.f, 0.f};
    bf16x8 At[4][2], B0[2][2], B1[2][2];
    unsigned c00, c01, c10, c11, n00 = 0, n01 = 0, n10 = 0, n11 = 0;
    PG8_AOFFS(cur, c00, c01, c10, c11);
    if constexpr (Epi::PREFETCH) E.prefetch(lds, cur, S, tid);
    const char* const Ab = (const char*)Abase;
    {   const char* b0p = PG8_BT(cur, 0); const char* b1p = PG8_BT(cur, 1);
        PG8_STAGE2(PG8_SB(0, 0), b0p, voffB[0], voffB[1]); PG8_STAGE2(PG8_SB(0, 1), b0p + hstepB, voffB[0], voffB[1]); PG8_STAGE2(PG8_SA(0, 0), Ab, c00, c01); PG8_STAGE2(PG8_SA(0, 1), Ab, c10, c11);
        if (wr == 1) PG8_BAR;
        PG8_WAIT_V(2); PG8_BAR;
        PG8_STAGE2(PG8_SB(1, 0), b1p, voffB[0], voffB[1]); PG8_STAGE2(PG8_SA(1, 0), Ab + kstep, c00, c01); PG8_STAGE2(PG8_SB(1, 1), b1p + hstepB, voffB[0], voffB[1]);
        PG8_WAIT_V(6); PG8_BAR;
    }
    for (;;) {
        const bool has_next = S.next(ui + 1, nxt);
        const bool h1 = cur.nrows > HALF;
        for (int t = 0; t < nt; t += 2) {
            const bool last = (t == nt - 2);
            if (last && has_next) { PG8_AOFFS(nxt, n00, n01, n10, n11); if constexpr (Epi::PREFETCH) E.prefetch(lds, nxt, S, tid); }
            const bool usen = last && has_next;
            const int t2 = last ? 0 : t + 2, t3 = t2 + 1;
            const char* a1 = Ab + (size_t)(t + 1) * kstep;
            const char* a2 = Ab + (size_t)t2 * kstep; const char* a3 = Ab + (size_t)t3 * kstep;
            const char* b2 = usen ? PG8_BT(nxt, t2) : PG8_BT(cur, t2); const char* b3 = usen ? PG8_BT(nxt, t3) : PG8_BT(cur, t3);
            const unsigned o00 = usen ? n00 : c00, o01 = usen ? n01 : c01, o10 = usen ? n10 : c10, o11 = usen ? n11 : c11;
            PG8_LDB(B0, 0, 0); PG8_LDB(B1, 0, 1); PG8_SCHED; PG8_LDA(At, 0, 0); PG8_STAGE2(PG8_SA(1, 1), a1, c10, c11);
            PG8_WAIT_V(8); PG8_WAIT_L(0); PG8_BAR; PG8_MMA(0, 0, At, B0); PG8_MMA(0, 1, At, B1); PG8_BAR; PG8_SCHED;
            PG8_LDA(At, 0, 1); PG8_STAGE2(PG8_SB(0, 0), b2, voffB[0], voffB[1]); PG8_STAGE2(PG8_SB(0, 1), b2 + hstepB, voffB[0], voffB[1]); PG8_STAGE2(PG8_SA(0, 0), a2, o00, o01);
            PG8_WAIT_V(8); PG8_WAIT_L(0); PG8_BAR; if (h1) { PG8_MMA(1, 0, At, B0); PG8_MMA(1, 1, At, B1); } PG8_BAR; PG8_SCHED;
            PG8_LDB(B0, 1, 0); PG8_LDB(B1, 1, 1); PG8_SCHED; PG8_LDA(At, 1, 0); PG8_STAGE2(PG8_SA(0, 1), a2, o10, o11);
            PG8_WAIT_V(8); PG8_WAIT_L(0); PG8_BAR; PG8_MMA(0, 0, At, B0); PG8_MMA(0, 1, At, B1); PG8_BAR; PG8_SCHED;
            PG8_LDA(At, 1, 1); PG8_STAGE2(PG8_SB(1, 0), b3, voffB[0], voffB[1]); PG8_STAGE2(PG8_SB(1, 1), b3 + hstepB, voffB[0], voffB[1]); PG8_STAGE2(PG8_SA(1, 0), a3, o00, o01);
            PG8_WAIT_V(8); PG8_WAIT_L(0); PG8_BAR; if (h1) { PG8_MMA(1, 0, At, B0); PG8_MMA(1, 1, At, B1); } PG8_BAR; PG8_SCHED;
        }
        if (wr == 0) PG8_BAR;
        E(acc, cur, S, wr, wc, fr, fq);
        if (!has_next) break;
#pragma unroll
        for (int a = 0; a < 2; ++a)
#pragma unroll
            for (int b = 0; b < 2; ++b)
#pragma unroll
                for (int m = 0; m < 4; ++m)
#pragma unroll
                    for (int n = 0; n < 2; ++n) acc[a][b][m][n] = (f32x4){0.f, 0.f, 0.f, 0.f};
        cur = nxt; c00 = n00; c01 = n01; c10 = n10; c11 = n11; ++ui;
        if (wr == 1) PG8_BAR;
    }
    PG8_WAIT_V(0);
    PG8_BAR;
#undef PG8_SA
#undef PG8_SB
#undef PG8_STAGE2
#undef PG8_LDA
#undef PG8_LDB
#undef PG8_MMA
#undef PG8_WAIT_V
#undef PG8_WAIT_L
#undef PG8_BAR
#undef PG8_SCHED
#undef PG8_AOFFS
#undef PG8_BT
}
template <class Epi, class Sched, bool ALIGN_EPI = false, bool SP2 = false>
__device__ __forceinline__ void gemm_phase(PG8_LAS unsigned char* lds, const Gemm g, const Sched& S, const Epi& E) {
    const int tid = threadIdx.x, wid = __builtin_amdgcn_readfirstlane(tid >> 6), lane = tid & 63, wr = wid >> 2, wc = wid & 3, fr = lane & 15, fq = lane >> 4;
    const int K = g.K, nt = K / BK;
    unsigned voffA[2], voffB[2];
#pragma unroll
    for (int i = 0; i < 2; ++i) { int R, C; stage_rc(tid * 16 + i * 8192, R, C); const int Rb = Epi::PERM ? ((R & ~31) + perm32(R & 31)) : R;
        voffA[i] = (unsigned)(R * K + C) * 2u; voffB[i] = (unsigned)(Rb * K + C) * 2u; }
    const size_t kstep = (size_t)(BK * 2);
    const size_t hstep = (size_t)HALF * K * 2;
    const size_t tstep = 2 * hstep;
    const unsigned ldsw = (unsigned)wid * 1024u;
    const int aoff = lds_byte(wr * 64 + fr, fq * 8), boff = lds_byte(wc * 32 + fr, fq * 8);
#define PG8_SA(b, h) (((b) * 2 + (h)) * HTB)
#define PG8_SB(b, h) ((4 + (b) * 2 + (h)) * HTB)
#define PG8_STAGE(bufoff, gbase, voff) do { _Pragma("unroll") for (int _i = 0; _i < 2; ++_i) \
        __builtin_amdgcn_global_load_lds((const unsigned*)((const char*)(gbase) + (voff)[_i]), (PG8_LAS unsigned*)(lds + (bufoff) + ldsw + _i * 8192), 16, 0, 0); } while (0)
#define PG8_LDA(dst, b, h) do { _Pragma("unroll") for (int m = 0; m < 4; ++m) _Pragma("unroll") for (int k = 0; k < 2; ++k) dst[m][k] = *(const PG8_LAS bf16x8*)(lds + PG8_SA(b, h) + aoff + m * 2048 + k * 1024); } while (0)
#define PG8_LDB(dst, b, h) do { _Pragma("unroll") for (int n = 0; n < 2; ++n) _Pragma("unroll") for (int k = 0; k < 2; ++k) dst[n][k] = *(const PG8_LAS bf16x8*)(lds + PG8_SB(b, h) + boff + n * 2048 + k * 1024); } while (0)
#define PG8_MMA(ai, bj, At, Bt) do { __builtin_amdgcn_s_setprio(1); _Pragma("unroll") for (int m = 0; m < 4; ++m) _Pragma("unroll") for (int n = 0; n < 2; ++n) _Pragma("unroll") for (int k = 0; k < 2; ++k) \
        acc[ai][bj][m][n] = __builtin_amdgcn_mfma_f32_16x16x32_bf16(Bt[n][k], At[m][k], acc[ai][bj][m][n], 0, 0, 0); __builtin_amdgcn_s_setprio(0); } while (0)
#define PG8_WAIT_V(n) asm volatile("s_waitcnt vmcnt(" #n ")" ::: "memory")
#define PG8_WAIT_L(n) asm volatile("s_waitcnt lgkmcnt(" #n ")" ::: "memory")
#define PG8_BAR __builtin_amdgcn_s_barrier()
#define PG8_SCHED __builtin_amdgcn_sched_barrier(0)
    Unit cur, nxt; int ui = 0;
    if (!S.next(0, cur)) return;
    f32x4 acc[2][2][4][2];
#pragma unroll
    for (int a = 0; a < 2; ++a)
#pragma unroll
        for (int b = 0; b < 2; ++b)
#pragma unroll
            for (int m = 0; m < 4; ++m)
#pragma unroll
                for (int n = 0; n < 2; ++n) acc[a][b][m][n] = (f32x4){0.f, 0.f, 0.f, 0.f};
    bf16x8 At[4][2], B0[2][2], B1[2][2];
    const char* cA = (const char*)g.A + (size_t)cur.pm * tstep; const char* cB = (const char*)g.Bt + (size_t)cur.pn * tstep;
    S.a_ready(cur);
    if constexpr (SP2) {
        PG8_STAGE(PG8_SB(0, 0), cB, voffB); PG8_STAGE(PG8_SB(0, 1), cB + hstep, voffB); PG8_STAGE(PG8_SA(0, 0), cA, voffA); PG8_STAGE(PG8_SA(0, 1), cA + hstep, voffA);
        if (wr == 1) PG8_BAR;
        PG8_WAIT_V(2); PG8_BAR;
        PG8_STAGE(PG8_SB(1, 0), cB + kstep, voffB); PG8_STAGE(PG8_SA(1, 0), cA + kstep, voffA); PG8_STAGE(PG8_SB(1, 1), cB + hstep + kstep, voffB);
        PG8_WAIT_V(6); PG8_BAR;
    } else {
        PG8_STAGE(PG8_SB(0, 0), cB, voffB); PG8_STAGE(PG8_SA(0, 0), cA, voffA); PG8_STAGE(PG8_SB(0, 1), cB + hstep, voffB); PG8_STAGE(PG8_SA(0, 1), cA + hstep, voffA);
        if (wr == 1) PG8_BAR;
        PG8_WAIT_V(4); PG8_BAR;
        PG8_STAGE(PG8_SB(1, 0), cB + kstep, voffB); PG8_STAGE(PG8_SA(1, 0), cA + kstep, voffA); PG8_STAGE(PG8_SB(1, 1), cB + hstep + kstep, voffB);
        PG8_WAIT_V(6); PG8_BAR;
    }
    if constexpr (Epi::PREFETCH) E.prefetch(lds, cur, tid);
    for (;;) {
        const bool has_next = S.next(ui + 1, nxt);
        const char* nA = has_next ? (const char*)g.A + (size_t)nxt.pm * tstep : cA; const char* nB = has_next ? (const char*)g.Bt + (size_t)nxt.pn * tstep : cB;
        for (int t = 0; t < nt; t += 2) {
            const bool last = (t == nt - 2);
            const char* a1 = cA + (size_t)(t + 1) * kstep;
            const char* a2 = last ? nA : cA + (size_t)(t + 2) * kstep; const char* b2 = last ? nB : cB + (size_t)(t + 2) * kstep;
            const char* a3 = a2 + kstep; const char* b3 = b2 + kstep;
            if (last && has_next) S.a_ready(nxt);
            if constexpr (SP2) {
            PG8_LDB(B0, 0, 0); PG8_LDB(B1, 0, 1); PG8_SCHED; PG8_LDA(At, 0, 0); PG8_STAGE(PG8_SA(1, 1), a1 + hstep, voffA);
            PG8_WAIT_V(8); PG8_WAIT_L(0); PG8_BAR; PG8_MMA(0, 0, At, B0); PG8_MMA(0, 1, At, B1); PG8_BAR; PG8_SCHED;
            PG8_LDA(At, 0, 1); PG8_STAGE(PG8_SB(0, 0), b2, voffB); PG8_STAGE(PG8_SB(0, 1), b2 + hstep, voffB); PG8_STAGE(PG8_SA(0, 0), a2, voffA);
            PG8_WAIT_V(8); PG8_WAIT_L(0); PG8_BAR; PG8_MMA(1, 0, At, B0); PG8_MMA(1, 1, At, B1); PG8_BAR; PG8_SCHED;
            PG8_LDB(B0, 1, 0); PG8_LDB(B1, 1, 1); PG8_SCHED; PG8_LDA(At, 1, 0); PG8_STAGE(PG8_SA(0, 1), a2 + hstep, voffA);
            PG8_WAIT_V(8); PG8_WAIT_L(0); PG8_BAR; PG8_MMA(0, 0, At, B0); PG8_MMA(0, 1, At, B1); PG8_BAR; PG8_SCHED;
            PG8_LDA(At, 1, 1); PG8_STAGE(PG8_SB(1, 0), b3, voffB); PG8_STAGE(PG8_SB(1, 1), b3 + hstep, voffB); PG8_STAGE(PG8_SA(1, 0), a3, voffA);
            PG8_WAIT_V(8); PG8_WAIT_L(0); PG8_BAR; PG8_MMA(1, 0, At, B0); PG8_MMA(1, 1, At, B1); PG8_BAR; PG8_SCHED;
            } else {
            PG8_LDB(B0, 0, 0); PG8_SCHED; PG8_LDA(At, 0, 0); PG8_STAGE(PG8_SA(1, 1), a1 + hstep, voffA);
            PG8_WAIT_L(8); PG8_BAR; PG8_WAIT_L(0); PG8_MMA(0, 0, At, B0); PG8_BAR; PG8_SCHED;
            PG8_LDB(B1, 0, 1); PG8_STAGE(PG8_SB(0, 0), b2, voffB);
            PG8_BAR; PG8_WAIT_L(0); PG8_MMA(0, 1, At, B1); PG8_BAR;
            PG8_LDA(At, 0, 1); PG8_STAGE(PG8_SA(0, 0), a2, voffA);
            PG8_BAR; PG8_WAIT_L(0); PG8_MMA(1, 0, At, B0); PG8_BAR; PG8_SCHED;
            PG8_STAGE(PG8_SB(0, 1), b2 + hstep, voffB);
            PG8_WAIT_V(6); PG8_BAR; PG8_MMA(1, 1, At, B1); PG8_BAR;
            PG8_LDB(B0, 1, 0); PG8_SCHED; PG8_LDA(At, 1, 0); PG8_STAGE(PG8_SA(0, 1), a2 + hstep, voffA);
            PG8_WAIT_L(8); PG8_BAR; PG8_WAIT_L(0); PG8_MMA(0, 0, At, B0); PG8_BAR; PG8_SCHED;
            PG8_LDB(B1, 1, 1); PG8_STAGE(PG8_SB(1, 0), b3, voffB);
            PG8_BAR; PG8_WAIT_L(0); PG8_MMA(0, 1, At, B1); PG8_BAR;
            PG8_LDA(At, 1, 1); PG8_STAGE(PG8_SA(1, 0), a3, voffA);
            PG8_BAR; PG8_WAIT_L(0); PG8_MMA(1, 0, At, B0); PG8_BAR; PG8_SCHED;
            PG8_STAGE(PG8_SB(1, 1), b3 + hstep, voffB);
            PG8_WAIT_V(6); PG8_BAR; PG8_MMA(1, 1, At, B1); PG8_BAR;
            }
        }
        if constexpr (ALIGN_EPI) { if (wr == 0) PG8_BAR; }
        if constexpr (!Epi::AFTER_DRAIN) { E(acc, cur, wr, wc, fr, fq); S.done(cur); }
        if (!has_next) break;
#pragma unroll
        for (int a = 0; a < 2; ++a)
#pragma unroll
            for (int b = 0; b < 2; ++b)
#pragma unroll
                for (int m = 0; m < 4; ++m)
#pragma unroll
                    for (int n = 0; n < 2; ++n) acc[a][b][m][n] = (f32x4){0.f, 0.f, 0.f, 0.f};
        cur = nxt; cA = nA; cB = nB; ++ui;
        if constexpr (Epi::PREFETCH) { int l_ = fr + 16 * fq; asm volatile("" : "+v"(l_)); E.prefetch(lds, cur, wid * 64 + l_); }
        if constexpr (ALIGN_EPI) { if (wr == 1) PG8_BAR; }
    }
    PG8_WAIT_V(0);
    if constexpr (!ALIGN_EPI) { if (wr == 0) PG8_BAR; }
    PG8_BAR;
    if constexpr (Epi::AFTER_DRAIN) { E.fused(acc, cur, wr, wc, fr, fq, lds, wid, lane); S.done(cur); }
#undef PG8_SA
#undef PG8_SB
#undef PG8_STAGE
#undef PG8_LDA
#undef PG8_LDB
#undef PG8_MMA
#undef PG8_WAIT_V
#undef PG8_WAIT_L
#undef PG8_BAR
#undef PG8_SCHED
}
}

constexpr int NB = 4, SEQ = 8192, DM = 1024, TT = NB * SEQ;
constexpr int NPROJ = 2816, NPAD = 3072;
constexpr int PC_Q = 0, PC_K = 512, PC_V = 1024, PC_Z = 1536, PC_SQ = 2048, PC_SK = 2560, PC_SV = 2688;
constexpr int NE = 32, NCLS = 112, DE = 256;
constexpr float EPS = 1e-6f;
constexpr int NWAVES = 8, NTHR = 512;
constexpr int N_PHASES = 10;
#ifndef G1_SM
#define G1_SM 31
#endif
#ifndef PROBE_REP
#define PROBE_REP -1
#endif
#ifndef MK_ONE_LAUNCH
#define MK_ONE_LAUNCH 1
#endif

constexpr size_t MiB = 1u << 20;
constexpr size_t WS_CTL = 0, CTL_ZERO_BYTES = 65536;
constexpr size_t WS_MOD = 1 * MiB;
constexpr size_t WS_WINT = 2 * MiB, WS_WOUTT = 8 * MiB, WS_WGUT = 10 * MiB, WS_WDT = 42 * MiB;
constexpr size_t WS_H = 58 * MiB;
constexpr size_t WS_PROJ = 122 * MiB;
constexpr size_t WS_AB = 298 * MiB;
constexpr size_t WS_SSQ = WS_AB;
constexpr size_t WS_MIX = 300 * MiB;
constexpr size_t WS_GSF = 364 * MiB;
constexpr size_t WS_EREC = 404 * MiB, WS_CLIST = 412 * MiB;
constexpr size_t WS_HID = WS_PROJ;
constexpr size_t WS_GAP = WS_H, WS_GQP = WS_H + 32 * MiB;
constexpr size_t WS_GOP = 426 * MiB, WS_GBP = 458 * MiB, WS_GGL = 490 * MiB;
constexpr size_t WS_WRT = 491 * MiB;
constexpr size_t WS_END = 492 * MiB;
constexpr int CW_BAR = 4096, CW_ECNT = 8192, CW_CCNT = 8256;

constexpr int RING_BYTES = 131072, LDSCTL_OFF = RING_BYTES, LDS_BYTES = 147456, MISC_OFF = LDS_BYTES - 128;

#define GAS __attribute__((address_space(1)))
#define LAS __attribute__((address_space(3)))
typedef unsigned short bf16;
typedef unsigned v4u __attribute__((ext_vector_type(4)));
typedef float f32x4 __attribute__((ext_vector_type(4)));
typedef GAS unsigned gu32;
#define RLX_AGENT __ATOMIC_RELAXED, __HIP_MEMORY_SCOPE_AGENT
#define LDS_WAIT() asm volatile("s_waitcnt lgkmcnt(0)" ::: "memory")
__device__ __forceinline__ unsigned f2bf(float f) { unsigned u = __builtin_bit_cast(unsigned, f); return (u + 0x7fffu + ((u >> 16) & 1u)) >> 16; }
__device__ __forceinline__ unsigned pk2(float lo, float hi) { return f2bf(lo) | (f2bf(hi) << 16); }
__device__ __forceinline__ float bf2f(bf16 v) { return __builtin_bit_cast(float, (unsigned)v << 16); }
__device__ __forceinline__ float wave_sum(float v) {
#pragma unroll
    for (int o = 1; o < 64; o <<= 1) v += __shfl_xor(v, o);
    return v;
}
__device__ __forceinline__ float siluf(float y) { return y / (1.f + __expf(-y)); }
#define XB_TMO      128
#define XB_XCNT(j)  (256  + 64 * (j))
#define XB_XSUB(j)  (1280 + 64 * (j))
#define XB_XGEN(j)  (2304 + 64 * (j))
#define XB_TOP      3328
#define XB_TOPGEN   3392
#define XCD_BAR_WORDS 3456
#define XB_SPIN_CAP (1u << 18)
__device__ __forceinline__ unsigned xb_ld(unsigned* p)              { return __hip_atomic_load(p, __ATOMIC_RELAXED, __HIP_MEMORY_SCOPE_AGENT); }
__device__ __forceinline__ unsigned xb_add(unsigned* p, unsigned v) { return __hip_atomic_fetch_add(p, v, __ATOMIC_RELAXED, __HIP_MEMORY_SCOPE_AGENT); }
__device__ __forceinline__ unsigned xb_xcc_id() { return (unsigned)__builtin_amdgcn_s_getreg((3 << 11) | 20) & 0xFu; }
#define XB_SPIN(cond, bar) do { unsigned _sp = 0; while (cond) { __builtin_amdgcn_s_sleep(1); \
    if ((++_sp & 255u) == 0u) { if (xb_ld(&(bar)[XB_TMO])) break; if (_sp > XB_SPIN_CAP) { atomicAdd(&(bar)[XB_TMO], 1u); break; } } } } while (0)

struct XcdBarrier {
    unsigned* bar; unsigned x;
    volatile LAS unsigned* st;
};

__device__ __forceinline__ XcdBarrier xcd_barrier_post(unsigned* bar, volatile LAS unsigned* st, bool leader  ) {
    XcdBarrier b; b.bar = bar; b.x = xb_xcc_id(); b.st = st;
    if (leader) (void)xb_add(&bar[XB_XCNT(b.x)], 1u);
    return b;
}
__device__ __forceinline__ void xcd_barrier_complete(unsigned* bar, unsigned x, unsigned& nloc, unsigned& nx) {
    const unsigned G = gridDim.x * gridDim.y * gridDim.z;
    unsigned sum, cnt, mine, sp = 0u;
    for (;;) {
        sum = 0u; cnt = 0u; mine = 0u;
#pragma unroll
        for (unsigned j = 0; j < 16; ++j) { const unsigned c = xb_ld(&bar[XB_XCNT(j)]); sum += c; cnt += (c > 0u) ? 1u : 0u; mine = (j == x) ? c : mine; }
        if (sum == G) break;
        __builtin_amdgcn_s_sleep(1);
        if ((++sp & 255u) == 0u) { if (xb_ld(&bar[XB_TMO])) break; if (sp > XB_SPIN_CAP) { atomicAdd(&bar[XB_TMO], 1u); break; } }
    }
    nloc = mine > 0u ? mine : 1u; nx = cnt > 0u ? cnt : 1u;
}

__device__ __forceinline__ void xcd_barrier(const XcdBarrier& b, bool leader  ) {
    asm volatile("s_waitcnt vmcnt(0)" ::: "memory");
    __syncthreads();
    if (leader) {
        unsigned* bar = b.bar;
        __builtin_amdgcn_s_waitcnt(0);
        unsigned nloc = b.st[0], nx = b.st[1];
        if (nloc == 0u) { xcd_barrier_complete(bar, b.x, nloc, nx); b.st[0] = nloc; b.st[1] = nx; }
        const unsigned old = xb_add(&bar[XB_XSUB(b.x)], 1u);
        const unsigned gen = old / nloc;
        if (old + 1u == (gen + 1u) * nloc) {
            __builtin_amdgcn_fence(__ATOMIC_RELEASE, "agent");
            asm volatile("s_waitcnt vmcnt(0)" ::: "memory");
            const unsigned og = xb_add(&bar[XB_TOP], 1u);
            const unsigned tg = og / nx;
            if (og + 1u == (tg + 1u) * nx) xb_add(&bar[XB_TOPGEN], 1u);
            else XB_SPIN(xb_ld(&bar[XB_TOPGEN]) == tg, bar);
            __builtin_amdgcn_fence(__ATOMIC_ACQUIRE, "agent");
            xb_add(&bar[XB_XGEN(b.x)], 1u);
            asm volatile("s_waitcnt vmcnt(0)" ::: "memory");
        } else {
            XB_SPIN(xb_ld(&bar[XB_XGEN(b.x)]) == gen, bar);
            __builtin_amdgcn_fence(__ATOMIC_ACQUIRE, "agent");
            asm volatile("s_waitcnt vmcnt(0)" ::: "memory");
        }
    }
    __syncthreads();
}

struct Args { const void* in[23]; float* out; unsigned char* ws; int ph_lo, ph_hi; };
enum { I_X = 0, I_C, I_POS, I_WADA, I_BADA, I_NORM_MIX, I_WIN, I_CONVW, I_ALOG, I_DTB, I_GNORM, I_QNORM, I_KNORM, I_SINKS, I_WOUT, I_NORM_FFN, I_WGRP, I_BGRP, I_WRT, I_BRT, I_WGATE, I_WUP, I_WDOWN };

template <class CM>
__device__ __forceinline__ void transpose_item(const float* W, int ldw, int k0, bf16* WT, int ldt, int n0, CM cm, LAS float* scr, int lane) {
    const int sc = cm(n0 + (lane & 31));
    float tv[32];
#pragma unroll
    for (int i = 0; i < 32; ++i) { const int kk = 2 * i + (lane >> 5); tv[i] = W[(size_t)(k0 + kk) * ldw + (sc >= 0 ? sc : 0)]; }
#pragma unroll
    for (int i = 0; i < 32; ++i) { const int kk = 2 * i + (lane >> 5); scr[kk * 33 + (lane & 31)] = sc >= 0 ? tv[i] : 0.f; }
    LDS_WAIT(); asm volatile("" ::: "memory");
    const int c = lane & 7;
#pragma unroll
    for (int j = 0; j < 4; ++j) { const int n = (lane >> 3) + 8 * j; const LAS float* s = scr + (8 * c) * 33 + n;
        v4u o; o.x = pk2(s[0 * 33], s[1 * 33]); o.y = pk2(s[2 * 33], s[3 * 33]); o.z = pk2(s[4 * 33], s[5 * 33]); o.w = pk2(s[6 * 33], s[7 * 33]);
        *(v4u*)(WT + (size_t)(n0 + n) * ldt + k0 + 8 * c) = o; }
    LDS_WAIT(); asm volatile("" ::: "memory");
}
struct CmIn { __device__ __forceinline__ int operator()(int n) const { return n < 2048 ? n : (n < 2816 ? n + 16 : (n < 2832 ? 2048 + (n - 2816) : -1)); } };
struct CmOff { int off; __device__ __forceinline__ int operator()(int n) const { return n + off; } };
struct CmId { __device__ __forceinline__ int operator()(int n) const { return n; } };

__device__ __forceinline__ void p0_prologue(const Args& A, LAS unsigned char* lds, int tid, int lane, int wave) {
    unsigned char* ws = A.ws;
    LAS float* scr = (LAS float*)(lds + wave * 8448);
    const int G = gridDim.x, gw = blockIdx.x * NWAVES + wave, NGW = G * NWAVES;
    constexpr int IT_IN = (NPAD / 32) * (DM / 64), IT_OUT = (DM / 32) * (DM / 64);
    for (int it = gw; it < IT_IN + IT_OUT; it += NGW) {
        if (it < IT_IN) { const int nb = it % (NPAD / 32), kb = it / (NPAD / 32); transpose_item((const float*)A.in[I_WIN], 2832, kb * 64, (bf16*)(ws + WS_WINT), DM, nb * 32, CmIn(), scr, lane); }
        else { const int r = it - IT_IN, nb = r % (DM / 32), kb = r / (DM / 32); transpose_item((const float*)A.in[I_WOUT], DM, kb * 64, (bf16*)(ws + WS_WOUTT), DM, nb * 32, CmId(), scr, lane); }
    }
    {   constexpr int IT_GU = NE * 16 * 16, IT_D = NE * 32 * 4;
        const float* wgate = (const float*)A.in[I_WGATE]; const float* wup = (const float*)A.in[I_WUP]; const float* wdown = (const float*)A.in[I_WDOWN];
        for (int it = gw; it < IT_GU + IT_D; it += NGW) {
            if (it < IT_GU) { const int e = it >> 8, r = it & 255, nb = r & 15, kb = r >> 4, j = nb >> 3, q = nb & 7;
                const float* W = (q < 4 ? wgate : wup) + (size_t)e * 1024 * 256; const int col0 = j * 128 + (q & 3) * 32;
                transpose_item(W, 256, kb * 64, (bf16*)(ws + WS_WGUT) + (size_t)e * 512 * 1024, 1024, nb * 32, CmOff{col0 - nb * 32}, scr, lane); }
            else { const int r2 = it - IT_GU, e = r2 >> 7, r = r2 & 127, nb = r & 31, kb = r >> 5;
                transpose_item(wdown + (size_t)e * 256 * 1024, 1024, kb * 64, (bf16*)(ws + WS_WDT) + (size_t)e * 1024 * 256, 256, nb * 32, CmId(), scr, lane); }
        }
    }
    {   const float* wgp = (const float*)A.in[I_WGRP]; const float* wrt = (const float*)A.in[I_WRT];
        bf16* wf = (bf16*)(ws + WS_WRT);
        for (int idx = blockIdx.x * NTHR + tid; idx < 48 * 1024; idx += G * NTHR) { const int j = idx & 7, ln = (idx >> 3) & 63, ks = (idx >> 9) & 31, nt = idx >> 14;
            const int o = 16 * nt + (ln & 15), k = 32 * ks + 8 * (ln >> 4) + j;
            const float w = o < 4 ? wgp[k * 4 + o] : (o < 36 ? wrt[k * 32 + o - 4] : 0.f);
            const unsigned hb = f2bf(w); wf[idx] = (bf16)hb; wf[48 * 1024 + idx] = (bf16)f2bf(w - __builtin_bit_cast(float, hb << 16)); }
    }
    LAS float* cact = (LAS float*)(lds + 69632);
    LAS float* red = (LAS float*)(lds + 69632 + 16384);
    const float* c = (const float*)A.in[I_C]; const float* wada = (const float*)A.in[I_WADA]; const float* bada = (const float*)A.in[I_BADA];
    float* mod = (float*)(ws + WS_MOD);
    if ((int)blockIdx.x < 96) {
        __syncthreads();
        for (int i = tid; i < 4096; i += NTHR) cact[i] = siluf(c[i]);
        __syncthreads();
        for (int u = blockIdx.x; u < 96; u += G) {
            const int n = u * 64 + lane; float a0 = 0.f, a1 = 0.f, a2 = 0.f, a3 = 0.f;
#pragma unroll 16
            for (int k = wave * 128; k < wave * 128 + 128; ++k) { const float w = wada[(size_t)k * 6144 + n]; a0 += cact[k] * w; a1 += cact[1024 + k] * w; a2 += cact[2048 + k] * w; a3 += cact[3072 + k] * w; }
            red[(wave * 4 + 0) * 64 + lane] = a0; red[(wave * 4 + 1) * 64 + lane] = a1; red[(wave * 4 + 2) * 64 + lane] = a2; red[(wave * 4 + 3) * 64 + lane] = a3;
            __syncthreads();
            if (tid < 256) { const int b = tid >> 6, l = tid & 63; float s = bada[u * 64 + l];
#pragma unroll
                for (int w = 0; w < 8; ++w) s += red[(w * 4 + b) * 64 + l];
                mod[b * 6144 + u * 64 + l] = s; }
            __syncthreads();
        }
    }
}

template <bool ROUTE>
__device__ __forceinline__ void norm_rows(const Args& A, const float* X, const float* gain, const float* shift, const float* scale, bf16* H, LAS unsigned char* lds, int lane, int wave) {
    LAS float* hl = (LAS float*)(lds + wave * 4096);
    const int G = gridDim.x, gw = blockIdx.x * NWAVES + wave, NGW = G * NWAVES;
    unsigned char* ws = A.ws;
    for (int r0 = gw * 16; r0 < TT; r0 += NGW * 16) {
        const int b = r0 / SEQ;
        f32x4 mf[4], af[4];
#pragma unroll
        for (int j = 0; j < 4; ++j) { const int col = 4 * lane + 256 * j; const f32x4 g = *(const f32x4*)(gain + col), sc = *(const f32x4*)(scale + b * 6144 + col);
            mf[j] = g * (sc + 1.0f); af[j] = *(const f32x4*)(shift + b * 6144 + col); }
#pragma unroll 4
        for (int i = 0; i < 16; ++i) {
            const int row = r0 + i;
            const f32x4* xr = (const f32x4*)(X + (size_t)row * DM) + lane;
            f32x4 v[4]; float s = 0.f;
#pragma unroll
            for (int j = 0; j < 4; ++j) { v[j] = xr[64 * j]; s += (v[j].x * v[j].x + v[j].y * v[j].y) + (v[j].z * v[j].z + v[j].w * v[j].w); }
            const float rstd = 1.f / sqrtf(wave_sum(s) * (1.f / DM) + EPS);
            unsigned long long* o8 = (unsigned long long*)(H + (size_t)row * DM) + lane;
#pragma unroll
            for (int j = 0; j < 4; ++j) { v[j] = v[j] * rstd * mf[j] + af[j];
                o8[64 * j] = (unsigned long long)pk2(v[j].x, v[j].y) | ((unsigned long long)pk2(v[j].z, v[j].w) << 32); }
            if constexpr (ROUTE) {
                const float* wg = (const float*)A.in[I_WGRP]; const float* wr = (const float*)A.in[I_WRT];
                float lg[36];
#pragma unroll
                for (int o = 0; o < 36; ++o) lg[o] = 0.f;
#pragma unroll
                for (int j = 0; j < 4; ++j) *(LAS f32x4*)(hl + 4 * lane + 256 * j) = v[j];
                LDS_WAIT(); asm volatile("" ::: "memory");
#pragma unroll 1
                for (int ii = 0; ii < 16; ++ii) { const int k = lane + 64 * ii; const float hv = hl[k];
                    const f32x4 g4 = *(const f32x4*)(wg + k * 4);
                    lg[0] += hv * g4.x; lg[1] += hv * g4.y; lg[2] += hv * g4.z; lg[3] += hv * g4.w;
#pragma unroll
                    for (int q = 0; q < 8; ++q) { const f32x4 r4 = *(const f32x4*)(wr + k * 32 + q * 4);
                        lg[4 + q * 4 + 0] += hv * r4.x; lg[4 + q * 4 + 1] += hv * r4.y; lg[4 + q * 4 + 2] += hv * r4.z; lg[4 + q * 4 + 3] += hv * r4.w; } }
                LDS_WAIT(); asm volatile("" ::: "memory");
#pragma unroll
                for (int o = 0; o < 36; ++o) lg[o] = wave_sum(lg[o]);
                const float* bg = (const float*)A.in[I_BGRP]; const float* br = (const float*)A.in[I_BRT];
#pragma unroll
                for (int o = 0; o < 4; ++o) lg[o] += bg[o];
#pragma unroll
                for (int o = 0; o < 32; ++o) lg[4 + o] += br[o];
                int gi = 0; float gm = lg[0];
#pragma unroll
                for (int o = 1; o < 4; ++o) if (lg[o] > gm) { gm = lg[o]; gi = o; }
                float gs = 0.f;
#pragma unroll
                for (int o = 0; o < 4; ++o) gs += __expf(lg[o] - gm);
                const float pg = 1.f / gs;
                float le[8];
#pragma unroll
                for (int j = 0; j < 8; ++j) { le[j] = lg[4 + j];
#pragma unroll
                    for (int g = 1; g < 4; ++g) le[j] = (gi == g) ? lg[4 + g * 8 + j] : le[j]; }
                int j1 = 0; float m1 = le[0];
#pragma unroll
                for (int j = 1; j < 8; ++j) if (le[j] > m1) { m1 = le[j]; j1 = j; }
                int j2 = -1; float m2 = -3.0e38f;
#pragma unroll
                for (int j = 0; j < 8; ++j) if (j != j1 && le[j] > m2) { m2 = le[j]; j2 = j; }
                const float ex = __expf(m2 - m1), w1 = pg / (1.f + ex), w2 = pg * ex / (1.f + ex);
                if (lane == 0) {
                    const int e1 = gi * 8 + j1, e2 = gi * 8 + j2;
                    unsigned* ctl = (unsigned*)(ws + WS_CTL);
                    int2* erec = (int2*)(ws + WS_EREC); int* clist = (int*)(ws + WS_CLIST);
                    const unsigned p1 = atomicAdd(ctl + CW_ECNT + e1, 1u); erec[(size_t)e1 * TT + p1] = make_int2(row * 2 + (e1 > e2 ? 1 : 0), __builtin_bit_cast(int, w1));
                    const unsigned p2 = atomicAdd(ctl + CW_ECNT + e2, 1u); erec[(size_t)e2 * TT + p2] = make_int2(row * 2 + (e2 > e1 ? 1 : 0), __builtin_bit_cast(int, w2));
                    const int a = j1 < j2 ? j1 : j2, bb = j1 < j2 ? j2 : j1;
                    const int cls = gi * 28 + (a * 7 - (a * (a - 1)) / 2 + (bb - a - 1));
                    const unsigned pc = atomicAdd(ctl + CW_CCNT + cls, 1u); clist[(size_t)cls * TT + pc] = row;
                }
            }
        }
    }
}

typedef short bf16x8_t __attribute__((ext_vector_type(8)));
typedef float f32x16 __attribute__((ext_vector_type(16)));
typedef unsigned v2u __attribute__((ext_vector_type(2)));
typedef float f32x2_t __attribute__((ext_vector_type(2)));
typedef __bf16 bf16x2_t __attribute__((ext_vector_type(2)));
__device__ __forceinline__ unsigned cvtpk(float lo, float hi) { const f32x2_t f = {lo, hi}; return __builtin_bit_cast(unsigned, __builtin_convertvector(f, bf16x2_t)); }
__device__ __forceinline__ void fast_sincos(float ang, float& sn, float& cs) {
    float rev = ang * 0.15915494309189535f; rev -= floorf(rev);
    sn = __builtin_amdgcn_sinf(rev); cs = __builtin_amdgcn_cosf(rev);
}
__device__ __forceinline__ void swa_mfma(const Args& A, LAS unsigned char* lds, int tid, int lane, int wave, int blk, int nblk) {
    unsigned char* ws = A.ws;
    const bf16* proj = (const bf16*)(ws + WS_PROJ);
    bf16* mix = (bf16*)(ws + WS_MIX); const float* sinks = (const float*)A.in[I_SINKS];
    const int* pos = (const int*)A.in[I_POS]; const float* qn = (const float*)A.in[I_QNORM]; const float* kn = (const float*)A.in[I_KNORM];
    constexpr int KST = 144, VST = 520;
    LAS unsigned char* Kl = lds; LAS unsigned char* Vt = lds + 256 * KST;
    const int g = wave >> 1, qh = wave & 1, ql = lane & 31, hh = lane >> 5;
    constexpr float LOG2E = 1.4426950408889634f, CS = 0.125f * LOG2E, L2T = 13.287712379549449f / 32.f;
    const int sch = tid & 7;
    float kinv[8], kgn[8];
#pragma unroll
    for (int j = 0; j < 8; ++j) { kinv[j] = __builtin_amdgcn_exp2f(-(float)((sch & 3) * 8 + j) * L2T); kgn[j] = kn[sch * 8 + j]; }
    float qinv[2][8];
#pragma unroll
    for (int ks = 0; ks < 2; ++ks)
#pragma unroll
        for (int j = 0; j < 8; ++j) qinv[ks][j] = __builtin_amdgcn_exp2f(-(float)(ks * 16 + hh * 8 + j) * L2T);
    for (int u = blk; u < NB * 2 * (SEQ / 128); u += nblk) {
        const int n = u & 63, kvh = (u >> 6) & 1, b = u >> 7;
        const int tb = b * SEQ + n * 128;
        __syncthreads();
#pragma unroll
        for (int it = 0; it < 4; ++it) { const int idx = tid + it * NTHR, key = idx >> 3, ch = idx & 7; int tk = tb - 128 + key; if (tk < b * SEQ) tk = b * SEQ;
            const v4u kv = *(const v4u*)(proj + (size_t)tk * NPROJ + PC_SK + kvh * 64 + ch * 8);
            const v4u vv = *(const v4u*)(proj + (size_t)tk * NPROJ + PC_SV + kvh * 64 + ch * 8);
            const float pf = (float)pos[tk];
            float x[8] = { __builtin_bit_cast(float, kv.x << 16), __builtin_bit_cast(float, kv.x & 0xffff0000u), __builtin_bit_cast(float, kv.y << 16), __builtin_bit_cast(float, kv.y & 0xffff0000u),
                           __builtin_bit_cast(float, kv.z << 16), __builtin_bit_cast(float, kv.z & 0xffff0000u), __builtin_bit_cast(float, kv.w << 16), __builtin_bit_cast(float, kv.w & 0xffff0000u) };
            float ss = 0.f;
#pragma unroll
            for (int j = 0; j < 8; ++j) ss += x[j] * x[j];
            ss += __shfl_xor(ss, 1); ss += __shfl_xor(ss, 2); ss += __shfl_xor(ss, 4);
            const float rn = 1.f / sqrtf(ss * (1.f / 64.f) + EPS);
            float o[8];
#pragma unroll
            for (int j = 0; j < 8; ++j) { const float xn = x[j] * rn * kgn[j]; const float pr = __shfl_xor(xn, 4); float sn, cs; fast_sincos(pf * kinv[j], sn, cs);
                o[j] = (ch < 4) ? xn * cs - pr * sn : pr * sn + xn * cs; }
            v4u ko; ko.x = cvtpk(o[0], o[1]); ko.y = cvtpk(o[2], o[3]); ko.z = cvtpk(o[4], o[5]); ko.w = cvtpk(o[6], o[7]);
            *(LAS v4u*)(Kl + key * KST + ch * 16) = ko;
            LAS unsigned short* vp = (LAS unsigned short*)(Vt + (ch * 8) * VST + key * 2);
            vp[0 * (VST / 2)] = (unsigned short)(vv.x & 0xffffu); vp[1 * (VST / 2)] = (unsigned short)(vv.x >> 16);
            vp[2 * (VST / 2)] = (unsigned short)(vv.y & 0xffffu); vp[3 * (VST / 2)] = (unsigned short)(vv.y >> 16);
            vp[4 * (VST / 2)] = (unsigned short)(vv.z & 0xffffu); vp[5 * (VST / 2)] = (unsigned short)(vv.z >> 16);
            vp[6 * (VST / 2)] = (unsigned short)(vv.w & 0xffffu); vp[7 * (VST / 2)] = (unsigned short)(vv.w >> 16); }
        __syncthreads();
        const int hq = kvh * 4 + g; const float sinkl = sinks[hq] * LOG2E;
#pragma unroll 1
        for (int qt = 0; qt < 2; ++qt) {
            const int i0 = qh * 64 + qt * 32, iq = i0 + ql;
            const size_t tq = (size_t)(tb + iq);
            bf16x8_t qf[4];
            {   float xq[4][8]; float ss = 0.f;
#pragma unroll
                for (int ks = 0; ks < 4; ++ks) { const v4u r = *(const v4u*)(proj + tq * NPROJ + PC_SQ + hq * 64 + ks * 16 + hh * 8);
                    xq[ks][0] = __builtin_bit_cast(float, r.x << 16); xq[ks][1] = __builtin_bit_cast(float, r.x & 0xffff0000u); xq[ks][2] = __builtin_bit_cast(float, r.y << 16); xq[ks][3] = __builtin_bit_cast(float, r.y & 0xffff0000u);
                    xq[ks][4] = __builtin_bit_cast(float, r.z << 16); xq[ks][5] = __builtin_bit_cast(float, r.z & 0xffff0000u); xq[ks][6] = __builtin_bit_cast(float, r.w << 16); xq[ks][7] = __builtin_bit_cast(float, r.w & 0xffff0000u);
#pragma unroll
                    for (int j = 0; j < 8; ++j) ss += xq[ks][j] * xq[ks][j]; }
                ss += __shfl_xor(ss, 32);
                const float rn = 1.f / sqrtf(ss * (1.f / 64.f) + EPS); const float pf = (float)pos[tq];
#pragma unroll
                for (int ks = 0; ks < 4; ++ks)
#pragma unroll
                    for (int j = 0; j < 8; ++j) xq[ks][j] *= rn * qn[ks * 16 + hh * 8 + j];
#pragma unroll
                for (int ks = 0; ks < 2; ++ks)
#pragma unroll
                    for (int j = 0; j < 8; ++j) { float sn, cs; fast_sincos(pf * qinv[ks][j], sn, cs); const float x1 = xq[ks][j], x2 = xq[ks + 2][j];
                        xq[ks][j] = x1 * cs - x2 * sn; xq[ks + 2][j] = x1 * sn + x2 * cs; }
#pragma unroll
                for (int ks = 0; ks < 4; ++ks) { union { bf16x8_t v; unsigned u[4]; } p; p.u[0] = cvtpk(xq[ks][0], xq[ks][1]); p.u[1] = cvtpk(xq[ks][2], xq[ks][3]); p.u[2] = cvtpk(xq[ks][4], xq[ks][5]); p.u[3] = cvtpk(xq[ks][6], xq[ks][7]); qf[ks] = p.v; }
            }
            f32x16 sc[5];
#pragma unroll
            for (int kt = 0; kt < 5; ++kt) { f32x16 acc;
#pragma unroll
                for (int r = 0; r < 16; ++r) acc[r] = 0.f;
#pragma unroll
                for (int ks = 0; ks < 4; ++ks) { const bf16x8_t kf = *(const LAS bf16x8_t*)(Kl + (i0 + 32 * kt + ql) * KST + (ks * 16 + hh * 8) * 2);
                    acc = __builtin_amdgcn_mfma_f32_32x32x16_bf16(kf, qf[ks], acc, 0, 0, 0); }
                sc[kt] = acc; }
            float mloc = -3.0e38f;
#pragma unroll
            for (int kt = 0; kt < 5; ++kt) {
                if (kt == 0 || kt == 4 || n == 0) {
#pragma unroll
                    for (int r = 0; r < 16; ++r) { const int j = i0 + 32 * kt + (r & 3) + 8 * (r >> 2) + 4 * hh;
                        const bool valid = (j > iq) && (j <= iq + 128) && (n > 0 || j >= 128);
                        const float sv = valid ? sc[kt][r] * CS : -1.0e30f; sc[kt][r] = sv; mloc = fmaxf(mloc, sv); }
                } else {
#pragma unroll
                    for (int r = 0; r < 16; ++r) { const float sv = sc[kt][r] * CS; sc[kt][r] = sv; mloc = fmaxf(mloc, sv); }
                } }
            float mx = fmaxf(mloc, __shfl_xor(mloc, 32)); mx = fmaxf(mx, sinkl);
            float lsum = 0.f;
#pragma unroll
            for (int kt = 0; kt < 5; ++kt)
#pragma unroll
                for (int r = 0; r < 16; ++r) { const float p = __builtin_amdgcn_exp2f(sc[kt][r] - mx); sc[kt][r] = p; lsum += p; }
            lsum += __shfl_xor(lsum, 32); lsum += __builtin_amdgcn_exp2f(sinkl - mx);
            f32x16 o0, o1;
#pragma unroll
            for (int r = 0; r < 16; ++r) { o0[r] = 0.f; o1[r] = 0.f; }
#pragma unroll
            for (int kt = 0; kt < 5; ++kt)
#pragma unroll
                for (int s2 = 0; s2 < 2; ++s2) {
                    union { bf16x8_t v; unsigned u[4]; } pf;
#pragma unroll
                    for (int p = 0; p < 4; ++p) pf.u[p] = cvtpk(sc[kt][8 * s2 + 2 * p], sc[kt][8 * s2 + 2 * p + 1]);
                    const int jb = i0 + 32 * kt + 16 * s2 + 4 * hh;
                    union { bf16x8_t v; v2u u[2]; } v0, v1;
                    const LAS unsigned char* r0 = Vt + ql * VST + jb * 2; const LAS unsigned char* r1 = Vt + (32 + ql) * VST + jb * 2;
                    v0.u[0] = *(const LAS v2u*)(r0); v0.u[1] = *(const LAS v2u*)(r0 + 16);
                    v1.u[0] = *(const LAS v2u*)(r1); v1.u[1] = *(const LAS v2u*)(r1 + 16);
                    o0 = __builtin_amdgcn_mfma_f32_32x32x16_bf16(v0.v, pf.v, o0, 0, 0, 0);
                    o1 = __builtin_amdgcn_mfma_f32_32x32x16_bf16(v1.v, pf.v, o1, 0, 0, 0);
                }
            const float il = 1.f / lsum;
            bf16* op = mix + tq * DM + 512 + hq * 64 + 4 * hh;
#pragma unroll
            for (int rq = 0; rq < 4; ++rq) {
                v2u w0; w0.x = cvtpk(o0[4 * rq] * il, o0[4 * rq + 1] * il); w0.y = cvtpk(o0[4 * rq + 2] * il, o0[4 * rq + 3] * il);
                *(v2u*)(op + 8 * rq) = w0;
                v2u w1; w1.x = cvtpk(o1[4 * rq] * il, o1[4 * rq + 1] * il); w1.y = cvtpk(o1[4 * rq + 2] * il, o1[4 * rq + 3] * il);
                *(v2u*)(op + 32 + 8 * rq) = w1; }
        }
    }
}

__device__ __forceinline__ int frag_a_idx(int row, int col) { const int mt = row >> 4, l15 = row & 15, ks = col >> 5, x = col & 31, jh = x >> 4, g4 = (x >> 2) & 3, jl = x & 3; return ((mt * 2 + ks) * 64 + g4 * 16 + l15) * 8 + 4 * jh + jl; }
__device__ __forceinline__ int frag_c_idx(int row, int col) { const int w = col >> 4, l15 = col & 15, mt = row >> 4, y = row & 15, g4 = y >> 2, i = y & 3; return ((w * 64 + g4 * 16 + l15) * 4 + mt) * 4 + i; }
__device__ __forceinline__ void gdn_g1_naive(const Args& A, LAS float* L, int tid) {
    unsigned char* ws = A.ws;
    const bf16* proj = (const bf16*)(ws + WS_PROJ); const float* ab = (const float*)(ws + WS_AB);
    bf16* AP = (bf16*)(ws + WS_GAP); bf16* BP = (bf16*)(ws + WS_GBP); bf16* QP = (bf16*)(ws + WS_GQP); bf16* OP = (bf16*)(ws + WS_GOP); float* GL = (float*)(ws + WS_GGL);
    const float* convw = (const float*)A.in[I_CONVW];
    constexpr int LD = 65, AR = 64 * LD;
    LAS float* q = L; LAS float* k = q + AR; LAS float* v = k + AR; LAS float* Mm = v + AR; LAS float* At = Mm + AR; LAS float* w = At + AR;
    LAS float* Gc = w + AR; LAS float* beta = Gc + 64;
    const int i8 = tid >> 3, e0 = (tid & 7) * 8;
    for (int cid = blockIdx.x; cid < NB * 8 * 128; cid += gridDim.x) {
        const int n = cid & 127, bh = cid >> 7, b = bh >> 3, h = bh & 7;
        const float Ah = expf(((const float*)A.in[I_ALOG])[h]), dtb = ((const float*)A.in[I_DTB])[h];
        const int t0 = b * SEQ + n * 64;
        __syncthreads();
        for (int idx = tid; idx < 3 * 4096; idx += NTHR) {
            const int part = idx >> 12, rem = idx & 4095, i = rem >> 6, d = rem & 63, c = part * 512 + h * 64 + d;
            float y = 0.f;
#pragma unroll
            for (int j = 0; j < 4; ++j) { const int s = n * 64 + i - 3 + j; if (s >= 0) y += convw[j * 1536 + c] * bf2f(proj[(size_t)(b * SEQ + s) * NPROJ + c]); }
            y = y / (1.f + __expf(-y));
            (part == 0 ? q : (part == 1 ? k : v))[i * LD + d] = y;
        }
        if (tid < 64) { const float a = ab[(size_t)(t0 + tid) * 16 + h], bb = ab[(size_t)(t0 + tid) * 16 + 8 + h]; const float xx = a + dtb;
            const float sp = xx > 20.f ? xx : log1pf(expf(xx)); Gc[tid] = -Ah * sp; beta[tid] = 1.f / (1.f + __expf(-bb)); }
        __syncthreads();
        if (tid < 128) { LAS float* arr = tid < 64 ? q : k; const int i = tid & 63; float ss = 0.f;
            for (int d = 0; d < 64; ++d) ss += arr[i * LD + d] * arr[i * LD + d];
            const float r = (1.f / sqrtf(ss + EPS)) * (tid < 64 ? 0.125f : 1.f);
            for (int d = 0; d < 64; ++d) arr[i * LD + d] *= r; }
        if (tid == 128) { float run = 0.f; for (int i = 0; i < 64; ++i) { run += Gc[i]; Gc[i] = run; } }
        __syncthreads();
        {   const int i = i8;
            for (int jj = 0; jj < 8; ++jj) { const int j = e0 + jj; float dq = 0.f, dk = 0.f;
_Pragma("unroll 2") for (int d = 0; d < 64; ++d) { const float kj = k[j * LD + d]; dq += q[i * LD + d] * kj; dk += k[i * LD + d] * kj; }
                const float dec = (i >= j) ? __expf(Gc[i] - Gc[j]) : 0.f;
                At[i * LD + j] = dq * dec; Mm[i * LD + j] = (i > j) ? dk * beta[i] * dec : 0.f; }
        }
        __syncthreads();
        for (int idx = tid; idx < 4096; idx += NTHR) { const int i = idx >> 6, d = idx & 63; v[i * LD + d] *= beta[i]; w[i * LD + d] = k[i * LD + d] * beta[i] * __expf(Gc[i]); }
        __syncthreads();
        if (tid < 128) { LAS float* arr = tid < 64 ? v : w; const int c = tid & 63;
            _Pragma("unroll 1") for (int i = 1; i < 64; ++i) { float a = arr[i * LD + c]; _Pragma("unroll 4") for (int j = 0; j < i; ++j) a -= Mm[i * LD + j] * arr[j * LD + c]; arr[i * LD + c] = a; } }
        __syncthreads();
        const float gl = Gc[63];
        const size_t cb = (size_t)cid * 4096;
        {
            const int d = i8; float a[8], bq[8];
#pragma unroll
            for (int ee = 0; ee < 8; ++ee) { a[ee] = 0.f; bq[ee] = 0.f; }
_Pragma("unroll 2")
            for (int c = 0; c < 64; ++c) { const float kd = k[c * LD + d] * __expf(gl - Gc[c]);
#pragma unroll
                for (int ee = 0; ee < 8; ++ee) { a[ee] -= kd * w[c * LD + e0 + ee]; bq[ee] += kd * v[c * LD + e0 + ee]; } }
#pragma unroll
            for (int ee = 0; ee < 8; ++ee) { const int dp = e0 + ee; AP[cb + frag_a_idx(d, dp)] = (bf16)f2bf(a[ee]); BP[cb + frag_c_idx(d, dp)] = (bf16)f2bf(bq[ee]); }
        }
        {
            const int c = i8; float a[8], bq[8]; const float eg = __expf(Gc[c]);
#pragma unroll
            for (int ee = 0; ee < 8; ++ee) { a[ee] = eg * q[c * LD + e0 + ee]; bq[ee] = 0.f; }
_Pragma("unroll 2")
            for (int s2 = 0; s2 <= c; ++s2) { const float av = At[c * LD + s2];
#pragma unroll
                for (int ee = 0; ee < 8; ++ee) { a[ee] -= av * w[s2 * LD + e0 + ee]; bq[ee] += av * v[s2 * LD + e0 + ee]; } }
#pragma unroll
            for (int ee = 0; ee < 8; ++ee) { const int dp = e0 + ee; QP[cb + frag_a_idx(c, dp)] = (bf16)f2bf(a[ee]); OP[cb + frag_c_idx(c, dp)] = (bf16)f2bf(bq[ee]); }
        }
        if (tid == 0) GL[cid] = __expf(gl);
    }
}
__device__ __forceinline__ float wave_incl_scan_f(float v, int lane) {
#pragma unroll
    for (int o = 1; o < 64; o <<= 1) { const float t = __shfl_up(v, o); if (lane >= o) v += t; }
    return v;
}
__device__ __forceinline__ v2u pack4(f32x4 v) { v2u r; r.x = cvtpk(v.x, v.y); r.y = cvtpk(v.z, v.w); return r; }
__device__ __forceinline__ bf16x8_t mk8(v2u lo, v2u hi) { union { bf16x8_t v; unsigned u[4]; } x; x.u[0] = lo.x; x.u[1] = lo.y; x.u[2] = hi.x; x.u[3] = hi.y; return x.v; }
template <int SM, int STG = 7>
__device__ __forceinline__ void gdn_g1_mfma(const Args& A, LAS unsigned char* lds, int tid, int lane, int wave) {
    unsigned char* ws = A.ws;
    const bf16* proj = (const bf16*)(ws + WS_PROJ); const float* ab = (const float*)(ws + WS_AB);
    bf16* AP = (bf16*)(ws + WS_GAP); bf16* BP = (bf16*)(ws + WS_GBP); bf16* QP = (bf16*)(ws + WS_GQP); bf16* OP = (bf16*)(ws + WS_GOP); float* GL = (float*)(ws + WS_GGL);
    const float* convw = (const float*)A.in[I_CONVW];
    constexpr int KST = 144, RST = 68;
    LAS unsigned char* const Kr0 = lds;
    const int l15 = lane & 15, g4 = lane >> 4;
    const v2u zero2 = {0u, 0u};
    const int G = gridDim.x;
    const int ppart = wave >> 1, pt4 = 4 * ((wave & 1) * 8 + (lane >> 3)), pd0 = (lane & 7) * 8;
    v4u xr7[7];
#define G1_PREFETCH(IDX) do { if (wave < 6) { const int h_ = (IDX) & 7, bn_ = (IDX) >> 3, b_ = bn_ >> 7, n_ = bn_ & 127; \
        _Pragma("unroll") for (int r = 0; r < 7; ++r) { const int s_ = n_ * 64 + pt4 - 3 + r, sc_ = s_ < 0 ? 0 : s_; \
            const v4u r_ = *(const v4u*)(proj + (size_t)(b_ * SEQ + sc_) * NPROJ + ppart * 512 + h_ * 64 + pd0); const unsigned m_ = s_ < 0 ? 0u : 0xffffffffu; \
            xr7[r] = (v4u){r_.x & m_, r_.y & m_, r_.z & m_, r_.w & m_}; } } } while (0)
    int hcur = -1;
    constexpr int NC = NB * 8 * 128;
    if ((int)blockIdx.x < NC) G1_PREFETCH((int)blockIdx.x);
    for (int base = blockIdx.x; base < NC; base += 16 * G) {
    {
        LAS float* const GsT0 = (LAS float*)(Kr0 + 91648);
        __syncthreads();
        for (int q = wave; q < 16; q += 8) { const int idx2 = base + q * G;
            if (idx2 < NC) { const int h2 = idx2 & 7, bn2 = idx2 >> 3, b2 = bn2 >> 7, n2 = bn2 & 127;
                const size_t t2 = (size_t)(b2 * SEQ + n2 * 64 + lane) * 16;
                const float Ah = __expf(((const float*)A.in[I_ALOG])[h2]), dtb = ((const float*)A.in[I_DTB])[h2];
                const float xx = ab[t2 + h2] + dtb, bb2 = ab[t2 + 8 + h2];
                const float sp = xx > 20.f ? xx : log1pf(__expf(xx));
                const float Gv = wave_incl_scan_f(-Ah * sp, lane);
                GsT0[q * 64 + lane] = Gv; GsT0[1024 + q * 64 + lane] = 1.f / (1.f + __expf(-bb2));
                if ((SM & 16) && lane == 63) GL[(b2 * 8 + h2) * 128 + n2] = __expf(Gv); } }
    }
#pragma unroll 1
    for (int it = 0; it < 16; ++it) {
        const int idx = base + it * G; if (idx >= NC) break;
        const int h = idx & 7, bn = idx >> 3, b = bn >> 7, n = bn & 127, bh = b * 8 + h, cid = bh * 128 + n;
        const size_t cb = (size_t)cid * 4096;
        int oz = 0; asm volatile("" : "+v"(oz));
        LAS unsigned char* const Kr = Kr0 + oz; LAS unsigned char* const Qr = Kr + 9216; LAS unsigned char* const kdT = Kr + 18432; LAS unsigned char* const Mm = Kr + 27648; LAS unsigned char* const At = Kr + 36864;
        LAS float* const Rt = (LAS float*)(Kr + 46080);
        LAS float* const Md = (LAS float*)(Kr + 80896);
        LAS unsigned char* const Tl = Kr + 86016;
        LAS float* const Gs = (LAS float*)(Kr + 91648) + 64 * it; LAS float* const Bs = Gs + 1024;
        LAS float* const cwl = (LAS float*)(Kr + 88576);
        __syncthreads();
        if (h != hcur) { hcur = h; for (int q = tid; q < 768; q += NTHR) { const int part = q >> 8, j = (q >> 6) & 3, d = q & 63; cwl[q] = convw[j * 1536 + part * 512 + h * 64 + d]; } __syncthreads(); }
        const bool more = (idx + G < NC);
        if (wave < 6) {
            const int d0 = pd0, t4 = pt4, dg = d0 >> 3, swk = dg << 3, swr = (dg & 3) << 3;
            float y[4][8];
            {   float wv[4][8];
#pragma unroll
                for (int j = 0; j < 4; ++j) { const f32x4 w0 = *(const LAS f32x4*)(cwl + (ppart * 4 + j) * 64 + d0), w1 = *(const LAS f32x4*)(cwl + (ppart * 4 + j) * 64 + d0 + 4);
                    wv[j][0] = w0.x; wv[j][1] = w0.y; wv[j][2] = w0.z; wv[j][3] = w0.w; wv[j][4] = w1.x; wv[j][5] = w1.y; wv[j][6] = w1.z; wv[j][7] = w1.w; }
#define G1_XE(r, e) __builtin_bit_cast(float, ((e) & 1) ? (((e) >> 1) == 0 ? xr7[r].x : ((e) >> 1) == 1 ? xr7[r].y : ((e) >> 1) == 2 ? xr7[r].z : xr7[r].w) & 0xffff0000u \
                                                        : (((e) >> 1) == 0 ? xr7[r].x : ((e) >> 1) == 1 ? xr7[r].y : ((e) >> 1) == 2 ? xr7[r].z : xr7[r].w) << 16)
#pragma unroll
                for (int tk = 0; tk < 4; ++tk)
#pragma unroll
                    for (int e = 0; e < 8; ++e) { const float a_ = wv[0][e] * G1_XE(tk, e) + wv[1][e] * G1_XE(tk + 1, e) + wv[2][e] * G1_XE(tk + 2, e) + wv[3][e] * G1_XE(tk + 3, e);
                        y[tk][e] = a_ * __builtin_amdgcn_rcpf(1.f + __expf(-a_)); }
#undef G1_XE
            }
            if (more) G1_PREFETCH(idx + G);
            const f32x4 G4 = *(const LAS f32x4*)(Gs + t4), B4 = *(const LAS f32x4*)(Bs + t4); const float gl = Gs[63];
            if (ppart < 2) {
                float rn[4];
#pragma unroll
                for (int tk = 0; tk < 4; ++tk) { float ss = 0.f;
#pragma unroll
                    for (int e = 0; e < 8; ++e) ss += y[tk][e] * y[tk][e];
                    ss += __shfl_xor(ss, 1); ss += __shfl_xor(ss, 2); ss += __shfl_xor(ss, 4);
                    rn[tk] = (1.f / sqrtf(ss + EPS)) * (ppart == 0 ? 0.125f : 1.f); }
#pragma unroll
                for (int tk = 0; tk < 4; ++tk) {
#pragma unroll
                    for (int e = 0; e < 8; ++e) y[tk][e] *= rn[tk];
                    v4u pk; pk.x = cvtpk(y[tk][0], y[tk][1]); pk.y = cvtpk(y[tk][2], y[tk][3]); pk.z = cvtpk(y[tk][4], y[tk][5]); pk.w = cvtpk(y[tk][6], y[tk][7]);
                    *(LAS v4u*)((ppart == 0 ? Qr : Kr) + (t4 + tk) * KST + d0 * 2) = pk; }
                if (ppart == 1) {
                    const float ek0 = __expf(gl - G4.x), ek1 = __expf(gl - G4.y), ek2 = __expf(gl - G4.z), ek3 = __expf(gl - G4.w);
                    const float bg0 = B4.x * __expf(G4.x), bg1 = B4.y * __expf(G4.y), bg2 = B4.z * __expf(G4.z), bg3 = B4.w * __expf(G4.w);
#pragma unroll
                    for (int e = 0; e < 8; ++e) {
                        v2u kd; kd.x = cvtpk(y[0][e] * ek0, y[1][e] * ek1); kd.y = cvtpk(y[2][e] * ek2, y[3][e] * ek3);
                        *(LAS v2u*)(kdT + (d0 + e) * KST + (t4 ^ swk) * 2) = kd;
                        *(LAS f32x4*)(Rt + (d0 + e) * RST + (t4 ^ swr)) = (f32x4){y[0][e] * bg0, y[1][e] * bg1, y[2][e] * bg2, y[3][e] * bg3}; }
                }
            } else {
#pragma unroll
                for (int e = 0; e < 8; ++e) *(LAS f32x4*)(Rt + (64 + d0 + e) * RST + (t4 ^ swr)) = (f32x4){y[0][e] * B4.x, y[1][e] * B4.y, y[2][e] * B4.z, y[3][e] * B4.w};
            }
        }
        __syncthreads();
#define G1_TILE(which, ct, st) do { const LAS unsigned char* Xb_ = (which) ? Kr : Qr; const int c_ = 16 * (ct) + l15; const float Gc_ = Gs[c_], bc_ = Bs[c_]; \
            f32x4 acc_ = {0.f, 0.f, 0.f, 0.f}; \
            _Pragma("unroll") for (int ks = 0; ks < 2; ++ks) { const bf16x8_t bf_ = *(const LAS bf16x8_t*)(Xb_ + c_ * KST + (32 * ks + 8 * g4) * 2); \
                const bf16x8_t af_ = *(const LAS bf16x8_t*)(Kr + (16 * (st) + l15) * KST + (32 * ks + 8 * g4) * 2); acc_ = __builtin_amdgcn_mfma_f32_16x16x32_bf16(af_, bf_, acc_, 0, 0, 0); } \
            f32x4 vals_; \
            _Pragma("unroll") for (int r = 0; r < 4; ++r) { const int s2_ = 16 * (st) + 4 * g4 + r; const float dec_ = __expf(fminf(Gc_ - Gs[s2_], 0.f)); \
                vals_[r] = (which) ? ((s2_ < c_) ? -acc_[r] * bc_ * dec_ : 0.f) : ((s2_ <= c_) ? acc_[r] * dec_ : 0.f); } \
            *(LAS v2u*)(((which) ? Mm : At) + c_ * KST + (16 * (st) + 4 * g4) * 2) = pack4(vals_); \
            if ((which) && (st) == (ct)) *(LAS f32x4*)(Md + ((ct) * 16 + l15) * 20 + 4 * g4) = -vals_; } while (0)
        if constexpr (STG & 1) {
            const int ct = wave & 3, st0 = 2 * (wave >> 2);
            G1_TILE(1, ct, st0); G1_TILE(1, ct, st0 + 1);
        }
        __syncthreads();
        if constexpr (STG & 1) {
            if (wave != 0) { for (int tix = wave - 1; tix < 16; tix += 7) { const int ct = tix & 3, st = tix >> 2; G1_TILE(0, ct, st); } }
        }
        if ((STG & 2) && wave == 0) {
            float t[16];
#pragma unroll
            for (int r = 0; r < 16; ++r) { float acc = (r == l15) ? 1.f : 0.f;
#pragma unroll
                for (int s4 = 0; s4 < r; s4 += 4) { const f32x4 m = *(const LAS f32x4*)(Md + (g4 * 16 + r) * 20 + s4);
                    acc -= m.x * t[s4]; if (s4 + 1 < r) acc -= m.y * t[s4 + 1]; if (s4 + 2 < r) acc -= m.z * t[s4 + 2]; if (s4 + 3 < r) acc -= m.w * t[s4 + 3]; }
                t[r] = acc; }
#pragma unroll
            for (int r = 0; r < 16; ++r) *(LAS unsigned short*)(Tl + ((g4 * 16 + r) * 16 + l15) * 2) = (unsigned short)f2bf(t[r]);
        }
        __syncthreads();
        if constexpr (STG & 4) {
        f32x4 wt[4];
        {   const int colw = 16 * wave + l15;
#pragma unroll
            for (int i = 0; i < 4; ++i) {
                f32x4 acc = *(const LAS f32x4*)(Rt + colw * RST + ((16 * i + 4 * g4) ^ (((colw >> 3) & 3) << 3)));
                const LAS unsigned char* mrow = Mm + (16 * i + l15) * KST + (4 * g4) * 2;
                if (i >= 1) { const v2u alo = *(const LAS v2u*)(mrow), ahi = (i >= 2) ? *(const LAS v2u*)(mrow + 32) : zero2;
                    acc = __builtin_amdgcn_mfma_f32_16x16x32_bf16(mk8(alo, ahi), mk8(pack4(wt[0]), (i >= 2) ? pack4(wt[1]) : zero2), acc, 0, 0, 0); }
                if (i == 3) { const v2u alo = *(const LAS v2u*)(mrow + 64);
                    acc = __builtin_amdgcn_mfma_f32_16x16x32_bf16(mk8(alo, zero2), mk8(pack4(wt[2]), zero2), acc, 0, 0, 0); }
                const v2u tlo = *(const LAS v2u*)(Tl + ((i * 16 + l15) * 16 + 4 * g4) * 2);
                wt[i] = __builtin_amdgcn_mfma_f32_16x16x32_bf16(mk8(tlo, zero2), mk8(pack4(acc), zero2), (f32x4){0.f, 0.f, 0.f, 0.f}, 0, 0, 0);
            }
        }
        if (wave < 4) {
            bf16x8_t wn[2];
#pragma unroll
            for (int ks = 0; ks < 2; ++ks) { v2u lo = pack4(wt[2 * ks]), hi = pack4(wt[2 * ks + 1]); lo.x ^= 0x80008000u; lo.y ^= 0x80008000u; hi.x ^= 0x80008000u; hi.y ^= 0x80008000u; wn[ks] = mk8(lo, hi); }
#pragma unroll
            for (int nt = 0; nt < 4; ++nt) { const int x = 16 * nt + l15;
                f32x4 ca = {0.f, 0.f, 0.f, 0.f};
                const v2u qraw = *(const LAS v2u*)(Qr + x * KST + (16 * wave + 4 * g4) * 2); const float eg = __expf(Gs[x]);
                f32x4 cq; cq.x = eg * __builtin_bit_cast(float, qraw.x << 16); cq.y = eg * __builtin_bit_cast(float, qraw.x & 0xffff0000u); cq.z = eg * __builtin_bit_cast(float, qraw.y << 16); cq.w = eg * __builtin_bit_cast(float, qraw.y & 0xffff0000u);
#pragma unroll
                for (int ks = 0; ks < 2; ++ks) { const int xs = (x >> 3) << 3; const LAS unsigned char* kp0 = kdT + x * KST + ((32 * ks + 4 * g4) ^ xs) * 2; const LAS unsigned char* kp1 = kdT + x * KST + ((32 * ks + 16 + 4 * g4) ^ xs) * 2; const LAS unsigned char* ap = At + x * KST + (32 * ks + 4 * g4) * 2;
                    ca = __builtin_amdgcn_mfma_f32_16x16x32_bf16(wn[ks], mk8(*(const LAS v2u*)(kp0), *(const LAS v2u*)(kp1)), ca, 0, 0, 0);
                    cq = __builtin_amdgcn_mfma_f32_16x16x32_bf16(wn[ks], mk8(*(const LAS v2u*)(ap), *(const LAS v2u*)(ap + 32)), cq, 0, 0, 0); }
                const size_t off = cb + (size_t)((nt * 2 + (wave >> 1)) * 64 + lane) * 8 + 4 * (wave & 1);
                if (SM & 1) *(v2u*)(AP + off) = pack4(ca); if (SM & 2) *(v2u*)(QP + off) = pack4(cq);
            }
        } else {
            bf16x8_t ub[2];
#pragma unroll
            for (int ks = 0; ks < 2; ++ks) ub[ks] = mk8(pack4(wt[2 * ks]), pack4(wt[2 * ks + 1]));
            unsigned bo[8], oo[8];
#pragma unroll
            for (int mt = 0; mt < 4; ++mt) { const int x = 16 * mt + l15;
                f32x4 cbv = {0.f, 0.f, 0.f, 0.f}, co = {0.f, 0.f, 0.f, 0.f};
#pragma unroll
                for (int ks = 0; ks < 2; ++ks) { const int xs = (x >> 3) << 3; const LAS unsigned char* kp0 = kdT + x * KST + ((32 * ks + 4 * g4) ^ xs) * 2; const LAS unsigned char* kp1 = kdT + x * KST + ((32 * ks + 16 + 4 * g4) ^ xs) * 2; const LAS unsigned char* ap = At + x * KST + (32 * ks + 4 * g4) * 2;
                    cbv = __builtin_amdgcn_mfma_f32_16x16x32_bf16(mk8(*(const LAS v2u*)(kp0), *(const LAS v2u*)(kp1)), ub[ks], cbv, 0, 0, 0);
                    co = __builtin_amdgcn_mfma_f32_16x16x32_bf16(mk8(*(const LAS v2u*)(ap), *(const LAS v2u*)(ap + 32)), ub[ks], co, 0, 0, 0); }
                const v2u pb = pack4(cbv), po = pack4(co); bo[2 * mt] = pb.x; bo[2 * mt + 1] = pb.y; oo[2 * mt] = po.x; oo[2 * mt + 1] = po.y; }
            const size_t off = cb + (size_t)((wave - 4) * 64 + lane) * 16;
            if (SM & 4) { *(v4u*)(BP + off) = (v4u){bo[0], bo[1], bo[2], bo[3]}; *(v4u*)(BP + off + 8) = (v4u){bo[4], bo[5], bo[6], bo[7]}; }
            if (SM & 8) { *(v4u*)(OP + off) = (v4u){oo[0], oo[1], oo[2], oo[3]}; *(v4u*)(OP + off + 8) = (v4u){oo[4], oo[5], oo[6], oo[7]}; }
        }
        }
    }
    }
#undef G1_TILE
#undef G1_PREFETCH
}

__device__ __forceinline__ f32x4 g2_unpack(const v4u (&p)[2], int mt) {
    const unsigned d0 = mt == 0 ? p[0].x : mt == 1 ? p[0].z : mt == 2 ? p[1].x : p[1].z, d1 = mt == 0 ? p[0].y : mt == 1 ? p[0].w : mt == 2 ? p[1].y : p[1].w;
    f32x4 r; r.x = __builtin_bit_cast(float, d0 << 16); r.y = __builtin_bit_cast(float, d0 & 0xffff0000u); r.z = __builtin_bit_cast(float, d1 << 16); r.w = __builtin_bit_cast(float, d1 & 0xffff0000u); return r;
}
template <int VAR = 0>
__device__ __forceinline__ void gdn_scan(const Args& A, int bh, LAS unsigned char* lds, int tid, int lane, int wave) {
    unsigned char* ws = A.ws;
    const char* AP = (const char*)(ws + WS_GAP); const char* BP = (const char*)(ws + WS_GBP); const float* GL = (const float*)(ws + WS_GGL); bf16* SF = (bf16*)(ws + WS_GSF);
    constexpr int SLOT = 16384, NSL = 8, EGL_OFF = NSL * SLOT;
    LAS float* eglt = (LAS float*)(lds + EGL_OFF);
    __syncthreads();
    { int tl = tid; asm volatile("" : "+v"(tl));
      if (tl < 128) eglt[tl] = GL[bh * 128 + tl]; }
    if (wave < 4) {
        f32x4 sC[4]; bf16x8_t sB[2];
#pragma unroll
        for (int mt = 0; mt < 4; ++mt) sC[mt] = (f32x4){0.f, 0.f, 0.f, 0.f};
#pragma unroll
        for (int ks = 0; ks < 2; ++ks)
#pragma unroll
            for (int j = 0; j < 8; ++j) sB[ks][j] = 0;
        asm volatile("s_waitcnt vmcnt(0) lgkmcnt(0)" ::: "memory");
        __builtin_amdgcn_s_barrier();
        struct SSet { bf16x8_t fa[4][2]; v4u fb[2]; float egl; };
#define SC_LOAD(S, n) do { const int n_ = (n) < SEQ / 64 ? (n) : SEQ / 64 - 1; const LAS unsigned char* slot_ = lds + (n_ & (NSL - 1)) * SLOT; \
            _Pragma("unroll") for (int mt = 0; mt < 4; ++mt) _Pragma("unroll") for (int ks = 0; ks < 2; ++ks) S.fa[mt][ks] = *(const LAS bf16x8_t*)(slot_ + ((mt * 2 + ks) * 64 + lane) * 16); \
            S.fb[0] = *(const LAS v4u*)(slot_ + 8192 + (wave * 64 + lane) * 32); S.fb[1] = *(const LAS v4u*)(slot_ + 8192 + (wave * 64 + lane) * 32 + 16); S.egl = eglt[n_]; } while (0)
#define SC_STEP(S, n) do { bf16* sf = SF + (size_t)(bh * 128 + (n)) * 4096 + (size_t)((wave * 2) * 64 + lane) * 8; \
            *(bf16x8_t*)(sf) = sB[0]; *(bf16x8_t*)(sf + 512) = sB[1]; \
            f32x4 sacc[4]; \
            _Pragma("unroll") for (int mt = 0; mt < 4; ++mt) sacc[mt] = sC[mt] * S.egl + g2_unpack(S.fb, mt); \
            _Pragma("unroll") for (int mt = 0; mt < 4; ++mt) _Pragma("unroll") for (int ks = 0; ks < 2; ++ks) sacc[mt] = __builtin_amdgcn_mfma_f32_16x16x32_bf16(S.fa[mt][ks], sB[ks], sacc[mt], 0, 0, 0); \
            _Pragma("unroll") for (int mt = 0; mt < 4; ++mt) sC[mt] = sacc[mt]; \
            _Pragma("unroll") for (int ks = 0; ks < 2; ++ks) { union { bf16x8_t v; unsigned u[4]; } pk_; \
                pk_.u[0] = cvtpk(sC[2 * ks].x, sC[2 * ks].y); pk_.u[1] = cvtpk(sC[2 * ks].z, sC[2 * ks].w); pk_.u[2] = cvtpk(sC[2 * ks + 1].x, sC[2 * ks + 1].y); pk_.u[3] = cvtpk(sC[2 * ks + 1].z, sC[2 * ks + 1].w); sB[ks] = pk_.v; } \
            asm volatile("s_waitcnt lgkmcnt(0)" ::: "memory"); \
            __builtin_amdgcn_s_barrier(); } while (0)
        SSet s0;
#pragma unroll 1
        for (int n = 0; n < SEQ / 64; ++n) {
            if (VAR == 2) { asm volatile("s_waitcnt lgkmcnt(0)" ::: "memory"); __builtin_amdgcn_s_barrier(); continue; }
            SC_LOAD(s0, n);
            SC_STEP(s0, n);
        }
#undef SC_LOAD
#undef SC_STEP
    } else {
        const int f = wave - 4;
        const unsigned lin = (unsigned)(2 * f) * 1024u + (unsigned)lane * 16u;
#define G2_DMA(nn) do { const int n_ = (nn) < SEQ / 64 ? (nn) : SEQ / 64 - 1; const size_t cb_ = (size_t)(bh * 128 + n_) * 8192; LAS unsigned char* d_ = lds + ((nn) & (NSL - 1)) * SLOT + (2 * f) * 1024; \
        __builtin_amdgcn_global_load_lds((const unsigned*)(AP + cb_ + lin), (LAS unsigned*)(d_), 16, 0, 0); __builtin_amdgcn_global_load_lds((const unsigned*)(AP + cb_ + lin + 1024), (LAS unsigned*)(d_ + 1024), 16, 0, 0); \
        __builtin_amdgcn_global_load_lds((const unsigned*)(BP + cb_ + lin), (LAS unsigned*)(d_ + 8192), 16, 0, 0); __builtin_amdgcn_global_load_lds((const unsigned*)(BP + cb_ + lin + 1024), (LAS unsigned*)(d_ + 8192 + 1024), 16, 0, 0); } while (0)
        asm volatile("s_waitcnt vmcnt(0) lgkmcnt(0)" ::: "memory");
        G2_DMA(0); G2_DMA(1); G2_DMA(2); G2_DMA(3); G2_DMA(4); G2_DMA(5); G2_DMA(6);
        asm volatile("s_waitcnt vmcnt(24)" ::: "memory");
        __builtin_amdgcn_s_barrier();
#pragma unroll 1
        for (int n = 0; n < SEQ / 64; ++n) {
            if (VAR != 1) G2_DMA(n + 7);
            asm volatile("s_waitcnt vmcnt(24)" ::: "memory");
            __builtin_amdgcn_s_barrier();
        }
#undef G2_DMA
        asm volatile("s_waitcnt vmcnt(0)" ::: "memory");
    }
    __syncthreads();
}
__device__ __forceinline__ void gdn_out(const Args& A, LAS unsigned char* lds, int lane, int wave) {
    unsigned char* ws = A.ws;
    const bf16* proj = (const bf16*)(ws + WS_PROJ); bf16* mix = (bf16*)(ws + WS_MIX);
    const bf16* QP = (const bf16*)(ws + WS_GQP); const bf16* OP = (const bf16*)(ws + WS_GOP); const bf16* SF = (const bf16*)(ws + WS_GSF);
    const float* onorm = (const float*)A.in[I_GNORM];
    const int mt = wave & 3, l15 = lane & 15, g4 = lane >> 4, rr = lane >> 2, q4 = lane & 3;
    constexpr int OST = 68;
    LAS float* ot = (LAS float*)(lds + wave * 4608);
    float gain[16];
#pragma unroll
    for (int k = 0; k < 16; ++k) gain[k] = onorm[16 * q4 + k];
    struct OSet { bf16x8_t qa[2], sb[4][2]; v2u oi[4]; v4u z0, z1; };
#define GO_LOAD(S, CID) do { const int n_ = (CID) & 127, bh_ = (CID) >> 7, b_ = bh_ >> 3, h_ = bh_ & 7; const size_t cb_ = (size_t)(CID) * 4096; \
        const size_t t_ = (size_t)b_ * SEQ + n_ * 64 + 16 * mt + rr; \
        S.z0 = *(const v4u*)(proj + t_ * NPROJ + PC_Z + h_ * 64 + 16 * q4); S.z1 = *(const v4u*)(proj + t_ * NPROJ + PC_Z + h_ * 64 + 16 * q4 + 8); \
        _Pragma("unroll") for (int ks = 0; ks < 2; ++ks) S.qa[ks] = *(const bf16x8_t*)(QP + cb_ + ((mt * 2 + ks) * 64 + lane) * 8); \
        _Pragma("unroll") for (int nt = 0; nt < 4; ++nt) { _Pragma("unroll") for (int ks = 0; ks < 2; ++ks) S.sb[nt][ks] = *(const bf16x8_t*)(SF + cb_ + ((nt * 2 + ks) * 64 + lane) * 8); \
            S.oi[nt] = *(const v2u*)(OP + cb_ + ((nt * 64 + lane) * 4 + mt) * 4); } } while (0)
#define GO_STEP(S, CID) do { const int n_ = (CID) & 127, bh_ = (CID) >> 7, b_ = bh_ >> 3, h_ = bh_ & 7; const size_t t_ = (size_t)b_ * SEQ + n_ * 64 + 16 * mt + rr; \
        _Pragma("unroll") for (int nt = 0; nt < 4; ++nt) { \
            f32x4 acc; acc.x = __builtin_bit_cast(float, S.oi[nt].x << 16); acc.y = __builtin_bit_cast(float, S.oi[nt].x & 0xffff0000u); acc.z = __builtin_bit_cast(float, S.oi[nt].y << 16); acc.w = __builtin_bit_cast(float, S.oi[nt].y & 0xffff0000u); \
            _Pragma("unroll") for (int ks = 0; ks < 2; ++ks) acc = __builtin_amdgcn_mfma_f32_16x16x32_bf16(S.qa[ks], S.sb[nt][ks], acc, 0, 0, 0); \
            _Pragma("unroll") for (int i = 0; i < 4; ++i) ot[(4 * g4 + i) * OST + 16 * nt + l15] = acc[i]; } \
        LDS_WAIT(); asm volatile("" ::: "memory"); \
        float o[16]; float ss = 0.f; \
        _Pragma("unroll") for (int k = 0; k < 4; ++k) { const f32x4 v = *(const LAS f32x4*)(ot + rr * OST + 16 * q4 + 4 * k); o[4 * k] = v.x; o[4 * k + 1] = v.y; o[4 * k + 2] = v.z; o[4 * k + 3] = v.w; } \
        _Pragma("unroll") for (int k = 0; k < 16; ++k) ss += o[k] * o[k]; \
        ss += __shfl_xor(ss, 1); ss += __shfl_xor(ss, 2); \
        const float r = 1.f / sqrtf(ss * (1.f / 64.f) + EPS); \
        const unsigned zu[8] = {S.z0.x, S.z0.y, S.z0.z, S.z0.w, S.z1.x, S.z1.y, S.z1.z, S.z1.w}; \
        unsigned ou[8]; \
        _Pragma("unroll") for (int k = 0; k < 8; ++k) { const float za = __builtin_bit_cast(float, zu[k] << 16), zb = __builtin_bit_cast(float, zu[k] & 0xffff0000u); \
            ou[k] = cvtpk(o[2 * k] * r * gain[2 * k] * siluf(za), o[2 * k + 1] * r * gain[2 * k + 1] * siluf(zb)); } \
        bf16* op = mix + t_ * DM + h_ * 64 + 16 * q4; \
        *(v4u*)(op) = (v4u){ou[0], ou[1], ou[2], ou[3]}; *(v4u*)(op + 8) = (v4u){ou[4], ou[5], ou[6], ou[7]}; \
        LDS_WAIT(); asm volatile("" ::: "memory"); } while (0)
    const int NC = NB * 8 * 128, st = gridDim.x * 2;
    int cid = blockIdx.x * 2 + (wave >> 2);
    OSet s0, s1, s2;
    if (cid < NC) GO_LOAD(s0, cid);
    if (cid + st < NC) GO_LOAD(s1, cid + st);
#pragma unroll 1
    for (; cid < NC; cid += 3 * st) {
        if (cid + 2 * st < NC) GO_LOAD(s2, cid + 2 * st);
        GO_STEP(s0, cid);
        if (cid + st < NC) { if (cid + 3 * st < NC) GO_LOAD(s0, cid + 3 * st); GO_STEP(s1, cid + st); }
        if (cid + 2 * st < NC) { if (cid + 4 * st < NC) GO_LOAD(s1, cid + 4 * st); GO_STEP(s2, cid + 2 * st); }
    }
#undef GO_LOAD
#undef GO_STEP
}

template <bool DRY, int VAR = 0>
__device__ __forceinline__ void norm_route_mfma(const Args& A, const float* X, const float* ssqp, const float* gain, const float* shift, const float* scale, bf16* H, LAS unsigned char* lds, int tid, int lane, int wave) {
    unsigned char* ws = A.ws;
    const int G = gridDim.x;
    const int l15 = lane & 15, g4 = lane >> 4;
    LAS unsigned char* wfl = lds;
    LAS float* mfl = (LAS float*)(lds + 98304); LAS float* afl = mfl + 1024;
    LAS float* lgs = (LAS float*)(lds + 98304 + 8192 + wave * 3328);
    const float* bg = (const float*)A.in[I_BGRP]; const float* br = (const float*)A.in[I_BRT];
#define P7_LOADW(half) do { const v4u* src_ = (const v4u*)(ws + WS_WRT); \
        for (int q = tid; q < 3072; q += NTHR) { const int nt_ = q >> 10, r_ = q & 1023; const int g_ = (nt_ * 32 + 16 * (half)) * 64 + r_; \
            *(LAS v4u*)(wfl + q * 16) = src_[g_]; *(LAS v4u*)(wfl + 49152 + q * 16) = src_[6144 + g_]; } } while (0)
    int bcur = -1;
    for (int rb = blockIdx.x * 128; rb < TT; rb += G * 128) {
        const int b = rb / SEQ, r0 = rb + wave * 16, row = r0 + l15;
        if (b != bcur) { bcur = b; __syncthreads();
            for (int q = tid; q < 1024; q += NTHR) { mfl[q] = gain[q] * (scale[b * 6144 + q] + 1.0f); afl[q] = shift[b * 6144 + q]; }
            __syncthreads(); }
        const float* xr = X + (size_t)row * DM + 8 * g4;
        float ss;
        {   const f32x4 p4 = *(const f32x4*)(ssqp + (size_t)row * 16 + 4 * g4); ss = (p4.x + p4.y) + (p4.z + p4.w); }
        ss += __shfl_xor(ss, 16); ss += __shfl_xor(ss, 32);
        const float rstd = 1.f / sqrtf(ss * (1.f / DM) + EPS);
        f32x4 acc[3];
#pragma unroll
        for (int nt = 0; nt < 3; ++nt) acc[nt] = (f32x4){0.f, 0.f, 0.f, 0.f};
        bf16* hrow = H + (size_t)row * DM + 8 * g4;
#pragma unroll 1
        for (int half = 0; half < 2; ++half) {
        __syncthreads(); P7_LOADW(half); __syncthreads();
#pragma unroll 8
        for (int ks = 16 * half; ks < 16 * half + 16; ++ks) {
            float hv[8];
            {   const f32x4 a = *(const f32x4*)(xr + 32 * ks), c = *(const f32x4*)(xr + 32 * ks + 4);
                const f32x4 m0 = *(const LAS f32x4*)(mfl + 32 * ks + 8 * g4), m1 = *(const LAS f32x4*)(mfl + 32 * ks + 8 * g4 + 4), h0 = *(const LAS f32x4*)(afl + 32 * ks + 8 * g4), h1 = *(const LAS f32x4*)(afl + 32 * ks + 8 * g4 + 4);
                const f32x4 v0 = a * rstd * m0 + h0, v1 = c * rstd * m1 + h1;
                hv[0] = v0.x; hv[1] = v0.y; hv[2] = v0.z; hv[3] = v0.w; hv[4] = v1.x; hv[5] = v1.y; hv[6] = v1.z; hv[7] = v1.w; }
            unsigned hu[4], lu[4];
#pragma unroll
            for (int p = 0; p < 4; ++p) { hu[p] = cvtpk(hv[2 * p], hv[2 * p + 1]);
                const float ra = hv[2 * p] - __builtin_bit_cast(float, hu[p] << 16), rb2 = hv[2 * p + 1] - __builtin_bit_cast(float, hu[p] & 0xffff0000u); lu[p] = cvtpk(ra, rb2); }
            *(v4u*)(hrow + 32 * ks) = (v4u){hu[0], hu[1], hu[2], hu[3]};
            union { bf16x8_t v; unsigned u[4]; } ah, al; ah.u[0] = hu[0]; ah.u[1] = hu[1]; ah.u[2] = hu[2]; ah.u[3] = hu[3]; al.u[0] = lu[0]; al.u[1] = lu[1]; al.u[2] = lu[2]; al.u[3] = lu[3];
#pragma unroll
            for (int nt = 0; nt < 3; ++nt) { const int fo = ((nt * 16 + (ks & 15)) * 64 + lane) * 16;
                const bf16x8_t bh = *(const LAS bf16x8_t*)(wfl + fo), bl = *(const LAS bf16x8_t*)(wfl + 49152 + fo);
                acc[nt] = __builtin_amdgcn_mfma_f32_16x16x32_bf16(ah.v, bh, acc[nt], 0, 0, 0);
                acc[nt] = __builtin_amdgcn_mfma_f32_16x16x32_bf16(ah.v, bl, acc[nt], 0, 0, 0);
                acc[nt] = __builtin_amdgcn_mfma_f32_16x16x32_bf16(al.v, bh, acc[nt], 0, 0, 0); }
        }
        }
#pragma unroll
        for (int nt = 0; nt < 3; ++nt)
#pragma unroll
            for (int r = 0; r < 4; ++r) lgs[(4 * g4 + r) * 52 + 16 * nt + l15] = acc[nt][r];
        LDS_WAIT(); asm volatile("" ::: "memory");
        if (lane < 16) {
            float lg[36];
#pragma unroll
            for (int q = 0; q < 9; ++q) { const f32x4 v = *(const LAS f32x4*)(lgs + lane * 52 + 4 * q); lg[4 * q] = v.x; lg[4 * q + 1] = v.y; lg[4 * q + 2] = v.z; lg[4 * q + 3] = v.w; }
#pragma unroll
            for (int o = 0; o < 4; ++o) lg[o] += bg[o];
#pragma unroll
            for (int o = 0; o < 32; ++o) lg[4 + o] += br[o];
            int gi = 0; float gm = lg[0];
#pragma unroll
            for (int o = 1; o < 4; ++o) if (lg[o] > gm) { gm = lg[o]; gi = o; }
            float gs = 0.f;
#pragma unroll
            for (int o = 0; o < 4; ++o) gs += __expf(lg[o] - gm);
            const float pg = 1.f / gs;
            float le[8];
#pragma unroll
            for (int j = 0; j < 8; ++j) { le[j] = lg[4 + j];
#pragma unroll
                for (int g = 1; g < 4; ++g) le[j] = (gi == g) ? lg[4 + g * 8 + j] : le[j]; }
            int j1 = 0; float m1 = le[0];
#pragma unroll
            for (int j = 1; j < 8; ++j) if (le[j] > m1) { m1 = le[j]; j1 = j; }
            int j2 = -1; float m2 = -3.0e38f;
#pragma unroll
            for (int j = 0; j < 8; ++j) if (j != j1 && le[j] > m2) { m2 = le[j]; j2 = j; }
            const float ex = __expf(m2 - m1), w1 = pg / (1.f + ex), w2 = pg * ex / (1.f + ex);
            const int e1 = gi * 8 + j1, e2 = gi * 8 + j2, rw = r0 + lane;
            unsigned* ctl = (unsigned*)(ws + WS_CTL);
            int2* erec = (int2*)(ws + WS_EREC); int* clist = (int*)(ws + WS_CLIST);
            if constexpr (DRY) { ((int2*)(ws + WS_PROJ + 168 * MiB))[rw] = make_int2(e1 * 64 + e2, __builtin_bit_cast(int, w1 + w2)); } else {
            const unsigned p1 = atomicAdd(ctl + CW_ECNT + e1, 1u); erec[(size_t)e1 * TT + p1] = make_int2(rw * 2 + (e1 > e2 ? 1 : 0), __builtin_bit_cast(int, w1));
            const unsigned p2 = atomicAdd(ctl + CW_ECNT + e2, 1u); erec[(size_t)e2 * TT + p2] = make_int2(rw * 2 + (e2 > e1 ? 1 : 0), __builtin_bit_cast(int, w2));
            const int a = j1 < j2 ? j1 : j2, bb = j1 < j2 ? j2 : j1;
            const int cls = gi * 28 + (a * 7 - (a * (a - 1)) / 2 + (bb - a - 1));
            const unsigned pc = atomicAdd(ctl + CW_CCNT + cls, 1u); clist[(size_t)cls * TT + pc] = rw; }
        }
        LDS_WAIT(); asm volatile("" ::: "memory");
    }
#undef P7_LOADW
}

__device__ __forceinline__ int wave_incl_scan(int v, int lane) {
#pragma unroll
    for (int o = 1; o < 64; o <<= 1) { const int t = __shfl_up(v, o); if (lane >= o) v += t; }
    return v;
}
template <int NOPART = 0>
struct SchedET {
    int G, c, cntv, preF, erank, totF, totP; const int2* rec; const char* W;
    __device__ __forceinline__ void init(const unsigned* cnt, const int2* rec_, const char* W_, int G_, int c_, int lane) {
        G = G_; c = c_; rec = rec_; W = W_;
        cntv = lane < NE ? (int)cnt[lane] : 0;
        const int rem = cntv & 255;
        const int incF = wave_incl_scan(cntv >> 8, lane), incP = wave_incl_scan(rem ? 1 : 0, lane);
        totF = __builtin_amdgcn_readlane(incF, 63); totP = NOPART ? 0 : __builtin_amdgcn_readlane(incP, 63);
        preF = lane < NE ? incF : 0x7fffffff;
        int rank = 0;
        for (int l = 0; l < NE; ++l) { const int r2 = __builtin_amdgcn_readlane(rem, l); rank += (r2 > rem || (r2 == rem && l < lane)) ? 1 : 0; }
        erank = __builtin_amdgcn_ds_permute((lane < NE ? rank : lane) << 2, lane);
    }
    __device__ __forceinline__ bool next(int i, pg8::UnitG& u) const {
        const int L = i * G + c; if (L >= 2 * (totF + totP)) return false;
        if (L < 2 * totF) { const int ft = L >> 1;
            const int e = __builtin_amdgcn_readfirstlane(__popcll(__ballot(preF <= ft)));
            const int base = e ? __builtin_amdgcn_readlane(preF, e - 1) : 0;
            u.id = e; u.tile = ft - base; u.pn = L & 1; u.nrows = 256;
        } else { const int p = (L - 2 * totF) >> 1;
            const int e = __builtin_amdgcn_readlane(erank, p);
            const int cnt = __builtin_amdgcn_readlane(cntv, e);
            u.id = e; u.tile = cnt >> 8; u.pn = L & 1; u.nrows = cnt & 255; }
        return true;
    }
    __device__ __forceinline__ int tok(const pg8::UnitG& u, int r) const { return r < u.nrows ? (rec[(size_t)u.id * TT + u.tile * 256 + r].x >> 1) : 0; }
    __device__ __forceinline__ const char* bseg(const pg8::UnitG& u, int) const { return W + ((size_t)u.id * 512 + u.pn * 256) * 2048; }
};
typedef SchedET<0> SchedE;
struct EpiGU {
    static constexpr bool PERM = true, PREFETCH = false;
    bf16* HID;
    template <class SC> __device__ __forceinline__ void operator()(const pg8::f32x4 (&acc)[2][2][4][2], const pg8::UnitG& u, const SC& S, int wr, int wc, int fr, int fq) const {
#pragma unroll
        for (int ai = 0; ai < 2; ++ai)
#pragma unroll
            for (int m = 0; m < 4; ++m) { const int r = ai * 128 + wr * 64 + m * 16 + fr;
                if (r < u.nrows) { const int2 rc = S.rec[(size_t)u.id * TT + u.tile * 256 + r]; const int t = rc.x >> 1, half = rc.x & 1; const float w = __builtin_bit_cast(float, rc.y);
                    float hv[8];
#pragma unroll
                    for (int n = 0; n < 2; ++n)
#pragma unroll
                        for (int j = 0; j < 4; ++j) { const float g = acc[ai][0][m][n][j], up = acc[ai][1][m][n][j]; hv[n * 4 + j] = w * siluf(g) * up; }
                    v4u o; o.x = pk2(hv[0], hv[1]); o.y = pk2(hv[2], hv[3]); o.z = pk2(hv[4], hv[5]); o.w = pk2(hv[6], hv[7]);
                    *(v4u*)(HID + (size_t)t * 512 + half * 256 + u.pn * 128 + wc * 32 + 8 * fq) = o; } }
    }
};
struct SchedC {
    int G, c, cntA, cntB, preA, preB, total_rt; const int* clist; const char* W;
    __device__ __forceinline__ void init(const unsigned* cnt, const int* clist_, const char* W_, int G_, int c_, int lane) {
        G = G_; c = c_; clist = clist_; W = W_;
        cntA = (int)cnt[lane]; cntB = lane < NCLS - 64 ? (int)cnt[64 + lane] : 0;
        const int ia = wave_incl_scan((cntA + 255) >> 8, lane); const int ta = __builtin_amdgcn_readlane(ia, 63);
        const int ib = wave_incl_scan((cntB + 255) >> 8, lane) + ta;
        total_rt = __builtin_amdgcn_readlane(ib, 63);
        preA = ia; preB = lane < NCLS - 64 ? ib : 0x7fffffff;
    }
    __device__ __forceinline__ bool next(int i, pg8::UnitG& u) const {
        const int L = i * G + c; if (L >= 4 * total_rt) return false;
        const int rt = L >> 2;
        const int cls = __builtin_amdgcn_readfirstlane(__popcll(__ballot(preA <= rt)) + __popcll(__ballot(preB <= rt)));
        int base = 0; if (cls > 0) base = (cls - 1 < 64) ? __builtin_amdgcn_readlane(preA, cls - 1) : __builtin_amdgcn_readlane(preB, cls - 65);
        const int cnt = cls < 64 ? __builtin_amdgcn_readlane(cntA, cls) : __builtin_amdgcn_readlane(cntB, cls - 64);
        u.id = cls; u.tile = rt - base; u.pn = L & 3; const int rem = cnt - u.tile * 256; u.nrows = rem < 256 ? rem : 256;
        return true;
    }
    __device__ __forceinline__ int tok(const pg8::UnitG& u, int r) const { return r < u.nrows ? clist[(size_t)u.id * TT + u.tile * 256 + r] : 0; }
    __device__ __forceinline__ const char* bseg(const pg8::UnitG& u, int seg) const {
        const int g = u.id / 28; int a = 0, rem = u.id % 28; while (rem >= 7 - a) { rem -= 7 - a; ++a; } const int b = a + 1 + rem;
        const int e = g * 8 + (seg ? b : a);
        return W + ((size_t)e * 1024 + u.pn * 256) * 512;
    }
};
template <int VAR = 0>
struct EpiDownT {
    static constexpr bool PERM = false, PREFETCH = false;
    float* OUT; const float* gate2;
    const LAS unsigned char* gt;
    template <class SC> __device__ __forceinline__ void prefetch(LAS unsigned char* lds, const pg8::UnitG& u, const SC& S, int tid) const {
#pragma unroll
        for (int i = 0; i < 4; ++i) { const int r = (tid >> 3) + 64 * i; const int t = S.tok(u, r);
            __builtin_amdgcn_global_load_lds((const unsigned*)((const char*)OUT + (size_t)t * 4096 + (size_t)u.pn * 1024 + (size_t)(tid & 7) * 128), (LAS unsigned*)(lds + pg8::STAGE_BYTES + 256), 4, 0, 0); }
    }
    template <class SC> __device__ __forceinline__ void operator()(const pg8::f32x4 (&acc)[2][2][4][2], const pg8::UnitG& u, const SC& S, int wr, int wc, int fr, int fq) const {
#pragma unroll
        for (int ai = 0; ai < 2; ++ai)
#pragma unroll
            for (int m = 0; m < 4; ++m) { const int r = ai * 128 + wr * 64 + m * 16 + fr;
                if (r < u.nrows) { const int t = S.clist[(size_t)u.id * TT + u.tile * 256 + r]; const int b = t / SEQ; const int col0 = u.pn * 256 + wc * 32 + 4 * fq;
                    float* op = OUT + (size_t)t * DM + col0; const float* gp = gate2 + b * 6144 + col0;
#pragma unroll
                    for (int bj = 0; bj < 2; ++bj)
#pragma unroll
                        for (int n = 0; n < 2; ++n) { const int off = bj * 128 + n * 16; const f32x4 xv = (VAR == 1) ? (f32x4){1.f, 1.f, 1.f, 1.f} : *(const f32x4*)(op + off);
                            f32x4 gv;
                            if (VAR == 2) gv = (f32x4){1.f, 1.f, 1.f, 1.f};
                            else if (gt) { const v2u g2 = *(const LAS v2u*)(gt + (b * 1024 + col0 + off) * 2);
                                gv.x = __builtin_bit_cast(float, g2.x << 16); gv.y = __builtin_bit_cast(float, g2.x & 0xffff0000u); gv.z = __builtin_bit_cast(float, g2.y << 16); gv.w = __builtin_bit_cast(float, g2.y & 0xffff0000u); }
                            else gv = *(const f32x4*)(gp + off);
                            *(f32x4*)(op + off) = xv + gv * acc[ai][bj][m][n]; } } }
    }
};
typedef EpiDownT<0> EpiDown;

__global__ void __launch_bounds__(NTHR, 2) fwd_kernel(Args args) {
    extern __shared__ __attribute__((aligned(16))) unsigned char lds_raw[];
    LAS unsigned char* lds = (LAS unsigned char*)lds_raw;
    volatile LAS unsigned* MISC = (volatile LAS unsigned*)(lds + MISC_OFF);
    const int G = gridDim.x;
    unsigned char* ws = args.ws;
    const int wave_s = __builtin_amdgcn_readfirstlane(threadIdx.x >> 6);
    for (int u = threadIdx.x; u < (LDS_BYTES - LDSCTL_OFF) / 4; u += NTHR) ((LAS unsigned*)(lds + LDSCTL_OFF))[u] = 0u;
    __syncthreads();
    const int lo = args.ph_lo, hi = args.ph_hi;
    const bool use_bar = (hi - lo) > 1;
    XcdBarrier bar; bar.bar = (unsigned*)(ws + WS_CTL) + CW_BAR; bar.x = 0; bar.st = nullptr;
    if (use_bar) bar = xcd_barrier_post((unsigned*)(ws + WS_CTL) + CW_BAR, MISC + 8, threadIdx.x == 0);
#define IN(k) (lo <= (k) && (k) < hi)
#define BOTH(k) (IN(k) && IN((k) + 1))
#if PROBE_REP == 1000
#define GRID_BAR(k) do { if (BOTH(k)) { xcd_barrier(bar, wave_s == 0 && __builtin_amdgcn_mbcnt_hi(~0u, __builtin_amdgcn_mbcnt_lo(~0u, 0u)) == 0u); xcd_barrier(bar, wave_s == 0 && __builtin_amdgcn_mbcnt_hi(~0u, __builtin_amdgcn_mbcnt_lo(~0u, 0u)) == 0u); } } while (0)
#else
#define GRID_BAR(k) do { if (BOTH(k)) xcd_barrier(bar, wave_s == 0 && __builtin_amdgcn_mbcnt_hi(~0u, __builtin_amdgcn_mbcnt_lo(~0u, 0u)) == 0u); } while (0)
#endif
#define FRESH_IDS() const int wave = wave_s; int lane = (int)__builtin_amdgcn_mbcnt_hi(~0u, __builtin_amdgcn_mbcnt_lo(~0u, 0u)); asm volatile("" : "+v"(lane)); const int tid = wave * 64 + lane; (void)tid
    const float* mod = (const float*)(ws + WS_MOD);

    if (IN(0)) { FRESH_IDS(); p0_prologue(args, lds, tid, lane, wave); GRID_BAR(0); }
    if (IN(1)) { FRESH_IDS(); norm_rows<false>(args, (const float*)args.in[I_X], (const float*)args.in[I_NORM_MIX], mod + 0, mod + 1024, (bf16*)(ws + WS_H), lds, lane, wave); GRID_BAR(1); }
    if (IN(2)) { FRESH_IDS();
        pg8::Gemm g{(const pg8::bf16_t*)(ws + WS_H), (const pg8::bf16_t*)(ws + WS_WINT), TT, NPAD, DM}; pg8::StaticOrder S; S.init(TT, NPAD, G, (int)blockIdx.x);
        pg8::EpiProj E{(pg8::bf16_t*)(ws + WS_PROJ), (float*)(ws + WS_AB), NPROJ};
        pg8::gemm_phase<pg8::EpiProj, pg8::StaticOrder, true, true>(lds, g, S, E);
        GRID_BAR(2);
    }
    if (IN(3)) { FRESH_IDS(); gdn_g1_mfma<31>(args, lds, tid, lane, wave); GRID_BAR(3); }
    if (IN(4)) { FRESH_IDS();
        if ((int)blockIdx.x < 32) gdn_scan(args, (int)blockIdx.x, lds, tid, lane, wave);
        else swa_mfma(args, lds, tid, lane, wave, (int)blockIdx.x - 32, G - 32);
        GRID_BAR(4);
    }
    if (IN(5)) { FRESH_IDS(); gdn_out(args, lds, lane, wave); GRID_BAR(5); }
    if (IN(6)) { FRESH_IDS();
        pg8::Gemm g{(const pg8::bf16_t*)(ws + WS_MIX), (const pg8::bf16_t*)(ws + WS_WOUTT), TT, DM, DM}; pg8::StaticOrder S; S.init(TT, DM, G, (int)blockIdx.x);
        pg8::EpiOut E{(const float*)args.in[I_X], args.out, mod + 2048, SEQ, 6144, (float*)(ws + WS_SSQ)};
        pg8::gemm_phase<pg8::EpiOut, pg8::StaticOrder, true, true>(lds, g, S, E);
        GRID_BAR(6);
    }
    if (IN(7)) { FRESH_IDS(); norm_route_mfma<false>(args, args.out, (const float*)(ws + WS_SSQ), (const float*)args.in[I_NORM_FFN], mod + 3072, mod + 4096, (bf16*)(ws + WS_H), lds, tid, lane, wave); GRID_BAR(7); }
    if (IN(8)) { FRESH_IDS();
        SchedE S; S.init((const unsigned*)(ws + WS_CTL) + CW_ECNT, (const int2*)(ws + WS_EREC), (const char*)(ws + WS_WGUT), G, (int)blockIdx.x, lane);
        EpiGU E{(bf16*)(ws + WS_HID)};
        pg8::gemm_phase_g<EpiGU, SchedE>(lds, (const pg8::bf16_t*)(ws + WS_H), 1024, 1024, 16, 16, S, E);
        GRID_BAR(8);
    }
    if (IN(9)) { FRESH_IDS();
        SchedC S; S.init((const unsigned*)(ws + WS_CTL) + CW_CCNT, (const int*)(ws + WS_CLIST), (const char*)(ws + WS_WDT), G, (int)blockIdx.x, lane);
        LAS unsigned char* gtl = lds + RING_BYTES + 512;
        for (int q = tid; q < 4096; q += NTHR) *(LAS unsigned short*)(gtl + q * 2) = (unsigned short)f2bf(mod[(q >> 10) * 6144 + 5120 + (q & 1023)]);
        __syncthreads();
        EpiDown E{args.out, mod + 5120, gtl};
        pg8::gemm_phase_g<EpiDown, SchedC>(lds, (const pg8::bf16_t*)(ws + WS_HID), 512, 256, 8, 4, S, E);
    }
#undef IN
#undef BOTH
#undef GRID_BAR
}

#if PROBE_REP >= 0 && PROBE_REP < 1000
template <int P>
__global__ void __launch_bounds__(NTHR, 2) probe_kernel(Args args) {
    extern __shared__ __attribute__((aligned(16))) unsigned char lds_raw[];
    LAS unsigned char* lds = (LAS unsigned char*)lds_raw;
    const int tid = threadIdx.x, lane = tid & 63, wave = __builtin_amdgcn_readfirstlane(tid >> 6);
    const int G = gridDim.x; unsigned char* ws = args.ws; const float* mod = (const float*)(ws + WS_MOD);
    if constexpr (P == 1) norm_rows<false>(args, (const float*)args.in[I_X], (const float*)args.in[I_NORM_MIX], mod + 0, mod + 1024, (bf16*)(ws + WS_GAP + 0)  , lds, lane, wave);
    if constexpr (P == 2) { pg8::Gemm g{(const pg8::bf16_t*)(ws + WS_H), (const pg8::bf16_t*)(ws + WS_WINT), TT, NPAD, DM}; pg8::StaticOrder S; S.init(TT, NPAD, G, (int)blockIdx.x);
        pg8::EpiProj E{(pg8::bf16_t*)(ws + WS_PROJ), (float*)(ws + WS_AB), NPROJ}; pg8::gemm_phase<pg8::EpiProj, pg8::StaticOrder, true, true>(lds, g, S, E); }
    if constexpr (P == 0) p0_prologue(args, lds, tid, lane, wave);
    if constexpr (P == 4) gdn_g1_mfma<31>(args, lds, tid, lane, wave);
    if constexpr (P == 40) gdn_g1_mfma<31, 0>(args, lds, tid, lane, wave);
    if constexpr (P == 41) gdn_g1_mfma<31, 1>(args, lds, tid, lane, wave);
    if constexpr (P == 42) gdn_g1_mfma<31, 3>(args, lds, tid, lane, wave);
    if constexpr (P == 43) gdn_g1_mfma<0, 7>(args, lds, tid, lane, wave);
    if constexpr (P == 50) { if ((int)blockIdx.x < 32) gdn_scan(args, (int)blockIdx.x, lds, tid, lane, wave); }
    if constexpr (P == 501) { if ((int)blockIdx.x < 32) gdn_scan<1>(args, (int)blockIdx.x, lds, tid, lane, wave); }
    if constexpr (P == 502) { if ((int)blockIdx.x < 32) gdn_scan<2>(args, (int)blockIdx.x, lds, tid, lane, wave); }
    if constexpr (P == 52) gdn_out(args, lds, lane, wave);
    if constexpr (P == 51) { if ((int)blockIdx.x >= 32) swa_mfma(args, lds, tid, lane, wave, (int)blockIdx.x - 32, G - 32); }
    if constexpr (P == 6) { pg8::Gemm g{(const pg8::bf16_t*)(ws + WS_MIX), (const pg8::bf16_t*)(ws + WS_WOUTT), TT, DM, DM}; pg8::StaticOrder S; S.init(TT, DM, G, (int)blockIdx.x);
        pg8::EpiOut E{(const float*)args.in[I_X], (float*)(ws + WS_GSF)  , mod + 2048, SEQ, 6144, nullptr}; pg8::gemm_phase<pg8::EpiOut, pg8::StaticOrder, true, true>(lds, g, S, E); }
    if constexpr (P == 81) { SchedET<1> S; S.init((const unsigned*)(ws + WS_CTL) + CW_ECNT, (const int2*)(ws + WS_EREC), (const char*)(ws + WS_WGUT), G, (int)blockIdx.x, lane);
        EpiGU E{(bf16*)(ws + WS_HID)}; pg8::gemm_phase_g<EpiGU, SchedET<1>>(lds, (const pg8::bf16_t*)(ws + WS_H), 1024, 1024, 16, 16, S, E); }
    if constexpr (P == 8) { SchedE S; S.init((const unsigned*)(ws + WS_CTL) + CW_ECNT, (const int2*)(ws + WS_EREC), (const char*)(ws + WS_WGUT), G, (int)blockIdx.x, lane);
        EpiGU E{(bf16*)(ws + WS_HID)}; pg8::gemm_phase_g<EpiGU, SchedE>(lds, (const pg8::bf16_t*)(ws + WS_H), 1024, 1024, 16, 16, S, E); }
    if constexpr (P == 71) norm_route_mfma<true, 1>(args, args.out, (const float*)(ws + WS_SSQ), (const float*)args.in[I_NORM_FFN], mod + 3072, mod + 4096, (bf16*)(ws + WS_PROJ + 32 * MiB), lds, tid, lane, wave);
    if constexpr (P == 7) norm_route_mfma<true>(args, args.out, (const float*)(ws + WS_SSQ), (const float*)args.in[I_NORM_FFN], mod + 3072, mod + 4096, (bf16*)(ws + WS_PROJ + 32 * MiB), lds, tid, lane, wave);
    if constexpr (P == 91 || P == 92) { SchedC S; S.init((const unsigned*)(ws + WS_CTL) + CW_CCNT, (const int*)(ws + WS_CLIST), (const char*)(ws + WS_WDT), G, (int)blockIdx.x, lane);
        EpiDownT<P - 90> E{(float*)(ws + WS_PROJ + 32 * MiB), mod + 5120, nullptr}; pg8::gemm_phase_g<EpiDownT<P - 90>, SchedC>(lds, (const pg8::bf16_t*)(ws + WS_HID), 512, 256, 8, 4, S, E); }
    if constexpr (P == 9) { SchedC S; S.init((const unsigned*)(ws + WS_CTL) + CW_CCNT, (const int*)(ws + WS_CLIST), (const char*)(ws + WS_WDT), G, (int)blockIdx.x, lane);
        EpiDown E{(float*)(ws + WS_PROJ + 32 * MiB), mod + 5120, nullptr}; pg8::gemm_phase_g<EpiDown, SchedC>(lds, (const pg8::bf16_t*)(ws + WS_HID), 512, 256, 8, 4, S, E); }
}
#endif
extern "C" void kernel_launch(void* const* d_in, const int* in_sizes, int n_in, void* d_out, int out_size, void* d_ws, size_t ws_size, hipStream_t stream) {
    static int grid = 0;
    if (grid == 0) {
        if (n_in != 23 || in_sizes[0] != TT * DM || out_size != TT * DM || ws_size < WS_END) { fprintf(stderr, "kernel_launch: unexpected shapes: n_in %d in0 %d out %d ws %zu (need %zu)\n", n_in, n_in > 0 ? in_sizes[0] : -1, out_size, ws_size, (size_t)WS_END); grid = -1; return; }
        int dev = 0, cus = 0, per_cu = 0;
        if (hipGetDevice(&dev) != hipSuccess || hipDeviceGetAttribute(&cus, hipDeviceAttributeMultiprocessorCount, dev) != hipSuccess) { grid = -1; return; }
        if (hipFuncSetAttribute((const void*)fwd_kernel, hipFuncAttributeMaxDynamicSharedMemorySize, LDS_BYTES) != hipSuccess) { fprintf(stderr, "kernel_launch: hipFuncSetAttribute failed\n"); grid = -1; return; }
        if (hipOccupancyMaxActiveBlocksPerMultiprocessor(&per_cu, (const void*)fwd_kernel, NTHR, LDS_BYTES) != hipSuccess || per_cu < 1) fprintf(stderr, "kernel_launch: occupancy query reports %d\n", per_cu);
        (void)hipGetLastError();
        grid = cus;
    }
    if (grid < 0) return;
    if (hipMemsetAsync((char*)d_ws + WS_CTL, 0, CTL_ZERO_BYTES, stream) != hipSuccess) { fprintf(stderr, "kernel_launch: memset failed\n"); return; }
    Args a{};
    for (int i = 0; i < 23; ++i) a.in[i] = d_in[i];
    a.out = (float*)d_out; a.ws = (unsigned char*)d_ws;
#if MK_ONE_LAUNCH
    a.ph_lo = 0; a.ph_hi = N_PHASES;
    hipLaunchKernelGGL(fwd_kernel, dim3(grid), dim3(NTHR), LDS_BYTES, stream, a);
#if PROBE_REP >= 0 && PROBE_REP < 1000
    hipFuncSetAttribute((const void*)probe_kernel<PROBE_REP>, hipFuncAttributeMaxDynamicSharedMemorySize, LDS_BYTES);
    hipLaunchKernelGGL(probe_kernel<PROBE_REP>, dim3(grid), dim3(NTHR), LDS_BYTES, stream, a);
#endif
#else
    for (int p = 0; p < N_PHASES; ++p) { a.ph_lo = p; a.ph_hi = p + 1; hipLaunchKernelGGL(fwd_kernel, dim3(grid), dim3(NTHR), LDS_BYTES, stream, a); }
#endif
}
```

```cpp
#include <hip/hip_runtime.h>
#include <cstdio>
#include <cstdint>
namespace pg8 {
#define PG8_LAS __attribute__((address_space(3)))
typedef unsigned short bf16_t;
typedef short bf16x8 __attribute__((ext_vector_type(8)));
typedef float f32x4 __attribute__((ext_vector_type(4)));
typedef unsigned u32x4 __attribute__((ext_vector_type(4)));
constexpr int BM = 256, BK = 64, HALF = 128, HTB = HALF * BK * 2  , STAGE_BYTES = 8 * HTB, NXCD = 8, WGM = 8;

__host__ __device__ __forceinline__ int lds_byte(int r, int c) { const int st = (r >> 4) * 2 + (c >> 5), rr = r & 15, cc = c & 31, ob = rr * 64 + cc * 2; return st * 1024 + (ob ^ (((ob >> 9) & 1) << 5)); }
__host__ __device__ __forceinline__ void stage_rc(int b, int& R, int& C) { const int st = b / 1024, sb = b % 1024, swz = sb ^ (((sb >> 9) & 1) << 5); R = (st >> 1) * 16 + swz / 64; C = (st & 1) * 32 + (swz % 64) / 2; }
__host__ __device__ __forceinline__ int perm32(int rho) { const int n = rho >> 4, i = rho & 15; return 8 * (i >> 2) + 4 * n + (i & 3); }

struct Unit { int pm, pn; };
struct Gemm { const bf16_t* A; const bf16_t* Bt; int M, N, K; };

struct StaticOrder {
    int nM, nN, nwg, G, c;
    __host__ __device__ void init(int M, int N, int G_, int c_) { nM = M / BM; nN = N / BM; nwg = nM * nN; G = G_; c = c_; }
    __host__ __device__ bool next(int i, Unit& u) const {
        const long L = (long)i * G + c; if (L >= nwg) return false;
        int wgid = (int)L; { const int q = nwg / NXCD, r = nwg % NXCD, xcd = wgid % NXCD, off = wgid / NXCD; wgid = (xcd < r ? xcd * (q + 1) : r * (q + 1) + (xcd - r) * q) + off; }
        const int nig = WGM * nN, gid = wgid / nig, fm = gid * WGM, gsz = (nM - fm) < WGM ? (nM - fm) : WGM;
        u.pm = fm + ((wgid % nig) % gsz); u.pn = (wgid % nig) / gsz; return true;
    }
    __device__ __forceinline__ void a_ready(const Unit&) const {}
    __device__ __forceinline__ void done(const Unit&) const {}
};

__device__ __forceinline__ unsigned cvt_pk_bf16(float lo, float hi) { unsigned r; asm volatile("v_cvt_pk_bf16_f32 %0, %1, %2" : "=v"(r) : "v"(lo), "v"(hi)); return r; }

__device__ __forceinline__ void store16_wt(void* base, unsigned byte_off, u32x4 v) {
    __amdgpu_buffer_rsrc_t r = __builtin_amdgcn_make_buffer_rsrc(base, 0, 0x7fffffff, 0x00020000);
    __builtin_amdgcn_raw_buffer_store_b128(v, r, (int)byte_off, 0, 16);
}
struct EpiProj {
    static constexpr bool PERM = true, AFTER_DRAIN = false, PREFETCH = false;
    bf16_t* P; float* AB; int ldp;
    __device__ __forceinline__ void operator()(const f32x4 (&acc)[2][2][4][2], const Unit& u, int wr, int wc, int fr, int fq) const {
        const int row0 = u.pm * BM + wr * 64 + fr;
        if (u.pn < 11) {
            const int col0 = u.pn * BM + wc * 32 + 8 * fq;
#pragma unroll
            for (int ai = 0; ai < 2; ++ai)
#pragma unroll
                for (int m = 0; m < 4; ++m) { const unsigned ro = ((unsigned)(row0 + ai * HALF + m * 16) * (unsigned)ldp + (unsigned)col0) * 2u;
#pragma unroll
                    for (int bj = 0; bj < 2; ++bj) { const f32x4 v0 = acc[ai][bj][m][0], v1 = acc[ai][bj][m][1];
                        u32x4 w; w.x = cvt_pk_bf16(v0[0], v0[1]); w.y = cvt_pk_bf16(v0[2], v0[3]); w.z = cvt_pk_bf16(v1[0], v1[1]); w.w = cvt_pk_bf16(v1[2], v1[3]);
                        *(u32x4*)((char*)P + ro + (unsigned)(bj * HALF) * 2u) = w; } }
        } else if (wc == 0 && fq < 2) {
#pragma unroll
            for (int ai = 0; ai < 2; ++ai)
#pragma unroll
                for (int m = 0; m < 4; ++m) { float* rowp = AB + (size_t)(row0 + ai * HALF + m * 16) * 16 + 8 * fq;
                    *(f32x4*)(rowp) = acc[ai][0][m][0]; *(f32x4*)(rowp + 4) = acc[ai][0][m][1]; }
        }
    }
};
struct EpiOut {
    static constexpr bool PERM = false, AFTER_DRAIN = false, PREFETCH = false;
    const float* X; float* O; const float* gate; int rows_per_batch, ldg;
    float* SSQ;
    __device__ __forceinline__ void prefetch(PG8_LAS unsigned char* lds, const Unit& u, int tid) const {
        const char* base = (const char*)X + ((size_t)(u.pm * BM) * 1024 + (size_t)u.pn * BM) * 4 + (size_t)(tid >> 3) * 4096 + (size_t)(tid & 7) * 128;
#pragma unroll
        for (int i = 0; i < 4; ++i) __builtin_amdgcn_global_load_lds((const unsigned*)(base + (size_t)i * 64 * 4096), (PG8_LAS unsigned*)(lds + STAGE_BYTES + 256), 4, 0, 0);
    }
    __device__ __forceinline__ void operator()(const f32x4 (&acc)[2][2][4][2], const Unit& u, int wr, int wc, int fr, int fq) const {
        const int row0 = u.pm * BM + wr * 64 + fr, col0 = u.pn * BM + wc * 32 + 4 * fq;
        const float* gb = gate + (size_t)((u.pm * BM) / rows_per_batch) * ldg + col0;
        f32x4 gv[2][2];
#pragma unroll
        for (int bj = 0; bj < 2; ++bj)
#pragma unroll
            for (int n = 0; n < 2; ++n) gv[bj][n] = *(const f32x4*)(gb + bj * HALF + n * 16);
#pragma unroll
        for (int ai = 0; ai < 2; ++ai)
#pragma unroll
            for (int m = 0; m < 4; ++m) { const size_t ro = (size_t)(row0 + ai * HALF + m * 16) * 1024 + col0; float ss = 0.f;
#pragma unroll
                for (int bj = 0; bj < 2; ++bj)
#pragma unroll
                    for (int n = 0; n < 2; ++n) { const f32x4 xv = *(const f32x4*)(X + ro + bj * HALF + n * 16); const f32x4 v = xv + gv[bj][n] * acc[ai][bj][m][n];
                        *(f32x4*)(O + ro + bj * HALF + n * 16) = v; ss += (v.x * v.x + v.y * v.y) + (v.z * v.z + v.w * v.w); }
                if (SSQ) { ss += __shfl_xor(ss, 16); ss += __shfl_xor(ss, 32); if (fq == 0) SSQ[(size_t)(row0 + ai * HALF + m * 16) * 16 + u.pn * 4 + wc] = ss; } }
    }
};

struct UnitG { int id, tile, pn, nrows; };
template <class Epi, class Sched>
__device__ __forceinline__ void gemm_phase_g(PG8_LAS unsigned char* lds, const bf16_t* Abase, const int KA, const int KB, const int nt, const int ksplit, const Sched& S, const Epi& E) {
    const int tid = threadIdx.x, wid = __builtin_amdgcn_readfirstlane(tid >> 6), lane = tid & 63, wr = wid >> 2, wc = wid & 3, fr = lane & 15, fq = lane >> 4;
    int Rr[2]; unsigned cB2[2], voffB[2];
#pragma unroll
    for (int i = 0; i < 2; ++i) { int R, C; stage_rc(tid * 16 + i * 8192, R, C); const int Rb = Epi::PERM ? ((R & ~31) + perm32(R & 31)) : R;
        Rr[i] = R; cB2[i] = (unsigned)C * 2u; voffB[i] = (unsigned)(Rb * KB + C) * 2u; }
    const size_t kstep = (size_t)(BK * 2);
    const size_t hstepB = (size_t)HALF * KB * 2;
    const unsigned ldsw = (unsigned)wid * 1024u;
    const int aoff = lds_byte(wr * 64 + fr, fq * 8), boff = lds_byte(wc * 32 + fr, fq * 8);
#define PG8_SA(b, h) (((b) * 2 + (h)) * HTB)
#define PG8_SB(b, h) ((4 + (b) * 2 + (h)) * HTB)
#define PG8_STAGE2(bufoff, gbase, v0, v1) do { \
        __builtin_amdgcn_global_load_lds((const unsigned*)((const char*)(gbase) + (v0)), (PG8_LAS unsigned*)(lds + (bufoff) + ldsw), 16, 0, 0); \
        __builtin_amdgcn_global_load_lds((const unsigned*)((const char*)(gbase) + (v1)), (PG8_LAS unsigned*)(lds + (bufoff) + ldsw + 8192), 16, 0, 0); } while (0)
#define PG8_LDA(dst, b, h) do { _Pragma("unroll") for (int m = 0; m < 4; ++m) _Pragma("unroll") for (int k = 0; k < 2; ++k) dst[m][k] = *(const PG8_LAS bf16x8*)(lds + PG8_SA(b, h) + aoff + m * 2048 + k * 1024); } while (0)
#define PG8_LDB(dst, b, h) do { _Pragma("unroll") for (int n = 0; n < 2; ++n) _Pragma("unroll") for (int k = 0; k < 2; ++k) dst[n][k] = *(const PG8_LAS bf16x8*)(lds + PG8_SB(b, h) + boff + n * 2048 + k * 1024); } while (0)
#define PG8_MMA(ai, bj, At, Bt) do { __builtin_amdgcn_s_setprio(1); _Pragma("unroll") for (int m = 0; m < 4; ++m) _Pragma("unroll") for (int n = 0; n < 2; ++n) _Pragma("unroll") for (int k = 0; k < 2; ++k) \
        acc[ai][bj][m][n] = __builtin_amdgcn_mfma_f32_16x16x32_bf16(Bt[n][k], At[m][k], acc[ai][bj][m][n], 0, 0, 0); __builtin_amdgcn_s_setprio(0); } while (0)
#define PG8_WAIT_V(n) asm volatile("s_waitcnt vmcnt(" #n ")" ::: "memory")
#define PG8_WAIT_L(n) asm volatile("s_waitcnt lgkmcnt(" #n ")" ::: "memory")
#define PG8_BAR __builtin_amdgcn_s_barrier()
#define PG8_SCHED __builtin_amdgcn_sched_barrier(0)
#define PG8_AOFFS(u, o00, o01, o10, o11) do { const unsigned _ks = (unsigned)KA * 2u; \
        o00 = (unsigned)S.tok(u, Rr[0]) * _ks + cB2[0]; o01 = (unsigned)S.tok(u, Rr[1]) * _ks + cB2[1]; \
        o10 = (unsigned)S.tok(u, HALF + Rr[0]) * _ks + cB2[0]; o11 = (unsigned)S.tok(u, HALF + Rr[1]) * _ks + cB2[1]; } while (0)
#define PG8_BT(u, t) (((t) < ksplit) ? S.bseg(u, 0) + (size_t)(t) * kstep : S.bseg(u, 1) + (size_t)((t) - ksplit) * kstep)
    UnitG cur, nxt; int ui = 0;
    if (!S.next(0, cur)) return;
    f32x4 acc[2][2][4][2];
#pragma unroll
    for (int a = 0; a < 2; ++a)
#pragma unroll
        for (int b = 0; b < 2; ++b)
#pragma unroll
            for (int m = 0; m < 4; ++m)
#pragma unroll
                for (int n = 0; n < 2; ++n) acc[a][b][m][n] = (f32x4){0.f, 0.f, 0.f, 0.f};
    bf16x8 At[4][2], B0[2][2], B1[2][2];
    unsigned c00, c01, c10, c11, n00 = 0, n01 = 0, n10 = 0, n11 = 0;
    PG8_AOFFS(cur, c00, c01, c10, c11);
    if constexpr (Epi::PREFETCH) E.prefetch(lds, cur, S, tid);
    const char* const Ab = (const char*)Abase;
    {   const char* b0p = PG8_BT(cur, 0); const char* b1p = PG8_BT(cur, 1);
        PG8_STAGE2(PG8_SB(0, 0), b0p, voffB[0], voffB[1]); PG8_STAGE2(PG8_SB(0, 1), b0p + hstepB, voffB[0], voffB[1]); PG8_STAGE2(PG8_SA(0, 0), Ab, c00, c01); PG8_STAGE2(PG8_SA(0, 1), Ab, c10, c11);
        if (wr == 1) PG8_BAR;
        PG8_WAIT_V(2); PG8_BAR;
        PG8_STAGE2(PG8_SB(1, 0), b1p, voffB[0], voffB[1]); PG8_STAGE2(PG8_SA(1, 0), Ab + kstep, c00, c01); PG8_STAGE2(PG8_SB(1, 1), b1p + hstepB, voffB[0], voffB[1]);
        PG8_WAIT_V(6); PG8_BAR;
    }
    for (;;) {
        const bool has_next = S.next(ui + 1, nxt);
        const bool h1 = cur.nrows > HALF;
        for (int t = 0; t < nt; t += 2) {
            const bool last = (t == nt - 2);
            if (last && has_next) { PG8_AOFFS(nxt, n00, n01, n10, n11); if constexpr (Epi::PREFETCH) E.prefetch(lds, nxt, S, tid); }
            const bool usen = last && has_next;
            const int t2 = last ? 0 : t + 2, t3 = t2 + 1;
            const char* a1 = Ab + (size_t)(t + 1) * kstep;
            const char* a2 = Ab + (size_t)t2 * kstep; const char* a3 = Ab + (size_t)t3 * kstep;
            const char* b2 = usen ? PG8_BT(nxt, t2) : PG8_BT(cur, t2); const char* b3 = usen ? PG8_BT(nxt, t3) : PG8_BT(cur, t3);
            const unsigned o00 = usen ? n00 : c00, o01 = usen ? n01 : c01, o10 = usen ? n10 : c10, o11 = usen ? n11 : c11;
            PG8_LDB(B0, 0, 0); PG8_LDB(B1, 0, 1); PG8_SCHED; PG8_LDA(At, 0, 0); PG8_STAGE2(PG8_SA(1, 1), a1, c10, c11);
            PG8_WAIT_V(8); PG8_WAIT_L(0); PG8_BAR; PG8_MMA(0, 0, At, B0); PG8_MMA(0, 1, At, B1); PG8_BAR; PG8_SCHED;
            PG8_LDA(At, 0, 1); PG8_STAGE2(PG8_SB(0, 0), b2, voffB[0], voffB[1]); PG8_STAGE2(PG8_SB(0, 1), b2 + hstepB, voffB[0], voffB[1]); PG8_STAGE2(PG8_SA(0, 0), a2, o00, o01);
            PG8_WAIT_V(8); PG8_WAIT_L(0); PG8_BAR; if (h1) { PG8_MMA(1, 0, At, B0); PG8_MMA(1, 1, At, B1); } PG8_BAR; PG8_SCHED;
            PG8_LDB(B0, 1, 0); PG8_LDB(B1, 1, 1); PG8_SCHED; PG8_LDA(At, 1, 0); PG8_STAGE2(PG8_SA(0, 1), a2, o10, o11);
            PG8_WAIT_V(8); PG8_WAIT_L(0); PG8_BAR; PG8_MMA(0, 0, At, B0); PG8_MMA(0, 1, At, B1); PG8_BAR; PG8_SCHED;
            PG8_LDA(At, 1, 1); PG8_STAGE2(PG8_SB(1, 0), b3, voffB[0], voffB[1]); PG8_STAGE2(PG8_SB(1, 1), b3 + hstepB, voffB[0], voffB[1]); PG8_STAGE2(PG8_SA(1, 0), a3, o00, o01);
            PG8_WAIT_V(8); PG8_WAIT_L(0); PG8_BAR; if (h1) { PG8_MMA(1, 0, At, B0); PG8_MMA(1, 1, At, B1); } PG8_BAR; PG8_SCHED;
        }
        if (wr == 0) PG8_BAR;
        E(acc, cur, S, wr, wc, fr, fq);
        if (!has_next) break;
#pragma unroll
        for (int a = 0; a < 2; ++a)
#pragma unroll
            for (int b = 0; b < 2; ++b)
#pragma unroll
                for (int m = 0; m < 4; ++m)
#pragma unroll
                    for (int n = 0; n < 2; ++n) acc[a][b][m][n] = (f32x4){0.f, 0.f, 0.f, 0.f};
        cur = nxt; c00 = n00; c01 = n01; c10 = n10; c11 = n11; ++ui;
        if (wr == 1) PG8_BAR;
    }
    PG8_WAIT_V(0);
    PG8_BAR;
#undef PG8_SA
#undef PG8_SB
#undef PG8_STAGE2
#undef PG8_LDA
#undef PG8_LDB
#undef PG8_MMA
#undef PG8_WAIT_V
#undef PG8_WAIT_L
#undef PG8_BAR
#undef PG8_SCHED
#undef PG8_AOFFS
#undef PG8_BT
}
template <class Epi, class Sched, bool ALIGN_EPI = false, bool SP2 = false>
__device__ __forceinline__ void gemm_phase(PG8_LAS unsigned char* lds, const Gemm g, const Sched& S, const Epi& E) {
    const int tid = threadIdx.x, wid = __builtin_amdgcn_readfirstlane(tid >> 6), lane = tid & 63, wr = wid >> 2, wc = wid & 3, fr = lane & 15, fq = lane >> 4;
    const int K = g.K, nt = K / BK;
    unsigned voffA[2], voffB[2];
#pragma unroll
    for (int i = 0; i < 2; ++i) { int R, C; stage_rc(tid * 16 + i * 8192, R, C); const int Rb = Epi::PERM ? ((R & ~31) + perm32(R & 31)) : R;
        voffA[i] = (unsigned)(R * K + C) * 2u; voffB[i] = (unsigned)(Rb * K + C) * 2u; }
    const size_t kstep = (size_t)(BK * 2);
    const size_t hstep = (size_t)HALF * K * 2;
    const size_t tstep = 2 * hstep;
    const unsigned ldsw = (unsigned)wid * 1024u;
    const int aoff = lds_byte(wr * 64 + fr, fq * 8), boff = lds_byte(wc * 32 + fr, fq * 8);
#define PG8_SA(b, h) (((b) * 2 + (h)) * HTB)
#define PG8_SB(b, h) ((4 + (b) * 2 + (h)) * HTB)
#define PG8_STAGE(bufoff, gbase, voff) do { _Pragma("unroll") for (int _i = 0; _i < 2; ++_i) \
        __builtin_amdgcn_global_load_lds((const unsigned*)((const char*)(gbase) + (voff)[_i]), (PG8_LAS unsigned*)(lds + (bufoff) + ldsw + _i * 8192), 16, 0, 0); } while (0)
#define PG8_LDA(dst, b, h) do { _Pragma("unroll") for (int m = 0; m < 4; ++m) _Pragma("unroll") for (int k = 0; k < 2; ++k) dst[m][k] = *(const PG8_LAS bf16x8*)(lds + PG8_SA(b, h) + aoff + m * 2048 + k * 1024); } while (0)
#define PG8_LDB(dst, b, h) do { _Pragma("unroll") for (int n = 0; n < 2; ++n) _Pragma("unroll") for (int k = 0; k < 2; ++k) dst[n][k] = *(const PG8_LAS bf16x8*)(lds + PG8_SB(b, h) + boff + n * 2048 + k * 1024); } while (0)
#define PG8_MMA(ai, bj, At, Bt) do { __builtin_amdgcn_s_setprio(1); _Pragma("unroll") for (int m = 0; m < 4; ++m) _Pragma("unroll") for (int n = 0; n < 2; ++n) _Pragma("unroll") for (int k = 0; k < 2; ++k) \
        acc[ai][bj][m][n] = __builtin_amdgcn_mfma_f32_16x16x32_bf16(Bt[n][k], At[m][k], acc[ai][bj][m][n], 0, 0, 0); __builtin_amdgcn_s_setprio(0); } while (0)
#define PG8_WAIT_V(n) asm volatile("s_waitcnt vmcnt(" #n ")" ::: "memory")
#define PG8_WAIT_L(n) asm volatile("s_waitcnt lgkmcnt(" #n ")" ::: "memory")
#define PG8_BAR __builtin_amdgcn_s_barrier()
#define PG8_SCHED __builtin_amdgcn_sched_barrier(0)
    Unit cur, nxt; int ui = 0;
    if (!S.next(0, cur)) return;
    f32x4 acc[2][2][4][2];
#pragma unroll
    for (int a = 0; a < 2; ++a)
#pragma unroll
        for (int b = 0; b < 2; ++b)
#pragma unroll
            for (int m = 0; m < 4; ++m)
#pragma unroll
                for (int n = 0; n < 2; ++n) acc[a][b][m][n] = (f32x4){0.f, 0.f, 0.f, 0.f};
    bf16x8 At[4][2], B0[2][2], B1[2][2];
    const char* cA = (const char*)g.A + (size_t)cur.pm * tstep; const char* cB = (const char*)g.Bt + (size_t)cur.pn * tstep;
    S.a_ready(cur);
    if constexpr (SP2) {
        PG8_STAGE(PG8_SB(0, 0), cB, voffB); PG8_STAGE(PG8_SB(0, 1), cB + hstep, voffB); PG8_STAGE(PG8_SA(0, 0), cA, voffA); PG8_STAGE(PG8_SA(0, 1), cA + hstep, voffA);
        if (wr == 1) PG8_BAR;
        PG8_WAIT_V(2); PG8_BAR;
        PG8_STAGE(PG8_SB(1, 0), cB + kstep, voffB); PG8_STAGE(PG8_SA(1, 0), cA + kstep, voffA); PG8_STAGE(PG8_SB(1, 1), cB + hstep + kstep, voffB);
        PG8_WAIT_V(6); PG8_BAR;
    } else {
        PG8_STAGE(PG8_SB(0, 0), cB, voffB); PG8_STAGE(PG8_SA(0, 0), cA, voffA); PG8_STAGE(PG8_SB(0, 1), cB + hstep, voffB); PG8_STAGE(PG8_SA(0, 1), cA + hstep, voffA);
        if (wr == 1) PG8_BAR;
        PG8_WAIT_V(4); PG8_BAR;
        PG8_STAGE(PG8_SB(1, 0), cB + kstep, voffB); PG8_STAGE(PG8_SA(1, 0), cA + kstep, voffA); PG8_STAGE(PG8_SB(1, 1), cB + hstep + kstep, voffB);
        PG8_WAIT_V(6); PG8_BAR;
    }
    if constexpr (Epi::PREFETCH) E.prefetch(lds, cur, tid);
    for (;;) {
        const bool has_next = S.next(ui + 1, nxt);
        const char* nA = has_next ? (const char*)g.A + (size_t)nxt.pm * tstep : cA; const char* nB = has_next ? (const char*)g.Bt + (size_t)nxt.pn * tstep : cB;
        for (int t = 0; t < nt; t += 2) {
            const bool last = (t == nt - 2);
            const char* a1 = cA + (size_t)(t + 1) * kstep;
            const char* a2 = last ? nA : cA + (size_t)(t + 2) * kstep; const char* b2 = last ? nB : cB + (size_t)(t + 2) * kstep;
            const char* a3 = a2 + kstep; const char* b3 = b2 + kstep;
            if (last && has_next) S.a_ready(nxt);
            if constexpr (SP2) {
            PG8_LDB(B0, 0, 0); PG8_LDB(B1, 0, 1); PG8_SCHED; PG8_LDA(At, 0, 0); PG8_STAGE(PG8_SA(1, 1), a1 + hstep, voffA);
            PG8_WAIT_V(8); PG8_WAIT_L(0); PG8_BAR; PG8_MMA(0, 0, At, B0); PG8_MMA(0, 1, At, B1); PG8_BAR; PG8_SCHED;
            PG8_LDA(At, 0, 1); PG8_STAGE(PG8_SB(0, 0), b2, voffB); PG8_STAGE(PG8_SB(0, 1), b2 + hstep, voffB); PG8_STAGE(PG8_SA(0, 0), a2, voffA);
            PG8_WAIT_V(8); PG8_WAIT_L(0); PG8_BAR; PG8_MMA(1, 0, At, B0); PG8_MMA(1, 1, At, B1); PG8_BAR; PG8_SCHED;
            PG8_LDB(B0, 1, 0); PG8_LDB(B1, 1, 1); PG8_SCHED; PG8_LDA(At, 1, 0); PG8_STAGE(PG8_SA(0, 1), a2 + hstep, voffA);
            PG8_WAIT_V(8); PG8_WAIT_L(0); PG8_BAR; PG8_MMA(0, 0, At, B0); PG8_MMA(0, 1, At, B1); PG8_BAR; PG8_SCHED;
            PG8_LDA(At, 1, 1); PG8_STAGE(PG8_SB(1, 0), b3, voffB); PG8_STAGE(PG8_SB(1, 1), b3 + hstep, voffB); PG8_STAGE(PG8_SA(1, 0), a3, voffA);
            PG8_WAIT_V(8); PG8_WAIT_L(0); PG8_BAR; PG8_MMA(1, 0, At, B0); PG8_MMA(1, 1, At, B1); PG8_BAR; PG8_SCHED;
            } else {
            PG8_LDB(B0, 0, 0); PG8_SCHED; PG8_LDA(At, 0, 0); PG8_STAGE(PG8_SA(1, 1), a1 + hstep, voffA);
            PG8_WAIT_L(8); PG8_BAR; PG8_WAIT_L(0); PG8_MMA(0, 0, At, B0); PG8_BAR; PG8_SCHED;
            PG8_LDB(B1, 0, 1); PG8_STAGE(PG8_SB(0, 0), b2, voffB);
            PG8_BAR; PG8_WAIT_L(0); PG8_MMA(0, 1, At, B1); PG8_BAR;
            PG8_LDA(At, 0, 1); PG8_STAGE(PG8_SA(0, 0), a2, voffA);
            PG8_BAR; PG8_WAIT_L(0); PG8_MMA(1, 0, At, B0); PG8_BAR; PG8_SCHED;
            PG8_STAGE(PG8_SB(0, 1), b2 + hstep, voffB);
            PG8_WAIT_V(6); PG8_BAR; PG8_MMA(1, 1, At, B1); PG8_BAR;
            PG8_LDB(B0, 1, 0); PG8_SCHED; PG8_LDA(At, 1, 0); PG8_STAGE(PG8_SA(0, 1), a2 + hstep, voffA);
            PG8_WAIT_L(8); PG8_BAR; PG8_WAIT_L(0); PG8_MMA(0, 0, At, B0); PG8_BAR; PG8_SCHED;
            PG8_LDB(B1, 1, 1); PG8_STAGE(PG8_SB(1, 0), b3, voffB);
            PG8_BAR; PG8_WAIT_L(0); PG8_MMA(0, 1, At, B1); PG8_BAR;
            PG8_LDA(At, 1, 1); PG8_STAGE(PG8_SA(1, 0), a3, voffA);
            PG8_BAR; PG8_WAIT_L(0); PG8_MMA(1, 0, At, B0); PG8_BAR; PG8_SCHED;
            PG8_STAGE(PG8_SB(1, 1), b3 + hstep, voffB);
            PG8_WAIT_V(6); PG8_BAR; PG8_MMA(1, 1, At, B1); PG8_BAR;
            }
        }
        if constexpr (ALIGN_EPI) { if (wr == 0) PG8_BAR; }
        if constexpr (!Epi::AFTER_DRAIN) { E(acc, cur, wr, wc, fr, fq); S.done(cur); }
        if (!has_next) break;
#pragma unroll
        for (int a = 0; a < 2; ++a)
#pragma unroll
            for (int b = 0; b < 2; ++b)
#pragma unroll
                for (int m = 0; m < 4; ++m)
#pragma unroll
                    for (int n = 0; n < 2; ++n) acc[a][b][m][n] = (f32x4){0.f, 0.f, 0.f, 0.f};
        cur = nxt; cA = nA; cB = nB; ++ui;
        if constexpr (Epi::PREFETCH) { int l_ = fr + 16 * fq; asm volatile("" : "+v"(l_)); E.prefetch(lds, cur, wid * 64 + l_); }
        if constexpr (ALIGN_EPI) { if (wr == 1) PG8_BAR; }
    }
    PG8_WAIT_V(0);
    if constexpr (!ALIGN_EPI) { if (wr == 0) PG8_BAR; }
    PG8_BAR;
    if constexpr (Epi::AFTER_DRAIN) { E.fused(acc, cur, wr, wc, fr, fq, lds, wid, lane); S.done(cur); }
#undef PG8_SA
#undef PG8_SB
#undef PG8_STAGE
#undef PG8_LDA
#undef PG8_LDB
#undef PG8_MMA
#undef PG8_WAIT_V
#undef PG8_WAIT_L
#undef PG8_BAR
#undef PG8_SCHED
}
}

constexpr int NB = 4, SEQ = 8192, DM = 1024, TT = NB * SEQ;
constexpr int NPROJ = 2816, NPAD = 3072;
constexpr int PC_Q = 0, PC_K = 512, PC_V = 1024, PC_Z = 1536, PC_SQ = 2048, PC_SK = 2560, PC_SV = 2688;
constexpr int NE = 32, NCLS = 112, DE = 256;
constexpr float EPS = 1e-6f;
constexpr int NWAVES = 8, NTHR = 512;
constexpr int N_PHASES = 10;
#ifndef G1_SM
#define G1_SM 31
#endif
#ifndef PROBE_REP
#define PROBE_REP -1
#endif
#ifndef MK_ONE_LAUNCH
#define MK_ONE_LAUNCH 1
#endif

constexpr size_t MiB = 1u << 20;
constexpr size_t WS_CTL = 0, CTL_ZERO_BYTES = 65536;
constexpr size_t WS_MOD = 1 * MiB;
constexpr size_t WS_WINT = 2 * MiB, WS_WOUTT = 8 * MiB, WS_WGUT = 10 * MiB, WS_WDT = 42 * MiB;
constexpr size_t WS_H = 58 * MiB;
constexpr size_t WS_PROJ = 122 * MiB;
constexpr size_t WS_AB = 298 * MiB;
constexpr size_t WS_SSQ = WS_AB;
constexpr size_t WS_MIX = 300 * MiB;
constexpr size_t WS_GSF = 364 * MiB;
constexpr size_t WS_EREC = 404 * MiB, WS_CLIST = 412 * MiB;
constexpr size_t WS_HID = WS_PROJ;
constexpr size_t WS_GAP = WS_H, WS_GQP = WS_H + 32 * MiB;
constexpr size_t WS_GOP = 426 * MiB, WS_GBP = 458 * MiB, WS_GGL = 490 * MiB;
constexpr size_t WS_WRT = 491 * MiB;
constexpr size_t WS_END = 492 * MiB;
constexpr int CW_BAR = 4096, CW_ECNT = 8192, CW_CCNT = 8256;

constexpr int RING_BYTES = 131072, LDSCTL_OFF = RING_BYTES, LDS_BYTES = 147456, MISC_OFF = LDS_BYTES - 128;

#define GAS __attribute__((address_space(1)))
#define LAS __attribute__((address_space(3)))
typedef unsigned short bf16;
typedef unsigned v4u __attribute__((ext_vector_type(4)));
typedef float f32x4 __attribute__((ext_vector_type(4)));
typedef GAS unsigned gu32;
#define RLX_AGENT __ATOMIC_RELAXED, __HIP_MEMORY_SCOPE_AGENT
#define LDS_WAIT() asm volatile("s_waitcnt lgkmcnt(0)" ::: "memory")
__device__ __forceinline__ unsigned f2bf(float f) { unsigned u = __builtin_bit_cast(unsigned, f); return (u + 0x7fffu + ((u >> 16) & 1u)) >> 16; }
__device__ __forceinline__ unsigned pk2(float lo, float hi) { return f2bf(lo) | (f2bf(hi) << 16); }
__device__ __forceinline__ float bf2f(bf16 v) { return __builtin_bit_cast(float, (unsigned)v << 16); }
__device__ __forceinline__ float wave_sum(float v) {
#pragma unroll
    for (int o = 1; o < 64; o <<= 1) v += __shfl_xor(v, o);
    return v;
}
__device__ __forceinline__ float siluf(float y) { return y / (1.f + __expf(-y)); }
#define XB_TMO      128
#define XB_XCNT(j)  (256  + 64 * (j))
#define XB_XSUB(j)  (1280 + 64 * (j))
#define XB_XGEN(j)  (2304 + 64 * (j))
#define XB_TOP      3328
#define XB_TOPGEN   3392
#define XCD_BAR_WORDS 3456
#define XB_SPIN_CAP (1u << 18)
__device__ __forceinline__ unsigned xb_ld(unsigned* p)              { return __hip_atomic_load(p, __ATOMIC_RELAXED, __HIP_MEMORY_SCOPE_AGENT); }
__device__ __forceinline__ unsigned xb_add(unsigned* p, unsigned v) { return __hip_atomic_fetch_add(p, v, __ATOMIC_RELAXED, __HIP_MEMORY_SCOPE_AGENT); }
__device__ __forceinline__ unsigned xb_xcc_id() { return (unsigned)__builtin_amdgcn_s_getreg((3 << 11) | 20) & 0xFu; }
#define XB_SPIN(cond, bar) do { unsigned _sp = 0; while (cond) { __builtin_amdgcn_s_sleep(1); \
    if ((++_sp & 255u) == 0u) { if (xb_ld(&(bar)[XB_TMO])) break; if (_sp > XB_SPIN_CAP) { atomicAdd(&(bar)[XB_TMO], 1u); break; } } } } while (0)

struct XcdBarrier {
    unsigned* bar; unsigned x;
    volatile LAS unsigned* st;
};

__device__ __forceinline__ XcdBarrier xcd_barrier_post(unsigned* bar, volatile LAS unsigned* st, bool leader  ) {
    XcdBarrier b; b.bar = bar; b.x = xb_xcc_id(); b.st = st;
    if (leader) (void)xb_add(&bar[XB_XCNT(b.x)], 1u);
    return b;
}
__device__ __forceinline__ void xcd_barrier_complete(unsigned* bar, unsigned x, unsigned& nloc, unsigned& nx) {
    const unsigned G = gridDim.x * gridDim.y * gridDim.z;
    unsigned sum, cnt, mine, sp = 0u;
    for (;;) {
        sum = 0u; cnt = 0u; mine = 0u;
#pragma unroll
        for (unsigned j = 0; j < 16; ++j) { const unsigned c = xb_ld(&bar[XB_XCNT(j)]); sum += c; cnt += (c > 0u) ? 1u : 0u; mine = (j == x) ? c : mine; }
        if (sum == G) break;
        __builtin_amdgcn_s_sleep(1);
        if ((++sp & 255u) == 0u) { if (xb_ld(&bar[XB_TMO])) break; if (sp > XB_SPIN_CAP) { atomicAdd(&bar[XB_TMO], 1u); break; } }
    }
    nloc = mine > 0u ? mine : 1u; nx = cnt > 0u ? cnt : 1u;
}

__device__ __forceinline__ void xcd_barrier(const XcdBarrier& b, bool leader  ) {
    asm volatile("s_waitcnt vmcnt(0)" ::: "memory");
    __syncthreads();
    if (leader) {
        unsigned* bar = b.bar;
        __builtin_amdgcn_s_waitcnt(0);
        unsigned nloc = b.st[0], nx = b.st[1];
        if (nloc == 0u) { xcd_barrier_complete(bar, b.x, nloc, nx); b.st[0] = nloc; b.st[1] = nx; }
        const unsigned old = xb_add(&bar[XB_XSUB(b.x)], 1u);
        const unsigned gen = old / nloc;
        if (old + 1u == (gen + 1u) * nloc) {
            __builtin_amdgcn_fence(__ATOMIC_RELEASE, "agent");
            asm volatile("s_waitcnt vmcnt(0)" ::: "memory");
            const unsigned og = xb_add(&bar[XB_TOP], 1u);
            const unsigned tg = og / nx;
            if (og + 1u == (tg + 1u) * nx) xb_add(&bar[XB_TOPGEN], 1u);
            else XB_SPIN(xb_ld(&bar[XB_TOPGEN]) == tg, bar);
            __builtin_amdgcn_fence(__ATOMIC_ACQUIRE, "agent");
            xb_add(&bar[XB_XGEN(b.x)], 1u);
            asm volatile("s_waitcnt vmcnt(0)" ::: "memory");
        } else {
            XB_SPIN(xb_ld(&bar[XB_XGEN(b.x)]) == gen, bar);
            __builtin_amdgcn_fence(__ATOMIC_ACQUIRE, "agent");
            asm volatile("s_waitcnt vmcnt(0)" ::: "memory");
        }
    }
    __syncthreads();
}

struct Args { const void* in[23]; float* out; unsigned char* ws; int ph_lo, ph_hi; };
enum { I_X = 0, I_C, I_POS, I_WADA, I_BADA, I_NORM_MIX, I_WIN, I_CONVW, I_ALOG, I_DTB, I_GNORM, I_QNORM, I_KNORM, I_SINKS, I_WOUT, I_NORM_FFN, I_WGRP, I_BGRP, I_WRT, I_BRT, I_WGATE, I_WUP, I_WDOWN };

template <class CM>
__device__ __forceinline__ void transpose_item(const float* W, int ldw, int k0, bf16* WT, int ldt, int n0, CM cm, LAS float* scr, int lane) {
    const int sc = cm(n0 + (lane & 31));
    float tv[32];
#pragma unroll
    for (int i = 0; i < 32; ++i) { const int kk = 2 * i + (lane >> 5); tv[i] = W[(size_t)(k0 + kk) * ldw + (sc >= 0 ? sc : 0)]; }
#pragma unroll
    for (int i = 0; i < 32; ++i) { const int kk = 2 * i + (lane >> 5); scr[kk * 33 + (lane & 31)] = sc >= 0 ? tv[i] : 0.f; }
    LDS_WAIT(); asm volatile("" ::: "memory");
    const int c = lane & 7;
#pragma unroll
    for (int j = 0; j < 4; ++j) { const int n = (lane >> 3) + 8 * j; const LAS float* s = scr + (8 * c) * 33 + n;
        v4u o; o.x = pk2(s[0 * 33], s[1 * 33]); o.y = pk2(s[2 * 33], s[3 * 33]); o.z = pk2(s[4 * 33], s[5 * 33]); o.w = pk2(s[6 * 33], s[7 * 33]);
        *(v4u*)(WT + (size_t)(n0 + n) * ldt + k0 + 8 * c) = o; }
    LDS_WAIT(); asm volatile("" ::: "memory");
}
struct CmIn { __device__ __forceinline__ int operator()(int n) const { return n < 2048 ? n : (n < 2816 ? n + 16 : (n < 2832 ? 2048 + (n - 2816) : -1)); } };
struct CmOff { int off; __device__ __forceinline__ int operator()(int n) const { return n + off; } };
struct CmId { __device__ __forceinline__ int operator()(int n) const { return n; } };

__device__ __forceinline__ void expert_weight_copy(const Args& A, LAS unsigned char* lds, int lane, int wave) {
    unsigned char* ws = A.ws;
    LAS float* scr = (LAS float*)(lds + wave * 8448);
    const int G = gridDim.x, gw = blockIdx.x * NWAVES + wave, NGW = G * NWAVES;
    {   constexpr int IT_GU = NE * 16 * 16, IT_D = NE * 32 * 4;
        const float* wgate = (const float*)A.in[I_WGATE]; const float* wup = (const float*)A.in[I_WUP]; const float* wdown = (const float*)A.in[I_WDOWN];
        for (int it = gw; it < IT_GU + IT_D; it += NGW) {
            if (it < IT_GU) { const int e = it >> 8, r = it & 255, nb = r & 15, kb = r >> 4, j = nb >> 3, q = nb & 7;
                const float* W = (q < 4 ? wgate : wup) + (size_t)e * 1024 * 256; const int col0 = j * 128 + (q & 3) * 32;
                transpose_item(W, 256, kb * 64, (bf16*)(ws + WS_WGUT) + (size_t)e * 512 * 1024, 1024, nb * 32, CmOff{col0 - nb * 32}, scr, lane); }
            else { const int r2 = it - IT_GU, e = r2 >> 7, r = r2 & 127, nb = r & 31, kb = r >> 5;
                transpose_item(wdown + (size_t)e * 256 * 1024, 1024, kb * 64, (bf16*)(ws + WS_WDT) + (size_t)e * 1024 * 256, 256, nb * 32, CmId(), scr, lane); }
        }
    }
}
__device__ __forceinline__ void p0_prologue(const Args& A, LAS unsigned char* lds, int tid, int lane, int wave) {
    unsigned char* ws = A.ws;
    LAS float* scr = (LAS float*)(lds + wave * 8448);
    const int G = gridDim.x, gw = blockIdx.x * NWAVES + wave, NGW = G * NWAVES;
    constexpr int IT_IN = (NPAD / 32) * (DM / 64), IT_OUT = (DM / 32) * (DM / 64);
    for (int it = gw; it < IT_IN + IT_OUT; it += NGW) {
        if (it < IT_IN) { const int nb = it % (NPAD / 32), kb = it / (NPAD / 32); transpose_item((const float*)A.in[I_WIN], 2832, kb * 64, (bf16*)(ws + WS_WINT), DM, nb * 32, CmIn(), scr, lane); }
        else { const int r = it - IT_IN, nb = r % (DM / 32), kb = r / (DM / 32); transpose_item((const float*)A.in[I_WOUT], DM, kb * 64, (bf16*)(ws + WS_WOUTT), DM, nb * 32, CmId(), scr, lane); }
    }
    {   const float* wgp = (const float*)A.in[I_WGRP]; const float* wrt = (const float*)A.in[I_WRT];
        bf16* wf = (bf16*)(ws + WS_WRT);
        for (int idx = blockIdx.x * NTHR + tid; idx < 48 * 1024; idx += G * NTHR) { const int j = idx & 7, ln = (idx >> 3) & 63, ks = (idx >> 9) & 31, nt = idx >> 14;
            const int o = 16 * nt + (ln & 15), k = 32 * ks + 8 * (ln >> 4) + j;
            const float w = o < 4 ? wgp[k * 4 + o] : (o < 36 ? wrt[k * 32 + o - 4] : 0.f);
            const unsigned hb = f2bf(w); wf[idx] = (bf16)hb; wf[48 * 1024 + idx] = (bf16)f2bf(w - __builtin_bit_cast(float, hb << 16)); }
    }
    LAS float* cact = (LAS float*)(lds + 69632);
    LAS float* red = (LAS float*)(lds + 69632 + 16384);
    const float* c = (const float*)A.in[I_C]; const float* wada = (const float*)A.in[I_WADA]; const float* bada = (const float*)A.in[I_BADA];
    float* mod = (float*)(ws + WS_MOD);
    if ((int)blockIdx.x < 192) {
        __syncthreads();
        for (int i = tid; i < 4096; i += NTHR) cact[i] = siluf(c[i]);
        __syncthreads();
        for (int u = blockIdx.x; u < 192; u += G) {
            const int n = u * 32 + (lane & 31), kh = lane >> 5; float a0 = 0.f, a1 = 0.f, a2 = 0.f, a3 = 0.f;
#pragma unroll 16
            for (int i = 0; i < 64; ++i) { const int k = wave * 128 + 2 * i + kh; const float w = wada[(size_t)k * 6144 + n]; a0 += cact[k] * w; a1 += cact[1024 + k] * w; a2 += cact[2048 + k] * w; a3 += cact[3072 + k] * w; }
            a0 += __shfl_xor(a0, 32); a1 += __shfl_xor(a1, 32); a2 += __shfl_xor(a2, 32); a3 += __shfl_xor(a3, 32);
            if (lane < 32) { red[(wave * 4 + 0) * 64 + lane] = a0; red[(wave * 4 + 1) * 64 + lane] = a1; red[(wave * 4 + 2) * 64 + lane] = a2; red[(wave * 4 + 3) * 64 + lane] = a3; }
            __syncthreads();
            if (tid < 128) { const int b = tid >> 5, l = tid & 31; float s = bada[u * 32 + l];
#pragma unroll
                for (int w = 0; w < 8; ++w) s += red[(w * 4 + b) * 64 + l];
                mod[b * 6144 + u * 32 + l] = s; }
            __syncthreads();
        }
    }
}

template <bool ROUTE>
__device__ __forceinline__ void norm_rows(const Args& A, const float* X, const float* gain, const float* shift, const float* scale, bf16* H, LAS unsigned char* lds, int lane, int wave) {
    LAS float* hl = (LAS float*)(lds + wave * 4096);
    const int G = gridDim.x, gw = blockIdx.x * NWAVES + wave, NGW = G * NWAVES;
    unsigned char* ws = A.ws;
    for (int r0 = gw * 16; r0 < TT; r0 += NGW * 16) {
        const int b = r0 / SEQ;
        f32x4 mf[4], af[4];
#pragma unroll
        for (int j = 0; j < 4; ++j) { const int col = 4 * lane + 256 * j; const f32x4 g = *(const f32x4*)(gain + col), sc = *(const f32x4*)(scale + b * 6144 + col);
            mf[j] = g * (sc + 1.0f); af[j] = *(const f32x4*)(shift + b * 6144 + col); }
#pragma unroll 4
        for (int i = 0; i < 16; ++i) {
            const int row = r0 + i;
            const f32x4* xr = (const f32x4*)(X + (size_t)row * DM) + lane;
            f32x4 v[4]; float s = 0.f;
#pragma unroll
            for (int j = 0; j < 4; ++j) { v[j] = xr[64 * j]; s += (v[j].x * v[j].x + v[j].y * v[j].y) + (v[j].z * v[j].z + v[j].w * v[j].w); }
            const float rstd = 1.f / sqrtf(wave_sum(s) * (1.f / DM) + EPS);
            unsigned long long* o8 = (unsigned long long*)(H + (size_t)row * DM) + lane;
#pragma unroll
            for (int j = 0; j < 4; ++j) { v[j] = v[j] * rstd * mf[j] + af[j];
                o8[64 * j] = (unsigned long long)pk2(v[j].x, v[j].y) | ((unsigned long long)pk2(v[j].z, v[j].w) << 32); }
            if constexpr (ROUTE) {
                const float* wg = (const float*)A.in[I_WGRP]; const float* wr = (const float*)A.in[I_WRT];
                float lg[36];
#pragma unroll
                for (int o = 0; o < 36; ++o) lg[o] = 0.f;
#pragma unroll
                for (int j = 0; j < 4; ++j) *(LAS f32x4*)(hl + 4 * lane + 256 * j) = v[j];
                LDS_WAIT(); asm volatile("" ::: "memory");
#pragma unroll 1
                for (int ii = 0; ii < 16; ++ii) { const int k = lane + 64 * ii; const float hv = hl[k];
                    const f32x4 g4 = *(const f32x4*)(wg + k * 4);
                    lg[0] += hv * g4.x; lg[1] += hv * g4.y; lg[2] += hv * g4.z; lg[3] += hv * g4.w;
#pragma unroll
                    for (int q = 0; q < 8; ++q) { const f32x4 r4 = *(const f32x4*)(wr + k * 32 + q * 4);
                        lg[4 + q * 4 + 0] += hv * r4.x; lg[4 + q * 4 + 1] += hv * r4.y; lg[4 + q * 4 + 2] += hv * r4.z; lg[4 + q * 4 + 3] += hv * r4.w; } }
                LDS_WAIT(); asm volatile("" ::: "memory");
#pragma unroll
                for (int o = 0; o < 36; ++o) lg[o] = wave_sum(lg[o]);
                const float* bg = (const float*)A.in[I_BGRP]; const float* br = (const float*)A.in[I_BRT];
#pragma unroll
                for (int o = 0; o < 4; ++o) lg[o] += bg[o];
#pragma unroll
                for (int o = 0; o < 32; ++o) lg[4 + o] += br[o];
                int gi = 0; float gm = lg[0];
#pragma unroll
                for (int o = 1; o < 4; ++o) if (lg[o] > gm) { gm = lg[o]; gi = o; }
                float gs = 0.f;
#pragma unroll
                for (int o = 0; o < 4; ++o) gs += __expf(lg[o] - gm);
                const float pg = 1.f / gs;
                float le[8];
#pragma unroll
                for (int j = 0; j < 8; ++j) { le[j] = lg[4 + j];
#pragma unroll
                    for (int g = 1; g < 4; ++g) le[j] = (gi == g) ? lg[4 + g * 8 + j] : le[j]; }
                int j1 = 0; float m1 = le[0];
#pragma unroll
                for (int j = 1; j < 8; ++j) if (le[j] > m1) { m1 = le[j]; j1 = j; }
                int j2 = -1; float m2 = -3.0e38f;
#pragma unroll
                for (int j = 0; j < 8; ++j) if (j != j1 && le[j] > m2) { m2 = le[j]; j2 = j; }
                const float ex = __expf(m2 - m1), w1 = pg / (1.f + ex), w2 = pg * ex / (1.f + ex);
                if (lane == 0) {
                    const int e1 = gi * 8 + j1, e2 = gi * 8 + j2;
                    unsigned* ctl = (unsigned*)(ws + WS_CTL);
                    int2* erec = (int2*)(ws + WS_EREC); int* clist = (int*)(ws + WS_CLIST);
                    const unsigned p1 = atomicAdd(ctl + CW_ECNT + e1, 1u); erec[(size_t)e1 * TT + p1] = make_int2(row * 2 + (e1 > e2 ? 1 : 0), __builtin_bit_cast(int, w1));
                    const unsigned p2 = atomicAdd(ctl + CW_ECNT + e2, 1u); erec[(size_t)e2 * TT + p2] = make_int2(row * 2 + (e2 > e1 ? 1 : 0), __builtin_bit_cast(int, w2));
                    const int a = j1 < j2 ? j1 : j2, bb = j1 < j2 ? j2 : j1;
                    const int cls = gi * 28 + (a * 7 - (a * (a - 1)) / 2 + (bb - a - 1));
                    const unsigned pc = atomicAdd(ctl + CW_CCNT + cls, 1u); clist[(size_t)cls * TT + pc] = row;
                }
            }
        }
    }
}

typedef short bf16x8_t __attribute__((ext_vector_type(8)));
typedef float f32x16 __attribute__((ext_vector_type(16)));
typedef unsigned v2u __attribute__((ext_vector_type(2)));
typedef float f32x2_t __attribute__((ext_vector_type(2)));
typedef __bf16 bf16x2_t __attribute__((ext_vector_type(2)));
__device__ __forceinline__ unsigned cvtpk(float lo, float hi) { const f32x2_t f = {lo, hi}; return __builtin_bit_cast(unsigned, __builtin_convertvector(f, bf16x2_t)); }
__device__ __forceinline__ void fast_sincos(float ang, float& sn, float& cs) {
    float rev = ang * 0.15915494309189535f; rev -= floorf(rev);
    sn = __builtin_amdgcn_sinf(rev); cs = __builtin_amdgcn_cosf(rev);
}
__device__ __forceinline__ void swa_mfma(const Args& A, LAS unsigned char* lds, int tid, int lane, int wave, int blk, int nblk) {
    unsigned char* ws = A.ws;
    const bf16* proj = (const bf16*)(ws + WS_PROJ);
    bf16* mix = (bf16*)(ws + WS_MIX); const float* sinks = (const float*)A.in[I_SINKS];
    const int* pos = (const int*)A.in[I_POS]; const float* qn = (const float*)A.in[I_QNORM]; const float* kn = (const float*)A.in[I_KNORM];
    constexpr int KST = 144, VST = 520;
    LAS unsigned char* Kl = lds; LAS unsigned char* Vt = lds + 256 * KST;
    const int g = wave >> 1, qh = wave & 1, ql = lane & 31, hh = lane >> 5;
    constexpr float LOG2E = 1.4426950408889634f, CS = 0.125f * LOG2E, L2T = 13.287712379549449f / 32.f;
    const int sch = tid & 7;
    float kinv[8], kgn[8];
#pragma unroll
    for (int j = 0; j < 8; ++j) { kinv[j] = __builtin_amdgcn_exp2f(-(float)((sch & 3) * 8 + j) * L2T); kgn[j] = kn[sch * 8 + j]; }
    float qinv[2][8];
#pragma unroll
    for (int ks = 0; ks < 2; ++ks)
#pragma unroll
        for (int j = 0; j < 8; ++j) qinv[ks][j] = __builtin_amdgcn_exp2f(-(float)(ks * 16 + hh * 8 + j) * L2T);
    for (int u = blk; u < NB * 2 * (SEQ / 128); u += nblk) {
        const int n = u & 63, kvh = (u >> 6) & 1, b = u >> 7;
        const int tb = b * SEQ + n * 128;
        __syncthreads();
#pragma unroll
        for (int it = 0; it < 4; ++it) { const int idx = tid + it * NTHR, key = idx >> 3, ch = idx & 7; int tk = tb - 128 + key; if (tk < b * SEQ) tk = b * SEQ;
            const v4u kv = *(const v4u*)(proj + (size_t)tk * NPROJ + PC_SK + kvh * 64 + ch * 8);
            const v4u vv = *(const v4u*)(proj + (size_t)tk * NPROJ + PC_SV + kvh * 64 + ch * 8);
            const float pf = (float)pos[tk];
            float x[8] = { __builtin_bit_cast(float, kv.x << 16), __builtin_bit_cast(float, kv.x & 0xffff0000u), __builtin_bit_cast(float, kv.y << 16), __builtin_bit_cast(float, kv.y & 0xffff0000u),
                           __builtin_bit_cast(float, kv.z << 16), __builtin_bit_cast(float, kv.z & 0xffff0000u), __builtin_bit_cast(float, kv.w << 16), __builtin_bit_cast(float, kv.w & 0xffff0000u) };
            float ss = 0.f;
#pragma unroll
            for (int j = 0; j < 8; ++j) ss += x[j] * x[j];
            ss += __shfl_xor(ss, 1); ss += __shfl_xor(ss, 2); ss += __shfl_xor(ss, 4);
            const float rn = 1.f / sqrtf(ss * (1.f / 64.f) + EPS);
            float o[8];
#pragma unroll
            for (int j = 0; j < 8; ++j) { const float xn = x[j] * rn * kgn[j]; const float pr = __shfl_xor(xn, 4); float sn, cs; fast_sincos(pf * kinv[j], sn, cs);
                o[j] = (ch < 4) ? xn * cs - pr * sn : pr * sn + xn * cs; }
            v4u ko; ko.x = cvtpk(o[0], o[1]); ko.y = cvtpk(o[2], o[3]); ko.z = cvtpk(o[4], o[5]); ko.w = cvtpk(o[6], o[7]);
            *(LAS v4u*)(Kl + key * KST + ch * 16) = ko;
            LAS unsigned short* vp = (LAS unsigned short*)(Vt + (ch * 8) * VST + key * 2);
            vp[0 * (VST / 2)] = (unsigned short)(vv.x & 0xffffu); vp[1 * (VST / 2)] = (unsigned short)(vv.x >> 16);
            vp[2 * (VST / 2)] = (unsigned short)(vv.y & 0xffffu); vp[3 * (VST / 2)] = (unsigned short)(vv.y >> 16);
            vp[4 * (VST / 2)] = (unsigned short)(vv.z & 0xffffu); vp[5 * (VST / 2)] = (unsigned short)(vv.z >> 16);
            vp[6 * (VST / 2)] = (unsigned short)(vv.w & 0xffffu); vp[7 * (VST / 2)] = (unsigned short)(vv.w >> 16); }
        __syncthreads();
        const int hq = kvh * 4 + g; const float sinkl = sinks[hq] * LOG2E;
#pragma unroll 1
        for (int qt = 0; qt < 2; ++qt) {
            const int i0 = qh * 64 + qt * 32, iq = i0 + ql;
            const size_t tq = (size_t)(tb + iq);
            bf16x8_t qf[4];
            {   float xq[4][8]; float ss = 0.f;
#pragma unroll
                for (int ks = 0; ks < 4; ++ks) { const v4u r = *(const v4u*)(proj + tq * NPROJ + PC_SQ + hq * 64 + ks * 16 + hh * 8);
                    xq[ks][0] = __builtin_bit_cast(float, r.x << 16); xq[ks][1] = __builtin_bit_cast(float, r.x & 0xffff0000u); xq[ks][2] = __builtin_bit_cast(float, r.y << 16); xq[ks][3] = __builtin_bit_cast(float, r.y & 0xffff0000u);
                    xq[ks][4] = __builtin_bit_cast(float, r.z << 16); xq[ks][5] = __builtin_bit_cast(float, r.z & 0xffff0000u); xq[ks][6] = __builtin_bit_cast(float, r.w << 16); xq[ks][7] = __builtin_bit_cast(float, r.w & 0xffff0000u);
#pragma unroll
                    for (int j = 0; j < 8; ++j) ss += xq[ks][j] * xq[ks][j]; }
                ss += __shfl_xor(ss, 32);
                const float rn = 1.f / sqrtf(ss * (1.f / 64.f) + EPS); const float pf = (float)pos[tq];
#pragma unroll
                for (int ks = 0; ks < 4; ++ks)
#pragma unroll
                    for (int j = 0; j < 8; ++j) xq[ks][j] *= rn * qn[ks * 16 + hh * 8 + j];
#pragma unroll
                for (int ks = 0; ks < 2; ++ks)
#pragma unroll
                    for (int j = 0; j < 8; ++j) { float sn, cs; fast_sincos(pf * qinv[ks][j], sn, cs); const float x1 = xq[ks][j], x2 = xq[ks + 2][j];
                        xq[ks][j] = x1 * cs - x2 * sn; xq[ks + 2][j] = x1 * sn + x2 * cs; }
#pragma unroll
                for (int ks = 0; ks < 4; ++ks) { union { bf16x8_t v; unsigned u[4]; } p; p.u[0] = cvtpk(xq[ks][0], xq[ks][1]); p.u[1] = cvtpk(xq[ks][2], xq[ks][3]); p.u[2] = cvtpk(xq[ks][4], xq[ks][5]); p.u[3] = cvtpk(xq[ks][6], xq[ks][7]); qf[ks] = p.v; }
            }
            f32x16 sc[5];
#pragma unroll
            for (int kt = 0; kt < 5; ++kt) { f32x16 acc;
#pragma unroll
                for (int r = 0; r < 16; ++r) acc[r] = 0.f;
#pragma unroll
                for (int ks = 0; ks < 4; ++ks) { const bf16x8_t kf = *(const LAS bf16x8_t*)(Kl + (i0 + 32 * kt + ql) * KST + (ks * 16 + hh * 8) * 2);
                    acc = __builtin_amdgcn_mfma_f32_32x32x16_bf16(kf, qf[ks], acc, 0, 0, 0); }
                sc[kt] = acc; }
            float mloc = -3.0e38f;
#pragma unroll
            for (int kt = 0; kt < 5; ++kt) {
                if (kt == 0 || kt == 4 || n == 0) {
#pragma unroll
                    for (int r = 0; r < 16; ++r) { const int j = i0 + 32 * kt + (r & 3) + 8 * (r >> 2) + 4 * hh;
                        const bool valid = (j > iq) && (j <= iq + 128) && (n > 0 || j >= 128);
                        const float sv = valid ? sc[kt][r] * CS : -1.0e30f; sc[kt][r] = sv; mloc = fmaxf(mloc, sv); }
                } else {
#pragma unroll
                    for (int r = 0; r < 16; ++r) { const float sv = sc[kt][r] * CS; sc[kt][r] = sv; mloc = fmaxf(mloc, sv); }
                } }
            float mx = fmaxf(mloc, __shfl_xor(mloc, 32)); mx = fmaxf(mx, sinkl);
            float lsum = 0.f;
#pragma unroll
            for (int kt = 0; kt < 5; ++kt)
#pragma unroll
                for (int r = 0; r < 16; ++r) { const float p = __builtin_amdgcn_exp2f(sc[kt][r] - mx); sc[kt][r] = p; lsum += p; }
            lsum += __shfl_xor(lsum, 32); lsum += __builtin_amdgcn_exp2f(sinkl - mx);
            f32x16 o0, o1;
#pragma unroll
            for (int r = 0; r < 16; ++r) { o0[r] = 0.f; o1[r] = 0.f; }
#pragma unroll
            for (int kt = 0; kt < 5; ++kt)
#pragma unroll
                for (int s2 = 0; s2 < 2; ++s2) {
                    union { bf16x8_t v; unsigned u[4]; } pf;
#pragma unroll
                    for (int p = 0; p < 4; ++p) pf.u[p] = cvtpk(sc[kt][8 * s2 + 2 * p], sc[kt][8 * s2 + 2 * p + 1]);
                    const int jb = i0 + 32 * kt + 16 * s2 + 4 * hh;
                    union { bf16x8_t v; v2u u[2]; } v0, v1;
                    const LAS unsigned char* r0 = Vt + ql * VST + jb * 2; const LAS unsigned char* r1 = Vt + (32 + ql) * VST + jb * 2;
                    v0.u[0] = *(const LAS v2u*)(r0); v0.u[1] = *(const LAS v2u*)(r0 + 16);
                    v1.u[0] = *(const LAS v2u*)(r1); v1.u[1] = *(const LAS v2u*)(r1 + 16);
                    o0 = __builtin_amdgcn_mfma_f32_32x32x16_bf16(v0.v, pf.v, o0, 0, 0, 0);
                    o1 = __builtin_amdgcn_mfma_f32_32x32x16_bf16(v1.v, pf.v, o1, 0, 0, 0);
                }
            const float il = 1.f / lsum;
            bf16* op = mix + tq * DM + 512 + hq * 64 + 4 * hh;
#pragma unroll
            for (int rq = 0; rq < 4; ++rq) {
                v2u w0; w0.x = cvtpk(o0[4 * rq] * il, o0[4 * rq + 1] * il); w0.y = cvtpk(o0[4 * rq + 2] * il, o0[4 * rq + 3] * il);
                *(v2u*)(op + 8 * rq) = w0;
                v2u w1; w1.x = cvtpk(o1[4 * rq] * il, o1[4 * rq + 1] * il); w1.y = cvtpk(o1[4 * rq + 2] * il, o1[4 * rq + 3] * il);
                *(v2u*)(op + 32 + 8 * rq) = w1; }
        }
    }
}

__device__ __forceinline__ int frag_a_idx(int row, int col) { const int mt = row >> 4, l15 = row & 15, ks = col >> 5, x = col & 31, jh = x >> 4, g4 = (x >> 2) & 3, jl = x & 3; return ((mt * 2 + ks) * 64 + g4 * 16 + l15) * 8 + 4 * jh + jl; }
__device__ __forceinline__ int frag_c_idx(int row, int col) { const int w = col >> 4, l15 = col & 15, mt = row >> 4, y = row & 15, g4 = y >> 2, i = y & 3; return ((w * 64 + g4 * 16 + l15) * 4 + mt) * 4 + i; }
__device__ __forceinline__ void gdn_g1_naive(const Args& A, LAS float* L, int tid) {
    unsigned char* ws = A.ws;
    const bf16* proj = (const bf16*)(ws + WS_PROJ); const float* ab = (const float*)(ws + WS_AB);
    bf16* AP = (bf16*)(ws + WS_GAP); bf16* BP = (bf16*)(ws + WS_GBP); bf16* QP = (bf16*)(ws + WS_GQP); bf16* OP = (bf16*)(ws + WS_GOP); float* GL = (float*)(ws + WS_GGL);
    const float* convw = (const float*)A.in[I_CONVW];
    constexpr int LD = 65, AR = 64 * LD;
    LAS float* q = L; LAS float* k = q + AR; LAS float* v = k + AR; LAS float* Mm = v + AR; LAS float* At = Mm + AR; LAS float* w = At + AR;
    LAS float* Gc = w + AR; LAS float* beta = Gc + 64;
    const int i8 = tid >> 3, e0 = (tid & 7) * 8;
    for (int cid = blockIdx.x; cid < NB * 8 * 128; cid += gridDim.x) {
        const int n = cid & 127, bh = cid >> 7, b = bh >> 3, h = bh & 7;
        const float Ah = expf(((const float*)A.in[I_ALOG])[h]), dtb = ((const float*)A.in[I_DTB])[h];
        const int t0 = b * SEQ + n * 64;
        __syncthreads();
        for (int idx = tid; idx < 3 * 4096; idx += NTHR) {
            const int part = idx >> 12, rem = idx & 4095, i = rem >> 6, d = rem & 63, c = part * 512 + h * 64 + d;
            float y = 0.f;
#pragma unroll
            for (int j = 0; j < 4; ++j) { const int s = n * 64 + i - 3 + j; if (s >= 0) y += convw[j * 1536 + c] * bf2f(proj[(size_t)(b * SEQ + s) * NPROJ + c]); }
            y = y / (1.f + __expf(-y));
            (part == 0 ? q : (part == 1 ? k : v))[i * LD + d] = y;
        }
        if (tid < 64) { const float a = ab[(size_t)(t0 + tid) * 16 + h], bb = ab[(size_t)(t0 + tid) * 16 + 8 + h]; const float xx = a + dtb;
            const float sp = xx > 20.f ? xx : log1pf(expf(xx)); Gc[tid] = -Ah * sp; beta[tid] = 1.f / (1.f + __expf(-bb)); }
        __syncthreads();
        if (tid < 128) { LAS float* arr = tid < 64 ? q : k; const int i = tid & 63; float ss = 0.f;
            for (int d = 0; d < 64; ++d) ss += arr[i * LD + d] * arr[i * LD + d];
            const float r = (1.f / sqrtf(ss + EPS)) * (tid < 64 ? 0.125f : 1.f);
            for (int d = 0; d < 64; ++d) arr[i * LD + d] *= r; }
        if (tid == 128) { float run = 0.f; for (int i = 0; i < 64; ++i) { run += Gc[i]; Gc[i] = run; } }
        __syncthreads();
        {   const int i = i8;
            for (int jj = 0; jj < 8; ++jj) { const int j = e0 + jj; float dq = 0.f, dk = 0.f;
_Pragma("unroll 2") for (int d = 0; d < 64; ++d) { const float kj = k[j * LD + d]; dq += q[i * LD + d] * kj; dk += k[i * LD + d] * kj; }
                const float dec = (i >= j) ? __expf(Gc[i] - Gc[j]) : 0.f;
                At[i * LD + j] = dq * dec; Mm[i * LD + j] = (i > j) ? dk * beta[i] * dec : 0.f; }
        }
        __syncthreads();
        for (int idx = tid; idx < 4096; idx += NTHR) { const int i = idx >> 6, d = idx & 63; v[i * LD + d] *= beta[i]; w[i * LD + d] = k[i * LD + d] * beta[i] * __expf(Gc[i]); }
        __syncthreads();
        if (tid < 128) { LAS float* arr = tid < 64 ? v : w; const int c = tid & 63;
            _Pragma("unroll 1") for (int i = 1; i < 64; ++i) { float a = arr[i * LD + c]; _Pragma("unroll 4") for (int j = 0; j < i; ++j) a -= Mm[i * LD + j] * arr[j * LD + c]; arr[i * LD + c] = a; } }
        __syncthreads();
        const float gl = Gc[63];
        const size_t cb = (size_t)cid * 4096;
        {
            const int d = i8; float a[8], bq[8];
#pragma unroll
            for (int ee = 0; ee < 8; ++ee) { a[ee] = 0.f; bq[ee] = 0.f; }
_Pragma("unroll 2")
            for (int c = 0; c < 64; ++c) { const float kd = k[c * LD + d] * __expf(gl - Gc[c]);
#pragma unroll
                for (int ee = 0; ee < 8; ++ee) { a[ee] -= kd * w[c * LD + e0 + ee]; bq[ee] += kd * v[c * LD + e0 + ee]; } }
#pragma unroll
            for (int ee = 0; ee < 8; ++ee) { const int dp = e0 + ee; AP[cb + frag_a_idx(d, dp)] = (bf16)f2bf(a[ee]); BP[cb + frag_c_idx(d, dp)] = (bf16)f2bf(bq[ee]); }
        }
        {
            const int c = i8; float a[8], bq[8]; const float eg = __expf(Gc[c]);
#pragma unroll
            for (int ee = 0; ee < 8; ++ee) { a[ee] = eg * q[c * LD + e0 + ee]; bq[ee] = 0.f; }
_Pragma("unroll 2")
            for (int s2 = 0; s2 <= c; ++s2) { const float av = At[c * LD + s2];
#pragma unroll
                for (int ee = 0; ee < 8; ++ee) { a[ee] -= av * w[s2 * LD + e0 + ee]; bq[ee] += av * v[s2 * LD + e0 + ee]; } }
#pragma unroll
            for (int ee = 0; ee < 8; ++ee) { const int dp = e0 + ee; QP[cb + frag_a_idx(c, dp)] = (bf16)f2bf(a[ee]); OP[cb + frag_c_idx(c, dp)] = (bf16)f2bf(bq[ee]); }
        }
        if (tid == 0) GL[cid] = __expf(gl);
    }
}
__device__ __forceinline__ float wave_incl_scan_f(float v, int lane) {
#pragma unroll
    for (int o = 1; o < 64; o <<= 1) { const float t = __shfl_up(v, o); if (lane >= o) v += t; }
    return v;
}
__device__ __forceinline__ v2u pack4(f32x4 v) { v2u r; r.x = cvtpk(v.x, v.y); r.y = cvtpk(v.z, v.w); return r; }
__device__ __forceinline__ bf16x8_t mk8(v2u lo, v2u hi) { union { bf16x8_t v; unsigned u[4]; } x; x.u[0] = lo.x; x.u[1] = lo.y; x.u[2] = hi.x; x.u[3] = hi.y; return x.v; }
template <int SM, int STG = 7>
__device__ __forceinline__ void gdn_g1_mfma(const Args& A, LAS unsigned char* lds, int tid, int lane, int wave) {
    unsigned char* ws = A.ws;
    const bf16* proj = (const bf16*)(ws + WS_PROJ); const float* ab = (const float*)(ws + WS_AB);
    bf16* AP = (bf16*)(ws + WS_GAP); bf16* BP = (bf16*)(ws + WS_GBP); bf16* QP = (bf16*)(ws + WS_GQP); bf16* OP = (bf16*)(ws + WS_GOP); float* GL = (float*)(ws + WS_GGL);
    const float* convw = (const float*)A.in[I_CONVW];
    constexpr int KST = 144, RST = 68;
    LAS unsigned char* const Kr0 = lds;
    const int l15 = lane & 15, g4 = lane >> 4;
    const v2u zero2 = {0u, 0u};
    const int G = gridDim.x;
    const int ppart = wave >> 1, pt4 = 4 * ((wave & 1) * 8 + (lane >> 3)), pd0 = (lane & 7) * 8;
    v4u xr7[7];
#define G1_PREFETCH(IDX) do { if (wave < 6) { const int h_ = (IDX) & 7, bn_ = (IDX) >> 3, b_ = bn_ >> 7, n_ = bn_ & 127; \
        _Pragma("unroll") for (int r = 0; r < 7; ++r) { const int s_ = n_ * 64 + pt4 - 3 + r, sc_ = s_ < 0 ? 0 : s_; \
            const v4u r_ = *(const v4u*)(proj + (size_t)(b_ * SEQ + sc_) * NPROJ + ppart * 512 + h_ * 64 + pd0); const unsigned m_ = s_ < 0 ? 0u : 0xffffffffu; \
            xr7[r] = (v4u){r_.x & m_, r_.y & m_, r_.z & m_, r_.w & m_}; } } } while (0)
    int hcur = -1;
    constexpr int NC = NB * 8 * 128;
    if ((int)blockIdx.x < NC) G1_PREFETCH((int)blockIdx.x);
    for (int base = blockIdx.x; base < NC; base += 16 * G) {
    {
        LAS float* const GsT0 = (LAS float*)(Kr0 + 91648);
        __syncthreads();
        for (int q = wave; q < 16; q += 8) { const int idx2 = base + q * G;
            if (idx2 < NC) { const int h2 = idx2 & 7, bn2 = idx2 >> 3, b2 = bn2 >> 7, n2 = bn2 & 127;
                const size_t t2 = (size_t)(b2 * SEQ + n2 * 64 + lane) * 16;
                const float Ah = __expf(((const float*)A.in[I_ALOG])[h2]), dtb = ((const float*)A.in[I_DTB])[h2];
                const float xx = ab[t2 + h2] + dtb, bb2 = ab[t2 + 8 + h2];
                const float sp = xx > 20.f ? xx : log1pf(__expf(xx));
                const float Gv = wave_incl_scan_f(-Ah * sp, lane);
                GsT0[q * 64 + lane] = Gv; GsT0[1024 + q * 64 + lane] = 1.f / (1.f + __expf(-bb2));
                if ((SM & 16) && lane == 63) GL[(b2 * 8 + h2) * 128 + n2] = __expf(Gv); } }
    }
#pragma unroll 1
    for (int it = 0; it < 16; ++it) {
        const int idx = base + it * G; if (idx >= NC) break;
        const int h = idx & 7, bn = idx >> 3, b = bn >> 7, n = bn & 127, bh = b * 8 + h, cid = bh * 128 + n;
        const size_t cb = (size_t)cid * 4096;
        int oz = 0; asm volatile("" : "+v"(oz));
        LAS unsigned char* const Kr = Kr0 + oz; LAS unsigned char* const Qr = Kr + 9216; LAS unsigned char* const kdT = Kr + 18432; LAS unsigned char* const Mm = Kr + 27648; LAS unsigned char* const At = Kr + 36864;
        LAS float* const Rt = (LAS float*)(Kr + 46080);
        LAS float* const Md = (LAS float*)(Kr + 80896);
        LAS unsigned char* const Tl = Kr + 86016;
        LAS float* const Gs = (LAS float*)(Kr + 91648) + 64 * it; LAS float* const Bs = Gs + 1024;
        LAS float* const cwl = (LAS float*)(Kr + 88576);
        __syncthreads();
        if (h != hcur) { hcur = h; for (int q = tid; q < 768; q += NTHR) { const int part = q >> 8, j = (q >> 6) & 3, d = q & 63; cwl[q] = convw[j * 1536 + part * 512 + h * 64 + d]; } __syncthreads(); }
        const bool more = (idx + G < NC);
        if (wave < 6) {
            const int d0 = pd0, t4 = pt4, dg = d0 >> 3, swk = dg << 3, swr = (dg & 3) << 3;
            float y[4][8];
            {   float wv[4][8];
#pragma unroll
                for (int j = 0; j < 4; ++j) { const f32x4 w0 = *(const LAS f32x4*)(cwl + (ppart * 4 + j) * 64 + d0), w1 = *(const LAS f32x4*)(cwl + (ppart * 4 + j) * 64 + d0 + 4);
                    wv[j][0] = w0.x; wv[j][1] = w0.y; wv[j][2] = w0.z; wv[j][3] = w0.w; wv[j][4] = w1.x; wv[j][5] = w1.y; wv[j][6] = w1.z; wv[j][7] = w1.w; }
#define G1_XE(r, e) __builtin_bit_cast(float, ((e) & 1) ? (((e) >> 1) == 0 ? xr7[r].x : ((e) >> 1) == 1 ? xr7[r].y : ((e) >> 1) == 2 ? xr7[r].z : xr7[r].w) & 0xffff0000u \
                                                        : (((e) >> 1) == 0 ? xr7[r].x : ((e) >> 1) == 1 ? xr7[r].y : ((e) >> 1) == 2 ? xr7[r].z : xr7[r].w) << 16)
#pragma unroll
                for (int tk = 0; tk < 4; ++tk)
#pragma unroll
                    for (int e = 0; e < 8; ++e) { const float a_ = wv[0][e] * G1_XE(tk, e) + wv[1][e] * G1_XE(tk + 1, e) + wv[2][e] * G1_XE(tk + 2, e) + wv[3][e] * G1_XE(tk + 3, e);
                        y[tk][e] = a_ * __builtin_amdgcn_rcpf(1.f + __expf(-a_)); }
#undef G1_XE
            }
            if (more) G1_PREFETCH(idx + G);
            const f32x4 G4 = *(const LAS f32x4*)(Gs + t4), B4 = *(const LAS f32x4*)(Bs + t4); const float gl = Gs[63];
            if (ppart < 2) {
                float rn[4];
#pragma unroll
                for (int tk = 0; tk < 4; ++tk) { float ss = 0.f;
#pragma unroll
                    for (int e = 0; e < 8; ++e) ss += y[tk][e] * y[tk][e];
                    ss += __shfl_xor(ss, 1); ss += __shfl_xor(ss, 2); ss += __shfl_xor(ss, 4);
                    rn[tk] = (1.f / sqrtf(ss + EPS)) * (ppart == 0 ? 0.125f : 1.f); }
#pragma unroll
                for (int tk = 0; tk < 4; ++tk) {
#pragma unroll
                    for (int e = 0; e < 8; ++e) y[tk][e] *= rn[tk];
                    v4u pk; pk.x = cvtpk(y[tk][0], y[tk][1]); pk.y = cvtpk(y[tk][2], y[tk][3]); pk.z = cvtpk(y[tk][4], y[tk][5]); pk.w = cvtpk(y[tk][6], y[tk][7]);
                    *(LAS v4u*)((ppart == 0 ? Qr : Kr) + (t4 + tk) * KST + d0 * 2) = pk; }
                if (ppart == 1) {
                    const float ek0 = __expf(gl - G4.x), ek1 = __expf(gl - G4.y), ek2 = __expf(gl - G4.z), ek3 = __expf(gl - G4.w);
                    const float bg0 = B4.x * __expf(G4.x), bg1 = B4.y * __expf(G4.y), bg2 = B4.z * __expf(G4.z), bg3 = B4.w * __expf(G4.w);
#pragma unroll
                    for (int e = 0; e < 8; ++e) {
                        v2u kd; kd.x = cvtpk(y[0][e] * ek0, y[1][e] * ek1); kd.y = cvtpk(y[2][e] * ek2, y[3][e] * ek3);
                        *(LAS v2u*)(kdT + (d0 + e) * KST + (t4 ^ swk) * 2) = kd;
                        *(LAS f32x4*)(Rt + (d0 + e) * RST + (t4 ^ swr)) = (f32x4){y[0][e] * bg0, y[1][e] * bg1, y[2][e] * bg2, y[3][e] * bg3}; }
                }
            } else {
#pragma unroll
                for (int e = 0; e < 8; ++e) *(LAS f32x4*)(Rt + (64 + d0 + e) * RST + (t4 ^ swr)) = (f32x4){y[0][e] * B4.x, y[1][e] * B4.y, y[2][e] * B4.z, y[3][e] * B4.w};
            }
        }
        __syncthreads();
#define G1_TILE(which, ct, st) do { const LAS unsigned char* Xb_ = (which) ? Kr : Qr; const int c_ = 16 * (ct) + l15; const float Gc_ = Gs[c_], bc_ = Bs[c_]; \
            f32x4 acc_ = {0.f, 0.f, 0.f, 0.f}; \
            _Pragma("unroll") for (int ks = 0; ks < 2; ++ks) { const bf16x8_t bf_ = *(const LAS bf16x8_t*)(Xb_ + c_ * KST + (32 * ks + 8 * g4) * 2); \
                const bf16x8_t af_ = *(const LAS bf16x8_t*)(Kr + (16 * (st) + l15) * KST + (32 * ks + 8 * g4) * 2); acc_ = __builtin_amdgcn_mfma_f32_16x16x32_bf16(af_, bf_, acc_, 0, 0, 0); } \
            f32x4 vals_; \
            _Pragma("unroll") for (int r = 0; r < 4; ++r) { const int s2_ = 16 * (st) + 4 * g4 + r; const float dec_ = __expf(fminf(Gc_ - Gs[s2_], 0.f)); \
                vals_[r] = (which) ? ((s2_ < c_) ? -acc_[r] * bc_ * dec_ : 0.f) : ((s2_ <= c_) ? acc_[r] * dec_ : 0.f); } \
            *(LAS v2u*)(((which) ? Mm : At) + c_ * KST + (16 * (st) + 4 * g4) * 2) = pack4(vals_); \
            if ((which) && (st) == (ct)) *(LAS f32x4*)(Md + ((ct) * 16 + l15) * 20 + 4 * g4) = -vals_; } while (0)
        if constexpr (STG & 1) {
            const int ct = wave & 3, st0 = 2 * (wave >> 2);
            G1_TILE(1, ct, st0); G1_TILE(1, ct, st0 + 1);
        }
        __syncthreads();
        if constexpr (STG & 1) {
            if (wave != 0) { for (int tix = wave - 1; tix < 16; tix += 7) { const int ct = tix & 3, st = tix >> 2; G1_TILE(0, ct, st); } }
        }
        if ((STG & 2) && wave == 0) {
            float t[16];
#pragma unroll
            for (int r = 0; r < 16; ++r) { float acc = (r == l15) ? 1.f : 0.f;
#pragma unroll
                for (int s4 = 0; s4 < r; s4 += 4) { const f32x4 m = *(const LAS f32x4*)(Md + (g4 * 16 + r) * 20 + s4);
                    acc -= m.x * t[s4]; if (s4 + 1 < r) acc -= m.y * t[s4 + 1]; if (s4 + 2 < r) acc -= m.z * t[s4 + 2]; if (s4 + 3 < r) acc -= m.w * t[s4 + 3]; }
                t[r] = acc; }
#pragma unroll
            for (int r = 0; r < 16; ++r) *(LAS unsigned short*)(Tl + ((g4 * 16 + r) * 16 + l15) * 2) = (unsigned short)f2bf(t[r]);
        }
        __syncthreads();
        if constexpr (STG & 4) {
        f32x4 wt[4];
        {   const int colw = 16 * wave + l15;
#pragma unroll
            for (int i = 0; i < 4; ++i) {
                f32x4 acc = *(const LAS f32x4*)(Rt + colw * RST + ((16 * i + 4 * g4) ^ (((colw >> 3) & 3) << 3)));
                const LAS unsigned char* mrow = Mm + (16 * i + l15) * KST + (4 * g4) * 2;
                if (i >= 1) { const v2u alo = *(const LAS v2u*)(mrow), ahi = (i >= 2) ? *(const LAS v2u*)(mrow + 32) : zero2;
                    acc = __builtin_amdgcn_mfma_f32_16x16x32_bf16(mk8(alo, ahi), mk8(pack4(wt[0]), (i >= 2) ? pack4(wt[1]) : zero2), acc, 0, 0, 0); }
                if (i == 3) { const v2u alo = *(const LAS v2u*)(mrow + 64);
                    acc = __builtin_amdgcn_mfma_f32_16x16x32_bf16(mk8(alo, zero2), mk8(pack4(wt[2]), zero2), acc, 0, 0, 0); }
                const v2u tlo = *(const LAS v2u*)(Tl + ((i * 16 + l15) * 16 + 4 * g4) * 2);
                wt[i] = __builtin_amdgcn_mfma_f32_16x16x32_bf16(mk8(tlo, zero2), mk8(pack4(acc), zero2), (f32x4){0.f, 0.f, 0.f, 0.f}, 0, 0, 0);
            }
        }
        if (wave < 4) {
            bf16x8_t wn[2];
#pragma unroll
            for (int ks = 0; ks < 2; ++ks) { v2u lo = pack4(wt[2 * ks]), hi = pack4(wt[2 * ks + 1]); lo.x ^= 0x80008000u; lo.y ^= 0x80008000u; hi.x ^= 0x80008000u; hi.y ^= 0x80008000u; wn[ks] = mk8(lo, hi); }
#pragma unroll
            for (int nt = 0; nt < 4; ++nt) { const int x = 16 * nt + l15;
                f32x4 ca = {0.f, 0.f, 0.f, 0.f};
                const v2u qraw = *(const LAS v2u*)(Qr + x * KST + (16 * wave + 4 * g4) * 2); const float eg = __expf(Gs[x]);
                f32x4 cq; cq.x = eg * __builtin_bit_cast(float, qraw.x << 16); cq.y = eg * __builtin_bit_cast(float, qraw.x & 0xffff0000u); cq.z = eg * __builtin_bit_cast(float, qraw.y << 16); cq.w = eg * __builtin_bit_cast(float, qraw.y & 0xffff0000u);
#pragma unroll
                for (int ks = 0; ks < 2; ++ks) { const int xs = (x >> 3) << 3; const LAS unsigned char* kp0 = kdT + x * KST + ((32 * ks + 4 * g4) ^ xs) * 2; const LAS unsigned char* kp1 = kdT + x * KST + ((32 * ks + 16 + 4 * g4) ^ xs) * 2; const LAS unsigned char* ap = At + x * KST + (32 * ks + 4 * g4) * 2;
                    ca = __builtin_amdgcn_mfma_f32_16x16x32_bf16(wn[ks], mk8(*(const LAS v2u*)(kp0), *(const LAS v2u*)(kp1)), ca, 0, 0, 0);
                    cq = __builtin_amdgcn_mfma_f32_16x16x32_bf16(wn[ks], mk8(*(const LAS v2u*)(ap), *(const LAS v2u*)(ap + 32)), cq, 0, 0, 0); }
                const size_t off = cb + (size_t)((nt * 2 + (wave >> 1)) * 64 + lane) * 8 + 4 * (wave & 1);
                if (SM & 1) *(v2u*)(AP + off) = pack4(ca); if (SM & 2) *(v2u*)(QP + off) = pack4(cq);
            }
        } else {
            bf16x8_t ub[2];
#pragma unroll
            for (int ks = 0; ks < 2; ++ks) ub[ks] = mk8(pack4(wt[2 * ks]), pack4(wt[2 * ks + 1]));
            unsigned bo[8], oo[8];
#pragma unroll
            for (int mt = 0; mt < 4; ++mt) { const int x = 16 * mt + l15;
                f32x4 cbv = {0.f, 0.f, 0.f, 0.f}, co = {0.f, 0.f, 0.f, 0.f};
#pragma unroll
                for (int ks = 0; ks < 2; ++ks) { const int xs = (x >> 3) << 3; const LAS unsigned char* kp0 = kdT + x * KST + ((32 * ks + 4 * g4) ^ xs) * 2; const LAS unsigned char* kp1 = kdT + x * KST + ((32 * ks + 16 + 4 * g4) ^ xs) * 2; const LAS unsigned char* ap = At + x * KST + (32 * ks + 4 * g4) * 2;
                    cbv = __builtin_amdgcn_mfma_f32_16x16x32_bf16(mk8(*(const LAS v2u*)(kp0), *(const LAS v2u*)(kp1)), ub[ks], cbv, 0, 0, 0);
                    co = __builtin_amdgcn_mfma_f32_16x16x32_bf16(mk8(*(const LAS v2u*)(ap), *(const LAS v2u*)(ap + 32)), ub[ks], co, 0, 0, 0); }
                const v2u pb = pack4(cbv), po = pack4(co); bo[2 * mt] = pb.x; bo[2 * mt + 1] = pb.y; oo[2 * mt] = po.x; oo[2 * mt + 1] = po.y; }
            const size_t off = cb + (size_t)((wave - 4) * 64 + lane) * 16;
            if (SM & 4) { *(v4u*)(BP + off) = (v4u){bo[0], bo[1], bo[2], bo[3]}; *(v4u*)(BP + off + 8) = (v4u){bo[4], bo[5], bo[6], bo[7]}; }
            if (SM & 8) { *(v4u*)(OP + off) = (v4u){oo[0], oo[1], oo[2], oo[3]}; *(v4u*)(OP + off + 8) = (v4u){oo[4], oo[5], oo[6], oo[7]}; }
        }
        }
    }
    }
#undef G1_TILE
#undef G1_PREFETCH
}

__device__ __forceinline__ f32x4 g2_unpack(const v4u (&p)[2], int mt) {
    const unsigned d0 = mt == 0 ? p[0].x : mt == 1 ? p[0].z : mt == 2 ? p[1].x : p[1].z, d1 = mt == 0 ? p[0].y : mt == 1 ? p[0].w : mt == 2 ? p[1].y : p[1].w;
    f32x4 r; r.x = __builtin_bit_cast(float, d0 << 16); r.y = __builtin_bit_cast(float, d0 & 0xffff0000u); r.z = __builtin_bit_cast(float, d1 << 16); r.w = __builtin_bit_cast(float, d1 & 0xffff0000u); return r;
}
template <int VAR = 0>
__device__ __forceinline__ void gdn_scan(const Args& A, int bh, LAS unsigned char* lds, int tid, int lane, int wave) {
    unsigned char* ws = A.ws;
    const char* AP = (const char*)(ws + WS_GAP); const char* BP = (const char*)(ws + WS_GBP); const float* GL = (const float*)(ws + WS_GGL); bf16* SF = (bf16*)(ws + WS_GSF);
    constexpr int SLOT = 16384, NSL = 8, EGL_OFF = NSL * SLOT;
    LAS float* eglt = (LAS float*)(lds + EGL_OFF);
    __syncthreads();
    { int tl = tid; asm volatile("" : "+v"(tl));
      if (tl < 128) eglt[tl] = GL[bh * 128 + tl]; }
    if (wave < 4) {
        f32x4 sC[4]; bf16x8_t sB[2];
#pragma unroll
        for (int mt = 0; mt < 4; ++mt) sC[mt] = (f32x4){0.f, 0.f, 0.f, 0.f};
#pragma unroll
        for (int ks = 0; ks < 2; ++ks)
#pragma unroll
            for (int j = 0; j < 8; ++j) sB[ks][j] = 0;
        asm volatile("s_waitcnt vmcnt(0) lgkmcnt(0)" ::: "memory");
        __builtin_amdgcn_s_barrier();
        struct SSet { bf16x8_t fa[4][2]; v4u fb[2]; float egl; };
#define SC_LOAD(S, n) do { const int n_ = (n) < SEQ / 64 ? (n) : SEQ / 64 - 1; const LAS unsigned char* slot_ = lds + (n_ & (NSL - 1)) * SLOT; \
            _Pragma("unroll") for (int mt = 0; mt < 4; ++mt) _Pragma("unroll") for (int ks = 0; ks < 2; ++ks) S.fa[mt][ks] = *(const LAS bf16x8_t*)(slot_ + ((mt * 2 + ks) * 64 + lane) * 16); \
            S.fb[0] = *(const LAS v4u*)(slot_ + 8192 + (wave * 64 + lane) * 32); S.fb[1] = *(const LAS v4u*)(slot_ + 8192 + (wave * 64 + lane) * 32 + 16); S.egl = eglt[n_]; } while (0)
#define SC_STEP(S, n) do { bf16* sf = SF + (size_t)(bh * 128 + (n)) * 4096 + (size_t)((wave * 2) * 64 + lane) * 8; \
            *(bf16x8_t*)(sf) = sB[0]; *(bf16x8_t*)(sf + 512) = sB[1]; \
            f32x4 sacc[4]; \
            _Pragma("unroll") for (int mt = 0; mt < 4; ++mt) sacc[mt] = sC[mt] * S.egl + g2_unpack(S.fb, mt); \
            _Pragma("unroll") for (int mt = 0; mt < 4; ++mt) _Pragma("unroll") for (int ks = 0; ks < 2; ++ks) sacc[mt] = __builtin_amdgcn_mfma_f32_16x16x32_bf16(S.fa[mt][ks], sB[ks], sacc[mt], 0, 0, 0); \
            _Pragma("unroll") for (int mt = 0; mt < 4; ++mt) sC[mt] = sacc[mt]; \
            _Pragma("unroll") for (int ks = 0; ks < 2; ++ks) { union { bf16x8_t v; unsigned u[4]; } pk_; \
                pk_.u[0] = cvtpk(sC[2 * ks].x, sC[2 * ks].y); pk_.u[1] = cvtpk(sC[2 * ks].z, sC[2 * ks].w); pk_.u[2] = cvtpk(sC[2 * ks + 1].x, sC[2 * ks + 1].y); pk_.u[3] = cvtpk(sC[2 * ks + 1].z, sC[2 * ks + 1].w); sB[ks] = pk_.v; } \
            asm volatile("s_waitcnt lgkmcnt(0)" ::: "memory"); \
            __builtin_amdgcn_s_barrier(); } while (0)
        SSet s0;
#pragma unroll 1
        for (int n = 0; n < SEQ / 64; ++n) {
            if (VAR == 2) { asm volatile("s_waitcnt lgkmcnt(0)" ::: "memory"); __builtin_amdgcn_s_barrier(); continue; }
            SC_LOAD(s0, n);
            SC_STEP(s0, n);
        }
#undef SC_LOAD
#undef SC_STEP
    } else {
        const int f = wave - 4;
        const unsigned lin = (unsigned)(2 * f) * 1024u + (unsigned)lane * 16u;
#define G2_DMA(nn) do { const int n_ = (nn) < SEQ / 64 ? (nn) : SEQ / 64 - 1; const size_t cb_ = (size_t)(bh * 128 + n_) * 8192; LAS unsigned char* d_ = lds + ((nn) & (NSL - 1)) * SLOT + (2 * f) * 1024; \
        __builtin_amdgcn_global_load_lds((const unsigned*)(AP + cb_ + lin), (LAS unsigned*)(d_), 16, 0, 0); __builtin_amdgcn_global_load_lds((const unsigned*)(AP + cb_ + lin + 1024), (LAS unsigned*)(d_ + 1024), 16, 0, 0); \
        __builtin_amdgcn_global_load_lds((const unsigned*)(BP + cb_ + lin), (LAS unsigned*)(d_ + 8192), 16, 0, 0); __builtin_amdgcn_global_load_lds((const unsigned*)(BP + cb_ + lin + 1024), (LAS unsigned*)(d_ + 8192 + 1024), 16, 0, 0); } while (0)
        asm volatile("s_waitcnt vmcnt(0) lgkmcnt(0)" ::: "memory");
        G2_DMA(0); G2_DMA(1); G2_DMA(2); G2_DMA(3); G2_DMA(4); G2_DMA(5); G2_DMA(6);
        asm volatile("s_waitcnt vmcnt(24)" ::: "memory");
        __builtin_amdgcn_s_barrier();
#pragma unroll 1
        for (int n = 0; n < SEQ / 64; ++n) {
            if (VAR != 1) G2_DMA(n + 7);
            asm volatile("s_waitcnt vmcnt(24)" ::: "memory");
            __builtin_amdgcn_s_barrier();
        }
#undef G2_DMA
        asm volatile("s_waitcnt vmcnt(0)" ::: "memory");
    }
    __syncthreads();
}
__device__ __forceinline__ void gdn_out(const Args& A, LAS unsigned char* lds, int lane, int wave) {
    unsigned char* ws = A.ws;
    const bf16* proj = (const bf16*)(ws + WS_PROJ); bf16* mix = (bf16*)(ws + WS_MIX);
    const bf16* QP = (const bf16*)(ws + WS_GQP); const bf16* OP = (const bf16*)(ws + WS_GOP); const bf16* SF = (const bf16*)(ws + WS_GSF);
    const float* onorm = (const float*)A.in[I_GNORM];
    const int mt = wave & 3, l15 = lane & 15, g4 = lane >> 4, rr = lane >> 2, q4 = lane & 3;
    constexpr int OST = 68;
    LAS float* ot = (LAS float*)(lds + wave * 4608);
    float gain[16];
#pragma unroll
    for (int k = 0; k < 16; ++k) gain[k] = onorm[16 * q4 + k];
    struct OSet { bf16x8_t qa[2], sb[4][2]; v2u oi[4]; v4u z0, z1; };
#define GO_LOAD(S, CID) do { const int n_ = (CID) & 127, bh_ = (CID) >> 7, b_ = bh_ >> 3, h_ = bh_ & 7; const size_t cb_ = (size_t)(CID) * 4096; \
        const size_t t_ = (size_t)b_ * SEQ + n_ * 64 + 16 * mt + rr; \
        S.z0 = *(const v4u*)(proj + t_ * NPROJ + PC_Z + h_ * 64 + 16 * q4); S.z1 = *(const v4u*)(proj + t_ * NPROJ + PC_Z + h_ * 64 + 16 * q4 + 8); \
        _Pragma("unroll") for (int ks = 0; ks < 2; ++ks) S.qa[ks] = *(const bf16x8_t*)(QP + cb_ + ((mt * 2 + ks) * 64 + lane) * 8); \
        _Pragma("unroll") for (int nt = 0; nt < 4; ++nt) { _Pragma("unroll") for (int ks = 0; ks < 2; ++ks) S.sb[nt][ks] = *(const bf16x8_t*)(SF + cb_ + ((nt * 2 + ks) * 64 + lane) * 8); \
            S.oi[nt] = *(const v2u*)(OP + cb_ + ((nt * 64 + lane) * 4 + mt) * 4); } } while (0)
#define GO_STEP(S, CID) do { const int n_ = (CID) & 127, bh_ = (CID) >> 7, b_ = bh_ >> 3, h_ = bh_ & 7; const size_t t_ = (size_t)b_ * SEQ + n_ * 64 + 16 * mt + rr; \
        _Pragma("unroll") for (int nt = 0; nt < 4; ++nt) { \
            f32x4 acc; acc.x = __builtin_bit_cast(float, S.oi[nt].x << 16); acc.y = __builtin_bit_cast(float, S.oi[nt].x & 0xffff0000u); acc.z = __builtin_bit_cast(float, S.oi[nt].y << 16); acc.w = __builtin_bit_cast(float, S.oi[nt].y & 0xffff0000u); \
            _Pragma("unroll") for (int ks = 0; ks < 2; ++ks) acc = __builtin_amdgcn_mfma_f32_16x16x32_bf16(S.qa[ks], S.sb[nt][ks], acc, 0, 0, 0); \
            _Pragma("unroll") for (int i = 0; i < 4; ++i) ot[(4 * g4 + i) * OST + 16 * nt + l15] = acc[i]; } \
        LDS_WAIT(); asm volatile("" ::: "memory"); \
        float o[16]; float ss = 0.f; \
        _Pragma("unroll") for (int k = 0; k < 4; ++k) { const f32x4 v = *(const LAS f32x4*)(ot + rr * OST + 16 * q4 + 4 * k); o[4 * k] = v.x; o[4 * k + 1] = v.y; o[4 * k + 2] = v.z; o[4 * k + 3] = v.w; } \
        _Pragma("unroll") for (int k = 0; k < 16; ++k) ss += o[k] * o[k]; \
        ss += __shfl_xor(ss, 1); ss += __shfl_xor(ss, 2); \
        const float r = 1.f / sqrtf(ss * (1.f / 64.f) + EPS); \
        const unsigned zu[8] = {S.z0.x, S.z0.y, S.z0.z, S.z0.w, S.z1.x, S.z1.y, S.z1.z, S.z1.w}; \
        unsigned ou[8]; \
        _Pragma("unroll") for (int k = 0; k < 8; ++k) { const float za = __builtin_bit_cast(float, zu[k] << 16), zb = __builtin_bit_cast(float, zu[k] & 0xffff0000u); \
            ou[k] = cvtpk(o[2 * k] * r * gain[2 * k] * siluf(za), o[2 * k + 1] * r * gain[2 * k + 1] * siluf(zb)); } \
        bf16* op = mix + t_ * DM + h_ * 64 + 16 * q4; \
        *(v4u*)(op) = (v4u){ou[0], ou[1], ou[2], ou[3]}; *(v4u*)(op + 8) = (v4u){ou[4], ou[5], ou[6], ou[7]}; \
        LDS_WAIT(); asm volatile("" ::: "memory"); } while (0)
    const int NC = NB * 8 * 128, st = gridDim.x * 2;
    int cid = blockIdx.x * 2 + (wave >> 2);
    OSet s0, s1, s2;
    if (cid < NC) GO_LOAD(s0, cid);
    if (cid + st < NC) GO_LOAD(s1, cid + st);
#pragma unroll 1
    for (; cid < NC; cid += 3 * st) {
        if (cid + 2 * st < NC) GO_LOAD(s2, cid + 2 * st);
        GO_STEP(s0, cid);
        if (cid + st < NC) { if (cid + 3 * st < NC) GO_LOAD(s0, cid + 3 * st); GO_STEP(s1, cid + st); }
        if (cid + 2 * st < NC) { if (cid + 4 * st < NC) GO_LOAD(s1, cid + 4 * st); GO_STEP(s2, cid + 2 * st); }
    }
#undef GO_LOAD
#undef GO_STEP
}

template <bool DRY, int VAR = 0>
__device__ __forceinline__ void norm_route_mfma(const Args& A, const float* X, const float* ssqp, const float* gain, const float* shift, const float* scale, bf16* H, LAS unsigned char* lds, int tid, int lane, int wave) {
    unsigned char* ws = A.ws;
    const int G = gridDim.x;
    const int l15 = lane & 15, g4 = lane >> 4;
    LAS unsigned char* wfl = lds;
    LAS float* mfl = (LAS float*)(lds + 98304); LAS float* afl = mfl + 1024;
    LAS float* lgs = (LAS float*)(lds + 98304 + 8192 + wave * 3328);
    const float* bg = (const float*)A.in[I_BGRP]; const float* br = (const float*)A.in[I_BRT];
#define P7_LOADW(half) do { const v4u* src_ = (const v4u*)(ws + WS_WRT); \
        for (int q = tid; q < 3072; q += NTHR) { const int nt_ = q >> 10, r_ = q & 1023; const int g_ = (nt_ * 32 + 16 * (half)) * 64 + r_; \
            *(LAS v4u*)(wfl + q * 16) = src_[g_]; *(LAS v4u*)(wfl + 49152 + q * 16) = src_[6144 + g_]; } } while (0)
    int bcur = -1;
    for (int rb = blockIdx.x * 128; rb < TT; rb += G * 128) {
        const int b = rb / SEQ, r0 = rb + wave * 16, row = r0 + l15;
        if (b != bcur) { bcur = b; __syncthreads();
            for (int q = tid; q < 1024; q += NTHR) { mfl[q] = gain[q] * (scale[b * 6144 + q] + 1.0f); afl[q] = shift[b * 6144 + q]; }
            __syncthreads(); }
        const float* xr = X + (size_t)row * DM + 8 * g4;
        float ss;
        {   const f32x4 p4 = *(const f32x4*)(ssqp + (size_t)row * 16 + 4 * g4); ss = (p4.x + p4.y) + (p4.z + p4.w); }
        ss += __shfl_xor(ss, 16); ss += __shfl_xor(ss, 32);
        const float rstd = 1.f / sqrtf(ss * (1.f / DM) + EPS);
        f32x4 acc[3];
#pragma unroll
        for (int nt = 0; nt < 3; ++nt) acc[nt] = (f32x4){0.f, 0.f, 0.f, 0.f};
        bf16* hrow = H + (size_t)row * DM + 8 * g4;
#pragma unroll 1
        for (int half = 0; half < 2; ++half) {
        __syncthreads(); P7_LOADW(half); __syncthreads();
#pragma unroll 8
        for (int ks = 16 * half; ks < 16 * half + 16; ++ks) {
            float hv[8];
            {   const f32x4 a = *(const f32x4*)(xr + 32 * ks), c = *(const f32x4*)(xr + 32 * ks + 4);
                const f32x4 m0 = *(const LAS f32x4*)(mfl + 32 * ks + 8 * g4), m1 = *(const LAS f32x4*)(mfl + 32 * ks + 8 * g4 + 4), h0 = *(const LAS f32x4*)(afl + 32 * ks + 8 * g4), h1 = *(const LAS f32x4*)(afl + 32 * ks + 8 * g4 + 4);
                const f32x4 v0 = a * rstd * m0 + h0, v1 = c * rstd * m1 + h1;
                hv[0] = v0.x; hv[1] = v0.y; hv[2] = v0.z; hv[3] = v0.w; hv[4] = v1.x; hv[5] = v1.y; hv[6] = v1.z; hv[7] = v1.w; }
            unsigned hu[4], lu[4];
#pragma unroll
            for (int p = 0; p < 4; ++p) { hu[p] = cvtpk(hv[2 * p], hv[2 * p + 1]);
                const float ra = hv[2 * p] - __builtin_bit_cast(float, hu[p] << 16), rb2 = hv[2 * p + 1] - __builtin_bit_cast(float, hu[p] & 0xffff0000u); lu[p] = cvtpk(ra, rb2); }
            *(v4u*)(hrow + 32 * ks) = (v4u){hu[0], hu[1], hu[2], hu[3]};
            union { bf16x8_t v; unsigned u[4]; } ah, al; ah.u[0] = hu[0]; ah.u[1] = hu[1]; ah.u[2] = hu[2]; ah.u[3] = hu[3]; al.u[0] = lu[0]; al.u[1] = lu[1]; al.u[2] = lu[2]; al.u[3] = lu[3];
#pragma unroll
            for (int nt = 0; nt < 3; ++nt) { const int fo = ((nt * 16 + (ks & 15)) * 64 + lane) * 16;
                const bf16x8_t bh = *(const LAS bf16x8_t*)(wfl + fo), bl = *(const LAS bf16x8_t*)(wfl + 49152 + fo);
                acc[nt] = __builtin_amdgcn_mfma_f32_16x16x32_bf16(ah.v, bh, acc[nt], 0, 0, 0);
                acc[nt] = __builtin_amdgcn_mfma_f32_16x16x32_bf16(ah.v, bl, acc[nt], 0, 0, 0);
                acc[nt] = __builtin_amdgcn_mfma_f32_16x16x32_bf16(al.v, bh, acc[nt], 0, 0, 0); }
        }
        }
#pragma unroll
        for (int nt = 0; nt < 3; ++nt)
#pragma unroll
            for (int r = 0; r < 4; ++r) lgs[(4 * g4 + r) * 52 + 16 * nt + l15] = acc[nt][r];
        LDS_WAIT(); asm volatile("" ::: "memory");
        if (lane < 16) {
            float lg[36];
#pragma unroll
            for (int q = 0; q < 9; ++q) { const f32x4 v = *(const LAS f32x4*)(lgs + lane * 52 + 4 * q); lg[4 * q] = v.x; lg[4 * q + 1] = v.y; lg[4 * q + 2] = v.z; lg[4 * q + 3] = v.w; }
#pragma unroll
            for (int o = 0; o < 4; ++o) lg[o] += bg[o];
#pragma unroll
            for (int o = 0; o < 32; ++o) lg[4 + o] += br[o];
            int gi = 0; float gm = lg[0];
#pragma unroll
            for (int o = 1; o < 4; ++o) if (lg[o] > gm) { gm = lg[o]; gi = o; }
            float gs = 0.f;
#pragma unroll
            for (int o = 0; o < 4; ++o) gs += __expf(lg[o] - gm);
            const float pg = 1.f / gs;
            float le[8];
#pragma unroll
            for (int j = 0; j < 8; ++j) { le[j] = lg[4 + j];
#pragma unroll
                for (int g = 1; g < 4; ++g) le[j] = (gi == g) ? lg[4 + g * 8 + j] : le[j]; }
            int j1 = 0; float m1 = le[0];
#pragma unroll
            for (int j = 1; j < 8; ++j) if (le[j] > m1) { m1 = le[j]; j1 = j; }
            int j2 = -1; float m2 = -3.0e38f;
#pragma unroll
            for (int j = 0; j < 8; ++j) if (j != j1 && le[j] > m2) { m2 = le[j]; j2 = j; }
            const float ex = __expf(m2 - m1), w1 = pg / (1.f + ex), w2 = pg * ex / (1.f + ex);
            const int e1 = gi * 8 + j1, e2 = gi * 8 + j2, rw = r0 + lane;
            unsigned* ctl = (unsigned*)(ws + WS_CTL);
            int2* erec = (int2*)(ws + WS_EREC); int* clist = (int*)(ws + WS_CLIST);
            if constexpr (DRY) { ((int2*)(ws + WS_PROJ + 168 * MiB))[rw] = make_int2(e1 * 64 + e2, __builtin_bit_cast(int, w1 + w2)); } else {
            const unsigned p1 = atomicAdd(ctl + CW_ECNT + e1, 1u); erec[(size_t)e1 * TT + p1] = make_int2(rw * 2 + (e1 > e2 ? 1 : 0), __builtin_bit_cast(int, w1));
            const unsigned p2 = atomicAdd(ctl + CW_ECNT + e2, 1u); erec[(size_t)e2 * TT + p2] = make_int2(rw * 2 + (e2 > e1 ? 1 : 0), __builtin_bit_cast(int, w2));
            const int a = j1 < j2 ? j1 : j2, bb = j1 < j2 ? j2 : j1;
            const int cls = gi * 28 + (a * 7 - (a * (a - 1)) / 2 + (bb - a - 1));
            const unsigned pc = atomicAdd(ctl + CW_CCNT + cls, 1u); clist[(size_t)cls * TT + pc] = rw; }
        }
        LDS_WAIT(); asm volatile("" ::: "memory");
    }
#undef P7_LOADW
}

__device__ __forceinline__ int wave_incl_scan(int v, int lane) {
#pragma unroll
    for (int o = 1; o < 64; o <<= 1) { const int t = __shfl_up(v, o); if (lane >= o) v += t; }
    return v;
}
template <int NOPART = 0>
struct SchedET {
    int G, c, cntv, preF, erank, totF, totP; const int2* rec; const char* W;
    __device__ __forceinline__ void init(const unsigned* cnt, const int2* rec_, const char* W_, int G_, int c_, int lane) {
        G = G_; c = c_; rec = rec_; W = W_;
        cntv = lane < NE ? (int)cnt[lane] : 0;
        const int rem = cntv & 255;
        const int incF = wave_incl_scan(cntv >> 8, lane), incP = wave_incl_scan(rem ? 1 : 0, lane);
        totF = __builtin_amdgcn_readlane(incF, 63); totP = NOPART ? 0 : __builtin_amdgcn_readlane(incP, 63);
        preF = lane < NE ? incF : 0x7fffffff;
        int rank = 0;
        for (int l = 0; l < NE; ++l) { const int r2 = __builtin_amdgcn_readlane(rem, l); rank += (r2 > rem || (r2 == rem && l < lane)) ? 1 : 0; }
        erank = __builtin_amdgcn_ds_permute((lane < NE ? rank : lane) << 2, lane);
    }
    __device__ __forceinline__ bool next(int i, pg8::UnitG& u) const {
        const int L = i * G + c; if (L >= 2 * (totF + totP)) return false;
        if (L < 2 * totF) { const int ft = L >> 1;
            const int e = __builtin_amdgcn_readfirstlane(__popcll(__ballot(preF <= ft)));
            const int base = e ? __builtin_amdgcn_readlane(preF, e - 1) : 0;
            u.id = e; u.tile = ft - base; u.pn = L & 1; u.nrows = 256;
        } else { const int p = (L - 2 * totF) >> 1;
            const int e = __builtin_amdgcn_readlane(erank, p);
            const int cnt = __builtin_amdgcn_readlane(cntv, e);
            u.id = e; u.tile = cnt >> 8; u.pn = L & 1; u.nrows = cnt & 255; }
        return true;
    }
    __device__ __forceinline__ int tok(const pg8::UnitG& u, int r) const { return r < u.nrows ? (rec[(size_t)u.id * TT + u.tile * 256 + r].x >> 1) : 0; }
    __device__ __forceinline__ const char* bseg(const pg8::UnitG& u, int) const { return W + ((size_t)u.id * 512 + u.pn * 256) * 2048; }
};
typedef SchedET<0> SchedE;
struct EpiGU {
    static constexpr bool PERM = true, PREFETCH = false;
    bf16* HID;
    template <class SC> __device__ __forceinline__ void operator()(const pg8::f32x4 (&acc)[2][2][4][2], const pg8::UnitG& u, const SC& S, int wr, int wc, int fr, int fq) const {
#pragma unroll
        for (int ai = 0; ai < 2; ++ai)
#pragma unroll
            for (int m = 0; m < 4; ++m) { const int r = ai * 128 + wr * 64 + m * 16 + fr;
                if (r < u.nrows) { const int2 rc = S.rec[(size_t)u.id * TT + u.tile * 256 + r]; const int t = rc.x >> 1, half = rc.x & 1; const float w = __builtin_bit_cast(float, rc.y);
                    float hv[8];
#pragma unroll
                    for (int n = 0; n < 2; ++n)
#pragma unroll
                        for (int j = 0; j < 4; ++j) { const float g = acc[ai][0][m][n][j], up = acc[ai][1][m][n][j]; hv[n * 4 + j] = w * siluf(g) * up; }
                    v4u o; o.x = pk2(hv[0], hv[1]); o.y = pk2(hv[2], hv[3]); o.z = pk2(hv[4], hv[5]); o.w = pk2(hv[6], hv[7]);
                    *(v4u*)(HID + (size_t)t * 512 + half * 256 + u.pn * 128 + wc * 32 + 8 * fq) = o; } }
    }
};
struct SchedC {
    int G, c, cntA, cntB, preA, preB, total_rt; const int* clist; const char* W;
    __device__ __forceinline__ void init(const unsigned* cnt, const int* clist_, const char* W_, int G_, int c_, int lane) {
        G = G_; c = c_; clist = clist_; W = W_;
        cntA = (int)cnt[lane]; cntB = lane < NCLS - 64 ? (int)cnt[64 + lane] : 0;
        const int ia = wave_incl_scan((cntA + 255) >> 8, lane); const int ta = __builtin_amdgcn_readlane(ia, 63);
        const int ib = wave_incl_scan((cntB + 255) >> 8, lane) + ta;
        total_rt = __builtin_amdgcn_readlane(ib, 63);
        preA = ia; preB = lane < NCLS - 64 ? ib : 0x7fffffff;
    }
    __device__ __forceinline__ bool next(int i, pg8::UnitG& u) const {
        const int L = i * G + c; if (L >= 4 * total_rt) return false;
        const int rt = L >> 2;
        const int cls = __builtin_amdgcn_readfirstlane(__popcll(__ballot(preA <= rt)) + __popcll(__ballot(preB <= rt)));
        int base = 0; if (cls > 0) base = (cls - 1 < 64) ? __builtin_amdgcn_readlane(preA, cls - 1) : __builtin_amdgcn_readlane(preB, cls - 65);
        const int cnt = cls < 64 ? __builtin_amdgcn_readlane(cntA, cls) : __builtin_amdgcn_readlane(cntB, cls - 64);
        u.id = cls; u.tile = rt - base; u.pn = L & 3; const int rem = cnt - u.tile * 256; u.nrows = rem < 256 ? rem : 256;
        return true;
    }
    __device__ __forceinline__ int tok(const pg8::UnitG& u, int r) const { return r < u.nrows ? clist[(size_t)u.id * TT + u.tile * 256 + r] : 0; }
    __device__ __forceinline__ const char* bseg(const pg8::UnitG& u, int seg) const {
        const int g = u.id / 28; int a = 0, rem = u.id % 28; while (rem >= 7 - a) { rem -= 7 - a; ++a; } const int b = a + 1 + rem;
        const int e = g * 8 + (seg ? b : a);
        return W + ((size_t)e * 1024 + u.pn * 256) * 512;
    }
};
template <int VAR = 0>
struct EpiDownT {
    static constexpr bool PERM = false, PREFETCH = false;
    float* OUT; const float* gate2;
    const LAS unsigned char* gt;
    template <class SC> __device__ __forceinline__ void prefetch(LAS unsigned char* lds, const pg8::UnitG& u, const SC& S, int tid) const {
#pragma unroll
        for (int i = 0; i < 4; ++i) { const int r = (tid >> 3) + 64 * i; const int t = S.tok(u, r);
            __builtin_amdgcn_global_load_lds((const unsigned*)((const char*)OUT + (size_t)t * 4096 + (size_t)u.pn * 1024 + (size_t)(tid & 7) * 128), (LAS unsigned*)(lds + pg8::STAGE_BYTES + 256), 4, 0, 0); }
    }
    template <class SC> __device__ __forceinline__ void operator()(const pg8::f32x4 (&acc)[2][2][4][2], const pg8::UnitG& u, const SC& S, int wr, int wc, int fr, int fq) const {
#pragma unroll
        for (int ai = 0; ai < 2; ++ai)
#pragma unroll
            for (int m = 0; m < 4; ++m) { const int r = ai * 128 + wr * 64 + m * 16 + fr;
                if (r < u.nrows) { const int t = S.clist[(size_t)u.id * TT + u.tile * 256 + r]; const int b = t / SEQ; const int col0 = u.pn * 256 + wc * 32 + 4 * fq;
                    float* op = OUT + (size_t)t * DM + col0; const float* gp = gate2 + b * 6144 + col0;
#pragma unroll
                    for (int bj = 0; bj < 2; ++bj)
#pragma unroll
                        for (int n = 0; n < 2; ++n) { const int off = bj * 128 + n * 16; const f32x4 xv = (VAR == 1) ? (f32x4){1.f, 1.f, 1.f, 1.f} : *(const f32x4*)(op + off);
                            f32x4 gv;
                            if (VAR == 2) gv = (f32x4){1.f, 1.f, 1.f, 1.f};
                            else if (gt) { const v2u g2 = *(const LAS v2u*)(gt + (b * 1024 + col0 + off) * 2);
                                gv.x = __builtin_bit_cast(float, g2.x << 16); gv.y = __builtin_bit_cast(float, g2.x & 0xffff0000u); gv.z = __builtin_bit_cast(float, g2.y << 16); gv.w = __builtin_bit_cast(float, g2.y & 0xffff0000u); }
                            else gv = *(const f32x4*)(gp + off);
                            *(f32x4*)(op + off) = xv + gv * acc[ai][bj][m][n]; } } }
    }
};
typedef EpiDownT<0> EpiDown;

__global__ void __launch_bounds__(NTHR, 2) fwd_kernel(Args args) {
    extern __shared__ __attribute__((aligned(16))) unsigned char lds_raw[];
    LAS unsigned char* lds = (LAS unsigned char*)lds_raw;
    volatile LAS unsigned* MISC = (volatile LAS unsigned*)(lds + MISC_OFF);
    const int G = gridDim.x;
    unsigned char* ws = args.ws;
    const int wave_s = __builtin_amdgcn_readfirstlane(threadIdx.x >> 6);
    for (int u = threadIdx.x; u < (LDS_BYTES - LDSCTL_OFF) / 4; u += NTHR) ((LAS unsigned*)(lds + LDSCTL_OFF))[u] = 0u;
    __syncthreads();
    const int lo = args.ph_lo, hi = args.ph_hi;
    const bool use_bar = (hi - lo) > 1;
    XcdBarrier bar; bar.bar = (unsigned*)(ws + WS_CTL) + CW_BAR; bar.x = 0; bar.st = nullptr;
    if (use_bar) bar = xcd_barrier_post((unsigned*)(ws + WS_CTL) + CW_BAR, MISC + 8, threadIdx.x == 0);
#define IN(k) (lo <= (k) && (k) < hi)
#define BOTH(k) (IN(k) && IN((k) + 1))
#if PROBE_REP == 1000
#define GRID_BAR(k) do { if (BOTH(k)) { xcd_barrier(bar, wave_s == 0 && __builtin_amdgcn_mbcnt_hi(~0u, __builtin_amdgcn_mbcnt_lo(~0u, 0u)) == 0u); xcd_barrier(bar, wave_s == 0 && __builtin_amdgcn_mbcnt_hi(~0u, __builtin_amdgcn_mbcnt_lo(~0u, 0u)) == 0u); } } while (0)
#else
#define GRID_BAR(k) do { if (BOTH(k)) xcd_barrier(bar, wave_s == 0 && __builtin_amdgcn_mbcnt_hi(~0u, __builtin_amdgcn_mbcnt_lo(~0u, 0u)) == 0u); } while (0)
#endif
#define FRESH_IDS() const int wave = wave_s; int lane = (int)__builtin_amdgcn_mbcnt_hi(~0u, __builtin_amdgcn_mbcnt_lo(~0u, 0u)); asm volatile("" : "+v"(lane)); const int tid = wave * 64 + lane; (void)tid
    const float* mod = (const float*)(ws + WS_MOD);

    if (IN(0)) { FRESH_IDS(); p0_prologue(args, lds, tid, lane, wave); GRID_BAR(0); }
    if (IN(1)) { FRESH_IDS(); norm_rows<false>(args, (const float*)args.in[I_X], (const float*)args.in[I_NORM_MIX], mod + 0, mod + 1024, (bf16*)(ws + WS_H), lds, lane, wave); GRID_BAR(1); }
    if (IN(2)) { FRESH_IDS();
        pg8::Gemm g{(const pg8::bf16_t*)(ws + WS_H), (const pg8::bf16_t*)(ws + WS_WINT), TT, NPAD, DM}; pg8::StaticOrder S; S.init(TT, NPAD, G, (int)blockIdx.x);
        pg8::EpiProj E{(pg8::bf16_t*)(ws + WS_PROJ), (float*)(ws + WS_AB), NPROJ};
        pg8::gemm_phase<pg8::EpiProj, pg8::StaticOrder, true, true>(lds, g, S, E);
        GRID_BAR(2);
    }
    if (IN(3)) { FRESH_IDS(); gdn_g1_mfma<31>(args, lds, tid, lane, wave); GRID_BAR(3); }
    if (IN(4)) { FRESH_IDS();
        if ((int)blockIdx.x < 32) gdn_scan(args, (int)blockIdx.x, lds, tid, lane, wave);
        else swa_mfma(args, lds, tid, lane, wave, (int)blockIdx.x - 32, G - 32);
        GRID_BAR(4);
    }
    if (IN(5)) { FRESH_IDS(); gdn_out(args, lds, lane, wave); GRID_BAR(5); }
    if (IN(6)) { FRESH_IDS();
        pg8::Gemm g{(const pg8::bf16_t*)(ws + WS_MIX), (const pg8::bf16_t*)(ws + WS_WOUTT), TT, DM, DM}; pg8::StaticOrder S; S.init(TT, DM, G, (int)blockIdx.x);
        pg8::EpiOut E{(const float*)args.in[I_X], args.out, mod + 2048, SEQ, 6144, (float*)(ws + WS_SSQ)};
        const bool first = ((blockIdx.x >> 3) & 1) != 0;
        if (first) { expert_weight_copy(args, lds, lane, wave); __syncthreads(); }
        pg8::gemm_phase<pg8::EpiOut, pg8::StaticOrder, true, true>(lds, g, S, E);
        if (!first) { __syncthreads(); expert_weight_copy(args, lds, lane, wave); }
        GRID_BAR(6);
    }
    if (IN(7)) { FRESH_IDS(); norm_route_mfma<false>(args, args.out, (const float*)(ws + WS_SSQ), (const float*)args.in[I_NORM_FFN], mod + 3072, mod + 4096, (bf16*)(ws + WS_H), lds, tid, lane, wave); GRID_BAR(7); }
    if (IN(8)) { FRESH_IDS();
        SchedE S; S.init((const unsigned*)(ws + WS_CTL) + CW_ECNT, (const int2*)(ws + WS_EREC), (const char*)(ws + WS_WGUT), G, (int)blockIdx.x, lane);
        EpiGU E{(bf16*)(ws + WS_HID)};
        pg8::gemm_phase_g<EpiGU, SchedE>(lds, (const pg8::bf16_t*)(ws + WS_H), 1024, 1024, 16, 16, S, E);
        GRID_BAR(8);
    }
    if (IN(9)) { FRESH_IDS();
        SchedC S; S.init((const unsigned*)(ws + WS_CTL) + CW_CCNT, (const int*)(ws + WS_CLIST), (const char*)(ws + WS_WDT), G, (int)blockIdx.x, lane);
        LAS unsigned char* gtl = lds + RING_BYTES + 512;
        for (int q = tid; q < 4096; q += NTHR) *(LAS unsigned short*)(gtl + q * 2) = (unsigned short)f2bf(mod[(q >> 10) * 6144 + 5120 + (q & 1023)]);
        __syncthreads();
        EpiDown E{args.out, mod + 5120, gtl};
        pg8::gemm_phase_g<EpiDown, SchedC>(lds, (const pg8::bf16_t*)(ws + WS_HID), 512, 256, 8, 4, S, E);
    }
#undef IN
#undef BOTH
#undef GRID_BAR
}

#if PROBE_REP >= 0 && PROBE_REP < 1000
template <int P>
__global__ void __launch_bounds__(NTHR, 2) probe_kernel(Args args) {
    extern __shared__ __attribute__((aligned(16))) unsigned char lds_raw[];
    LAS unsigned char* lds = (LAS unsigned char*)lds_raw;
    const int tid = threadIdx.x, lane = tid & 63, wave = __builtin_amdgcn_readfirstlane(tid >> 6);
    const int G = gridDim.x; unsigned char* ws = args.ws; const float* mod = (const float*)(ws + WS_MOD);
    if constexpr (P == 1) norm_rows<false>(args, (const float*)args.in[I_X], (const float*)args.in[I_NORM_MIX], mod + 0, mod + 1024, (bf16*)(ws + WS_GAP + 0)  , lds, lane, wave);
    if constexpr (P == 2) { pg8::Gemm g{(const pg8::bf16_t*)(ws + WS_H), (const pg8::bf16_t*)(ws + WS_WINT), TT, NPAD, DM}; pg8::StaticOrder S; S.init(TT, NPAD, G, (int)blockIdx.x);
        pg8::EpiProj E{(pg8::bf16_t*)(ws + WS_PROJ), (float*)(ws + WS_AB), NPROJ}; pg8::gemm_phase<pg8::EpiProj, pg8::StaticOrder, true, true>(lds, g, S, E); }
    if constexpr (P == 0) p0_prologue(args, lds, tid, lane, wave);
    if constexpr (P == 4) gdn_g1_mfma<31>(args, lds, tid, lane, wave);
    if constexpr (P == 40) gdn_g1_mfma<31, 0>(args, lds, tid, lane, wave);
    if constexpr (P == 41) gdn_g1_mfma<31, 1>(args, lds, tid, lane, wave);
    if constexpr (P == 42) gdn_g1_mfma<31, 3>(args, lds, tid, lane, wave);
    if constexpr (P == 43) gdn_g1_mfma<0, 7>(args, lds, tid, lane, wave);
    if constexpr (P == 50) { if ((int)blockIdx.x < 32) gdn_scan(args, (int)blockIdx.x, lds, tid, lane, wave); }
    if constexpr (P == 501) { if ((int)blockIdx.x < 32) gdn_scan<1>(args, (int)blockIdx.x, lds, tid, lane, wave); }
    if constexpr (P == 502) { if ((int)blockIdx.x < 32) gdn_scan<2>(args, (int)blockIdx.x, lds, tid, lane, wave); }
    if constexpr (P == 52) gdn_out(args, lds, lane, wave);
    if constexpr (P == 51) { if ((int)blockIdx.x >= 32) swa_mfma(args, lds, tid, lane, wave, (int)blockIdx.x - 32, G - 32); }
    if constexpr (P == 60) expert_weight_copy(args, lds, lane, wave);
    if constexpr (P == 61) { pg8::Gemm g{(const pg8::bf16_t*)(ws + WS_MIX), (const pg8::bf16_t*)(ws + WS_WOUTT), TT, DM, DM}; pg8::StaticOrder S; S.init(TT, DM, G, (int)blockIdx.x);
        pg8::EpiOut E{(const float*)args.in[I_X], (float*)(ws + WS_GSF)  , mod + 2048, SEQ, 6144, nullptr};
        const bool first = ((blockIdx.x >> 3) & 1) != 0;
        if (first) { expert_weight_copy(args, lds, lane, wave); __syncthreads(); }
        pg8::gemm_phase<pg8::EpiOut, pg8::StaticOrder, true, true>(lds, g, S, E);
        if (!first) { __syncthreads(); expert_weight_copy(args, lds, lane, wave); } }
    if constexpr (P == 6) { pg8::Gemm g{(const pg8::bf16_t*)(ws + WS_MIX), (const pg8::bf16_t*)(ws + WS_WOUTT), TT, DM, DM}; pg8::StaticOrder S; S.init(TT, DM, G, (int)blockIdx.x);
        pg8::EpiOut E{(const float*)args.in[I_X], (float*)(ws + WS_GSF)  , mod + 2048, SEQ, 6144, nullptr}; pg8::gemm_phase<pg8::EpiOut, pg8::StaticOrder, true, true>(lds, g, S, E); }
    if constexpr (P == 81) { SchedET<1> S; S.init((const unsigned*)(ws + WS_CTL) + CW_ECNT, (const int2*)(ws + WS_EREC), (const char*)(ws + WS_WGUT), G, (int)blockIdx.x, lane);
        EpiGU E{(bf16*)(ws + WS_HID)}; pg8::gemm_phase_g<EpiGU, SchedET<1>>(lds, (const pg8::bf16_t*)(ws + WS_H), 1024, 1024, 16, 16, S, E); }
    if constexpr (P == 8) { SchedE S; S.init((const unsigned*)(ws + WS_CTL) + CW_ECNT, (const int2*)(ws + WS_EREC), (const char*)(ws + WS_WGUT), G, (int)blockIdx.x, lane);
        EpiGU E{(bf16*)(ws + WS_HID)}; pg8::gemm_phase_g<EpiGU, SchedE>(lds, (const pg8::bf16_t*)(ws + WS_H), 1024, 1024, 16, 16, S, E); }
    if constexpr (P == 71) norm_route_mfma<true, 1>(args, args.out, (const float*)(ws + WS_SSQ), (const float*)args.in[I_NORM_FFN], mod + 3072, mod + 4096, (bf16*)(ws + WS_PROJ + 32 * MiB), lds, tid, lane, wave);
    if constexpr (P == 7) norm_route_mfma<true>(args, args.out, (const float*)(ws + WS_SSQ), (const float*)args.in[I_NORM_FFN], mod + 3072, mod + 4096, (bf16*)(ws + WS_PROJ + 32 * MiB), lds, tid, lane, wave);
    if constexpr (P == 91 || P == 92) { SchedC S; S.init((const unsigned*)(ws + WS_CTL) + CW_CCNT, (const int*)(ws + WS_CLIST), (const char*)(ws + WS_WDT), G, (int)blockIdx.x, lane);
        EpiDownT<P - 90> E{(float*)(ws + WS_PROJ + 32 * MiB), mod + 5120, nullptr}; pg8::gemm_phase_g<EpiDownT<P - 90>, SchedC>(lds, (const pg8::bf16_t*)(ws + WS_HID), 512, 256, 8, 4, S, E); }
    if constexpr (P == 9) { SchedC S; S.init((const unsigned*)(ws + WS_CTL) + CW_CCNT, (const int*)(ws + WS_CLIST), (const char*)(ws + WS_WDT), G, (int)blockIdx.x, lane);
        EpiDown E{(float*)(ws + WS_PROJ + 32 * MiB), mod + 5120, nullptr}; pg8::gemm_phase_g<EpiDown, SchedC>(lds, (const pg8::bf16_t*)(ws + WS_HID), 512, 256, 8, 4, S, E); }
}
#endif
extern "C" void kernel_launch(void* const* d_in, const int* in_sizes, int n_in, void* d_out, int out_size, void* d_ws, size_t ws_size, hipStream_t stream) {
    static int grid = 0;
    if (grid == 0) {
        if (n_in != 23 || in_sizes[0] != TT * DM || out_size != TT * DM || ws_size < WS_END) { fprintf(stderr, "kernel_launch: unexpected shapes: n_in %d in0 %d out %d ws %zu (need %zu)\n", n_in, n_in > 0 ? in_sizes[0] : -1, out_size, ws_size, (size_t)WS_END); grid = -1; return; }
        int dev = 0, cus = 0, per_cu = 0;
        if (hipGetDevice(&dev) != hipSuccess || hipDeviceGetAttribute(&cus, hipDeviceAttributeMultiprocessorCount, dev) != hipSuccess) { grid = -1; return; }
        if (hipFuncSetAttribute((const void*)fwd_kernel, hipFuncAttributeMaxDynamicSharedMemorySize, LDS_BYTES) != hipSuccess) { fprintf(stderr, "kernel_launch: hipFuncSetAttribute failed\n"); grid = -1; return; }
        if (hipOccupancyMaxActiveBlocksPerMultiprocessor(&per_cu, (const void*)fwd_kernel, NTHR, LDS_BYTES) != hipSuccess || per_cu < 1) fprintf(stderr, "kernel_launch: occupancy query reports %d\n", per_cu);
        (void)hipGetLastError();
        grid = cus;
    }
    if (grid < 0) return;
    if (hipMemsetAsync((char*)d_ws + WS_CTL, 0, CTL_ZERO_BYTES, stream) != hipSuccess) { fprintf(stderr, "kernel_launch: memset failed\n"); return; }
    Args a{};
    for (int i = 0; i < 23; ++i) a.in[i] = d_in[i];
    a.out = (float*)d_out; a.ws = (unsigned char*)d_ws;
#if MK_ONE_LAUNCH
    a.ph_lo = 0; a.ph_hi = N_PHASES;
    hipLaunchKernelGGL(fwd_kernel, dim3(grid), dim3(NTHR), LDS_BYTES, stream, a);
#if PROBE_REP >= 0 && PROBE_REP < 1000
    hipFuncSetAttribute((const void*)probe_kernel<PROBE_REP>, hipFuncAttributeMaxDynamicSharedMemorySize, LDS_BYTES);
    hipLaunchKernelGGL(probe_kernel<PROBE_REP>, dim3(grid), dim3(NTHR), LDS_BYTES, stream, a);
#endif
#else
    for (int p = 0; p < N_PHASES; ++p) { a.ph_lo = p; a.ph_hi = p + 1; hipLaunchKernelGGL(fwd_kernel, dim3(grid), dim3(NTHR), LDS_BYTES, stream, a); }
#endif
}
```

```cpp
#include <hip/hip_runtime.h>
#include <cstdio>
#include <cstdint>
namespace pg8 {
#define PG8_LAS __attribute__((address_space(3)))
typedef unsigned short bf16_t;
typedef short bf16x8 __attribute__((ext_vector_type(8)));
typedef float f32x4 __attribute__((ext_vector_type(4)));
typedef unsigned u32x4 __attribute__((ext_vector_type(4)));
constexpr int BM = 256, BK = 64, HALF = 128, HTB = HALF * BK * 2  , STAGE_BYTES = 8 * HTB, NXCD = 8, WGM = 8;

__host__ __device__ __forceinline__ int lds_byte(int r, int c) { const int st = (r >> 4) * 2 + (c >> 5), rr = r & 15, cc = c & 31, ob = rr * 64 + cc * 2; return st * 1024 + (ob ^ (((ob >> 9) & 1) << 5)); }
__host__ __device__ __forceinline__ void stage_rc(int b, int& R, int& C) { const int st = b / 1024, sb = b % 1024, swz = sb ^ (((sb >> 9) & 1) << 5); R = (st >> 1) * 16 + swz / 64; C = (st & 1) * 32 + (swz % 64) / 2; }
__host__ __device__ __forceinline__ int perm32(int rho) { const int n = rho >> 4, i = rho & 15; return 8 * (i >> 2) + 4 * n + (i & 3); }

struct Unit { int pm, pn; };
struct Gemm { const bf16_t* A; const bf16_t* Bt; int M, N, K; };

struct StaticOrder {
    int nM, nN, nwg, G, c;
    __host__ __device__ void init(int M, int N, int G_, int c_) { nM = M / BM; nN = N / BM; nwg = nM * nN; G = G_; c = c_; }
    __host__ __device__ bool next(int i, Unit& u) const {
        const long L = (long)i * G + c; if (L >= nwg) return false;
        int wgid = (int)L; { const int q = nwg / NXCD, r = nwg % NXCD, xcd = wgid % NXCD, off = wgid / NXCD; wgid = (xcd < r ? xcd * (q + 1) : r * (q + 1) + (xcd - r) * q) + off; }
        const int nig = WGM * nN, gid = wgid / nig, fm = gid * WGM, gsz = (nM - fm) < WGM ? (nM - fm) : WGM;
        u.pm = fm + ((wgid % nig) % gsz); u.pn = (wgid % nig) / gsz; return true;
    }
    __device__ __forceinline__ void a_ready(const Unit&) const {}
    __device__ __forceinline__ void done(const Unit&) const {}
};

__device__ __forceinline__ unsigned cvt_pk_bf16(float lo, float hi) { unsigned r; asm volatile("v_cvt_pk_bf16_f32 %0, %1, %2" : "=v"(r) : "v"(lo), "v"(hi)); return r; }

__device__ __forceinline__ void store16_wt(void* base, unsigned byte_off, u32x4 v) {
    __amdgpu_buffer_rsrc_t r = __builtin_amdgcn_make_buffer_rsrc(base, 0, 0x7fffffff, 0x00020000);
    __builtin_amdgcn_raw_buffer_store_b128(v, r, (int)byte_off, 0, 16);
}
struct EpiProj {
    static constexpr bool PERM = true, AFTER_DRAIN = false, PREFETCH = false;
    bf16_t* P; float* AB; int ldp;
    __device__ __forceinline__ void operator()(const f32x4 (&acc)[2][2][4][2], const Unit& u, int wr, int wc, int fr, int fq) const {
        const int row0 = u.pm * BM + wr * 64 + fr;
        if (u.pn < 11) {
            const int col0 = u.pn * BM + wc * 32 + 8 * fq;
#pragma unroll
            for (int ai = 0; ai < 2; ++ai)
#pragma unroll
                for (int m = 0; m < 4; ++m) { const unsigned ro = ((unsigned)(row0 + ai * HALF + m * 16) * (unsigned)ldp + (unsigned)col0) * 2u;
#pragma unroll
                    for (int bj = 0; bj < 2; ++bj) { const f32x4 v0 = acc[ai][bj][m][0], v1 = acc[ai][bj][m][1];
                        u32x4 w; w.x = cvt_pk_bf16(v0[0], v0[1]); w.y = cvt_pk_bf16(v0[2], v0[3]); w.z = cvt_pk_bf16(v1[0], v1[1]); w.w = cvt_pk_bf16(v1[2], v1[3]);
                        *(u32x4*)((char*)P + ro + (unsigned)(bj * HALF) * 2u) = w; } }
        } else if (wc == 0 && fq < 2) {
#pragma unroll
            for (int ai = 0; ai < 2; ++ai)
#pragma unroll
                for (int m = 0; m < 4; ++m) { float* rowp = AB + (size_t)(row0 + ai * HALF + m * 16) * 16 + 8 * fq;
                    *(f32x4*)(rowp) = acc[ai][0][m][0]; *(f32x4*)(rowp + 4) = acc[ai][0][m][1]; }
        }
    }
};
struct EpiOut {
    static constexpr bool PERM = false, AFTER_DRAIN = false, PREFETCH = false;
    const float* X; float* O; const float* gate; int rows_per_batch, ldg;
    float* SSQ;
    __device__ __forceinline__ void prefetch(PG8_LAS unsigned char* lds, const Unit& u, int tid) const {
        const char* base = (const char*)X + ((size_t)(u.pm * BM) * 1024 + (size_t)u.pn * BM) * 4 + (size_t)(tid >> 3) * 4096 + (size_t)(tid & 7) * 128;
#pragma unroll
        for (int i = 0; i < 4; ++i) __builtin_amdgcn_global_load_lds((const unsigned*)(base + (size_t)i * 64 * 4096), (PG8_LAS unsigned*)(lds + STAGE_BYTES + 256), 4, 0, 0);
    }
    __device__ __forceinline__ void operator()(const f32x4 (&acc)[2][2][4][2], const Unit& u, int wr, int wc, int fr, int fq) const {
        const int row0 = u.pm * BM + wr * 64 + fr, col0 = u.pn * BM + wc * 32 + 4 * fq;
        const float* gb = gate + (size_t)((u.pm * BM) / rows_per_batch) * ldg + col0;
        f32x4 gv[2][2];
#pragma unroll
        for (int bj = 0; bj < 2; ++bj)
#pragma unroll
            for (int n = 0; n < 2; ++n) gv[bj][n] = *(const f32x4*)(gb + bj * HALF + n * 16);
#pragma unroll
        for (int ai = 0; ai < 2; ++ai)
#pragma unroll
            for (int m = 0; m < 4; ++m) { const size_t ro = (size_t)(row0 + ai * HALF + m * 16) * 1024 + col0; float ss = 0.f;
#pragma unroll
                for (int bj = 0; bj < 2; ++bj)
#pragma unroll
                    for (int n = 0; n < 2; ++n) { const f32x4 xv = *(const f32x4*)(X + ro + bj * HALF + n * 16); const f32x4 v = xv + gv[bj][n] * acc[ai][bj][m][n];
                        *(f32x4*)(O + ro + bj * HALF + n * 16) = v; ss += (v.x * v.x + v.y * v.y) + (v.z * v.z + v.w * v.w); }
                if (SSQ) { ss += __shfl_xor(ss, 16); ss += __shfl_xor(ss, 32); if (fq == 0) SSQ[(size_t)(row0 + ai * HALF + m * 16) * 16 + u.pn * 4 + wc] = ss; } }
    }
};

struct UnitG { int id, tile, pn, nrows; };
template <class Epi, class Sched>
__device__ __forceinline__ void gemm_phase_g(PG8_LAS unsigned char* lds, const bf16_t* Abase, const int KA, const int KB, const int nt, const int ksplit, const Sched& S, const Epi& E) {
    const int tid = threadIdx.x, wid = __builtin_amdgcn_readfirstlane(tid >> 6), lane = tid & 63, wr = wid >> 2, wc = wid & 3, fr = lane & 15, fq = lane >> 4;
    int Rr[2]; unsigned cB2[2], voffB[2];
#pragma unroll
    for (int i = 0; i < 2; ++i) { int R, C; stage_rc(tid * 16 + i * 8192, R, C); const int Rb = Epi::PERM ? ((R & ~31) + perm32(R & 31)) : R;
        Rr[i] = R; cB2[i] = (unsigned)C * 2u; voffB[i] = (unsigned)(Rb * KB + C) * 2u; }
    const size_t kstep = (size_t)(BK * 2);
    const size_t hstepB = (size_t)HALF * KB * 2;
    const unsigned ldsw = (unsigned)wid * 1024u;
    const int aoff = lds_byte(wr * 64 + fr, fq * 8), boff = lds_byte(wc * 32 + fr, fq * 8);
#define PG8_SA(b, h) (((b) * 2 + (h)) * HTB)
#define PG8_SB(b, h) ((4 + (b) * 2 + (h)) * HTB)
#define PG8_STAGE2(bufoff, gbase, v0, v1) do { \
        __builtin_amdgcn_global_load_lds((const unsigned*)((const char*)(gbase) + (v0)), (PG8_LAS unsigned*)(lds + (bufoff) + ldsw), 16, 0, 0); \
        __builtin_amdgcn_global_load_lds((const unsigned*)((const char*)(gbase) + (v1)), (PG8_LAS unsigned*)(lds + (bufoff) + ldsw + 8192), 16, 0, 0); } while (0)
#define PG8_LDA(dst, b, h) do { _Pragma("unroll") for (int m = 0; m < 4; ++m) _Pragma("unroll") for (int k = 0; k < 2; ++k) dst[m][k] = *(const PG8_LAS bf16x8*)(lds + PG8_SA(b, h) + aoff + m * 2048 + k * 1024); } while (0)
#define PG8_LDB(dst, b, h) do { _Pragma("unroll") for (int n = 0; n < 2; ++n) _Pragma("unroll") for (int k = 0; k < 2; ++k) dst[n][k] = *(const PG8_LAS bf16x8*)(lds + PG8_SB(b, h) + boff + n * 2048 + k * 1024); } while (0)
#define PG8_MMA(ai, bj, At, Bt) do { __builtin_amdgcn_s_setprio(1); _Pragma("unroll") for (int m = 0; m < 4; ++m) _Pragma("unroll") for (int n = 0; n < 2; ++n) _Pragma("unroll") for (int k = 0; k < 2; ++k) \
        acc[ai][bj][m][n] = __builtin_amdgcn_mfma_f32_16x16x32_bf16(Bt[n][k], At[m][k], acc[ai][bj][m][n], 0, 0, 0); __builtin_amdgcn_s_setprio(0); } while (0)
#define PG8_WAIT_V(n) asm volatile("s_waitcnt vmcnt(" #n ")" ::: "memory")
#define PG8_WAIT_L(n) asm volatile("s_waitcnt lgkmcnt(" #n ")" ::: "memory")
#define PG8_BAR __builtin_amdgcn_s_barrier()
#define PG8_SCHED __builtin_amdgcn_sched_barrier(0)
#define PG8_AOFFS(u, o00, o01, o10, o11) do { const unsigned _ks = (unsigned)KA * 2u; \
        o00 = (unsigned)S.tok(u, Rr[0]) * _ks + cB2[0]; o01 = (unsigned)S.tok(u, Rr[1]) * _ks + cB2[1]; \
        o10 = (unsigned)S.tok(u, HALF + Rr[0]) * _ks + cB2[0]; o11 = (unsigned)S.tok(u, HALF + Rr[1]) * _ks + cB2[1]; } while (0)
#define PG8_BT(u, t) (((t) < ksplit) ? S.bseg(u, 0) + (size_t)(t) * kstep : S.bseg(u, 1) + (size_t)((t) - ksplit) * kstep)
    UnitG cur, nxt; int ui = 0;
    if (!S.next(0, cur)) return;
    f32x4 acc[2][2][4][2];
#pragma unroll
    for (int a = 0; a < 2; ++a)
#pragma unroll
        for (int b = 0; b < 2; ++b)
#pragma unroll
            for (int m = 0; m < 4; ++m)
#pragma unroll
                for (int n = 0; n < 2; ++n) acc[a][b][m][n] = (f32x4){0.f, 0.f, 0.f, 0.f};
    bf16x8 At[4][2], B0[2][2], B1[2][2];
    unsigned c00, c01, c10, c11, n00 = 0, n01 = 0, n10 = 0, n11 = 0;
    PG8_AOFFS(cur, c00, c01, c10, c11);
    if constexpr (Epi::PREFETCH) E.prefetch(lds, cur, S, tid);
    const char* const Ab = (const char*)Abase;
    {   const char* b0p = PG8_BT(cur, 0); const char* b1p = PG8_BT(cur, 1);
        PG8_STAGE2(PG8_SB(0, 0), b0p, voffB[0], voffB[1]); PG8_STAGE2(PG8_SB(0, 1), b0p + hstepB, voffB[0], voffB[1]); PG8_STAGE2(PG8_SA(0, 0), Ab, c00, c01); PG8_STAGE2(PG8_SA(0, 1), Ab, c10, c11);
        if (wr == 1) PG8_BAR;
        PG8_WAIT_V(2); PG8_BAR;
        PG8_STAGE2(PG8_SB(1, 0), b1p, voffB[0], voffB[1]); PG8_STAGE2(PG8_SA(1, 0), Ab + kstep, c00, c01); PG8_STAGE2(PG8_SB(1, 1), b1p + hstepB, voffB[0], voffB[1]);
        PG8_WAIT_V(6); PG8_BAR;
    }
    for (;;) {
        const bool has_next = S.next(ui + 1, nxt);
        const bool h1 = cur.nrows > HALF;
        for (int t = 0; t < nt; t += 2) {
            const bool last = (t == nt - 2);
            if (last && has_next) { PG8_AOFFS(nxt, n00, n01, n10, n11); if constexpr (Epi::PREFETCH) E.prefetch(lds, nxt, S, tid); }
            const bool usen = last && has_next;
            const int t2 = last ? 0 : t + 2, t3 = t2 + 1;
            const char* a1 = Ab + (size_t)(t + 1) * kstep;
            const char* a2 = Ab + (size_t)t2 * kstep; const char* a3 = Ab + (size_t)t3 * kstep;
            const char* b2 = usen ? PG8_BT(nxt, t2) : PG8_BT(cur, t2); const char* b3 = usen ? PG8_BT(nxt, t3) : PG8_BT(cur, t3);
            const unsigned o00 = usen ? n00 : c00, o01 = usen ? n01 : c01, o10 = usen ? n10 : c10, o11 = usen ? n11 : c11;
            PG8_LDB(B0, 0, 0); PG8_LDB(B1, 0, 1); PG8_SCHED; PG8_LDA(At, 0, 0); PG8_STAGE2(PG8_SA(1, 1), a1, c10, c11);
            PG8_WAIT_V(8); PG8_WAIT_L(0); PG8_BAR; PG8_MMA(0, 0, At, B0); PG8_MMA(0, 1, At, B1); PG8_BAR; PG8_SCHED;
            PG8_LDA(At, 0, 1); PG8_STAGE2(PG8_SB(0, 0), b2, voffB[0], voffB[1]); PG8_STAGE2(PG8_SB(0, 1), b2 + hstepB, voffB[0], voffB[1]); PG8_STAGE2(PG8_SA(0, 0), a2, o00, o01);
            PG8_WAIT_V(8); PG8_WAIT_L(0); PG8_BAR; if (h1) { PG8_MMA(1, 0, At, B0); PG8_MMA(1, 1, At, B1); } PG8_BAR; PG8_SCHED;
            PG8_LDB(B0, 1, 0); PG8_LDB(B1, 1, 1); PG8_SCHED; PG8_LDA(At, 1, 0); PG8_STAGE2(PG8_SA(0, 1), a2, o10, o11);
            PG8_WAIT_V(8); PG8_WAIT_L(0); PG8_BAR; PG8_MMA(0, 0, At, B0); PG8_MMA(0, 1, At, B1); PG8_BAR; PG8_SCHED;
            PG8_LDA(At, 1, 1); PG8_STAGE2(PG8_SB(1, 0), b3, voffB[0], voffB[1]); PG8_STAGE2(PG8_SB(1, 1), b3 + hstepB, voffB[0], voffB[1]); PG8_STAGE2(PG8_SA(1, 0), a3, o00, o01);
            PG8_WAIT_V(8); PG8_WAIT_L(0); PG8_BAR; if (h1) { PG8_MMA(1, 0, At, B0); PG8_MMA(1, 1, At, B1); } PG8_BAR; PG8_SCHED;
        }
        if (wr == 0) PG8_BAR;
        E(acc, cur, S, wr, wc, fr, fq);
        if (!has_next) break;
#pragma unroll
        for (int a = 0; a < 2; ++a)
#pragma unroll
            for (int b = 0; b < 2; ++b)
#pragma unroll
                for (int m = 0; m < 4; ++m)
#pragma unroll
                    for (int n = 0; n < 2; ++n) acc[a][b][m][n] = (f32x4){0.f, 0.f, 0.f, 0.f};
        cur = nxt; c00 = n00; c01 = n01; c10 = n10; c11 = n11; ++ui;
        if (wr == 1) PG8_BAR;
    }
    PG8_WAIT_V(0);
    PG8_BAR;
#undef PG8_SA
#undef PG8_SB
#undef PG8_STAGE2
#undef PG8_LDA
#undef PG8_LDB
#undef PG8_MMA
#undef PG8_WAIT_V
#undef PG8_WAIT_L
#undef PG8_BAR
#undef PG8_SCHED
#undef PG8_AOFFS
#undef PG8_BT
}
template <class Epi, class Sched, bool ALIGN_EPI = false, bool SP2 = false>
__device__ __forceinline__ void gemm_phase(PG8_LAS unsigned char* lds, const Gemm g, const Sched& S, const Epi& E) {
    const int tid = threadIdx.x, wid = __builtin_amdgcn_readfirstlane(tid >> 6), lane = tid & 63, wr = wid >> 2, wc = wid & 3, fr = lane & 15, fq = lane >> 4;
    const int K = g.K, nt = K / BK;
    unsigned voffA[2], voffB[2];
#pragma unroll
    for (int i = 0; i < 2; ++i) { int R, C; stage_rc(tid * 16 + i * 8192, R, C); const int Rb = Epi::PERM ? ((R & ~31) + perm32(R & 31)) : R;
        voffA[i] = (unsigned)(R * K + C) * 2u; voffB[i] = (unsigned)(Rb * K + C) * 2u; }
    const size_t kstep = (size_t)(BK * 2);
    const size_t hstep = (size_t)HALF * K * 2;
    const size_t tstep = 2 * hstep;
    const unsigned ldsw = (unsigned)wid * 1024u;
    const int aoff = lds_byte(wr * 64 + fr, fq * 8), boff = lds_byte(wc * 32 + fr, fq * 8);
#define PG8_SA(b, h) (((b) * 2 + (h)) * HTB)
#define PG8_SB(b, h) ((4 + (b) * 2 + (h)) * HTB)
#define PG8_STAGE(bufoff, gbase, voff) do { _Pragma("unroll") for (int _i = 0; _i < 2; ++_i) \
        __builtin_amdgcn_global_load_lds((const unsigned*)((const char*)(gbase) + (voff)[_i]), (PG8_LAS unsigned*)(lds + (bufoff) + ldsw + _i * 8192), 16, 0, 0); } while (0)
#define PG8_LDA(dst, b, h) do { _Pragma("unroll") for (int m = 0; m < 4; ++m) _Pragma("unroll") for (int k = 0; k < 2; ++k) dst[m][k] = *(const PG8_LAS bf16x8*)(lds + PG8_SA(b, h) + aoff + m * 2048 + k * 1024); } while (0)
#define PG8_LDB(dst, b, h) do { _Pragma("unroll") for (int n = 0; n < 2; ++n) _Pragma("unroll") for (int k = 0; k < 2; ++k) dst[n][k] = *(const PG8_LAS bf16x8*)(lds + PG8_SB(b, h) + boff + n * 2048 + k * 1024); } while (0)
#define PG8_MMA(ai, bj, At, Bt) do { __builtin_amdgcn_s_setprio(1); _Pragma("unroll") for (int m = 0; m < 4; ++m) _Pragma("unroll") for (int n = 0; n < 2; ++n) _Pragma("unroll") for (int k = 0; k < 2; ++k) \
        acc[ai][bj][m][n] = __builtin_amdgcn_mfma_f32_16x16x32_bf16(Bt[n][k], At[m][k], acc[ai][bj][m][n], 0, 0, 0); __builtin_amdgcn_s_setprio(0); } while (0)
#define PG8_WAIT_V(n) asm volatile("s_waitcnt vmcnt(" #n ")" ::: "memory")
#define PG8_WAIT_L(n) asm volatile("s_waitcnt lgkmcnt(" #n ")" ::: "memory")
#define PG8_BAR __builtin_amdgcn_s_barrier()
#define PG8_SCHED __builtin_amdgcn_sched_barrier(0)
    Unit cur, nxt; int ui = 0;
    if (!S.next(0, cur)) return;
    f32x4 acc[2][2][4][2];
#pragma unroll
    for (int a = 0; a < 2; ++a)
#pragma unroll
        for (int b = 0; b < 2; ++b)
#pragma unroll
            for (int m = 0; m < 4; ++m)
#pragma unroll
                for (int n = 0; n < 2; ++n) acc[a][b][m][n] = (f32x4){0.f, 0.f, 0.f, 0.f};
    bf16x8 At[4][2], B0[2][2], B1[2][2];
    const char* cA = (const char*)g.A + (size_t)cur.pm * tstep; const char* cB = (const char*)g.Bt + (size_t)cur.pn * tstep;
    S.a_ready(cur);
    if constexpr (SP2) {
        PG8_STAGE(PG8_SB(0, 0), cB, voffB); PG8_STAGE(PG8_SB(0, 1), cB + hstep, voffB); PG8_STAGE(PG8_SA(0, 0), cA, voffA); PG8_STAGE(PG8_SA(0, 1), cA + hstep, voffA);
        if (wr == 1) PG8_BAR;
        PG8_WAIT_V(2); PG8_BAR;
        PG8_STAGE(PG8_SB(1, 0), cB + kstep, voffB); PG8_STAGE(PG8_SA(1, 0), cA + kstep, voffA); PG8_STAGE(PG8_SB(1, 1), cB + hstep + kstep, voffB);
        PG8_WAIT_V(6); PG8_BAR;
    } else {
        PG8_STAGE(PG8_SB(0, 0), cB, voffB); PG8_STAGE(PG8_SA(0, 0), cA, voffA); PG8_STAGE(PG8_SB(0, 1), cB + hstep, voffB); PG8_STAGE(PG8_SA(0, 1), cA + hstep, voffA);
        if (wr == 1) PG8_BAR;
        PG8_WAIT_V(4); PG8_BAR;
        PG8_STAGE(PG8_SB(1, 0), cB + kstep, voffB); PG8_STAGE(PG8_SA(1, 0), cA + kstep, voffA); PG8_STAGE(PG8_SB(1, 1), cB + hstep + kstep, voffB);
        PG8_WAIT_V(6); PG8_BAR;
    }
    if constexpr (Epi::PREFETCH) E.prefetch(lds, cur, tid);
    for (;;) {
        const bool has_next = S.next(ui + 1, nxt);
        const char* nA = has_next ? (const char*)g.A + (size_t)nxt.pm * tstep : cA; const char* nB = has_next ? (const char*)g.Bt + (size_t)nxt.pn * tstep : cB;
        for (int t = 0; t < nt; t += 2) {
            const bool last = (t == nt - 2);
            const char* a1 = cA + (size_t)(t + 1) * kstep;
            const char* a2 = last ? nA : cA + (size_t)(t + 2) * kstep; const char* b2 = last ? nB : cB + (size_t)(t + 2) * kstep;
            const char* a3 = a2 + kstep; const char* b3 = b2 + kstep;
            if (last && has_next) S.a_ready(nxt);
            if constexpr (SP2) {
            PG8_LDB(B0, 0, 0); PG8_LDB(B1, 0, 1); PG8_SCHED; PG8_LDA(At, 0, 0); PG8_STAGE(PG8_SA(1, 1), a1 + hstep, voffA);
            PG8_WAIT_V(8); PG8_WAIT_L(0); PG8_BAR; PG8_MMA(0, 0, At, B0); PG8_MMA(0, 1, At, B1); PG8_BAR; PG8_SCHED;
            PG8_LDA(At, 0, 1); PG8_STAGE(PG8_SB(0, 0), b2, voffB); PG8_STAGE(PG8_SB(0, 1), b2 + hstep, voffB); PG8_STAGE(PG8_SA(0, 0), a2, voffA);
            PG8_WAIT_V(8); PG8_WAIT_L(0); PG8_BAR; PG8_MMA(1, 0, At, B0); PG8_MMA(1, 1, At, B1); PG8_BAR; PG8_SCHED;
            PG8_LDB(B0, 1, 0); PG8_LDB(B1, 1, 1); PG8_SCHED; PG8_LDA(At, 1, 0); PG8_STAGE(PG8_SA(0, 1), a2 + hstep, voffA);
            PG8_WAIT_V(8); PG8_WAIT_L(0); PG8_BAR; PG8_MMA(0, 0, At, B0); PG8_MMA(0, 1, At, B1); PG8_BAR; PG8_SCHED;
            PG8_LDA(At, 1, 1); PG8_STAGE(PG8_SB(1, 0), b3, voffB); PG8_STAGE(PG8_SB(1, 1), b3 + hstep, voffB); PG8_STAGE(PG8_SA(1, 0), a3, voffA);
            PG8_WAIT_V(8); PG8_WAIT_L(0); PG8_BAR; PG8_MMA(1, 0, At, B0); PG8_MMA(1, 1, At, B1); PG8_BAR; PG8_SCHED;
            } else {
            PG8_LDB(B0, 0, 0); PG8_SCHED; PG8_LDA(At, 0, 0); PG8_STAGE(PG8_SA(1, 1), a1 + hstep, voffA);
            PG8_WAIT_L(8); PG8_BAR; PG8_WAIT_L(0); PG8_MMA(0, 0, At, B0); PG8_BAR; PG8_SCHED;
            PG8_LDB(B1, 0, 1); PG8_STAGE(PG8_SB(0, 0), b2, voffB);
            PG8_BAR; PG8_WAIT_L(0); PG8_MMA(0, 1, At, B1); PG8_BAR;
            PG8_LDA(At, 0, 1); PG8_STAGE(PG8_SA(0, 0), a2, voffA);
            PG8_BAR; PG8_WAIT_L(0); PG8_MMA(1, 0, At, B0); PG8_BAR; PG8_SCHED;
            PG8_STAGE(PG8_SB(0, 1), b2 + hstep, voffB);
            PG8_WAIT_V(6); PG8_BAR; PG8_MMA(1, 1, At, B1); PG8_BAR;
            PG8_LDB(B0, 1, 0); PG8_SCHED; PG8_LDA(At, 1, 0); PG8_STAGE(PG8_SA(0, 1), a2 + hstep, voffA);
            PG8_WAIT_L(8); PG8_BAR; PG8_WAIT_L(0); PG8_MMA(0, 0, At, B0); PG8_BAR; PG8_SCHED;
            PG8_LDB(B1, 1, 1); PG8_STAGE(PG8_SB(1, 0), b3, voffB);
            PG8_BAR; PG8_WAIT_L(0); PG8_MMA(0, 1, At, B1); PG8_BAR;
            PG8_LDA(At, 1, 1); PG8_STAGE(PG8_SA(1, 0), a3, voffA);
            PG8_BAR; PG8_WAIT_L(0); PG8_MMA(1, 0, At, B0); PG8_BAR; PG8_SCHED;
            PG8_STAGE(PG8_SB(1, 1), b3 + hstep, voffB);
            PG8_WAIT_V(6); PG8_BAR; PG8_MMA(1, 1, At, B1); PG8_BAR;
            }
        }
        if constexpr (ALIGN_EPI) { if (wr == 0) PG8_BAR; }
        if constexpr (!Epi::AFTER_DRAIN) { E(acc, cur, wr, wc, fr, fq); S.done(cur); }
        if (!has_next) break;
#pragma unroll
        for (int a = 0; a < 2; ++a)
#pragma unroll
            for (int b = 0; b < 2; ++b)
#pragma unroll
                for (int m = 0; m < 4; ++m)
#pragma unroll
                    for (int n = 0; n < 2; ++n) acc[a][b][m][n] = (f32x4){0.f, 0.f, 0.f, 0.f};
        cur = nxt; cA = nA; cB = nB; ++ui;
        if constexpr (Epi::PREFETCH) { int l_ = fr + 16 * fq; asm volatile("" : "+v"(l_)); E.prefetch(lds, cur, wid * 64 + l_); }
        if constexpr (ALIGN_EPI) { if (wr == 1) PG8_BAR; }
    }
    PG8_WAIT_V(0);
    if constexpr (!ALIGN_EPI) { if (wr == 0) PG8_BAR; }
    PG8_BAR;
    if constexpr (Epi::AFTER_DRAIN) { E.fused(acc, cur, wr, wc, fr, fq, lds, wid, lane); S.done(cur); }
#undef PG8_SA
#undef PG8_SB
#undef PG8_STAGE
#undef PG8_LDA
#undef PG8_LDB
#undef PG8_MMA
#undef PG8_WAIT_V
#undef PG8_WAIT_L
#undef PG8_BAR
#undef PG8_SCHED
}
}

constexpr int NB = 4, SEQ = 8192, DM = 1024, TT = NB * SEQ;
constexpr int NPROJ = 2816, NPAD = 3072;
constexpr int PC_Q = 0, PC_K = 512, PC_V = 1024, PC_Z = 1536, PC_SQ = 2048, PC_SK = 2560, PC_SV = 2688;
constexpr int NE = 32, NCLS = 112, DE = 256;
constexpr float EPS = 1e-6f;
constexpr int NWAVES = 8, NTHR = 512;
constexpr int N_PHASES = 10;
#ifndef G1_SM
#define G1_SM 31
#endif
#ifndef PROBE_REP
#define PROBE_REP -1
#endif
#ifndef MK_ONE_LAUNCH
#define MK_ONE_LAUNCH 1
#endif

constexpr size_t MiB = 1u << 20;
constexpr size_t WS_CTL = 0, CTL_ZERO_BYTES = 65536;
constexpr size_t WS_MOD = 1 * MiB;
constexpr size_t WS_WINT = 2 * MiB, WS_WOUTT = 8 * MiB, WS_WGUT = 10 * MiB, WS_WDT = 42 * MiB;
constexpr size_t WS_H = 58 * MiB;
constexpr size_t WS_PROJ = 122 * MiB;
constexpr size_t WS_AB = 298 * MiB;
constexpr size_t WS_SSQ = WS_AB;
constexpr size_t WS_MIX = 300 * MiB;
constexpr size_t WS_GSF = 364 * MiB;
constexpr size_t WS_EREC = 404 * MiB, WS_CLIST = 412 * MiB;
constexpr size_t WS_HID = WS_PROJ;
constexpr size_t WS_GAP = WS_H, WS_GQP = WS_H + 32 * MiB;
constexpr size_t WS_GOP = 426 * MiB, WS_GBP = 458 * MiB, WS_GGL = 490 * MiB;
constexpr size_t WS_WRT = 491 * MiB;
constexpr size_t WS_END = 492 * MiB;
constexpr int CW_BAR = 4096, CW_ECNT = 8192, CW_CCNT = 8256;

constexpr int RING_BYTES = 131072, LDSCTL_OFF = RING_BYTES, LDS_BYTES = 147456, MISC_OFF = LDS_BYTES - 128;

#define GAS __attribute__((address_space(1)))
#define LAS __attribute__((address_space(3)))
typedef unsigned short bf16;
typedef unsigned v4u __attribute__((ext_vector_type(4)));
typedef float f32x4 __attribute__((ext_vector_type(4)));
typedef GAS unsigned gu32;
#define RLX_AGENT __ATOMIC_RELAXED, __HIP_MEMORY_SCOPE_AGENT
#define LDS_WAIT() asm volatile("s_waitcnt lgkmcnt(0)" ::: "memory")
__device__ __forceinline__ unsigned f2bf(float f) { unsigned u = __builtin_bit_cast(unsigned, f); return (u + 0x7fffu + ((u >> 16) & 1u)) >> 16; }
__device__ __forceinline__ unsigned pk2(float lo, float hi) { return f2bf(lo) | (f2bf(hi) << 16); }
__device__ __forceinline__ float bf2f(bf16 v) { return __builtin_bit_cast(float, (unsigned)v << 16); }
__device__ __forceinline__ float wave_sum(float v) {
#pragma unroll
    for (int o = 1; o < 64; o <<= 1) v += __shfl_xor(v, o);
    return v;
}
__device__ __forceinline__ float siluf(float y) { return y / (1.f + __expf(-y)); }
#define XB_TMO      128
#define XB_XCNT(j)  (256  + 64 * (j))
#define XB_XSUB(j)  (1280 + 64 * (j))
#define XB_XGEN(j)  (2304 + 64 * (j))
#define XB_TOP      3328
#define XB_TOPGEN   3392
#define XCD_BAR_WORDS 3456
#define XB_SPIN_CAP (1u << 18)
__device__ __forceinline__ unsigned xb_ld(unsigned* p)              { return __hip_atomic_load(p, __ATOMIC_RELAXED, __HIP_MEMORY_SCOPE_AGENT); }
__device__ __forceinline__ unsigned xb_add(unsigned* p, unsigned v) { return __hip_atomic_fetch_add(p, v, __ATOMIC_RELAXED, __HIP_MEMORY_SCOPE_AGENT); }
__device__ __forceinline__ unsigned xb_xcc_id() { return (unsigned)__builtin_amdgcn_s_getreg((3 << 11) | 20) & 0xFu; }
#define XB_SPIN(cond, bar) do { unsigned _sp = 0; while (cond) { __builtin_amdgcn_s_sleep(1); \
    if ((++_sp & 255u) == 0u) { if (xb_ld(&(bar)[XB_TMO])) break; if (_sp > XB_SPIN_CAP) { atomicAdd(&(bar)[XB_TMO], 1u); break; } } } } while (0)

struct XcdBarrier {
    unsigned* bar; unsigned x;
    volatile LAS unsigned* st;
};

__device__ __forceinline__ XcdBarrier xcd_barrier_post(unsigned* bar, volatile LAS unsigned* st, bool leader  ) {
    XcdBarrier b; b.bar = bar; b.x = xb_xcc_id(); b.st = st;
    if (leader) (void)xb_add(&bar[XB_XCNT(b.x)], 1u);
    return b;
}
__device__ __forceinline__ void xcd_barrier_complete(unsigned* bar, unsigned x, unsigned& nloc, unsigned& nx) {
    const unsigned G = gridDim.x * gridDim.y * gridDim.z;
    unsigned sum, cnt, mine, sp = 0u;
    for (;;) {
        sum = 0u; cnt = 0u; mine = 0u;
#pragma unroll
        for (unsigned j = 0; j < 16; ++j) { const unsigned c = xb_ld(&bar[XB_XCNT(j)]); sum += c; cnt += (c > 0u) ? 1u : 0u; mine = (j == x) ? c : mine; }
        if (sum == G) break;
        __builtin_amdgcn_s_sleep(1);
        if ((++sp & 255u) == 0u) { if (xb_ld(&bar[XB_TMO])) break; if (sp > XB_SPIN_CAP) { atomicAdd(&bar[XB_TMO], 1u); break; } }
    }
    nloc = mine > 0u ? mine : 1u; nx = cnt > 0u ? cnt : 1u;
}

__device__ __forceinline__ void xcd_barrier(const XcdBarrier& b, bool leader  ) {
    asm volatile("s_waitcnt vmcnt(0)" ::: "memory");
    __syncthreads();
    if (leader) {
        unsigned* bar = b.bar;
        __builtin_amdgcn_s_waitcnt(0);
        unsigned nloc = b.st[0], nx = b.st[1];
        if (nloc == 0u) { xcd_barrier_complete(bar, b.x, nloc, nx); b.st[0] = nloc; b.st[1] = nx; }
        const unsigned old = xb_add(&bar[XB_XSUB(b.x)], 1u);
        const unsigned gen = old / nloc;
        if (old + 1u == (gen + 1u) * nloc) {
            __builtin_amdgcn_fence(__ATOMIC_RELEASE, "agent");
            asm volatile("s_waitcnt vmcnt(0)" ::: "memory");
            const unsigned og = xb_add(&bar[XB_TOP], 1u);
            const unsigned tg = og / nx;
            if (og + 1u == (tg + 1u) * nx) xb_add(&bar[XB_TOPGEN], 1u);
            else XB_SPIN(xb_ld(&bar[XB_TOPGEN]) == tg, bar);
            __builtin_amdgcn_fence(__ATOMIC_ACQUIRE, "agent");
            xb_add(&bar[XB_XGEN(b.x)], 1u);
            asm volatile("s_waitcnt vmcnt(0)" ::: "memory");
        } else {
            XB_SPIN(xb_ld(&bar[XB_XGEN(b.x)]) == gen, bar);
            __builtin_amdgcn_fence(__ATOMIC_ACQUIRE, "agent");
            asm volatile("s_waitcnt vmcnt(0)" ::: "memory");
        }
    }
    __syncthreads();
}

struct Args { const void* in[23]; float* out; unsigned char* ws; int ph_lo, ph_hi; };
enum { I_X = 0, I_C, I_POS, I_WADA, I_BADA, I_NORM_MIX, I_WIN, I_CONVW, I_ALOG, I_DTB, I_GNORM, I_QNORM, I_KNORM, I_SINKS, I_WOUT, I_NORM_FFN, I_WGRP, I_BGRP, I_WRT, I_BRT, I_WGATE, I_WUP, I_WDOWN };

template <class CM>
__device__ __forceinline__ void transpose_item(const float* W, int ldw, int k0, bf16* WT, int ldt, int n0, CM cm, LAS float* scr, int lane) {
    const int sc = cm(n0 + (lane & 31));
    float tv[32];
#pragma unroll
    for (int i = 0; i < 32; ++i) { const int kk = 2 * i + (lane >> 5); tv[i] = W[(size_t)(k0 + kk) * ldw + (sc >= 0 ? sc : 0)]; }
#pragma unroll
    for (int i = 0; i < 32; ++i) { const int kk = 2 * i + (lane >> 5); scr[kk * 33 + (lane & 31)] = sc >= 0 ? tv[i] : 0.f; }
    LDS_WAIT(); asm volatile("" ::: "memory");
    const int c = lane & 7;
#pragma unroll
    for (int j = 0; j < 4; ++j) { const int n = (lane >> 3) + 8 * j; const LAS float* s = scr + (8 * c) * 33 + n;
        v4u o; o.x = pk2(s[0 * 33], s[1 * 33]); o.y = pk2(s[2 * 33], s[3 * 33]); o.z = pk2(s[4 * 33], s[5 * 33]); o.w = pk2(s[6 * 33], s[7 * 33]);
        *(v4u*)(WT + (size_t)(n0 + n) * ldt + k0 + 8 * c) = o; }
    LDS_WAIT(); asm volatile("" ::: "memory");
}
struct CmIn { __device__ __forceinline__ int operator()(int n) const { return n < 2048 ? n : (n < 2816 ? n + 16 : (n < 2832 ? 2048 + (n - 2816) : -1)); } };
struct CmOff { int off; __device__ __forceinline__ int operator()(int n) const { return n + off; } };
struct CmId { __device__ __forceinline__ int operator()(int n) const { return n; } };

__device__ __forceinline__ void expert_weight_copy(const Args& A, LAS unsigned char* lds, int lane, int wave) {
    unsigned char* ws = A.ws;
    LAS float* scr = (LAS float*)(lds + wave * 8448);
    const int G = gridDim.x, gw = blockIdx.x * NWAVES + wave, NGW = G * NWAVES;
    {   constexpr int IT_GU = NE * 16 * 16, IT_D = NE * 32 * 4;
        const float* wgate = (const float*)A.in[I_WGATE]; const float* wup = (const float*)A.in[I_WUP]; const float* wdown = (const float*)A.in[I_WDOWN];
        for (int it = gw; it < IT_GU + IT_D; it += NGW) {
            if (it < IT_GU) { const int e = it >> 8, r = it & 255, nb = r & 15, kb = r >> 4, j = nb >> 3, q = nb & 7;
                const float* W = (q < 4 ? wgate : wup) + (size_t)e * 1024 * 256; const int col0 = j * 128 + (q & 3) * 32;
                transpose_item(W, 256, kb * 64, (bf16*)(ws + WS_WGUT) + (size_t)e * 512 * 1024, 1024, nb * 32, CmOff{col0 - nb * 32}, scr, lane); }
            else { const int r2 = it - IT_GU, e = r2 >> 7, r = r2 & 127, nb = r & 31, kb = r >> 5;
                transpose_item(wdown + (size_t)e * 256 * 1024, 1024, kb * 64, (bf16*)(ws + WS_WDT) + (size_t)e * 1024 * 256, 256, nb * 32, CmId(), scr, lane); }
        }
    }
}
__device__ __forceinline__ void p0_prologue(const Args& A, LAS unsigned char* lds, int tid, int lane, int wave) {
    unsigned char* ws = A.ws;
    LAS float* scr = (LAS float*)(lds + wave * 8448);
    const int G = gridDim.x, gw = blockIdx.x * NWAVES + wave, NGW = G * NWAVES;
    constexpr int IT_IN = (NPAD / 32) * (DM / 64), IT_OUT = (DM / 32) * (DM / 64);
    for (int it = gw; it < IT_IN + IT_OUT; it += NGW) {
        if (it < IT_IN) { const int nb = it % (NPAD / 32), kb = it / (NPAD / 32); transpose_item((const float*)A.in[I_WIN], 2832, kb * 64, (bf16*)(ws + WS_WINT), DM, nb * 32, CmIn(), scr, lane); }
        else { const int r = it - IT_IN, nb = r % (DM / 32), kb = r / (DM / 32); transpose_item((const float*)A.in[I_WOUT], DM, kb * 64, (bf16*)(ws + WS_WOUTT), DM, nb * 32, CmId(), scr, lane); }
    }
    {   const float* wgp = (const float*)A.in[I_WGRP]; const float* wrt = (const float*)A.in[I_WRT];
        bf16* wf = (bf16*)(ws + WS_WRT);
        for (int idx = blockIdx.x * NTHR + tid; idx < 48 * 1024; idx += G * NTHR) { const int j = idx & 7, ln = (idx >> 3) & 63, ks = (idx >> 9) & 31, nt = idx >> 14;
            const int o = 16 * nt + (ln & 15), k = 32 * ks + 8 * (ln >> 4) + j;
            const float w = o < 4 ? wgp[k * 4 + o] : (o < 36 ? wrt[k * 32 + o - 4] : 0.f);
            const unsigned hb = f2bf(w); wf[idx] = (bf16)hb; wf[48 * 1024 + idx] = (bf16)f2bf(w - __builtin_bit_cast(float, hb << 16)); }
    }
    LAS float* cact = (LAS float*)(lds + 69632);
    LAS float* red = (LAS float*)(lds + 69632 + 16384);
    const float* c = (const float*)A.in[I_C]; const float* wada = (const float*)A.in[I_WADA]; const float* bada = (const float*)A.in[I_BADA];
    float* mod = (float*)(ws + WS_MOD);
    if ((int)blockIdx.x < 192) {
        __syncthreads();
        for (int i = tid; i < 4096; i += NTHR) cact[i] = siluf(c[i]);
        __syncthreads();
        for (int u = blockIdx.x; u < 192; u += G) {
            const int n = u * 32 + (lane & 31), kh = lane >> 5; float a0 = 0.f, a1 = 0.f, a2 = 0.f, a3 = 0.f;
#pragma unroll 16
            for (int i = 0; i < 64; ++i) { const int k = wave * 128 + 2 * i + kh; const float w = wada[(size_t)k * 6144 + n]; a0 += cact[k] * w; a1 += cact[1024 + k] * w; a2 += cact[2048 + k] * w; a3 += cact[3072 + k] * w; }
            a0 += __shfl_xor(a0, 32); a1 += __shfl_xor(a1, 32); a2 += __shfl_xor(a2, 32); a3 += __shfl_xor(a3, 32);
            if (lane < 32) { red[(wave * 4 + 0) * 64 + lane] = a0; red[(wave * 4 + 1) * 64 + lane] = a1; red[(wave * 4 + 2) * 64 + lane] = a2; red[(wave * 4 + 3) * 64 + lane] = a3; }
            __syncthreads();
            if (tid < 128) { const int b = tid >> 5, l = tid & 31; float s = bada[u * 32 + l];
#pragma unroll
                for (int w = 0; w < 8; ++w) s += red[(w * 4 + b) * 64 + l];
                mod[b * 6144 + u * 32 + l] = s; }
            __syncthreads();
        }
    }
}

template <bool ROUTE>
__device__ __forceinline__ void norm_rows(const Args& A, const float* X, const float* gain, const float* shift, const float* scale, bf16* H, LAS unsigned char* lds, int lane, int wave) {
    LAS float* hl = (LAS float*)(lds + wave * 4096);
    const int G = gridDim.x, gw = blockIdx.x * NWAVES + wave, NGW = G * NWAVES;
    unsigned char* ws = A.ws;
    for (int r0 = gw * 16; r0 < TT; r0 += NGW * 16) {
        const int b = r0 / SEQ;
        f32x4 mf[4], af[4];
#pragma unroll
        for (int j = 0; j < 4; ++j) { const int col = 4 * lane + 256 * j; const f32x4 g = *(const f32x4*)(gain + col), sc = *(const f32x4*)(scale + b * 6144 + col);
            mf[j] = g * (sc + 1.0f); af[j] = *(const f32x4*)(shift + b * 6144 + col); }
#pragma unroll 4
        for (int i = 0; i < 16; ++i) {
            const int row = r0 + i;
            const f32x4* xr = (const f32x4*)(X + (size_t)row * DM) + lane;
            f32x4 v[4]; float s = 0.f;
#pragma unroll
            for (int j = 0; j < 4; ++j) { v[j] = xr[64 * j]; s += (v[j].x * v[j].x + v[j].y * v[j].y) + (v[j].z * v[j].z + v[j].w * v[j].w); }
            const float rstd = 1.f / sqrtf(wave_sum(s) * (1.f / DM) + EPS);
            unsigned long long* o8 = (unsigned long long*)(H + (size_t)row * DM) + lane;
#pragma unroll
            for (int j = 0; j < 4; ++j) { v[j] = v[j] * rstd * mf[j] + af[j];
                o8[64 * j] = (unsigned long long)pk2(v[j].x, v[j].y) | ((unsigned long long)pk2(v[j].z, v[j].w) << 32); }
            if constexpr (ROUTE) {
                const float* wg = (const float*)A.in[I_WGRP]; const float* wr = (const float*)A.in[I_WRT];
                float lg[36];
#pragma unroll
                for (int o = 0; o < 36; ++o) lg[o] = 0.f;
#pragma unroll
                for (int j = 0; j < 4; ++j) *(LAS f32x4*)(hl + 4 * lane + 256 * j) = v[j];
                LDS_WAIT(); asm volatile("" ::: "memory");
#pragma unroll 1
                for (int ii = 0; ii < 16; ++ii) { const int k = lane + 64 * ii; const float hv = hl[k];
                    const f32x4 g4 = *(const f32x4*)(wg + k * 4);
                    lg[0] += hv * g4.x; lg[1] += hv * g4.y; lg[2] += hv * g4.z; lg[3] += hv * g4.w;
#pragma unroll
                    for (int q = 0; q < 8; ++q) { const f32x4 r4 = *(const f32x4*)(wr + k * 32 + q * 4);
                        lg[4 + q * 4 + 0] += hv * r4.x; lg[4 + q * 4 + 1] += hv * r4.y; lg[4 + q * 4 + 2] += hv * r4.z; lg[4 + q * 4 + 3] += hv * r4.w; } }
                LDS_WAIT(); asm volatile("" ::: "memory");
#pragma unroll
                for (int o = 0; o < 36; ++o) lg[o] = wave_sum(lg[o]);
                const float* bg = (const float*)A.in[I_BGRP]; const float* br = (const float*)A.in[I_BRT];
#pragma unroll
                for (int o = 0; o < 4; ++o) lg[o] += bg[o];
#pragma unroll
                for (int o = 0; o < 32; ++o) lg[4 + o] += br[o];
                int gi = 0; float gm = lg[0];
#pragma unroll
                for (int o = 1; o < 4; ++o) if (lg[o] > gm) { gm = lg[o]; gi = o; }
                float gs = 0.f;
#pragma unroll
                for (int o = 0; o < 4; ++o) gs += __expf(lg[o] - gm);
                const float pg = 1.f / gs;
                float le[8];
#pragma unroll
                for (int j = 0; j < 8; ++j) { le[j] = lg[4 + j];
#pragma unroll
                    for (int g = 1; g < 4; ++g) le[j] = (gi == g) ? lg[4 + g * 8 + j] : le[j]; }
                int j1 = 0; float m1 = le[0];
#pragma unroll
                for (int j = 1; j < 8; ++j) if (le[j] > m1) { m1 = le[j]; j1 = j; }
                int j2 = -1; float m2 = -3.0e38f;
#pragma unroll
                for (int j = 0; j < 8; ++j) if (j != j1 && le[j] > m2) { m2 = le[j]; j2 = j; }
                const float ex = __expf(m2 - m1), w1 = pg / (1.f + ex), w2 = pg * ex / (1.f + ex);
                if (lane == 0) {
                    const int e1 = gi * 8 + j1, e2 = gi * 8 + j2;
                    unsigned* ctl = (unsigned*)(ws + WS_CTL);
                    int2* erec = (int2*)(ws + WS_EREC); int* clist = (int*)(ws + WS_CLIST);
                    const unsigned p1 = atomicAdd(ctl + CW_ECNT + e1, 1u); erec[(size_t)e1 * TT + p1] = make_int2(row * 2 + (e1 > e2 ? 1 : 0), __builtin_bit_cast(int, w1));
                    const unsigned p2 = atomicAdd(ctl + CW_ECNT + e2, 1u); erec[(size_t)e2 * TT + p2] = make_int2(row * 2 + (e2 > e1 ? 1 : 0), __builtin_bit_cast(int, w2));
                    const int a = j1 < j2 ? j1 : j2, bb = j1 < j2 ? j2 : j1;
                    const int cls = gi * 28 + (a * 7 - (a * (a - 1)) / 2 + (bb - a - 1));
                    const unsigned pc = atomicAdd(ctl + CW_CCNT + cls, 1u); clist[(size_t)cls * TT + pc] = row;
                }
            }
        }
    }
}

typedef short bf16x8_t __attribute__((ext_vector_type(8)));
typedef float f32x16 __attribute__((ext_vector_type(16)));
typedef unsigned v2u __attribute__((ext_vector_type(2)));
typedef float f32x2_t __attribute__((ext_vector_type(2)));
typedef __bf16 bf16x2_t __attribute__((ext_vector_type(2)));
__device__ __forceinline__ unsigned cvtpk(float lo, float hi) { const f32x2_t f = {lo, hi}; return __builtin_bit_cast(unsigned, __builtin_convertvector(f, bf16x2_t)); }
__device__ __forceinline__ void fast_sincos(float ang, float& sn, float& cs) {
    float rev = ang * 0.15915494309189535f; rev -= floorf(rev);
    sn = __builtin_amdgcn_sinf(rev); cs = __builtin_amdgcn_cosf(rev);
}
__device__ __forceinline__ void swa_mfma(const Args& A, LAS unsigned char* lds, int tid, int lane, int wave, int blk, int nblk) {
    unsigned char* ws = A.ws;
    const bf16* proj = (const bf16*)(ws + WS_PROJ);
    bf16* mix = (bf16*)(ws + WS_MIX); const float* sinks = (const float*)A.in[I_SINKS];
    const int* pos = (const int*)A.in[I_POS]; const float* qn = (const float*)A.in[I_QNORM]; const float* kn = (const float*)A.in[I_KNORM];
    constexpr int KST = 144, VST = 520;
    LAS unsigned char* Kl = lds; LAS unsigned char* Vt = lds + 256 * KST;
    const int g = wave >> 1, qh = wave & 1, ql = lane & 31, hh = lane >> 5;
    constexpr float LOG2E = 1.4426950408889634f, CS = 0.125f * LOG2E, L2T = 13.287712379549449f / 32.f;
    const int sch = tid & 7;
    float kinv[8], kgn[8];
#pragma unroll
    for (int j = 0; j < 8; ++j) { kinv[j] = __builtin_amdgcn_exp2f(-(float)((sch & 3) * 8 + j) * L2T); kgn[j] = kn[sch * 8 + j]; }
    float qinv[2][8];
#pragma unroll
    for (int ks = 0; ks < 2; ++ks)
#pragma unroll
        for (int j = 0; j < 8; ++j) qinv[ks][j] = __builtin_amdgcn_exp2f(-(float)(ks * 16 + hh * 8 + j) * L2T);
    for (int u = blk; u < NB * 2 * (SEQ / 128); u += nblk) {
        const int n = u & 63, kvh = (u >> 6) & 1, b = u >> 7;
        const int tb = b * SEQ + n * 128;
        __syncthreads();
#pragma unroll
        for (int it = 0; it < 4; ++it) { const int idx = tid + it * NTHR, key = idx >> 3, ch = idx & 7; int tk = tb - 128 + key; if (tk < b * SEQ) tk = b * SEQ;
            const v4u kv = *(const v4u*)(proj + (size_t)tk * NPROJ + PC_SK + kvh * 64 + ch * 8);
            const v4u vv = *(const v4u*)(proj + (size_t)tk * NPROJ + PC_SV + kvh * 64 + ch * 8);
            const float pf = (float)pos[tk];
            float x[8] = { __builtin_bit_cast(float, kv.x << 16), __builtin_bit_cast(float, kv.x & 0xffff0000u), __builtin_bit_cast(float, kv.y << 16), __builtin_bit_cast(float, kv.y & 0xffff0000u),
                           __builtin_bit_cast(float, kv.z << 16), __builtin_bit_cast(float, kv.z & 0xffff0000u), __builtin_bit_cast(float, kv.w << 16), __builtin_bit_cast(float, kv.w & 0xffff0000u) };
            float ss = 0.f;
#pragma unroll
            for (int j = 0; j < 8; ++j) ss += x[j] * x[j];
            ss += __shfl_xor(ss, 1); ss += __shfl_xor(ss, 2); ss += __shfl_xor(ss, 4);
            const float rn = 1.f / sqrtf(ss * (1.f / 64.f) + EPS);
            float o[8];
#pragma unroll
            for (int j = 0; j < 8; ++j) { const float xn = x[j] * rn * kgn[j]; const float pr = __shfl_xor(xn, 4); float sn, cs; fast_sincos(pf * kinv[j], sn, cs);
                o[j] = (ch < 4) ? xn * cs - pr * sn : pr * sn + xn * cs; }
            v4u ko; ko.x = cvtpk(o[0], o[1]); ko.y = cvtpk(o[2], o[3]); ko.z = cvtpk(o[4], o[5]); ko.w = cvtpk(o[6], o[7]);
            *(LAS v4u*)(Kl + key * KST + ch * 16) = ko;
            LAS unsigned short* vp = (LAS unsigned short*)(Vt + (ch * 8) * VST + key * 2);
            vp[0 * (VST / 2)] = (unsigned short)(vv.x & 0xffffu); vp[1 * (VST / 2)] = (unsigned short)(vv.x >> 16);
            vp[2 * (VST / 2)] = (unsigned short)(vv.y & 0xffffu); vp[3 * (VST / 2)] = (unsigned short)(vv.y >> 16);
            vp[4 * (VST / 2)] = (unsigned short)(vv.z & 0xffffu); vp[5 * (VST / 2)] = (unsigned short)(vv.z >> 16);
            vp[6 * (VST / 2)] = (unsigned short)(vv.w & 0xffffu); vp[7 * (VST / 2)] = (unsigned short)(vv.w >> 16); }
        __syncthreads();
        const int hq = kvh * 4 + g; const float sinkl = sinks[hq] * LOG2E;
#pragma unroll 1
        for (int qt = 0; qt < 2; ++qt) {
            const int i0 = qh * 64 + qt * 32, iq = i0 + ql;
            const size_t tq = (size_t)(tb + iq);
            bf16x8_t qf[4];
            {   float xq[4][8]; float ss = 0.f;
#pragma unroll
                for (int ks = 0; ks < 4; ++ks) { const v4u r = *(const v4u*)(proj + tq * NPROJ + PC_SQ + hq * 64 + ks * 16 + hh * 8);
                    xq[ks][0] = __builtin_bit_cast(float, r.x << 16); xq[ks][1] = __builtin_bit_cast(float, r.x & 0xffff0000u); xq[ks][2] = __builtin_bit_cast(float, r.y << 16); xq[ks][3] = __builtin_bit_cast(float, r.y & 0xffff0000u);
                    xq[ks][4] = __builtin_bit_cast(float, r.z << 16); xq[ks][5] = __builtin_bit_cast(float, r.z & 0xffff0000u); xq[ks][6] = __builtin_bit_cast(float, r.w << 16); xq[ks][7] = __builtin_bit_cast(float, r.w & 0xffff0000u);
#pragma unroll
                    for (int j = 0; j < 8; ++j) ss += xq[ks][j] * xq[ks][j]; }
                ss += __shfl_xor(ss, 32);
                const float rn = 1.f / sqrtf(ss * (1.f / 64.f) + EPS); const float pf = (float)pos[tq];
#pragma unroll
                for (int ks = 0; ks < 4; ++ks)
#pragma unroll
                    for (int j = 0; j < 8; ++j) xq[ks][j] *= rn * qn[ks * 16 + hh * 8 + j];
#pragma unroll
                for (int ks = 0; ks < 2; ++ks)
#pragma unroll
                    for (int j = 0; j < 8; ++j) { float sn, cs; fast_sincos(pf * qinv[ks][j], sn, cs); const float x1 = xq[ks][j], x2 = xq[ks + 2][j];
                        xq[ks][j] = x1 * cs - x2 * sn; xq[ks + 2][j] = x1 * sn + x2 * cs; }
#pragma unroll
                for (int ks = 0; ks < 4; ++ks) { union { bf16x8_t v; unsigned u[4]; } p; p.u[0] = cvtpk(xq[ks][0], xq[ks][1]); p.u[1] = cvtpk(xq[ks][2], xq[ks][3]); p.u[2] = cvtpk(xq[ks][4], xq[ks][5]); p.u[3] = cvtpk(xq[ks][6], xq[ks][7]); qf[ks] = p.v; }
            }
            f32x16 sc[5];
#pragma unroll
            for (int kt = 0; kt < 5; ++kt) { f32x16 acc;
#pragma unroll
                for (int r = 0; r < 16; ++r) acc[r] = 0.f;
#pragma unroll
                for (int ks = 0; ks < 4; ++ks) { const bf16x8_t kf = *(const LAS bf16x8_t*)(Kl + (i0 + 32 * kt + ql) * KST + (ks * 16 + hh * 8) * 2);
                    acc = __builtin_amdgcn_mfma_f32_32x32x16_bf16(kf, qf[ks], acc, 0, 0, 0); }
                sc[kt] = acc; }
            float mloc = -3.0e38f;
#pragma unroll
            for (int kt = 0; kt < 5; ++kt) {
                if (kt == 0 || kt == 4 || n == 0) {
#pragma unroll
                    for (int r = 0; r < 16; ++r) { const int j = i0 + 32 * kt + (r & 3) + 8 * (r >> 2) + 4 * hh;
                        const bool valid = (j > iq) && (j <= iq + 128) && (n > 0 || j >= 128);
                        const float sv = valid ? sc[kt][r] * CS : -1.0e30f; sc[kt][r] = sv; mloc = fmaxf(mloc, sv); }
                } else {
#pragma unroll
                    for (int r = 0; r < 16; ++r) { const float sv = sc[kt][r] * CS; sc[kt][r] = sv; mloc = fmaxf(mloc, sv); }
                } }
            float mx = fmaxf(mloc, __shfl_xor(mloc, 32)); mx = fmaxf(mx, sinkl);
            float lsum = 0.f;
#pragma unroll
            for (int kt = 0; kt < 5; ++kt)
#pragma unroll
                for (int r = 0; r < 16; ++r) { const float p = __builtin_amdgcn_exp2f(sc[kt][r] - mx); sc[kt][r] = p; lsum += p; }
            lsum += __shfl_xor(lsum, 32); lsum += __builtin_amdgcn_exp2f(sinkl - mx);
            f32x16 o0, o1;
#pragma unroll
            for (int r = 0; r < 16; ++r) { o0[r] = 0.f; o1[r] = 0.f; }
#pragma unroll
            for (int kt = 0; kt < 5; ++kt)
#pragma unroll
                for (int s2 = 0; s2 < 2; ++s2) {
                    union { bf16x8_t v; unsigned u[4]; } pf;
#pragma unroll
                    for (int p = 0; p < 4; ++p) pf.u[p] = cvtpk(sc[kt][8 * s2 + 2 * p], sc[kt][8 * s2 + 2 * p + 1]);
                    const int jb = i0 + 32 * kt + 16 * s2 + 4 * hh;
                    union { bf16x8_t v; v2u u[2]; } v0, v1;
                    const LAS unsigned char* r0 = Vt + ql * VST + jb * 2; const LAS unsigned char* r1 = Vt + (32 + ql) * VST + jb * 2;
                    v0.u[0] = *(const LAS v2u*)(r0); v0.u[1] = *(const LAS v2u*)(r0 + 16);
                    v1.u[0] = *(const LAS v2u*)(r1); v1.u[1] = *(const LAS v2u*)(r1 + 16);
                    o0 = __builtin_amdgcn_mfma_f32_32x32x16_bf16(v0.v, pf.v, o0, 0, 0, 0);
                    o1 = __builtin_amdgcn_mfma_f32_32x32x16_bf16(v1.v, pf.v, o1, 0, 0, 0);
                }
            const float il = 1.f / lsum;
            bf16* op = mix + tq * DM + 512 + hq * 64 + 4 * hh;
#pragma unroll
            for (int rq = 0; rq < 4; ++rq) {
                v2u w0; w0.x = cvtpk(o0[4 * rq] * il, o0[4 * rq + 1] * il); w0.y = cvtpk(o0[4 * rq + 2] * il, o0[4 * rq + 3] * il);
                *(v2u*)(op + 8 * rq) = w0;
                v2u w1; w1.x = cvtpk(o1[4 * rq] * il, o1[4 * rq + 1] * il); w1.y = cvtpk(o1[4 * rq + 2] * il, o1[4 * rq + 3] * il);
                *(v2u*)(op + 32 + 8 * rq) = w1; }
        }
    }
}

__device__ __forceinline__ int frag_a_idx(int row, int col) { const int mt = row >> 4, l15 = row & 15, ks = col >> 5, x = col & 31, jh = x >> 4, g4 = (x >> 2) & 3, jl = x & 3; return ((mt * 2 + ks) * 64 + g4 * 16 + l15) * 8 + 4 * jh + jl; }
__device__ __forceinline__ int frag_c_idx(int row, int col) { const int w = col >> 4, l15 = col & 15, mt = row >> 4, y = row & 15, g4 = y >> 2, i = y & 3; return ((w * 64 + g4 * 16 + l15) * 4 + mt) * 4 + i; }
__device__ __forceinline__ void gdn_g1_naive(const Args& A, LAS float* L, int tid) {
    unsigned char* ws = A.ws;
    const bf16* proj = (const bf16*)(ws + WS_PROJ); const float* ab = (const float*)(ws + WS_AB);
    bf16* AP = (bf16*)(ws + WS_GAP); bf16* BP = (bf16*)(ws + WS_GBP); bf16* QP = (bf16*)(ws + WS_GQP); bf16* OP = (bf16*)(ws + WS_GOP); float* GL = (float*)(ws + WS_GGL);
    const float* convw = (const float*)A.in[I_CONVW];
    constexpr int LD = 65, AR = 64 * LD;
    LAS float* q = L; LAS float* k = q + AR; LAS float* v = k + AR; LAS float* Mm = v + AR; LAS float* At = Mm + AR; LAS float* w = At + AR;
    LAS float* Gc = w + AR; LAS float* beta = Gc + 64;
    const int i8 = tid >> 3, e0 = (tid & 7) * 8;
    for (int cid = blockIdx.x; cid < NB * 8 * 128; cid += gridDim.x) {
        const int n = cid & 127, bh = cid >> 7, b = bh >> 3, h = bh & 7;
        const float Ah = expf(((const float*)A.in[I_ALOG])[h]), dtb = ((const float*)A.in[I_DTB])[h];
        const int t0 = b * SEQ + n * 64;
        __syncthreads();
        for (int idx = tid; idx < 3 * 4096; idx += NTHR) {
            const int part = idx >> 12, rem = idx & 4095, i = rem >> 6, d = rem & 63, c = part * 512 + h * 64 + d;
            float y = 0.f;
#pragma unroll
            for (int j = 0; j < 4; ++j) { const int s = n * 64 + i - 3 + j; if (s >= 0) y += convw[j * 1536 + c] * bf2f(proj[(size_t)(b * SEQ + s) * NPROJ + c]); }
            y = y / (1.f + __expf(-y));
            (part == 0 ? q : (part == 1 ? k : v))[i * LD + d] = y;
        }
        if (tid < 64) { const float a = ab[(size_t)(t0 + tid) * 16 + h], bb = ab[(size_t)(t0 + tid) * 16 + 8 + h]; const float xx = a + dtb;
            const float sp = xx > 20.f ? xx : log1pf(expf(xx)); Gc[tid] = -Ah * sp; beta[tid] = 1.f / (1.f + __expf(-bb)); }
        __syncthreads();
        if (tid < 128) { LAS float* arr = tid < 64 ? q : k; const int i = tid & 63; float ss = 0.f;
            for (int d = 0; d < 64; ++d) ss += arr[i * LD + d] * arr[i * LD + d];
            const float r = (1.f / sqrtf(ss + EPS)) * (tid < 64 ? 0.125f : 1.f);
            for (int d = 0; d < 64; ++d) arr[i * LD + d] *= r; }
        if (tid == 128) { float run = 0.f; for (int i = 0; i < 64; ++i) { run += Gc[i]; Gc[i] = run; } }
        __syncthreads();
        {   const int i = i8;
            for (int jj = 0; jj < 8; ++jj) { const int j = e0 + jj; float dq = 0.f, dk = 0.f;
_Pragma("unroll 2") for (int d = 0; d < 64; ++d) { const float kj = k[j * LD + d]; dq += q[i * LD + d] * kj; dk += k[i * LD + d] * kj; }
                const float dec = (i >= j) ? __expf(Gc[i] - Gc[j]) : 0.f;
                At[i * LD + j] = dq * dec; Mm[i * LD + j] = (i > j) ? dk * beta[i] * dec : 0.f; }
        }
        __syncthreads();
        for (int idx = tid; idx < 4096; idx += NTHR) { const int i = idx >> 6, d = idx & 63; v[i * LD + d] *= beta[i]; w[i * LD + d] = k[i * LD + d] * beta[i] * __expf(Gc[i]); }
        __syncthreads();
        if (tid < 128) { LAS float* arr = tid < 64 ? v : w; const int c = tid & 63;
            _Pragma("unroll 1") for (int i = 1; i < 64; ++i) { float a = arr[i * LD + c]; _Pragma("unroll 4") for (int j = 0; j < i; ++j) a -= Mm[i * LD + j] * arr[j * LD + c]; arr[i * LD + c] = a; } }
        __syncthreads();
        const float gl = Gc[63];
        const size_t cb = (size_t)cid * 4096;
        {
            const int d = i8; float a[8], bq[8];
#pragma unroll
            for (int ee = 0; ee < 8; ++ee) { a[ee] = 0.f; bq[ee] = 0.f; }
_Pragma("unroll 2")
            for (int c = 0; c < 64; ++c) { const float kd = k[c * LD + d] * __expf(gl - Gc[c]);
#pragma unroll
                for (int ee = 0; ee < 8; ++ee) { a[ee] -= kd * w[c * LD + e0 + ee]; bq[ee] += kd * v[c * LD + e0 + ee]; } }
#pragma unroll
            for (int ee = 0; ee < 8; ++ee) { const int dp = e0 + ee; AP[cb + frag_a_idx(d, dp)] = (bf16)f2bf(a[ee]); BP[cb + frag_c_idx(d, dp)] = (bf16)f2bf(bq[ee]); }
        }
        {
            const int c = i8; float a[8], bq[8]; const float eg = __expf(Gc[c]);
#pragma unroll
            for (int ee = 0; ee < 8; ++ee) { a[ee] = eg * q[c * LD + e0 + ee]; bq[ee] = 0.f; }
_Pragma("unroll 2")
            for (int s2 = 0; s2 <= c; ++s2) { const float av = At[c * LD + s2];
#pragma unroll
                for (int ee = 0; ee < 8; ++ee) { a[ee] -= av * w[s2 * LD + e0 + ee]; bq[ee] += av * v[s2 * LD + e0 + ee]; } }
#pragma unroll
            for (int ee = 0; ee < 8; ++ee) { const int dp = e0 + ee; QP[cb + frag_a_idx(c, dp)] = (bf16)f2bf(a[ee]); OP[cb + frag_c_idx(c, dp)] = (bf16)f2bf(bq[ee]); }
        }
        if (tid == 0) GL[cid] = __expf(gl);
    }
}
__device__ __forceinline__ float wave_incl_scan_f(float v, int lane) {
#pragma unroll
    for (int o = 1; o < 64; o <<= 1) { const float t = __shfl_up(v, o); if (lane >= o) v += t; }
    return v;
}
__device__ __forceinline__ v2u pack4(f32x4 v) { v2u r; r.x = cvtpk(v.x, v.y); r.y = cvtpk(v.z, v.w); return r; }
__device__ __forceinline__ bf16x8_t mk8(v2u lo, v2u hi) { union { bf16x8_t v; unsigned u[4]; } x; x.u[0] = lo.x; x.u[1] = lo.y; x.u[2] = hi.x; x.u[3] = hi.y; return x.v; }
template <int SM, int STG = 7>
__device__ __forceinline__ void gdn_g1_mfma(const Args& A, LAS unsigned char* lds, int tid, int lane, int wave) {
    unsigned char* ws = A.ws;
    const bf16* proj = (const bf16*)(ws + WS_PROJ); const float* ab = (const float*)(ws + WS_AB);
    bf16* AP = (bf16*)(ws + WS_GAP); bf16* BP = (bf16*)(ws + WS_GBP); bf16* QP = (bf16*)(ws + WS_GQP); bf16* OP = (bf16*)(ws + WS_GOP); float* GL = (float*)(ws + WS_GGL);
    const float* convw = (const float*)A.in[I_CONVW];
    constexpr int KST = 144, RST = 68;
    LAS unsigned char* const Kr0 = lds;
    const int l15 = lane & 15, g4 = lane >> 4;
    const v2u zero2 = {0u, 0u};
    const int G = gridDim.x;
    const int ppart = wave >> 1, pt4 = 4 * ((wave & 1) * 8 + (lane >> 3)), pd0 = (lane & 7) * 8;
    v4u xr7[7];
#define G1_PREFETCH(IDX) do { if (wave < 6) { const int h_ = (IDX) & 7, bn_ = (IDX) >> 3, b_ = bn_ >> 7, n_ = bn_ & 127; \
        _Pragma("unroll") for (int r = 0; r < 7; ++r) { const int s_ = n_ * 64 + pt4 - 3 + r, sc_ = s_ < 0 ? 0 : s_; \
            const v4u r_ = *(const v4u*)(proj + (size_t)(b_ * SEQ + sc_) * NPROJ + ppart * 512 + h_ * 64 + pd0); const unsigned m_ = s_ < 0 ? 0u : 0xffffffffu; \
            xr7[r] = (v4u){r_.x & m_, r_.y & m_, r_.z & m_, r_.w & m_}; } } } while (0)
    int hcur = -1;
    constexpr int NC = NB * 8 * 128;
    if ((int)blockIdx.x < NC) G1_PREFETCH((int)blockIdx.x);
    for (int base = blockIdx.x; base < NC; base += 16 * G) {
    {
        LAS float* const GsT0 = (LAS float*)(Kr0 + 91648);
        __syncthreads();
        for (int q = wave; q < 16; q += 8) { const int idx2 = base + q * G;
            if (idx2 < NC) { const int h2 = idx2 & 7, bn2 = idx2 >> 3, b2 = bn2 >> 7, n2 = bn2 & 127;
                const size_t t2 = (size_t)(b2 * SEQ + n2 * 64 + lane) * 16;
                const float Ah = __expf(((const float*)A.in[I_ALOG])[h2]), dtb = ((const float*)A.in[I_DTB])[h2];
                const float xx = ab[t2 + h2] + dtb, bb2 = ab[t2 + 8 + h2];
                const float sp = xx > 20.f ? xx : log1pf(__expf(xx));
                const float Gv = wave_incl_scan_f(-Ah * sp, lane);
                GsT0[q * 64 + lane] = Gv; GsT0[1024 + q * 64 + lane] = 1.f / (1.f + __expf(-bb2));
                if ((SM & 16) && lane == 63) GL[(b2 * 8 + h2) * 128 + n2] = __expf(Gv); } }
    }
#pragma unroll 1
    for (int it = 0; it < 16; ++it) {
        const int idx = base + it * G; if (idx >= NC) break;
        const int h = idx & 7, bn = idx >> 3, b = bn >> 7, n = bn & 127, bh = b * 8 + h, cid = bh * 128 + n;
        const size_t cb = (size_t)cid * 4096;
        int oz = 0; asm volatile("" : "+v"(oz));
        LAS unsigned char* const Kr = Kr0 + oz; LAS unsigned char* const Qr = Kr + 9216; LAS unsigned char* const kdT = Kr + 18432; LAS unsigned char* const Mm = Kr + 27648; LAS unsigned char* const At = Kr + 36864;
        LAS float* const Rt = (LAS float*)(Kr + 46080);
        LAS float* const Md = (LAS float*)(Kr + 80896);
        LAS unsigned char* const Tl = Kr + 86016;
        LAS float* const Gs = (LAS float*)(Kr + 91648) + 64 * it; LAS float* const Bs = Gs + 1024;
        LAS float* const cwl = (LAS float*)(Kr + 88576);
        __syncthreads();
        if (h != hcur) { hcur = h; for (int q = tid; q < 768; q += NTHR) { const int part = q >> 8, j = (q >> 6) & 3, d = q & 63; cwl[q] = convw[j * 1536 + part * 512 + h * 64 + d]; } __syncthreads(); }
        const bool more = (idx + G < NC);
        if (wave < 6) {
            const int d0 = pd0, t4 = pt4, dg = d0 >> 3, swk = dg << 3, swr = (dg & 3) << 3;
            float y[4][8];
            {   float wv[4][8];
#pragma unroll
                for (int j = 0; j < 4; ++j) { const f32x4 w0 = *(const LAS f32x4*)(cwl + (ppart * 4 + j) * 64 + d0), w1 = *(const LAS f32x4*)(cwl + (ppart * 4 + j) * 64 + d0 + 4);
                    wv[j][0] = w0.x; wv[j][1] = w0.y; wv[j][2] = w0.z; wv[j][3] = w0.w; wv[j][4] = w1.x; wv[j][5] = w1.y; wv[j][6] = w1.z; wv[j][7] = w1.w; }
#define G1_XE(r, e) __builtin_bit_cast(float, ((e) & 1) ? (((e) >> 1) == 0 ? xr7[r].x : ((e) >> 1) == 1 ? xr7[r].y : ((e) >> 1) == 2 ? xr7[r].z : xr7[r].w) & 0xffff0000u \
                                                        : (((e) >> 1) == 0 ? xr7[r].x : ((e) >> 1) == 1 ? xr7[r].y : ((e) >> 1) == 2 ? xr7[r].z : xr7[r].w) << 16)
#pragma unroll
                for (int tk = 0; tk < 4; ++tk)
#pragma unroll
                    for (int e = 0; e < 8; ++e) { const float a_ = wv[0][e] * G1_XE(tk, e) + wv[1][e] * G1_XE(tk + 1, e) + wv[2][e] * G1_XE(tk + 2, e) + wv[3][e] * G1_XE(tk + 3, e);
                        y[tk][e] = a_ * __builtin_amdgcn_rcpf(1.f + __expf(-a_)); }
#undef G1_XE
            }
            if (more) G1_PREFETCH(idx + G);
            const f32x4 G4 = *(const LAS f32x4*)(Gs + t4), B4 = *(const LAS f32x4*)(Bs + t4); const float gl = Gs[63];
            if (ppart < 2) {
                float rn[4];
#pragma unroll
                for (int tk = 0; tk < 4; ++tk) { float ss = 0.f;
#pragma unroll
                    for (int e = 0; e < 8; ++e) ss += y[tk][e] * y[tk][e];
                    ss += __shfl_xor(ss, 1); ss += __shfl_xor(ss, 2); ss += __shfl_xor(ss, 4);
                    rn[tk] = (1.f / sqrtf(ss + EPS)) * (ppart == 0 ? 0.125f : 1.f); }
#pragma unroll
                for (int tk = 0; tk < 4; ++tk) {
#pragma unroll
                    for (int e = 0; e < 8; ++e) y[tk][e] *= rn[tk];
                    v4u pk; pk.x = cvtpk(y[tk][0], y[tk][1]); pk.y = cvtpk(y[tk][2], y[tk][3]); pk.z = cvtpk(y[tk][4], y[tk][5]); pk.w = cvtpk(y[tk][6], y[tk][7]);
                    *(LAS v4u*)((ppart == 0 ? Qr : Kr) + (t4 + tk) * KST + d0 * 2) = pk; }
                if (ppart == 1) {
                    const float ek0 = __expf(gl - G4.x), ek1 = __expf(gl - G4.y), ek2 = __expf(gl - G4.z), ek3 = __expf(gl - G4.w);
                    const float bg0 = B4.x * __expf(G4.x), bg1 = B4.y * __expf(G4.y), bg2 = B4.z * __expf(G4.z), bg3 = B4.w * __expf(G4.w);
#pragma unroll
                    for (int e = 0; e < 8; ++e) {
                        v2u kd; kd.x = cvtpk(y[0][e] * ek0, y[1][e] * ek1); kd.y = cvtpk(y[2][e] * ek2, y[3][e] * ek3);
                        *(LAS v2u*)(kdT + (d0 + e) * KST + (t4 ^ swk) * 2) = kd;
                        *(LAS f32x4*)(Rt + (d0 + e) * RST + (t4 ^ swr)) = (f32x4){y[0][e] * bg0, y[1][e] * bg1, y[2][e] * bg2, y[3][e] * bg3}; }
                }
            } else {
#pragma unroll
                for (int e = 0; e < 8; ++e) *(LAS f32x4*)(Rt + (64 + d0 + e) * RST + (t4 ^ swr)) = (f32x4){y[0][e] * B4.x, y[1][e] * B4.y, y[2][e] * B4.z, y[3][e] * B4.w};
            }
        }
        __syncthreads();
#define G1_TILE(which, ct, st) do { const LAS unsigned char* Xb_ = (which) ? Kr : Qr; const int c_ = 16 * (ct) + l15; const float Gc_ = Gs[c_], bc_ = Bs[c_]; \
            f32x4 acc_ = {0.f, 0.f, 0.f, 0.f}; \
            _Pragma("unroll") for (int ks = 0; ks < 2; ++ks) { const bf16x8_t bf_ = *(const LAS bf16x8_t*)(Xb_ + c_ * KST + (32 * ks + 8 * g4) * 2); \
                const bf16x8_t af_ = *(const LAS bf16x8_t*)(Kr + (16 * (st) + l15) * KST + (32 * ks + 8 * g4) * 2); acc_ = __builtin_amdgcn_mfma_f32_16x16x32_bf16(af_, bf_, acc_, 0, 0, 0); } \
            f32x4 vals_; \
            _Pragma("unroll") for (int r = 0; r < 4; ++r) { const int s2_ = 16 * (st) + 4 * g4 + r; const float dec_ = __expf(fminf(Gc_ - Gs[s2_], 0.f)); \
                vals_[r] = (which) ? ((s2_ < c_) ? -acc_[r] * bc_ * dec_ : 0.f) : ((s2_ <= c_) ? acc_[r] * dec_ : 0.f); } \
            *(LAS v2u*)(((which) ? Mm : At) + c_ * KST + (16 * (st) + 4 * g4) * 2) = pack4(vals_); \
            if ((which) && (st) == (ct)) *(LAS f32x4*)(Md + ((ct) * 16 + l15) * 20 + 4 * g4) = -vals_; } while (0)
        if constexpr (STG & 1) {
            const int ct = wave & 3, st0 = 2 * (wave >> 2);
            G1_TILE(1, ct, st0); G1_TILE(1, ct, st0 + 1);
        }
        __syncthreads();
        if constexpr (STG & 1) {
            if (wave != 0) { for (int tix = wave - 1; tix < 16; tix += 7) { const int ct = tix & 3, st = tix >> 2; G1_TILE(0, ct, st); } }
        }
        if ((STG & 2) && wave == 0) {
            float t[16];
#pragma unroll
            for (int r = 0; r < 16; ++r) { float acc = (r == l15) ? 1.f : 0.f;
#pragma unroll
                for (int s4 = 0; s4 < r; s4 += 4) { const f32x4 m = *(const LAS f32x4*)(Md + (g4 * 16 + r) * 20 + s4);
                    acc -= m.x * t[s4]; if (s4 + 1 < r) acc -= m.y * t[s4 + 1]; if (s4 + 2 < r) acc -= m.z * t[s4 + 2]; if (s4 + 3 < r) acc -= m.w * t[s4 + 3]; }
                t[r] = acc; }
#pragma unroll
            for (int r = 0; r < 16; ++r) *(LAS unsigned short*)(Tl + ((g4 * 16 + r) * 16 + l15) * 2) = (unsigned short)f2bf(t[r]);
        }
        __syncthreads();
        if constexpr (STG & 4) {
        f32x4 wt[4];
        {   const int colw = 16 * wave + l15;
#pragma unroll
            for (int i = 0; i < 4; ++i) {
                f32x4 acc = *(const LAS f32x4*)(Rt + colw * RST + ((16 * i + 4 * g4) ^ (((colw >> 3) & 3) << 3)));
                const LAS unsigned char* mrow = Mm + (16 * i + l15) * KST + (4 * g4) * 2;
                if (i >= 1) { const v2u alo = *(const LAS v2u*)(mrow), ahi = (i >= 2) ? *(const LAS v2u*)(mrow + 32) : zero2;
                    acc = __builtin_amdgcn_mfma_f32_16x16x32_bf16(mk8(alo, ahi), mk8(pack4(wt[0]), (i >= 2) ? pack4(wt[1]) : zero2), acc, 0, 0, 0); }
                if (i == 3) { const v2u alo = *(const LAS v2u*)(mrow + 64);
                    acc = __builtin_amdgcn_mfma_f32_16x16x32_bf16(mk8(alo, zero2), mk8(pack4(wt[2]), zero2), acc, 0, 0, 0); }
                const v2u tlo = *(const LAS v2u*)(Tl + ((i * 16 + l15) * 16 + 4 * g4) * 2);
                wt[i] = __builtin_amdgcn_mfma_f32_16x16x32_bf16(mk8(tlo, zero2), mk8(pack4(acc), zero2), (f32x4){0.f, 0.f, 0.f, 0.f}, 0, 0, 0);
            }
        }
        if (wave < 4) {
            bf16x8_t wn[2];
#pragma unroll
            for (int ks = 0; ks < 2; ++ks) { v2u lo = pack4(wt[2 * ks]), hi = pack4(wt[2 * ks + 1]); lo.x ^= 0x80008000u; lo.y ^= 0x80008000u; hi.x ^= 0x80008000u; hi.y ^= 0x80008000u; wn[ks] = mk8(lo, hi); }
#pragma unroll
            for (int nt = 0; nt < 4; ++nt) { const int x = 16 * nt + l15;
                f32x4 ca = {0.f, 0.f, 0.f, 0.f};
                const v2u qraw = *(const LAS v2u*)(Qr + x * KST + (16 * wave + 4 * g4) * 2); const float eg = __expf(Gs[x]);
                f32x4 cq; cq.x = eg * __builtin_bit_cast(float, qraw.x << 16); cq.y = eg * __builtin_bit_cast(float, qraw.x & 0xffff0000u); cq.z = eg * __builtin_bit_cast(float, qraw.y << 16); cq.w = eg * __builtin_bit_cast(float, qraw.y & 0xffff0000u);
#pragma unroll
                for (int ks = 0; ks < 2; ++ks) { const int xs = (x >> 3) << 3; const LAS unsigned char* kp0 = kdT + x * KST + ((32 * ks + 4 * g4) ^ xs) * 2; const LAS unsigned char* kp1 = kdT + x * KST + ((32 * ks + 16 + 4 * g4) ^ xs) * 2; const LAS unsigned char* ap = At + x * KST + (32 * ks + 4 * g4) * 2;
                    ca = __builtin_amdgcn_mfma_f32_16x16x32_bf16(wn[ks], mk8(*(const LAS v2u*)(kp0), *(const LAS v2u*)(kp1)), ca, 0, 0, 0);
                    cq = __builtin_amdgcn_mfma_f32_16x16x32_bf16(wn[ks], mk8(*(const LAS v2u*)(ap), *(const LAS v2u*)(ap + 32)), cq, 0, 0, 0); }
                const size_t off = cb + (size_t)((nt * 2 + (wave >> 1)) * 64 + lane) * 8 + 4 * (wave & 1);
                if (SM & 1) *(v2u*)(AP + off) = pack4(ca); if (SM & 2) *(v2u*)(QP + off) = pack4(cq);
            }
        } else {
            bf16x8_t ub[2];
#pragma unroll
            for (int ks = 0; ks < 2; ++ks) ub[ks] = mk8(pack4(wt[2 * ks]), pack4(wt[2 * ks + 1]));
            unsigned bo[8], oo[8];
#pragma unroll
            for (int mt = 0; mt < 4; ++mt) { const int x = 16 * mt + l15;
                f32x4 cbv = {0.f, 0.f, 0.f, 0.f}, co = {0.f, 0.f, 0.f, 0.f};
#pragma unroll
                for (int ks = 0; ks < 2; ++ks) { const int xs = (x >> 3) << 3; const LAS unsigned char* kp0 = kdT + x * KST + ((32 * ks + 4 * g4) ^ xs) * 2; const LAS unsigned char* kp1 = kdT + x * KST + ((32 * ks + 16 + 4 * g4) ^ xs) * 2; const LAS unsigned char* ap = At + x * KST + (32 * ks + 4 * g4) * 2;
                    cbv = __builtin_amdgcn_mfma_f32_16x16x32_bf16(mk8(*(const LAS v2u*)(kp0), *(const LAS v2u*)(kp1)), ub[ks], cbv, 0, 0, 0);
                    co = __builtin_amdgcn_mfma_f32_16x16x32_bf16(mk8(*(const LAS v2u*)(ap), *(const LAS v2u*)(ap + 32)), ub[ks], co, 0, 0, 0); }
                const v2u pb = pack4(cbv), po = pack4(co); bo[2 * mt] = pb.x; bo[2 * mt + 1] = pb.y; oo[2 * mt] = po.x; oo[2 * mt + 1] = po.y; }
            const size_t off = cb + (size_t)((wave - 4) * 64 + lane) * 16;
            if (SM & 4) { *(v4u*)(BP + off) = (v4u){bo[0], bo[1], bo[2], bo[3]}; *(v4u*)(BP + off + 8) = (v4u){bo[4], bo[5], bo[6], bo[7]}; }
            if (SM & 8) { *(v4u*)(OP + off) = (v4u){oo[0], oo[1], oo[2], oo[3]}; *(v4u*)(OP + off + 8) = (v4u){oo[4], oo[5], oo[6], oo[7]}; }
        }
        }
    }
    }
#undef G1_TILE
#undef G1_PREFETCH
}

__device__ __forceinline__ f32x4 g2_unpack(const v4u (&p)[2], int mt) {
    const unsigned d0 = mt == 0 ? p[0].x : mt == 1 ? p[0].z : mt == 2 ? p[1].x : p[1].z, d1 = mt == 0 ? p[0].y : mt == 1 ? p[0].w : mt == 2 ? p[1].y : p[1].w;
    f32x4 r; r.x = __builtin_bit_cast(float, d0 << 16); r.y = __builtin_bit_cast(float, d0 & 0xffff0000u); r.z = __builtin_bit_cast(float, d1 << 16); r.w = __builtin_bit_cast(float, d1 & 0xffff0000u); return r;
}
template <int VAR = 0>
__device__ __forceinline__ void gdn_scan(const Args& A, int bh, LAS unsigned char* lds, int tid, int lane, int wave) {
    unsigned char* ws = A.ws;
    const char* AP = (const char*)(ws + WS_GAP); const char* BP = (const char*)(ws + WS_GBP); const float* GL = (const float*)(ws + WS_GGL); bf16* SF = (bf16*)(ws + WS_GSF);
    constexpr int SLOT = 16384, NSL = 8, EGL_OFF = NSL * SLOT;
    LAS float* eglt = (LAS float*)(lds + EGL_OFF);
    __syncthreads();
    { int tl = tid; asm volatile("" : "+v"(tl));
      if (tl < 128) eglt[tl] = GL[bh * 128 + tl]; }
    if (wave < 4) {
        f32x4 sC[4]; bf16x8_t sB[2];
#pragma unroll
        for (int mt = 0; mt < 4; ++mt) sC[mt] = (f32x4){0.f, 0.f, 0.f, 0.f};
#pragma unroll
        for (int ks = 0; ks < 2; ++ks)
#pragma unroll
            for (int j = 0; j < 8; ++j) sB[ks][j] = 0;
        asm volatile("s_waitcnt vmcnt(0) lgkmcnt(0)" ::: "memory");
        __builtin_amdgcn_s_barrier();
        struct SSet { bf16x8_t fa[4][2]; v4u fb[2]; float egl; };
#define SC_LOAD(S, n) do { const int n_ = (n) < SEQ / 64 ? (n) : SEQ / 64 - 1; const LAS unsigned char* slot_ = lds + (n_ & (NSL - 1)) * SLOT; \
            _Pragma("unroll") for (int mt = 0; mt < 4; ++mt) _Pragma("unroll") for (int ks = 0; ks < 2; ++ks) S.fa[mt][ks] = *(const LAS bf16x8_t*)(slot_ + ((mt * 2 + ks) * 64 + lane) * 16); \
            S.fb[0] = *(const LAS v4u*)(slot_ + 8192 + (wave * 64 + lane) * 32); S.fb[1] = *(const LAS v4u*)(slot_ + 8192 + (wave * 64 + lane) * 32 + 16); S.egl = eglt[n_]; } while (0)
#define SC_STEP(S, n) do { bf16* sf = SF + (size_t)(bh * 128 + (n)) * 4096 + (size_t)((wave * 2) * 64 + lane) * 8; \
            *(bf16x8_t*)(sf) = sB[0]; *(bf16x8_t*)(sf + 512) = sB[1]; \
            f32x4 sacc[4]; \
            _Pragma("unroll") for (int mt = 0; mt < 4; ++mt) sacc[mt] = sC[mt] * S.egl + g2_unpack(S.fb, mt); \
            _Pragma("unroll") for (int mt = 0; mt < 4; ++mt) _Pragma("unroll") for (int ks = 0; ks < 2; ++ks) sacc[mt] = __builtin_amdgcn_mfma_f32_16x16x32_bf16(S.fa[mt][ks], sB[ks], sacc[mt], 0, 0, 0); \
            _Pragma("unroll") for (int mt = 0; mt < 4; ++mt) sC[mt] = sacc[mt]; \
            _Pragma("unroll") for (int ks = 0; ks < 2; ++ks) { union { bf16x8_t v; unsigned u[4]; } pk_; \
                pk_.u[0] = cvtpk(sC[2 * ks].x, sC[2 * ks].y); pk_.u[1] = cvtpk(sC[2 * ks].z, sC[2 * ks].w); pk_.u[2] = cvtpk(sC[2 * ks + 1].x, sC[2 * ks + 1].y); pk_.u[3] = cvtpk(sC[2 * ks + 1].z, sC[2 * ks + 1].w); sB[ks] = pk_.v; } \
            asm volatile("s_waitcnt lgkmcnt(0)" ::: "memory"); \
            __builtin_amdgcn_s_barrier(); } while (0)
        SSet s0;
#pragma unroll 1
        for (int n = 0; n < SEQ / 64; ++n) {
            if (VAR == 2) { asm volatile("s_waitcnt lgkmcnt(0)" ::: "memory"); __builtin_amdgcn_s_barrier(); continue; }
            SC_LOAD(s0, n);
            SC_STEP(s0, n);
        }
#undef SC_LOAD
#undef SC_STEP
    } else {
        const int f = wave - 4;
        const unsigned lin = (unsigned)(2 * f) * 1024u + (unsigned)lane * 16u;
#define G2_DMA(nn) do { const int n_ = (nn) < SEQ / 64 ? (nn) : SEQ / 64 - 1; const size_t cb_ = (size_t)(bh * 128 + n_) * 8192; LAS unsigned char* d_ = lds + ((nn) & (NSL - 1)) * SLOT + (2 * f) * 1024; \
        __builtin_amdgcn_global_load_lds((const unsigned*)(AP + cb_ + lin), (LAS unsigned*)(d_), 16, 0, 0); __builtin_amdgcn_global_load_lds((const unsigned*)(AP + cb_ + lin + 1024), (LAS unsigned*)(d_ + 1024), 16, 0, 0); \
        __builtin_amdgcn_global_load_lds((const unsigned*)(BP + cb_ + lin), (LAS unsigned*)(d_ + 8192), 16, 0, 0); __builtin_amdgcn_global_load_lds((const unsigned*)(BP + cb_ + lin + 1024), (LAS unsigned*)(d_ + 8192 + 1024), 16, 0, 0); } while (0)
        asm volatile("s_waitcnt vmcnt(0) lgkmcnt(0)" ::: "memory");
        G2_DMA(0); G2_DMA(1); G2_DMA(2); G2_DMA(3); G2_DMA(4); G2_DMA(5); G2_DMA(6);
        asm volatile("s_waitcnt vmcnt(24)" ::: "memory");
        __builtin_amdgcn_s_barrier();
#pragma unroll 1
        for (int n = 0; n < SEQ / 64; ++n) {
            if (VAR != 1) G2_DMA(n + 7);
            asm volatile("s_waitcnt vmcnt(24)" ::: "memory");
            __builtin_amdgcn_s_barrier();
        }
#undef G2_DMA
        asm volatile("s_waitcnt vmcnt(0)" ::: "memory");
    }
    __syncthreads();
}
__device__ __forceinline__ void gdn_out(const Args& A, LAS unsigned char* lds, int lane, int wave) {
    unsigned char* ws = A.ws;
    const bf16* proj = (const bf16*)(ws + WS_PROJ); bf16* mix = (bf16*)(ws + WS_MIX);
    const bf16* QP = (const bf16*)(ws + WS_GQP); const bf16* OP = (const bf16*)(ws + WS_GOP); const bf16* SF = (const bf16*)(ws + WS_GSF);
    const float* onorm = (const float*)A.in[I_GNORM];
    const int mt = wave & 3, l15 = lane & 15, g4 = lane >> 4, rr = lane >> 2, q4 = lane & 3;
    constexpr int OST = 68;
    LAS float* ot = (LAS float*)(lds + wave * 4608);
    float gain[16];
#pragma unroll
    for (int k = 0; k < 16; ++k) gain[k] = onorm[16 * q4 + k];
    struct OSet { bf16x8_t qa[2], sb[4][2]; v2u oi[4]; v4u z0, z1; };
#define GO_LOAD(S, CID) do { const int n_ = (CID) & 127, bh_ = (CID) >> 7, b_ = bh_ >> 3, h_ = bh_ & 7; const size_t cb_ = (size_t)(CID) * 4096; \
        const size_t t_ = (size_t)b_ * SEQ + n_ * 64 + 16 * mt + rr; \
        S.z0 = *(const v4u*)(proj + t_ * NPROJ + PC_Z + h_ * 64 + 16 * q4); S.z1 = *(const v4u*)(proj + t_ * NPROJ + PC_Z + h_ * 64 + 16 * q4 + 8); \
        _Pragma("unroll") for (int ks = 0; ks < 2; ++ks) S.qa[ks] = *(const bf16x8_t*)(QP + cb_ + ((mt * 2 + ks) * 64 + lane) * 8); \
        _Pragma("unroll") for (int nt = 0; nt < 4; ++nt) { _Pragma("unroll") for (int ks = 0; ks < 2; ++ks) S.sb[nt][ks] = *(const bf16x8_t*)(SF + cb_ + ((nt * 2 + ks) * 64 + lane) * 8); \
            S.oi[nt] = *(const v2u*)(OP + cb_ + ((nt * 64 + lane) * 4 + mt) * 4); } } while (0)
#define GO_STEP(S, CID) do { const int n_ = (CID) & 127, bh_ = (CID) >> 7, b_ = bh_ >> 3, h_ = bh_ & 7; const size_t t_ = (size_t)b_ * SEQ + n_ * 64 + 16 * mt + rr; \
        _Pragma("unroll") for (int nt = 0; nt < 4; ++nt) { \
            f32x4 acc; acc.x = __builtin_bit_cast(float, S.oi[nt].x << 16); acc.y = __builtin_bit_cast(float, S.oi[nt].x & 0xffff0000u); acc.z = __builtin_bit_cast(float, S.oi[nt].y << 16); acc.w = __builtin_bit_cast(float, S.oi[nt].y & 0xffff0000u); \
            _Pragma("unroll") for (int ks = 0; ks < 2; ++ks) acc = __builtin_amdgcn_mfma_f32_16x16x32_bf16(S.qa[ks], S.sb[nt][ks], acc, 0, 0, 0); \
            _Pragma("unroll") for (int i = 0; i < 4; ++i) ot[(4 * g4 + i) * OST + 16 * nt + l15] = acc[i]; } \
        LDS_WAIT(); asm volatile("" ::: "memory"); \
        float o[16]; float ss = 0.f; \
        _Pragma("unroll") for (int k = 0; k < 4; ++k) { const f32x4 v = *(const LAS f32x4*)(ot + rr * OST + 16 * q4 + 4 * k); o[4 * k] = v.x; o[4 * k + 1] = v.y; o[4 * k + 2] = v.z; o[4 * k + 3] = v.w; } \
        _Pragma("unroll") for (int k = 0; k < 16; ++k) ss += o[k] * o[k]; \
        ss += __shfl_xor(ss, 1); ss += __shfl_xor(ss, 2); \
        const float r = 1.f / sqrtf(ss * (1.f / 64.f) + EPS); \
        const unsigned zu[8] = {S.z0.x, S.z0.y, S.z0.z, S.z0.w, S.z1.x, S.z1.y, S.z1.z, S.z1.w}; \
        unsigned ou[8]; \
        _Pragma("unroll") for (int k = 0; k < 8; ++k) { const float za = __builtin_bit_cast(float, zu[k] << 16), zb = __builtin_bit_cast(float, zu[k] & 0xffff0000u); \
            ou[k] = cvtpk(o[2 * k] * r * gain[2 * k] * siluf(za), o[2 * k + 1] * r * gain[2 * k + 1] * siluf(zb)); } \
        bf16* op = mix + t_ * DM + h_ * 64 + 16 * q4; \
        *(v4u*)(op) = (v4u){ou[0], ou[1], ou[2], ou[3]}; *(v4u*)(op + 8) = (v4u){ou[4], ou[5], ou[6], ou[7]}; \
        LDS_WAIT(); asm volatile("" ::: "memory"); } while (0)
    const int NC = NB * 8 * 128, st = gridDim.x * 2;
    int cid = blockIdx.x * 2 + (wave >> 2);
    OSet s0, s1, s2;
    if (cid < NC) GO_LOAD(s0, cid);
    if (cid + st < NC) GO_LOAD(s1, cid + st);
#pragma unroll 1
    for (; cid < NC; cid += 3 * st) {
        if (cid + 2 * st < NC) GO_LOAD(s2, cid + 2 * st);
        GO_STEP(s0, cid);
        if (cid + st < NC) { if (cid + 3 * st < NC) GO_LOAD(s0, cid + 3 * st); GO_STEP(s1, cid + st); }
        if (cid + 2 * st < NC) { if (cid + 4 * st < NC) GO_LOAD(s1, cid + 4 * st); GO_STEP(s2, cid + 2 * st); }
    }
#undef GO_LOAD
#undef GO_STEP
}

template <bool DRY, int VAR = 0>
__device__ __forceinline__ void norm_route_mfma(const Args& A, const float* X, const float* ssqp, const float* gain, const float* shift, const float* scale, bf16* H, LAS unsigned char* lds, int tid, int lane, int wave) {
    unsigned char* ws = A.ws;
    const int G = gridDim.x;
    const int l15 = lane & 15, g4 = lane >> 4;
    LAS unsigned char* wfl = lds;
    LAS float* mfl = (LAS float*)(lds + 98304); LAS float* afl = mfl + 1024;
    LAS float* lgs = (LAS float*)(lds + 98304 + 8192 + wave * 3328);
    const float* bg = (const float*)A.in[I_BGRP]; const float* br = (const float*)A.in[I_BRT];
#define P7_LOADW(half) do { const v4u* src_ = (const v4u*)(ws + WS_WRT); \
        for (int q = tid; q < 3072; q += NTHR) { const int nt_ = q >> 10, r_ = q & 1023; const int g_ = (nt_ * 32 + 16 * (half)) * 64 + r_; \
            *(LAS v4u*)(wfl + q * 16) = src_[g_]; *(LAS v4u*)(wfl + 49152 + q * 16) = src_[6144 + g_]; } } while (0)
    int bcur = -1;
    for (int rb = blockIdx.x * 128; rb < TT; rb += G * 128) {
        const int b = rb / SEQ, r0 = rb + wave * 16, row = r0 + l15;
        if (b != bcur) { bcur = b; __syncthreads();
            for (int q = tid; q < 1024; q += NTHR) { mfl[q] = gain[q] * (scale[b * 6144 + q] + 1.0f); afl[q] = shift[b * 6144 + q]; }
            __syncthreads(); }
        const float* xr = X + (size_t)row * DM + 8 * g4;
        float ss;
        {   const f32x4 p4 = *(const f32x4*)(ssqp + (size_t)row * 16 + 4 * g4); ss = (p4.x + p4.y) + (p4.z + p4.w); }
        ss += __shfl_xor(ss, 16); ss += __shfl_xor(ss, 32);
        const float rstd = 1.f / sqrtf(ss * (1.f / DM) + EPS);
        f32x4 acc[3];
#pragma unroll
        for (int nt = 0; nt < 3; ++nt) acc[nt] = (f32x4){0.f, 0.f, 0.f, 0.f};
        bf16* hrow = H + (size_t)row * DM + 8 * g4;
#pragma unroll 1
        for (int half = 0; half < 2; ++half) {
        __syncthreads(); P7_LOADW(half); __syncthreads();
#pragma unroll 8
        for (int ks = 16 * half; ks < 16 * half + 16; ++ks) {
            float hv[8];
            {   const f32x4 a = *(const f32x4*)(xr + 32 * ks), c = *(const f32x4*)(xr + 32 * ks + 4);
                const f32x4 m0 = *(const LAS f32x4*)(mfl + 32 * ks + 8 * g4), m1 = *(const LAS f32x4*)(mfl + 32 * ks + 8 * g4 + 4), h0 = *(const LAS f32x4*)(afl + 32 * ks + 8 * g4), h1 = *(const LAS f32x4*)(afl + 32 * ks + 8 * g4 + 4);
                const f32x4 v0 = a * rstd * m0 + h0, v1 = c * rstd * m1 + h1;
                hv[0] = v0.x; hv[1] = v0.y; hv[2] = v0.z; hv[3] = v0.w; hv[4] = v1.x; hv[5] = v1.y; hv[6] = v1.z; hv[7] = v1.w; }
            unsigned hu[4], lu[4];
#pragma unroll
            for (int p = 0; p < 4; ++p) { hu[p] = cvtpk(hv[2 * p], hv[2 * p + 1]);
                const float ra = hv[2 * p] - __builtin_bit_cast(float, hu[p] << 16), rb2 = hv[2 * p + 1] - __builtin_bit_cast(float, hu[p] & 0xffff0000u); lu[p] = cvtpk(ra, rb2); }
            *(v4u*)(hrow + 32 * ks) = (v4u){hu[0], hu[1], hu[2], hu[3]};
            union { bf16x8_t v; unsigned u[4]; } ah, al; ah.u[0] = hu[0]; ah.u[1] = hu[1]; ah.u[2] = hu[2]; ah.u[3] = hu[3]; al.u[0] = lu[0]; al.u[1] = lu[1]; al.u[2] = lu[2]; al.u[3] = lu[3];
#pragma unroll
            for (int nt = 0; nt < 3; ++nt) { const int fo = ((nt * 16 + (ks & 15)) * 64 + lane) * 16;
                const bf16x8_t bh = *(const LAS bf16x8_t*)(wfl + fo), bl = *(const LAS bf16x8_t*)(wfl + 49152 + fo);
                acc[nt] = __builtin_amdgcn_mfma_f32_16x16x32_bf16(ah.v, bh, acc[nt], 0, 0, 0);
                acc[nt] = __builtin_amdgcn_mfma_f32_16x16x32_bf16(ah.v, bl, acc[nt], 0, 0, 0);
                acc[nt] = __builtin_amdgcn_mfma_f32_16x16x32_bf16(al.v, bh, acc[nt], 0, 0, 0); }
        }
        }
#pragma unroll
        for (int nt = 0; nt < 3; ++nt)
#pragma unroll
            for (int r = 0; r < 4; ++r) lgs[(4 * g4 + r) * 52 + 16 * nt + l15] = acc[nt][r];
        LDS_WAIT(); asm volatile("" ::: "memory");
        if (lane < 16) {
            float lg[36];
#pragma unroll
            for (int q = 0; q < 9; ++q) { const f32x4 v = *(const LAS f32x4*)(lgs + lane * 52 + 4 * q); lg[4 * q] = v.x; lg[4 * q + 1] = v.y; lg[4 * q + 2] = v.z; lg[4 * q + 3] = v.w; }
#pragma unroll
            for (int o = 0; o < 4; ++o) lg[o] += bg[o];
#pragma unroll
            for (int o = 0; o < 32; ++o) lg[4 + o] += br[o];
            int gi = 0; float gm = lg[0];
#pragma unroll
            for (int o = 1; o < 4; ++o) if (lg[o] > gm) { gm = lg[o]; gi = o; }
            float gs = 0.f;
#pragma unroll
            for (int o = 0; o < 4; ++o) gs += __expf(lg[o] - gm);
            const float pg = 1.f / gs;
            float le[8];
#pragma unroll
            for (int j = 0; j < 8; ++j) { le[j] = lg[4 + j];
#pragma unroll
                for (int g = 1; g < 4; ++g) le[j] = (gi == g) ? lg[4 + g * 8 + j] : le[j]; }
            int j1 = 0; float m1 = le[0];
#pragma unroll
            for (int j = 1; j < 8; ++j) if (le[j] > m1) { m1 = le[j]; j1 = j; }
            int j2 = -1; float m2 = -3.0e38f;
#pragma unroll
            for (int j = 0; j < 8; ++j) if (j != j1 && le[j] > m2) { m2 = le[j]; j2 = j; }
            const float ex = __expf(m2 - m1), w1 = pg / (1.f + ex), w2 = pg * ex / (1.f + ex);
            const int e1 = gi * 8 + j1, e2 = gi * 8 + j2, rw = r0 + lane;
            unsigned* ctl = (unsigned*)(ws + WS_CTL);
            int2* erec = (int2*)(ws + WS_EREC); int* clist = (int*)(ws + WS_CLIST);
            if constexpr (DRY) { ((int2*)(ws + WS_PROJ + 168 * MiB))[rw] = make_int2(e1 * 64 + e2, __builtin_bit_cast(int, w1 + w2)); } else {
            const unsigned p1 = atomicAdd(ctl + CW_ECNT + e1, 1u); erec[(size_t)e1 * TT + p1] = make_int2(rw * 2 + (e1 > e2 ? 1 : 0), __builtin_bit_cast(int, w1));
            const unsigned p2 = atomicAdd(ctl + CW_ECNT + e2, 1u); erec[(size_t)e2 * TT + p2] = make_int2(rw * 2 + (e2 > e1 ? 1 : 0), __builtin_bit_cast(int, w2));
            const int a = j1 < j2 ? j1 : j2, bb = j1 < j2 ? j2 : j1;
            const int cls = gi * 28 + (a * 7 - (a * (a - 1)) / 2 + (bb - a - 1));
            const unsigned pc = atomicAdd(ctl + CW_CCNT + cls, 1u); clist[(size_t)cls * TT + pc] = rw; }
        }
        LDS_WAIT(); asm volatile("" ::: "memory");
    }
#undef P7_LOADW
}

__device__ __forceinline__ int wave_incl_scan(int v, int lane) {
#pragma unroll
    for (int o = 1; o < 64; o <<= 1) { const int t = __shfl_up(v, o); if (lane >= o) v += t; }
    return v;
}
template <int NOPART = 0>
struct SchedET {
    int G, c, cntv, preF, erank, totF, totP; const int2* rec; const char* W;
    __device__ __forceinline__ void init(const unsigned* cnt, const int2* rec_, const char* W_, int G_, int c_, int lane) {
        G = G_; c = c_; rec = rec_; W = W_;
        cntv = lane < NE ? (int)cnt[lane] : 0;
        const int rem = cntv & 255;
        const int incF = wave_incl_scan(cntv >> 8, lane), incP = wave_incl_scan(rem ? 1 : 0, lane);
        totF = __builtin_amdgcn_readlane(incF, 63); totP = NOPART ? 0 : __builtin_amdgcn_readlane(incP, 63);
        preF = lane < NE ? incF : 0x7fffffff;
        int rank = 0;
        for (int l = 0; l < NE; ++l) { const int r2 = __builtin_amdgcn_readlane(rem, l); rank += (r2 > rem || (r2 == rem && l < lane)) ? 1 : 0; }
        erank = __builtin_amdgcn_ds_permute((lane < NE ? rank : lane) << 2, lane);
    }
    __device__ __forceinline__ bool next(int i, pg8::UnitG& u) const {
        const int L = i * G + c; if (L >= 2 * (totF + totP)) return false;
        if (L < 2 * totF) { const int F8 = totF & ~7; const bool xm = L < 2 * F8;
            const int ft = xm ? 8 * (L >> 4) + (L & 7) : (L >> 1), pnv = xm ? (L >> 3) & 1 : (L & 1);
            const int e = __builtin_amdgcn_readfirstlane(__popcll(__ballot(preF <= ft)));
            const int base = e ? __builtin_amdgcn_readlane(preF, e - 1) : 0;
            u.id = e; u.tile = ft - base; u.pn = pnv; u.nrows = 256;
        } else { const int p = (L - 2 * totF) >> 1;
            const int e = __builtin_amdgcn_readlane(erank, p);
            const int cnt = __builtin_amdgcn_readlane(cntv, e);
            u.id = e; u.tile = cnt >> 8; u.pn = L & 1; u.nrows = cnt & 255; }
        return true;
    }
    __device__ __forceinline__ int tok(const pg8::UnitG& u, int r) const { return r < u.nrows ? (rec[(size_t)u.id * TT + u.tile * 256 + r].x >> 1) : 0; }
    __device__ __forceinline__ const char* bseg(const pg8::UnitG& u, int) const { return W + ((size_t)u.id * 512 + u.pn * 256) * 2048; }
};
typedef SchedET<0> SchedE;
struct EpiGU {
    static constexpr bool PERM = true, PREFETCH = false;
    bf16* HID;
    template <class SC> __device__ __forceinline__ void operator()(const pg8::f32x4 (&acc)[2][2][4][2], const pg8::UnitG& u, const SC& S, int wr, int wc, int fr, int fq) const {
#pragma unroll
        for (int ai = 0; ai < 2; ++ai)
#pragma unroll
            for (int m = 0; m < 4; ++m) { const int r = ai * 128 + wr * 64 + m * 16 + fr;
                if (r < u.nrows) { const int2 rc = S.rec[(size_t)u.id * TT + u.tile * 256 + r]; const int t = rc.x >> 1, half = rc.x & 1; const float w = __builtin_bit_cast(float, rc.y);
                    float hv[8];
#pragma unroll
                    for (int n = 0; n < 2; ++n)
#pragma unroll
                        for (int j = 0; j < 4; ++j) { const float g = acc[ai][0][m][n][j], up = acc[ai][1][m][n][j]; hv[n * 4 + j] = w * siluf(g) * up; }
                    v4u o; o.x = pk2(hv[0], hv[1]); o.y = pk2(hv[2], hv[3]); o.z = pk2(hv[4], hv[5]); o.w = pk2(hv[6], hv[7]);
                    *(v4u*)(HID + (size_t)t * 512 + half * 256 + u.pn * 128 + wc * 32 + 8 * fq) = o; } }
    }
};
struct SchedC {
    int G, c, cntA, cntB, preA, preB, total_rt; const int* clist; const char* W;
    __device__ __forceinline__ void init(const unsigned* cnt, const int* clist_, const char* W_, int G_, int c_, int lane) {
        G = G_; c = c_; clist = clist_; W = W_;
        cntA = (int)cnt[lane]; cntB = lane < NCLS - 64 ? (int)cnt[64 + lane] : 0;
        const int ia = wave_incl_scan((cntA + 255) >> 8, lane); const int ta = __builtin_amdgcn_readlane(ia, 63);
        const int ib = wave_incl_scan((cntB + 255) >> 8, lane) + ta;
        total_rt = __builtin_amdgcn_readlane(ib, 63);
        preA = ia; preB = lane < NCLS - 64 ? ib : 0x7fffffff;
    }
    __device__ __forceinline__ bool next(int i, pg8::UnitG& u) const {
        const int L = i * G + c; if (L >= 4 * total_rt) return false;
        const int R8 = total_rt & ~7; const bool xm = L < 4 * R8;
        const int rt = xm ? 8 * (L >> 5) + (L & 7) : (L >> 2), pnv = xm ? (L >> 3) & 3 : (L & 3);
        const int cls = __builtin_amdgcn_readfirstlane(__popcll(__ballot(preA <= rt)) + __popcll(__ballot(preB <= rt)));
        int base = 0; if (cls > 0) base = (cls - 1 < 64) ? __builtin_amdgcn_readlane(preA, cls - 1) : __builtin_amdgcn_readlane(preB, cls - 65);
        const int cnt = cls < 64 ? __builtin_amdgcn_readlane(cntA, cls) : __builtin_amdgcn_readlane(cntB, cls - 64);
        u.id = cls; u.tile = rt - base; u.pn = pnv; const int rem = cnt - u.tile * 256; u.nrows = rem < 256 ? rem : 256;
        return true;
    }
    __device__ __forceinline__ int tok(const pg8::UnitG& u, int r) const { return r < u.nrows ? clist[(size_t)u.id * TT + u.tile * 256 + r] : 0; }
    __device__ __forceinline__ const char* bseg(const pg8::UnitG& u, int seg) const {
        const int g = u.id / 28; int a = 0, rem = u.id % 28; while (rem >= 7 - a) { rem -= 7 - a; ++a; } const int b = a + 1 + rem;
        const int e = g * 8 + (seg ? b : a);
        return W + ((size_t)e * 1024 + u.pn * 256) * 512;
    }
};
template <int VAR = 0>
struct EpiDownT {
    static constexpr bool PERM = false, PREFETCH = false;
    float* OUT; const float* gate2;
    const LAS unsigned char* gt;
    template <class SC> __device__ __forceinline__ void prefetch(LAS unsigned char* lds, const pg8::UnitG& u, const SC& S, int tid) const {
#pragma unroll
        for (int i = 0; i < 4; ++i) { const int r = (tid >> 3) + 64 * i; const int t = S.tok(u, r);
            __builtin_amdgcn_global_load_lds((const unsigned*)((const char*)OUT + (size_t)t * 4096 + (size_t)u.pn * 1024 + (size_t)(tid & 7) * 128), (LAS unsigned*)(lds + pg8::STAGE_BYTES + 256), 4, 0, 0); }
    }
    template <class SC> __device__ __forceinline__ void operator()(const pg8::f32x4 (&acc)[2][2][4][2], const pg8::UnitG& u, const SC& S, int wr, int wc, int fr, int fq) const {
#pragma unroll
        for (int ai = 0; ai < 2; ++ai)
#pragma unroll
            for (int m = 0; m < 4; ++m) { const int r = ai * 128 + wr * 64 + m * 16 + fr;
                if (r < u.nrows) { const int t = S.clist[(size_t)u.id * TT + u.tile * 256 + r]; const int b = t / SEQ; const int col0 = u.pn * 256 + wc * 32 + 4 * fq;
                    float* op = OUT + (size_t)t * DM + col0; const float* gp = gate2 + b * 6144 + col0;
#pragma unroll
                    for (int bj = 0; bj < 2; ++bj)
#pragma unroll
                        for (int n = 0; n < 2; ++n) { const int off = bj * 128 + n * 16; const f32x4 xv = (VAR == 1) ? (f32x4){1.f, 1.f, 1.f, 1.f} : *(const f32x4*)(op + off);
                            f32x4 gv;
                            if (VAR == 2) gv = (f32x4){1.f, 1.f, 1.f, 1.f};
                            else if (gt) { const v2u g2 = *(const LAS v2u*)(gt + (b * 1024 + col0 + off) * 2);
                                gv.x = __builtin_bit_cast(float, g2.x << 16); gv.y = __builtin_bit_cast(float, g2.x & 0xffff0000u); gv.z = __builtin_bit_cast(float, g2.y << 16); gv.w = __builtin_bit_cast(float, g2.y & 0xffff0000u); }
                            else gv = *(const f32x4*)(gp + off);
                            *(f32x4*)(op + off) = xv + gv * acc[ai][bj][m][n]; } } }
    }
};
typedef EpiDownT<0> EpiDown;

__global__ void __launch_bounds__(NTHR, 2) fwd_kernel(Args args) {
    extern __shared__ __attribute__((aligned(16))) unsigned char lds_raw[];
    LAS unsigned char* lds = (LAS unsigned char*)lds_raw;
    volatile LAS unsigned* MISC = (volatile LAS unsigned*)(lds + MISC_OFF);
    const int G = gridDim.x;
    unsigned char* ws = args.ws;
    const int wave_s = __builtin_amdgcn_readfirstlane(threadIdx.x >> 6);
    for (int u = threadIdx.x; u < (LDS_BYTES - LDSCTL_OFF) / 4; u += NTHR) ((LAS unsigned*)(lds + LDSCTL_OFF))[u] = 0u;
    __syncthreads();
    const int lo = args.ph_lo, hi = args.ph_hi;
    const bool use_bar = (hi - lo) > 1;
    XcdBarrier bar; bar.bar = (unsigned*)(ws + WS_CTL) + CW_BAR; bar.x = 0; bar.st = nullptr;
    if (use_bar) bar = xcd_barrier_post((unsigned*)(ws + WS_CTL) + CW_BAR, MISC + 8, threadIdx.x == 0);
#define IN(k) (lo <= (k) && (k) < hi)
#define BOTH(k) (IN(k) && IN((k) + 1))
#if PROBE_REP == 1000
#define GRID_BAR(k) do { if (BOTH(k)) { xcd_barrier(bar, wave_s == 0 && __builtin_amdgcn_mbcnt_hi(~0u, __builtin_amdgcn_mbcnt_lo(~0u, 0u)) == 0u); xcd_barrier(bar, wave_s == 0 && __builtin_amdgcn_mbcnt_hi(~0u, __builtin_amdgcn_mbcnt_lo(~0u, 0u)) == 0u); } } while (0)
#else
#define GRID_BAR(k) do { if (BOTH(k)) xcd_barrier(bar, wave_s == 0 && __builtin_amdgcn_mbcnt_hi(~0u, __builtin_amdgcn_mbcnt_lo(~0u, 0u)) == 0u); } while (0)
#endif
#define FRESH_IDS() const int wave = wave_s; int lane = (int)__builtin_amdgcn_mbcnt_hi(~0u, __builtin_amdgcn_mbcnt_lo(~0u, 0u)); asm volatile("" : "+v"(lane)); const int tid = wave * 64 + lane; (void)tid
    const float* mod = (const float*)(ws + WS_MOD);

    if (IN(0)) { FRESH_IDS(); p0_prologue(args, lds, tid, lane, wave); GRID_BAR(0); }
    if (IN(1)) { FRESH_IDS(); norm_rows<false>(args, (const float*)args.in[I_X], (const float*)args.in[I_NORM_MIX], mod + 0, mod + 1024, (bf16*)(ws + WS_H), lds, lane, wave); GRID_BAR(1); }
    if (IN(2)) { FRESH_IDS();
        pg8::Gemm g{(const pg8::bf16_t*)(ws + WS_H), (const pg8::bf16_t*)(ws + WS_WINT), TT, NPAD, DM}; pg8::StaticOrder S; S.init(TT, NPAD, G, (int)blockIdx.x);
        pg8::EpiProj E{(pg8::bf16_t*)(ws + WS_PROJ), (float*)(ws + WS_AB), NPROJ};
        pg8::gemm_phase<pg8::EpiProj, pg8::StaticOrder, true, true>(lds, g, S, E);
        GRID_BAR(2);
    }
    if (IN(3)) { FRESH_IDS(); gdn_g1_mfma<31>(args, lds, tid, lane, wave); GRID_BAR(3); }
    if (IN(4)) { FRESH_IDS();
        if ((int)blockIdx.x < 32) gdn_scan(args, (int)blockIdx.x, lds, tid, lane, wave);
        else swa_mfma(args, lds, tid, lane, wave, (int)blockIdx.x - 32, G - 32);
        GRID_BAR(4);
    }
    if (IN(5)) { FRESH_IDS(); gdn_out(args, lds, lane, wave); GRID_BAR(5); }
    if (IN(6)) { FRESH_IDS();
        pg8::Gemm g{(const pg8::bf16_t*)(ws + WS_MIX), (const pg8::bf16_t*)(ws + WS_WOUTT), TT, DM, DM}; pg8::StaticOrder S; S.init(TT, DM, G, (int)blockIdx.x);
        pg8::EpiOut E{(const float*)args.in[I_X], args.out, mod + 2048, SEQ, 6144, (float*)(ws + WS_SSQ)};
        const bool first = ((blockIdx.x >> 3) & 1) != 0;
        if (first) { expert_weight_copy(args, lds, lane, wave); __syncthreads(); }
        pg8::gemm_phase<pg8::EpiOut, pg8::StaticOrder, true, true>(lds, g, S, E);
        if (!first) { __syncthreads(); expert_weight_copy(args, lds, lane, wave); }
        GRID_BAR(6);
    }
    if (IN(7)) { FRESH_IDS(); norm_route_mfma<false>(args, args.out, (const float*)(ws + WS_SSQ), (const float*)args.in[I_NORM_FFN], mod + 3072, mod + 4096, (bf16*)(ws + WS_H), lds, tid, lane, wave); GRID_BAR(7); }
    if (IN(8)) { FRESH_IDS();
        SchedE S; S.init((const unsigned*)(ws + WS_CTL) + CW_ECNT, (const int2*)(ws + WS_EREC), (const char*)(ws + WS_WGUT), G, (int)blockIdx.x, lane);
        EpiGU E{(bf16*)(ws + WS_HID)};
        pg8::gemm_phase_g<EpiGU, SchedE>(lds, (const pg8::bf16_t*)(ws + WS_H), 1024, 1024, 16, 16, S, E);
        GRID_BAR(8);
    }
    if (IN(9)) { FRESH_IDS();
        SchedC S; S.init((const unsigned*)(ws + WS_CTL) + CW_CCNT, (const int*)(ws + WS_CLIST), (const char*)(ws + WS_WDT), G, (int)blockIdx.x, lane);
        LAS unsigned char* gtl = lds + RING_BYTES + 512;
        for (int q = tid; q < 4096; q += NTHR) *(LAS unsigned short*)(gtl + q * 2) = (unsigned short)f2bf(mod[(q >> 10) * 6144 + 5120 + (q & 1023)]);
        __syncthreads();
        EpiDown E{args.out, mod + 5120, gtl};
        pg8::gemm_phase_g<EpiDown, SchedC>(lds, (const pg8::bf16_t*)(ws + WS_HID), 512, 256, 8, 4, S, E);
    }
#undef IN
#undef BOTH
#undef GRID_BAR
}

#if PROBE_REP >= 0 && PROBE_REP < 1000
template <int P>
__global__ void __launch_bounds__(NTHR, 2) probe_kernel(Args args) {
    extern __shared__ __attribute__((aligned(16))) unsigned char lds_raw[];
    LAS unsigned char* lds = (LAS unsigned char*)lds_raw;
    const int tid = threadIdx.x, lane = tid & 63, wave = __builtin_amdgcn_readfirstlane(tid >> 6);
    const int G = gridDim.x; unsigned char* ws = args.ws; const float* mod = (const float*)(ws + WS_MOD);
    if constexpr (P == 1) norm_rows<false>(args, (const float*)args.in[I_X], (const float*)args.in[I_NORM_MIX], mod + 0, mod + 1024, (bf16*)(ws + WS_GAP + 0)  , lds, lane, wave);
    if constexpr (P == 2) { pg8::Gemm g{(const pg8::bf16_t*)(ws + WS_H), (const pg8::bf16_t*)(ws + WS_WINT), TT, NPAD, DM}; pg8::StaticOrder S; S.init(TT, NPAD, G, (int)blockIdx.x);
        pg8::EpiProj E{(pg8::bf16_t*)(ws + WS_PROJ), (float*)(ws + WS_AB), NPROJ}; pg8::gemm_phase<pg8::EpiProj, pg8::StaticOrder, true, true>(lds, g, S, E); }
    if constexpr (P == 0) p0_prologue(args, lds, tid, lane, wave);
    if constexpr (P == 4) gdn_g1_mfma<31>(args, lds, tid, lane, wave);
    if constexpr (P == 40) gdn_g1_mfma<31, 0>(args, lds, tid, lane, wave);
    if constexpr (P == 41) gdn_g1_mfma<31, 1>(args, lds, tid, lane, wave);
    if constexpr (P == 42) gdn_g1_mfma<31, 3>(args, lds, tid, lane, wave);
    if constexpr (P == 43) gdn_g1_mfma<0, 7>(args, lds, tid, lane, wave);
    if constexpr (P == 50) { if ((int)blockIdx.x < 32) gdn_scan(args, (int)blockIdx.x, lds, tid, lane, wave); }
    if constexpr (P == 501) { if ((int)blockIdx.x < 32) gdn_scan<1>(args, (int)blockIdx.x, lds, tid, lane, wave); }
    if constexpr (P == 502) { if ((int)blockIdx.x < 32) gdn_scan<2>(args, (int)blockIdx.x, lds, tid, lane, wave); }
    if constexpr (P == 52) gdn_out(args, lds, lane, wave);
    if constexpr (P == 51) { if ((int)blockIdx.x >= 32) swa_mfma(args, lds, tid, lane, wave, (int)blockIdx.x - 32, G - 32); }
    if constexpr (P == 60) expert_weight_copy(args, lds, lane, wave);
    if constexpr (P == 61) { pg8::Gemm g{(const pg8::bf16_t*)(ws + WS_MIX), (const pg8::bf16_t*)(ws + WS_WOUTT), TT, DM, DM}; pg8::StaticOrder S; S.init(TT, DM, G, (int)blockIdx.x);
        pg8::EpiOut E{(const float*)args.in[I_X], (float*)(ws + WS_GSF)  , mod + 2048, SEQ, 6144, nullptr};
        const bool first = ((blockIdx.x >> 3) & 1) != 0;
        if (first) { expert_weight_copy(args, lds, lane, wave); __syncthreads(); }
        pg8::gemm_phase<pg8::EpiOut, pg8::StaticOrder, true, true>(lds, g, S, E);
        if (!first) { __syncthreads(); expert_weight_copy(args, lds, lane, wave); } }
    if constexpr (P == 6) { pg8::Gemm g{(const pg8::bf16_t*)(ws + WS_MIX), (const pg8::bf16_t*)(ws + WS_WOUTT), TT, DM, DM}; pg8::StaticOrder S; S.init(TT, DM, G, (int)blockIdx.x);
        pg8::EpiOut E{(const float*)args.in[I_X], (float*)(ws + WS_GSF)  , mod + 2048, SEQ, 6144, nullptr}; pg8::gemm_phase<pg8::EpiOut, pg8::StaticOrder, true, true>(lds, g, S, E); }
    if constexpr (P == 81) { SchedET<1> S; S.init((const unsigned*)(ws + WS_CTL) + CW_ECNT, (const int2*)(ws + WS_EREC), (const char*)(ws + WS_WGUT), G, (int)blockIdx.x, lane);
        EpiGU E{(bf16*)(ws + WS_HID)}; pg8::gemm_phase_g<EpiGU, SchedET<1>>(lds, (const pg8::bf16_t*)(ws + WS_H), 1024, 1024, 16, 16, S, E); }
    if constexpr (P == 8) { SchedE S; S.init((const unsigned*)(ws + WS_CTL) + CW_ECNT, (const int2*)(ws + WS_EREC), (const char*)(ws + WS_WGUT), G, (int)blockIdx.x, lane);
        EpiGU E{(bf16*)(ws + WS_HID)}; pg8::gemm_phase_g<EpiGU, SchedE>(lds, (const pg8::bf16_t*)(ws + WS_H), 1024, 1024, 16, 16, S, E); }
    if constexpr (P == 71) norm_route_mfma<true, 1>(args, args.out, (const float*)(ws + WS_SSQ), (const float*)args.in[I_NORM_FFN], mod + 3072, mod + 4096, (bf16*)(ws + WS_PROJ + 32 * MiB), lds, tid, lane, wave);
    if constexpr (P == 7) norm_route_mfma<true>(args, args.out, (const float*)(ws + WS_SSQ), (const float*)args.in[I_NORM_FFN], mod + 3072, mod + 4096, (bf16*)(ws + WS_PROJ + 32 * MiB), lds, tid, lane, wave);
    if constexpr (P == 91 || P == 92) { SchedC S; S.init((const unsigned*)(ws + WS_CTL) + CW_CCNT, (const int*)(ws + WS_CLIST), (const char*)(ws + WS_WDT), G, (int)blockIdx.x, lane);
        EpiDownT<P - 90> E{(float*)(ws + WS_PROJ + 32 * MiB), mod + 5120, nullptr}; pg8::gemm_phase_g<EpiDownT<P - 90>, SchedC>(lds, (const pg8::bf16_t*)(ws + WS_HID), 512, 256, 8, 4, S, E); }
    if constexpr (P == 9) { SchedC S; S.init((const unsigned*)(ws + WS_CTL) + CW_CCNT, (const int*)(ws + WS_CLIST), (const char*)(ws + WS_WDT), G, (int)blockIdx.x, lane);
        EpiDown E{(float*)(ws + WS_PROJ + 32 * MiB), mod + 5120, nullptr}; pg8::gemm_phase_g<EpiDown, SchedC>(lds, (const pg8::bf16_t*)(ws + WS_HID), 512, 256, 8, 4, S, E); }
}
#endif
extern "C" void kernel_launch(void* const* d_in, const int* in_sizes, int n_in, void* d_out, int out_size, void* d_ws, size_t ws_size, hipStream_t stream) {
    static int grid = 0;
    if (grid == 0) {
        if (n_in != 23 || in_sizes[0] != TT * DM || out_size != TT * DM || ws_size < WS_END) { fprintf(stderr, "kernel_launch: unexpected shapes: n_in %d in0 %d out %d ws %zu (need %zu)\n", n_in, n_in > 0 ? in_sizes[0] : -1, out_size, ws_size, (size_t)WS_END); grid = -1; return; }
        int dev = 0, cus = 0, per_cu = 0;
        if (hipGetDevice(&dev) != hipSuccess || hipDeviceGetAttribute(&cus, hipDeviceAttributeMultiprocessorCount, dev) != hipSuccess) { grid = -1; return; }
        if (hipFuncSetAttribute((const void*)fwd_kernel, hipFuncAttributeMaxDynamicSharedMemorySize, LDS_BYTES) != hipSuccess) { fprintf(stderr, "kernel_launch: hipFuncSetAttribute failed\n"); grid = -1; return; }
        if (hipOccupancyMaxActiveBlocksPerMultiprocessor(&per_cu, (const void*)fwd_kernel, NTHR, LDS_BYTES) != hipSuccess || per_cu < 1) fprintf(stderr, "kernel_launch: occupancy query reports %d\n", per_cu);
        (void)hipGetLastError();
        grid = cus;
    }
    if (grid < 0) return;
    if (hipMemsetAsync((char*)d_ws + WS_CTL, 0, CTL_ZERO_BYTES, stream) != hipSuccess) { fprintf(stderr, "kernel_launch: memset failed\n"); return; }
    Args a{};
    for (int i = 0; i < 23; ++i) a.in[i] = d_in[i];
    a.out = (float*)d_out; a.ws = (unsigned char*)d_ws;
#if MK_ONE_LAUNCH
    a.ph_lo = 0; a.ph_hi = N_PHASES;
    hipLaunchKernelGGL(fwd_kernel, dim3(grid), dim3(NTHR), LDS_BYTES, stream, a);
#if PROBE_REP >= 0 && PROBE_REP < 1000
    hipFuncSetAttribute((const void*)probe_kernel<PROBE_REP>, hipFuncAttributeMaxDynamicSharedMemorySize, LDS_BYTES);
    hipLaunchKernelGGL(probe_kernel<PROBE_REP>, dim3(grid), dim3(NTHR), LDS_BYTES, stream, a);
#endif
#else
    for (int p = 0; p < N_PHASES; ++p) { a.ph_lo = p; a.ph_hi = p + 1; hipLaunchKernelGGL(fwd_kernel, dim3(grid), dim3(NTHR), LDS_BYTES, stream, a); }
#endif
}
```

```cpp
#include <hip/hip_runtime.h>
#include <cstdio>
#include <cstdint>
namespace pg8 {
#define PG8_LAS __attribute__((address_space(3)))
typedef unsigned short bf16_t;
typedef short bf16x8 __attribute__((ext_vector_type(8)));
typedef float f32x4 __attribute__((ext_vector_type(4)));
typedef unsigned u32x4 __attribute__((ext_vector_type(4)));
constexpr int BM = 256, BK = 64, HALF = 128, HTB = HALF * BK * 2  , STAGE_BYTES = 8 * HTB, NXCD = 8, WGM = 8;

__host__ __device__ __forceinline__ int lds_byte(int r, int c) { const int st = (r >> 4) * 2 + (c >> 5), rr = r & 15, cc = c & 31, ob = rr * 64 + cc * 2; return st * 1024 + (ob ^ (((ob >> 9) & 1) << 5)); }
__host__ __device__ __forceinline__ void stage_rc(int b, int& R, int& C) { const int st = b / 1024, sb = b % 1024, swz = sb ^ (((sb >> 9) & 1) << 5); R = (st >> 1) * 16 + swz / 64; C = (st & 1) * 32 + (swz % 64) / 2; }
__host__ __device__ __forceinline__ int perm32(int rho) { const int n = rho >> 4, i = rho & 15; return 8 * (i >> 2) + 4 * n + (i & 3); }

struct Unit { int pm, pn; };
struct Gemm { const bf16_t* A; const bf16_t* Bt; int M, N, K; };

struct StaticOrder {
    int nM, nN, nwg, G, c;
    __host__ __device__ void init(int M, int N, int G_, int c_) { nM = M / BM; nN = N / BM; nwg = nM * nN; G = G_; c = c_; }
    __host__ __device__ bool next(int i, Unit& u) const {
        const long L = (long)i * G + c; if (L >= nwg) return false;
        int wgid = (int)L; { const int q = nwg / NXCD, r = nwg % NXCD, xcd = wgid % NXCD, off = wgid / NXCD; wgid = (xcd < r ? xcd * (q + 1) : r * (q + 1) + (xcd - r) * q) + off; }
        const int nig = WGM * nN, gid = wgid / nig, fm = gid * WGM, gsz = (nM - fm) < WGM ? (nM - fm) : WGM;
        u.pm = fm + ((wgid % nig) % gsz); u.pn = (wgid % nig) / gsz; return true;
    }
    __device__ __forceinline__ void a_ready(const Unit&) const {}
    __device__ __forceinline__ void done(const Unit&) const {}
};

__device__ __forceinline__ unsigned cvt_pk_bf16(float lo, float hi) { unsigned r; asm volatile("v_cvt_pk_bf16_f32 %0, %1, %2" : "=v"(r) : "v"(lo), "v"(hi)); return r; }

__device__ __forceinline__ void store16_wt(void* base, unsigned byte_off, u32x4 v) {
    __amdgpu_buffer_rsrc_t r = __builtin_amdgcn_make_buffer_rsrc(base, 0, 0x7fffffff, 0x00020000);
    __builtin_amdgcn_raw_buffer_store_b128(v, r, (int)byte_off, 0, 16);
}
struct EpiProj {
    static constexpr bool PERM = true, AFTER_DRAIN = false, PREFETCH = false;
    bf16_t* P; float* AB; int ldp;
    __device__ __forceinline__ void operator()(const f32x4 (&acc)[2][2][4][2], const Unit& u, int wr, int wc, int fr, int fq) const {
        const int row0 = u.pm * BM + wr * 64 + fr;
        if (u.pn < 11) {
            const int col0 = u.pn * BM + wc * 32 + 8 * fq;
#pragma unroll
            for (int ai = 0; ai < 2; ++ai)
#pragma unroll
                for (int m = 0; m < 4; ++m) { const unsigned ro = ((unsigned)(row0 + ai * HALF + m * 16) * (unsigned)ldp + (unsigned)col0) * 2u;
#pragma unroll
                    for (int bj = 0; bj < 2; ++bj) { const f32x4 v0 = acc[ai][bj][m][0], v1 = acc[ai][bj][m][1];
                        u32x4 w; w.x = cvt_pk_bf16(v0[0], v0[1]); w.y = cvt_pk_bf16(v0[2], v0[3]); w.z = cvt_pk_bf16(v1[0], v1[1]); w.w = cvt_pk_bf16(v1[2], v1[3]);
                        *(u32x4*)((char*)P + ro + (unsigned)(bj * HALF) * 2u) = w; } }
        } else if (wc == 0 && fq < 2) {
#pragma unroll
            for (int ai = 0; ai < 2; ++ai)
#pragma unroll
                for (int m = 0; m < 4; ++m) { float* rowp = AB + (size_t)(row0 + ai * HALF + m * 16) * 16 + 8 * fq;
                    *(f32x4*)(rowp) = acc[ai][0][m][0]; *(f32x4*)(rowp + 4) = acc[ai][0][m][1]; }
        }
    }
};
struct EpiOut {
    static constexpr bool PERM = false, AFTER_DRAIN = false, PREFETCH = false;
    const float* X; float* O; const float* gate; int rows_per_batch, ldg;
    float* SSQ;
    __device__ __forceinline__ void prefetch(PG8_LAS unsigned char* lds, const Unit& u, int tid) const {
        const char* base = (const char*)X + ((size_t)(u.pm * BM) * 1024 + (size_t)u.pn * BM) * 4 + (size_t)(tid >> 3) * 4096 + (size_t)(tid & 7) * 128;
#pragma unroll
        for (int i = 0; i < 4; ++i) __builtin_amdgcn_global_load_lds((const unsigned*)(base + (size_t)i * 64 * 4096), (PG8_LAS unsigned*)(lds + STAGE_BYTES + 256), 4, 0, 0);
    }
    __device__ __forceinline__ void operator()(const f32x4 (&acc)[2][2][4][2], const Unit& u, int wr, int wc, int fr, int fq) const {
        const int row0 = u.pm * BM + wr * 64 + fr, col0 = u.pn * BM + wc * 32 + 4 * fq;
        const float* gb = gate + (size_t)((u.pm * BM) / rows_per_batch) * ldg + col0;
        f32x4 gv[2][2];
#pragma unroll
        for (int bj = 0; bj < 2; ++bj)
#pragma unroll
            for (int n = 0; n < 2; ++n) gv[bj][n] = *(const f32x4*)(gb + bj * HALF + n * 16);
#pragma unroll
        for (int ai = 0; ai < 2; ++ai)
#pragma unroll
            for (int m = 0; m < 4; ++m) { const size_t ro = (size_t)(row0 + ai * HALF + m * 16) * 1024 + col0; float ss = 0.f;
#pragma unroll
                for (int bj = 0; bj < 2; ++bj)
#pragma unroll
                    for (int n = 0; n < 2; ++n) { const f32x4 xv = *(const f32x4*)(X + ro + bj * HALF + n * 16); const f32x4 v = xv + gv[bj][n] * acc[ai][bj][m][n];
                        *(f32x4*)(O + ro + bj * HALF + n * 16) = v; ss += (v.x * v.x + v.y * v.y) + (v.z * v.z + v.w * v.w); }
                if (SSQ) { ss += __shfl_xor(ss, 16); ss += __shfl_xor(ss, 32); if (fq == 0) SSQ[(size_t)(row0 + ai * HALF + m * 16) * 16 + u.pn * 4 + wc] = ss; } }
    }
};

struct UnitG { int id, tile, pn, nrows; };
typedef int i32x8 __attribute__((ext_vector_type(8)));
typedef int i32x4 __attribute__((ext_vector_type(4)));
__device__ __forceinline__ i32x8 cat8(bf16x8 a, bf16x8 b) { const i32x4 x = __builtin_bit_cast(i32x4, a), y = __builtin_bit_cast(i32x4, b); return __builtin_shufflevector(x, y, 0, 1, 2, 3, 4, 5, 6, 7); }
template <class Epi, class Sched, bool F8 = false>
__device__ __forceinline__ void gemm_phase_g(PG8_LAS unsigned char* lds, const bf16_t* Abase, const int KA, const int KB, const int nt_, const int ksplit, const Sched& S, const Epi& E) {
    const int tid = threadIdx.x, wid = __builtin_amdgcn_readfirstlane(tid >> 6), lane = tid & 63, wr = wid >> 2, wc = wid & 3, fr = lane & 15, fq = lane >> 4;
    int Rr[2]; unsigned cB2[2], voffB[2];
#pragma unroll
    for (int i = 0; i < 2; ++i) { int R, C; stage_rc(tid * 16 + i * 8192, R, C); const int Rb = Epi::PERM ? ((R & ~31) + perm32(R & 31)) : R;
        Rr[i] = R; cB2[i] = (unsigned)C * 2u; voffB[i] = (unsigned)(Rb * KB + C) * 2u; }
    const size_t kstep = (size_t)(BK * 2);
    const size_t hstepB = (size_t)HALF * KB * 2;
    const unsigned ldsw = (unsigned)wid * 1024u;
    const int aoff = lds_byte(wr * 64 + fr, fq * 8), boff = lds_byte(wc * 32 + fr, fq * 8);
#define PG8_SA(b, h) (((b) * 2 + (h)) * HTB)
#define PG8_SB(b, h) ((4 + (b) * 2 + (h)) * HTB)
#define PG8_STAGE2(bufoff, gbase, v0, v1) do { \
        __builtin_amdgcn_global_load_lds((const unsigned*)((const char*)(gbase) + (v0)), (PG8_LAS unsigned*)(lds + (bufoff) + ldsw), 16, 0, 0); \
        __builtin_amdgcn_global_load_lds((const unsigned*)((const char*)(gbase) + (v1)), (PG8_LAS unsigned*)(lds + (bufoff) + ldsw + 8192), 16, 0, 0); } while (0)
#define PG8_LDA(dst, b, h) do { _Pragma("unroll") for (int m = 0; m < 4; ++m) _Pragma("unroll") for (int k = 0; k < 2; ++k) dst[m][k] = *(const PG8_LAS bf16x8*)(lds + PG8_SA(b, h) + aoff + m * 2048 + k * 1024); } while (0)
#define PG8_LDB(dst, b, h) do { _Pragma("unroll") for (int n = 0; n < 2; ++n) _Pragma("unroll") for (int k = 0; k < 2; ++k) dst[n][k] = *(const PG8_LAS bf16x8*)(lds + PG8_SB(b, h) + boff + n * 2048 + k * 1024); } while (0)
#define PG8_MMA(ai, bj, At, Bt) do { __builtin_amdgcn_s_setprio(1); \
        if constexpr (F8) { _Pragma("unroll") for (int m = 0; m < 4; ++m) _Pragma("unroll") for (int n = 0; n < 2; ++n) \
            acc[ai][bj][m][n] = __builtin_amdgcn_mfma_scale_f32_16x16x128_f8f6f4(cat8(Bt[n][0], Bt[n][1]), cat8(At[m][0], At[m][1]), acc[ai][bj][m][n], 0, 0, 0, 0x7f7f7f7f, 0, 0x7f7f7f7f); \
            _Pragma("unroll") for (int m = 0; m < 4; ++m) _Pragma("unroll") for (int n = 0; n < 2; ++n) asm volatile("" : "+v"(acc[ai][bj][m][n])); }   \
        else { _Pragma("unroll") for (int m = 0; m < 4; ++m) _Pragma("unroll") for (int n = 0; n < 2; ++n) _Pragma("unroll") for (int k = 0; k < 2; ++k) \
            acc[ai][bj][m][n] = __builtin_amdgcn_mfma_f32_16x16x32_bf16(Bt[n][k], At[m][k], acc[ai][bj][m][n], 0, 0, 0); } \
        __builtin_amdgcn_s_setprio(0); } while (0)
#define PG8_WAIT_V(n) asm volatile("s_waitcnt vmcnt(" #n ")" ::: "memory")
#define PG8_WAIT_L(n) asm volatile("s_waitcnt lgkmcnt(" #n ")" ::: "memory")
#define PG8_BAR __builtin_amdgcn_s_barrier()
#define PG8_SCHED __builtin_amdgcn_sched_barrier(0)
#define PG8_AOFFS(u, o00, o01, o10, o11) do { const unsigned _ks = (unsigned)KA * 2u; \
        o00 = (unsigned)S.tok(u, Rr[0]) * _ks + cB2[0]; o01 = (unsigned)S.tok(u, Rr[1]) * _ks + cB2[1]; \
        o10 = (unsigned)S.tok(u, HALF + Rr[0]) * _ks + cB2[0]; o11 = (unsigned)S.tok(u, HALF + Rr[1]) * _ks + cB2[1]; } while (0)
#define PG8_BT(u, t) (((t) < ksplit) ? S.bseg(u, 0) + (size_t)(t) * kstep : S.bseg(u, 1) + (size_t)((t) - ksplit) * kstep)
    UnitG cur, nxt; int ui = 0;
    int nt = nt_; asm volatile("" : "+s"(nt));
    if (!S.next(0, cur)) return;
    f32x4 acc[2][2][4][2];
#pragma unroll
    for (int a = 0; a < 2; ++a)
#pragma unroll
        for (int b = 0; b < 2; ++b)
#pragma unroll
            for (int m = 0; m < 4; ++m)
#pragma unroll
                for (int n = 0; n < 2; ++n) acc[a][b][m][n] = (f32x4){0.f, 0.f, 0.f, 0.f};
    bf16x8 At[4][2], B0[2][2], B1[2][2];
    unsigned c00, c01, c10, c11, n00 = 0, n01 = 0, n10 = 0, n11 = 0;
    PG8_AOFFS(cur, c00, c01, c10, c11);
    if constexpr (Epi::PREFETCH) E.prefetch(lds, cur, S, tid);
    const char* const Ab = (const char*)Abase;
    {   const char* b0p = PG8_BT(cur, 0); const char* b1p = PG8_BT(cur, 1);
        PG8_STAGE2(PG8_SB(0, 0), b0p, voffB[0], voffB[1]); PG8_STAGE2(PG8_SB(0, 1), b0p + hstepB, voffB[0], voffB[1]); PG8_STAGE2(PG8_SA(0, 0), Ab, c00, c01); PG8_STAGE2(PG8_SA(0, 1), Ab, c10, c11);
        if (wr == 1) PG8_BAR;
        PG8_WAIT_V(2); PG8_BAR;
        PG8_STAGE2(PG8_SB(1, 0), b1p, voffB[0], voffB[1]); PG8_STAGE2(PG8_SA(1, 0), Ab + kstep, c00, c01); PG8_STAGE2(PG8_SB(1, 1), b1p + hstepB, voffB[0], voffB[1]);
        PG8_WAIT_V(6); PG8_BAR;
    }
    for (;;) {
        const bool has_next = S.next(ui + 1, nxt);
        const bool h1 = cur.nrows > HALF;
#pragma unroll 1
        for (int t = 0; t < nt; t += 2) {
            const bool last = (t == nt - 2);
            if (last && has_next) { PG8_AOFFS(nxt, n00, n01, n10, n11); if constexpr (Epi::PREFETCH) E.prefetch(lds, nxt, S, tid); }
            const bool usen = last && has_next;
            const int t2 = last ? 0 : t + 2, t3 = t2 + 1;
            const char* a1 = Ab + (size_t)(t + 1) * kstep;
            const char* a2 = Ab + (size_t)t2 * kstep; const char* a3 = Ab + (size_t)t3 * kstep;
            const char* b2 = usen ? PG8_BT(nxt, t2) : PG8_BT(cur, t2); const char* b3 = usen ? PG8_BT(nxt, t3) : PG8_BT(cur, t3);
            const unsigned o00 = usen ? n00 : c00, o01 = usen ? n01 : c01, o10 = usen ? n10 : c10, o11 = usen ? n11 : c11;
            PG8_LDB(B0, 0, 0); PG8_LDB(B1, 0, 1); PG8_SCHED; PG8_LDA(At, 0, 0); PG8_STAGE2(PG8_SA(1, 1), a1, c10, c11);
            PG8_WAIT_V(8); PG8_WAIT_L(0); PG8_BAR; PG8_MMA(0, 0, At, B0); PG8_MMA(0, 1, At, B1); PG8_BAR; PG8_SCHED;
            PG8_LDA(At, 0, 1); PG8_STAGE2(PG8_SB(0, 0), b2, voffB[0], voffB[1]); PG8_STAGE2(PG8_SB(0, 1), b2 + hstepB, voffB[0], voffB[1]); PG8_STAGE2(PG8_SA(0, 0), a2, o00, o01);
            PG8_WAIT_V(8); PG8_WAIT_L(0); PG8_BAR; if (h1) { PG8_MMA(1, 0, At, B0); PG8_MMA(1, 1, At, B1); } PG8_BAR; PG8_SCHED;
            PG8_LDB(B0, 1, 0); PG8_LDB(B1, 1, 1); PG8_SCHED; PG8_LDA(At, 1, 0); PG8_STAGE2(PG8_SA(0, 1), a2, o10, o11);
            PG8_WAIT_V(8); PG8_WAIT_L(0); PG8_BAR; PG8_MMA(0, 0, At, B0); PG8_MMA(0, 1, At, B1); PG8_BAR; PG8_SCHED;
            PG8_LDA(At, 1, 1); PG8_STAGE2(PG8_SB(1, 0), b3, voffB[0], voffB[1]); PG8_STAGE2(PG8_SB(1, 1), b3 + hstepB, voffB[0], voffB[1]); PG8_STAGE2(PG8_SA(1, 0), a3, o00, o01);
            PG8_WAIT_V(8); PG8_WAIT_L(0); PG8_BAR; if (h1) { PG8_MMA(1, 0, At, B0); PG8_MMA(1, 1, At, B1); } PG8_BAR; PG8_SCHED;
        }
        if (wr == 0) PG8_BAR;
        E(acc, cur, S, wr, wc, fr, fq);
        if (!has_next) break;
#pragma unroll
        for (int a = 0; a < 2; ++a)
#pragma unroll
            for (int b = 0; b < 2; ++b)
#pragma unroll
                for (int m = 0; m < 4; ++m)
#pragma unroll
                    for (int n = 0; n < 2; ++n) acc[a][b][m][n] = (f32x4){0.f, 0.f, 0.f, 0.f};
        cur = nxt; c00 = n00; c01 = n01; c10 = n10; c11 = n11; ++ui;
        if (wr == 1) PG8_BAR;
    }
    PG8_WAIT_V(0);
    PG8_BAR;
#undef PG8_SA
#undef PG8_SB
#undef PG8_STAGE2
#undef PG8_LDA
#undef PG8_LDB
#undef PG8_MMA
#undef PG8_WAIT_V
#undef PG8_WAIT_L
#undef PG8_BAR
#undef PG8_SCHED
#undef PG8_AOFFS
#undef PG8_BT
}
template <class Epi, class Sched, bool ALIGN_EPI = false, bool SP2 = false>
__device__ __forceinline__ void gemm_phase(PG8_LAS unsigned char* lds, const Gemm g, const Sched& S, const Epi& E) {
    const int tid = threadIdx.x, wid = __builtin_amdgcn_readfirstlane(tid >> 6), lane = tid & 63, wr = wid >> 2, wc = wid & 3, fr = lane & 15, fq = lane >> 4;
    const int K = g.K, nt = K / BK;
    unsigned voffA[2], voffB[2];
#pragma unroll
    for (int i = 0; i < 2; ++i) { int R, C; stage_rc(tid * 16 + i * 8192, R, C); const int Rb = Epi::PERM ? ((R & ~31) + perm32(R & 31)) : R;
        voffA[i] = (unsigned)(R * K + C) * 2u; voffB[i] = (unsigned)(Rb * K + C) * 2u; }
    const size_t kstep = (size_t)(BK * 2);
    const size_t hstep = (size_t)HALF * K * 2;
    const size_t tstep = 2 * hstep;
    const unsigned ldsw = (unsigned)wid * 1024u;
    const int aoff = lds_byte(wr * 64 + fr, fq * 8), boff = lds_byte(wc * 32 + fr, fq * 8);
#define PG8_SA(b, h) (((b) * 2 + (h)) * HTB)
#define PG8_SB(b, h) ((4 + (b) * 2 + (h)) * HTB)
#define PG8_STAGE(bufoff, gbase, voff) do { _Pragma("unroll") for (int _i = 0; _i < 2; ++_i) \
        __builtin_amdgcn_global_load_lds((const unsigned*)((const char*)(gbase) + (voff)[_i]), (PG8_LAS unsigned*)(lds + (bufoff) + ldsw + _i * 8192), 16, 0, 0); } while (0)
#define PG8_LDA(dst, b, h) do { _Pragma("unroll") for (int m = 0; m < 4; ++m) _Pragma("unroll") for (int k = 0; k < 2; ++k) dst[m][k] = *(const PG8_LAS bf16x8*)(lds + PG8_SA(b, h) + aoff + m * 2048 + k * 1024); } while (0)
#define PG8_LDB(dst, b, h) do { _Pragma("unroll") for (int n = 0; n < 2; ++n) _Pragma("unroll") for (int k = 0; k < 2; ++k) dst[n][k] = *(const PG8_LAS bf16x8*)(lds + PG8_SB(b, h) + boff + n * 2048 + k * 1024); } while (0)
#define PG8_MMA(ai, bj, At, Bt) do { __builtin_amdgcn_s_setprio(1); _Pragma("unroll") for (int m = 0; m < 4; ++m) _Pragma("unroll") for (int n = 0; n < 2; ++n) _Pragma("unroll") for (int k = 0; k < 2; ++k) \
        acc[ai][bj][m][n] = __builtin_amdgcn_mfma_f32_16x16x32_bf16(Bt[n][k], At[m][k], acc[ai][bj][m][n], 0, 0, 0); __builtin_amdgcn_s_setprio(0); } while (0)
#define PG8_WAIT_V(n) asm volatile("s_waitcnt vmcnt(" #n ")" ::: "memory")
#define PG8_WAIT_L(n) asm volatile("s_waitcnt lgkmcnt(" #n ")" ::: "memory")
#define PG8_BAR __builtin_amdgcn_s_barrier()
#define PG8_SCHED __builtin_amdgcn_sched_barrier(0)
    Unit cur, nxt; int ui = 0;
    if (!S.next(0, cur)) return;
    f32x4 acc[2][2][4][2];
#pragma unroll
    for (int a = 0; a < 2; ++a)
#pragma unroll
        for (int b = 0; b < 2; ++b)
#pragma unroll
            for (int m = 0; m < 4; ++m)
#pragma unroll
                for (int n = 0; n < 2; ++n) acc[a][b][m][n] = (f32x4){0.f, 0.f, 0.f, 0.f};
    bf16x8 At[4][2], B0[2][2], B1[2][2];
    const char* cA = (const char*)g.A + (size_t)cur.pm * tstep; const char* cB = (const char*)g.Bt + (size_t)cur.pn * tstep;
    S.a_ready(cur);
    if constexpr (SP2) {
        PG8_STAGE(PG8_SB(0, 0), cB, voffB); PG8_STAGE(PG8_SB(0, 1), cB + hstep, voffB); PG8_STAGE(PG8_SA(0, 0), cA, voffA); PG8_STAGE(PG8_SA(0, 1), cA + hstep, voffA);
        if (wr == 1) PG8_BAR;
        PG8_WAIT_V(2); PG8_BAR;
        PG8_STAGE(PG8_SB(1, 0), cB + kstep, voffB); PG8_STAGE(PG8_SA(1, 0), cA + kstep, voffA); PG8_STAGE(PG8_SB(1, 1), cB + hstep + kstep, voffB);
        PG8_WAIT_V(6); PG8_BAR;
    } else {
        PG8_STAGE(PG8_SB(0, 0), cB, voffB); PG8_STAGE(PG8_SA(0, 0), cA, voffA); PG8_STAGE(PG8_SB(0, 1), cB + hstep, voffB); PG8_STAGE(PG8_SA(0, 1), cA + hstep, voffA);
        if (wr == 1) PG8_BAR;
        PG8_WAIT_V(4); PG8_BAR;
        PG8_STAGE(PG8_SB(1, 0), cB + kstep, voffB); PG8_STAGE(PG8_SA(1, 0), cA + kstep, voffA); PG8_STAGE(PG8_SB(1, 1), cB + hstep + kstep, voffB);
        PG8_WAIT_V(6); PG8_BAR;
    }
    if constexpr (Epi::PREFETCH) E.prefetch(lds, cur, tid);
    for (;;) {
        const bool has_next = S.next(ui + 1, nxt);
        const char* nA = has_next ? (const char*)g.A + (size_t)nxt.pm * tstep : cA; const char* nB = has_next ? (const char*)g.Bt + (size_t)nxt.pn * tstep : cB;
        for (int t = 0; t < nt; t += 2) {
            const bool last = (t == nt - 2);
            const char* a1 = cA + (size_t)(t + 1) * kstep;
            const char* a2 = last ? nA : cA + (size_t)(t + 2) * kstep; const char* b2 = last ? nB : cB + (size_t)(t + 2) * kstep;
            const char* a3 = a2 + kstep; const char* b3 = b2 + kstep;
            if (last && has_next) S.a_ready(nxt);
            if constexpr (SP2) {
            PG8_LDB(B0, 0, 0); PG8_LDB(B1, 0, 1); PG8_SCHED; PG8_LDA(At, 0, 0); PG8_STAGE(PG8_SA(1, 1), a1 + hstep, voffA);
            PG8_WAIT_V(8); PG8_WAIT_L(0); PG8_BAR; PG8_MMA(0, 0, At, B0); PG8_MMA(0, 1, At, B1); PG8_BAR; PG8_SCHED;
            PG8_LDA(At, 0, 1); PG8_STAGE(PG8_SB(0, 0), b2, voffB); PG8_STAGE(PG8_SB(0, 1), b2 + hstep, voffB); PG8_STAGE(PG8_SA(0, 0), a2, voffA);
            PG8_WAIT_V(8); PG8_WAIT_L(0); PG8_BAR; PG8_MMA(1, 0, At, B0); PG8_MMA(1, 1, At, B1); PG8_BAR; PG8_SCHED;
            PG8_LDB(B0, 1, 0); PG8_LDB(B1, 1, 1); PG8_SCHED; PG8_LDA(At, 1, 0); PG8_STAGE(PG8_SA(0, 1), a2 + hstep, voffA);
            PG8_WAIT_V(8); PG8_WAIT_L(0); PG8_BAR; PG8_MMA(0, 0, At, B0); PG8_MMA(0, 1, At, B1); PG8_BAR; PG8_SCHED;
            PG8_LDA(At, 1, 1); PG8_STAGE(PG8_SB(1, 0), b3, voffB); PG8_STAGE(PG8_SB(1, 1), b3 + hstep, voffB); PG8_STAGE(PG8_SA(1, 0), a3, voffA);
            PG8_WAIT_V(8); PG8_WAIT_L(0); PG8_BAR; PG8_MMA(1, 0, At, B0); PG8_MMA(1, 1, At, B1); PG8_BAR; PG8_SCHED;
            } else {
            PG8_LDB(B0, 0, 0); PG8_SCHED; PG8_LDA(At, 0, 0); PG8_STAGE(PG8_SA(1, 1), a1 + hstep, voffA);
            PG8_WAIT_L(8); PG8_BAR; PG8_WAIT_L(0); PG8_MMA(0, 0, At, B0); PG8_BAR; PG8_SCHED;
            PG8_LDB(B1, 0, 1); PG8_STAGE(PG8_SB(0, 0), b2, voffB);
            PG8_BAR; PG8_WAIT_L(0); PG8_MMA(0, 1, At, B1); PG8_BAR;
            PG8_LDA(At, 0, 1); PG8_STAGE(PG8_SA(0, 0), a2, voffA);
            PG8_BAR; PG8_WAIT_L(0); PG8_MMA(1, 0, At, B0); PG8_BAR; PG8_SCHED;
            PG8_STAGE(PG8_SB(0, 1), b2 + hstep, voffB);
            PG8_WAIT_V(6); PG8_BAR; PG8_MMA(1, 1, At, B1); PG8_BAR;
            PG8_LDB(B0, 1, 0); PG8_SCHED; PG8_LDA(At, 1, 0); PG8_STAGE(PG8_SA(0, 1), a2 + hstep, voffA);
            PG8_WAIT_L(8); PG8_BAR; PG8_WAIT_L(0); PG8_MMA(0, 0, At, B0); PG8_BAR; PG8_SCHED;
            PG8_LDB(B1, 1, 1); PG8_STAGE(PG8_SB(1, 0), b3, voffB);
            PG8_BAR; PG8_WAIT_L(0); PG8_MMA(0, 1, At, B1); PG8_BAR;
            PG8_LDA(At, 1, 1); PG8_STAGE(PG8_SA(1, 0), a3, voffA);
            PG8_BAR; PG8_WAIT_L(0); PG8_MMA(1, 0, At, B0); PG8_BAR; PG8_SCHED;
            PG8_STAGE(PG8_SB(1, 1), b3 + hstep, voffB);
            PG8_WAIT_V(6); PG8_BAR; PG8_MMA(1, 1, At, B1); PG8_BAR;
            }
        }
        if constexpr (ALIGN_EPI) { if (wr == 0) PG8_BAR; }
        if constexpr (!Epi::AFTER_DRAIN) { E(acc, cur, wr, wc, fr, fq); S.done(cur); }
        if (!has_next) break;
#pragma unroll
        for (int a = 0; a < 2; ++a)
#pragma unroll
            for (int b = 0; b < 2; ++b)
#pragma unroll
                for (int m = 0; m < 4; ++m)
#pragma unroll
                    for (int n = 0; n < 2; ++n) acc[a][b][m][n] = (f32x4){0.f, 0.f, 0.f, 0.f};
        cur = nxt; cA = nA; cB = nB; ++ui;
        if constexpr (Epi::PREFETCH) { int l_ = fr + 16 * fq; asm volatile("" : "+v"(l_)); E.prefetch(lds, cur, wid * 64 + l_); }
        if constexpr (ALIGN_EPI) { if (wr == 1) PG8_BAR; }
    }
    PG8_WAIT_V(0);
    if constexpr (!ALIGN_EPI) { if (wr == 0) PG8_BAR; }
    PG8_BAR;
    if constexpr (Epi::AFTER_DRAIN) { E.fused(acc, cur, wr, wc, fr, fq, lds, wid, lane); S.done(cur); }
#undef PG8_SA
#undef PG8_SB
#undef PG8_STAGE
#undef PG8_LDA
#undef PG8_LDB
#undef PG8_MMA
#undef PG8_WAIT_V
#undef PG8_WAIT_L
#undef PG8_BAR
#undef PG8_SCHED
}
}

constexpr int NB = 4, SEQ = 8192, DM = 1024, TT = NB * SEQ;
constexpr int NPROJ = 2816, NPAD = 3072;
constexpr int PC_Q = 0, PC_K = 512, PC_V = 1024, PC_Z = 1536, PC_SQ = 2048, PC_SK = 2560, PC_SV = 2688;
constexpr int NE = 32, NCLS = 112, DE = 256;
constexpr float EPS = 1e-6f;
constexpr int NWAVES = 8, NTHR = 512;
constexpr int N_PHASES = 10;
#ifndef G1_SM
#define G1_SM 31
#endif
#ifndef PROBE_REP
#define PROBE_REP -1
#endif
#ifndef MK_ONE_LAUNCH
#define MK_ONE_LAUNCH 1
#endif

constexpr size_t MiB = 1u << 20;
constexpr size_t WS_CTL = 0, CTL_ZERO_BYTES = 65536;
constexpr size_t WS_MOD = 1 * MiB;
constexpr size_t WS_WINT = 2 * MiB, WS_WOUTT = 8 * MiB, WS_WGUT = 10 * MiB, WS_WDT = 42 * MiB;
constexpr size_t WS_H = 58 * MiB;
constexpr size_t WS_PROJ = 122 * MiB;
constexpr size_t WS_AB = 298 * MiB;
constexpr size_t WS_SSQ = WS_AB;
constexpr size_t WS_MIX = 300 * MiB;
constexpr size_t WS_GSF = 364 * MiB;
constexpr size_t WS_EREC = 404 * MiB, WS_CLIST = 412 * MiB;
constexpr size_t WS_HID = WS_PROJ;
constexpr size_t WS_GAP = WS_H, WS_GQP = WS_H + 32 * MiB;
constexpr size_t WS_GOP = 426 * MiB, WS_GBP = 458 * MiB, WS_GGL = 490 * MiB;
constexpr size_t WS_WRT = 491 * MiB;
constexpr size_t WS_END = 492 * MiB;
constexpr int CW_BAR = 4096, CW_ECNT = 8192, CW_CCNT = 8256;

constexpr int RING_BYTES = 131072, LDSCTL_OFF = RING_BYTES, LDS_BYTES = 147456, MISC_OFF = LDS_BYTES - 128;

#define GAS __attribute__((address_space(1)))
#define LAS __attribute__((address_space(3)))
typedef unsigned short bf16;
typedef unsigned v4u __attribute__((ext_vector_type(4)));
typedef float f32x4 __attribute__((ext_vector_type(4)));
typedef GAS unsigned gu32;
#define RLX_AGENT __ATOMIC_RELAXED, __HIP_MEMORY_SCOPE_AGENT
#define LDS_WAIT() asm volatile("s_waitcnt lgkmcnt(0)" ::: "memory")
__device__ __forceinline__ unsigned f2bf(float f) { unsigned u = __builtin_bit_cast(unsigned, f); return (u + 0x7fffu + ((u >> 16) & 1u)) >> 16; }
__device__ __forceinline__ unsigned pk2(float lo, float hi) { return f2bf(lo) | (f2bf(hi) << 16); }
__device__ __forceinline__ float bf2f(bf16 v) { return __builtin_bit_cast(float, (unsigned)v << 16); }
__device__ __forceinline__ float wave_sum(float v) {
#pragma unroll
    for (int o = 1; o < 64; o <<= 1) v += __shfl_xor(v, o);
    return v;
}
__device__ __forceinline__ float siluf(float y) { return y / (1.f + __expf(-y)); }
#define XB_TMO      128
#define XB_XCNT(j)  (256  + 64 * (j))
#define XB_XSUB(j)  (1280 + 64 * (j))
#define XB_XGEN(j)  (2304 + 64 * (j))
#define XB_TOP      3328
#define XB_TOPGEN   3392
#define XCD_BAR_WORDS 3456
#define XB_SPIN_CAP (1u << 18)
__device__ __forceinline__ unsigned xb_ld(unsigned* p)              { return __hip_atomic_load(p, __ATOMIC_RELAXED, __HIP_MEMORY_SCOPE_AGENT); }
__device__ __forceinline__ unsigned xb_add(unsigned* p, unsigned v) { return __hip_atomic_fetch_add(p, v, __ATOMIC_RELAXED, __HIP_MEMORY_SCOPE_AGENT); }
__device__ __forceinline__ unsigned xb_xcc_id() { return (unsigned)__builtin_amdgcn_s_getreg((3 << 11) | 20) & 0xFu; }
#define XB_SPIN(cond, bar) do { unsigned _sp = 0; while (cond) { __builtin_amdgcn_s_sleep(1); \
    if ((++_sp & 255u) == 0u) { if (xb_ld(&(bar)[XB_TMO])) break; if (_sp > XB_SPIN_CAP) { atomicAdd(&(bar)[XB_TMO], 1u); break; } } } } while (0)

struct XcdBarrier {
    unsigned* bar; unsigned x;
    volatile LAS unsigned* st;
};

__device__ __forceinline__ XcdBarrier xcd_barrier_post(unsigned* bar, volatile LAS unsigned* st, bool leader  ) {
    XcdBarrier b; b.bar = bar; b.x = xb_xcc_id(); b.st = st;
    if (leader) (void)xb_add(&bar[XB_XCNT(b.x)], 1u);
    return b;
}
__device__ __forceinline__ void xcd_barrier_complete(unsigned* bar, unsigned x, unsigned& nloc, unsigned& nx) {
    const unsigned G = gridDim.x * gridDim.y * gridDim.z;
    unsigned sum, cnt, mine, sp = 0u;
    for (;;) {
        sum = 0u; cnt = 0u; mine = 0u;
#pragma unroll
        for (unsigned j = 0; j < 16; ++j) { const unsigned c = xb_ld(&bar[XB_XCNT(j)]); sum += c; cnt += (c > 0u) ? 1u : 0u; mine = (j == x) ? c : mine; }
        if (sum == G) break;
        __builtin_amdgcn_s_sleep(1);
        if ((++sp & 255u) == 0u) { if (xb_ld(&bar[XB_TMO])) break; if (sp > XB_SPIN_CAP) { atomicAdd(&bar[XB_TMO], 1u); break; } }
    }
    nloc = mine > 0u ? mine : 1u; nx = cnt > 0u ? cnt : 1u;
}

__device__ __forceinline__ void xcd_barrier(const XcdBarrier& b, bool leader  ) {
    asm volatile("s_waitcnt vmcnt(0)" ::: "memory");
    __syncthreads();
    if (leader) {
        unsigned* bar = b.bar;
        __builtin_amdgcn_s_waitcnt(0);
        unsigned nloc = b.st[0], nx = b.st[1];
        if (nloc == 0u) { xcd_barrier_complete(bar, b.x, nloc, nx); b.st[0] = nloc; b.st[1] = nx; }
        const unsigned old = xb_add(&bar[XB_XSUB(b.x)], 1u);
        const unsigned gen = old / nloc;
        if (old + 1u == (gen + 1u) * nloc) {
            __builtin_amdgcn_fence(__ATOMIC_RELEASE, "agent");
            asm volatile("s_waitcnt vmcnt(0)" ::: "memory");
            const unsigned og = xb_add(&bar[XB_TOP], 1u);
            const unsigned tg = og / nx;
            if (og + 1u == (tg + 1u) * nx) xb_add(&bar[XB_TOPGEN], 1u);
            else XB_SPIN(xb_ld(&bar[XB_TOPGEN]) == tg, bar);
            __builtin_amdgcn_fence(__ATOMIC_ACQUIRE, "agent");
            xb_add(&bar[XB_XGEN(b.x)], 1u);
            asm volatile("s_waitcnt vmcnt(0)" ::: "memory");
        } else {
            XB_SPIN(xb_ld(&bar[XB_XGEN(b.x)]) == gen, bar);
            __builtin_amdgcn_fence(__ATOMIC_ACQUIRE, "agent");
            asm volatile("s_waitcnt vmcnt(0)" ::: "memory");
        }
    }
    __syncthreads();
}

struct Args { const void* in[23]; float* out; unsigned char* ws; int ph_lo, ph_hi; };
enum { I_X = 0, I_C, I_POS, I_WADA, I_BADA, I_NORM_MIX, I_WIN, I_CONVW, I_ALOG, I_DTB, I_GNORM, I_QNORM, I_KNORM, I_SINKS, I_WOUT, I_NORM_FFN, I_WGRP, I_BGRP, I_WRT, I_BRT, I_WGATE, I_WUP, I_WDOWN };


__device__ __forceinline__ unsigned pk4f8(float a, float b, float c, float d) {
    a = __builtin_amdgcn_fmed3f(a, -448.f, 448.f); b = __builtin_amdgcn_fmed3f(b, -448.f, 448.f); c = __builtin_amdgcn_fmed3f(c, -448.f, 448.f); d = __builtin_amdgcn_fmed3f(d, -448.f, 448.f);
    int v = 0; v = __builtin_amdgcn_cvt_pk_fp8_f32(a, b, v, false); v = __builtin_amdgcn_cvt_pk_fp8_f32(c, d, v, true); return (unsigned)v; }
typedef unsigned v2u8_t __attribute__((ext_vector_type(2)));
constexpr float W8_SCALE = 64.f, HID8_SCALE = 8.f;
template <class CM>
__device__ __forceinline__ void transpose_item(const float* W, int ldw, int k0, bf16* WT, int ldt, int n0, CM cm, LAS float* scr, int lane) {
    const int sc = cm(n0 + (lane & 31));
    float tv[32];
#pragma unroll
    for (int i = 0; i < 32; ++i) { const int kk = 2 * i + (lane >> 5); tv[i] = W[(size_t)(k0 + kk) * ldw + (sc >= 0 ? sc : 0)]; }
#pragma unroll
    for (int i = 0; i < 32; ++i) { const int kk = 2 * i + (lane >> 5); scr[kk * 33 + (lane & 31)] = sc >= 0 ? tv[i] : 0.f; }
    LDS_WAIT(); asm volatile("" ::: "memory");
    const int c = lane & 7;
#pragma unroll
    for (int j = 0; j < 4; ++j) { const int n = (lane >> 3) + 8 * j; const LAS float* s = scr + (8 * c) * 33 + n;
        v4u o; o.x = pk2(s[0 * 33], s[1 * 33]); o.y = pk2(s[2 * 33], s[3 * 33]); o.z = pk2(s[4 * 33], s[5 * 33]); o.w = pk2(s[6 * 33], s[7 * 33]);
        *(v4u*)(WT + (size_t)(n0 + n) * ldt + k0 + 8 * c) = o; }
    LDS_WAIT(); asm volatile("" ::: "memory");
}
template <class CM>
__device__ __forceinline__ void transpose_item8(const float* W, int ldw, int k0, unsigned char* WT, int ldt, int n0, CM cm, LAS float* scr, int lane, float scl) {
    const int sc = cm(n0 + (lane & 31));
    float tv[32];
#pragma unroll
    for (int i = 0; i < 32; ++i) { const int kk = 2 * i + (lane >> 5); tv[i] = W[(size_t)(k0 + kk) * ldw + (sc >= 0 ? sc : 0)]; }
#pragma unroll
    for (int i = 0; i < 32; ++i) { const int kk = 2 * i + (lane >> 5); scr[kk * 33 + (lane & 31)] = sc >= 0 ? tv[i] * scl : 0.f; }
    LDS_WAIT(); asm volatile("" ::: "memory");
    const int c = lane & 7;
#pragma unroll
    for (int j = 0; j < 4; ++j) { const int n = (lane >> 3) + 8 * j; const LAS float* s = scr + (8 * c) * 33 + n;
        v2u8_t o; o.x = pk4f8(s[0 * 33], s[1 * 33], s[2 * 33], s[3 * 33]); o.y = pk4f8(s[4 * 33], s[5 * 33], s[6 * 33], s[7 * 33]);
        *(v2u8_t*)(WT + (size_t)(n0 + n) * ldt + k0 + 8 * c) = o; }
    LDS_WAIT(); asm volatile("" ::: "memory");
}
struct CmIn { __device__ __forceinline__ int operator()(int n) const { return n < 2048 ? n : (n < 2816 ? n + 16 : (n < 2832 ? 2048 + (n - 2816) : -1)); } };
struct CmOff { int off; __device__ __forceinline__ int operator()(int n) const { return n + off; } };
struct CmId { __device__ __forceinline__ int operator()(int n) const { return n; } };

__device__ __forceinline__ void expert_weight_copy(const Args& A, LAS unsigned char* lds, int lane, int wave) {
    unsigned char* ws = A.ws;
    LAS float* scr = (LAS float*)(lds + wave * 8448);
    const int G = gridDim.x, gw = blockIdx.x * NWAVES + wave, NGW = G * NWAVES;
    {   constexpr int IT_GU = NE * 16 * 16, IT_D = NE * 32 * 4;
        const float* wgate = (const float*)A.in[I_WGATE]; const float* wup = (const float*)A.in[I_WUP]; const float* wdown = (const float*)A.in[I_WDOWN];
        for (int it = gw; it < IT_GU + IT_D; it += NGW) {
            if (it < IT_GU) { const int e = it >> 8, r = it & 255, nb = r & 15, kb = r >> 4, j = nb >> 3, q = nb & 7;
                const float* W = (q < 4 ? wgate : wup) + (size_t)e * 1024 * 256; const int col0 = j * 128 + (q & 3) * 32;
                transpose_item8(W, 256, kb * 64, ws + WS_WGUT + (size_t)e * 512 * 1024, 1024, nb * 32, CmOff{col0 - nb * 32}, scr, lane, W8_SCALE); }
            else { const int r2 = it - IT_GU, e = r2 >> 7, r = r2 & 127, nb = r & 31, kb = r >> 5;
                transpose_item8(wdown + (size_t)e * 256 * 1024, 1024, kb * 64, ws + WS_WDT + (size_t)e * 1024 * 256, 256, nb * 32, CmId(), scr, lane, W8_SCALE); }
        }
    }
}
__device__ __forceinline__ void p0_prologue(const Args& A, LAS unsigned char* lds, int tid, int lane, int wave) {
    unsigned char* ws = A.ws;
    LAS float* scr = (LAS float*)(lds + wave * 8448);
    const int G = gridDim.x, gw = blockIdx.x * NWAVES + wave, NGW = G * NWAVES;
    constexpr int IT_IN = (NPAD / 32) * (DM / 64), IT_OUT = (DM / 32) * (DM / 64);
    for (int it = gw; it < IT_IN + IT_OUT; it += NGW) {
        if (it < IT_IN) { const int nb = it % (NPAD / 32), kb = it / (NPAD / 32); transpose_item((const float*)A.in[I_WIN], 2832, kb * 64, (bf16*)(ws + WS_WINT), DM, nb * 32, CmIn(), scr, lane); }
        else { const int r = it - IT_IN, nb = r % (DM / 32), kb = r / (DM / 32); transpose_item((const float*)A.in[I_WOUT], DM, kb * 64, (bf16*)(ws + WS_WOUTT), DM, nb * 32, CmId(), scr, lane); }
    }
    {   const float* wgp = (const float*)A.in[I_WGRP]; const float* wrt = (const float*)A.in[I_WRT];
        bf16* wf = (bf16*)(ws + WS_WRT);
        for (int idx = blockIdx.x * NTHR + tid; idx < 48 * 1024; idx += G * NTHR) { const int j = idx & 7, ln = (idx >> 3) & 63, ks = (idx >> 9) & 31, nt = idx >> 14;
            const int o = 16 * nt + (ln & 15), k = 32 * ks + 8 * (ln >> 4) + j;
            const float w = o < 4 ? wgp[k * 4 + o] : (o < 36 ? wrt[k * 32 + o - 4] : 0.f);
            const unsigned hb = f2bf(w); wf[idx] = (bf16)hb; wf[48 * 1024 + idx] = (bf16)f2bf(w - __builtin_bit_cast(float, hb << 16)); }
    }
    LAS float* cact = (LAS float*)(lds + 69632);
    LAS float* red = (LAS float*)(lds + 69632 + 16384);
    const float* c = (const float*)A.in[I_C]; const float* wada = (const float*)A.in[I_WADA]; const float* bada = (const float*)A.in[I_BADA];
    float* mod = (float*)(ws + WS_MOD);
    if ((int)blockIdx.x < 192) {
        __syncthreads();
        for (int i = tid; i < 4096; i += NTHR) cact[i] = siluf(c[i]);
        __syncthreads();
        for (int u = blockIdx.x; u < 192; u += G) {
            const int n = u * 32 + (lane & 31), kh = lane >> 5; float a0 = 0.f, a1 = 0.f, a2 = 0.f, a3 = 0.f;
#pragma unroll 16
            for (int i = 0; i < 64; ++i) { const int k = wave * 128 + 2 * i + kh; const float w = wada[(size_t)k * 6144 + n]; a0 += cact[k] * w; a1 += cact[1024 + k] * w; a2 += cact[2048 + k] * w; a3 += cact[3072 + k] * w; }
            a0 += __shfl_xor(a0, 32); a1 += __shfl_xor(a1, 32); a2 += __shfl_xor(a2, 32); a3 += __shfl_xor(a3, 32);
            if (lane < 32) { red[(wave * 4 + 0) * 64 + lane] = a0; red[(wave * 4 + 1) * 64 + lane] = a1; red[(wave * 4 + 2) * 64 + lane] = a2; red[(wave * 4 + 3) * 64 + lane] = a3; }
            __syncthreads();
            if (tid < 128) { const int b = tid >> 5, l = tid & 31; float s = bada[u * 32 + l];
#pragma unroll
                for (int w = 0; w < 8; ++w) s += red[(w * 4 + b) * 64 + l];
                mod[b * 6144 + u * 32 + l] = s; }
            __syncthreads();
        }
    }
}

template <bool ROUTE>
__device__ __forceinline__ void norm_rows(const Args& A, const float* X, const float* gain, const float* shift, const float* scale, bf16* H, LAS unsigned char* lds, int lane, int wave) {
    LAS float* hl = (LAS float*)(lds + wave * 4096);
    const int G = gridDim.x, gw = blockIdx.x * NWAVES + wave, NGW = G * NWAVES;
    unsigned char* ws = A.ws;
    for (int r0 = gw * 16; r0 < TT; r0 += NGW * 16) {
        const int b = r0 / SEQ;
        f32x4 mf[4], af[4];
#pragma unroll
        for (int j = 0; j < 4; ++j) { const int col = 4 * lane + 256 * j; const f32x4 g = *(const f32x4*)(gain + col), sc = *(const f32x4*)(scale + b * 6144 + col);
            mf[j] = g * (sc + 1.0f); af[j] = *(const f32x4*)(shift + b * 6144 + col); }
#pragma unroll 4
        for (int i = 0; i < 16; ++i) {
            const int row = r0 + i;
            const f32x4* xr = (const f32x4*)(X + (size_t)row * DM) + lane;
            f32x4 v[4]; float s = 0.f;
#pragma unroll
            for (int j = 0; j < 4; ++j) { v[j] = xr[64 * j]; s += (v[j].x * v[j].x + v[j].y * v[j].y) + (v[j].z * v[j].z + v[j].w * v[j].w); }
            const float rstd = 1.f / sqrtf(wave_sum(s) * (1.f / DM) + EPS);
            unsigned long long* o8 = (unsigned long long*)(H + (size_t)row * DM) + lane;
#pragma unroll
            for (int j = 0; j < 4; ++j) { v[j] = v[j] * rstd * mf[j] + af[j];
                o8[64 * j] = (unsigned long long)pk2(v[j].x, v[j].y) | ((unsigned long long)pk2(v[j].z, v[j].w) << 32); }
            if constexpr (ROUTE) {
                const float* wg = (const float*)A.in[I_WGRP]; const float* wr = (const float*)A.in[I_WRT];
                float lg[36];
#pragma unroll
                for (int o = 0; o < 36; ++o) lg[o] = 0.f;
#pragma unroll
                for (int j = 0; j < 4; ++j) *(LAS f32x4*)(hl + 4 * lane + 256 * j) = v[j];
                LDS_WAIT(); asm volatile("" ::: "memory");
#pragma unroll 1
                for (int ii = 0; ii < 16; ++ii) { const int k = lane + 64 * ii; const float hv = hl[k];
                    const f32x4 g4 = *(const f32x4*)(wg + k * 4);
                    lg[0] += hv * g4.x; lg[1] += hv * g4.y; lg[2] += hv * g4.z; lg[3] += hv * g4.w;
#pragma unroll
                    for (int q = 0; q < 8; ++q) { const f32x4 r4 = *(const f32x4*)(wr + k * 32 + q * 4);
                        lg[4 + q * 4 + 0] += hv * r4.x; lg[4 + q * 4 + 1] += hv * r4.y; lg[4 + q * 4 + 2] += hv * r4.z; lg[4 + q * 4 + 3] += hv * r4.w; } }
                LDS_WAIT(); asm volatile("" ::: "memory");
#pragma unroll
                for (int o = 0; o < 36; ++o) lg[o] = wave_sum(lg[o]);
                const float* bg = (const float*)A.in[I_BGRP]; const float* br = (const float*)A.in[I_BRT];
#pragma unroll
                for (int o = 0; o < 4; ++o) lg[o] += bg[o];
#pragma unroll
                for (int o = 0; o < 32; ++o) lg[4 + o] += br[o];
                int gi = 0; float gm = lg[0];
#pragma unroll
                for (int o = 1; o < 4; ++o) if (lg[o] > gm) { gm = lg[o]; gi = o; }
                float gs = 0.f;
#pragma unroll
                for (int o = 0; o < 4; ++o) gs += __expf(lg[o] - gm);
                const float pg = 1.f / gs;
                float le[8];
#pragma unroll
                for (int j = 0; j < 8; ++j) { le[j] = lg[4 + j];
#pragma unroll
                    for (int g = 1; g < 4; ++g) le[j] = (gi == g) ? lg[4 + g * 8 + j] : le[j]; }
                int j1 = 0; float m1 = le[0];
#pragma unroll
                for (int j = 1; j < 8; ++j) if (le[j] > m1) { m1 = le[j]; j1 = j; }
                int j2 = -1; float m2 = -3.0e38f;
#pragma unroll
                for (int j = 0; j < 8; ++j) if (j != j1 && le[j] > m2) { m2 = le[j]; j2 = j; }
                const float ex = __expf(m2 - m1), w1 = pg / (1.f + ex), w2 = pg * ex / (1.f + ex);
                if (lane == 0) {
                    const int e1 = gi * 8 + j1, e2 = gi * 8 + j2;
                    unsigned* ctl = (unsigned*)(ws + WS_CTL);
                    int2* erec = (int2*)(ws + WS_EREC); int* clist = (int*)(ws + WS_CLIST);
                    const unsigned p1 = atomicAdd(ctl + CW_ECNT + e1, 1u); erec[(size_t)e1 * TT + p1] = make_int2(row * 2 + (e1 > e2 ? 1 : 0), __builtin_bit_cast(int, w1));
                    const unsigned p2 = atomicAdd(ctl + CW_ECNT + e2, 1u); erec[(size_t)e2 * TT + p2] = make_int2(row * 2 + (e2 > e1 ? 1 : 0), __builtin_bit_cast(int, w2));
                    const int a = j1 < j2 ? j1 : j2, bb = j1 < j2 ? j2 : j1;
                    const int cls = gi * 28 + (a * 7 - (a * (a - 1)) / 2 + (bb - a - 1));
                    const unsigned pc = atomicAdd(ctl + CW_CCNT + cls, 1u); clist[(size_t)cls * TT + pc] = row;
                }
            }
        }
    }
}

typedef short bf16x8_t __attribute__((ext_vector_type(8)));
typedef float f32x16 __attribute__((ext_vector_type(16)));
typedef unsigned v2u __attribute__((ext_vector_type(2)));
typedef float f32x2_t __attribute__((ext_vector_type(2)));
typedef __bf16 bf16x2_t __attribute__((ext_vector_type(2)));
__device__ __forceinline__ unsigned cvtpk(float lo, float hi) { const f32x2_t f = {lo, hi}; return __builtin_bit_cast(unsigned, __builtin_convertvector(f, bf16x2_t)); }
__device__ __forceinline__ void fast_sincos(float ang, float& sn, float& cs) {
    float rev = ang * 0.15915494309189535f; rev -= floorf(rev);
    sn = __builtin_amdgcn_sinf(rev); cs = __builtin_amdgcn_cosf(rev);
}
__device__ __forceinline__ void swa_mfma(const Args& A, LAS unsigned char* lds, int tid, int lane, int wave, int blk, int nblk) {
    unsigned char* ws = A.ws;
    const bf16* proj = (const bf16*)(ws + WS_PROJ);
    bf16* mix = (bf16*)(ws + WS_MIX); const float* sinks = (const float*)A.in[I_SINKS];
    const int* pos = (const int*)A.in[I_POS]; const float* qn = (const float*)A.in[I_QNORM]; const float* kn = (const float*)A.in[I_KNORM];
    constexpr int KST = 144, VST = 520;
    LAS unsigned char* Kl = lds; LAS unsigned char* Vt = lds + 256 * KST;
    const int g = wave >> 1, qh = wave & 1, ql = lane & 31, hh = lane >> 5;
    constexpr float LOG2E = 1.4426950408889634f, CS = 0.125f * LOG2E, L2T = 13.287712379549449f / 32.f;
    const int sch = tid & 7;
    float kinv[8], kgn[8];
#pragma unroll
    for (int j = 0; j < 8; ++j) { kinv[j] = __builtin_amdgcn_exp2f(-(float)((sch & 3) * 8 + j) * L2T); kgn[j] = kn[sch * 8 + j]; }
    float qinv[2][8];
#pragma unroll
    for (int ks = 0; ks < 2; ++ks)
#pragma unroll
        for (int j = 0; j < 8; ++j) qinv[ks][j] = __builtin_amdgcn_exp2f(-(float)(ks * 16 + hh * 8 + j) * L2T);
    for (int u = blk; u < NB * 2 * (SEQ / 128); u += nblk) {
        const int n = u & 63, kvh = (u >> 6) & 1, b = u >> 7;
        const int tb = b * SEQ + n * 128;
        __syncthreads();
#pragma unroll
        for (int it = 0; it < 4; ++it) { const int idx = tid + it * NTHR, key = idx >> 3, ch = idx & 7; int tk = tb - 128 + key; if (tk < b * SEQ) tk = b * SEQ;
            const v4u kv = *(const v4u*)(proj + (size_t)tk * NPROJ + PC_SK + kvh * 64 + ch * 8);
            const v4u vv = *(const v4u*)(proj + (size_t)tk * NPROJ + PC_SV + kvh * 64 + ch * 8);
            const float pf = (float)pos[tk];
            float x[8] = { __builtin_bit_cast(float, kv.x << 16), __builtin_bit_cast(float, kv.x & 0xffff0000u), __builtin_bit_cast(float, kv.y << 16), __builtin_bit_cast(float, kv.y & 0xffff0000u),
                           __builtin_bit_cast(float, kv.z << 16), __builtin_bit_cast(float, kv.z & 0xffff0000u), __builtin_bit_cast(float, kv.w << 16), __builtin_bit_cast(float, kv.w & 0xffff0000u) };
            float ss = 0.f;
#pragma unroll
            for (int j = 0; j < 8; ++j) ss += x[j] * x[j];
            ss += __shfl_xor(ss, 1); ss += __shfl_xor(ss, 2); ss += __shfl_xor(ss, 4);
            const float rn = 1.f / sqrtf(ss * (1.f / 64.f) + EPS);
            float o[8];
#pragma unroll
            for (int j = 0; j < 8; ++j) { const float xn = x[j] * rn * kgn[j]; const float pr = __shfl_xor(xn, 4); float sn, cs; fast_sincos(pf * kinv[j], sn, cs);
                o[j] = (ch < 4) ? xn * cs - pr * sn : pr * sn + xn * cs; }
            v4u ko; ko.x = cvtpk(o[0], o[1]); ko.y = cvtpk(o[2], o[3]); ko.z = cvtpk(o[4], o[5]); ko.w = cvtpk(o[6], o[7]);
            *(LAS v4u*)(Kl + key * KST + ch * 16) = ko;
            LAS unsigned short* vp = (LAS unsigned short*)(Vt + (ch * 8) * VST + key * 2);
            vp[0 * (VST / 2)] = (unsigned short)(vv.x & 0xffffu); vp[1 * (VST / 2)] = (unsigned short)(vv.x >> 16);
            vp[2 * (VST / 2)] = (unsigned short)(vv.y & 0xffffu); vp[3 * (VST / 2)] = (unsigned short)(vv.y >> 16);
            vp[4 * (VST / 2)] = (unsigned short)(vv.z & 0xffffu); vp[5 * (VST / 2)] = (unsigned short)(vv.z >> 16);
            vp[6 * (VST / 2)] = (unsigned short)(vv.w & 0xffffu); vp[7 * (VST / 2)] = (unsigned short)(vv.w >> 16); }
        __syncthreads();
        const int hq = kvh * 4 + g; const float sinkl = sinks[hq] * LOG2E;
#pragma unroll 1
        for (int qt = 0; qt < 2; ++qt) {
            const int i0 = qh * 64 + qt * 32, iq = i0 + ql;
            const size_t tq = (size_t)(tb + iq);
            bf16x8_t qf[4];
            {   float xq[4][8]; float ss = 0.f;
#pragma unroll
                for (int ks = 0; ks < 4; ++ks) { const v4u r = *(const v4u*)(proj + tq * NPROJ + PC_SQ + hq * 64 + ks * 16 + hh * 8);
                    xq[ks][0] = __builtin_bit_cast(float, r.x << 16); xq[ks][1] = __builtin_bit_cast(float, r.x & 0xffff0000u); xq[ks][2] = __builtin_bit_cast(float, r.y << 16); xq[ks][3] = __builtin_bit_cast(float, r.y & 0xffff0000u);
                    xq[ks][4] = __builtin_bit_cast(float, r.z << 16); xq[ks][5] = __builtin_bit_cast(float, r.z & 0xffff0000u); xq[ks][6] = __builtin_bit_cast(float, r.w << 16); xq[ks][7] = __builtin_bit_cast(float, r.w & 0xffff0000u);
#pragma unroll
                    for (int j = 0; j < 8; ++j) ss += xq[ks][j] * xq[ks][j]; }
                ss += __shfl_xor(ss, 32);
                const float rn = 1.f / sqrtf(ss * (1.f / 64.f) + EPS); const float pf = (float)pos[tq];
#pragma unroll
                for (int ks = 0; ks < 4; ++ks)
#pragma unroll
                    for (int j = 0; j < 8; ++j) xq[ks][j] *= rn * qn[ks * 16 + hh * 8 + j];
#pragma unroll
                for (int ks = 0; ks < 2; ++ks)
#pragma unroll
                    for (int j = 0; j < 8; ++j) { float sn, cs; fast_sincos(pf * qinv[ks][j], sn, cs); const float x1 = xq[ks][j], x2 = xq[ks + 2][j];
                        xq[ks][j] = x1 * cs - x2 * sn; xq[ks + 2][j] = x1 * sn + x2 * cs; }
#pragma unroll
                for (int ks = 0; ks < 4; ++ks) { union { bf16x8_t v; unsigned u[4]; } p; p.u[0] = cvtpk(xq[ks][0], xq[ks][1]); p.u[1] = cvtpk(xq[ks][2], xq[ks][3]); p.u[2] = cvtpk(xq[ks][4], xq[ks][5]); p.u[3] = cvtpk(xq[ks][6], xq[ks][7]); qf[ks] = p.v; }
            }
            f32x16 sc[5];
#pragma unroll
            for (int kt = 0; kt < 5; ++kt) { f32x16 acc;
#pragma unroll
                for (int r = 0; r < 16; ++r) acc[r] = 0.f;
#pragma unroll
                for (int ks = 0; ks < 4; ++ks) { const bf16x8_t kf = *(const LAS bf16x8_t*)(Kl + (i0 + 32 * kt + ql) * KST + (ks * 16 + hh * 8) * 2);
                    acc = __builtin_amdgcn_mfma_f32_32x32x16_bf16(kf, qf[ks], acc, 0, 0, 0); }
                sc[kt] = acc; }
            float mloc = -3.0e38f;
#pragma unroll
            for (int kt = 0; kt < 5; ++kt) {
                if (kt == 0 || kt == 4 || n == 0) {
#pragma unroll
                    for (int r = 0; r < 16; ++r) { const int j = i0 + 32 * kt + (r & 3) + 8 * (r >> 2) + 4 * hh;
                        const bool valid = (j > iq) && (j <= iq + 128) && (n > 0 || j >= 128);
                        const float sv = valid ? sc[kt][r] * CS : -1.0e30f; sc[kt][r] = sv; mloc = fmaxf(mloc, sv); }
                } else {
#pragma unroll
                    for (int r = 0; r < 16; ++r) { const float sv = sc[kt][r] * CS; sc[kt][r] = sv; mloc = fmaxf(mloc, sv); }
                } }
            float mx = fmaxf(mloc, __shfl_xor(mloc, 32)); mx = fmaxf(mx, sinkl);
            float lsum = 0.f;
#pragma unroll
            for (int kt = 0; kt < 5; ++kt)
#pragma unroll
                for (int r = 0; r < 16; ++r) { const float p = __builtin_amdgcn_exp2f(sc[kt][r] - mx); sc[kt][r] = p; lsum += p; }
            lsum += __shfl_xor(lsum, 32); lsum += __builtin_amdgcn_exp2f(sinkl - mx);
            f32x16 o0, o1;
#pragma unroll
            for (int r = 0; r < 16; ++r) { o0[r] = 0.f; o1[r] = 0.f; }
#pragma unroll
            for (int kt = 0; kt < 5; ++kt)
#pragma unroll
                for (int s2 = 0; s2 < 2; ++s2) {
                    union { bf16x8_t v; unsigned u[4]; } pf;
#pragma unroll
                    for (int p = 0; p < 4; ++p) pf.u[p] = cvtpk(sc[kt][8 * s2 + 2 * p], sc[kt][8 * s2 + 2 * p + 1]);
                    const int jb = i0 + 32 * kt + 16 * s2 + 4 * hh;
                    union { bf16x8_t v; v2u u[2]; } v0, v1;
                    const LAS unsigned char* r0 = Vt + ql * VST + jb * 2; const LAS unsigned char* r1 = Vt + (32 + ql) * VST + jb * 2;
                    v0.u[0] = *(const LAS v2u*)(r0); v0.u[1] = *(const LAS v2u*)(r0 + 16);
                    v1.u[0] = *(const LAS v2u*)(r1); v1.u[1] = *(const LAS v2u*)(r1 + 16);
                    o0 = __builtin_amdgcn_mfma_f32_32x32x16_bf16(v0.v, pf.v, o0, 0, 0, 0);
                    o1 = __builtin_amdgcn_mfma_f32_32x32x16_bf16(v1.v, pf.v, o1, 0, 0, 0);
                }
            const float il = 1.f / lsum;
            bf16* op = mix + tq * DM + 512 + hq * 64 + 4 * hh;
#pragma unroll
            for (int rq = 0; rq < 4; ++rq) {
                v2u w0; w0.x = cvtpk(o0[4 * rq] * il, o0[4 * rq + 1] * il); w0.y = cvtpk(o0[4 * rq + 2] * il, o0[4 * rq + 3] * il);
                *(v2u*)(op + 8 * rq) = w0;
                v2u w1; w1.x = cvtpk(o1[4 * rq] * il, o1[4 * rq + 1] * il); w1.y = cvtpk(o1[4 * rq + 2] * il, o1[4 * rq + 3] * il);
                *(v2u*)(op + 32 + 8 * rq) = w1; }
        }
    }
}

__device__ __forceinline__ int frag_a_idx(int row, int col) { const int mt = row >> 4, l15 = row & 15, ks = col >> 5, x = col & 31, jh = x >> 4, g4 = (x >> 2) & 3, jl = x & 3; return ((mt * 2 + ks) * 64 + g4 * 16 + l15) * 8 + 4 * jh + jl; }
__device__ __forceinline__ int frag_c_idx(int row, int col) { const int w = col >> 4, l15 = col & 15, mt = row >> 4, y = row & 15, g4 = y >> 2, i = y & 3; return ((w * 64 + g4 * 16 + l15) * 4 + mt) * 4 + i; }
__device__ __forceinline__ void gdn_g1_naive(const Args& A, LAS float* L, int tid) {
    unsigned char* ws = A.ws;
    const bf16* proj = (const bf16*)(ws + WS_PROJ); const float* ab = (const float*)(ws + WS_AB);
    bf16* AP = (bf16*)(ws + WS_GAP); bf16* BP = (bf16*)(ws + WS_GBP); bf16* QP = (bf16*)(ws + WS_GQP); bf16* OP = (bf16*)(ws + WS_GOP); float* GL = (float*)(ws + WS_GGL);
    const float* convw = (const float*)A.in[I_CONVW];
    constexpr int LD = 65, AR = 64 * LD;
    LAS float* q = L; LAS float* k = q + AR; LAS float* v = k + AR; LAS float* Mm = v + AR; LAS float* At = Mm + AR; LAS float* w = At + AR;
    LAS float* Gc = w + AR; LAS float* beta = Gc + 64;
    const int i8 = tid >> 3, e0 = (tid & 7) * 8;
    for (int cid = blockIdx.x; cid < NB * 8 * 128; cid += gridDim.x) {
        const int n = cid & 127, bh = cid >> 7, b = bh >> 3, h = bh & 7;
        const float Ah = expf(((const float*)A.in[I_ALOG])[h]), dtb = ((const float*)A.in[I_DTB])[h];
        const int t0 = b * SEQ + n * 64;
        __syncthreads();
        for (int idx = tid; idx < 3 * 4096; idx += NTHR) {
            const int part = idx >> 12, rem = idx & 4095, i = rem >> 6, d = rem & 63, c = part * 512 + h * 64 + d;
            float y = 0.f;
#pragma unroll
            for (int j = 0; j < 4; ++j) { const int s = n * 64 + i - 3 + j; if (s >= 0) y += convw[j * 1536 + c] * bf2f(proj[(size_t)(b * SEQ + s) * NPROJ + c]); }
            y = y / (1.f + __expf(-y));
            (part == 0 ? q : (part == 1 ? k : v))[i * LD + d] = y;
        }
        if (tid < 64) { const float a = ab[(size_t)(t0 + tid) * 16 + h], bb = ab[(size_t)(t0 + tid) * 16 + 8 + h]; const float xx = a + dtb;
            const float sp = xx > 20.f ? xx : log1pf(expf(xx)); Gc[tid] = -Ah * sp; beta[tid] = 1.f / (1.f + __expf(-bb)); }
        __syncthreads();
        if (tid < 128) { LAS float* arr = tid < 64 ? q : k; const int i = tid & 63; float ss = 0.f;
            for (int d = 0; d < 64; ++d) ss += arr[i * LD + d] * arr[i * LD + d];
            const float r = (1.f / sqrtf(ss + EPS)) * (tid < 64 ? 0.125f : 1.f);
            for (int d = 0; d < 64; ++d) arr[i * LD + d] *= r; }
        if (tid == 128) { float run = 0.f; for (int i = 0; i < 64; ++i) { run += Gc[i]; Gc[i] = run; } }
        __syncthreads();
        {   const int i = i8;
            for (int jj = 0; jj < 8; ++jj) { const int j = e0 + jj; float dq = 0.f, dk = 0.f;
_Pragma("unroll 2") for (int d = 0; d < 64; ++d) { const float kj = k[j * LD + d]; dq += q[i * LD + d] * kj; dk += k[i * LD + d] * kj; }
                const float dec = (i >= j) ? __expf(Gc[i] - Gc[j]) : 0.f;
                At[i * LD + j] = dq * dec; Mm[i * LD + j] = (i > j) ? dk * beta[i] * dec : 0.f; }
        }
        __syncthreads();
        for (int idx = tid; idx < 4096; idx += NTHR) { const int i = idx >> 6, d = idx & 63; v[i * LD + d] *= beta[i]; w[i * LD + d] = k[i * LD + d] * beta[i] * __expf(Gc[i]); }
        __syncthreads();
        if (tid < 128) { LAS float* arr = tid < 64 ? v : w; const int c = tid & 63;
            _Pragma("unroll 1") for (int i = 1; i < 64; ++i) { float a = arr[i * LD + c]; _Pragma("unroll 4") for (int j = 0; j < i; ++j) a -= Mm[i * LD + j] * arr[j * LD + c]; arr[i * LD + c] = a; } }
        __syncthreads();
        const float gl = Gc[63];
        const size_t cb = (size_t)cid * 4096;
        {
            const int d = i8; float a[8], bq[8];
#pragma unroll
            for (int ee = 0; ee < 8; ++ee) { a[ee] = 0.f; bq[ee] = 0.f; }
_Pragma("unroll 2")
            for (int c = 0; c < 64; ++c) { const float kd = k[c * LD + d] * __expf(gl - Gc[c]);
#pragma unroll
                for (int ee = 0; ee < 8; ++ee) { a[ee] -= kd * w[c * LD + e0 + ee]; bq[ee] += kd * v[c * LD + e0 + ee]; } }
#pragma unroll
            for (int ee = 0; ee < 8; ++ee) { const int dp = e0 + ee; AP[cb + frag_a_idx(d, dp)] = (bf16)f2bf(a[ee]); BP[cb + frag_c_idx(d, dp)] = (bf16)f2bf(bq[ee]); }
        }
        {
            const int c = i8; float a[8], bq[8]; const float eg = __expf(Gc[c]);
#pragma unroll
            for (int ee = 0; ee < 8; ++ee) { a[ee] = eg * q[c * LD + e0 + ee]; bq[ee] = 0.f; }
_Pragma("unroll 2")
            for (int s2 = 0; s2 <= c; ++s2) { const float av = At[c * LD + s2];
#pragma unroll
                for (int ee = 0; ee < 8; ++ee) { a[ee] -= av * w[s2 * LD + e0 + ee]; bq[ee] += av * v[s2 * LD + e0 + ee]; } }
#pragma unroll
            for (int ee = 0; ee < 8; ++ee) { const int dp = e0 + ee; QP[cb + frag_a_idx(c, dp)] = (bf16)f2bf(a[ee]); OP[cb + frag_c_idx(c, dp)] = (bf16)f2bf(bq[ee]); }
        }
        if (tid == 0) GL[cid] = __expf(gl);
    }
}
__device__ __forceinline__ float wave_incl_scan_f(float v, int lane) {
#pragma unroll
    for (int o = 1; o < 64; o <<= 1) { const float t = __shfl_up(v, o); if (lane >= o) v += t; }
    return v;
}
__device__ __forceinline__ v2u pack4(f32x4 v) { v2u r; r.x = cvtpk(v.x, v.y); r.y = cvtpk(v.z, v.w); return r; }
__device__ __forceinline__ bf16x8_t mk8(v2u lo, v2u hi) { union { bf16x8_t v; unsigned u[4]; } x; x.u[0] = lo.x; x.u[1] = lo.y; x.u[2] = hi.x; x.u[3] = hi.y; return x.v; }
template <int SM, int STG = 7>
__device__ __forceinline__ void gdn_g1_mfma(const Args& A, LAS unsigned char* lds, int tid, int lane, int wave) {
    unsigned char* ws = A.ws;
    const bf16* proj = (const bf16*)(ws + WS_PROJ); const float* ab = (const float*)(ws + WS_AB);
    bf16* AP = (bf16*)(ws + WS_GAP); bf16* BP = (bf16*)(ws + WS_GBP); bf16* QP = (bf16*)(ws + WS_GQP); bf16* OP = (bf16*)(ws + WS_GOP); float* GL = (float*)(ws + WS_GGL);
    const float* convw = (const float*)A.in[I_CONVW];
    constexpr int KST = 144, RST = 68;
    LAS unsigned char* const Kr0 = lds;
    const int l15 = lane & 15, g4 = lane >> 4;
    const v2u zero2 = {0u, 0u};
    const int G = gridDim.x;
    const int ppart = wave >> 1, pt4 = 4 * ((wave & 1) * 8 + (lane >> 3)), pd0 = (lane & 7) * 8;
    v4u xr7[7];
#define G1_PREFETCH(IDX) do { if (wave < 6) { const int h_ = (IDX) & 7, bn_ = (IDX) >> 3, b_ = bn_ >> 7, n_ = bn_ & 127; \
        _Pragma("unroll") for (int r = 0; r < 7; ++r) { const int s_ = n_ * 64 + pt4 - 3 + r, sc_ = s_ < 0 ? 0 : s_; \
            const v4u r_ = *(const v4u*)(proj + (size_t)(b_ * SEQ + sc_) * NPROJ + ppart * 512 + h_ * 64 + pd0); const unsigned m_ = s_ < 0 ? 0u : 0xffffffffu; \
            xr7[r] = (v4u){r_.x & m_, r_.y & m_, r_.z & m_, r_.w & m_}; } } } while (0)
    int hcur = -1;
    constexpr int NC = NB * 8 * 128;
    if ((int)blockIdx.x < NC) G1_PREFETCH((int)blockIdx.x);
    for (int base = blockIdx.x; base < NC; base += 16 * G) {
    {
        LAS float* const GsT0 = (LAS float*)(Kr0 + 91648);
        __syncthreads();
        for (int q = wave; q < 16; q += 8) { const int idx2 = base + q * G;
            if (idx2 < NC) { const int h2 = idx2 & 7, bn2 = idx2 >> 3, b2 = bn2 >> 7, n2 = bn2 & 127;
                const size_t t2 = (size_t)(b2 * SEQ + n2 * 64 + lane) * 16;
                const float Ah = __expf(((const float*)A.in[I_ALOG])[h2]), dtb = ((const float*)A.in[I_DTB])[h2];
                const float xx = ab[t2 + h2] + dtb, bb2 = ab[t2 + 8 + h2];
                const float sp = xx > 20.f ? xx : log1pf(__expf(xx));
                const float Gv = wave_incl_scan_f(-Ah * sp, lane);
                GsT0[q * 64 + lane] = Gv; GsT0[1024 + q * 64 + lane] = 1.f / (1.f + __expf(-bb2));
                if ((SM & 16) && lane == 63) GL[(b2 * 8 + h2) * 128 + n2] = __expf(Gv); } }
    }
#pragma unroll 1
    for (int it = 0; it < 16; ++it) {
        const int idx = base + it * G; if (idx >= NC) break;
        const int h = idx & 7, bn = idx >> 3, b = bn >> 7, n = bn & 127, bh = b * 8 + h, cid = bh * 128 + n;
        const size_t cb = (size_t)cid * 4096;
        int oz = 0; asm volatile("" : "+v"(oz));
        LAS unsigned char* const Kr = Kr0 + oz; LAS unsigned char* const Qr = Kr + 9216; LAS unsigned char* const kdT = Kr + 18432; LAS unsigned char* const Mm = Kr + 27648; LAS unsigned char* const At = Kr + 36864;
        LAS float* const Rt = (LAS float*)(Kr + 46080);
        LAS float* const Md = (LAS float*)(Kr + 80896);
        LAS unsigned char* const Tl = Kr + 86016;
        LAS float* const Gs = (LAS float*)(Kr + 91648) + 64 * it; LAS float* const Bs = Gs + 1024;
        LAS float* const cwl = (LAS float*)(Kr + 88576);
        __syncthreads();
        if (h != hcur) { hcur = h; for (int q = tid; q < 768; q += NTHR) { const int part = q >> 8, j = (q >> 6) & 3, d = q & 63; cwl[q] = convw[j * 1536 + part * 512 + h * 64 + d]; } __syncthreads(); }
        const bool more = (idx + G < NC);
        if (wave < 6) {
            const int d0 = pd0, t4 = pt4, dg = d0 >> 3, swk = dg << 3, swr = (dg & 3) << 3;
            float y[4][8];
            {   float wv[4][8];
#pragma unroll
                for (int j = 0; j < 4; ++j) { const f32x4 w0 = *(const LAS f32x4*)(cwl + (ppart * 4 + j) * 64 + d0), w1 = *(const LAS f32x4*)(cwl + (ppart * 4 + j) * 64 + d0 + 4);
                    wv[j][0] = w0.x; wv[j][1] = w0.y; wv[j][2] = w0.z; wv[j][3] = w0.w; wv[j][4] = w1.x; wv[j][5] = w1.y; wv[j][6] = w1.z; wv[j][7] = w1.w; }
#define G1_XE(r, e) __builtin_bit_cast(float, ((e) & 1) ? (((e) >> 1) == 0 ? xr7[r].x : ((e) >> 1) == 1 ? xr7[r].y : ((e) >> 1) == 2 ? xr7[r].z : xr7[r].w) & 0xffff0000u \
                                                        : (((e) >> 1) == 0 ? xr7[r].x : ((e) >> 1) == 1 ? xr7[r].y : ((e) >> 1) == 2 ? xr7[r].z : xr7[r].w) << 16)
#pragma unroll
                for (int tk = 0; tk < 4; ++tk)
#pragma unroll
                    for (int e = 0; e < 8; ++e) { const float a_ = wv[0][e] * G1_XE(tk, e) + wv[1][e] * G1_XE(tk + 1, e) + wv[2][e] * G1_XE(tk + 2, e) + wv[3][e] * G1_XE(tk + 3, e);
                        y[tk][e] = a_ * __builtin_amdgcn_rcpf(1.f + __expf(-a_)); }
#undef G1_XE
            }
            if (more) G1_PREFETCH(idx + G);
            const f32x4 G4 = *(const LAS f32x4*)(Gs + t4), B4 = *(const LAS f32x4*)(Bs + t4); const float gl = Gs[63];
            if (ppart < 2) {
                float rn[4];
#pragma unroll
                for (int tk = 0; tk < 4; ++tk) { float ss = 0.f;
#pragma unroll
                    for (int e = 0; e < 8; ++e) ss += y[tk][e] * y[tk][e];
                    ss += __shfl_xor(ss, 1); ss += __shfl_xor(ss, 2); ss += __shfl_xor(ss, 4);
                    rn[tk] = (1.f / sqrtf(ss + EPS)) * (ppart == 0 ? 0.125f : 1.f); }
#pragma unroll
                for (int tk = 0; tk < 4; ++tk) {
#pragma unroll
                    for (int e = 0; e < 8; ++e) y[tk][e] *= rn[tk];
                    v4u pk; pk.x = cvtpk(y[tk][0], y[tk][1]); pk.y = cvtpk(y[tk][2], y[tk][3]); pk.z = cvtpk(y[tk][4], y[tk][5]); pk.w = cvtpk(y[tk][6], y[tk][7]);
                    *(LAS v4u*)((ppart == 0 ? Qr : Kr) + (t4 + tk) * KST + d0 * 2) = pk; }
                if (ppart == 1) {
                    const float ek0 = __expf(gl - G4.x), ek1 = __expf(gl - G4.y), ek2 = __expf(gl - G4.z), ek3 = __expf(gl - G4.w);
                    const float bg0 = B4.x * __expf(G4.x), bg1 = B4.y * __expf(G4.y), bg2 = B4.z * __expf(G4.z), bg3 = B4.w * __expf(G4.w);
#pragma unroll
                    for (int e = 0; e < 8; ++e) {
                        v2u kd; kd.x = cvtpk(y[0][e] * ek0, y[1][e] * ek1); kd.y = cvtpk(y[2][e] * ek2, y[3][e] * ek3);
                        *(LAS v2u*)(kdT + (d0 + e) * KST + (t4 ^ swk) * 2) = kd;
                        *(LAS f32x4*)(Rt + (d0 + e) * RST + (t4 ^ swr)) = (f32x4){y[0][e] * bg0, y[1][e] * bg1, y[2][e] * bg2, y[3][e] * bg3}; }
                }
            } else {
#pragma unroll
                for (int e = 0; e < 8; ++e) *(LAS f32x4*)(Rt + (64 + d0 + e) * RST + (t4 ^ swr)) = (f32x4){y[0][e] * B4.x, y[1][e] * B4.y, y[2][e] * B4.z, y[3][e] * B4.w};
            }
        }
        __syncthreads();
#define G1_TILE(which, ct, st) do { const LAS unsigned char* Xb_ = (which) ? Kr : Qr; const int c_ = 16 * (ct) + l15; const float Gc_ = Gs[c_], bc_ = Bs[c_]; \
            f32x4 acc_ = {0.f, 0.f, 0.f, 0.f}; \
            _Pragma("unroll") for (int ks = 0; ks < 2; ++ks) { const bf16x8_t bf_ = *(const LAS bf16x8_t*)(Xb_ + c_ * KST + (32 * ks + 8 * g4) * 2); \
                const bf16x8_t af_ = *(const LAS bf16x8_t*)(Kr + (16 * (st) + l15) * KST + (32 * ks + 8 * g4) * 2); acc_ = __builtin_amdgcn_mfma_f32_16x16x32_bf16(af_, bf_, acc_, 0, 0, 0); } \
            f32x4 vals_; \
            _Pragma("unroll") for (int r = 0; r < 4; ++r) { const int s2_ = 16 * (st) + 4 * g4 + r; const float dec_ = __expf(fminf(Gc_ - Gs[s2_], 0.f)); \
                vals_[r] = (which) ? ((s2_ < c_) ? -acc_[r] * bc_ * dec_ : 0.f) : ((s2_ <= c_) ? acc_[r] * dec_ : 0.f); } \
            *(LAS v2u*)(((which) ? Mm : At) + c_ * KST + (16 * (st) + 4 * g4) * 2) = pack4(vals_); \
            if ((which) && (st) == (ct)) *(LAS f32x4*)(Md + ((ct) * 16 + l15) * 20 + 4 * g4) = -vals_; } while (0)
        if constexpr (STG & 1) {
            const int ct = wave & 3, st0 = 2 * (wave >> 2);
            G1_TILE(1, ct, st0); G1_TILE(1, ct, st0 + 1);
        }
        __syncthreads();
        if constexpr (STG & 1) {
            if (wave != 0) { for (int tix = wave - 1; tix < 16; tix += 7) { const int ct = tix & 3, st = tix >> 2; G1_TILE(0, ct, st); } }
        }
        if ((STG & 2) && wave == 0) {
            float t[16];
#pragma unroll
            for (int r = 0; r < 16; ++r) { float acc = (r == l15) ? 1.f : 0.f;
#pragma unroll
                for (int s4 = 0; s4 < r; s4 += 4) { const f32x4 m = *(const LAS f32x4*)(Md + (g4 * 16 + r) * 20 + s4);
                    acc -= m.x * t[s4]; if (s4 + 1 < r) acc -= m.y * t[s4 + 1]; if (s4 + 2 < r) acc -= m.z * t[s4 + 2]; if (s4 + 3 < r) acc -= m.w * t[s4 + 3]; }
                t[r] = acc; }
#pragma unroll
            for (int r = 0; r < 16; ++r) *(LAS unsigned short*)(Tl + ((g4 * 16 + r) * 16 + l15) * 2) = (unsigned short)f2bf(t[r]);
        }
        __syncthreads();
        if constexpr (STG & 4) {
        f32x4 wt[4];
        {   const int colw = 16 * wave + l15;
#pragma unroll
            for (int i = 0; i < 4; ++i) {
                f32x4 acc = *(const LAS f32x4*)(Rt + colw * RST + ((16 * i + 4 * g4) ^ (((colw >> 3) & 3) << 3)));
                const LAS unsigned char* mrow = Mm + (16 * i + l15) * KST + (4 * g4) * 2;
                if (i >= 1) { const v2u alo = *(const LAS v2u*)(mrow), ahi = (i >= 2) ? *(const LAS v2u*)(mrow + 32) : zero2;
                    acc = __builtin_amdgcn_mfma_f32_16x16x32_bf16(mk8(alo, ahi), mk8(pack4(wt[0]), (i >= 2) ? pack4(wt[1]) : zero2), acc, 0, 0, 0); }
                if (i == 3) { const v2u alo = *(const LAS v2u*)(mrow + 64);
                    acc = __builtin_amdgcn_mfma_f32_16x16x32_bf16(mk8(alo, zero2), mk8(pack4(wt[2]), zero2), acc, 0, 0, 0); }
                const v2u tlo = *(const LAS v2u*)(Tl + ((i * 16 + l15) * 16 + 4 * g4) * 2);
                wt[i] = __builtin_amdgcn_mfma_f32_16x16x32_bf16(mk8(tlo, zero2), mk8(pack4(acc), zero2), (f32x4){0.f, 0.f, 0.f, 0.f}, 0, 0, 0);
            }
        }
        if (wave < 4) {
            bf16x8_t wn[2];
#pragma unroll
            for (int ks = 0; ks < 2; ++ks) { v2u lo = pack4(wt[2 * ks]), hi = pack4(wt[2 * ks + 1]); lo.x ^= 0x80008000u; lo.y ^= 0x80008000u; hi.x ^= 0x80008000u; hi.y ^= 0x80008000u; wn[ks] = mk8(lo, hi); }
#pragma unroll
            for (int nt = 0; nt < 4; ++nt) { const int x = 16 * nt + l15;
                f32x4 ca = {0.f, 0.f, 0.f, 0.f};
                const v2u qraw = *(const LAS v2u*)(Qr + x * KST + (16 * wave + 4 * g4) * 2); const float eg = __expf(Gs[x]);
                f32x4 cq; cq.x = eg * __builtin_bit_cast(float, qraw.x << 16); cq.y = eg * __builtin_bit_cast(float, qraw.x & 0xffff0000u); cq.z = eg * __builtin_bit_cast(float, qraw.y << 16); cq.w = eg * __builtin_bit_cast(float, qraw.y & 0xffff0000u);
#pragma unroll
                for (int ks = 0; ks < 2; ++ks) { const int xs = (x >> 3) << 3; const LAS unsigned char* kp0 = kdT + x * KST + ((32 * ks + 4 * g4) ^ xs) * 2; const LAS unsigned char* kp1 = kdT + x * KST + ((32 * ks + 16 + 4 * g4) ^ xs) * 2; const LAS unsigned char* ap = At + x * KST + (32 * ks + 4 * g4) * 2;
                    ca = __builtin_amdgcn_mfma_f32_16x16x32_bf16(wn[ks], mk8(*(const LAS v2u*)(kp0), *(const LAS v2u*)(kp1)), ca, 0, 0, 0);
                    cq = __builtin_amdgcn_mfma_f32_16x16x32_bf16(wn[ks], mk8(*(const LAS v2u*)(ap), *(const LAS v2u*)(ap + 32)), cq, 0, 0, 0); }
                const size_t off = cb + (size_t)((nt * 2 + (wave >> 1)) * 64 + lane) * 8 + 4 * (wave & 1);
                if (SM & 1) *(v2u*)(AP + off) = pack4(ca); if (SM & 2) *(v2u*)(QP + off) = pack4(cq);
            }
        } else {
            bf16x8_t ub[2];
#pragma unroll
            for (int ks = 0; ks < 2; ++ks) ub[ks] = mk8(pack4(wt[2 * ks]), pack4(wt[2 * ks + 1]));
            unsigned bo[8], oo[8];
#pragma unroll
            for (int mt = 0; mt < 4; ++mt) { const int x = 16 * mt + l15;
                f32x4 cbv = {0.f, 0.f, 0.f, 0.f}, co = {0.f, 0.f, 0.f, 0.f};
#pragma unroll
                for (int ks = 0; ks < 2; ++ks) { const int xs = (x >> 3) << 3; const LAS unsigned char* kp0 = kdT + x * KST + ((32 * ks + 4 * g4) ^ xs) * 2; const LAS unsigned char* kp1 = kdT + x * KST + ((32 * ks + 16 + 4 * g4) ^ xs) * 2; const LAS unsigned char* ap = At + x * KST + (32 * ks + 4 * g4) * 2;
                    cbv = __builtin_amdgcn_mfma_f32_16x16x32_bf16(mk8(*(const LAS v2u*)(kp0), *(const LAS v2u*)(kp1)), ub[ks], cbv, 0, 0, 0);
                    co = __builtin_amdgcn_mfma_f32_16x16x32_bf16(mk8(*(const LAS v2u*)(ap), *(const LAS v2u*)(ap + 32)), ub[ks], co, 0, 0, 0); }
                const v2u pb = pack4(cbv), po = pack4(co); bo[2 * mt] = pb.x; bo[2 * mt + 1] = pb.y; oo[2 * mt] = po.x; oo[2 * mt + 1] = po.y; }
            const size_t off = cb + (size_t)((wave - 4) * 64 + lane) * 16;
            if (SM & 4) { *(v4u*)(BP + off) = (v4u){bo[0], bo[1], bo[2], bo[3]}; *(v4u*)(BP + off + 8) = (v4u){bo[4], bo[5], bo[6], bo[7]}; }
            if (SM & 8) { *(v4u*)(OP + off) = (v4u){oo[0], oo[1], oo[2], oo[3]}; *(v4u*)(OP + off + 8) = (v4u){oo[4], oo[5], oo[6], oo[7]}; }
        }
        }
    }
    }
#undef G1_TILE
#undef G1_PREFETCH
}

__device__ __forceinline__ f32x4 g2_unpack(const v4u (&p)[2], int mt) {
    const unsigned d0 = mt == 0 ? p[0].x : mt == 1 ? p[0].z : mt == 2 ? p[1].x : p[1].z, d1 = mt == 0 ? p[0].y : mt == 1 ? p[0].w : mt == 2 ? p[1].y : p[1].w;
    f32x4 r; r.x = __builtin_bit_cast(float, d0 << 16); r.y = __builtin_bit_cast(float, d0 & 0xffff0000u); r.z = __builtin_bit_cast(float, d1 << 16); r.w = __builtin_bit_cast(float, d1 & 0xffff0000u); return r;
}
template <int VAR = 0>
__device__ __forceinline__ void gdn_scan(const Args& A, int bh, LAS unsigned char* lds, int tid, int lane, int wave) {
    unsigned char* ws = A.ws;
    const char* AP = (const char*)(ws + WS_GAP); const char* BP = (const char*)(ws + WS_GBP); const float* GL = (const float*)(ws + WS_GGL); bf16* SF = (bf16*)(ws + WS_GSF);
    constexpr int SLOT = 16384, NSL = 8, EGL_OFF = NSL * SLOT;
    LAS float* eglt = (LAS float*)(lds + EGL_OFF);
    __syncthreads();
    { int tl = tid; asm volatile("" : "+v"(tl));
      if (tl < 128) eglt[tl] = GL[bh * 128 + tl]; }
    if (wave < 4) {
        f32x4 sC[4]; bf16x8_t sB[2];
#pragma unroll
        for (int mt = 0; mt < 4; ++mt) sC[mt] = (f32x4){0.f, 0.f, 0.f, 0.f};
#pragma unroll
        for (int ks = 0; ks < 2; ++ks)
#pragma unroll
            for (int j = 0; j < 8; ++j) sB[ks][j] = 0;
        asm volatile("s_waitcnt vmcnt(0) lgkmcnt(0)" ::: "memory");
        __builtin_amdgcn_s_barrier();
        struct SSet { bf16x8_t fa[4][2]; v4u fb[2]; float egl; };
#define SC_LOAD(S, n) do { const int n_ = (n) < SEQ / 64 ? (n) : SEQ / 64 - 1; const LAS unsigned char* slot_ = lds + (n_ & (NSL - 1)) * SLOT; \
            _Pragma("unroll") for (int mt = 0; mt < 4; ++mt) _Pragma("unroll") for (int ks = 0; ks < 2; ++ks) S.fa[mt][ks] = *(const LAS bf16x8_t*)(slot_ + ((mt * 2 + ks) * 64 + lane) * 16); \
            S.fb[0] = *(const LAS v4u*)(slot_ + 8192 + (wave * 64 + lane) * 32); S.fb[1] = *(const LAS v4u*)(slot_ + 8192 + (wave * 64 + lane) * 32 + 16); S.egl = eglt[n_]; } while (0)
#define SC_STEP(S, n) do { bf16* sf = SF + (size_t)(bh * 128 + (n)) * 4096 + (size_t)((wave * 2) * 64 + lane) * 8; \
            *(bf16x8_t*)(sf) = sB[0]; *(bf16x8_t*)(sf + 512) = sB[1]; \
            f32x4 sacc[4]; \
            _Pragma("unroll") for (int mt = 0; mt < 4; ++mt) sacc[mt] = sC[mt] * S.egl + g2_unpack(S.fb, mt); \
            _Pragma("unroll") for (int mt = 0; mt < 4; ++mt) _Pragma("unroll") for (int ks = 0; ks < 2; ++ks) sacc[mt] = __builtin_amdgcn_mfma_f32_16x16x32_bf16(S.fa[mt][ks], sB[ks], sacc[mt], 0, 0, 0); \
            _Pragma("unroll") for (int mt = 0; mt < 4; ++mt) sC[mt] = sacc[mt]; \
            _Pragma("unroll") for (int ks = 0; ks < 2; ++ks) { union { bf16x8_t v; unsigned u[4]; } pk_; \
                pk_.u[0] = cvtpk(sC[2 * ks].x, sC[2 * ks].y); pk_.u[1] = cvtpk(sC[2 * ks].z, sC[2 * ks].w); pk_.u[2] = cvtpk(sC[2 * ks + 1].x, sC[2 * ks + 1].y); pk_.u[3] = cvtpk(sC[2 * ks + 1].z, sC[2 * ks + 1].w); sB[ks] = pk_.v; } \
            asm volatile("s_waitcnt lgkmcnt(0)" ::: "memory"); \
            __builtin_amdgcn_s_barrier(); } while (0)
        SSet s0;
#pragma unroll 1
        for (int n = 0; n < SEQ / 64; ++n) {
            if (VAR == 2) { asm volatile("s_waitcnt lgkmcnt(0)" ::: "memory"); __builtin_amdgcn_s_barrier(); continue; }
            SC_LOAD(s0, n);
            SC_STEP(s0, n);
        }
#undef SC_LOAD
#undef SC_STEP
    } else {
        const int f = wave - 4;
        const unsigned lin = (unsigned)(2 * f) * 1024u + (unsigned)lane * 16u;
#define G2_DMA(nn) do { const int n_ = (nn) < SEQ / 64 ? (nn) : SEQ / 64 - 1; const size_t cb_ = (size_t)(bh * 128 + n_) * 8192; LAS unsigned char* d_ = lds + ((nn) & (NSL - 1)) * SLOT + (2 * f) * 1024; \
        __builtin_amdgcn_global_load_lds((const unsigned*)(AP + cb_ + lin), (LAS unsigned*)(d_), 16, 0, 0); __builtin_amdgcn_global_load_lds((const unsigned*)(AP + cb_ + lin + 1024), (LAS unsigned*)(d_ + 1024), 16, 0, 0); \
        __builtin_amdgcn_global_load_lds((const unsigned*)(BP + cb_ + lin), (LAS unsigned*)(d_ + 8192), 16, 0, 0); __builtin_amdgcn_global_load_lds((const unsigned*)(BP + cb_ + lin + 1024), (LAS unsigned*)(d_ + 8192 + 1024), 16, 0, 0); } while (0)
        asm volatile("s_waitcnt vmcnt(0) lgkmcnt(0)" ::: "memory");
        G2_DMA(0); G2_DMA(1); G2_DMA(2); G2_DMA(3); G2_DMA(4); G2_DMA(5); G2_DMA(6);
        asm volatile("s_waitcnt vmcnt(24)" ::: "memory");
        __builtin_amdgcn_s_barrier();
#pragma unroll 1
        for (int n = 0; n < SEQ / 64; ++n) {
            if (VAR != 1) G2_DMA(n + 7);
            asm volatile("s_waitcnt vmcnt(24)" ::: "memory");
            __builtin_amdgcn_s_barrier();
        }
#undef G2_DMA
        asm volatile("s_waitcnt vmcnt(0)" ::: "memory");
    }
    __syncthreads();
}
__device__ __forceinline__ void gdn_out(const Args& A, LAS unsigned char* lds, int lane, int wave) {
    unsigned char* ws = A.ws;
    const bf16* proj = (const bf16*)(ws + WS_PROJ); bf16* mix = (bf16*)(ws + WS_MIX);
    const bf16* QP = (const bf16*)(ws + WS_GQP); const bf16* OP = (const bf16*)(ws + WS_GOP); const bf16* SF = (const bf16*)(ws + WS_GSF);
    const float* onorm = (const float*)A.in[I_GNORM];
    const int mt = wave & 3, l15 = lane & 15, g4 = lane >> 4, rr = lane >> 2, q4 = lane & 3;
    constexpr int OST = 68;
    LAS float* ot = (LAS float*)(lds + wave * 4608);
    float gain[16];
#pragma unroll
    for (int k = 0; k < 16; ++k) gain[k] = onorm[16 * q4 + k];
    struct OSet { bf16x8_t qa[2], sb[4][2]; v2u oi[4]; v4u z0, z1; };
#define GO_LOAD(S, CID) do { const int n_ = (CID) & 127, bh_ = (CID) >> 7, b_ = bh_ >> 3, h_ = bh_ & 7; const size_t cb_ = (size_t)(CID) * 4096; \
        const size_t t_ = (size_t)b_ * SEQ + n_ * 64 + 16 * mt + rr; \
        S.z0 = *(const v4u*)(proj + t_ * NPROJ + PC_Z + h_ * 64 + 16 * q4); S.z1 = *(const v4u*)(proj + t_ * NPROJ + PC_Z + h_ * 64 + 16 * q4 + 8); \
        _Pragma("unroll") for (int ks = 0; ks < 2; ++ks) S.qa[ks] = *(const bf16x8_t*)(QP + cb_ + ((mt * 2 + ks) * 64 + lane) * 8); \
        _Pragma("unroll") for (int nt = 0; nt < 4; ++nt) { _Pragma("unroll") for (int ks = 0; ks < 2; ++ks) S.sb[nt][ks] = *(const bf16x8_t*)(SF + cb_ + ((nt * 2 + ks) * 64 + lane) * 8); \
            S.oi[nt] = *(const v2u*)(OP + cb_ + ((nt * 64 + lane) * 4 + mt) * 4); } } while (0)
#define GO_STEP(S, CID) do { const int n_ = (CID) & 127, bh_ = (CID) >> 7, b_ = bh_ >> 3, h_ = bh_ & 7; const size_t t_ = (size_t)b_ * SEQ + n_ * 64 + 16 * mt + rr; \
        _Pragma("unroll") for (int nt = 0; nt < 4; ++nt) { \
            f32x4 acc; acc.x = __builtin_bit_cast(float, S.oi[nt].x << 16); acc.y = __builtin_bit_cast(float, S.oi[nt].x & 0xffff0000u); acc.z = __builtin_bit_cast(float, S.oi[nt].y << 16); acc.w = __builtin_bit_cast(float, S.oi[nt].y & 0xffff0000u); \
            _Pragma("unroll") for (int ks = 0; ks < 2; ++ks) acc = __builtin_amdgcn_mfma_f32_16x16x32_bf16(S.qa[ks], S.sb[nt][ks], acc, 0, 0, 0); \
            _Pragma("unroll") for (int i = 0; i < 4; ++i) ot[(4 * g4 + i) * OST + 16 * nt + l15] = acc[i]; } \
        LDS_WAIT(); asm volatile("" ::: "memory"); \
        float o[16]; float ss = 0.f; \
        _Pragma("unroll") for (int k = 0; k < 4; ++k) { const f32x4 v = *(const LAS f32x4*)(ot + rr * OST + 16 * q4 + 4 * k); o[4 * k] = v.x; o[4 * k + 1] = v.y; o[4 * k + 2] = v.z; o[4 * k + 3] = v.w; } \
        _Pragma("unroll") for (int k = 0; k < 16; ++k) ss += o[k] * o[k]; \
        ss += __shfl_xor(ss, 1); ss += __shfl_xor(ss, 2); \
        const float r = 1.f / sqrtf(ss * (1.f / 64.f) + EPS); \
        const unsigned zu[8] = {S.z0.x, S.z0.y, S.z0.z, S.z0.w, S.z1.x, S.z1.y, S.z1.z, S.z1.w}; \
        unsigned ou[8]; \
        _Pragma("unroll") for (int k = 0; k < 8; ++k) { const float za = __builtin_bit_cast(float, zu[k] << 16), zb = __builtin_bit_cast(float, zu[k] & 0xffff0000u); \
            ou[k] = cvtpk(o[2 * k] * r * gain[2 * k] * siluf(za), o[2 * k + 1] * r * gain[2 * k + 1] * siluf(zb)); } \
        bf16* op = mix + t_ * DM + h_ * 64 + 16 * q4; \
        *(v4u*)(op) = (v4u){ou[0], ou[1], ou[2], ou[3]}; *(v4u*)(op + 8) = (v4u){ou[4], ou[5], ou[6], ou[7]}; \
        LDS_WAIT(); asm volatile("" ::: "memory"); } while (0)
    const int NC = NB * 8 * 128, st = gridDim.x * 2;
    int cid = blockIdx.x * 2 + (wave >> 2);
    OSet s0, s1, s2;
    if (cid < NC) GO_LOAD(s0, cid);
    if (cid + st < NC) GO_LOAD(s1, cid + st);
#pragma unroll 1
    for (; cid < NC; cid += 3 * st) {
        if (cid + 2 * st < NC) GO_LOAD(s2, cid + 2 * st);
        GO_STEP(s0, cid);
        if (cid + st < NC) { if (cid + 3 * st < NC) GO_LOAD(s0, cid + 3 * st); GO_STEP(s1, cid + st); }
        if (cid + 2 * st < NC) { if (cid + 4 * st < NC) GO_LOAD(s1, cid + 4 * st); GO_STEP(s2, cid + 2 * st); }
    }
#undef GO_LOAD
#undef GO_STEP
}

template <bool DRY, int VAR = 0>
__device__ __forceinline__ void norm_route_mfma(const Args& A, const float* X, const float* ssqp, const float* gain, const float* shift, const float* scale, bf16* H, LAS unsigned char* lds, int tid, int lane, int wave) {
    unsigned char* ws = A.ws;
    const int G = gridDim.x;
    const int l15 = lane & 15, g4 = lane >> 4;
    LAS unsigned char* wfl = lds;
    LAS float* mfl = (LAS float*)(lds + 98304); LAS float* afl = mfl + 1024;
    LAS float* lgs = (LAS float*)(lds + 98304 + 8192 + wave * 3328);
    const float* bg = (const float*)A.in[I_BGRP]; const float* br = (const float*)A.in[I_BRT];
#define P7_LOADW(half) do { const v4u* src_ = (const v4u*)(ws + WS_WRT); \
        for (int q = tid; q < 3072; q += NTHR) { const int nt_ = q >> 10, r_ = q & 1023; const int g_ = (nt_ * 32 + 16 * (half)) * 64 + r_; \
            *(LAS v4u*)(wfl + q * 16) = src_[g_]; *(LAS v4u*)(wfl + 49152 + q * 16) = src_[6144 + g_]; } } while (0)
    int bcur = -1;
    for (int rb = blockIdx.x * 128; rb < TT; rb += G * 128) {
        const int b = rb / SEQ, r0 = rb + wave * 16, row = r0 + l15;
        if (b != bcur) { bcur = b; __syncthreads();
            for (int q = tid; q < 1024; q += NTHR) { mfl[q] = gain[q] * (scale[b * 6144 + q] + 1.0f); afl[q] = shift[b * 6144 + q]; }
            __syncthreads(); }
        const float* xr = X + (size_t)row * DM + 8 * g4;
        float ss;
        {   const f32x4 p4 = *(const f32x4*)(ssqp + (size_t)row * 16 + 4 * g4); ss = (p4.x + p4.y) + (p4.z + p4.w); }
        ss += __shfl_xor(ss, 16); ss += __shfl_xor(ss, 32);
        const float rstd = 1.f / sqrtf(ss * (1.f / DM) + EPS);
        f32x4 acc[3];
#pragma unroll
        for (int nt = 0; nt < 3; ++nt) acc[nt] = (f32x4){0.f, 0.f, 0.f, 0.f};
        unsigned char* hrow = (unsigned char*)H + (size_t)row * DM + 8 * g4;
#pragma unroll 1
        for (int half = 0; half < 2; ++half) {
        __syncthreads(); P7_LOADW(half); __syncthreads();
#pragma unroll 8
        for (int ks = 16 * half; ks < 16 * half + 16; ++ks) {
            float hv[8];
            {   const f32x4 a = *(const f32x4*)(xr + 32 * ks), c = *(const f32x4*)(xr + 32 * ks + 4);
                const f32x4 m0 = *(const LAS f32x4*)(mfl + 32 * ks + 8 * g4), m1 = *(const LAS f32x4*)(mfl + 32 * ks + 8 * g4 + 4), h0 = *(const LAS f32x4*)(afl + 32 * ks + 8 * g4), h1 = *(const LAS f32x4*)(afl + 32 * ks + 8 * g4 + 4);
                const f32x4 v0 = a * rstd * m0 + h0, v1 = c * rstd * m1 + h1;
                hv[0] = v0.x; hv[1] = v0.y; hv[2] = v0.z; hv[3] = v0.w; hv[4] = v1.x; hv[5] = v1.y; hv[6] = v1.z; hv[7] = v1.w; }
            unsigned hu[4], lu[4];
#pragma unroll
            for (int p = 0; p < 4; ++p) { hu[p] = cvtpk(hv[2 * p], hv[2 * p + 1]);
                const float ra = hv[2 * p] - __builtin_bit_cast(float, hu[p] << 16), rb2 = hv[2 * p + 1] - __builtin_bit_cast(float, hu[p] & 0xffff0000u); lu[p] = cvtpk(ra, rb2); }
            *(v2u8_t*)(hrow + 32 * ks) = (v2u8_t){pk4f8(hv[0], hv[1], hv[2], hv[3]), pk4f8(hv[4], hv[5], hv[6], hv[7])};
            union { bf16x8_t v; unsigned u[4]; } ah, al; ah.u[0] = hu[0]; ah.u[1] = hu[1]; ah.u[2] = hu[2]; ah.u[3] = hu[3]; al.u[0] = lu[0]; al.u[1] = lu[1]; al.u[2] = lu[2]; al.u[3] = lu[3];
#pragma unroll
            for (int nt = 0; nt < 3; ++nt) { const int fo = ((nt * 16 + (ks & 15)) * 64 + lane) * 16;
                const bf16x8_t bh = *(const LAS bf16x8_t*)(wfl + fo), bl = *(const LAS bf16x8_t*)(wfl + 49152 + fo);
                acc[nt] = __builtin_amdgcn_mfma_f32_16x16x32_bf16(ah.v, bh, acc[nt], 0, 0, 0);
                acc[nt] = __builtin_amdgcn_mfma_f32_16x16x32_bf16(ah.v, bl, acc[nt], 0, 0, 0);
                acc[nt] = __builtin_amdgcn_mfma_f32_16x16x32_bf16(al.v, bh, acc[nt], 0, 0, 0); }
        }
        }
#pragma unroll
        for (int nt = 0; nt < 3; ++nt)
#pragma unroll
            for (int r = 0; r < 4; ++r) lgs[(4 * g4 + r) * 52 + 16 * nt + l15] = acc[nt][r];
        LDS_WAIT(); asm volatile("" ::: "memory");
        if (lane < 16) {
            float lg[36];
#pragma unroll
            for (int q = 0; q < 9; ++q) { const f32x4 v = *(const LAS f32x4*)(lgs + lane * 52 + 4 * q); lg[4 * q] = v.x; lg[4 * q + 1] = v.y; lg[4 * q + 2] = v.z; lg[4 * q + 3] = v.w; }
#pragma unroll
            for (int o = 0; o < 4; ++o) lg[o] += bg[o];
#pragma unroll
            for (int o = 0; o < 32; ++o) lg[4 + o] += br[o];
            int gi = 0; float gm = lg[0];
#pragma unroll
            for (int o = 1; o < 4; ++o) if (lg[o] > gm) { gm = lg[o]; gi = o; }
            float gs = 0.f;
#pragma unroll
            for (int o = 0; o < 4; ++o) gs += __expf(lg[o] - gm);
            const float pg = 1.f / gs;
            float le[8];
#pragma unroll
            for (int j = 0; j < 8; ++j) { le[j] = lg[4 + j];
#pragma unroll
                for (int g = 1; g < 4; ++g) le[j] = (gi == g) ? lg[4 + g * 8 + j] : le[j]; }
            int j1 = 0; float m1 = le[0];
#pragma unroll
            for (int j = 1; j < 8; ++j) if (le[j] > m1) { m1 = le[j]; j1 = j; }
            int j2 = -1; float m2 = -3.0e38f;
#pragma unroll
            for (int j = 0; j < 8; ++j) if (j != j1 && le[j] > m2) { m2 = le[j]; j2 = j; }
            const float ex = __expf(m2 - m1), w1 = pg / (1.f + ex), w2 = pg * ex / (1.f + ex);
            const int e1 = gi * 8 + j1, e2 = gi * 8 + j2, rw = r0 + lane;
            unsigned* ctl = (unsigned*)(ws + WS_CTL);
            int2* erec = (int2*)(ws + WS_EREC); int* clist = (int*)(ws + WS_CLIST);
            if constexpr (DRY) { ((int2*)(ws + WS_PROJ + 168 * MiB))[rw] = make_int2(e1 * 64 + e2, __builtin_bit_cast(int, w1 + w2)); } else {
            const unsigned p1 = atomicAdd(ctl + CW_ECNT + e1, 1u); erec[(size_t)e1 * TT + p1] = make_int2(rw * 2 + (e1 > e2 ? 1 : 0), __builtin_bit_cast(int, w1));
            const unsigned p2 = atomicAdd(ctl + CW_ECNT + e2, 1u); erec[(size_t)e2 * TT + p2] = make_int2(rw * 2 + (e2 > e1 ? 1 : 0), __builtin_bit_cast(int, w2));
            const int a = j1 < j2 ? j1 : j2, bb = j1 < j2 ? j2 : j1;
            const int cls = gi * 28 + (a * 7 - (a * (a - 1)) / 2 + (bb - a - 1));
            const unsigned pc = atomicAdd(ctl + CW_CCNT + cls, 1u); clist[(size_t)cls * TT + pc] = rw; }
        }
        LDS_WAIT(); asm volatile("" ::: "memory");
    }
#undef P7_LOADW
}

__device__ __forceinline__ int wave_incl_scan(int v, int lane) {
#pragma unroll
    for (int o = 1; o < 64; o <<= 1) { const int t = __shfl_up(v, o); if (lane >= o) v += t; }
    return v;
}
template <int NOPART = 0>
struct SchedET {
    int G, c, cntv, preF, erank, totF, totP; const int2* rec; const char* W;
    __device__ __forceinline__ void init(const unsigned* cnt, const int2* rec_, const char* W_, int G_, int c_, int lane) {
        G = G_; c = c_; rec = rec_; W = W_;
        cntv = lane < NE ? (int)cnt[lane] : 0;
        const int rem = cntv & 255;
        const int incF = wave_incl_scan(cntv >> 8, lane), incP = wave_incl_scan(rem ? 1 : 0, lane);
        totF = __builtin_amdgcn_readlane(incF, 63); totP = NOPART ? 0 : __builtin_amdgcn_readlane(incP, 63);
        preF = lane < NE ? incF : 0x7fffffff;
        int rank = 0;
        for (int l = 0; l < NE; ++l) { const int r2 = __builtin_amdgcn_readlane(rem, l); rank += (r2 > rem || (r2 == rem && l < lane)) ? 1 : 0; }
        erank = __builtin_amdgcn_ds_permute((lane < NE ? rank : lane) << 2, lane);
    }
    __device__ __forceinline__ bool next(int i, pg8::UnitG& u) const {
        const int L = i * G + c; if (L >= 2 * (totF + totP)) return false;
        if (L < 2 * totF) { const int F8 = totF & ~7; const bool xm = L < 2 * F8;
            const int ft = xm ? 8 * (L >> 4) + (L & 7) : (L >> 1), pnv = xm ? (L >> 3) & 1 : (L & 1);
            const int e = __builtin_amdgcn_readfirstlane(__popcll(__ballot(preF <= ft)));
            const int base = e ? __builtin_amdgcn_readlane(preF, e - 1) : 0;
            u.id = e; u.tile = ft - base; u.pn = pnv; u.nrows = 256;
        } else { const int p = (L - 2 * totF) >> 1;
            const int e = __builtin_amdgcn_readlane(erank, p);
            const int cnt = __builtin_amdgcn_readlane(cntv, e);
            u.id = e; u.tile = cnt >> 8; u.pn = L & 1; u.nrows = cnt & 255; }
        return true;
    }
    __device__ __forceinline__ int tok(const pg8::UnitG& u, int r) const { return r < u.nrows ? (rec[(size_t)u.id * TT + u.tile * 256 + r].x >> 1) : 0; }
    __device__ __forceinline__ const char* bseg(const pg8::UnitG& u, int) const { return W + ((size_t)u.id * 512 + u.pn * 256) * 1024; }
};
typedef SchedET<0> SchedE;
struct EpiGU {
    static constexpr bool PERM = true, PREFETCH = false;
    bf16* HID;
    template <class SC> __device__ __forceinline__ void operator()(const pg8::f32x4 (&acc)[2][2][4][2], const pg8::UnitG& u, const SC& S, int wr, int wc, int fr, int fq) const {
#pragma unroll
        for (int ai = 0; ai < 2; ++ai)
#pragma unroll
            for (int m = 0; m < 4; ++m) { const int r = ai * 128 + wr * 64 + m * 16 + fr;
                if (r < u.nrows) { const int2 rc = S.rec[(size_t)u.id * TT + u.tile * 256 + r]; const int t = rc.x >> 1, half = rc.x & 1; const float w = __builtin_bit_cast(float, rc.y);
                    float hv[8];
#pragma unroll
                    for (int n = 0; n < 2; ++n)
#pragma unroll
                        for (int j = 0; j < 4; ++j) { const float g = acc[ai][0][m][n][j] * (1.f / W8_SCALE), up = acc[ai][1][m][n][j] * (HID8_SCALE / W8_SCALE); hv[n * 4 + j] = w * siluf(g) * up; }
                    *(v2u8_t*)((unsigned char*)HID + (size_t)t * 512 + half * 256 + u.pn * 128 + wc * 32 + 8 * fq) = (v2u8_t){pk4f8(hv[0], hv[1], hv[2], hv[3]), pk4f8(hv[4], hv[5], hv[6], hv[7])}; } }
    }
};
struct SchedC {
    int G, c, cntA, cntB, preA, preB, total_rt; const int* clist; const char* W;
    __device__ __forceinline__ void init(const unsigned* cnt, const int* clist_, const char* W_, int G_, int c_, int lane) {
        G = G_; c = c_; clist = clist_; W = W_;
        cntA = (int)cnt[lane]; cntB = lane < NCLS - 64 ? (int)cnt[64 + lane] : 0;
        const int ia = wave_incl_scan((cntA + 255) >> 8, lane); const int ta = __builtin_amdgcn_readlane(ia, 63);
        const int ib = wave_incl_scan((cntB + 255) >> 8, lane) + ta;
        total_rt = __builtin_amdgcn_readlane(ib, 63);
        preA = ia; preB = lane < NCLS - 64 ? ib : 0x7fffffff;
    }
    __device__ __forceinline__ bool next(int i, pg8::UnitG& u) const {
        const int L = i * G + c; if (L >= 4 * total_rt) return false;
        const int R8 = total_rt & ~7; const bool xm = L < 4 * R8;
        const int rt = xm ? 8 * (L >> 5) + (L & 7) : (L >> 2), pnv = xm ? (L >> 3) & 3 : (L & 3);
        const int cls = __builtin_amdgcn_readfirstlane(__popcll(__ballot(preA <= rt)) + __popcll(__ballot(preB <= rt)));
        int base = 0; if (cls > 0) base = (cls - 1 < 64) ? __builtin_amdgcn_readlane(preA, cls - 1) : __builtin_amdgcn_readlane(preB, cls - 65);
        const int cnt = cls < 64 ? __builtin_amdgcn_readlane(cntA, cls) : __builtin_amdgcn_readlane(cntB, cls - 64);
        u.id = cls; u.tile = rt - base; u.pn = pnv; const int rem = cnt - u.tile * 256; u.nrows = rem < 256 ? rem : 256;
        return true;
    }
    __device__ __forceinline__ int tok(const pg8::UnitG& u, int r) const { return r < u.nrows ? clist[(size_t)u.id * TT + u.tile * 256 + r] : 0; }
    __device__ __forceinline__ const char* bseg(const pg8::UnitG& u, int seg) const {
        const int g = u.id / 28; int a = 0, rem = u.id % 28; while (rem >= 7 - a) { rem -= 7 - a; ++a; } const int b = a + 1 + rem;
        const int e = g * 8 + (seg ? b : a);
        return W + ((size_t)e * 1024 + u.pn * 256) * 256;
    }
};
template <int VAR = 0>
struct EpiDownT {
    static constexpr bool PERM = false, PREFETCH = false;
    float* OUT; const float* gate2;
    const LAS unsigned char* gt;
    template <class SC> __device__ __forceinline__ void prefetch(LAS unsigned char* lds, const pg8::UnitG& u, const SC& S, int tid) const {
#pragma unroll
        for (int i = 0; i < 4; ++i) { const int r = (tid >> 3) + 64 * i; const int t = S.tok(u, r);
            __builtin_amdgcn_global_load_lds((const unsigned*)((const char*)OUT + (size_t)t * 4096 + (size_t)u.pn * 1024 + (size_t)(tid & 7) * 128), (LAS unsigned*)(lds + pg8::STAGE_BYTES + 256), 4, 0, 0); }
    }
    template <class SC> __device__ __forceinline__ void operator()(const pg8::f32x4 (&acc)[2][2][4][2], const pg8::UnitG& u, const SC& S, int wr, int wc, int fr, int fq) const {
#pragma unroll
        for (int ai = 0; ai < 2; ++ai)
#pragma unroll
            for (int m = 0; m < 4; ++m) { const int r = ai * 128 + wr * 64 + m * 16 + fr;
                if (r < u.nrows) { const int t = S.clist[(size_t)u.id * TT + u.tile * 256 + r]; const int b = t / SEQ; const int col0 = u.pn * 256 + wc * 32 + 4 * fq;
                    float* op = OUT + (size_t)t * DM + col0; const float* gp = gate2 + b * 6144 + col0;
#pragma unroll
                    for (int bj = 0; bj < 2; ++bj)
#pragma unroll
                        for (int n = 0; n < 2; ++n) { const int off = bj * 128 + n * 16; const f32x4 xv = (VAR == 1) ? (f32x4){1.f, 1.f, 1.f, 1.f} : *(const f32x4*)(op + off);
                            f32x4 gv;
                            if (VAR == 2) gv = (f32x4){1.f, 1.f, 1.f, 1.f};
                            else if (gt) { const v2u g2 = *(const LAS v2u*)(gt + (b * 1024 + col0 + off) * 2);
                                gv.x = __builtin_bit_cast(float, g2.x << 16); gv.y = __builtin_bit_cast(float, g2.x & 0xffff0000u); gv.z = __builtin_bit_cast(float, g2.y << 16); gv.w = __builtin_bit_cast(float, g2.y & 0xffff0000u); }
                            else gv = *(const f32x4*)(gp + off);
                            *(f32x4*)(op + off) = xv + gv * (acc[ai][bj][m][n] * (1.f / (W8_SCALE * HID8_SCALE))); } } }
    }
};
typedef EpiDownT<0> EpiDown;

__global__ void __launch_bounds__(NTHR, 2) fwd_kernel(Args args) {
    extern __shared__ __attribute__((aligned(16))) unsigned char lds_raw[];
    LAS unsigned char* lds = (LAS unsigned char*)lds_raw;
    volatile LAS unsigned* MISC = (volatile LAS unsigned*)(lds + MISC_OFF);
    const int G = gridDim.x;
    unsigned char* ws = args.ws;
    const int wave_s = __builtin_amdgcn_readfirstlane(threadIdx.x >> 6);
    for (int u = threadIdx.x; u < (LDS_BYTES - LDSCTL_OFF) / 4; u += NTHR) ((LAS unsigned*)(lds + LDSCTL_OFF))[u] = 0u;
    __syncthreads();
    const int lo = args.ph_lo, hi = args.ph_hi;
    const bool use_bar = (hi - lo) > 1;
    XcdBarrier bar; bar.bar = (unsigned*)(ws + WS_CTL) + CW_BAR; bar.x = 0; bar.st = nullptr;
    if (use_bar) bar = xcd_barrier_post((unsigned*)(ws + WS_CTL) + CW_BAR, MISC + 8, threadIdx.x == 0);
#define IN(k) (lo <= (k) && (k) < hi)
#define BOTH(k) (IN(k) && IN((k) + 1))
#if PROBE_REP == 1000
#define GRID_BAR(k) do { if (BOTH(k)) { xcd_barrier(bar, wave_s == 0 && __builtin_amdgcn_mbcnt_hi(~0u, __builtin_amdgcn_mbcnt_lo(~0u, 0u)) == 0u); xcd_barrier(bar, wave_s == 0 && __builtin_amdgcn_mbcnt_hi(~0u, __builtin_amdgcn_mbcnt_lo(~0u, 0u)) == 0u); } } while (0)
#else
#define GRID_BAR(k) do { if (BOTH(k)) xcd_barrier(bar, wave_s == 0 && __builtin_amdgcn_mbcnt_hi(~0u, __builtin_amdgcn_mbcnt_lo(~0u, 0u)) == 0u); } while (0)
#endif
#define FRESH_IDS() const int wave = wave_s; int lane = (int)__builtin_amdgcn_mbcnt_hi(~0u, __builtin_amdgcn_mbcnt_lo(~0u, 0u)); asm volatile("" : "+v"(lane)); const int tid = wave * 64 + lane; (void)tid
    const float* mod = (const float*)(ws + WS_MOD);

    if (IN(0)) { FRESH_IDS(); p0_prologue(args, lds, tid, lane, wave); GRID_BAR(0); }
    if (IN(1)) { FRESH_IDS(); norm_rows<false>(args, (const float*)args.in[I_X], (const float*)args.in[I_NORM_MIX], mod + 0, mod + 1024, (bf16*)(ws + WS_H), lds, lane, wave); GRID_BAR(1); }
    if (IN(2)) { FRESH_IDS();
        pg8::Gemm g{(const pg8::bf16_t*)(ws + WS_H), (const pg8::bf16_t*)(ws + WS_WINT), TT, NPAD, DM}; pg8::StaticOrder S; S.init(TT, NPAD, G, (int)blockIdx.x);
        pg8::EpiProj E{(pg8::bf16_t*)(ws + WS_PROJ), (float*)(ws + WS_AB), NPROJ};
        pg8::gemm_phase<pg8::EpiProj, pg8::StaticOrder, true, true>(lds, g, S, E);
        GRID_BAR(2);
    }
    if (IN(3)) { FRESH_IDS(); gdn_g1_mfma<31>(args, lds, tid, lane, wave); GRID_BAR(3); }
    if (IN(4)) { FRESH_IDS();
        if ((int)blockIdx.x < 32) gdn_scan(args, (int)blockIdx.x, lds, tid, lane, wave);
        else swa_mfma(args, lds, tid, lane, wave, (int)blockIdx.x - 32, G - 32);
        GRID_BAR(4);
    }
    if (IN(5)) { FRESH_IDS(); gdn_out(args, lds, lane, wave); GRID_BAR(5); }
    if (IN(6)) { FRESH_IDS();
        pg8::Gemm g{(const pg8::bf16_t*)(ws + WS_MIX), (const pg8::bf16_t*)(ws + WS_WOUTT), TT, DM, DM}; pg8::StaticOrder S; S.init(TT, DM, G, (int)blockIdx.x);
        pg8::EpiOut E{(const float*)args.in[I_X], args.out, mod + 2048, SEQ, 6144, (float*)(ws + WS_SSQ)};
        const bool first = ((blockIdx.x >> 3) & 1) != 0;
        if (first) { expert_weight_copy(args, lds, lane, wave); __syncthreads(); }
        pg8::gemm_phase<pg8::EpiOut, pg8::StaticOrder, true, true>(lds, g, S, E);
        if (!first) { __syncthreads(); expert_weight_copy(args, lds, lane, wave); }
        GRID_BAR(6);
    }
    if (IN(7)) { FRESH_IDS(); norm_route_mfma<false>(args, args.out, (const float*)(ws + WS_SSQ), (const float*)args.in[I_NORM_FFN], mod + 3072, mod + 4096, (bf16*)(ws + WS_H), lds, tid, lane, wave); GRID_BAR(7); }
    if (IN(8)) { FRESH_IDS();
        SchedE S; S.init((const unsigned*)(ws + WS_CTL) + CW_ECNT, (const int2*)(ws + WS_EREC), (const char*)(ws + WS_WGUT), G, (int)blockIdx.x, lane);
        EpiGU E{(bf16*)(ws + WS_HID)};
        pg8::gemm_phase_g<EpiGU, SchedE, true>(lds, (const pg8::bf16_t*)(ws + WS_H), 512, 512, 8, 8, S, E);
        GRID_BAR(8);
    }
    if (IN(9)) { FRESH_IDS();
        SchedC S; S.init((const unsigned*)(ws + WS_CTL) + CW_CCNT, (const int*)(ws + WS_CLIST), (const char*)(ws + WS_WDT), G, (int)blockIdx.x, lane);
        LAS unsigned char* gtl = lds + RING_BYTES + 512;
        for (int q = tid; q < 4096; q += NTHR) *(LAS unsigned short*)(gtl + q * 2) = (unsigned short)f2bf(mod[(q >> 10) * 6144 + 5120 + (q & 1023)]);
        __syncthreads();
        EpiDown E{args.out, mod + 5120, gtl};
        pg8::gemm_phase_g<EpiDown, SchedC, true>(lds, (const pg8::bf16_t*)(ws + WS_HID), 256, 128, 4, 2, S, E);
    }
#undef IN
#undef BOTH
#undef GRID_BAR
}

#if PROBE_REP >= 0 && PROBE_REP < 1000
template <int P>
__global__ void __launch_bounds__(NTHR, 2) probe_kernel(Args args) {
    extern __shared__ __attribute__((aligned(16))) unsigned char lds_raw[];
    LAS unsigned char* lds = (LAS unsigned char*)lds_raw;
    const int tid = threadIdx.x, lane = tid & 63, wave = __builtin_amdgcn_readfirstlane(tid >> 6);
    const int G = gridDim.x; unsigned char* ws = args.ws; const float* mod = (const float*)(ws + WS_MOD);
    if constexpr (P == 1) norm_rows<false>(args, (const float*)args.in[I_X], (const float*)args.in[I_NORM_MIX], mod + 0, mod + 1024, (bf16*)(ws + WS_GAP + 0)  , lds, lane, wave);
    if constexpr (P == 2) { pg8::Gemm g{(const pg8::bf16_t*)(ws + WS_H), (const pg8::bf16_t*)(ws + WS_WINT), TT, NPAD, DM}; pg8::StaticOrder S; S.init(TT, NPAD, G, (int)blockIdx.x);
        pg8::EpiProj E{(pg8::bf16_t*)(ws + WS_PROJ), (float*)(ws + WS_AB), NPROJ}; pg8::gemm_phase<pg8::EpiProj, pg8::StaticOrder, true, true>(lds, g, S, E); }
    if constexpr (P == 0) p0_prologue(args, lds, tid, lane, wave);
    if constexpr (P == 4) gdn_g1_mfma<31>(args, lds, tid, lane, wave);
    if constexpr (P == 40) gdn_g1_mfma<31, 0>(args, lds, tid, lane, wave);
    if constexpr (P == 41) gdn_g1_mfma<31, 1>(args, lds, tid, lane, wave);
    if constexpr (P == 42) gdn_g1_mfma<31, 3>(args, lds, tid, lane, wave);
    if constexpr (P == 43) gdn_g1_mfma<0, 7>(args, lds, tid, lane, wave);
    if constexpr (P == 50) { if ((int)blockIdx.x < 32) gdn_scan(args, (int)blockIdx.x, lds, tid, lane, wave); }
    if constexpr (P == 501) { if ((int)blockIdx.x < 32) gdn_scan<1>(args, (int)blockIdx.x, lds, tid, lane, wave); }
    if constexpr (P == 502) { if ((int)blockIdx.x < 32) gdn_scan<2>(args, (int)blockIdx.x, lds, tid, lane, wave); }
    if constexpr (P == 52) gdn_out(args, lds, lane, wave);
    if constexpr (P == 51) { if ((int)blockIdx.x >= 32) swa_mfma(args, lds, tid, lane, wave, (int)blockIdx.x - 32, G - 32); }
    if constexpr (P == 60) expert_weight_copy(args, lds, lane, wave);
    if constexpr (P == 61) { pg8::Gemm g{(const pg8::bf16_t*)(ws + WS_MIX), (const pg8::bf16_t*)(ws + WS_WOUTT), TT, DM, DM}; pg8::StaticOrder S; S.init(TT, DM, G, (int)blockIdx.x);
        pg8::EpiOut E{(const float*)args.in[I_X], (float*)(ws + WS_GSF)  , mod + 2048, SEQ, 6144, nullptr};
        const bool first = ((blockIdx.x >> 3) & 1) != 0;
        if (first) { expert_weight_copy(args, lds, lane, wave); __syncthreads(); }
        pg8::gemm_phase<pg8::EpiOut, pg8::StaticOrder, true, true>(lds, g, S, E);
        if (!first) { __syncthreads(); expert_weight_copy(args, lds, lane, wave); } }
    if constexpr (P == 6) { pg8::Gemm g{(const pg8::bf16_t*)(ws + WS_MIX), (const pg8::bf16_t*)(ws + WS_WOUTT), TT, DM, DM}; pg8::StaticOrder S; S.init(TT, DM, G, (int)blockIdx.x);
        pg8::EpiOut E{(const float*)args.in[I_X], (float*)(ws + WS_GSF)  , mod + 2048, SEQ, 6144, nullptr}; pg8::gemm_phase<pg8::EpiOut, pg8::StaticOrder, true, true>(lds, g, S, E); }
    if constexpr (P == 81) { SchedET<1> S; S.init((const unsigned*)(ws + WS_CTL) + CW_ECNT, (const int2*)(ws + WS_EREC), (const char*)(ws + WS_WGUT), G, (int)blockIdx.x, lane);
        EpiGU E{(bf16*)(ws + WS_HID)}; pg8::gemm_phase_g<EpiGU, SchedET<1>, true>(lds, (const pg8::bf16_t*)(ws + WS_H), 512, 512, 8, 8, S, E); }
    if constexpr (P == 8) { SchedE S; S.init((const unsigned*)(ws + WS_CTL) + CW_ECNT, (const int2*)(ws + WS_EREC), (const char*)(ws + WS_WGUT), G, (int)blockIdx.x, lane);
        EpiGU E{(bf16*)(ws + WS_HID)}; pg8::gemm_phase_g<EpiGU, SchedE, true>(lds, (const pg8::bf16_t*)(ws + WS_H), 512, 512, 8, 8, S, E); }
    if constexpr (P == 71) norm_route_mfma<true, 1>(args, args.out, (const float*)(ws + WS_SSQ), (const float*)args.in[I_NORM_FFN], mod + 3072, mod + 4096, (bf16*)(ws + WS_PROJ + 32 * MiB), lds, tid, lane, wave);
    if constexpr (P == 7) norm_route_mfma<true>(args, args.out, (const float*)(ws + WS_SSQ), (const float*)args.in[I_NORM_FFN], mod + 3072, mod + 4096, (bf16*)(ws + WS_PROJ + 32 * MiB), lds, tid, lane, wave);
    if constexpr (P == 91 || P == 92) { SchedC S; S.init((const unsigned*)(ws + WS_CTL) + CW_CCNT, (const int*)(ws + WS_CLIST), (const char*)(ws + WS_WDT), G, (int)blockIdx.x, lane);
        EpiDownT<P - 90> E{(float*)(ws + WS_PROJ + 32 * MiB), mod + 5120, nullptr}; pg8::gemm_phase_g<EpiDownT<P - 90>, SchedC, true>(lds, (const pg8::bf16_t*)(ws + WS_HID), 256, 128, 4, 2, S, E); }
    if constexpr (P == 9) { SchedC S; S.init((const unsigned*)(ws + WS_CTL) + CW_CCNT, (const int*)(ws + WS_CLIST), (const char*)(ws + WS_WDT), G, (int)blockIdx.x, lane);
        EpiDown E{(float*)(ws + WS_PROJ + 32 * MiB), mod + 5120, nullptr}; pg8::gemm_phase_g<EpiDown, SchedC, true>(lds, (const pg8::bf16_t*)(ws + WS_HID), 256, 128, 4, 2, S, E); }
}
#endif
extern "C" void kernel_launch(void* const* d_in, const int* in_sizes, int n_in, void* d_out, int out_size, void* d_ws, size_t ws_size, hipStream_t stream) {
    static int grid = 0;
    if (grid == 0) {
        if (n_in != 23 || in_sizes[0] != TT * DM || out_size != TT * DM || ws_size < WS_END) { fprintf(stderr, "kernel_launch: unexpected shapes: n_in %d in0 %d out %d ws %zu (need %zu)\n", n_in, n_in > 0 ? in_sizes[0] : -1, out_size, ws_size, (size_t)WS_END); grid = -1; return; }
        int dev = 0, cus = 0, per_cu = 0;
        if (hipGetDevice(&dev) != hipSuccess || hipDeviceGetAttribute(&cus, hipDeviceAttributeMultiprocessorCount, dev) != hipSuccess) { grid = -1; return; }
        if (hipFuncSetAttribute((const void*)fwd_kernel, hipFuncAttributeMaxDynamicSharedMemorySize, LDS_BYTES) != hipSuccess) { fprintf(stderr, "kernel_launch: hipFuncSetAttribute failed\n"); grid = -1; return; }
        if (hipOccupancyMaxActiveBlocksPerMultiprocessor(&per_cu, (const void*)fwd_kernel, NTHR, LDS_BYTES) != hipSuccess || per_cu < 1) fprintf(stderr, "kernel_launch: occupancy query reports %d\n", per_cu);
        (void)hipGetLastError();
        grid = cus;
    }
    if (grid < 0) return;
    if (hipMemsetAsync((char*)d_ws + WS_CTL, 0, CTL_ZERO_BYTES, stream) != hipSuccess) { fprintf(stderr, "kernel_launch: memset failed\n"); return; }
    Args a{};
    for (int i = 0; i < 23; ++i) a.in[i] = d_in[i];
    a.out = (float*)d_out; a.ws = (unsigned char*)d_ws;
#if MK_ONE_LAUNCH
    a.ph_lo = 0; a.ph_hi = N_PHASES;
    hipLaunchKernelGGL(fwd_kernel, dim3(grid), dim3(NTHR), LDS_BYTES, stream, a);
#if PROBE_REP >= 0 && PROBE_REP < 1000
    hipFuncSetAttribute((const void*)probe_kernel<PROBE_REP>, hipFuncAttributeMaxDynamicSharedMemorySize, LDS_BYTES);
    hipLaunchKernelGGL(probe_kernel<PROBE_REP>, dim3(grid), dim3(NTHR), LDS_BYTES, stream, a);
#endif
#else
    for (int p = 0; p < N_PHASES; ++p) { a.ph_lo = p; a.ph_hi = p + 1; hipLaunchKernelGGL(fwd_kernel, dim3(grid), dim3(NTHR), LDS_BYTES, stream, a); }
#endif
}
```

```cpp
#include <hip/hip_runtime.h>
#include <cstdio>
#include <cstdint>
namespace pg8 {
#define PG8_LAS __attribute__((address_space(3)))
typedef unsigned short bf16_t;
typedef short bf16x8 __attribute__((ext_vector_type(8)));
typedef float f32x4 __attribute__((ext_vector_type(4)));
typedef unsigned u32x4 __attribute__((ext_vector_type(4)));
constexpr int BM = 256, BK = 64, HALF = 128, HTB = HALF * BK * 2  , STAGE_BYTES = 8 * HTB, NXCD = 8, WGM = 8;

__host__ __device__ __forceinline__ int lds_byte(int r, int c) { const int st = (r >> 4) * 2 + (c >> 5), rr = r & 15, cc = c & 31, ob = rr * 64 + cc * 2; return st * 1024 + (ob ^ (((ob >> 9) & 1) << 5)); }
__host__ __device__ __forceinline__ void stage_rc(int b, int& R, int& C) { const int st = b / 1024, sb = b % 1024, swz = sb ^ (((sb >> 9) & 1) << 5); R = (st >> 1) * 16 + swz / 64; C = (st & 1) * 32 + (swz % 64) / 2; }
__host__ __device__ __forceinline__ int perm32(int rho) { const int n = rho >> 4, i = rho & 15; return 8 * (i >> 2) + 4 * n + (i & 3); }

struct Unit { int pm, pn; };
struct Gemm { const bf16_t* A; const bf16_t* Bt; int M, N, K; };

struct StaticOrder {
    int nM, nN, nwg, G, c;
    __host__ __device__ void init(int M, int N, int G_, int c_) { nM = M / BM; nN = N / BM; nwg = nM * nN; G = G_; c = c_; }
    __host__ __device__ bool next(int i, Unit& u) const {
        const long L = (long)i * G + c; if (L >= nwg) return false;
        int wgid = (int)L; { const int q = nwg / NXCD, r = nwg % NXCD, xcd = wgid % NXCD, off = wgid / NXCD; wgid = (xcd < r ? xcd * (q + 1) : r * (q + 1) + (xcd - r) * q) + off; }
        const int nig = WGM * nN, gid = wgid / nig, fm = gid * WGM, gsz = (nM - fm) < WGM ? (nM - fm) : WGM;
        u.pm = fm + ((wgid % nig) % gsz); u.pn = (wgid % nig) / gsz; return true;
    }
    __device__ __forceinline__ void a_ready(const Unit&) const {}
    __device__ __forceinline__ void done(const Unit&) const {}
};

__device__ __forceinline__ unsigned cvt_pk_bf16(float lo, float hi) { unsigned r; asm volatile("v_cvt_pk_bf16_f32 %0, %1, %2" : "=v"(r) : "v"(lo), "v"(hi)); return r; }

__device__ __forceinline__ void store16_wt(void* base, unsigned byte_off, u32x4 v) {
    __amdgpu_buffer_rsrc_t r = __builtin_amdgcn_make_buffer_rsrc(base, 0, 0x7fffffff, 0x00020000);
    __builtin_amdgcn_raw_buffer_store_b128(v, r, (int)byte_off, 0, 16);
}
struct EpiProj {
    static constexpr bool PERM = true, AFTER_DRAIN = false, PREFETCH = false;
    bf16_t* P; float* AB; int ldp;
    __device__ __forceinline__ void operator()(const f32x4 (&acc)[2][2][4][2], const Unit& u, int wr, int wc, int fr, int fq) const {
        const int row0 = u.pm * BM + wr * 64 + fr;
        if (u.pn < 11) {
            const int col0 = u.pn * BM + wc * 32 + 8 * fq;
#pragma unroll
            for (int ai = 0; ai < 2; ++ai)
#pragma unroll
                for (int m = 0; m < 4; ++m) { const unsigned ro = ((unsigned)(row0 + ai * HALF + m * 16) * (unsigned)ldp + (unsigned)col0) * 2u;
#pragma unroll
                    for (int bj = 0; bj < 2; ++bj) { const f32x4 v0 = acc[ai][bj][m][0], v1 = acc[ai][bj][m][1];
                        u32x4 w; w.x = cvt_pk_bf16(v0[0], v0[1]); w.y = cvt_pk_bf16(v0[2], v0[3]); w.z = cvt_pk_bf16(v1[0], v1[1]); w.w = cvt_pk_bf16(v1[2], v1[3]);
                        *(u32x4*)((char*)P + ro + (unsigned)(bj * HALF) * 2u) = w; } }
        } else if (wc == 0 && fq < 2) {
#pragma unroll
            for (int ai = 0; ai < 2; ++ai)
#pragma unroll
                for (int m = 0; m < 4; ++m) { float* rowp = AB + (size_t)(row0 + ai * HALF + m * 16) * 16 + 8 * fq;
                    *(f32x4*)(rowp) = acc[ai][0][m][0]; *(f32x4*)(rowp + 4) = acc[ai][0][m][1]; }
        }
    }
};
struct EpiOut {
    static constexpr bool PERM = true, AFTER_DRAIN = false, PREFETCH = false;
    const float* X; bf16_t* O; const float* gate; int rows_per_batch, ldg;
    float* SSQ;
    __device__ __forceinline__ void operator()(const f32x4 (&acc)[2][2][4][2], const Unit& u, int wr, int wc, int fr, int fq) const {
        const int row0 = u.pm * BM + wr * 64 + fr, col0 = u.pn * BM + wc * 32 + 8 * fq;
        const float* gb = gate + (size_t)((u.pm * BM) / rows_per_batch) * ldg + col0;
        f32x4 gv[2][2];
#pragma unroll
        for (int bj = 0; bj < 2; ++bj)
#pragma unroll
            for (int n = 0; n < 2; ++n) gv[bj][n] = *(const f32x4*)(gb + bj * HALF + n * 4);
#pragma unroll
        for (int ai = 0; ai < 2; ++ai)
#pragma unroll
            for (int m = 0; m < 4; ++m) { const size_t ro = (size_t)(row0 + ai * HALF + m * 16) * 1024 + col0; float ss = 0.f;
#pragma unroll
                for (int bj = 0; bj < 2; ++bj) { const f32x4 x0 = *(const f32x4*)(X + ro + bj * HALF), x1 = *(const f32x4*)(X + ro + bj * HALF + 4);
                    const f32x4 v0 = x0 + gv[bj][0] * acc[ai][bj][m][0], v1 = x1 + gv[bj][1] * acc[ai][bj][m][1];
                    u32x4 w; w.x = cvt_pk_bf16(v0[0], v0[1]); w.y = cvt_pk_bf16(v0[2], v0[3]); w.z = cvt_pk_bf16(v1[0], v1[1]); w.w = cvt_pk_bf16(v1[2], v1[3]);
                    *(u32x4*)(O + ro + bj * HALF) = w;
                    ss += ((v0.x * v0.x + v0.y * v0.y) + (v0.z * v0.z + v0.w * v0.w)) + ((v1.x * v1.x + v1.y * v1.y) + (v1.z * v1.z + v1.w * v1.w)); }
                if (SSQ) { ss += __shfl_xor(ss, 16); ss += __shfl_xor(ss, 32); if (fq == 0) SSQ[(size_t)(row0 + ai * HALF + m * 16) * 16 + u.pn * 4 + wc] = ss; } }
    }
};

struct UnitG { int id, tile, pn, nrows; };
typedef int i32x8 __attribute__((ext_vector_type(8)));
typedef int i32x4 __attribute__((ext_vector_type(4)));
__device__ __forceinline__ i32x8 cat8(bf16x8 a, bf16x8 b) { const i32x4 x = __builtin_bit_cast(i32x4, a), y = __builtin_bit_cast(i32x4, b); return __builtin_shufflevector(x, y, 0, 1, 2, 3, 4, 5, 6, 7); }
template <class Epi, class Sched, bool F8 = false>
__device__ __forceinline__ void gemm_phase_g(PG8_LAS unsigned char* lds, const bf16_t* Abase, const int KA, const int KB, const int nt_, const int ksplit, const Sched& S, const Epi& E) {
    const int tid = threadIdx.x, wid = __builtin_amdgcn_readfirstlane(tid >> 6), lane = tid & 63, wr = wid >> 2, wc = wid & 3, fr = lane & 15, fq = lane >> 4;
    int Rr[2]; unsigned cB2[2], voffB[2];
#pragma unroll
    for (int i = 0; i < 2; ++i) { int R, C; stage_rc(tid * 16 + i * 8192, R, C); const int Rb = Epi::PERM ? ((R & ~31) + perm32(R & 31)) : R;
        Rr[i] = R; cB2[i] = (unsigned)C * 2u; voffB[i] = (unsigned)(Rb * KB + C) * 2u; }
    const size_t kstep = (size_t)(BK * 2);
    const size_t hstepB = (size_t)HALF * KB * 2;
    const unsigned ldsw = (unsigned)wid * 1024u;
    const int aoff = lds_byte(wr * 64 + fr, fq * 8), boff = lds_byte(wc * 32 + fr, fq * 8);
#define PG8_SA(b, h) (((b) * 2 + (h)) * HTB)
#define PG8_SB(b, h) ((4 + (b) * 2 + (h)) * HTB)
#define PG8_STAGE2(bufoff, gbase, v0, v1) do { \
        __builtin_amdgcn_global_load_lds((const unsigned*)((const char*)(gbase) + (v0)), (PG8_LAS unsigned*)(lds + (bufoff) + ldsw), 16, 0, 0); \
        __builtin_amdgcn_global_load_lds((const unsigned*)((const char*)(gbase) + (v1)), (PG8_LAS unsigned*)(lds + (bufoff) + ldsw + 8192), 16, 0, 0); } while (0)
#define PG8_LDA(dst, b, h) do { _Pragma("unroll") for (int m = 0; m < 4; ++m) _Pragma("unroll") for (int k = 0; k < 2; ++k) dst[m][k] = *(const PG8_LAS bf16x8*)(lds + PG8_SA(b, h) + aoff + m * 2048 + k * 1024); } while (0)
#define PG8_LDB(dst, b, h) do { _Pragma("unroll") for (int n = 0; n < 2; ++n) _Pragma("unroll") for (int k = 0; k < 2; ++k) dst[n][k] = *(const PG8_LAS bf16x8*)(lds + PG8_SB(b, h) + boff + n * 2048 + k * 1024); } while (0)
#define PG8_MMA(ai, bj, At, Bt) do { __builtin_amdgcn_s_setprio(1); \
        if constexpr (F8) { _Pragma("unroll") for (int m = 0; m < 4; ++m) _Pragma("unroll") for (int n = 0; n < 2; ++n) \
            acc[ai][bj][m][n] = __builtin_amdgcn_mfma_scale_f32_16x16x128_f8f6f4(cat8(Bt[n][0], Bt[n][1]), cat8(At[m][0], At[m][1]), acc[ai][bj][m][n], 0, 0, 0, 0x7f7f7f7f, 0, 0x7f7f7f7f); \
            _Pragma("unroll") for (int m = 0; m < 4; ++m) _Pragma("unroll") for (int n = 0; n < 2; ++n) asm volatile("" : "+v"(acc[ai][bj][m][n])); }   \
        else { _Pragma("unroll") for (int m = 0; m < 4; ++m) _Pragma("unroll") for (int n = 0; n < 2; ++n) _Pragma("unroll") for (int k = 0; k < 2; ++k) \
            acc[ai][bj][m][n] = __builtin_amdgcn_mfma_f32_16x16x32_bf16(Bt[n][k], At[m][k], acc[ai][bj][m][n], 0, 0, 0); } \
        __builtin_amdgcn_s_setprio(0); } while (0)
#define PG8_WAIT_V(n) asm volatile("s_waitcnt vmcnt(" #n ")" ::: "memory")
#define PG8_WAIT_L(n) asm volatile("s_waitcnt lgkmcnt(" #n ")" ::: "memory")
#define PG8_BAR __builtin_amdgcn_s_barrier()
#define PG8_SCHED __builtin_amdgcn_sched_barrier(0)
#define PG8_AOFFS(u, o00, o01, o10, o11) do { const unsigned _ks = (unsigned)KA * 2u; \
        o00 = (unsigned)S.tok(u, Rr[0]) * _ks + cB2[0]; o01 = (unsigned)S.tok(u, Rr[1]) * _ks + cB2[1]; \
        o10 = (unsigned)S.tok(u, HALF + Rr[0]) * _ks + cB2[0]; o11 = (unsigned)S.tok(u, HALF + Rr[1]) * _ks + cB2[1]; } while (0)
#define PG8_BT(u, t) (((t) < ksplit) ? S.bseg(u, 0) + (size_t)(t) * kstep : S.bseg(u, 1) + (size_t)((t) - ksplit) * kstep)
    UnitG cur, nxt; int ui = 0;
    int nt = nt_; asm volatile("" : "+s"(nt));
    if (!S.next(0, cur)) return;
    f32x4 acc[2][2][4][2];
#pragma unroll
    for (int a = 0; a < 2; ++a)
#pragma unroll
        for (int b = 0; b < 2; ++b)
#pragma unroll
            for (int m = 0; m < 4; ++m)
#pragma unroll
                for (int n = 0; n < 2; ++n) acc[a][b][m][n] = (f32x4){0.f, 0.f, 0.f, 0.f};
    bf16x8 At[4][2], B0[2][2], B1[2][2];
    unsigned c00, c01, c10, c11, n00 = 0, n01 = 0, n10 = 0, n11 = 0;
    PG8_AOFFS(cur, c00, c01, c10, c11);
    if constexpr (Epi::PREFETCH) E.prefetch(lds, cur, S, tid);
    const char* const Ab = (const char*)Abase;
    {   const char* b0p = PG8_BT(cur, 0); const char* b1p = PG8_BT(cur, 1);
        PG8_STAGE2(PG8_SB(0, 0), b0p, voffB[0], voffB[1]); PG8_STAGE2(PG8_SB(0, 1), b0p + hstepB, voffB[0], voffB[1]); PG8_STAGE2(PG8_SA(0, 0), Ab, c00, c01); PG8_STAGE2(PG8_SA(0, 1), Ab, c10, c11);
        if (wr == 1) PG8_BAR;
        PG8_WAIT_V(2); PG8_BAR;
        PG8_STAGE2(PG8_SB(1, 0), b1p, voffB[0], voffB[1]); PG8_STAGE2(PG8_SA(1, 0), Ab + kstep, c00, c01); PG8_STAGE2(PG8_SB(1, 1), b1p + hstepB, voffB[0], voffB[1]);
        PG8_WAIT_V(6); PG8_BAR;
    }
    for (;;) {
        const bool has_next = S.next(ui + 1, nxt);
        const bool h1 = cur.nrows > HALF;
#pragma unroll 1
        for (int t = 0; t < nt; t += 2) {
            const bool last = (t == nt - 2);
            if (last && has_next) { PG8_AOFFS(nxt, n00, n01, n10, n11); if constexpr (Epi::PREFETCH) E.prefetch(lds, nxt, S, tid); }
            const bool usen = last && has_next;
            const int t2 = last ? 0 : t + 2, t3 = t2 + 1;
            const char* a1 = Ab + (size_t)(t + 1) * kstep;
            const char* a2 = Ab + (size_t)t2 * kstep; const char* a3 = Ab + (size_t)t3 * kstep;
            const char* b2 = usen ? PG8_BT(nxt, t2) : PG8_BT(cur, t2); const char* b3 = usen ? PG8_BT(nxt, t3) : PG8_BT(cur, t3);
            const unsigned o00 = usen ? n00 : c00, o01 = usen ? n01 : c01, o10 = usen ? n10 : c10, o11 = usen ? n11 : c11;
            PG8_LDB(B0, 0, 0); PG8_LDB(B1, 0, 1); PG8_SCHED; PG8_LDA(At, 0, 0); PG8_STAGE2(PG8_SA(1, 1), a1, c10, c11);
            PG8_WAIT_V(8); PG8_WAIT_L(0); PG8_BAR; PG8_MMA(0, 0, At, B0); PG8_MMA(0, 1, At, B1); PG8_BAR; PG8_SCHED;
            PG8_LDA(At, 0, 1); PG8_STAGE2(PG8_SB(0, 0), b2, voffB[0], voffB[1]); PG8_STAGE2(PG8_SB(0, 1), b2 + hstepB, voffB[0], voffB[1]); PG8_STAGE2(PG8_SA(0, 0), a2, o00, o01);
            PG8_WAIT_V(8); PG8_WAIT_L(0); PG8_BAR; if (h1) { PG8_MMA(1, 0, At, B0); PG8_MMA(1, 1, At, B1); } PG8_BAR; PG8_SCHED;
            PG8_LDB(B0, 1, 0); PG8_LDB(B1, 1, 1); PG8_SCHED; PG8_LDA(At, 1, 0); PG8_STAGE2(PG8_SA(0, 1), a2, o10, o11);
            PG8_WAIT_V(8); PG8_WAIT_L(0); PG8_BAR; PG8_MMA(0, 0, At, B0); PG8_MMA(0, 1, At, B1); PG8_BAR; PG8_SCHED;
            PG8_LDA(At, 1, 1); PG8_STAGE2(PG8_SB(1, 0), b3, voffB[0], voffB[1]); PG8_STAGE2(PG8_SB(1, 1), b3 + hstepB, voffB[0], voffB[1]); PG8_STAGE2(PG8_SA(1, 0), a3, o00, o01);
            PG8_WAIT_V(8); PG8_WAIT_L(0); PG8_BAR; if (h1) { PG8_MMA(1, 0, At, B0); PG8_MMA(1, 1, At, B1); } PG8_BAR; PG8_SCHED;
        }
        if (wr == 0) PG8_BAR;
        E(acc, cur, S, wr, wc, fr, fq);
        if (!has_next) break;
#pragma unroll
        for (int a = 0; a < 2; ++a)
#pragma unroll
            for (int b = 0; b < 2; ++b)
#pragma unroll
                for (int m = 0; m < 4; ++m)
#pragma unroll
                    for (int n = 0; n < 2; ++n) acc[a][b][m][n] = (f32x4){0.f, 0.f, 0.f, 0.f};
        cur = nxt; c00 = n00; c01 = n01; c10 = n10; c11 = n11; ++ui;
        if (wr == 1) PG8_BAR;
    }
    PG8_WAIT_V(0);
    PG8_BAR;
#undef PG8_SA
#undef PG8_SB
#undef PG8_STAGE2
#undef PG8_LDA
#undef PG8_LDB
#undef PG8_MMA
#undef PG8_WAIT_V
#undef PG8_WAIT_L
#undef PG8_BAR
#undef PG8_SCHED
#undef PG8_AOFFS
#undef PG8_BT
}
template <class Epi, class Sched, bool ALIGN_EPI = false, bool SP2 = false>
__device__ __forceinline__ void gemm_phase(PG8_LAS unsigned char* lds, const Gemm g, const Sched& S, const Epi& E) {
    const int tid = threadIdx.x, wid = __builtin_amdgcn_readfirstlane(tid >> 6), lane = tid & 63, wr = wid >> 2, wc = wid & 3, fr = lane & 15, fq = lane >> 4;
    const int K = g.K, nt = K / BK;
    unsigned voffA[2], voffB[2];
#pragma unroll
    for (int i = 0; i < 2; ++i) { int R, C; stage_rc(tid * 16 + i * 8192, R, C); const int Rb = Epi::PERM ? ((R & ~31) + perm32(R & 31)) : R;
        voffA[i] = (unsigned)(R * K + C) * 2u; voffB[i] = (unsigned)(Rb * K + C) * 2u; }
    const size_t kstep = (size_t)(BK * 2);
    const size_t hstep = (size_t)HALF * K * 2;
    const size_t tstep = 2 * hstep;
    const unsigned ldsw = (unsigned)wid * 1024u;
    const int aoff = lds_byte(wr * 64 + fr, fq * 8), boff = lds_byte(wc * 32 + fr, fq * 8);
#define PG8_SA(b, h) (((b) * 2 + (h)) * HTB)
#define PG8_SB(b, h) ((4 + (b) * 2 + (h)) * HTB)
#define PG8_STAGE(bufoff, gbase, voff) do { _Pragma("unroll") for (int _i = 0; _i < 2; ++_i) \
        __builtin_amdgcn_global_load_lds((const unsigned*)((const char*)(gbase) + (voff)[_i]), (PG8_LAS unsigned*)(lds + (bufoff) + ldsw + _i * 8192), 16, 0, 0); } while (0)
#define PG8_LDA(dst, b, h) do { _Pragma("unroll") for (int m = 0; m < 4; ++m) _Pragma("unroll") for (int k = 0; k < 2; ++k) dst[m][k] = *(const PG8_LAS bf16x8*)(lds + PG8_SA(b, h) + aoff + m * 2048 + k * 1024); } while (0)
#define PG8_LDB(dst, b, h) do { _Pragma("unroll") for (int n = 0; n < 2; ++n) _Pragma("unroll") for (int k = 0; k < 2; ++k) dst[n][k] = *(const PG8_LAS bf16x8*)(lds + PG8_SB(b, h) + boff + n * 2048 + k * 1024); } while (0)
#define PG8_MMA(ai, bj, At, Bt) do { __builtin_amdgcn_s_setprio(1); _Pragma("unroll") for (int m = 0; m < 4; ++m) _Pragma("unroll") for (int n = 0; n < 2; ++n) _Pragma("unroll") for (int k = 0; k < 2; ++k) \
        acc[ai][bj][m][n] = __builtin_amdgcn_mfma_f32_16x16x32_bf16(Bt[n][k], At[m][k], acc[ai][bj][m][n], 0, 0, 0); __builtin_amdgcn_s_setprio(0); } while (0)
#define PG8_WAIT_V(n) asm volatile("s_waitcnt vmcnt(" #n ")" ::: "memory")
#define PG8_WAIT_L(n) asm volatile("s_waitcnt lgkmcnt(" #n ")" ::: "memory")
#define PG8_BAR __builtin_amdgcn_s_barrier()
#define PG8_SCHED __builtin_amdgcn_sched_barrier(0)
    Unit cur, nxt; int ui = 0;
    if (!S.next(0, cur)) return;
    f32x4 acc[2][2][4][2];
#pragma unroll
    for (int a = 0; a < 2; ++a)
#pragma unroll
        for (int b = 0; b < 2; ++b)
#pragma unroll
            for (int m = 0; m < 4; ++m)
#pragma unroll
                for (int n = 0; n < 2; ++n) acc[a][b][m][n] = (f32x4){0.f, 0.f, 0.f, 0.f};
    bf16x8 At[4][2], B0[2][2], B1[2][2];
    const char* cA = (const char*)g.A + (size_t)cur.pm * tstep; const char* cB = (const char*)g.Bt + (size_t)cur.pn * tstep;
    S.a_ready(cur);
    if constexpr (SP2) {
        PG8_STAGE(PG8_SB(0, 0), cB, voffB); PG8_STAGE(PG8_SB(0, 1), cB + hstep, voffB); PG8_STAGE(PG8_SA(0, 0), cA, voffA); PG8_STAGE(PG8_SA(0, 1), cA + hstep, voffA);
        if (wr == 1) PG8_BAR;
        PG8_WAIT_V(2); PG8_BAR;
        PG8_STAGE(PG8_SB(1, 0), cB + kstep, voffB); PG8_STAGE(PG8_SA(1, 0), cA + kstep, voffA); PG8_STAGE(PG8_SB(1, 1), cB + hstep + kstep, voffB);
        PG8_WAIT_V(6); PG8_BAR;
    } else {
        PG8_STAGE(PG8_SB(0, 0), cB, voffB); PG8_STAGE(PG8_SA(0, 0), cA, voffA); PG8_STAGE(PG8_SB(0, 1), cB + hstep, voffB); PG8_STAGE(PG8_SA(0, 1), cA + hstep, voffA);
        if (wr == 1) PG8_BAR;
        PG8_WAIT_V(4); PG8_BAR;
        PG8_STAGE(PG8_SB(1, 0), cB + kstep, voffB); PG8_STAGE(PG8_SA(1, 0), cA + kstep, voffA); PG8_STAGE(PG8_SB(1, 1), cB + hstep + kstep, voffB);
        PG8_WAIT_V(6); PG8_BAR;
    }
    if constexpr (Epi::PREFETCH) E.prefetch(lds, cur, tid);
    for (;;) {
        const bool has_next = S.next(ui + 1, nxt);
        const char* nA = has_next ? (const char*)g.A + (size_t)nxt.pm * tstep : cA; const char* nB = has_next ? (const char*)g.Bt + (size_t)nxt.pn * tstep : cB;
        for (int t = 0; t < nt; t += 2) {
            const bool last = (t == nt - 2);
            const char* a1 = cA + (size_t)(t + 1) * kstep;
            const char* a2 = last ? nA : cA + (size_t)(t + 2) * kstep; const char* b2 = last ? nB : cB + (size_t)(t + 2) * kstep;
            const char* a3 = a2 + kstep; const char* b3 = b2 + kstep;
            if (last && has_next) S.a_ready(nxt);
            if constexpr (SP2) {
            PG8_LDB(B0, 0, 0); PG8_LDB(B1, 0, 1); PG8_SCHED; PG8_LDA(At, 0, 0); PG8_STAGE(PG8_SA(1, 1), a1 + hstep, voffA);
            PG8_WAIT_V(8); PG8_WAIT_L(0); PG8_BAR; PG8_MMA(0, 0, At, B0); PG8_MMA(0, 1, At, B1); PG8_BAR; PG8_SCHED;
            PG8_LDA(At, 0, 1); PG8_STAGE(PG8_SB(0, 0), b2, voffB); PG8_STAGE(PG8_SB(0, 1), b2 + hstep, voffB); PG8_STAGE(PG8_SA(0, 0), a2, voffA);
            PG8_WAIT_V(8); PG8_WAIT_L(0); PG8_BAR; PG8_MMA(1, 0, At, B0); PG8_MMA(1, 1, At, B1); PG8_BAR; PG8_SCHED;
            PG8_LDB(B0, 1, 0); PG8_LDB(B1, 1, 1); PG8_SCHED; PG8_LDA(At, 1, 0); PG8_STAGE(PG8_SA(0, 1), a2 + hstep, voffA);
            PG8_WAIT_V(8); PG8_WAIT_L(0); PG8_BAR; PG8_MMA(0, 0, At, B0); PG8_MMA(0, 1, At, B1); PG8_BAR; PG8_SCHED;
            PG8_LDA(At, 1, 1); PG8_STAGE(PG8_SB(1, 0), b3, voffB); PG8_STAGE(PG8_SB(1, 1), b3 + hstep, voffB); PG8_STAGE(PG8_SA(1, 0), a3, voffA);
            PG8_WAIT_V(8); PG8_WAIT_L(0); PG8_BAR; PG8_MMA(1, 0, At, B0); PG8_MMA(1, 1, At, B1); PG8_BAR; PG8_SCHED;
            } else {
            PG8_LDB(B0, 0, 0); PG8_SCHED; PG8_LDA(At, 0, 0); PG8_STAGE(PG8_SA(1, 1), a1 + hstep, voffA);
            PG8_WAIT_L(8); PG8_BAR; PG8_WAIT_L(0); PG8_MMA(0, 0, At, B0); PG8_BAR; PG8_SCHED;
            PG8_LDB(B1, 0, 1); PG8_STAGE(PG8_SB(0, 0), b2, voffB);
            PG8_BAR; PG8_WAIT_L(0); PG8_MMA(0, 1, At, B1); PG8_BAR;
            PG8_LDA(At, 0, 1); PG8_STAGE(PG8_SA(0, 0), a2, voffA);
            PG8_BAR; PG8_WAIT_L(0); PG8_MMA(1, 0, At, B0); PG8_BAR; PG8_SCHED;
            PG8_STAGE(PG8_SB(0, 1), b2 + hstep, voffB);
            PG8_WAIT_V(6); PG8_BAR; PG8_MMA(1, 1, At, B1); PG8_BAR;
            PG8_LDB(B0, 1, 0); PG8_SCHED; PG8_LDA(At, 1, 0); PG8_STAGE(PG8_SA(0, 1), a2 + hstep, voffA);
            PG8_WAIT_L(8); PG8_BAR; PG8_WAIT_L(0); PG8_MMA(0, 0, At, B0); PG8_BAR; PG8_SCHED;
            PG8_LDB(B1, 1, 1); PG8_STAGE(PG8_SB(1, 0), b3, voffB);
            PG8_BAR; PG8_WAIT_L(0); PG8_MMA(0, 1, At, B1); PG8_BAR;
            PG8_LDA(At, 1, 1); PG8_STAGE(PG8_SA(1, 0), a3, voffA);
            PG8_BAR; PG8_WAIT_L(0); PG8_MMA(1, 0, At, B0); PG8_BAR; PG8_SCHED;
            PG8_STAGE(PG8_SB(1, 1), b3 + hstep, voffB);
            PG8_WAIT_V(6); PG8_BAR; PG8_MMA(1, 1, At, B1); PG8_BAR;
            }
        }
        if constexpr (ALIGN_EPI) { if (wr == 0) PG8_BAR; }
        if constexpr (!Epi::AFTER_DRAIN) { E(acc, cur, wr, wc, fr, fq); S.done(cur); }
        if (!has_next) break;
#pragma unroll
        for (int a = 0; a < 2; ++a)
#pragma unroll
            for (int b = 0; b < 2; ++b)
#pragma unroll
                for (int m = 0; m < 4; ++m)
#pragma unroll
                    for (int n = 0; n < 2; ++n) acc[a][b][m][n] = (f32x4){0.f, 0.f, 0.f, 0.f};
        cur = nxt; cA = nA; cB = nB; ++ui;
        if constexpr (Epi::PREFETCH) { int l_ = fr + 16 * fq; asm volatile("" : "+v"(l_)); E.prefetch(lds, cur, wid * 64 + l_); }
        if constexpr (ALIGN_EPI) { if (wr == 1) PG8_BAR; }
    }
    PG8_WAIT_V(0);
    if constexpr (!ALIGN_EPI) { if (wr == 0) PG8_BAR; }
    PG8_BAR;
    if constexpr (Epi::AFTER_DRAIN) { E.fused(acc, cur, wr, wc, fr, fq, lds, wid, lane); S.done(cur); }
#undef PG8_SA
#undef PG8_SB
#undef PG8_STAGE
#undef PG8_LDA
#undef PG8_LDB
#undef PG8_MMA
#undef PG8_WAIT_V
#undef PG8_WAIT_L
#undef PG8_BAR
#undef PG8_SCHED
}
}

constexpr int NB = 4, SEQ = 8192, DM = 1024, TT = NB * SEQ;
constexpr int NPROJ = 2816, NPAD = 3072;
constexpr int PC_Q = 0, PC_K = 512, PC_V = 1024, PC_Z = 1536, PC_SQ = 2048, PC_SK = 2560, PC_SV = 2688;
constexpr int NE = 32, NCLS = 112, DE = 256;
constexpr float EPS = 1e-6f;
constexpr int NWAVES = 8, NTHR = 512;
constexpr int N_PHASES = 10;
#ifndef G1_SM
#define G1_SM 31
#endif
#ifndef PROBE_REP
#define PROBE_REP -1
#endif
#ifndef MK_ONE_LAUNCH
#define MK_ONE_LAUNCH 1
#endif

constexpr size_t MiB = 1u << 20;
constexpr size_t WS_CTL = 0, CTL_ZERO_BYTES = 65536;
constexpr size_t WS_MOD = 1 * MiB;
constexpr size_t WS_WINT = 2 * MiB, WS_WOUTT = 8 * MiB, WS_WGUT = 10 * MiB, WS_WDT = 42 * MiB;
constexpr size_t WS_H = 58 * MiB;
constexpr size_t WS_PROJ = 122 * MiB;
constexpr size_t WS_AB = 298 * MiB;
constexpr size_t WS_SSQ = WS_AB;
constexpr size_t WS_MIX = 300 * MiB;
constexpr size_t WS_GSF = 364 * MiB;
constexpr size_t WS_EREC = 404 * MiB, WS_CLIST = 412 * MiB;
constexpr size_t WS_HID = WS_PROJ;
constexpr size_t WS_X1B = WS_PROJ + 64 * MiB;
constexpr size_t WS_GAP = WS_H, WS_GQP = WS_H + 32 * MiB;
constexpr size_t WS_GOP = 426 * MiB, WS_GBP = 458 * MiB, WS_GGL = 490 * MiB;
constexpr size_t WS_WRT = 491 * MiB;
constexpr size_t WS_END = 492 * MiB;
constexpr int CW_BAR = 4096, CW_ECNT = 8192, CW_CCNT = 8256;

constexpr int RING_BYTES = 131072, LDSCTL_OFF = RING_BYTES, LDS_BYTES = 147456, MISC_OFF = LDS_BYTES - 128;

#define GAS __attribute__((address_space(1)))
#define LAS __attribute__((address_space(3)))
typedef unsigned short bf16;
typedef unsigned v4u __attribute__((ext_vector_type(4)));
typedef float f32x4 __attribute__((ext_vector_type(4)));
typedef GAS unsigned gu32;
#define RLX_AGENT __ATOMIC_RELAXED, __HIP_MEMORY_SCOPE_AGENT
#define LDS_WAIT() asm volatile("s_waitcnt lgkmcnt(0)" ::: "memory")
__device__ __forceinline__ unsigned f2bf(float f) { unsigned u = __builtin_bit_cast(unsigned, f); return (u + 0x7fffu + ((u >> 16) & 1u)) >> 16; }
__device__ __forceinline__ unsigned pk2(float lo, float hi) { return f2bf(lo) | (f2bf(hi) << 16); }
__device__ __forceinline__ float bf2f(bf16 v) { return __builtin_bit_cast(float, (unsigned)v << 16); }
__device__ __forceinline__ float wave_sum(float v) {
#pragma unroll
    for (int o = 1; o < 64; o <<= 1) v += __shfl_xor(v, o);
    return v;
}
__device__ __forceinline__ float siluf(float y) { return y / (1.f + __expf(-y)); }
#define XB_TMO      128
#define XB_XCNT(j)  (256  + 64 * (j))
#define XB_XSUB(j)  (1280 + 64 * (j))
#define XB_XGEN(j)  (2304 + 64 * (j))
#define XB_TOP      3328
#define XB_TOPGEN   3392
#define XCD_BAR_WORDS 3456
#define XB_SPIN_CAP (1u << 18)
__device__ __forceinline__ unsigned xb_ld(unsigned* p)              { return __hip_atomic_load(p, __ATOMIC_RELAXED, __HIP_MEMORY_SCOPE_AGENT); }
__device__ __forceinline__ unsigned xb_add(unsigned* p, unsigned v) { return __hip_atomic_fetch_add(p, v, __ATOMIC_RELAXED, __HIP_MEMORY_SCOPE_AGENT); }
__device__ __forceinline__ unsigned xb_xcc_id() { return (unsigned)__builtin_amdgcn_s_getreg((3 << 11) | 20) & 0xFu; }
#define XB_SPIN(cond, bar) do { unsigned _sp = 0; while (cond) { __builtin_amdgcn_s_sleep(1); \
    if ((++_sp & 255u) == 0u) { if (xb_ld(&(bar)[XB_TMO])) break; if (_sp > XB_SPIN_CAP) { atomicAdd(&(bar)[XB_TMO], 1u); break; } } } } while (0)

struct XcdBarrier {
    unsigned* bar; unsigned x;
    volatile LAS unsigned* st;
};

__device__ __forceinline__ XcdBarrier xcd_barrier_post(unsigned* bar, volatile LAS unsigned* st, bool leader  ) {
    XcdBarrier b; b.bar = bar; b.x = xb_xcc_id(); b.st = st;
    if (leader) (void)xb_add(&bar[XB_XCNT(b.x)], 1u);
    return b;
}
__device__ __forceinline__ void xcd_barrier_complete(unsigned* bar, unsigned x, unsigned& nloc, unsigned& nx) {
    const unsigned G = gridDim.x * gridDim.y * gridDim.z;
    unsigned sum, cnt, mine, sp = 0u;
    for (;;) {
        sum = 0u; cnt = 0u; mine = 0u;
#pragma unroll
        for (unsigned j = 0; j < 16; ++j) { const unsigned c = xb_ld(&bar[XB_XCNT(j)]); sum += c; cnt += (c > 0u) ? 1u : 0u; mine = (j == x) ? c : mine; }
        if (sum == G) break;
        __builtin_amdgcn_s_sleep(1);
        if ((++sp & 255u) == 0u) { if (xb_ld(&bar[XB_TMO])) break; if (sp > XB_SPIN_CAP) { atomicAdd(&bar[XB_TMO], 1u); break; } }
    }
    nloc = mine > 0u ? mine : 1u; nx = cnt > 0u ? cnt : 1u;
}

__device__ __forceinline__ void xcd_barrier(const XcdBarrier& b, bool leader  ) {
    asm volatile("s_waitcnt vmcnt(0)" ::: "memory");
    __syncthreads();
    if (leader) {
        unsigned* bar = b.bar;
        __builtin_amdgcn_s_waitcnt(0);
        unsigned nloc = b.st[0], nx = b.st[1];
        if (nloc == 0u) { xcd_barrier_complete(bar, b.x, nloc, nx); b.st[0] = nloc; b.st[1] = nx; }
        const unsigned old = xb_add(&bar[XB_XSUB(b.x)], 1u);
        const unsigned gen = old / nloc;
        if (old + 1u == (gen + 1u) * nloc) {
            __builtin_amdgcn_fence(__ATOMIC_RELEASE, "agent");
            asm volatile("s_waitcnt vmcnt(0)" ::: "memory");
            const unsigned og = xb_add(&bar[XB_TOP], 1u);
            const unsigned tg = og / nx;
            if (og + 1u == (tg + 1u) * nx) xb_add(&bar[XB_TOPGEN], 1u);
            else XB_SPIN(xb_ld(&bar[XB_TOPGEN]) == tg, bar);
            __builtin_amdgcn_fence(__ATOMIC_ACQUIRE, "agent");
            xb_add(&bar[XB_XGEN(b.x)], 1u);
            asm volatile("s_waitcnt vmcnt(0)" ::: "memory");
        } else {
            XB_SPIN(xb_ld(&bar[XB_XGEN(b.x)]) == gen, bar);
            __builtin_amdgcn_fence(__ATOMIC_ACQUIRE, "agent");
            asm volatile("s_waitcnt vmcnt(0)" ::: "memory");
        }
    }
    __syncthreads();
}

struct Args { const void* in[23]; float* out; unsigned char* ws; int ph_lo, ph_hi; };
enum { I_X = 0, I_C, I_POS, I_WADA, I_BADA, I_NORM_MIX, I_WIN, I_CONVW, I_ALOG, I_DTB, I_GNORM, I_QNORM, I_KNORM, I_SINKS, I_WOUT, I_NORM_FFN, I_WGRP, I_BGRP, I_WRT, I_BRT, I_WGATE, I_WUP, I_WDOWN };


__device__ __forceinline__ unsigned pk4f8(float a, float b, float c, float d) {
    a = __builtin_amdgcn_fmed3f(a, -448.f, 448.f); b = __builtin_amdgcn_fmed3f(b, -448.f, 448.f); c = __builtin_amdgcn_fmed3f(c, -448.f, 448.f); d = __builtin_amdgcn_fmed3f(d, -448.f, 448.f);
    int v = 0; v = __builtin_amdgcn_cvt_pk_fp8_f32(a, b, v, false); v = __builtin_amdgcn_cvt_pk_fp8_f32(c, d, v, true); return (unsigned)v; }
typedef unsigned v2u8_t __attribute__((ext_vector_type(2)));
constexpr float W8_SCALE = 64.f, HID8_SCALE = 8.f;
template <class CM>
__device__ __forceinline__ void transpose_item(const float* W, int ldw, int k0, bf16* WT, int ldt, int n0, CM cm, LAS float* scr, int lane) {
    const int sc = cm(n0 + (lane & 31));
    float tv[32];
#pragma unroll
    for (int i = 0; i < 32; ++i) { const int kk = 2 * i + (lane >> 5); tv[i] = W[(size_t)(k0 + kk) * ldw + (sc >= 0 ? sc : 0)]; }
#pragma unroll
    for (int i = 0; i < 32; ++i) { const int kk = 2 * i + (lane >> 5); scr[kk * 33 + (lane & 31)] = sc >= 0 ? tv[i] : 0.f; }
    LDS_WAIT(); asm volatile("" ::: "memory");
    const int c = lane & 7;
#pragma unroll
    for (int j = 0; j < 4; ++j) { const int n = (lane >> 3) + 8 * j; const LAS float* s = scr + (8 * c) * 33 + n;
        v4u o; o.x = pk2(s[0 * 33], s[1 * 33]); o.y = pk2(s[2 * 33], s[3 * 33]); o.z = pk2(s[4 * 33], s[5 * 33]); o.w = pk2(s[6 * 33], s[7 * 33]);
        *(v4u*)(WT + (size_t)(n0 + n) * ldt + k0 + 8 * c) = o; }
    LDS_WAIT(); asm volatile("" ::: "memory");
}
template <class CM>
__device__ __forceinline__ void transpose_item8(const float* W, int ldw, int k0, unsigned char* WT, int ldt, int n0, CM cm, LAS float* scr, int lane, float scl) {
    const int sc = cm(n0 + (lane & 31));
    float tv[32];
#pragma unroll
    for (int i = 0; i < 32; ++i) { const int kk = 2 * i + (lane >> 5); tv[i] = W[(size_t)(k0 + kk) * ldw + (sc >= 0 ? sc : 0)]; }
#pragma unroll
    for (int i = 0; i < 32; ++i) { const int kk = 2 * i + (lane >> 5); scr[kk * 33 + (lane & 31)] = sc >= 0 ? tv[i] * scl : 0.f; }
    LDS_WAIT(); asm volatile("" ::: "memory");
    const int c = lane & 7;
#pragma unroll
    for (int j = 0; j < 4; ++j) { const int n = (lane >> 3) + 8 * j; const LAS float* s = scr + (8 * c) * 33 + n;
        v2u8_t o; o.x = pk4f8(s[0 * 33], s[1 * 33], s[2 * 33], s[3 * 33]); o.y = pk4f8(s[4 * 33], s[5 * 33], s[6 * 33], s[7 * 33]);
        *(v2u8_t*)(WT + (size_t)(n0 + n) * ldt + k0 + 8 * c) = o; }
    LDS_WAIT(); asm volatile("" ::: "memory");
}
struct CmIn { __device__ __forceinline__ int operator()(int n) const { return n < 2048 ? n : (n < 2816 ? n + 16 : (n < 2832 ? 2048 + (n - 2816) : -1)); } };
struct CmOff { int off; __device__ __forceinline__ int operator()(int n) const { return n + off; } };
struct CmId { __device__ __forceinline__ int operator()(int n) const { return n; } };

__device__ __forceinline__ void expert_weight_copy(const Args& A, LAS unsigned char* lds, int lane, int wave) {
    unsigned char* ws = A.ws;
    LAS float* scr = (LAS float*)(lds + wave * 8448);
    const int G = gridDim.x, gw = blockIdx.x * NWAVES + wave, NGW = G * NWAVES;
    {   constexpr int IT_GU = NE * 16 * 16, IT_D = NE * 32 * 4;
        const float* wgate = (const float*)A.in[I_WGATE]; const float* wup = (const float*)A.in[I_WUP]; const float* wdown = (const float*)A.in[I_WDOWN];
        for (int it = gw; it < IT_GU + IT_D; it += NGW) {
            if (it < IT_GU) { const int e = it >> 8, r = it & 255, nb = r & 15, kb = r >> 4, j = nb >> 3, q = nb & 7;
                const float* W = (q < 4 ? wgate : wup) + (size_t)e * 1024 * 256; const int col0 = j * 128 + (q & 3) * 32;
                transpose_item8(W, 256, kb * 64, ws + WS_WGUT + (size_t)e * 512 * 1024, 1024, nb * 32, CmOff{col0 - nb * 32}, scr, lane, W8_SCALE); }
            else { const int r2 = it - IT_GU, e = r2 >> 7, r = r2 & 127, nb = r & 31, kb = r >> 5;
                transpose_item8(wdown + (size_t)e * 256 * 1024, 1024, kb * 64, ws + WS_WDT + (size_t)e * 1024 * 256, 256, nb * 32, CmId(), scr, lane, W8_SCALE); }
        }
    }
}
__device__ __forceinline__ void p0_prologue(const Args& A, LAS unsigned char* lds, int tid, int lane, int wave) {
    unsigned char* ws = A.ws;
    LAS float* scr = (LAS float*)(lds + wave * 8448);
    const int G = gridDim.x, gw = blockIdx.x * NWAVES + wave, NGW = G * NWAVES;
    constexpr int IT_IN = (NPAD / 32) * (DM / 64), IT_OUT = (DM / 32) * (DM / 64);
    for (int it = gw; it < IT_IN + IT_OUT; it += NGW) {
        if (it < IT_IN) { const int nb = it % (NPAD / 32), kb = it / (NPAD / 32); transpose_item((const float*)A.in[I_WIN], 2832, kb * 64, (bf16*)(ws + WS_WINT), DM, nb * 32, CmIn(), scr, lane); }
        else { const int r = it - IT_IN, nb = r % (DM / 32), kb = r / (DM / 32); transpose_item((const float*)A.in[I_WOUT], DM, kb * 64, (bf16*)(ws + WS_WOUTT), DM, nb * 32, CmId(), scr, lane); }
    }
    {   const float* wgp = (const float*)A.in[I_WGRP]; const float* wrt = (const float*)A.in[I_WRT];
        bf16* wf = (bf16*)(ws + WS_WRT);
        for (int idx = blockIdx.x * NTHR + tid; idx < 48 * 1024; idx += G * NTHR) { const int j = idx & 7, ln = (idx >> 3) & 63, ks = (idx >> 9) & 31, nt = idx >> 14;
            const int o = 16 * nt + (ln & 15), k = 32 * ks + 8 * (ln >> 4) + j;
            const float w = o < 4 ? wgp[k * 4 + o] : (o < 36 ? wrt[k * 32 + o - 4] : 0.f);
            const unsigned hb = f2bf(w); wf[idx] = (bf16)hb; wf[48 * 1024 + idx] = (bf16)f2bf(w - __builtin_bit_cast(float, hb << 16)); }
    }
    LAS float* cact = (LAS float*)(lds + 69632);
    LAS float* red = (LAS float*)(lds + 69632 + 16384);
    const float* c = (const float*)A.in[I_C]; const float* wada = (const float*)A.in[I_WADA]; const float* bada = (const float*)A.in[I_BADA];
    float* mod = (float*)(ws + WS_MOD);
    if ((int)blockIdx.x < 192) {
        __syncthreads();
        for (int i = tid; i < 4096; i += NTHR) cact[i] = siluf(c[i]);
        __syncthreads();
        for (int u = blockIdx.x; u < 192; u += G) {
            const int n = u * 32 + (lane & 31), kh = lane >> 5; float a0 = 0.f, a1 = 0.f, a2 = 0.f, a3 = 0.f;
#pragma unroll 16
            for (int i = 0; i < 64; ++i) { const int k = wave * 128 + 2 * i + kh; const float w = wada[(size_t)k * 6144 + n]; a0 += cact[k] * w; a1 += cact[1024 + k] * w; a2 += cact[2048 + k] * w; a3 += cact[3072 + k] * w; }
            a0 += __shfl_xor(a0, 32); a1 += __shfl_xor(a1, 32); a2 += __shfl_xor(a2, 32); a3 += __shfl_xor(a3, 32);
            if (lane < 32) { red[(wave * 4 + 0) * 64 + lane] = a0; red[(wave * 4 + 1) * 64 + lane] = a1; red[(wave * 4 + 2) * 64 + lane] = a2; red[(wave * 4 + 3) * 64 + lane] = a3; }
            __syncthreads();
            if (tid < 128) { const int b = tid >> 5, l = tid & 31; float s = bada[u * 32 + l];
#pragma unroll
                for (int w = 0; w < 8; ++w) s += red[(w * 4 + b) * 64 + l];
                mod[b * 6144 + u * 32 + l] = s; }
            __syncthreads();
        }
    }
}

template <bool ROUTE>
__device__ __forceinline__ void norm_rows(const Args& A, const float* X, const float* gain, const float* shift, const float* scale, bf16* H, LAS unsigned char* lds, int lane, int wave) {
    LAS float* hl = (LAS float*)(lds + wave * 4096);
    const int G = gridDim.x, gw = blockIdx.x * NWAVES + wave, NGW = G * NWAVES;
    unsigned char* ws = A.ws;
    for (int r0 = gw * 16; r0 < TT; r0 += NGW * 16) {
        const int b = r0 / SEQ;
        f32x4 mf[4], af[4];
#pragma unroll
        for (int j = 0; j < 4; ++j) { const int col = 4 * lane + 256 * j; const f32x4 g = *(const f32x4*)(gain + col), sc = *(const f32x4*)(scale + b * 6144 + col);
            mf[j] = g * (sc + 1.0f); af[j] = *(const f32x4*)(shift + b * 6144 + col); }
#pragma unroll 4
        for (int i = 0; i < 16; ++i) {
            const int row = r0 + i;
            const f32x4* xr = (const f32x4*)(X + (size_t)row * DM) + lane;
            f32x4 v[4]; float s = 0.f;
#pragma unroll
            for (int j = 0; j < 4; ++j) { v[j] = xr[64 * j]; s += (v[j].x * v[j].x + v[j].y * v[j].y) + (v[j].z * v[j].z + v[j].w * v[j].w); }
            const float rstd = 1.f / sqrtf(wave_sum(s) * (1.f / DM) + EPS);
            unsigned long long* o8 = (unsigned long long*)(H + (size_t)row * DM) + lane;
#pragma unroll
            for (int j = 0; j < 4; ++j) { v[j] = v[j] * rstd * mf[j] + af[j];
                o8[64 * j] = (unsigned long long)pk2(v[j].x, v[j].y) | ((unsigned long long)pk2(v[j].z, v[j].w) << 32); }
            if constexpr (ROUTE) {
                const float* wg = (const float*)A.in[I_WGRP]; const float* wr = (const float*)A.in[I_WRT];
                float lg[36];
#pragma unroll
                for (int o = 0; o < 36; ++o) lg[o] = 0.f;
#pragma unroll
                for (int j = 0; j < 4; ++j) *(LAS f32x4*)(hl + 4 * lane + 256 * j) = v[j];
                LDS_WAIT(); asm volatile("" ::: "memory");
#pragma unroll 1
                for (int ii = 0; ii < 16; ++ii) { const int k = lane + 64 * ii; const float hv = hl[k];
                    const f32x4 g4 = *(const f32x4*)(wg + k * 4);
                    lg[0] += hv * g4.x; lg[1] += hv * g4.y; lg[2] += hv * g4.z; lg[3] += hv * g4.w;
#pragma unroll
                    for (int q = 0; q < 8; ++q) { const f32x4 r4 = *(const f32x4*)(wr + k * 32 + q * 4);
                        lg[4 + q * 4 + 0] += hv * r4.x; lg[4 + q * 4 + 1] += hv * r4.y; lg[4 + q * 4 + 2] += hv * r4.z; lg[4 + q * 4 + 3] += hv * r4.w; } }
                LDS_WAIT(); asm volatile("" ::: "memory");
#pragma unroll
                for (int o = 0; o < 36; ++o) lg[o] = wave_sum(lg[o]);
                const float* bg = (const float*)A.in[I_BGRP]; const float* br = (const float*)A.in[I_BRT];
#pragma unroll
                for (int o = 0; o < 4; ++o) lg[o] += bg[o];
#pragma unroll
                for (int o = 0; o < 32; ++o) lg[4 + o] += br[o];
                int gi = 0; float gm = lg[0];
#pragma unroll
                for (int o = 1; o < 4; ++o) if (lg[o] > gm) { gm = lg[o]; gi = o; }
                float gs = 0.f;
#pragma unroll
                for (int o = 0; o < 4; ++o) gs += __expf(lg[o] - gm);
                const float pg = 1.f / gs;
                float le[8];
#pragma unroll
                for (int j = 0; j < 8; ++j) { le[j] = lg[4 + j];
#pragma unroll
                    for (int g = 1; g < 4; ++g) le[j] = (gi == g) ? lg[4 + g * 8 + j] : le[j]; }
                int j1 = 0; float m1 = le[0];
#pragma unroll
                for (int j = 1; j < 8; ++j) if (le[j] > m1) { m1 = le[j]; j1 = j; }
                int j2 = -1; float m2 = -3.0e38f;
#pragma unroll
                for (int j = 0; j < 8; ++j) if (j != j1 && le[j] > m2) { m2 = le[j]; j2 = j; }
                const float ex = __expf(m2 - m1), w1 = pg / (1.f + ex), w2 = pg * ex / (1.f + ex);
                if (lane == 0) {
                    const int e1 = gi * 8 + j1, e2 = gi * 8 + j2;
                    unsigned* ctl = (unsigned*)(ws + WS_CTL);
                    int2* erec = (int2*)(ws + WS_EREC); int* clist = (int*)(ws + WS_CLIST);
                    const unsigned p1 = atomicAdd(ctl + CW_ECNT + e1, 1u); erec[(size_t)e1 * TT + p1] = make_int2(row * 2 + (e1 > e2 ? 1 : 0), __builtin_bit_cast(int, w1));
                    const unsigned p2 = atomicAdd(ctl + CW_ECNT + e2, 1u); erec[(size_t)e2 * TT + p2] = make_int2(row * 2 + (e2 > e1 ? 1 : 0), __builtin_bit_cast(int, w2));
                    const int a = j1 < j2 ? j1 : j2, bb = j1 < j2 ? j2 : j1;
                    const int cls = gi * 28 + (a * 7 - (a * (a - 1)) / 2 + (bb - a - 1));
                    const unsigned pc = atomicAdd(ctl + CW_CCNT + cls, 1u); clist[(size_t)cls * TT + pc] = row;
                }
            }
        }
    }
}

typedef short bf16x8_t __attribute__((ext_vector_type(8)));
typedef float f32x16 __attribute__((ext_vector_type(16)));
typedef unsigned v2u __attribute__((ext_vector_type(2)));
typedef float f32x2_t __attribute__((ext_vector_type(2)));
typedef __bf16 bf16x2_t __attribute__((ext_vector_type(2)));
__device__ __forceinline__ unsigned cvtpk(float lo, float hi) { const f32x2_t f = {lo, hi}; return __builtin_bit_cast(unsigned, __builtin_convertvector(f, bf16x2_t)); }
__device__ __forceinline__ void fast_sincos(float ang, float& sn, float& cs) {
    float rev = ang * 0.15915494309189535f; rev -= floorf(rev);
    sn = __builtin_amdgcn_sinf(rev); cs = __builtin_amdgcn_cosf(rev);
}
__device__ __forceinline__ void swa_mfma(const Args& A, LAS unsigned char* lds, int tid, int lane, int wave, int blk, int nblk) {
    unsigned char* ws = A.ws;
    const bf16* proj = (const bf16*)(ws + WS_PROJ);
    bf16* mix = (bf16*)(ws + WS_MIX); const float* sinks = (const float*)A.in[I_SINKS];
    const int* pos = (const int*)A.in[I_POS]; const float* qn = (const float*)A.in[I_QNORM]; const float* kn = (const float*)A.in[I_KNORM];
    constexpr int KST = 144, VST = 520;
    LAS unsigned char* Kl = lds; LAS unsigned char* Vt = lds + 256 * KST;
    const int g = wave >> 1, qh = wave & 1, ql = lane & 31, hh = lane >> 5;
    constexpr float LOG2E = 1.4426950408889634f, CS = 0.125f * LOG2E, L2T = 13.287712379549449f / 32.f;
    const int sch = tid & 7;
    float kinv[8], kgn[8];
#pragma unroll
    for (int j = 0; j < 8; ++j) { kinv[j] = __builtin_amdgcn_exp2f(-(float)((sch & 3) * 8 + j) * L2T); kgn[j] = kn[sch * 8 + j]; }
    float qinv[2][8];
#pragma unroll
    for (int ks = 0; ks < 2; ++ks)
#pragma unroll
        for (int j = 0; j < 8; ++j) qinv[ks][j] = __builtin_amdgcn_exp2f(-(float)(ks * 16 + hh * 8 + j) * L2T);
    for (int u = blk; u < NB * 2 * (SEQ / 128); u += nblk) {
        const int n = u & 63, kvh = (u >> 6) & 1, b = u >> 7;
        const int tb = b * SEQ + n * 128;
        __syncthreads();
#pragma unroll
        for (int it = 0; it < 4; ++it) { const int idx = tid + it * NTHR, key = idx >> 3, ch = idx & 7; int tk = tb - 128 + key; if (tk < b * SEQ) tk = b * SEQ;
            const v4u kv = *(const v4u*)(proj + (size_t)tk * NPROJ + PC_SK + kvh * 64 + ch * 8);
            const v4u vv = *(const v4u*)(proj + (size_t)tk * NPROJ + PC_SV + kvh * 64 + ch * 8);
            const float pf = (float)pos[tk];
            float x[8] = { __builtin_bit_cast(float, kv.x << 16), __builtin_bit_cast(float, kv.x & 0xffff0000u), __builtin_bit_cast(float, kv.y << 16), __builtin_bit_cast(float, kv.y & 0xffff0000u),
                           __builtin_bit_cast(float, kv.z << 16), __builtin_bit_cast(float, kv.z & 0xffff0000u), __builtin_bit_cast(float, kv.w << 16), __builtin_bit_cast(float, kv.w & 0xffff0000u) };
            float ss = 0.f;
#pragma unroll
            for (int j = 0; j < 8; ++j) ss += x[j] * x[j];
            ss += __shfl_xor(ss, 1); ss += __shfl_xor(ss, 2); ss += __shfl_xor(ss, 4);
            const float rn = 1.f / sqrtf(ss * (1.f / 64.f) + EPS);
            float o[8];
#pragma unroll
            for (int j = 0; j < 8; ++j) { const float xn = x[j] * rn * kgn[j]; const float pr = __shfl_xor(xn, 4); float sn, cs; fast_sincos(pf * kinv[j], sn, cs);
                o[j] = (ch < 4) ? xn * cs - pr * sn : pr * sn + xn * cs; }
            v4u ko; ko.x = cvtpk(o[0], o[1]); ko.y = cvtpk(o[2], o[3]); ko.z = cvtpk(o[4], o[5]); ko.w = cvtpk(o[6], o[7]);
            *(LAS v4u*)(Kl + key * KST + ch * 16) = ko;
            LAS unsigned short* vp = (LAS unsigned short*)(Vt + (ch * 8) * VST + key * 2);
            vp[0 * (VST / 2)] = (unsigned short)(vv.x & 0xffffu); vp[1 * (VST / 2)] = (unsigned short)(vv.x >> 16);
            vp[2 * (VST / 2)] = (unsigned short)(vv.y & 0xffffu); vp[3 * (VST / 2)] = (unsigned short)(vv.y >> 16);
            vp[4 * (VST / 2)] = (unsigned short)(vv.z & 0xffffu); vp[5 * (VST / 2)] = (unsigned short)(vv.z >> 16);
            vp[6 * (VST / 2)] = (unsigned short)(vv.w & 0xffffu); vp[7 * (VST / 2)] = (unsigned short)(vv.w >> 16); }
        __syncthreads();
        const int hq = kvh * 4 + g; const float sinkl = sinks[hq] * LOG2E;
#pragma unroll 1
        for (int qt = 0; qt < 2; ++qt) {
            const int i0 = qh * 64 + qt * 32, iq = i0 + ql;
            const size_t tq = (size_t)(tb + iq);
            bf16x8_t qf[4];
            {   float xq[4][8]; float ss = 0.f;
#pragma unroll
                for (int ks = 0; ks < 4; ++ks) { const v4u r = *(const v4u*)(proj + tq * NPROJ + PC_SQ + hq * 64 + ks * 16 + hh * 8);
                    xq[ks][0] = __builtin_bit_cast(float, r.x << 16); xq[ks][1] = __builtin_bit_cast(float, r.x & 0xffff0000u); xq[ks][2] = __builtin_bit_cast(float, r.y << 16); xq[ks][3] = __builtin_bit_cast(float, r.y & 0xffff0000u);
                    xq[ks][4] = __builtin_bit_cast(float, r.z << 16); xq[ks][5] = __builtin_bit_cast(float, r.z & 0xffff0000u); xq[ks][6] = __builtin_bit_cast(float, r.w << 16); xq[ks][7] = __builtin_bit_cast(float, r.w & 0xffff0000u);
#pragma unroll
                    for (int j = 0; j < 8; ++j) ss += xq[ks][j] * xq[ks][j]; }
                ss += __shfl_xor(ss, 32);
                const float rn = 1.f / sqrtf(ss * (1.f / 64.f) + EPS); const float pf = (float)pos[tq];
#pragma unroll
                for (int ks = 0; ks < 4; ++ks)
#pragma unroll
                    for (int j = 0; j < 8; ++j) xq[ks][j] *= rn * qn[ks * 16 + hh * 8 + j];
#pragma unroll
                for (int ks = 0; ks < 2; ++ks)
#pragma unroll
                    for (int j = 0; j < 8; ++j) { float sn, cs; fast_sincos(pf * qinv[ks][j], sn, cs); const float x1 = xq[ks][j], x2 = xq[ks + 2][j];
                        xq[ks][j] = x1 * cs - x2 * sn; xq[ks + 2][j] = x1 * sn + x2 * cs; }
#pragma unroll
                for (int ks = 0; ks < 4; ++ks) { union { bf16x8_t v; unsigned u[4]; } p; p.u[0] = cvtpk(xq[ks][0], xq[ks][1]); p.u[1] = cvtpk(xq[ks][2], xq[ks][3]); p.u[2] = cvtpk(xq[ks][4], xq[ks][5]); p.u[3] = cvtpk(xq[ks][6], xq[ks][7]); qf[ks] = p.v; }
            }
            f32x16 sc[5];
#pragma unroll
            for (int kt = 0; kt < 5; ++kt) { f32x16 acc;
#pragma unroll
                for (int r = 0; r < 16; ++r) acc[r] = 0.f;
#pragma unroll
                for (int ks = 0; ks < 4; ++ks) { const bf16x8_t kf = *(const LAS bf16x8_t*)(Kl + (i0 + 32 * kt + ql) * KST + (ks * 16 + hh * 8) * 2);
                    acc = __builtin_amdgcn_mfma_f32_32x32x16_bf16(kf, qf[ks], acc, 0, 0, 0); }
                sc[kt] = acc; }
            float mloc = -3.0e38f;
#pragma unroll
            for (int kt = 0; kt < 5; ++kt) {
                if (kt == 0 || kt == 4 || n == 0) {
#pragma unroll
                    for (int r = 0; r < 16; ++r) { const int j = i0 + 32 * kt + (r & 3) + 8 * (r >> 2) + 4 * hh;
                        const bool valid = (j > iq) && (j <= iq + 128) && (n > 0 || j >= 128);
                        const float sv = valid ? sc[kt][r] * CS : -1.0e30f; sc[kt][r] = sv; mloc = fmaxf(mloc, sv); }
                } else {
#pragma unroll
                    for (int r = 0; r < 16; ++r) { const float sv = sc[kt][r] * CS; sc[kt][r] = sv; mloc = fmaxf(mloc, sv); }
                } }
            float mx = fmaxf(mloc, __shfl_xor(mloc, 32)); mx = fmaxf(mx, sinkl);
            float lsum = 0.f;
#pragma unroll
            for (int kt = 0; kt < 5; ++kt)
#pragma unroll
                for (int r = 0; r < 16; ++r) { const float p = __builtin_amdgcn_exp2f(sc[kt][r] - mx); sc[kt][r] = p; lsum += p; }
            lsum += __shfl_xor(lsum, 32); lsum += __builtin_amdgcn_exp2f(sinkl - mx);
            f32x16 o0, o1;
#pragma unroll
            for (int r = 0; r < 16; ++r) { o0[r] = 0.f; o1[r] = 0.f; }
#pragma unroll
            for (int kt = 0; kt < 5; ++kt)
#pragma unroll
                for (int s2 = 0; s2 < 2; ++s2) {
                    union { bf16x8_t v; unsigned u[4]; } pf;
#pragma unroll
                    for (int p = 0; p < 4; ++p) pf.u[p] = cvtpk(sc[kt][8 * s2 + 2 * p], sc[kt][8 * s2 + 2 * p + 1]);
                    const int jb = i0 + 32 * kt + 16 * s2 + 4 * hh;
                    union { bf16x8_t v; v2u u[2]; } v0, v1;
                    const LAS unsigned char* r0 = Vt + ql * VST + jb * 2; const LAS unsigned char* r1 = Vt + (32 + ql) * VST + jb * 2;
                    v0.u[0] = *(const LAS v2u*)(r0); v0.u[1] = *(const LAS v2u*)(r0 + 16);
                    v1.u[0] = *(const LAS v2u*)(r1); v1.u[1] = *(const LAS v2u*)(r1 + 16);
                    o0 = __builtin_amdgcn_mfma_f32_32x32x16_bf16(v0.v, pf.v, o0, 0, 0, 0);
                    o1 = __builtin_amdgcn_mfma_f32_32x32x16_bf16(v1.v, pf.v, o1, 0, 0, 0);
                }
            const float il = 1.f / lsum;
            bf16* op = mix + tq * DM + 512 + hq * 64 + 4 * hh;
#pragma unroll
            for (int rq = 0; rq < 4; ++rq) {
                v2u w0; w0.x = cvtpk(o0[4 * rq] * il, o0[4 * rq + 1] * il); w0.y = cvtpk(o0[4 * rq + 2] * il, o0[4 * rq + 3] * il);
                *(v2u*)(op + 8 * rq) = w0;
                v2u w1; w1.x = cvtpk(o1[4 * rq] * il, o1[4 * rq + 1] * il); w1.y = cvtpk(o1[4 * rq + 2] * il, o1[4 * rq + 3] * il);
                *(v2u*)(op + 32 + 8 * rq) = w1; }
        }
    }
}

__device__ __forceinline__ int frag_a_idx(int row, int col) { const int mt = row >> 4, l15 = row & 15, ks = col >> 5, x = col & 31, jh = x >> 4, g4 = (x >> 2) & 3, jl = x & 3; return ((mt * 2 + ks) * 64 + g4 * 16 + l15) * 8 + 4 * jh + jl; }
__device__ __forceinline__ int frag_c_idx(int row, int col) { const int w = col >> 4, l15 = col & 15, mt = row >> 4, y = row & 15, g4 = y >> 2, i = y & 3; return ((w * 64 + g4 * 16 + l15) * 4 + mt) * 4 + i; }
__device__ __forceinline__ void gdn_g1_naive(const Args& A, LAS float* L, int tid) {
    unsigned char* ws = A.ws;
    const bf16* proj = (const bf16*)(ws + WS_PROJ); const float* ab = (const float*)(ws + WS_AB);
    bf16* AP = (bf16*)(ws + WS_GAP); bf16* BP = (bf16*)(ws + WS_GBP); bf16* QP = (bf16*)(ws + WS_GQP); bf16* OP = (bf16*)(ws + WS_GOP); float* GL = (float*)(ws + WS_GGL);
    const float* convw = (const float*)A.in[I_CONVW];
    constexpr int LD = 65, AR = 64 * LD;
    LAS float* q = L; LAS float* k = q + AR; LAS float* v = k + AR; LAS float* Mm = v + AR; LAS float* At = Mm + AR; LAS float* w = At + AR;
    LAS float* Gc = w + AR; LAS float* beta = Gc + 64;
    const int i8 = tid >> 3, e0 = (tid & 7) * 8;
    for (int cid = blockIdx.x; cid < NB * 8 * 128; cid += gridDim.x) {
        const int n = cid & 127, bh = cid >> 7, b = bh >> 3, h = bh & 7;
        const float Ah = expf(((const float*)A.in[I_ALOG])[h]), dtb = ((const float*)A.in[I_DTB])[h];
        const int t0 = b * SEQ + n * 64;
        __syncthreads();
        for (int idx = tid; idx < 3 * 4096; idx += NTHR) {
            const int part = idx >> 12, rem = idx & 4095, i = rem >> 6, d = rem & 63, c = part * 512 + h * 64 + d;
            float y = 0.f;
#pragma unroll
            for (int j = 0; j < 4; ++j) { const int s = n * 64 + i - 3 + j; if (s >= 0) y += convw[j * 1536 + c] * bf2f(proj[(size_t)(b * SEQ + s) * NPROJ + c]); }
            y = y / (1.f + __expf(-y));
            (part == 0 ? q : (part == 1 ? k : v))[i * LD + d] = y;
        }
        if (tid < 64) { const float a = ab[(size_t)(t0 + tid) * 16 + h], bb = ab[(size_t)(t0 + tid) * 16 + 8 + h]; const float xx = a + dtb;
            const float sp = xx > 20.f ? xx : log1pf(expf(xx)); Gc[tid] = -Ah * sp; beta[tid] = 1.f / (1.f + __expf(-bb)); }
        __syncthreads();
        if (tid < 128) { LAS float* arr = tid < 64 ? q : k; const int i = tid & 63; float ss = 0.f;
            for (int d = 0; d < 64; ++d) ss += arr[i * LD + d] * arr[i * LD + d];
            const float r = (1.f / sqrtf(ss + EPS)) * (tid < 64 ? 0.125f : 1.f);
            for (int d = 0; d < 64; ++d) arr[i * LD + d] *= r; }
        if (tid == 128) { float run = 0.f; for (int i = 0; i < 64; ++i) { run += Gc[i]; Gc[i] = run; } }
        __syncthreads();
        {   const int i = i8;
            for (int jj = 0; jj < 8; ++jj) { const int j = e0 + jj; float dq = 0.f, dk = 0.f;
_Pragma("unroll 2") for (int d = 0; d < 64; ++d) { const float kj = k[j * LD + d]; dq += q[i * LD + d] * kj; dk += k[i * LD + d] * kj; }
                const float dec = (i >= j) ? __expf(Gc[i] - Gc[j]) : 0.f;
                At[i * LD + j] = dq * dec; Mm[i * LD + j] = (i > j) ? dk * beta[i] * dec : 0.f; }
        }
        __syncthreads();
        for (int idx = tid; idx < 4096; idx += NTHR) { const int i = idx >> 6, d = idx & 63; v[i * LD + d] *= beta[i]; w[i * LD + d] = k[i * LD + d] * beta[i] * __expf(Gc[i]); }
        __syncthreads();
        if (tid < 128) { LAS float* arr = tid < 64 ? v : w; const int c = tid & 63;
            _Pragma("unroll 1") for (int i = 1; i < 64; ++i) { float a = arr[i * LD + c]; _Pragma("unroll 4") for (int j = 0; j < i; ++j) a -= Mm[i * LD + j] * arr[j * LD + c]; arr[i * LD + c] = a; } }
        __syncthreads();
        const float gl = Gc[63];
        const size_t cb = (size_t)cid * 4096;
        {
            const int d = i8; float a[8], bq[8];
#pragma unroll
            for (int ee = 0; ee < 8; ++ee) { a[ee] = 0.f; bq[ee] = 0.f; }
_Pragma("unroll 2")
            for (int c = 0; c < 64; ++c) { const float kd = k[c * LD + d] * __expf(gl - Gc[c]);
#pragma unroll
                for (int ee = 0; ee < 8; ++ee) { a[ee] -= kd * w[c * LD + e0 + ee]; bq[ee] += kd * v[c * LD + e0 + ee]; } }
#pragma unroll
            for (int ee = 0; ee < 8; ++ee) { const int dp = e0 + ee; AP[cb + frag_a_idx(d, dp)] = (bf16)f2bf(a[ee]); BP[cb + frag_c_idx(d, dp)] = (bf16)f2bf(bq[ee]); }
        }
        {
            const int c = i8; float a[8], bq[8]; const float eg = __expf(Gc[c]);
#pragma unroll
            for (int ee = 0; ee < 8; ++ee) { a[ee] = eg * q[c * LD + e0 + ee]; bq[ee] = 0.f; }
_Pragma("unroll 2")
            for (int s2 = 0; s2 <= c; ++s2) { const float av = At[c * LD + s2];
#pragma unroll
                for (int ee = 0; ee < 8; ++ee) { a[ee] -= av * w[s2 * LD + e0 + ee]; bq[ee] += av * v[s2 * LD + e0 + ee]; } }
#pragma unroll
            for (int ee = 0; ee < 8; ++ee) { const int dp = e0 + ee; QP[cb + frag_a_idx(c, dp)] = (bf16)f2bf(a[ee]); OP[cb + frag_c_idx(c, dp)] = (bf16)f2bf(bq[ee]); }
        }
        if (tid == 0) GL[cid] = __expf(gl);
    }
}
__device__ __forceinline__ float wave_incl_scan_f(float v, int lane) {
#pragma unroll
    for (int o = 1; o < 64; o <<= 1) { const float t = __shfl_up(v, o); if (lane >= o) v += t; }
    return v;
}
__device__ __forceinline__ v2u pack4(f32x4 v) { v2u r; r.x = cvtpk(v.x, v.y); r.y = cvtpk(v.z, v.w); return r; }
__device__ __forceinline__ bf16x8_t mk8(v2u lo, v2u hi) { union { bf16x8_t v; unsigned u[4]; } x; x.u[0] = lo.x; x.u[1] = lo.y; x.u[2] = hi.x; x.u[3] = hi.y; return x.v; }
template <int SM, int STG = 7>
__device__ __forceinline__ void gdn_g1_mfma(const Args& A, LAS unsigned char* lds, int tid, int lane, int wave) {
    unsigned char* ws = A.ws;
    const bf16* proj = (const bf16*)(ws + WS_PROJ); const float* ab = (const float*)(ws + WS_AB);
    bf16* AP = (bf16*)(ws + WS_GAP); bf16* BP = (bf16*)(ws + WS_GBP); bf16* QP = (bf16*)(ws + WS_GQP); bf16* OP = (bf16*)(ws + WS_GOP); float* GL = (float*)(ws + WS_GGL);
    const float* convw = (const float*)A.in[I_CONVW];
    constexpr int KST = 144, RST = 68;
    LAS unsigned char* const Kr0 = lds;
    const int l15 = lane & 15, g4 = lane >> 4;
    const v2u zero2 = {0u, 0u};
    const int G = gridDim.x;
    const int ppart = wave >> 1, pt4 = 4 * ((wave & 1) * 8 + (lane >> 3)), pd0 = (lane & 7) * 8;
    v4u xr7[7];
#define G1_PREFETCH(IDX) do { if (wave < 6) { const int h_ = (IDX) & 7, bn_ = (IDX) >> 3, b_ = bn_ >> 7, n_ = bn_ & 127; \
        _Pragma("unroll") for (int r = 0; r < 7; ++r) { const int s_ = n_ * 64 + pt4 - 3 + r, sc_ = s_ < 0 ? 0 : s_; \
            const v4u r_ = *(const v4u*)(proj + (size_t)(b_ * SEQ + sc_) * NPROJ + ppart * 512 + h_ * 64 + pd0); const unsigned m_ = s_ < 0 ? 0u : 0xffffffffu; \
            xr7[r] = (v4u){r_.x & m_, r_.y & m_, r_.z & m_, r_.w & m_}; } } } while (0)
    int hcur = -1;
    constexpr int NC = NB * 8 * 128;
    if ((int)blockIdx.x < NC) G1_PREFETCH((int)blockIdx.x);
    for (int base = blockIdx.x; base < NC; base += 16 * G) {
    {
        LAS float* const GsT0 = (LAS float*)(Kr0 + 91648);
        __syncthreads();
        for (int q = wave; q < 16; q += 8) { const int idx2 = base + q * G;
            if (idx2 < NC) { const int h2 = idx2 & 7, bn2 = idx2 >> 3, b2 = bn2 >> 7, n2 = bn2 & 127;
                const size_t t2 = (size_t)(b2 * SEQ + n2 * 64 + lane) * 16;
                const float Ah = __expf(((const float*)A.in[I_ALOG])[h2]), dtb = ((const float*)A.in[I_DTB])[h2];
                const float xx = ab[t2 + h2] + dtb, bb2 = ab[t2 + 8 + h2];
                const float sp = xx > 20.f ? xx : log1pf(__expf(xx));
                const float Gv = wave_incl_scan_f(-Ah * sp, lane);
                GsT0[q * 64 + lane] = Gv; GsT0[1024 + q * 64 + lane] = 1.f / (1.f + __expf(-bb2));
                if ((SM & 16) && lane == 63) GL[(b2 * 8 + h2) * 128 + n2] = __expf(Gv); } }
    }
#pragma unroll 1
    for (int it = 0; it < 16; ++it) {
        const int idx = base + it * G; if (idx >= NC) break;
        const int h = idx & 7, bn = idx >> 3, b = bn >> 7, n = bn & 127, bh = b * 8 + h, cid = bh * 128 + n;
        const size_t cb = (size_t)cid * 4096;
        int oz = 0; asm volatile("" : "+v"(oz));
        LAS unsigned char* const Kr = Kr0 + oz; LAS unsigned char* const Qr = Kr + 9216; LAS unsigned char* const kdT = Kr + 18432; LAS unsigned char* const Mm = Kr + 27648; LAS unsigned char* const At = Kr + 36864;
        LAS float* const Rt = (LAS float*)(Kr + 46080);
        LAS float* const Md = (LAS float*)(Kr + 80896);
        LAS unsigned char* const Tl = Kr + 86016;
        LAS float* const Gs = (LAS float*)(Kr + 91648) + 64 * it; LAS float* const Bs = Gs + 1024;
        LAS float* const cwl = (LAS float*)(Kr + 88576);
        __syncthreads();
        if (h != hcur) { hcur = h; for (int q = tid; q < 768; q += NTHR) { const int part = q >> 8, j = (q >> 6) & 3, d = q & 63; cwl[q] = convw[j * 1536 + part * 512 + h * 64 + d]; } __syncthreads(); }
        const bool more = (idx + G < NC);
        if (wave < 6) {
            const int d0 = pd0, t4 = pt4, dg = d0 >> 3, swk = dg << 3, swr = (dg & 3) << 3;
            float y[4][8];
            {   float wv[4][8];
#pragma unroll
                for (int j = 0; j < 4; ++j) { const f32x4 w0 = *(const LAS f32x4*)(cwl + (ppart * 4 + j) * 64 + d0), w1 = *(const LAS f32x4*)(cwl + (ppart * 4 + j) * 64 + d0 + 4);
                    wv[j][0] = w0.x; wv[j][1] = w0.y; wv[j][2] = w0.z; wv[j][3] = w0.w; wv[j][4] = w1.x; wv[j][5] = w1.y; wv[j][6] = w1.z; wv[j][7] = w1.w; }
#define G1_XE(r, e) __builtin_bit_cast(float, ((e) & 1) ? (((e) >> 1) == 0 ? xr7[r].x : ((e) >> 1) == 1 ? xr7[r].y : ((e) >> 1) == 2 ? xr7[r].z : xr7[r].w) & 0xffff0000u \
                                                        : (((e) >> 1) == 0 ? xr7[r].x : ((e) >> 1) == 1 ? xr7[r].y : ((e) >> 1) == 2 ? xr7[r].z : xr7[r].w) << 16)
#pragma unroll
                for (int tk = 0; tk < 4; ++tk)
#pragma unroll
                    for (int e = 0; e < 8; ++e) { const float a_ = wv[0][e] * G1_XE(tk, e) + wv[1][e] * G1_XE(tk + 1, e) + wv[2][e] * G1_XE(tk + 2, e) + wv[3][e] * G1_XE(tk + 3, e);
                        y[tk][e] = a_ * __builtin_amdgcn_rcpf(1.f + __expf(-a_)); }
#undef G1_XE
            }
            if (more) G1_PREFETCH(idx + G);
            const f32x4 G4 = *(const LAS f32x4*)(Gs + t4), B4 = *(const LAS f32x4*)(Bs + t4); const float gl = Gs[63];
            if (ppart < 2) {
                float rn[4];
#pragma unroll
                for (int tk = 0; tk < 4; ++tk) { float ss = 0.f;
#pragma unroll
                    for (int e = 0; e < 8; ++e) ss += y[tk][e] * y[tk][e];
                    ss += __shfl_xor(ss, 1); ss += __shfl_xor(ss, 2); ss += __shfl_xor(ss, 4);
                    rn[tk] = (1.f / sqrtf(ss + EPS)) * (ppart == 0 ? 0.125f : 1.f); }
#pragma unroll
                for (int tk = 0; tk < 4; ++tk) {
#pragma unroll
                    for (int e = 0; e < 8; ++e) y[tk][e] *= rn[tk];
                    v4u pk; pk.x = cvtpk(y[tk][0], y[tk][1]); pk.y = cvtpk(y[tk][2], y[tk][3]); pk.z = cvtpk(y[tk][4], y[tk][5]); pk.w = cvtpk(y[tk][6], y[tk][7]);
                    *(LAS v4u*)((ppart == 0 ? Qr : Kr) + (t4 + tk) * KST + d0 * 2) = pk; }
                if (ppart == 1) {
                    const float ek0 = __expf(gl - G4.x), ek1 = __expf(gl - G4.y), ek2 = __expf(gl - G4.z), ek3 = __expf(gl - G4.w);
                    const float bg0 = B4.x * __expf(G4.x), bg1 = B4.y * __expf(G4.y), bg2 = B4.z * __expf(G4.z), bg3 = B4.w * __expf(G4.w);
#pragma unroll
                    for (int e = 0; e < 8; ++e) {
                        v2u kd; kd.x = cvtpk(y[0][e] * ek0, y[1][e] * ek1); kd.y = cvtpk(y[2][e] * ek2, y[3][e] * ek3);
                        *(LAS v2u*)(kdT + (d0 + e) * KST + (t4 ^ swk) * 2) = kd;
                        *(LAS f32x4*)(Rt + (d0 + e) * RST + (t4 ^ swr)) = (f32x4){y[0][e] * bg0, y[1][e] * bg1, y[2][e] * bg2, y[3][e] * bg3}; }
                }
            } else {
#pragma unroll
                for (int e = 0; e < 8; ++e) *(LAS f32x4*)(Rt + (64 + d0 + e) * RST + (t4 ^ swr)) = (f32x4){y[0][e] * B4.x, y[1][e] * B4.y, y[2][e] * B4.z, y[3][e] * B4.w};
            }
        }
        __syncthreads();
#define G1_TILE(which, ct, st) do { const LAS unsigned char* Xb_ = (which) ? Kr : Qr; const int c_ = 16 * (ct) + l15; const float Gc_ = Gs[c_], bc_ = Bs[c_]; \
            f32x4 acc_ = {0.f, 0.f, 0.f, 0.f}; \
            _Pragma("unroll") for (int ks = 0; ks < 2; ++ks) { const bf16x8_t bf_ = *(const LAS bf16x8_t*)(Xb_ + c_ * KST + (32 * ks + 8 * g4) * 2); \
                const bf16x8_t af_ = *(const LAS bf16x8_t*)(Kr + (16 * (st) + l15) * KST + (32 * ks + 8 * g4) * 2); acc_ = __builtin_amdgcn_mfma_f32_16x16x32_bf16(af_, bf_, acc_, 0, 0, 0); } \
            f32x4 vals_; \
            _Pragma("unroll") for (int r = 0; r < 4; ++r) { const int s2_ = 16 * (st) + 4 * g4 + r; const float dec_ = __expf(fminf(Gc_ - Gs[s2_], 0.f)); \
                vals_[r] = (which) ? ((s2_ < c_) ? -acc_[r] * bc_ * dec_ : 0.f) : ((s2_ <= c_) ? acc_[r] * dec_ : 0.f); } \
            *(LAS v2u*)(((which) ? Mm : At) + c_ * KST + (16 * (st) + 4 * g4) * 2) = pack4(vals_); \
            if ((which) && (st) == (ct)) *(LAS f32x4*)(Md + ((ct) * 16 + l15) * 20 + 4 * g4) = -vals_; } while (0)
        if constexpr (STG & 1) {
            const int ct = wave & 3, st0 = 2 * (wave >> 2);
            G1_TILE(1, ct, st0); G1_TILE(1, ct, st0 + 1);
        }
        __syncthreads();
        if constexpr (STG & 1) {
            if (wave != 0) { for (int tix = wave - 1; tix < 16; tix += 7) { const int ct = tix & 3, st = tix >> 2; G1_TILE(0, ct, st); } }
        }
        if ((STG & 2) && wave == 0) {
            float t[16];
#pragma unroll
            for (int r = 0; r < 16; ++r) { float acc = (r == l15) ? 1.f : 0.f;
#pragma unroll
                for (int s4 = 0; s4 < r; s4 += 4) { const f32x4 m = *(const LAS f32x4*)(Md + (g4 * 16 + r) * 20 + s4);
                    acc -= m.x * t[s4]; if (s4 + 1 < r) acc -= m.y * t[s4 + 1]; if (s4 + 2 < r) acc -= m.z * t[s4 + 2]; if (s4 + 3 < r) acc -= m.w * t[s4 + 3]; }
                t[r] = acc; }
#pragma unroll
            for (int r = 0; r < 16; ++r) *(LAS unsigned short*)(Tl + ((g4 * 16 + r) * 16 + l15) * 2) = (unsigned short)f2bf(t[r]);
        }
        __syncthreads();
        if constexpr (STG & 4) {
        f32x4 wt[4];
        {   const int colw = 16 * wave + l15;
#pragma unroll
            for (int i = 0; i < 4; ++i) {
                f32x4 acc = *(const LAS f32x4*)(Rt + colw * RST + ((16 * i + 4 * g4) ^ (((colw >> 3) & 3) << 3)));
                const LAS unsigned char* mrow = Mm + (16 * i + l15) * KST + (4 * g4) * 2;
                if (i >= 1) { const v2u alo = *(const LAS v2u*)(mrow), ahi = (i >= 2) ? *(const LAS v2u*)(mrow + 32) : zero2;
                    acc = __builtin_amdgcn_mfma_f32_16x16x32_bf16(mk8(alo, ahi), mk8(pack4(wt[0]), (i >= 2) ? pack4(wt[1]) : zero2), acc, 0, 0, 0); }
                if (i == 3) { const v2u alo = *(const LAS v2u*)(mrow + 64);
                    acc = __builtin_amdgcn_mfma_f32_16x16x32_bf16(mk8(alo, zero2), mk8(pack4(wt[2]), zero2), acc, 0, 0, 0); }
                const v2u tlo = *(const LAS v2u*)(Tl + ((i * 16 + l15) * 16 + 4 * g4) * 2);
                wt[i] = __builtin_amdgcn_mfma_f32_16x16x32_bf16(mk8(tlo, zero2), mk8(pack4(acc), zero2), (f32x4){0.f, 0.f, 0.f, 0.f}, 0, 0, 0);
            }
        }
        if (wave < 4) {
            bf16x8_t wn[2];
#pragma unroll
            for (int ks = 0; ks < 2; ++ks) { v2u lo = pack4(wt[2 * ks]), hi = pack4(wt[2 * ks + 1]); lo.x ^= 0x80008000u; lo.y ^= 0x80008000u; hi.x ^= 0x80008000u; hi.y ^= 0x80008000u; wn[ks] = mk8(lo, hi); }
#pragma unroll
            for (int nt = 0; nt < 4; ++nt) { const int x = 16 * nt + l15;
                f32x4 ca = {0.f, 0.f, 0.f, 0.f};
                const v2u qraw = *(const LAS v2u*)(Qr + x * KST + (16 * wave + 4 * g4) * 2); const float eg = __expf(Gs[x]);
                f32x4 cq; cq.x = eg * __builtin_bit_cast(float, qraw.x << 16); cq.y = eg * __builtin_bit_cast(float, qraw.x & 0xffff0000u); cq.z = eg * __builtin_bit_cast(float, qraw.y << 16); cq.w = eg * __builtin_bit_cast(float, qraw.y & 0xffff0000u);
#pragma unroll
                for (int ks = 0; ks < 2; ++ks) { const int xs = (x >> 3) << 3; const LAS unsigned char* kp0 = kdT + x * KST + ((32 * ks + 4 * g4) ^ xs) * 2; const LAS unsigned char* kp1 = kdT + x * KST + ((32 * ks + 16 + 4 * g4) ^ xs) * 2; const LAS unsigned char* ap = At + x * KST + (32 * ks + 4 * g4) * 2;
                    ca = __builtin_amdgcn_mfma_f32_16x16x32_bf16(wn[ks], mk8(*(const LAS v2u*)(kp0), *(const LAS v2u*)(kp1)), ca, 0, 0, 0);
                    cq = __builtin_amdgcn_mfma_f32_16x16x32_bf16(wn[ks], mk8(*(const LAS v2u*)(ap), *(const LAS v2u*)(ap + 32)), cq, 0, 0, 0); }
                const size_t off = cb + (size_t)((nt * 2 + (wave >> 1)) * 64 + lane) * 8 + 4 * (wave & 1);
                if (SM & 1) *(v2u*)(AP + off) = pack4(ca); if (SM & 2) *(v2u*)(QP + off) = pack4(cq);
            }
        } else {
            bf16x8_t ub[2];
#pragma unroll
            for (int ks = 0; ks < 2; ++ks) ub[ks] = mk8(pack4(wt[2 * ks]), pack4(wt[2 * ks + 1]));
            unsigned bo[8], oo[8];
#pragma unroll
            for (int mt = 0; mt < 4; ++mt) { const int x = 16 * mt + l15;
                f32x4 cbv = {0.f, 0.f, 0.f, 0.f}, co = {0.f, 0.f, 0.f, 0.f};
#pragma unroll
                for (int ks = 0; ks < 2; ++ks) { const int xs = (x >> 3) << 3; const LAS unsigned char* kp0 = kdT + x * KST + ((32 * ks + 4 * g4) ^ xs) * 2; const LAS unsigned char* kp1 = kdT + x * KST + ((32 * ks + 16 + 4 * g4) ^ xs) * 2; const LAS unsigned char* ap = At + x * KST + (32 * ks + 4 * g4) * 2;
                    cbv = __builtin_amdgcn_mfma_f32_16x16x32_bf16(mk8(*(const LAS v2u*)(kp0), *(const LAS v2u*)(kp1)), ub[ks], cbv, 0, 0, 0);
                    co = __builtin_amdgcn_mfma_f32_16x16x32_bf16(mk8(*(const LAS v2u*)(ap), *(const LAS v2u*)(ap + 32)), ub[ks], co, 0, 0, 0); }
                const v2u pb = pack4(cbv), po = pack4(co); bo[2 * mt] = pb.x; bo[2 * mt + 1] = pb.y; oo[2 * mt] = po.x; oo[2 * mt + 1] = po.y; }
            const size_t off = cb + (size_t)((wave - 4) * 64 + lane) * 16;
            if (SM & 4) { *(v4u*)(BP + off) = (v4u){bo[0], bo[1], bo[2], bo[3]}; *(v4u*)(BP + off + 8) = (v4u){bo[4], bo[5], bo[6], bo[7]}; }
            if (SM & 8) { *(v4u*)(OP + off) = (v4u){oo[0], oo[1], oo[2], oo[3]}; *(v4u*)(OP + off + 8) = (v4u){oo[4], oo[5], oo[6], oo[7]}; }
        }
        }
    }
    }
#undef G1_TILE
#undef G1_PREFETCH
}

__device__ __forceinline__ f32x4 g2_unpack(const v4u (&p)[2], int mt) {
    const unsigned d0 = mt == 0 ? p[0].x : mt == 1 ? p[0].z : mt == 2 ? p[1].x : p[1].z, d1 = mt == 0 ? p[0].y : mt == 1 ? p[0].w : mt == 2 ? p[1].y : p[1].w;
    f32x4 r; r.x = __builtin_bit_cast(float, d0 << 16); r.y = __builtin_bit_cast(float, d0 & 0xffff0000u); r.z = __builtin_bit_cast(float, d1 << 16); r.w = __builtin_bit_cast(float, d1 & 0xffff0000u); return r;
}
template <int VAR = 0>
__device__ __forceinline__ void gdn_scan(const Args& A, int bh, LAS unsigned char* lds, int tid, int lane, int wave) {
    unsigned char* ws = A.ws;
    const char* AP = (const char*)(ws + WS_GAP); const char* BP = (const char*)(ws + WS_GBP); const float* GL = (const float*)(ws + WS_GGL); bf16* SF = (bf16*)(ws + WS_GSF);
    constexpr int SLOT = 16384, NSL = 8, EGL_OFF = NSL * SLOT;
    LAS float* eglt = (LAS float*)(lds + EGL_OFF);
    __syncthreads();
    { int tl = tid; asm volatile("" : "+v"(tl));
      if (tl < 128) eglt[tl] = GL[bh * 128 + tl]; }
    if (wave < 4) {
        f32x4 sC[4]; bf16x8_t sB[2];
#pragma unroll
        for (int mt = 0; mt < 4; ++mt) sC[mt] = (f32x4){0.f, 0.f, 0.f, 0.f};
#pragma unroll
        for (int ks = 0; ks < 2; ++ks)
#pragma unroll
            for (int j = 0; j < 8; ++j) sB[ks][j] = 0;
        asm volatile("s_waitcnt vmcnt(0) lgkmcnt(0)" ::: "memory");
        __builtin_amdgcn_s_barrier();
        struct SSet { bf16x8_t fa[4][2]; v4u fb[2]; float egl; };
#define SC_LOAD(S, n) do { const int n_ = (n) < SEQ / 64 ? (n) : SEQ / 64 - 1; const LAS unsigned char* slot_ = lds + (n_ & (NSL - 1)) * SLOT; \
            _Pragma("unroll") for (int mt = 0; mt < 4; ++mt) _Pragma("unroll") for (int ks = 0; ks < 2; ++ks) S.fa[mt][ks] = *(const LAS bf16x8_t*)(slot_ + ((mt * 2 + ks) * 64 + lane) * 16); \
            S.fb[0] = *(const LAS v4u*)(slot_ + 8192 + (wave * 64 + lane) * 32); S.fb[1] = *(const LAS v4u*)(slot_ + 8192 + (wave * 64 + lane) * 32 + 16); S.egl = eglt[n_]; } while (0)
#define SC_STEP(S, n) do { bf16* sf = SF + (size_t)(bh * 128 + (n)) * 4096 + (size_t)((wave * 2) * 64 + lane) * 8; \
            *(bf16x8_t*)(sf) = sB[0]; *(bf16x8_t*)(sf + 512) = sB[1]; \
            f32x4 sacc[4]; \
            _Pragma("unroll") for (int mt = 0; mt < 4; ++mt) sacc[mt] = sC[mt] * S.egl + g2_unpack(S.fb, mt); \
            _Pragma("unroll") for (int mt = 0; mt < 4; ++mt) _Pragma("unroll") for (int ks = 0; ks < 2; ++ks) sacc[mt] = __builtin_amdgcn_mfma_f32_16x16x32_bf16(S.fa[mt][ks], sB[ks], sacc[mt], 0, 0, 0); \
            _Pragma("unroll") for (int mt = 0; mt < 4; ++mt) sC[mt] = sacc[mt]; \
            _Pragma("unroll") for (int ks = 0; ks < 2; ++ks) { union { bf16x8_t v; unsigned u[4]; } pk_; \
                pk_.u[0] = cvtpk(sC[2 * ks].x, sC[2 * ks].y); pk_.u[1] = cvtpk(sC[2 * ks].z, sC[2 * ks].w); pk_.u[2] = cvtpk(sC[2 * ks + 1].x, sC[2 * ks + 1].y); pk_.u[3] = cvtpk(sC[2 * ks + 1].z, sC[2 * ks + 1].w); sB[ks] = pk_.v; } \
            asm volatile("s_waitcnt lgkmcnt(0)" ::: "memory"); \
            __builtin_amdgcn_s_barrier(); } while (0)
        SSet s0;
#pragma unroll 1
        for (int n = 0; n < SEQ / 64; ++n) {
            if (VAR == 2) { asm volatile("s_waitcnt lgkmcnt(0)" ::: "memory"); __builtin_amdgcn_s_barrier(); continue; }
            SC_LOAD(s0, n);
            SC_STEP(s0, n);
        }
#undef SC_LOAD
#undef SC_STEP
    } else {
        const int f = wave - 4;
        const unsigned lin = (unsigned)(2 * f) * 1024u + (unsigned)lane * 16u;
#define G2_DMA(nn) do { const int n_ = (nn) < SEQ / 64 ? (nn) : SEQ / 64 - 1; const size_t cb_ = (size_t)(bh * 128 + n_) * 8192; LAS unsigned char* d_ = lds + ((nn) & (NSL - 1)) * SLOT + (2 * f) * 1024; \
        __builtin_amdgcn_global_load_lds((const unsigned*)(AP + cb_ + lin), (LAS unsigned*)(d_), 16, 0, 0); __builtin_amdgcn_global_load_lds((const unsigned*)(AP + cb_ + lin + 1024), (LAS unsigned*)(d_ + 1024), 16, 0, 0); \
        __builtin_amdgcn_global_load_lds((const unsigned*)(BP + cb_ + lin), (LAS unsigned*)(d_ + 8192), 16, 0, 0); __builtin_amdgcn_global_load_lds((const unsigned*)(BP + cb_ + lin + 1024), (LAS unsigned*)(d_ + 8192 + 1024), 16, 0, 0); } while (0)
        asm volatile("s_waitcnt vmcnt(0) lgkmcnt(0)" ::: "memory");
        G2_DMA(0); G2_DMA(1); G2_DMA(2); G2_DMA(3); G2_DMA(4); G2_DMA(5); G2_DMA(6);
        asm volatile("s_waitcnt vmcnt(24)" ::: "memory");
        __builtin_amdgcn_s_barrier();
#pragma unroll 1
        for (int n = 0; n < SEQ / 64; ++n) {
            if (VAR != 1) G2_DMA(n + 7);
            asm volatile("s_waitcnt vmcnt(24)" ::: "memory");
            __builtin_amdgcn_s_barrier();
        }
#undef G2_DMA
        asm volatile("s_waitcnt vmcnt(0)" ::: "memory");
    }
    __syncthreads();
}
__device__ __forceinline__ void gdn_out(const Args& A, LAS unsigned char* lds, int lane, int wave) {
    unsigned char* ws = A.ws;
    const bf16* proj = (const bf16*)(ws + WS_PROJ); bf16* mix = (bf16*)(ws + WS_MIX);
    const bf16* QP = (const bf16*)(ws + WS_GQP); const bf16* OP = (const bf16*)(ws + WS_GOP); const bf16* SF = (const bf16*)(ws + WS_GSF);
    const float* onorm = (const float*)A.in[I_GNORM];
    const int mt = wave & 3, l15 = lane & 15, g4 = lane >> 4, rr = lane >> 2, q4 = lane & 3;
    constexpr int OST = 68;
    LAS float* ot = (LAS float*)(lds + wave * 4608);
    float gain[16];
#pragma unroll
    for (int k = 0; k < 16; ++k) gain[k] = onorm[16 * q4 + k];
    struct OSet { bf16x8_t qa[2], sb[4][2]; v2u oi[4]; v4u z0, z1; };
#define GO_LOAD(S, CID) do { const int n_ = (CID) & 127, bh_ = (CID) >> 7, b_ = bh_ >> 3, h_ = bh_ & 7; const size_t cb_ = (size_t)(CID) * 4096; \
        const size_t t_ = (size_t)b_ * SEQ + n_ * 64 + 16 * mt + rr; \
        S.z0 = *(const v4u*)(proj + t_ * NPROJ + PC_Z + h_ * 64 + 16 * q4); S.z1 = *(const v4u*)(proj + t_ * NPROJ + PC_Z + h_ * 64 + 16 * q4 + 8); \
        _Pragma("unroll") for (int ks = 0; ks < 2; ++ks) S.qa[ks] = *(const bf16x8_t*)(QP + cb_ + ((mt * 2 + ks) * 64 + lane) * 8); \
        _Pragma("unroll") for (int nt = 0; nt < 4; ++nt) { _Pragma("unroll") for (int ks = 0; ks < 2; ++ks) S.sb[nt][ks] = *(const bf16x8_t*)(SF + cb_ + ((nt * 2 + ks) * 64 + lane) * 8); \
            S.oi[nt] = *(const v2u*)(OP + cb_ + ((nt * 64 + lane) * 4 + mt) * 4); } } while (0)
#define GO_STEP(S, CID) do { const int n_ = (CID) & 127, bh_ = (CID) >> 7, b_ = bh_ >> 3, h_ = bh_ & 7; const size_t t_ = (size_t)b_ * SEQ + n_ * 64 + 16 * mt + rr; \
        _Pragma("unroll") for (int nt = 0; nt < 4; ++nt) { \
            f32x4 acc; acc.x = __builtin_bit_cast(float, S.oi[nt].x << 16); acc.y = __builtin_bit_cast(float, S.oi[nt].x & 0xffff0000u); acc.z = __builtin_bit_cast(float, S.oi[nt].y << 16); acc.w = __builtin_bit_cast(float, S.oi[nt].y & 0xffff0000u); \
            _Pragma("unroll") for (int ks = 0; ks < 2; ++ks) acc = __builtin_amdgcn_mfma_f32_16x16x32_bf16(S.qa[ks], S.sb[nt][ks], acc, 0, 0, 0); \
            _Pragma("unroll") for (int i = 0; i < 4; ++i) ot[(4 * g4 + i) * OST + 16 * nt + l15] = acc[i]; } \
        LDS_WAIT(); asm volatile("" ::: "memory"); \
        float o[16]; float ss = 0.f; \
        _Pragma("unroll") for (int k = 0; k < 4; ++k) { const f32x4 v = *(const LAS f32x4*)(ot + rr * OST + 16 * q4 + 4 * k); o[4 * k] = v.x; o[4 * k + 1] = v.y; o[4 * k + 2] = v.z; o[4 * k + 3] = v.w; } \
        _Pragma("unroll") for (int k = 0; k < 16; ++k) ss += o[k] * o[k]; \
        ss += __shfl_xor(ss, 1); ss += __shfl_xor(ss, 2); \
        const float r = 1.f / sqrtf(ss * (1.f / 64.f) + EPS); \
        const unsigned zu[8] = {S.z0.x, S.z0.y, S.z0.z, S.z0.w, S.z1.x, S.z1.y, S.z1.z, S.z1.w}; \
        unsigned ou[8]; \
        _Pragma("unroll") for (int k = 0; k < 8; ++k) { const float za = __builtin_bit_cast(float, zu[k] << 16), zb = __builtin_bit_cast(float, zu[k] & 0xffff0000u); \
            ou[k] = cvtpk(o[2 * k] * r * gain[2 * k] * siluf(za), o[2 * k + 1] * r * gain[2 * k + 1] * siluf(zb)); } \
        bf16* op = mix + t_ * DM + h_ * 64 + 16 * q4; \
        *(v4u*)(op) = (v4u){ou[0], ou[1], ou[2], ou[3]}; *(v4u*)(op + 8) = (v4u){ou[4], ou[5], ou[6], ou[7]}; \
        LDS_WAIT(); asm volatile("" ::: "memory"); } while (0)
    const int NC = NB * 8 * 128, st = gridDim.x * 2;
    int cid = blockIdx.x * 2 + (wave >> 2);
    OSet s0, s1, s2;
    if (cid < NC) GO_LOAD(s0, cid);
    if (cid + st < NC) GO_LOAD(s1, cid + st);
#pragma unroll 1
    for (; cid < NC; cid += 3 * st) {
        if (cid + 2 * st < NC) GO_LOAD(s2, cid + 2 * st);
        GO_STEP(s0, cid);
        if (cid + st < NC) { if (cid + 3 * st < NC) GO_LOAD(s0, cid + 3 * st); GO_STEP(s1, cid + st); }
        if (cid + 2 * st < NC) { if (cid + 4 * st < NC) GO_LOAD(s1, cid + 4 * st); GO_STEP(s2, cid + 2 * st); }
    }
#undef GO_LOAD
#undef GO_STEP
}

template <bool DRY, int VAR = 0>
__device__ __forceinline__ void norm_route_mfma(const Args& A, const bf16* X, const float* ssqp, const float* gain, const float* shift, const float* scale, bf16* H, LAS unsigned char* lds, int tid, int lane, int wave) {
    unsigned char* ws = A.ws;
    const int G = gridDim.x;
    const int l15 = lane & 15, g4 = lane >> 4;
    LAS unsigned char* wfl = lds;
    LAS float* mfl = (LAS float*)(lds + 98304); LAS float* afl = mfl + 1024;
    LAS float* lgs = (LAS float*)(lds + 98304 + 8192 + wave * 3328);
    const float* bg = (const float*)A.in[I_BGRP]; const float* br = (const float*)A.in[I_BRT];
#define P7_LOADW(half) do { const v4u* src_ = (const v4u*)(ws + WS_WRT); \
        for (int q = tid; q < 3072; q += NTHR) { const int nt_ = q >> 10, r_ = q & 1023; const int g_ = (nt_ * 32 + 16 * (half)) * 64 + r_; \
            *(LAS v4u*)(wfl + q * 16) = src_[g_]; *(LAS v4u*)(wfl + 49152 + q * 16) = src_[6144 + g_]; } } while (0)
    int bcur = -1;
    for (int rb = blockIdx.x * 128; rb < TT; rb += G * 128) {
        const int b = rb / SEQ, r0 = rb + wave * 16, row = r0 + l15;
        if (b != bcur) { bcur = b; __syncthreads();
            for (int q = tid; q < 1024; q += NTHR) { mfl[q] = gain[q] * (scale[b * 6144 + q] + 1.0f); afl[q] = shift[b * 6144 + q]; }
            __syncthreads(); }
        const bf16* xr = X + (size_t)row * DM + 8 * g4;
        float ss;
        {   const f32x4 p4 = *(const f32x4*)(ssqp + (size_t)row * 16 + 4 * g4); ss = (p4.x + p4.y) + (p4.z + p4.w); }
        ss += __shfl_xor(ss, 16); ss += __shfl_xor(ss, 32);
        const float rstd = 1.f / sqrtf(ss * (1.f / DM) + EPS);
        f32x4 acc[3];
#pragma unroll
        for (int nt = 0; nt < 3; ++nt) acc[nt] = (f32x4){0.f, 0.f, 0.f, 0.f};
        unsigned char* hrow = (unsigned char*)H + (size_t)row * DM + 8 * g4;
#pragma unroll 1
        for (int half = 0; half < 2; ++half) {
        __syncthreads(); P7_LOADW(half); __syncthreads();
#pragma unroll 8
        for (int ks = 16 * half; ks < 16 * half + 16; ++ks) {
            float hv[8];
            {   const v4u xq = *(const v4u*)(xr + 32 * ks);
                const f32x4 a = (f32x4){__builtin_bit_cast(float, xq.x << 16), __builtin_bit_cast(float, xq.x & 0xffff0000u), __builtin_bit_cast(float, xq.y << 16), __builtin_bit_cast(float, xq.y & 0xffff0000u)};
                const f32x4 c = (f32x4){__builtin_bit_cast(float, xq.z << 16), __builtin_bit_cast(float, xq.z & 0xffff0000u), __builtin_bit_cast(float, xq.w << 16), __builtin_bit_cast(float, xq.w & 0xffff0000u)};
                const f32x4 m0 = *(const LAS f32x4*)(mfl + 32 * ks + 8 * g4), m1 = *(const LAS f32x4*)(mfl + 32 * ks + 8 * g4 + 4), h0 = *(const LAS f32x4*)(afl + 32 * ks + 8 * g4), h1 = *(const LAS f32x4*)(afl + 32 * ks + 8 * g4 + 4);
                const f32x4 v0 = a * rstd * m0 + h0, v1 = c * rstd * m1 + h1;
                hv[0] = v0.x; hv[1] = v0.y; hv[2] = v0.z; hv[3] = v0.w; hv[4] = v1.x; hv[5] = v1.y; hv[6] = v1.z; hv[7] = v1.w; }
            unsigned hu[4], lu[4];
#pragma unroll
            for (int p = 0; p < 4; ++p) { hu[p] = cvtpk(hv[2 * p], hv[2 * p + 1]);
                const float ra = hv[2 * p] - __builtin_bit_cast(float, hu[p] << 16), rb2 = hv[2 * p + 1] - __builtin_bit_cast(float, hu[p] & 0xffff0000u); lu[p] = cvtpk(ra, rb2); }
            *(v2u8_t*)(hrow + 32 * ks) = (v2u8_t){pk4f8(hv[0], hv[1], hv[2], hv[3]), pk4f8(hv[4], hv[5], hv[6], hv[7])};
            union { bf16x8_t v; unsigned u[4]; } ah, al; ah.u[0] = hu[0]; ah.u[1] = hu[1]; ah.u[2] = hu[2]; ah.u[3] = hu[3]; al.u[0] = lu[0]; al.u[1] = lu[1]; al.u[2] = lu[2]; al.u[3] = lu[3];
#pragma unroll
            for (int nt = 0; nt < 3; ++nt) { const int fo = ((nt * 16 + (ks & 15)) * 64 + lane) * 16;
                const bf16x8_t bh = *(const LAS bf16x8_t*)(wfl + fo), bl = *(const LAS bf16x8_t*)(wfl + 49152 + fo);
                acc[nt] = __builtin_amdgcn_mfma_f32_16x16x32_bf16(ah.v, bh, acc[nt], 0, 0, 0);
                acc[nt] = __builtin_amdgcn_mfma_f32_16x16x32_bf16(ah.v, bl, acc[nt], 0, 0, 0);
                acc[nt] = __builtin_amdgcn_mfma_f32_16x16x32_bf16(al.v, bh, acc[nt], 0, 0, 0); }
        }
        }
#pragma unroll
        for (int nt = 0; nt < 3; ++nt)
#pragma unroll
            for (int r = 0; r < 4; ++r) lgs[(4 * g4 + r) * 52 + 16 * nt + l15] = acc[nt][r];
        LDS_WAIT(); asm volatile("" ::: "memory");
        if (lane < 16) {
            float lg[36];
#pragma unroll
            for (int q = 0; q < 9; ++q) { const f32x4 v = *(const LAS f32x4*)(lgs + lane * 52 + 4 * q); lg[4 * q] = v.x; lg[4 * q + 1] = v.y; lg[4 * q + 2] = v.z; lg[4 * q + 3] = v.w; }
#pragma unroll
            for (int o = 0; o < 4; ++o) lg[o] += bg[o];
#pragma unroll
            for (int o = 0; o < 32; ++o) lg[4 + o] += br[o];
            int gi = 0; float gm = lg[0];
#pragma unroll
            for (int o = 1; o < 4; ++o) if (lg[o] > gm) { gm = lg[o]; gi = o; }
            float gs = 0.f;
#pragma unroll
            for (int o = 0; o < 4; ++o) gs += __expf(lg[o] - gm);
            const float pg = 1.f / gs;
            float le[8];
#pragma unroll
            for (int j = 0; j < 8; ++j) { le[j] = lg[4 + j];
#pragma unroll
                for (int g = 1; g < 4; ++g) le[j] = (gi == g) ? lg[4 + g * 8 + j] : le[j]; }
            int j1 = 0; float m1 = le[0];
#pragma unroll
            for (int j = 1; j < 8; ++j) if (le[j] > m1) { m1 = le[j]; j1 = j; }
            int j2 = -1; float m2 = -3.0e38f;
#pragma unroll
            for (int j = 0; j < 8; ++j) if (j != j1 && le[j] > m2) { m2 = le[j]; j2 = j; }
            const float ex = __expf(m2 - m1), w1 = pg / (1.f + ex), w2 = pg * ex / (1.f + ex);
            const int e1 = gi * 8 + j1, e2 = gi * 8 + j2, rw = r0 + lane;
            unsigned* ctl = (unsigned*)(ws + WS_CTL);
            int2* erec = (int2*)(ws + WS_EREC); int* clist = (int*)(ws + WS_CLIST);
            if constexpr (DRY) { ((int2*)(ws + WS_PROJ + 168 * MiB))[rw] = make_int2(e1 * 64 + e2, __builtin_bit_cast(int, w1 + w2)); } else {
            const unsigned p1 = atomicAdd(ctl + CW_ECNT + e1, 1u); erec[(size_t)e1 * TT + p1] = make_int2(rw * 2 + (e1 > e2 ? 1 : 0), __builtin_bit_cast(int, w1));
            const unsigned p2 = atomicAdd(ctl + CW_ECNT + e2, 1u); erec[(size_t)e2 * TT + p2] = make_int2(rw * 2 + (e2 > e1 ? 1 : 0), __builtin_bit_cast(int, w2));
            const int a = j1 < j2 ? j1 : j2, bb = j1 < j2 ? j2 : j1;
            const int cls = gi * 28 + (a * 7 - (a * (a - 1)) / 2 + (bb - a - 1));
            const unsigned pc = atomicAdd(ctl + CW_CCNT + cls, 1u); clist[(size_t)cls * TT + pc] = rw; }
        }
        LDS_WAIT(); asm volatile("" ::: "memory");
    }
#undef P7_LOADW
}

__device__ __forceinline__ int wave_incl_scan(int v, int lane) {
#pragma unroll
    for (int o = 1; o < 64; o <<= 1) { const int t = __shfl_up(v, o); if (lane >= o) v += t; }
    return v;
}
template <int NOPART = 0>
struct SchedET {
    int G, c, cntv, preF, erank, totF, totP; const int2* rec; const char* W;
    __device__ __forceinline__ void init(const unsigned* cnt, const int2* rec_, const char* W_, int G_, int c_, int lane) {
        G = G_; c = c_; rec = rec_; W = W_;
        cntv = lane < NE ? (int)cnt[lane] : 0;
        const int rem = cntv & 255;
        const int incF = wave_incl_scan(cntv >> 8, lane), incP = wave_incl_scan(rem ? 1 : 0, lane);
        totF = __builtin_amdgcn_readlane(incF, 63); totP = NOPART ? 0 : __builtin_amdgcn_readlane(incP, 63);
        preF = lane < NE ? incF : 0x7fffffff;
        int rank = 0;
        for (int l = 0; l < NE; ++l) { const int r2 = __builtin_amdgcn_readlane(rem, l); rank += (r2 > rem || (r2 == rem && l < lane)) ? 1 : 0; }
        erank = __builtin_amdgcn_ds_permute((lane < NE ? rank : lane) << 2, lane);
    }
    __device__ __forceinline__ bool next(int i, pg8::UnitG& u) const {
        const int L = i * G + c; if (L >= 2 * (totF + totP)) return false;
        if (L < 2 * totF) { const int F8 = totF & ~7; const bool xm = L < 2 * F8;
            const int ft = xm ? 8 * (L >> 4) + (L & 7) : (L >> 1), pnv = xm ? (L >> 3) & 1 : (L & 1);
            const int e = __builtin_amdgcn_readfirstlane(__popcll(__ballot(preF <= ft)));
            const int base = e ? __builtin_amdgcn_readlane(preF, e - 1) : 0;
            u.id = e; u.tile = ft - base; u.pn = pnv; u.nrows = 256;
        } else { const int p = (L - 2 * totF) >> 1;
            const int e = __builtin_amdgcn_readlane(erank, p);
            const int cnt = __builtin_amdgcn_readlane(cntv, e);
            u.id = e; u.tile = cnt >> 8; u.pn = L & 1; u.nrows = cnt & 255; }
        return true;
    }
    __device__ __forceinline__ int tok(const pg8::UnitG& u, int r) const { return r < u.nrows ? (rec[(size_t)u.id * TT + u.tile * 256 + r].x >> 1) : 0; }
    __device__ __forceinline__ const char* bseg(const pg8::UnitG& u, int) const { return W + ((size_t)u.id * 512 + u.pn * 256) * 1024; }
};
typedef SchedET<0> SchedE;
struct EpiGU {
    static constexpr bool PERM = true, PREFETCH = false;
    bf16* HID;
    template <class SC> __device__ __forceinline__ void operator()(const pg8::f32x4 (&acc)[2][2][4][2], const pg8::UnitG& u, const SC& S, int wr, int wc, int fr, int fq) const {
#pragma unroll
        for (int ai = 0; ai < 2; ++ai)
#pragma unroll
            for (int m = 0; m < 4; ++m) { const int r = ai * 128 + wr * 64 + m * 16 + fr;
                if (r < u.nrows) { const int2 rc = S.rec[(size_t)u.id * TT + u.tile * 256 + r]; const int t = rc.x >> 1, half = rc.x & 1; const float w = __builtin_bit_cast(float, rc.y);
                    float hv[8];
#pragma unroll
                    for (int n = 0; n < 2; ++n)
#pragma unroll
                        for (int j = 0; j < 4; ++j) { const float g = acc[ai][0][m][n][j] * (1.f / W8_SCALE), up = acc[ai][1][m][n][j] * (HID8_SCALE / W8_SCALE); hv[n * 4 + j] = w * siluf(g) * up; }
                    *(v2u8_t*)((unsigned char*)HID + (size_t)t * 512 + half * 256 + u.pn * 128 + wc * 32 + 8 * fq) = (v2u8_t){pk4f8(hv[0], hv[1], hv[2], hv[3]), pk4f8(hv[4], hv[5], hv[6], hv[7])}; } }
    }
};
struct SchedC {
    int G, c, cntA, cntB, preA, preB, total_rt; const int* clist; const char* W;
    __device__ __forceinline__ void init(const unsigned* cnt, const int* clist_, const char* W_, int G_, int c_, int lane) {
        G = G_; c = c_; clist = clist_; W = W_;
        cntA = (int)cnt[lane]; cntB = lane < NCLS - 64 ? (int)cnt[64 + lane] : 0;
        const int ia = wave_incl_scan((cntA + 255) >> 8, lane); const int ta = __builtin_amdgcn_readlane(ia, 63);
        const int ib = wave_incl_scan((cntB + 255) >> 8, lane) + ta;
        total_rt = __builtin_amdgcn_readlane(ib, 63);
        preA = ia; preB = lane < NCLS - 64 ? ib : 0x7fffffff;
    }
    __device__ __forceinline__ bool next(int i, pg8::UnitG& u) const {
        const int L = i * G + c; if (L >= 4 * total_rt) return false;
        const int R8 = total_rt & ~7; const bool xm = L < 4 * R8;
        const int rt = xm ? 8 * (L >> 5) + (L & 7) : (L >> 2), pnv = xm ? (L >> 3) & 3 : (L & 3);
        const int cls = __builtin_amdgcn_readfirstlane(__popcll(__ballot(preA <= rt)) + __popcll(__ballot(preB <= rt)));
        int base = 0; if (cls > 0) base = (cls - 1 < 64) ? __builtin_amdgcn_readlane(preA, cls - 1) : __builtin_amdgcn_readlane(preB, cls - 65);
        const int cnt = cls < 64 ? __builtin_amdgcn_readlane(cntA, cls) : __builtin_amdgcn_readlane(cntB, cls - 64);
        u.id = cls; u.tile = rt - base; u.pn = pnv; const int rem = cnt - u.tile * 256; u.nrows = rem < 256 ? rem : 256;
        return true;
    }
    __device__ __forceinline__ int tok(const pg8::UnitG& u, int r) const { return r < u.nrows ? clist[(size_t)u.id * TT + u.tile * 256 + r] : 0; }
    __device__ __forceinline__ const char* bseg(const pg8::UnitG& u, int seg) const {
        const int g = u.id / 28; int a = 0, rem = u.id % 28; while (rem >= 7 - a) { rem -= 7 - a; ++a; } const int b = a + 1 + rem;
        const int e = g * 8 + (seg ? b : a);
        return W + ((size_t)e * 1024 + u.pn * 256) * 256;
    }
};
template <int VAR = 0>
struct EpiDownT {
    static constexpr bool PERM = false, PREFETCH = false;
    float* OUT; const float* gate2;
    const bf16* X1;
    const LAS unsigned char* gt;
    template <class SC> __device__ __forceinline__ void prefetch(LAS unsigned char* lds, const pg8::UnitG& u, const SC& S, int tid) const {
#pragma unroll
        for (int i = 0; i < 4; ++i) { const int r = (tid >> 3) + 64 * i; const int t = S.tok(u, r);
            __builtin_amdgcn_global_load_lds((const unsigned*)((const char*)OUT + (size_t)t * 4096 + (size_t)u.pn * 1024 + (size_t)(tid & 7) * 128), (LAS unsigned*)(lds + pg8::STAGE_BYTES + 256), 4, 0, 0); }
    }
    template <class SC> __device__ __forceinline__ void operator()(const pg8::f32x4 (&acc)[2][2][4][2], const pg8::UnitG& u, const SC& S, int wr, int wc, int fr, int fq) const {
#pragma unroll
        for (int ai = 0; ai < 2; ++ai)
#pragma unroll
            for (int m = 0; m < 4; ++m) { const int r = ai * 128 + wr * 64 + m * 16 + fr;
                if (r < u.nrows) { const int t = S.clist[(size_t)u.id * TT + u.tile * 256 + r]; const int b = t / SEQ; const int col0 = u.pn * 256 + wc * 32 + 4 * fq;
                    float* op = OUT + (size_t)t * DM + col0; const float* gp = gate2 + b * 6144 + col0;
#pragma unroll
                    for (int bj = 0; bj < 2; ++bj)
#pragma unroll
                        for (int n = 0; n < 2; ++n) { const int off = bj * 128 + n * 16; const v2u xq = *(const v2u*)(X1 + (size_t)t * DM + col0 + off);
                            const f32x4 xv = (f32x4){__builtin_bit_cast(float, xq.x << 16), __builtin_bit_cast(float, xq.x & 0xffff0000u), __builtin_bit_cast(float, xq.y << 16), __builtin_bit_cast(float, xq.y & 0xffff0000u)};
                            f32x4 gv;
                            if (VAR == 2) gv = (f32x4){1.f, 1.f, 1.f, 1.f};
                            else if (gt) { const v2u g2 = *(const LAS v2u*)(gt + (b * 1024 + col0 + off) * 2);
                                gv.x = __builtin_bit_cast(float, g2.x << 16); gv.y = __builtin_bit_cast(float, g2.x & 0xffff0000u); gv.z = __builtin_bit_cast(float, g2.y << 16); gv.w = __builtin_bit_cast(float, g2.y & 0xffff0000u); }
                            else gv = *(const f32x4*)(gp + off);
                            *(f32x4*)(op + off) = xv + gv * (acc[ai][bj][m][n] * (1.f / (W8_SCALE * HID8_SCALE))); } } }
    }
};
typedef EpiDownT<0> EpiDown;

__global__ void __launch_bounds__(NTHR, 2) fwd_kernel(Args args) {
    extern __shared__ __attribute__((aligned(16))) unsigned char lds_raw[];
    LAS unsigned char* lds = (LAS unsigned char*)lds_raw;
    volatile LAS unsigned* MISC = (volatile LAS unsigned*)(lds + MISC_OFF);
    const int G = gridDim.x;
    unsigned char* ws = args.ws;
    const int wave_s = __builtin_amdgcn_readfirstlane(threadIdx.x >> 6);
    for (int u = threadIdx.x; u < (LDS_BYTES - LDSCTL_OFF) / 4; u += NTHR) ((LAS unsigned*)(lds + LDSCTL_OFF))[u] = 0u;
    __syncthreads();
    const int lo = args.ph_lo, hi = args.ph_hi;
    const bool use_bar = (hi - lo) > 1;
    XcdBarrier bar; bar.bar = (unsigned*)(ws + WS_CTL) + CW_BAR; bar.x = 0; bar.st = nullptr;
    if (use_bar) bar = xcd_barrier_post((unsigned*)(ws + WS_CTL) + CW_BAR, MISC + 8, threadIdx.x == 0);
#define IN(k) (lo <= (k) && (k) < hi)
#define BOTH(k) (IN(k) && IN((k) + 1))
#if PROBE_REP == 1000
#define GRID_BAR(k) do { if (BOTH(k)) { xcd_barrier(bar, wave_s == 0 && __builtin_amdgcn_mbcnt_hi(~0u, __builtin_amdgcn_mbcnt_lo(~0u, 0u)) == 0u); xcd_barrier(bar, wave_s == 0 && __builtin_amdgcn_mbcnt_hi(~0u, __builtin_amdgcn_mbcnt_lo(~0u, 0u)) == 0u); } } while (0)
#else
#define GRID_BAR(k) do { if (BOTH(k)) xcd_barrier(bar, wave_s == 0 && __builtin_amdgcn_mbcnt_hi(~0u, __builtin_amdgcn_mbcnt_lo(~0u, 0u)) == 0u); } while (0)
#endif
#define FRESH_IDS() const int wave = wave_s; int lane = (int)__builtin_amdgcn_mbcnt_hi(~0u, __builtin_amdgcn_mbcnt_lo(~0u, 0u)); asm volatile("" : "+v"(lane)); const int tid = wave * 64 + lane; (void)tid
    const float* mod = (const float*)(ws + WS_MOD);

    if (IN(0)) { FRESH_IDS(); p0_prologue(args, lds, tid, lane, wave); GRID_BAR(0); }
    if (IN(1)) { FRESH_IDS(); norm_rows<false>(args, (const float*)args.in[I_X], (const float*)args.in[I_NORM_MIX], mod + 0, mod + 1024, (bf16*)(ws + WS_H), lds, lane, wave); GRID_BAR(1); }
    if (IN(2)) { FRESH_IDS();
        pg8::Gemm g{(const pg8::bf16_t*)(ws + WS_H), (const pg8::bf16_t*)(ws + WS_WINT), TT, NPAD, DM}; pg8::StaticOrder S; S.init(TT, NPAD, G, (int)blockIdx.x);
        pg8::EpiProj E{(pg8::bf16_t*)(ws + WS_PROJ), (float*)(ws + WS_AB), NPROJ};
        pg8::gemm_phase<pg8::EpiProj, pg8::StaticOrder, true, true>(lds, g, S, E);
        GRID_BAR(2);
    }
    if (IN(3)) { FRESH_IDS(); gdn_g1_mfma<31>(args, lds, tid, lane, wave); GRID_BAR(3); }
    if (IN(4)) { FRESH_IDS();
        if ((int)blockIdx.x < 32) gdn_scan(args, (int)blockIdx.x, lds, tid, lane, wave);
        else swa_mfma(args, lds, tid, lane, wave, (int)blockIdx.x - 32, G - 32);
        GRID_BAR(4);
    }
    if (IN(5)) { FRESH_IDS(); gdn_out(args, lds, lane, wave); GRID_BAR(5); }
    if (IN(6)) { FRESH_IDS();
        pg8::Gemm g{(const pg8::bf16_t*)(ws + WS_MIX), (const pg8::bf16_t*)(ws + WS_WOUTT), TT, DM, DM}; pg8::StaticOrder S; S.init(TT, DM, G, (int)blockIdx.x);
        pg8::EpiOut E{(const float*)args.in[I_X], (pg8::bf16_t*)(ws + WS_X1B), mod + 2048, SEQ, 6144, (float*)(ws + WS_SSQ)};
        const bool first = ((blockIdx.x >> 3) & 1) != 0;
        if (first) { expert_weight_copy(args, lds, lane, wave); __syncthreads(); }
        pg8::gemm_phase<pg8::EpiOut, pg8::StaticOrder, true, true>(lds, g, S, E);
        if (!first) { __syncthreads(); expert_weight_copy(args, lds, lane, wave); }
        GRID_BAR(6);
    }
    if (IN(7)) { FRESH_IDS(); norm_route_mfma<false>(args, (const bf16*)(ws + WS_X1B), (const float*)(ws + WS_SSQ), (const float*)args.in[I_NORM_FFN], mod + 3072, mod + 4096, (bf16*)(ws + WS_H), lds, tid, lane, wave); GRID_BAR(7); }
    if (IN(8)) { FRESH_IDS();
        SchedE S; S.init((const unsigned*)(ws + WS_CTL) + CW_ECNT, (const int2*)(ws + WS_EREC), (const char*)(ws + WS_WGUT), G, (int)blockIdx.x, lane);
        EpiGU E{(bf16*)(ws + WS_HID)};
        pg8::gemm_phase_g<EpiGU, SchedE, true>(lds, (const pg8::bf16_t*)(ws + WS_H), 512, 512, 8, 8, S, E);
        GRID_BAR(8);
    }
    if (IN(9)) { FRESH_IDS();
        SchedC S; S.init((const unsigned*)(ws + WS_CTL) + CW_CCNT, (const int*)(ws + WS_CLIST), (const char*)(ws + WS_WDT), G, (int)blockIdx.x, lane);
        LAS unsigned char* gtl = lds + RING_BYTES + 512;
        for (int q = tid; q < 4096; q += NTHR) *(LAS unsigned short*)(gtl + q * 2) = (unsigned short)f2bf(mod[(q >> 10) * 6144 + 5120 + (q & 1023)]);
        __syncthreads();
        EpiDown E{args.out, mod + 5120, (const bf16*)(ws + WS_X1B), gtl};
        pg8::gemm_phase_g<EpiDown, SchedC, true>(lds, (const pg8::bf16_t*)(ws + WS_HID), 256, 128, 4, 2, S, E);
    }
#undef IN
#undef BOTH
#undef GRID_BAR
}

#if PROBE_REP >= 0 && PROBE_REP < 1000
template <int P>
__global__ void __launch_bounds__(NTHR, 2) probe_kernel(Args args) {
    extern __shared__ __attribute__((aligned(16))) unsigned char lds_raw[];
    LAS unsigned char* lds = (LAS unsigned char*)lds_raw;
    const int tid = threadIdx.x, lane = tid & 63, wave = __builtin_amdgcn_readfirstlane(tid >> 6);
    const int G = gridDim.x; unsigned char* ws = args.ws; const float* mod = (const float*)(ws + WS_MOD);
    if constexpr (P == 1) norm_rows<false>(args, (const float*)args.in[I_X], (const float*)args.in[I_NORM_MIX], mod + 0, mod + 1024, (bf16*)(ws + WS_GAP + 0)  , lds, lane, wave);
    if constexpr (P == 2) { pg8::Gemm g{(const pg8::bf16_t*)(ws + WS_H), (const pg8::bf16_t*)(ws + WS_WINT), TT, NPAD, DM}; pg8::StaticOrder S; S.init(TT, NPAD, G, (int)blockIdx.x);
        pg8::EpiProj E{(pg8::bf16_t*)(ws + WS_PROJ), (float*)(ws + WS_AB), NPROJ}; pg8::gemm_phase<pg8::EpiProj, pg8::StaticOrder, true, true>(lds, g, S, E); }
    if constexpr (P == 0) p0_prologue(args, lds, tid, lane, wave);
    if constexpr (P == 4) gdn_g1_mfma<31>(args, lds, tid, lane, wave);
    if constexpr (P == 40) gdn_g1_mfma<31, 0>(args, lds, tid, lane, wave);
    if constexpr (P == 41) gdn_g1_mfma<31, 1>(args, lds, tid, lane, wave);
    if constexpr (P == 42) gdn_g1_mfma<31, 3>(args, lds, tid, lane, wave);
    if constexpr (P == 43) gdn_g1_mfma<0, 7>(args, lds, tid, lane, wave);
    if constexpr (P == 50) { if ((int)blockIdx.x < 32) gdn_scan(args, (int)blockIdx.x, lds, tid, lane, wave); }
    if constexpr (P == 501) { if ((int)blockIdx.x < 32) gdn_scan<1>(args, (int)blockIdx.x, lds, tid, lane, wave); }
    if constexpr (P == 502) { if ((int)blockIdx.x < 32) gdn_scan<2>(args, (int)blockIdx.x, lds, tid, lane, wave); }
    if constexpr (P == 52) gdn_out(args, lds, lane, wave);
    if constexpr (P == 51) { if ((int)blockIdx.x >= 32) swa_mfma(args, lds, tid, lane, wave, (int)blockIdx.x - 32, G - 32); }
    if constexpr (P == 60) expert_weight_copy(args, lds, lane, wave);
    if constexpr (P == 61) { pg8::Gemm g{(const pg8::bf16_t*)(ws + WS_MIX), (const pg8::bf16_t*)(ws + WS_WOUTT), TT, DM, DM}; pg8::StaticOrder S; S.init(TT, DM, G, (int)blockIdx.x);
        pg8::EpiOut E{(const float*)args.in[I_X], (pg8::bf16_t*)(ws + WS_GSF)  , mod + 2048, SEQ, 6144, nullptr};
        const bool first = ((blockIdx.x >> 3) & 1) != 0;
        if (first) { expert_weight_copy(args, lds, lane, wave); __syncthreads(); }
        pg8::gemm_phase<pg8::EpiOut, pg8::StaticOrder, true, true>(lds, g, S, E);
        if (!first) { __syncthreads(); expert_weight_copy(args, lds, lane, wave); } }
    if constexpr (P == 6) { pg8::Gemm g{(const pg8::bf16_t*)(ws + WS_MIX), (const pg8::bf16_t*)(ws + WS_WOUTT), TT, DM, DM}; pg8::StaticOrder S; S.init(TT, DM, G, (int)blockIdx.x);
        pg8::EpiOut E{(const float*)args.in[I_X], (pg8::bf16_t*)(ws + WS_GSF)  , mod + 2048, SEQ, 6144, nullptr}; pg8::gemm_phase<pg8::EpiOut, pg8::StaticOrder, true, true>(lds, g, S, E); }
    if constexpr (P == 81) { SchedET<1> S; S.init((const unsigned*)(ws + WS_CTL) + CW_ECNT, (const int2*)(ws + WS_EREC), (const char*)(ws + WS_WGUT), G, (int)blockIdx.x, lane);
        EpiGU E{(bf16*)(ws + WS_HID)}; pg8::gemm_phase_g<EpiGU, SchedET<1>, true>(lds, (const pg8::bf16_t*)(ws + WS_H), 512, 512, 8, 8, S, E); }
    if constexpr (P == 8) { SchedE S; S.init((const unsigned*)(ws + WS_CTL) + CW_ECNT, (const int2*)(ws + WS_EREC), (const char*)(ws + WS_WGUT), G, (int)blockIdx.x, lane);
        EpiGU E{(bf16*)(ws + WS_HID)}; pg8::gemm_phase_g<EpiGU, SchedE, true>(lds, (const pg8::bf16_t*)(ws + WS_H), 512, 512, 8, 8, S, E); }
    if constexpr (P == 71) norm_route_mfma<true, 1>(args, (const bf16*)(ws + WS_X1B), (const float*)(ws + WS_SSQ), (const float*)args.in[I_NORM_FFN], mod + 3072, mod + 4096, (bf16*)(ws + WS_GSF), lds, tid, lane, wave);
    if constexpr (P == 7) norm_route_mfma<true>(args, (const bf16*)(ws + WS_X1B), (const float*)(ws + WS_SSQ), (const float*)args.in[I_NORM_FFN], mod + 3072, mod + 4096, (bf16*)(ws + WS_GSF), lds, tid, lane, wave);
    if constexpr (P == 91 || P == 92) { SchedC S; S.init((const unsigned*)(ws + WS_CTL) + CW_CCNT, (const int*)(ws + WS_CLIST), (const char*)(ws + WS_WDT), G, (int)blockIdx.x, lane);
        EpiDownT<P - 90> E{(float*)(ws + WS_GSF), mod + 5120, (const bf16*)(ws + WS_X1B), nullptr}; pg8::gemm_phase_g<EpiDownT<P - 90>, SchedC, true>(lds, (const pg8::bf16_t*)(ws + WS_HID), 256, 128, 4, 2, S, E); }
    if constexpr (P == 9) { SchedC S; S.init((const unsigned*)(ws + WS_CTL) + CW_CCNT, (const int*)(ws + WS_CLIST), (const char*)(ws + WS_WDT), G, (int)blockIdx.x, lane);
        EpiDown E{(float*)(ws + WS_GSF), mod + 5120, (const bf16*)(ws + WS_X1B), nullptr}; pg8::gemm_phase_g<EpiDown, SchedC, true>(lds, (const pg8::bf16_t*)(ws + WS_HID), 256, 128, 4, 2, S, E); }
}
#endif
extern "C" void kernel_launch(void* const* d_in, const int* in_sizes, int n_in, void* d_out, int out_size, void* d_ws, size_t ws_size, hipStream_t stream) {
    static int grid = 0;
    if (grid == 0) {
        if (n_in != 23 || in_sizes[0] != TT * DM || out_size != TT * DM || ws_size < WS_END) { fprintf(stderr, "kernel_launch: unexpected shapes: n_in %d in0 %d out %d ws %zu (need %zu)\n", n_in, n_in > 0 ? in_sizes[0] : -1, out_size, ws_size, (size_t)WS_END); grid = -1; return; }
        int dev = 0, cus = 0, per_cu = 0;
        if (hipGetDevice(&dev) != hipSuccess || hipDeviceGetAttribute(&cus, hipDeviceAttributeMultiprocessorCount, dev) != hipSuccess) { grid = -1; return; }
        if (hipFuncSetAttribute((const void*)fwd_kernel, hipFuncAttributeMaxDynamicSharedMemorySize, LDS_BYTES) != hipSuccess) { fprintf(stderr, "kernel_launch: hipFuncSetAttribute failed\n"); grid = -1; return; }
        if (hipOccupancyMaxActiveBlocksPerMultiprocessor(&per_cu, (const void*)fwd_kernel, NTHR, LDS_BYTES) != hipSuccess || per_cu < 1) fprintf(stderr, "kernel_launch: occupancy query reports %d\n", per_cu);
        (void)hipGetLastError();
        grid = cus;
    }
    if (grid < 0) return;
    if (hipMemsetAsync((char*)d_ws + WS_CTL, 0, CTL_ZERO_BYTES, stream) != hipSuccess) { fprintf(stderr, "kernel_launch: memset failed\n"); return; }
    Args a{};
    for (int i = 0; i < 23; ++i) a.in[i] = d_in[i];
    a.out = (float*)d_out; a.ws = (unsigned char*)d_ws;
#if MK_ONE_LAUNCH
    a.ph_lo = 0; a.ph_hi = N_PHASES;
    hipLaunchKernelGGL(fwd_kernel, dim3(grid), dim3(NTHR), LDS_BYTES, stream, a);
#if PROBE_REP >= 0 && PROBE_REP < 1000
    hipFuncSetAttribute((const void*)probe_kernel<PROBE_REP>, hipFuncAttributeMaxDynamicSharedMemorySize, LDS_BYTES);
    hipLaunchKernelGGL(probe_kernel<PROBE_REP>, dim3(grid), dim3(NTHR), LDS_BYTES, stream, a);
#endif
#else
    for (int p = 0; p < N_PHASES; ++p) { a.ph_lo = p; a.ph_hi = p + 1; hipLaunchKernelGGL(fwd_kernel, dim3(grid), dim3(NTHR), LDS_BYTES, stream, a); }
#endif
}
```

```cpp
#include <hip/hip_runtime.h>
#include <cstdio>
#include <cstdint>
namespace pg8 {
#define PG8_LAS __attribute__((address_space(3)))
typedef unsigned short bf16_t;
typedef short bf16x8 __attribute__((ext_vector_type(8)));
typedef float f32x4 __attribute__((ext_vector_type(4)));
typedef unsigned u32x4 __attribute__((ext_vector_type(4)));
constexpr int BM = 256, BK = 64, HALF = 128, HTB = HALF * BK * 2  , STAGE_BYTES = 8 * HTB, NXCD = 8, WGM = 8;

__host__ __device__ __forceinline__ int lds_byte(int r, int c) { const int st = (r >> 4) * 2 + (c >> 5), rr = r & 15, cc = c & 31, ob = rr * 64 + cc * 2; return st * 1024 + (ob ^ (((ob >> 9) & 1) << 5)); }
__host__ __device__ __forceinline__ void stage_rc(int b, int& R, int& C) { const int st = b / 1024, sb = b % 1024, swz = sb ^ (((sb >> 9) & 1) << 5); R = (st >> 1) * 16 + swz / 64; C = (st & 1) * 32 + (swz % 64) / 2; }
__host__ __device__ __forceinline__ int perm32(int rho) { const int n = rho >> 4, i = rho & 15; return 8 * (i >> 2) + 4 * n + (i & 3); }

struct Unit { int pm, pn; };
struct Gemm { const bf16_t* A; const bf16_t* Bt; int M, N, K; };

struct StaticOrder {
    int nM, nN, nwg, G, c;
    __host__ __device__ void init(int M, int N, int G_, int c_) { nM = M / BM; nN = N / BM; nwg = nM * nN; G = G_; c = c_; }
    __host__ __device__ bool next(int i, Unit& u) const {
        const long L = (long)i * G + c; if (L >= nwg) return false;
        int wgid = (int)L; { const int q = nwg / NXCD, r = nwg % NXCD, xcd = wgid % NXCD, off = wgid / NXCD; wgid = (xcd < r ? xcd * (q + 1) : r * (q + 1) + (xcd - r) * q) + off; }
        const int nig = WGM * nN, gid = wgid / nig, fm = gid * WGM, gsz = (nM - fm) < WGM ? (nM - fm) : WGM;
        u.pm = fm + ((wgid % nig) % gsz); u.pn = (wgid % nig) / gsz; return true;
    }
    __device__ __forceinline__ void a_ready(const Unit&) const {}
    __device__ __forceinline__ void done(const Unit&) const {}
};

__device__ __forceinline__ unsigned cvt_pk_bf16(float lo, float hi) { unsigned r; asm volatile("v_cvt_pk_bf16_f32 %0, %1, %2" : "=v"(r) : "v"(lo), "v"(hi)); return r; }

__device__ __forceinline__ void store16_wt(void* base, unsigned byte_off, u32x4 v) {
    __amdgpu_buffer_rsrc_t r = __builtin_amdgcn_make_buffer_rsrc(base, 0, 0x7fffffff, 0x00020000);
    __builtin_amdgcn_raw_buffer_store_b128(v, r, (int)byte_off, 0, 16);
}
struct EpiProj {
    static constexpr bool PERM = true, AFTER_DRAIN = false, PREFETCH = false;
    bf16_t* P; float* AB; int ldp;
    __device__ __forceinline__ void operator()(const f32x4 (&acc)[2][2][4][2], const Unit& u, int wr, int wc, int fr, int fq) const {
        const int row0 = u.pm * BM + wr * 64 + fr;
        if (u.pn < 11) {
            const int col0 = u.pn * BM + wc * 32 + 8 * fq;
#pragma unroll
            for (int ai = 0; ai < 2; ++ai)
#pragma unroll
                for (int m = 0; m < 4; ++m) { const unsigned ro = ((unsigned)(row0 + ai * HALF + m * 16) * (unsigned)ldp + (unsigned)col0) * 2u;
#pragma unroll
                    for (int bj = 0; bj < 2; ++bj) { const f32x4 v0 = acc[ai][bj][m][0], v1 = acc[ai][bj][m][1];
                        u32x4 w; w.x = cvt_pk_bf16(v0[0], v0[1]); w.y = cvt_pk_bf16(v0[2], v0[3]); w.z = cvt_pk_bf16(v1[0], v1[1]); w.w = cvt_pk_bf16(v1[2], v1[3]);
                        *(u32x4*)((char*)P + ro + (unsigned)(bj * HALF) * 2u) = w; } }
        } else if (wc == 0 && fq < 2) {
#pragma unroll
            for (int ai = 0; ai < 2; ++ai)
#pragma unroll
                for (int m = 0; m < 4; ++m) { float* rowp = AB + (size_t)(row0 + ai * HALF + m * 16) * 16 + 8 * fq;
                    *(f32x4*)(rowp) = acc[ai][0][m][0]; *(f32x4*)(rowp + 4) = acc[ai][0][m][1]; }
        }
    }
};
struct EpiOut {
    static constexpr bool PERM = true, AFTER_DRAIN = false, PREFETCH = false;
    const float* X; bf16_t* O; const float* gate; int rows_per_batch, ldg;
    float* SSQ;
    __device__ __forceinline__ void operator()(const f32x4 (&acc)[2][2][4][2], const Unit& u, int wr, int wc, int fr, int fq) const {
        const int row0 = u.pm * BM + wr * 64 + fr, col0 = u.pn * BM + wc * 32 + 8 * fq;
        const float* gb = gate + (size_t)((u.pm * BM) / rows_per_batch) * ldg + col0;
        f32x4 gv[2][2];
#pragma unroll
        for (int bj = 0; bj < 2; ++bj)
#pragma unroll
            for (int n = 0; n < 2; ++n) gv[bj][n] = *(const f32x4*)(gb + bj * HALF + n * 4);
#pragma unroll
        for (int ai = 0; ai < 2; ++ai)
#pragma unroll
            for (int m = 0; m < 4; ++m) { const size_t ro = (size_t)(row0 + ai * HALF + m * 16) * 1024 + col0; float ss = 0.f;
#pragma unroll
                for (int bj = 0; bj < 2; ++bj) { const f32x4 x0 = *(const f32x4*)(X + ro + bj * HALF), x1 = *(const f32x4*)(X + ro + bj * HALF + 4);
                    const f32x4 v0 = x0 + gv[bj][0] * acc[ai][bj][m][0], v1 = x1 + gv[bj][1] * acc[ai][bj][m][1];
                    u32x4 w; w.x = cvt_pk_bf16(v0[0], v0[1]); w.y = cvt_pk_bf16(v0[2], v0[3]); w.z = cvt_pk_bf16(v1[0], v1[1]); w.w = cvt_pk_bf16(v1[2], v1[3]);
                    *(u32x4*)(O + ro + bj * HALF) = w;
                    ss += ((v0.x * v0.x + v0.y * v0.y) + (v0.z * v0.z + v0.w * v0.w)) + ((v1.x * v1.x + v1.y * v1.y) + (v1.z * v1.z + v1.w * v1.w)); }
                if (SSQ) { ss += __shfl_xor(ss, 16); ss += __shfl_xor(ss, 32); if (fq == 0) SSQ[(size_t)(row0 + ai * HALF + m * 16) * 16 + u.pn * 4 + wc] = ss; } }
    }
};

struct UnitG { int id, tile, pn, nrows; };
constexpr int TAB_OFF = STAGE_BYTES + 9216;
typedef int i32x8 __attribute__((ext_vector_type(8)));
typedef int i32x4 __attribute__((ext_vector_type(4)));
__device__ __forceinline__ i32x8 cat8(bf16x8 a, bf16x8 b) { const i32x4 x = __builtin_bit_cast(i32x4, a), y = __builtin_bit_cast(i32x4, b); return __builtin_shufflevector(x, y, 0, 1, 2, 3, 4, 5, 6, 7); }
template <class Epi, class Sched, bool F8 = false>
__device__ __forceinline__ void gemm_phase_g(PG8_LAS unsigned char* lds, const bf16_t* Abase, const int KA, const int KB, const int nt_, const int ksplit, const Sched& S, const Epi& E) {
    const int tid = threadIdx.x, wid = __builtin_amdgcn_readfirstlane(tid >> 6), lane = tid & 63, wr = wid >> 2, wc = wid & 3, fr = lane & 15, fq = lane >> 4;
    int Rr[2]; unsigned cB2[2], voffB[2];
#pragma unroll
    for (int i = 0; i < 2; ++i) { int R, C; stage_rc(tid * 16 + i * 8192, R, C); const int Rb = Epi::PERM ? ((R & ~31) + perm32(R & 31)) : R;
        Rr[i] = R; cB2[i] = (unsigned)C * 2u; voffB[i] = (unsigned)(Rb * KB + C) * 2u; }
    const size_t kstep = (size_t)(BK * 2);
    const size_t hstepB = (size_t)HALF * KB * 2;
    const unsigned ldsw = (unsigned)wid * 1024u;
    const int aoff = lds_byte(wr * 64 + fr, fq * 8), boff = lds_byte(wc * 32 + fr, fq * 8);
#define PG8_SA(b, h) (((b) * 2 + (h)) * HTB)
#define PG8_SB(b, h) ((4 + (b) * 2 + (h)) * HTB)
#define PG8_STAGE2(bufoff, gbase, v0, v1) do { \
        __builtin_amdgcn_global_load_lds((const unsigned*)((const char*)(gbase) + (v0)), (PG8_LAS unsigned*)(lds + (bufoff) + ldsw), 16, 0, 0); \
        __builtin_amdgcn_global_load_lds((const unsigned*)((const char*)(gbase) + (v1)), (PG8_LAS unsigned*)(lds + (bufoff) + ldsw + 8192), 16, 0, 0); } while (0)
#define PG8_LDA(dst, b, h) do { _Pragma("unroll") for (int m = 0; m < 4; ++m) _Pragma("unroll") for (int k = 0; k < 2; ++k) dst[m][k] = *(const PG8_LAS bf16x8*)(lds + PG8_SA(b, h) + aoff + m * 2048 + k * 1024); } while (0)
#define PG8_LDB(dst, b, h) do { _Pragma("unroll") for (int n = 0; n < 2; ++n) _Pragma("unroll") for (int k = 0; k < 2; ++k) dst[n][k] = *(const PG8_LAS bf16x8*)(lds + PG8_SB(b, h) + boff + n * 2048 + k * 1024); } while (0)
#define PG8_MMA(ai, bj, At, Bt) do { __builtin_amdgcn_s_setprio(1); \
        if constexpr (F8) { _Pragma("unroll") for (int m = 0; m < 4; ++m) _Pragma("unroll") for (int n = 0; n < 2; ++n) \
            acc[ai][bj][m][n] = __builtin_amdgcn_mfma_scale_f32_16x16x128_f8f6f4(cat8(Bt[n][0], Bt[n][1]), cat8(At[m][0], At[m][1]), acc[ai][bj][m][n], 0, 0, 0, 0x7f7f7f7f, 0, 0x7f7f7f7f); \
            _Pragma("unroll") for (int m = 0; m < 4; ++m) _Pragma("unroll") for (int n = 0; n < 2; ++n) asm volatile("" : "+v"(acc[ai][bj][m][n])); }   \
        else { _Pragma("unroll") for (int m = 0; m < 4; ++m) _Pragma("unroll") for (int n = 0; n < 2; ++n) _Pragma("unroll") for (int k = 0; k < 2; ++k) \
            acc[ai][bj][m][n] = __builtin_amdgcn_mfma_f32_16x16x32_bf16(Bt[n][k], At[m][k], acc[ai][bj][m][n], 0, 0, 0); } \
        __builtin_amdgcn_s_setprio(0); } while (0)
#define PG8_WAIT_V(n) asm volatile("s_waitcnt vmcnt(" #n ")" ::: "memory")
#define PG8_WAIT_L(n) asm volatile("s_waitcnt lgkmcnt(" #n ")" ::: "memory")
#define PG8_BAR __builtin_amdgcn_s_barrier()
#define PG8_SCHED __builtin_amdgcn_sched_barrier(0)
#define PG8_AOFFS(u, tb, o00, o01, o10, o11) do { const unsigned _ks = (unsigned)KA * 2u; \
        o00 = (unsigned)S.tok(lds + (tb), u, Rr[0]) * _ks + cB2[0]; o01 = (unsigned)S.tok(lds + (tb), u, Rr[1]) * _ks + cB2[1]; \
        o10 = (unsigned)S.tok(lds + (tb), u, HALF + Rr[0]) * _ks + cB2[0]; o11 = (unsigned)S.tok(lds + (tb), u, HALF + Rr[1]) * _ks + cB2[1]; } while (0)
#define PG8_BT(u, t) (((t) < ksplit) ? S.bseg(u, 0) + (size_t)(t) * kstep : S.bseg(u, 1) + (size_t)((t) - ksplit) * kstep)
    const char* const Ab_ = (const char*)Abase;
    UnitG cur, nxt; int ui = 0;
    int nt = nt_; asm volatile("" : "+s"(nt));
    if (!S.next(0, cur)) return;
    f32x4 acc[2][2][4][2];
#pragma unroll
    for (int a = 0; a < 2; ++a)
#pragma unroll
        for (int b = 0; b < 2; ++b)
#pragma unroll
            for (int m = 0; m < 4; ++m)
#pragma unroll
                for (int n = 0; n < 2; ++n) acc[a][b][m][n] = (f32x4){0.f, 0.f, 0.f, 0.f};
    bf16x8 At[4][2], B0[2][2], B1[2][2];
    unsigned c00, c01, c10, c11, n00 = 0, n01 = 0, n10 = 0, n11 = 0;
    int tb_cur = TAB_OFF, tb_nxt = TAB_OFF + 2048, tb_fre = TAB_OFF + 4096;
    S.tab_load(lds + tb_cur, cur, wid, lane);
    PG8_WAIT_V(0); PG8_BAR;
    PG8_AOFFS(cur, tb_cur, c00, c01, c10, c11);
    if constexpr (Epi::PREFETCH) E.prefetch(lds, Ab_, cur, c00 - cB2[0], c01 - cB2[1], c10 - cB2[0], c11 - cB2[1], (int)(cB2[0] >> 4), (int)(cB2[1] >> 4), wid);
    const char* const Ab = (const char*)Abase;
    {   const char* b0p = PG8_BT(cur, 0); const char* b1p = PG8_BT(cur, 1);
        PG8_STAGE2(PG8_SB(0, 0), b0p, voffB[0], voffB[1]); PG8_STAGE2(PG8_SB(0, 1), b0p + hstepB, voffB[0], voffB[1]); PG8_STAGE2(PG8_SA(0, 0), Ab, c00, c01); PG8_STAGE2(PG8_SA(0, 1), Ab, c10, c11);
        if (wr == 1) PG8_BAR;
        PG8_WAIT_V(2); PG8_BAR;
        PG8_STAGE2(PG8_SB(1, 0), b1p, voffB[0], voffB[1]); PG8_STAGE2(PG8_SA(1, 0), Ab + kstep, c00, c01); PG8_STAGE2(PG8_SB(1, 1), b1p + hstepB, voffB[0], voffB[1]);
        PG8_WAIT_V(6); PG8_BAR;
    }
    for (;;) {
        const bool has_next = S.next(ui + 1, nxt);
        if (has_next) S.tab_load(lds + tb_nxt, nxt, wid, lane);
        const bool h1 = cur.nrows > HALF;
#pragma unroll 1
        for (int t = 0; t < nt; t += 2) {
            const bool last = (t == nt - 2);
            if (last && has_next) { PG8_AOFFS(nxt, tb_nxt, n00, n01, n10, n11); }
            const bool usen = last && has_next;
            const int t2 = last ? 0 : t + 2, t3 = t2 + 1;
            const char* a1 = Ab + (size_t)(t + 1) * kstep;
            const char* a2 = Ab + (size_t)t2 * kstep; const char* a3 = Ab + (size_t)t3 * kstep;
            const char* b2 = usen ? PG8_BT(nxt, t2) : PG8_BT(cur, t2); const char* b3 = usen ? PG8_BT(nxt, t3) : PG8_BT(cur, t3);
            const unsigned o00 = usen ? n00 : c00, o01 = usen ? n01 : c01, o10 = usen ? n10 : c10, o11 = usen ? n11 : c11;
            PG8_LDB(B0, 0, 0); PG8_LDB(B1, 0, 1); PG8_SCHED; PG8_LDA(At, 0, 0); PG8_STAGE2(PG8_SA(1, 1), a1, c10, c11);
            PG8_WAIT_V(8); PG8_WAIT_L(0); PG8_BAR; PG8_MMA(0, 0, At, B0); PG8_MMA(0, 1, At, B1); PG8_BAR; PG8_SCHED;
            PG8_LDA(At, 0, 1); PG8_STAGE2(PG8_SB(0, 0), b2, voffB[0], voffB[1]); PG8_STAGE2(PG8_SB(0, 1), b2 + hstepB, voffB[0], voffB[1]); PG8_STAGE2(PG8_SA(0, 0), a2, o00, o01);
            PG8_WAIT_V(8); PG8_WAIT_L(0); PG8_BAR; if (h1) { PG8_MMA(1, 0, At, B0); PG8_MMA(1, 1, At, B1); } PG8_BAR; PG8_SCHED;
            PG8_LDB(B0, 1, 0); PG8_LDB(B1, 1, 1); PG8_SCHED; PG8_LDA(At, 1, 0); PG8_STAGE2(PG8_SA(0, 1), a2, o10, o11);
            PG8_WAIT_V(8); PG8_WAIT_L(0); PG8_BAR; PG8_MMA(0, 0, At, B0); PG8_MMA(0, 1, At, B1); PG8_BAR; PG8_SCHED;
            PG8_LDA(At, 1, 1); PG8_STAGE2(PG8_SB(1, 0), b3, voffB[0], voffB[1]); PG8_STAGE2(PG8_SB(1, 1), b3 + hstepB, voffB[0], voffB[1]); PG8_STAGE2(PG8_SA(1, 0), a3, o00, o01);
            PG8_WAIT_V(8); PG8_WAIT_L(0); PG8_BAR; if (h1) { PG8_MMA(1, 0, At, B0); PG8_MMA(1, 1, At, B1); } PG8_BAR; PG8_SCHED;
        }
        if (wr == 0) PG8_BAR;
        if constexpr (Epi::PREFETCH) { if (has_next) E.prefetch(lds, Ab_, nxt, n00 - cB2[0], n01 - cB2[1], n10 - cB2[0], n11 - cB2[1], (int)(cB2[0] >> 4), (int)(cB2[1] >> 4), wid); }
        E(acc, cur, S, lds + tb_cur, wr, wc, fr, fq);
        if (!has_next) break;
#pragma unroll
        for (int a = 0; a < 2; ++a)
#pragma unroll
            for (int b = 0; b < 2; ++b)
#pragma unroll
                for (int m = 0; m < 4; ++m)
#pragma unroll
                    for (int n = 0; n < 2; ++n) acc[a][b][m][n] = (f32x4){0.f, 0.f, 0.f, 0.f};
        cur = nxt; c00 = n00; c01 = n01; c10 = n10; c11 = n11; ++ui;
        { const int t_ = tb_cur; tb_cur = tb_nxt; tb_nxt = tb_fre; tb_fre = t_; }
        if (wr == 1) PG8_BAR;
    }
    PG8_WAIT_V(0);
    PG8_BAR;
#undef PG8_SA
#undef PG8_SB
#undef PG8_STAGE2
#undef PG8_LDA
#undef PG8_LDB
#undef PG8_MMA
#undef PG8_WAIT_V
#undef PG8_WAIT_L
#undef PG8_BAR
#undef PG8_SCHED
#undef PG8_AOFFS
#undef PG8_BT
}
template <class Epi, class Sched, bool ALIGN_EPI = false, bool SP2 = false>
__device__ __forceinline__ void gemm_phase(PG8_LAS unsigned char* lds, const Gemm g, const Sched& S, const Epi& E) {
    const int tid = threadIdx.x, wid = __builtin_amdgcn_readfirstlane(tid >> 6), lane = tid & 63, wr = wid >> 2, wc = wid & 3, fr = lane & 15, fq = lane >> 4;
    const int K = g.K, nt = K / BK;
    unsigned voffA[2], voffB[2];
#pragma unroll
    for (int i = 0; i < 2; ++i) { int R, C; stage_rc(tid * 16 + i * 8192, R, C); const int Rb = Epi::PERM ? ((R & ~31) + perm32(R & 31)) : R;
        voffA[i] = (unsigned)(R * K + C) * 2u; voffB[i] = (unsigned)(Rb * K + C) * 2u; }
    const size_t kstep = (size_t)(BK * 2);
    const size_t hstep = (size_t)HALF * K * 2;
    const size_t tstep = 2 * hstep;
    const unsigned ldsw = (unsigned)wid * 1024u;
    const int aoff = lds_byte(wr * 64 + fr, fq * 8), boff = lds_byte(wc * 32 + fr, fq * 8);
#define PG8_SA(b, h) (((b) * 2 + (h)) * HTB)
#define PG8_SB(b, h) ((4 + (b) * 2 + (h)) * HTB)
#define PG8_STAGE(bufoff, gbase, voff) do { _Pragma("unroll") for (int _i = 0; _i < 2; ++_i) \
        __builtin_amdgcn_global_load_lds((const unsigned*)((const char*)(gbase) + (voff)[_i]), (PG8_LAS unsigned*)(lds + (bufoff) + ldsw + _i * 8192), 16, 0, 0); } while (0)
#define PG8_LDA(dst, b, h) do { _Pragma("unroll") for (int m = 0; m < 4; ++m) _Pragma("unroll") for (int k = 0; k < 2; ++k) dst[m][k] = *(const PG8_LAS bf16x8*)(lds + PG8_SA(b, h) + aoff + m * 2048 + k * 1024); } while (0)
#define PG8_LDB(dst, b, h) do { _Pragma("unroll") for (int n = 0; n < 2; ++n) _Pragma("unroll") for (int k = 0; k < 2; ++k) dst[n][k] = *(const PG8_LAS bf16x8*)(lds + PG8_SB(b, h) + boff + n * 2048 + k * 1024); } while (0)
#define PG8_MMA(ai, bj, At, Bt) do { __builtin_amdgcn_s_setprio(1); _Pragma("unroll") for (int m = 0; m < 4; ++m) _Pragma("unroll") for (int n = 0; n < 2; ++n) _Pragma("unroll") for (int k = 0; k < 2; ++k) \
        acc[ai][bj][m][n] = __builtin_amdgcn_mfma_f32_16x16x32_bf16(Bt[n][k], At[m][k], acc[ai][bj][m][n], 0, 0, 0); __builtin_amdgcn_s_setprio(0); } while (0)
#define PG8_WAIT_V(n) asm volatile("s_waitcnt vmcnt(" #n ")" ::: "memory")
#define PG8_WAIT_L(n) asm volatile("s_waitcnt lgkmcnt(" #n ")" ::: "memory")
#define PG8_BAR __builtin_amdgcn_s_barrier()
#define PG8_SCHED __builtin_amdgcn_sched_barrier(0)
    Unit cur, nxt; int ui = 0;
    if (!S.next(0, cur)) return;
    f32x4 acc[2][2][4][2];
#pragma unroll
    for (int a = 0; a < 2; ++a)
#pragma unroll
        for (int b = 0; b < 2; ++b)
#pragma unroll
            for (int m = 0; m < 4; ++m)
#pragma unroll
                for (int n = 0; n < 2; ++n) acc[a][b][m][n] = (f32x4){0.f, 0.f, 0.f, 0.f};
    bf16x8 At[4][2], B0[2][2], B1[2][2];
    const char* cA = (const char*)g.A + (size_t)cur.pm * tstep; const char* cB = (const char*)g.Bt + (size_t)cur.pn * tstep;
    S.a_ready(cur);
    if constexpr (SP2) {
        PG8_STAGE(PG8_SB(0, 0), cB, voffB); PG8_STAGE(PG8_SB(0, 1), cB + hstep, voffB); PG8_STAGE(PG8_SA(0, 0), cA, voffA); PG8_STAGE(PG8_SA(0, 1), cA + hstep, voffA);
        if (wr == 1) PG8_BAR;
        PG8_WAIT_V(2); PG8_BAR;
        PG8_STAGE(PG8_SB(1, 0), cB + kstep, voffB); PG8_STAGE(PG8_SA(1, 0), cA + kstep, voffA); PG8_STAGE(PG8_SB(1, 1), cB + hstep + kstep, voffB);
        PG8_WAIT_V(6); PG8_BAR;
    } else {
        PG8_STAGE(PG8_SB(0, 0), cB, voffB); PG8_STAGE(PG8_SA(0, 0), cA, voffA); PG8_STAGE(PG8_SB(0, 1), cB + hstep, voffB); PG8_STAGE(PG8_SA(0, 1), cA + hstep, voffA);
        if (wr == 1) PG8_BAR;
        PG8_WAIT_V(4); PG8_BAR;
        PG8_STAGE(PG8_SB(1, 0), cB + kstep, voffB); PG8_STAGE(PG8_SA(1, 0), cA + kstep, voffA); PG8_STAGE(PG8_SB(1, 1), cB + hstep + kstep, voffB);
        PG8_WAIT_V(6); PG8_BAR;
    }
    if constexpr (Epi::PREFETCH) E.prefetch(lds, cur, tid);
    for (;;) {
        const bool has_next = S.next(ui + 1, nxt);
        const char* nA = has_next ? (const char*)g.A + (size_t)nxt.pm * tstep : cA; const char* nB = has_next ? (const char*)g.Bt + (size_t)nxt.pn * tstep : cB;
        for (int t = 0; t < nt; t += 2) {
            const bool last = (t == nt - 2);
            const char* a1 = cA + (size_t)(t + 1) * kstep;
            const char* a2 = last ? nA : cA + (size_t)(t + 2) * kstep; const char* b2 = last ? nB : cB + (size_t)(t + 2) * kstep;
            const char* a3 = a2 + kstep; const char* b3 = b2 + kstep;
            if (last && has_next) S.a_ready(nxt);
            if constexpr (SP2) {
            PG8_LDB(B0, 0, 0); PG8_LDB(B1, 0, 1); PG8_SCHED; PG8_LDA(At, 0, 0); PG8_STAGE(PG8_SA(1, 1), a1 + hstep, voffA);
            PG8_WAIT_V(8); PG8_WAIT_L(0); PG8_BAR; PG8_MMA(0, 0, At, B0); PG8_MMA(0, 1, At, B1); PG8_BAR; PG8_SCHED;
            PG8_LDA(At, 0, 1); PG8_STAGE(PG8_SB(0, 0), b2, voffB); PG8_STAGE(PG8_SB(0, 1), b2 + hstep, voffB); PG8_STAGE(PG8_SA(0, 0), a2, voffA);
            PG8_WAIT_V(8); PG8_WAIT_L(0); PG8_BAR; PG8_MMA(1, 0, At, B0); PG8_MMA(1, 1, At, B1); PG8_BAR; PG8_SCHED;
            PG8_LDB(B0, 1, 0); PG8_LDB(B1, 1, 1); PG8_SCHED; PG8_LDA(At, 1, 0); PG8_STAGE(PG8_SA(0, 1), a2 + hstep, voffA);
            PG8_WAIT_V(8); PG8_WAIT_L(0); PG8_BAR; PG8_MMA(0, 0, At, B0); PG8_MMA(0, 1, At, B1); PG8_BAR; PG8_SCHED;
            PG8_LDA(At, 1, 1); PG8_STAGE(PG8_SB(1, 0), b3, voffB); PG8_STAGE(PG8_SB(1, 1), b3 + hstep, voffB); PG8_STAGE(PG8_SA(1, 0), a3, voffA);
            PG8_WAIT_V(8); PG8_WAIT_L(0); PG8_BAR; PG8_MMA(1, 0, At, B0); PG8_MMA(1, 1, At, B1); PG8_BAR; PG8_SCHED;
            } else {
            PG8_LDB(B0, 0, 0); PG8_SCHED; PG8_LDA(At, 0, 0); PG8_STAGE(PG8_SA(1, 1), a1 + hstep, voffA);
            PG8_WAIT_L(8); PG8_BAR; PG8_WAIT_L(0); PG8_MMA(0, 0, At, B0); PG8_BAR; PG8_SCHED;
            PG8_LDB(B1, 0, 1); PG8_STAGE(PG8_SB(0, 0), b2, voffB);
            PG8_BAR; PG8_WAIT_L(0); PG8_MMA(0, 1, At, B1); PG8_BAR;
            PG8_LDA(At, 0, 1); PG8_STAGE(PG8_SA(0, 0), a2, voffA);
            PG8_BAR; PG8_WAIT_L(0); PG8_MMA(1, 0, At, B0); PG8_BAR; PG8_SCHED;
            PG8_STAGE(PG8_SB(0, 1), b2 + hstep, voffB);
            PG8_WAIT_V(6); PG8_BAR; PG8_MMA(1, 1, At, B1); PG8_BAR;
            PG8_LDB(B0, 1, 0); PG8_SCHED; PG8_LDA(At, 1, 0); PG8_STAGE(PG8_SA(0, 1), a2 + hstep, voffA);
            PG8_WAIT_L(8); PG8_BAR; PG8_WAIT_L(0); PG8_MMA(0, 0, At, B0); PG8_BAR; PG8_SCHED;
            PG8_LDB(B1, 1, 1); PG8_STAGE(PG8_SB(1, 0), b3, voffB);
            PG8_BAR; PG8_WAIT_L(0); PG8_MMA(0, 1, At, B1); PG8_BAR;
            PG8_LDA(At, 1, 1); PG8_STAGE(PG8_SA(1, 0), a3, voffA);
            PG8_BAR; PG8_WAIT_L(0); PG8_MMA(1, 0, At, B0); PG8_BAR; PG8_SCHED;
            PG8_STAGE(PG8_SB(1, 1), b3 + hstep, voffB);
            PG8_WAIT_V(6); PG8_BAR; PG8_MMA(1, 1, At, B1); PG8_BAR;
            }
        }
        if constexpr (ALIGN_EPI) { if (wr == 0) PG8_BAR; }
        if constexpr (!Epi::AFTER_DRAIN) { E(acc, cur, wr, wc, fr, fq); S.done(cur); }
        if (!has_next) break;
#pragma unroll
        for (int a = 0; a < 2; ++a)
#pragma unroll
            for (int b = 0; b < 2; ++b)
#pragma unroll
                for (int m = 0; m < 4; ++m)
#pragma unroll
                    for (int n = 0; n < 2; ++n) acc[a][b][m][n] = (f32x4){0.f, 0.f, 0.f, 0.f};
        cur = nxt; cA = nA; cB = nB; ++ui;
        if constexpr (Epi::PREFETCH) { int l_ = fr + 16 * fq; asm volatile("" : "+v"(l_)); E.prefetch(lds, cur, wid * 64 + l_); }
        if constexpr (ALIGN_EPI) { if (wr == 1) PG8_BAR; }
    }
    PG8_WAIT_V(0);
    if constexpr (!ALIGN_EPI) { if (wr == 0) PG8_BAR; }
    PG8_BAR;
    if constexpr (Epi::AFTER_DRAIN) { E.fused(acc, cur, wr, wc, fr, fq, lds, wid, lane); S.done(cur); }
#undef PG8_SA
#undef PG8_SB
#undef PG8_STAGE
#undef PG8_LDA
#undef PG8_LDB
#undef PG8_MMA
#undef PG8_WAIT_V
#undef PG8_WAIT_L
#undef PG8_BAR
#undef PG8_SCHED
}
}

constexpr int NB = 4, SEQ = 8192, DM = 1024, TT = NB * SEQ;
constexpr int NPROJ = 2816, NPAD = 3072;
constexpr int PC_Q = 0, PC_K = 512, PC_V = 1024, PC_Z = 1536, PC_SQ = 2048, PC_SK = 2560, PC_SV = 2688;
constexpr int NE = 32, NCLS = 112, DE = 256;
constexpr float EPS = 1e-6f;
constexpr int NWAVES = 8, NTHR = 512;
constexpr int N_PHASES = 10;
#ifndef G1_SM
#define G1_SM 31
#endif
#ifndef PROBE_REP
#define PROBE_REP -1
#endif
#ifndef MK_ONE_LAUNCH
#define MK_ONE_LAUNCH 1
#endif

constexpr size_t MiB = 1u << 20;
constexpr size_t WS_CTL = 0, CTL_ZERO_BYTES = 65536;
constexpr size_t WS_MOD = 1 * MiB;
constexpr size_t WS_WINT = 2 * MiB, WS_WOUTT = 8 * MiB, WS_WGUT = 10 * MiB, WS_WDT = 42 * MiB;
constexpr size_t WS_H = 58 * MiB;
constexpr size_t WS_PROJ = 122 * MiB;
constexpr size_t WS_AB = 298 * MiB;
constexpr size_t WS_SSQ = WS_AB;
constexpr size_t WS_MIX = 300 * MiB;
constexpr size_t WS_GSF = 364 * MiB;
constexpr size_t WS_EREC = 404 * MiB, WS_CLIST = 412 * MiB;
constexpr size_t WS_HID = WS_PROJ;
constexpr size_t WS_X1B = WS_PROJ + 64 * MiB;
constexpr size_t WS_GAP = WS_H, WS_GQP = WS_H + 32 * MiB;
constexpr size_t WS_GOP = 426 * MiB, WS_GBP = 458 * MiB, WS_GGL = 490 * MiB;
constexpr size_t WS_WRT = 491 * MiB;
constexpr size_t WS_END = 492 * MiB;
constexpr int CW_BAR = 4096, CW_ECNT = 8192, CW_CCNT = 8256;

constexpr int RING_BYTES = 131072, LDSCTL_OFF = RING_BYTES, LDS_BYTES = 147456, MISC_OFF = LDS_BYTES - 128;

#define GAS __attribute__((address_space(1)))
#define LAS __attribute__((address_space(3)))
typedef unsigned short bf16;
typedef unsigned v4u __attribute__((ext_vector_type(4)));
typedef float f32x4 __attribute__((ext_vector_type(4)));
typedef GAS unsigned gu32;
#define RLX_AGENT __ATOMIC_RELAXED, __HIP_MEMORY_SCOPE_AGENT
#define LDS_WAIT() asm volatile("s_waitcnt lgkmcnt(0)" ::: "memory")
__device__ __forceinline__ unsigned f2bf(float f) { unsigned u = __builtin_bit_cast(unsigned, f); return (u + 0x7fffu + ((u >> 16) & 1u)) >> 16; }
__device__ __forceinline__ unsigned pk2(float lo, float hi) { return f2bf(lo) | (f2bf(hi) << 16); }
__device__ __forceinline__ float bf2f(bf16 v) { return __builtin_bit_cast(float, (unsigned)v << 16); }
__device__ __forceinline__ float wave_sum(float v) {
#pragma unroll
    for (int o = 1; o < 64; o <<= 1) v += __shfl_xor(v, o);
    return v;
}
__device__ __forceinline__ float siluf(float y) { return y / (1.f + __expf(-y)); }
#define XB_TMO      128
#define XB_XCNT(j)  (256  + 64 * (j))
#define XB_XSUB(j)  (1280 + 64 * (j))
#define XB_XGEN(j)  (2304 + 64 * (j))
#define XB_TOP      3328
#define XB_TOPGEN   3392
#define XCD_BAR_WORDS 3456
#define XB_SPIN_CAP (1u << 18)
__device__ __forceinline__ unsigned xb_ld(unsigned* p)              { return __hip_atomic_load(p, __ATOMIC_RELAXED, __HIP_MEMORY_SCOPE_AGENT); }
__device__ __forceinline__ unsigned xb_add(unsigned* p, unsigned v) { return __hip_atomic_fetch_add(p, v, __ATOMIC_RELAXED, __HIP_MEMORY_SCOPE_AGENT); }
__device__ __forceinline__ unsigned xb_xcc_id() { return (unsigned)__builtin_amdgcn_s_getreg((3 << 11) | 20) & 0xFu; }
#define XB_SPIN(cond, bar) do { unsigned _sp = 0; while (cond) { __builtin_amdgcn_s_sleep(1); \
    if ((++_sp & 255u) == 0u) { if (xb_ld(&(bar)[XB_TMO])) break; if (_sp > XB_SPIN_CAP) { atomicAdd(&(bar)[XB_TMO], 1u); break; } } } } while (0)

struct XcdBarrier {
    unsigned* bar; unsigned x;
    volatile LAS unsigned* st;
};

__device__ __forceinline__ XcdBarrier xcd_barrier_post(unsigned* bar, volatile LAS unsigned* st, bool leader  ) {
    XcdBarrier b; b.bar = bar; b.x = xb_xcc_id(); b.st = st;
    if (leader) (void)xb_add(&bar[XB_XCNT(b.x)], 1u);
    return b;
}
__device__ __forceinline__ void xcd_barrier_complete(unsigned* bar, unsigned x, unsigned& nloc, unsigned& nx) {
    const unsigned G = gridDim.x * gridDim.y * gridDim.z;
    unsigned sum, cnt, mine, sp = 0u;
    for (;;) {
        sum = 0u; cnt = 0u; mine = 0u;
#pragma unroll
        for (unsigned j = 0; j < 16; ++j) { const unsigned c = xb_ld(&bar[XB_XCNT(j)]); sum += c; cnt += (c > 0u) ? 1u : 0u; mine = (j == x) ? c : mine; }
        if (sum == G) break;
        __builtin_amdgcn_s_sleep(1);
        if ((++sp & 255u) == 0u) { if (xb_ld(&bar[XB_TMO])) break; if (sp > XB_SPIN_CAP) { atomicAdd(&bar[XB_TMO], 1u); break; } }
    }
    nloc = mine > 0u ? mine : 1u; nx = cnt > 0u ? cnt : 1u;
}

__device__ __forceinline__ void xcd_barrier(const XcdBarrier& b, bool leader  ) {
    asm volatile("s_waitcnt vmcnt(0)" ::: "memory");
    __syncthreads();
    if (leader) {
        unsigned* bar = b.bar;
        __builtin_amdgcn_s_waitcnt(0);
        unsigned nloc = b.st[0], nx = b.st[1];
        if (nloc == 0u) { xcd_barrier_complete(bar, b.x, nloc, nx); b.st[0] = nloc; b.st[1] = nx; }
        const unsigned old = xb_add(&bar[XB_XSUB(b.x)], 1u);
        const unsigned gen = old / nloc;
        if (old + 1u == (gen + 1u) * nloc) {
            __builtin_amdgcn_fence(__ATOMIC_RELEASE, "agent");
            asm volatile("s_waitcnt vmcnt(0)" ::: "memory");
            const unsigned og = xb_add(&bar[XB_TOP], 1u);
            const unsigned tg = og / nx;
            if (og + 1u == (tg + 1u) * nx) xb_add(&bar[XB_TOPGEN], 1u);
            else XB_SPIN(xb_ld(&bar[XB_TOPGEN]) == tg, bar);
            __builtin_amdgcn_fence(__ATOMIC_ACQUIRE, "agent");
            xb_add(&bar[XB_XGEN(b.x)], 1u);
            asm volatile("s_waitcnt vmcnt(0)" ::: "memory");
        } else {
            XB_SPIN(xb_ld(&bar[XB_XGEN(b.x)]) == gen, bar);
            __builtin_amdgcn_fence(__ATOMIC_ACQUIRE, "agent");
            asm volatile("s_waitcnt vmcnt(0)" ::: "memory");
        }
    }
    __syncthreads();
}

struct Args { const void* in[23]; float* out; unsigned char* ws; int ph_lo, ph_hi; };
enum { I_X = 0, I_C, I_POS, I_WADA, I_BADA, I_NORM_MIX, I_WIN, I_CONVW, I_ALOG, I_DTB, I_GNORM, I_QNORM, I_KNORM, I_SINKS, I_WOUT, I_NORM_FFN, I_WGRP, I_BGRP, I_WRT, I_BRT, I_WGATE, I_WUP, I_WDOWN };


__device__ __forceinline__ unsigned pk4f8(float a, float b, float c, float d) {
    a = __builtin_amdgcn_fmed3f(a, -448.f, 448.f); b = __builtin_amdgcn_fmed3f(b, -448.f, 448.f); c = __builtin_amdgcn_fmed3f(c, -448.f, 448.f); d = __builtin_amdgcn_fmed3f(d, -448.f, 448.f);
    int v = 0; v = __builtin_amdgcn_cvt_pk_fp8_f32(a, b, v, false); v = __builtin_amdgcn_cvt_pk_fp8_f32(c, d, v, true); return (unsigned)v; }
typedef unsigned v2u8_t __attribute__((ext_vector_type(2)));
constexpr float W8_SCALE = 64.f, HID8_SCALE = 8.f;
template <class CM>
__device__ __forceinline__ void transpose_item(const float* W, int ldw, int k0, bf16* WT, int ldt, int n0, CM cm, LAS float* scr, int lane) {
    const int sc = cm(n0 + (lane & 31));
    float tv[32];
#pragma unroll
    for (int i = 0; i < 32; ++i) { const int kk = 2 * i + (lane >> 5); tv[i] = W[(size_t)(k0 + kk) * ldw + (sc >= 0 ? sc : 0)]; }
#pragma unroll
    for (int i = 0; i < 32; ++i) { const int kk = 2 * i + (lane >> 5); scr[kk * 33 + (lane & 31)] = sc >= 0 ? tv[i] : 0.f; }
    LDS_WAIT(); asm volatile("" ::: "memory");
    const int c = lane & 7;
#pragma unroll
    for (int j = 0; j < 4; ++j) { const int n = (lane >> 3) + 8 * j; const LAS float* s = scr + (8 * c) * 33 + n;
        v4u o; o.x = pk2(s[0 * 33], s[1 * 33]); o.y = pk2(s[2 * 33], s[3 * 33]); o.z = pk2(s[4 * 33], s[5 * 33]); o.w = pk2(s[6 * 33], s[7 * 33]);
        *(v4u*)(WT + (size_t)(n0 + n) * ldt + k0 + 8 * c) = o; }
    LDS_WAIT(); asm volatile("" ::: "memory");
}
template <class CM>
__device__ __forceinline__ void transpose_item8(const float* W, int ldw, int k0, unsigned char* WT, int ldt, int n0, CM cm, LAS float* scr, int lane, float scl) {
    const int sc = cm(n0 + (lane & 31));
    float tv[32];
#pragma unroll
    for (int i = 0; i < 32; ++i) { const int kk = 2 * i + (lane >> 5); tv[i] = W[(size_t)(k0 + kk) * ldw + (sc >= 0 ? sc : 0)]; }
#pragma unroll
    for (int i = 0; i < 32; ++i) { const int kk = 2 * i + (lane >> 5); scr[kk * 33 + (lane & 31)] = sc >= 0 ? tv[i] * scl : 0.f; }
    LDS_WAIT(); asm volatile("" ::: "memory");
    const int c = lane & 7;
#pragma unroll
    for (int j = 0; j < 4; ++j) { const int n = (lane >> 3) + 8 * j; const LAS float* s = scr + (8 * c) * 33 + n;
        v2u8_t o; o.x = pk4f8(s[0 * 33], s[1 * 33], s[2 * 33], s[3 * 33]); o.y = pk4f8(s[4 * 33], s[5 * 33], s[6 * 33], s[7 * 33]);
        *(v2u8_t*)(WT + (size_t)(n0 + n) * ldt + k0 + 8 * c) = o; }
    LDS_WAIT(); asm volatile("" ::: "memory");
}
struct CmIn { __device__ __forceinline__ int operator()(int n) const { return n < 2048 ? n : (n < 2816 ? n + 16 : (n < 2832 ? 2048 + (n - 2816) : -1)); } };
struct CmOff { int off; __device__ __forceinline__ int operator()(int n) const { return n + off; } };
struct CmId { __device__ __forceinline__ int operator()(int n) const { return n; } };

__device__ __forceinline__ void expert_weight_copy(const Args& A, LAS unsigned char* lds, int lane, int wave) {
    unsigned char* ws = A.ws;
    LAS float* scr = (LAS float*)(lds + wave * 8448);
    const int G = gridDim.x, gw = blockIdx.x * NWAVES + wave, NGW = G * NWAVES;
    {   constexpr int IT_GU = NE * 16 * 16, IT_D = NE * 32 * 4;
        const float* wgate = (const float*)A.in[I_WGATE]; const float* wup = (const float*)A.in[I_WUP]; const float* wdown = (const float*)A.in[I_WDOWN];
        for (int it = gw; it < IT_GU + IT_D; it += NGW) {
            if (it < IT_GU) { const int e = it >> 8, r = it & 255, nb = r & 15, kb = r >> 4, j = nb >> 3, q = nb & 7;
                const float* W = (q < 4 ? wgate : wup) + (size_t)e * 1024 * 256; const int col0 = j * 128 + (q & 3) * 32;
                transpose_item8(W, 256, kb * 64, ws + WS_WGUT + (size_t)e * 512 * 1024, 1024, nb * 32, CmOff{col0 - nb * 32}, scr, lane, W8_SCALE); }
            else { const int r2 = it - IT_GU, e = r2 >> 7, r = r2 & 127, nb = r & 31, kb = r >> 5;
                transpose_item8(wdown + (size_t)e * 256 * 1024, 1024, kb * 64, ws + WS_WDT + (size_t)e * 1024 * 256, 256, nb * 32, CmId(), scr, lane, W8_SCALE); }
        }
    }
}
__device__ __forceinline__ void p0_prologue(const Args& A, LAS unsigned char* lds, int tid, int lane, int wave) {
    unsigned char* ws = A.ws;
    LAS float* scr = (LAS float*)(lds + wave * 8448);
    const int G = gridDim.x, gw = blockIdx.x * NWAVES + wave, NGW = G * NWAVES;
    constexpr int IT_IN = (NPAD / 32) * (DM / 64), IT_OUT = (DM / 32) * (DM / 64);
    for (int it = gw; it < IT_IN + IT_OUT; it += NGW) {
        if (it < IT_IN) { const int nb = it % (NPAD / 32), kb = it / (NPAD / 32); transpose_item((const float*)A.in[I_WIN], 2832, kb * 64, (bf16*)(ws + WS_WINT), DM, nb * 32, CmIn(), scr, lane); }
        else { const int r = it - IT_IN, nb = r % (DM / 32), kb = r / (DM / 32); transpose_item((const float*)A.in[I_WOUT], DM, kb * 64, (bf16*)(ws + WS_WOUTT), DM, nb * 32, CmId(), scr, lane); }
    }
    {   const float* wgp = (const float*)A.in[I_WGRP]; const float* wrt = (const float*)A.in[I_WRT];
        bf16* wf = (bf16*)(ws + WS_WRT);
        for (int idx = blockIdx.x * NTHR + tid; idx < 48 * 1024; idx += G * NTHR) { const int j = idx & 7, ln = (idx >> 3) & 63, ks = (idx >> 9) & 31, nt = idx >> 14;
            const int o = 16 * nt + (ln & 15), k = 32 * ks + 8 * (ln >> 4) + j;
            const float w = o < 4 ? wgp[k * 4 + o] : (o < 36 ? wrt[k * 32 + o - 4] : 0.f);
            const unsigned hb = f2bf(w); wf[idx] = (bf16)hb; wf[48 * 1024 + idx] = (bf16)f2bf(w - __builtin_bit_cast(float, hb << 16)); }
    }
    LAS float* cact = (LAS float*)(lds + 69632);
    LAS float* red = (LAS float*)(lds + 69632 + 16384);
    const float* c = (const float*)A.in[I_C]; const float* wada = (const float*)A.in[I_WADA]; const float* bada = (const float*)A.in[I_BADA];
    float* mod = (float*)(ws + WS_MOD);
    if ((int)blockIdx.x < 192) {
        __syncthreads();
        for (int i = tid; i < 4096; i += NTHR) cact[i] = siluf(c[i]);
        __syncthreads();
        for (int u = blockIdx.x; u < 192; u += G) {
            const int n = u * 32 + (lane & 31), kh = lane >> 5; float a0 = 0.f, a1 = 0.f, a2 = 0.f, a3 = 0.f;
#pragma unroll 16
            for (int i = 0; i < 64; ++i) { const int k = wave * 128 + 2 * i + kh; const float w = wada[(size_t)k * 6144 + n]; a0 += cact[k] * w; a1 += cact[1024 + k] * w; a2 += cact[2048 + k] * w; a3 += cact[3072 + k] * w; }
            a0 += __shfl_xor(a0, 32); a1 += __shfl_xor(a1, 32); a2 += __shfl_xor(a2, 32); a3 += __shfl_xor(a3, 32);
            if (lane < 32) { red[(wave * 4 + 0) * 64 + lane] = a0; red[(wave * 4 + 1) * 64 + lane] = a1; red[(wave * 4 + 2) * 64 + lane] = a2; red[(wave * 4 + 3) * 64 + lane] = a3; }
            __syncthreads();
            if (tid < 128) { const int b = tid >> 5, l = tid & 31; float s = bada[u * 32 + l];
#pragma unroll
                for (int w = 0; w < 8; ++w) s += red[(w * 4 + b) * 64 + l];
                mod[b * 6144 + u * 32 + l] = s; }
            __syncthreads();
        }
    }
}

template <bool ROUTE>
__device__ __forceinline__ void norm_rows(const Args& A, const float* X, const float* gain, const float* shift, const float* scale, bf16* H, LAS unsigned char* lds, int lane, int wave) {
    LAS float* hl = (LAS float*)(lds + wave * 4096);
    const int G = gridDim.x, gw = blockIdx.x * NWAVES + wave, NGW = G * NWAVES;
    unsigned char* ws = A.ws;
    for (int r0 = gw * 16; r0 < TT; r0 += NGW * 16) {
        const int b = r0 / SEQ;
        f32x4 mf[4], af[4];
#pragma unroll
        for (int j = 0; j < 4; ++j) { const int col = 4 * lane + 256 * j; const f32x4 g = *(const f32x4*)(gain + col), sc = *(const f32x4*)(scale + b * 6144 + col);
            mf[j] = g * (sc + 1.0f); af[j] = *(const f32x4*)(shift + b * 6144 + col); }
#pragma unroll 4
        for (int i = 0; i < 16; ++i) {
            const int row = r0 + i;
            const f32x4* xr = (const f32x4*)(X + (size_t)row * DM) + lane;
            f32x4 v[4]; float s = 0.f;
#pragma unroll
            for (int j = 0; j < 4; ++j) { v[j] = xr[64 * j]; s += (v[j].x * v[j].x + v[j].y * v[j].y) + (v[j].z * v[j].z + v[j].w * v[j].w); }
            const float rstd = 1.f / sqrtf(wave_sum(s) * (1.f / DM) + EPS);
            unsigned long long* o8 = (unsigned long long*)(H + (size_t)row * DM) + lane;
#pragma unroll
            for (int j = 0; j < 4; ++j) { v[j] = v[j] * rstd * mf[j] + af[j];
                o8[64 * j] = (unsigned long long)pk2(v[j].x, v[j].y) | ((unsigned long long)pk2(v[j].z, v[j].w) << 32); }
            if constexpr (ROUTE) {
                const float* wg = (const float*)A.in[I_WGRP]; const float* wr = (const float*)A.in[I_WRT];
                float lg[36];
#pragma unroll
                for (int o = 0; o < 36; ++o) lg[o] = 0.f;
#pragma unroll
                for (int j = 0; j < 4; ++j) *(LAS f32x4*)(hl + 4 * lane + 256 * j) = v[j];
                LDS_WAIT(); asm volatile("" ::: "memory");
#pragma unroll 1
                for (int ii = 0; ii < 16; ++ii) { const int k = lane + 64 * ii; const float hv = hl[k];
                    const f32x4 g4 = *(const f32x4*)(wg + k * 4);
                    lg[0] += hv * g4.x; lg[1] += hv * g4.y; lg[2] += hv * g4.z; lg[3] += hv * g4.w;
#pragma unroll
                    for (int q = 0; q < 8; ++q) { const f32x4 r4 = *(const f32x4*)(wr + k * 32 + q * 4);
                        lg[4 + q * 4 + 0] += hv * r4.x; lg[4 + q * 4 + 1] += hv * r4.y; lg[4 + q * 4 + 2] += hv * r4.z; lg[4 + q * 4 + 3] += hv * r4.w; } }
                LDS_WAIT(); asm volatile("" ::: "memory");
#pragma unroll
                for (int o = 0; o < 36; ++o) lg[o] = wave_sum(lg[o]);
                const float* bg = (const float*)A.in[I_BGRP]; const float* br = (const float*)A.in[I_BRT];
#pragma unroll
                for (int o = 0; o < 4; ++o) lg[o] += bg[o];
#pragma unroll
                for (int o = 0; o < 32; ++o) lg[4 + o] += br[o];
                int gi = 0; float gm = lg[0];
#pragma unroll
                for (int o = 1; o < 4; ++o) if (lg[o] > gm) { gm = lg[o]; gi = o; }
                float gs = 0.f;
#pragma unroll
                for (int o = 0; o < 4; ++o) gs += __expf(lg[o] - gm);
                const float pg = 1.f / gs;
                float le[8];
#pragma unroll
                for (int j = 0; j < 8; ++j) { le[j] = lg[4 + j];
#pragma unroll
                    for (int g = 1; g < 4; ++g) le[j] = (gi == g) ? lg[4 + g * 8 + j] : le[j]; }
                int j1 = 0; float m1 = le[0];
#pragma unroll
                for (int j = 1; j < 8; ++j) if (le[j] > m1) { m1 = le[j]; j1 = j; }
                int j2 = -1; float m2 = -3.0e38f;
#pragma unroll
                for (int j = 0; j < 8; ++j) if (j != j1 && le[j] > m2) { m2 = le[j]; j2 = j; }
                const float ex = __expf(m2 - m1), w1 = pg / (1.f + ex), w2 = pg * ex / (1.f + ex);
                if (lane == 0) {
                    const int e1 = gi * 8 + j1, e2 = gi * 8 + j2;
                    unsigned* ctl = (unsigned*)(ws + WS_CTL);
                    int2* erec = (int2*)(ws + WS_EREC); int* clist = (int*)(ws + WS_CLIST);
                    const unsigned p1 = atomicAdd(ctl + CW_ECNT + e1, 1u); erec[(size_t)e1 * TT + p1] = make_int2(row * 2 + (e1 > e2 ? 1 : 0), __builtin_bit_cast(int, w1));
                    const unsigned p2 = atomicAdd(ctl + CW_ECNT + e2, 1u); erec[(size_t)e2 * TT + p2] = make_int2(row * 2 + (e2 > e1 ? 1 : 0), __builtin_bit_cast(int, w2));
                    const int a = j1 < j2 ? j1 : j2, bb = j1 < j2 ? j2 : j1;
                    const int cls = gi * 28 + (a * 7 - (a * (a - 1)) / 2 + (bb - a - 1));
                    const unsigned pc = atomicAdd(ctl + CW_CCNT + cls, 1u); clist[(size_t)cls * TT + pc] = row;
                }
            }
        }
    }
}

typedef short bf16x8_t __attribute__((ext_vector_type(8)));
typedef float f32x16 __attribute__((ext_vector_type(16)));
typedef unsigned v2u __attribute__((ext_vector_type(2)));
typedef float f32x2_t __attribute__((ext_vector_type(2)));
typedef __bf16 bf16x2_t __attribute__((ext_vector_type(2)));
__device__ __forceinline__ unsigned cvtpk(float lo, float hi) { const f32x2_t f = {lo, hi}; return __builtin_bit_cast(unsigned, __builtin_convertvector(f, bf16x2_t)); }
__device__ __forceinline__ void fast_sincos(float ang, float& sn, float& cs) {
    float rev = ang * 0.15915494309189535f; rev -= floorf(rev);
    sn = __builtin_amdgcn_sinf(rev); cs = __builtin_amdgcn_cosf(rev);
}
__device__ __forceinline__ void swa_mfma(const Args& A, LAS unsigned char* lds, int tid, int lane, int wave, int blk, int nblk) {
    unsigned char* ws = A.ws;
    const bf16* proj = (const bf16*)(ws + WS_PROJ);
    bf16* mix = (bf16*)(ws + WS_MIX); const float* sinks = (const float*)A.in[I_SINKS];
    const int* pos = (const int*)A.in[I_POS]; const float* qn = (const float*)A.in[I_QNORM]; const float* kn = (const float*)A.in[I_KNORM];
    constexpr int KST = 144, VST = 520;
    LAS unsigned char* Kl = lds; LAS unsigned char* Vt = lds + 256 * KST;
    const int g = wave >> 1, qh = wave & 1, ql = lane & 31, hh = lane >> 5;
    constexpr float LOG2E = 1.4426950408889634f, CS = 0.125f * LOG2E, L2T = 13.287712379549449f / 32.f;
    const int sch = tid & 7;
    float kinv[8], kgn[8];
#pragma unroll
    for (int j = 0; j < 8; ++j) { kinv[j] = __builtin_amdgcn_exp2f(-(float)((sch & 3) * 8 + j) * L2T); kgn[j] = kn[sch * 8 + j]; }
    float qinv[2][8];
#pragma unroll
    for (int ks = 0; ks < 2; ++ks)
#pragma unroll
        for (int j = 0; j < 8; ++j) qinv[ks][j] = __builtin_amdgcn_exp2f(-(float)(ks * 16 + hh * 8 + j) * L2T);
    for (int u = blk; u < NB * 2 * (SEQ / 128); u += nblk) {
        const int n = u & 63, kvh = (u >> 6) & 1, b = u >> 7;
        const int tb = b * SEQ + n * 128;
        __syncthreads();
#pragma unroll
        for (int it = 0; it < 4; ++it) { const int idx = tid + it * NTHR, key = idx >> 3, ch = idx & 7; int tk = tb - 128 + key; if (tk < b * SEQ) tk = b * SEQ;
            const v4u kv = *(const v4u*)(proj + (size_t)tk * NPROJ + PC_SK + kvh * 64 + ch * 8);
            const v4u vv = *(const v4u*)(proj + (size_t)tk * NPROJ + PC_SV + kvh * 64 + ch * 8);
            const float pf = (float)pos[tk];
            float x[8] = { __builtin_bit_cast(float, kv.x << 16), __builtin_bit_cast(float, kv.x & 0xffff0000u), __builtin_bit_cast(float, kv.y << 16), __builtin_bit_cast(float, kv.y & 0xffff0000u),
                           __builtin_bit_cast(float, kv.z << 16), __builtin_bit_cast(float, kv.z & 0xffff0000u), __builtin_bit_cast(float, kv.w << 16), __builtin_bit_cast(float, kv.w & 0xffff0000u) };
            float ss = 0.f;
#pragma unroll
            for (int j = 0; j < 8; ++j) ss += x[j] * x[j];
            ss += __shfl_xor(ss, 1); ss += __shfl_xor(ss, 2); ss += __shfl_xor(ss, 4);
            const float rn = 1.f / sqrtf(ss * (1.f / 64.f) + EPS);
            float o[8];
#pragma unroll
            for (int j = 0; j < 8; ++j) { const float xn = x[j] * rn * kgn[j]; const float pr = __shfl_xor(xn, 4); float sn, cs; fast_sincos(pf * kinv[j], sn, cs);
                o[j] = (ch < 4) ? xn * cs - pr * sn : pr * sn + xn * cs; }
            v4u ko; ko.x = cvtpk(o[0], o[1]); ko.y = cvtpk(o[2], o[3]); ko.z = cvtpk(o[4], o[5]); ko.w = cvtpk(o[6], o[7]);
            *(LAS v4u*)(Kl + key * KST + ch * 16) = ko;
            LAS unsigned short* vp = (LAS unsigned short*)(Vt + (ch * 8) * VST + key * 2);
            vp[0 * (VST / 2)] = (unsigned short)(vv.x & 0xffffu); vp[1 * (VST / 2)] = (unsigned short)(vv.x >> 16);
            vp[2 * (VST / 2)] = (unsigned short)(vv.y & 0xffffu); vp[3 * (VST / 2)] = (unsigned short)(vv.y >> 16);
            vp[4 * (VST / 2)] = (unsigned short)(vv.z & 0xffffu); vp[5 * (VST / 2)] = (unsigned short)(vv.z >> 16);
            vp[6 * (VST / 2)] = (unsigned short)(vv.w & 0xffffu); vp[7 * (VST / 2)] = (unsigned short)(vv.w >> 16); }
        __syncthreads();
        const int hq = kvh * 4 + g; const float sinkl = sinks[hq] * LOG2E;
#pragma unroll 1
        for (int qt = 0; qt < 2; ++qt) {
            const int i0 = qh * 64 + qt * 32, iq = i0 + ql;
            const size_t tq = (size_t)(tb + iq);
            bf16x8_t qf[4];
            {   float xq[4][8]; float ss = 0.f;
#pragma unroll
                for (int ks = 0; ks < 4; ++ks) { const v4u r = *(const v4u*)(proj + tq * NPROJ + PC_SQ + hq * 64 + ks * 16 + hh * 8);
                    xq[ks][0] = __builtin_bit_cast(float, r.x << 16); xq[ks][1] = __builtin_bit_cast(float, r.x & 0xffff0000u); xq[ks][2] = __builtin_bit_cast(float, r.y << 16); xq[ks][3] = __builtin_bit_cast(float, r.y & 0xffff0000u);
                    xq[ks][4] = __builtin_bit_cast(float, r.z << 16); xq[ks][5] = __builtin_bit_cast(float, r.z & 0xffff0000u); xq[ks][6] = __builtin_bit_cast(float, r.w << 16); xq[ks][7] = __builtin_bit_cast(float, r.w & 0xffff0000u);
#pragma unroll
                    for (int j = 0; j < 8; ++j) ss += xq[ks][j] * xq[ks][j]; }
                ss += __shfl_xor(ss, 32);
                const float rn = 1.f / sqrtf(ss * (1.f / 64.f) + EPS); const float pf = (float)pos[tq];
#pragma unroll
                for (int ks = 0; ks < 4; ++ks)
#pragma unroll
                    for (int j = 0; j < 8; ++j) xq[ks][j] *= rn * qn[ks * 16 + hh * 8 + j];
#pragma unroll
                for (int ks = 0; ks < 2; ++ks)
#pragma unroll
                    for (int j = 0; j < 8; ++j) { float sn, cs; fast_sincos(pf * qinv[ks][j], sn, cs); const float x1 = xq[ks][j], x2 = xq[ks + 2][j];
                        xq[ks][j] = x1 * cs - x2 * sn; xq[ks + 2][j] = x1 * sn + x2 * cs; }
#pragma unroll
                for (int ks = 0; ks < 4; ++ks) { union { bf16x8_t v; unsigned u[4]; } p; p.u[0] = cvtpk(xq[ks][0], xq[ks][1]); p.u[1] = cvtpk(xq[ks][2], xq[ks][3]); p.u[2] = cvtpk(xq[ks][4], xq[ks][5]); p.u[3] = cvtpk(xq[ks][6], xq[ks][7]); qf[ks] = p.v; }
            }
            f32x16 sc[5];
#pragma unroll
            for (int kt = 0; kt < 5; ++kt) { f32x16 acc;
#pragma unroll
                for (int r = 0; r < 16; ++r) acc[r] = 0.f;
#pragma unroll
                for (int ks = 0; ks < 4; ++ks) { const bf16x8_t kf = *(const LAS bf16x8_t*)(Kl + (i0 + 32 * kt + ql) * KST + (ks * 16 + hh * 8) * 2);
                    acc = __builtin_amdgcn_mfma_f32_32x32x16_bf16(kf, qf[ks], acc, 0, 0, 0); }
                sc[kt] = acc; }
            float mloc = -3.0e38f;
#pragma unroll
            for (int kt = 0; kt < 5; ++kt) {
                if (kt == 0 || kt == 4 || n == 0) {
#pragma unroll
                    for (int r = 0; r < 16; ++r) { const int j = i0 + 32 * kt + (r & 3) + 8 * (r >> 2) + 4 * hh;
                        const bool valid = (j > iq) && (j <= iq + 128) && (n > 0 || j >= 128);
                        const float sv = valid ? sc[kt][r] * CS : -1.0e30f; sc[kt][r] = sv; mloc = fmaxf(mloc, sv); }
                } else {
#pragma unroll
                    for (int r = 0; r < 16; ++r) { const float sv = sc[kt][r] * CS; sc[kt][r] = sv; mloc = fmaxf(mloc, sv); }
                } }
            float mx = fmaxf(mloc, __shfl_xor(mloc, 32)); mx = fmaxf(mx, sinkl);
            float lsum = 0.f;
#pragma unroll
            for (int kt = 0; kt < 5; ++kt)
#pragma unroll
                for (int r = 0; r < 16; ++r) { const float p = __builtin_amdgcn_exp2f(sc[kt][r] - mx); sc[kt][r] = p; lsum += p; }
            lsum += __shfl_xor(lsum, 32); lsum += __builtin_amdgcn_exp2f(sinkl - mx);
            f32x16 o0, o1;
#pragma unroll
            for (int r = 0; r < 16; ++r) { o0[r] = 0.f; o1[r] = 0.f; }
#pragma unroll
            for (int kt = 0; kt < 5; ++kt)
#pragma unroll
                for (int s2 = 0; s2 < 2; ++s2) {
                    union { bf16x8_t v; unsigned u[4]; } pf;
#pragma unroll
                    for (int p = 0; p < 4; ++p) pf.u[p] = cvtpk(sc[kt][8 * s2 + 2 * p], sc[kt][8 * s2 + 2 * p + 1]);
                    const int jb = i0 + 32 * kt + 16 * s2 + 4 * hh;
                    union { bf16x8_t v; v2u u[2]; } v0, v1;
                    const LAS unsigned char* r0 = Vt + ql * VST + jb * 2; const LAS unsigned char* r1 = Vt + (32 + ql) * VST + jb * 2;
                    v0.u[0] = *(const LAS v2u*)(r0); v0.u[1] = *(const LAS v2u*)(r0 + 16);
                    v1.u[0] = *(const LAS v2u*)(r1); v1.u[1] = *(const LAS v2u*)(r1 + 16);
                    o0 = __builtin_amdgcn_mfma_f32_32x32x16_bf16(v0.v, pf.v, o0, 0, 0, 0);
                    o1 = __builtin_amdgcn_mfma_f32_32x32x16_bf16(v1.v, pf.v, o1, 0, 0, 0);
                }
            const float il = 1.f / lsum;
            bf16* op = mix + tq * DM + 512 + hq * 64 + 4 * hh;
#pragma unroll
            for (int rq = 0; rq < 4; ++rq) {
                v2u w0; w0.x = cvtpk(o0[4 * rq] * il, o0[4 * rq + 1] * il); w0.y = cvtpk(o0[4 * rq + 2] * il, o0[4 * rq + 3] * il);
                *(v2u*)(op + 8 * rq) = w0;
                v2u w1; w1.x = cvtpk(o1[4 * rq] * il, o1[4 * rq + 1] * il); w1.y = cvtpk(o1[4 * rq + 2] * il, o1[4 * rq + 3] * il);
                *(v2u*)(op + 32 + 8 * rq) = w1; }
        }
    }
}

__device__ __forceinline__ int frag_a_idx(int row, int col) { const int mt = row >> 4, l15 = row & 15, ks = col >> 5, x = col & 31, jh = x >> 4, g4 = (x >> 2) & 3, jl = x & 3; return ((mt * 2 + ks) * 64 + g4 * 16 + l15) * 8 + 4 * jh + jl; }
__device__ __forceinline__ int frag_c_idx(int row, int col) { const int w = col >> 4, l15 = col & 15, mt = row >> 4, y = row & 15, g4 = y >> 2, i = y & 3; return ((w * 64 + g4 * 16 + l15) * 4 + mt) * 4 + i; }
__device__ __forceinline__ void gdn_g1_naive(const Args& A, LAS float* L, int tid) {
    unsigned char* ws = A.ws;
    const bf16* proj = (const bf16*)(ws + WS_PROJ); const float* ab = (const float*)(ws + WS_AB);
    bf16* AP = (bf16*)(ws + WS_GAP); bf16* BP = (bf16*)(ws + WS_GBP); bf16* QP = (bf16*)(ws + WS_GQP); bf16* OP = (bf16*)(ws + WS_GOP); float* GL = (float*)(ws + WS_GGL);
    const float* convw = (const float*)A.in[I_CONVW];
    constexpr int LD = 65, AR = 64 * LD;
    LAS float* q = L; LAS float* k = q + AR; LAS float* v = k + AR; LAS float* Mm = v + AR; LAS float* At = Mm + AR; LAS float* w = At + AR;
    LAS float* Gc = w + AR; LAS float* beta = Gc + 64;
    const int i8 = tid >> 3, e0 = (tid & 7) * 8;
    for (int cid = blockIdx.x; cid < NB * 8 * 128; cid += gridDim.x) {
        const int n = cid & 127, bh = cid >> 7, b = bh >> 3, h = bh & 7;
        const float Ah = expf(((const float*)A.in[I_ALOG])[h]), dtb = ((const float*)A.in[I_DTB])[h];
        const int t0 = b * SEQ + n * 64;
        __syncthreads();
        for (int idx = tid; idx < 3 * 4096; idx += NTHR) {
            const int part = idx >> 12, rem = idx & 4095, i = rem >> 6, d = rem & 63, c = part * 512 + h * 64 + d;
            float y = 0.f;
#pragma unroll
            for (int j = 0; j < 4; ++j) { const int s = n * 64 + i - 3 + j; if (s >= 0) y += convw[j * 1536 + c] * bf2f(proj[(size_t)(b * SEQ + s) * NPROJ + c]); }
            y = y / (1.f + __expf(-y));
            (part == 0 ? q : (part == 1 ? k : v))[i * LD + d] = y;
        }
        if (tid < 64) { const float a = ab[(size_t)(t0 + tid) * 16 + h], bb = ab[(size_t)(t0 + tid) * 16 + 8 + h]; const float xx = a + dtb;
            const float sp = xx > 20.f ? xx : log1pf(expf(xx)); Gc[tid] = -Ah * sp; beta[tid] = 1.f / (1.f + __expf(-bb)); }
        __syncthreads();
        if (tid < 128) { LAS float* arr = tid < 64 ? q : k; const int i = tid & 63; float ss = 0.f;
            for (int d = 0; d < 64; ++d) ss += arr[i * LD + d] * arr[i * LD + d];
            const float r = (1.f / sqrtf(ss + EPS)) * (tid < 64 ? 0.125f : 1.f);
            for (int d = 0; d < 64; ++d) arr[i * LD + d] *= r; }
        if (tid == 128) { float run = 0.f; for (int i = 0; i < 64; ++i) { run += Gc[i]; Gc[i] = run; } }
        __syncthreads();
        {   const int i = i8;
            for (int jj = 0; jj < 8; ++jj) { const int j = e0 + jj; float dq = 0.f, dk = 0.f;
_Pragma("unroll 2") for (int d = 0; d < 64; ++d) { const float kj = k[j * LD + d]; dq += q[i * LD + d] * kj; dk += k[i * LD + d] * kj; }
                const float dec = (i >= j) ? __expf(Gc[i] - Gc[j]) : 0.f;
                At[i * LD + j] = dq * dec; Mm[i * LD + j] = (i > j) ? dk * beta[i] * dec : 0.f; }
        }
        __syncthreads();
        for (int idx = tid; idx < 4096; idx += NTHR) { const int i = idx >> 6, d = idx & 63; v[i * LD + d] *= beta[i]; w[i * LD + d] = k[i * LD + d] * beta[i] * __expf(Gc[i]); }
        __syncthreads();
        if (tid < 128) { LAS float* arr = tid < 64 ? v : w; const int c = tid & 63;
            _Pragma("unroll 1") for (int i = 1; i < 64; ++i) { float a = arr[i * LD + c]; _Pragma("unroll 4") for (int j = 0; j < i; ++j) a -= Mm[i * LD + j] * arr[j * LD + c]; arr[i * LD + c] = a; } }
        __syncthreads();
        const float gl = Gc[63];
        const size_t cb = (size_t)cid * 4096;
        {
            const int d = i8; float a[8], bq[8];
#pragma unroll
            for (int ee = 0; ee < 8; ++ee) { a[ee] = 0.f; bq[ee] = 0.f; }
_Pragma("unroll 2")
            for (int c = 0; c < 64; ++c) { const float kd = k[c * LD + d] * __expf(gl - Gc[c]);
#pragma unroll
                for (int ee = 0; ee < 8; ++ee) { a[ee] -= kd * w[c * LD + e0 + ee]; bq[ee] += kd * v[c * LD + e0 + ee]; } }
#pragma unroll
            for (int ee = 0; ee < 8; ++ee) { const int dp = e0 + ee; AP[cb + frag_a_idx(d, dp)] = (bf16)f2bf(a[ee]); BP[cb + frag_c_idx(d, dp)] = (bf16)f2bf(bq[ee]); }
        }
        {
            const int c = i8; float a[8], bq[8]; const float eg = __expf(Gc[c]);
#pragma unroll
            for (int ee = 0; ee < 8; ++ee) { a[ee] = eg * q[c * LD + e0 + ee]; bq[ee] = 0.f; }
_Pragma("unroll 2")
            for (int s2 = 0; s2 <= c; ++s2) { const float av = At[c * LD + s2];
#pragma unroll
                for (int ee = 0; ee < 8; ++ee) { a[ee] -= av * w[s2 * LD + e0 + ee]; bq[ee] += av * v[s2 * LD + e0 + ee]; } }
#pragma unroll
            for (int ee = 0; ee < 8; ++ee) { const int dp = e0 + ee; QP[cb + frag_a_idx(c, dp)] = (bf16)f2bf(a[ee]); OP[cb + frag_c_idx(c, dp)] = (bf16)f2bf(bq[ee]); }
        }
        if (tid == 0) GL[cid] = __expf(gl);
    }
}
__device__ __forceinline__ float wave_incl_scan_f(float v, int lane) {
#pragma unroll
    for (int o = 1; o < 64; o <<= 1) { const float t = __shfl_up(v, o); if (lane >= o) v += t; }
    return v;
}
__device__ __forceinline__ v2u pack4(f32x4 v) { v2u r; r.x = cvtpk(v.x, v.y); r.y = cvtpk(v.z, v.w); return r; }
__device__ __forceinline__ bf16x8_t mk8(v2u lo, v2u hi) { union { bf16x8_t v; unsigned u[4]; } x; x.u[0] = lo.x; x.u[1] = lo.y; x.u[2] = hi.x; x.u[3] = hi.y; return x.v; }
template <int SM, int STG = 7>
__device__ __forceinline__ void gdn_g1_mfma(const Args& A, LAS unsigned char* lds, int tid, int lane, int wave) {
    unsigned char* ws = A.ws;
    const bf16* proj = (const bf16*)(ws + WS_PROJ); const float* ab = (const float*)(ws + WS_AB);
    bf16* AP = (bf16*)(ws + WS_GAP); bf16* BP = (bf16*)(ws + WS_GBP); bf16* QP = (bf16*)(ws + WS_GQP); bf16* OP = (bf16*)(ws + WS_GOP); float* GL = (float*)(ws + WS_GGL);
    const float* convw = (const float*)A.in[I_CONVW];
    constexpr int KST = 144, RST = 68;
    LAS unsigned char* const Kr0 = lds;
    const int l15 = lane & 15, g4 = lane >> 4;
    const v2u zero2 = {0u, 0u};
    const int G = gridDim.x;
    const int ppart = wave >> 1, pt4 = 4 * ((wave & 1) * 8 + (lane >> 3)), pd0 = (lane & 7) * 8;
    v4u xr7[7];
#define G1_PREFETCH(IDX) do { if (wave < 6) { const int h_ = (IDX) & 7, bn_ = (IDX) >> 3, b_ = bn_ >> 7, n_ = bn_ & 127; \
        _Pragma("unroll") for (int r = 0; r < 7; ++r) { const int s_ = n_ * 64 + pt4 - 3 + r, sc_ = s_ < 0 ? 0 : s_; \
            const v4u r_ = *(const v4u*)(proj + (size_t)(b_ * SEQ + sc_) * NPROJ + ppart * 512 + h_ * 64 + pd0); const unsigned m_ = s_ < 0 ? 0u : 0xffffffffu; \
            xr7[r] = (v4u){r_.x & m_, r_.y & m_, r_.z & m_, r_.w & m_}; } } } while (0)
    int hcur = -1;
    constexpr int NC = NB * 8 * 128;
    if ((int)blockIdx.x < NC) G1_PREFETCH((int)blockIdx.x);
    for (int base = blockIdx.x; base < NC; base += 16 * G) {
    {
        LAS float* const GsT0 = (LAS float*)(Kr0 + 91648);
        __syncthreads();
        for (int q = wave; q < 16; q += 8) { const int idx2 = base + q * G;
            if (idx2 < NC) { const int h2 = idx2 & 7, bn2 = idx2 >> 3, b2 = bn2 >> 7, n2 = bn2 & 127;
                const size_t t2 = (size_t)(b2 * SEQ + n2 * 64 + lane) * 16;
                const float Ah = __expf(((const float*)A.in[I_ALOG])[h2]), dtb = ((const float*)A.in[I_DTB])[h2];
                const float xx = ab[t2 + h2] + dtb, bb2 = ab[t2 + 8 + h2];
                const float sp = xx > 20.f ? xx : log1pf(__expf(xx));
                const float Gv = wave_incl_scan_f(-Ah * sp, lane);
                GsT0[q * 64 + lane] = Gv; GsT0[1024 + q * 64 + lane] = 1.f / (1.f + __expf(-bb2));
                if ((SM & 16) && lane == 63) GL[(b2 * 8 + h2) * 128 + n2] = __expf(Gv); } }
    }
#pragma unroll 1
    for (int it = 0; it < 16; ++it) {
        const int idx = base + it * G; if (idx >= NC) break;
        const int h = idx & 7, bn = idx >> 3, b = bn >> 7, n = bn & 127, bh = b * 8 + h, cid = bh * 128 + n;
        const size_t cb = (size_t)cid * 4096;
        int oz = 0; asm volatile("" : "+v"(oz));
        LAS unsigned char* const Kr = Kr0 + oz; LAS unsigned char* const Qr = Kr + 9216; LAS unsigned char* const kdT = Kr + 18432; LAS unsigned char* const Mm = Kr + 27648; LAS unsigned char* const At = Kr + 36864;
        LAS float* const Rt = (LAS float*)(Kr + 46080);
        LAS float* const Md = (LAS float*)(Kr + 80896);
        LAS unsigned char* const Tl = Kr + 86016;
        LAS float* const Gs = (LAS float*)(Kr + 91648) + 64 * it; LAS float* const Bs = Gs + 1024;
        LAS float* const cwl = (LAS float*)(Kr + 88576);
        __syncthreads();
        if (h != hcur) { hcur = h; for (int q = tid; q < 768; q += NTHR) { const int part = q >> 8, j = (q >> 6) & 3, d = q & 63; cwl[q] = convw[j * 1536 + part * 512 + h * 64 + d]; } __syncthreads(); }
        const bool more = (idx + G < NC);
        if (wave < 6) {
            const int d0 = pd0, t4 = pt4, dg = d0 >> 3, swk = dg << 3, swr = (dg & 3) << 3;
            float y[4][8];
            {   float wv[4][8];
#pragma unroll
                for (int j = 0; j < 4; ++j) { const f32x4 w0 = *(const LAS f32x4*)(cwl + (ppart * 4 + j) * 64 + d0), w1 = *(const LAS f32x4*)(cwl + (ppart * 4 + j) * 64 + d0 + 4);
                    wv[j][0] = w0.x; wv[j][1] = w0.y; wv[j][2] = w0.z; wv[j][3] = w0.w; wv[j][4] = w1.x; wv[j][5] = w1.y; wv[j][6] = w1.z; wv[j][7] = w1.w; }
#define G1_XE(r, e) __builtin_bit_cast(float, ((e) & 1) ? (((e) >> 1) == 0 ? xr7[r].x : ((e) >> 1) == 1 ? xr7[r].y : ((e) >> 1) == 2 ? xr7[r].z : xr7[r].w) & 0xffff0000u \
                                                        : (((e) >> 1) == 0 ? xr7[r].x : ((e) >> 1) == 1 ? xr7[r].y : ((e) >> 1) == 2 ? xr7[r].z : xr7[r].w) << 16)
#pragma unroll
                for (int tk = 0; tk < 4; ++tk)
#pragma unroll
                    for (int e = 0; e < 8; ++e) { const float a_ = wv[0][e] * G1_XE(tk, e) + wv[1][e] * G1_XE(tk + 1, e) + wv[2][e] * G1_XE(tk + 2, e) + wv[3][e] * G1_XE(tk + 3, e);
                        y[tk][e] = a_ * __builtin_amdgcn_rcpf(1.f + __expf(-a_)); }
#undef G1_XE
            }
            if (more) G1_PREFETCH(idx + G);
            const f32x4 G4 = *(const LAS f32x4*)(Gs + t4), B4 = *(const LAS f32x4*)(Bs + t4); const float gl = Gs[63];
            if (ppart < 2) {
                float rn[4];
#pragma unroll
                for (int tk = 0; tk < 4; ++tk) { float ss = 0.f;
#pragma unroll
                    for (int e = 0; e < 8; ++e) ss += y[tk][e] * y[tk][e];
                    ss += __shfl_xor(ss, 1); ss += __shfl_xor(ss, 2); ss += __shfl_xor(ss, 4);
                    rn[tk] = (1.f / sqrtf(ss + EPS)) * (ppart == 0 ? 0.125f : 1.f); }
#pragma unroll
                for (int tk = 0; tk < 4; ++tk) {
#pragma unroll
                    for (int e = 0; e < 8; ++e) y[tk][e] *= rn[tk];
                    v4u pk; pk.x = cvtpk(y[tk][0], y[tk][1]); pk.y = cvtpk(y[tk][2], y[tk][3]); pk.z = cvtpk(y[tk][4], y[tk][5]); pk.w = cvtpk(y[tk][6], y[tk][7]);
                    *(LAS v4u*)((ppart == 0 ? Qr : Kr) + (t4 + tk) * KST + d0 * 2) = pk; }
                if (ppart == 1) {
                    const float ek0 = __expf(gl - G4.x), ek1 = __expf(gl - G4.y), ek2 = __expf(gl - G4.z), ek3 = __expf(gl - G4.w);
                    const float bg0 = B4.x * __expf(G4.x), bg1 = B4.y * __expf(G4.y), bg2 = B4.z * __expf(G4.z), bg3 = B4.w * __expf(G4.w);
#pragma unroll
                    for (int e = 0; e < 8; ++e) {
                        v2u kd; kd.x = cvtpk(y[0][e] * ek0, y[1][e] * ek1); kd.y = cvtpk(y[2][e] * ek2, y[3][e] * ek3);
                        *(LAS v2u*)(kdT + (d0 + e) * KST + (t4 ^ swk) * 2) = kd;
                        *(LAS f32x4*)(Rt + (d0 + e) * RST + (t4 ^ swr)) = (f32x4){y[0][e] * bg0, y[1][e] * bg1, y[2][e] * bg2, y[3][e] * bg3}; }
                }
            } else {
#pragma unroll
                for (int e = 0; e < 8; ++e) *(LAS f32x4*)(Rt + (64 + d0 + e) * RST + (t4 ^ swr)) = (f32x4){y[0][e] * B4.x, y[1][e] * B4.y, y[2][e] * B4.z, y[3][e] * B4.w};
            }
        }
        __syncthreads();
#define G1_TILE(which, ct, st) do { const LAS unsigned char* Xb_ = (which) ? Kr : Qr; const int c_ = 16 * (ct) + l15; const float Gc_ = Gs[c_], bc_ = Bs[c_]; \
            f32x4 acc_ = {0.f, 0.f, 0.f, 0.f}; \
            _Pragma("unroll") for (int ks = 0; ks < 2; ++ks) { const bf16x8_t bf_ = *(const LAS bf16x8_t*)(Xb_ + c_ * KST + (32 * ks + 8 * g4) * 2); \
                const bf16x8_t af_ = *(const LAS bf16x8_t*)(Kr + (16 * (st) + l15) * KST + (32 * ks + 8 * g4) * 2); acc_ = __builtin_amdgcn_mfma_f32_16x16x32_bf16(af_, bf_, acc_, 0, 0, 0); } \
            f32x4 vals_; \
            _Pragma("unroll") for (int r = 0; r < 4; ++r) { const int s2_ = 16 * (st) + 4 * g4 + r; const float dec_ = __expf(fminf(Gc_ - Gs[s2_], 0.f)); \
                vals_[r] = (which) ? ((s2_ < c_) ? -acc_[r] * bc_ * dec_ : 0.f) : ((s2_ <= c_) ? acc_[r] * dec_ : 0.f); } \
            *(LAS v2u*)(((which) ? Mm : At) + c_ * KST + (16 * (st) + 4 * g4) * 2) = pack4(vals_); \
            if ((which) && (st) == (ct)) *(LAS f32x4*)(Md + ((ct) * 16 + l15) * 20 + 4 * g4) = -vals_; } while (0)
        if constexpr (STG & 1) {
            const int ct = wave & 3, st0 = 2 * (wave >> 2);
            G1_TILE(1, ct, st0); G1_TILE(1, ct, st0 + 1);
        }
        __syncthreads();
        if constexpr (STG & 1) {
            if (wave != 0) { for (int tix = wave - 1; tix < 16; tix += 7) { const int ct = tix & 3, st = tix >> 2; G1_TILE(0, ct, st); } }
        }
        if ((STG & 2) && wave == 0) {
            float t[16];
#pragma unroll
            for (int r = 0; r < 16; ++r) { float acc = (r == l15) ? 1.f : 0.f;
#pragma unroll
                for (int s4 = 0; s4 < r; s4 += 4) { const f32x4 m = *(const LAS f32x4*)(Md + (g4 * 16 + r) * 20 + s4);
                    acc -= m.x * t[s4]; if (s4 + 1 < r) acc -= m.y * t[s4 + 1]; if (s4 + 2 < r) acc -= m.z * t[s4 + 2]; if (s4 + 3 < r) acc -= m.w * t[s4 + 3]; }
                t[r] = acc; }
#pragma unroll
            for (int r = 0; r < 16; ++r) *(LAS unsigned short*)(Tl + ((g4 * 16 + r) * 16 + l15) * 2) = (unsigned short)f2bf(t[r]);
        }
        __syncthreads();
        if constexpr (STG & 4) {
        f32x4 wt[4];
        {   const int colw = 16 * wave + l15;
#pragma unroll
            for (int i = 0; i < 4; ++i) {
                f32x4 acc = *(const LAS f32x4*)(Rt + colw * RST + ((16 * i + 4 * g4) ^ (((colw >> 3) & 3) << 3)));
                const LAS unsigned char* mrow = Mm + (16 * i + l15) * KST + (4 * g4) * 2;
                if (i >= 1) { const v2u alo = *(const LAS v2u*)(mrow), ahi = (i >= 2) ? *(const LAS v2u*)(mrow + 32) : zero2;
                    acc = __builtin_amdgcn_mfma_f32_16x16x32_bf16(mk8(alo, ahi), mk8(pack4(wt[0]), (i >= 2) ? pack4(wt[1]) : zero2), acc, 0, 0, 0); }
                if (i == 3) { const v2u alo = *(const LAS v2u*)(mrow + 64);
                    acc = __builtin_amdgcn_mfma_f32_16x16x32_bf16(mk8(alo, zero2), mk8(pack4(wt[2]), zero2), acc, 0, 0, 0); }
                const v2u tlo = *(const LAS v2u*)(Tl + ((i * 16 + l15) * 16 + 4 * g4) * 2);
                wt[i] = __builtin_amdgcn_mfma_f32_16x16x32_bf16(mk8(tlo, zero2), mk8(pack4(acc), zero2), (f32x4){0.f, 0.f, 0.f, 0.f}, 0, 0, 0);
            }
        }
        if (wave < 4) {
            bf16x8_t wn[2];
#pragma unroll
            for (int ks = 0; ks < 2; ++ks) { v2u lo = pack4(wt[2 * ks]), hi = pack4(wt[2 * ks + 1]); lo.x ^= 0x80008000u; lo.y ^= 0x80008000u; hi.x ^= 0x80008000u; hi.y ^= 0x80008000u; wn[ks] = mk8(lo, hi); }
#pragma unroll
            for (int nt = 0; nt < 4; ++nt) { const int x = 16 * nt + l15;
                f32x4 ca = {0.f, 0.f, 0.f, 0.f};
                const v2u qraw = *(const LAS v2u*)(Qr + x * KST + (16 * wave + 4 * g4) * 2); const float eg = __expf(Gs[x]);
                f32x4 cq; cq.x = eg * __builtin_bit_cast(float, qraw.x << 16); cq.y = eg * __builtin_bit_cast(float, qraw.x & 0xffff0000u); cq.z = eg * __builtin_bit_cast(float, qraw.y << 16); cq.w = eg * __builtin_bit_cast(float, qraw.y & 0xffff0000u);
#pragma unroll
                for (int ks = 0; ks < 2; ++ks) { const int xs = (x >> 3) << 3; const LAS unsigned char* kp0 = kdT + x * KST + ((32 * ks + 4 * g4) ^ xs) * 2; const LAS unsigned char* kp1 = kdT + x * KST + ((32 * ks + 16 + 4 * g4) ^ xs) * 2; const LAS unsigned char* ap = At + x * KST + (32 * ks + 4 * g4) * 2;
                    ca = __builtin_amdgcn_mfma_f32_16x16x32_bf16(wn[ks], mk8(*(const LAS v2u*)(kp0), *(const LAS v2u*)(kp1)), ca, 0, 0, 0);
                    cq = __builtin_amdgcn_mfma_f32_16x16x32_bf16(wn[ks], mk8(*(const LAS v2u*)(ap), *(const LAS v2u*)(ap + 32)), cq, 0, 0, 0); }
                const size_t off = cb + (size_t)((nt * 2 + (wave >> 1)) * 64 + lane) * 8 + 4 * (wave & 1);
                if (SM & 1) *(v2u*)(AP + off) = pack4(ca); if (SM & 2) *(v2u*)(QP + off) = pack4(cq);
            }
        } else {
            bf16x8_t ub[2];
#pragma unroll
            for (int ks = 0; ks < 2; ++ks) ub[ks] = mk8(pack4(wt[2 * ks]), pack4(wt[2 * ks + 1]));
            unsigned bo[8], oo[8];
#pragma unroll
            for (int mt = 0; mt < 4; ++mt) { const int x = 16 * mt + l15;
                f32x4 cbv = {0.f, 0.f, 0.f, 0.f}, co = {0.f, 0.f, 0.f, 0.f};
#pragma unroll
                for (int ks = 0; ks < 2; ++ks) { const int xs = (x >> 3) << 3; const LAS unsigned char* kp0 = kdT + x * KST + ((32 * ks + 4 * g4) ^ xs) * 2; const LAS unsigned char* kp1 = kdT + x * KST + ((32 * ks + 16 + 4 * g4) ^ xs) * 2; const LAS unsigned char* ap = At + x * KST + (32 * ks + 4 * g4) * 2;
                    cbv = __builtin_amdgcn_mfma_f32_16x16x32_bf16(mk8(*(const LAS v2u*)(kp0), *(const LAS v2u*)(kp1)), ub[ks], cbv, 0, 0, 0);
                    co = __builtin_amdgcn_mfma_f32_16x16x32_bf16(mk8(*(const LAS v2u*)(ap), *(const LAS v2u*)(ap + 32)), ub[ks], co, 0, 0, 0); }
                const v2u pb = pack4(cbv), po = pack4(co); bo[2 * mt] = pb.x; bo[2 * mt + 1] = pb.y; oo[2 * mt] = po.x; oo[2 * mt + 1] = po.y; }
            const size_t off = cb + (size_t)((wave - 4) * 64 + lane) * 16;
            if (SM & 4) { *(v4u*)(BP + off) = (v4u){bo[0], bo[1], bo[2], bo[3]}; *(v4u*)(BP + off + 8) = (v4u){bo[4], bo[5], bo[6], bo[7]}; }
            if (SM & 8) { *(v4u*)(OP + off) = (v4u){oo[0], oo[1], oo[2], oo[3]}; *(v4u*)(OP + off + 8) = (v4u){oo[4], oo[5], oo[6], oo[7]}; }
        }
        }
    }
    }
#undef G1_TILE
#undef G1_PREFETCH
}

__device__ __forceinline__ f32x4 g2_unpack(const v4u (&p)[2], int mt) {
    const unsigned d0 = mt == 0 ? p[0].x : mt == 1 ? p[0].z : mt == 2 ? p[1].x : p[1].z, d1 = mt == 0 ? p[0].y : mt == 1 ? p[0].w : mt == 2 ? p[1].y : p[1].w;
    f32x4 r; r.x = __builtin_bit_cast(float, d0 << 16); r.y = __builtin_bit_cast(float, d0 & 0xffff0000u); r.z = __builtin_bit_cast(float, d1 << 16); r.w = __builtin_bit_cast(float, d1 & 0xffff0000u); return r;
}
template <int VAR = 0>
__device__ __forceinline__ void gdn_scan(const Args& A, int bh, LAS unsigned char* lds, int tid, int lane, int wave) {
    unsigned char* ws = A.ws;
    const char* AP = (const char*)(ws + WS_GAP); const char* BP = (const char*)(ws + WS_GBP); const float* GL = (const float*)(ws + WS_GGL); bf16* SF = (bf16*)(ws + WS_GSF);
    constexpr int SLOT = 16384, NSL = 8, EGL_OFF = NSL * SLOT;
    LAS float* eglt = (LAS float*)(lds + EGL_OFF);
    __syncthreads();
    { int tl = tid; asm volatile("" : "+v"(tl));
      if (tl < 128) eglt[tl] = GL[bh * 128 + tl]; }
    if (wave < 4) {
        f32x4 sC[4]; bf16x8_t sB[2];
#pragma unroll
        for (int mt = 0; mt < 4; ++mt) sC[mt] = (f32x4){0.f, 0.f, 0.f, 0.f};
#pragma unroll
        for (int ks = 0; ks < 2; ++ks)
#pragma unroll
            for (int j = 0; j < 8; ++j) sB[ks][j] = 0;
        asm volatile("s_waitcnt vmcnt(0) lgkmcnt(0)" ::: "memory");
        __builtin_amdgcn_s_barrier();
        struct SSet { bf16x8_t fa[4][2]; v4u fb[2]; float egl; };
#define SC_LOAD(S, n) do { const int n_ = (n) < SEQ / 64 ? (n) : SEQ / 64 - 1; const LAS unsigned char* slot_ = lds + (n_ & (NSL - 1)) * SLOT; \
            _Pragma("unroll") for (int mt = 0; mt < 4; ++mt) _Pragma("unroll") for (int ks = 0; ks < 2; ++ks) S.fa[mt][ks] = *(const LAS bf16x8_t*)(slot_ + ((mt * 2 + ks) * 64 + lane) * 16); \
            S.fb[0] = *(const LAS v4u*)(slot_ + 8192 + (wave * 64 + lane) * 32); S.fb[1] = *(const LAS v4u*)(slot_ + 8192 + (wave * 64 + lane) * 32 + 16); S.egl = eglt[n_]; } while (0)
#define SC_STEP(S, n) do { bf16* sf = SF + (size_t)(bh * 128 + (n)) * 4096 + (size_t)((wave * 2) * 64 + lane) * 8; \
            *(bf16x8_t*)(sf) = sB[0]; *(bf16x8_t*)(sf + 512) = sB[1]; \
            f32x4 sacc[4]; \
            _Pragma("unroll") for (int mt = 0; mt < 4; ++mt) sacc[mt] = sC[mt] * S.egl + g2_unpack(S.fb, mt); \
            _Pragma("unroll") for (int mt = 0; mt < 4; ++mt) _Pragma("unroll") for (int ks = 0; ks < 2; ++ks) sacc[mt] = __builtin_amdgcn_mfma_f32_16x16x32_bf16(S.fa[mt][ks], sB[ks], sacc[mt], 0, 0, 0); \
            _Pragma("unroll") for (int mt = 0; mt < 4; ++mt) sC[mt] = sacc[mt]; \
            _Pragma("unroll") for (int ks = 0; ks < 2; ++ks) { union { bf16x8_t v; unsigned u[4]; } pk_; \
                pk_.u[0] = cvtpk(sC[2 * ks].x, sC[2 * ks].y); pk_.u[1] = cvtpk(sC[2 * ks].z, sC[2 * ks].w); pk_.u[2] = cvtpk(sC[2 * ks + 1].x, sC[2 * ks + 1].y); pk_.u[3] = cvtpk(sC[2 * ks + 1].z, sC[2 * ks + 1].w); sB[ks] = pk_.v; } \
            asm volatile("s_waitcnt lgkmcnt(0)" ::: "memory"); \
            __builtin_amdgcn_s_barrier(); } while (0)
        SSet s0;
#pragma unroll 1
        for (int n = 0; n < SEQ / 64; ++n) {
            if (VAR == 2) { asm volatile("s_waitcnt lgkmcnt(0)" ::: "memory"); __builtin_amdgcn_s_barrier(); continue; }
            SC_LOAD(s0, n);
            SC_STEP(s0, n);
        }
#undef SC_LOAD
#undef SC_STEP
    } else {
        const int f = wave - 4;
        const unsigned lin = (unsigned)(2 * f) * 1024u + (unsigned)lane * 16u;
#define G2_DMA(nn) do { const int n_ = (nn) < SEQ / 64 ? (nn) : SEQ / 64 - 1; const size_t cb_ = (size_t)(bh * 128 + n_) * 8192; LAS unsigned char* d_ = lds + ((nn) & (NSL - 1)) * SLOT + (2 * f) * 1024; \
        __builtin_amdgcn_global_load_lds((const unsigned*)(AP + cb_ + lin), (LAS unsigned*)(d_), 16, 0, 0); __builtin_amdgcn_global_load_lds((const unsigned*)(AP + cb_ + lin + 1024), (LAS unsigned*)(d_ + 1024), 16, 0, 0); \
        __builtin_amdgcn_global_load_lds((const unsigned*)(BP + cb_ + lin), (LAS unsigned*)(d_ + 8192), 16, 0, 0); __builtin_amdgcn_global_load_lds((const unsigned*)(BP + cb_ + lin + 1024), (LAS unsigned*)(d_ + 8192 + 1024), 16, 0, 0); } while (0)
        asm volatile("s_waitcnt vmcnt(0) lgkmcnt(0)" ::: "memory");
        G2_DMA(0); G2_DMA(1); G2_DMA(2); G2_DMA(3); G2_DMA(4); G2_DMA(5); G2_DMA(6);
        asm volatile("s_waitcnt vmcnt(24)" ::: "memory");
        __builtin_amdgcn_s_barrier();
#pragma unroll 1
        for (int n = 0; n < SEQ / 64; ++n) {
            if (VAR != 1) G2_DMA(n + 7);
            asm volatile("s_waitcnt vmcnt(24)" ::: "memory");
            __builtin_amdgcn_s_barrier();
        }
#undef G2_DMA
        asm volatile("s_waitcnt vmcnt(0)" ::: "memory");
    }
    __syncthreads();
}
__device__ __forceinline__ void gdn_out(const Args& A, LAS unsigned char* lds, int lane, int wave) {
    unsigned char* ws = A.ws;
    const bf16* proj = (const bf16*)(ws + WS_PROJ); bf16* mix = (bf16*)(ws + WS_MIX);
    const bf16* QP = (const bf16*)(ws + WS_GQP); const bf16* OP = (const bf16*)(ws + WS_GOP); const bf16* SF = (const bf16*)(ws + WS_GSF);
    const float* onorm = (const float*)A.in[I_GNORM];
    const int mt = wave & 3, l15 = lane & 15, g4 = lane >> 4, rr = lane >> 2, q4 = lane & 3;
    constexpr int OST = 68;
    LAS float* ot = (LAS float*)(lds + wave * 4608);
    float gain[16];
#pragma unroll
    for (int k = 0; k < 16; ++k) gain[k] = onorm[16 * q4 + k];
    struct OSet { bf16x8_t qa[2], sb[4][2]; v2u oi[4]; v4u z0, z1; };
#define GO_LOAD(S, CID) do { const int n_ = (CID) & 127, bh_ = (CID) >> 7, b_ = bh_ >> 3, h_ = bh_ & 7; const size_t cb_ = (size_t)(CID) * 4096; \
        const size_t t_ = (size_t)b_ * SEQ + n_ * 64 + 16 * mt + rr; \
        S.z0 = *(const v4u*)(proj + t_ * NPROJ + PC_Z + h_ * 64 + 16 * q4); S.z1 = *(const v4u*)(proj + t_ * NPROJ + PC_Z + h_ * 64 + 16 * q4 + 8); \
        _Pragma("unroll") for (int ks = 0; ks < 2; ++ks) S.qa[ks] = *(const bf16x8_t*)(QP + cb_ + ((mt * 2 + ks) * 64 + lane) * 8); \
        _Pragma("unroll") for (int nt = 0; nt < 4; ++nt) { _Pragma("unroll") for (int ks = 0; ks < 2; ++ks) S.sb[nt][ks] = *(const bf16x8_t*)(SF + cb_ + ((nt * 2 + ks) * 64 + lane) * 8); \
            S.oi[nt] = *(const v2u*)(OP + cb_ + ((nt * 64 + lane) * 4 + mt) * 4); } } while (0)
#define GO_STEP(S, CID) do { const int n_ = (CID) & 127, bh_ = (CID) >> 7, b_ = bh_ >> 3, h_ = bh_ & 7; const size_t t_ = (size_t)b_ * SEQ + n_ * 64 + 16 * mt + rr; \
        _Pragma("unroll") for (int nt = 0; nt < 4; ++nt) { \
            f32x4 acc; acc.x = __builtin_bit_cast(float, S.oi[nt].x << 16); acc.y = __builtin_bit_cast(float, S.oi[nt].x & 0xffff0000u); acc.z = __builtin_bit_cast(float, S.oi[nt].y << 16); acc.w = __builtin_bit_cast(float, S.oi[nt].y & 0xffff0000u); \
            _Pragma("unroll") for (int ks = 0; ks < 2; ++ks) acc = __builtin_amdgcn_mfma_f32_16x16x32_bf16(S.qa[ks], S.sb[nt][ks], acc, 0, 0, 0); \
            _Pragma("unroll") for (int i = 0; i < 4; ++i) ot[(4 * g4 + i) * OST + 16 * nt + l15] = acc[i]; } \
        LDS_WAIT(); asm volatile("" ::: "memory"); \
        float o[16]; float ss = 0.f; \
        _Pragma("unroll") for (int k = 0; k < 4; ++k) { const f32x4 v = *(const LAS f32x4*)(ot + rr * OST + 16 * q4 + 4 * k); o[4 * k] = v.x; o[4 * k + 1] = v.y; o[4 * k + 2] = v.z; o[4 * k + 3] = v.w; } \
        _Pragma("unroll") for (int k = 0; k < 16; ++k) ss += o[k] * o[k]; \
        ss += __shfl_xor(ss, 1); ss += __shfl_xor(ss, 2); \
        const float r = 1.f / sqrtf(ss * (1.f / 64.f) + EPS); \
        const unsigned zu[8] = {S.z0.x, S.z0.y, S.z0.z, S.z0.w, S.z1.x, S.z1.y, S.z1.z, S.z1.w}; \
        unsigned ou[8]; \
        _Pragma("unroll") for (int k = 0; k < 8; ++k) { const float za = __builtin_bit_cast(float, zu[k] << 16), zb = __builtin_bit_cast(float, zu[k] & 0xffff0000u); \
            ou[k] = cvtpk(o[2 * k] * r * gain[2 * k] * siluf(za), o[2 * k + 1] * r * gain[2 * k + 1] * siluf(zb)); } \
        bf16* op = mix + t_ * DM + h_ * 64 + 16 * q4; \
        *(v4u*)(op) = (v4u){ou[0], ou[1], ou[2], ou[3]}; *(v4u*)(op + 8) = (v4u){ou[4], ou[5], ou[6], ou[7]}; \
        LDS_WAIT(); asm volatile("" ::: "memory"); } while (0)
    const int NC = NB * 8 * 128, st = gridDim.x * 2;
    int cid = blockIdx.x * 2 + (wave >> 2);
    OSet s0, s1, s2;
    if (cid < NC) GO_LOAD(s0, cid);
    if (cid + st < NC) GO_LOAD(s1, cid + st);
#pragma unroll 1
    for (; cid < NC; cid += 3 * st) {
        if (cid + 2 * st < NC) GO_LOAD(s2, cid + 2 * st);
        GO_STEP(s0, cid);
        if (cid + st < NC) { if (cid + 3 * st < NC) GO_LOAD(s0, cid + 3 * st); GO_STEP(s1, cid + st); }
        if (cid + 2 * st < NC) { if (cid + 4 * st < NC) GO_LOAD(s1, cid + 4 * st); GO_STEP(s2, cid + 2 * st); }
    }
#undef GO_LOAD
#undef GO_STEP
}

template <bool DRY, int VAR = 0>
__device__ __forceinline__ void norm_route_mfma(const Args& A, const bf16* X, const float* ssqp, const float* gain, const float* shift, const float* scale, bf16* H, LAS unsigned char* lds, int tid, int lane, int wave) {
    unsigned char* ws = A.ws;
    const int G = gridDim.x;
    const int l15 = lane & 15, g4 = lane >> 4;
    LAS unsigned char* wfl = lds;
    LAS float* mfl = (LAS float*)(lds + 98304); LAS float* afl = mfl + 1024;
    LAS float* lgs = (LAS float*)(lds + 98304 + 8192 + wave * 3328);
    const float* bg = (const float*)A.in[I_BGRP]; const float* br = (const float*)A.in[I_BRT];
#define P7_LOADW(half) do { const v4u* src_ = (const v4u*)(ws + WS_WRT); \
        for (int q = tid; q < 3072; q += NTHR) { const int nt_ = q >> 10, r_ = q & 1023; const int g_ = (nt_ * 32 + 16 * (half)) * 64 + r_; \
            *(LAS v4u*)(wfl + q * 16) = src_[g_]; *(LAS v4u*)(wfl + 49152 + q * 16) = src_[6144 + g_]; } } while (0)
    int bcur = -1;
    for (int rb = blockIdx.x * 128; rb < TT; rb += G * 128) {
        const int b = rb / SEQ, r0 = rb + wave * 16, row = r0 + l15;
        if (b != bcur) { bcur = b; __syncthreads();
            for (int q = tid; q < 1024; q += NTHR) { mfl[q] = gain[q] * (scale[b * 6144 + q] + 1.0f); afl[q] = shift[b * 6144 + q]; }
            __syncthreads(); }
        const bf16* xr = X + (size_t)row * DM + 8 * g4;
        float ss;
        {   const f32x4 p4 = *(const f32x4*)(ssqp + (size_t)row * 16 + 4 * g4); ss = (p4.x + p4.y) + (p4.z + p4.w); }
        ss += __shfl_xor(ss, 16); ss += __shfl_xor(ss, 32);
        const float rstd = 1.f / sqrtf(ss * (1.f / DM) + EPS);
        f32x4 acc[3];
#pragma unroll
        for (int nt = 0; nt < 3; ++nt) acc[nt] = (f32x4){0.f, 0.f, 0.f, 0.f};
        unsigned char* hrow = (unsigned char*)H + (size_t)row * DM + 8 * g4;
#pragma unroll 1
        for (int half = 0; half < 2; ++half) {
        __syncthreads(); P7_LOADW(half); __syncthreads();
#pragma unroll 8
        for (int ks = 16 * half; ks < 16 * half + 16; ++ks) {
            float hv[8];
            {   const v4u xq = *(const v4u*)(xr + 32 * ks);
                const f32x4 a = (f32x4){__builtin_bit_cast(float, xq.x << 16), __builtin_bit_cast(float, xq.x & 0xffff0000u), __builtin_bit_cast(float, xq.y << 16), __builtin_bit_cast(float, xq.y & 0xffff0000u)};
                const f32x4 c = (f32x4){__builtin_bit_cast(float, xq.z << 16), __builtin_bit_cast(float, xq.z & 0xffff0000u), __builtin_bit_cast(float, xq.w << 16), __builtin_bit_cast(float, xq.w & 0xffff0000u)};
                const f32x4 m0 = *(const LAS f32x4*)(mfl + 32 * ks + 8 * g4), m1 = *(const LAS f32x4*)(mfl + 32 * ks + 8 * g4 + 4), h0 = *(const LAS f32x4*)(afl + 32 * ks + 8 * g4), h1 = *(const LAS f32x4*)(afl + 32 * ks + 8 * g4 + 4);
                const f32x4 v0 = a * rstd * m0 + h0, v1 = c * rstd * m1 + h1;
                hv[0] = v0.x; hv[1] = v0.y; hv[2] = v0.z; hv[3] = v0.w; hv[4] = v1.x; hv[5] = v1.y; hv[6] = v1.z; hv[7] = v1.w; }
            unsigned hu[4], lu[4];
#pragma unroll
            for (int p = 0; p < 4; ++p) { hu[p] = cvtpk(hv[2 * p], hv[2 * p + 1]);
                const float ra = hv[2 * p] - __builtin_bit_cast(float, hu[p] << 16), rb2 = hv[2 * p + 1] - __builtin_bit_cast(float, hu[p] & 0xffff0000u); lu[p] = cvtpk(ra, rb2); }
            *(v2u8_t*)(hrow + 32 * ks) = (v2u8_t){pk4f8(hv[0], hv[1], hv[2], hv[3]), pk4f8(hv[4], hv[5], hv[6], hv[7])};
            union { bf16x8_t v; unsigned u[4]; } ah, al; ah.u[0] = hu[0]; ah.u[1] = hu[1]; ah.u[2] = hu[2]; ah.u[3] = hu[3]; al.u[0] = lu[0]; al.u[1] = lu[1]; al.u[2] = lu[2]; al.u[3] = lu[3];
#pragma unroll
            for (int nt = 0; nt < 3; ++nt) { const int fo = ((nt * 16 + (ks & 15)) * 64 + lane) * 16;
                const bf16x8_t bh = *(const LAS bf16x8_t*)(wfl + fo), bl = *(const LAS bf16x8_t*)(wfl + 49152 + fo);
                acc[nt] = __builtin_amdgcn_mfma_f32_16x16x32_bf16(ah.v, bh, acc[nt], 0, 0, 0);
                acc[nt] = __builtin_amdgcn_mfma_f32_16x16x32_bf16(ah.v, bl, acc[nt], 0, 0, 0);
                acc[nt] = __builtin_amdgcn_mfma_f32_16x16x32_bf16(al.v, bh, acc[nt], 0, 0, 0); }
        }
        }
#pragma unroll
        for (int nt = 0; nt < 3; ++nt)
#pragma unroll
            for (int r = 0; r < 4; ++r) lgs[(4 * g4 + r) * 52 + 16 * nt + l15] = acc[nt][r];
        LDS_WAIT(); asm volatile("" ::: "memory");
        if (lane < 16) {
            float lg[36];
#pragma unroll
            for (int q = 0; q < 9; ++q) { const f32x4 v = *(const LAS f32x4*)(lgs + lane * 52 + 4 * q); lg[4 * q] = v.x; lg[4 * q + 1] = v.y; lg[4 * q + 2] = v.z; lg[4 * q + 3] = v.w; }
#pragma unroll
            for (int o = 0; o < 4; ++o) lg[o] += bg[o];
#pragma unroll
            for (int o = 0; o < 32; ++o) lg[4 + o] += br[o];
            int gi = 0; float gm = lg[0];
#pragma unroll
            for (int o = 1; o < 4; ++o) if (lg[o] > gm) { gm = lg[o]; gi = o; }
            float gs = 0.f;
#pragma unroll
            for (int o = 0; o < 4; ++o) gs += __expf(lg[o] - gm);
            const float pg = 1.f / gs;
            float le[8];
#pragma unroll
            for (int j = 0; j < 8; ++j) { le[j] = lg[4 + j];
#pragma unroll
                for (int g = 1; g < 4; ++g) le[j] = (gi == g) ? lg[4 + g * 8 + j] : le[j]; }
            int j1 = 0; float m1 = le[0];
#pragma unroll
            for (int j = 1; j < 8; ++j) if (le[j] > m1) { m1 = le[j]; j1 = j; }
            int j2 = -1; float m2 = -3.0e38f;
#pragma unroll
            for (int j = 0; j < 8; ++j) if (j != j1 && le[j] > m2) { m2 = le[j]; j2 = j; }
            const float ex = __expf(m2 - m1), w1 = pg / (1.f + ex), w2 = pg * ex / (1.f + ex);
            const int e1 = gi * 8 + j1, e2 = gi * 8 + j2, rw = r0 + lane;
            unsigned* ctl = (unsigned*)(ws + WS_CTL);
            int2* erec = (int2*)(ws + WS_EREC); int* clist = (int*)(ws + WS_CLIST);
            if constexpr (DRY) { ((int2*)(ws + WS_PROJ + 168 * MiB))[rw] = make_int2(e1 * 64 + e2, __builtin_bit_cast(int, w1 + w2)); } else {
            const unsigned p1 = atomicAdd(ctl + CW_ECNT + e1, 1u); erec[(size_t)e1 * TT + p1] = make_int2(rw * 2 + (e1 > e2 ? 1 : 0), __builtin_bit_cast(int, w1));
            const unsigned p2 = atomicAdd(ctl + CW_ECNT + e2, 1u); erec[(size_t)e2 * TT + p2] = make_int2(rw * 2 + (e2 > e1 ? 1 : 0), __builtin_bit_cast(int, w2));
            const int a = j1 < j2 ? j1 : j2, bb = j1 < j2 ? j2 : j1;
            const int cls = gi * 28 + (a * 7 - (a * (a - 1)) / 2 + (bb - a - 1));
            const unsigned pc = atomicAdd(ctl + CW_CCNT + cls, 1u); clist[(size_t)cls * TT + pc] = rw; }
        }
        LDS_WAIT(); asm volatile("" ::: "memory");
    }
#undef P7_LOADW
}

__device__ __forceinline__ int wave_incl_scan(int v, int lane) {
#pragma unroll
    for (int o = 1; o < 64; o <<= 1) { const int t = __shfl_up(v, o); if (lane >= o) v += t; }
    return v;
}
template <int NOPART = 0>
struct SchedET {
    int G, c, cntv, preF, erank, totF, totP; const int2* rec; const char* W;
    __device__ __forceinline__ void init(const unsigned* cnt, const int2* rec_, const char* W_, int G_, int c_, int lane) {
        G = G_; c = c_; rec = rec_; W = W_;
        cntv = lane < NE ? (int)cnt[lane] : 0;
        const int rem = cntv & 255;
        const int incF = wave_incl_scan(cntv >> 8, lane), incP = wave_incl_scan(rem ? 1 : 0, lane);
        totF = __builtin_amdgcn_readlane(incF, 63); totP = NOPART ? 0 : __builtin_amdgcn_readlane(incP, 63);
        preF = lane < NE ? incF : 0x7fffffff;
        int rank = 0;
        for (int l = 0; l < NE; ++l) { const int r2 = __builtin_amdgcn_readlane(rem, l); rank += (r2 > rem || (r2 == rem && l < lane)) ? 1 : 0; }
        erank = __builtin_amdgcn_ds_permute((lane < NE ? rank : lane) << 2, lane);
    }
    __device__ __forceinline__ bool next(int i, pg8::UnitG& u) const {
        const int L = i * G + c; if (L >= 2 * (totF + totP)) return false;
        if (L < 2 * totF) { const bool xm = L < ((2 * totF) & ~255);
            const int uu = xm ? (L & ~255) + 32 * (L & 7) + ((L & 255) >> 3) : L;
            const int ft = uu >> 1, pnv = uu & 1;
            const int e = __builtin_amdgcn_readfirstlane(__popcll(__ballot(preF <= ft)));
            const int base = e ? __builtin_amdgcn_readlane(preF, e - 1) : 0;
            u.id = e; u.tile = ft - base; u.pn = pnv; u.nrows = 256;
        } else { const int p = (L - 2 * totF) >> 1;
            const int e = __builtin_amdgcn_readlane(erank, p);
            const int cnt = __builtin_amdgcn_readlane(cntv, e);
            u.id = e; u.tile = cnt >> 8; u.pn = L & 1; u.nrows = cnt & 255; }
        return true;
    }
    __device__ __forceinline__ void tab_load(LAS unsigned char* tab, const pg8::UnitG& u, int wid, int lane) const {
        __builtin_amdgcn_global_load_lds((const unsigned*)((const char*)(rec + (size_t)u.id * TT + u.tile * 256) + wid * 256 + lane * 4), (LAS unsigned*)(tab + wid * 256), 4, 0, 0); }
    __device__ __forceinline__ int tok(const LAS unsigned char* tab, const pg8::UnitG& u, int r) const { return r < u.nrows ? (*(const LAS int*)(tab + r * 8) >> 1) : 0; }
    __device__ __forceinline__ const char* bseg(const pg8::UnitG& u, int) const { return W + ((size_t)u.id * 512 + u.pn * 256) * 1024; }
};
typedef SchedET<0> SchedE;
constexpr int PF_DUMP_OFF = RING_BYTES + 9216;
#ifndef MOE_PF
#define MOE_PF 0
#endif
struct EpiGU {
    static constexpr bool PERM = true, PREFETCH = (MOE_PF & 1) != 0;
    bf16* HID;
    __device__ __forceinline__ void prefetch(LAS unsigned char* lds, const char* Ab, const pg8::UnitG&, unsigned r0, unsigned r1, unsigned r2, unsigned r3, int pi0, int pi1, int wid) const {
        LAS unsigned* dump = (LAS unsigned*)(lds + PF_DUMP_OFF + wid * 256);
        if (pi0 < 6) { __builtin_amdgcn_global_load_lds((const unsigned*)(Ab + r0 + (2 + pi0) * 128), dump, 4, 0, 0); __builtin_amdgcn_global_load_lds((const unsigned*)(Ab + r2 + (2 + pi0) * 128), dump, 4, 0, 0); }
        if (pi1 < 6) { __builtin_amdgcn_global_load_lds((const unsigned*)(Ab + r1 + (2 + pi1) * 128), dump, 4, 0, 0); __builtin_amdgcn_global_load_lds((const unsigned*)(Ab + r3 + (2 + pi1) * 128), dump, 4, 0, 0); }
    }
    template <class SC> __device__ __forceinline__ void operator()(const pg8::f32x4 (&acc)[2][2][4][2], const pg8::UnitG& u, const SC& S, const LAS unsigned char* tab, int wr, int wc, int fr, int fq) const {
#pragma unroll
        for (int ai = 0; ai < 2; ++ai)
#pragma unroll
            for (int m = 0; m < 4; ++m) { const int r = ai * 128 + wr * 64 + m * 16 + fr;
                if (r < u.nrows) { const v2u rq = *(const LAS v2u*)(tab + r * 8); const int2 rc = make_int2((int)rq.x, (int)rq.y); const int t = rc.x >> 1, half = rc.x & 1; const float w = __builtin_bit_cast(float, rc.y);
                    float hv[8];
#pragma unroll
                    for (int n = 0; n < 2; ++n)
#pragma unroll
                        for (int j = 0; j < 4; ++j) { const float g = acc[ai][0][m][n][j] * (1.f / W8_SCALE), up = acc[ai][1][m][n][j] * (HID8_SCALE / W8_SCALE); hv[n * 4 + j] = w * siluf(g) * up; }
                    *(v2u8_t*)((unsigned char*)HID + (size_t)t * 512 + half * 256 + u.pn * 128 + wc * 32 + 8 * fq) = (v2u8_t){pk4f8(hv[0], hv[1], hv[2], hv[3]), pk4f8(hv[4], hv[5], hv[6], hv[7])}; } }
    }
};
struct SchedC {
    int G, c, cntA, cntB, preA, preB, total_rt; const int* clist; const char* W;
    __device__ __forceinline__ void init(const unsigned* cnt, const int* clist_, const char* W_, int G_, int c_, int lane) {
        G = G_; c = c_; clist = clist_; W = W_;
        cntA = (int)cnt[lane]; cntB = lane < NCLS - 64 ? (int)cnt[64 + lane] : 0;
        const int ia = wave_incl_scan((cntA + 255) >> 8, lane); const int ta = __builtin_amdgcn_readlane(ia, 63);
        const int ib = wave_incl_scan((cntB + 255) >> 8, lane) + ta;
        total_rt = __builtin_amdgcn_readlane(ib, 63);
        preA = ia; preB = lane < NCLS - 64 ? ib : 0x7fffffff;
    }
    __device__ __forceinline__ bool next(int i, pg8::UnitG& u) const {
        const int L = i * G + c; if (L >= 4 * total_rt) return false;
        const bool xm = L < ((4 * total_rt) & ~255);
        const int uu = xm ? (L & ~255) + 32 * (L & 7) + ((L & 255) >> 3) : L;
        const int rt = uu >> 2, pnv = uu & 3;
        const int cls = __builtin_amdgcn_readfirstlane(__popcll(__ballot(preA <= rt)) + __popcll(__ballot(preB <= rt)));
        int base = 0; if (cls > 0) base = (cls - 1 < 64) ? __builtin_amdgcn_readlane(preA, cls - 1) : __builtin_amdgcn_readlane(preB, cls - 65);
        const int cnt = cls < 64 ? __builtin_amdgcn_readlane(cntA, cls) : __builtin_amdgcn_readlane(cntB, cls - 64);
        u.id = cls; u.tile = rt - base; u.pn = pnv; const int rem = cnt - u.tile * 256; u.nrows = rem < 256 ? rem : 256;
        return true;
    }
    __device__ __forceinline__ void tab_load(LAS unsigned char* tab, const pg8::UnitG& u, int wid, int lane) const {
        if (wid < 4) __builtin_amdgcn_global_load_lds((const unsigned*)((const char*)(clist + (size_t)u.id * TT + u.tile * 256) + wid * 256 + lane * 4), (LAS unsigned*)(tab + wid * 256), 4, 0, 0); }
    __device__ __forceinline__ int tok(const LAS unsigned char* tab, const pg8::UnitG& u, int r) const { return r < u.nrows ? *(const LAS int*)(tab + r * 4) : 0; }
    __device__ __forceinline__ const char* bseg(const pg8::UnitG& u, int seg) const {
        const int g = u.id / 28; int a = 0, rem = u.id % 28; while (rem >= 7 - a) { rem -= 7 - a; ++a; } const int b = a + 1 + rem;
        const int e = g * 8 + (seg ? b : a);
        return W + ((size_t)e * 1024 + u.pn * 256) * 256;
    }
};
template <int VAR = 0>
struct EpiDownT {
    static constexpr bool PERM = false, PREFETCH = (MOE_PF & 2) != 0;
    float* OUT; const float* gate2;
    const bf16* X1;
    const LAS unsigned char* gt;
    __device__ __forceinline__ void prefetch(LAS unsigned char* lds, const char* Ab, const pg8::UnitG& u, unsigned r0, unsigned r1, unsigned r2, unsigned r3, int pi0, int pi1, int wid) const {
        LAS unsigned* dump = (LAS unsigned*)(lds + PF_DUMP_OFF + wid * 256);
        const char* xb = (const char*)X1 + (size_t)u.pn * 512;
#define PF_ONE(r, pi) do { if ((pi) < 2) __builtin_amdgcn_global_load_lds((const unsigned*)(Ab + (r) + (2 + (pi)) * 128), dump, 4, 0, 0); \
                           else if ((pi) < 6) __builtin_amdgcn_global_load_lds((const unsigned*)(xb + (size_t)((r) >> 9) * 2048 + ((pi) - 2) * 128), dump, 4, 0, 0); } while (0)
        PF_ONE(r0, pi0); PF_ONE(r2, pi0); PF_ONE(r1, pi1); PF_ONE(r3, pi1);
#undef PF_ONE
    }
    template <class SC> __device__ __forceinline__ void operator()(const pg8::f32x4 (&acc)[2][2][4][2], const pg8::UnitG& u, const SC& S, const LAS unsigned char* tab, int wr, int wc, int fr, int fq) const {
#pragma unroll
        for (int ai = 0; ai < 2; ++ai)
#pragma unroll
            for (int m = 0; m < 4; ++m) { const int r = ai * 128 + wr * 64 + m * 16 + fr;
                if (r < u.nrows) { const int t = *(const LAS int*)(tab + r * 4); const int b = t / SEQ; const int col0 = u.pn * 256 + wc * 32 + 4 * fq;
                    float* op = OUT + (size_t)t * DM + col0; const float* gp = gate2 + b * 6144 + col0;
#pragma unroll
                    for (int bj = 0; bj < 2; ++bj)
#pragma unroll
                        for (int n = 0; n < 2; ++n) { const int off = bj * 128 + n * 16; const v2u xq = *(const v2u*)(X1 + (size_t)t * DM + col0 + off);
                            const f32x4 xv = (f32x4){__builtin_bit_cast(float, xq.x << 16), __builtin_bit_cast(float, xq.x & 0xffff0000u), __builtin_bit_cast(float, xq.y << 16), __builtin_bit_cast(float, xq.y & 0xffff0000u)};
                            f32x4 gv;
                            if (VAR == 2) gv = (f32x4){1.f, 1.f, 1.f, 1.f};
                            else if (gt) { const v2u g2 = *(const LAS v2u*)(gt + (b * 1024 + col0 + off) * 2);
                                gv.x = __builtin_bit_cast(float, g2.x << 16); gv.y = __builtin_bit_cast(float, g2.x & 0xffff0000u); gv.z = __builtin_bit_cast(float, g2.y << 16); gv.w = __builtin_bit_cast(float, g2.y & 0xffff0000u); }
                            else gv = *(const f32x4*)(gp + off);
                            *(f32x4*)(op + off) = xv + gv * (acc[ai][bj][m][n] * (1.f / (W8_SCALE * HID8_SCALE))); } } }
    }
};
typedef EpiDownT<0> EpiDown;

__global__ void __launch_bounds__(NTHR, 2) fwd_kernel(Args args) {
    extern __shared__ __attribute__((aligned(16))) unsigned char lds_raw[];
    LAS unsigned char* lds = (LAS unsigned char*)lds_raw;
    volatile LAS unsigned* MISC = (volatile LAS unsigned*)(lds + MISC_OFF);
    const int G = gridDim.x;
    unsigned char* ws = args.ws;
    const int wave_s = __builtin_amdgcn_readfirstlane(threadIdx.x >> 6);
    for (int u = threadIdx.x; u < (LDS_BYTES - LDSCTL_OFF) / 4; u += NTHR) ((LAS unsigned*)(lds + LDSCTL_OFF))[u] = 0u;
    __syncthreads();
    const int lo = args.ph_lo, hi = args.ph_hi;
    const bool use_bar = (hi - lo) > 1;
    XcdBarrier bar; bar.bar = (unsigned*)(ws + WS_CTL) + CW_BAR; bar.x = 0; bar.st = nullptr;
    if (use_bar) bar = xcd_barrier_post((unsigned*)(ws + WS_CTL) + CW_BAR, MISC + 8, threadIdx.x == 0);
#define IN(k) (lo <= (k) && (k) < hi)
#define BOTH(k) (IN(k) && IN((k) + 1))
#if PROBE_REP == 1000
#define GRID_BAR(k) do { if (BOTH(k)) { xcd_barrier(bar, wave_s == 0 && __builtin_amdgcn_mbcnt_hi(~0u, __builtin_amdgcn_mbcnt_lo(~0u, 0u)) == 0u); xcd_barrier(bar, wave_s == 0 && __builtin_amdgcn_mbcnt_hi(~0u, __builtin_amdgcn_mbcnt_lo(~0u, 0u)) == 0u); } } while (0)
#else
#define GRID_BAR(k) do { if (BOTH(k)) xcd_barrier(bar, wave_s == 0 && __builtin_amdgcn_mbcnt_hi(~0u, __builtin_amdgcn_mbcnt_lo(~0u, 0u)) == 0u); } while (0)
#endif
#define FRESH_IDS() const int wave = wave_s; int lane = (int)__builtin_amdgcn_mbcnt_hi(~0u, __builtin_amdgcn_mbcnt_lo(~0u, 0u)); asm volatile("" : "+v"(lane)); const int tid = wave * 64 + lane; (void)tid
    const float* mod = (const float*)(ws + WS_MOD);

    if (IN(0)) { FRESH_IDS(); p0_prologue(args, lds, tid, lane, wave); GRID_BAR(0); }
    if (IN(1)) { FRESH_IDS(); norm_rows<false>(args, (const float*)args.in[I_X], (const float*)args.in[I_NORM_MIX], mod + 0, mod + 1024, (bf16*)(ws + WS_H), lds, lane, wave); GRID_BAR(1); }
    if (IN(2)) { FRESH_IDS();
        pg8::Gemm g{(const pg8::bf16_t*)(ws + WS_H), (const pg8::bf16_t*)(ws + WS_WINT), TT, NPAD, DM}; pg8::StaticOrder S; S.init(TT, NPAD, G, (int)blockIdx.x);
        pg8::EpiProj E{(pg8::bf16_t*)(ws + WS_PROJ), (float*)(ws + WS_AB), NPROJ};
        pg8::gemm_phase<pg8::EpiProj, pg8::StaticOrder, true, true>(lds, g, S, E);
        GRID_BAR(2);
    }
    if (IN(3)) { FRESH_IDS(); gdn_g1_mfma<31>(args, lds, tid, lane, wave); GRID_BAR(3); }
    if (IN(4)) { FRESH_IDS();
        if ((int)blockIdx.x < 32) gdn_scan(args, (int)blockIdx.x, lds, tid, lane, wave);
        else swa_mfma(args, lds, tid, lane, wave, (int)blockIdx.x - 32, G - 32);
        GRID_BAR(4);
    }
    if (IN(5)) { FRESH_IDS(); gdn_out(args, lds, lane, wave); GRID_BAR(5); }
    if (IN(6)) { FRESH_IDS();
        pg8::Gemm g{(const pg8::bf16_t*)(ws + WS_MIX), (const pg8::bf16_t*)(ws + WS_WOUTT), TT, DM, DM}; pg8::StaticOrder S; S.init(TT, DM, G, (int)blockIdx.x);
        pg8::EpiOut E{(const float*)args.in[I_X], (pg8::bf16_t*)(ws + WS_X1B), mod + 2048, SEQ, 6144, (float*)(ws + WS_SSQ)};
        const bool first = ((blockIdx.x >> 3) & 1) != 0;
        if (first) { expert_weight_copy(args, lds, lane, wave); __syncthreads(); }
        pg8::gemm_phase<pg8::EpiOut, pg8::StaticOrder, true, true>(lds, g, S, E);
        if (!first) { __syncthreads(); expert_weight_copy(args, lds, lane, wave); }
        GRID_BAR(6);
    }
    if (IN(7)) { FRESH_IDS(); norm_route_mfma<false>(args, (const bf16*)(ws + WS_X1B), (const float*)(ws + WS_SSQ), (const float*)args.in[I_NORM_FFN], mod + 3072, mod + 4096, (bf16*)(ws + WS_H), lds, tid, lane, wave); GRID_BAR(7); }
    if (IN(8)) { FRESH_IDS();
        SchedE S; S.init((const unsigned*)(ws + WS_CTL) + CW_ECNT, (const int2*)(ws + WS_EREC), (const char*)(ws + WS_WGUT), G, (int)blockIdx.x, lane);
        EpiGU E{(bf16*)(ws + WS_HID)};
        pg8::gemm_phase_g<EpiGU, SchedE, true>(lds, (const pg8::bf16_t*)(ws + WS_H), 512, 512, 8, 8, S, E);
        GRID_BAR(8);
    }
    if (IN(9)) { FRESH_IDS();
        SchedC S; S.init((const unsigned*)(ws + WS_CTL) + CW_CCNT, (const int*)(ws + WS_CLIST), (const char*)(ws + WS_WDT), G, (int)blockIdx.x, lane);
        LAS unsigned char* gtl = lds + RING_BYTES + 512;
        for (int q = tid; q < 4096; q += NTHR) *(LAS unsigned short*)(gtl + q * 2) = (unsigned short)f2bf(mod[(q >> 10) * 6144 + 5120 + (q & 1023)]);
        __syncthreads();
        EpiDown E{args.out, mod + 5120, (const bf16*)(ws + WS_X1B), gtl};
        pg8::gemm_phase_g<EpiDown, SchedC, true>(lds, (const pg8::bf16_t*)(ws + WS_HID), 256, 128, 4, 2, S, E);
    }
#undef IN
#undef BOTH
#undef GRID_BAR
}

#if PROBE_REP >= 0 && PROBE_REP < 1000
template <int P>
__global__ void __launch_bounds__(NTHR, 2) probe_kernel(Args args) {
    extern __shared__ __attribute__((aligned(16))) unsigned char lds_raw[];
    LAS unsigned char* lds = (LAS unsigned char*)lds_raw;
    const int tid = threadIdx.x, lane = tid & 63, wave = __builtin_amdgcn_readfirstlane(tid >> 6);
    const int G = gridDim.x; unsigned char* ws = args.ws; const float* mod = (const float*)(ws + WS_MOD);
    if constexpr (P == 1) norm_rows<false>(args, (const float*)args.in[I_X], (const float*)args.in[I_NORM_MIX], mod + 0, mod + 1024, (bf16*)(ws + WS_GAP + 0)  , lds, lane, wave);
    if constexpr (P == 2) { pg8::Gemm g{(const pg8::bf16_t*)(ws + WS_H), (const pg8::bf16_t*)(ws + WS_WINT), TT, NPAD, DM}; pg8::StaticOrder S; S.init(TT, NPAD, G, (int)blockIdx.x);
        pg8::EpiProj E{(pg8::bf16_t*)(ws + WS_PROJ), (float*)(ws + WS_AB), NPROJ}; pg8::gemm_phase<pg8::EpiProj, pg8::StaticOrder, true, true>(lds, g, S, E); }
    if constexpr (P == 0) p0_prologue(args, lds, tid, lane, wave);
    if constexpr (P == 4) gdn_g1_mfma<31>(args, lds, tid, lane, wave);
    if constexpr (P == 40) gdn_g1_mfma<31, 0>(args, lds, tid, lane, wave);
    if constexpr (P == 41) gdn_g1_mfma<31, 1>(args, lds, tid, lane, wave);
    if constexpr (P == 42) gdn_g1_mfma<31, 3>(args, lds, tid, lane, wave);
    if constexpr (P == 43) gdn_g1_mfma<0, 7>(args, lds, tid, lane, wave);
    if constexpr (P == 50) { if ((int)blockIdx.x < 32) gdn_scan(args, (int)blockIdx.x, lds, tid, lane, wave); }
    if constexpr (P == 501) { if ((int)blockIdx.x < 32) gdn_scan<1>(args, (int)blockIdx.x, lds, tid, lane, wave); }
    if constexpr (P == 502) { if ((int)blockIdx.x < 32) gdn_scan<2>(args, (int)blockIdx.x, lds, tid, lane, wave); }
    if constexpr (P == 52) gdn_out(args, lds, lane, wave);
    if constexpr (P == 51) { if ((int)blockIdx.x >= 32) swa_mfma(args, lds, tid, lane, wave, (int)blockIdx.x - 32, G - 32); }
    if constexpr (P == 60) expert_weight_copy(args, lds, lane, wave);
    if constexpr (P == 61) { pg8::Gemm g{(const pg8::bf16_t*)(ws + WS_MIX), (const pg8::bf16_t*)(ws + WS_WOUTT), TT, DM, DM}; pg8::StaticOrder S; S.init(TT, DM, G, (int)blockIdx.x);
        pg8::EpiOut E{(const float*)args.in[I_X], (pg8::bf16_t*)(ws + WS_X1B)  , mod + 2048, SEQ, 6144, nullptr};
        const bool first = ((blockIdx.x >> 3) & 1) != 0;
        if (first) { expert_weight_copy(args, lds, lane, wave); __syncthreads(); }
        pg8::gemm_phase<pg8::EpiOut, pg8::StaticOrder, true, true>(lds, g, S, E);
        if (!first) { __syncthreads(); expert_weight_copy(args, lds, lane, wave); } }
    if constexpr (P == 6) { pg8::Gemm g{(const pg8::bf16_t*)(ws + WS_MIX), (const pg8::bf16_t*)(ws + WS_WOUTT), TT, DM, DM}; pg8::StaticOrder S; S.init(TT, DM, G, (int)blockIdx.x);
        pg8::EpiOut E{(const float*)args.in[I_X], (pg8::bf16_t*)(ws + WS_X1B)  , mod + 2048, SEQ, 6144, nullptr}; pg8::gemm_phase<pg8::EpiOut, pg8::StaticOrder, true, true>(lds, g, S, E); }
    if constexpr (P == 81) { SchedET<1> S; S.init((const unsigned*)(ws + WS_CTL) + CW_ECNT, (const int2*)(ws + WS_EREC), (const char*)(ws + WS_WGUT), G, (int)blockIdx.x, lane);
        EpiGU E{(bf16*)(ws + WS_HID)}; pg8::gemm_phase_g<EpiGU, SchedET<1>, true>(lds, (const pg8::bf16_t*)(ws + WS_H), 512, 512, 8, 8, S, E); }
    if constexpr (P == 8) { SchedE S; S.init((const unsigned*)(ws + WS_CTL) + CW_ECNT, (const int2*)(ws + WS_EREC), (const char*)(ws + WS_WGUT), G, (int)blockIdx.x, lane);
        EpiGU E{(bf16*)(ws + WS_HID)}; pg8::gemm_phase_g<EpiGU, SchedE, true>(lds, (const pg8::bf16_t*)(ws + WS_H), 512, 512, 8, 8, S, E); }
    if constexpr (P == 71) norm_route_mfma<true, 1>(args, (const bf16*)(ws + WS_X1B), (const float*)(ws + WS_SSQ), (const float*)args.in[I_NORM_FFN], mod + 3072, mod + 4096, (bf16*)(ws + WS_GSF), lds, tid, lane, wave);
    if constexpr (P == 7) norm_route_mfma<true>(args, (const bf16*)(ws + WS_X1B), (const float*)(ws + WS_SSQ), (const float*)args.in[I_NORM_FFN], mod + 3072, mod + 4096, (bf16*)(ws + WS_GSF), lds, tid, lane, wave);
    if constexpr (P == 91 || P == 92) { SchedC S; S.init((const unsigned*)(ws + WS_CTL) + CW_CCNT, (const int*)(ws + WS_CLIST), (const char*)(ws + WS_WDT), G, (int)blockIdx.x, lane);
        EpiDownT<P - 90> E{args.out  , mod + 5120, (const bf16*)(ws + WS_X1B), nullptr}; pg8::gemm_phase_g<EpiDownT<P - 90>, SchedC, true>(lds, (const pg8::bf16_t*)(ws + WS_HID), 256, 128, 4, 2, S, E); }
    if constexpr (P == 9) { SchedC S; S.init((const unsigned*)(ws + WS_CTL) + CW_CCNT, (const int*)(ws + WS_CLIST), (const char*)(ws + WS_WDT), G, (int)blockIdx.x, lane);
        EpiDown E{args.out  , mod + 5120, (const bf16*)(ws + WS_X1B), nullptr}; pg8::gemm_phase_g<EpiDown, SchedC, true>(lds, (const pg8::bf16_t*)(ws + WS_HID), 256, 128, 4, 2, S, E); }
}
#endif
extern "C" void kernel_launch(void* const* d_in, const int* in_sizes, int n_in, void* d_out, int out_size, void* d_ws, size_t ws_size, hipStream_t stream) {
    static int grid = 0;
    if (grid == 0) {
        if (n_in != 23 || in_sizes[0] != TT * DM || out_size != TT * DM || ws_size < WS_END) { fprintf(stderr, "kernel_launch: unexpected shapes: n_in %d in0 %d out %d ws %zu (need %zu)\n", n_in, n_in > 0 ? in_sizes[0] : -1, out_size, ws_size, (size_t)WS_END); grid = -1; return; }
        int dev = 0, cus = 0, per_cu = 0;
        if (hipGetDevice(&dev) != hipSuccess || hipDeviceGetAttribute(&cus, hipDeviceAttributeMultiprocessorCount, dev) != hipSuccess) { grid = -1; return; }
        if (hipFuncSetAttribute((const void*)fwd_kernel, hipFuncAttributeMaxDynamicSharedMemorySize, LDS_BYTES) != hipSuccess) { fprintf(stderr, "kernel_launch: hipFuncSetAttribute failed\n"); grid = -1; return; }
        if (hipOccupancyMaxActiveBlocksPerMultiprocessor(&per_cu, (const void*)fwd_kernel, NTHR, LDS_BYTES) != hipSuccess || per_cu < 1) fprintf(stderr, "kernel_launch: occupancy query reports %d\n", per_cu);
        (void)hipGetLastError();
        grid = cus;
    }
    if (grid < 0) return;
    if (hipMemsetAsync((char*)d_ws + WS_CTL, 0, CTL_ZERO_BYTES, stream) != hipSuccess) { fprintf(stderr, "kernel_launch: memset failed\n"); return; }
    Args a{};
    for (int i = 0; i < 23; ++i) a.in[i] = d_in[i];
    a.out = (float*)d_out; a.ws = (unsigned char*)d_ws;
#if MK_ONE_LAUNCH
    a.ph_lo = 0; a.ph_hi = N_PHASES;
    hipLaunchKernelGGL(fwd_kernel, dim3(grid), dim3(NTHR), LDS_BYTES, stream, a);
#if PROBE_REP >= 0 && PROBE_REP < 1000
    hipFuncSetAttribute((const void*)probe_kernel<PROBE_REP>, hipFuncAttributeMaxDynamicSharedMemorySize, LDS_BYTES);
    hipLaunchKernelGGL(probe_kernel<PROBE_REP>, dim3(grid), dim3(NTHR), LDS_BYTES, stream, a);
#endif
#else
    for (int p = 0; p < N_PHASES; ++p) { a.ph_lo = p; a.ph_hi = p + 1; hipLaunchKernelGGL(fwd_kernel, dim3(grid), dim3(NTHR), LDS_BYTES, stream, a); }
#endif
}
```
